# Optimizing an MI355X kernel written in HIP

```python
import math
import jax
import jax.numpy as jnp
from jax import lax
import numpy as np

D_MODEL = 1024
BATCH = 8
SEQ = 2048
DEPTH = 1
DEC_BATCH = 128
DEC_SEQ = 1
PAST_LEN = 8192
PAGE_SIZE = 128

N_META = 16
SSD_HEADS = 8
SSD_HEAD_DIM = 64
SSD_WIDTH = SSD_HEADS * SSD_HEAD_DIM
SSD_GROUPS = 2
D_STATE = 64
CONV_W = 4
CONV_DIM = SSD_WIDTH + 2 * SSD_GROUPS * D_STATE
SSD_CHUNK = 128
MLA_HEADS = 8
QK_NOPE = 64
QK_ROPE = 32
QK_DIM = QK_NOPE + QK_ROPE
V_DIM = 64
MLA_WIDTH = MLA_HEADS * V_DIM
Q_LORA = 384
KV_LORA = 256
ROPE_THETA = 10000.0
Q_BLOCK = 128
ATTN_SCALE = QK_DIM ** -0.5
D_FF = -(-8 * D_MODEL // (3 * 256)) * 256
EPS = 1e-6
IN_COLS = SSD_WIDTH + CONV_DIM + SSD_HEADS + Q_LORA + KV_LORA + QK_ROPE
IN_SPLITS = (SSD_WIDTH, SSD_WIDTH + CONV_DIM, SSD_WIDTH + CONV_DIM + SSD_HEADS,
             SSD_WIDTH + CONV_DIM + SSD_HEADS + Q_LORA, IN_COLS - QK_ROPE)

kernel_name = 'hybrid_ssd_mla_meta_decoder_step'


def rmsnorm(x, g):
    xf = x.astype(jnp.float32)
    r = lax.rsqrt(jnp.mean(xf * xf, axis=-1, keepdims=True) + EPS)
    return (xf * r * g.astype(jnp.float32)).astype(x.dtype)


def rope_angles(pos):
    inv = ROPE_THETA ** (-jnp.arange(QK_ROPE // 2, dtype=jnp.float32) * (2.0 / QK_ROPE))
    ang = pos.astype(jnp.float32)[:, None] * inv[None, :]
    return jnp.cos(ang), jnp.sin(ang)


def apply_rope(x, cos, sin):
    xf = x.astype(jnp.float32)
    x1, x2 = xf[..., :QK_ROPE // 2], xf[..., QK_ROPE // 2:]
    return jnp.concatenate([x1 * cos - x2 * sin, x1 * sin + x2 * cos], axis=-1).astype(x.dtype)


def head_gain(g_nope, g_rope):
    return jnp.concatenate([g_nope, g_rope, g_rope], axis=-1)


def project(x, g, w):
    return jnp.split(rmsnorm(x, g) @ w, IN_SPLITS, axis=-1)


def causal_conv(xpad, w, b):
    L = xpad.shape[1] - (CONV_W - 1)
    out = b
    for k in range(CONV_W):
        out = out + xpad[:, k:k + L] * w[k]
    return out


def ssd_scan(x, dt, A, Bm, Cm, h0, chunk):
    b, l, h, p = x.shape
    n = Bm.shape[-1]
    c = l // chunk
    rep = h // Bm.shape[2]
    Bh = jnp.repeat(Bm.astype(jnp.float32), rep, axis=2).reshape(b, c, chunk, h, n)
    Ch = jnp.repeat(Cm.astype(jnp.float32), rep, axis=2).reshape(b, c, chunk, h, n)
    xf = x.astype(jnp.float32).reshape(b, c, chunk, h, p)
    dtc = dt.reshape(b, c, chunk, h)
    acs = jnp.cumsum(dtc * A, axis=2)
    seg = acs[:, :, :, None, :] - acs[:, :, None, :, :]
    causal = jnp.tril(jnp.ones((chunk, chunk), dtype=bool))[None, None, :, :, None]
    Lmat = jnp.exp(jnp.where(causal, seg, -jnp.inf))
    scores = jnp.einsum('bcihn,bcjhn->bcijh', Ch, Bh) * Lmat * dtc[:, :, None, :, :]
    y_diag = jnp.einsum('bcijh,bcjhp->bcihp', scores, xf)
    decay = jnp.exp(acs[:, :, -1:, :] - acs)
    states = jnp.einsum('bcjhn,bcjh,bcjhp->bchpn', Bh, decay * dtc, xf)
    chunk_decay = jnp.exp(acs[:, :, -1, :])

    def step(hc, inp):
        st, dec = inp
        return hc * dec[:, :, None, None] + st, hc

    h_final, h_in = lax.scan(step, h0.astype(jnp.float32),
                             (jnp.transpose(states, (1, 0, 2, 3, 4)), jnp.transpose(chunk_decay, (1, 0, 2))))
    h_in = jnp.transpose(h_in, (1, 0, 2, 3, 4))
    y_off = jnp.einsum('bcihn,bchpn,bcih->bcihp', Ch, h_in, jnp.exp(acs))
    return (y_diag + y_off).reshape(b, l, h, p), h_final


def ssd_branch(z, xpad, dt_raw, h0, segments, conv_w, conv_b, dt_bias, a_log, d_skip, norm_g):
    xa = jax.nn.silu(causal_conv(xpad, conv_w, conv_b))
    b, t = xa.shape[:2]
    gn = SSD_GROUPS * D_STATE
    xs = xa[..., :SSD_WIDTH].reshape(b, t, SSD_HEADS, SSD_HEAD_DIM)
    Bm = xa[..., SSD_WIDTH:SSD_WIDTH + gn].reshape(b, t, SSD_GROUPS, D_STATE)
    Cm = xa[..., SSD_WIDTH + gn:].reshape(b, t, SSD_GROUPS, D_STATE)
    dt = jax.nn.softplus(dt_raw.astype(jnp.float32) + dt_bias.astype(jnp.float32))
    A = -jnp.exp(a_log.astype(jnp.float32))
    ys = []
    h = h0.astype(jnp.float32)
    start = 0
    for length, chunk in segments:
        sl = slice(start, start + length)
        y, h = ssd_scan(xs[:, sl], dt[:, sl], A, Bm[:, sl], Cm[:, sl], h, chunk)
        ys.append(y)
        start += length
    y = jnp.concatenate(ys, axis=1)
    y = y + d_skip.astype(jnp.float32)[:, None] * xs.astype(jnp.float32)
    y = y.reshape(b, t, SSD_WIDTH) * jax.nn.silu(z.astype(jnp.float32))
    yg = y.reshape(b, t, SSD_GROUPS, SSD_WIDTH // SSD_GROUPS)
    yg = yg * lax.rsqrt(jnp.mean(yg * yg, axis=-1, keepdims=True) + EPS)
    out = (yg.reshape(b, t, SSD_WIDTH) * norm_g.astype(jnp.float32)).astype(z.dtype)
    return out, h, xpad[:, -(CONV_W - 1):]


def mla_queries(c_q, g_qn, w_uq, cos, sin, gq):
    b, t = c_q.shape[:2]
    q = (rmsnorm(c_q, g_qn) @ w_uq).reshape(b, t, MLA_HEADS, QK_DIM)
    q = jnp.concatenate([q[..., :QK_NOPE], apply_rope(q[..., QK_NOPE:], cos, sin)], axis=-1)
    return rmsnorm(q, gq)


def mla_keys_values(lat, kr, w_ukv, gk):
    b, t = lat.shape[:2]
    kv = (lat @ w_ukv).reshape(b, t, MLA_HEADS, QK_NOPE + V_DIM)
    kr_h = jnp.broadcast_to(kr[:, :, None, :], (b, t, MLA_HEADS, QK_ROPE)).astype(kv.dtype)
    k = jnp.concatenate([kv[..., :QK_NOPE], kr_h], axis=-1)
    return rmsnorm(k, gk), kv[..., QK_NOPE:]


def block_causal_attention(q, k, v):
    b, t, h, _ = q.shape
    nb = -(-t // Q_BLOCK)
    tp = nb * Q_BLOCK
    pad = ((0, 0), (0, tp - t), (0, 0), (0, 0))
    qp, kp, vp = jnp.pad(q, pad), jnp.pad(k, pad), jnp.pad(v, pad)
    kpos = jnp.arange(tp)

    def blk(start):
        qb = lax.dynamic_slice_in_dim(qp, start, Q_BLOCK, axis=1)
        s = jnp.einsum('bqhd,bkhd->bhqk', qb, kp).astype(jnp.float32) * ATTN_SCALE
        qpos = start + jnp.arange(Q_BLOCK)
        s = jnp.where(kpos[None, :] <= qpos[:, None], s, -jnp.inf)
        p = jax.nn.softmax(s, axis=-1)
        return jnp.einsum('bhqk,bkhd->bqhd', p.astype(vp.dtype), vp)

    o = lax.map(blk, jnp.arange(nb) * Q_BLOCK)
    return jnp.transpose(o, (1, 0, 2, 3, 4)).reshape(b, tp, h, V_DIM)[:, :t]


def paged_attention(q, k_new, v_new, lat_pool, kr_pool, layer, page_table, w_ukv, gk):
    b, s, h, _ = q.shape
    qf = q.astype(jnp.float32)

    def update(carry, k, v, mask):
        m, l, acc = carry
        sc = jnp.einsum('bshd,bkhd->bhsk', qf, k.astype(jnp.float32)) * ATTN_SCALE
        if mask is not None:
            sc = jnp.where(mask, sc, -jnp.inf)
        m_new = jnp.maximum(m, jnp.max(sc, axis=-1))
        p = jnp.exp(sc - m_new[..., None])
        corr = jnp.exp(m - m_new)
        acc = acc * corr[..., None] + jnp.einsum('bhsk,bkhd->bhsd', p, v.astype(jnp.float32))
        return m_new, l * corr + jnp.sum(p, axis=-1), acc

    def page_step(carry, pids):
        k, v = mla_keys_values(lat_pool[layer, pids], kr_pool[layer, pids], w_ukv, gk)
        return update(carry, k, v, None), None

    init = (jnp.full((b, h, s), -jnp.inf, jnp.float32), jnp.zeros((b, h, s), jnp.float32),
            jnp.zeros((b, h, s, V_DIM), jnp.float32))
    carry, _ = lax.scan(page_step, init, page_table.T)
    causal = jnp.tril(jnp.ones((s, s), dtype=bool))[None, None]
    m, l, acc = update(carry, k_new, v_new, causal)
    o = acc / l[..., None]
    return jnp.transpose(o, (0, 2, 1, 3)).astype(q.dtype)


def finish_layer(x, ssd_out, att, mla_out_g, w_out, ffn_norm_g, w_gate, w_up, w_down):
    b, t = x.shape[:2]
    mla_out = rmsnorm(att.reshape(b, t, MLA_WIDTH), mla_out_g)
    h = x + jnp.concatenate([ssd_out, mla_out], axis=-1) @ w_out
    n = rmsnorm(h, ffn_norm_g)
    return h + (jax.nn.silu(n @ w_gate) * (n @ w_up)) @ w_down


def setup_inputs(seed: int = 0) -> dict:
    key = jax.random.key(seed)
    ks = jax.random.split(key, 32)

    def nrm(i, shape, scale):
        return jax.random.normal(ks[i], shape, jnp.float32) * scale

    def gain(i, shape):
        return 1.0 + nrm(i, shape, 0.02)

    L = DEPTH
    n_pages = PAST_LEN // PAGE_SIZE
    n_used = DEC_BATCH * n_pages
    n_pool = n_used + max(1, n_used // 4)
    page_table = jax.random.permutation(ks[0], n_pool)[:n_used].reshape(DEC_BATCH, n_pages).astype(jnp.int32)
    dt0 = jnp.exp(jax.random.uniform(ks[1], (L, SSD_HEADS), jnp.float32,
                                     minval=math.log(1e-3), maxval=math.log(1e-1)))
    dt_bias = dt0 + jnp.log(-jnp.expm1(-dt0))
    a_log = jnp.log(jax.random.uniform(ks[2], (L, SSD_HEADS), jnp.float32, minval=1.0, maxval=16.0))
    mix = SSD_WIDTH + MLA_WIDTH
    return {
        'x_prompt': nrm(3, (BATCH, SEQ, D_MODEL), 1.0),
        'x_sample': nrm(4, (DEC_BATCH, DEC_SEQ, D_MODEL), 1.0),
        'cache_kv_latent': nrm(5, (L, n_pool, PAGE_SIZE, KV_LORA), 1.0),
        'cache_k_rope': nrm(6, (L, n_pool, PAGE_SIZE, QK_ROPE), 1.0),
        'state_conv': nrm(7, (L, DEC_BATCH, CONV_W - 1, CONV_DIM), 1.0),
        'state_ssm': nrm(8, (L, DEC_BATCH, SSD_HEADS, SSD_HEAD_DIM, D_STATE), 0.1),
        'page_table': page_table,
        'meta_tokens': nrm(9, (N_META, D_MODEL), 1.0),
        'attn_norm_g': gain(10, (L, D_MODEL)),
        'w_in': nrm(11, (L, D_MODEL, IN_COLS), D_MODEL ** -0.5),
        'conv_w': nrm(12, (L, CONV_W, CONV_DIM), CONV_W ** -0.5),
        'conv_b': nrm(13, (L, CONV_DIM), 0.02),
        'dt_bias': dt_bias,
        'a_log': a_log,
        'd_skip': gain(14, (L, SSD_HEADS)),
        'ssd_norm_g': gain(15, (L, SSD_WIDTH)),
        'q_norm_g': gain(16, (L, Q_LORA)),
        'w_uq': nrm(17, (L, Q_LORA, MLA_HEADS * QK_DIM), Q_LORA ** -0.5),
        'kv_norm_g': gain(18, (L, KV_LORA)),
        'w_ukv': nrm(19, (L, KV_LORA, MLA_HEADS * (QK_NOPE + V_DIM)), KV_LORA ** -0.5),
        'q_head_g_nope': gain(20, (L, QK_NOPE)),
        'q_head_g_rope': gain(21, (L, QK_ROPE // 2)),
        'k_head_g_nope': gain(22, (L, QK_NOPE)),
        'k_head_g_rope': gain(23, (L, QK_ROPE // 2)),
        'mla_out_g': gain(24, (L, MLA_WIDTH)),
        'w_out': nrm(25, (L, mix, D_MODEL), mix ** -0.5),
        'ffn_norm_g': gain(26, (L, D_MODEL)),
        'w_gate': nrm(27, (L, D_MODEL, D_FF), D_MODEL ** -0.5),
        'w_up': nrm(28, (L, D_MODEL, D_FF), D_MODEL ** -0.5),
        'w_down': nrm(29, (L, D_FF, D_MODEL), D_FF ** -0.5),
    }


def reference(x_prompt, x_sample, cache_kv_latent, cache_k_rope, state_conv, state_ssm, page_table,
              meta_tokens, attn_norm_g, w_in, conv_w, conv_b, dt_bias, a_log, d_skip, ssd_norm_g,
              q_norm_g, w_uq, kv_norm_g, w_ukv, q_head_g_nope, q_head_g_rope, k_head_g_nope,
              k_head_g_rope, mla_out_g, w_out, ffn_norm_g, w_gate, w_up, w_down):
    b = x_prompt.shape[0]
    hp = jnp.concatenate([jnp.broadcast_to(meta_tokens[None].astype(x_prompt.dtype), (b, N_META, D_MODEL)),
                          x_prompt], axis=1)
    hs = x_sample
    t = hp.shape[1]
    s = hs.shape[1]
    past = page_table.shape[1] * cache_kv_latent.shape[2]
    cos_p, sin_p = rope_angles(jnp.arange(t))
    cos_s, sin_s = rope_angles(past + jnp.arange(s))
    lat_p_l, kr_p_l, conv_p_l, ssm_p_l = [], [], [], []
    lat_s_l, kr_s_l, conv_s_l, ssm_s_l = [], [], [], []
    for l in range(DEPTH):
        gq = head_gain(q_head_g_nope[l], q_head_g_rope[l])
        gk = head_gain(k_head_g_nope[l], k_head_g_rope[l])
        ssd_w = (conv_w[l], conv_b[l], dt_bias[l], a_log[l], d_skip[l], ssd_norm_g[l])
        ffn_w = (mla_out_g[l], w_out[l], ffn_norm_g[l], w_gate[l], w_up[l], w_down[l])

        z, xbc, dt_raw, c_q, c_kv, kr_raw = project(hp, attn_norm_g[l], w_in[l])
        xpad = jnp.concatenate([jnp.zeros((b, CONV_W - 1, CONV_DIM), xbc.dtype), xbc], axis=1)
        h0 = jnp.zeros((b, SSD_HEADS, SSD_HEAD_DIM, D_STATE), jnp.float32)
        ssd_p, h_p, conv_p = ssd_branch(z, xpad, dt_raw, h0, ((N_META, N_META), (t - N_META, SSD_CHUNK)), *ssd_w)
        lat_p = rmsnorm(c_kv, kv_norm_g[l])
        kr_p = apply_rope(kr_raw, cos_p[None], sin_p[None])
        q = mla_queries(c_q, q_norm_g[l], w_uq[l], cos_p[None, :, None], sin_p[None, :, None], gq)
        k, v = mla_keys_values(lat_p, kr_p, w_ukv[l], gk)
        att_p = block_causal_attention(q, k, v)
        hp = finish_layer(hp, ssd_p, att_p, *ffn_w)

        z, xbc, dt_raw, c_q, c_kv, kr_raw = project(hs, attn_norm_g[l], w_in[l])
        xpad = jnp.concatenate([state_conv[l].astype(xbc.dtype), xbc], axis=1)
        ssd_s, h_s, conv_s = ssd_branch(z, xpad, dt_raw, state_ssm[l], ((s, s),), *ssd_w)
        lat_s = rmsnorm(c_kv, kv_norm_g[l])
        kr_s = apply_rope(kr_raw, cos_s[None], sin_s[None])
        q = mla_queries(c_q, q_norm_g[l], w_uq[l], cos_s[None, :, None], sin_s[None, :, None], gq)
        k, v = mla_keys_values(lat_s, kr_s, w_ukv[l], gk)
        att_s = paged_attention(q, k, v, cache_kv_latent, cache_k_rope, l, page_table, w_ukv[l], gk)
        hs = finish_layer(hs, ssd_s, att_s, *ffn_w)

        lat_p_l.append(lat_p)
        kr_p_l.append(kr_p)
        conv_p_l.append(conv_p)
        ssm_p_l.append(h_p.astype(x_prompt.dtype))
        lat_s_l.append(lat_s)
        kr_s_l.append(kr_s)
        conv_s_l.append(conv_s)
        ssm_s_l.append(h_s.astype(state_ssm.dtype))

    y_prompt = hp[:, N_META:]
    y_sample = hs
    return (y_prompt, y_sample,
            jnp.stack(lat_p_l), jnp.stack(kr_p_l), jnp.stack(conv_p_l), jnp.stack(ssm_p_l),
            jnp.stack(lat_s_l), jnp.stack(kr_s_l), jnp.stack(conv_s_l), jnp.stack(ssm_s_l))
```

```cpp
#define MK_DIAG 0
#define MK_ONE_LAUNCH 1
#include <hip/hip_runtime.h>
#include <cstdio>
#include <cstdint>
namespace nv {
constexpr int DM = 1024, NB = 8, SEQ = 2048, NMETA = 16, T = SEQ + NMETA;
constexpr int DB = 128, PAST = 8192, PAGE = 128, NPAGES = 64;
constexpr int NH = 8, HP = 64, SSDW = 512, NG = 2, DS = 64, CONVD = 768;
constexpr int QKN = 64, QKR = 32, QKD = 96, VD = 64, MLAW = 512, QL = 384, KVL = 256;
constexpr int DFF = 2816, INC = 1960;
constexpr int O_Z = 0, O_XBC = 512, O_DT = 1280, O_CQ = 1288, O_CKV = 1672, O_KR = 1928;
constexpr int RP = NB * T;
constexpr int R = RP + DB;
constexpr float EPS = 1e-6f;
constexpr float ATTN_SCALE = 0.10206207261596577f;
constexpr size_t OUT_YP = 0, OUT_YS = 16777216, OUT_LATP = 16908288, OUT_KRP = 21135360, OUT_CONVP = 21663744,
                 OUT_SSMP = 21682176, OUT_LATS = 21944320, OUT_KRS = 21977088, OUT_CONVS = 21981184, OUT_SSMS = 22276096,
                 OUT_TOTAL = 26470400;

__device__ __forceinline__ float wsum(float v) {
#pragma unroll
    for (int o = 32; o > 0; o >>= 1) v += __shfl_xor(v, o);
    return v;
}
__device__ __forceinline__ float wmax(float v) {
#pragma unroll
    for (int o = 32; o > 0; o >>= 1) v = fmaxf(v, __shfl_xor(v, o));
    return v;
}
__device__ __forceinline__ float silu_f(float x) { return x / (1.f + expf(-x)); }
__device__ __forceinline__ float softplus_f(float x) { return fmaxf(x, 0.f) + log1pf(expf(-fabsf(x))); }
__device__ __forceinline__ float rope_inv(int j) { return exp2f(-(float)j * (13.287712379549449f / 16.0f)); }

__global__ void k_build_x(const float* xp, const float* xs, const float* meta, float* X) {
    const int row = blockIdx.x; const int tid = threadIdx.x;
    const float* src;
    if (row < RP) { const int b = row / T, t = row % T; src = (t < NMETA) ? meta + (size_t)t * DM : xp + ((size_t)b * SEQ + (t - NMETA)) * DM; }
    else src = xs + (size_t)(row - RP) * DM;
    ((float4*)(X + (size_t)row * DM))[tid] = ((const float4*)src)[tid];
}
__global__ void k_rmsnorm(const float* in, int ldi, int ic, int n, const float* g, float* out, int ldo, int oc, int rows) {
    const int row = blockIdx.x * 4 + (threadIdx.x >> 6), lane = threadIdx.x & 63;
    if (row >= rows) return;
    const float* x = in + (size_t)row * ldi + ic;
    float s = 0.f;
    for (int i = lane; i < n; i += 64) { const float v = x[i]; s += v * v; }
    s = wsum(s);
    const float r = 1.0f / sqrtf(s / (float)n + EPS);
    float* o = out + (size_t)row * ldo + oc;
    for (int i = lane; i < n; i += 64) o[i] = x[i] * r * g[i];
}
__global__ void __launch_bounds__(256) k_gemm(const float* A, int lda, const float* B, int ldb, float* C, int ldc, const float* Rs, int ldr, int M, int N, int K) {
    __shared__ float As[16][68];
    __shared__ float Bs[16][68];
    const int tid = threadIdx.x, tx = tid & 15, ty = tid >> 4;
    const int m0 = blockIdx.y * 64, n0 = blockIdx.x * 64;
    float acc[4][4];
#pragma unroll
    for (int i = 0; i < 4; ++i)
#pragma unroll
        for (int j = 0; j < 4; ++j) acc[i][j] = 0.f;
    for (int k0 = 0; k0 < K; k0 += 16) {
        { const int r = tid >> 2, kk = (tid & 3) * 4; const float4 v = *(const float4*)(A + (size_t)(m0 + r) * lda + k0 + kk);
          As[kk + 0][r] = v.x; As[kk + 1][r] = v.y; As[kk + 2][r] = v.z; As[kk + 3][r] = v.w; }
        { const int kk = tid >> 4, nn = (tid & 15) * 4; const float* bp = B + (size_t)(k0 + kk) * ldb + n0 + nn;
#pragma unroll
          for (int j = 0; j < 4; ++j) Bs[kk][nn + j] = (n0 + nn + j < N) ? bp[j] : 0.f; }
        __syncthreads();
#pragma unroll
        for (int kk = 0; kk < 16; ++kk) {
            const float4 a = *(const float4*)&As[kk][ty * 4]; const float4 b = *(const float4*)&Bs[kk][tx * 4];
            const float av[4] = {a.x, a.y, a.z, a.w}, bv[4] = {b.x, b.y, b.z, b.w};
#pragma unroll
            for (int i = 0; i < 4; ++i)
#pragma unroll
                for (int j = 0; j < 4; ++j) acc[i][j] += av[i] * bv[j];
        }
        __syncthreads();
    }
#pragma unroll
    for (int i = 0; i < 4; ++i) { const int row = m0 + ty * 4 + i;
#pragma unroll
        for (int j = 0; j < 4; ++j) { const int col = n0 + tx * 4 + j; if (col < N) { float v = acc[i][j]; if (Rs) v += Rs[(size_t)row * ldr + col]; C[(size_t)row * ldc + col] = v; } } }
}
__device__ __forceinline__ int row_pos(int row) { return row < RP ? (row % T) : PAST; }
__global__ void k_rope_kr(const float* PROJ, float* KR) {
    const int i = blockIdx.x * blockDim.x + threadIdx.x; if (i >= R * 16) return;
    const int row = i >> 4, j = i & 15; const float pos = (float)row_pos(row);
    const float ang = pos * rope_inv(j); const float c = cosf(ang), s = sinf(ang);
    const float x1 = PROJ[(size_t)row * INC + O_KR + j], x2 = PROJ[(size_t)row * INC + O_KR + 16 + j];
    KR[(size_t)row * 32 + j] = x1 * c - x2 * s; KR[(size_t)row * 32 + 16 + j] = x1 * s + x2 * c;
}
__global__ void k_q_post(const float* QRAW, const float* gqn, const float* gqr, float* Q) {
    const int w = blockIdx.x * 4 + (threadIdx.x >> 6), lane = threadIdx.x & 63; if (w >= R * NH) return;
    const int row = w / NH; const float* q = QRAW + (size_t)w * QKD; const float pos = (float)row_pos(row);
    const float a = q[lane];
    float rr = 0.f;
    if (lane < 32) { const int j = lane & 15; const float ang = pos * rope_inv(j); const float c = cosf(ang), s = sinf(ang);
        const float x1 = q[64 + j], x2 = q[80 + j]; rr = (lane < 16) ? (x1 * c - x2 * s) : (x1 * s + x2 * c); }
    const float ss = wsum(a * a + rr * rr);
    const float r = 1.0f / sqrtf(ss / 96.f + EPS);
    Q[(size_t)w * QKD + lane] = a * r * gqn[lane];
    if (lane < 32) Q[(size_t)w * QKD + 64 + lane] = rr * r * gqr[lane & 15];
}
__global__ void k_k_post(const float* KV, const float* KR, const float* gkn, const float* gkr, float* K, float* V) {
    const int w = blockIdx.x * 4 + (threadIdx.x >> 6), lane = threadIdx.x & 63; if (w >= R * NH) return;
    const int row = w / NH, h = w % NH;
    const float a = KV[(size_t)row * 1024 + h * 128 + lane];
    const float rr = (lane < 32) ? KR[(size_t)row * 32 + lane] : 0.f;
    const float ss = wsum(a * a + rr * rr);
    const float r = 1.0f / sqrtf(ss / 96.f + EPS);
    K[(size_t)w * QKD + lane] = a * r * gkn[lane];
    if (lane < 32) K[(size_t)w * QKD + 64 + lane] = rr * r * gkr[lane & 15];
    V[(size_t)w * VD + lane] = KV[(size_t)row * 1024 + h * 128 + 64 + lane];
}
__global__ void k_conv(const float* PROJ, const float* state_conv, const float* cw, const float* cb, const float* dtb, float* XA, float* DT) {
    const int row = blockIdx.x, tid = threadIdx.x;
    for (int c = tid; c < CONVD; c += 256) {
        float acc = cb[c];
#pragma unroll
        for (int k = 0; k < 4; ++k) {
            float xv;
            if (row < RP) { const int t = row % T; const int tt = t - 3 + k; xv = (tt >= 0) ? PROJ[(size_t)(row - 3 + k) * INC + O_XBC + c] : 0.f; }
            else { const int b = row - RP; xv = (k < 3) ? state_conv[((size_t)b * 3 + k) * CONVD + c] : PROJ[(size_t)row * INC + O_XBC + c]; }
            acc += xv * cw[k * CONVD + c];
        }
        XA[(size_t)row * CONVD + c] = silu_f(acc);
    }
    if (tid < NH) DT[(size_t)row * NH + tid] = softplus_f(PROJ[(size_t)row * INC + O_DT + tid] + dtb[tid]);
}
__global__ void __launch_bounds__(64) k_scan_prompt(const float* XA, const float* DT, const float* a_log, const float* d_skip, float* Y, float* ssm_p) {
    const int b = blockIdx.x / NH, h = blockIdx.x % NH, p = threadIdx.x; const int g = h / (NH / NG);
    const float A = -expf(a_log[h]), D = d_skip[h];
    float st[DS];
#pragma unroll
    for (int n = 0; n < DS; ++n) st[n] = 0.f;
    for (int t = 0; t < T; ++t) {
        const size_t row = (size_t)b * T + t;
        const float dt = DT[row * NH + h]; const float a = expf(dt * A);
        const float x = XA[row * CONVD + h * HP + p]; const float u = dt * x;
        const float* Bm = XA + row * CONVD + SSDW + g * DS; const float* Cm = XA + row * CONVD + SSDW + NG * DS + g * DS;
        float y = 0.f;
#pragma unroll
        for (int n = 0; n < DS; ++n) { st[n] = st[n] * a + u * Bm[n]; y += Cm[n] * st[n]; }
        Y[row * SSDW + h * HP + p] = y + D * x;
    }
#pragma unroll
    for (int n = 0; n < DS; ++n) ssm_p[(((size_t)b * NH + h) * HP + p) * DS + n] = st[n];
}
__global__ void __launch_bounds__(64) k_scan_decode(const float* XA, const float* DT, const float* a_log, const float* d_skip, const float* state_ssm, float* Y, float* ssm_s) {
    const int b = blockIdx.x / NH, h = blockIdx.x % NH, p = threadIdx.x; const int g = h / (NH / NG);
    const float A = -expf(a_log[h]), D = d_skip[h];
    const size_t row = (size_t)RP + b;
    const float dt = DT[row * NH + h]; const float a = expf(dt * A);
    const float x = XA[row * CONVD + h * HP + p]; const float u = dt * x;
    const float* Bm = XA + row * CONVD + SSDW + g * DS; const float* Cm = XA + row * CONVD + SSDW + NG * DS + g * DS;
    const size_t sb = (((size_t)b * NH + h) * HP + p) * DS;
    float y = 0.f;
    for (int n = 0; n < DS; ++n) { const float s = state_ssm[sb + n] * a + u * Bm[n]; ssm_s[sb + n] = s; y += Cm[n] * s; }
    Y[row * SSDW + h * HP + p] = y + D * x;
}
__global__ void k_ssd_out(const float* Y, const float* PROJ, const float* ng, float* MIX) {
    const int w = blockIdx.x * 4 + (threadIdx.x >> 6), lane = threadIdx.x & 63; if (w >= R * NG) return;
    const int row = w / NG, g = w % NG;
    float v[4]; float s = 0.f;
#pragma unroll
    for (int i = 0; i < 4; ++i) { const int c = g * 256 + lane + 64 * i; v[i] = Y[(size_t)row * SSDW + c] * silu_f(PROJ[(size_t)row * INC + O_Z + c]); s += v[i] * v[i]; }
    s = wsum(s); const float r = 1.0f / sqrtf(s / 256.f + EPS);
#pragma unroll
    for (int i = 0; i < 4; ++i) { const int c = g * 256 + lane + 64 * i; MIX[(size_t)row * 1024 + c] = v[i] * r * ng[c]; }
}
__global__ void __launch_bounds__(64) k_attn_prompt(const float* Q, const float* K, const float* V, float* ATT) {
    const int bh = blockIdx.y, b = bh / NH, h = bh % NH; const int t = blockIdx.x * 64 + threadIdx.x;
    const int tmax_blk = min(blockIdx.x * 64 + 63, T - 1);
    const bool valid = t < T; const int tq = valid ? t : T - 1;
    float q[QKD];
    const float* qp = Q + (((size_t)b * T + tq) * NH + h) * QKD;
#pragma unroll
    for (int d = 0; d < QKD; ++d) q[d] = qp[d] * ATTN_SCALE;
    float o[VD];
#pragma unroll
    for (int d = 0; d < VD; ++d) o[d] = 0.f;
    float m = -INFINITY, l = 0.f;
    for (int j = 0; j <= tmax_blk; ++j) {
        const float* kp = K + (((size_t)b * T + j) * NH + h) * QKD; const float* vp = V + (((size_t)b * T + j) * NH + h) * VD;
        float s = 0.f;
#pragma unroll
        for (int d = 0; d < QKD; ++d) s += q[d] * kp[d];
        if (j > tq) s = -INFINITY;
        const float mn = fmaxf(m, s);
        const float corr = expf(m - mn);
        const float pw = expf(s - mn);
        l = l * corr + pw;
#pragma unroll
        for (int d = 0; d < VD; ++d) o[d] = o[d] * corr + pw * vp[d];
        m = mn;
    }
    if (valid) { const float il = 1.f / l; float* op = ATT + ((size_t)b * T + t) * MLAW + h * VD;
#pragma unroll
        for (int d = 0; d < VD; ++d) op[d] = o[d] * il; }
}
__global__ void __launch_bounds__(256) k_attn_decode(const float* Q, const float* Knew, const float* Vnew, const float* cache_lat, const float* cache_kr, const int* page_table,
                                                     const float* w_ukv, const float* gkn, const float* gkr, float* ATT) {
    extern __shared__ float sm[];
    float* Wuk = sm;
    float* sc = sm + 256 * 64;
    float* red = sc + PAST;
    float* accl = red + 256;
    float* qg = accl + 256;
    const int b = blockIdx.x / NH, h = blockIdx.x % NH, tid = threadIdx.x;
    const size_t qrow = ((size_t)(RP + b) * NH + h) * QKD;
    for (int i = tid; i < 256 * 64; i += 256) { const int c = i >> 6, d = i & 63; Wuk[i] = w_ukv[(size_t)c * 1024 + h * 128 + d]; }
    if (tid < 96) qg[tid] = Q[qrow + tid] * (tid < 64 ? gkn[tid] : gkr[(tid - 64) & 15]);
    __syncthreads();
    for (int ch = 0; ch < PAST / 256; ++ch) {
        const int t = ch * 256 + tid; const int page = page_table[b * NPAGES + t / PAGE]; const size_t tok = (size_t)page * PAGE + (t % PAGE);
        const float* lat = cache_lat + tok * KVL; const float* kr = cache_kr + tok * QKR;
        float k[64];
#pragma unroll
        for (int d = 0; d < 64; ++d) k[d] = 0.f;
        for (int c = 0; c < KVL; ++c) { const float lv = lat[c]; const float* wr = Wuk + c * 64;
#pragma unroll
            for (int d = 0; d < 64; ++d) k[d] += lv * wr[d]; }
        float ss = 0.f, dot = 0.f;
#pragma unroll
        for (int d = 0; d < 64; ++d) { ss += k[d] * k[d]; dot += k[d] * qg[d]; }
#pragma unroll
        for (int j = 0; j < 32; ++j) { const float kv = kr[j]; ss += kv * kv; dot += kv * qg[64 + j]; }
        sc[t] = ATTN_SCALE * dot / sqrtf(ss / 96.f + EPS);
    }
    float snew = 0.f;
    { const float* kn = Knew + qrow; const float* qq = Q + qrow; for (int d = 0; d < QKD; ++d) snew += qq[d] * kn[d]; snew *= ATTN_SCALE; }
    __syncthreads();
    float mx = snew;
    for (int t = tid; t < PAST; t += 256) mx = fmaxf(mx, sc[t]);
    red[tid] = mx; __syncthreads();
    for (int s = 128; s > 0; s >>= 1) { if (tid < s) red[tid] = fmaxf(red[tid], red[tid + s]); __syncthreads(); }
    mx = red[0]; __syncthreads();
    float ls = 0.f;
    for (int t = tid; t < PAST; t += 256) { const float p = expf(sc[t] - mx); sc[t] = p; ls += p; }
    red[tid] = ls; __syncthreads();
    for (int s = 128; s > 0; s >>= 1) { if (tid < s) red[tid] += red[tid + s]; __syncthreads(); }
    const float pnew = expf(snew - mx);
    const float l = red[0] + pnew; __syncthreads();
    float acc = 0.f;
    for (int t = 0; t < PAST; ++t) { const int page = page_table[b * NPAGES + t / PAGE]; const size_t tok = (size_t)page * PAGE + (t % PAGE); acc += sc[t] * cache_lat[tok * KVL + tid]; }
    accl[tid] = acc; __syncthreads();
    if (tid < 64) { float o = 0.f; for (int c = 0; c < KVL; ++c) o += accl[c] * w_ukv[(size_t)c * 1024 + h * 128 + 64 + tid];
        o += pnew * Vnew[((size_t)(RP + b) * NH + h) * VD + tid];
        ATT[(size_t)(RP + b) * MLAW + h * VD + tid] = o / l; }
}
__global__ void k_silu_mul(float* G, const float* U, size_t n) { const size_t i = (size_t)blockIdx.x * blockDim.x + threadIdx.x; if (i < n) G[i] = silu_f(G[i]) * U[i]; }
__global__ void k_outputs(const float* OUTF, const float* LAT, const float* KR, const float* PROJ, const float* state_conv, float* out) {
    const size_t i = (size_t)blockIdx.x * blockDim.x + threadIdx.x; if (i >= OUT_SSMP) { return; }
    if (i < OUT_YS) { const size_t r = i / DM, c = i % DM; const size_t b = r / SEQ, t = r % SEQ; out[i] = OUTF[(b * T + NMETA + t) * DM + c]; }
    else if (i < OUT_LATP) { const size_t j = i - OUT_YS; out[i] = OUTF[(size_t)RP * DM + j]; }
    else if (i < OUT_KRP) { const size_t j = i - OUT_LATP; out[i] = LAT[j]; }
    else if (i < OUT_CONVP) { const size_t j = i - OUT_KRP; out[i] = KR[j]; }
    else { const size_t j = i - OUT_CONVP; const size_t b = j / (3 * CONVD), k = (j / CONVD) % 3, c = j % CONVD; out[i] = PROJ[(b * T + (T - 3) + k) * INC + O_XBC + c]; }
}
__global__ void k_outputs2(const float* LAT, const float* KR, const float* PROJ, const float* state_conv, float* out) {
    const size_t i = (size_t)blockIdx.x * blockDim.x + threadIdx.x;
    if (i < (size_t)DB * KVL) out[OUT_LATS + i] = LAT[(size_t)RP * KVL + i];
    if (i < (size_t)DB * QKR) out[OUT_KRS + i] = KR[(size_t)RP * QKR + i];
    if (i < (size_t)DB * 3 * CONVD) { const size_t b = i / (3 * CONVD), k = (i / CONVD) % 3, c = i % CONVD;
        out[OUT_CONVS + i] = (k < 2) ? state_conv[(b * 3 + k + 1) * CONVD + c] : PROJ[((size_t)RP + b) * INC + O_XBC + c]; }
}

struct Ws { float *X, *XN, *PROJ, *LAT, *KR, *CQN, *QRAW, *Q, *KV, *K, *V, *XA, *DT, *Y, *MIX, *ATT, *H, *HN, *G, *U, *OUTF; };
inline Ws carve(float* base) {
    Ws w; size_t o = 0; auto take = [&](size_t n) { float* p = base + o; o += (n + 255) & ~(size_t)255; return p; };
    w.X = take((size_t)R * DM); w.XN = take((size_t)R * DM); w.PROJ = take((size_t)R * INC); w.LAT = take((size_t)R * KVL); w.KR = take((size_t)R * QKR);
    w.CQN = take((size_t)R * QL); w.QRAW = take((size_t)R * 768); w.Q = take((size_t)R * 768); w.KV = take((size_t)R * 1024); w.K = take((size_t)R * 768); w.V = take((size_t)R * 512);
    w.XA = take((size_t)R * CONVD); w.DT = take((size_t)R * NH); w.Y = take((size_t)R * SSDW); w.MIX = take((size_t)R * 1024); w.ATT = take((size_t)R * MLAW);
    w.H = take((size_t)R * DM); w.HN = take((size_t)R * DM); w.G = take((size_t)R * DFF); w.U = take((size_t)R * DFF); w.OUTF = take((size_t)R * DM);
    return w;
}
inline void gemm(hipStream_t s, const float* A, int lda, const float* B, int ldb, float* C, int ldc, const float* Rs, int ldr, int M, int N, int K) {
    k_gemm<<<dim3((N + 63) / 64, M / 64), 256, 0, s>>>(A, lda, B, ldb, C, ldc, Rs, ldr, M, N, K);
}
inline void forward(void* const* in, float* out, float* wsf, hipStream_t s) {
    const float* x_prompt = (const float*)in[0]; const float* x_sample = (const float*)in[1]; const float* c_lat = (const float*)in[2]; const float* c_kr = (const float*)in[3];
    const float* state_conv = (const float*)in[4]; const float* state_ssm = (const float*)in[5]; const int* page_table = (const int*)in[6]; const float* meta = (const float*)in[7];
    const float* attn_g = (const float*)in[8]; const float* w_in = (const float*)in[9]; const float* conv_w = (const float*)in[10]; const float* conv_b = (const float*)in[11];
    const float* dt_bias = (const float*)in[12]; const float* a_log = (const float*)in[13]; const float* d_skip = (const float*)in[14]; const float* ssd_g = (const float*)in[15];
    const float* qn_g = (const float*)in[16]; const float* w_uq = (const float*)in[17]; const float* kvn_g = (const float*)in[18]; const float* w_ukv = (const float*)in[19];
    const float* gqn = (const float*)in[20]; const float* gqr = (const float*)in[21]; const float* gkn = (const float*)in[22]; const float* gkr = (const float*)in[23];
    const float* mla_g = (const float*)in[24]; const float* w_out = (const float*)in[25]; const float* ffn_g = (const float*)in[26]; const float* w_gate = (const float*)in[27];
    const float* w_up = (const float*)in[28]; const float* w_down = (const float*)in[29];
    Ws w = carve(wsf);
    k_build_x<<<R, 256, 0, s>>>(x_prompt, x_sample, meta, w.X);
    k_rmsnorm<<<R / 4, 256, 0, s>>>(w.X, DM, 0, DM, attn_g, w.XN, DM, 0, R);
    gemm(s, w.XN, DM, w_in, INC, w.PROJ, INC, nullptr, 0, R, INC, DM);
    k_rmsnorm<<<R / 4, 256, 0, s>>>(w.PROJ, INC, O_CKV, KVL, kvn_g, w.LAT, KVL, 0, R);
    k_rope_kr<<<(R * 16 + 255) / 256, 256, 0, s>>>(w.PROJ, w.KR);
    k_rmsnorm<<<R / 4, 256, 0, s>>>(w.PROJ, INC, O_CQ, QL, qn_g, w.CQN, QL, 0, R);
    gemm(s, w.CQN, QL, w_uq, 768, w.QRAW, 768, nullptr, 0, R, 768, QL);
    k_q_post<<<R * NH / 4, 256, 0, s>>>(w.QRAW, gqn, gqr, w.Q);
    gemm(s, w.LAT, KVL, w_ukv, 1024, w.KV, 1024, nullptr, 0, R, 1024, KVL);
    k_k_post<<<R * NH / 4, 256, 0, s>>>(w.KV, w.KR, gkn, gkr, w.K, w.V);
    k_conv<<<R, 256, 0, s>>>(w.PROJ, state_conv, conv_w, conv_b, dt_bias, w.XA, w.DT);
    k_scan_prompt<<<NB * NH, 64, 0, s>>>(w.XA, w.DT, a_log, d_skip, w.Y, out + OUT_SSMP);
    k_scan_decode<<<DB * NH, 64, 0, s>>>(w.XA, w.DT, a_log, d_skip, state_ssm, w.Y, out + OUT_SSMS);
    k_ssd_out<<<R * NG / 4, 256, 0, s>>>(w.Y, w.PROJ, ssd_g, w.MIX);
    k_attn_prompt<<<dim3((T + 63) / 64, NB * NH), 64, 0, s>>>(w.Q, w.K, w.V, w.ATT);
    { const int smb = (256 * 64 + PAST + 256 + 256 + 96) * 4;
      hipFuncSetAttribute((const void*)k_attn_decode, hipFuncAttributeMaxDynamicSharedMemorySize, smb);
      k_attn_decode<<<DB * NH, 256, smb, s>>>(w.Q, w.K, w.V, c_lat, c_kr, page_table, w_ukv, gkn, gkr, w.ATT); }
    k_rmsnorm<<<R / 4, 256, 0, s>>>(w.ATT, MLAW, 0, MLAW, mla_g, w.MIX, 1024, 512, R);
    gemm(s, w.MIX, 1024, w_out, DM, w.H, DM, w.X, DM, R, DM, 1024);
    k_rmsnorm<<<R / 4, 256, 0, s>>>(w.H, DM, 0, DM, ffn_g, w.HN, DM, 0, R);
    gemm(s, w.HN, DM, w_gate, DFF, w.G, DFF, nullptr, 0, R, DFF, DM);
    gemm(s, w.HN, DM, w_up, DFF, w.U, DFF, nullptr, 0, R, DFF, DM);
    { const size_t n = (size_t)R * DFF; k_silu_mul<<<(unsigned)((n + 255) / 256), 256, 0, s>>>(w.G, w.U, n); }
    gemm(s, w.G, DFF, w_down, DM, w.OUTF, DM, w.H, DM, R, DM, DFF);
    k_outputs<<<(unsigned)((OUT_SSMP + 255) / 256), 256, 0, s>>>(w.OUTF, w.LAT, w.KR, w.PROJ, state_conv, out);
    k_outputs2<<<(DB * 3 * CONVD + 255) / 256, 256, 0, s>>>(w.LAT, w.KR, w.PROJ, state_conv, out);
}
}
namespace pg8 {
#define PG8_LAS __attribute__((address_space(3)))
typedef unsigned short bf16_t;
typedef short bf16x8 __attribute__((ext_vector_type(8)));
typedef float f32x4 __attribute__((ext_vector_type(4)));
typedef unsigned u32x4 __attribute__((ext_vector_type(4)));
constexpr int BM = 256, BK = 64, HALF = 128, HTB = HALF * BK * 2  , STAGE_BYTES = 8 * HTB, NXCD = 8, WGM = 8;

__host__ __device__ __forceinline__ int lds_byte(int r, int c) { const int st = (r >> 4) * 2 + (c >> 5), rr = r & 15, cc = c & 31, ob = rr * 64 + cc * 2; return st * 1024 + (ob ^ (((ob >> 9) & 1) << 5)); }
__host__ __device__ __forceinline__ void stage_rc(int b, int& R, int& C) { const int st = b / 1024, sb = b % 1024, swz = sb ^ (((sb >> 9) & 1) << 5); R = (st >> 1) * 16 + swz / 64; C = (st & 1) * 32 + (swz % 64) / 2; }
__host__ __device__ __forceinline__ int perm32(int rho) { const int n = rho >> 4, i = rho & 15; return 8 * (i >> 2) + 4 * n + (i & 3); }

struct Unit { int pm, pn; };
struct Gemm { const bf16_t* A; const bf16_t* Bt; int M, N, K; int rmode;
    __host__ __device__ __forceinline__ int rowbase(int pm) const { return rmode ? (pm >> 3) * 2064 + 16 + (pm & 7) * 256 : pm * 256; } };

struct StaticOrder {
    int nM, nN, nwg, G, c;
    __host__ __device__ void init(int M, int N, int G_, int c_) { nM = M / BM; nN = N / BM; nwg = nM * nN; G = G_; c = c_; }
    __host__ __device__ bool next(int i, Unit& u) const {
        const long L = (long)i * G + c; if (L >= nwg) return false;
        int wgid = (int)L; { const int q = nwg / NXCD, r = nwg % NXCD, xcd = wgid % NXCD, off = wgid / NXCD; wgid = (xcd < r ? xcd * (q + 1) : r * (q + 1) + (xcd - r) * q) + off; }
        const int nig = WGM * nN, gid = wgid / nig, fm = gid * WGM, gsz = (nM - fm) < WGM ? (nM - fm) : WGM;
        u.pm = fm + ((wgid % nig) % gsz); u.pn = (wgid % nig) / gsz; return true;
    }
    __device__ __forceinline__ void a_ready(const Unit&) const {}
    __device__ __forceinline__ void done(const Unit&) const {}
};


template <class Epi, class Sched, bool ALIGN_EPI = false, bool SP2 = false>
__device__ __forceinline__ void gemm_phase(PG8_LAS unsigned char* lds, const Gemm g, const Sched& S, const Epi& E) {
    const int tid = threadIdx.x, wid = __builtin_amdgcn_readfirstlane(tid >> 6), lane = tid & 63, wr = wid >> 2, wc = wid & 3, fr = lane & 15, fq = lane >> 4;
    const int K = g.K, nt = K / BK;
    unsigned voffA[2], voffB[2];
#pragma unroll
    for (int i = 0; i < 2; ++i) { int R, C; stage_rc(tid * 16 + i * 8192, R, C); const int Rb = Epi::PERM ? ((R & ~31) + perm32(R & 31)) : R;
        voffA[i] = (unsigned)(R * K + C) * 2u; voffB[i] = (unsigned)(Rb * K + C) * 2u; }
    const size_t kstep = (size_t)(BK * 2);
    const size_t hstep = (size_t)HALF * K * 2;
    const size_t tstep = 2 * hstep;
    const unsigned ldsw = (unsigned)wid * 1024u;
    const int aoff = lds_byte(wr * 64 + fr, fq * 8), boff = lds_byte(wc * 32 + fr, fq * 8);
#define PG8_SA(b, h) (((b) * 2 + (h)) * HTB)
#define PG8_SB(b, h) ((4 + (b) * 2 + (h)) * HTB)
#define PG8_STAGE(bufoff, gbase, voff) do { _Pragma("unroll") for (int _i = 0; _i < 2; ++_i) \
        __builtin_amdgcn_global_load_lds((const unsigned*)((const char*)(gbase) + (voff)[_i]), (PG8_LAS unsigned*)(lds + (bufoff) + ldsw + _i * 8192), 16, 0, 0); } while (0)
#define PG8_LDA(dst, b, h) do { _Pragma("unroll") for (int m = 0; m < 4; ++m) _Pragma("unroll") for (int k = 0; k < 2; ++k) dst[m][k] = *(const PG8_LAS bf16x8*)(lds + PG8_SA(b, h) + aoff + m * 2048 + k * 1024); } while (0)
#define PG8_LDB(dst, b, h) do { _Pragma("unroll") for (int n = 0; n < 2; ++n) _Pragma("unroll") for (int k = 0; k < 2; ++k) dst[n][k] = *(const PG8_LAS bf16x8*)(lds + PG8_SB(b, h) + boff + n * 2048 + k * 1024); } while (0)
#define PG8_MMA(ai, bj, At, Bt) do { __builtin_amdgcn_s_setprio(1); _Pragma("unroll") for (int m = 0; m < 4; ++m) _Pragma("unroll") for (int n = 0; n < 2; ++n) _Pragma("unroll") for (int k = 0; k < 2; ++k) \
        acc[ai][bj][m][n] = __builtin_amdgcn_mfma_f32_16x16x32_bf16(Bt[n][k], At[m][k], acc[ai][bj][m][n], 0, 0, 0); __builtin_amdgcn_s_setprio(0); } while (0)
#define PG8_WAIT_V(n) asm volatile("s_waitcnt vmcnt(" #n ")" ::: "memory")
#define PG8_WAIT_L(n) asm volatile("s_waitcnt lgkmcnt(" #n ")" ::: "memory")
#define PG8_BAR __builtin_amdgcn_s_barrier()
#define PG8_SCHED __builtin_amdgcn_sched_barrier(0)
    Unit cur, nxt; int ui = 0;
    if (!S.next(0, cur)) return;
    f32x4 acc[2][2][4][2];
#pragma unroll
    for (int a = 0; a < 2; ++a)
#pragma unroll
        for (int b = 0; b < 2; ++b)
#pragma unroll
            for (int m = 0; m < 4; ++m)
#pragma unroll
                for (int n = 0; n < 2; ++n) acc[a][b][m][n] = (f32x4){0.f, 0.f, 0.f, 0.f};
    bf16x8 At[4][2], B0[2][2], B1[2][2];
    const char* cA = (const char*)g.A + (size_t)g.rowbase(cur.pm) * K * 2; const char* cB = (const char*)g.Bt + (size_t)cur.pn * tstep;
    S.a_ready(cur);
    if constexpr (SP2) {
        PG8_STAGE(PG8_SB(0, 0), cB, voffB); PG8_STAGE(PG8_SB(0, 1), cB + hstep, voffB); PG8_STAGE(PG8_SA(0, 0), cA, voffA); PG8_STAGE(PG8_SA(0, 1), cA + hstep, voffA);
        if (wr == 1) PG8_BAR;
        PG8_WAIT_V(2); PG8_BAR;
        PG8_STAGE(PG8_SB(1, 0), cB + kstep, voffB); PG8_STAGE(PG8_SA(1, 0), cA + kstep, voffA); PG8_STAGE(PG8_SB(1, 1), cB + hstep + kstep, voffB);
        PG8_WAIT_V(6); PG8_BAR;
    } else {
        PG8_STAGE(PG8_SB(0, 0), cB, voffB); PG8_STAGE(PG8_SA(0, 0), cA, voffA); PG8_STAGE(PG8_SB(0, 1), cB + hstep, voffB); PG8_STAGE(PG8_SA(0, 1), cA + hstep, voffA);
        if (wr == 1) PG8_BAR;
        PG8_WAIT_V(4); PG8_BAR;
        PG8_STAGE(PG8_SB(1, 0), cB + kstep, voffB); PG8_STAGE(PG8_SA(1, 0), cA + kstep, voffA); PG8_STAGE(PG8_SB(1, 1), cB + hstep + kstep, voffB);
        PG8_WAIT_V(6); PG8_BAR;
    }
    for (;;) {
        const bool has_next = S.next(ui + 1, nxt);
        const char* nA = has_next ? (const char*)g.A + (size_t)g.rowbase(nxt.pm) * K * 2 : cA; const char* nB = has_next ? (const char*)g.Bt + (size_t)nxt.pn * tstep : cB;
        for (int t = 0; t < nt; t += 2) {
            const bool last = (t == nt - 2);
            const char* a1 = cA + (size_t)(t + 1) * kstep;
            const char* a2 = last ? nA : cA + (size_t)(t + 2) * kstep; const char* b2 = last ? nB : cB + (size_t)(t + 2) * kstep;
            const char* a3 = a2 + kstep; const char* b3 = b2 + kstep;
            if (last && has_next) S.a_ready(nxt);
            if constexpr (SP2) {
            PG8_LDB(B0, 0, 0); PG8_LDB(B1, 0, 1); PG8_SCHED; PG8_LDA(At, 0, 0); PG8_STAGE(PG8_SA(1, 1), a1 + hstep, voffA);
            PG8_WAIT_V(8); PG8_WAIT_L(0); PG8_BAR; PG8_MMA(0, 0, At, B0); PG8_MMA(0, 1, At, B1); PG8_BAR; PG8_SCHED;
            PG8_LDA(At, 0, 1); PG8_STAGE(PG8_SB(0, 0), b2, voffB); PG8_STAGE(PG8_SB(0, 1), b2 + hstep, voffB); PG8_STAGE(PG8_SA(0, 0), a2, voffA);
            PG8_WAIT_V(8); PG8_WAIT_L(0); PG8_BAR; PG8_MMA(1, 0, At, B0); PG8_MMA(1, 1, At, B1); PG8_BAR; PG8_SCHED;
            PG8_LDB(B0, 1, 0); PG8_LDB(B1, 1, 1); PG8_SCHED; PG8_LDA(At, 1, 0); PG8_STAGE(PG8_SA(0, 1), a2 + hstep, voffA);
            PG8_WAIT_V(8); PG8_WAIT_L(0); PG8_BAR; PG8_MMA(0, 0, At, B0); PG8_MMA(0, 1, At, B1); PG8_BAR; PG8_SCHED;
            PG8_LDA(At, 1, 1); PG8_STAGE(PG8_SB(1, 0), b3, voffB); PG8_STAGE(PG8_SB(1, 1), b3 + hstep, voffB); PG8_STAGE(PG8_SA(1, 0), a3, voffA);
            PG8_WAIT_V(8); PG8_WAIT_L(0); PG8_BAR; PG8_MMA(1, 0, At, B0); PG8_MMA(1, 1, At, B1); PG8_BAR; PG8_SCHED;
            } else {
            PG8_LDB(B0, 0, 0); PG8_SCHED; PG8_LDA(At, 0, 0); PG8_STAGE(PG8_SA(1, 1), a1 + hstep, voffA);
            PG8_WAIT_L(8); PG8_BAR; PG8_WAIT_L(0); PG8_MMA(0, 0, At, B0); PG8_BAR; PG8_SCHED;
            PG8_LDB(B1, 0, 1); PG8_STAGE(PG8_SB(0, 0), b2, voffB);
            PG8_BAR; PG8_WAIT_L(0); PG8_MMA(0, 1, At, B1); PG8_BAR;
            PG8_LDA(At, 0, 1); PG8_STAGE(PG8_SA(0, 0), a2, voffA);
            PG8_BAR; PG8_WAIT_L(0); PG8_MMA(1, 0, At, B0); PG8_BAR; PG8_SCHED;
            PG8_STAGE(PG8_SB(0, 1), b2 + hstep, voffB);
            PG8_WAIT_V(6); PG8_BAR; PG8_MMA(1, 1, At, B1); PG8_BAR;
            PG8_LDB(B0, 1, 0); PG8_SCHED; PG8_LDA(At, 1, 0); PG8_STAGE(PG8_SA(0, 1), a2 + hstep, voffA);
            PG8_WAIT_L(8); PG8_BAR; PG8_WAIT_L(0); PG8_MMA(0, 0, At, B0); PG8_BAR; PG8_SCHED;
            PG8_LDB(B1, 1, 1); PG8_STAGE(PG8_SB(1, 0), b3, voffB);
            PG8_BAR; PG8_WAIT_L(0); PG8_MMA(0, 1, At, B1); PG8_BAR;
            PG8_LDA(At, 1, 1); PG8_STAGE(PG8_SA(1, 0), a3, voffA);
            PG8_BAR; PG8_WAIT_L(0); PG8_MMA(1, 0, At, B0); PG8_BAR; PG8_SCHED;
            PG8_STAGE(PG8_SB(1, 1), b3 + hstep, voffB);
            PG8_WAIT_V(6); PG8_BAR; PG8_MMA(1, 1, At, B1); PG8_BAR;
            }
        }
        if constexpr (ALIGN_EPI) { if (wr == 0) PG8_BAR; }
        if constexpr (!Epi::AFTER_DRAIN) { E(acc, cur, wr, wc, fr, fq); S.done(cur); }
        if (!has_next) break;
#pragma unroll
        for (int a = 0; a < 2; ++a)
#pragma unroll
            for (int b = 0; b < 2; ++b)
#pragma unroll
                for (int m = 0; m < 4; ++m)
#pragma unroll
                    for (int n = 0; n < 2; ++n) acc[a][b][m][n] = (f32x4){0.f, 0.f, 0.f, 0.f};
        cur = nxt; cA = nA; cB = nB; ++ui;
        if constexpr (ALIGN_EPI) { if (wr == 1) PG8_BAR; }
    }
    PG8_WAIT_V(0);
    if constexpr (!ALIGN_EPI) { if (wr == 0) PG8_BAR; }
    PG8_BAR;
    if constexpr (Epi::AFTER_DRAIN) { E.fused(acc, cur, wr, wc, fr, fq, lds, wid, lane); S.done(cur); }
#undef PG8_SA
#undef PG8_SB
#undef PG8_STAGE
#undef PG8_LDA
#undef PG8_LDB
#undef PG8_MMA
#undef PG8_WAIT_V
#undef PG8_WAIT_L
#undef PG8_BAR
#undef PG8_SCHED
}
}

#define GAS __attribute__((address_space(1)))
#define LAS __attribute__((address_space(3)))
typedef unsigned short bf16;
typedef unsigned v4u __attribute__((ext_vector_type(4)));
typedef unsigned v2u __attribute__((ext_vector_type(2)));
typedef float f32x4 __attribute__((ext_vector_type(4)));
typedef float f32x16 __attribute__((ext_vector_type(16)));
typedef short bf16x8 __attribute__((ext_vector_type(8)));
typedef short s16x4 __attribute__((ext_vector_type(4)));
typedef GAS unsigned gu32;
#define RLX_AGENT __ATOMIC_RELAXED, __HIP_MEMORY_SCOPE_AGENT
#define LDS_WAIT() asm volatile("s_waitcnt lgkmcnt(0)" ::: "memory")
#define VM_WAIT() asm volatile("s_waitcnt vmcnt(0)" ::: "memory")
typedef float f32x2_t __attribute__((ext_vector_type(2))); typedef __bf16 bf16x2_t __attribute__((ext_vector_type(2)));
__device__ __forceinline__ unsigned pk2(float lo, float hi) { f32x2_t v = {lo, hi}; bf16x2_t b = __builtin_convertvector(v, bf16x2_t); return __builtin_bit_cast(unsigned, b); }
__device__ __forceinline__ bf16 f2bf(float f) { return (bf16)(pk2(f, 0.f) & 0xffffu); }
__device__ __forceinline__ float bf2f(bf16 v) { return __uint_as_float((unsigned)v << 16); }
__device__ __forceinline__ float bflo(unsigned w) { return __uint_as_float(w << 16); }
__device__ __forceinline__ float bfhi(unsigned w) { return __uint_as_float(w & 0xffff0000u); }

#define XB_TMO      128
#define XB_XCNT(j)  (256  + 64 * (j))
#define XB_XSUB(j)  (1280 + 64 * (j))
#define XB_XGEN(j)  (2304 + 64 * (j))
#define XB_TOP      3328
#define XB_TOPGEN   3392
#define XCD_BAR_WORDS 3456
#define XB_SPIN_CAP (1u << 18)
__device__ __forceinline__ unsigned xb_ld(unsigned* p)              { return __hip_atomic_load(p, __ATOMIC_RELAXED, __HIP_MEMORY_SCOPE_AGENT); }
__device__ __forceinline__ unsigned xb_add(unsigned* p, unsigned v) { return __hip_atomic_fetch_add(p, v, __ATOMIC_RELAXED, __HIP_MEMORY_SCOPE_AGENT); }
__device__ __forceinline__ unsigned xb_xcc_id() { return (unsigned)__builtin_amdgcn_s_getreg((3 << 11) | 20) & 0xFu; }
#define XB_SPIN(cond, bar) do { unsigned _sp = 0; while (cond) { __builtin_amdgcn_s_sleep(1); \
    if ((++_sp & 255u) == 0u) { if (xb_ld(&(bar)[XB_TMO])) break; if (_sp > XB_SPIN_CAP) { atomicAdd(&(bar)[XB_TMO], 1u); break; } } } } while (0)
struct XcdBarrier { unsigned* bar; unsigned x; volatile LAS unsigned* st; };
__device__ __forceinline__ XcdBarrier xcd_barrier_post(unsigned* bar, volatile LAS unsigned* st) {
    XcdBarrier b; b.bar = bar; b.x = xb_xcc_id(); b.st = st;
    if (threadIdx.x == 0) (void)xb_add(&bar[XB_XCNT(b.x)], 1u);
    return b;
}
__device__ __forceinline__ void xcd_barrier_complete(unsigned* bar, unsigned x, unsigned& nloc, unsigned& nx) {
    const unsigned G = gridDim.x * gridDim.y * gridDim.z;
    unsigned sum, cnt, mine, sp = 0u;
    for (;;) {
        sum = 0u; cnt = 0u; mine = 0u;
#pragma unroll
        for (unsigned j = 0; j < 16; ++j) { const unsigned c = xb_ld(&bar[XB_XCNT(j)]); sum += c; cnt += (c > 0u) ? 1u : 0u; mine = (j == x) ? c : mine; }
        if (sum == G) break;
        __builtin_amdgcn_s_sleep(1);
        if ((++sp & 255u) == 0u) { if (xb_ld(&bar[XB_TMO])) break; if (sp > XB_SPIN_CAP) { atomicAdd(&bar[XB_TMO], 1u); break; } }
    }
    nloc = mine > 0u ? mine : 1u; nx = cnt > 0u ? cnt : 1u;
}
__device__ __forceinline__ void xcd_barrier(const XcdBarrier& b) {
    asm volatile("s_waitcnt vmcnt(0)" ::: "memory");
    __syncthreads();
    if (threadIdx.x == 0) {
        unsigned* bar = b.bar;
        __builtin_amdgcn_s_waitcnt(0);
        unsigned nloc = b.st[0], nx = b.st[1];
        if (nloc == 0u) { xcd_barrier_complete(bar, b.x, nloc, nx); b.st[0] = nloc; b.st[1] = nx; }
        const unsigned old = xb_add(&bar[XB_XSUB(b.x)], 1u);
        const unsigned gen = old / nloc;
        if (old + 1u == (gen + 1u) * nloc) {
            __builtin_amdgcn_fence(__ATOMIC_RELEASE, "agent");
            asm volatile("s_waitcnt vmcnt(0)" ::: "memory");
            const unsigned og = xb_add(&bar[XB_TOP], 1u);
            const unsigned tg = og / nx;
            if (og + 1u == (tg + 1u) * nx) xb_add(&bar[XB_TOPGEN], 1u);
            else XB_SPIN(xb_ld(&bar[XB_TOPGEN]) == tg, bar);
            __builtin_amdgcn_fence(__ATOMIC_ACQUIRE, "agent");
            xb_add(&bar[XB_XGEN(b.x)], 1u);
            asm volatile("s_waitcnt vmcnt(0)" ::: "memory");
        } else {
            XB_SPIN(xb_ld(&bar[XB_XGEN(b.x)]) == gen, bar);
            __builtin_amdgcn_fence(__ATOMIC_ACQUIRE, "agent");
            asm volatile("s_waitcnt vmcnt(0)" ::: "memory");
        }
    }
    __syncthreads();
}

constexpr int DM = 1024, NB = 8, SEQ = 2048, NMETA = 16, TT = SEQ + NMETA;
constexpr int DB = 128, PAST = 8192, PAGE = 128, NPAGES = 64;
constexpr int NH = 8, HP = 64, SSDW = 512, NG = 2, DS = 64, CONVD = 768;
constexpr int QKD = 96, VD = 64, MLAW = 512, QL = 384, KVL = 256, DFF = 2816, INC = 1960;
constexpr int RP = NB * TT, R = RP + DB;
constexpr int MMAIN = NB * SEQ;
constexpr int NS = NMETA + DB;
constexpr float EPS = 1e-6f, ATTN_SCALE = 0.10206207261596577f, LOG2E = 1.4426950408889634f;
constexpr int PJ = 2048, C_Z = 0, C_XBC = 512, C_CKV = 1280, C_CQ = 1536, C_DT = 1920, C_KR = 1928;
constexpr int S_Z = 0, S_XBC = 512, S_DT = 1280, S_CQ = 1288, S_CKV = 1672, S_KR = 1928;
constexpr int TPAD = 2112;
constexpr int NCH = 33, CHL = 64, TOFF = 48;
constexpr size_t OUT_YP = 0, OUT_YS = 16777216, OUT_LATP = 16908288, OUT_KRP = 21135360, OUT_CONVP = 21663744,
                 OUT_SSMP = 21682176, OUT_LATS = 21944320, OUT_KRS = 21977088, OUT_CONVS = 21981184, OUT_SSMS = 22276096;

constexpr size_t MiB = 1u << 20;
constexpr size_t WS_CTL = 0, CTL_ZERO_BYTES = 1 * MiB;
constexpr int CW_BAR = 4096;
constexpr size_t WS_WIN = 2 * MiB;
constexpr size_t WS_WUQ = 6 * MiB;
constexpr size_t WS_WUKV = 7 * MiB;
constexpr size_t WS_WOUT = 8 * MiB;
constexpr size_t WS_WGU = 10 * MiB;
constexpr size_t WS_WDN = 22 * MiB;
constexpr size_t WS_XN = 32 * MiB;
constexpr size_t WS_PROJ = 66 * MiB;
constexpr size_t WS_DTRAW = 132 * MiB;
constexpr size_t WS_DT = 133 * MiB;
constexpr size_t WS_LAT = 134 * MiB;
constexpr size_t WS_CQN = 143 * MiB;
constexpr size_t WS_KRF = 156 * MiB;
constexpr size_t WS_XST = 159 * MiB;
constexpr size_t WS_BT = 176 * MiB;
constexpr size_t WS_BC = 181 * MiB;
constexpr size_t WS_XAS = 190 * MiB;
constexpr size_t WS_QRAW = 191 * MiB;
constexpr size_t WS_KVRAW = 216 * MiB;
constexpr size_t WS_Q = 249 * MiB;
constexpr size_t WS_K = 274 * MiB;
constexpr size_t WS_VT = 299 * MiB;
constexpr size_t WS_STATES = 316 * MiB;
constexpr size_t WS_DECAY = 350 * MiB;
constexpr size_t WS_HIN = 351 * MiB;
constexpr size_t WS_MIX = 368 * MiB;
constexpr size_t WS_ACT = 401 * MiB;
constexpr size_t WS_VS = 491 * MiB;
constexpr size_t WS_DPART = 492 * MiB;
constexpr size_t WS_HS = 494 * MiB;
constexpr size_t WS_OPT_END = 496 * MiB;
constexpr size_t WS_NAIVE = 2048 * MiB;
constexpr size_t WS_DIAG = 1 * MiB;

constexpr int RING_OFF = 0, RING_BYTES = 131072;
constexpr int LDSCTL_OFF = RING_BYTES, MISC_OFF = LDSCTL_OFF + 320;
constexpr int LDS_BYTES = 147456;
constexpr int NWAVES = 8, NTHR = 512;

struct Args { const void* in[30]; float* out; unsigned char* ws; int ph_lo, ph_hi, li, pad; };

struct Frame {
    LAS unsigned char* lds;
    int tid, lane, wave, G, vcu, gw, NGW;
    unsigned char* ws; float* out;
    const void* const* in;
};
__device__ __forceinline__ float wave_sum(float v) {
#pragma unroll
    for (int o = 1; o < 64; o <<= 1) v += __shfl_xor(v, o);
    return v;
}
__device__ __forceinline__ float wave_max(float v) {
#pragma unroll
    for (int o = 1; o < 64; o <<= 1) v = fmaxf(v, __shfl_xor(v, o));
    return v;
}
__device__ __forceinline__ float silu_f(float x) { return x / (1.f + __expf(-x)); }
__device__ __forceinline__ float softplus_f(float x) { return fmaxf(x, 0.f) + log1pf(expf(-fabsf(x))); }
__device__ __forceinline__ float rope_inv(int j) { return exp2f(-(float)j * (13.287712379549449f / 16.0f)); }
struct EpiProj {
    static constexpr bool PERM = true, AFTER_DRAIN = false;
    bf16* O; float* dtraw; int rmode;
    __device__ __forceinline__ void operator()(const pg8::f32x4 (&acc)[2][2][4][2], const pg8::Unit& u, int wr, int wc, int fr, int fq) const {
        const int rb = rmode ? (u.pm >> 3) * 2064 + 16 + (u.pm & 7) * 256 : u.pm * 256;
        const int row0 = rb + wr * 64 + fr, col0 = u.pn * 256 + wc * 32 + 8 * fq;
#pragma unroll
        for (int ai = 0; ai < 2; ++ai)
#pragma unroll
            for (int m = 0; m < 4; ++m) { const int row = row0 + ai * 128 + m * 16; bf16* rowp = O + (size_t)row * PJ + col0;
#pragma unroll
                for (int bj = 0; bj < 2; ++bj) { const pg8::f32x4 v0 = acc[ai][bj][m][0], v1 = acc[ai][bj][m][1];
                    v4u w; w.x = pk2(v0[0], v0[1]); w.y = pk2(v0[2], v0[3]); w.z = pk2(v1[0], v1[1]); w.w = pk2(v1[2], v1[3]);
                    *(v4u*)(rowp + bj * 128) = w; }
                if (u.pn == 7 && wc == 0 && fq == 0) { *(pg8::f32x4*)(dtraw + (size_t)row * 8) = acc[ai][1][m][0]; *(pg8::f32x4*)(dtraw + (size_t)row * 8 + 4) = acc[ai][1][m][1]; } }
    }
};
struct EpiBf16 {
    static constexpr bool PERM = true, AFTER_DRAIN = false;
    bf16* O; int ldc; int rmode;
    __device__ __forceinline__ void operator()(const pg8::f32x4 (&acc)[2][2][4][2], const pg8::Unit& u, int wr, int wc, int fr, int fq) const {
        const int rb = rmode ? (u.pm >> 3) * 2064 + 16 + (u.pm & 7) * 256 : u.pm * 256;
        const int row0 = rb + wr * 64 + fr, col0 = u.pn * 256 + wc * 32 + 8 * fq;
#pragma unroll
        for (int ai = 0; ai < 2; ++ai)
#pragma unroll
            for (int m = 0; m < 4; ++m) { bf16* rowp = O + (size_t)(row0 + ai * 128 + m * 16) * ldc + col0;
#pragma unroll
                for (int bj = 0; bj < 2; ++bj) { const pg8::f32x4 v0 = acc[ai][bj][m][0], v1 = acc[ai][bj][m][1];
                    v4u w; w.x = pk2(v0[0], v0[1]); w.y = pk2(v0[2], v0[3]); w.z = pk2(v1[0], v1[1]); w.w = pk2(v1[2], v1[3]);
                    *(v4u*)(rowp + bj * 128) = w; } }
    }
};
struct EpiResF32 {
    static constexpr bool PERM = false, AFTER_DRAIN = false;
    const float* res; float* out;
    __device__ __forceinline__ void operator()(const pg8::f32x4 (&acc)[2][2][4][2], const pg8::Unit& u, int wr, int wc, int fr, int fq) const {
        const int row0 = u.pm * 256 + wr * 64 + fr, col0 = u.pn * 256 + wc * 32 + 4 * fq;
#pragma unroll
        for (int ai = 0; ai < 2; ++ai)
#pragma unroll
            for (int m = 0; m < 4; ++m) { const size_t off = (size_t)(row0 + ai * 128 + m * 16) * DM + col0;
#pragma unroll
                for (int bj = 0; bj < 2; ++bj)
#pragma unroll
                    for (int n = 0; n < 2; ++n) { const pg8::f32x4 r = *(const pg8::f32x4*)(res + off + bj * 128 + n * 16); *(pg8::f32x4*)(out + off + bj * 128 + n * 16) = r + acc[ai][bj][m][n]; } }
    }
};
struct EpiSwiGLU {
    static constexpr bool PERM = true, AFTER_DRAIN = false;
    bf16* O;
    __device__ __forceinline__ void operator()(const pg8::f32x4 (&acc)[2][2][4][2], const pg8::Unit& u, int wr, int wc, int fr, int fq) const {
        const int rb = (u.pm >> 3) * 2064 + 16 + (u.pm & 7) * 256;
        const int row0 = rb + wr * 64 + fr, col0 = u.pn * 128 + wc * 32 + 8 * fq;
#pragma unroll
        for (int ai = 0; ai < 2; ++ai)
#pragma unroll
            for (int m = 0; m < 4; ++m) { float a[8];
#pragma unroll
                for (int n = 0; n < 2; ++n)
#pragma unroll
                    for (int e = 0; e < 4; ++e) a[4 * n + e] = silu_f(acc[ai][0][m][n][e]) * acc[ai][1][m][n][e];
                v4u w; w.x = pk2(a[0], a[1]); w.y = pk2(a[2], a[3]); w.z = pk2(a[4], a[5]); w.w = pk2(a[6], a[7]);
                *(v4u*)(O + (size_t)(row0 + ai * 128 + m * 16) * DFF + col0) = w; }
    }
};

template <class ARow, class Epi>
__device__ __forceinline__ void small_gemm(const bf16* A, int lda, const bf16* Bt, int K, int nrt, int nct, const ARow& arow, const Epi& E, int gw, int NGW, int lane) {
    const int ntask = nrt * nct;
    for (int task = gw; task < ntask; task += NGW) {
        const int rt = task % nrt, ct = task / nrt;
        const bf16* ap = A + (size_t)arow(rt * 16 + (lane & 15)) * lda + 8 * (lane >> 4);
        const bf16* bp = Bt + (size_t)(ct * 16 + (lane & 15)) * K + 8 * (lane >> 4);
        f32x4 acc = {0.f, 0.f, 0.f, 0.f};
#pragma unroll 8
        for (int k0 = 0; k0 < K; k0 += 32) {
            const bf16x8 a = *(const bf16x8*)(ap + k0), b = *(const bf16x8*)(bp + k0);
            acc = __builtin_amdgcn_mfma_f32_16x16x32_bf16(a, b, acc, 0, 0, 0);
        }
        E(acc, rt, ct, lane);
    }
}

template <class RM>
__device__ __forceinline__ void transpose_item(const float* W, int N, int ldw, bf16* WT, int ldt, int item, LAS float* scr, int lane, const RM& rm) {
    const int nblk = (N + 31) / 32, kb = item / nblk, nb = item % nblk, k0 = 64 * kb, n0 = 32 * nb;
    { const int n = n0 + (lane & 31);
#pragma unroll 8
      for (int i = 0; i < 32; ++i) { const int kk = 2 * i + (lane >> 5); scr[kk * 33 + (lane & 31)] = (n < N) ? W[(size_t)(k0 + kk) * ldw + n] : 0.f; } }
    LDS_WAIT(); asm volatile("" ::: "memory");
    const int c = lane & 7;
#pragma unroll
    for (int j = 0; j < 4; ++j) { const int n = (lane >> 3) + 8 * j; const LAS float* s = scr + (8 * c) * 33 + n;
        if (n0 + n < N) { v4u o; o.x = pk2(s[0 * 33], s[1 * 33]); o.y = pk2(s[2 * 33], s[3 * 33]); o.z = pk2(s[4 * 33], s[5 * 33]); o.w = pk2(s[6 * 33], s[7 * 33]);
            *(v4u*)(WT + (size_t)rm(n0 + n) * ldt + k0 + 8 * c) = o; } }
    LDS_WAIT(); asm volatile("" ::: "memory");
}
__device__ __forceinline__ int map_in(int n) {
    return n < S_DT ? n : n < S_CQ ? C_DT + (n - S_DT) : n < S_CKV ? C_CQ + (n - S_CQ) : n < S_KR ? C_CKV + (n - S_CKV) : n;
}
__device__ __forceinline__ void p0_prologue(Frame& F) {
    LAS float* scr = (LAS float*)(F.lds + RING_OFF + F.wave * 16384);
    const float* w_in = (const float*)F.in[9]; const float* w_uq = (const float*)F.in[17]; const float* w_ukv = (const float*)F.in[19]; const float* w_out = (const float*)F.in[25];
    const float* w_gate = (const float*)F.in[27]; const float* w_up = (const float*)F.in[28]; const float* w_down = (const float*)F.in[29];
    bf16* WIN = (bf16*)(F.ws + WS_WIN); bf16* WUQ = (bf16*)(F.ws + WS_WUQ); bf16* WUKV = (bf16*)(F.ws + WS_WUKV); bf16* WOUT = (bf16*)(F.ws + WS_WOUT); bf16* WGU = (bf16*)(F.ws + WS_WGU); bf16* WDN = (bf16*)(F.ws + WS_WDN);
    constexpr int I_IN = 16 * 62, I_UQ = 6 * 24, I_UKV = 4 * 32, I_OUT = 16 * 32, I_G = 16 * 88, I_DN = 44 * 32;
    constexpr int NITEMS = I_IN + I_UQ + I_UKV + I_OUT + 2 * I_G + I_DN;
    for (int it = F.gw; it < NITEMS; it += F.NGW) {
        int r = it;
        if (r < I_IN) { transpose_item(w_in, INC, INC, WIN, DM, r, scr, F.lane, [](int n) { return map_in(n); }); continue; } r -= I_IN;
        if (r < I_UQ) { transpose_item(w_uq, 768, 768, WUQ, QL, r, scr, F.lane, [](int n) { return n; }); continue; } r -= I_UQ;
        if (r < I_UKV) { transpose_item(w_ukv, 1024, 1024, WUKV, KVL, r, scr, F.lane, [](int n) { return n; }); continue; } r -= I_UKV;
        if (r < I_OUT) { transpose_item(w_out, DM, DM, WOUT, 1024, r, scr, F.lane, [](int n) { return n; }); continue; } r -= I_OUT;
        if (r < I_G) { transpose_item(w_gate, DFF, DFF, WGU, DM, r, scr, F.lane, [](int n) { return 256 * (n >> 7) + (n & 127); }); continue; } r -= I_G;
        if (r < I_G) { transpose_item(w_up, DFF, DFF, WGU, DM, r, scr, F.lane, [](int n) { return 256 * (n >> 7) + 128 + (n & 127); }); continue; } r -= I_G;
        transpose_item(w_down, DM, DM, WDN, DFF, r, scr, F.lane, [](int n) { return n; });
    }
    for (int i = F.gw * 64 + F.lane; i < 88 * 1024 / 8; i += F.NGW * 64) *(v4u*)(WIN + (size_t)1960 * 1024 + (size_t)i * 8) = (v4u){0u, 0u, 0u, 0u};
    const float* xp = (const float*)F.in[0]; const float* xs = (const float*)F.in[1]; const float* meta = (const float*)F.in[7]; const float* g = (const float*)F.in[8];
    bf16* XN = (bf16*)(F.ws + WS_XN);
    f32x4 gv[4];
#pragma unroll
    for (int j = 0; j < 4; ++j) gv[j] = ((const f32x4*)g)[F.lane + 64 * j];
    for (int row = F.gw; row < R; row += F.NGW) {
        const float* src;
        if (row < RP) { const int b = row / TT, t = row % TT; src = (t < NMETA) ? meta + (size_t)t * DM : xp + ((size_t)b * SEQ + (t - NMETA)) * DM; } else src = xs + (size_t)(row - RP) * DM;
        f32x4 v[4]; float s = 0.f;
#pragma unroll
        for (int j = 0; j < 4; ++j) { v[j] = ((const f32x4*)src)[F.lane + 64 * j]; s += (v[j].x * v[j].x + v[j].y * v[j].y) + (v[j].z * v[j].z + v[j].w * v[j].w); }
        const float rs = 1.0f / sqrtf(wave_sum(s) * (1.f / DM) + EPS);
        v2u* o8 = (v2u*)(XN + (size_t)row * DM) + F.lane;
#pragma unroll
        for (int j = 0; j < 4; ++j) { v2u o; o.x = pk2(v[j].x * rs * gv[j].x, v[j].y * rs * gv[j].y); o.y = pk2(v[j].z * rs * gv[j].z, v[j].w * rs * gv[j].w); o8[64 * j] = o; }
    }
}

__device__ __forceinline__ int small_arow(int r) { return r < NMETA ? r : RP + (r - NMETA); }
__device__ __forceinline__ void p1_inproj(Frame& F) {
    const bf16* XN = (const bf16*)(F.ws + WS_XN); const bf16* WIN = (const bf16*)(F.ws + WS_WIN); bf16* PROJ = (bf16*)(F.ws + WS_PROJ); float* DTRAW = (float*)(F.ws + WS_DTRAW);
    { pg8::Gemm g{XN, WIN, MMAIN, PJ, DM, 1}; pg8::StaticOrder S; S.init(MMAIN, PJ, F.G, (int)blockIdx.x);
      EpiProj E{PROJ, DTRAW, 1};
      pg8::gemm_phase<EpiProj, pg8::StaticOrder, true, true>(F.lds + RING_OFF, g, S, E); }
    auto epi = [&](const f32x4& acc, int rt, int ct, int lane) {
        const int col = ct * 16 + (lane & 15);
#pragma unroll
        for (int i = 0; i < 4; ++i) { const int r = rt * 16 + 4 * (lane >> 4) + i; const bf16 v = f2bf(acc[i]);
            if (r < NMETA) { for (int b = 0; b < NB; ++b) { PROJ[(size_t)(b * TT + r) * PJ + col] = v; if (col >= C_DT && col < C_DT + 8) DTRAW[(size_t)(b * TT + r) * 8 + (col - C_DT)] = acc[i]; } }
            else { const int row = RP + (r - NMETA); PROJ[(size_t)row * PJ + col] = v; if (col >= C_DT && col < C_DT + 8) DTRAW[(size_t)row * 8 + (col - C_DT)] = acc[i]; } }
    };
    small_gemm(XN, DM, WIN, DM, NS / 16, PJ / 16, [](int r) { return small_arow(r); }, epi, F.gw, F.NGW, F.lane);
}

constexpr int CV_LDS_STRIDE = 66;
__device__ __forceinline__ void p2_elementwise(Frame& F) {
    const bf16* PROJ = (const bf16*)(F.ws + WS_PROJ); const float* DTRAW = (const float*)(F.ws + WS_DTRAW); float* DT = (float*)(F.ws + WS_DT);
    bf16* LAT = (bf16*)(F.ws + WS_LAT); bf16* CQN = (bf16*)(F.ws + WS_CQN); float* KRF = (float*)(F.ws + WS_KRF);
    const float* kvg = (const float*)F.in[18]; const float* qng = (const float*)F.in[16]; const float* dtb = (const float*)F.in[12];
    for (int row = F.gw; row < R; row += F.NGW) {
        const bf16* pr = PROJ + (size_t)row * PJ;
        { const v2u w = *(const v2u*)(pr + C_CKV + 4 * F.lane); const float v0 = bflo(w.x), v1 = bfhi(w.x), v2 = bflo(w.y), v3 = bfhi(w.y);
          const float rs = 1.0f / sqrtf(wave_sum((v0 * v0 + v1 * v1) + (v2 * v2 + v3 * v3)) * (1.f / KVL) + EPS);
          const f32x4 gg = ((const f32x4*)kvg)[F.lane]; const f32x4 o = {v0 * rs * gg.x, v1 * rs * gg.y, v2 * rs * gg.z, v3 * rs * gg.w};
          float* of = (row < RP) ? F.out + OUT_LATP + (size_t)row * KVL : F.out + OUT_LATS + (size_t)(row - RP) * KVL;
          ((f32x4*)of)[F.lane] = o; v2u ob; ob.x = pk2(o.x, o.y); ob.y = pk2(o.z, o.w); *(v2u*)(LAT + (size_t)row * KVL + 4 * F.lane) = ob; }
        { const unsigned* p = (const unsigned*)(pr + C_CQ + 6 * F.lane); const unsigned w0 = p[0], w1 = p[1], w2 = p[2];
          const float v0 = bflo(w0), v1 = bfhi(w0), v2 = bflo(w1), v3 = bfhi(w1), v4 = bflo(w2), v5 = bfhi(w2);
          const float rs = 1.0f / sqrtf(wave_sum((v0 * v0 + v1 * v1) + (v2 * v2 + v3 * v3) + (v4 * v4 + v5 * v5)) * (1.f / QL) + EPS);
          const float* gq = qng + 6 * F.lane; unsigned* o = (unsigned*)(CQN + (size_t)row * QL + 6 * F.lane);
          o[0] = pk2(v0 * rs * gq[0], v1 * rs * gq[1]); o[1] = pk2(v2 * rs * gq[2], v3 * rs * gq[3]); o[2] = pk2(v4 * rs * gq[4], v5 * rs * gq[5]); }
        if (F.lane < 16) { const int j = F.lane; const float pos = (float)(row < RP ? row % TT : PAST); const float ang = pos * rope_inv(j); const float c = cosf(ang), s = sinf(ang);
          const float x1 = bf2f(pr[C_KR + j]), x2 = bf2f(pr[C_KR + 16 + j]); const float y1 = x1 * c - x2 * s, y2 = x1 * s + x2 * c;
          KRF[(size_t)row * 32 + j] = y1; KRF[(size_t)row * 32 + 16 + j] = y2;
          float* of = (row < RP) ? F.out + OUT_KRP + (size_t)row * 32 : F.out + OUT_KRS + (size_t)(row - RP) * 32; of[j] = y1; of[16 + j] = y2; }
        if (F.lane < 8) DT[(size_t)row * 8 + F.lane] = softplus_f(DTRAW[(size_t)row * 8 + F.lane] + dtb[F.lane]);
    }
    const float* cw = (const float*)F.in[10]; const float* cb = (const float*)F.in[11];
    bf16* XST = (bf16*)(F.ws + WS_XST); bf16* BT = (bf16*)(F.ws + WS_BT); bf16* BC = (bf16*)(F.ws + WS_BC);
    LAS bf16* tile = (LAS bf16*)(F.lds + RING_OFF);
    for (int u = blockIdx.x; u < NB * NCH; u += F.G) {
        const int b = u / NCH, tb = u % NCH; const int t0 = tb * CHL - TOFF;
        if (F.tid < 384) {
            const int c = 2 * F.tid;
            const float w0a = cw[0 * CONVD + c], w1a = cw[1 * CONVD + c], w2a = cw[2 * CONVD + c], w3a = cw[3 * CONVD + c], ba = cb[c];
            const float w0b = cw[0 * CONVD + c + 1], w1b = cw[1 * CONVD + c + 1], w2b = cw[2 * CONVD + c + 1], w3b = cw[3 * CONVD + c + 1], bb = cb[c + 1];
            float ha0 = 0.f, ha1 = 0.f, ha2 = 0.f, hb0 = 0.f, hb1 = 0.f, hb2 = 0.f;
            const bf16* base = PROJ + (size_t)b * TT * PJ + C_XBC + c;
#pragma unroll
            for (int k = 0; k < 3; ++k) { const int t = t0 - 3 + k; float xa = 0.f, xb = 0.f; if (t >= 0) { const unsigned w = *(const unsigned*)(base + (size_t)t * PJ); xa = bflo(w); xb = bfhi(w); }
                ha0 = ha1; ha1 = ha2; ha2 = xa; hb0 = hb1; hb1 = hb2; hb2 = xb; }
#pragma unroll 8
            for (int tl = 0; tl < CHL; ++tl) { const int t = t0 + tl; float xa = 0.f, xb = 0.f; if (t >= 0) { const unsigned w = *(const unsigned*)(base + (size_t)t * PJ); xa = bflo(w); xb = bfhi(w); }
                float ya = silu_f(ba + ha0 * w0a + ha1 * w1a + ha2 * w2a + xa * w3a), yb = silu_f(bb + hb0 * w0b + hb1 * w1b + hb2 * w2b + xb * w3b);
                if (t < 0) { ya = 0.f; yb = 0.f; }
                ha0 = ha1; ha1 = ha2; ha2 = xa; hb0 = hb1; hb1 = hb2; hb2 = xb;
                const unsigned pk = pk2(ya, yb);
                tile[c * CV_LDS_STRIDE + tl] = (bf16)(pk & 0xffffu); tile[(c + 1) * CV_LDS_STRIDE + tl] = (bf16)(pk >> 16);
                if (c >= SSDW && t >= 0) *(unsigned*)(BC + (size_t)(b * TT + t) * 256 + (c - SSDW)) = pk; }
        }
        __syncthreads();
        for (int i = F.tid; i < 640 * 8; i += NTHR) { const int c = i >> 3, pc = i & 7;
            const LAS unsigned* s = (const LAS unsigned*)(tile + c * CV_LDS_STRIDE + pc * 8); v4u o; o.x = s[0]; o.y = s[1]; o.z = s[2]; o.w = s[3];
            bf16* dst = (c < SSDW) ? XST + ((size_t)(b * SSDW + c)) * TPAD : BT + ((size_t)(b * 128 + (c - SSDW))) * TPAD;
            *(v4u*)(dst + tb * CHL + pc * 8) = o; }
        __syncthreads();
    }
    const float* sconv = (const float*)F.in[4]; float* XAS = (float*)(F.ws + WS_XAS);
    for (int i = blockIdx.x * NTHR + F.tid; i < DB * CONVD; i += F.G * NTHR) { const int b = i / CONVD, c = i % CONVD;
        const float xc = bf2f(PROJ[(size_t)(RP + b) * PJ + C_XBC + c]);
        const float s0 = sconv[(size_t)(b * 3 + 0) * CONVD + c], s1 = sconv[(size_t)(b * 3 + 1) * CONVD + c], s2 = sconv[(size_t)(b * 3 + 2) * CONVD + c];
        XAS[i] = silu_f(cb[c] + s0 * cw[c] + s1 * cw[CONVD + c] + s2 * cw[2 * CONVD + c] + xc * cw[3 * CONVD + c]);
        float* oc = F.out + OUT_CONVS + (size_t)b * 3 * CONVD + c; oc[0] = s1; oc[CONVD] = s2; oc[2 * CONVD] = xc; }
    for (int i = blockIdx.x * NTHR + F.tid; i < NB * 3 * CONVD; i += F.G * NTHR) { const int b = i / (3 * CONVD), k = (i / CONVD) % 3, c = i % CONVD;
        F.out[OUT_CONVP + i] = bf2f(PROJ[(size_t)(b * TT + TT - 3 + k) * PJ + C_XBC + c]); }
}
#define MFMA32(a, b, c) __builtin_amdgcn_mfma_f32_32x32x16_bf16((a), (b), (c), 0, 0, 0)
#define MFMA16(a, b, c) __builtin_amdgcn_mfma_f32_16x16x32_bf16((a), (b), (c), 0, 0, 0)
__device__ __forceinline__ int crow(int reg, int hi) { return (reg & 3) + 8 * (reg >> 2) + 4 * hi; }
__device__ __forceinline__ bf16x8 pack8(const f32x16& x, int s) {
    v4u p; p.x = pk2(x[8 * s + 0], x[8 * s + 1]); p.y = pk2(x[8 * s + 2], x[8 * s + 3]); p.z = pk2(x[8 * s + 4], x[8 * s + 5]); p.w = pk2(x[8 * s + 6], x[8 * s + 7]);
    return __builtin_bit_cast(bf16x8, p);
}
__device__ __forceinline__ bf16x8 ld2x8(const bf16* p0, const bf16* p1) {
    const v2u a = *(const v2u*)p0, b = *(const v2u*)p1; v4u r; r.x = a.x; r.y = a.y; r.z = b.x; r.w = b.y; return __builtin_bit_cast(bf16x8, r);
}
__device__ __forceinline__ float softmax_ref(Frame& F) {
    const float* gqn = (const float*)F.in[20]; const float* gqr = (const float*)F.in[21]; const float* gkn = (const float*)F.in[22]; const float* gkr = (const float*)F.in[23];
    float a = fabsf(gqn[F.lane]), b = fabsf(gkn[F.lane]);
    if (F.lane < 16) { a = fmaxf(a, fabsf(gqr[F.lane])); b = fmaxf(b, fabsf(gkr[F.lane])); }
    return LOG2E * 9.797958971132712f * wave_max(a) * wave_max(b) * 1.0001f;
}
constexpr size_t WS_YS = 495 * MiB;

__device__ __forceinline__ void p3_upproj_states(Frame& F) {
    const bf16* CQN = (const bf16*)(F.ws + WS_CQN); const bf16* LAT = (const bf16*)(F.ws + WS_LAT); const bf16* WUQ = (const bf16*)(F.ws + WS_WUQ); const bf16* WUKV = (const bf16*)(F.ws + WS_WUKV);
    bf16* QRAW = (bf16*)(F.ws + WS_QRAW); bf16* KVRAW = (bf16*)(F.ws + WS_KVRAW);
    { pg8::Gemm g{CQN, WUQ, MMAIN, 768, QL, 1}; pg8::StaticOrder S; S.init(MMAIN, 768, F.G, (int)blockIdx.x); EpiBf16 E{QRAW, 768, 1};
      pg8::gemm_phase<EpiBf16, pg8::StaticOrder, true, true>(F.lds + RING_OFF, g, S, E); }
    { pg8::Gemm g{LAT, WUKV, MMAIN, 1024, KVL, 1}; pg8::StaticOrder S; S.init(MMAIN, 1024, F.G, (int)blockIdx.x); EpiBf16 E{KVRAW, 1024, 1};
      pg8::gemm_phase<EpiBf16, pg8::StaticOrder, true, true>(F.lds + RING_OFF, g, S, E); }
    small_gemm(CQN, QL, WUQ, QL, DB / 16, 768 / 16, [](int r) { return RP + r; },
        [&](const f32x4& acc, int rt, int ct, int lane) { const int col = ct * 16 + (lane & 15);
#pragma unroll
            for (int i = 0; i < 4; ++i) QRAW[(size_t)(RP + rt * 16 + 4 * (lane >> 4) + i) * 768 + col] = f2bf(acc[i]); }, F.gw, F.NGW, F.lane);
    small_gemm(LAT, KVL, WUKV, KVL, NS / 16, 1024 / 16, [](int r) { return small_arow(r); },
        [&](const f32x4& acc, int rt, int ct, int lane) { const int col = ct * 16 + (lane & 15);
#pragma unroll
            for (int i = 0; i < 4; ++i) { const int r = rt * 16 + 4 * (lane >> 4) + i; const bf16 v = f2bf(acc[i]);
                if (r < NMETA) { for (int b = 0; b < NB; ++b) KVRAW[(size_t)(b * TT + r) * 1024 + col] = v; } else KVRAW[(size_t)(RP + r - NMETA) * 1024 + col] = v; } }, F.gw, F.NGW, F.lane);
    const float* DT = (const float*)(F.ws + WS_DT); const float* a_log = (const float*)F.in[13];
    const bf16* XST = (const bf16*)(F.ws + WS_XST); const bf16* BT = (const bf16*)(F.ws + WS_BT);
    float* STATES = (float*)(F.ws + WS_STATES); float* DECAY = (float*)(F.ws + WS_DECAY);
    LAS float* wl = (LAS float*)(F.lds + RING_OFF + F.wave * 1024);
    const int r32 = F.lane & 31, hi = F.lane >> 5;
    for (int u = F.gw; u < NB * NCH * NH; u += F.NGW) {
        const int h = u % NH, c = (u / NH) % NCH, b = u / (NH * NCH); const int g = h >> 2;
        const int t = c * CHL - TOFF + F.lane;
        const float dt = (t >= 0) ? DT[(size_t)(b * TT + t) * 8 + h] : 0.f;
        const float A = -__expf(a_log[h]);
        float acs = dt * A;
#pragma unroll
        for (int o = 1; o < 64; o <<= 1) { const float v = __shfl_up(acs, o); if (F.lane >= o) acs += v; }
        const float last = __shfl(acs, 63);
        wl[F.lane] = __expf(last - acs) * dt;
        LDS_WAIT(); asm volatile("" ::: "memory");
        f32x16 acc[2][2];
#pragma unroll
        for (int i = 0; i < 2; ++i)
#pragma unroll
            for (int j = 0; j < 2; ++j) acc[i][j] = (f32x16){};
        const bf16* xb = XST + ((size_t)(b * SSDW + h * HP)) * TPAD + c * CHL; const bf16* bb = BT + ((size_t)(b * 128 + g * DS)) * TPAD + c * CHL;
#pragma unroll
        for (int s = 0; s < 4; ++s) {
            const f32x4 w0 = *(const LAS f32x4*)(wl + 16 * s + 8 * hi), w1 = *(const LAS f32x4*)(wl + 16 * s + 8 * hi + 4);
            bf16x8 af[2], bfr[2];
#pragma unroll
            for (int pt = 0; pt < 2; ++pt) { const v4u x = *(const v4u*)(xb + (size_t)(32 * pt + r32) * TPAD + 16 * s + 8 * hi);
                v4u y; y.x = pk2(bflo(x.x) * w0.x, bfhi(x.x) * w0.y); y.y = pk2(bflo(x.y) * w0.z, bfhi(x.y) * w0.w); y.z = pk2(bflo(x.z) * w1.x, bfhi(x.z) * w1.y); y.w = pk2(bflo(x.w) * w1.z, bfhi(x.w) * w1.w);
                af[pt] = __builtin_bit_cast(bf16x8, y); }
#pragma unroll
            for (int nt = 0; nt < 2; ++nt) bfr[nt] = *(const bf16x8*)(bb + (size_t)(32 * nt + r32) * TPAD + 16 * s + 8 * hi);
#pragma unroll
            for (int pt = 0; pt < 2; ++pt)
#pragma unroll
                for (int nt = 0; nt < 2; ++nt) acc[pt][nt] = MFMA32(af[pt], bfr[nt], acc[pt][nt]);
        }
        float* so = STATES + ((size_t)((b * NCH + c) * NH + h)) * 4096;
#pragma unroll
        for (int pt = 0; pt < 2; ++pt)
#pragma unroll
            for (int nt = 0; nt < 2; ++nt)
#pragma unroll
                for (int rg = 0; rg < 16; ++rg) so[(32 * pt + crow(rg, hi)) * 64 + 32 * nt + r32] = acc[pt][nt][rg];
        if (F.lane == 0) DECAY[(b * NCH + c) * NH + h] = __expf(last);
        LDS_WAIT(); asm volatile("" ::: "memory");
    }
}

__device__ __forceinline__ void p4_post(Frame& F) {
    const bf16* QRAW = (const bf16*)(F.ws + WS_QRAW); const bf16* KVRAW = (const bf16*)(F.ws + WS_KVRAW); const float* KRF = (const float*)(F.ws + WS_KRF);
    bf16* Q = (bf16*)(F.ws + WS_Q); bf16* K = (bf16*)(F.ws + WS_K); bf16* VT = (bf16*)(F.ws + WS_VT); float* VS = (float*)(F.ws + WS_VS);
    const float* gqn = (const float*)F.in[20]; const float* gqr = (const float*)F.in[21]; const float* gkn = (const float*)F.in[22]; const float* gkr = (const float*)F.in[23];
    const int h = F.lane >> 3, sub = F.lane & 7;
    for (int row = F.gw; row < R; row += F.NGW) {
        const int t = (row < RP) ? row % TT : PAST; const int b = row / TT;
        { const bf16* kp = KVRAW + (size_t)row * 1024 + 128 * h + 8 * sub; const v4u kw = *(const v4u*)kp; const v4u vw = *(const v4u*)(kp + 64);
          const f32x4 kr = *(const f32x4*)(KRF + (size_t)row * 32 + 4 * sub);
          float kn[8] = {bflo(kw.x), bfhi(kw.x), bflo(kw.y), bfhi(kw.y), bflo(kw.z), bfhi(kw.z), bflo(kw.w), bfhi(kw.w)};
          float ss = (kr.x * kr.x + kr.y * kr.y) + (kr.z * kr.z + kr.w * kr.w);
#pragma unroll
          for (int e = 0; e < 8; ++e) ss += kn[e] * kn[e];
          ss += __shfl_xor(ss, 1); ss += __shfl_xor(ss, 2); ss += __shfl_xor(ss, 4);
          const float rs = 1.0f / sqrtf(ss * (1.f / 96.f) + EPS);
          const float* gn = gkn + 8 * sub; v4u o; o.x = pk2(kn[0] * rs * gn[0], kn[1] * rs * gn[1]); o.y = pk2(kn[2] * rs * gn[2], kn[3] * rs * gn[3]); o.z = pk2(kn[4] * rs * gn[4], kn[5] * rs * gn[5]); o.w = pk2(kn[6] * rs * gn[6], kn[7] * rs * gn[7]);
          *(v4u*)(K + (size_t)row * 768 + 96 * h + 8 * sub) = o;
          const float* gr = gkr + ((4 * sub) & 15); v2u o2; o2.x = pk2(kr.x * rs * gr[0], kr.y * rs * gr[1]); o2.y = pk2(kr.z * rs * gr[2], kr.w * rs * gr[3]);
          *(v2u*)(K + (size_t)row * 768 + 96 * h + 64 + 4 * sub) = o2;
          const unsigned vv[4] = {vw.x, vw.y, vw.z, vw.w};
          if (row < RP) { bf16* vt = VT + ((size_t)((b * NH + h) * VD + 8 * sub)) * TPAD + t;
#pragma unroll
              for (int e = 0; e < 4; ++e) { vt[(size_t)(2 * e) * TPAD] = (bf16)(vv[e] & 0xffffu); vt[(size_t)(2 * e + 1) * TPAD] = (bf16)(vv[e] >> 16); } }
          else { float* vs = VS + (size_t)(row - RP) * 512 + 64 * h + 8 * sub;
#pragma unroll
              for (int e = 0; e < 4; ++e) { vs[2 * e] = bflo(vv[e]); vs[2 * e + 1] = bfhi(vv[e]); } } }
        if (row >= RP || t >= NMETA) {
            const bf16* qp = QRAW + (size_t)row * 768 + 96 * h; const v4u qw = *(const v4u*)(qp + 8 * sub);
            const unsigned r1 = *(const unsigned*)(qp + 64 + 2 * sub), r2 = *(const unsigned*)(qp + 80 + 2 * sub);
            float qn[8] = {bflo(qw.x), bfhi(qw.x), bflo(qw.y), bfhi(qw.y), bflo(qw.z), bfhi(qw.z), bflo(qw.w), bfhi(qw.w)};
            const float pos = (float)t; const float a0 = pos * rope_inv(2 * sub), a1 = pos * rope_inv(2 * sub + 1);
            const float c0 = cosf(a0), s0 = sinf(a0), c1 = cosf(a1), s1 = sinf(a1);
            const float x10 = bflo(r1), x11 = bfhi(r1), x20 = bflo(r2), x21 = bfhi(r2);
            const float y10 = x10 * c0 - x20 * s0, y20 = x10 * s0 + x20 * c0, y11 = x11 * c1 - x21 * s1, y21 = x11 * s1 + x21 * c1;
            float ss = (y10 * y10 + y20 * y20) + (y11 * y11 + y21 * y21);
#pragma unroll
            for (int e = 0; e < 8; ++e) ss += qn[e] * qn[e];
            ss += __shfl_xor(ss, 1); ss += __shfl_xor(ss, 2); ss += __shfl_xor(ss, 4);
            const float rs = (ATTN_SCALE * LOG2E) / sqrtf(ss * (1.f / 96.f) + EPS);
            const float* gn = gqn + 8 * sub; v4u o; o.x = pk2(qn[0] * rs * gn[0], qn[1] * rs * gn[1]); o.y = pk2(qn[2] * rs * gn[2], qn[3] * rs * gn[3]); o.z = pk2(qn[4] * rs * gn[4], qn[5] * rs * gn[5]); o.w = pk2(qn[6] * rs * gn[6], qn[7] * rs * gn[7]);
            bf16* qo = Q + (size_t)row * 768 + 96 * h; *(v4u*)(qo + 8 * sub) = o;
            const float g0 = gqr[2 * sub], g1 = gqr[2 * sub + 1];
            *(unsigned*)(qo + 64 + 2 * sub) = pk2(y10 * rs * g0, y11 * rs * g1); *(unsigned*)(qo + 80 + 2 * sub) = pk2(y20 * rs * g0, y21 * rs * g1);
        }
    }
    for (int i = blockIdx.x * NTHR + F.tid; i < NB * NH * VD * 6; i += F.G * NTHR) *(v4u*)(VT + (size_t)(i / 6) * TPAD + TT + (i % 6) * 8) = (v4u){0u, 0u, 0u, 0u};
    const float* STATES = (const float*)(F.ws + WS_STATES); const float* DECAY = (const float*)(F.ws + WS_DECAY); bf16* HIN = (bf16*)(F.ws + WS_HIN);
    for (int e = blockIdx.x * NTHR + F.tid; e < NB * NH * 4096; e += F.G * NTHR) {
        const int b = e / (NH * 4096), hh = (e / 4096) % NH, pn = e % 4096;
        float hv = 0.f;
#pragma unroll 11
        for (int c = 0; c < NCH; ++c) { const size_t idx = ((size_t)((b * NCH + c) * NH + hh)) * 4096 + pn;
            HIN[idx] = f2bf(hv); hv = hv * DECAY[(b * NCH + c) * NH + hh] + STATES[idx]; }
        F.out[OUT_SSMP + e] = hv;
    }
    const float* XAS = (const float*)(F.ws + WS_XAS); const float* DT = (const float*)(F.ws + WS_DT); const float* sst = (const float*)F.in[5];
    const float* a_log = (const float*)F.in[13]; const float* d_skip = (const float*)F.in[14]; float* YS = (float*)(F.ws + WS_YS);
    for (int u = F.gw; u < DB * NH * 16; u += F.NGW) {
        const int pq = u & 15, hh = (u >> 4) & 7, b = u >> 7; const int g = hh >> 2; const int p = 4 * pq + (F.lane >> 4), n4 = F.lane & 15;
        const float dt = DT[(size_t)(RP + b) * 8 + hh]; const float a = __expf(dt * -__expf(a_log[hh]));
        const float x = XAS[(size_t)b * CONVD + hh * HP + p]; const float uu = dt * x;
        const f32x4 Bv = *(const f32x4*)(XAS + (size_t)b * CONVD + SSDW + g * DS + 4 * n4), Cv = *(const f32x4*)(XAS + (size_t)b * CONVD + SSDW + 128 + g * DS + 4 * n4);
        const size_t si = (((size_t)b * NH + hh) * HP + p) * DS + 4 * n4;
        const f32x4 s0 = *(const f32x4*)(sst + si); const f32x4 s1 = s0 * a + uu * Bv;
        *(f32x4*)(F.out + OUT_SSMS + si) = s1;
        float y = (Cv.x * s1.x + Cv.y * s1.y) + (Cv.z * s1.z + Cv.w * s1.w);
        y += __shfl_xor(y, 1); y += __shfl_xor(y, 2); y += __shfl_xor(y, 4); y += __shfl_xor(y, 8);
        if (n4 == 0) YS[(size_t)b * 512 + hh * HP + p] = y + d_skip[hh] * x;
    }
}
constexpr int DA_ROWB = 528;
constexpr int DA_LAT = 0, DA_KR = 128 * DA_ROWB, DA_PB = DA_KR + 128 * 33 * 4, DA_QG = DA_PB + 2 * 16 * 32 * 2, DA_END = DA_QG + 8 * 96 * 4;
constexpr int P5_EXCH = 100 * 1024;
static_assert(DA_END <= P5_EXCH, "LDS map of P5");

__device__ __forceinline__ void p5_attn_prompt(Frame& F, float M0) {
    const bf16* Q = (const bf16*)(F.ws + WS_Q); const bf16* K = (const bf16*)(F.ws + WS_K); const bf16* VT = (const bf16*)(F.ws + WS_VT); bf16* MIX = (bf16*)(F.ws + WS_MIX);
    const float* mg = (const float*)F.in[24];
    LAS float* exch = (LAS float*)(F.lds + P5_EXCH);
    const int h = F.wave, r32 = F.lane & 31, hi = F.lane >> 5;
    f32x16 negm;
#pragma unroll
    for (int i = 0; i < 16; ++i) negm[i] = -M0;
    for (int u = blockIdx.x; u < 256; u += F.G) {
        const int b = u >> 5, a0 = u & 31;
#pragma unroll 1
        for (int half = 0; half < 2; ++half) {
            const int a = half ? 63 - a0 : a0; const int q0 = NMETA + 32 * a; const int qi = q0 + r32;
            const bf16* qp = Q + (size_t)(b * TT + qi) * 768 + 96 * h + 8 * hi;
            bf16x8 qf[6];
#pragma unroll
            for (int s = 0; s < 6; ++s) qf[s] = *(const bf16x8*)(qp + 16 * s);
            f32x16 o0 = (f32x16){}, o1 = (f32x16){}; float l = 0.f;
            const bf16* kbase = K + (size_t)(b * TT + r32) * 768 + 96 * h + 8 * hi;
            const bf16* vbase = VT + ((size_t)((b * NH + h) * VD + r32)) * TPAD + 4 * hi;
            const int nkt = a + 2;
            bf16x8 kf[6];
#pragma unroll
            for (int s = 0; s < 6; ++s) kf[s] = *(const bf16x8*)(kbase + 16 * s);
#pragma unroll 1
            for (int kt = 0; kt < nkt; ++kt) {
                const int j0 = 32 * kt;
                bf16x8 vf[2][2];
#pragma unroll
                for (int dt = 0; dt < 2; ++dt)
#pragma unroll
                    for (int s2 = 0; s2 < 2; ++s2) { const bf16* vp = vbase + (size_t)(32 * dt) * TPAD + j0 + 16 * s2; vf[dt][s2] = ld2x8(vp, vp + 8); }
                f32x16 S = negm;
#pragma unroll
                for (int s = 0; s < 6; ++s) S = MFMA32(kf[s], qf[s], S);
                if (kt + 1 < nkt) {
#pragma unroll
                    for (int s = 0; s < 6; ++s) kf[s] = *(const bf16x8*)(kbase + (size_t)(j0 + 32) * 768 + 16 * s); }
#pragma unroll
                for (int i = 0; i < 16; ++i) S[i] = __builtin_amdgcn_exp2f(S[i]);
                if (kt >= a) {
#pragma unroll
                    for (int i = 0; i < 16; ++i) if (j0 + crow(i, hi) > qi) S[i] = 0.f; }
#pragma unroll
                for (int i = 0; i < 16; ++i) l += S[i];
                const bf16x8 p0 = pack8(S, 0), p1 = pack8(S, 1);
                o0 = MFMA32(vf[0][0], p0, o0); o0 = MFMA32(vf[0][1], p1, o0);
                o1 = MFMA32(vf[1][0], p0, o1); o1 = MFMA32(vf[1][1], p1, o1);
            }
            l += __shfl_xor(l, 32);
            const float il = 1.0f / l; float ss = 0.f;
#pragma unroll
            for (int i = 0; i < 16; ++i) { o0[i] *= il; o1[i] *= il; ss += o0[i] * o0[i] + o1[i] * o1[i]; }
            ss += __shfl_xor(ss, 32);
            if (hi == 0) exch[h * 32 + r32] = ss;
            __syncthreads();
            float tot = 0.f;
#pragma unroll
            for (int hh = 0; hh < NH; ++hh) tot += exch[hh * 32 + r32];
            const float rs = 1.0f / sqrtf(tot * (1.f / MLAW) + EPS);
            bf16* mo = MIX + (size_t)(b * TT + qi) * 1024 + 512 + 64 * h + 4 * hi;
#pragma unroll
            for (int gq = 0; gq < 4; ++gq) {
                const f32x4 g0 = *(const f32x4*)(mg + 64 * h + 8 * gq + 4 * hi), g1 = *(const f32x4*)(mg + 64 * h + 32 + 8 * gq + 4 * hi);
                v2u w0, w1; w0.x = pk2(o0[4 * gq] * rs * g0.x, o0[4 * gq + 1] * rs * g0.y); w0.y = pk2(o0[4 * gq + 2] * rs * g0.z, o0[4 * gq + 3] * rs * g0.w);
                w1.x = pk2(o1[4 * gq] * rs * g1.x, o1[4 * gq + 1] * rs * g1.y); w1.y = pk2(o1[4 * gq + 2] * rs * g1.z, o1[4 * gq + 3] * rs * g1.w);
                *(v2u*)(mo + 8 * gq) = w0; *(v2u*)(mo + 32 + 8 * gq) = w1; }
            __syncthreads();
        }
    }
}

__device__ __forceinline__ void p5_ssd_out(Frame& F) {
    const float* DT = (const float*)(F.ws + WS_DT); const float* a_log = (const float*)F.in[13]; const float* d_skip = (const float*)F.in[14]; const float* ng = (const float*)F.in[15];
    const bf16* XST = (const bf16*)(F.ws + WS_XST); const bf16* BC = (const bf16*)(F.ws + WS_BC); const bf16* HIN = (const bf16*)(F.ws + WS_HIN); const bf16* PROJ = (const bf16*)(F.ws + WS_PROJ);
    bf16* MIX = (bf16*)(F.ws + WS_MIX);
    LAS float* tab = (LAS float*)(F.lds + RING_OFF + F.wave * 1024);
    LAS float* exch = (LAS float*)(F.lds + P5_EXCH + 2048);
    const int h = F.wave, g = h >> 2, r32 = F.lane & 31, hi = F.lane >> 5;
    const float A = -__expf(a_log[h]), Dh = d_skip[h];
    for (int u = blockIdx.x; u < NB * NCH; u += F.G) {
        const int b = u / NCH, c = u % NCH; const int tbase = c * CHL - TOFF;
        { const int t = tbase + F.lane; const float dt = (t >= 0) ? DT[(size_t)(b * TT + t) * 8 + h] : 0.f;
          float acs = dt * A;
#pragma unroll
          for (int o = 1; o < 64; o <<= 1) { const float v = __shfl_up(acs, o); if (F.lane >= o) acs += v; }
          tab[F.lane] = acs; tab[64 + F.lane] = dt; }
        LDS_WAIT(); asm volatile("" ::: "memory");
        const bf16* hb = HIN + ((size_t)((b * NCH + c) * NH + h)) * 4096 + 8 * hi;
        const bf16* xb = XST + ((size_t)(b * SSDW + h * HP)) * TPAD + c * CHL + 4 * hi;
#pragma unroll 1
        for (int it = 0; it < 2; ++it) {
            const int ii = 32 * it + r32; const int t = tbase + ii; const int tc = t < 0 ? 0 : t;
            bf16x8 cf[4];
            { const bf16* cp = BC + (size_t)(b * TT + tc) * 256 + 128 + g * DS + 8 * hi;
#pragma unroll
              for (int s = 0; s < 4; ++s) cf[s] = *(const bf16x8*)(cp + 16 * s); }
            f32x16 y[2];
            const float ai = tab[ii]; const float ei = __expf(ai);
#pragma unroll
            for (int pt = 0; pt < 2; ++pt) { f32x16 acc = (f32x16){};
#pragma unroll
                for (int s = 0; s < 4; ++s) acc = MFMA32(*(const bf16x8*)(hb + (size_t)(32 * pt + r32) * 64 + 16 * s), cf[s], acc);
#pragma unroll
                for (int i = 0; i < 16; ++i) acc[i] *= ei;
                y[pt] = acc; }
#pragma unroll 1
            for (int jt = 0; jt <= it; ++jt) {
                f32x16 S = (f32x16){};
                { int tj = tbase + 32 * jt + r32; tj = tj < 0 ? 0 : tj; const bf16* bp = BC + (size_t)(b * TT + tj) * 256 + g * DS + 8 * hi;
#pragma unroll
                  for (int s = 0; s < 4; ++s) S = MFMA32(*(const bf16x8*)(bp + 16 * s), cf[s], S); }
#pragma unroll
                for (int i = 0; i < 16; ++i) { const int jj = 32 * jt + crow(i, hi); const float e = (jj <= ii) ? __expf(ai - tab[jj]) * tab[64 + jj] : 0.f; S[i] *= e; }
                const bf16x8 p0 = pack8(S, 0), p1 = pack8(S, 1);
#pragma unroll
                for (int pt = 0; pt < 2; ++pt) { const bf16* xp = xb + (size_t)(32 * pt + r32) * TPAD + 32 * jt;
                    y[pt] = MFMA32(ld2x8(xp, xp + 8), p0, y[pt]); y[pt] = MFMA32(ld2x8(xp + 16, xp + 24), p1, y[pt]); }
            }
            const bf16* zp = PROJ + (size_t)(b * TT + tc) * PJ + C_Z + 64 * h + 4 * hi;
            const bf16* xt = XST + ((size_t)(b * SSDW + h * HP)) * TPAD + c * CHL + ii;
            float ss = 0.f;
#pragma unroll
            for (int pt = 0; pt < 2; ++pt)
#pragma unroll
                for (int gq = 0; gq < 4; ++gq) { const v2u zw = *(const v2u*)(zp + 32 * pt + 8 * gq); const float zz[4] = {bflo(zw.x), bfhi(zw.x), bflo(zw.y), bfhi(zw.y)};
#pragma unroll
                    for (int e = 0; e < 4; ++e) { const int p = 32 * pt + 8 * gq + 4 * hi + e; const float x = bf2f(xt[(size_t)p * TPAD]);
                        const float v = (y[pt][4 * gq + e] + Dh * x) * silu_f(zz[e]); y[pt][4 * gq + e] = v; ss += v * v; } }
            ss += __shfl_xor(ss, 32);
            LAS float* ex = exch + it * 256;
            if (hi == 0) ex[h * 32 + r32] = ss;
            __syncthreads();
            const float tot = (ex[(4 * g) * 32 + r32] + ex[(4 * g + 1) * 32 + r32]) + (ex[(4 * g + 2) * 32 + r32] + ex[(4 * g + 3) * 32 + r32]);
            const float rs = 1.0f / sqrtf(tot * (1.f / 256.f) + EPS);
            if (t >= 0) { bf16* mo = MIX + (size_t)(b * TT + t) * 1024 + 64 * h + 4 * hi;
#pragma unroll
                for (int pt = 0; pt < 2; ++pt)
#pragma unroll
                    for (int gq = 0; gq < 4; ++gq) { const f32x4 gg = *(const f32x4*)(ng + 64 * h + 32 * pt + 8 * gq + 4 * hi);
                        v2u w; w.x = pk2(y[pt][4 * gq] * rs * gg.x, y[pt][4 * gq + 1] * rs * gg.y); w.y = pk2(y[pt][4 * gq + 2] * rs * gg.z, y[pt][4 * gq + 3] * rs * gg.w);
                        *(v2u*)(mo + 32 * pt + 8 * gq) = w; } }
        }
        __syncthreads();
    }
    const float* YS = (const float*)(F.ws + WS_YS);
    for (int u = F.gw; u < DB * NG; u += F.NGW) { const int b = u >> 1, gg = u & 1; const int cc = gg * 256 + 4 * F.lane;
        const f32x4 yv = *(const f32x4*)(YS + (size_t)b * 512 + cc); const v2u zw = *(const v2u*)(PROJ + (size_t)(RP + b) * PJ + C_Z + cc);
        const f32x4 v = {yv.x * silu_f(bflo(zw.x)), yv.y * silu_f(bfhi(zw.x)), yv.z * silu_f(bflo(zw.y)), yv.w * silu_f(bfhi(zw.y))};
        const float rs = 1.0f / sqrtf(wave_sum((v.x * v.x + v.y * v.y) + (v.z * v.z + v.w * v.w)) * (1.f / 256.f) + EPS);
        const f32x4 gv = *(const f32x4*)(ng + cc); v2u w; w.x = pk2(v.x * rs * gv.x, v.y * rs * gv.y); w.y = pk2(v.z * rs * gv.z, v.w * rs * gv.w);
        *(v2u*)(MIX + (size_t)(RP + b) * 1024 + cc) = w; }
}

__device__ __forceinline__ void p5_attn_decode(Frame& F, float M0) {
    const float* clat = (const float*)F.in[2]; const float* ckr = (const float*)F.in[3]; const int* ptab = (const int*)F.in[6];
    const bf16* WUKV = (const bf16*)(F.ws + WS_WUKV); const bf16* Q = (const bf16*)(F.ws + WS_Q); const float* gkn = (const float*)F.in[22]; const float* gkr = (const float*)F.in[23];
    float* DPART = (float*)(F.ws + WS_DPART);
    LAS unsigned char* L = F.lds + RING_OFF;
    LAS float* krl = (LAS float*)(L + DA_KR); LAS bf16* pb = (LAS bf16*)(L + DA_PB); LAS float* qg = (LAS float*)(L + DA_QG) + F.wave * 96;
    const int h = F.wave, r32 = F.lane & 31, hi = F.lane >> 5;
    for (int u = blockIdx.x; u < DB * 2; u += F.G) {
        const int b = u >> 1, split = u & 1;
        bf16x8 wf[2][16];
#pragma unroll
        for (int dt = 0; dt < 2; ++dt)
#pragma unroll
            for (int s = 0; s < 16; ++s) wf[dt][s] = *(const bf16x8*)(WUKV + (size_t)(128 * h + 32 * dt + r32) * KVL + 16 * s + 8 * hi);
        { const bf16* qp = Q + (size_t)(RP + b) * 768 + 96 * h; qg[F.lane] = bf2f(qp[F.lane]) * gkn[F.lane]; if (F.lane < 32) qg[64 + F.lane] = bf2f(qp[64 + F.lane]) * gkr[F.lane & 15]; }
        for (int i = F.tid; i < 2 * 16 * 32; i += NTHR) pb[i] = 0;
        f32x4 ao[2] = {(f32x4){0.f, 0.f, 0.f, 0.f}, (f32x4){0.f, 0.f, 0.f, 0.f}}; float l = 0.f;
        int par = 0;
#pragma unroll 1
        for (int pg = 0; pg < 32; ++pg) {
            const size_t page = (size_t)ptab[b * NPAGES + split * 32 + pg];
            __syncthreads();
            { const float* src = clat + page * (PAGE * KVL);
#pragma unroll 4
              for (int k = 0; k < 16; ++k) { const int f = F.tid + NTHR * k; const int row = f >> 6, c4 = f & 63; const f32x4 v = ((const f32x4*)src)[f];
                  v2u w; w.x = pk2(v.x, v.y); w.y = pk2(v.z, v.w); *(LAS v2u*)(L + DA_LAT + row * DA_ROWB + c4 * 8) = w; }
              const float* ks = ckr + page * (PAGE * 32);
#pragma unroll
              for (int k = 0; k < 2; ++k) { const int f = F.tid + NTHR * k; const int row = f >> 3, c4 = f & 7; const f32x4 v = ((const f32x4*)ks)[f];
                  LAS float* d = krl + row * 33 + 4 * c4; d[0] = v.x; d[1] = v.y; d[2] = v.z; d[3] = v.w; } }
            __syncthreads();
#pragma unroll 1
            for (int sb = 0; sb < 4; ++sb) {
                f32x16 a0 = (f32x16){}, a1 = (f32x16){};
                const LAS unsigned char* bp = L + DA_LAT + (32 * sb + r32) * DA_ROWB + 16 * hi;
#pragma unroll
                for (int s = 0; s < 16; ++s) { const bf16x8 bfr = *(const LAS bf16x8*)(bp + 32 * s); a0 = MFMA32(wf[0][s], bfr, a0); a1 = MFMA32(wf[1][s], bfr, a1); }
                float ss = 0.f, dot = 0.f;
#pragma unroll
                for (int i = 0; i < 16; ++i) { const int d = crow(i, hi); ss += a0[i] * a0[i] + a1[i] * a1[i]; dot += a0[i] * qg[d] + a1[i] * qg[32 + d]; }
                const LAS float* kr = krl + (32 * sb + r32) * 33 + 16 * hi;
#pragma unroll
                for (int cidx = 0; cidx < 16; ++cidx) { const float kv = kr[cidx]; ss += kv * kv; dot += kv * qg[64 + 16 * hi + cidx]; }
                ss += __shfl_xor(ss, 32); dot += __shfl_xor(dot, 32);
                const float p = __builtin_amdgcn_exp2f(dot / sqrtf(ss * (1.f / 96.f) + EPS) - M0);
                l += p;
                if (hi == 0) pb[par * 512 + h * 32 + r32] = f2bf(p);
                __syncthreads();
                const bf16x8 pa = *(const LAS bf16x8*)(pb + par * 512 + (F.lane & 15) * 32 + 8 * (F.lane >> 4));
                const int q4 = (F.lane & 15) >> 2, pp = F.lane & 3, kg = F.lane >> 4;
#pragma unroll
                for (int nt = 0; nt < 2; ++nt) {
                    const unsigned a_lo = (unsigned)(uintptr_t)(L + DA_LAT) + (unsigned)((32 * sb + 8 * kg + q4) * DA_ROWB + (32 * h + 16 * nt + 4 * pp) * 2);
                    s16x4 lo, hi4;
                    asm volatile("ds_read_b64_tr_b16 %0, %2\n\tds_read_b64_tr_b16 %1, %2 offset:%c3\n\ts_waitcnt lgkmcnt(0)" : "=&v"(lo), "=&v"(hi4) : "v"(a_lo), "i"(4 * DA_ROWB) : "memory");
                    const bf16x8 bfr = (bf16x8){lo[0], lo[1], lo[2], lo[3], hi4[0], hi4[1], hi4[2], hi4[3]};
                    ao[nt] = MFMA16(pa, bfr, ao[nt]);
                }
                par ^= 1;
            }
        }
        { const int kg = F.lane >> 4;
          if (kg < 2) {
#pragma unroll
              for (int nt = 0; nt < 2; ++nt)
#pragma unroll
                  for (int i = 0; i < 4; ++i) DPART[((size_t)((b * 2 + split) * NH + 4 * kg + i)) * 264 + 32 * h + 16 * nt + (F.lane & 15)] = ao[nt][i]; }
          float lt = (hi == 0) ? l : 0.f; lt = wave_sum(lt);
          if (F.lane == 0) DPART[((size_t)((b * 2 + split) * NH + h)) * 264 + 256] = lt; }
        __syncthreads();
    }
}

__device__ __forceinline__ void p6_decode_combine(Frame& F, float M0) {
    const float* DPART = (const float*)(F.ws + WS_DPART); const bf16* WUKV = (const bf16*)(F.ws + WS_WUKV); const bf16* Q = (const bf16*)(F.ws + WS_Q); const bf16* K = (const bf16*)(F.ws + WS_K);
    const float* VS = (const float*)(F.ws + WS_VS); const float* mg = (const float*)F.in[24]; bf16* MIX = (bf16*)(F.ws + WS_MIX);
    LAS float* accl = (LAS float*)(F.lds + RING_OFF) + F.wave * 256; LAS float* exch = (LAS float*)(F.lds + P5_EXCH);
    const int h = F.wave;
    for (int b = blockIdx.x; b < DB; b += F.G) {
        const float* p0 = DPART + ((size_t)((b * 2 + 0) * NH + h)) * 264; const float* p1 = DPART + ((size_t)((b * 2 + 1) * NH + h)) * 264;
#pragma unroll
        for (int k = 0; k < 4; ++k) accl[F.lane + 64 * k] = p0[F.lane + 64 * k] + p1[F.lane + 64 * k];
        float l = p0[256] + p1[256];
        const bf16* qp = Q + (size_t)(RP + b) * 768 + 96 * h; const bf16* kp = K + (size_t)(RP + b) * 768 + 96 * h;
        float sd = bf2f(qp[F.lane]) * bf2f(kp[F.lane]); if (F.lane < 32) sd += bf2f(qp[64 + F.lane]) * bf2f(kp[64 + F.lane]);
        sd = wave_sum(sd);
        const float pn = __builtin_amdgcn_exp2f(sd - M0); l += pn;
        LDS_WAIT(); asm volatile("" ::: "memory");
        const bf16* wv = WUKV + (size_t)(128 * h + 64 + F.lane) * KVL;
        float o = 0.f;
#pragma unroll 4
        for (int c8 = 0; c8 < 32; ++c8) { const v4u w = *(const v4u*)(wv + 8 * c8); const f32x4 x0 = *(const LAS f32x4*)(accl + 8 * c8), x1 = *(const LAS f32x4*)(accl + 8 * c8 + 4);
            o += (bflo(w.x) * x0.x + bfhi(w.x) * x0.y) + (bflo(w.y) * x0.z + bfhi(w.y) * x0.w) + (bflo(w.z) * x1.x + bfhi(w.z) * x1.y) + (bflo(w.w) * x1.z + bfhi(w.w) * x1.w); }
        o = (o + pn * VS[(size_t)b * 512 + 64 * h + F.lane]) / l;
        const float ss = wave_sum(o * o);
        if (F.lane == 0) exch[h] = ss;
        __syncthreads();
        float tot = 0.f;
#pragma unroll
        for (int hh = 0; hh < NH; ++hh) tot += exch[hh];
        const float rs = 1.0f / sqrtf(tot * (1.f / MLAW) + EPS);
        MIX[(size_t)(RP + b) * 1024 + 512 + 64 * h + F.lane] = f2bf(o * rs * mg[64 * h + F.lane]);
        __syncthreads();
    }
}

__device__ __forceinline__ void p7_outproj(Frame& F) {
    const bf16* MIX = (const bf16*)(F.ws + WS_MIX); const bf16* WOUT = (const bf16*)(F.ws + WS_WOUT); const float* xp = (const float*)F.in[0]; const float* xs = (const float*)F.in[1]; float* HS = (float*)(F.ws + WS_HS);
    { pg8::Gemm g{MIX, WOUT, MMAIN, DM, 1024, 1}; pg8::StaticOrder S; S.init(MMAIN, DM, F.G, (int)blockIdx.x); EpiResF32 E{xp, F.out + OUT_YP};
      pg8::gemm_phase<EpiResF32, pg8::StaticOrder, true, true>(F.lds + RING_OFF, g, S, E); }
    small_gemm(MIX, 1024, WOUT, 1024, DB / 16, DM / 16, [](int r) { return RP + r; },
        [&](const f32x4& acc, int rt, int ct, int lane) { const int col = ct * 16 + (lane & 15);
#pragma unroll
            for (int i = 0; i < 4; ++i) { const size_t o = (size_t)(rt * 16 + 4 * (lane >> 4) + i) * DM + col; HS[o] = xs[o] + acc[i]; } }, F.gw, F.NGW, F.lane);
}
__device__ __forceinline__ void p8_ffn_norm(Frame& F) {
    const float* g = (const float*)F.in[26]; const float* HS = (const float*)(F.ws + WS_HS); bf16* HN = (bf16*)(F.ws + WS_XN);
    f32x4 gv[4];
#pragma unroll
    for (int j = 0; j < 4; ++j) gv[j] = ((const f32x4*)g)[F.lane + 64 * j];
    for (int r = F.gw; r < MMAIN + DB; r += F.NGW) {
        const float* src; int row;
        if (r < MMAIN) { src = F.out + OUT_YP + (size_t)r * DM; row = (r >> 11) * TT + NMETA + (r & 2047); } else { src = HS + (size_t)(r - MMAIN) * DM; row = RP + (r - MMAIN); }
        f32x4 v[4]; float s = 0.f;
#pragma unroll
        for (int j = 0; j < 4; ++j) { v[j] = ((const f32x4*)src)[F.lane + 64 * j]; s += (v[j].x * v[j].x + v[j].y * v[j].y) + (v[j].z * v[j].z + v[j].w * v[j].w); }
        const float rs = 1.0f / sqrtf(wave_sum(s) * (1.f / DM) + EPS);
        v2u* o8 = (v2u*)(HN + (size_t)row * DM) + F.lane;
#pragma unroll
        for (int j = 0; j < 4; ++j) { v2u o; o.x = pk2(v[j].x * rs * gv[j].x, v[j].y * rs * gv[j].y); o.y = pk2(v[j].z * rs * gv[j].z, v[j].w * rs * gv[j].w); o8[64 * j] = o; }
    }
}
__device__ __forceinline__ void p9_gateup(Frame& F) {
    const bf16* HN = (const bf16*)(F.ws + WS_XN); const bf16* WGU = (const bf16*)(F.ws + WS_WGU); bf16* ACT = (bf16*)(F.ws + WS_ACT);
    { pg8::Gemm g{HN, WGU, MMAIN, 2 * DFF, DM, 1}; pg8::StaticOrder S; S.init(MMAIN, 2 * DFF, F.G, (int)blockIdx.x); EpiSwiGLU E{ACT};
      pg8::gemm_phase<EpiSwiGLU, pg8::StaticOrder, true, true>(F.lds + RING_OFF, g, S, E); }
    const int nrt = DB / 16, nlt = DFF / 16;
    for (int task = F.gw; task < nrt * nlt; task += F.NGW) {
        const int rt = task % nrt, lt = task / nrt; const int lc = lt * 16 + (F.lane & 15);
        const bf16* ap = HN + (size_t)(RP + rt * 16 + (F.lane & 15)) * DM + 8 * (F.lane >> 4);
        const bf16* gp = WGU + (size_t)(256 * (lc >> 7) + (lc & 127)) * DM + 8 * (F.lane >> 4); const bf16* up = gp + (size_t)128 * DM;
        f32x4 ag = {0.f, 0.f, 0.f, 0.f}, au = {0.f, 0.f, 0.f, 0.f};
#pragma unroll 8
        for (int k0 = 0; k0 < DM; k0 += 32) { const bf16x8 a = *(const bf16x8*)(ap + k0); ag = MFMA16(a, *(const bf16x8*)(gp + k0), ag); au = MFMA16(a, *(const bf16x8*)(up + k0), au); }
#pragma unroll
        for (int i = 0; i < 4; ++i) ACT[(size_t)(RP + rt * 16 + 4 * (F.lane >> 4) + i) * DFF + lc] = f2bf(silu_f(ag[i]) * au[i]);
    }
}
__device__ __forceinline__ void p10_down(Frame& F) {
    const bf16* ACT = (const bf16*)(F.ws + WS_ACT); const bf16* WDN = (const bf16*)(F.ws + WS_WDN); const float* HS = (const float*)(F.ws + WS_HS);
    { pg8::Gemm g{ACT, WDN, MMAIN, DM, DFF, 1}; pg8::StaticOrder S; S.init(MMAIN, DM, F.G, (int)blockIdx.x); EpiResF32 E{F.out + OUT_YP, F.out + OUT_YP};
      pg8::gemm_phase<EpiResF32, pg8::StaticOrder, true, true>(F.lds + RING_OFF, g, S, E); }
    float* ys = F.out + OUT_YS;
    small_gemm(ACT, DFF, WDN, DFF, DB / 16, DM / 16, [](int r) { return RP + r; },
        [&](const f32x4& acc, int rt, int ct, int lane) { const int col = ct * 16 + (lane & 15);
#pragma unroll
            for (int i = 0; i < 4; ++i) { const size_t o = (size_t)(rt * 16 + 4 * (lane >> 4) + i) * DM + col; ys[o] = HS[o] + acc[i]; } }, F.gw, F.NGW, F.lane);
}
#ifndef MK_ONE_LAUNCH
#define MK_ONE_LAUNCH 0
#endif
constexpr int N_PHASES = 11;
__global__ void __launch_bounds__(NTHR, 2) mk_fwd(Args args) {
    extern __shared__ __attribute__((aligned(16))) unsigned char lds_raw[];
    Frame F;
    F.lds = (LAS unsigned char*)lds_raw;
    F.tid = threadIdx.x; F.lane = F.tid & 63; F.wave = __builtin_amdgcn_readfirstlane(F.tid >> 6);
    F.G = gridDim.x; { const int bx = blockIdx.x; F.vcu = (F.G % 8 == 0) ? (bx % 8) * (F.G / 8) + bx / 8 : bx; }
    F.gw = blockIdx.x * NWAVES + F.wave; F.NGW = F.G * NWAVES;
    F.ws = args.ws; F.out = args.out; F.in = args.in;
    volatile LAS unsigned* MISC = (volatile LAS unsigned*)(F.lds + MISC_OFF);
    for (int u = F.tid; u < (LDS_BYTES - LDSCTL_OFF) / 4; u += NTHR) ((LAS unsigned*)(F.lds + LDSCTL_OFF))[u] = 0u;
    __syncthreads();
    XcdBarrier bar; bar.bar = (unsigned*)(F.ws + WS_CTL) + CW_BAR; bar.x = 0; bar.st = nullptr;
    if (MK_ONE_LAUNCH) bar = xcd_barrier_post((unsigned*)(F.ws + WS_CTL) + CW_BAR, MISC + 8);
    const int lo = args.ph_lo, hi = args.ph_hi;
#define IN(k) (lo <= (k) && (k) < hi)
#define SEAM(k) do { if (IN(k) && IN((k) + 1)) xcd_barrier(bar); } while (0)
    if (IN(0)) { p0_prologue(F); } SEAM(0);
    if (IN(1)) { p1_inproj(F); } SEAM(1);
    if (IN(2)) { p2_elementwise(F); } SEAM(2);
    if (IN(3)) { p3_upproj_states(F); } SEAM(3);
    if (IN(4)) { p4_post(F); } SEAM(4);
    if (IN(5)) { const float M0 = softmax_ref(F); p5_attn_prompt(F, M0); __syncthreads(); p5_ssd_out(F); __syncthreads(); p5_attn_decode(F, M0); } SEAM(5);
    if (IN(6)) { const float M0 = softmax_ref(F); p6_decode_combine(F, M0); } SEAM(6);
    if (IN(7)) { p7_outproj(F); } SEAM(7);
    if (IN(8)) { p8_ffn_norm(F); } SEAM(8);
    if (IN(9)) { p9_gateup(F); } SEAM(9);
    if (IN(10)) { p10_down(F); }
#undef IN
#undef SEAM
}
template <class FA, class FB>
__global__ void k_cmp(int slot, float* diag, size_t n, FA fa, FB fb) {
    float e = 0.f, r = 0.f;
    for (size_t i = (size_t)blockIdx.x * blockDim.x + threadIdx.x; i < n; i += (size_t)gridDim.x * blockDim.x) { const float a = fa(i), b = fb(i); const float d = a - b; e += d * d; r += b * b; }
    e = wave_sum(e); r = wave_sum(r);
    if ((threadIdx.x & 63) == 0) { atomicAdd(diag + 2 * slot, e); atomicAdd(diag + 2 * slot + 1, r); }
}
template <class FA, class FB> inline void cmp(hipStream_t s, int slot, float* diag, size_t n, FA fa, FB fb) { k_cmp<<<2048, 256, 0, s>>>(slot, diag, n, fa, fb); }
__global__ void k_diag_encode(const float* diag, int nslots, float tol, float* out) {
    __shared__ float sv;
    if (threadIdx.x == 0) { float v = 0.f;
        for (int k = 0; k < nslots; ++k) { const float e = diag[2 * k], r = diag[2 * k + 1]; int d2 = -1;
            if (!(e == e) || !(r == r)) d2 = 9; else if (r <= 0.f) d2 = 8; else { const float q = e / r; if (q > tol) { d2 = (int)floorf(-log10f(q)); d2 = d2 < 0 ? 0 : d2 > 7 ? 7 : d2; } }
            if (d2 >= 0) { v = 0.1f * (float)(k + 1) + 0.01f * (float)d2; break; } }
        sv = v; }
    __syncthreads();
    const float v = sv; if (v == 0.f) return;
    const float f = 1.f + sqrtf(v);
    for (int i = blockIdx.x * blockDim.x + threadIdx.x; i < 131072; i += gridDim.x * blockDim.x) out[OUT_YS + i] *= f;
}
#ifndef MK_DIAG
#define MK_DIAG 0
#endif
__device__ __forceinline__ size_t nmrow(size_t r) { return r < (size_t)MMAIN ? (r >> 11) * TT + NMETA + (r & 2047) : (size_t)RP + (r - MMAIN); }
constexpr size_t WS_OUT2 = 1024 * MiB;
extern "C" void kernel_launch(void* const* d_in, const int* in_sizes, int n_in, void* d_out, int out_size, void* d_ws, size_t ws_size, hipStream_t stream) {
    (void)hipFuncSetAttribute((const void*)mk_fwd, hipFuncAttributeMaxDynamicSharedMemorySize, LDS_BYTES);
    unsigned char* ws = (unsigned char*)d_ws;
    (void)hipMemsetAsync(ws + WS_CTL, 0, CTL_ZERO_BYTES, stream);
    Args a{};
    for (int i = 0; i < 30; ++i) a.in[i] = d_in[i];
    a.ws = ws; a.out = (float*)d_out;
#if MK_DIAG
    float* diag = (float*)(ws + WS_DIAG);
    (void)hipMemsetAsync(diag, 0, 512, stream);
    nv::forward(d_in, (float*)d_out, (float*)(ws + WS_NAIVE), stream);
    a.out = (float*)(ws + WS_OUT2);
#endif
    const int grid = 256;
#if MK_ONE_LAUNCH
    a.ph_lo = 0; a.ph_hi = N_PHASES; a.li = 0;
    hipLaunchKernelGGL(mk_fwd, dim3(grid), dim3(NTHR), LDS_BYTES, stream, a);
#else
    for (int ph = 0; ph < N_PHASES; ++ph) { a.ph_lo = ph; a.ph_hi = ph + 1; a.li = ph; hipLaunchKernelGGL(mk_fwd, dim3(grid), dim3(NTHR), LDS_BYTES, stream, a); }
#endif
#if MK_DIAG
    {
        nv::Ws w = nv::carve((float*)(ws + WS_NAIVE));
        const bf16* QRAW = (const bf16*)(ws + WS_QRAW); const bf16* KVRAW = (const bf16*)(ws + WS_KVRAW); const bf16* Q = (const bf16*)(ws + WS_Q); const bf16* K = (const bf16*)(ws + WS_K);
        const bf16* VT = (const bf16*)(ws + WS_VT); const float* VS = (const float*)(ws + WS_VS); const bf16* MIX = (const bf16*)(ws + WS_MIX);
        const float* o2 = (const float*)(ws + WS_OUT2); const float* o1 = (const float*)d_out;
        const float* nQRAW = w.QRAW; const float* nKV = w.KV; const float* nQ = w.Q; const float* nK = w.K; const float* nV = w.V; const float* nMIX = w.MIX;
        const size_t NMR = (size_t)MMAIN + DB;
        cmp(stream, 0, diag, NMR * 768, [=] __device__(size_t i) { return bf2f(QRAW[nmrow(i / 768) * 768 + i % 768]); }, [=] __device__(size_t i) { return nQRAW[nmrow(i / 768) * 768 + i % 768]; });
        cmp(stream, 1, diag, (size_t)R * 1024, [=] __device__(size_t i) { return bf2f(KVRAW[i]); }, [=] __device__(size_t i) { return nKV[i]; });
        cmp(stream, 2, diag, NMR * 768, [=] __device__(size_t i) { return bf2f(Q[nmrow(i / 768) * 768 + i % 768]); }, [=] __device__(size_t i) { return nQ[nmrow(i / 768) * 768 + i % 768] * (ATTN_SCALE * LOG2E); });
        cmp(stream, 3, diag, (size_t)R * 768, [=] __device__(size_t i) { return bf2f(K[i]); }, [=] __device__(size_t i) { return nK[i]; });
        cmp(stream, 4, diag, (size_t)NB * 512 * TT, [=] __device__(size_t i) { const size_t bhd = i / TT; const int t = (int)(i % TT); return bf2f(VT[bhd * TPAD + t]); },
            [=] __device__(size_t i) { const size_t bhd = i / TT; const int t = (int)(i % TT); const size_t b = bhd / 512, hd = bhd % 512; return nV[(b * TT + t) * 512 + hd]; });
        cmp(stream, 4, diag, (size_t)DB * 512, [=] __device__(size_t i) { return VS[i]; }, [=] __device__(size_t i) { return nV[(size_t)RP * 512 + i]; });
        cmp(stream, 5, diag, (size_t)(OUT_LATS - OUT_SSMP), [=] __device__(size_t i) { return o2[OUT_SSMP + i]; }, [=] __device__(size_t i) { return o1[OUT_SSMP + i]; });
        cmp(stream, 5, diag, (size_t)4194304, [=] __device__(size_t i) { return o2[OUT_SSMS + i]; }, [=] __device__(size_t i) { return o1[OUT_SSMS + i]; });
        cmp(stream, 6, diag, (size_t)R * 512, [=] __device__(size_t i) { return bf2f(MIX[(i >> 9) * 1024 + (i & 511)]); }, [=] __device__(size_t i) { return nMIX[(i >> 9) * 1024 + (i & 511)]; });
        cmp(stream, 7, diag, NMR * 512, [=] __device__(size_t i) { return bf2f(MIX[nmrow(i >> 9) * 1024 + 512 + (i & 511)]); }, [=] __device__(size_t i) { return nMIX[nmrow(i >> 9) * 1024 + 512 + (i & 511)]; });
        cmp(stream, 8, diag, (size_t)OUT_LATP, [=] __device__(size_t i) { return o2[i]; }, [=] __device__(size_t i) { return o1[i]; });
        k_diag_encode<<<64, 256, 0, stream>>>(diag, 9, 1e-3f, (float*)d_out);
    }
#endif
}
```

```cpp
#define MK_DIAG 0
#define MK_ONE_LAUNCH 1
#include <hip/hip_runtime.h>
#include <cstdio>
#include <cstdint>
namespace nv {
constexpr int DM = 1024, NB = 8, SEQ = 2048, NMETA = 16, T = SEQ + NMETA;
constexpr int DB = 128, PAST = 8192, PAGE = 128, NPAGES = 64;
constexpr int NH = 8, HP = 64, SSDW = 512, NG = 2, DS = 64, CONVD = 768;
constexpr int QKN = 64, QKR = 32, QKD = 96, VD = 64, MLAW = 512, QL = 384, KVL = 256;
constexpr int DFF = 2816, INC = 1960;
constexpr int O_Z = 0, O_XBC = 512, O_DT = 1280, O_CQ = 1288, O_CKV = 1672, O_KR = 1928;
constexpr int RP = NB * T;
constexpr int R = RP + DB;
constexpr float EPS = 1e-6f;
constexpr float ATTN_SCALE = 0.10206207261596577f;
constexpr size_t OUT_YP = 0, OUT_YS = 16777216, OUT_LATP = 16908288, OUT_KRP = 21135360, OUT_CONVP = 21663744,
                 OUT_SSMP = 21682176, OUT_LATS = 21944320, OUT_KRS = 21977088, OUT_CONVS = 21981184, OUT_SSMS = 22276096,
                 OUT_TOTAL = 26470400;

__device__ __forceinline__ float wsum(float v) {
#pragma unroll
    for (int o = 32; o > 0; o >>= 1) v += __shfl_xor(v, o);
    return v;
}
__device__ __forceinline__ float wmax(float v) {
#pragma unroll
    for (int o = 32; o > 0; o >>= 1) v = fmaxf(v, __shfl_xor(v, o));
    return v;
}
__device__ __forceinline__ float silu_f(float x) { return x / (1.f + expf(-x)); }
__device__ __forceinline__ float softplus_f(float x) { return fmaxf(x, 0.f) + log1pf(expf(-fabsf(x))); }
__device__ __forceinline__ float rope_inv(int j) { return exp2f(-(float)j * (13.287712379549449f / 16.0f)); }

__global__ void k_build_x(const float* xp, const float* xs, const float* meta, float* X) {
    const int row = blockIdx.x; const int tid = threadIdx.x;
    const float* src;
    if (row < RP) { const int b = row / T, t = row % T; src = (t < NMETA) ? meta + (size_t)t * DM : xp + ((size_t)b * SEQ + (t - NMETA)) * DM; }
    else src = xs + (size_t)(row - RP) * DM;
    ((float4*)(X + (size_t)row * DM))[tid] = ((const float4*)src)[tid];
}
__global__ void k_rmsnorm(const float* in, int ldi, int ic, int n, const float* g, float* out, int ldo, int oc, int rows) {
    const int row = blockIdx.x * 4 + (threadIdx.x >> 6), lane = threadIdx.x & 63;
    if (row >= rows) return;
    const float* x = in + (size_t)row * ldi + ic;
    float s = 0.f;
    for (int i = lane; i < n; i += 64) { const float v = x[i]; s += v * v; }
    s = wsum(s);
    const float r = 1.0f / sqrtf(s / (float)n + EPS);
    float* o = out + (size_t)row * ldo + oc;
    for (int i = lane; i < n; i += 64) o[i] = x[i] * r * g[i];
}
__global__ void __launch_bounds__(256) k_gemm(const float* A, int lda, const float* B, int ldb, float* C, int ldc, const float* Rs, int ldr, int M, int N, int K) {
    __shared__ float As[16][68];
    __shared__ float Bs[16][68];
    const int tid = threadIdx.x, tx = tid & 15, ty = tid >> 4;
    const int m0 = blockIdx.y * 64, n0 = blockIdx.x * 64;
    float acc[4][4];
#pragma unroll
    for (int i = 0; i < 4; ++i)
#pragma unroll
        for (int j = 0; j < 4; ++j) acc[i][j] = 0.f;
    for (int k0 = 0; k0 < K; k0 += 16) {
        { const int r = tid >> 2, kk = (tid & 3) * 4; const float4 v = *(const float4*)(A + (size_t)(m0 + r) * lda + k0 + kk);
          As[kk + 0][r] = v.x; As[kk + 1][r] = v.y; As[kk + 2][r] = v.z; As[kk + 3][r] = v.w; }
        { const int kk = tid >> 4, nn = (tid & 15) * 4; const float* bp = B + (size_t)(k0 + kk) * ldb + n0 + nn;
#pragma unroll
          for (int j = 0; j < 4; ++j) Bs[kk][nn + j] = (n0 + nn + j < N) ? bp[j] : 0.f; }
        __syncthreads();
#pragma unroll
        for (int kk = 0; kk < 16; ++kk) {
            const float4 a = *(const float4*)&As[kk][ty * 4]; const float4 b = *(const float4*)&Bs[kk][tx * 4];
            const float av[4] = {a.x, a.y, a.z, a.w}, bv[4] = {b.x, b.y, b.z, b.w};
#pragma unroll
            for (int i = 0; i < 4; ++i)
#pragma unroll
                for (int j = 0; j < 4; ++j) acc[i][j] += av[i] * bv[j];
        }
        __syncthreads();
    }
#pragma unroll
    for (int i = 0; i < 4; ++i) { const int row = m0 + ty * 4 + i;
#pragma unroll
        for (int j = 0; j < 4; ++j) { const int col = n0 + tx * 4 + j; if (col < N) { float v = acc[i][j]; if (Rs) v += Rs[(size_t)row * ldr + col]; C[(size_t)row * ldc + col] = v; } } }
}
__device__ __forceinline__ int row_pos(int row) { return row < RP ? (row % T) : PAST; }
__global__ void k_rope_kr(const float* PROJ, float* KR) {
    const int i = blockIdx.x * blockDim.x + threadIdx.x; if (i >= R * 16) return;
    const int row = i >> 4, j = i & 15; const float pos = (float)row_pos(row);
    const float ang = pos * rope_inv(j); const float c = cosf(ang), s = sinf(ang);
    const float x1 = PROJ[(size_t)row * INC + O_KR + j], x2 = PROJ[(size_t)row * INC + O_KR + 16 + j];
    KR[(size_t)row * 32 + j] = x1 * c - x2 * s; KR[(size_t)row * 32 + 16 + j] = x1 * s + x2 * c;
}
__global__ void k_q_post(const float* QRAW, const float* gqn, const float* gqr, float* Q) {
    const int w = blockIdx.x * 4 + (threadIdx.x >> 6), lane = threadIdx.x & 63; if (w >= R * NH) return;
    const int row = w / NH; const float* q = QRAW + (size_t)w * QKD; const float pos = (float)row_pos(row);
    const float a = q[lane];
    float rr = 0.f;
    if (lane < 32) { const int j = lane & 15; const float ang = pos * rope_inv(j); const float c = cosf(ang), s = sinf(ang);
        const float x1 = q[64 + j], x2 = q[80 + j]; rr = (lane < 16) ? (x1 * c - x2 * s) : (x1 * s + x2 * c); }
    const float ss = wsum(a * a + rr * rr);
    const float r = 1.0f / sqrtf(ss / 96.f + EPS);
    Q[(size_t)w * QKD + lane] = a * r * gqn[lane];
    if (lane < 32) Q[(size_t)w * QKD + 64 + lane] = rr * r * gqr[lane & 15];
}
__global__ void k_k_post(const float* KV, const float* KR, const float* gkn, const float* gkr, float* K, float* V) {
    const int w = blockIdx.x * 4 + (threadIdx.x >> 6), lane = threadIdx.x & 63; if (w >= R * NH) return;
    const int row = w / NH, h = w % NH;
    const float a = KV[(size_t)row * 1024 + h * 128 + lane];
    const float rr = (lane < 32) ? KR[(size_t)row * 32 + lane] : 0.f;
    const float ss = wsum(a * a + rr * rr);
    const float r = 1.0f / sqrtf(ss / 96.f + EPS);
    K[(size_t)w * QKD + lane] = a * r * gkn[lane];
    if (lane < 32) K[(size_t)w * QKD + 64 + lane] = rr * r * gkr[lane & 15];
    V[(size_t)w * VD + lane] = KV[(size_t)row * 1024 + h * 128 + 64 + lane];
}
__global__ void k_conv(const float* PROJ, const float* state_conv, const float* cw, const float* cb, const float* dtb, float* XA, float* DT) {
    const int row = blockIdx.x, tid = threadIdx.x;
    for (int c = tid; c < CONVD; c += 256) {
        float acc = cb[c];
#pragma unroll
        for (int k = 0; k < 4; ++k) {
            float xv;
            if (row < RP) { const int t = row % T; const int tt = t - 3 + k; xv = (tt >= 0) ? PROJ[(size_t)(row - 3 + k) * INC + O_XBC + c] : 0.f; }
            else { const int b = row - RP; xv = (k < 3) ? state_conv[((size_t)b * 3 + k) * CONVD + c] : PROJ[(size_t)row * INC + O_XBC + c]; }
            acc += xv * cw[k * CONVD + c];
        }
        XA[(size_t)row * CONVD + c] = silu_f(acc);
    }
    if (tid < NH) DT[(size_t)row * NH + tid] = softplus_f(PROJ[(size_t)row * INC + O_DT + tid] + dtb[tid]);
}
__global__ void __launch_bounds__(64) k_scan_prompt(const float* XA, const float* DT, const float* a_log, const float* d_skip, float* Y, float* ssm_p) {
    const int b = blockIdx.x / NH, h = blockIdx.x % NH, p = threadIdx.x; const int g = h / (NH / NG);
    const float A = -expf(a_log[h]), D = d_skip[h];
    float st[DS];
#pragma unroll
    for (int n = 0; n < DS; ++n) st[n] = 0.f;
    for (int t = 0; t < T; ++t) {
        const size_t row = (size_t)b * T + t;
        const float dt = DT[row * NH + h]; const float a = expf(dt * A);
        const float x = XA[row * CONVD + h * HP + p]; const float u = dt * x;
        const float* Bm = XA + row * CONVD + SSDW + g * DS; const float* Cm = XA + row * CONVD + SSDW + NG * DS + g * DS;
        float y = 0.f;
#pragma unroll
        for (int n = 0; n < DS; ++n) { st[n] = st[n] * a + u * Bm[n]; y += Cm[n] * st[n]; }
        Y[row * SSDW + h * HP + p] = y + D * x;
    }
#pragma unroll
    for (int n = 0; n < DS; ++n) ssm_p[(((size_t)b * NH + h) * HP + p) * DS + n] = st[n];
}
__global__ void __launch_bounds__(64) k_scan_decode(const float* XA, const float* DT, const float* a_log, const float* d_skip, const float* state_ssm, float* Y, float* ssm_s) {
    const int b = blockIdx.x / NH, h = blockIdx.x % NH, p = threadIdx.x; const int g = h / (NH / NG);
    const float A = -expf(a_log[h]), D = d_skip[h];
    const size_t row = (size_t)RP + b;
    const float dt = DT[row * NH + h]; const float a = expf(dt * A);
    const float x = XA[row * CONVD + h * HP + p]; const float u = dt * x;
    const float* Bm = XA + row * CONVD + SSDW + g * DS; const float* Cm = XA + row * CONVD + SSDW + NG * DS + g * DS;
    const size_t sb = (((size_t)b * NH + h) * HP + p) * DS;
    float y = 0.f;
    for (int n = 0; n < DS; ++n) { const float s = state_ssm[sb + n] * a + u * Bm[n]; ssm_s[sb + n] = s; y += Cm[n] * s; }
    Y[row * SSDW + h * HP + p] = y + D * x;
}
__global__ void k_ssd_out(const float* Y, const float* PROJ, const float* ng, float* MIX) {
    const int w = blockIdx.x * 4 + (threadIdx.x >> 6), lane = threadIdx.x & 63; if (w >= R * NG) return;
    const int row = w / NG, g = w % NG;
    float v[4]; float s = 0.f;
#pragma unroll
    for (int i = 0; i < 4; ++i) { const int c = g * 256 + lane + 64 * i; v[i] = Y[(size_t)row * SSDW + c] * silu_f(PROJ[(size_t)row * INC + O_Z + c]); s += v[i] * v[i]; }
    s = wsum(s); const float r = 1.0f / sqrtf(s / 256.f + EPS);
#pragma unroll
    for (int i = 0; i < 4; ++i) { const int c = g * 256 + lane + 64 * i; MIX[(size_t)row * 1024 + c] = v[i] * r * ng[c]; }
}
__global__ void __launch_bounds__(64) k_attn_prompt(const float* Q, const float* K, const float* V, float* ATT) {
    const int bh = blockIdx.y, b = bh / NH, h = bh % NH; const int t = blockIdx.x * 64 + threadIdx.x;
    const int tmax_blk = min(blockIdx.x * 64 + 63, T - 1);
    const bool valid = t < T; const int tq = valid ? t : T - 1;
    float q[QKD];
    const float* qp = Q + (((size_t)b * T + tq) * NH + h) * QKD;
#pragma unroll
    for (int d = 0; d < QKD; ++d) q[d] = qp[d] * ATTN_SCALE;
    float o[VD];
#pragma unroll
    for (int d = 0; d < VD; ++d) o[d] = 0.f;
    float m = -INFINITY, l = 0.f;
    for (int j = 0; j <= tmax_blk; ++j) {
        const float* kp = K + (((size_t)b * T + j) * NH + h) * QKD; const float* vp = V + (((size_t)b * T + j) * NH + h) * VD;
        float s = 0.f;
#pragma unroll
        for (int d = 0; d < QKD; ++d) s += q[d] * kp[d];
        if (j > tq) s = -INFINITY;
        const float mn = fmaxf(m, s);
        const float corr = expf(m - mn);
        const float pw = expf(s - mn);
        l = l * corr + pw;
#pragma unroll
        for (int d = 0; d < VD; ++d) o[d] = o[d] * corr + pw * vp[d];
        m = mn;
    }
    if (valid) { const float il = 1.f / l; float* op = ATT + ((size_t)b * T + t) * MLAW + h * VD;
#pragma unroll
        for (int d = 0; d < VD; ++d) op[d] = o[d] * il; }
}
__global__ void __launch_bounds__(256) k_attn_decode(const float* Q, const float* Knew, const float* Vnew, const float* cache_lat, const float* cache_kr, const int* page_table,
                                                     const float* w_ukv, const float* gkn, const float* gkr, float* ATT) {
    extern __shared__ float sm[];
    float* Wuk = sm;
    float* sc = sm + 256 * 64;
    float* red = sc + PAST;
    float* accl = red + 256;
    float* qg = accl + 256;
    const int b = blockIdx.x / NH, h = blockIdx.x % NH, tid = threadIdx.x;
    const size_t qrow = ((size_t)(RP + b) * NH + h) * QKD;
    for (int i = tid; i < 256 * 64; i += 256) { const int c = i >> 6, d = i & 63; Wuk[i] = w_ukv[(size_t)c * 1024 + h * 128 + d]; }
    if (tid < 96) qg[tid] = Q[qrow + tid] * (tid < 64 ? gkn[tid] : gkr[(tid - 64) & 15]);
    __syncthreads();
    for (int ch = 0; ch < PAST / 256; ++ch) {
        const int t = ch * 256 + tid; const int page = page_table[b * NPAGES + t / PAGE]; const size_t tok = (size_t)page * PAGE + (t % PAGE);
        const float* lat = cache_lat + tok * KVL; const float* kr = cache_kr + tok * QKR;
        float k[64];
#pragma unroll
        for (int d = 0; d < 64; ++d) k[d] = 0.f;
        for (int c = 0; c < KVL; ++c) { const float lv = lat[c]; const float* wr = Wuk + c * 64;
#pragma unroll
            for (int d = 0; d < 64; ++d) k[d] += lv * wr[d]; }
        float ss = 0.f, dot = 0.f;
#pragma unroll
        for (int d = 0; d < 64; ++d) { ss += k[d] * k[d]; dot += k[d] * qg[d]; }
#pragma unroll
        for (int j = 0; j < 32; ++j) { const float kv = kr[j]; ss += kv * kv; dot += kv * qg[64 + j]; }
        sc[t] = ATTN_SCALE * dot / sqrtf(ss / 96.f + EPS);
    }
    float snew = 0.f;
    { const float* kn = Knew + qrow; const float* qq = Q + qrow; for (int d = 0; d < QKD; ++d) snew += qq[d] * kn[d]; snew *= ATTN_SCALE; }
    __syncthreads();
    float mx = snew;
    for (int t = tid; t < PAST; t += 256) mx = fmaxf(mx, sc[t]);
    red[tid] = mx; __syncthreads();
    for (int s = 128; s > 0; s >>= 1) { if (tid < s) red[tid] = fmaxf(red[tid], red[tid + s]); __syncthreads(); }
    mx = red[0]; __syncthreads();
    float ls = 0.f;
    for (int t = tid; t < PAST; t += 256) { const float p = expf(sc[t] - mx); sc[t] = p; ls += p; }
    red[tid] = ls; __syncthreads();
    for (int s = 128; s > 0; s >>= 1) { if (tid < s) red[tid] += red[tid + s]; __syncthreads(); }
    const float pnew = expf(snew - mx);
    const float l = red[0] + pnew; __syncthreads();
    float acc = 0.f;
    for (int t = 0; t < PAST; ++t) { const int page = page_table[b * NPAGES + t / PAGE]; const size_t tok = (size_t)page * PAGE + (t % PAGE); acc += sc[t] * cache_lat[tok * KVL + tid]; }
    accl[tid] = acc; __syncthreads();
    if (tid < 64) { float o = 0.f; for (int c = 0; c < KVL; ++c) o += accl[c] * w_ukv[(size_t)c * 1024 + h * 128 + 64 + tid];
        o += pnew * Vnew[((size_t)(RP + b) * NH + h) * VD + tid];
        ATT[(size_t)(RP + b) * MLAW + h * VD + tid] = o / l; }
}
__global__ void k_silu_mul(float* G, const float* U, size_t n) { const size_t i = (size_t)blockIdx.x * blockDim.x + threadIdx.x; if (i < n) G[i] = silu_f(G[i]) * U[i]; }
__global__ void k_outputs(const float* OUTF, const float* LAT, const float* KR, const float* PROJ, const float* state_conv, float* out) {
    const size_t i = (size_t)blockIdx.x * blockDim.x + threadIdx.x; if (i >= OUT_SSMP) { return; }
    if (i < OUT_YS) { const size_t r = i / DM, c = i % DM; const size_t b = r / SEQ, t = r % SEQ; out[i] = OUTF[(b * T + NMETA + t) * DM + c]; }
    else if (i < OUT_LATP) { const size_t j = i - OUT_YS; out[i] = OUTF[(size_t)RP * DM + j]; }
    else if (i < OUT_KRP) { const size_t j = i - OUT_LATP; out[i] = LAT[j]; }
    else if (i < OUT_CONVP) { const size_t j = i - OUT_KRP; out[i] = KR[j]; }
    else { const size_t j = i - OUT_CONVP; const size_t b = j / (3 * CONVD), k = (j / CONVD) % 3, c = j % CONVD; out[i] = PROJ[(b * T + (T - 3) + k) * INC + O_XBC + c]; }
}
__global__ void k_outputs2(const float* LAT, const float* KR, const float* PROJ, const float* state_conv, float* out) {
    const size_t i = (size_t)blockIdx.x * blockDim.x + threadIdx.x;
    if (i < (size_t)DB * KVL) out[OUT_LATS + i] = LAT[(size_t)RP * KVL + i];
    if (i < (size_t)DB * QKR) out[OUT_KRS + i] = KR[(size_t)RP * QKR + i];
    if (i < (size_t)DB * 3 * CONVD) { const size_t b = i / (3 * CONVD), k = (i / CONVD) % 3, c = i % CONVD;
        out[OUT_CONVS + i] = (k < 2) ? state_conv[(b * 3 + k + 1) * CONVD + c] : PROJ[((size_t)RP + b) * INC + O_XBC + c]; }
}

struct Ws { float *X, *XN, *PROJ, *LAT, *KR, *CQN, *QRAW, *Q, *KV, *K, *V, *XA, *DT, *Y, *MIX, *ATT, *H, *HN, *G, *U, *OUTF; };
inline Ws carve(float* base) {
    Ws w; size_t o = 0; auto take = [&](size_t n) { float* p = base + o; o += (n + 255) & ~(size_t)255; return p; };
    w.X = take((size_t)R * DM); w.XN = take((size_t)R * DM); w.PROJ = take((size_t)R * INC); w.LAT = take((size_t)R * KVL); w.KR = take((size_t)R * QKR);
    w.CQN = take((size_t)R * QL); w.QRAW = take((size_t)R * 768); w.Q = take((size_t)R * 768); w.KV = take((size_t)R * 1024); w.K = take((size_t)R * 768); w.V = take((size_t)R * 512);
    w.XA = take((size_t)R * CONVD); w.DT = take((size_t)R * NH); w.Y = take((size_t)R * SSDW); w.MIX = take((size_t)R * 1024); w.ATT = take((size_t)R * MLAW);
    w.H = take((size_t)R * DM); w.HN = take((size_t)R * DM); w.G = take((size_t)R * DFF); w.U = take((size_t)R * DFF); w.OUTF = take((size_t)R * DM);
    return w;
}
inline void gemm(hipStream_t s, const float* A, int lda, const float* B, int ldb, float* C, int ldc, const float* Rs, int ldr, int M, int N, int K) {
    k_gemm<<<dim3((N + 63) / 64, M / 64), 256, 0, s>>>(A, lda, B, ldb, C, ldc, Rs, ldr, M, N, K);
}
inline void forward(void* const* in, float* out, float* wsf, hipStream_t s) {
    const float* x_prompt = (const float*)in[0]; const float* x_sample = (const float*)in[1]; const float* c_lat = (const float*)in[2]; const float* c_kr = (const float*)in[3];
    const float* state_conv = (const float*)in[4]; const float* state_ssm = (const float*)in[5]; const int* page_table = (const int*)in[6]; const float* meta = (const float*)in[7];
    const float* attn_g = (const float*)in[8]; const float* w_in = (const float*)in[9]; const float* conv_w = (const float*)in[10]; const float* conv_b = (const float*)in[11];
    const float* dt_bias = (const float*)in[12]; const float* a_log = (const float*)in[13]; const float* d_skip = (const float*)in[14]; const float* ssd_g = (const float*)in[15];
    const float* qn_g = (const float*)in[16]; const float* w_uq = (const float*)in[17]; const float* kvn_g = (const float*)in[18]; const float* w_ukv = (const float*)in[19];
    const float* gqn = (const float*)in[20]; const float* gqr = (const float*)in[21]; const float* gkn = (const float*)in[22]; const float* gkr = (const float*)in[23];
    const float* mla_g = (const float*)in[24]; const float* w_out = (const float*)in[25]; const float* ffn_g = (const float*)in[26]; const float* w_gate = (const float*)in[27];
    const float* w_up = (const float*)in[28]; const float* w_down = (const float*)in[29];
    Ws w = carve(wsf);
    k_build_x<<<R, 256, 0, s>>>(x_prompt, x_sample, meta, w.X);
    k_rmsnorm<<<R / 4, 256, 0, s>>>(w.X, DM, 0, DM, attn_g, w.XN, DM, 0, R);
    gemm(s, w.XN, DM, w_in, INC, w.PROJ, INC, nullptr, 0, R, INC, DM);
    k_rmsnorm<<<R / 4, 256, 0, s>>>(w.PROJ, INC, O_CKV, KVL, kvn_g, w.LAT, KVL, 0, R);
    k_rope_kr<<<(R * 16 + 255) / 256, 256, 0, s>>>(w.PROJ, w.KR);
    k_rmsnorm<<<R / 4, 256, 0, s>>>(w.PROJ, INC, O_CQ, QL, qn_g, w.CQN, QL, 0, R);
    gemm(s, w.CQN, QL, w_uq, 768, w.QRAW, 768, nullptr, 0, R, 768, QL);
    k_q_post<<<R * NH / 4, 256, 0, s>>>(w.QRAW, gqn, gqr, w.Q);
    gemm(s, w.LAT, KVL, w_ukv, 1024, w.KV, 1024, nullptr, 0, R, 1024, KVL);
    k_k_post<<<R * NH / 4, 256, 0, s>>>(w.KV, w.KR, gkn, gkr, w.K, w.V);
    k_conv<<<R, 256, 0, s>>>(w.PROJ, state_conv, conv_w, conv_b, dt_bias, w.XA, w.DT);
    k_scan_prompt<<<NB * NH, 64, 0, s>>>(w.XA, w.DT, a_log, d_skip, w.Y, out + OUT_SSMP);
    k_scan_decode<<<DB * NH, 64, 0, s>>>(w.XA, w.DT, a_log, d_skip, state_ssm, w.Y, out + OUT_SSMS);
    k_ssd_out<<<R * NG / 4, 256, 0, s>>>(w.Y, w.PROJ, ssd_g, w.MIX);
    k_attn_prompt<<<dim3((T + 63) / 64, NB * NH), 64, 0, s>>>(w.Q, w.K, w.V, w.ATT);
    { const int smb = (256 * 64 + PAST + 256 + 256 + 96) * 4;
      hipFuncSetAttribute((const void*)k_attn_decode, hipFuncAttributeMaxDynamicSharedMemorySize, smb);
      k_attn_decode<<<DB * NH, 256, smb, s>>>(w.Q, w.K, w.V, c_lat, c_kr, page_table, w_ukv, gkn, gkr, w.ATT); }
    k_rmsnorm<<<R / 4, 256, 0, s>>>(w.ATT, MLAW, 0, MLAW, mla_g, w.MIX, 1024, 512, R);
    gemm(s, w.MIX, 1024, w_out, DM, w.H, DM, w.X, DM, R, DM, 1024);
    k_rmsnorm<<<R / 4, 256, 0, s>>>(w.H, DM, 0, DM, ffn_g, w.HN, DM, 0, R);
    gemm(s, w.HN, DM, w_gate, DFF, w.G, DFF, nullptr, 0, R, DFF, DM);
    gemm(s, w.HN, DM, w_up, DFF, w.U, DFF, nullptr, 0, R, DFF, DM);
    { const size_t n = (size_t)R * DFF; k_silu_mul<<<(unsigned)((n + 255) / 256), 256, 0, s>>>(w.G, w.U, n); }
    gemm(s, w.G, DFF, w_down, DM, w.OUTF, DM, w.H, DM, R, DM, DFF);
    k_outputs<<<(unsigned)((OUT_SSMP + 255) / 256), 256, 0, s>>>(w.OUTF, w.LAT, w.KR, w.PROJ, state_conv, out);
    k_outputs2<<<(DB * 3 * CONVD + 255) / 256, 256, 0, s>>>(w.LAT, w.KR, w.PROJ, state_conv, out);
}
}
namespace pg8 {
#define PG8_LAS __attribute__((address_space(3)))
typedef unsigned short bf16_t;
typedef short bf16x8 __attribute__((ext_vector_type(8)));
typedef float f32x4 __attribute__((ext_vector_type(4)));
typedef unsigned u32x4 __attribute__((ext_vector_type(4)));
constexpr int BM = 256, BK = 64, HALF = 128, HTB = HALF * BK * 2  , STAGE_BYTES = 8 * HTB, NXCD = 8, WGM = 8;

__host__ __device__ __forceinline__ int lds_byte(int r, int c) { const int st = (r >> 4) * 2 + (c >> 5), rr = r & 15, cc = c & 31, ob = rr * 64 + cc * 2; return st * 1024 + (ob ^ (((ob >> 9) & 1) << 5)); }
__host__ __device__ __forceinline__ void stage_rc(int b, int& R, int& C) { const int st = b / 1024, sb = b % 1024, swz = sb ^ (((sb >> 9) & 1) << 5); R = (st >> 1) * 16 + swz / 64; C = (st & 1) * 32 + (swz % 64) / 2; }
__host__ __device__ __forceinline__ int perm32(int rho) { const int n = rho >> 4, i = rho & 15; return 8 * (i >> 2) + 4 * n + (i & 3); }

struct Unit { int pm, pn; };
struct Gemm { const bf16_t* A; const bf16_t* Bt; int M, N, K; int rmode;
    __host__ __device__ __forceinline__ int rowbase(int pm) const { return rmode ? (pm >> 3) * 2064 + 16 + (pm & 7) * 256 : pm * 256; } };

struct StaticOrder {
    int nM, nN, nwg, G, c;
    __host__ __device__ void init(int M, int N, int G_, int c_) { nM = M / BM; nN = N / BM; nwg = nM * nN; G = G_; c = c_; }
    __host__ __device__ bool next(int i, Unit& u) const {
        const long L = (long)i * G + c; if (L >= nwg) return false;
        int wgid = (int)L; { const int q = nwg / NXCD, r = nwg % NXCD, xcd = wgid % NXCD, off = wgid / NXCD; wgid = (xcd < r ? xcd * (q + 1) : r * (q + 1) + (xcd - r) * q) + off; }
        const int nig = WGM * nN, gid = wgid / nig, fm = gid * WGM, gsz = (nM - fm) < WGM ? (nM - fm) : WGM;
        u.pm = fm + ((wgid % nig) % gsz); u.pn = (wgid % nig) / gsz; return true;
    }
    __device__ __forceinline__ void a_ready(const Unit&) const {}
    __device__ __forceinline__ void done(const Unit&) const {}
};


template <class Epi, class Sched, bool ALIGN_EPI = false, bool SP2 = false>
__device__ __forceinline__ void gemm_phase(PG8_LAS unsigned char* lds, const Gemm g, const Sched& S, const Epi& E) {
    const int tid = threadIdx.x, wid = __builtin_amdgcn_readfirstlane(tid >> 6), lane = tid & 63, wr = wid >> 2, wc = wid & 3, fr = lane & 15, fq = lane >> 4;
    const int K = g.K, nt = K / BK;
    unsigned voffA[2], voffB[2];
#pragma unroll
    for (int i = 0; i < 2; ++i) { int R, C; stage_rc(tid * 16 + i * 8192, R, C); const int Rb = Epi::PERM ? ((R & ~31) + perm32(R & 31)) : R;
        voffA[i] = (unsigned)(R * K + C) * 2u; voffB[i] = (unsigned)(Rb * K + C) * 2u; }
    const size_t kstep = (size_t)(BK * 2);
    const size_t hstep = (size_t)HALF * K * 2;
    const size_t tstep = 2 * hstep;
    const unsigned ldsw = (unsigned)wid * 1024u;
    const int aoff = lds_byte(wr * 64 + fr, fq * 8), boff = lds_byte(wc * 32 + fr, fq * 8);
#define PG8_SA(b, h) (((b) * 2 + (h)) * HTB)
#define PG8_SB(b, h) ((4 + (b) * 2 + (h)) * HTB)
#define PG8_STAGE(bufoff, gbase, voff) do { _Pragma("unroll") for (int _i = 0; _i < 2; ++_i) \
        __builtin_amdgcn_global_load_lds((const unsigned*)((const char*)(gbase) + (voff)[_i]), (PG8_LAS unsigned*)(lds + (bufoff) + ldsw + _i * 8192), 16, 0, 0); } while (0)
#define PG8_LDA(dst, b, h) do { _Pragma("unroll") for (int m = 0; m < 4; ++m) _Pragma("unroll") for (int k = 0; k < 2; ++k) dst[m][k] = *(const PG8_LAS bf16x8*)(lds + PG8_SA(b, h) + aoff + m * 2048 + k * 1024); } while (0)
#define PG8_LDB(dst, b, h) do { _Pragma("unroll") for (int n = 0; n < 2; ++n) _Pragma("unroll") for (int k = 0; k < 2; ++k) dst[n][k] = *(const PG8_LAS bf16x8*)(lds + PG8_SB(b, h) + boff + n * 2048 + k * 1024); } while (0)
#define PG8_MMA(ai, bj, At, Bt) do { __builtin_amdgcn_s_setprio(1); _Pragma("unroll") for (int m = 0; m < 4; ++m) _Pragma("unroll") for (int n = 0; n < 2; ++n) _Pragma("unroll") for (int k = 0; k < 2; ++k) \
        acc[ai][bj][m][n] = __builtin_amdgcn_mfma_f32_16x16x32_bf16(Bt[n][k], At[m][k], acc[ai][bj][m][n], 0, 0, 0); __builtin_amdgcn_s_setprio(0); } while (0)
#define PG8_WAIT_V(n) asm volatile("s_waitcnt vmcnt(" #n ")" ::: "memory")
#define PG8_WAIT_L(n) asm volatile("s_waitcnt lgkmcnt(" #n ")" ::: "memory")
#define PG8_BAR __builtin_amdgcn_s_barrier()
#define PG8_SCHED __builtin_amdgcn_sched_barrier(0)
    Unit cur, nxt; int ui = 0;
    if (!S.next(0, cur)) return;
    f32x4 acc[2][2][4][2];
#pragma unroll
    for (int a = 0; a < 2; ++a)
#pragma unroll
        for (int b = 0; b < 2; ++b)
#pragma unroll
            for (int m = 0; m < 4; ++m)
#pragma unroll
                for (int n = 0; n < 2; ++n) acc[a][b][m][n] = (f32x4){0.f, 0.f, 0.f, 0.f};
    bf16x8 At[4][2], B0[2][2], B1[2][2];
    const char* cA = (const char*)g.A + (size_t)g.rowbase(cur.pm) * K * 2; const char* cB = (const char*)g.Bt + (size_t)cur.pn * tstep;
    S.a_ready(cur);
    if constexpr (SP2) {
        PG8_STAGE(PG8_SB(0, 0), cB, voffB); PG8_STAGE(PG8_SB(0, 1), cB + hstep, voffB); PG8_STAGE(PG8_SA(0, 0), cA, voffA); PG8_STAGE(PG8_SA(0, 1), cA + hstep, voffA);
        if (wr == 1) PG8_BAR;
        PG8_WAIT_V(2); PG8_BAR;
        PG8_STAGE(PG8_SB(1, 0), cB + kstep, voffB); PG8_STAGE(PG8_SA(1, 0), cA + kstep, voffA); PG8_STAGE(PG8_SB(1, 1), cB + hstep + kstep, voffB);
        PG8_WAIT_V(6); PG8_BAR;
    } else {
        PG8_STAGE(PG8_SB(0, 0), cB, voffB); PG8_STAGE(PG8_SA(0, 0), cA, voffA); PG8_STAGE(PG8_SB(0, 1), cB + hstep, voffB); PG8_STAGE(PG8_SA(0, 1), cA + hstep, voffA);
        if (wr == 1) PG8_BAR;
        PG8_WAIT_V(4); PG8_BAR;
        PG8_STAGE(PG8_SB(1, 0), cB + kstep, voffB); PG8_STAGE(PG8_SA(1, 0), cA + kstep, voffA); PG8_STAGE(PG8_SB(1, 1), cB + hstep + kstep, voffB);
        PG8_WAIT_V(6); PG8_BAR;
    }
    for (;;) {
        const bool has_next = S.next(ui + 1, nxt);
        const char* nA = has_next ? (const char*)g.A + (size_t)g.rowbase(nxt.pm) * K * 2 : cA; const char* nB = has_next ? (const char*)g.Bt + (size_t)nxt.pn * tstep : cB;
        for (int t = 0; t < nt; t += 2) {
            const bool last = (t == nt - 2);
            const char* a1 = cA + (size_t)(t + 1) * kstep;
            const char* a2 = last ? nA : cA + (size_t)(t + 2) * kstep; const char* b2 = last ? nB : cB + (size_t)(t + 2) * kstep;
            const char* a3 = a2 + kstep; const char* b3 = b2 + kstep;
            if (last && has_next) S.a_ready(nxt);
            if constexpr (SP2) {
            PG8_LDB(B0, 0, 0); PG8_LDB(B1, 0, 1); PG8_SCHED; PG8_LDA(At, 0, 0); PG8_STAGE(PG8_SA(1, 1), a1 + hstep, voffA);
            PG8_WAIT_V(8); PG8_WAIT_L(0); PG8_BAR; PG8_MMA(0, 0, At, B0); PG8_MMA(0, 1, At, B1); PG8_BAR; PG8_SCHED;
            PG8_LDA(At, 0, 1); PG8_STAGE(PG8_SB(0, 0), b2, voffB); PG8_STAGE(PG8_SB(0, 1), b2 + hstep, voffB); PG8_STAGE(PG8_SA(0, 0), a2, voffA);
            PG8_WAIT_V(8); PG8_WAIT_L(0); PG8_BAR; PG8_MMA(1, 0, At, B0); PG8_MMA(1, 1, At, B1); PG8_BAR; PG8_SCHED;
            PG8_LDB(B0, 1, 0); PG8_LDB(B1, 1, 1); PG8_SCHED; PG8_LDA(At, 1, 0); PG8_STAGE(PG8_SA(0, 1), a2 + hstep, voffA);
            PG8_WAIT_V(8); PG8_WAIT_L(0); PG8_BAR; PG8_MMA(0, 0, At, B0); PG8_MMA(0, 1, At, B1); PG8_BAR; PG8_SCHED;
            PG8_LDA(At, 1, 1); PG8_STAGE(PG8_SB(1, 0), b3, voffB); PG8_STAGE(PG8_SB(1, 1), b3 + hstep, voffB); PG8_STAGE(PG8_SA(1, 0), a3, voffA);
            PG8_WAIT_V(8); PG8_WAIT_L(0); PG8_BAR; PG8_MMA(1, 0, At, B0); PG8_MMA(1, 1, At, B1); PG8_BAR; PG8_SCHED;
            } else {
            PG8_LDB(B0, 0, 0); PG8_SCHED; PG8_LDA(At, 0, 0); PG8_STAGE(PG8_SA(1, 1), a1 + hstep, voffA);
            PG8_WAIT_L(8); PG8_BAR; PG8_WAIT_L(0); PG8_MMA(0, 0, At, B0); PG8_BAR; PG8_SCHED;
            PG8_LDB(B1, 0, 1); PG8_STAGE(PG8_SB(0, 0), b2, voffB);
            PG8_BAR; PG8_WAIT_L(0); PG8_MMA(0, 1, At, B1); PG8_BAR;
            PG8_LDA(At, 0, 1); PG8_STAGE(PG8_SA(0, 0), a2, voffA);
            PG8_BAR; PG8_WAIT_L(0); PG8_MMA(1, 0, At, B0); PG8_BAR; PG8_SCHED;
            PG8_STAGE(PG8_SB(0, 1), b2 + hstep, voffB);
            PG8_WAIT_V(6); PG8_BAR; PG8_MMA(1, 1, At, B1); PG8_BAR;
            PG8_LDB(B0, 1, 0); PG8_SCHED; PG8_LDA(At, 1, 0); PG8_STAGE(PG8_SA(0, 1), a2 + hstep, voffA);
            PG8_WAIT_L(8); PG8_BAR; PG8_WAIT_L(0); PG8_MMA(0, 0, At, B0); PG8_BAR; PG8_SCHED;
            PG8_LDB(B1, 1, 1); PG8_STAGE(PG8_SB(1, 0), b3, voffB);
            PG8_BAR; PG8_WAIT_L(0); PG8_MMA(0, 1, At, B1); PG8_BAR;
            PG8_LDA(At, 1, 1); PG8_STAGE(PG8_SA(1, 0), a3, voffA);
            PG8_BAR; PG8_WAIT_L(0); PG8_MMA(1, 0, At, B0); PG8_BAR; PG8_SCHED;
            PG8_STAGE(PG8_SB(1, 1), b3 + hstep, voffB);
            PG8_WAIT_V(6); PG8_BAR; PG8_MMA(1, 1, At, B1); PG8_BAR;
            }
        }
        if constexpr (ALIGN_EPI) { if (wr == 0) PG8_BAR; }
        if constexpr (!Epi::AFTER_DRAIN) { E(acc, cur, wr, wc, fr, fq); S.done(cur); }
        if (!has_next) break;
#pragma unroll
        for (int a = 0; a < 2; ++a)
#pragma unroll
            for (int b = 0; b < 2; ++b)
#pragma unroll
                for (int m = 0; m < 4; ++m)
#pragma unroll
                    for (int n = 0; n < 2; ++n) acc[a][b][m][n] = (f32x4){0.f, 0.f, 0.f, 0.f};
        cur = nxt; cA = nA; cB = nB; ++ui;
        if constexpr (ALIGN_EPI) { if (wr == 1) PG8_BAR; }
    }
    PG8_WAIT_V(0);
    if constexpr (!ALIGN_EPI) { if (wr == 0) PG8_BAR; }
    PG8_BAR;
    if constexpr (Epi::AFTER_DRAIN) { E.fused(acc, cur, wr, wc, fr, fq, lds, wid, lane); S.done(cur); }
#undef PG8_SA
#undef PG8_SB
#undef PG8_STAGE
#undef PG8_LDA
#undef PG8_LDB
#undef PG8_MMA
#undef PG8_WAIT_V
#undef PG8_WAIT_L
#undef PG8_BAR
#undef PG8_SCHED
}
}

#define GAS __attribute__((address_space(1)))
#define LAS __attribute__((address_space(3)))
typedef unsigned short bf16;
typedef unsigned v4u __attribute__((ext_vector_type(4)));
typedef unsigned v2u __attribute__((ext_vector_type(2)));
typedef float f32x4 __attribute__((ext_vector_type(4)));
typedef float f32x16 __attribute__((ext_vector_type(16)));
typedef short bf16x8 __attribute__((ext_vector_type(8)));
typedef short s16x4 __attribute__((ext_vector_type(4)));
typedef GAS unsigned gu32;
#define RLX_AGENT __ATOMIC_RELAXED, __HIP_MEMORY_SCOPE_AGENT
#define LDS_WAIT() asm volatile("s_waitcnt lgkmcnt(0)" ::: "memory")
#define VM_WAIT() asm volatile("s_waitcnt vmcnt(0)" ::: "memory")
typedef float f32x2_t __attribute__((ext_vector_type(2))); typedef __bf16 bf16x2_t __attribute__((ext_vector_type(2)));
__device__ __forceinline__ unsigned pk2(float lo, float hi) { f32x2_t v = {lo, hi}; bf16x2_t b = __builtin_convertvector(v, bf16x2_t); return __builtin_bit_cast(unsigned, b); }
__device__ __forceinline__ bf16 f2bf(float f) { return (bf16)(pk2(f, 0.f) & 0xffffu); }
__device__ __forceinline__ float bf2f(bf16 v) { return __uint_as_float((unsigned)v << 16); }
__device__ __forceinline__ float bflo(unsigned w) { return __uint_as_float(w << 16); }
__device__ __forceinline__ float bfhi(unsigned w) { return __uint_as_float(w & 0xffff0000u); }

#define XB_TMO      128
#define XB_XCNT(j)  (256  + 64 * (j))
#define XB_XSUB(j)  (1280 + 64 * (j))
#define XB_XGEN(j)  (2304 + 64 * (j))
#define XB_TOP      3328
#define XB_TOPGEN   3392
#define XCD_BAR_WORDS 3456
#define XB_SPIN_CAP (1u << 18)
__device__ __forceinline__ unsigned xb_ld(unsigned* p)              { return __hip_atomic_load(p, __ATOMIC_RELAXED, __HIP_MEMORY_SCOPE_AGENT); }
__device__ __forceinline__ unsigned xb_add(unsigned* p, unsigned v) { return __hip_atomic_fetch_add(p, v, __ATOMIC_RELAXED, __HIP_MEMORY_SCOPE_AGENT); }
__device__ __forceinline__ unsigned xb_xcc_id() { return (unsigned)__builtin_amdgcn_s_getreg((3 << 11) | 20) & 0xFu; }
#define XB_SPIN(cond, bar) do { unsigned _sp = 0; while (cond) { __builtin_amdgcn_s_sleep(1); \
    if ((++_sp & 255u) == 0u) { if (xb_ld(&(bar)[XB_TMO])) break; if (_sp > XB_SPIN_CAP) { atomicAdd(&(bar)[XB_TMO], 1u); break; } } } } while (0)
struct XcdBarrier { unsigned* bar; unsigned x; volatile LAS unsigned* st; };
__device__ __forceinline__ XcdBarrier xcd_barrier_post(unsigned* bar, volatile LAS unsigned* st) {
    XcdBarrier b; b.bar = bar; b.x = xb_xcc_id(); b.st = st;
    if (threadIdx.x == 0) (void)xb_add(&bar[XB_XCNT(b.x)], 1u);
    return b;
}
__device__ __forceinline__ void xcd_barrier_complete(unsigned* bar, unsigned x, unsigned& nloc, unsigned& nx) {
    const unsigned G = gridDim.x * gridDim.y * gridDim.z;
    unsigned sum, cnt, mine, sp = 0u;
    for (;;) {
        sum = 0u; cnt = 0u; mine = 0u;
#pragma unroll
        for (unsigned j = 0; j < 16; ++j) { const unsigned c = xb_ld(&bar[XB_XCNT(j)]); sum += c; cnt += (c > 0u) ? 1u : 0u; mine = (j == x) ? c : mine; }
        if (sum == G) break;
        __builtin_amdgcn_s_sleep(1);
        if ((++sp & 255u) == 0u) { if (xb_ld(&bar[XB_TMO])) break; if (sp > XB_SPIN_CAP) { atomicAdd(&bar[XB_TMO], 1u); break; } }
    }
    nloc = mine > 0u ? mine : 1u; nx = cnt > 0u ? cnt : 1u;
}
__device__ __forceinline__ void xcd_barrier(const XcdBarrier& b) {
    asm volatile("s_waitcnt vmcnt(0)" ::: "memory");
    __syncthreads();
    if (threadIdx.x == 0) {
        unsigned* bar = b.bar;
        __builtin_amdgcn_s_waitcnt(0);
        unsigned nloc = b.st[0], nx = b.st[1];
        if (nloc == 0u) { xcd_barrier_complete(bar, b.x, nloc, nx); b.st[0] = nloc; b.st[1] = nx; }
        const unsigned old = xb_add(&bar[XB_XSUB(b.x)], 1u);
        const unsigned gen = old / nloc;
        if (old + 1u == (gen + 1u) * nloc) {
            __builtin_amdgcn_fence(__ATOMIC_RELEASE, "agent");
            asm volatile("s_waitcnt vmcnt(0)" ::: "memory");
            const unsigned og = xb_add(&bar[XB_TOP], 1u);
            const unsigned tg = og / nx;
            if (og + 1u == (tg + 1u) * nx) xb_add(&bar[XB_TOPGEN], 1u);
            else XB_SPIN(xb_ld(&bar[XB_TOPGEN]) == tg, bar);
            __builtin_amdgcn_fence(__ATOMIC_ACQUIRE, "agent");
            xb_add(&bar[XB_XGEN(b.x)], 1u);
            asm volatile("s_waitcnt vmcnt(0)" ::: "memory");
        } else {
            XB_SPIN(xb_ld(&bar[XB_XGEN(b.x)]) == gen, bar);
            __builtin_amdgcn_fence(__ATOMIC_ACQUIRE, "agent");
            asm volatile("s_waitcnt vmcnt(0)" ::: "memory");
        }
    }
    __syncthreads();
}

constexpr int DM = 1024, NB = 8, SEQ = 2048, NMETA = 16, TT = SEQ + NMETA;
constexpr int DB = 128, PAST = 8192, PAGE = 128, NPAGES = 64;
constexpr int NH = 8, HP = 64, SSDW = 512, NG = 2, DS = 64, CONVD = 768;
constexpr int QKD = 96, VD = 64, MLAW = 512, QL = 384, KVL = 256, DFF = 2816, INC = 1960;
constexpr int RP = NB * TT, R = RP + DB;
constexpr int MMAIN = NB * SEQ;
constexpr int NS = NMETA + DB;
constexpr float EPS = 1e-6f, ATTN_SCALE = 0.10206207261596577f, LOG2E = 1.4426950408889634f;
constexpr int PJ = 2048, C_Z = 0, C_XBC = 512, C_CKV = 1280, C_CQ = 1536, C_DT = 1920, C_KR = 1928;
constexpr int S_Z = 0, S_XBC = 512, S_DT = 1280, S_CQ = 1288, S_CKV = 1672, S_KR = 1928;
constexpr int TPAD = 2112;
constexpr int NCH = 33, CHL = 64, TOFF = 48;
constexpr size_t OUT_YP = 0, OUT_YS = 16777216, OUT_LATP = 16908288, OUT_KRP = 21135360, OUT_CONVP = 21663744,
                 OUT_SSMP = 21682176, OUT_LATS = 21944320, OUT_KRS = 21977088, OUT_CONVS = 21981184, OUT_SSMS = 22276096;

constexpr size_t MiB = 1u << 20;
constexpr size_t WS_CTL = 0, CTL_ZERO_BYTES = 1 * MiB;
constexpr int CW_BAR = 4096;
constexpr size_t WS_SS = 512 * 1024;
constexpr size_t WS_WIN = 2 * MiB;
constexpr size_t WS_WUQ = 6 * MiB;
constexpr size_t WS_WUKV = 7 * MiB;
constexpr size_t WS_WOUT = 8 * MiB;
constexpr size_t WS_WGU = 10 * MiB;
constexpr size_t WS_WDN = 22 * MiB;
constexpr size_t WS_XN = 32 * MiB;
constexpr size_t WS_PROJ = 66 * MiB;
constexpr size_t WS_DTRAW = 132 * MiB;
constexpr size_t WS_DT = 133 * MiB;
constexpr size_t WS_LAT = 134 * MiB;
constexpr size_t WS_CQN = 143 * MiB;
constexpr size_t WS_KRF = 156 * MiB;
constexpr size_t WS_XST = 159 * MiB;
constexpr size_t WS_BT = 176 * MiB;
constexpr size_t WS_BC = 181 * MiB;
constexpr size_t WS_XAS = 190 * MiB;
constexpr size_t WS_QRAW = 191 * MiB;
constexpr size_t WS_KVRAW = 216 * MiB;
constexpr size_t WS_Q = 249 * MiB;
constexpr size_t WS_K = 274 * MiB;
constexpr size_t WS_VT = 299 * MiB;
constexpr size_t WS_STATES = 316 * MiB;
constexpr size_t WS_DECAY = 350 * MiB;
constexpr size_t WS_HIN = 351 * MiB;
constexpr size_t WS_MIX = 368 * MiB;
constexpr size_t WS_ACT = 401 * MiB;
constexpr size_t WS_VS = 491 * MiB;
constexpr size_t WS_DPART = 492 * MiB;
constexpr size_t WS_HS = 494 * MiB;
constexpr size_t WS_ROPE = 496 * MiB;
constexpr size_t WS_SSP = 520 * MiB;
constexpr size_t WS_OPT_END = 522 * MiB;
constexpr size_t WS_NAIVE = 2048 * MiB;
constexpr size_t WS_DIAG = 1 * MiB;

constexpr int RING_OFF = 0, RING_BYTES = 131072;
constexpr int LDSCTL_OFF = RING_BYTES, MISC_OFF = LDSCTL_OFF + 320;
constexpr int LDS_BYTES = 147456;
constexpr int NWAVES = 8, NTHR = 512;

struct Args { const void* in[30]; float* out; unsigned char* ws; int ph_lo, ph_hi, li, pad; };

struct Frame {
    LAS unsigned char* lds;
    int tid, lane, wave, G, vcu, gw, NGW;
    unsigned char* ws; float* out;
    const void* const* in;
};
__device__ __forceinline__ float wave_sum(float v) {
#pragma unroll
    for (int o = 1; o < 64; o <<= 1) v += __shfl_xor(v, o);
    return v;
}
__device__ __forceinline__ float wave_max(float v) {
#pragma unroll
    for (int o = 1; o < 64; o <<= 1) v = fmaxf(v, __shfl_xor(v, o));
    return v;
}
__device__ __forceinline__ float silu_f(float x) { return x / (1.f + __expf(-x)); }
__device__ __forceinline__ float softplus_f(float x) { return fmaxf(x, 0.f) + log1pf(expf(-fabsf(x))); }
__device__ __forceinline__ float rope_inv(int j) { return exp2f(-(float)j * (13.287712379549449f / 16.0f)); }
struct EpiProj {
    static constexpr bool PERM = true, AFTER_DRAIN = false;
    bf16* O; float* dtraw; int rmode;
    __device__ __forceinline__ void operator()(const pg8::f32x4 (&acc)[2][2][4][2], const pg8::Unit& u, int wr, int wc, int fr, int fq) const {
        const int rb = rmode ? (u.pm >> 3) * 2064 + 16 + (u.pm & 7) * 256 : u.pm * 256;
        const int row0 = rb + wr * 64 + fr, col0 = u.pn * 256 + wc * 32 + 8 * fq;
#pragma unroll
        for (int ai = 0; ai < 2; ++ai)
#pragma unroll
            for (int m = 0; m < 4; ++m) { const int row = row0 + ai * 128 + m * 16; bf16* rowp = O + (size_t)row * PJ + col0;
#pragma unroll
                for (int bj = 0; bj < 2; ++bj) { const pg8::f32x4 v0 = acc[ai][bj][m][0], v1 = acc[ai][bj][m][1];
                    v4u w; w.x = pk2(v0[0], v0[1]); w.y = pk2(v0[2], v0[3]); w.z = pk2(v1[0], v1[1]); w.w = pk2(v1[2], v1[3]);
                    *(v4u*)(rowp + bj * 128) = w; }
                if (u.pn == 7 && wc == 0 && fq == 0) { *(pg8::f32x4*)(dtraw + (size_t)row * 8) = acc[ai][1][m][0]; *(pg8::f32x4*)(dtraw + (size_t)row * 8 + 4) = acc[ai][1][m][1]; } }
    }
};
struct EpiBf16 {
    static constexpr bool PERM = true, AFTER_DRAIN = false;
    bf16* O; int ldc; int rmode;
    __device__ __forceinline__ void operator()(const pg8::f32x4 (&acc)[2][2][4][2], const pg8::Unit& u, int wr, int wc, int fr, int fq) const {
        const int rb = rmode ? (u.pm >> 3) * 2064 + 16 + (u.pm & 7) * 256 : u.pm * 256;
        const int row0 = rb + wr * 64 + fr, col0 = u.pn * 256 + wc * 32 + 8 * fq;
#pragma unroll
        for (int ai = 0; ai < 2; ++ai)
#pragma unroll
            for (int m = 0; m < 4; ++m) { bf16* rowp = O + (size_t)(row0 + ai * 128 + m * 16) * ldc + col0;
#pragma unroll
                for (int bj = 0; bj < 2; ++bj) { const pg8::f32x4 v0 = acc[ai][bj][m][0], v1 = acc[ai][bj][m][1];
                    v4u w; w.x = pk2(v0[0], v0[1]); w.y = pk2(v0[2], v0[3]); w.z = pk2(v1[0], v1[1]); w.w = pk2(v1[2], v1[3]);
                    *(v4u*)(rowp + bj * 128) = w; } }
    }
};
struct EpiResF32 {
    static constexpr bool PERM = false, AFTER_DRAIN = false;
    const float* res; float* out;
    __device__ __forceinline__ void operator()(const pg8::f32x4 (&acc)[2][2][4][2], const pg8::Unit& u, int wr, int wc, int fr, int fq) const {
        const int row0 = u.pm * 256 + wr * 64 + fr, col0 = u.pn * 256 + wc * 32 + 4 * fq;
#pragma unroll
        for (int ai = 0; ai < 2; ++ai)
#pragma unroll
            for (int m = 0; m < 4; ++m) { const size_t off = (size_t)(row0 + ai * 128 + m * 16) * DM + col0;
#pragma unroll
                for (int bj = 0; bj < 2; ++bj)
#pragma unroll
                    for (int n = 0; n < 2; ++n) { const pg8::f32x4 r = *(const pg8::f32x4*)(res + off + bj * 128 + n * 16); *(pg8::f32x4*)(out + off + bj * 128 + n * 16) = r + acc[ai][bj][m][n]; } }
    }
};
struct EpiOutProj {
    static constexpr bool PERM = false, AFTER_DRAIN = false;
    const float* res; float* out; bf16* HB; float* SS;
    __device__ __forceinline__ void operator()(const pg8::f32x4 (&acc)[2][2][4][2], const pg8::Unit& u, int wr, int wc, int fr, int fq) const {
        const int rb = (u.pm >> 3) * 2064 + 16 + (u.pm & 7) * 256;
        const int row0 = u.pm * 256 + wr * 64 + fr, col0 = u.pn * 256 + wc * 32 + 4 * fq;
#pragma unroll
        for (int ai = 0; ai < 2; ++ai)
#pragma unroll
            for (int m = 0; m < 4; ++m) { const int orow = row0 + ai * 128 + m * 16; const size_t off = (size_t)orow * DM + col0; bf16* hb = HB + (size_t)(rb + wr * 64 + fr + ai * 128 + m * 16) * DM + col0; float ss = 0.f;
#pragma unroll
                for (int bj = 0; bj < 2; ++bj)
#pragma unroll
                    for (int n = 0; n < 2; ++n) { const pg8::f32x4 v = *(const pg8::f32x4*)(res + off + bj * 128 + n * 16) + acc[ai][bj][m][n];
                        ss += (v[0] * v[0] + v[1] * v[1]) + (v[2] * v[2] + v[3] * v[3]); v2u w; w.x = pk2(v[0], v[1]); w.y = pk2(v[2], v[3]); *(v2u*)(hb + bj * 128 + n * 16) = w; }
                ss += __shfl_xor(ss, 16); ss += __shfl_xor(ss, 32);
                if (fq == 0) SS[(size_t)orow * 16 + u.pn * 4 + wc] = ss; }
    }
};
struct EpiDown {
    static constexpr bool PERM = false, AFTER_DRAIN = false;
    const bf16* HB; float* out;
    __device__ __forceinline__ void operator()(const pg8::f32x4 (&acc)[2][2][4][2], const pg8::Unit& u, int wr, int wc, int fr, int fq) const {
        const int rb = (u.pm >> 3) * 2064 + 16 + (u.pm & 7) * 256;
        const int row0 = u.pm * 256 + wr * 64 + fr, col0 = u.pn * 256 + wc * 32 + 4 * fq;
#pragma unroll
        for (int ai = 0; ai < 2; ++ai)
#pragma unroll
            for (int m = 0; m < 4; ++m) { const size_t off = (size_t)(row0 + ai * 128 + m * 16) * DM + col0; const bf16* hb = HB + (size_t)(rb + wr * 64 + fr + ai * 128 + m * 16) * DM + col0;
#pragma unroll
                for (int bj = 0; bj < 2; ++bj)
#pragma unroll
                    for (int n = 0; n < 2; ++n) { const v2u w = *(const v2u*)(hb + bj * 128 + n * 16); const pg8::f32x4 r = {bflo(w.x), bfhi(w.x), bflo(w.y), bfhi(w.y)}; *(pg8::f32x4*)(out + off + bj * 128 + n * 16) = r + acc[ai][bj][m][n]; } }
    }
};
struct EpiSwiGLU {
    static constexpr bool PERM = true, AFTER_DRAIN = false;
    bf16* O; const float* SS;
    __device__ __forceinline__ void operator()(const pg8::f32x4 (&acc)[2][2][4][2], const pg8::Unit& u, int wr, int wc, int fr, int fq) const {
        const int rb = (u.pm >> 3) * 2064 + 16 + (u.pm & 7) * 256;
        const int row0 = rb + wr * 64 + fr, col0 = u.pn * 128 + wc * 32 + 8 * fq, orow0 = u.pm * 256 + wr * 64 + fr;
#pragma unroll
        for (int ai = 0; ai < 2; ++ai)
#pragma unroll
            for (int m = 0; m < 4; ++m) { float a[8]; const pg8::f32x4* sp = (const pg8::f32x4*)(SS + (size_t)(orow0 + ai * 128 + m * 16) * 16); const pg8::f32x4 s4 = (sp[0] + sp[1]) + (sp[2] + sp[3]);
                const float rs = 1.0f / sqrtf(((s4[0] + s4[1]) + (s4[2] + s4[3])) * (1.f / DM) + EPS);
#pragma unroll
                for (int n = 0; n < 2; ++n)
#pragma unroll
                    for (int e = 0; e < 4; ++e) a[4 * n + e] = silu_f(rs * acc[ai][0][m][n][e]) * (rs * acc[ai][1][m][n][e]);
                v4u w; w.x = pk2(a[0], a[1]); w.y = pk2(a[2], a[3]); w.z = pk2(a[4], a[5]); w.w = pk2(a[6], a[7]);
                *(v4u*)(O + (size_t)(row0 + ai * 128 + m * 16) * DFF + col0) = w; }
    }
};

template <class ARow, class Epi>
__device__ __forceinline__ void small_gemm(const bf16* A, int lda, const bf16* Bt, int K, int nrt, int nct, const ARow& arow, const Epi& E, int gw, int NGW, int lane) {
    const int ntask = nrt * nct;
    for (int task = gw; task < ntask; task += NGW) {
        const int rt = task % nrt, ct = task / nrt;
        const bf16* ap = A + (size_t)arow(rt * 16 + (lane & 15)) * lda + 8 * (lane >> 4);
        const bf16* bp = Bt + (size_t)(ct * 16 + (lane & 15)) * K + 8 * (lane >> 4);
        f32x4 acc = {0.f, 0.f, 0.f, 0.f};
#pragma unroll 8
        for (int k0 = 0; k0 < K; k0 += 32) {
            const bf16x8 a = *(const bf16x8*)(ap + k0), b = *(const bf16x8*)(bp + k0);
            acc = __builtin_amdgcn_mfma_f32_16x16x32_bf16(a, b, acc, 0, 0, 0);
        }
        E(acc, rt, ct, lane);
    }
}

template <class RM>
__device__ __forceinline__ void transpose_item(const float* W, int N, int ldw, bf16* WT, int ldt, int item, LAS float* scr, int lane, const RM& rm, const float* kscale = nullptr) {
    const int nblk = (N + 31) / 32, kb = item / nblk, nb = item % nblk, k0 = 64 * kb, n0 = 32 * nb;
    { const int n = n0 + (lane & 31); float v[32];
#pragma unroll
      for (int i = 0; i < 32; ++i) { const int kk = 2 * i + (lane >> 5); v[i] = (n < N) ? W[(size_t)(k0 + kk) * ldw + n] : 0.f; }
#pragma unroll
      for (int i = 0; i < 32; ++i) { const int kk = 2 * i + (lane >> 5); float x = v[i]; if (kscale) x *= kscale[k0 + kk]; scr[kk * 33 + (lane & 31)] = x; } }
    LDS_WAIT(); asm volatile("" ::: "memory");
    const int c = lane & 7;
#pragma unroll
    for (int j = 0; j < 4; ++j) { const int n = (lane >> 3) + 8 * j; const LAS float* s = scr + (8 * c) * 33 + n;
        if (n0 + n < N) { v4u o; o.x = pk2(s[0 * 33], s[1 * 33]); o.y = pk2(s[2 * 33], s[3 * 33]); o.z = pk2(s[4 * 33], s[5 * 33]); o.w = pk2(s[6 * 33], s[7 * 33]);
            *(v4u*)(WT + (size_t)rm(n0 + n) * ldt + k0 + 8 * c) = o; } }
    LDS_WAIT(); asm volatile("" ::: "memory");
}
__device__ __forceinline__ int map_in(int n) {
    return n < S_DT ? n : n < S_CQ ? C_DT + (n - S_DT) : n < S_CKV ? C_CQ + (n - S_CQ) : n < S_KR ? C_CKV + (n - S_CKV) : n;
}
__device__ __forceinline__ void p0_prologue(Frame& F) {
    LAS float* scr = (LAS float*)(F.lds + RING_OFF + F.wave * 16384);
    const float* w_in = (const float*)F.in[9]; const float* w_uq = (const float*)F.in[17]; const float* w_ukv = (const float*)F.in[19]; const float* w_out = (const float*)F.in[25];
    const float* w_gate = (const float*)F.in[27]; const float* w_up = (const float*)F.in[28]; const float* w_down = (const float*)F.in[29];
    bf16* WIN = (bf16*)(F.ws + WS_WIN); bf16* WUQ = (bf16*)(F.ws + WS_WUQ); bf16* WUKV = (bf16*)(F.ws + WS_WUKV); bf16* WOUT = (bf16*)(F.ws + WS_WOUT); bf16* WGU = (bf16*)(F.ws + WS_WGU); bf16* WDN = (bf16*)(F.ws + WS_WDN);
    const float* ffg = (const float*)F.in[26];
    constexpr int I_IN = 16 * 62, I_UQ = 6 * 24, I_UKV = 4 * 32, I_OUT = 16 * 32, I_G = 16 * 88, I_DN = 44 * 32;
    constexpr int NITEMS = I_IN + I_UQ + I_UKV + I_OUT + 2 * I_G + I_DN;
    for (int it = F.gw; it < NITEMS; it += F.NGW) {
        int r = it;
        if (r < I_IN) { transpose_item(w_in, INC, INC, WIN, DM, r, scr, F.lane, [](int n) { return map_in(n); }); continue; } r -= I_IN;
        if (r < I_UQ) { transpose_item(w_uq, 768, 768, WUQ, QL, r, scr, F.lane, [](int n) { return n; }); continue; } r -= I_UQ;
        if (r < I_UKV) { transpose_item(w_ukv, 1024, 1024, WUKV, KVL, r, scr, F.lane, [](int n) { return n; }); continue; } r -= I_UKV;
        if (r < I_OUT) { transpose_item(w_out, DM, DM, WOUT, 1024, r, scr, F.lane, [](int n) { return n; }); continue; } r -= I_OUT;
        if (r < I_G) { transpose_item(w_gate, DFF, DFF, WGU, DM, r, scr, F.lane, [](int n) { return 256 * (n >> 7) + (n & 127); }, ffg); continue; } r -= I_G;
        if (r < I_G) { transpose_item(w_up, DFF, DFF, WGU, DM, r, scr, F.lane, [](int n) { return 256 * (n >> 7) + 128 + (n & 127); }, ffg); continue; } r -= I_G;
        transpose_item(w_down, DM, DM, WDN, DFF, r, scr, F.lane, [](int n) { return n; });
    }
    for (int i = F.gw * 64 + F.lane; i < 88 * 1024 / 8; i += F.NGW * 64) *(v4u*)(WIN + (size_t)1960 * 1024 + (size_t)i * 8) = (v4u){0u, 0u, 0u, 0u};
    const float* xp = (const float*)F.in[0]; const float* xs = (const float*)F.in[1]; const float* meta = (const float*)F.in[7]; const float* g = (const float*)F.in[8];
    bf16* XN = (bf16*)(F.ws + WS_XN);
    f32x4 gv[4];
#pragma unroll
    for (int j = 0; j < 4; ++j) gv[j] = ((const f32x4*)g)[F.lane + 64 * j];
    for (int r0 = 2 * F.gw; r0 < R; r0 += 2 * F.NGW) {
        f32x4 v[2][4];
#pragma unroll
        for (int i = 0; i < 2; ++i) { const int row = r0 + i; const float* src;
            if (row < RP) { const int b = row / TT, t = row % TT; src = (t < NMETA) ? meta + (size_t)t * DM : xp + ((size_t)b * SEQ + (t - NMETA)) * DM; } else src = xs + (size_t)(row - RP) * DM;
#pragma unroll
            for (int j = 0; j < 4; ++j) v[i][j] = ((const f32x4*)src)[F.lane + 64 * j]; }
#pragma unroll
        for (int i = 0; i < 2; ++i) { float s = 0.f;
#pragma unroll
            for (int j = 0; j < 4; ++j) s += (v[i][j].x * v[i][j].x + v[i][j].y * v[i][j].y) + (v[i][j].z * v[i][j].z + v[i][j].w * v[i][j].w);
            const float rs = 1.0f / sqrtf(wave_sum(s) * (1.f / DM) + EPS);
            v2u* o8 = (v2u*)(XN + (size_t)(r0 + i) * DM) + F.lane;
#pragma unroll
            for (int j = 0; j < 4; ++j) { v2u o; o.x = pk2(v[i][j].x * rs * gv[j].x, v[i][j].y * rs * gv[j].y); o.y = pk2(v[i][j].z * rs * gv[j].z, v[i][j].w * rs * gv[j].w); o8[64 * j] = o; } }
    }
    float* ROPE = (float*)(F.ws + WS_ROPE);
    for (int i = blockIdx.x * NTHR + F.tid; i < (TT + 1) * 16; i += F.G * NTHR) { const int p = i >> 4, j = i & 15; const float ang = (float)(p < TT ? p : PAST) * rope_inv(j); ROPE[2 * i] = cosf(ang); ROPE[2 * i + 1] = sinf(ang); }
}

__device__ __forceinline__ int small_arow(int r) { return r < NMETA ? r : RP + (r - NMETA); }
__device__ __forceinline__ void p1_inproj(Frame& F) {
    const bf16* XN = (const bf16*)(F.ws + WS_XN); const bf16* WIN = (const bf16*)(F.ws + WS_WIN); bf16* PROJ = (bf16*)(F.ws + WS_PROJ); float* DTRAW = (float*)(F.ws + WS_DTRAW);
    { pg8::Gemm g{XN, WIN, MMAIN, PJ, DM, 1}; pg8::StaticOrder S; S.init(MMAIN, PJ, F.G, (int)blockIdx.x);
      EpiProj E{PROJ, DTRAW, 1};
      pg8::gemm_phase<EpiProj, pg8::StaticOrder, true, true>(F.lds + RING_OFF, g, S, E); }
    auto epi = [&](const f32x4& acc, int rt, int ct, int lane) {
        const int col = ct * 16 + (lane & 15);
#pragma unroll
        for (int i = 0; i < 4; ++i) { const int r = rt * 16 + 4 * (lane >> 4) + i; const bf16 v = f2bf(acc[i]);
            if (r < NMETA) { for (int b = 0; b < NB; ++b) { PROJ[(size_t)(b * TT + r) * PJ + col] = v; if (col >= C_DT && col < C_DT + 8) DTRAW[(size_t)(b * TT + r) * 8 + (col - C_DT)] = acc[i]; } }
            else { const int row = RP + (r - NMETA); PROJ[(size_t)row * PJ + col] = v; if (col >= C_DT && col < C_DT + 8) DTRAW[(size_t)row * 8 + (col - C_DT)] = acc[i]; } }
    };
    small_gemm(XN, DM, WIN, DM, NS / 16, PJ / 16, [](int r) { return small_arow(r); }, epi, F.gw, F.NGW, F.lane);
}

constexpr int CV_LDS_STRIDE = 82;
__device__ __forceinline__ void p2_elementwise(Frame& F) {
    const bf16* PROJ = (const bf16*)(F.ws + WS_PROJ); const float* DTRAW = (const float*)(F.ws + WS_DTRAW); float* DT = (float*)(F.ws + WS_DT);
    bf16* LAT = (bf16*)(F.ws + WS_LAT); bf16* CQN = (bf16*)(F.ws + WS_CQN); float* KRF = (float*)(F.ws + WS_KRF);
    const float* kvg = (const float*)F.in[18]; const float* qng = (const float*)F.in[16]; const float* dtb = (const float*)F.in[12]; const float* ROPE = (const float*)(F.ws + WS_ROPE);
    for (int r0 = 4 * F.gw; r0 < R; r0 += 4 * F.NGW) {
        v2u wk[4]; unsigned wq[4][3]; unsigned short kr1[4], kr2[4]; float dtr[4]; f32x2_t cs[4];
#pragma unroll
        for (int i = 0; i < 4; ++i) { const int row = r0 + i; const bf16* pr = PROJ + (size_t)row * PJ;
            wk[i] = *(const v2u*)(pr + C_CKV + 4 * F.lane); const unsigned* p = (const unsigned*)(pr + C_CQ + 6 * F.lane); wq[i][0] = p[0]; wq[i][1] = p[1]; wq[i][2] = p[2];
            kr1[i] = pr[C_KR + (F.lane & 15)]; kr2[i] = pr[C_KR + 16 + (F.lane & 15)]; dtr[i] = DTRAW[(size_t)row * 8 + (F.lane & 7)];
            cs[i] = *(const f32x2_t*)(ROPE + 2 * ((row < RP ? row % TT : TT) * 16 + (F.lane & 15))); }
        const f32x4 gg = ((const f32x4*)kvg)[F.lane]; const float* gq = qng + 6 * F.lane; const float g0 = gq[0], g1 = gq[1], g2 = gq[2], g3 = gq[3], g4 = gq[4], g5 = gq[5]; const float dbias = dtb[F.lane & 7];
#pragma unroll
        for (int i = 0; i < 4; ++i) { const int row = r0 + i;
            { const float v0 = bflo(wk[i].x), v1 = bfhi(wk[i].x), v2 = bflo(wk[i].y), v3 = bfhi(wk[i].y);
              const float rs = 1.0f / sqrtf(wave_sum((v0 * v0 + v1 * v1) + (v2 * v2 + v3 * v3)) * (1.f / KVL) + EPS);
              const f32x4 o = {v0 * rs * gg.x, v1 * rs * gg.y, v2 * rs * gg.z, v3 * rs * gg.w};
              float* of = (row < RP) ? F.out + OUT_LATP + (size_t)row * KVL : F.out + OUT_LATS + (size_t)(row - RP) * KVL;
              ((f32x4*)of)[F.lane] = o; v2u ob; ob.x = pk2(o.x, o.y); ob.y = pk2(o.z, o.w); *(v2u*)(LAT + (size_t)row * KVL + 4 * F.lane) = ob; }
            { const float v0 = bflo(wq[i][0]), v1 = bfhi(wq[i][0]), v2 = bflo(wq[i][1]), v3 = bfhi(wq[i][1]), v4 = bflo(wq[i][2]), v5 = bfhi(wq[i][2]);
              const float rs = 1.0f / sqrtf(wave_sum((v0 * v0 + v1 * v1) + (v2 * v2 + v3 * v3) + (v4 * v4 + v5 * v5)) * (1.f / QL) + EPS);
              unsigned* o = (unsigned*)(CQN + (size_t)row * QL + 6 * F.lane);
              o[0] = pk2(v0 * rs * g0, v1 * rs * g1); o[1] = pk2(v2 * rs * g2, v3 * rs * g3); o[2] = pk2(v4 * rs * g4, v5 * rs * g5); }
            if (F.lane < 16) { const int j = F.lane; const float c = cs[i].x, s = cs[i].y;
              const float x1 = bf2f(kr1[i]), x2 = bf2f(kr2[i]); const float y1 = x1 * c - x2 * s, y2 = x1 * s + x2 * c;
              KRF[(size_t)row * 32 + j] = y1; KRF[(size_t)row * 32 + 16 + j] = y2;
              float* of = (row < RP) ? F.out + OUT_KRP + (size_t)row * 32 : F.out + OUT_KRS + (size_t)(row - RP) * 32; of[j] = y1; of[16 + j] = y2; }
            if (F.lane < 8) DT[(size_t)row * 8 + F.lane] = softplus_f(dtr[i] + dbias); }
    }
    const float* cw = (const float*)F.in[10]; const float* cb = (const float*)F.in[11];
    bf16* XST = (bf16*)(F.ws + WS_XST); bf16* BT = (bf16*)(F.ws + WS_BT); bf16* BC = (bf16*)(F.ws + WS_BC);
    LAS bf16* tile = (LAS bf16*)(F.lds + RING_OFF);
    for (int i = blockIdx.x * NTHR + F.tid; i < NB * 640 * 6; i += F.G * NTHR) { const int rowi = i / 6, pc = i % 6; const int bb = rowi / 640, cc = rowi % 640;
        bf16* dst = (cc < SSDW) ? XST + ((size_t)(bb * SSDW + cc)) * TPAD : BT + ((size_t)(bb * 128 + (cc - SSDW))) * TPAD; *(v4u*)(dst + pc * 8) = (v4u){0u, 0u, 0u, 0u}; }
    for (int u = blockIdx.x; u < NB * 32 * 3; u += F.G) {
        const int third = u % 3, tb = 1 + (u / 3) % 32, b = u / 96; const int t0 = tb * CHL - TOFF;
        {
            const int cl = 2 * (F.tid & 127), c = third * 256 + cl, tq = F.tid >> 7;
            const float w0a = cw[0 * CONVD + c], w1a = cw[1 * CONVD + c], w2a = cw[2 * CONVD + c], w3a = cw[3 * CONVD + c], ba = cb[c];
            const float w0b = cw[0 * CONVD + c + 1], w1b = cw[1 * CONVD + c + 1], w2b = cw[2 * CONVD + c + 1], w3b = cw[3 * CONVD + c + 1], bb = cb[c + 1];
            const bf16* base = PROJ + (size_t)b * TT * PJ + C_XBC + c;
#define CV_QUARTER(tfirst, lcol) do { float xa[19], xb[19]; \
                _Pragma("unroll") for (int k = 0; k < 19; ++k) { const int t = (tfirst) - 3 + k; xa[k] = 0.f; xb[k] = 0.f; if (t >= 0) { const unsigned w = *(const unsigned*)(base + (size_t)t * PJ); xa[k] = bflo(w); xb[k] = bfhi(w); } } \
                _Pragma("unroll") for (int k = 0; k < 16; ++k) { const int t = (tfirst) + k; \
                    const float ya = silu_f(ba + xa[k] * w0a + xa[k + 1] * w1a + xa[k + 2] * w2a + xa[k + 3] * w3a), yb = silu_f(bb + xb[k] * w0b + xb[k + 1] * w1b + xb[k + 2] * w2b + xb[k + 3] * w3b); \
                    const unsigned pk = pk2(ya, yb); \
                    tile[cl * CV_LDS_STRIDE + (lcol) + k] = (bf16)(pk & 0xffffu); tile[(cl + 1) * CV_LDS_STRIDE + (lcol) + k] = (bf16)(pk >> 16); \
                    if (third == 2) *(unsigned*)(BC + (size_t)(b * TT + t) * 256 + cl) = pk; } } while (0)
            CV_QUARTER(t0 + 16 * tq, 16 * tq);
            if (tb == 1 && tq == 0) CV_QUARTER(0, 64);
#undef CV_QUARTER
        }
        __syncthreads();
        { const int nrows = (third == 2) ? 128 : 256; const int npc = (tb == 1) ? 10 : 8;
          for (int i = F.tid; i < nrows * npc; i += NTHR) { const int cl = i / npc, pc = i % npc;
            const LAS unsigned* s = (const LAS unsigned*)(tile + cl * CV_LDS_STRIDE + pc * 8); v4u o; o.x = s[0]; o.y = s[1]; o.z = s[2]; o.w = s[3];
            bf16* dst = (third < 2) ? XST + ((size_t)(b * SSDW + third * 256 + cl)) * TPAD : BT + ((size_t)(b * 128 + cl)) * TPAD;
            *(v4u*)(dst + ((pc < 8) ? tb * CHL + pc * 8 : TOFF + (pc - 8) * 8)) = o; } }
        __syncthreads();
    }
    const float* sconv = (const float*)F.in[4]; float* XAS = (float*)(F.ws + WS_XAS);
    for (int i = blockIdx.x * NTHR + F.tid; i < DB * CONVD; i += F.G * NTHR) { const int b = i / CONVD, c = i % CONVD;
        const float xc = bf2f(PROJ[(size_t)(RP + b) * PJ + C_XBC + c]);
        const float s0 = sconv[(size_t)(b * 3 + 0) * CONVD + c], s1 = sconv[(size_t)(b * 3 + 1) * CONVD + c], s2 = sconv[(size_t)(b * 3 + 2) * CONVD + c];
        XAS[i] = silu_f(cb[c] + s0 * cw[c] + s1 * cw[CONVD + c] + s2 * cw[2 * CONVD + c] + xc * cw[3 * CONVD + c]);
        float* oc = F.out + OUT_CONVS + (size_t)b * 3 * CONVD + c; oc[0] = s1; oc[CONVD] = s2; oc[2 * CONVD] = xc; }
    for (int i = blockIdx.x * NTHR + F.tid; i < NB * 3 * CONVD; i += F.G * NTHR) { const int b = i / (3 * CONVD), k = (i / CONVD) % 3, c = i % CONVD;
        F.out[OUT_CONVP + i] = bf2f(PROJ[(size_t)(b * TT + TT - 3 + k) * PJ + C_XBC + c]); }
}
#define MFMA32(a, b, c) __builtin_amdgcn_mfma_f32_32x32x16_bf16((a), (b), (c), 0, 0, 0)
#define MFMA16(a, b, c) __builtin_amdgcn_mfma_f32_16x16x32_bf16((a), (b), (c), 0, 0, 0)
__device__ __forceinline__ int crow(int reg, int hi) { return (reg & 3) + 8 * (reg >> 2) + 4 * hi; }
__device__ __forceinline__ bf16x8 pack8(const f32x16& x, int s) {
    v4u p; p.x = pk2(x[8 * s + 0], x[8 * s + 1]); p.y = pk2(x[8 * s + 2], x[8 * s + 3]); p.z = pk2(x[8 * s + 4], x[8 * s + 5]); p.w = pk2(x[8 * s + 6], x[8 * s + 7]);
    return __builtin_bit_cast(bf16x8, p);
}
__device__ __forceinline__ bf16x8 ld2x8(const bf16* p0, const bf16* p1) {
    const v2u a = *(const v2u*)p0, b = *(const v2u*)p1; v4u r; r.x = a.x; r.y = a.y; r.z = b.x; r.w = b.y; return __builtin_bit_cast(bf16x8, r);
}
__device__ __forceinline__ float softmax_ref(Frame& F) {
    const float* gqn = (const float*)F.in[20]; const float* gqr = (const float*)F.in[21]; const float* gkn = (const float*)F.in[22]; const float* gkr = (const float*)F.in[23];
    float a = fabsf(gqn[F.lane]), b = fabsf(gkn[F.lane]);
    if (F.lane < 16) { a = fmaxf(a, fabsf(gqr[F.lane])); b = fmaxf(b, fabsf(gkr[F.lane])); }
    return LOG2E * 9.797958971132712f * wave_max(a) * wave_max(b) * 1.0001f;
}
constexpr size_t WS_YS = 495 * MiB;
constexpr size_t WS_KS = 498 * MiB;
constexpr int NKT = 65;

__device__ __forceinline__ void p3_upproj_states(Frame& F) {
    const bf16* CQN = (const bf16*)(F.ws + WS_CQN); const bf16* LAT = (const bf16*)(F.ws + WS_LAT); const bf16* WUQ = (const bf16*)(F.ws + WS_WUQ); const bf16* WUKV = (const bf16*)(F.ws + WS_WUKV);
    bf16* QRAW = (bf16*)(F.ws + WS_QRAW); bf16* KVRAW = (bf16*)(F.ws + WS_KVRAW);
    { pg8::Gemm g{CQN, WUQ, MMAIN, 768, QL, 1}; pg8::StaticOrder S; S.init(MMAIN, 768, F.G, (int)blockIdx.x); EpiBf16 E{QRAW, 768, 1};
      pg8::gemm_phase<EpiBf16, pg8::StaticOrder, true, true>(F.lds + RING_OFF, g, S, E); }
    { pg8::Gemm g{LAT, WUKV, MMAIN, 1024, KVL, 1}; pg8::StaticOrder S; S.init(MMAIN, 1024, F.G, (int)blockIdx.x); EpiBf16 E{KVRAW, 1024, 1};
      pg8::gemm_phase<EpiBf16, pg8::StaticOrder, true, true>(F.lds + RING_OFF, g, S, E); }
    small_gemm(CQN, QL, WUQ, QL, DB / 16, 768 / 16, [](int r) { return RP + r; },
        [&](const f32x4& acc, int rt, int ct, int lane) { const int col = ct * 16 + (lane & 15);
#pragma unroll
            for (int i = 0; i < 4; ++i) QRAW[(size_t)(RP + rt * 16 + 4 * (lane >> 4) + i) * 768 + col] = f2bf(acc[i]); }, F.gw, F.NGW, F.lane);
    small_gemm(LAT, KVL, WUKV, KVL, NS / 16, 1024 / 16, [](int r) { return small_arow(r); },
        [&](const f32x4& acc, int rt, int ct, int lane) { const int col = ct * 16 + (lane & 15);
#pragma unroll
            for (int i = 0; i < 4; ++i) { const int r = rt * 16 + 4 * (lane >> 4) + i; const bf16 v = f2bf(acc[i]);
                if (r < NMETA) { for (int b = 0; b < NB; ++b) KVRAW[(size_t)(b * TT + r) * 1024 + col] = v; } else KVRAW[(size_t)(RP + r - NMETA) * 1024 + col] = v; } }, F.gw, F.NGW, F.lane);
    const float* DT = (const float*)(F.ws + WS_DT); const float* a_log = (const float*)F.in[13];
    const bf16* XST = (const bf16*)(F.ws + WS_XST); const bf16* BT = (const bf16*)(F.ws + WS_BT);
    float* STATES = (float*)(F.ws + WS_STATES); float* DECAY = (float*)(F.ws + WS_DECAY);
    LAS float* wl = (LAS float*)(F.lds + RING_OFF + F.wave * 1024);
    const int r32 = F.lane & 31, hi = F.lane >> 5;
    for (int u = F.gw; u < NB * NCH * NH; u += F.NGW) {
        const int h = u % NH, c = (u / NH) % NCH, b = u / (NH * NCH); const int g = h >> 2;
        const int t = c * CHL - TOFF + F.lane;
        const float dt = (t >= 0) ? DT[(size_t)(b * TT + t) * 8 + h] : 0.f;
        const float A = -__expf(a_log[h]);
        float acs = dt * A;
#pragma unroll
        for (int o = 1; o < 64; o <<= 1) { const float v = __shfl_up(acs, o); if (F.lane >= o) acs += v; }
        const float last = __shfl(acs, 63);
        wl[F.lane] = __expf(last - acs) * dt;
        LDS_WAIT(); asm volatile("" ::: "memory");
        f32x16 acc[2][2];
#pragma unroll
        for (int i = 0; i < 2; ++i)
#pragma unroll
            for (int j = 0; j < 2; ++j) acc[i][j] = (f32x16){};
        const bf16* xb = XST + ((size_t)(b * SSDW + h * HP)) * TPAD + c * CHL; const bf16* bb = BT + ((size_t)(b * 128 + g * DS)) * TPAD + c * CHL;
#pragma unroll
        for (int s = 0; s < 4; ++s) {
            const f32x4 w0 = *(const LAS f32x4*)(wl + 16 * s + 8 * hi), w1 = *(const LAS f32x4*)(wl + 16 * s + 8 * hi + 4);
            bf16x8 af[2], bfr[2];
#pragma unroll
            for (int pt = 0; pt < 2; ++pt) { const v4u x = *(const v4u*)(xb + (size_t)(32 * pt + r32) * TPAD + 16 * s + 8 * hi);
                v4u y; y.x = pk2(bflo(x.x) * w0.x, bfhi(x.x) * w0.y); y.y = pk2(bflo(x.y) * w0.z, bfhi(x.y) * w0.w); y.z = pk2(bflo(x.z) * w1.x, bfhi(x.z) * w1.y); y.w = pk2(bflo(x.w) * w1.z, bfhi(x.w) * w1.w);
                af[pt] = __builtin_bit_cast(bf16x8, y); }
#pragma unroll
            for (int nt = 0; nt < 2; ++nt) bfr[nt] = *(const bf16x8*)(bb + (size_t)(32 * nt + r32) * TPAD + 16 * s + 8 * hi);
#pragma unroll
            for (int pt = 0; pt < 2; ++pt)
#pragma unroll
                for (int nt = 0; nt < 2; ++nt) acc[pt][nt] = MFMA32(af[pt], bfr[nt], acc[pt][nt]);
        }
        float* so = STATES + ((size_t)((b * NCH + c) * NH + h)) * 4096;
#pragma unroll
        for (int pt = 0; pt < 2; ++pt)
#pragma unroll
            for (int nt = 0; nt < 2; ++nt)
#pragma unroll
                for (int rg = 0; rg < 16; ++rg) so[(32 * pt + crow(rg, hi)) * 64 + 32 * nt + r32] = acc[pt][nt][rg];
        if (F.lane == 0) DECAY[(b * NCH + c) * NH + h] = __expf(last);
        LDS_WAIT(); asm volatile("" ::: "memory");
    }
}

__device__ __forceinline__ void p4_post(Frame& F) {
    const bf16* QRAW = (const bf16*)(F.ws + WS_QRAW); const bf16* KVRAW = (const bf16*)(F.ws + WS_KVRAW); const float* KRF = (const float*)(F.ws + WS_KRF);
    bf16* Q = (bf16*)(F.ws + WS_Q); bf16* K = (bf16*)(F.ws + WS_K); bf16* VT = (bf16*)(F.ws + WS_VT); float* VS = (float*)(F.ws + WS_VS);
    const float* gqn = (const float*)F.in[20]; const float* gqr = (const float*)F.in[21]; const float* gkn = (const float*)F.in[22]; const float* gkr = (const float*)F.in[23];
    const float* ROPE = (const float*)(F.ws + WS_ROPE);
    const int h = F.lane >> 3, sub = F.lane & 7;
    bf16* KS = (bf16*)(F.ws + WS_KS);
    for (int row = F.gw; row < R; row += F.NGW) {
        const int t = (row < RP) ? row % TT : PAST;
        if (row >= RP) { const bf16* kp = KVRAW + (size_t)row * 1024 + 128 * h + 8 * sub; const v4u kw = *(const v4u*)kp; const v4u vw = *(const v4u*)(kp + 64);
          const f32x4 kr = *(const f32x4*)(KRF + (size_t)row * 32 + 4 * sub);
          float kn[8] = {bflo(kw.x), bfhi(kw.x), bflo(kw.y), bfhi(kw.y), bflo(kw.z), bfhi(kw.z), bflo(kw.w), bfhi(kw.w)};
          float ss = (kr.x * kr.x + kr.y * kr.y) + (kr.z * kr.z + kr.w * kr.w);
#pragma unroll
          for (int e = 0; e < 8; ++e) ss += kn[e] * kn[e];
          ss += __shfl_xor(ss, 1); ss += __shfl_xor(ss, 2); ss += __shfl_xor(ss, 4);
          const float rs = 1.0f / sqrtf(ss * (1.f / 96.f) + EPS);
          const float* gn = gkn + 8 * sub; v4u o; o.x = pk2(kn[0] * rs * gn[0], kn[1] * rs * gn[1]); o.y = pk2(kn[2] * rs * gn[2], kn[3] * rs * gn[3]); o.z = pk2(kn[4] * rs * gn[4], kn[5] * rs * gn[5]); o.w = pk2(kn[6] * rs * gn[6], kn[7] * rs * gn[7]);
          bf16* ko = KS + (size_t)(row - RP) * 768 + 96 * h; *(v4u*)(ko + 8 * sub) = o;
          const float* gr = gkr + ((4 * sub) & 15); v2u o2; o2.x = pk2(kr.x * rs * gr[0], kr.y * rs * gr[1]); o2.y = pk2(kr.z * rs * gr[2], kr.w * rs * gr[3]);
          *(v2u*)(ko + 64 + 4 * sub) = o2;
          const unsigned vv[4] = {vw.x, vw.y, vw.z, vw.w}; float* vs = VS + (size_t)(row - RP) * 512 + 64 * h + 8 * sub;
#pragma unroll
          for (int e = 0; e < 4; ++e) { vs[2 * e] = bflo(vv[e]); vs[2 * e + 1] = bfhi(vv[e]); } }
        if (row >= RP || t >= NMETA) {
            const bf16* qp = QRAW + (size_t)row * 768 + 96 * h; const v4u qw = *(const v4u*)(qp + 8 * sub);
            const unsigned r1 = *(const unsigned*)(qp + 64 + 2 * sub), r2 = *(const unsigned*)(qp + 80 + 2 * sub);
            float qn[8] = {bflo(qw.x), bfhi(qw.x), bflo(qw.y), bfhi(qw.y), bflo(qw.z), bfhi(qw.z), bflo(qw.w), bfhi(qw.w)};
            const f32x4 cs = *(const f32x4*)(ROPE + 2 * ((row < RP ? t : TT) * 16 + 2 * sub)); const float c0 = cs.x, s0 = cs.y, c1 = cs.z, s1 = cs.w;
            const float x10 = bflo(r1), x11 = bfhi(r1), x20 = bflo(r2), x21 = bfhi(r2);
            const float y10 = x10 * c0 - x20 * s0, y20 = x10 * s0 + x20 * c0, y11 = x11 * c1 - x21 * s1, y21 = x11 * s1 + x21 * c1;
            float ss = (y10 * y10 + y20 * y20) + (y11 * y11 + y21 * y21);
#pragma unroll
            for (int e = 0; e < 8; ++e) ss += qn[e] * qn[e];
            ss += __shfl_xor(ss, 1); ss += __shfl_xor(ss, 2); ss += __shfl_xor(ss, 4);
            const float rs = (ATTN_SCALE * LOG2E) / sqrtf(ss * (1.f / 96.f) + EPS);
            const float* gn = gqn + 8 * sub; v4u o; o.x = pk2(qn[0] * rs * gn[0], qn[1] * rs * gn[1]); o.y = pk2(qn[2] * rs * gn[2], qn[3] * rs * gn[3]); o.z = pk2(qn[4] * rs * gn[4], qn[5] * rs * gn[5]); o.w = pk2(qn[6] * rs * gn[6], qn[7] * rs * gn[7]);
            bf16* qo = Q + (size_t)row * 768 + 96 * h; *(v4u*)(qo + 8 * sub) = o;
            const float g0 = gqr[2 * sub], g1 = gqr[2 * sub + 1];
            *(unsigned*)(qo + 64 + 2 * sub) = pk2(y10 * rs * g0, y11 * rs * g1); *(unsigned*)(qo + 80 + 2 * sub) = pk2(y20 * rs * g0, y21 * rs * g1);
        }
    }
    { bf16* KF = (bf16*)(F.ws + WS_K); bf16* VF = (bf16*)(F.ws + WS_VT);
      LAS unsigned char* vtile = F.lds + RING_OFF + F.wave * 4608;
      const int r8 = F.lane >> 3;
      for (int u = F.gw; u < NB * NKT * NH; u += F.NGW) {
          const int hh = u % NH, kt = (u / NH) % NKT, bb = u / (NH * NKT);
          bf16* kfb = KF + ((size_t)((bb * NH + hh) * NKT + kt)) * (6 * 512); bf16* vfb = VF + ((size_t)((bb * NH + hh) * NKT + kt)) * (4 * 512);
#pragma unroll
          for (int i = 0; i < 4; ++i) {
              const int key = 8 * i + r8, tk = kt * 32 + key; v4u kw = (v4u){0u, 0u, 0u, 0u}, vw = kw; f32x4 kr = {0.f, 0.f, 0.f, 0.f};
              if (tk < TT) { const bf16* kp = KVRAW + (size_t)(bb * TT + tk) * 1024 + 128 * hh + 8 * sub; kw = *(const v4u*)kp; vw = *(const v4u*)(kp + 64); kr = *(const f32x4*)(KRF + (size_t)(bb * TT + tk) * 32 + 4 * sub); }
              float kn[8] = {bflo(kw.x), bfhi(kw.x), bflo(kw.y), bfhi(kw.y), bflo(kw.z), bfhi(kw.z), bflo(kw.w), bfhi(kw.w)};
              float ss = (kr.x * kr.x + kr.y * kr.y) + (kr.z * kr.z + kr.w * kr.w);
#pragma unroll
              for (int e = 0; e < 8; ++e) ss += kn[e] * kn[e];
              ss += __shfl_xor(ss, 1); ss += __shfl_xor(ss, 2); ss += __shfl_xor(ss, 4);
              const float rs = 1.0f / sqrtf(ss * (1.f / 96.f) + EPS);
              const float* gn = gkn + 8 * sub; v4u o; o.x = pk2(kn[0] * rs * gn[0], kn[1] * rs * gn[1]); o.y = pk2(kn[2] * rs * gn[2], kn[3] * rs * gn[3]); o.z = pk2(kn[4] * rs * gn[4], kn[5] * rs * gn[5]); o.w = pk2(kn[6] * rs * gn[6], kn[7] * rs * gn[7]);
              *(v4u*)(kfb + (sub >> 1) * 512 + ((sub & 1) * 32 + key) * 8) = o;
              const float* gr = gkr + ((4 * sub) & 15); v2u o2; o2.x = pk2(kr.x * rs * gr[0], kr.y * rs * gr[1]); o2.y = pk2(kr.z * rs * gr[2], kr.w * rs * gr[3]);
              *(v2u*)(kfb + (4 + (sub >> 2)) * 512 + (((sub >> 1) & 1) * 32 + key) * 8 + 4 * (sub & 1)) = o2;
              *(LAS v4u*)(vtile + key * 144 + sub * 16) = vw; }
          LDS_WAIT(); asm volatile("" ::: "memory");
          const int g = F.lane >> 4, q4 = (F.lane & 15) >> 2, pp = F.lane & 3;
          const unsigned a_lo = (unsigned)(uintptr_t)vtile + (unsigned)((4 * (g >> 1) + q4) * 144 + (16 * (g & 1) + 4 * pp) * 2);
#define VF_TR(dt, s2) do { s16x4 lo, hi4; \
              asm volatile("ds_read_b64_tr_b16 %0, %2 offset:%c3\n\tds_read_b64_tr_b16 %1, %2 offset:%c4\n\ts_waitcnt lgkmcnt(0)" : "=&v"(lo), "=&v"(hi4) : "v"(a_lo), "i"(16 * (s2) * 144 + 64 * (dt)), "i"(16 * (s2) * 144 + 64 * (dt) + 8 * 144) : "memory"); \
              v4u o; o.x = (unsigned)(unsigned short)lo[0] | ((unsigned)(unsigned short)lo[1] << 16); o.y = (unsigned)(unsigned short)lo[2] | ((unsigned)(unsigned short)lo[3] << 16); \
              o.z = (unsigned)(unsigned short)hi4[0] | ((unsigned)(unsigned short)hi4[1] << 16); o.w = (unsigned)(unsigned short)hi4[2] | ((unsigned)(unsigned short)hi4[3] << 16); \
              *(v4u*)(vfb + ((dt) * 2 + (s2)) * 512 + F.lane * 8) = o; } while (0)
          VF_TR(0, 0); VF_TR(0, 1); VF_TR(1, 0); VF_TR(1, 1);
#undef VF_TR
          LDS_WAIT(); asm volatile("" ::: "memory");
      } }
    const float* STATES = (const float*)(F.ws + WS_STATES); const float* DECAY = (const float*)(F.ws + WS_DECAY); bf16* HIN = (bf16*)(F.ws + WS_HIN);
    for (int e = blockIdx.x * NTHR + F.tid; e < NB * NH * 4096; e += F.G * NTHR) {
        const int b = e / (NH * 4096), hh = (e / 4096) % NH, pn = e % 4096;
        float hv = 0.f;
#pragma unroll 11
        for (int c = 0; c < NCH; ++c) { const size_t idx = ((size_t)((b * NCH + c) * NH + hh)) * 4096 + pn;
            HIN[idx] = f2bf(hv); hv = hv * DECAY[(b * NCH + c) * NH + hh] + STATES[idx]; }
        F.out[OUT_SSMP + e] = hv;
    }
    const float* XAS = (const float*)(F.ws + WS_XAS); const float* DT = (const float*)(F.ws + WS_DT); const float* sst = (const float*)F.in[5];
    const float* a_log = (const float*)F.in[13]; const float* d_skip = (const float*)F.in[14]; float* YS = (float*)(F.ws + WS_YS);
    for (int u = F.gw; u < DB * NH * 16; u += F.NGW) {
        const int pq = u & 15, hh = (u >> 4) & 7, b = u >> 7; const int g = hh >> 2; const int p = 4 * pq + (F.lane >> 4), n4 = F.lane & 15;
        const float dt = DT[(size_t)(RP + b) * 8 + hh]; const float a = __expf(dt * -__expf(a_log[hh]));
        const float x = XAS[(size_t)b * CONVD + hh * HP + p]; const float uu = dt * x;
        const f32x4 Bv = *(const f32x4*)(XAS + (size_t)b * CONVD + SSDW + g * DS + 4 * n4), Cv = *(const f32x4*)(XAS + (size_t)b * CONVD + SSDW + 128 + g * DS + 4 * n4);
        const size_t si = (((size_t)b * NH + hh) * HP + p) * DS + 4 * n4;
        const f32x4 s0 = *(const f32x4*)(sst + si); const f32x4 s1 = s0 * a + uu * Bv;
        *(f32x4*)(F.out + OUT_SSMS + si) = s1;
        float y = (Cv.x * s1.x + Cv.y * s1.y) + (Cv.z * s1.z + Cv.w * s1.w);
        y += __shfl_xor(y, 1); y += __shfl_xor(y, 2); y += __shfl_xor(y, 4); y += __shfl_xor(y, 8);
        if (n4 == 0) YS[(size_t)b * 512 + hh * HP + p] = y + d_skip[hh] * x;
    }
}
constexpr int DA_ROWB = 528;
constexpr int DA_LAT = 0, DA_KR = 128 * DA_ROWB, DA_PB = DA_KR + 128 * 33 * 4, DA_QG = DA_PB + 2 * 16 * 32 * 2, DA_END = DA_QG + 8 * 96 * 4;
constexpr int P5_EXCH = 100 * 1024;
static_assert(DA_END <= P5_EXCH, "LDS map of P5");

constexpr int AT_SLOT = 10240, AT_D = 4;
constexpr size_t WS_ATT = 499 * MiB;
__device__ __forceinline__ void at_issue(Frame& F, const bf16* kt_k, const bf16* kt_v, LAS unsigned char* slot) {
    const char* srcA = (F.wave < 6) ? (const char*)kt_k + F.wave * 1024 : (const char*)kt_v + (F.wave - 6) * 1024;
    __builtin_amdgcn_global_load_lds((const unsigned*)(srcA + F.lane * 16), (LAS unsigned*)(slot + F.wave * 1024), 16, 0, 0);
    __builtin_amdgcn_global_load_lds((const unsigned*)((const char*)kt_v + 2048 + F.wave * 256 + F.lane * 4), (LAS unsigned*)(slot + 8192 + F.wave * 256), 4, 0, 0);
}
__device__ __forceinline__ void p5_attn_prompt(Frame& F, float M0) {
    const bf16* Q = (const bf16*)(F.ws + WS_Q); const bf16* KF = (const bf16*)(F.ws + WS_K); const bf16* VF = (const bf16*)(F.ws + WS_VT); bf16* ATT = (bf16*)(F.ws + WS_ATT);
    LAS unsigned char* ring = F.lds + RING_OFF;
    const int w = F.wave, r32 = F.lane & 31, hi = F.lane >> 5;
    f32x16 negm;
#pragma unroll
    for (int i = 0; i < 16; ++i) negm[i] = -M0;
    for (int u = blockIdx.x; u < 256; u += F.G) {
        const int b = u >> 5, h = (u >> 2) & 7, pr = u & 3;
        const bf16* kfb = KF + ((size_t)((b * NH + h) * NKT)) * (6 * 512); const bf16* vfb = VF + ((size_t)((b * NH + h) * NKT)) * (4 * 512);
#pragma unroll 1
        for (int half = 0; half < 2; ++half) {
            const int qb = half ? 7 - pr : pr; const int a = 8 * qb + w; const int qi = NMETA + 32 * a + r32;
            const int nkt = 8 * qb + 9, nkw = a + 2;
            const bf16* qp = Q + (size_t)(b * TT + qi) * 768 + 96 * h + 8 * hi;
            bf16x8 qf[6];
#pragma unroll
            for (int s = 0; s < 6; ++s) qf[s] = *(const bf16x8*)(qp + 16 * s);
            f32x16 o0 = (f32x16){}, o1 = (f32x16){}; float l = 0.f;
#pragma unroll
            for (int j = 0; j < AT_D - 1; ++j) at_issue(F, kfb + (size_t)j * 3072, vfb + (size_t)j * 2048, ring + j * AT_SLOT);
#pragma unroll 1
            for (int kt = 0; kt < nkt; ++kt) {
                const int rem = nkt - 1 - kt;
                if (rem >= 2) asm volatile("s_waitcnt vmcnt(4)" ::: "memory"); else if (rem == 1) asm volatile("s_waitcnt vmcnt(2)" ::: "memory"); else asm volatile("s_waitcnt vmcnt(0)" ::: "memory");
                __builtin_amdgcn_s_barrier(); asm volatile("" ::: "memory");
                if (kt + AT_D - 1 < nkt) at_issue(F, kfb + (size_t)(kt + AT_D - 1) * 3072, vfb + (size_t)(kt + AT_D - 1) * 2048, ring + ((kt + AT_D - 1) & (AT_D - 1)) * AT_SLOT);
                if (kt < nkw) {
                    const LAS unsigned char* sl = ring + (kt & (AT_D - 1)) * AT_SLOT + F.lane * 16; const int j0 = 32 * kt;
                    f32x16 S = negm;
#pragma unroll
                    for (int s = 0; s < 6; ++s) S = MFMA32(*(const LAS bf16x8*)(sl + 1024 * s), qf[s], S);
                    bf16x8 vf[4];
#pragma unroll
                    for (int i = 0; i < 4; ++i) vf[i] = *(const LAS bf16x8*)(sl + 6144 + 1024 * i);
#pragma unroll
                    for (int i = 0; i < 16; ++i) S[i] = __builtin_amdgcn_exp2f(S[i]);
                    if (kt >= a) {
#pragma unroll
                        for (int i = 0; i < 16; ++i) if (j0 + crow(i, hi) > qi) S[i] = 0.f; }
#pragma unroll
                    for (int i = 0; i < 16; ++i) l += S[i];
                    const bf16x8 p0 = pack8(S, 0), p1 = pack8(S, 1);
                    o0 = MFMA32(vf[0], p0, o0); o0 = MFMA32(vf[1], p1, o0);
                    o1 = MFMA32(vf[2], p0, o1); o1 = MFMA32(vf[3], p1, o1);
                }
            }
            l += __shfl_xor(l, 32);
            const float il = 1.0f / l;
            bf16* ao = ATT + (size_t)(b * TT + qi) * 512 + 64 * h + 4 * hi;
#pragma unroll
            for (int gq = 0; gq < 4; ++gq) {
                v2u w0, w1; w0.x = pk2(o0[4 * gq] * il, o0[4 * gq + 1] * il); w0.y = pk2(o0[4 * gq + 2] * il, o0[4 * gq + 3] * il);
                w1.x = pk2(o1[4 * gq] * il, o1[4 * gq + 1] * il); w1.y = pk2(o1[4 * gq + 2] * il, o1[4 * gq + 3] * il);
                *(v2u*)(ao + 8 * gq) = w0; *(v2u*)(ao + 32 + 8 * gq) = w1; }
            asm volatile("s_waitcnt lgkmcnt(0)" ::: "memory"); __builtin_amdgcn_s_barrier(); asm volatile("" ::: "memory");
        }
    }
}

__device__ __forceinline__ void p5_ssd_out(Frame& F) {
    const float* DT = (const float*)(F.ws + WS_DT); const float* a_log = (const float*)F.in[13]; const float* d_skip = (const float*)F.in[14]; const float* ng = (const float*)F.in[15];
    const bf16* XST = (const bf16*)(F.ws + WS_XST); const bf16* BC = (const bf16*)(F.ws + WS_BC); const bf16* HIN = (const bf16*)(F.ws + WS_HIN); const bf16* PROJ = (const bf16*)(F.ws + WS_PROJ);
    bf16* MIX = (bf16*)(F.ws + WS_MIX);
    LAS float* tab = (LAS float*)(F.lds + RING_OFF + F.wave * 1024);
    LAS float* exch = (LAS float*)(F.lds + P5_EXCH + 2048);
    const int h = F.wave, g = h >> 2, r32 = F.lane & 31, hi = F.lane >> 5;
    const float A = -__expf(a_log[h]), Dh = d_skip[h];
    for (int u = blockIdx.x; u < NB * (NCH - 1); u += F.G) {
        const int b = u / (NCH - 1), c = 1 + u % (NCH - 1); const int tbase = c * CHL - TOFF;
        { const int t = tbase + F.lane; const float dt = (t >= 0) ? DT[(size_t)(b * TT + t) * 8 + h] : 0.f;
          float acs = dt * A;
#pragma unroll
          for (int o = 1; o < 64; o <<= 1) { const float v = __shfl_up(acs, o); if (F.lane >= o) acs += v; }
          tab[F.lane] = acs; tab[64 + F.lane] = dt; }
        LDS_WAIT(); asm volatile("" ::: "memory");
        const bf16* hb = HIN + ((size_t)((b * NCH + c) * NH + h)) * 4096 + 8 * hi;
        const bf16* xb = XST + ((size_t)(b * SSDW + h * HP)) * TPAD + c * CHL + 4 * hi;
#pragma unroll 1
        for (int it = 0; it < 2; ++it) {
            const int ii = 32 * it + r32; const int t = tbase + ii; const int tc = t < 0 ? 0 : t;
            bf16x8 cf[4];
            { const bf16* cp = BC + (size_t)(b * TT + tc) * 256 + 128 + g * DS + 8 * hi;
#pragma unroll
              for (int s = 0; s < 4; ++s) cf[s] = *(const bf16x8*)(cp + 16 * s); }
            f32x16 y[2];
            const float ai = tab[ii]; const float ei = __expf(ai);
#pragma unroll
            for (int pt = 0; pt < 2; ++pt) { f32x16 acc = (f32x16){};
#pragma unroll
                for (int s = 0; s < 4; ++s) acc = MFMA32(*(const bf16x8*)(hb + (size_t)(32 * pt + r32) * 64 + 16 * s), cf[s], acc);
#pragma unroll
                for (int i = 0; i < 16; ++i) acc[i] *= ei;
                y[pt] = acc; }
#pragma unroll 1
            for (int jt = 0; jt <= it; ++jt) {
                f32x16 S = (f32x16){};
                { int tj = tbase + 32 * jt + r32; tj = tj < 0 ? 0 : tj; const bf16* bp = BC + (size_t)(b * TT + tj) * 256 + g * DS + 8 * hi;
#pragma unroll
                  for (int s = 0; s < 4; ++s) S = MFMA32(*(const bf16x8*)(bp + 16 * s), cf[s], S); }
#pragma unroll
                for (int i = 0; i < 16; ++i) { const int jj = 32 * jt + crow(i, hi); const float e = (jj <= ii) ? __expf(ai - tab[jj]) * tab[64 + jj] : 0.f; S[i] *= e; }
                const bf16x8 p0 = pack8(S, 0), p1 = pack8(S, 1);
#pragma unroll
                for (int pt = 0; pt < 2; ++pt) { const bf16* xp = xb + (size_t)(32 * pt + r32) * TPAD + 32 * jt;
                    y[pt] = MFMA32(ld2x8(xp, xp + 8), p0, y[pt]); y[pt] = MFMA32(ld2x8(xp + 16, xp + 24), p1, y[pt]); }
            }
            const bf16* zp = PROJ + (size_t)(b * TT + tc) * PJ + C_Z + 64 * h + 4 * hi;
            const bf16* xt = XST + ((size_t)(b * SSDW + h * HP)) * TPAD + c * CHL + ii;
            float ss = 0.f;
#pragma unroll
            for (int pt = 0; pt < 2; ++pt)
#pragma unroll
                for (int gq = 0; gq < 4; ++gq) { const v2u zw = *(const v2u*)(zp + 32 * pt + 8 * gq); const float zz[4] = {bflo(zw.x), bfhi(zw.x), bflo(zw.y), bfhi(zw.y)};
#pragma unroll
                    for (int e = 0; e < 4; ++e) { const int p = 32 * pt + 8 * gq + 4 * hi + e; const float x = bf2f(xt[(size_t)p * TPAD]);
                        const float v = (y[pt][4 * gq + e] + Dh * x) * silu_f(zz[e]); y[pt][4 * gq + e] = v; ss += v * v; } }
            ss += __shfl_xor(ss, 32);
            LAS float* ex = exch + it * 256;
            if (hi == 0) ex[h * 32 + r32] = ss;
            __syncthreads();
            const float tot = (ex[(4 * g) * 32 + r32] + ex[(4 * g + 1) * 32 + r32]) + (ex[(4 * g + 2) * 32 + r32] + ex[(4 * g + 3) * 32 + r32]);
            const float rs = 1.0f / sqrtf(tot * (1.f / 256.f) + EPS);
            if (t >= 0) { bf16* mo = MIX + (size_t)(b * TT + t) * 1024 + 64 * h + 4 * hi;
#pragma unroll
                for (int pt = 0; pt < 2; ++pt)
#pragma unroll
                    for (int gq = 0; gq < 4; ++gq) { const f32x4 gg = *(const f32x4*)(ng + 64 * h + 32 * pt + 8 * gq + 4 * hi);
                        v2u w; w.x = pk2(y[pt][4 * gq] * rs * gg.x, y[pt][4 * gq + 1] * rs * gg.y); w.y = pk2(y[pt][4 * gq + 2] * rs * gg.z, y[pt][4 * gq + 3] * rs * gg.w);
                        *(v2u*)(mo + 32 * pt + 8 * gq) = w; } }
        }
        __syncthreads();
    }
    const float* YS = (const float*)(F.ws + WS_YS);
    for (int u = F.gw; u < DB * NG; u += F.NGW) { const int b = u >> 1, gg = u & 1; const int cc = gg * 256 + 4 * F.lane;
        const f32x4 yv = *(const f32x4*)(YS + (size_t)b * 512 + cc); const v2u zw = *(const v2u*)(PROJ + (size_t)(RP + b) * PJ + C_Z + cc);
        const f32x4 v = {yv.x * silu_f(bflo(zw.x)), yv.y * silu_f(bfhi(zw.x)), yv.z * silu_f(bflo(zw.y)), yv.w * silu_f(bfhi(zw.y))};
        const float rs = 1.0f / sqrtf(wave_sum((v.x * v.x + v.y * v.y) + (v.z * v.z + v.w * v.w)) * (1.f / 256.f) + EPS);
        const f32x4 gv = *(const f32x4*)(ng + cc); v2u w; w.x = pk2(v.x * rs * gv.x, v.y * rs * gv.y); w.y = pk2(v.z * rs * gv.z, v.w * rs * gv.w);
        *(v2u*)(MIX + (size_t)(RP + b) * 1024 + cc) = w; }
}

constexpr int DB_STAGE = 0, DB_KRST = 65536, DB_LAT = DB_KRST + 8192, DB_KR = DB_LAT + 64 * DA_ROWB, DB_PB = DB_KR + 64 * 36 * 4, DB_QG = DB_PB + 16 * 64 * 2, DB_END = DB_QG + 8 * 96 * 4;
static_assert(DB_END <= RING_BYTES, "decode attention LDS map");
#define RAW_BAR_L() do { asm volatile("s_waitcnt lgkmcnt(0)" ::: "memory"); __builtin_amdgcn_s_barrier(); asm volatile("" ::: "memory"); } while (0)
#define RAW_BAR_VL() do { asm volatile("s_waitcnt vmcnt(0) lgkmcnt(0)" ::: "memory"); __builtin_amdgcn_s_barrier(); asm volatile("" ::: "memory"); } while (0)
__device__ __forceinline__ void da_issue(Frame& F, LAS unsigned char* L, const float* clat, const float* ckr, const int* ptab, int b, int split, int hp) {
    const size_t tok0 = (size_t)ptab[b * NPAGES + split * 32 + (hp >> 1)] * PAGE + (hp & 1) * 64;
    const char* src = (const char*)(clat + tok0 * KVL) + (size_t)(F.wave * 8) * 1024 + F.lane * 16;
#pragma unroll
    for (int i = 0; i < 8; ++i) __builtin_amdgcn_global_load_lds((const unsigned*)(src + i * 1024), (LAS unsigned*)(L + DB_STAGE + (F.wave * 8 + i) * 1024), 16, 0, 0);
    __builtin_amdgcn_global_load_lds((const unsigned*)((const char*)(ckr + tok0 * 32) + F.wave * 1024 + F.lane * 16), (LAS unsigned*)(L + DB_KRST + F.wave * 1024), 16, 0, 0);
}
__device__ __forceinline__ void da_convert(Frame& F, LAS unsigned char* L) {
#pragma unroll 4
    for (int k = 0; k < 8; ++k) { const int f = F.tid + NTHR * k; const int row = f >> 6, c4 = f & 63; const f32x4 v = *(const LAS f32x4*)(L + DB_STAGE + f * 16);
        v2u w; w.x = pk2(v.x, v.y); w.y = pk2(v.z, v.w); *(LAS v2u*)(L + DB_LAT + row * DA_ROWB + c4 * 8) = w; }
    { const int f = F.tid; const int row = f >> 3, c4 = f & 7; const f32x4 v = *(const LAS f32x4*)(L + DB_KRST + f * 16);
      *(LAS f32x4*)((LAS float*)(L + DB_KR) + row * 36 + 4 * c4) = v; }
}
template <int MODE>
__device__ __forceinline__ void p5_attn_decode_t(Frame& F, float M0) {
    const float* clat = (const float*)F.in[2]; const float* ckr = (const float*)F.in[3]; const int* ptab = (const int*)F.in[6];
    const bf16* WUKV = (const bf16*)(F.ws + WS_WUKV); const bf16* Q = (const bf16*)(F.ws + WS_Q); const float* gkn = (const float*)F.in[22]; const float* gkr = (const float*)F.in[23];
    float* DPART = (float*)(F.ws + WS_DPART);
    LAS unsigned char* L = F.lds + RING_OFF;
    LAS float* krl = (LAS float*)(L + DB_KR); LAS bf16* pb = (LAS bf16*)(L + DB_PB); LAS float* qg = (LAS float*)(L + DB_QG) + F.wave * 96;
    const int h = F.wave, r32 = F.lane & 31, hi = F.lane >> 5;
    for (int u = blockIdx.x; u < DB * 2; u += F.G) {
        const int b = u >> 1, split = u & 1;
        da_issue(F, L, clat, ckr, ptab, b, split, 0);
        bf16x8 wf[2][16];
#pragma unroll
        for (int dt = 0; dt < 2; ++dt)
#pragma unroll
            for (int s = 0; s < 16; ++s) wf[dt][s] = *(const bf16x8*)(WUKV + (size_t)(128 * h + 32 * dt + r32) * KVL + 16 * s + 8 * hi);
        { const bf16* qp = Q + (size_t)(RP + b) * 768 + 96 * h; qg[F.lane] = bf2f(qp[F.lane]) * gkn[F.lane]; if (F.lane < 32) qg[64 + F.lane] = bf2f(qp[64 + F.lane]) * gkr[F.lane & 15]; }
        for (int i = F.tid; i < 16 * 64; i += NTHR) pb[i] = 0;
        f32x4 ao[2] = {(f32x4){0.f, 0.f, 0.f, 0.f}, (f32x4){0.f, 0.f, 0.f, 0.f}}; float l = 0.f;
        RAW_BAR_VL();
        da_convert(F, L);
        RAW_BAR_L();
        da_issue(F, L, clat, ckr, ptab, b, split, 1);
#pragma unroll 1
        for (int hp = 0; hp < 64; ++hp) {
          if (MODE == 0 || MODE == 3) {
#pragma unroll 1
            for (int sb = 0; sb < 2; ++sb) {
                const LAS unsigned char* bp = L + DB_LAT + (32 * sb + r32) * DA_ROWB + 16 * hi;
                f32x16 a0 = (f32x16){}, a1 = (f32x16){};
                bf16x8 fa[4], fb[4];
#pragma unroll
                for (int s = 0; s < 4; ++s) fa[s] = *(const LAS bf16x8*)(bp + 32 * s);
#pragma unroll
                for (int g4 = 0; g4 < 4; ++g4) {
                    if (g4 < 3) {
#pragma unroll
                        for (int s = 0; s < 4; ++s) fb[s] = *(const LAS bf16x8*)(bp + 32 * (4 * g4 + 4 + s)); }
#pragma unroll
                    for (int s = 0; s < 4; ++s) { a0 = MFMA32(wf[0][4 * g4 + s], fa[s], a0); a1 = MFMA32(wf[1][4 * g4 + s], fa[s], a1); }
#pragma unroll
                    for (int s = 0; s < 4; ++s) fa[s] = fb[s];
                }
                __builtin_amdgcn_sched_barrier(0);
                float ss, dot;
                {
                    const LAS float* qv = qg + 4 * hi;
                    f32x4 s4 = {0.f, 0.f, 0.f, 0.f}, d4 = {0.f, 0.f, 0.f, 0.f};
#pragma unroll
                    for (int g4 = 0; g4 < 4; ++g4) { const f32x4 q0 = *(const LAS f32x4*)(qv + 8 * g4), q1 = *(const LAS f32x4*)(qv + 32 + 8 * g4);
                        const f32x4 x0 = {a0[4 * g4], a0[4 * g4 + 1], a0[4 * g4 + 2], a0[4 * g4 + 3]}, x1 = {a1[4 * g4], a1[4 * g4 + 1], a1[4 * g4 + 2], a1[4 * g4 + 3]};
                        s4 += x0 * x0; s4 += x1 * x1; d4 += x0 * q0; d4 += x1 * q1; }
                    const LAS float* kr = krl + (32 * sb + r32) * 36 + 16 * hi; const LAS float* qr = qg + 64 + 16 * hi;
#pragma unroll
                    for (int g4 = 0; g4 < 4; ++g4) { const f32x4 kv = *(const LAS f32x4*)(kr + 4 * g4), qq = *(const LAS f32x4*)(qr + 4 * g4); s4 += kv * kv; d4 += kv * qq; }
                    ss = (s4.x + s4.y) + (s4.z + s4.w); dot = (d4.x + d4.y) + (d4.z + d4.w);
                }
                __builtin_amdgcn_sched_barrier(0);
                ss += __shfl_xor(ss, 32); dot += __shfl_xor(dot, 32);
                const float p = __builtin_amdgcn_exp2f(dot * __builtin_amdgcn_rsqf(ss * (1.f / 96.f) + EPS) - M0);
                l += p;
                if (hi == 0) pb[h * 64 + 32 * sb + r32] = f2bf(p);
            }
            RAW_BAR_L();
            if (MODE < 4) { const int q4 = (F.lane & 15) >> 2, pp = F.lane & 3, kg = F.lane >> 4;
              const unsigned a_lo = (unsigned)(uintptr_t)(L + DB_LAT) + (unsigned)((8 * kg + q4) * DA_ROWB + (32 * h + 4 * pp) * 2);
              const LAS bf16* pap = pb + (F.lane & 15) * 64 + 8 * kg;
              s16x4 t0, t1, t2, t3, t4, t5, t6, t7;
              asm volatile("ds_read_b64_tr_b16 %0, %8 offset:%c9\n\tds_read_b64_tr_b16 %1, %8 offset:%c10\n\tds_read_b64_tr_b16 %2, %8 offset:%c11\n\tds_read_b64_tr_b16 %3, %8 offset:%c12\n\t"
                           "ds_read_b64_tr_b16 %4, %8 offset:%c13\n\tds_read_b64_tr_b16 %5, %8 offset:%c14\n\tds_read_b64_tr_b16 %6, %8 offset:%c15\n\tds_read_b64_tr_b16 %7, %8 offset:%c16\n\ts_waitcnt lgkmcnt(0)"
                           : "=&v"(t0), "=&v"(t1), "=&v"(t2), "=&v"(t3), "=&v"(t4), "=&v"(t5), "=&v"(t6), "=&v"(t7)
                           : "v"(a_lo), "i"(0), "i"(4 * DA_ROWB), "i"(32), "i"(32 + 4 * DA_ROWB), "i"(32 * DA_ROWB), "i"(32 * DA_ROWB + 4 * DA_ROWB), "i"(32 * DA_ROWB + 32), "i"(32 * DA_ROWB + 32 + 4 * DA_ROWB) : "memory");
              const bf16x8 pa0 = *(const LAS bf16x8*)(pap), pa1 = *(const LAS bf16x8*)(pap + 32);
#define DA_FR(x, y) ((bf16x8){x[0], x[1], x[2], x[3], y[0], y[1], y[2], y[3]})
              ao[0] = MFMA16(pa0, DA_FR(t0, t1), ao[0]); ao[1] = MFMA16(pa0, DA_FR(t2, t3), ao[1]);
              ao[0] = MFMA16(pa1, DA_FR(t4, t5), ao[0]); ao[1] = MFMA16(pa1, DA_FR(t6, t7), ao[1]);
#undef DA_FR
#define DA_PV(ks, nt) do { } while (0)
#undef DA_PV
            }
          }
            RAW_BAR_VL();
            if (hp + 1 < 64) { if (MODE <= 1 || MODE >= 3) da_convert(F, L); RAW_BAR_L(); if (hp + 2 < 64 && MODE < 3) da_issue(F, L, clat, ckr, ptab, b, split, hp + 2); }
        }
        if (MODE >= 3 && l == 123.456f) DPART[0] = l;
        if (MODE == 0) { const int kg = F.lane >> 4;
          if (kg < 2) {
#pragma unroll
              for (int nt = 0; nt < 2; ++nt)
#pragma unroll
                  for (int i = 0; i < 4; ++i) DPART[((size_t)((b * 2 + split) * NH + 4 * kg + i)) * 264 + 32 * h + 16 * nt + (F.lane & 15)] = ao[nt][i]; }
          float lt = (hi == 0) ? l : 0.f; lt = wave_sum(lt);
          if (F.lane == 0) DPART[((size_t)((b * 2 + split) * NH + h)) * 264 + 256] = lt; }
        RAW_BAR_L();
    }
}

__device__ __forceinline__ void p5_attn_decode(Frame& F, float M0) { p5_attn_decode_t<0>(F, M0); }

__device__ __forceinline__ void p6_decode_combine(Frame& F, float M0) {
    {
      const bf16* ATT = (const bf16*)(F.ws + WS_ATT); bf16* MIXo = (bf16*)(F.ws + WS_MIX); const float* mgg = (const float*)F.in[24];
      const f32x4 g0 = ((const f32x4*)mgg)[2 * F.lane], g1 = ((const f32x4*)mgg)[2 * F.lane + 1];
      for (int r = F.gw; r < MMAIN; r += F.NGW) { const size_t row = (size_t)(r >> 11) * TT + NMETA + (r & 2047);
          const v4u x = *(const v4u*)(ATT + row * 512 + 8 * F.lane);
          const float v[8] = {bflo(x.x), bfhi(x.x), bflo(x.y), bfhi(x.y), bflo(x.z), bfhi(x.z), bflo(x.w), bfhi(x.w)};
          float ss = 0.f;
#pragma unroll
          for (int e = 0; e < 8; ++e) ss += v[e] * v[e];
          const float rs = 1.0f / sqrtf(wave_sum(ss) * (1.f / MLAW) + EPS);
          v4u o; o.x = pk2(v[0] * rs * g0.x, v[1] * rs * g0.y); o.y = pk2(v[2] * rs * g0.z, v[3] * rs * g0.w); o.z = pk2(v[4] * rs * g1.x, v[5] * rs * g1.y); o.w = pk2(v[6] * rs * g1.z, v[7] * rs * g1.w);
          *(v4u*)(MIXo + row * 1024 + 512 + 8 * F.lane) = o; } }
    const float* DPART = (const float*)(F.ws + WS_DPART); const bf16* WUKV = (const bf16*)(F.ws + WS_WUKV); const bf16* Q = (const bf16*)(F.ws + WS_Q); const bf16* KS = (const bf16*)(F.ws + WS_KS);
    const float* VS = (const float*)(F.ws + WS_VS); const float* mg = (const float*)F.in[24]; bf16* MIX = (bf16*)(F.ws + WS_MIX);
    LAS float* accl = (LAS float*)(F.lds + RING_OFF) + F.wave * 256; LAS float* exch = (LAS float*)(F.lds + P5_EXCH);
    const int h = F.wave;
    for (int b = blockIdx.x; b < DB; b += F.G) {
        const float* p0 = DPART + ((size_t)((b * 2 + 0) * NH + h)) * 264; const float* p1 = DPART + ((size_t)((b * 2 + 1) * NH + h)) * 264;
#pragma unroll
        for (int k = 0; k < 4; ++k) accl[F.lane + 64 * k] = p0[F.lane + 64 * k] + p1[F.lane + 64 * k];
        float l = p0[256] + p1[256];
        const bf16* qp = Q + (size_t)(RP + b) * 768 + 96 * h; const bf16* kp = KS + (size_t)b * 768 + 96 * h;
        float sd = bf2f(qp[F.lane]) * bf2f(kp[F.lane]); if (F.lane < 32) sd += bf2f(qp[64 + F.lane]) * bf2f(kp[64 + F.lane]);
        sd = wave_sum(sd);
        const float pn = __builtin_amdgcn_exp2f(sd - M0); l += pn;
        LDS_WAIT(); asm volatile("" ::: "memory");
        const bf16* wv = WUKV + (size_t)(128 * h + 64 + F.lane) * KVL;
        float o = 0.f;
#pragma unroll 4
        for (int c8 = 0; c8 < 32; ++c8) { const v4u w = *(const v4u*)(wv + 8 * c8); const f32x4 x0 = *(const LAS f32x4*)(accl + 8 * c8), x1 = *(const LAS f32x4*)(accl + 8 * c8 + 4);
            o += (bflo(w.x) * x0.x + bfhi(w.x) * x0.y) + (bflo(w.y) * x0.z + bfhi(w.y) * x0.w) + (bflo(w.z) * x1.x + bfhi(w.z) * x1.y) + (bflo(w.w) * x1.z + bfhi(w.w) * x1.w); }
        o = (o + pn * VS[(size_t)b * 512 + 64 * h + F.lane]) / l;
        const float ss = wave_sum(o * o);
        if (F.lane == 0) exch[h] = ss;
        __syncthreads();
        float tot = 0.f;
#pragma unroll
        for (int hh = 0; hh < NH; ++hh) tot += exch[hh];
        const float rs = 1.0f / sqrtf(tot * (1.f / MLAW) + EPS);
        MIX[(size_t)(RP + b) * 1024 + 512 + 64 * h + F.lane] = f2bf(o * rs * mg[64 * h + F.lane]);
        __syncthreads();
    }
}

__device__ __forceinline__ void p7_outproj(Frame& F) {
    const bf16* MIX = (const bf16*)(F.ws + WS_MIX); const bf16* WOUT = (const bf16*)(F.ws + WS_WOUT); const float* xp = (const float*)F.in[0]; const float* xs = (const float*)F.in[1]; float* HS = (float*)(F.ws + WS_HS);
    bf16* HB = (bf16*)(F.ws + WS_XN); float* SS = (float*)(F.ws + WS_SSP);
    { pg8::Gemm g{MIX, WOUT, MMAIN, DM, 1024, 1}; pg8::StaticOrder S; S.init(MMAIN, DM, F.G, (int)blockIdx.x); EpiOutProj E{xp, F.out + OUT_YP, HB, SS};
      pg8::gemm_phase<EpiOutProj, pg8::StaticOrder, true, true>(F.lds + RING_OFF, g, S, E); }
    small_gemm(MIX, 1024, WOUT, 1024, DB / 16, DM / 16, [](int r) { return RP + r; },
        [&](const f32x4& acc, int rt, int ct, int lane) { const int col = ct * 16 + (lane & 15);
#pragma unroll
            for (int i = 0; i < 4; ++i) { const int r = rt * 16 + 4 * (lane >> 4) + i; const size_t o = (size_t)r * DM + col; const float v = xs[o] + acc[i]; HS[o] = v; HB[(size_t)(RP + r) * DM + col] = f2bf(v);
                float ss = v * v; ss += __shfl_xor(ss, 1); ss += __shfl_xor(ss, 2); ss += __shfl_xor(ss, 4); ss += __shfl_xor(ss, 8);
                if ((lane & 15) == 0) SS[(size_t)MMAIN * 16 + (size_t)r * 64 + ct] = ss; } }, F.gw, F.NGW, F.lane);
}
__device__ __forceinline__ void p9_gateup(Frame& F) {
    const bf16* HB = (const bf16*)(F.ws + WS_XN); const bf16* WGU = (const bf16*)(F.ws + WS_WGU); bf16* ACT = (bf16*)(F.ws + WS_ACT); const float* SS = (const float*)(F.ws + WS_SSP);
    { pg8::Gemm g{HB, WGU, MMAIN, 2 * DFF, DM, 1}; pg8::StaticOrder S; S.init(MMAIN, 2 * DFF, F.G, (int)blockIdx.x); EpiSwiGLU E{ACT, SS};
      pg8::gemm_phase<EpiSwiGLU, pg8::StaticOrder, true, true>(F.lds + RING_OFF, g, S, E); }
    const int gw = F.gw, ngw = F.NGW;
    const int nrt = DB / 16, nlt = DFF / 16;
    for (int task = gw; task < nrt * nlt; task += ngw) {
        const int rt = task % nrt, lt = task / nrt; const int lc = lt * 16 + (F.lane & 15);
        const bf16* ap = HB + (size_t)(RP + rt * 16 + (F.lane & 15)) * DM + 8 * (F.lane >> 4);
        const bf16* gp = WGU + (size_t)(256 * (lc >> 7) + (lc & 127)) * DM + 8 * (F.lane >> 4); const bf16* up = gp + (size_t)128 * DM;
        f32x4 ag = {0.f, 0.f, 0.f, 0.f}, au = {0.f, 0.f, 0.f, 0.f};
#pragma unroll 8
        for (int k0 = 0; k0 < DM; k0 += 32) { const bf16x8 a = *(const bf16x8*)(ap + k0); ag = MFMA16(a, *(const bf16x8*)(gp + k0), ag); au = MFMA16(a, *(const bf16x8*)(up + k0), au); }
#pragma unroll
        for (int i = 0; i < 4; ++i) { const int r = rt * 16 + 4 * (F.lane >> 4) + i; const f32x4* sp = (const f32x4*)(SS + (size_t)MMAIN * 16 + (size_t)r * 64); f32x4 s4 = sp[0];
#pragma unroll
            for (int q = 1; q < 16; ++q) s4 += sp[q];
            const float rs = 1.0f / sqrtf(((s4[0] + s4[1]) + (s4[2] + s4[3])) * (1.f / DM) + EPS);
            ACT[(size_t)(RP + r) * DFF + lc] = f2bf(silu_f(rs * ag[i]) * (rs * au[i])); }
    }
}
__device__ __forceinline__ void p10_down(Frame& F) {
    const bf16* ACT = (const bf16*)(F.ws + WS_ACT); const bf16* WDN = (const bf16*)(F.ws + WS_WDN); const float* HS = (const float*)(F.ws + WS_HS);
    { pg8::Gemm g{ACT, WDN, MMAIN, DM, DFF, 1}; pg8::StaticOrder S; S.init(MMAIN, DM, F.G, (int)blockIdx.x); EpiDown E{(const bf16*)(F.ws + WS_XN), F.out + OUT_YP};
      pg8::gemm_phase<EpiDown, pg8::StaticOrder, true, true>(F.lds + RING_OFF, g, S, E); }
    float* ys = F.out + OUT_YS;
    small_gemm(ACT, DFF, WDN, DFF, DB / 16, DM / 16, [](int r) { return RP + r; },
        [&](const f32x4& acc, int rt, int ct, int lane) { const int col = ct * 16 + (lane & 15);
#pragma unroll
            for (int i = 0; i < 4; ++i) { const size_t o = (size_t)(rt * 16 + 4 * (lane >> 4) + i) * DM + col; ys[o] = HS[o] + acc[i]; } }, F.gw, F.NGW, F.lane);
}
#ifndef MK_ONE_LAUNCH
#define MK_ONE_LAUNCH 0
#endif
constexpr int N_PHASES = 10;
__global__ void __launch_bounds__(NTHR, 2) mk_fwd(Args args) {
    extern __shared__ __attribute__((aligned(16))) unsigned char lds_raw[];
    Frame F;
    F.lds = (LAS unsigned char*)lds_raw;
    F.tid = threadIdx.x; F.lane = F.tid & 63; F.wave = __builtin_amdgcn_readfirstlane(F.tid >> 6);
    F.G = gridDim.x; { const int bx = blockIdx.x; F.vcu = (F.G % 8 == 0) ? (bx % 8) * (F.G / 8) + bx / 8 : bx; }
    F.gw = blockIdx.x * NWAVES + F.wave; F.NGW = F.G * NWAVES;
    F.ws = args.ws; F.out = args.out; F.in = args.in;
    volatile LAS unsigned* MISC = (volatile LAS unsigned*)(F.lds + MISC_OFF);
    for (int u = F.tid; u < (LDS_BYTES - LDSCTL_OFF) / 4; u += NTHR) ((LAS unsigned*)(F.lds + LDSCTL_OFF))[u] = 0u;
    __syncthreads();
    XcdBarrier bar; bar.bar = (unsigned*)(F.ws + WS_CTL) + CW_BAR; bar.x = 0; bar.st = nullptr;
    if (MK_ONE_LAUNCH) bar = xcd_barrier_post((unsigned*)(F.ws + WS_CTL) + CW_BAR, MISC + 8);
    const int lo = args.ph_lo, hi = args.ph_hi;
#ifdef MK_TS
    unsigned long long* TSB = (unsigned long long*)(F.ws + 600 * MiB); int tsn = 0;
#define STAMP() do { if (blockIdx.x == 0 && F.tid == 0) TSB[tsn] = __builtin_amdgcn_s_memrealtime(); ++tsn; } while (0)
    STAMP();
#else
#define STAMP() do { } while (0)
#endif
#define IN(k) (lo <= (k) && (k) < hi)
#define SEAM(k) do { if (IN(k) && IN((k) + 1)) xcd_barrier(bar); STAMP(); } while (0)
#ifndef MK_REPEAT
#define MK_REPEAT 0
#endif
#define REP(id, stmt) do { stmt; if (MK_REPEAT & (1 << (id))) { __syncthreads(); stmt; } } while (0)
    if (IN(0)) { REP(0, p0_prologue(F)); } SEAM(0);
    if (IN(1)) { REP(1, p1_inproj(F)); } SEAM(1);
    if (IN(2)) {
#ifdef MK_SLEEP_PROBE
        { const unsigned long long t0 = __builtin_amdgcn_s_memrealtime(); while (__builtin_amdgcn_s_memrealtime() - t0 < 3000ull) __builtin_amdgcn_s_sleep(32); }
#endif
        REP(2, p2_elementwise(F)); } SEAM(2);
    if (IN(3)) { REP(3, p3_upproj_states(F)); } SEAM(3);
    if (IN(4)) { REP(4, p4_post(F)); } SEAM(4);
    if (IN(5)) { const float M0 = softmax_ref(F); REP(5, p5_attn_prompt(F, M0)); __syncthreads(); REP(6, p5_ssd_out(F)); __syncthreads(); REP(7, p5_attn_decode(F, M0));
#ifdef MK_DA_PROBE
        __syncthreads(); p5_attn_decode_t<MK_DA_PROBE>(F, M0);
#endif
    } SEAM(5);
    if (IN(6)) { const float M0 = softmax_ref(F); REP(8, p6_decode_combine(F, M0)); } SEAM(6);
    if (IN(7)) { REP(9, p7_outproj(F)); } SEAM(7);
    if (IN(8)) { REP(11, p9_gateup(F)); } SEAM(8);
    if (IN(9)) { p10_down(F); }
#ifdef MK_TS
    __syncthreads(); STAMP();
#endif
#undef IN
#undef SEAM
}
template <class FA, class FB>
__global__ void k_cmp(int slot, float* diag, size_t n, FA fa, FB fb) {
    float e = 0.f, r = 0.f;
    for (size_t i = (size_t)blockIdx.x * blockDim.x + threadIdx.x; i < n; i += (size_t)gridDim.x * blockDim.x) { const float a = fa(i), b = fb(i); const float d = a - b; e += d * d; r += b * b; }
    e = wave_sum(e); r = wave_sum(r);
    if ((threadIdx.x & 63) == 0) { atomicAdd(diag + 2 * slot, e); atomicAdd(diag + 2 * slot + 1, r); }
}
template <class FA, class FB> inline void cmp(hipStream_t s, int slot, float* diag, size_t n, FA fa, FB fb) { k_cmp<<<2048, 256, 0, s>>>(slot, diag, n, fa, fb); }
__global__ void k_diag_encode(const float* diag, int nslots, float tol, float* out) {
    __shared__ float sv;
    if (threadIdx.x == 0) { float v = 0.f;
        for (int k = 0; k < nslots; ++k) { const float e = diag[2 * k], r = diag[2 * k + 1]; int d2 = -1;
            if (!(e == e) || !(r == r)) d2 = 9; else if (r <= 0.f) d2 = 8; else { const float q = e / r; if (q > tol) { d2 = (int)floorf(-log10f(q)); d2 = d2 < 0 ? 0 : d2 > 7 ? 7 : d2; } }
            if (d2 >= 0) { v = 0.1f * (float)(k + 1) + 0.01f * (float)d2; break; } }
        sv = v; }
    __syncthreads();
    const float v = sv; if (v == 0.f) return;
    const float f = 1.f + sqrtf(v);
    for (int i = blockIdx.x * blockDim.x + threadIdx.x; i < 131072; i += gridDim.x * blockDim.x) out[OUT_YS + i] *= f;
}
#ifndef MK_DIAG
#define MK_DIAG 0
#endif
__device__ __forceinline__ size_t nmrow(size_t r) { return r < (size_t)MMAIN ? (r >> 11) * TT + NMETA + (r & 2047) : (size_t)RP + (r - MMAIN); }
constexpr size_t WS_OUT2 = 1024 * MiB;
#ifdef MK_TS
__global__ void k_ts_encode(const unsigned long long* ts, float* out, int ia, int ib) {
    const float ta = (float)(ts[ia + 1] - ts[ia]) * 0.01f, tb = (float)(ts[ib + 1] - ts[ib]) * 0.01f;
    const float f = 1.f + sqrtf(ta * 1e-3f);
    for (int i = blockIdx.x * blockDim.x + threadIdx.x; i < 131072; i += gridDim.x * blockDim.x) out[OUT_YS + i] *= f;
    if (blockIdx.x == 0 && threadIdx.x == 0) out[0] += tb * 0.1f;
}
#endif
extern "C" void kernel_launch(void* const* d_in, const int* in_sizes, int n_in, void* d_out, int out_size, void* d_ws, size_t ws_size, hipStream_t stream) {
    (void)hipFuncSetAttribute((const void*)mk_fwd, hipFuncAttributeMaxDynamicSharedMemorySize, LDS_BYTES);
    unsigned char* ws = (unsigned char*)d_ws;
    (void)hipMemsetAsync(ws + WS_CTL, 0, CTL_ZERO_BYTES, stream);
    Args a{};
    for (int i = 0; i < 30; ++i) a.in[i] = d_in[i];
    a.ws = ws; a.out = (float*)d_out;
#if MK_DIAG
    float* diag = (float*)(ws + WS_DIAG);
    (void)hipMemsetAsync(diag, 0, 512, stream);
    nv::forward(d_in, (float*)d_out, (float*)(ws + WS_NAIVE), stream);
    a.out = (float*)(ws + WS_OUT2);
#endif
    const int grid = 256;
#if MK_ONE_LAUNCH
    a.ph_lo = 0; a.ph_hi = N_PHASES; a.li = 0;
    hipLaunchKernelGGL(mk_fwd, dim3(grid), dim3(NTHR), LDS_BYTES, stream, a);
#else
    for (int ph = 0; ph < N_PHASES; ++ph) { a.ph_lo = ph; a.ph_hi = ph + 1; a.li = ph; hipLaunchKernelGGL(mk_fwd, dim3(grid), dim3(NTHR), LDS_BYTES, stream, a); }
#endif
#ifdef MK_TS
    k_ts_encode<<<64, 256, 0, stream>>>((const unsigned long long*)(ws + 600 * MiB), (float*)d_out, MK_TS_A, MK_TS_B);
#endif
#if MK_DIAG
    {
        nv::Ws w = nv::carve((float*)(ws + WS_NAIVE));
        const bf16* QRAW = (const bf16*)(ws + WS_QRAW); const bf16* KVRAW = (const bf16*)(ws + WS_KVRAW); const bf16* Q = (const bf16*)(ws + WS_Q); const bf16* K = (const bf16*)(ws + WS_K);
        const bf16* VT = (const bf16*)(ws + WS_VT); const float* VS = (const float*)(ws + WS_VS); const bf16* MIX = (const bf16*)(ws + WS_MIX);
        const float* o2 = (const float*)(ws + WS_OUT2); const float* o1 = (const float*)d_out;
        const float* nQRAW = w.QRAW; const float* nKV = w.KV; const float* nQ = w.Q; const float* nK = w.K; const float* nV = w.V; const float* nMIX = w.MIX;
        const size_t NMR = (size_t)MMAIN + DB;
        cmp(stream, 0, diag, NMR * 768, [=] __device__(size_t i) { return bf2f(QRAW[nmrow(i / 768) * 768 + i % 768]); }, [=] __device__(size_t i) { return nQRAW[nmrow(i / 768) * 768 + i % 768]; });
        cmp(stream, 1, diag, (size_t)R * 1024, [=] __device__(size_t i) { return bf2f(KVRAW[i]); }, [=] __device__(size_t i) { return nKV[i]; });
        cmp(stream, 2, diag, NMR * 768, [=] __device__(size_t i) { return bf2f(Q[nmrow(i / 768) * 768 + i % 768]); }, [=] __device__(size_t i) { return nQ[nmrow(i / 768) * 768 + i % 768] * (ATTN_SCALE * LOG2E); });
        cmp(stream, 3, diag, (size_t)R * 768, [=] __device__(size_t i) { return bf2f(K[i]); }, [=] __device__(size_t i) { return nK[i]; });
        cmp(stream, 4, diag, (size_t)NB * 512 * TT, [=] __device__(size_t i) { const size_t bhd = i / TT; const int t = (int)(i % TT); return bf2f(VT[bhd * TPAD + t]); },
            [=] __device__(size_t i) { const size_t bhd = i / TT; const int t = (int)(i % TT); const size_t b = bhd / 512, hd = bhd % 512; return nV[(b * TT + t) * 512 + hd]; });
        cmp(stream, 4, diag, (size_t)DB * 512, [=] __device__(size_t i) { return VS[i]; }, [=] __device__(size_t i) { return nV[(size_t)RP * 512 + i]; });
        cmp(stream, 5, diag, (size_t)(OUT_LATS - OUT_SSMP), [=] __device__(size_t i) { return o2[OUT_SSMP + i]; }, [=] __device__(size_t i) { return o1[OUT_SSMP + i]; });
        cmp(stream, 5, diag, (size_t)4194304, [=] __device__(size_t i) { return o2[OUT_SSMS + i]; }, [=] __device__(size_t i) { return o1[OUT_SSMS + i]; });
        cmp(stream, 6, diag, (size_t)R * 512, [=] __device__(size_t i) { return bf2f(MIX[(i >> 9) * 1024 + (i & 511)]); }, [=] __device__(size_t i) { return nMIX[(i >> 9) * 1024 + (i & 511)]; });
        cmp(stream, 7, diag, NMR * 512, [=] __device__(size_t i) { return bf2f(MIX[nmrow(i >> 9) * 1024 + 512 + (i & 511)]); }, [=] __device__(size_t i) { return nMIX[nmrow(i >> 9) * 1024 + 512 + (i & 511)]; });
        cmp(stream, 8, diag, (size_t)OUT_LATP, [=] __device__(size_t i) { return o2[i]; }, [=] __device__(size_t i) { return o1[i]; });
        k_diag_encode<<<64, 256, 0, stream>>>(diag, 9, 1e-3f, (float*)d_out);
    }
#endif
}
```

```cpp
#define MK_DIAG 0
#define MK_ONE_LAUNCH 1
#include <hip/hip_runtime.h>
#include <cstdio>
#include <cstdint>
namespace pg8 {
#define PG8_LAS __attribute__((address_space(3)))
typedef unsigned short bf16_t;
typedef short bf16x8 __attribute__((ext_vector_type(8)));
typedef float f32x4 __attribute__((ext_vector_type(4)));
typedef unsigned u32x4 __attribute__((ext_vector_type(4)));
constexpr int BM = 256, BK = 64, HALF = 128, HTB = HALF * BK * 2  , STAGE_BYTES = 8 * HTB, NXCD = 8, WGM = 8;

__host__ __device__ __forceinline__ int lds_byte(int r, int c) { const int st = (r >> 4) * 2 + (c >> 5), rr = r & 15, cc = c & 31, ob = rr * 64 + cc * 2; return st * 1024 + (ob ^ (((ob >> 9) & 1) << 5)); }
__host__ __device__ __forceinline__ void stage_rc(int b, int& R, int& C) { const int st = b / 1024, sb = b % 1024, swz = sb ^ (((sb >> 9) & 1) << 5); R = (st >> 1) * 16 + swz / 64; C = (st & 1) * 32 + (swz % 64) / 2; }
__host__ __device__ __forceinline__ int perm32(int rho) { const int n = rho >> 4, i = rho & 15; return 8 * (i >> 2) + 4 * n + (i & 3); }

struct Unit { int pm, pn; };
struct Gemm { const bf16_t* A; const bf16_t* Bt; int M, N, K; int rmode;
    __host__ __device__ __forceinline__ int rowbase(int pm) const { return rmode ? (pm >> 3) * 2064 + 16 + (pm & 7) * 256 : pm * 256; } };

struct StaticOrder {
    int nM, nN, nwg, G, c;
    __host__ __device__ void init(int M, int N, int G_, int c_) { nM = M / BM; nN = N / BM; nwg = nM * nN; G = G_; c = c_; }
    __host__ __device__ bool next(int i, Unit& u) const {
        const long L = (long)i * G + c; if (L >= nwg) return false;
        int wgid = (int)L; { const int q = nwg / NXCD, r = nwg % NXCD, xcd = wgid % NXCD, off = wgid / NXCD; wgid = (xcd < r ? xcd * (q + 1) : r * (q + 1) + (xcd - r) * q) + off; }
        const int nig = WGM * nN, gid = wgid / nig, fm = gid * WGM, gsz = (nM - fm) < WGM ? (nM - fm) : WGM;
        u.pm = fm + ((wgid % nig) % gsz); u.pn = (wgid % nig) / gsz; return true;
    }
    __device__ __forceinline__ void a_ready(const Unit&) const {}
    __device__ __forceinline__ void done(const Unit&) const {}
};


template <class Epi, class Sched, bool ALIGN_EPI = false, bool SP2 = false>
__device__ __forceinline__ void gemm_phase(PG8_LAS unsigned char* lds, const Gemm g, const Sched& S, const Epi& E) {
    const int tid = threadIdx.x, wid = __builtin_amdgcn_readfirstlane(tid >> 6), lane = tid & 63, wr = wid >> 2, wc = wid & 3, fr = lane & 15, fq = lane >> 4;
    const int K = g.K, nt = K / BK;
    unsigned voffA[2], voffB[2];
#pragma unroll
    for (int i = 0; i < 2; ++i) { int R, C; stage_rc(tid * 16 + i * 8192, R, C); const int Rb = Epi::PERM ? ((R & ~31) + perm32(R & 31)) : R;
        voffA[i] = (unsigned)(R * K + C) * 2u; voffB[i] = (unsigned)(Rb * K + C) * 2u; }
    const size_t kstep = (size_t)(BK * 2);
    const size_t hstep = (size_t)HALF * K * 2;
    const size_t tstep = 2 * hstep;
    const unsigned ldsw = (unsigned)wid * 1024u;
    const int aoff = lds_byte(wr * 64 + fr, fq * 8), boff = lds_byte(wc * 32 + fr, fq * 8);
#define PG8_SA(b, h) (((b) * 2 + (h)) * HTB)
#define PG8_SB(b, h) ((4 + (b) * 2 + (h)) * HTB)
#define PG8_STAGE(bufoff, gbase, voff) do { _Pragma("unroll") for (int _i = 0; _i < 2; ++_i) \
        __builtin_amdgcn_global_load_lds((const unsigned*)((const char*)(gbase) + (voff)[_i]), (PG8_LAS unsigned*)(lds + (bufoff) + ldsw + _i * 8192), 16, 0, 0); } while (0)
#define PG8_LDA(dst, b, h) do { _Pragma("unroll") for (int m = 0; m < 4; ++m) _Pragma("unroll") for (int k = 0; k < 2; ++k) dst[m][k] = *(const PG8_LAS bf16x8*)(lds + PG8_SA(b, h) + aoff + m * 2048 + k * 1024); } while (0)
#define PG8_LDB(dst, b, h) do { _Pragma("unroll") for (int n = 0; n < 2; ++n) _Pragma("unroll") for (int k = 0; k < 2; ++k) dst[n][k] = *(const PG8_LAS bf16x8*)(lds + PG8_SB(b, h) + boff + n * 2048 + k * 1024); } while (0)
#define PG8_MMA(ai, bj, At, Bt) do { __builtin_amdgcn_s_setprio(1); _Pragma("unroll") for (int m = 0; m < 4; ++m) _Pragma("unroll") for (int n = 0; n < 2; ++n) _Pragma("unroll") for (int k = 0; k < 2; ++k) \
        acc[ai][bj][m][n] = __builtin_amdgcn_mfma_f32_16x16x32_bf16(Bt[n][k], At[m][k], acc[ai][bj][m][n], 0, 0, 0); __builtin_amdgcn_s_setprio(0); } while (0)
#define PG8_WAIT_V(n) asm volatile("s_waitcnt vmcnt(" #n ")" ::: "memory")
#define PG8_WAIT_L(n) asm volatile("s_waitcnt lgkmcnt(" #n ")" ::: "memory")
#define PG8_BAR __builtin_amdgcn_s_barrier()
#define PG8_SCHED __builtin_amdgcn_sched_barrier(0)
    Unit cur, nxt; int ui = 0;
    if (!S.next(0, cur)) return;
    f32x4 acc[2][2][4][2];
#pragma unroll
    for (int a = 0; a < 2; ++a)
#pragma unroll
        for (int b = 0; b < 2; ++b)
#pragma unroll
            for (int m = 0; m < 4; ++m)
#pragma unroll
                for (int n = 0; n < 2; ++n) acc[a][b][m][n] = (f32x4){0.f, 0.f, 0.f, 0.f};
    bf16x8 At[4][2], B0[2][2], B1[2][2];
    const char* cA = (const char*)g.A + (size_t)g.rowbase(cur.pm) * K * 2; const char* cB = (const char*)g.Bt + (size_t)cur.pn * tstep;
    S.a_ready(cur);
    if constexpr (SP2) {
        PG8_STAGE(PG8_SB(0, 0), cB, voffB); PG8_STAGE(PG8_SB(0, 1), cB + hstep, voffB); PG8_STAGE(PG8_SA(0, 0), cA, voffA); PG8_STAGE(PG8_SA(0, 1), cA + hstep, voffA);
        if (wr == 1) PG8_BAR;
        PG8_WAIT_V(2); PG8_BAR;
        PG8_STAGE(PG8_SB(1, 0), cB + kstep, voffB); PG8_STAGE(PG8_SA(1, 0), cA + kstep, voffA); PG8_STAGE(PG8_SB(1, 1), cB + hstep + kstep, voffB);
        PG8_WAIT_V(6); PG8_BAR;
    } else {
        PG8_STAGE(PG8_SB(0, 0), cB, voffB); PG8_STAGE(PG8_SA(0, 0), cA, voffA); PG8_STAGE(PG8_SB(0, 1), cB + hstep, voffB); PG8_STAGE(PG8_SA(0, 1), cA + hstep, voffA);
        if (wr == 1) PG8_BAR;
        PG8_WAIT_V(4); PG8_BAR;
        PG8_STAGE(PG8_SB(1, 0), cB + kstep, voffB); PG8_STAGE(PG8_SA(1, 0), cA + kstep, voffA); PG8_STAGE(PG8_SB(1, 1), cB + hstep + kstep, voffB);
        PG8_WAIT_V(6); PG8_BAR;
    }
    for (;;) {
        const bool has_next = S.next(ui + 1, nxt);
        const char* nA = has_next ? (const char*)g.A + (size_t)g.rowbase(nxt.pm) * K * 2 : cA; const char* nB = has_next ? (const char*)g.Bt + (size_t)nxt.pn * tstep : cB;
        for (int t = 0; t < nt; t += 2) {
            const bool last = (t == nt - 2);
            const char* a1 = cA + (size_t)(t + 1) * kstep;
            const char* a2 = last ? nA : cA + (size_t)(t + 2) * kstep; const char* b2 = last ? nB : cB + (size_t)(t + 2) * kstep;
            const char* a3 = a2 + kstep; const char* b3 = b2 + kstep;
            if (last && has_next) S.a_ready(nxt);
            if constexpr (SP2) {
            PG8_LDB(B0, 0, 0); PG8_LDB(B1, 0, 1); PG8_SCHED; PG8_LDA(At, 0, 0); PG8_STAGE(PG8_SA(1, 1), a1 + hstep, voffA);
            PG8_WAIT_V(8); PG8_WAIT_L(0); PG8_BAR; PG8_MMA(0, 0, At, B0); PG8_MMA(0, 1, At, B1); PG8_BAR; PG8_SCHED;
            PG8_LDA(At, 0, 1); PG8_STAGE(PG8_SB(0, 0), b2, voffB); PG8_STAGE(PG8_SB(0, 1), b2 + hstep, voffB); PG8_STAGE(PG8_SA(0, 0), a2, voffA);
            PG8_WAIT_V(8); PG8_WAIT_L(0); PG8_BAR; PG8_MMA(1, 0, At, B0); PG8_MMA(1, 1, At, B1); PG8_BAR; PG8_SCHED;
            PG8_LDB(B0, 1, 0); PG8_LDB(B1, 1, 1); PG8_SCHED; PG8_LDA(At, 1, 0); PG8_STAGE(PG8_SA(0, 1), a2 + hstep, voffA);
            PG8_WAIT_V(8); PG8_WAIT_L(0); PG8_BAR; PG8_MMA(0, 0, At, B0); PG8_MMA(0, 1, At, B1); PG8_BAR; PG8_SCHED;
            PG8_LDA(At, 1, 1); PG8_STAGE(PG8_SB(1, 0), b3, voffB); PG8_STAGE(PG8_SB(1, 1), b3 + hstep, voffB); PG8_STAGE(PG8_SA(1, 0), a3, voffA);
            PG8_WAIT_V(8); PG8_WAIT_L(0); PG8_BAR; PG8_MMA(1, 0, At, B0); PG8_MMA(1, 1, At, B1); PG8_BAR; PG8_SCHED;
            } else {
            PG8_LDB(B0, 0, 0); PG8_SCHED; PG8_LDA(At, 0, 0); PG8_STAGE(PG8_SA(1, 1), a1 + hstep, voffA);
            PG8_WAIT_L(8); PG8_BAR; PG8_WAIT_L(0); PG8_MMA(0, 0, At, B0); PG8_BAR; PG8_SCHED;
            PG8_LDB(B1, 0, 1); PG8_STAGE(PG8_SB(0, 0), b2, voffB);
            PG8_BAR; PG8_WAIT_L(0); PG8_MMA(0, 1, At, B1); PG8_BAR;
            PG8_LDA(At, 0, 1); PG8_STAGE(PG8_SA(0, 0), a2, voffA);
            PG8_BAR; PG8_WAIT_L(0); PG8_MMA(1, 0, At, B0); PG8_BAR; PG8_SCHED;
            PG8_STAGE(PG8_SB(0, 1), b2 + hstep, voffB);
            PG8_WAIT_V(6); PG8_BAR; PG8_MMA(1, 1, At, B1); PG8_BAR;
            PG8_LDB(B0, 1, 0); PG8_SCHED; PG8_LDA(At, 1, 0); PG8_STAGE(PG8_SA(0, 1), a2 + hstep, voffA);
            PG8_WAIT_L(8); PG8_BAR; PG8_WAIT_L(0); PG8_MMA(0, 0, At, B0); PG8_BAR; PG8_SCHED;
            PG8_LDB(B1, 1, 1); PG8_STAGE(PG8_SB(1, 0), b3, voffB);
            PG8_BAR; PG8_WAIT_L(0); PG8_MMA(0, 1, At, B1); PG8_BAR;
            PG8_LDA(At, 1, 1); PG8_STAGE(PG8_SA(1, 0), a3, voffA);
            PG8_BAR; PG8_WAIT_L(0); PG8_MMA(1, 0, At, B0); PG8_BAR; PG8_SCHED;
            PG8_STAGE(PG8_SB(1, 1), b3 + hstep, voffB);
            PG8_WAIT_V(6); PG8_BAR; PG8_MMA(1, 1, At, B1); PG8_BAR;
            }
        }
        if constexpr (ALIGN_EPI) { if (wr == 0) PG8_BAR; }
        if constexpr (!Epi::AFTER_DRAIN) { E(acc, cur, wr, wc, fr, fq); S.done(cur); }
        if (!has_next) break;
#pragma unroll
        for (int a = 0; a < 2; ++a)
#pragma unroll
            for (int b = 0; b < 2; ++b)
#pragma unroll
                for (int m = 0; m < 4; ++m)
#pragma unroll
                    for (int n = 0; n < 2; ++n) acc[a][b][m][n] = (f32x4){0.f, 0.f, 0.f, 0.f};
        cur = nxt; cA = nA; cB = nB; ++ui;
        if constexpr (ALIGN_EPI) { if (wr == 1) PG8_BAR; }
    }
    PG8_WAIT_V(0);
    if constexpr (!ALIGN_EPI) { if (wr == 0) PG8_BAR; }
    PG8_BAR;
    if constexpr (Epi::AFTER_DRAIN) { E.fused(acc, cur, wr, wc, fr, fq, lds, wid, lane); S.done(cur); }
#undef PG8_SA
#undef PG8_SB
#undef PG8_STAGE
#undef PG8_LDA
#undef PG8_LDB
#undef PG8_MMA
#undef PG8_WAIT_V
#undef PG8_WAIT_L
#undef PG8_BAR
#undef PG8_SCHED
}
}

#define GAS __attribute__((address_space(1)))
#define LAS __attribute__((address_space(3)))
typedef unsigned short bf16;
typedef unsigned v4u __attribute__((ext_vector_type(4)));
typedef unsigned v2u __attribute__((ext_vector_type(2)));
typedef float f32x4 __attribute__((ext_vector_type(4)));
typedef float f32x16 __attribute__((ext_vector_type(16)));
typedef short bf16x8 __attribute__((ext_vector_type(8)));
typedef short s16x4 __attribute__((ext_vector_type(4)));
typedef GAS unsigned gu32;
#define RLX_AGENT __ATOMIC_RELAXED, __HIP_MEMORY_SCOPE_AGENT
#define LDS_WAIT() asm volatile("s_waitcnt lgkmcnt(0)" ::: "memory")
#define VM_WAIT() asm volatile("s_waitcnt vmcnt(0)" ::: "memory")
typedef float f32x2_t __attribute__((ext_vector_type(2))); typedef __bf16 bf16x2_t __attribute__((ext_vector_type(2)));
__device__ __forceinline__ unsigned pk2(float lo, float hi) { f32x2_t v = {lo, hi}; bf16x2_t b = __builtin_convertvector(v, bf16x2_t); return __builtin_bit_cast(unsigned, b); }
__device__ __forceinline__ bf16 f2bf(float f) { return (bf16)(pk2(f, 0.f) & 0xffffu); }
__device__ __forceinline__ float bf2f(bf16 v) { return __uint_as_float((unsigned)v << 16); }
__device__ __forceinline__ float bflo(unsigned w) { return __uint_as_float(w << 16); }
__device__ __forceinline__ float bfhi(unsigned w) { return __uint_as_float(w & 0xffff0000u); }

#define XB_TMO      128
#define XB_XCNT(j)  (256  + 64 * (j))
#define XB_XSUB(j)  (1280 + 64 * (j))
#define XB_XGEN(j)  (2304 + 64 * (j))
#define XB_TOP      3328
#define XB_TOPGEN   3392
#define XCD_BAR_WORDS 3456
#define XB_SPIN_CAP (1u << 18)
__device__ __forceinline__ unsigned xb_ld(unsigned* p)              { return __hip_atomic_load(p, __ATOMIC_RELAXED, __HIP_MEMORY_SCOPE_AGENT); }
__device__ __forceinline__ unsigned xb_add(unsigned* p, unsigned v) { return __hip_atomic_fetch_add(p, v, __ATOMIC_RELAXED, __HIP_MEMORY_SCOPE_AGENT); }
__device__ __forceinline__ unsigned xb_xcc_id() { return (unsigned)__builtin_amdgcn_s_getreg((3 << 11) | 20) & 0xFu; }
#define XB_SPIN(cond, bar) do { unsigned _sp = 0; while (cond) { __builtin_amdgcn_s_sleep(1); \
    if ((++_sp & 255u) == 0u) { if (xb_ld(&(bar)[XB_TMO])) break; if (_sp > XB_SPIN_CAP) { atomicAdd(&(bar)[XB_TMO], 1u); break; } } } } while (0)
struct XcdBarrier { unsigned* bar; unsigned x; volatile LAS unsigned* st; };
__device__ __forceinline__ XcdBarrier xcd_barrier_post(unsigned* bar, volatile LAS unsigned* st) {
    XcdBarrier b; b.bar = bar; b.x = xb_xcc_id(); b.st = st;
    if (threadIdx.x == 0) (void)xb_add(&bar[XB_XCNT(b.x)], 1u);
    return b;
}
__device__ __forceinline__ void xcd_barrier_complete(unsigned* bar, unsigned x, unsigned& nloc, unsigned& nx) {
    const unsigned G = gridDim.x * gridDim.y * gridDim.z;
    unsigned sum, cnt, mine, sp = 0u;
    for (;;) {
        sum = 0u; cnt = 0u; mine = 0u;
#pragma unroll
        for (unsigned j = 0; j < 16; ++j) { const unsigned c = xb_ld(&bar[XB_XCNT(j)]); sum += c; cnt += (c > 0u) ? 1u : 0u; mine = (j == x) ? c : mine; }
        if (sum == G) break;
        __builtin_amdgcn_s_sleep(1);
        if ((++sp & 255u) == 0u) { if (xb_ld(&bar[XB_TMO])) break; if (sp > XB_SPIN_CAP) { atomicAdd(&bar[XB_TMO], 1u); break; } }
    }
    nloc = mine > 0u ? mine : 1u; nx = cnt > 0u ? cnt : 1u;
}
__device__ __forceinline__ void xcd_barrier(const XcdBarrier& b) {
    asm volatile("s_waitcnt vmcnt(0)" ::: "memory");
    __syncthreads();
    if (threadIdx.x == 0) {
        unsigned* bar = b.bar;
        __builtin_amdgcn_s_waitcnt(0);
        unsigned nloc = b.st[0], nx = b.st[1];
        if (nloc == 0u) { xcd_barrier_complete(bar, b.x, nloc, nx); b.st[0] = nloc; b.st[1] = nx; }
        const unsigned old = xb_add(&bar[XB_XSUB(b.x)], 1u);
        const unsigned gen = old / nloc;
        if (old + 1u == (gen + 1u) * nloc) {
            __builtin_amdgcn_fence(__ATOMIC_RELEASE, "agent");
            asm volatile("s_waitcnt vmcnt(0)" ::: "memory");
            const unsigned og = xb_add(&bar[XB_TOP], 1u);
            const unsigned tg = og / nx;
            if (og + 1u == (tg + 1u) * nx) xb_add(&bar[XB_TOPGEN], 1u);
            else XB_SPIN(xb_ld(&bar[XB_TOPGEN]) == tg, bar);
            __builtin_amdgcn_fence(__ATOMIC_ACQUIRE, "agent");
            xb_add(&bar[XB_XGEN(b.x)], 1u);
            asm volatile("s_waitcnt vmcnt(0)" ::: "memory");
        } else {
            XB_SPIN(xb_ld(&bar[XB_XGEN(b.x)]) == gen, bar);
            __builtin_amdgcn_fence(__ATOMIC_ACQUIRE, "agent");
            asm volatile("s_waitcnt vmcnt(0)" ::: "memory");
        }
    }
    __syncthreads();
}

constexpr int DM = 1024, NB = 8, SEQ = 2048, NMETA = 16, TT = SEQ + NMETA;
constexpr int DB = 128, PAST = 8192, PAGE = 128, NPAGES = 64;
constexpr int NH = 8, HP = 64, SSDW = 512, NG = 2, DS = 64, CONVD = 768;
constexpr int QKD = 96, VD = 64, MLAW = 512, QL = 384, KVL = 256, DFF = 2816, INC = 1960;
constexpr int RP = NB * TT, R = RP + DB;
constexpr int MMAIN = NB * SEQ;
constexpr int NS = NMETA + DB;
constexpr float EPS = 1e-6f, ATTN_SCALE = 0.10206207261596577f, LOG2E = 1.4426950408889634f;
constexpr int PJ = 2048, C_Z = 0, C_XBC = 512, C_CKV = 1280, C_CQ = 1536, C_DT = 1920, C_KR = 1928;
constexpr int S_Z = 0, S_XBC = 512, S_DT = 1280, S_CQ = 1288, S_CKV = 1672, S_KR = 1928;
constexpr int TPAD = 2112;
constexpr int NCH = 33, CHL = 64, TOFF = 48;
constexpr size_t OUT_YP = 0, OUT_YS = 16777216, OUT_LATP = 16908288, OUT_KRP = 21135360, OUT_CONVP = 21663744,
                 OUT_SSMP = 21682176, OUT_LATS = 21944320, OUT_KRS = 21977088, OUT_CONVS = 21981184, OUT_SSMS = 22276096;

constexpr size_t MiB = 1u << 20;
constexpr size_t WS_CTL = 0, CTL_ZERO_BYTES = 32 * 1024;
constexpr int CW_BAR = 4096;
constexpr size_t WS_SS = 512 * 1024;
constexpr size_t WS_WIN = 2 * MiB;
constexpr size_t WS_WUQ = 6 * MiB;
constexpr size_t WS_WUKV = 7 * MiB;
constexpr size_t WS_WOUT = 8 * MiB;
constexpr size_t WS_WGU = 10 * MiB;
constexpr size_t WS_WDN = 22 * MiB;
constexpr size_t WS_XN = 32 * MiB;
constexpr size_t WS_PROJ = 66 * MiB;
constexpr size_t WS_DTRAW = 132 * MiB;
constexpr size_t WS_DT = 133 * MiB;
constexpr size_t WS_LAT = 134 * MiB;
constexpr size_t WS_CQN = 143 * MiB;
constexpr size_t WS_KRF = 156 * MiB;
constexpr size_t WS_XST = 159 * MiB;
constexpr size_t WS_BT = 176 * MiB;
constexpr size_t WS_BC = 181 * MiB;
constexpr size_t WS_XAS = 190 * MiB;
constexpr size_t WS_QRAW = 191 * MiB;
constexpr size_t WS_KVRAW = 216 * MiB;
constexpr size_t WS_Q = 249 * MiB;
constexpr size_t WS_K = 274 * MiB;
constexpr size_t WS_VT = 299 * MiB;
constexpr size_t WS_STATES = 316 * MiB;
constexpr size_t WS_DECAY = 350 * MiB;
constexpr size_t WS_HIN = 351 * MiB;
constexpr size_t WS_MIX = 368 * MiB;
constexpr size_t WS_ACT = 401 * MiB;
constexpr size_t WS_VS = 491 * MiB;
constexpr size_t WS_DPART = 492 * MiB;
constexpr size_t WS_HS = 494 * MiB;
constexpr size_t WS_ROPE = 496 * MiB;
constexpr size_t WS_SSP = 520 * MiB;
constexpr size_t WS_OPT_END = 522 * MiB;
constexpr size_t WS_NAIVE = 2048 * MiB;
constexpr size_t WS_DIAG = 1 * MiB;

constexpr int RING_OFF = 0, RING_BYTES = 131072;
constexpr int LDSCTL_OFF = RING_BYTES, MISC_OFF = LDSCTL_OFF + 320;
constexpr int LDS_BYTES = 147456;
constexpr int NWAVES = 8, NTHR = 512;

struct Args { const void* in[30]; float* out; unsigned char* ws; int ph_lo, ph_hi, li, pad; };

struct Frame {
    LAS unsigned char* lds;
    int tid, lane, wave, G, vcu, gw, NGW;
    unsigned char* ws; float* out;
    const void* const* in;
};
__device__ __forceinline__ float wave_sum(float v) {
#pragma unroll
    for (int o = 1; o < 64; o <<= 1) v += __shfl_xor(v, o);
    return v;
}
__device__ __forceinline__ float wave_max(float v) {
#pragma unroll
    for (int o = 1; o < 64; o <<= 1) v = fmaxf(v, __shfl_xor(v, o));
    return v;
}
__device__ __forceinline__ float silu_f(float x) { return x / (1.f + __expf(-x)); }
__device__ __forceinline__ float softplus_f(float x) { return fmaxf(x, 0.f) + log1pf(expf(-fabsf(x))); }
__device__ __forceinline__ float rope_inv(int j) { return exp2f(-(float)j * (13.287712379549449f / 16.0f)); }
struct EpiProj {
    static constexpr bool PERM = true, AFTER_DRAIN = false;
    bf16* O; float* dtraw; int rmode;
    __device__ __forceinline__ void operator()(const pg8::f32x4 (&acc)[2][2][4][2], const pg8::Unit& u, int wr, int wc, int fr, int fq) const {
        const int rb = rmode ? (u.pm >> 3) * 2064 + 16 + (u.pm & 7) * 256 : u.pm * 256;
        const int row0 = rb + wr * 64 + fr, col0 = u.pn * 256 + wc * 32 + 8 * fq;
#pragma unroll
        for (int ai = 0; ai < 2; ++ai)
#pragma unroll
            for (int m = 0; m < 4; ++m) { const int row = row0 + ai * 128 + m * 16; bf16* rowp = O + (size_t)row * PJ + col0;
#pragma unroll
                for (int bj = 0; bj < 2; ++bj) { const pg8::f32x4 v0 = acc[ai][bj][m][0], v1 = acc[ai][bj][m][1];
                    v4u w; w.x = pk2(v0[0], v0[1]); w.y = pk2(v0[2], v0[3]); w.z = pk2(v1[0], v1[1]); w.w = pk2(v1[2], v1[3]);
                    *(v4u*)(rowp + bj * 128) = w; }
                if (u.pn == 7 && wc == 0 && fq == 0) { *(pg8::f32x4*)(dtraw + (size_t)row * 8) = acc[ai][1][m][0]; *(pg8::f32x4*)(dtraw + (size_t)row * 8 + 4) = acc[ai][1][m][1]; } }
    }
};
struct EpiBf16 {
    static constexpr bool PERM = true, AFTER_DRAIN = false;
    bf16* O; int ldc; int rmode;
    __device__ __forceinline__ void operator()(const pg8::f32x4 (&acc)[2][2][4][2], const pg8::Unit& u, int wr, int wc, int fr, int fq) const {
        const int rb = rmode ? (u.pm >> 3) * 2064 + 16 + (u.pm & 7) * 256 : u.pm * 256;
        const int row0 = rb + wr * 64 + fr, col0 = u.pn * 256 + wc * 32 + 8 * fq;
#pragma unroll
        for (int ai = 0; ai < 2; ++ai)
#pragma unroll
            for (int m = 0; m < 4; ++m) { bf16* rowp = O + (size_t)(row0 + ai * 128 + m * 16) * ldc + col0;
#pragma unroll
                for (int bj = 0; bj < 2; ++bj) { const pg8::f32x4 v0 = acc[ai][bj][m][0], v1 = acc[ai][bj][m][1];
                    v4u w; w.x = pk2(v0[0], v0[1]); w.y = pk2(v0[2], v0[3]); w.z = pk2(v1[0], v1[1]); w.w = pk2(v1[2], v1[3]);
                    *(v4u*)(rowp + bj * 128) = w; } }
    }
};
struct EpiResF32 {
    static constexpr bool PERM = false, AFTER_DRAIN = false;
    const float* res; float* out;
    __device__ __forceinline__ void operator()(const pg8::f32x4 (&acc)[2][2][4][2], const pg8::Unit& u, int wr, int wc, int fr, int fq) const {
        const int row0 = u.pm * 256 + wr * 64 + fr, col0 = u.pn * 256 + wc * 32 + 4 * fq;
#pragma unroll
        for (int ai = 0; ai < 2; ++ai)
#pragma unroll
            for (int m = 0; m < 4; ++m) { const size_t off = (size_t)(row0 + ai * 128 + m * 16) * DM + col0;
#pragma unroll
                for (int bj = 0; bj < 2; ++bj)
#pragma unroll
                    for (int n = 0; n < 2; ++n) { const pg8::f32x4 r = *(const pg8::f32x4*)(res + off + bj * 128 + n * 16); *(pg8::f32x4*)(out + off + bj * 128 + n * 16) = r + acc[ai][bj][m][n]; } }
    }
};
struct EpiOutProj {
    static constexpr bool PERM = false, AFTER_DRAIN = false;
    const float* res; float* out; bf16* HB; float* SS;
    __device__ __forceinline__ void operator()(const pg8::f32x4 (&acc)[2][2][4][2], const pg8::Unit& u, int wr, int wc, int fr, int fq) const {
        const int rb = (u.pm >> 3) * 2064 + 16 + (u.pm & 7) * 256;
        const int row0 = u.pm * 256 + wr * 64 + fr, col0 = u.pn * 256 + wc * 32 + 4 * fq;
#pragma unroll
        for (int ai = 0; ai < 2; ++ai)
#pragma unroll
            for (int m = 0; m < 4; ++m) { const int orow = row0 + ai * 128 + m * 16; const size_t off = (size_t)orow * DM + col0; bf16* hb = HB + (size_t)(rb + wr * 64 + fr + ai * 128 + m * 16) * DM + col0; float ss = 0.f;
#pragma unroll
                for (int bj = 0; bj < 2; ++bj)
#pragma unroll
                    for (int n = 0; n < 2; ++n) { const pg8::f32x4 v = *(const pg8::f32x4*)(res + off + bj * 128 + n * 16) + acc[ai][bj][m][n];
                        ss += (v[0] * v[0] + v[1] * v[1]) + (v[2] * v[2] + v[3] * v[3]); v2u w; w.x = pk2(v[0], v[1]); w.y = pk2(v[2], v[3]); *(v2u*)(hb + bj * 128 + n * 16) = w; }
                ss += __shfl_xor(ss, 16); ss += __shfl_xor(ss, 32);
                if (fq == 0) SS[(size_t)orow * 16 + u.pn * 4 + wc] = ss; }
    }
};
struct EpiDown {
    static constexpr bool PERM = false, AFTER_DRAIN = false;
    const bf16* HB; float* out;
    __device__ __forceinline__ void operator()(const pg8::f32x4 (&acc)[2][2][4][2], const pg8::Unit& u, int wr, int wc, int fr, int fq) const {
        const int rb = (u.pm >> 3) * 2064 + 16 + (u.pm & 7) * 256;
        const int row0 = u.pm * 256 + wr * 64 + fr, col0 = u.pn * 256 + wc * 32 + 4 * fq;
#pragma unroll
        for (int ai = 0; ai < 2; ++ai)
#pragma unroll
            for (int m = 0; m < 4; ++m) { const size_t off = (size_t)(row0 + ai * 128 + m * 16) * DM + col0; const bf16* hb = HB + (size_t)(rb + wr * 64 + fr + ai * 128 + m * 16) * DM + col0;
#pragma unroll
                for (int bj = 0; bj < 2; ++bj)
#pragma unroll
                    for (int n = 0; n < 2; ++n) { const v2u w = *(const v2u*)(hb + bj * 128 + n * 16); const pg8::f32x4 r = {bflo(w.x), bfhi(w.x), bflo(w.y), bfhi(w.y)}; *(pg8::f32x4*)(out + off + bj * 128 + n * 16) = r + acc[ai][bj][m][n]; } }
    }
};
struct EpiSwiGLU {
    static constexpr bool PERM = true, AFTER_DRAIN = false;
    bf16* O; const float* SS;
    __device__ __forceinline__ void operator()(const pg8::f32x4 (&acc)[2][2][4][2], const pg8::Unit& u, int wr, int wc, int fr, int fq) const {
        const int rb = (u.pm >> 3) * 2064 + 16 + (u.pm & 7) * 256;
        const int row0 = rb + wr * 64 + fr, col0 = u.pn * 128 + wc * 32 + 8 * fq, orow0 = u.pm * 256 + wr * 64 + fr;
#pragma unroll
        for (int ai = 0; ai < 2; ++ai)
#pragma unroll
            for (int m = 0; m < 4; ++m) { float a[8]; const pg8::f32x4* sp = (const pg8::f32x4*)(SS + (size_t)(orow0 + ai * 128 + m * 16) * 16); const pg8::f32x4 s4 = (sp[0] + sp[1]) + (sp[2] + sp[3]);
                const float rs = 1.0f / sqrtf(((s4[0] + s4[1]) + (s4[2] + s4[3])) * (1.f / DM) + EPS);
#pragma unroll
                for (int n = 0; n < 2; ++n)
#pragma unroll
                    for (int e = 0; e < 4; ++e) a[4 * n + e] = silu_f(rs * acc[ai][0][m][n][e]) * (rs * acc[ai][1][m][n][e]);
                v4u w; w.x = pk2(a[0], a[1]); w.y = pk2(a[2], a[3]); w.z = pk2(a[4], a[5]); w.w = pk2(a[6], a[7]);
                *(v4u*)(O + (size_t)(row0 + ai * 128 + m * 16) * DFF + col0) = w; }
    }
};

template <class ARow, class Epi>
__device__ __forceinline__ void small_gemm(const bf16* A, int lda, const bf16* Bt, int K, int nrt, int nct, const ARow& arow, const Epi& E, int gw, int NGW, int lane) {
    const int ntask = nrt * nct;
    for (int task = gw; task < ntask; task += NGW) {
        const int rt = task % nrt, ct = task / nrt;
        const bf16* ap = A + (size_t)arow(rt * 16 + (lane & 15)) * lda + 8 * (lane >> 4);
        const bf16* bp = Bt + (size_t)(ct * 16 + (lane & 15)) * K + 8 * (lane >> 4);
        f32x4 acc = {0.f, 0.f, 0.f, 0.f};
#pragma unroll 8
        for (int k0 = 0; k0 < K; k0 += 32) {
            const bf16x8 a = *(const bf16x8*)(ap + k0), b = *(const bf16x8*)(bp + k0);
            acc = __builtin_amdgcn_mfma_f32_16x16x32_bf16(a, b, acc, 0, 0, 0);
        }
        E(acc, rt, ct, lane);
    }
}

template <class RM>
__device__ __forceinline__ void transpose_item(const float* W, int N, int ldw, bf16* WT, int ldt, int item, LAS float* scr, int lane, const RM& rm, const float* kscale = nullptr) {
    const int nblk = (N + 31) / 32, kb = item / nblk, nb = item % nblk, k0 = 64 * kb, n0 = 32 * nb;
    { const int n = n0 + (lane & 31); float v[32];
#pragma unroll
      for (int i = 0; i < 32; ++i) { const int kk = 2 * i + (lane >> 5); v[i] = (n < N) ? W[(size_t)(k0 + kk) * ldw + n] : 0.f; }
#pragma unroll
      for (int i = 0; i < 32; ++i) { const int kk = 2 * i + (lane >> 5); float x = v[i]; if (kscale) x *= kscale[k0 + kk]; scr[kk * 33 + (lane & 31)] = x; } }
    LDS_WAIT(); asm volatile("" ::: "memory");
    const int c = lane & 7;
#pragma unroll
    for (int j = 0; j < 4; ++j) { const int n = (lane >> 3) + 8 * j; const LAS float* s = scr + (8 * c) * 33 + n;
        if (n0 + n < N) { v4u o; o.x = pk2(s[0 * 33], s[1 * 33]); o.y = pk2(s[2 * 33], s[3 * 33]); o.z = pk2(s[4 * 33], s[5 * 33]); o.w = pk2(s[6 * 33], s[7 * 33]);
            *(v4u*)(WT + (size_t)rm(n0 + n) * ldt + k0 + 8 * c) = o; } }
    LDS_WAIT(); asm volatile("" ::: "memory");
}
__device__ __forceinline__ int map_in(int n) {
    return n < S_DT ? n : n < S_CQ ? C_DT + (n - S_DT) : n < S_CKV ? C_CQ + (n - S_CQ) : n < S_KR ? C_CKV + (n - S_CKV) : n;
}
__device__ __forceinline__ void p0_prologue(Frame& F) {
    LAS float* scr = (LAS float*)(F.lds + RING_OFF + F.wave * 16384);
    const float* w_in = (const float*)F.in[9]; const float* w_uq = (const float*)F.in[17]; const float* w_ukv = (const float*)F.in[19]; const float* w_out = (const float*)F.in[25];
    const float* w_gate = (const float*)F.in[27]; const float* w_up = (const float*)F.in[28]; const float* w_down = (const float*)F.in[29];
    bf16* WIN = (bf16*)(F.ws + WS_WIN); bf16* WUQ = (bf16*)(F.ws + WS_WUQ); bf16* WUKV = (bf16*)(F.ws + WS_WUKV); bf16* WOUT = (bf16*)(F.ws + WS_WOUT); bf16* WGU = (bf16*)(F.ws + WS_WGU); bf16* WDN = (bf16*)(F.ws + WS_WDN);
    const float* ffg = (const float*)F.in[26];
    constexpr int I_IN = 16 * 62, I_UQ = 6 * 24, I_UKV = 4 * 32, I_OUT = 16 * 32, I_G = 16 * 88, I_DN = 44 * 32;
    constexpr int NITEMS = I_IN + I_UQ + I_UKV + I_OUT + 2 * I_G + I_DN;
    for (int it = F.gw; it < NITEMS; it += F.NGW) {
        int r = it;
        if (r < I_IN) { transpose_item(w_in, INC, INC, WIN, DM, r, scr, F.lane, [](int n) { return map_in(n); }); continue; } r -= I_IN;
        if (r < I_UQ) { transpose_item(w_uq, 768, 768, WUQ, QL, r, scr, F.lane, [](int n) { return n; }); continue; } r -= I_UQ;
        if (r < I_UKV) { transpose_item(w_ukv, 1024, 1024, WUKV, KVL, r, scr, F.lane, [](int n) { return n; }); continue; } r -= I_UKV;
        if (r < I_OUT) { transpose_item(w_out, DM, DM, WOUT, 1024, r, scr, F.lane, [](int n) { return n; }); continue; } r -= I_OUT;
        if (r < I_G) { transpose_item(w_gate, DFF, DFF, WGU, DM, r, scr, F.lane, [](int n) { return 256 * (n >> 7) + (n & 127); }, ffg); continue; } r -= I_G;
        if (r < I_G) { transpose_item(w_up, DFF, DFF, WGU, DM, r, scr, F.lane, [](int n) { return 256 * (n >> 7) + 128 + (n & 127); }, ffg); continue; } r -= I_G;
        transpose_item(w_down, DM, DM, WDN, DFF, r, scr, F.lane, [](int n) { return n; });
    }
    for (int i = F.gw * 64 + F.lane; i < 88 * 1024 / 8; i += F.NGW * 64) *(v4u*)(WIN + (size_t)1960 * 1024 + (size_t)i * 8) = (v4u){0u, 0u, 0u, 0u};
    const float* xp = (const float*)F.in[0]; const float* xs = (const float*)F.in[1]; const float* meta = (const float*)F.in[7]; const float* g = (const float*)F.in[8];
    bf16* XN = (bf16*)(F.ws + WS_XN);
    f32x4 gv[4];
#pragma unroll
    for (int j = 0; j < 4; ++j) gv[j] = ((const f32x4*)g)[F.lane + 64 * j];
    for (int r0 = 2 * F.gw; r0 < R; r0 += 2 * F.NGW) {
        f32x4 v[2][4];
#pragma unroll
        for (int i = 0; i < 2; ++i) { const int row = r0 + i; const float* src;
            if (row < RP) { const int b = row / TT, t = row % TT; src = (t < NMETA) ? meta + (size_t)t * DM : xp + ((size_t)b * SEQ + (t - NMETA)) * DM; } else src = xs + (size_t)(row - RP) * DM;
#pragma unroll
            for (int j = 0; j < 4; ++j) v[i][j] = ((const f32x4*)src)[F.lane + 64 * j]; }
#pragma unroll
        for (int i = 0; i < 2; ++i) { float s = 0.f;
#pragma unroll
            for (int j = 0; j < 4; ++j) s += (v[i][j].x * v[i][j].x + v[i][j].y * v[i][j].y) + (v[i][j].z * v[i][j].z + v[i][j].w * v[i][j].w);
            const float rs = 1.0f / sqrtf(wave_sum(s) * (1.f / DM) + EPS);
            v2u* o8 = (v2u*)(XN + (size_t)(r0 + i) * DM) + F.lane;
#pragma unroll
            for (int j = 0; j < 4; ++j) { v2u o; o.x = pk2(v[i][j].x * rs * gv[j].x, v[i][j].y * rs * gv[j].y); o.y = pk2(v[i][j].z * rs * gv[j].z, v[i][j].w * rs * gv[j].w); o8[64 * j] = o; } }
    }
    float* ROPE = (float*)(F.ws + WS_ROPE);
    for (int i = blockIdx.x * NTHR + F.tid; i < (TT + 1) * 16; i += F.G * NTHR) { const int p = i >> 4, j = i & 15; const float ang = (float)(p < TT ? p : PAST) * rope_inv(j); ROPE[2 * i] = cosf(ang); ROPE[2 * i + 1] = sinf(ang); }
}

__device__ __forceinline__ int small_arow(int r) { return r < NMETA ? r : RP + (r - NMETA); }
__device__ __forceinline__ void p1_inproj(Frame& F) {
    const bf16* XN = (const bf16*)(F.ws + WS_XN); const bf16* WIN = (const bf16*)(F.ws + WS_WIN); bf16* PROJ = (bf16*)(F.ws + WS_PROJ); float* DTRAW = (float*)(F.ws + WS_DTRAW);
    { pg8::Gemm g{XN, WIN, MMAIN, PJ, DM, 1}; pg8::StaticOrder S; S.init(MMAIN, PJ, F.G, (int)blockIdx.x);
      EpiProj E{PROJ, DTRAW, 1};
      pg8::gemm_phase<EpiProj, pg8::StaticOrder, true, true>(F.lds + RING_OFF, g, S, E); }
    auto epi = [&](const f32x4& acc, int rt, int ct, int lane) {
        const int col = ct * 16 + (lane & 15);
#pragma unroll
        for (int i = 0; i < 4; ++i) { const int r = rt * 16 + 4 * (lane >> 4) + i; const bf16 v = f2bf(acc[i]);
            if (r < NMETA) { for (int b = 0; b < NB; ++b) { PROJ[(size_t)(b * TT + r) * PJ + col] = v; if (col >= C_DT && col < C_DT + 8) DTRAW[(size_t)(b * TT + r) * 8 + (col - C_DT)] = acc[i]; } }
            else { const int row = RP + (r - NMETA); PROJ[(size_t)row * PJ + col] = v; if (col >= C_DT && col < C_DT + 8) DTRAW[(size_t)row * 8 + (col - C_DT)] = acc[i]; } }
    };
    small_gemm(XN, DM, WIN, DM, NS / 16, PJ / 16, [](int r) { return small_arow(r); }, epi, F.gw, F.NGW, F.lane);
}

constexpr int CV_LDS_STRIDE = 82;
__device__ __forceinline__ void p2_elementwise(Frame& F) {
    const bf16* PROJ = (const bf16*)(F.ws + WS_PROJ); const float* DTRAW = (const float*)(F.ws + WS_DTRAW); float* DT = (float*)(F.ws + WS_DT);
    bf16* LAT = (bf16*)(F.ws + WS_LAT); bf16* CQN = (bf16*)(F.ws + WS_CQN); float* KRF = (float*)(F.ws + WS_KRF);
    const float* kvg = (const float*)F.in[18]; const float* qng = (const float*)F.in[16]; const float* dtb = (const float*)F.in[12]; const float* ROPE = (const float*)(F.ws + WS_ROPE);
    for (int r0 = 4 * F.gw; r0 < R; r0 += 4 * F.NGW) {
        v2u wk[4]; unsigned wq[4][3]; unsigned short kr1[4], kr2[4]; float dtr[4]; f32x2_t cs[4];
#pragma unroll
        for (int i = 0; i < 4; ++i) { const int row = r0 + i; const bf16* pr = PROJ + (size_t)row * PJ;
            wk[i] = *(const v2u*)(pr + C_CKV + 4 * F.lane); const unsigned* p = (const unsigned*)(pr + C_CQ + 6 * F.lane); wq[i][0] = p[0]; wq[i][1] = p[1]; wq[i][2] = p[2];
            kr1[i] = pr[C_KR + (F.lane & 15)]; kr2[i] = pr[C_KR + 16 + (F.lane & 15)]; dtr[i] = DTRAW[(size_t)row * 8 + (F.lane & 7)];
            cs[i] = *(const f32x2_t*)(ROPE + 2 * ((row < RP ? row % TT : TT) * 16 + (F.lane & 15))); }
        const f32x4 gg = ((const f32x4*)kvg)[F.lane]; const float* gq = qng + 6 * F.lane; const float g0 = gq[0], g1 = gq[1], g2 = gq[2], g3 = gq[3], g4 = gq[4], g5 = gq[5]; const float dbias = dtb[F.lane & 7];
#pragma unroll
        for (int i = 0; i < 4; ++i) { const int row = r0 + i;
            { const float v0 = bflo(wk[i].x), v1 = bfhi(wk[i].x), v2 = bflo(wk[i].y), v3 = bfhi(wk[i].y);
              const float rs = 1.0f / sqrtf(wave_sum((v0 * v0 + v1 * v1) + (v2 * v2 + v3 * v3)) * (1.f / KVL) + EPS);
              const f32x4 o = {v0 * rs * gg.x, v1 * rs * gg.y, v2 * rs * gg.z, v3 * rs * gg.w};
              float* of = (row < RP) ? F.out + OUT_LATP + (size_t)row * KVL : F.out + OUT_LATS + (size_t)(row - RP) * KVL;
              ((f32x4*)of)[F.lane] = o; v2u ob; ob.x = pk2(o.x, o.y); ob.y = pk2(o.z, o.w); *(v2u*)(LAT + (size_t)row * KVL + 4 * F.lane) = ob; }
            { const float v0 = bflo(wq[i][0]), v1 = bfhi(wq[i][0]), v2 = bflo(wq[i][1]), v3 = bfhi(wq[i][1]), v4 = bflo(wq[i][2]), v5 = bfhi(wq[i][2]);
              const float rs = 1.0f / sqrtf(wave_sum((v0 * v0 + v1 * v1) + (v2 * v2 + v3 * v3) + (v4 * v4 + v5 * v5)) * (1.f / QL) + EPS);
              unsigned* o = (unsigned*)(CQN + (size_t)row * QL + 6 * F.lane);
              o[0] = pk2(v0 * rs * g0, v1 * rs * g1); o[1] = pk2(v2 * rs * g2, v3 * rs * g3); o[2] = pk2(v4 * rs * g4, v5 * rs * g5); }
            if (F.lane < 16) { const int j = F.lane; const float c = cs[i].x, s = cs[i].y;
              const float x1 = bf2f(kr1[i]), x2 = bf2f(kr2[i]); const float y1 = x1 * c - x2 * s, y2 = x1 * s + x2 * c;
              KRF[(size_t)row * 32 + j] = y1; KRF[(size_t)row * 32 + 16 + j] = y2;
              float* of = (row < RP) ? F.out + OUT_KRP + (size_t)row * 32 : F.out + OUT_KRS + (size_t)(row - RP) * 32; of[j] = y1; of[16 + j] = y2; }
            if (F.lane < 8) DT[(size_t)row * 8 + F.lane] = softplus_f(dtr[i] + dbias); }
    }
    const float* cw = (const float*)F.in[10]; const float* cb = (const float*)F.in[11];
    bf16* XST = (bf16*)(F.ws + WS_XST); bf16* BT = (bf16*)(F.ws + WS_BT); bf16* BC = (bf16*)(F.ws + WS_BC);
    LAS bf16* tile = (LAS bf16*)(F.lds + RING_OFF);
    for (int i = blockIdx.x * NTHR + F.tid; i < NB * 640 * 6; i += F.G * NTHR) { const int rowi = i / 6, pc = i % 6; const int bb = rowi / 640, cc = rowi % 640;
        bf16* dst = (cc < SSDW) ? XST + ((size_t)(bb * SSDW + cc)) * TPAD : BT + ((size_t)(bb * 128 + (cc - SSDW))) * TPAD; *(v4u*)(dst + pc * 8) = (v4u){0u, 0u, 0u, 0u}; }
    for (int u = blockIdx.x; u < NB * 32 * 3; u += F.G) {
        const int third = u % 3, tb = 1 + (u / 3) % 32, b = u / 96; const int t0 = tb * CHL - TOFF;
        {
            const int cl = 2 * (F.tid & 127), c = third * 256 + cl, tq = F.tid >> 7;
            const float w0a = cw[0 * CONVD + c], w1a = cw[1 * CONVD + c], w2a = cw[2 * CONVD + c], w3a = cw[3 * CONVD + c], ba = cb[c];
            const float w0b = cw[0 * CONVD + c + 1], w1b = cw[1 * CONVD + c + 1], w2b = cw[2 * CONVD + c + 1], w3b = cw[3 * CONVD + c + 1], bb = cb[c + 1];
            const bf16* base = PROJ + (size_t)b * TT * PJ + C_XBC + c;
#define CV_QUARTER(tfirst, lcol) do { float xa[19], xb[19]; \
                _Pragma("unroll") for (int k = 0; k < 19; ++k) { const int t = (tfirst) - 3 + k; xa[k] = 0.f; xb[k] = 0.f; if (t >= 0) { const unsigned w = *(const unsigned*)(base + (size_t)t * PJ); xa[k] = bflo(w); xb[k] = bfhi(w); } } \
                _Pragma("unroll") for (int k = 0; k < 16; ++k) { const int t = (tfirst) + k; \
                    const float ya = silu_f(ba + xa[k] * w0a + xa[k + 1] * w1a + xa[k + 2] * w2a + xa[k + 3] * w3a), yb = silu_f(bb + xb[k] * w0b + xb[k + 1] * w1b + xb[k + 2] * w2b + xb[k + 3] * w3b); \
                    const unsigned pk = pk2(ya, yb); \
                    tile[cl * CV_LDS_STRIDE + (lcol) + k] = (bf16)(pk & 0xffffu); tile[(cl + 1) * CV_LDS_STRIDE + (lcol) + k] = (bf16)(pk >> 16); \
                    if (third == 2) *(unsigned*)(BC + (size_t)(b * TT + t) * 256 + cl) = pk; } } while (0)
            CV_QUARTER(t0 + 16 * tq, 16 * tq);
            if (tb == 1 && tq == 0) CV_QUARTER(0, 64);
#undef CV_QUARTER
        }
        __syncthreads();
        { const int nrows = (third == 2) ? 128 : 256; const int npc = (tb == 1) ? 10 : 8;
          for (int i = F.tid; i < nrows * npc; i += NTHR) { const int cl = i / npc, pc = i % npc;
            const LAS unsigned* s = (const LAS unsigned*)(tile + cl * CV_LDS_STRIDE + pc * 8); v4u o; o.x = s[0]; o.y = s[1]; o.z = s[2]; o.w = s[3];
            bf16* dst = (third < 2) ? XST + ((size_t)(b * SSDW + third * 256 + cl)) * TPAD : BT + ((size_t)(b * 128 + cl)) * TPAD;
            *(v4u*)(dst + ((pc < 8) ? tb * CHL + pc * 8 : TOFF + (pc - 8) * 8)) = o; } }
        __syncthreads();
    }
    const float* sconv = (const float*)F.in[4]; float* XAS = (float*)(F.ws + WS_XAS);
    for (int i = blockIdx.x * NTHR + F.tid; i < DB * CONVD; i += F.G * NTHR) { const int b = i / CONVD, c = i % CONVD;
        const float xc = bf2f(PROJ[(size_t)(RP + b) * PJ + C_XBC + c]);
        const float s0 = sconv[(size_t)(b * 3 + 0) * CONVD + c], s1 = sconv[(size_t)(b * 3 + 1) * CONVD + c], s2 = sconv[(size_t)(b * 3 + 2) * CONVD + c];
        XAS[i] = silu_f(cb[c] + s0 * cw[c] + s1 * cw[CONVD + c] + s2 * cw[2 * CONVD + c] + xc * cw[3 * CONVD + c]);
        float* oc = F.out + OUT_CONVS + (size_t)b * 3 * CONVD + c; oc[0] = s1; oc[CONVD] = s2; oc[2 * CONVD] = xc; }
    for (int i = blockIdx.x * NTHR + F.tid; i < NB * 3 * CONVD; i += F.G * NTHR) { const int b = i / (3 * CONVD), k = (i / CONVD) % 3, c = i % CONVD;
        F.out[OUT_CONVP + i] = bf2f(PROJ[(size_t)(b * TT + TT - 3 + k) * PJ + C_XBC + c]); }
}
#define MFMA32(a, b, c) __builtin_amdgcn_mfma_f32_32x32x16_bf16((a), (b), (c), 0, 0, 0)
#define MFMA16(a, b, c) __builtin_amdgcn_mfma_f32_16x16x32_bf16((a), (b), (c), 0, 0, 0)
__device__ __forceinline__ int crow(int reg, int hi) { return (reg & 3) + 8 * (reg >> 2) + 4 * hi; }
__device__ __forceinline__ bf16x8 pack8(const f32x16& x, int s) {
    v4u p; p.x = pk2(x[8 * s + 0], x[8 * s + 1]); p.y = pk2(x[8 * s + 2], x[8 * s + 3]); p.z = pk2(x[8 * s + 4], x[8 * s + 5]); p.w = pk2(x[8 * s + 6], x[8 * s + 7]);
    return __builtin_bit_cast(bf16x8, p);
}
__device__ __forceinline__ bf16x8 ld2x8(const bf16* p0, const bf16* p1) {
    const v2u a = *(const v2u*)p0, b = *(const v2u*)p1; v4u r; r.x = a.x; r.y = a.y; r.z = b.x; r.w = b.y; return __builtin_bit_cast(bf16x8, r);
}
__device__ __forceinline__ float softmax_ref(Frame& F) {
    const float* gqn = (const float*)F.in[20]; const float* gqr = (const float*)F.in[21]; const float* gkn = (const float*)F.in[22]; const float* gkr = (const float*)F.in[23];
    float a = fabsf(gqn[F.lane]), b = fabsf(gkn[F.lane]);
    if (F.lane < 16) { a = fmaxf(a, fabsf(gqr[F.lane])); b = fmaxf(b, fabsf(gkr[F.lane])); }
    return LOG2E * 9.797958971132712f * wave_max(a) * wave_max(b) * 1.0001f;
}
constexpr size_t WS_YS = 495 * MiB;
constexpr size_t WS_KS = 498 * MiB;
constexpr int NKT = 65;

__device__ __forceinline__ void p3_upproj_states(Frame& F) {
    const bf16* CQN = (const bf16*)(F.ws + WS_CQN); const bf16* LAT = (const bf16*)(F.ws + WS_LAT); const bf16* WUQ = (const bf16*)(F.ws + WS_WUQ); const bf16* WUKV = (const bf16*)(F.ws + WS_WUKV);
    bf16* QRAW = (bf16*)(F.ws + WS_QRAW); bf16* KVRAW = (bf16*)(F.ws + WS_KVRAW);
    { pg8::Gemm g{CQN, WUQ, MMAIN, 768, QL, 1}; pg8::StaticOrder S; S.init(MMAIN, 768, F.G, (int)blockIdx.x); EpiBf16 E{QRAW, 768, 1};
      pg8::gemm_phase<EpiBf16, pg8::StaticOrder, true, true>(F.lds + RING_OFF, g, S, E); }
    { pg8::Gemm g{LAT, WUKV, MMAIN, 1024, KVL, 1}; pg8::StaticOrder S; S.init(MMAIN, 1024, F.G, (int)blockIdx.x); EpiBf16 E{KVRAW, 1024, 1};
      pg8::gemm_phase<EpiBf16, pg8::StaticOrder, true, true>(F.lds + RING_OFF, g, S, E); }
    const bool sub = (F.G == 256); if (sub && blockIdx.x < 192) return;
    const int sgw = sub ? (blockIdx.x - 192) * NWAVES + F.wave : F.gw, sngw = sub ? 64 * NWAVES : F.NGW;
    small_gemm(CQN, QL, WUQ, QL, DB / 16, 768 / 16, [](int r) { return RP + r; },
        [&](const f32x4& acc, int rt, int ct, int lane) { const int col = ct * 16 + (lane & 15);
#pragma unroll
            for (int i = 0; i < 4; ++i) QRAW[(size_t)(RP + rt * 16 + 4 * (lane >> 4) + i) * 768 + col] = f2bf(acc[i]); }, sgw, sngw, F.lane);
    small_gemm(LAT, KVL, WUKV, KVL, NS / 16, 1024 / 16, [](int r) { return small_arow(r); },
        [&](const f32x4& acc, int rt, int ct, int lane) { const int col = ct * 16 + (lane & 15);
#pragma unroll
            for (int i = 0; i < 4; ++i) { const int r = rt * 16 + 4 * (lane >> 4) + i; const bf16 v = f2bf(acc[i]);
                if (r < NMETA) { for (int b = 0; b < NB; ++b) KVRAW[(size_t)(b * TT + r) * 1024 + col] = v; } else KVRAW[(size_t)(RP + r - NMETA) * 1024 + col] = v; } }, sgw, sngw, F.lane);
    const float* DT = (const float*)(F.ws + WS_DT); const float* a_log = (const float*)F.in[13];
    const bf16* XST = (const bf16*)(F.ws + WS_XST); const bf16* BT = (const bf16*)(F.ws + WS_BT);
    float* STATES = (float*)(F.ws + WS_STATES); float* DECAY = (float*)(F.ws + WS_DECAY);
    LAS float* wl = (LAS float*)(F.lds + RING_OFF + F.wave * 1024);
    const int r32 = F.lane & 31, hi = F.lane >> 5;
    for (int u = sgw; u < NB * NCH * NH; u += sngw) {
        const int h = u % NH, c = (u / NH) % NCH, b = u / (NH * NCH); const int g = h >> 2;
        const int t = c * CHL - TOFF + F.lane;
        const float dt = (t >= 0) ? DT[(size_t)(b * TT + t) * 8 + h] : 0.f;
        const float A = -__expf(a_log[h]);
        float acs = dt * A;
#pragma unroll
        for (int o = 1; o < 64; o <<= 1) { const float v = __shfl_up(acs, o); if (F.lane >= o) acs += v; }
        const float last = __shfl(acs, 63);
        wl[F.lane] = __expf(last - acs) * dt;
        LDS_WAIT(); asm volatile("" ::: "memory");
        f32x16 acc[2][2];
#pragma unroll
        for (int i = 0; i < 2; ++i)
#pragma unroll
            for (int j = 0; j < 2; ++j) acc[i][j] = (f32x16){};
        const bf16* xb = XST + ((size_t)(b * SSDW + h * HP)) * TPAD + c * CHL; const bf16* bb = BT + ((size_t)(b * 128 + g * DS)) * TPAD + c * CHL;
#pragma unroll
        for (int s = 0; s < 4; ++s) {
            const f32x4 w0 = *(const LAS f32x4*)(wl + 16 * s + 8 * hi), w1 = *(const LAS f32x4*)(wl + 16 * s + 8 * hi + 4);
            bf16x8 af[2], bfr[2];
#pragma unroll
            for (int pt = 0; pt < 2; ++pt) { const v4u x = *(const v4u*)(xb + (size_t)(32 * pt + r32) * TPAD + 16 * s + 8 * hi);
                v4u y; y.x = pk2(bflo(x.x) * w0.x, bfhi(x.x) * w0.y); y.y = pk2(bflo(x.y) * w0.z, bfhi(x.y) * w0.w); y.z = pk2(bflo(x.z) * w1.x, bfhi(x.z) * w1.y); y.w = pk2(bflo(x.w) * w1.z, bfhi(x.w) * w1.w);
                af[pt] = __builtin_bit_cast(bf16x8, y); }
#pragma unroll
            for (int nt = 0; nt < 2; ++nt) bfr[nt] = *(const bf16x8*)(bb + (size_t)(32 * nt + r32) * TPAD + 16 * s + 8 * hi);
#pragma unroll
            for (int pt = 0; pt < 2; ++pt)
#pragma unroll
                for (int nt = 0; nt < 2; ++nt) acc[pt][nt] = MFMA32(af[pt], bfr[nt], acc[pt][nt]);
        }
        float* so = STATES + ((size_t)((b * NCH + c) * NH + h)) * 4096;
#pragma unroll
        for (int pt = 0; pt < 2; ++pt)
#pragma unroll
            for (int nt = 0; nt < 2; ++nt)
#pragma unroll
                for (int rg = 0; rg < 16; ++rg) so[(32 * pt + crow(rg, hi)) * 64 + 32 * nt + r32] = acc[pt][nt][rg];
        if (F.lane == 0) DECAY[(b * NCH + c) * NH + h] = __expf(last);
        LDS_WAIT(); asm volatile("" ::: "memory");
    }
}

#ifdef MK_TS
#define P4_STAMP(k) do { if (blockIdx.x == 0 && F.tid == 0) ((unsigned long long*)(F.ws + 600 * MiB))[20 + (k)] = __builtin_amdgcn_s_memrealtime(); } while (0)
#else
#define P4_STAMP(k) do { } while (0)
#endif
__device__ __forceinline__ void p4_post(Frame& F) {
    const bf16* QRAW = (const bf16*)(F.ws + WS_QRAW); const bf16* KVRAW = (const bf16*)(F.ws + WS_KVRAW); const float* KRF = (const float*)(F.ws + WS_KRF);
    bf16* Q = (bf16*)(F.ws + WS_Q); bf16* K = (bf16*)(F.ws + WS_K); bf16* VT = (bf16*)(F.ws + WS_VT); float* VS = (float*)(F.ws + WS_VS);
    const float* gqn = (const float*)F.in[20]; const float* gqr = (const float*)F.in[21]; const float* gkn = (const float*)F.in[22]; const float* gkr = (const float*)F.in[23];
    const float* ROPE = (const float*)(F.ws + WS_ROPE);
    const int h = F.lane >> 3, sub = F.lane & 7;
    bf16* KS = (bf16*)(F.ws + WS_KS);
    for (int row = RP + F.gw; row < R; row += F.NGW) {
        const int t = PAST;
        if (row >= RP) { const bf16* kp = KVRAW + (size_t)row * 1024 + 128 * h + 8 * sub; const v4u kw = *(const v4u*)kp; const v4u vw = *(const v4u*)(kp + 64);
          const f32x4 kr = *(const f32x4*)(KRF + (size_t)row * 32 + 4 * sub);
          float kn[8] = {bflo(kw.x), bfhi(kw.x), bflo(kw.y), bfhi(kw.y), bflo(kw.z), bfhi(kw.z), bflo(kw.w), bfhi(kw.w)};
          float ss = (kr.x * kr.x + kr.y * kr.y) + (kr.z * kr.z + kr.w * kr.w);
#pragma unroll
          for (int e = 0; e < 8; ++e) ss += kn[e] * kn[e];
          ss += __shfl_xor(ss, 1); ss += __shfl_xor(ss, 2); ss += __shfl_xor(ss, 4);
          const float rs = 1.0f / sqrtf(ss * (1.f / 96.f) + EPS);
          const float* gn = gkn + 8 * sub; v4u o; o.x = pk2(kn[0] * rs * gn[0], kn[1] * rs * gn[1]); o.y = pk2(kn[2] * rs * gn[2], kn[3] * rs * gn[3]); o.z = pk2(kn[4] * rs * gn[4], kn[5] * rs * gn[5]); o.w = pk2(kn[6] * rs * gn[6], kn[7] * rs * gn[7]);
          bf16* ko = KS + (size_t)(row - RP) * 768 + 96 * h; *(v4u*)(ko + 8 * sub) = o;
          const float* gr = gkr + ((4 * sub) & 15); v2u o2; o2.x = pk2(kr.x * rs * gr[0], kr.y * rs * gr[1]); o2.y = pk2(kr.z * rs * gr[2], kr.w * rs * gr[3]);
          *(v2u*)(ko + 64 + 4 * sub) = o2;
          const unsigned vv[4] = {vw.x, vw.y, vw.z, vw.w}; float* vs = VS + (size_t)(row - RP) * 512 + 64 * h + 8 * sub;
#pragma unroll
          for (int e = 0; e < 4; ++e) { vs[2 * e] = bflo(vv[e]); vs[2 * e + 1] = bfhi(vv[e]); } }
        if (row >= RP || t >= NMETA) {
            const bf16* qp = QRAW + (size_t)row * 768 + 96 * h; const v4u qw = *(const v4u*)(qp + 8 * sub);
            const unsigned r1 = *(const unsigned*)(qp + 64 + 2 * sub), r2 = *(const unsigned*)(qp + 80 + 2 * sub);
            float qn[8] = {bflo(qw.x), bfhi(qw.x), bflo(qw.y), bfhi(qw.y), bflo(qw.z), bfhi(qw.z), bflo(qw.w), bfhi(qw.w)};
            const f32x4 cs = *(const f32x4*)(ROPE + 2 * ((row < RP ? t : TT) * 16 + 2 * sub)); const float c0 = cs.x, s0 = cs.y, c1 = cs.z, s1 = cs.w;
            const float x10 = bflo(r1), x11 = bfhi(r1), x20 = bflo(r2), x21 = bfhi(r2);
            const float y10 = x10 * c0 - x20 * s0, y20 = x10 * s0 + x20 * c0, y11 = x11 * c1 - x21 * s1, y21 = x11 * s1 + x21 * c1;
            float ss = (y10 * y10 + y20 * y20) + (y11 * y11 + y21 * y21);
#pragma unroll
            for (int e = 0; e < 8; ++e) ss += qn[e] * qn[e];
            ss += __shfl_xor(ss, 1); ss += __shfl_xor(ss, 2); ss += __shfl_xor(ss, 4);
            const float rs = (ATTN_SCALE * LOG2E) / sqrtf(ss * (1.f / 96.f) + EPS);
            const float* gn = gqn + 8 * sub; v4u o; o.x = pk2(qn[0] * rs * gn[0], qn[1] * rs * gn[1]); o.y = pk2(qn[2] * rs * gn[2], qn[3] * rs * gn[3]); o.z = pk2(qn[4] * rs * gn[4], qn[5] * rs * gn[5]); o.w = pk2(qn[6] * rs * gn[6], qn[7] * rs * gn[7]);
            bf16* qo = Q + (size_t)row * 768 + 96 * h; *(v4u*)(qo + 8 * sub) = o;
            const float g0 = gqr[2 * sub], g1 = gqr[2 * sub + 1];
            *(unsigned*)(qo + 64 + 2 * sub) = pk2(y10 * rs * g0, y11 * rs * g1); *(unsigned*)(qo + 80 + 2 * sub) = pk2(y20 * rs * g0, y21 * rs * g1);
        }
    }
    { bf16* KF = (bf16*)(F.ws + WS_K); bf16* VF = (bf16*)(F.ws + WS_VT);
      LAS unsigned char* vtile = F.lds + RING_OFF + F.wave * 4608;
      const int r8 = F.lane >> 3;
      for (int u = F.gw; u < NB * NKT * NH; u += F.NGW) {
          const int hh = u % NH, kt = (u / NH) % NKT, bb = u / (NH * NKT);
          bf16* kfb = KF + ((size_t)((bb * NH + hh) * NKT + kt)) * (6 * 512); bf16* vfb = VF + ((size_t)((bb * NH + hh) * NKT + kt)) * (4 * 512);
          v4u kwa[4], vwa[4]; f32x4 kra[4];
#pragma unroll
          for (int i = 0; i < 4; ++i) { const int tk = kt * 32 + 8 * i + r8; const int tkc = tk < TT ? tk : TT - 1;
              const bf16* kp = KVRAW + (size_t)(bb * TT + tkc) * 1024 + 128 * hh + 8 * sub; kwa[i] = *(const v4u*)kp; vwa[i] = *(const v4u*)(kp + 64); kra[i] = *(const f32x4*)(KRF + (size_t)(bb * TT + tkc) * 32 + 4 * sub); }
#pragma unroll
          for (int i = 0; i < 4; ++i) {
              const int key = 8 * i + r8, tk = kt * 32 + key; v4u kw = kwa[i], vw = vwa[i]; f32x4 kr = kra[i];
              if (tk >= TT) { kw = (v4u){0u, 0u, 0u, 0u}; vw = kw; kr = (f32x4){0.f, 0.f, 0.f, 0.f}; }
              float kn[8] = {bflo(kw.x), bfhi(kw.x), bflo(kw.y), bfhi(kw.y), bflo(kw.z), bfhi(kw.z), bflo(kw.w), bfhi(kw.w)};
              float ss = (kr.x * kr.x + kr.y * kr.y) + (kr.z * kr.z + kr.w * kr.w);
#pragma unroll
              for (int e = 0; e < 8; ++e) ss += kn[e] * kn[e];
              ss += __shfl_xor(ss, 1); ss += __shfl_xor(ss, 2); ss += __shfl_xor(ss, 4);
              const float rs = 1.0f / sqrtf(ss * (1.f / 96.f) + EPS);
              const float* gn = gkn + 8 * sub; v4u o; o.x = pk2(kn[0] * rs * gn[0], kn[1] * rs * gn[1]); o.y = pk2(kn[2] * rs * gn[2], kn[3] * rs * gn[3]); o.z = pk2(kn[4] * rs * gn[4], kn[5] * rs * gn[5]); o.w = pk2(kn[6] * rs * gn[6], kn[7] * rs * gn[7]);
              *(v4u*)(kfb + (sub >> 1) * 512 + ((sub & 1) * 32 + key) * 8) = o;
              const float* gr = gkr + ((4 * sub) & 15); v2u o2; o2.x = pk2(kr.x * rs * gr[0], kr.y * rs * gr[1]); o2.y = pk2(kr.z * rs * gr[2], kr.w * rs * gr[3]);
              *(v2u*)(kfb + (4 + (sub >> 2)) * 512 + (((sub >> 1) & 1) * 32 + key) * 8 + 4 * (sub & 1)) = o2;
              *(LAS v4u*)(vtile + key * 144 + sub * 16) = vw; }
          LDS_WAIT(); asm volatile("" ::: "memory");
          const int g = F.lane >> 4, q4 = (F.lane & 15) >> 2, pp = F.lane & 3;
          const unsigned a_lo = (unsigned)(uintptr_t)vtile + (unsigned)((4 * (g >> 1) + q4) * 144 + (16 * (g & 1) + 4 * pp) * 2);
#define VF_TR(dt, s2) do { s16x4 lo, hi4; \
              asm volatile("ds_read_b64_tr_b16 %0, %2 offset:%c3\n\tds_read_b64_tr_b16 %1, %2 offset:%c4\n\ts_waitcnt lgkmcnt(0)" : "=&v"(lo), "=&v"(hi4) : "v"(a_lo), "i"(16 * (s2) * 144 + 64 * (dt)), "i"(16 * (s2) * 144 + 64 * (dt) + 8 * 144) : "memory"); \
              v4u o; o.x = (unsigned)(unsigned short)lo[0] | ((unsigned)(unsigned short)lo[1] << 16); o.y = (unsigned)(unsigned short)lo[2] | ((unsigned)(unsigned short)lo[3] << 16); \
              o.z = (unsigned)(unsigned short)hi4[0] | ((unsigned)(unsigned short)hi4[1] << 16); o.w = (unsigned)(unsigned short)hi4[2] | ((unsigned)(unsigned short)hi4[3] << 16); \
              *(v4u*)(vfb + ((dt) * 2 + (s2)) * 512 + F.lane * 8) = o; } while (0)
          VF_TR(0, 0); VF_TR(0, 1); VF_TR(1, 0); VF_TR(1, 1);
#undef VF_TR
          LDS_WAIT(); asm volatile("" ::: "memory");
      } }
    P4_STAMP(0);
    const float* STATES = (const float*)(F.ws + WS_STATES); const float* DECAY = (const float*)(F.ws + WS_DECAY); bf16* HIN = (bf16*)(F.ws + WS_HIN);
    for (int e = blockIdx.x * NTHR + F.tid; e < NB * NH * 4096; e += F.G * NTHR) {
        const int b = e / (NH * 4096), hh = (e / 4096) % NH, pn = e % 4096;
        float hv = 0.f;
#pragma unroll 11
        for (int c = 0; c < NCH; ++c) { const size_t idx = ((size_t)((b * NCH + c) * NH + hh)) * 4096 + pn;
            HIN[idx] = f2bf(hv); hv = hv * DECAY[(b * NCH + c) * NH + hh] + STATES[idx]; }
        F.out[OUT_SSMP + e] = hv;
    }
    P4_STAMP(1);
    const float* XAS = (const float*)(F.ws + WS_XAS); const float* DT = (const float*)(F.ws + WS_DT); const float* sst = (const float*)F.in[5];
    const float* a_log = (const float*)F.in[13]; const float* d_skip = (const float*)F.in[14]; float* YS = (float*)(F.ws + WS_YS);
    for (int u = F.gw; u < DB * NH * 16; u += F.NGW) {
        const int pq = u & 15, hh = (u >> 4) & 7, b = u >> 7; const int g = hh >> 2; const int p = 4 * pq + (F.lane >> 4), n4 = F.lane & 15;
        const float dt = DT[(size_t)(RP + b) * 8 + hh]; const float a = __expf(dt * -__expf(a_log[hh]));
        const float x = XAS[(size_t)b * CONVD + hh * HP + p]; const float uu = dt * x;
        const f32x4 Bv = *(const f32x4*)(XAS + (size_t)b * CONVD + SSDW + g * DS + 4 * n4), Cv = *(const f32x4*)(XAS + (size_t)b * CONVD + SSDW + 128 + g * DS + 4 * n4);
        const size_t si = (((size_t)b * NH + hh) * HP + p) * DS + 4 * n4;
        const f32x4 s0 = *(const f32x4*)(sst + si); const f32x4 s1 = s0 * a + uu * Bv;
        *(f32x4*)(F.out + OUT_SSMS + si) = s1;
        float y = (Cv.x * s1.x + Cv.y * s1.y) + (Cv.z * s1.z + Cv.w * s1.w);
        y += __shfl_xor(y, 1); y += __shfl_xor(y, 2); y += __shfl_xor(y, 4); y += __shfl_xor(y, 8);
        if (n4 == 0) YS[(size_t)b * 512 + hh * HP + p] = y + d_skip[hh] * x;
    }
}
constexpr int DA_ROWB = 528;
constexpr int DA_LAT = 0, DA_KR = 128 * DA_ROWB, DA_PB = DA_KR + 128 * 33 * 4, DA_QG = DA_PB + 2 * 16 * 32 * 2, DA_END = DA_QG + 8 * 96 * 4;
constexpr int P5_EXCH = 100 * 1024;
static_assert(DA_END <= P5_EXCH, "LDS map of P5");

constexpr int AT_SLOT = 10240, AT_D = 4;
constexpr size_t WS_ATT = 499 * MiB;
__device__ __forceinline__ void at_issue(Frame& F, const bf16* kt_k, const bf16* kt_v, LAS unsigned char* slot) {
    const char* srcA = (F.wave < 6) ? (const char*)kt_k + F.wave * 1024 : (const char*)kt_v + (F.wave - 6) * 1024;
    __builtin_amdgcn_global_load_lds((const unsigned*)(srcA + F.lane * 16), (LAS unsigned*)(slot + F.wave * 1024), 16, 0, 0);
    __builtin_amdgcn_global_load_lds((const unsigned*)((const char*)kt_v + 2048 + F.wave * 256 + F.lane * 4), (LAS unsigned*)(slot + 8192 + F.wave * 256), 4, 0, 0);
}
__device__ __forceinline__ void p5_attn_prompt(Frame& F, float M0) {
    const bf16* QRAW = (const bf16*)(F.ws + WS_QRAW); const bf16* KF = (const bf16*)(F.ws + WS_K); const bf16* VF = (const bf16*)(F.ws + WS_VT); bf16* ATT = (bf16*)(F.ws + WS_ATT);
    const float* ROPE = (const float*)(F.ws + WS_ROPE); const float* gqn = (const float*)F.in[20]; const float* gqr = (const float*)F.in[21];
    LAS unsigned char* ring = F.lds + RING_OFF;
    const int w = F.wave, r32 = F.lane & 31, hi = F.lane >> 5;
    f32x16 negm;
#pragma unroll
    for (int i = 0; i < 16; ++i) negm[i] = -M0;
    for (int u = blockIdx.x; u < 256; u += F.G) {
        const int b = u >> 5, h = (u >> 2) & 7, pr = u & 3;
        const bf16* kfb = KF + ((size_t)((b * NH + h) * NKT)) * (6 * 512); const bf16* vfb = VF + ((size_t)((b * NH + h) * NKT)) * (4 * 512);
#pragma unroll 1
        for (int half = 0; half < 2; ++half) {
            const int qb = half ? 7 - pr : pr; const int a = 8 * qb + w; const int qi = NMETA + 32 * a + r32;
            const int nkt = 8 * qb + 9, nkw = a + 2;
            bf16x8 qf[6];
            { const bf16* qp = QRAW + (size_t)(b * TT + qi) * 768 + 96 * h + 8 * hi;
              v4u qw[6];
#pragma unroll
              for (int s = 0; s < 6; ++s) qw[s] = *(const v4u*)(qp + 16 * s);
              f32x4 cs[4];
#pragma unroll
              for (int i = 0; i < 4; ++i) cs[i] = *(const f32x4*)(ROPE + 2 * (qi * 16 + 8 * hi) + 4 * i);
              float qv[6][8]; float ss = 0.f;
#pragma unroll
              for (int s = 0; s < 6; ++s) { const unsigned ww[4] = {qw[s].x, qw[s].y, qw[s].z, qw[s].w};
#pragma unroll
                  for (int e = 0; e < 4; ++e) { qv[s][2 * e] = bflo(ww[e]); qv[s][2 * e + 1] = bfhi(ww[e]); ss += qv[s][2 * e] * qv[s][2 * e] + qv[s][2 * e + 1] * qv[s][2 * e + 1]; } }
              ss += __shfl_xor(ss, 32);
              const float rs = (ATTN_SCALE * LOG2E) / sqrtf(ss * (1.f / 96.f) + EPS);
#pragma unroll
              for (int jj = 0; jj < 8; ++jj) { const float c = cs[jj >> 1][2 * (jj & 1)], sn = cs[jj >> 1][2 * (jj & 1) + 1]; const float x1 = qv[4][jj], x2 = qv[5][jj];
                  const float gr = gqr[8 * hi + jj] * rs; qv[4][jj] = (x1 * c - x2 * sn) * gr; qv[5][jj] = (x1 * sn + x2 * c) * gr; }
#pragma unroll
              for (int s = 0; s < 4; ++s) { const f32x4 g0 = *(const f32x4*)(gqn + 16 * s + 8 * hi), g1 = *(const f32x4*)(gqn + 16 * s + 8 * hi + 4);
                  qv[s][0] *= g0.x * rs; qv[s][1] *= g0.y * rs; qv[s][2] *= g0.z * rs; qv[s][3] *= g0.w * rs; qv[s][4] *= g1.x * rs; qv[s][5] *= g1.y * rs; qv[s][6] *= g1.z * rs; qv[s][7] *= g1.w * rs; }
#pragma unroll
              for (int s = 0; s < 6; ++s) { v4u o; o.x = pk2(qv[s][0], qv[s][1]); o.y = pk2(qv[s][2], qv[s][3]); o.z = pk2(qv[s][4], qv[s][5]); o.w = pk2(qv[s][6], qv[s][7]); qf[s] = __builtin_bit_cast(bf16x8, o); } }
            f32x16 o0 = (f32x16){}, o1 = (f32x16){}; float l = 0.f;
#pragma unroll
            for (int j = 0; j < AT_D - 1; ++j) at_issue(F, kfb + (size_t)j * 3072, vfb + (size_t)j * 2048, ring + j * AT_SLOT);
#pragma unroll 1
            for (int kt = 0; kt < nkt; ++kt) {
                const int rem = nkt - 1 - kt;
                if (rem >= 2) asm volatile("s_waitcnt vmcnt(4)" ::: "memory"); else if (rem == 1) asm volatile("s_waitcnt vmcnt(2)" ::: "memory"); else asm volatile("s_waitcnt vmcnt(0)" ::: "memory");
                __builtin_amdgcn_s_barrier(); asm volatile("" ::: "memory");
                if (kt + AT_D - 1 < nkt) at_issue(F, kfb + (size_t)(kt + AT_D - 1) * 3072, vfb + (size_t)(kt + AT_D - 1) * 2048, ring + ((kt + AT_D - 1) & (AT_D - 1)) * AT_SLOT);
                if (kt < nkw) {
                    const LAS unsigned char* sl = ring + (kt & (AT_D - 1)) * AT_SLOT + F.lane * 16; const int j0 = 32 * kt;
                    f32x16 S = negm;
#pragma unroll
                    for (int s = 0; s < 6; ++s) S = MFMA32(*(const LAS bf16x8*)(sl + 1024 * s), qf[s], S);
                    bf16x8 vf[4];
#pragma unroll
                    for (int i = 0; i < 4; ++i) vf[i] = *(const LAS bf16x8*)(sl + 6144 + 1024 * i);
#pragma unroll
                    for (int i = 0; i < 16; ++i) S[i] = __builtin_amdgcn_exp2f(S[i]);
                    if (kt >= a) {
#pragma unroll
                        for (int i = 0; i < 16; ++i) if (j0 + crow(i, hi) > qi) S[i] = 0.f; }
#pragma unroll
                    for (int i = 0; i < 16; ++i) l += S[i];
                    const bf16x8 p0 = pack8(S, 0), p1 = pack8(S, 1);
                    o0 = MFMA32(vf[0], p0, o0); o0 = MFMA32(vf[1], p1, o0);
                    o1 = MFMA32(vf[2], p0, o1); o1 = MFMA32(vf[3], p1, o1);
                }
            }
            l += __shfl_xor(l, 32);
            const float il = 1.0f / l;
            bf16* ao = ATT + (size_t)(b * TT + qi) * 512 + 64 * h + 4 * hi;
#pragma unroll
            for (int gq = 0; gq < 4; ++gq) {
                v2u w0, w1; w0.x = pk2(o0[4 * gq] * il, o0[4 * gq + 1] * il); w0.y = pk2(o0[4 * gq + 2] * il, o0[4 * gq + 3] * il);
                w1.x = pk2(o1[4 * gq] * il, o1[4 * gq + 1] * il); w1.y = pk2(o1[4 * gq + 2] * il, o1[4 * gq + 3] * il);
                *(v2u*)(ao + 8 * gq) = w0; *(v2u*)(ao + 32 + 8 * gq) = w1; }
            asm volatile("s_waitcnt lgkmcnt(0)" ::: "memory"); __builtin_amdgcn_s_barrier(); asm volatile("" ::: "memory");
        }
    }
}

__device__ __forceinline__ void p5_ssd_out(Frame& F) {
    const float* DT = (const float*)(F.ws + WS_DT); const float* a_log = (const float*)F.in[13]; const float* d_skip = (const float*)F.in[14]; const float* ng = (const float*)F.in[15];
    const bf16* XST = (const bf16*)(F.ws + WS_XST); const bf16* BC = (const bf16*)(F.ws + WS_BC); const bf16* HIN = (const bf16*)(F.ws + WS_HIN); const bf16* PROJ = (const bf16*)(F.ws + WS_PROJ);
    bf16* MIX = (bf16*)(F.ws + WS_MIX);
    LAS float* tab = (LAS float*)(F.lds + RING_OFF + F.wave * 1024);
    LAS float* exch = (LAS float*)(F.lds + P5_EXCH + 2048);
    const int h = F.wave, g = h >> 2, r32 = F.lane & 31, hi = F.lane >> 5;
    const float A = -__expf(a_log[h]), Dh = d_skip[h];
    for (int u = blockIdx.x; u < NB * (NCH - 1); u += F.G) {
        const int b = u / (NCH - 1), c = 1 + u % (NCH - 1); const int tbase = c * CHL - TOFF;
        { const int t = tbase + F.lane; const float dt = (t >= 0) ? DT[(size_t)(b * TT + t) * 8 + h] : 0.f;
          float acs = dt * A;
#pragma unroll
          for (int o = 1; o < 64; o <<= 1) { const float v = __shfl_up(acs, o); if (F.lane >= o) acs += v; }
          tab[F.lane] = acs; tab[64 + F.lane] = dt; }
        LDS_WAIT(); asm volatile("" ::: "memory");
        const bf16* hb = HIN + ((size_t)((b * NCH + c) * NH + h)) * 4096 + 8 * hi;
        const bf16* xb = XST + ((size_t)(b * SSDW + h * HP)) * TPAD + c * CHL + 4 * hi;
#pragma unroll 1
        for (int it = 0; it < 2; ++it) {
            const int ii = 32 * it + r32; const int t = tbase + ii; const int tc = t < 0 ? 0 : t;
            bf16x8 cf[4], hf[2][4], bfr[4], xf[2][2]; v2u zw[2][4];
            { const bf16* cp = BC + (size_t)(b * TT + tc) * 256 + 128 + g * DS + 8 * hi;
#pragma unroll
              for (int s = 0; s < 4; ++s) cf[s] = *(const bf16x8*)(cp + 16 * s); }
#pragma unroll
            for (int pt = 0; pt < 2; ++pt)
#pragma unroll
                for (int s = 0; s < 4; ++s) hf[pt][s] = *(const bf16x8*)(hb + (size_t)(32 * pt + r32) * 64 + 16 * s);
#define SO_LOAD_J(jt) do { int tj = tbase + 32 * (jt) + r32; tj = tj < 0 ? 0 : tj; const bf16* bp = BC + (size_t)(b * TT + tj) * 256 + g * DS + 8 * hi; \
                _Pragma("unroll") for (int s = 0; s < 4; ++s) bfr[s] = *(const bf16x8*)(bp + 16 * s); \
                _Pragma("unroll") for (int pt = 0; pt < 2; ++pt) { const bf16* xp = xb + (size_t)(32 * pt + r32) * TPAD + 32 * (jt); xf[pt][0] = ld2x8(xp, xp + 8); xf[pt][1] = ld2x8(xp + 16, xp + 24); } } while (0)
            SO_LOAD_J(0);
            { const bf16* zp = PROJ + (size_t)(b * TT + tc) * PJ + C_Z + 64 * h + 4 * hi;
#pragma unroll
              for (int pt = 0; pt < 2; ++pt)
#pragma unroll
                  for (int gq = 0; gq < 4; ++gq) zw[pt][gq] = *(const v2u*)(zp + 32 * pt + 8 * gq); }
            f32x16 y[2];
            const float ai = tab[ii]; const float ei = __expf(ai);
#pragma unroll
            for (int pt = 0; pt < 2; ++pt) { f32x16 acc = (f32x16){};
#pragma unroll
                for (int s = 0; s < 4; ++s) acc = MFMA32(hf[pt][s], cf[s], acc);
#pragma unroll
                for (int i = 0; i < 16; ++i) acc[i] *= ei;
                y[pt] = acc; }
#pragma unroll 1
            for (int jt = 0; jt <= it; ++jt) {
                f32x16 S = (f32x16){};
#pragma unroll
                for (int s = 0; s < 4; ++s) S = MFMA32(bfr[s], cf[s], S);
#pragma unroll
                for (int i = 0; i < 16; ++i) { const int jj = 32 * jt + crow(i, hi); const float e = (jj <= ii) ? __expf(ai - tab[jj]) * tab[64 + jj] : 0.f; S[i] = S[i] * e + ((jj == ii) ? Dh : 0.f); }
                const bf16x8 p0 = pack8(S, 0), p1 = pack8(S, 1);
#pragma unroll
                for (int pt = 0; pt < 2; ++pt) { y[pt] = MFMA32(xf[pt][0], p0, y[pt]); y[pt] = MFMA32(xf[pt][1], p1, y[pt]); }
                if (jt < it) SO_LOAD_J(1);
            }
#undef SO_LOAD_J
            float ss = 0.f;
#pragma unroll
            for (int pt = 0; pt < 2; ++pt)
#pragma unroll
                for (int gq = 0; gq < 4; ++gq) { const float zz[4] = {bflo(zw[pt][gq].x), bfhi(zw[pt][gq].x), bflo(zw[pt][gq].y), bfhi(zw[pt][gq].y)};
#pragma unroll
                    for (int e = 0; e < 4; ++e) { const float v = y[pt][4 * gq + e] * silu_f(zz[e]); y[pt][4 * gq + e] = v; ss += v * v; } }
            ss += __shfl_xor(ss, 32);
            LAS float* ex = exch + it * 256;
            if (hi == 0) ex[h * 32 + r32] = ss;
            __syncthreads();
            const float tot = (ex[(4 * g) * 32 + r32] + ex[(4 * g + 1) * 32 + r32]) + (ex[(4 * g + 2) * 32 + r32] + ex[(4 * g + 3) * 32 + r32]);
            const float rs = 1.0f / sqrtf(tot * (1.f / 256.f) + EPS);
            if (t >= 0) { bf16* mo = MIX + (size_t)(b * TT + t) * 1024 + 64 * h + 4 * hi;
#pragma unroll
                for (int pt = 0; pt < 2; ++pt)
#pragma unroll
                    for (int gq = 0; gq < 4; ++gq) { const f32x4 gg = *(const f32x4*)(ng + 64 * h + 32 * pt + 8 * gq + 4 * hi);
                        v2u w; w.x = pk2(y[pt][4 * gq] * rs * gg.x, y[pt][4 * gq + 1] * rs * gg.y); w.y = pk2(y[pt][4 * gq + 2] * rs * gg.z, y[pt][4 * gq + 3] * rs * gg.w);
                        *(v2u*)(mo + 32 * pt + 8 * gq) = w; } }
        }
        __syncthreads();
    }
    const float* YS = (const float*)(F.ws + WS_YS);
    for (int u = F.gw; u < DB * NG; u += F.NGW) { const int b = u >> 1, gg = u & 1; const int cc = gg * 256 + 4 * F.lane;
        const f32x4 yv = *(const f32x4*)(YS + (size_t)b * 512 + cc); const v2u zw = *(const v2u*)(PROJ + (size_t)(RP + b) * PJ + C_Z + cc);
        const f32x4 v = {yv.x * silu_f(bflo(zw.x)), yv.y * silu_f(bfhi(zw.x)), yv.z * silu_f(bflo(zw.y)), yv.w * silu_f(bfhi(zw.y))};
        const float rs = 1.0f / sqrtf(wave_sum((v.x * v.x + v.y * v.y) + (v.z * v.z + v.w * v.w)) * (1.f / 256.f) + EPS);
        const f32x4 gv = *(const f32x4*)(ng + cc); v2u w; w.x = pk2(v.x * rs * gv.x, v.y * rs * gv.y); w.y = pk2(v.z * rs * gv.z, v.w * rs * gv.w);
        *(v2u*)(MIX + (size_t)(RP + b) * 1024 + cc) = w; }
}

constexpr int DB_STAGE = 0, DB_KRST = 65536, DB_LAT = DB_KRST + 8192, DB_KR = DB_LAT + 64 * DA_ROWB, DB_PB = DB_KR + 64 * 36 * 4, DB_QG = DB_PB + 16 * 64 * 2, DB_END = DB_QG + 8 * 96 * 4;
static_assert(DB_END <= RING_BYTES, "decode attention LDS map");
#define RAW_BAR_L() do { asm volatile("s_waitcnt lgkmcnt(0)" ::: "memory"); __builtin_amdgcn_s_barrier(); asm volatile("" ::: "memory"); } while (0)
#define RAW_BAR_VL() do { asm volatile("s_waitcnt vmcnt(0) lgkmcnt(0)" ::: "memory"); __builtin_amdgcn_s_barrier(); asm volatile("" ::: "memory"); } while (0)
__device__ __forceinline__ void da_issue(Frame& F, LAS unsigned char* L, const float* clat, const float* ckr, const int* ptab, int b, int split, int hp) {
    const size_t tok0 = (size_t)ptab[b * NPAGES + split * 32 + (hp >> 1)] * PAGE + (hp & 1) * 64;
    const char* src = (const char*)(clat + tok0 * KVL) + (size_t)(F.wave * 8) * 1024 + F.lane * 16;
#pragma unroll
    for (int i = 0; i < 8; ++i) __builtin_amdgcn_global_load_lds((const unsigned*)(src + i * 1024), (LAS unsigned*)(L + DB_STAGE + (F.wave * 8 + i) * 1024), 16, 0, 0);
    __builtin_amdgcn_global_load_lds((const unsigned*)((const char*)(ckr + tok0 * 32) + F.wave * 1024 + F.lane * 16), (LAS unsigned*)(L + DB_KRST + F.wave * 1024), 16, 0, 0);
}
__device__ __forceinline__ void da_convert(Frame& F, LAS unsigned char* L) {
#pragma unroll 4
    for (int k = 0; k < 8; ++k) { const int f = F.tid + NTHR * k; const int row = f >> 6, c4 = f & 63; const f32x4 v = *(const LAS f32x4*)(L + DB_STAGE + f * 16);
        v2u w; w.x = pk2(v.x, v.y); w.y = pk2(v.z, v.w); *(LAS v2u*)(L + DB_LAT + row * DA_ROWB + c4 * 8) = w; }
    { const int f = F.tid; const int row = f >> 3, c4 = f & 7; const f32x4 v = *(const LAS f32x4*)(L + DB_KRST + f * 16);
      *(LAS f32x4*)((LAS float*)(L + DB_KR) + row * 36 + 4 * c4) = v; }
}
template <int MODE>
__device__ __forceinline__ void p5_attn_decode_t(Frame& F, float M0) {
    const float* clat = (const float*)F.in[2]; const float* ckr = (const float*)F.in[3]; const int* ptab = (const int*)F.in[6];
    const bf16* WUKV = (const bf16*)(F.ws + WS_WUKV); const bf16* Q = (const bf16*)(F.ws + WS_Q); const float* gkn = (const float*)F.in[22]; const float* gkr = (const float*)F.in[23];
    float* DPART = (float*)(F.ws + WS_DPART);
    LAS unsigned char* L = F.lds + RING_OFF;
    LAS float* krl = (LAS float*)(L + DB_KR); LAS bf16* pb = (LAS bf16*)(L + DB_PB); LAS float* qg = (LAS float*)(L + DB_QG) + F.wave * 96;
    const int h = F.wave, r32 = F.lane & 31, hi = F.lane >> 5;
    for (int u = blockIdx.x; u < DB * 2; u += F.G) {
        const int b = u >> 1, split = u & 1;
        da_issue(F, L, clat, ckr, ptab, b, split, 0);
        bf16x8 wf[4][8];
#pragma unroll
        for (int dt = 0; dt < 4; ++dt)
#pragma unroll
            for (int s = 0; s < 8; ++s) wf[dt][s] = *(const bf16x8*)(WUKV + (size_t)(128 * h + 16 * dt + (F.lane & 15)) * KVL + 32 * s + 8 * (F.lane >> 4));
        { const bf16* qp = Q + (size_t)(RP + b) * 768 + 96 * h; qg[F.lane] = bf2f(qp[F.lane]) * gkn[F.lane]; if (F.lane < 32) qg[64 + F.lane] = bf2f(qp[64 + F.lane]) * gkr[F.lane & 15]; }
        for (int i = F.tid; i < 16 * 64; i += NTHR) pb[i] = 0;
        f32x4 ao[2] = {(f32x4){0.f, 0.f, 0.f, 0.f}, (f32x4){0.f, 0.f, 0.f, 0.f}}; float l = 0.f;
        RAW_BAR_VL();
        da_convert(F, L);
        RAW_BAR_L();
        da_issue(F, L, clat, ckr, ptab, b, split, 1);
#pragma unroll 1
        for (int hp = 0; hp < 64; ++hp) {
          if (MODE == 0 || MODE == 3) {
            const int n16 = F.lane & 15, kg4 = F.lane >> 4;
#pragma unroll 1
            for (int sb = 0; sb < 2; ++sb) {
                const LAS unsigned char* bp = L + DB_LAT + (32 * sb + n16) * DA_ROWB + 16 * kg4;
                f32x4 acc[4][2];
#pragma unroll
                for (int dt = 0; dt < 4; ++dt) { acc[dt][0] = (f32x4){0.f, 0.f, 0.f, 0.f}; acc[dt][1] = acc[dt][0]; }
                bf16x8 fa[2], fb[2];
                fa[0] = *(const LAS bf16x8*)(bp); fa[1] = *(const LAS bf16x8*)(bp + 16 * DA_ROWB);
#pragma unroll
                for (int s = 0; s < 8; ++s) {
                    if (s < 7) { fb[0] = *(const LAS bf16x8*)(bp + 64 * (s + 1)); fb[1] = *(const LAS bf16x8*)(bp + 16 * DA_ROWB + 64 * (s + 1)); }
#pragma unroll
                    for (int dt = 0; dt < 4; ++dt) { acc[dt][0] = MFMA16(wf[dt][s], fa[0], acc[dt][0]); acc[dt][1] = MFMA16(wf[dt][s], fa[1], acc[dt][1]); }
                    fa[0] = fb[0]; fa[1] = fb[1];
                }
                __builtin_amdgcn_sched_barrier(0);
                f32x4 s4[2] = {(f32x4){0.f, 0.f, 0.f, 0.f}, (f32x4){0.f, 0.f, 0.f, 0.f}}, d4[2] = {s4[0], s4[0]};
#pragma unroll
                for (int dt = 0; dt < 4; ++dt) { const f32x4 qq = *(const LAS f32x4*)(qg + 16 * dt + 4 * kg4);
#pragma unroll
                    for (int tt = 0; tt < 2; ++tt) { s4[tt] += acc[dt][tt] * acc[dt][tt]; d4[tt] += acc[dt][tt] * qq; } }
                { const LAS float* qr = qg + 64 + 8 * kg4; const f32x4 q0 = *(const LAS f32x4*)(qr), q1 = *(const LAS f32x4*)(qr + 4);
#pragma unroll
                  for (int tt = 0; tt < 2; ++tt) { const LAS float* kr = krl + (32 * sb + 16 * tt + n16) * 36 + 8 * kg4; const f32x4 k0 = *(const LAS f32x4*)(kr), k1 = *(const LAS f32x4*)(kr + 4);
                      s4[tt] += k0 * k0; s4[tt] += k1 * k1; d4[tt] += k0 * q0; d4[tt] += k1 * q1; } }
                __builtin_amdgcn_sched_barrier(0);
#pragma unroll
                for (int tt = 0; tt < 2; ++tt) { float ss = (s4[tt].x + s4[tt].y) + (s4[tt].z + s4[tt].w), dot = (d4[tt].x + d4[tt].y) + (d4[tt].z + d4[tt].w);
                    ss += __shfl_xor(ss, 16); dot += __shfl_xor(dot, 16); ss += __shfl_xor(ss, 32); dot += __shfl_xor(dot, 32);
                    const float p = __builtin_amdgcn_exp2f(dot * __builtin_amdgcn_rsqf(ss * (1.f / 96.f) + EPS) - M0);
                    if (kg4 == 0) { l += p; pb[h * 64 + 32 * sb + 16 * tt + n16] = f2bf(p); } }
            }
            RAW_BAR_L();
            if (MODE < 4) { const int q4 = (F.lane & 15) >> 2, pp = F.lane & 3, kg = F.lane >> 4;
              const unsigned a_lo = (unsigned)(uintptr_t)(L + DB_LAT) + (unsigned)((8 * kg + q4) * DA_ROWB + (32 * h + 4 * pp) * 2);
              const LAS bf16* pap = pb + (F.lane & 15) * 64 + 8 * kg;
              s16x4 t0, t1, t2, t3, t4, t5, t6, t7;
              asm volatile("ds_read_b64_tr_b16 %0, %8 offset:%c9\n\tds_read_b64_tr_b16 %1, %8 offset:%c10\n\tds_read_b64_tr_b16 %2, %8 offset:%c11\n\tds_read_b64_tr_b16 %3, %8 offset:%c12\n\t"
                           "ds_read_b64_tr_b16 %4, %8 offset:%c13\n\tds_read_b64_tr_b16 %5, %8 offset:%c14\n\tds_read_b64_tr_b16 %6, %8 offset:%c15\n\tds_read_b64_tr_b16 %7, %8 offset:%c16\n\ts_waitcnt lgkmcnt(0)"
                           : "=&v"(t0), "=&v"(t1), "=&v"(t2), "=&v"(t3), "=&v"(t4), "=&v"(t5), "=&v"(t6), "=&v"(t7)
                           : "v"(a_lo), "i"(0), "i"(4 * DA_ROWB), "i"(32), "i"(32 + 4 * DA_ROWB), "i"(32 * DA_ROWB), "i"(32 * DA_ROWB + 4 * DA_ROWB), "i"(32 * DA_ROWB + 32), "i"(32 * DA_ROWB + 32 + 4 * DA_ROWB) : "memory");
              const bf16x8 pa0 = *(const LAS bf16x8*)(pap), pa1 = *(const LAS bf16x8*)(pap + 32);
#define DA_FR(x, y) ((bf16x8){x[0], x[1], x[2], x[3], y[0], y[1], y[2], y[3]})
              ao[0] = MFMA16(pa0, DA_FR(t0, t1), ao[0]); ao[1] = MFMA16(pa0, DA_FR(t2, t3), ao[1]);
              ao[0] = MFMA16(pa1, DA_FR(t4, t5), ao[0]); ao[1] = MFMA16(pa1, DA_FR(t6, t7), ao[1]);
#undef DA_FR
#define DA_PV(ks, nt) do { } while (0)
#undef DA_PV
            }
          }
            RAW_BAR_VL();
            if (hp + 1 < 64) { if (MODE <= 1 || MODE >= 3) da_convert(F, L); RAW_BAR_L(); if (hp + 2 < 64 && MODE < 3) da_issue(F, L, clat, ckr, ptab, b, split, hp + 2); }
        }
        if (MODE >= 3 && l == 123.456f) DPART[0] = l;
        if (MODE == 0) { const int kg = F.lane >> 4;
          if (kg < 2) {
#pragma unroll
              for (int nt = 0; nt < 2; ++nt)
#pragma unroll
                  for (int i = 0; i < 4; ++i) DPART[((size_t)((b * 2 + split) * NH + 4 * kg + i)) * 264 + 32 * h + 16 * nt + (F.lane & 15)] = ao[nt][i]; }
          float lt = wave_sum(l);
          if (F.lane == 0) DPART[((size_t)((b * 2 + split) * NH + h)) * 264 + 256] = lt; }
        RAW_BAR_L();
    }
}

__device__ __forceinline__ void p5_attn_decode(Frame& F, float M0) { p5_attn_decode_t<0>(F, M0); }

__device__ __forceinline__ void p6_decode_combine(Frame& F, float M0) {
    {
      const bf16* ATT = (const bf16*)(F.ws + WS_ATT); bf16* MIXo = (bf16*)(F.ws + WS_MIX); const float* mgg = (const float*)F.in[24];
      const f32x4 g0 = ((const f32x4*)mgg)[2 * F.lane], g1 = ((const f32x4*)mgg)[2 * F.lane + 1];
      for (int r0 = 4 * F.gw; r0 < MMAIN; r0 += 4 * F.NGW) { v4u xx[4];
#pragma unroll
          for (int i = 0; i < 4; ++i) { const int r = r0 + i; const size_t row = (size_t)(r >> 11) * TT + NMETA + (r & 2047); xx[i] = *(const v4u*)(ATT + row * 512 + 8 * F.lane); }
#pragma unroll
          for (int i = 0; i < 4; ++i) { const int r = r0 + i; const size_t row = (size_t)(r >> 11) * TT + NMETA + (r & 2047); const v4u x = xx[i];
          const float v[8] = {bflo(x.x), bfhi(x.x), bflo(x.y), bfhi(x.y), bflo(x.z), bfhi(x.z), bflo(x.w), bfhi(x.w)};
          float ss = 0.f;
#pragma unroll
          for (int e = 0; e < 8; ++e) ss += v[e] * v[e];
          const float rs = 1.0f / sqrtf(wave_sum(ss) * (1.f / MLAW) + EPS);
          v4u o; o.x = pk2(v[0] * rs * g0.x, v[1] * rs * g0.y); o.y = pk2(v[2] * rs * g0.z, v[3] * rs * g0.w); o.z = pk2(v[4] * rs * g1.x, v[5] * rs * g1.y); o.w = pk2(v[6] * rs * g1.z, v[7] * rs * g1.w);
          *(v4u*)(MIXo + row * 1024 + 512 + 8 * F.lane) = o; } } }
    const float* DPART = (const float*)(F.ws + WS_DPART); const bf16* WUKV = (const bf16*)(F.ws + WS_WUKV); const bf16* Q = (const bf16*)(F.ws + WS_Q); const bf16* KS = (const bf16*)(F.ws + WS_KS);
    const float* VS = (const float*)(F.ws + WS_VS); const float* mg = (const float*)F.in[24]; bf16* MIX = (bf16*)(F.ws + WS_MIX);
    LAS float* accl = (LAS float*)(F.lds + RING_OFF) + F.wave * 256; LAS float* exch = (LAS float*)(F.lds + P5_EXCH);
    const int h = F.wave;
    for (int b = blockIdx.x; b < DB; b += F.G) {
        const float* p0 = DPART + ((size_t)((b * 2 + 0) * NH + h)) * 264; const float* p1 = DPART + ((size_t)((b * 2 + 1) * NH + h)) * 264;
#pragma unroll
        for (int k = 0; k < 4; ++k) accl[F.lane + 64 * k] = p0[F.lane + 64 * k] + p1[F.lane + 64 * k];
        float l = p0[256] + p1[256];
        const bf16* qp = Q + (size_t)(RP + b) * 768 + 96 * h; const bf16* kp = KS + (size_t)b * 768 + 96 * h;
        float sd = bf2f(qp[F.lane]) * bf2f(kp[F.lane]); if (F.lane < 32) sd += bf2f(qp[64 + F.lane]) * bf2f(kp[64 + F.lane]);
        sd = wave_sum(sd);
        const float pn = __builtin_amdgcn_exp2f(sd - M0); l += pn;
        LDS_WAIT(); asm volatile("" ::: "memory");
        const bf16* wv = WUKV + (size_t)(128 * h + 64 + F.lane) * KVL;
        float o = 0.f;
        { v4u wv4[32];
#pragma unroll
          for (int c8 = 0; c8 < 32; ++c8) wv4[c8] = *(const v4u*)(wv + 8 * c8);
#pragma unroll
          for (int c8 = 0; c8 < 32; ++c8) { const v4u w = wv4[c8]; const f32x4 x0 = *(const LAS f32x4*)(accl + 8 * c8), x1 = *(const LAS f32x4*)(accl + 8 * c8 + 4);
            o += (bflo(w.x) * x0.x + bfhi(w.x) * x0.y) + (bflo(w.y) * x0.z + bfhi(w.y) * x0.w) + (bflo(w.z) * x1.x + bfhi(w.z) * x1.y) + (bflo(w.w) * x1.z + bfhi(w.w) * x1.w); } }
        o = (o + pn * VS[(size_t)b * 512 + 64 * h + F.lane]) / l;
        const float ss = wave_sum(o * o);
        if (F.lane == 0) exch[h] = ss;
        __syncthreads();
        float tot = 0.f;
#pragma unroll
        for (int hh = 0; hh < NH; ++hh) tot += exch[hh];
        const float rs = 1.0f / sqrtf(tot * (1.f / MLAW) + EPS);
        MIX[(size_t)(RP + b) * 1024 + 512 + 64 * h + F.lane] = f2bf(o * rs * mg[64 * h + F.lane]);
        __syncthreads();
    }
}

__device__ __forceinline__ void p7_outproj(Frame& F) {
    const bf16* MIX = (const bf16*)(F.ws + WS_MIX); const bf16* WOUT = (const bf16*)(F.ws + WS_WOUT); const float* xp = (const float*)F.in[0]; const float* xs = (const float*)F.in[1]; float* HS = (float*)(F.ws + WS_HS);
    bf16* HB = (bf16*)(F.ws + WS_XN); float* SS = (float*)(F.ws + WS_SSP);
    { pg8::Gemm g{MIX, WOUT, MMAIN, DM, 1024, 1}; pg8::StaticOrder S; S.init(MMAIN, DM, F.G, (int)blockIdx.x); EpiOutProj E{xp, F.out + OUT_YP, HB, SS};
      pg8::gemm_phase<EpiOutProj, pg8::StaticOrder, true, true>(F.lds + RING_OFF, g, S, E); }
    small_gemm(MIX, 1024, WOUT, 1024, DB / 16, DM / 16, [](int r) { return RP + r; },
        [&](const f32x4& acc, int rt, int ct, int lane) { const int col = ct * 16 + (lane & 15);
#pragma unroll
            for (int i = 0; i < 4; ++i) { const int r = rt * 16 + 4 * (lane >> 4) + i; const size_t o = (size_t)r * DM + col; const float v = xs[o] + acc[i]; HS[o] = v; HB[(size_t)(RP + r) * DM + col] = f2bf(v);
                float ss = v * v; ss += __shfl_xor(ss, 1); ss += __shfl_xor(ss, 2); ss += __shfl_xor(ss, 4); ss += __shfl_xor(ss, 8);
                if ((lane & 15) == 0) SS[(size_t)MMAIN * 16 + (size_t)r * 64 + ct] = ss; } }, F.gw, F.NGW, F.lane);
}
__device__ __forceinline__ void p9_gateup(Frame& F) {
    const bf16* HB = (const bf16*)(F.ws + WS_XN); const bf16* WGU = (const bf16*)(F.ws + WS_WGU); bf16* ACT = (bf16*)(F.ws + WS_ACT); const float* SS = (const float*)(F.ws + WS_SSP);
    { pg8::Gemm g{HB, WGU, MMAIN, 2 * DFF, DM, 1}; pg8::StaticOrder S; S.init(MMAIN, 2 * DFF, F.G, (int)blockIdx.x); EpiSwiGLU E{ACT, SS};
      pg8::gemm_phase<EpiSwiGLU, pg8::StaticOrder, true, true>(F.lds + RING_OFF, g, S, E); }
    const int gw = F.gw, ngw = F.NGW;
    const int nrt = DB / 16, nlt = DFF / 16;
    for (int task = gw; task < nrt * nlt; task += ngw) {
        const int rt = task % nrt, lt = task / nrt; const int lc = lt * 16 + (F.lane & 15);
        const bf16* ap = HB + (size_t)(RP + rt * 16 + (F.lane & 15)) * DM + 8 * (F.lane >> 4);
        const bf16* gp = WGU + (size_t)(256 * (lc >> 7) + (lc & 127)) * DM + 8 * (F.lane >> 4); const bf16* up = gp + (size_t)128 * DM;
        f32x4 ag = {0.f, 0.f, 0.f, 0.f}, au = {0.f, 0.f, 0.f, 0.f};
#pragma unroll 8
        for (int k0 = 0; k0 < DM; k0 += 32) { const bf16x8 a = *(const bf16x8*)(ap + k0); ag = MFMA16(a, *(const bf16x8*)(gp + k0), ag); au = MFMA16(a, *(const bf16x8*)(up + k0), au); }
#pragma unroll
        for (int i = 0; i < 4; ++i) { const int r = rt * 16 + 4 * (F.lane >> 4) + i; const f32x4* sp = (const f32x4*)(SS + (size_t)MMAIN * 16 + (size_t)r * 64); f32x4 s4 = sp[0];
#pragma unroll
            for (int q = 1; q < 16; ++q) s4 += sp[q];
            const float rs = 1.0f / sqrtf(((s4[0] + s4[1]) + (s4[2] + s4[3])) * (1.f / DM) + EPS);
            ACT[(size_t)(RP + r) * DFF + lc] = f2bf(silu_f(rs * ag[i]) * (rs * au[i])); }
    }
}
__device__ __forceinline__ void p10_down(Frame& F) {
    const bf16* ACT = (const bf16*)(F.ws + WS_ACT); const bf16* WDN = (const bf16*)(F.ws + WS_WDN); const float* HS = (const float*)(F.ws + WS_HS);
    { pg8::Gemm g{ACT, WDN, MMAIN, DM, DFF, 1}; pg8::StaticOrder S; S.init(MMAIN, DM, F.G, (int)blockIdx.x); EpiDown E{(const bf16*)(F.ws + WS_XN), F.out + OUT_YP};
      pg8::gemm_phase<EpiDown, pg8::StaticOrder, true, true>(F.lds + RING_OFF, g, S, E); }
    float* ys = F.out + OUT_YS;
    small_gemm(ACT, DFF, WDN, DFF, DB / 16, DM / 16, [](int r) { return RP + r; },
        [&](const f32x4& acc, int rt, int ct, int lane) { const int col = ct * 16 + (lane & 15);
#pragma unroll
            for (int i = 0; i < 4; ++i) { const size_t o = (size_t)(rt * 16 + 4 * (lane >> 4) + i) * DM + col; ys[o] = HS[o] + acc[i]; } }, F.gw, F.NGW, F.lane);
}
#ifndef MK_ONE_LAUNCH
#define MK_ONE_LAUNCH 0
#endif
constexpr int N_PHASES = 10;
__global__ void __launch_bounds__(NTHR, 2) mk_fwd(Args args) {
    extern __shared__ __attribute__((aligned(16))) unsigned char lds_raw[];
    Frame F;
    F.lds = (LAS unsigned char*)lds_raw;
    F.tid = threadIdx.x; F.lane = F.tid & 63; F.wave = __builtin_amdgcn_readfirstlane(F.tid >> 6);
    F.G = gridDim.x; { const int bx = blockIdx.x; F.vcu = (F.G % 8 == 0) ? (bx % 8) * (F.G / 8) + bx / 8 : bx; }
    F.gw = blockIdx.x * NWAVES + F.wave; F.NGW = F.G * NWAVES;
    F.ws = args.ws; F.out = args.out; F.in = args.in;
    volatile LAS unsigned* MISC = (volatile LAS unsigned*)(F.lds + MISC_OFF);
    for (int u = F.tid; u < (LDS_BYTES - LDSCTL_OFF) / 4; u += NTHR) ((LAS unsigned*)(F.lds + LDSCTL_OFF))[u] = 0u;
    __syncthreads();
    XcdBarrier bar; bar.bar = (unsigned*)(F.ws + WS_CTL) + CW_BAR; bar.x = 0; bar.st = nullptr;
    const int lo = args.ph_lo, hi = args.ph_hi;
    if (hi - lo > 1) bar = xcd_barrier_post((unsigned*)(F.ws + WS_CTL) + CW_BAR, MISC + 8);
#ifdef MK_TS
    unsigned long long* TSB = (unsigned long long*)(F.ws + 600 * MiB); int tsn = 0;
#define STAMP() do { if (blockIdx.x == 0 && F.tid == 0) TSB[tsn] = __builtin_amdgcn_s_memrealtime(); ++tsn; } while (0)
    STAMP();
#else
#define STAMP() do { } while (0)
#endif
#define IN(k) (lo <= (k) && (k) < hi)
#define SEAM(k) do { if (IN(k) && IN((k) + 1)) xcd_barrier(bar); STAMP(); } while (0)
#ifndef MK_REPEAT
#define MK_REPEAT 0
#endif
#define REP(id, stmt) do { stmt; if (MK_REPEAT & (1 << (id))) { __syncthreads(); stmt; } } while (0)
    if (IN(0)) { REP(0, p0_prologue(F)); } SEAM(0);
    if (IN(1)) { REP(1, p1_inproj(F)); } SEAM(1);
    if (IN(2)) {
#ifdef MK_SLEEP_PROBE
        { const unsigned long long t0 = __builtin_amdgcn_s_memrealtime(); while (__builtin_amdgcn_s_memrealtime() - t0 < 3000ull) __builtin_amdgcn_s_sleep(32); }
#endif
        REP(2, p2_elementwise(F)); } SEAM(2);
    if (IN(3)) { REP(3, p3_upproj_states(F)); } SEAM(3);
    if (IN(4)) { REP(4, p4_post(F)); } SEAM(4);
    if (IN(5)) { const float M0 = softmax_ref(F); REP(5, p5_attn_prompt(F, M0)); __syncthreads();
#ifdef MK_TS5
        STAMP();
#endif
        REP(6, p5_ssd_out(F)); __syncthreads();
#ifdef MK_TS5
        STAMP();
#endif
        REP(7, p5_attn_decode(F, M0));
#ifdef MK_DA_PROBE
        __syncthreads(); p5_attn_decode_t<MK_DA_PROBE>(F, M0);
#endif
    } SEAM(5);
    if (IN(6)) { const float M0 = softmax_ref(F); REP(8, p6_decode_combine(F, M0)); } SEAM(6);
    if (IN(7)) { REP(9, p7_outproj(F)); } SEAM(7);
    if (IN(8)) { REP(11, p9_gateup(F)); } SEAM(8);
    if (IN(9)) { p10_down(F); }
#ifdef MK_TS
    __syncthreads(); STAMP();
#endif
#undef IN
#undef SEAM
}
#ifndef MK_DIAG
#define MK_DIAG 0
#endif
__device__ __forceinline__ size_t nmrow(size_t r) { return r < (size_t)MMAIN ? (r >> 11) * TT + NMETA + (r & 2047) : (size_t)RP + (r - MMAIN); }
constexpr size_t WS_OUT2 = 1024 * MiB;
#ifdef MK_TS
__global__ void k_ts_encode(const unsigned long long* ts, float* out, int ia0, int ia1, int ib0, int ib1) {
    const float ta = (float)(ts[ia1] - ts[ia0]) * 0.01f, tb = (float)(ts[ib1] - ts[ib0]) * 0.01f;
    const float f = 1.f + sqrtf(ta * 1e-3f);
    for (int i = blockIdx.x * blockDim.x + threadIdx.x; i < 131072; i += gridDim.x * blockDim.x) out[OUT_YS + i] *= f;
    if (blockIdx.x == 0 && threadIdx.x == 0) out[0] += tb * 0.1f;
}
#endif
extern "C" void kernel_launch(void* const* d_in, const int* in_sizes, int n_in, void* d_out, int out_size, void* d_ws, size_t ws_size, hipStream_t stream) {
    (void)hipFuncSetAttribute((const void*)mk_fwd, hipFuncAttributeMaxDynamicSharedMemorySize, LDS_BYTES);
    unsigned char* ws = (unsigned char*)d_ws;
    (void)hipMemsetAsync(ws + WS_CTL, 0, CTL_ZERO_BYTES, stream);
    Args a{};
    for (int i = 0; i < 30; ++i) a.in[i] = d_in[i];
    a.ws = ws; a.out = (float*)d_out;
#if MK_DIAG
    float* diag = (float*)(ws + WS_DIAG);
    (void)hipMemsetAsync(diag, 0, 512, stream);
    nv::forward(d_in, (float*)d_out, (float*)(ws + WS_NAIVE), stream);
    a.out = (float*)(ws + WS_OUT2);
#endif
    static int one_launch = -1;
    if (one_launch < 0) { int dev = 0, cus = 0, per_cu = 0; one_launch = 0;
        if (hipGetDevice(&dev) == hipSuccess && hipDeviceGetAttribute(&cus, hipDeviceAttributeMultiprocessorCount, dev) == hipSuccess && cus >= 256) one_launch = 1;
        (void)per_cu;
        (void)hipGetLastError(); }
    const int grid = 256;
    if (one_launch && MK_ONE_LAUNCH) { a.ph_lo = 0; a.ph_hi = N_PHASES; a.li = 0; hipLaunchKernelGGL(mk_fwd, dim3(grid), dim3(NTHR), LDS_BYTES, stream, a); }
    else for (int ph = 0; ph < N_PHASES; ++ph) { a.ph_lo = ph; a.ph_hi = ph + 1; a.li = ph; hipLaunchKernelGGL(mk_fwd, dim3(grid), dim3(NTHR), LDS_BYTES, stream, a); }
#ifdef MK_TS
    k_ts_encode<<<64, 256, 0, stream>>>((const unsigned long long*)(ws + 600 * MiB), (float*)d_out, MK_TS_A0, MK_TS_A1, MK_TS_B0, MK_TS_B1);
#endif
#if MK_DIAG
    {
        nv::Ws w = nv::carve((float*)(ws + WS_NAIVE));
        const bf16* QRAW = (const bf16*)(ws + WS_QRAW); const bf16* KVRAW = (const bf16*)(ws + WS_KVRAW); const bf16* Q = (const bf16*)(ws + WS_Q); const bf16* K = (const bf16*)(ws + WS_K);
        const bf16* VT = (const bf16*)(ws + WS_VT); const float* VS = (const float*)(ws + WS_VS); const bf16* MIX = (const bf16*)(ws + WS_MIX);
        const float* o2 = (const float*)(ws + WS_OUT2); const float* o1 = (const float*)d_out;
        const float* nQRAW = w.QRAW; const float* nKV = w.KV; const float* nQ = w.Q; const float* nK = w.K; const float* nV = w.V; const float* nMIX = w.MIX;
        const size_t NMR = (size_t)MMAIN + DB;
        cmp(stream, 0, diag, NMR * 768, [=] __device__(size_t i) { return bf2f(QRAW[nmrow(i / 768) * 768 + i % 768]); }, [=] __device__(size_t i) { return nQRAW[nmrow(i / 768) * 768 + i % 768]; });
        cmp(stream, 1, diag, (size_t)R * 1024, [=] __device__(size_t i) { return bf2f(KVRAW[i]); }, [=] __device__(size_t i) { return nKV[i]; });
        cmp(stream, 2, diag, NMR * 768, [=] __device__(size_t i) { return bf2f(Q[nmrow(i / 768) * 768 + i % 768]); }, [=] __device__(size_t i) { return nQ[nmrow(i / 768) * 768 + i % 768] * (ATTN_SCALE * LOG2E); });
        cmp(stream, 3, diag, (size_t)R * 768, [=] __device__(size_t i) { return bf2f(K[i]); }, [=] __device__(size_t i) { return nK[i]; });
        cmp(stream, 4, diag, (size_t)NB * 512 * TT, [=] __device__(size_t i) { const size_t bhd = i / TT; const int t = (int)(i % TT); return bf2f(VT[bhd * TPAD + t]); },
            [=] __device__(size_t i) { const size_t bhd = i / TT; const int t = (int)(i % TT); const size_t b = bhd / 512, hd = bhd % 512; return nV[(b * TT + t) * 512 + hd]; });
        cmp(stream, 4, diag, (size_t)DB * 512, [=] __device__(size_t i) { return VS[i]; }, [=] __device__(size_t i) { return nV[(size_t)RP * 512 + i]; });
        cmp(stream, 5, diag, (size_t)(OUT_LATS - OUT_SSMP), [=] __device__(size_t i) { return o2[OUT_SSMP + i]; }, [=] __device__(size_t i) { return o1[OUT_SSMP + i]; });
        cmp(stream, 5, diag, (size_t)4194304, [=] __device__(size_t i) { return o2[OUT_SSMS + i]; }, [=] __device__(size_t i) { return o1[OUT_SSMS + i]; });
        cmp(stream, 6, diag, (size_t)R * 512, [=] __device__(size_t i) { return bf2f(MIX[(i >> 9) * 1024 + (i & 511)]); }, [=] __device__(size_t i) { return nMIX[(i >> 9) * 1024 + (i & 511)]; });
        cmp(stream, 7, diag, NMR * 512, [=] __device__(size_t i) { return bf2f(MIX[nmrow(i >> 9) * 1024 + 512 + (i & 511)]); }, [=] __device__(size_t i) { return nMIX[nmrow(i >> 9) * 1024 + 512 + (i & 511)]; });
        cmp(stream, 8, diag, (size_t)OUT_LATP, [=] __device__(size_t i) { return o2[i]; }, [=] __device__(size_t i) { return o1[i]; });
        k_diag_encode<<<64, 256, 0, stream>>>(diag, 9, 1e-3f, (float*)d_out);
    }
#endif
}
```

```cpp
#define MK_DIAG 0
#define MK_ONE_LAUNCH 1
#include <hip/hip_runtime.h>
#include <cstdio>
#include <cstdint>
namespace pg8 {
#define PG8_LAS __attribute__((address_space(3)))
typedef unsigned short bf16_t;
typedef short bf16x8 __attribute__((ext_vector_type(8)));
typedef float f32x4 __attribute__((ext_vector_type(4)));
typedef unsigned u32x4 __attribute__((ext_vector_type(4)));
constexpr int BM = 256, BK = 64, HALF = 128, HTB = HALF * BK * 2  , STAGE_BYTES = 8 * HTB, NXCD = 8, WGM = 8;

__host__ __device__ __forceinline__ int lds_byte(int r, int c) { const int st = (r >> 4) * 2 + (c >> 5), rr = r & 15, cc = c & 31, ob = rr * 64 + cc * 2; return st * 1024 + (ob ^ (((ob >> 9) & 1) << 5)); }
__host__ __device__ __forceinline__ void stage_rc(int b, int& R, int& C) { const int st = b / 1024, sb = b % 1024, swz = sb ^ (((sb >> 9) & 1) << 5); R = (st >> 1) * 16 + swz / 64; C = (st & 1) * 32 + (swz % 64) / 2; }
__host__ __device__ __forceinline__ int perm32(int rho) { const int n = rho >> 4, i = rho & 15; return 8 * (i >> 2) + 4 * n + (i & 3); }

struct Unit { int pm, pn; };
struct Gemm { const bf16_t* A; const bf16_t* Bt; int M, N, K; int rmode;
    __host__ __device__ __forceinline__ int rowbase(int pm) const { return rmode ? (pm >> 3) * 2064 + 16 + (pm & 7) * 256 : pm * 256; } };

struct StaticOrder {
    int nM, nN, nwg, G, c;
    __host__ __device__ void init(int M, int N, int G_, int c_) { nM = M / BM; nN = N / BM; nwg = nM * nN; G = G_; c = c_; }
    __host__ __device__ bool next(int i, Unit& u) const {
        const long L = (long)i * G + c; if (L >= nwg) return false;
        int wgid = (int)L; { const int q = nwg / NXCD, r = nwg % NXCD, xcd = wgid % NXCD, off = wgid / NXCD; wgid = (xcd < r ? xcd * (q + 1) : r * (q + 1) + (xcd - r) * q) + off; }
        const int nig = WGM * nN, gid = wgid / nig, fm = gid * WGM, gsz = (nM - fm) < WGM ? (nM - fm) : WGM;
        u.pm = fm + ((wgid % nig) % gsz); u.pn = (wgid % nig) / gsz; return true;
    }
    __device__ __forceinline__ void a_ready(const Unit&) const {}
    __device__ __forceinline__ void done(const Unit&) const {}
};


template <class Epi, class Sched, bool ALIGN_EPI = false, bool SP2 = false>
__device__ __forceinline__ void gemm_phase(PG8_LAS unsigned char* lds, const Gemm g, const Sched& S, const Epi& E) {
    const int tid = threadIdx.x, wid = __builtin_amdgcn_readfirstlane(tid >> 6), lane = tid & 63, wr = wid >> 2, wc = wid & 3, fr = lane & 15, fq = lane >> 4;
    const int K = g.K, nt = K / BK;
    unsigned voffA[2], voffB[2];
#pragma unroll
    for (int i = 0; i < 2; ++i) { int R, C; stage_rc(tid * 16 + i * 8192, R, C); const int Rb = Epi::PERM ? ((R & ~31) + perm32(R & 31)) : R;
        voffA[i] = (unsigned)(R * K + C) * 2u; voffB[i] = (unsigned)(Rb * K + C) * 2u; }
    const size_t kstep = (size_t)(BK * 2);
    const size_t hstep = (size_t)HALF * K * 2;
    const size_t tstep = 2 * hstep;
    const unsigned ldsw = (unsigned)wid * 1024u;
    const int aoff = lds_byte(wr * 64 + fr, fq * 8), boff = lds_byte(wc * 32 + fr, fq * 8);
#define PG8_SA(b, h) (((b) * 2 + (h)) * HTB)
#define PG8_SB(b, h) ((4 + (b) * 2 + (h)) * HTB)
#define PG8_STAGE(bufoff, gbase, voff) do { _Pragma("unroll") for (int _i = 0; _i < 2; ++_i) \
        __builtin_amdgcn_global_load_lds((const unsigned*)((const char*)(gbase) + (voff)[_i]), (PG8_LAS unsigned*)(lds + (bufoff) + ldsw + _i * 8192), 16, 0, 0); } while (0)
#define PG8_LDA(dst, b, h) do { _Pragma("unroll") for (int m = 0; m < 4; ++m) _Pragma("unroll") for (int k = 0; k < 2; ++k) dst[m][k] = *(const PG8_LAS bf16x8*)(lds + PG8_SA(b, h) + aoff + m * 2048 + k * 1024); } while (0)
#define PG8_LDB(dst, b, h) do { _Pragma("unroll") for (int n = 0; n < 2; ++n) _Pragma("unroll") for (int k = 0; k < 2; ++k) dst[n][k] = *(const PG8_LAS bf16x8*)(lds + PG8_SB(b, h) + boff + n * 2048 + k * 1024); } while (0)
#define PG8_MMA(ai, bj, At, Bt) do { __builtin_amdgcn_s_setprio(1); _Pragma("unroll") for (int m = 0; m < 4; ++m) _Pragma("unroll") for (int n = 0; n < 2; ++n) _Pragma("unroll") for (int k = 0; k < 2; ++k) \
        acc[ai][bj][m][n] = __builtin_amdgcn_mfma_f32_16x16x32_bf16(Bt[n][k], At[m][k], acc[ai][bj][m][n], 0, 0, 0); __builtin_amdgcn_s_setprio(0); } while (0)
#define PG8_WAIT_V(n) asm volatile("s_waitcnt vmcnt(" #n ")" ::: "memory")
#define PG8_WAIT_L(n) asm volatile("s_waitcnt lgkmcnt(" #n ")" ::: "memory")
#define PG8_BAR __builtin_amdgcn_s_barrier()
#define PG8_SCHED __builtin_amdgcn_sched_barrier(0)
    Unit cur, nxt; int ui = 0;
    if (!S.next(0, cur)) return;
    f32x4 acc[2][2][4][2];
#pragma unroll
    for (int a = 0; a < 2; ++a)
#pragma unroll
        for (int b = 0; b < 2; ++b)
#pragma unroll
            for (int m = 0; m < 4; ++m)
#pragma unroll
                for (int n = 0; n < 2; ++n) acc[a][b][m][n] = (f32x4){0.f, 0.f, 0.f, 0.f};
    bf16x8 At[4][2], B0[2][2], B1[2][2];
    const char* cA = (const char*)g.A + (size_t)g.rowbase(cur.pm) * K * 2; const char* cB = (const char*)g.Bt + (size_t)cur.pn * tstep;
    S.a_ready(cur);
    if constexpr (SP2) {
        PG8_STAGE(PG8_SB(0, 0), cB, voffB); PG8_STAGE(PG8_SB(0, 1), cB + hstep, voffB); PG8_STAGE(PG8_SA(0, 0), cA, voffA); PG8_STAGE(PG8_SA(0, 1), cA + hstep, voffA);
        if (wr == 1) PG8_BAR;
        PG8_WAIT_V(2); PG8_BAR;
        PG8_STAGE(PG8_SB(1, 0), cB + kstep, voffB); PG8_STAGE(PG8_SA(1, 0), cA + kstep, voffA); PG8_STAGE(PG8_SB(1, 1), cB + hstep + kstep, voffB);
        PG8_WAIT_V(6); PG8_BAR;
    } else {
        PG8_STAGE(PG8_SB(0, 0), cB, voffB); PG8_STAGE(PG8_SA(0, 0), cA, voffA); PG8_STAGE(PG8_SB(0, 1), cB + hstep, voffB); PG8_STAGE(PG8_SA(0, 1), cA + hstep, voffA);
        if (wr == 1) PG8_BAR;
        PG8_WAIT_V(4); PG8_BAR;
        PG8_STAGE(PG8_SB(1, 0), cB + kstep, voffB); PG8_STAGE(PG8_SA(1, 0), cA + kstep, voffA); PG8_STAGE(PG8_SB(1, 1), cB + hstep + kstep, voffB);
        PG8_WAIT_V(6); PG8_BAR;
    }
    for (;;) {
        const bool has_next = S.next(ui + 1, nxt);
        const char* nA = has_next ? (const char*)g.A + (size_t)g.rowbase(nxt.pm) * K * 2 : cA; const char* nB = has_next ? (const char*)g.Bt + (size_t)nxt.pn * tstep : cB;
        for (int t = 0; t < nt; t += 2) {
            const bool last = (t == nt - 2);
            const char* a1 = cA + (size_t)(t + 1) * kstep;
            const char* a2 = last ? nA : cA + (size_t)(t + 2) * kstep; const char* b2 = last ? nB : cB + (size_t)(t + 2) * kstep;
            const char* a3 = a2 + kstep; const char* b3 = b2 + kstep;
            if (last && has_next) S.a_ready(nxt);
            if constexpr (SP2) {
            PG8_LDB(B0, 0, 0); PG8_LDB(B1, 0, 1); PG8_SCHED; PG8_LDA(At, 0, 0); PG8_STAGE(PG8_SA(1, 1), a1 + hstep, voffA);
            PG8_WAIT_V(8); PG8_WAIT_L(0); PG8_BAR; PG8_MMA(0, 0, At, B0); PG8_MMA(0, 1, At, B1); PG8_BAR; PG8_SCHED;
            PG8_LDA(At, 0, 1); PG8_STAGE(PG8_SB(0, 0), b2, voffB); PG8_STAGE(PG8_SB(0, 1), b2 + hstep, voffB); PG8_STAGE(PG8_SA(0, 0), a2, voffA);
            PG8_WAIT_V(8); PG8_WAIT_L(0); PG8_BAR; PG8_MMA(1, 0, At, B0); PG8_MMA(1, 1, At, B1); PG8_BAR; PG8_SCHED;
            PG8_LDB(B0, 1, 0); PG8_LDB(B1, 1, 1); PG8_SCHED; PG8_LDA(At, 1, 0); PG8_STAGE(PG8_SA(0, 1), a2 + hstep, voffA);
            PG8_WAIT_V(8); PG8_WAIT_L(0); PG8_BAR; PG8_MMA(0, 0, At, B0); PG8_MMA(0, 1, At, B1); PG8_BAR; PG8_SCHED;
            PG8_LDA(At, 1, 1); PG8_STAGE(PG8_SB(1, 0), b3, voffB); PG8_STAGE(PG8_SB(1, 1), b3 + hstep, voffB); PG8_STAGE(PG8_SA(1, 0), a3, voffA);
            PG8_WAIT_V(8); PG8_WAIT_L(0); PG8_BAR; PG8_MMA(1, 0, At, B0); PG8_MMA(1, 1, At, B1); PG8_BAR; PG8_SCHED;
            } else {
            PG8_LDB(B0, 0, 0); PG8_SCHED; PG8_LDA(At, 0, 0); PG8_STAGE(PG8_SA(1, 1), a1 + hstep, voffA);
            PG8_WAIT_L(8); PG8_BAR; PG8_WAIT_L(0); PG8_MMA(0, 0, At, B0); PG8_BAR; PG8_SCHED;
            PG8_LDB(B1, 0, 1); PG8_STAGE(PG8_SB(0, 0), b2, voffB);
            PG8_BAR; PG8_WAIT_L(0); PG8_MMA(0, 1, At, B1); PG8_BAR;
            PG8_LDA(At, 0, 1); PG8_STAGE(PG8_SA(0, 0), a2, voffA);
            PG8_BAR; PG8_WAIT_L(0); PG8_MMA(1, 0, At, B0); PG8_BAR; PG8_SCHED;
            PG8_STAGE(PG8_SB(0, 1), b2 + hstep, voffB);
            PG8_WAIT_V(6); PG8_BAR; PG8_MMA(1, 1, At, B1); PG8_BAR;
            PG8_LDB(B0, 1, 0); PG8_SCHED; PG8_LDA(At, 1, 0); PG8_STAGE(PG8_SA(0, 1), a2 + hstep, voffA);
            PG8_WAIT_L(8); PG8_BAR; PG8_WAIT_L(0); PG8_MMA(0, 0, At, B0); PG8_BAR; PG8_SCHED;
            PG8_LDB(B1, 1, 1); PG8_STAGE(PG8_SB(1, 0), b3, voffB);
            PG8_BAR; PG8_WAIT_L(0); PG8_MMA(0, 1, At, B1); PG8_BAR;
            PG8_LDA(At, 1, 1); PG8_STAGE(PG8_SA(1, 0), a3, voffA);
            PG8_BAR; PG8_WAIT_L(0); PG8_MMA(1, 0, At, B0); PG8_BAR; PG8_SCHED;
            PG8_STAGE(PG8_SB(1, 1), b3 + hstep, voffB);
            PG8_WAIT_V(6); PG8_BAR; PG8_MMA(1, 1, At, B1); PG8_BAR;
            }
        }
        if constexpr (ALIGN_EPI) { if (wr == 0) PG8_BAR; }
        if constexpr (!Epi::AFTER_DRAIN) { E(acc, cur, wr, wc, fr, fq); S.done(cur); }
        if (!has_next) break;
#pragma unroll
        for (int a = 0; a < 2; ++a)
#pragma unroll
            for (int b = 0; b < 2; ++b)
#pragma unroll
                for (int m = 0; m < 4; ++m)
#pragma unroll
                    for (int n = 0; n < 2; ++n) acc[a][b][m][n] = (f32x4){0.f, 0.f, 0.f, 0.f};
        cur = nxt; cA = nA; cB = nB; ++ui;
        if constexpr (ALIGN_EPI) { if (wr == 1) PG8_BAR; }
    }
    PG8_WAIT_V(0);
    if constexpr (!ALIGN_EPI) { if (wr == 0) PG8_BAR; }
    PG8_BAR;
    if constexpr (Epi::AFTER_DRAIN) { E.fused(acc, cur, wr, wc, fr, fq, lds, wid, lane); S.done(cur); }
#undef PG8_SA
#undef PG8_SB
#undef PG8_STAGE
#undef PG8_LDA
#undef PG8_LDB
#undef PG8_MMA
#undef PG8_WAIT_V
#undef PG8_WAIT_L
#undef PG8_BAR
#undef PG8_SCHED
}
}

#define GAS __attribute__((address_space(1)))
#define LAS __attribute__((address_space(3)))
typedef unsigned short bf16;
typedef unsigned v4u __attribute__((ext_vector_type(4)));
typedef unsigned v2u __attribute__((ext_vector_type(2)));
typedef float f32x4 __attribute__((ext_vector_type(4)));
typedef float f32x16 __attribute__((ext_vector_type(16)));
typedef short bf16x8 __attribute__((ext_vector_type(8)));
typedef short s16x4 __attribute__((ext_vector_type(4)));
typedef GAS unsigned gu32;
#define RLX_AGENT __ATOMIC_RELAXED, __HIP_MEMORY_SCOPE_AGENT
#define LDS_WAIT() asm volatile("s_waitcnt lgkmcnt(0)" ::: "memory")
#define VM_WAIT() asm volatile("s_waitcnt vmcnt(0)" ::: "memory")
typedef float f32x2_t __attribute__((ext_vector_type(2))); typedef __bf16 bf16x2_t __attribute__((ext_vector_type(2)));
__device__ __forceinline__ unsigned pk2(float lo, float hi) { f32x2_t v = {lo, hi}; bf16x2_t b = __builtin_convertvector(v, bf16x2_t); return __builtin_bit_cast(unsigned, b); }
__device__ __forceinline__ bf16 f2bf(float f) { return (bf16)(pk2(f, 0.f) & 0xffffu); }
__device__ __forceinline__ float bf2f(bf16 v) { return __uint_as_float((unsigned)v << 16); }
__device__ __forceinline__ float bflo(unsigned w) { return __uint_as_float(w << 16); }
__device__ __forceinline__ float bfhi(unsigned w) { return __uint_as_float(w & 0xffff0000u); }

#define XB_TMO      128
#define XB_XCNT(j)  (256  + 64 * (j))
#define XB_XSUB(j)  (1280 + 64 * (j))
#define XB_XGEN(j)  (2304 + 64 * (j))
#define XB_TOP      3328
#define XB_TOPGEN   3392
#define XCD_BAR_WORDS 3456
#define XB_SPIN_CAP (1u << 18)
__device__ __forceinline__ unsigned xb_ld(unsigned* p)              { return __hip_atomic_load(p, __ATOMIC_RELAXED, __HIP_MEMORY_SCOPE_AGENT); }
__device__ __forceinline__ unsigned xb_add(unsigned* p, unsigned v) { return __hip_atomic_fetch_add(p, v, __ATOMIC_RELAXED, __HIP_MEMORY_SCOPE_AGENT); }
__device__ __forceinline__ unsigned xb_xcc_id() { return (unsigned)__builtin_amdgcn_s_getreg((3 << 11) | 20) & 0xFu; }
#define XB_SPIN(cond, bar) do { unsigned _sp = 0; while (cond) { __builtin_amdgcn_s_sleep(1); \
    if ((++_sp & 255u) == 0u) { if (xb_ld(&(bar)[XB_TMO])) break; if (_sp > XB_SPIN_CAP) { atomicAdd(&(bar)[XB_TMO], 1u); break; } } } } while (0)
struct XcdBarrier { unsigned* bar; unsigned x; volatile LAS unsigned* st; };
__device__ __forceinline__ XcdBarrier xcd_barrier_post(unsigned* bar, volatile LAS unsigned* st) {
    XcdBarrier b; b.bar = bar; b.x = xb_xcc_id(); b.st = st;
    if (threadIdx.x == 0) (void)xb_add(&bar[XB_XCNT(b.x)], 1u);
    return b;
}
__device__ __forceinline__ void xcd_barrier_complete(unsigned* bar, unsigned x, unsigned& nloc, unsigned& nx) {
    const unsigned G = gridDim.x * gridDim.y * gridDim.z;
    unsigned sum, cnt, mine, sp = 0u;
    for (;;) {
        sum = 0u; cnt = 0u; mine = 0u;
#pragma unroll
        for (unsigned j = 0; j < 16; ++j) { const unsigned c = xb_ld(&bar[XB_XCNT(j)]); sum += c; cnt += (c > 0u) ? 1u : 0u; mine = (j == x) ? c : mine; }
        if (sum == G) break;
        __builtin_amdgcn_s_sleep(1);
        if ((++sp & 255u) == 0u) { if (xb_ld(&bar[XB_TMO])) break; if (sp > XB_SPIN_CAP) { atomicAdd(&bar[XB_TMO], 1u); break; } }
    }
    nloc = mine > 0u ? mine : 1u; nx = cnt > 0u ? cnt : 1u;
}
__device__ __forceinline__ void xcd_barrier(const XcdBarrier& b) {
    asm volatile("s_waitcnt vmcnt(0)" ::: "memory");
    __syncthreads();
    if (threadIdx.x == 0) {
        unsigned* bar = b.bar;
        __builtin_amdgcn_s_waitcnt(0);
        unsigned nloc = b.st[0], nx = b.st[1];
        if (nloc == 0u) { xcd_barrier_complete(bar, b.x, nloc, nx); b.st[0] = nloc; b.st[1] = nx; }
        const unsigned old = xb_add(&bar[XB_XSUB(b.x)], 1u);
        const unsigned gen = old / nloc;
        if (old + 1u == (gen + 1u) * nloc) {
            __builtin_amdgcn_fence(__ATOMIC_RELEASE, "agent");
            asm volatile("s_waitcnt vmcnt(0)" ::: "memory");
            const unsigned og = xb_add(&bar[XB_TOP], 1u);
            const unsigned tg = og / nx;
            if (og + 1u == (tg + 1u) * nx) xb_add(&bar[XB_TOPGEN], 1u);
            else XB_SPIN(xb_ld(&bar[XB_TOPGEN]) == tg, bar);
            __builtin_amdgcn_fence(__ATOMIC_ACQUIRE, "agent");
            xb_add(&bar[XB_XGEN(b.x)], 1u);
            asm volatile("s_waitcnt vmcnt(0)" ::: "memory");
        } else {
            XB_SPIN(xb_ld(&bar[XB_XGEN(b.x)]) == gen, bar);
            __builtin_amdgcn_fence(__ATOMIC_ACQUIRE, "agent");
            asm volatile("s_waitcnt vmcnt(0)" ::: "memory");
        }
    }
    __syncthreads();
}

constexpr int DM = 1024, NB = 8, SEQ = 2048, NMETA = 16, TT = SEQ + NMETA;
constexpr int DB = 128, PAST = 8192, PAGE = 128, NPAGES = 64;
constexpr int NH = 8, HP = 64, SSDW = 512, NG = 2, DS = 64, CONVD = 768;
constexpr int QKD = 96, VD = 64, MLAW = 512, QL = 384, KVL = 256, DFF = 2816, INC = 1960;
constexpr int RP = NB * TT, R = RP + DB;
constexpr int MMAIN = NB * SEQ;
constexpr int NS = NMETA + DB;
constexpr float EPS = 1e-6f, ATTN_SCALE = 0.10206207261596577f, LOG2E = 1.4426950408889634f;
constexpr int PJ = 2048, C_Z = 0, C_XBC = 512, C_CKV = 1280, C_CQ = 1536, C_DT = 1920, C_KR = 1928;
constexpr int S_Z = 0, S_XBC = 512, S_DT = 1280, S_CQ = 1288, S_CKV = 1672, S_KR = 1928;
constexpr int TPAD = 2112;
constexpr int NCH = 33, CHL = 64, TOFF = 48;
constexpr size_t OUT_YP = 0, OUT_YS = 16777216, OUT_LATP = 16908288, OUT_KRP = 21135360, OUT_CONVP = 21663744,
                 OUT_SSMP = 21682176, OUT_LATS = 21944320, OUT_KRS = 21977088, OUT_CONVS = 21981184, OUT_SSMS = 22276096;

constexpr size_t MiB = 1u << 20;
constexpr size_t WS_CTL = 0, CTL_ZERO_BYTES = 32 * 1024;
constexpr int CW_BAR = 4096;
constexpr size_t WS_SS = 512 * 1024;
constexpr size_t WS_WIN = 2 * MiB;
constexpr size_t WS_WUQ = 6 * MiB;
constexpr size_t WS_WUKV = 7 * MiB;
constexpr size_t WS_WOUT = 8 * MiB;
constexpr size_t WS_WGU = 10 * MiB;
constexpr size_t WS_WDN = 22 * MiB;
constexpr size_t WS_XN = 32 * MiB;
constexpr size_t WS_PROJ = 66 * MiB;
constexpr size_t WS_DTRAW = 132 * MiB;
constexpr size_t WS_DT = 133 * MiB;
constexpr size_t WS_LAT = 134 * MiB;
constexpr size_t WS_CQN = 143 * MiB;
constexpr size_t WS_KRF = 156 * MiB;
constexpr size_t WS_XST = 159 * MiB;
constexpr size_t WS_BT = 176 * MiB;
constexpr size_t WS_BC = 181 * MiB;
constexpr size_t WS_XAS = 190 * MiB;
constexpr size_t WS_QRAW = 191 * MiB;
constexpr size_t WS_KVRAW = 216 * MiB;
constexpr size_t WS_Q = 249 * MiB;
constexpr size_t WS_K = 274 * MiB;
constexpr size_t WS_VT = 299 * MiB;
constexpr size_t WS_STATES = 316 * MiB;
constexpr size_t WS_DECAY = 350 * MiB;
constexpr size_t WS_HIN = 351 * MiB;
constexpr size_t WS_MIX = 368 * MiB;
constexpr size_t WS_ACT = 401 * MiB;
constexpr size_t WS_VS = 491 * MiB;
constexpr size_t WS_DPART = 492 * MiB;
constexpr size_t WS_HS = 494 * MiB;
constexpr size_t WS_ROPE = 496 * MiB;
constexpr size_t WS_SSP = 520 * MiB;
constexpr size_t WS_OPT_END = 522 * MiB;
constexpr size_t WS_NAIVE = 2048 * MiB;
constexpr size_t WS_DIAG = 1 * MiB;

constexpr int RING_OFF = 0, RING_BYTES = 131072;
constexpr int LDSCTL_OFF = RING_BYTES, MISC_OFF = LDSCTL_OFF + 320;
constexpr int LDS_BYTES = 163840;
constexpr int NWAVES = 8, NTHR = 512;

struct Args { const void* in[30]; float* out; unsigned char* ws; int ph_lo, ph_hi, li, pad; };

struct Frame {
    LAS unsigned char* lds;
    int tid, lane, wave, G, vcu, gw, NGW;
    unsigned char* ws; float* out;
    const void* const* in;
};
__device__ __forceinline__ float wave_sum(float v) {
#pragma unroll
    for (int o = 1; o < 64; o <<= 1) v += __shfl_xor(v, o);
    return v;
}
__device__ __forceinline__ float wave_max(float v) {
#pragma unroll
    for (int o = 1; o < 64; o <<= 1) v = fmaxf(v, __shfl_xor(v, o));
    return v;
}
__device__ __forceinline__ float silu_f(float x) { return x / (1.f + __expf(-x)); }
__device__ __forceinline__ float softplus_f(float x) { return fmaxf(x, 0.f) + log1pf(expf(-fabsf(x))); }
__device__ __forceinline__ float rope_inv(int j) { return exp2f(-(float)j * (13.287712379549449f / 16.0f)); }
struct EpiProj {
    static constexpr bool PERM = true, AFTER_DRAIN = false;
    bf16* O; float* dtraw; int rmode;
    __device__ __forceinline__ void operator()(const pg8::f32x4 (&acc)[2][2][4][2], const pg8::Unit& u, int wr, int wc, int fr, int fq) const {
        const int rb = rmode ? (u.pm >> 3) * 2064 + 16 + (u.pm & 7) * 256 : u.pm * 256;
        const int row0 = rb + wr * 64 + fr, col0 = u.pn * 256 + wc * 32 + 8 * fq;
#pragma unroll
        for (int ai = 0; ai < 2; ++ai)
#pragma unroll
            for (int m = 0; m < 4; ++m) { const int row = row0 + ai * 128 + m * 16; bf16* rowp = O + (size_t)row * PJ + col0;
#pragma unroll
                for (int bj = 0; bj < 2; ++bj) { const pg8::f32x4 v0 = acc[ai][bj][m][0], v1 = acc[ai][bj][m][1];
                    v4u w; w.x = pk2(v0[0], v0[1]); w.y = pk2(v0[2], v0[3]); w.z = pk2(v1[0], v1[1]); w.w = pk2(v1[2], v1[3]);
                    *(v4u*)(rowp + bj * 128) = w; }
                if (u.pn == 7 && wc == 0 && fq == 0) { *(pg8::f32x4*)(dtraw + (size_t)row * 8) = acc[ai][1][m][0]; *(pg8::f32x4*)(dtraw + (size_t)row * 8 + 4) = acc[ai][1][m][1]; } }
    }
};
struct EpiBf16 {
    static constexpr bool PERM = true, AFTER_DRAIN = false;
    bf16* O; int ldc; int rmode;
    __device__ __forceinline__ void operator()(const pg8::f32x4 (&acc)[2][2][4][2], const pg8::Unit& u, int wr, int wc, int fr, int fq) const {
        const int rb = rmode ? (u.pm >> 3) * 2064 + 16 + (u.pm & 7) * 256 : u.pm * 256;
        const int row0 = rb + wr * 64 + fr, col0 = u.pn * 256 + wc * 32 + 8 * fq;
#pragma unroll
        for (int ai = 0; ai < 2; ++ai)
#pragma unroll
            for (int m = 0; m < 4; ++m) { bf16* rowp = O + (size_t)(row0 + ai * 128 + m * 16) * ldc + col0;
#pragma unroll
                for (int bj = 0; bj < 2; ++bj) { const pg8::f32x4 v0 = acc[ai][bj][m][0], v1 = acc[ai][bj][m][1];
                    v4u w; w.x = pk2(v0[0], v0[1]); w.y = pk2(v0[2], v0[3]); w.z = pk2(v1[0], v1[1]); w.w = pk2(v1[2], v1[3]);
                    *(v4u*)(rowp + bj * 128) = w; } }
    }
};
struct EpiResF32 {
    static constexpr bool PERM = false, AFTER_DRAIN = false;
    const float* res; float* out;
    __device__ __forceinline__ void operator()(const pg8::f32x4 (&acc)[2][2][4][2], const pg8::Unit& u, int wr, int wc, int fr, int fq) const {
        const int row0 = u.pm * 256 + wr * 64 + fr, col0 = u.pn * 256 + wc * 32 + 4 * fq;
#pragma unroll
        for (int ai = 0; ai < 2; ++ai)
#pragma unroll
            for (int m = 0; m < 4; ++m) { const size_t off = (size_t)(row0 + ai * 128 + m * 16) * DM + col0;
#pragma unroll
                for (int bj = 0; bj < 2; ++bj)
#pragma unroll
                    for (int n = 0; n < 2; ++n) { const pg8::f32x4 r = *(const pg8::f32x4*)(res + off + bj * 128 + n * 16); *(pg8::f32x4*)(out + off + bj * 128 + n * 16) = r + acc[ai][bj][m][n]; } }
    }
};
struct EpiOutProj {
    static constexpr bool PERM = false, AFTER_DRAIN = false;
    const float* res; float* out; bf16* HB; float* SS;
    __device__ __forceinline__ void operator()(const pg8::f32x4 (&acc)[2][2][4][2], const pg8::Unit& u, int wr, int wc, int fr, int fq) const {
        const int rb = (u.pm >> 3) * 2064 + 16 + (u.pm & 7) * 256;
        const int row0 = u.pm * 256 + wr * 64 + fr, col0 = u.pn * 256 + wc * 32 + 4 * fq;
        pg8::f32x4 rc[4], rn[4];
#define EOP_LOAD(dst, g) do { const size_t off_ = (size_t)(row0 + ((g) >> 2) * 128 + ((g) & 3) * 16) * DM + col0; \
            dst[0] = *(const pg8::f32x4*)(res + off_); dst[1] = *(const pg8::f32x4*)(res + off_ + 16); dst[2] = *(const pg8::f32x4*)(res + off_ + 128); dst[3] = *(const pg8::f32x4*)(res + off_ + 144); } while (0)
        EOP_LOAD(rc, 0);
#pragma unroll
        for (int g = 0; g < 8; ++g) { const int ai = g >> 2, m = g & 3;
            if (g < 7) EOP_LOAD(rn, g + 1);
            const int orow = row0 + ai * 128 + m * 16; bf16* hb = HB + (size_t)(rb + wr * 64 + fr + ai * 128 + m * 16) * DM + col0; float ss = 0.f;
#pragma unroll
            for (int bj = 0; bj < 2; ++bj)
#pragma unroll
                for (int n = 0; n < 2; ++n) { const pg8::f32x4 v = rc[2 * bj + n] + acc[ai][bj][m][n];
                    ss += (v[0] * v[0] + v[1] * v[1]) + (v[2] * v[2] + v[3] * v[3]); v2u w; w.x = pk2(v[0], v[1]); w.y = pk2(v[2], v[3]); *(v2u*)(hb + bj * 128 + n * 16) = w; }
            ss += __shfl_xor(ss, 16); ss += __shfl_xor(ss, 32);
            if (fq == 0) SS[(size_t)orow * 16 + u.pn * 4 + wc] = ss;
#pragma unroll
            for (int i = 0; i < 4; ++i) rc[i] = rn[i]; }
#undef EOP_LOAD
    }
};
struct EpiDown {
    static constexpr bool PERM = false, AFTER_DRAIN = false;
    const bf16* HB; float* out;
    __device__ __forceinline__ void operator()(const pg8::f32x4 (&acc)[2][2][4][2], const pg8::Unit& u, int wr, int wc, int fr, int fq) const {
        const int rb = (u.pm >> 3) * 2064 + 16 + (u.pm & 7) * 256;
        const int row0 = u.pm * 256 + wr * 64 + fr, col0 = u.pn * 256 + wc * 32 + 4 * fq;
        v2u rc[4], rn[4];
#define EDN_LOAD(dst, g) do { const bf16* hb_ = HB + (size_t)(rb + wr * 64 + fr + ((g) >> 2) * 128 + ((g) & 3) * 16) * DM + col0; \
            dst[0] = *(const v2u*)(hb_); dst[1] = *(const v2u*)(hb_ + 16); dst[2] = *(const v2u*)(hb_ + 128); dst[3] = *(const v2u*)(hb_ + 144); } while (0)
        EDN_LOAD(rc, 0);
#pragma unroll
        for (int g = 0; g < 8; ++g) { const int ai = g >> 2, m = g & 3;
            if (g < 7) EDN_LOAD(rn, g + 1);
            const size_t off = (size_t)(row0 + ai * 128 + m * 16) * DM + col0;
#pragma unroll
            for (int bj = 0; bj < 2; ++bj)
#pragma unroll
                for (int n = 0; n < 2; ++n) { const v2u w = rc[2 * bj + n]; const pg8::f32x4 r = {bflo(w.x), bfhi(w.x), bflo(w.y), bfhi(w.y)}; *(pg8::f32x4*)(out + off + bj * 128 + n * 16) = r + acc[ai][bj][m][n]; }
#pragma unroll
            for (int i = 0; i < 4; ++i) rc[i] = rn[i]; }
#undef EDN_LOAD
    }
};
struct EpiSwiGLU {
    static constexpr bool PERM = true, AFTER_DRAIN = false;
    bf16* O; const float* SS;
    __device__ __forceinline__ void operator()(const pg8::f32x4 (&acc)[2][2][4][2], const pg8::Unit& u, int wr, int wc, int fr, int fq) const {
        const int rb = (u.pm >> 3) * 2064 + 16 + (u.pm & 7) * 256;
        const int row0 = rb + wr * 64 + fr, col0 = u.pn * 128 + wc * 32 + 8 * fq, orow0 = u.pm * 256 + wr * 64 + fr;
#pragma unroll
        for (int ai = 0; ai < 2; ++ai)
#pragma unroll
            for (int m = 0; m < 4; ++m) { float a[8]; const pg8::f32x4* sp = (const pg8::f32x4*)(SS + (size_t)(orow0 + ai * 128 + m * 16) * 16); const pg8::f32x4 s4 = (sp[0] + sp[1]) + (sp[2] + sp[3]);
                const float rs = 1.0f / sqrtf(((s4[0] + s4[1]) + (s4[2] + s4[3])) * (1.f / DM) + EPS);
#pragma unroll
                for (int n = 0; n < 2; ++n)
#pragma unroll
                    for (int e = 0; e < 4; ++e) a[4 * n + e] = silu_f(rs * acc[ai][0][m][n][e]) * (rs * acc[ai][1][m][n][e]);
                v4u w; w.x = pk2(a[0], a[1]); w.y = pk2(a[2], a[3]); w.z = pk2(a[4], a[5]); w.w = pk2(a[6], a[7]);
                *(v4u*)(O + (size_t)(row0 + ai * 128 + m * 16) * DFF + col0) = w; }
    }
};

template <class ARow, class Epi>
__device__ __forceinline__ void small_gemm(const bf16* A, int lda, const bf16* Bt, int K, int nrt, int nct, const ARow& arow, const Epi& E, int gw, int NGW, int lane, int ksplit = 1) {
    const int ntask = nrt * nct * ksplit, kc = K / ksplit;
    for (int task = gw; task < ntask; task += NGW) {
        const int rt = task % nrt, ct = (task / nrt) % nct, kq = task / (nrt * nct);
        const bf16* ap = A + (size_t)arow(rt * 16 + (lane & 15)) * lda + kq * kc + 8 * (lane >> 4);
        const bf16* bp = Bt + (size_t)(ct * 16 + (lane & 15)) * K + kq * kc + 8 * (lane >> 4);
        f32x4 acc = {0.f, 0.f, 0.f, 0.f};
#pragma unroll 1
        for (int k0 = 0; k0 < kc; k0 += 32 * 11) {
            bf16x8 av[11], bv[11];
#pragma unroll
            for (int j = 0; j < 11; ++j) if (k0 + 32 * j < kc) { av[j] = *(const bf16x8*)(ap + k0 + 32 * j); bv[j] = *(const bf16x8*)(bp + k0 + 32 * j); }
#pragma unroll
            for (int j = 0; j < 11; ++j) if (k0 + 32 * j < kc) acc = __builtin_amdgcn_mfma_f32_16x16x32_bf16(av[j], bv[j], acc, 0, 0, 0);
        }
        E(acc, rt, ct, lane);
    }
}

template <class RM>
__device__ __forceinline__ void transpose_item(const float* W, int N, int ldw, bf16* WT, int ldt, int item, LAS float* scr, int lane, const RM& rm, const float* kscale = nullptr) {
    const int nblk = (N + 31) / 32, kb = item / nblk, nb = item % nblk, k0 = 64 * kb, n0 = 32 * nb;
    { const int n = n0 + (lane & 31); float v[32];
#pragma unroll
      for (int i = 0; i < 32; ++i) { const int kk = 2 * i + (lane >> 5); v[i] = (n < N) ? W[(size_t)(k0 + kk) * ldw + n] : 0.f; }
#pragma unroll
      for (int i = 0; i < 32; ++i) { const int kk = 2 * i + (lane >> 5); float x = v[i]; if (kscale) x *= kscale[k0 + kk]; scr[kk * 33 + (lane & 31)] = x; } }
    LDS_WAIT(); asm volatile("" ::: "memory");
    const int c = lane & 7;
#pragma unroll
    for (int j = 0; j < 4; ++j) { const int n = (lane >> 3) + 8 * j; const LAS float* s = scr + (8 * c) * 33 + n;
        if (n0 + n < N) { v4u o; o.x = pk2(s[0 * 33], s[1 * 33]); o.y = pk2(s[2 * 33], s[3 * 33]); o.z = pk2(s[4 * 33], s[5 * 33]); o.w = pk2(s[6 * 33], s[7 * 33]);
            *(v4u*)(WT + (size_t)rm(n0 + n) * ldt + k0 + 8 * c) = o; } }
    LDS_WAIT(); asm volatile("" ::: "memory");
}
__device__ __forceinline__ int map_in(int n) {
    return n < S_DT ? n : n < S_CQ ? C_DT + (n - S_DT) : n < S_CKV ? C_CQ + (n - S_CQ) : n < S_KR ? C_CKV + (n - S_CKV) : n;
}
__device__ __forceinline__ void p0_prologue(Frame& F) {
    LAS float* scr = (LAS float*)(F.lds + RING_OFF + F.wave * 16384);
    const float* w_in = (const float*)F.in[9]; const float* w_uq = (const float*)F.in[17]; const float* w_ukv = (const float*)F.in[19]; const float* w_out = (const float*)F.in[25];
    const float* w_gate = (const float*)F.in[27]; const float* w_up = (const float*)F.in[28]; const float* w_down = (const float*)F.in[29];
    bf16* WIN = (bf16*)(F.ws + WS_WIN); bf16* WUQ = (bf16*)(F.ws + WS_WUQ); bf16* WUKV = (bf16*)(F.ws + WS_WUKV); bf16* WOUT = (bf16*)(F.ws + WS_WOUT); bf16* WGU = (bf16*)(F.ws + WS_WGU); bf16* WDN = (bf16*)(F.ws + WS_WDN);
    const float* ffg = (const float*)F.in[26];
    constexpr int I_IN = 16 * 62, I_UQ = 6 * 24, I_UKV = 4 * 32, I_OUT = 16 * 32, I_G = 16 * 88, I_DN = 44 * 32;
    constexpr int NITEMS = I_IN + I_UQ + I_UKV + I_OUT + 2 * I_G + I_DN;
    for (int it = F.gw; it < NITEMS; it += F.NGW) {
        int r = it;
        if (r < I_IN) { transpose_item(w_in, INC, INC, WIN, DM, r, scr, F.lane, [](int n) { return map_in(n); }); continue; } r -= I_IN;
        if (r < I_UQ) { transpose_item(w_uq, 768, 768, WUQ, QL, r, scr, F.lane, [](int n) { return n; }); continue; } r -= I_UQ;
        if (r < I_UKV) { transpose_item(w_ukv, 1024, 1024, WUKV, KVL, r, scr, F.lane, [](int n) { return n; }); continue; } r -= I_UKV;
        if (r < I_OUT) { transpose_item(w_out, DM, DM, WOUT, 1024, r, scr, F.lane, [](int n) { return n; }); continue; } r -= I_OUT;
        if (r < I_G) { transpose_item(w_gate, DFF, DFF, WGU, DM, r, scr, F.lane, [](int n) { return 256 * (n >> 7) + (n & 127); }, ffg); continue; } r -= I_G;
        if (r < I_G) { transpose_item(w_up, DFF, DFF, WGU, DM, r, scr, F.lane, [](int n) { return 256 * (n >> 7) + 128 + (n & 127); }, ffg); continue; } r -= I_G;
        transpose_item(w_down, DM, DM, WDN, DFF, r, scr, F.lane, [](int n) { return n; });
    }
    for (int i = F.gw * 64 + F.lane; i < 88 * 1024 / 8; i += F.NGW * 64) *(v4u*)(WIN + (size_t)1960 * 1024 + (size_t)i * 8) = (v4u){0u, 0u, 0u, 0u};
    const float* xp = (const float*)F.in[0]; const float* xs = (const float*)F.in[1]; const float* meta = (const float*)F.in[7]; const float* g = (const float*)F.in[8];
    bf16* XN = (bf16*)(F.ws + WS_XN);
    f32x4 gv[4];
#pragma unroll
    for (int j = 0; j < 4; ++j) gv[j] = ((const f32x4*)g)[F.lane + 64 * j];
    for (int r0 = 2 * F.gw; r0 < R; r0 += 2 * F.NGW) {
        f32x4 v[2][4];
#pragma unroll
        for (int i = 0; i < 2; ++i) { const int row = r0 + i; const float* src;
            if (row < RP) { const int b = row / TT, t = row % TT; src = (t < NMETA) ? meta + (size_t)t * DM : xp + ((size_t)b * SEQ + (t - NMETA)) * DM; } else src = xs + (size_t)(row - RP) * DM;
#pragma unroll
            for (int j = 0; j < 4; ++j) v[i][j] = ((const f32x4*)src)[F.lane + 64 * j]; }
#pragma unroll
        for (int i = 0; i < 2; ++i) { float s = 0.f;
#pragma unroll
            for (int j = 0; j < 4; ++j) s += (v[i][j].x * v[i][j].x + v[i][j].y * v[i][j].y) + (v[i][j].z * v[i][j].z + v[i][j].w * v[i][j].w);
            const float rs = 1.0f / sqrtf(wave_sum(s) * (1.f / DM) + EPS);
            v2u* o8 = (v2u*)(XN + (size_t)(r0 + i) * DM) + F.lane;
#pragma unroll
            for (int j = 0; j < 4; ++j) { v2u o; o.x = pk2(v[i][j].x * rs * gv[j].x, v[i][j].y * rs * gv[j].y); o.y = pk2(v[i][j].z * rs * gv[j].z, v[i][j].w * rs * gv[j].w); o8[64 * j] = o; } }
    }
    float* ROPE = (float*)(F.ws + WS_ROPE);
    for (int i = blockIdx.x * NTHR + F.tid; i < (TT + 1) * 16; i += F.G * NTHR) { const int p = i >> 4, j = i & 15; const float ang = (float)(p < TT ? p : PAST) * rope_inv(j); ROPE[2 * i] = cosf(ang); ROPE[2 * i + 1] = sinf(ang); }
}

__device__ __forceinline__ int small_arow(int r) { return r < NMETA ? r : RP + (r - NMETA); }
__device__ __forceinline__ void p1_inproj(Frame& F) {
    const bf16* XN = (const bf16*)(F.ws + WS_XN); const bf16* WIN = (const bf16*)(F.ws + WS_WIN); bf16* PROJ = (bf16*)(F.ws + WS_PROJ); float* DTRAW = (float*)(F.ws + WS_DTRAW);
    { pg8::Gemm g{XN, WIN, MMAIN, PJ, DM, 1}; pg8::StaticOrder S; S.init(MMAIN, PJ, F.G, (int)blockIdx.x);
      EpiProj E{PROJ, DTRAW, 1};
      pg8::gemm_phase<EpiProj, pg8::StaticOrder, true, true>(F.lds + RING_OFF, g, S, E); }
    auto epi = [&](const f32x4& acc, int rt, int ct, int lane) {
        const int col = ct * 16 + (lane & 15);
#pragma unroll
        for (int i = 0; i < 4; ++i) { const int r = rt * 16 + 4 * (lane >> 4) + i; const bf16 v = f2bf(acc[i]);
            if (r < NMETA) { for (int b = 0; b < NB; ++b) { PROJ[(size_t)(b * TT + r) * PJ + col] = v; if (col >= C_DT && col < C_DT + 8) DTRAW[(size_t)(b * TT + r) * 8 + (col - C_DT)] = acc[i]; } }
            else { const int row = RP + (r - NMETA); PROJ[(size_t)row * PJ + col] = v; if (col >= C_DT && col < C_DT + 8) DTRAW[(size_t)row * 8 + (col - C_DT)] = acc[i]; } }
    };
    small_gemm(XN, DM, WIN, DM, NS / 16, PJ / 16, [](int r) { return small_arow(r); }, epi, F.gw, F.NGW, F.lane);
}

constexpr int CV_LDS_STRIDE = 82;
__device__ __forceinline__ void p2_elementwise(Frame& F) {
    const bf16* PROJ = (const bf16*)(F.ws + WS_PROJ); const float* DTRAW = (const float*)(F.ws + WS_DTRAW); float* DT = (float*)(F.ws + WS_DT);
    bf16* LAT = (bf16*)(F.ws + WS_LAT); bf16* CQN = (bf16*)(F.ws + WS_CQN); float* KRF = (float*)(F.ws + WS_KRF);
    const float* kvg = (const float*)F.in[18]; const float* qng = (const float*)F.in[16]; const float* dtb = (const float*)F.in[12]; const float* ROPE = (const float*)(F.ws + WS_ROPE);
    for (int r0 = 4 * F.gw; r0 < R; r0 += 4 * F.NGW) {
        v2u wk[4]; unsigned wq[4][3]; unsigned short kr1[4], kr2[4]; float dtr[4]; f32x2_t cs[4];
#pragma unroll
        for (int i = 0; i < 4; ++i) { const int row = r0 + i; const bf16* pr = PROJ + (size_t)row * PJ;
            wk[i] = *(const v2u*)(pr + C_CKV + 4 * F.lane); const unsigned* p = (const unsigned*)(pr + C_CQ + 6 * F.lane); wq[i][0] = p[0]; wq[i][1] = p[1]; wq[i][2] = p[2];
            kr1[i] = pr[C_KR + (F.lane & 15)]; kr2[i] = pr[C_KR + 16 + (F.lane & 15)]; dtr[i] = DTRAW[(size_t)row * 8 + (F.lane & 7)];
            cs[i] = *(const f32x2_t*)(ROPE + 2 * ((row < RP ? row % TT : TT) * 16 + (F.lane & 15))); }
        const f32x4 gg = ((const f32x4*)kvg)[F.lane]; const float* gq = qng + 6 * F.lane; const float g0 = gq[0], g1 = gq[1], g2 = gq[2], g3 = gq[3], g4 = gq[4], g5 = gq[5]; const float dbias = dtb[F.lane & 7];
#pragma unroll
        for (int i = 0; i < 4; ++i) { const int row = r0 + i;
            { const float v0 = bflo(wk[i].x), v1 = bfhi(wk[i].x), v2 = bflo(wk[i].y), v3 = bfhi(wk[i].y);
              const float rs = 1.0f / sqrtf(wave_sum((v0 * v0 + v1 * v1) + (v2 * v2 + v3 * v3)) * (1.f / KVL) + EPS);
              const f32x4 o = {v0 * rs * gg.x, v1 * rs * gg.y, v2 * rs * gg.z, v3 * rs * gg.w};
              float* of = (row < RP) ? F.out + OUT_LATP + (size_t)row * KVL : F.out + OUT_LATS + (size_t)(row - RP) * KVL;
              ((f32x4*)of)[F.lane] = o; v2u ob; ob.x = pk2(o.x, o.y); ob.y = pk2(o.z, o.w); *(v2u*)(LAT + (size_t)row * KVL + 4 * F.lane) = ob; }
            { const float v0 = bflo(wq[i][0]), v1 = bfhi(wq[i][0]), v2 = bflo(wq[i][1]), v3 = bfhi(wq[i][1]), v4 = bflo(wq[i][2]), v5 = bfhi(wq[i][2]);
              const float rs = 1.0f / sqrtf(wave_sum((v0 * v0 + v1 * v1) + (v2 * v2 + v3 * v3) + (v4 * v4 + v5 * v5)) * (1.f / QL) + EPS);
              unsigned* o = (unsigned*)(CQN + (size_t)row * QL + 6 * F.lane);
              o[0] = pk2(v0 * rs * g0, v1 * rs * g1); o[1] = pk2(v2 * rs * g2, v3 * rs * g3); o[2] = pk2(v4 * rs * g4, v5 * rs * g5); }
            if (F.lane < 16) { const int j = F.lane; const float c = cs[i].x, s = cs[i].y;
              const float x1 = bf2f(kr1[i]), x2 = bf2f(kr2[i]); const float y1 = x1 * c - x2 * s, y2 = x1 * s + x2 * c;
              KRF[(size_t)row * 32 + j] = y1; KRF[(size_t)row * 32 + 16 + j] = y2;
              float* of = (row < RP) ? F.out + OUT_KRP + (size_t)row * 32 : F.out + OUT_KRS + (size_t)(row - RP) * 32; of[j] = y1; of[16 + j] = y2; }
            if (F.lane < 8) DT[(size_t)row * 8 + F.lane] = softplus_f(dtr[i] + dbias); }
    }
    const float* cw = (const float*)F.in[10]; const float* cb = (const float*)F.in[11];
    bf16* XST = (bf16*)(F.ws + WS_XST); bf16* BT = (bf16*)(F.ws + WS_BT); bf16* BC = (bf16*)(F.ws + WS_BC);
    LAS bf16* tile = (LAS bf16*)(F.lds + RING_OFF);
    for (int i = blockIdx.x * NTHR + F.tid; i < NB * 640 * 6; i += F.G * NTHR) { const int rowi = i / 6, pc = i % 6; const int bb = rowi / 640, cc = rowi % 640;
        bf16* dst = (cc < SSDW) ? XST + ((size_t)(bb * SSDW + cc)) * TPAD : BT + ((size_t)(bb * 128 + (cc - SSDW))) * TPAD; *(v4u*)(dst + pc * 8) = (v4u){0u, 0u, 0u, 0u}; }
    for (int u = blockIdx.x; u < NB * 32 * 3; u += F.G) {
        const int third = u % 3, tb = 1 + (u / 3) % 32, b = u / 96; const int t0 = tb * CHL - TOFF;
        {
            const int cl = 2 * (F.tid & 127), c = third * 256 + cl, tq = F.tid >> 7;
            const float w0a = cw[0 * CONVD + c], w1a = cw[1 * CONVD + c], w2a = cw[2 * CONVD + c], w3a = cw[3 * CONVD + c], ba = cb[c];
            const float w0b = cw[0 * CONVD + c + 1], w1b = cw[1 * CONVD + c + 1], w2b = cw[2 * CONVD + c + 1], w3b = cw[3 * CONVD + c + 1], bb = cb[c + 1];
            const bf16* base = PROJ + (size_t)b * TT * PJ + C_XBC + c;
#define CV_QUARTER(tfirst, lcol) do { float xa[19], xb[19]; \
                _Pragma("unroll") for (int k = 0; k < 19; ++k) { const int t = (tfirst) - 3 + k; xa[k] = 0.f; xb[k] = 0.f; if (t >= 0) { const unsigned w = *(const unsigned*)(base + (size_t)t * PJ); xa[k] = bflo(w); xb[k] = bfhi(w); } } \
                _Pragma("unroll") for (int k = 0; k < 16; ++k) { const int t = (tfirst) + k; \
                    const float ya = silu_f(ba + xa[k] * w0a + xa[k + 1] * w1a + xa[k + 2] * w2a + xa[k + 3] * w3a), yb = silu_f(bb + xb[k] * w0b + xb[k + 1] * w1b + xb[k + 2] * w2b + xb[k + 3] * w3b); \
                    const unsigned pk = pk2(ya, yb); \
                    tile[cl * CV_LDS_STRIDE + (lcol) + k] = (bf16)(pk & 0xffffu); tile[(cl + 1) * CV_LDS_STRIDE + (lcol) + k] = (bf16)(pk >> 16); \
                    if (third == 2) *(unsigned*)(BC + (size_t)(b * TT + t) * 256 + cl) = pk; } } while (0)
            CV_QUARTER(t0 + 16 * tq, 16 * tq);
            if (tb == 1 && tq == 0) CV_QUARTER(0, 64);
#undef CV_QUARTER
        }
        __syncthreads();
        { const int nrows = (third == 2) ? 128 : 256; const int npc = (tb == 1) ? 10 : 8;
          for (int i = F.tid; i < nrows * npc; i += NTHR) { const int cl = i / npc, pc = i % npc;
            const LAS unsigned* s = (const LAS unsigned*)(tile + cl * CV_LDS_STRIDE + pc * 8); v4u o; o.x = s[0]; o.y = s[1]; o.z = s[2]; o.w = s[3];
            bf16* dst = (third < 2) ? XST + ((size_t)(b * SSDW + third * 256 + cl)) * TPAD : BT + ((size_t)(b * 128 + cl)) * TPAD;
            *(v4u*)(dst + ((pc < 8) ? tb * CHL + pc * 8 : TOFF + (pc - 8) * 8)) = o; } }
        __syncthreads();
    }
    const float* sconv = (const float*)F.in[4]; float* XAS = (float*)(F.ws + WS_XAS);
    for (int i = blockIdx.x * NTHR + F.tid; i < DB * CONVD; i += F.G * NTHR) { const int b = i / CONVD, c = i % CONVD;
        const float xc = bf2f(PROJ[(size_t)(RP + b) * PJ + C_XBC + c]);
        const float s0 = sconv[(size_t)(b * 3 + 0) * CONVD + c], s1 = sconv[(size_t)(b * 3 + 1) * CONVD + c], s2 = sconv[(size_t)(b * 3 + 2) * CONVD + c];
        XAS[i] = silu_f(cb[c] + s0 * cw[c] + s1 * cw[CONVD + c] + s2 * cw[2 * CONVD + c] + xc * cw[3 * CONVD + c]);
        float* oc = F.out + OUT_CONVS + (size_t)b * 3 * CONVD + c; oc[0] = s1; oc[CONVD] = s2; oc[2 * CONVD] = xc; }
    for (int i = blockIdx.x * NTHR + F.tid; i < NB * 3 * CONVD; i += F.G * NTHR) { const int b = i / (3 * CONVD), k = (i / CONVD) % 3, c = i % CONVD;
        F.out[OUT_CONVP + i] = bf2f(PROJ[(size_t)(b * TT + TT - 3 + k) * PJ + C_XBC + c]); }
}
#define MFMA32(a, b, c) __builtin_amdgcn_mfma_f32_32x32x16_bf16((a), (b), (c), 0, 0, 0)
#define MFMA16(a, b, c) __builtin_amdgcn_mfma_f32_16x16x32_bf16((a), (b), (c), 0, 0, 0)
__device__ __forceinline__ int crow(int reg, int hi) { return (reg & 3) + 8 * (reg >> 2) + 4 * hi; }
__device__ __forceinline__ bf16x8 pack8(const f32x16& x, int s) {
    v4u p; p.x = pk2(x[8 * s + 0], x[8 * s + 1]); p.y = pk2(x[8 * s + 2], x[8 * s + 3]); p.z = pk2(x[8 * s + 4], x[8 * s + 5]); p.w = pk2(x[8 * s + 6], x[8 * s + 7]);
    return __builtin_bit_cast(bf16x8, p);
}
__device__ __forceinline__ bf16x8 ld2x8(const bf16* p0, const bf16* p1) {
    const v2u a = *(const v2u*)p0, b = *(const v2u*)p1; v4u r; r.x = a.x; r.y = a.y; r.z = b.x; r.w = b.y; return __builtin_bit_cast(bf16x8, r);
}
__device__ __forceinline__ float softmax_ref(Frame& F) {
    const float* gqn = (const float*)F.in[20]; const float* gqr = (const float*)F.in[21]; const float* gkn = (const float*)F.in[22]; const float* gkr = (const float*)F.in[23];
    float a = fabsf(gqn[F.lane]), b = fabsf(gkn[F.lane]);
    if (F.lane < 16) { a = fmaxf(a, fabsf(gqr[F.lane])); b = fmaxf(b, fabsf(gkr[F.lane])); }
    return LOG2E * 9.797958971132712f * wave_max(a) * wave_max(b) * 1.0001f;
}
constexpr size_t WS_YS = 495 * MiB;
constexpr size_t WS_KS = 498 * MiB;
constexpr int NKT = 65;

__device__ __forceinline__ void p3_upproj_states(Frame& F) {
    const bf16* CQN = (const bf16*)(F.ws + WS_CQN); const bf16* LAT = (const bf16*)(F.ws + WS_LAT); const bf16* WUQ = (const bf16*)(F.ws + WS_WUQ); const bf16* WUKV = (const bf16*)(F.ws + WS_WUKV);
    bf16* QRAW = (bf16*)(F.ws + WS_QRAW); bf16* KVRAW = (bf16*)(F.ws + WS_KVRAW);
    { pg8::Gemm g{CQN, WUQ, MMAIN, 768, QL, 1}; pg8::StaticOrder S; S.init(MMAIN, 768, F.G, (int)blockIdx.x); EpiBf16 E{QRAW, 768, 1};
      pg8::gemm_phase<EpiBf16, pg8::StaticOrder, true, true>(F.lds + RING_OFF, g, S, E); }
    { pg8::Gemm g{LAT, WUKV, MMAIN, 1024, KVL, 1}; pg8::StaticOrder S; S.init(MMAIN, 1024, F.G, (int)blockIdx.x); EpiBf16 E{KVRAW, 1024, 1};
      pg8::gemm_phase<EpiBf16, pg8::StaticOrder, true, true>(F.lds + RING_OFF, g, S, E); }
    const bool sub = (F.G == 256); if (sub && blockIdx.x < 192) return;
    const int sgw = sub ? (blockIdx.x - 192) * NWAVES + F.wave : F.gw, sngw = sub ? 64 * NWAVES : F.NGW;
    small_gemm(CQN, QL, WUQ, QL, DB / 16, 768 / 16, [](int r) { return RP + r; },
        [&](const f32x4& acc, int rt, int ct, int lane) { const int col = ct * 16 + (lane & 15);
#pragma unroll
            for (int i = 0; i < 4; ++i) QRAW[(size_t)(RP + rt * 16 + 4 * (lane >> 4) + i) * 768 + col] = f2bf(acc[i]); }, sgw, sngw, F.lane);
    small_gemm(LAT, KVL, WUKV, KVL, NS / 16, 1024 / 16, [](int r) { return small_arow(r); },
        [&](const f32x4& acc, int rt, int ct, int lane) { const int col = ct * 16 + (lane & 15);
#pragma unroll
            for (int i = 0; i < 4; ++i) { const int r = rt * 16 + 4 * (lane >> 4) + i; const bf16 v = f2bf(acc[i]);
                if (r < NMETA) { for (int b = 0; b < NB; ++b) KVRAW[(size_t)(b * TT + r) * 1024 + col] = v; } else KVRAW[(size_t)(RP + r - NMETA) * 1024 + col] = v; } }, sgw, sngw, F.lane);
    const float* DT = (const float*)(F.ws + WS_DT); const float* a_log = (const float*)F.in[13];
    const bf16* XST = (const bf16*)(F.ws + WS_XST); const bf16* BT = (const bf16*)(F.ws + WS_BT);
    float* STATES = (float*)(F.ws + WS_STATES); float* DECAY = (float*)(F.ws + WS_DECAY);
    LAS float* wl = (LAS float*)(F.lds + RING_OFF + F.wave * 1024);
    const int r32 = F.lane & 31, hi = F.lane >> 5;
    for (int u = sgw; u < NB * NCH * NH; u += sngw) {
        const int h = u % NH, c = (u / NH) % NCH, b = u / (NH * NCH); const int g = h >> 2;
        const int t = c * CHL - TOFF + F.lane;
        const float dt = (t >= 0) ? DT[(size_t)(b * TT + t) * 8 + h] : 0.f;
        const float A = -__expf(a_log[h]);
        float acs = dt * A;
#pragma unroll
        for (int o = 1; o < 64; o <<= 1) { const float v = __shfl_up(acs, o); if (F.lane >= o) acs += v; }
        const float last = __shfl(acs, 63);
        wl[F.lane] = __expf(last - acs) * dt;
        LDS_WAIT(); asm volatile("" ::: "memory");
        f32x16 acc[2][2];
#pragma unroll
        for (int i = 0; i < 2; ++i)
#pragma unroll
            for (int j = 0; j < 2; ++j) acc[i][j] = (f32x16){};
        const bf16* xb = XST + ((size_t)(b * SSDW + h * HP)) * TPAD + c * CHL; const bf16* bb = BT + ((size_t)(b * 128 + g * DS)) * TPAD + c * CHL;
#pragma unroll
        for (int s = 0; s < 4; ++s) {
            const f32x4 w0 = *(const LAS f32x4*)(wl + 16 * s + 8 * hi), w1 = *(const LAS f32x4*)(wl + 16 * s + 8 * hi + 4);
            bf16x8 af[2], bfr[2];
#pragma unroll
            for (int pt = 0; pt < 2; ++pt) { const v4u x = *(const v4u*)(xb + (size_t)(32 * pt + r32) * TPAD + 16 * s + 8 * hi);
                v4u y; y.x = pk2(bflo(x.x) * w0.x, bfhi(x.x) * w0.y); y.y = pk2(bflo(x.y) * w0.z, bfhi(x.y) * w0.w); y.z = pk2(bflo(x.z) * w1.x, bfhi(x.z) * w1.y); y.w = pk2(bflo(x.w) * w1.z, bfhi(x.w) * w1.w);
                af[pt] = __builtin_bit_cast(bf16x8, y); }
#pragma unroll
            for (int nt = 0; nt < 2; ++nt) bfr[nt] = *(const bf16x8*)(bb + (size_t)(32 * nt + r32) * TPAD + 16 * s + 8 * hi);
#pragma unroll
            for (int pt = 0; pt < 2; ++pt)
#pragma unroll
                for (int nt = 0; nt < 2; ++nt) acc[pt][nt] = MFMA32(af[pt], bfr[nt], acc[pt][nt]);
        }
        float* so = STATES + ((size_t)((b * NCH + c) * NH + h)) * 4096;
#pragma unroll
        for (int pt = 0; pt < 2; ++pt)
#pragma unroll
            for (int nt = 0; nt < 2; ++nt)
#pragma unroll
                for (int rg = 0; rg < 16; ++rg) so[(32 * pt + crow(rg, hi)) * 64 + 32 * nt + r32] = acc[pt][nt][rg];
        if (F.lane == 0) DECAY[(b * NCH + c) * NH + h] = __expf(last);
        LDS_WAIT(); asm volatile("" ::: "memory");
    }
}

#ifdef MK_TS
#define P4_STAMP(k) do { if (blockIdx.x == 0 && F.tid == 0) ((unsigned long long*)(F.ws + 600 * MiB))[20 + (k)] = __builtin_amdgcn_s_memrealtime(); } while (0)
#else
#define P4_STAMP(k) do { } while (0)
#endif
__device__ __forceinline__ void p4_post(Frame& F) {
    const bf16* QRAW = (const bf16*)(F.ws + WS_QRAW); const bf16* KVRAW = (const bf16*)(F.ws + WS_KVRAW); const float* KRF = (const float*)(F.ws + WS_KRF);
    bf16* Q = (bf16*)(F.ws + WS_Q); bf16* K = (bf16*)(F.ws + WS_K); bf16* VT = (bf16*)(F.ws + WS_VT); float* VS = (float*)(F.ws + WS_VS);
    const float* gqn = (const float*)F.in[20]; const float* gqr = (const float*)F.in[21]; const float* gkn = (const float*)F.in[22]; const float* gkr = (const float*)F.in[23];
    const float* ROPE = (const float*)(F.ws + WS_ROPE);
    const int h = F.lane >> 3, sub = F.lane & 7;
    bf16* KS = (bf16*)(F.ws + WS_KS);
    for (int row = RP + F.gw; row < R; row += F.NGW) {
        const int t = PAST;
        if (row >= RP) { const bf16* kp = KVRAW + (size_t)row * 1024 + 128 * h + 8 * sub; const v4u kw = *(const v4u*)kp; const v4u vw = *(const v4u*)(kp + 64);
          const f32x4 kr = *(const f32x4*)(KRF + (size_t)row * 32 + 4 * sub);
          float kn[8] = {bflo(kw.x), bfhi(kw.x), bflo(kw.y), bfhi(kw.y), bflo(kw.z), bfhi(kw.z), bflo(kw.w), bfhi(kw.w)};
          float ss = (kr.x * kr.x + kr.y * kr.y) + (kr.z * kr.z + kr.w * kr.w);
#pragma unroll
          for (int e = 0; e < 8; ++e) ss += kn[e] * kn[e];
          ss += __shfl_xor(ss, 1); ss += __shfl_xor(ss, 2); ss += __shfl_xor(ss, 4);
          const float rs = 1.0f / sqrtf(ss * (1.f / 96.f) + EPS);
          const float* gn = gkn + 8 * sub; v4u o; o.x = pk2(kn[0] * rs * gn[0], kn[1] * rs * gn[1]); o.y = pk2(kn[2] * rs * gn[2], kn[3] * rs * gn[3]); o.z = pk2(kn[4] * rs * gn[4], kn[5] * rs * gn[5]); o.w = pk2(kn[6] * rs * gn[6], kn[7] * rs * gn[7]);
          bf16* ko = KS + (size_t)(row - RP) * 768 + 96 * h; *(v4u*)(ko + 8 * sub) = o;
          const float* gr = gkr + ((4 * sub) & 15); v2u o2; o2.x = pk2(kr.x * rs * gr[0], kr.y * rs * gr[1]); o2.y = pk2(kr.z * rs * gr[2], kr.w * rs * gr[3]);
          *(v2u*)(ko + 64 + 4 * sub) = o2;
          const unsigned vv[4] = {vw.x, vw.y, vw.z, vw.w}; float* vs = VS + (size_t)(row - RP) * 512 + 64 * h + 8 * sub;
#pragma unroll
          for (int e = 0; e < 4; ++e) { vs[2 * e] = bflo(vv[e]); vs[2 * e + 1] = bfhi(vv[e]); } }
        if (row >= RP || t >= NMETA) {
            const bf16* qp = QRAW + (size_t)row * 768 + 96 * h; const v4u qw = *(const v4u*)(qp + 8 * sub);
            const unsigned r1 = *(const unsigned*)(qp + 64 + 2 * sub), r2 = *(const unsigned*)(qp + 80 + 2 * sub);
            float qn[8] = {bflo(qw.x), bfhi(qw.x), bflo(qw.y), bfhi(qw.y), bflo(qw.z), bfhi(qw.z), bflo(qw.w), bfhi(qw.w)};
            const f32x4 cs = *(const f32x4*)(ROPE + 2 * ((row < RP ? t : TT) * 16 + 2 * sub)); const float c0 = cs.x, s0 = cs.y, c1 = cs.z, s1 = cs.w;
            const float x10 = bflo(r1), x11 = bfhi(r1), x20 = bflo(r2), x21 = bfhi(r2);
            const float y10 = x10 * c0 - x20 * s0, y20 = x10 * s0 + x20 * c0, y11 = x11 * c1 - x21 * s1, y21 = x11 * s1 + x21 * c1;
            float ss = (y10 * y10 + y20 * y20) + (y11 * y11 + y21 * y21);
#pragma unroll
            for (int e = 0; e < 8; ++e) ss += qn[e] * qn[e];
            ss += __shfl_xor(ss, 1); ss += __shfl_xor(ss, 2); ss += __shfl_xor(ss, 4);
            const float rs = (ATTN_SCALE * LOG2E) / sqrtf(ss * (1.f / 96.f) + EPS);
            const float* gn = gqn + 8 * sub; v4u o; o.x = pk2(qn[0] * rs * gn[0], qn[1] * rs * gn[1]); o.y = pk2(qn[2] * rs * gn[2], qn[3] * rs * gn[3]); o.z = pk2(qn[4] * rs * gn[4], qn[5] * rs * gn[5]); o.w = pk2(qn[6] * rs * gn[6], qn[7] * rs * gn[7]);
            bf16* qo = Q + (size_t)row * 768 + 96 * h; *(v4u*)(qo + 8 * sub) = o;
            const float g0 = gqr[2 * sub], g1 = gqr[2 * sub + 1];
            *(unsigned*)(qo + 64 + 2 * sub) = pk2(y10 * rs * g0, y11 * rs * g1); *(unsigned*)(qo + 80 + 2 * sub) = pk2(y20 * rs * g0, y21 * rs * g1);
        }
    }
    { bf16* KF = (bf16*)(F.ws + WS_K); bf16* VF = (bf16*)(F.ws + WS_VT);
      LAS unsigned char* vtile = F.lds + RING_OFF + F.wave * 4608;
      const int r8 = F.lane >> 3;
      for (int u = F.gw; u < NB * NKT * NH; u += F.NGW) {
          const int hh = u % NH, kt = (u / NH) % NKT, bb = u / (NH * NKT);
          bf16* kfb = KF + ((size_t)((bb * NH + hh) * NKT + kt)) * (6 * 512); bf16* vfb = VF + ((size_t)((bb * NH + hh) * NKT + kt)) * (4 * 512);
          v4u kwa[4], vwa[4]; f32x4 kra[4];
#pragma unroll
          for (int i = 0; i < 4; ++i) { const int tk = kt * 32 + 8 * i + r8; const int tkc = tk < TT ? tk : TT - 1;
              const bf16* kp = KVRAW + (size_t)(bb * TT + tkc) * 1024 + 128 * hh + 8 * sub; kwa[i] = *(const v4u*)kp; vwa[i] = *(const v4u*)(kp + 64); kra[i] = *(const f32x4*)(KRF + (size_t)(bb * TT + tkc) * 32 + 4 * sub); }
#pragma unroll
          for (int i = 0; i < 4; ++i) {
              const int key = 8 * i + r8, tk = kt * 32 + key; v4u kw = kwa[i], vw = vwa[i]; f32x4 kr = kra[i];
              if (tk >= TT) { kw = (v4u){0u, 0u, 0u, 0u}; vw = kw; kr = (f32x4){0.f, 0.f, 0.f, 0.f}; }
              float kn[8] = {bflo(kw.x), bfhi(kw.x), bflo(kw.y), bfhi(kw.y), bflo(kw.z), bfhi(kw.z), bflo(kw.w), bfhi(kw.w)};
              float ss = (kr.x * kr.x + kr.y * kr.y) + (kr.z * kr.z + kr.w * kr.w);
#pragma unroll
              for (int e = 0; e < 8; ++e) ss += kn[e] * kn[e];
              ss += __shfl_xor(ss, 1); ss += __shfl_xor(ss, 2); ss += __shfl_xor(ss, 4);
              const float rs = 1.0f / sqrtf(ss * (1.f / 96.f) + EPS);
              const float* gn = gkn + 8 * sub; v4u o; o.x = pk2(kn[0] * rs * gn[0], kn[1] * rs * gn[1]); o.y = pk2(kn[2] * rs * gn[2], kn[3] * rs * gn[3]); o.z = pk2(kn[4] * rs * gn[4], kn[5] * rs * gn[5]); o.w = pk2(kn[6] * rs * gn[6], kn[7] * rs * gn[7]);
              *(v4u*)(kfb + (sub >> 1) * 512 + ((sub & 1) * 32 + key) * 8) = o;
              const float* gr = gkr + ((4 * sub) & 15); v2u o2; o2.x = pk2(kr.x * rs * gr[0], kr.y * rs * gr[1]); o2.y = pk2(kr.z * rs * gr[2], kr.w * rs * gr[3]);
              *(v2u*)(kfb + (4 + (sub >> 2)) * 512 + (((sub >> 1) & 1) * 32 + key) * 8 + 4 * (sub & 1)) = o2;
              *(LAS v4u*)(vtile + key * 144 + sub * 16) = vw; }
          LDS_WAIT(); asm volatile("" ::: "memory");
          const int g = F.lane >> 4, q4 = (F.lane & 15) >> 2, pp = F.lane & 3;
          const unsigned a_lo = (unsigned)(uintptr_t)vtile + (unsigned)((4 * (g >> 1) + q4) * 144 + (16 * (g & 1) + 4 * pp) * 2);
#define VF_TR(dt, s2) do { s16x4 lo, hi4; \
              asm volatile("ds_read_b64_tr_b16 %0, %2 offset:%c3\n\tds_read_b64_tr_b16 %1, %2 offset:%c4\n\ts_waitcnt lgkmcnt(0)" : "=&v"(lo), "=&v"(hi4) : "v"(a_lo), "i"(16 * (s2) * 144 + 64 * (dt)), "i"(16 * (s2) * 144 + 64 * (dt) + 8 * 144) : "memory"); \
              v4u o; o.x = (unsigned)(unsigned short)lo[0] | ((unsigned)(unsigned short)lo[1] << 16); o.y = (unsigned)(unsigned short)lo[2] | ((unsigned)(unsigned short)lo[3] << 16); \
              o.z = (unsigned)(unsigned short)hi4[0] | ((unsigned)(unsigned short)hi4[1] << 16); o.w = (unsigned)(unsigned short)hi4[2] | ((unsigned)(unsigned short)hi4[3] << 16); \
              *(v4u*)(vfb + ((dt) * 2 + (s2)) * 512 + F.lane * 8) = o; } while (0)
          VF_TR(0, 0); VF_TR(0, 1); VF_TR(1, 0); VF_TR(1, 1);
#undef VF_TR
          LDS_WAIT(); asm volatile("" ::: "memory");
      } }
    P4_STAMP(0);
    const float* STATES = (const float*)(F.ws + WS_STATES); const float* DECAY = (const float*)(F.ws + WS_DECAY); bf16* HIN = (bf16*)(F.ws + WS_HIN);
    for (int e2 = blockIdx.x * NTHR + F.tid; e2 < NB * NH * 2048; e2 += F.G * NTHR) {
        const int e = 2 * e2; const int b = e / (NH * 4096), hh = (e / 4096) % NH, pn = e % 4096;
        float h0 = 0.f, h1 = 0.f;
#pragma unroll 1
        for (int c0 = 0; c0 < NCH; c0 += 11) {
            f32x2_t st[11]; float dc[11];
#pragma unroll
            for (int j = 0; j < 11; ++j) { const int c = c0 + j; st[j] = *(const f32x2_t*)(STATES + ((size_t)((b * NCH + c) * NH + hh)) * 4096 + pn); dc[j] = DECAY[(b * NCH + c) * NH + hh]; }
#pragma unroll
            for (int j = 0; j < 11; ++j) { const int c = c0 + j; *(unsigned*)(HIN + ((size_t)((b * NCH + c) * NH + hh)) * 4096 + pn) = pk2(h0, h1); h0 = h0 * dc[j] + st[j].x; h1 = h1 * dc[j] + st[j].y; }
        }
        *(f32x2_t*)(F.out + OUT_SSMP + e) = (f32x2_t){h0, h1};
    }
    P4_STAMP(1);
    const float* XAS = (const float*)(F.ws + WS_XAS); const float* DT = (const float*)(F.ws + WS_DT); const float* sst = (const float*)F.in[5];
    const float* a_log = (const float*)F.in[13]; const float* d_skip = (const float*)F.in[14]; float* YS = (float*)(F.ws + WS_YS);
    for (int u = F.gw; u < DB * NH * 16; u += F.NGW) {
        const int pq = u & 15, hh = (u >> 4) & 7, b = u >> 7; const int g = hh >> 2; const int p = 4 * pq + (F.lane >> 4), n4 = F.lane & 15;
        const float dt = DT[(size_t)(RP + b) * 8 + hh]; const float a = __expf(dt * -__expf(a_log[hh]));
        const float x = XAS[(size_t)b * CONVD + hh * HP + p]; const float uu = dt * x;
        const f32x4 Bv = *(const f32x4*)(XAS + (size_t)b * CONVD + SSDW + g * DS + 4 * n4), Cv = *(const f32x4*)(XAS + (size_t)b * CONVD + SSDW + 128 + g * DS + 4 * n4);
        const size_t si = (((size_t)b * NH + hh) * HP + p) * DS + 4 * n4;
        const f32x4 s0 = *(const f32x4*)(sst + si); const f32x4 s1 = s0 * a + uu * Bv;
        *(f32x4*)(F.out + OUT_SSMS + si) = s1;
        float y = (Cv.x * s1.x + Cv.y * s1.y) + (Cv.z * s1.z + Cv.w * s1.w);
        y += __shfl_xor(y, 1); y += __shfl_xor(y, 2); y += __shfl_xor(y, 4); y += __shfl_xor(y, 8);
        if (n4 == 0) YS[(size_t)b * 512 + hh * HP + p] = y + d_skip[hh] * x;
    }
}
constexpr int DA_ROWB = 528;
constexpr int DA_LAT = 0, DA_KR = 128 * DA_ROWB, DA_PB = DA_KR + 128 * 33 * 4, DA_QG = DA_PB + 2 * 16 * 32 * 2, DA_END = DA_QG + 8 * 96 * 4;
constexpr int P5_EXCH = 100 * 1024;
static_assert(DA_END <= P5_EXCH, "LDS map of P5");

constexpr int AT_SLOT = 10240, AT_D = 4;
constexpr size_t WS_ATT = 499 * MiB;
__device__ __forceinline__ void at_issue(Frame& F, const bf16* kt_k, const bf16* kt_v, LAS unsigned char* slot) {
    const char* srcA = (F.wave < 6) ? (const char*)kt_k + F.wave * 1024 : (const char*)kt_v + (F.wave - 6) * 1024;
    __builtin_amdgcn_global_load_lds((const unsigned*)(srcA + F.lane * 16), (LAS unsigned*)(slot + F.wave * 1024), 16, 0, 0);
    __builtin_amdgcn_global_load_lds((const unsigned*)((const char*)kt_v + 2048 + F.wave * 256 + F.lane * 4), (LAS unsigned*)(slot + 8192 + F.wave * 256), 4, 0, 0);
}
__device__ __forceinline__ void p5_attn_prompt(Frame& F, float M0) {
    const bf16* QRAW = (const bf16*)(F.ws + WS_QRAW); const bf16* KF = (const bf16*)(F.ws + WS_K); const bf16* VF = (const bf16*)(F.ws + WS_VT); bf16* ATT = (bf16*)(F.ws + WS_ATT);
    const float* ROPE = (const float*)(F.ws + WS_ROPE); const float* gqn = (const float*)F.in[20]; const float* gqr = (const float*)F.in[21];
    LAS unsigned char* ring = F.lds + RING_OFF;
    const int w = F.wave, r32 = F.lane & 31, hi = F.lane >> 5;
    f32x16 negm;
#pragma unroll
    for (int i = 0; i < 16; ++i) negm[i] = -M0;
    for (int u = blockIdx.x; u < 256; u += F.G) {
        const int b = u >> 5, h = (u >> 2) & 7, pr = u & 3;
        const bf16* kfb = KF + ((size_t)((b * NH + h) * NKT)) * (6 * 512); const bf16* vfb = VF + ((size_t)((b * NH + h) * NKT)) * (4 * 512);
#pragma unroll 1
        for (int half = 0; half < 2; ++half) {
            const int qb = half ? 7 - pr : pr; const int a = 8 * qb + w; const int qi = NMETA + 32 * a + r32;
            const int nkt = 8 * qb + 9, nkw = a + 2;
            bf16x8 qf[6];
            { const bf16* qp = QRAW + (size_t)(b * TT + qi) * 768 + 96 * h + 8 * hi;
              v4u qw[6];
#pragma unroll
              for (int s = 0; s < 6; ++s) qw[s] = *(const v4u*)(qp + 16 * s);
              f32x4 cs[4];
#pragma unroll
              for (int i = 0; i < 4; ++i) cs[i] = *(const f32x4*)(ROPE + 2 * (qi * 16 + 8 * hi) + 4 * i);
              float qv[6][8]; float ss = 0.f;
#pragma unroll
              for (int s = 0; s < 6; ++s) { const unsigned ww[4] = {qw[s].x, qw[s].y, qw[s].z, qw[s].w};
#pragma unroll
                  for (int e = 0; e < 4; ++e) { qv[s][2 * e] = bflo(ww[e]); qv[s][2 * e + 1] = bfhi(ww[e]); ss += qv[s][2 * e] * qv[s][2 * e] + qv[s][2 * e + 1] * qv[s][2 * e + 1]; } }
              ss += __shfl_xor(ss, 32);
              const float rs = (ATTN_SCALE * LOG2E) / sqrtf(ss * (1.f / 96.f) + EPS);
#pragma unroll
              for (int jj = 0; jj < 8; ++jj) { const float c = cs[jj >> 1][2 * (jj & 1)], sn = cs[jj >> 1][2 * (jj & 1) + 1]; const float x1 = qv[4][jj], x2 = qv[5][jj];
                  const float gr = gqr[8 * hi + jj] * rs; qv[4][jj] = (x1 * c - x2 * sn) * gr; qv[5][jj] = (x1 * sn + x2 * c) * gr; }
#pragma unroll
              for (int s = 0; s < 4; ++s) { const f32x4 g0 = *(const f32x4*)(gqn + 16 * s + 8 * hi), g1 = *(const f32x4*)(gqn + 16 * s + 8 * hi + 4);
                  qv[s][0] *= g0.x * rs; qv[s][1] *= g0.y * rs; qv[s][2] *= g0.z * rs; qv[s][3] *= g0.w * rs; qv[s][4] *= g1.x * rs; qv[s][5] *= g1.y * rs; qv[s][6] *= g1.z * rs; qv[s][7] *= g1.w * rs; }
#pragma unroll
              for (int s = 0; s < 6; ++s) { v4u o; o.x = pk2(qv[s][0], qv[s][1]); o.y = pk2(qv[s][2], qv[s][3]); o.z = pk2(qv[s][4], qv[s][5]); o.w = pk2(qv[s][6], qv[s][7]); qf[s] = __builtin_bit_cast(bf16x8, o); } }
            f32x16 o0 = (f32x16){}, o1 = (f32x16){}; float l = 0.f;
#pragma unroll
            for (int j = 0; j < AT_D - 1; ++j) at_issue(F, kfb + (size_t)j * 3072, vfb + (size_t)j * 2048, ring + j * AT_SLOT);
#pragma unroll 1
            for (int kt = 0; kt < nkt; ++kt) {
                const int rem = nkt - 1 - kt;
                if (rem >= 2) asm volatile("s_waitcnt vmcnt(4)" ::: "memory"); else if (rem == 1) asm volatile("s_waitcnt vmcnt(2)" ::: "memory"); else asm volatile("s_waitcnt vmcnt(0)" ::: "memory");
                __builtin_amdgcn_s_barrier(); asm volatile("" ::: "memory");
                if (kt + AT_D - 1 < nkt) at_issue(F, kfb + (size_t)(kt + AT_D - 1) * 3072, vfb + (size_t)(kt + AT_D - 1) * 2048, ring + ((kt + AT_D - 1) & (AT_D - 1)) * AT_SLOT);
                if (kt < nkw) {
                    const LAS unsigned char* sl = ring + (kt & (AT_D - 1)) * AT_SLOT + F.lane * 16; const int j0 = 32 * kt;
                    f32x16 S = negm;
#pragma unroll
                    for (int s = 0; s < 6; ++s) S = MFMA32(*(const LAS bf16x8*)(sl + 1024 * s), qf[s], S);
                    bf16x8 vf[4];
#pragma unroll
                    for (int i = 0; i < 4; ++i) vf[i] = *(const LAS bf16x8*)(sl + 6144 + 1024 * i);
#pragma unroll
                    for (int i = 0; i < 16; ++i) S[i] = __builtin_amdgcn_exp2f(S[i]);
                    if (kt >= a) {
#pragma unroll
                        for (int i = 0; i < 16; ++i) if (j0 + crow(i, hi) > qi) S[i] = 0.f; }
#pragma unroll
                    for (int i = 0; i < 16; ++i) l += S[i];
                    const bf16x8 p0 = pack8(S, 0), p1 = pack8(S, 1);
                    o0 = MFMA32(vf[0], p0, o0); o0 = MFMA32(vf[1], p1, o0);
                    o1 = MFMA32(vf[2], p0, o1); o1 = MFMA32(vf[3], p1, o1);
                }
            }
            l += __shfl_xor(l, 32);
            const float il = 1.0f / l;
            bf16* ao = ATT + (size_t)(b * TT + qi) * 512 + 64 * h + 4 * hi;
#pragma unroll
            for (int gq = 0; gq < 4; ++gq) {
                v2u w0, w1; w0.x = pk2(o0[4 * gq] * il, o0[4 * gq + 1] * il); w0.y = pk2(o0[4 * gq + 2] * il, o0[4 * gq + 3] * il);
                w1.x = pk2(o1[4 * gq] * il, o1[4 * gq + 1] * il); w1.y = pk2(o1[4 * gq + 2] * il, o1[4 * gq + 3] * il);
                *(v2u*)(ao + 8 * gq) = w0; *(v2u*)(ao + 32 + 8 * gq) = w1; }
            asm volatile("s_waitcnt lgkmcnt(0)" ::: "memory"); __builtin_amdgcn_s_barrier(); asm volatile("" ::: "memory");
        }
    }
}

__device__ __forceinline__ void p5_ssd_out(Frame& F) {
    const float* DT = (const float*)(F.ws + WS_DT); const float* a_log = (const float*)F.in[13]; const float* d_skip = (const float*)F.in[14]; const float* ng = (const float*)F.in[15];
    const bf16* XST = (const bf16*)(F.ws + WS_XST); const bf16* BC = (const bf16*)(F.ws + WS_BC); const bf16* HIN = (const bf16*)(F.ws + WS_HIN); const bf16* PROJ = (const bf16*)(F.ws + WS_PROJ);
    bf16* MIX = (bf16*)(F.ws + WS_MIX);
    LAS float* tab = (LAS float*)(F.lds + RING_OFF + F.wave * 1024);
    LAS float* exch = (LAS float*)(F.lds + P5_EXCH + 2048);
    const int h = F.wave, g = h >> 2, r32 = F.lane & 31, hi = F.lane >> 5;
    const float A = -__expf(a_log[h]), Dh = d_skip[h];
    for (int u = blockIdx.x; u < NB * (NCH - 1); u += F.G) {
        const int b = u / (NCH - 1), c = 1 + u % (NCH - 1); const int tbase = c * CHL - TOFF;
        { const int t = tbase + F.lane; const float dt = (t >= 0) ? DT[(size_t)(b * TT + t) * 8 + h] : 0.f;
          float acs = dt * A;
#pragma unroll
          for (int o = 1; o < 64; o <<= 1) { const float v = __shfl_up(acs, o); if (F.lane >= o) acs += v; }
          tab[F.lane] = acs; tab[64 + F.lane] = dt; }
        LDS_WAIT(); asm volatile("" ::: "memory");
        const bf16* hb = HIN + ((size_t)((b * NCH + c) * NH + h)) * 4096 + 8 * hi;
        const bf16* xb = XST + ((size_t)(b * SSDW + h * HP)) * TPAD + c * CHL + 4 * hi;
#pragma unroll 1
        for (int it = 0; it < 2; ++it) {
            const int ii = 32 * it + r32; const int t = tbase + ii; const int tc = t < 0 ? 0 : t;
            bf16x8 cf[4], hf[2][4], bfr[4], xf[2][2]; v2u zw[2][4];
            { const bf16* cp = BC + (size_t)(b * TT + tc) * 256 + 128 + g * DS + 8 * hi;
#pragma unroll
              for (int s = 0; s < 4; ++s) cf[s] = *(const bf16x8*)(cp + 16 * s); }
#pragma unroll
            for (int pt = 0; pt < 2; ++pt)
#pragma unroll
                for (int s = 0; s < 4; ++s) hf[pt][s] = *(const bf16x8*)(hb + (size_t)(32 * pt + r32) * 64 + 16 * s);
#define SO_LOAD_J(jt) do { int tj = tbase + 32 * (jt) + r32; tj = tj < 0 ? 0 : tj; const bf16* bp = BC + (size_t)(b * TT + tj) * 256 + g * DS + 8 * hi; \
                _Pragma("unroll") for (int s = 0; s < 4; ++s) bfr[s] = *(const bf16x8*)(bp + 16 * s); \
                _Pragma("unroll") for (int pt = 0; pt < 2; ++pt) { const bf16* xp = xb + (size_t)(32 * pt + r32) * TPAD + 32 * (jt); xf[pt][0] = ld2x8(xp, xp + 8); xf[pt][1] = ld2x8(xp + 16, xp + 24); } } while (0)
            SO_LOAD_J(0);
            { const bf16* zp = PROJ + (size_t)(b * TT + tc) * PJ + C_Z + 64 * h + 4 * hi;
#pragma unroll
              for (int pt = 0; pt < 2; ++pt)
#pragma unroll
                  for (int gq = 0; gq < 4; ++gq) zw[pt][gq] = *(const v2u*)(zp + 32 * pt + 8 * gq); }
            f32x16 y[2];
            const float ai = tab[ii]; const float ei = __expf(ai);
#pragma unroll
            for (int pt = 0; pt < 2; ++pt) { f32x16 acc = (f32x16){};
#pragma unroll
                for (int s = 0; s < 4; ++s) acc = MFMA32(hf[pt][s], cf[s], acc);
#pragma unroll
                for (int i = 0; i < 16; ++i) acc[i] *= ei;
                y[pt] = acc; }
#pragma unroll 1
            for (int jt = 0; jt <= it; ++jt) {
                f32x16 S = (f32x16){};
#pragma unroll
                for (int s = 0; s < 4; ++s) S = MFMA32(bfr[s], cf[s], S);
#pragma unroll
                for (int i = 0; i < 16; ++i) { const int jj = 32 * jt + crow(i, hi); const float e = (jj <= ii) ? __expf(ai - tab[jj]) * tab[64 + jj] : 0.f; S[i] = S[i] * e + ((jj == ii) ? Dh : 0.f); }
                const bf16x8 p0 = pack8(S, 0), p1 = pack8(S, 1);
#pragma unroll
                for (int pt = 0; pt < 2; ++pt) { y[pt] = MFMA32(xf[pt][0], p0, y[pt]); y[pt] = MFMA32(xf[pt][1], p1, y[pt]); }
                if (jt < it) SO_LOAD_J(1);
            }
#undef SO_LOAD_J
            float ss = 0.f;
#pragma unroll
            for (int pt = 0; pt < 2; ++pt)
#pragma unroll
                for (int gq = 0; gq < 4; ++gq) { const float zz[4] = {bflo(zw[pt][gq].x), bfhi(zw[pt][gq].x), bflo(zw[pt][gq].y), bfhi(zw[pt][gq].y)};
#pragma unroll
                    for (int e = 0; e < 4; ++e) { const float v = y[pt][4 * gq + e] * silu_f(zz[e]); y[pt][4 * gq + e] = v; ss += v * v; } }
            ss += __shfl_xor(ss, 32);
            LAS float* ex = exch + it * 256;
            if (hi == 0) ex[h * 32 + r32] = ss;
            __syncthreads();
            const float tot = (ex[(4 * g) * 32 + r32] + ex[(4 * g + 1) * 32 + r32]) + (ex[(4 * g + 2) * 32 + r32] + ex[(4 * g + 3) * 32 + r32]);
            const float rs = 1.0f / sqrtf(tot * (1.f / 256.f) + EPS);
            if (t >= 0) { bf16* mo = MIX + (size_t)(b * TT + t) * 1024 + 64 * h + 4 * hi;
#pragma unroll
                for (int pt = 0; pt < 2; ++pt)
#pragma unroll
                    for (int gq = 0; gq < 4; ++gq) { const f32x4 gg = *(const f32x4*)(ng + 64 * h + 32 * pt + 8 * gq + 4 * hi);
                        v2u w; w.x = pk2(y[pt][4 * gq] * rs * gg.x, y[pt][4 * gq + 1] * rs * gg.y); w.y = pk2(y[pt][4 * gq + 2] * rs * gg.z, y[pt][4 * gq + 3] * rs * gg.w);
                        *(v2u*)(mo + 32 * pt + 8 * gq) = w; } }
        }
        __syncthreads();
    }
    const float* YS = (const float*)(F.ws + WS_YS);
    for (int u = F.gw; u < DB * NG; u += F.NGW) { const int b = u >> 1, gg = u & 1; const int cc = gg * 256 + 4 * F.lane;
        const f32x4 yv = *(const f32x4*)(YS + (size_t)b * 512 + cc); const v2u zw = *(const v2u*)(PROJ + (size_t)(RP + b) * PJ + C_Z + cc);
        const f32x4 v = {yv.x * silu_f(bflo(zw.x)), yv.y * silu_f(bfhi(zw.x)), yv.z * silu_f(bflo(zw.y)), yv.w * silu_f(bfhi(zw.y))};
        const float rs = 1.0f / sqrtf(wave_sum((v.x * v.x + v.y * v.y) + (v.z * v.z + v.w * v.w)) * (1.f / 256.f) + EPS);
        const f32x4 gv = *(const f32x4*)(ng + cc); v2u w; w.x = pk2(v.x * rs * gv.x, v.y * rs * gv.y); w.y = pk2(v.z * rs * gv.z, v.w * rs * gv.w);
        *(v2u*)(MIX + (size_t)(RP + b) * 1024 + cc) = w; }
}

constexpr int DB_STAGE = 0, DB_KRST = 65536, DB_LAT = DB_KRST + 8192, DB_KR = DB_LAT + 64 * DA_ROWB, DB_PB = DB_KR + 64 * 36 * 4, DB_QG = DB_PB + 16 * 64 * 2, DB_END = DB_QG + 8 * 96 * 4;
static_assert(DB_END <= RING_BYTES, "decode attention LDS map");
#define RAW_BAR_L() do { asm volatile("s_waitcnt lgkmcnt(0)" ::: "memory"); __builtin_amdgcn_s_barrier(); asm volatile("" ::: "memory"); } while (0)
#define RAW_BAR_VL() do { asm volatile("s_waitcnt vmcnt(0) lgkmcnt(0)" ::: "memory"); __builtin_amdgcn_s_barrier(); asm volatile("" ::: "memory"); } while (0)
__device__ __forceinline__ void da_issue(Frame& F, LAS unsigned char* L, const float* clat, const float* ckr, const int* ptab, int b, int split, int hp) {
    const size_t tok0 = (size_t)ptab[b * NPAGES + split * 32 + (hp >> 1)] * PAGE + (hp & 1) * 64;
    const char* src = (const char*)(clat + tok0 * KVL) + (size_t)(F.wave * 8) * 1024 + F.lane * 16;
#pragma unroll
    for (int i = 0; i < 8; ++i) __builtin_amdgcn_global_load_lds((const unsigned*)(src + i * 1024), (LAS unsigned*)(L + DB_STAGE + (F.wave * 8 + i) * 1024), 16, 0, 0);
    __builtin_amdgcn_global_load_lds((const unsigned*)((const char*)(ckr + tok0 * 32) + F.wave * 1024 + F.lane * 16), (LAS unsigned*)(L + DB_KRST + F.wave * 1024), 16, 0, 0);
}
__device__ __forceinline__ void da_convert(Frame& F, LAS unsigned char* L) {
#pragma unroll 4
    for (int k = 0; k < 8; ++k) { const int f = F.tid + NTHR * k; const int row = f >> 6, c4 = f & 63; const f32x4 v = *(const LAS f32x4*)(L + DB_STAGE + f * 16);
        v2u w; w.x = pk2(v.x, v.y); w.y = pk2(v.z, v.w); *(LAS v2u*)(L + DB_LAT + row * DA_ROWB + c4 * 8) = w; }
    { const int f = F.tid; const int row = f >> 3, c4 = f & 7; const f32x4 v = *(const LAS f32x4*)(L + DB_KRST + f * 16);
      *(LAS f32x4*)((LAS float*)(L + DB_KR) + row * 36 + 4 * c4) = v; }
}
template <int MODE>
__device__ __forceinline__ void p5_attn_decode_t(Frame& F, float M0) {
    const float* clat = (const float*)F.in[2]; const float* ckr = (const float*)F.in[3]; const int* ptab = (const int*)F.in[6];
    const bf16* WUKV = (const bf16*)(F.ws + WS_WUKV); const bf16* Q = (const bf16*)(F.ws + WS_Q); const float* gkn = (const float*)F.in[22]; const float* gkr = (const float*)F.in[23];
    float* DPART = (float*)(F.ws + WS_DPART);
    LAS unsigned char* L = F.lds + RING_OFF;
    LAS float* krl = (LAS float*)(L + DB_KR); LAS bf16* pb = (LAS bf16*)(L + DB_PB); LAS float* qg = (LAS float*)(L + DB_QG) + F.wave * 96;
    const int h = F.wave, r32 = F.lane & 31, hi = F.lane >> 5;
    for (int u = blockIdx.x; u < DB * 2; u += F.G) {
        const int b = u >> 1, split = u & 1;
        da_issue(F, L, clat, ckr, ptab, b, split, 0);
        bf16x8 wf[4][8];
#pragma unroll
        for (int dt = 0; dt < 4; ++dt)
#pragma unroll
            for (int s = 0; s < 8; ++s) wf[dt][s] = *(const bf16x8*)(WUKV + (size_t)(128 * h + 16 * dt + (F.lane & 15)) * KVL + 32 * s + 8 * (F.lane >> 4));
        { const bf16* qp = Q + (size_t)(RP + b) * 768 + 96 * h; qg[F.lane] = bf2f(qp[F.lane]) * gkn[F.lane]; if (F.lane < 32) qg[64 + F.lane] = bf2f(qp[64 + F.lane]) * gkr[F.lane & 15]; }
        for (int i = F.tid; i < 16 * 64; i += NTHR) pb[i] = 0;
        f32x4 ao[2] = {(f32x4){0.f, 0.f, 0.f, 0.f}, (f32x4){0.f, 0.f, 0.f, 0.f}}; float l = 0.f;
        RAW_BAR_VL();
        da_convert(F, L);
        RAW_BAR_L();
        da_issue(F, L, clat, ckr, ptab, b, split, 1);
#pragma unroll 1
        for (int hp = 0; hp < 64; ++hp) {
          if (MODE == 0 || MODE == 3) {
            const int n16 = F.lane & 15, kg4 = F.lane >> 4;
#pragma unroll 1
            for (int sb = 0; sb < 2; ++sb) {
                const LAS unsigned char* bp = L + DB_LAT + (32 * sb + n16) * DA_ROWB + 16 * kg4;
                f32x4 acc[4][2];
#pragma unroll
                for (int dt = 0; dt < 4; ++dt) { acc[dt][0] = (f32x4){0.f, 0.f, 0.f, 0.f}; acc[dt][1] = acc[dt][0]; }
                bf16x8 fa[2], fb[2];
                fa[0] = *(const LAS bf16x8*)(bp); fa[1] = *(const LAS bf16x8*)(bp + 16 * DA_ROWB);
#pragma unroll
                for (int s = 0; s < 8; ++s) {
                    if (s < 7) { fb[0] = *(const LAS bf16x8*)(bp + 64 * (s + 1)); fb[1] = *(const LAS bf16x8*)(bp + 16 * DA_ROWB + 64 * (s + 1)); }
#pragma unroll
                    for (int dt = 0; dt < 4; ++dt) { acc[dt][0] = MFMA16(wf[dt][s], fa[0], acc[dt][0]); acc[dt][1] = MFMA16(wf[dt][s], fa[1], acc[dt][1]); }
                    fa[0] = fb[0]; fa[1] = fb[1];
                }
                __builtin_amdgcn_sched_barrier(0);
                f32x4 s4[2] = {(f32x4){0.f, 0.f, 0.f, 0.f}, (f32x4){0.f, 0.f, 0.f, 0.f}}, d4[2] = {s4[0], s4[0]};
#pragma unroll
                for (int dt = 0; dt < 4; ++dt) { const f32x4 qq = *(const LAS f32x4*)(qg + 16 * dt + 4 * kg4);
#pragma unroll
                    for (int tt = 0; tt < 2; ++tt) { s4[tt] += acc[dt][tt] * acc[dt][tt]; d4[tt] += acc[dt][tt] * qq; } }
                { const LAS float* qr = qg + 64 + 8 * kg4; const f32x4 q0 = *(const LAS f32x4*)(qr), q1 = *(const LAS f32x4*)(qr + 4);
#pragma unroll
                  for (int tt = 0; tt < 2; ++tt) { const LAS float* kr = krl + (32 * sb + 16 * tt + n16) * 36 + 8 * kg4; const f32x4 k0 = *(const LAS f32x4*)(kr), k1 = *(const LAS f32x4*)(kr + 4);
                      s4[tt] += k0 * k0; s4[tt] += k1 * k1; d4[tt] += k0 * q0; d4[tt] += k1 * q1; } }
                __builtin_amdgcn_sched_barrier(0);
#pragma unroll
                for (int tt = 0; tt < 2; ++tt) { float ss = (s4[tt].x + s4[tt].y) + (s4[tt].z + s4[tt].w), dot = (d4[tt].x + d4[tt].y) + (d4[tt].z + d4[tt].w);
                    ss += __shfl_xor(ss, 16); dot += __shfl_xor(dot, 16); ss += __shfl_xor(ss, 32); dot += __shfl_xor(dot, 32);
                    const float p = __builtin_amdgcn_exp2f(dot * __builtin_amdgcn_rsqf(ss * (1.f / 96.f) + EPS) - M0);
                    if (kg4 == 0) { l += p; pb[h * 64 + 32 * sb + 16 * tt + n16] = f2bf(p); } }
            }
            RAW_BAR_L();
            if (MODE < 4) { const int q4 = (F.lane & 15) >> 2, pp = F.lane & 3, kg = F.lane >> 4;
              const unsigned a_lo = (unsigned)(uintptr_t)(L + DB_LAT) + (unsigned)((8 * kg + q4) * DA_ROWB + (32 * h + 4 * pp) * 2);
              const LAS bf16* pap = pb + (F.lane & 15) * 64 + 8 * kg;
              s16x4 t0, t1, t2, t3, t4, t5, t6, t7;
              asm volatile("ds_read_b64_tr_b16 %0, %8 offset:%c9\n\tds_read_b64_tr_b16 %1, %8 offset:%c10\n\tds_read_b64_tr_b16 %2, %8 offset:%c11\n\tds_read_b64_tr_b16 %3, %8 offset:%c12\n\t"
                           "ds_read_b64_tr_b16 %4, %8 offset:%c13\n\tds_read_b64_tr_b16 %5, %8 offset:%c14\n\tds_read_b64_tr_b16 %6, %8 offset:%c15\n\tds_read_b64_tr_b16 %7, %8 offset:%c16\n\ts_waitcnt lgkmcnt(0)"
                           : "=&v"(t0), "=&v"(t1), "=&v"(t2), "=&v"(t3), "=&v"(t4), "=&v"(t5), "=&v"(t6), "=&v"(t7)
                           : "v"(a_lo), "i"(0), "i"(4 * DA_ROWB), "i"(32), "i"(32 + 4 * DA_ROWB), "i"(32 * DA_ROWB), "i"(32 * DA_ROWB + 4 * DA_ROWB), "i"(32 * DA_ROWB + 32), "i"(32 * DA_ROWB + 32 + 4 * DA_ROWB) : "memory");
              const bf16x8 pa0 = *(const LAS bf16x8*)(pap), pa1 = *(const LAS bf16x8*)(pap + 32);
#define DA_FR(x, y) ((bf16x8){x[0], x[1], x[2], x[3], y[0], y[1], y[2], y[3]})
              ao[0] = MFMA16(pa0, DA_FR(t0, t1), ao[0]); ao[1] = MFMA16(pa0, DA_FR(t2, t3), ao[1]);
              ao[0] = MFMA16(pa1, DA_FR(t4, t5), ao[0]); ao[1] = MFMA16(pa1, DA_FR(t6, t7), ao[1]);
#undef DA_FR
#define DA_PV(ks, nt) do { } while (0)
#undef DA_PV
            }
          }
            RAW_BAR_VL();
            if (hp + 1 < 64) { if (MODE <= 1 || MODE >= 3) da_convert(F, L); RAW_BAR_L(); if (hp + 2 < 64 && MODE < 3) da_issue(F, L, clat, ckr, ptab, b, split, hp + 2); }
        }
        if (MODE >= 3 && l == 123.456f) DPART[0] = l;
        if (MODE == 0) { const int kg = F.lane >> 4;
          if (kg < 2) {
#pragma unroll
              for (int nt = 0; nt < 2; ++nt)
#pragma unroll
                  for (int i = 0; i < 4; ++i) DPART[((size_t)((b * 2 + split) * NH + 4 * kg + i)) * 264 + 32 * h + 16 * nt + (F.lane & 15)] = ao[nt][i]; }
          float lt = wave_sum(l);
          if (F.lane == 0) DPART[((size_t)((b * 2 + split) * NH + h)) * 264 + 256] = lt; }
        RAW_BAR_L();
    }
}

__device__ __forceinline__ void p5_attn_decode(Frame& F, float M0) { p5_attn_decode_t<0>(F, M0); }

__device__ __forceinline__ void p6_decode_combine(Frame& F, float M0) {
    {
      const bf16* ATT = (const bf16*)(F.ws + WS_ATT); bf16* MIXo = (bf16*)(F.ws + WS_MIX); const float* mgg = (const float*)F.in[24];
      const f32x4 g0 = ((const f32x4*)mgg)[2 * F.lane], g1 = ((const f32x4*)mgg)[2 * F.lane + 1];
      for (int r0 = 4 * F.gw; r0 < MMAIN; r0 += 4 * F.NGW) { v4u xx[4];
#pragma unroll
          for (int i = 0; i < 4; ++i) { const int r = r0 + i; const size_t row = (size_t)(r >> 11) * TT + NMETA + (r & 2047); xx[i] = *(const v4u*)(ATT + row * 512 + 8 * F.lane); }
#pragma unroll
          for (int i = 0; i < 4; ++i) { const int r = r0 + i; const size_t row = (size_t)(r >> 11) * TT + NMETA + (r & 2047); const v4u x = xx[i];
          const float v[8] = {bflo(x.x), bfhi(x.x), bflo(x.y), bfhi(x.y), bflo(x.z), bfhi(x.z), bflo(x.w), bfhi(x.w)};
          float ss = 0.f;
#pragma unroll
          for (int e = 0; e < 8; ++e) ss += v[e] * v[e];
          const float rs = 1.0f / sqrtf(wave_sum(ss) * (1.f / MLAW) + EPS);
          v4u o; o.x = pk2(v[0] * rs * g0.x, v[1] * rs * g0.y); o.y = pk2(v[2] * rs * g0.z, v[3] * rs * g0.w); o.z = pk2(v[4] * rs * g1.x, v[5] * rs * g1.y); o.w = pk2(v[6] * rs * g1.z, v[7] * rs * g1.w);
          *(v4u*)(MIXo + row * 1024 + 512 + 8 * F.lane) = o; } } }
    const float* DPART = (const float*)(F.ws + WS_DPART); const bf16* WUKV = (const bf16*)(F.ws + WS_WUKV); const bf16* Q = (const bf16*)(F.ws + WS_Q); const bf16* KS = (const bf16*)(F.ws + WS_KS);
    const float* VS = (const float*)(F.ws + WS_VS); const float* mg = (const float*)F.in[24]; bf16* MIX = (bf16*)(F.ws + WS_MIX);
    LAS float* accl = (LAS float*)(F.lds + RING_OFF) + F.wave * 256; LAS float* exch = (LAS float*)(F.lds + P5_EXCH);
    const int h = F.wave;
    for (int b = blockIdx.x; b < DB; b += F.G) {
        const float* p0 = DPART + ((size_t)((b * 2 + 0) * NH + h)) * 264; const float* p1 = DPART + ((size_t)((b * 2 + 1) * NH + h)) * 264;
#pragma unroll
        for (int k = 0; k < 4; ++k) accl[F.lane + 64 * k] = p0[F.lane + 64 * k] + p1[F.lane + 64 * k];
        float l = p0[256] + p1[256];
        const bf16* qp = Q + (size_t)(RP + b) * 768 + 96 * h; const bf16* kp = KS + (size_t)b * 768 + 96 * h;
        float sd = bf2f(qp[F.lane]) * bf2f(kp[F.lane]); if (F.lane < 32) sd += bf2f(qp[64 + F.lane]) * bf2f(kp[64 + F.lane]);
        sd = wave_sum(sd);
        const float pn = __builtin_amdgcn_exp2f(sd - M0); l += pn;
        LDS_WAIT(); asm volatile("" ::: "memory");
        const bf16* wv = WUKV + (size_t)(128 * h + 64 + F.lane) * KVL;
        float o = 0.f;
        { v4u wv4[32];
#pragma unroll
          for (int c8 = 0; c8 < 32; ++c8) wv4[c8] = *(const v4u*)(wv + 8 * c8);
#pragma unroll
          for (int c8 = 0; c8 < 32; ++c8) { const v4u w = wv4[c8]; const f32x4 x0 = *(const LAS f32x4*)(accl + 8 * c8), x1 = *(const LAS f32x4*)(accl + 8 * c8 + 4);
            o += (bflo(w.x) * x0.x + bfhi(w.x) * x0.y) + (bflo(w.y) * x0.z + bfhi(w.y) * x0.w) + (bflo(w.z) * x1.x + bfhi(w.z) * x1.y) + (bflo(w.w) * x1.z + bfhi(w.w) * x1.w); } }
        o = (o + pn * VS[(size_t)b * 512 + 64 * h + F.lane]) / l;
        const float ss = wave_sum(o * o);
        if (F.lane == 0) exch[h] = ss;
        __syncthreads();
        float tot = 0.f;
#pragma unroll
        for (int hh = 0; hh < NH; ++hh) tot += exch[hh];
        const float rs = 1.0f / sqrtf(tot * (1.f / MLAW) + EPS);
        MIX[(size_t)(RP + b) * 1024 + 512 + 64 * h + F.lane] = f2bf(o * rs * mg[64 * h + F.lane]);
        __syncthreads();
    }
}

__device__ __forceinline__ void p7_outproj(Frame& F) {
    const bf16* MIX = (const bf16*)(F.ws + WS_MIX); const bf16* WOUT = (const bf16*)(F.ws + WS_WOUT); const float* xp = (const float*)F.in[0]; const float* xs = (const float*)F.in[1]; float* HS = (float*)(F.ws + WS_HS);
    bf16* HB = (bf16*)(F.ws + WS_XN); float* SS = (float*)(F.ws + WS_SSP); float* ysamp = F.out + OUT_YS;
    { pg8::Gemm g{MIX, WOUT, MMAIN, DM, 1024, 1}; pg8::StaticOrder S; S.init(MMAIN, DM, F.G, (int)blockIdx.x); EpiOutProj E{xp, F.out + OUT_YP, HB, SS};
      pg8::gemm_phase<EpiOutProj, pg8::StaticOrder, true, true>(F.lds + RING_OFF, g, S, E); }
    { LAS f32x4* part = (LAS f32x4*)(F.lds + RING_OFF);
      for (int tp = blockIdx.x; tp < 256; tp += F.G) {
          const int t = 2 * tp + (F.wave >> 2), kq = F.wave & 3, rt = t & 7, ct = t >> 3;
          const bf16* ap = MIX + (size_t)(RP + rt * 16 + (F.lane & 15)) * 1024 + 256 * kq + 8 * (F.lane >> 4);
          const bf16* bp = WOUT + (size_t)(ct * 16 + (F.lane & 15)) * 1024 + 256 * kq + 8 * (F.lane >> 4);
          bf16x8 av[8], bv[8];
#pragma unroll
          for (int j = 0; j < 8; ++j) { av[j] = *(const bf16x8*)(ap + 32 * j); bv[j] = *(const bf16x8*)(bp + 32 * j); }
          f32x4 acc = {0.f, 0.f, 0.f, 0.f};
#pragma unroll
          for (int j = 0; j < 8; ++j) acc = MFMA16(av[j], bv[j], acc);
          part[F.wave * 64 + F.lane] = acc;
          __syncthreads();
          if (kq == 0) { acc = (acc + part[(F.wave + 1) * 64 + F.lane]) + (part[(F.wave + 2) * 64 + F.lane] + part[(F.wave + 3) * 64 + F.lane]);
              const int col = ct * 16 + (F.lane & 15);
#pragma unroll
              for (int i = 0; i < 4; ++i) { const int r = rt * 16 + 4 * (F.lane >> 4) + i; const size_t o = (size_t)r * DM + col; const float v = xs[o] + acc[i]; HS[o] = v; ysamp[o] = v; HB[(size_t)(RP + r) * DM + col] = f2bf(v);
                  float ss = v * v; ss += __shfl_xor(ss, 1); ss += __shfl_xor(ss, 2); ss += __shfl_xor(ss, 4); ss += __shfl_xor(ss, 8);
                  if ((F.lane & 15) == 0) SS[(size_t)MMAIN * 16 + (size_t)r * 64 + ct] = ss; } }
          __syncthreads();
      } }
}
__device__ __forceinline__ void p9_gateup(Frame& F) {
    const bf16* HB = (const bf16*)(F.ws + WS_XN); const bf16* WGU = (const bf16*)(F.ws + WS_WGU); bf16* ACT = (bf16*)(F.ws + WS_ACT); const float* SS = (const float*)(F.ws + WS_SSP);
    { pg8::Gemm g{HB, WGU, MMAIN, 2 * DFF, DM, 1}; pg8::StaticOrder S; S.init(MMAIN, 2 * DFF, F.G, (int)blockIdx.x); EpiSwiGLU E{ACT, SS};
      pg8::gemm_phase<EpiSwiGLU, pg8::StaticOrder, true, true>(F.lds + RING_OFF, g, S, E); }
    const int gw = F.gw, ngw = F.NGW;
    const int nrt = DB / 16, nlt = DFF / 16;
    for (int task = gw; task < nrt * nlt; task += ngw) {
        const int rt = task % nrt, lt = task / nrt; const int lc = lt * 16 + (F.lane & 15);
        const bf16* ap = HB + (size_t)(RP + rt * 16 + (F.lane & 15)) * DM + 8 * (F.lane >> 4);
        const bf16* gp = WGU + (size_t)(256 * (lc >> 7) + (lc & 127)) * DM + 8 * (F.lane >> 4); const bf16* up = gp + (size_t)128 * DM;
        f32x4 ag = {0.f, 0.f, 0.f, 0.f}, au = {0.f, 0.f, 0.f, 0.f};
#pragma unroll 8
        for (int k0 = 0; k0 < DM; k0 += 32) { const bf16x8 a = *(const bf16x8*)(ap + k0); ag = MFMA16(a, *(const bf16x8*)(gp + k0), ag); au = MFMA16(a, *(const bf16x8*)(up + k0), au); }
#pragma unroll
        for (int i = 0; i < 4; ++i) { const int r = rt * 16 + 4 * (F.lane >> 4) + i; const f32x4* sp = (const f32x4*)(SS + (size_t)MMAIN * 16 + (size_t)r * 64); f32x4 s4 = sp[0];
#pragma unroll
            for (int q = 1; q < 16; ++q) s4 += sp[q];
            const float rs = 1.0f / sqrtf(((s4[0] + s4[1]) + (s4[2] + s4[3])) * (1.f / DM) + EPS);
            ACT[(size_t)(RP + r) * DFF + lc] = f2bf(silu_f(rs * ag[i]) * (rs * au[i])); }
    }
}
__device__ __forceinline__ void p10_down(Frame& F) {
    const bf16* ACT = (const bf16*)(F.ws + WS_ACT); const bf16* WDN = (const bf16*)(F.ws + WS_WDN); const float* HS = (const float*)(F.ws + WS_HS);
    { pg8::Gemm g{ACT, WDN, MMAIN, DM, DFF, 1}; pg8::StaticOrder S; S.init(MMAIN, DM, F.G, (int)blockIdx.x); EpiDown E{(const bf16*)(F.ws + WS_XN), F.out + OUT_YP};
      pg8::gemm_phase<EpiDown, pg8::StaticOrder, true, true>(F.lds + RING_OFF, g, S, E); }
    float* ys = F.out + OUT_YS;
    small_gemm(ACT, DFF, WDN, DFF, DB / 16, DM / 16, [](int r) { return RP + r; },
        [&](const f32x4& acc, int rt, int ct, int lane) { const int col = ct * 16 + (lane & 15);
#pragma unroll
            for (int i = 0; i < 4; ++i) atomicAdd(ys + (size_t)(rt * 16 + 4 * (lane >> 4) + i) * DM + col, acc[i]); }, F.gw, F.NGW, F.lane, 4);
}
#ifndef MK_ONE_LAUNCH
#define MK_ONE_LAUNCH 0
#endif
constexpr int N_PHASES = 10;
__global__ void __launch_bounds__(NTHR, 2) mk_fwd(Args args) {
    extern __shared__ __attribute__((aligned(16))) unsigned char lds_raw[];
    Frame F;
    F.lds = (LAS unsigned char*)lds_raw;
    F.tid = threadIdx.x; F.lane = F.tid & 63; F.wave = __builtin_amdgcn_readfirstlane(F.tid >> 6);
    F.G = gridDim.x; { const int bx = blockIdx.x; F.vcu = (F.G % 8 == 0) ? (bx % 8) * (F.G / 8) + bx / 8 : bx; }
    F.gw = blockIdx.x * NWAVES + F.wave; F.NGW = F.G * NWAVES;
    F.ws = args.ws; F.out = args.out; F.in = args.in;
    volatile LAS unsigned* MISC = (volatile LAS unsigned*)(F.lds + MISC_OFF);
    for (int u = F.tid; u < (LDS_BYTES - LDSCTL_OFF) / 4; u += NTHR) ((LAS unsigned*)(F.lds + LDSCTL_OFF))[u] = 0u;
    __syncthreads();
    XcdBarrier bar; bar.bar = (unsigned*)(F.ws + WS_CTL) + CW_BAR; bar.x = 0; bar.st = nullptr;
    const int lo = args.ph_lo, hi = args.ph_hi;
    if (hi - lo > 1) bar = xcd_barrier_post((unsigned*)(F.ws + WS_CTL) + CW_BAR, MISC + 8);
#ifdef MK_TS
    unsigned long long* TSB = (unsigned long long*)(F.ws + 600 * MiB); int tsn = 0;
#define STAMP() do { if (blockIdx.x == 0 && F.tid == 0) TSB[tsn] = __builtin_amdgcn_s_memrealtime(); ++tsn; } while (0)
    STAMP();
#else
#define STAMP() do { } while (0)
#endif
#define IN(k) (lo <= (k) && (k) < hi)
#define SEAM(k) do { if (IN(k) && IN((k) + 1)) xcd_barrier(bar); STAMP(); } while (0)
#ifndef MK_REPEAT
#define MK_REPEAT 0
#endif
#define REP(id, stmt) do { stmt; if (MK_REPEAT & (1 << (id))) { __syncthreads(); stmt; } } while (0)
    if (IN(0)) { REP(0, p0_prologue(F)); } SEAM(0);
    if (IN(1)) { REP(1, p1_inproj(F)); } SEAM(1);
    if (IN(2)) {
#ifdef MK_SLEEP_PROBE
        { const unsigned long long t0 = __builtin_amdgcn_s_memrealtime(); while (__builtin_amdgcn_s_memrealtime() - t0 < 3000ull) __builtin_amdgcn_s_sleep(32); }
#endif
        REP(2, p2_elementwise(F)); } SEAM(2);
    if (IN(3)) { REP(3, p3_upproj_states(F)); } SEAM(3);
    if (IN(4)) { REP(4, p4_post(F)); } SEAM(4);
    if (IN(5)) { const float M0 = softmax_ref(F);
        if (blockIdx.x & 1) { p5_attn_decode(F, M0); __syncthreads(); }
        p5_attn_prompt(F, M0); __syncthreads();
        p5_ssd_out(F); __syncthreads();
        if (!(blockIdx.x & 1)) p5_attn_decode(F, M0);
    } SEAM(5);
    if (IN(6)) { const float M0 = softmax_ref(F); REP(8, p6_decode_combine(F, M0)); } SEAM(6);
    if (IN(7)) { REP(9, p7_outproj(F)); } SEAM(7);
    if (IN(8)) { REP(11, p9_gateup(F)); } SEAM(8);
    if (IN(9)) { p10_down(F); }
#ifdef MK_TS
    __syncthreads(); STAMP();
#endif
#undef IN
#undef SEAM
}
#ifndef MK_DIAG
#define MK_DIAG 0
#endif
__device__ __forceinline__ size_t nmrow(size_t r) { return r < (size_t)MMAIN ? (r >> 11) * TT + NMETA + (r & 2047) : (size_t)RP + (r - MMAIN); }
constexpr size_t WS_OUT2 = 1024 * MiB;
#ifdef MK_TS
__global__ void k_ts_encode(const unsigned long long* ts, float* out, int ia0, int ia1, int ib0, int ib1) {
    const float ta = (float)(ts[ia1] - ts[ia0]) * 0.01f, tb = (float)(ts[ib1] - ts[ib0]) * 0.01f;
    const float f = 1.f + sqrtf(ta * 1e-3f);
    for (int i = blockIdx.x * blockDim.x + threadIdx.x; i < 131072; i += gridDim.x * blockDim.x) out[OUT_YS + i] *= f;
    if (blockIdx.x == 0 && threadIdx.x == 0) out[0] += tb * 0.1f;
}
#endif
extern "C" void kernel_launch(void* const* d_in, const int* in_sizes, int n_in, void* d_out, int out_size, void* d_ws, size_t ws_size, hipStream_t stream) {
    (void)hipFuncSetAttribute((const void*)mk_fwd, hipFuncAttributeMaxDynamicSharedMemorySize, LDS_BYTES);
    unsigned char* ws = (unsigned char*)d_ws;
    (void)hipMemsetAsync(ws + WS_CTL, 0, CTL_ZERO_BYTES, stream);
    Args a{};
    for (int i = 0; i < 30; ++i) a.in[i] = d_in[i];
    a.ws = ws; a.out = (float*)d_out;
#if MK_DIAG
    float* diag = (float*)(ws + WS_DIAG);
    (void)hipMemsetAsync(diag, 0, 512, stream);
    nv::forward(d_in, (float*)d_out, (float*)(ws + WS_NAIVE), stream);
    a.out = (float*)(ws + WS_OUT2);
#endif
    static int one_launch = -1;
    if (one_launch < 0) { int dev = 0, cus = 0, per_cu = 0; one_launch = 0;
        if (hipGetDevice(&dev) == hipSuccess && hipDeviceGetAttribute(&cus, hipDeviceAttributeMultiprocessorCount, dev) == hipSuccess && cus >= 256) one_launch = 1;
        (void)per_cu;
        (void)hipGetLastError(); }
    const int grid = 256;
    if (one_launch && MK_ONE_LAUNCH) { a.ph_lo = 0; a.ph_hi = N_PHASES; a.li = 0; hipLaunchKernelGGL(mk_fwd, dim3(grid), dim3(NTHR), LDS_BYTES, stream, a); }
    else for (int ph = 0; ph < N_PHASES; ++ph) { a.ph_lo = ph; a.ph_hi = ph + 1; a.li = ph; hipLaunchKernelGGL(mk_fwd, dim3(grid), dim3(NTHR), LDS_BYTES, stream, a); }
#ifdef MK_TS
    k_ts_encode<<<64, 256, 0, stream>>>((const unsigned long long*)(ws + 600 * MiB), (float*)d_out, MK_TS_A0, MK_TS_A1, MK_TS_B0, MK_TS_B1);
#endif
#if MK_DIAG
    {
        nv::Ws w = nv::carve((float*)(ws + WS_NAIVE));
        const bf16* QRAW = (const bf16*)(ws + WS_QRAW); const bf16* KVRAW = (const bf16*)(ws + WS_KVRAW); const bf16* Q = (const bf16*)(ws + WS_Q); const bf16* K = (const bf16*)(ws + WS_K);
        const bf16* VT = (const bf16*)(ws + WS_VT); const float* VS = (const float*)(ws + WS_VS); const bf16* MIX = (const bf16*)(ws + WS_MIX);
        const float* o2 = (const float*)(ws + WS_OUT2); const float* o1 = (const float*)d_out;
        const float* nQRAW = w.QRAW; const float* nKV = w.KV; const float* nQ = w.Q; const float* nK = w.K; const float* nV = w.V; const float* nMIX = w.MIX;
        const size_t NMR = (size_t)MMAIN + DB;
        cmp(stream, 0, diag, NMR * 768, [=] __device__(size_t i) { return bf2f(QRAW[nmrow(i / 768) * 768 + i % 768]); }, [=] __device__(size_t i) { return nQRAW[nmrow(i / 768) * 768 + i % 768]; });
        cmp(stream, 1, diag, (size_t)R * 1024, [=] __device__(size_t i) { return bf2f(KVRAW[i]); }, [=] __device__(size_t i) { return nKV[i]; });
        cmp(stream, 2, diag, NMR * 768, [=] __device__(size_t i) { return bf2f(Q[nmrow(i / 768) * 768 + i % 768]); }, [=] __device__(size_t i) { return nQ[nmrow(i / 768) * 768 + i % 768] * (ATTN_SCALE * LOG2E); });
        cmp(stream, 3, diag, (size_t)R * 768, [=] __device__(size_t i) { return bf2f(K[i]); }, [=] __device__(size_t i) { return nK[i]; });
        cmp(stream, 4, diag, (size_t)NB * 512 * TT, [=] __device__(size_t i) { const size_t bhd = i / TT; const int t = (int)(i % TT); return bf2f(VT[bhd * TPAD + t]); },
            [=] __device__(size_t i) { const size_t bhd = i / TT; const int t = (int)(i % TT); const size_t b = bhd / 512, hd = bhd % 512; return nV[(b * TT + t) * 512 + hd]; });
        cmp(stream, 4, diag, (size_t)DB * 512, [=] __device__(size_t i) { return VS[i]; }, [=] __device__(size_t i) { return nV[(size_t)RP * 512 + i]; });
        cmp(stream, 5, diag, (size_t)(OUT_LATS - OUT_SSMP), [=] __device__(size_t i) { return o2[OUT_SSMP + i]; }, [=] __device__(size_t i) { return o1[OUT_SSMP + i]; });
        cmp(stream, 5, diag, (size_t)4194304, [=] __device__(size_t i) { return o2[OUT_SSMS + i]; }, [=] __device__(size_t i) { return o1[OUT_SSMS + i]; });
        cmp(stream, 6, diag, (size_t)R * 512, [=] __device__(size_t i) { return bf2f(MIX[(i >> 9) * 1024 + (i & 511)]); }, [=] __device__(size_t i) { return nMIX[(i >> 9) * 1024 + (i & 511)]; });
        cmp(stream, 7, diag, NMR * 512, [=] __device__(size_t i) { return bf2f(MIX[nmrow(i >> 9) * 1024 + 512 + (i & 511)]); }, [=] __device__(size_t i) { return nMIX[nmrow(i >> 9) * 1024 + 512 + (i & 511)]; });
        cmp(stream, 8, diag, (size_t)OUT_LATP, [=] __device__(size_t i) { return o2[i]; }, [=] __device__(size_t i) { return o1[i]; });
        k_diag_encode<<<64, 256, 0, stream>>>(diag, 9, 1e-3f, (float*)d_out);
    }
#endif
}
```

```cpp
#define MK_DIAG 0
#define MK_ONE_LAUNCH 1
#include <hip/hip_runtime.h>
#include <cstdio>
#include <cstdint>
namespace pg8 {
#define PG8_LAS __attribute__((address_space(3)))
typedef unsigned short bf16_t;
typedef short bf16x8 __attribute__((ext_vector_type(8)));
typedef float f32x4 __attribute__((ext_vector_type(4)));
typedef unsigned u32x4 __attribute__((ext_vector_type(4)));
constexpr int BM = 256, BK = 64, HALF = 128, HTB = HALF * BK * 2  , STAGE_BYTES = 8 * HTB, NXCD = 8, WGM = 8;

__host__ __device__ __forceinline__ int lds_byte(int r, int c) { const int st = (r >> 4) * 2 + (c >> 5), rr = r & 15, cc = c & 31, ob = rr * 64 + cc * 2; return st * 1024 + (ob ^ (((ob >> 9) & 1) << 5)); }
__host__ __device__ __forceinline__ void stage_rc(int b, int& R, int& C) { const int st = b / 1024, sb = b % 1024, swz = sb ^ (((sb >> 9) & 1) << 5); R = (st >> 1) * 16 + swz / 64; C = (st & 1) * 32 + (swz % 64) / 2; }
__host__ __device__ __forceinline__ int perm32(int rho) { const int n = rho >> 4, i = rho & 15; return 8 * (i >> 2) + 4 * n + (i & 3); }

struct Unit { int pm, pn; };
struct Gemm { const bf16_t* A; const bf16_t* Bt; int M, N, K; int rmode;
    __host__ __device__ __forceinline__ int rowbase(int pm) const { return rmode ? (pm >> 3) * 2064 + 16 + (pm & 7) * 256 : pm * 256; } };

struct StaticOrder {
    int nM, nN, nwg, G, c;
    __host__ __device__ void init(int M, int N, int G_, int c_) { nM = M / BM; nN = N / BM; nwg = nM * nN; G = G_; c = c_; }
    __host__ __device__ bool next(int i, Unit& u) const {
        const long L = (long)i * G + c; if (L >= nwg) return false;
        int wgid = (int)L; { const int q = nwg / NXCD, r = nwg % NXCD, xcd = wgid % NXCD, off = wgid / NXCD; wgid = (xcd < r ? xcd * (q + 1) : r * (q + 1) + (xcd - r) * q) + off; }
        const int nig = WGM * nN, gid = wgid / nig, fm = gid * WGM, gsz = (nM - fm) < WGM ? (nM - fm) : WGM;
        u.pm = fm + ((wgid % nig) % gsz); u.pn = (wgid % nig) / gsz; return true;
    }
    __device__ __forceinline__ void a_ready(const Unit&) const {}
    __device__ __forceinline__ void done(const Unit&) const {}
};


template <class Epi, class Sched, bool ALIGN_EPI = false, bool SP2 = false>
__device__ __forceinline__ void gemm_phase(PG8_LAS unsigned char* lds, const Gemm g, const Sched& S, const Epi& E) {
    const int tid = threadIdx.x, wid = __builtin_amdgcn_readfirstlane(tid >> 6), lane = tid & 63, wr = wid >> 2, wc = wid & 3, fr = lane & 15, fq = lane >> 4;
    const int K = g.K, nt = K / BK;
    unsigned voffA[2], voffB[2];
#pragma unroll
    for (int i = 0; i < 2; ++i) { int R, C; stage_rc(tid * 16 + i * 8192, R, C); const int Rb = Epi::PERM ? ((R & ~31) + perm32(R & 31)) : R;
        voffA[i] = (unsigned)(R * K + C) * 2u; voffB[i] = (unsigned)(Rb * K + C) * 2u; }
    const size_t kstep = (size_t)(BK * 2);
    const size_t hstep = (size_t)HALF * K * 2;
    const size_t tstep = 2 * hstep;
    const unsigned ldsw = (unsigned)wid * 1024u;
    const int aoff = lds_byte(wr * 64 + fr, fq * 8), boff = lds_byte(wc * 32 + fr, fq * 8);
#define PG8_SA(b, h) (((b) * 2 + (h)) * HTB)
#define PG8_SB(b, h) ((4 + (b) * 2 + (h)) * HTB)
#define PG8_STAGE(bufoff, gbase, voff) do { _Pragma("unroll") for (int _i = 0; _i < 2; ++_i) \
        __builtin_amdgcn_global_load_lds((const unsigned*)((const char*)(gbase) + (voff)[_i]), (PG8_LAS unsigned*)(lds + (bufoff) + ldsw + _i * 8192), 16, 0, 0); } while (0)
#define PG8_LDA(dst, b, h) do { _Pragma("unroll") for (int m = 0; m < 4; ++m) _Pragma("unroll") for (int k = 0; k < 2; ++k) dst[m][k] = *(const PG8_LAS bf16x8*)(lds + PG8_SA(b, h) + aoff + m * 2048 + k * 1024); } while (0)
#define PG8_LDB(dst, b, h) do { _Pragma("unroll") for (int n = 0; n < 2; ++n) _Pragma("unroll") for (int k = 0; k < 2; ++k) dst[n][k] = *(const PG8_LAS bf16x8*)(lds + PG8_SB(b, h) + boff + n * 2048 + k * 1024); } while (0)
#define PG8_MMA(ai, bj, At, Bt) do { __builtin_amdgcn_s_setprio(1); _Pragma("unroll") for (int m = 0; m < 4; ++m) _Pragma("unroll") for (int n = 0; n < 2; ++n) _Pragma("unroll") for (int k = 0; k < 2; ++k) \
        acc[ai][bj][m][n] = __builtin_amdgcn_mfma_f32_16x16x32_bf16(Bt[n][k], At[m][k], acc[ai][bj][m][n], 0, 0, 0); __builtin_amdgcn_s_setprio(0); } while (0)
#define PG8_WAIT_V(n) asm volatile("s_waitcnt vmcnt(" #n ")" ::: "memory")
#define PG8_WAIT_L(n) asm volatile("s_waitcnt lgkmcnt(" #n ")" ::: "memory")
#define PG8_BAR __builtin_amdgcn_s_barrier()
#define PG8_SCHED __builtin_amdgcn_sched_barrier(0)
    Unit cur, nxt; int ui = 0;
    if (!S.next(0, cur)) return;
    f32x4 acc[2][2][4][2];
#pragma unroll
    for (int a = 0; a < 2; ++a)
#pragma unroll
        for (int b = 0; b < 2; ++b)
#pragma unroll
            for (int m = 0; m < 4; ++m)
#pragma unroll
                for (int n = 0; n < 2; ++n) acc[a][b][m][n] = (f32x4){0.f, 0.f, 0.f, 0.f};
    bf16x8 At[4][2], B0[2][2], B1[2][2];
    const char* cA = (const char*)g.A + (size_t)g.rowbase(cur.pm) * K * 2; const char* cB = (const char*)g.Bt + (size_t)cur.pn * tstep;
    S.a_ready(cur);
    if constexpr (SP2) {
        PG8_STAGE(PG8_SB(0, 0), cB, voffB); PG8_STAGE(PG8_SB(0, 1), cB + hstep, voffB); PG8_STAGE(PG8_SA(0, 0), cA, voffA); PG8_STAGE(PG8_SA(0, 1), cA + hstep, voffA);
        if (wr == 1) PG8_BAR;
        PG8_WAIT_V(2); PG8_BAR;
        PG8_STAGE(PG8_SB(1, 0), cB + kstep, voffB); PG8_STAGE(PG8_SA(1, 0), cA + kstep, voffA); PG8_STAGE(PG8_SB(1, 1), cB + hstep + kstep, voffB);
        PG8_WAIT_V(6); PG8_BAR;
    } else {
        PG8_STAGE(PG8_SB(0, 0), cB, voffB); PG8_STAGE(PG8_SA(0, 0), cA, voffA); PG8_STAGE(PG8_SB(0, 1), cB + hstep, voffB); PG8_STAGE(PG8_SA(0, 1), cA + hstep, voffA);
        if (wr == 1) PG8_BAR;
        PG8_WAIT_V(4); PG8_BAR;
        PG8_STAGE(PG8_SB(1, 0), cB + kstep, voffB); PG8_STAGE(PG8_SA(1, 0), cA + kstep, voffA); PG8_STAGE(PG8_SB(1, 1), cB + hstep + kstep, voffB);
        PG8_WAIT_V(6); PG8_BAR;
    }
    for (;;) {
        const bool has_next = S.next(ui + 1, nxt);
        const char* nA = has_next ? (const char*)g.A + (size_t)g.rowbase(nxt.pm) * K * 2 : cA; const char* nB = has_next ? (const char*)g.Bt + (size_t)nxt.pn * tstep : cB;
        for (int t = 0; t < nt; t += 2) {
            const bool last = (t == nt - 2);
            const char* a1 = cA + (size_t)(t + 1) * kstep;
            const char* a2 = last ? nA : cA + (size_t)(t + 2) * kstep; const char* b2 = last ? nB : cB + (size_t)(t + 2) * kstep;
            const char* a3 = a2 + kstep; const char* b3 = b2 + kstep;
            if (last && has_next) S.a_ready(nxt);
            if constexpr (SP2) {
            PG8_LDB(B0, 0, 0); PG8_LDB(B1, 0, 1); PG8_SCHED; PG8_LDA(At, 0, 0); PG8_STAGE(PG8_SA(1, 1), a1 + hstep, voffA);
            PG8_WAIT_V(8); PG8_WAIT_L(0); PG8_BAR; PG8_MMA(0, 0, At, B0); PG8_MMA(0, 1, At, B1); PG8_BAR; PG8_SCHED;
            PG8_LDA(At, 0, 1); PG8_STAGE(PG8_SB(0, 0), b2, voffB); PG8_STAGE(PG8_SB(0, 1), b2 + hstep, voffB); PG8_STAGE(PG8_SA(0, 0), a2, voffA);
            PG8_WAIT_V(8); PG8_WAIT_L(0); PG8_BAR; PG8_MMA(1, 0, At, B0); PG8_MMA(1, 1, At, B1); PG8_BAR; PG8_SCHED;
            PG8_LDB(B0, 1, 0); PG8_LDB(B1, 1, 1); PG8_SCHED; PG8_LDA(At, 1, 0); PG8_STAGE(PG8_SA(0, 1), a2 + hstep, voffA);
            PG8_WAIT_V(8); PG8_WAIT_L(0); PG8_BAR; PG8_MMA(0, 0, At, B0); PG8_MMA(0, 1, At, B1); PG8_BAR; PG8_SCHED;
            PG8_LDA(At, 1, 1); PG8_STAGE(PG8_SB(1, 0), b3, voffB); PG8_STAGE(PG8_SB(1, 1), b3 + hstep, voffB); PG8_STAGE(PG8_SA(1, 0), a3, voffA);
            PG8_WAIT_V(8); PG8_WAIT_L(0); PG8_BAR; PG8_MMA(1, 0, At, B0); PG8_MMA(1, 1, At, B1); PG8_BAR; PG8_SCHED;
            } else {
            PG8_LDB(B0, 0, 0); PG8_SCHED; PG8_LDA(At, 0, 0); PG8_STAGE(PG8_SA(1, 1), a1 + hstep, voffA);
            PG8_WAIT_L(8); PG8_BAR; PG8_WAIT_L(0); PG8_MMA(0, 0, At, B0); PG8_BAR; PG8_SCHED;
            PG8_LDB(B1, 0, 1); PG8_STAGE(PG8_SB(0, 0), b2, voffB);
            PG8_BAR; PG8_WAIT_L(0); PG8_MMA(0, 1, At, B1); PG8_BAR;
            PG8_LDA(At, 0, 1); PG8_STAGE(PG8_SA(0, 0), a2, voffA);
            PG8_BAR; PG8_WAIT_L(0); PG8_MMA(1, 0, At, B0); PG8_BAR; PG8_SCHED;
            PG8_STAGE(PG8_SB(0, 1), b2 + hstep, voffB);
            PG8_WAIT_V(6); PG8_BAR; PG8_MMA(1, 1, At, B1); PG8_BAR;
            PG8_LDB(B0, 1, 0); PG8_SCHED; PG8_LDA(At, 1, 0); PG8_STAGE(PG8_SA(0, 1), a2 + hstep, voffA);
            PG8_WAIT_L(8); PG8_BAR; PG8_WAIT_L(0); PG8_MMA(0, 0, At, B0); PG8_BAR; PG8_SCHED;
            PG8_LDB(B1, 1, 1); PG8_STAGE(PG8_SB(1, 0), b3, voffB);
            PG8_BAR; PG8_WAIT_L(0); PG8_MMA(0, 1, At, B1); PG8_BAR;
            PG8_LDA(At, 1, 1); PG8_STAGE(PG8_SA(1, 0), a3, voffA);
            PG8_BAR; PG8_WAIT_L(0); PG8_MMA(1, 0, At, B0); PG8_BAR; PG8_SCHED;
            PG8_STAGE(PG8_SB(1, 1), b3 + hstep, voffB);
            PG8_WAIT_V(6); PG8_BAR; PG8_MMA(1, 1, At, B1); PG8_BAR;
            }
        }
        if constexpr (ALIGN_EPI) { if (wr == 0) PG8_BAR; }
        if constexpr (!Epi::AFTER_DRAIN) { E(acc, cur, wr, wc, fr, fq); S.done(cur); }
        if (!has_next) break;
#pragma unroll
        for (int a = 0; a < 2; ++a)
#pragma unroll
            for (int b = 0; b < 2; ++b)
#pragma unroll
                for (int m = 0; m < 4; ++m)
#pragma unroll
                    for (int n = 0; n < 2; ++n) acc[a][b][m][n] = (f32x4){0.f, 0.f, 0.f, 0.f};
        cur = nxt; cA = nA; cB = nB; ++ui;
        if constexpr (ALIGN_EPI) { if (wr == 1) PG8_BAR; }
    }
    PG8_WAIT_V(0);
    if constexpr (!ALIGN_EPI) { if (wr == 0) PG8_BAR; }
    PG8_BAR;
    if constexpr (Epi::AFTER_DRAIN) { E.fused(acc, cur, wr, wc, fr, fq, lds, wid, lane); S.done(cur); }
#undef PG8_SA
#undef PG8_SB
#undef PG8_STAGE
#undef PG8_LDA
#undef PG8_LDB
#undef PG8_MMA
#undef PG8_WAIT_V
#undef PG8_WAIT_L
#undef PG8_BAR
#undef PG8_SCHED
}
}

#define GAS __attribute__((address_space(1)))
#define LAS __attribute__((address_space(3)))
typedef unsigned short bf16;
typedef unsigned v4u __attribute__((ext_vector_type(4)));
typedef unsigned v2u __attribute__((ext_vector_type(2)));
typedef float f32x4 __attribute__((ext_vector_type(4)));
typedef float f32x16 __attribute__((ext_vector_type(16)));
typedef short bf16x8 __attribute__((ext_vector_type(8)));
typedef short s16x4 __attribute__((ext_vector_type(4)));
typedef GAS unsigned gu32;
#define RLX_AGENT __ATOMIC_RELAXED, __HIP_MEMORY_SCOPE_AGENT
#define LDS_WAIT() asm volatile("s_waitcnt lgkmcnt(0)" ::: "memory")
#define VM_WAIT() asm volatile("s_waitcnt vmcnt(0)" ::: "memory")
typedef float f32x2_t __attribute__((ext_vector_type(2))); typedef __bf16 bf16x2_t __attribute__((ext_vector_type(2)));
__device__ __forceinline__ unsigned pk2(float lo, float hi) { f32x2_t v = {lo, hi}; bf16x2_t b = __builtin_convertvector(v, bf16x2_t); return __builtin_bit_cast(unsigned, b); }
__device__ __forceinline__ bf16 f2bf(float f) { return (bf16)(pk2(f, 0.f) & 0xffffu); }
__device__ __forceinline__ float bf2f(bf16 v) { return __uint_as_float((unsigned)v << 16); }
__device__ __forceinline__ float bflo(unsigned w) { return __uint_as_float(w << 16); }
__device__ __forceinline__ float bfhi(unsigned w) { return __uint_as_float(w & 0xffff0000u); }

#define XB_TMO      128
#define XB_XCNT(j)  (256  + 64 * (j))
#define XB_XSUB(j)  (1280 + 64 * (j))
#define XB_XGEN(j)  (2304 + 64 * (j))
#define XB_TOP      3328
#define XB_TOPGEN   3392
#define XCD_BAR_WORDS 3456
#define XB_SPIN_CAP (1u << 18)
__device__ __forceinline__ unsigned xb_ld(unsigned* p)              { return __hip_atomic_load(p, __ATOMIC_RELAXED, __HIP_MEMORY_SCOPE_AGENT); }
__device__ __forceinline__ unsigned xb_add(unsigned* p, unsigned v) { return __hip_atomic_fetch_add(p, v, __ATOMIC_RELAXED, __HIP_MEMORY_SCOPE_AGENT); }
__device__ __forceinline__ unsigned xb_xcc_id() { return (unsigned)__builtin_amdgcn_s_getreg((3 << 11) | 20) & 0xFu; }
#define XB_SPIN(cond, bar) do { unsigned _sp = 0; while (cond) { __builtin_amdgcn_s_sleep(1); \
    if ((++_sp & 255u) == 0u) { if (xb_ld(&(bar)[XB_TMO])) break; if (_sp > XB_SPIN_CAP) { atomicAdd(&(bar)[XB_TMO], 1u); break; } } } } while (0)
struct XcdBarrier { unsigned* bar; unsigned x; volatile LAS unsigned* st; };
__device__ __forceinline__ XcdBarrier xcd_barrier_post(unsigned* bar, volatile LAS unsigned* st) {
    XcdBarrier b; b.bar = bar; b.x = xb_xcc_id(); b.st = st;
    if (threadIdx.x == 0) (void)xb_add(&bar[XB_XCNT(b.x)], 1u);
    return b;
}
__device__ __forceinline__ void xcd_barrier_complete(unsigned* bar, unsigned x, unsigned& nloc, unsigned& nx) {
    const unsigned G = gridDim.x * gridDim.y * gridDim.z;
    unsigned sum, cnt, mine, sp = 0u;
    for (;;) {
        sum = 0u; cnt = 0u; mine = 0u;
#pragma unroll
        for (unsigned j = 0; j < 16; ++j) { const unsigned c = xb_ld(&bar[XB_XCNT(j)]); sum += c; cnt += (c > 0u) ? 1u : 0u; mine = (j == x) ? c : mine; }
        if (sum == G) break;
        __builtin_amdgcn_s_sleep(1);
        if ((++sp & 255u) == 0u) { if (xb_ld(&bar[XB_TMO])) break; if (sp > XB_SPIN_CAP) { atomicAdd(&bar[XB_TMO], 1u); break; } }
    }
    nloc = mine > 0u ? mine : 1u; nx = cnt > 0u ? cnt : 1u;
}
__device__ __forceinline__ void xcd_barrier(const XcdBarrier& b) {
    asm volatile("s_waitcnt vmcnt(0)" ::: "memory");
    __syncthreads();
    if (threadIdx.x == 0) {
        unsigned* bar = b.bar;
        __builtin_amdgcn_s_waitcnt(0);
        unsigned nloc = b.st[0], nx = b.st[1];
        if (nloc == 0u) { xcd_barrier_complete(bar, b.x, nloc, nx); b.st[0] = nloc; b.st[1] = nx; }
        const unsigned old = xb_add(&bar[XB_XSUB(b.x)], 1u);
        const unsigned gen = old / nloc;
        if (old + 1u == (gen + 1u) * nloc) {
            __builtin_amdgcn_fence(__ATOMIC_RELEASE, "agent");
            asm volatile("s_waitcnt vmcnt(0)" ::: "memory");
            const unsigned og = xb_add(&bar[XB_TOP], 1u);
            const unsigned tg = og / nx;
            if (og + 1u == (tg + 1u) * nx) xb_add(&bar[XB_TOPGEN], 1u);
            else XB_SPIN(xb_ld(&bar[XB_TOPGEN]) == tg, bar);
            __builtin_amdgcn_fence(__ATOMIC_ACQUIRE, "agent");
            xb_add(&bar[XB_XGEN(b.x)], 1u);
            asm volatile("s_waitcnt vmcnt(0)" ::: "memory");
        } else {
            XB_SPIN(xb_ld(&bar[XB_XGEN(b.x)]) == gen, bar);
            __builtin_amdgcn_fence(__ATOMIC_ACQUIRE, "agent");
            asm volatile("s_waitcnt vmcnt(0)" ::: "memory");
        }
    }
    __syncthreads();
}

constexpr int DM = 1024, NB = 8, SEQ = 2048, NMETA = 16, TT = SEQ + NMETA;
constexpr int DB = 128, PAST = 8192, PAGE = 128, NPAGES = 64;
constexpr int NH = 8, HP = 64, SSDW = 512, NG = 2, DS = 64, CONVD = 768;
constexpr int QKD = 96, VD = 64, MLAW = 512, QL = 384, KVL = 256, DFF = 2816, INC = 1960;
constexpr int RP = NB * TT, R = RP + DB;
constexpr int MMAIN = NB * SEQ;
constexpr int NS = NMETA + DB;
constexpr float EPS = 1e-6f, ATTN_SCALE = 0.10206207261596577f, LOG2E = 1.4426950408889634f;
constexpr int PJ = 2048, C_Z = 0, C_XBC = 512, C_CKV = 1280, C_CQ = 1536, C_DT = 1920, C_KR = 1928;
constexpr int S_Z = 0, S_XBC = 512, S_DT = 1280, S_CQ = 1288, S_CKV = 1672, S_KR = 1928;
constexpr int TPAD = 2112;
constexpr int NCH = 33, CHL = 64, TOFF = 48;
constexpr size_t OUT_YP = 0, OUT_YS = 16777216, OUT_LATP = 16908288, OUT_KRP = 21135360, OUT_CONVP = 21663744,
                 OUT_SSMP = 21682176, OUT_LATS = 21944320, OUT_KRS = 21977088, OUT_CONVS = 21981184, OUT_SSMS = 22276096;

constexpr size_t MiB = 1u << 20;
constexpr size_t WS_CTL = 0, CTL_ZERO_BYTES = 32 * 1024;
constexpr int CW_BAR = 4096;
constexpr size_t WS_SS = 512 * 1024;
constexpr size_t WS_WIN = 2 * MiB;
constexpr size_t WS_WUQ = 6 * MiB;
constexpr size_t WS_WUKV = 7 * MiB;
constexpr size_t WS_WOUT = 8 * MiB;
constexpr size_t WS_WGU = 10 * MiB;
constexpr size_t WS_WDN = 22 * MiB;
constexpr size_t WS_XN = 32 * MiB;
constexpr size_t WS_PROJ = 66 * MiB;
constexpr size_t WS_DTRAW = 132 * MiB;
constexpr size_t WS_DT = 133 * MiB;
constexpr size_t WS_LAT = 134 * MiB;
constexpr size_t WS_CQN = 143 * MiB;
constexpr size_t WS_KRF = 156 * MiB;
constexpr size_t WS_XST = 159 * MiB;
constexpr size_t WS_BT = 176 * MiB;
constexpr size_t WS_BC = 181 * MiB;
constexpr size_t WS_XAS = 190 * MiB;
constexpr size_t WS_QRAW = 191 * MiB;
constexpr size_t WS_KVRAW = 216 * MiB;
constexpr size_t WS_Q = 249 * MiB;
constexpr size_t WS_K = 274 * MiB;
constexpr size_t WS_VT = 299 * MiB;
constexpr size_t WS_STATES = 316 * MiB;
constexpr size_t WS_DECAY = 350 * MiB;
constexpr size_t WS_HIN = 351 * MiB;
constexpr size_t WS_MIX = 368 * MiB;
constexpr size_t WS_ACT = 401 * MiB;
constexpr size_t WS_VS = 491 * MiB;
constexpr size_t WS_DPART = 492 * MiB;
constexpr size_t WS_HS = 494 * MiB;
constexpr size_t WS_ROPE = 496 * MiB;
constexpr size_t WS_SSP = 520 * MiB;
constexpr size_t WS_OPT_END = 522 * MiB;
constexpr size_t WS_NAIVE = 2048 * MiB;
constexpr size_t WS_DIAG = 1 * MiB;

constexpr int RING_OFF = 0, RING_BYTES = 131072;
constexpr int LDSCTL_OFF = RING_BYTES, MISC_OFF = LDSCTL_OFF + 320;
constexpr int LDS_BYTES = 163840;
constexpr int NWAVES = 8, NTHR = 512;

struct Args { const void* in[30]; float* out; unsigned char* ws; int ph_lo, ph_hi, li, pad; };

struct Frame {
    LAS unsigned char* lds;
    int tid, lane, wave, G, vcu, gw, NGW;
    unsigned char* ws; float* out;
    const void* const* in;
};
__device__ __forceinline__ float wave_sum(float v) {
#pragma unroll
    for (int o = 1; o < 64; o <<= 1) v += __shfl_xor(v, o);
    return v;
}
__device__ __forceinline__ float wave_max(float v) {
#pragma unroll
    for (int o = 1; o < 64; o <<= 1) v = fmaxf(v, __shfl_xor(v, o));
    return v;
}
__device__ __forceinline__ float silu_f(float x) { return x / (1.f + __expf(-x)); }
__device__ __forceinline__ float softplus_f(float x) { return fmaxf(x, 0.f) + log1pf(expf(-fabsf(x))); }
__device__ __forceinline__ float rope_inv(int j) { return exp2f(-(float)j * (13.287712379549449f / 16.0f)); }
struct EpiProj {
    static constexpr bool PERM = true, AFTER_DRAIN = false;
    bf16* O; float* dtraw; int rmode;
    __device__ __forceinline__ void operator()(const pg8::f32x4 (&acc)[2][2][4][2], const pg8::Unit& u, int wr, int wc, int fr, int fq) const {
        const int rb = rmode ? (u.pm >> 3) * 2064 + 16 + (u.pm & 7) * 256 : u.pm * 256;
        const int row0 = rb + wr * 64 + fr, col0 = u.pn * 256 + wc * 32 + 8 * fq;
#pragma unroll
        for (int ai = 0; ai < 2; ++ai)
#pragma unroll
            for (int m = 0; m < 4; ++m) { const int row = row0 + ai * 128 + m * 16; bf16* rowp = O + (size_t)row * PJ + col0;
#pragma unroll
                for (int bj = 0; bj < 2; ++bj) { const pg8::f32x4 v0 = acc[ai][bj][m][0], v1 = acc[ai][bj][m][1];
                    v4u w; w.x = pk2(v0[0], v0[1]); w.y = pk2(v0[2], v0[3]); w.z = pk2(v1[0], v1[1]); w.w = pk2(v1[2], v1[3]);
                    *(v4u*)(rowp + bj * 128) = w; }
                if (u.pn == 7 && wc == 0 && fq == 0) { *(pg8::f32x4*)(dtraw + (size_t)row * 8) = acc[ai][1][m][0]; *(pg8::f32x4*)(dtraw + (size_t)row * 8 + 4) = acc[ai][1][m][1]; } }
    }
};
struct EpiBf16 {
    static constexpr bool PERM = true, AFTER_DRAIN = false;
    bf16* O; int ldc; int rmode;
    __device__ __forceinline__ void operator()(const pg8::f32x4 (&acc)[2][2][4][2], const pg8::Unit& u, int wr, int wc, int fr, int fq) const {
        const int rb = rmode ? (u.pm >> 3) * 2064 + 16 + (u.pm & 7) * 256 : u.pm * 256;
        const int row0 = rb + wr * 64 + fr, col0 = u.pn * 256 + wc * 32 + 8 * fq;
#pragma unroll
        for (int ai = 0; ai < 2; ++ai)
#pragma unroll
            for (int m = 0; m < 4; ++m) { bf16* rowp = O + (size_t)(row0 + ai * 128 + m * 16) * ldc + col0;
#pragma unroll
                for (int bj = 0; bj < 2; ++bj) { const pg8::f32x4 v0 = acc[ai][bj][m][0], v1 = acc[ai][bj][m][1];
                    v4u w; w.x = pk2(v0[0], v0[1]); w.y = pk2(v0[2], v0[3]); w.z = pk2(v1[0], v1[1]); w.w = pk2(v1[2], v1[3]);
                    *(v4u*)(rowp + bj * 128) = w; } }
    }
};
struct EpiResF32 {
    static constexpr bool PERM = false, AFTER_DRAIN = false;
    const float* res; float* out;
    __device__ __forceinline__ void operator()(const pg8::f32x4 (&acc)[2][2][4][2], const pg8::Unit& u, int wr, int wc, int fr, int fq) const {
        const int row0 = u.pm * 256 + wr * 64 + fr, col0 = u.pn * 256 + wc * 32 + 4 * fq;
#pragma unroll
        for (int ai = 0; ai < 2; ++ai)
#pragma unroll
            for (int m = 0; m < 4; ++m) { const size_t off = (size_t)(row0 + ai * 128 + m * 16) * DM + col0;
#pragma unroll
                for (int bj = 0; bj < 2; ++bj)
#pragma unroll
                    for (int n = 0; n < 2; ++n) { const pg8::f32x4 r = *(const pg8::f32x4*)(res + off + bj * 128 + n * 16); *(pg8::f32x4*)(out + off + bj * 128 + n * 16) = r + acc[ai][bj][m][n]; } }
    }
};
struct EpiOutProj {
    static constexpr bool PERM = false, AFTER_DRAIN = false;
    const float* res; float* out; bf16* HB; float* SS;
    __device__ __forceinline__ void operator()(const pg8::f32x4 (&acc)[2][2][4][2], const pg8::Unit& u, int wr, int wc, int fr, int fq) const {
        const int rb = (u.pm >> 3) * 2064 + 16 + (u.pm & 7) * 256;
        const int row0 = u.pm * 256 + wr * 64 + fr, col0 = u.pn * 256 + wc * 32 + 4 * fq;
        pg8::f32x4 rc[4], rn[4];
#define EOP_LOAD(dst, g) do { const size_t off_ = (size_t)(row0 + ((g) >> 2) * 128 + ((g) & 3) * 16) * DM + col0; \
            dst[0] = *(const pg8::f32x4*)(res + off_); dst[1] = *(const pg8::f32x4*)(res + off_ + 16); dst[2] = *(const pg8::f32x4*)(res + off_ + 128); dst[3] = *(const pg8::f32x4*)(res + off_ + 144); } while (0)
        EOP_LOAD(rc, 0);
#pragma unroll
        for (int g = 0; g < 8; ++g) { const int ai = g >> 2, m = g & 3;
            if (g < 7) EOP_LOAD(rn, g + 1);
            const int orow = row0 + ai * 128 + m * 16; bf16* hb = HB + (size_t)(rb + wr * 64 + fr + ai * 128 + m * 16) * DM + col0; float ss = 0.f;
#pragma unroll
            for (int bj = 0; bj < 2; ++bj)
#pragma unroll
                for (int n = 0; n < 2; ++n) { const pg8::f32x4 v = rc[2 * bj + n] + acc[ai][bj][m][n];
                    ss += (v[0] * v[0] + v[1] * v[1]) + (v[2] * v[2] + v[3] * v[3]); v2u w; w.x = pk2(v[0], v[1]); w.y = pk2(v[2], v[3]); *(v2u*)(hb + bj * 128 + n * 16) = w; }
            ss += __shfl_xor(ss, 16); ss += __shfl_xor(ss, 32);
            if (fq == 0) SS[(size_t)orow * 16 + u.pn * 4 + wc] = ss;
#pragma unroll
            for (int i = 0; i < 4; ++i) rc[i] = rn[i]; }
#undef EOP_LOAD
    }
};
struct EpiDown {
    static constexpr bool PERM = false, AFTER_DRAIN = false;
    const bf16* HB; float* out;
    __device__ __forceinline__ void operator()(const pg8::f32x4 (&acc)[2][2][4][2], const pg8::Unit& u, int wr, int wc, int fr, int fq) const {
        const int rb = (u.pm >> 3) * 2064 + 16 + (u.pm & 7) * 256;
        const int row0 = u.pm * 256 + wr * 64 + fr, col0 = u.pn * 256 + wc * 32 + 4 * fq;
        v2u rc[4], rn[4];
#define EDN_LOAD(dst, g) do { const bf16* hb_ = HB + (size_t)(rb + wr * 64 + fr + ((g) >> 2) * 128 + ((g) & 3) * 16) * DM + col0; \
            dst[0] = *(const v2u*)(hb_); dst[1] = *(const v2u*)(hb_ + 16); dst[2] = *(const v2u*)(hb_ + 128); dst[3] = *(const v2u*)(hb_ + 144); } while (0)
        EDN_LOAD(rc, 0);
#pragma unroll
        for (int g = 0; g < 8; ++g) { const int ai = g >> 2, m = g & 3;
            if (g < 7) EDN_LOAD(rn, g + 1);
            const size_t off = (size_t)(row0 + ai * 128 + m * 16) * DM + col0;
#pragma unroll
            for (int bj = 0; bj < 2; ++bj)
#pragma unroll
                for (int n = 0; n < 2; ++n) { const v2u w = rc[2 * bj + n]; const pg8::f32x4 r = {bflo(w.x), bfhi(w.x), bflo(w.y), bfhi(w.y)}; *(pg8::f32x4*)(out + off + bj * 128 + n * 16) = r + acc[ai][bj][m][n]; }
#pragma unroll
            for (int i = 0; i < 4; ++i) rc[i] = rn[i]; }
#undef EDN_LOAD
    }
};
struct EpiSwiGLU {
    static constexpr bool PERM = true, AFTER_DRAIN = false;
    bf16* O; const LAS float* RS; pg8::StaticOrder S;
    __device__ __forceinline__ void operator()(const pg8::f32x4 (&acc)[2][2][4][2], const pg8::Unit& u, int wr, int wc, int fr, int fq) const {
        const int rb = (u.pm >> 3) * 2064 + 16 + (u.pm & 7) * 256;
        const int row0 = rb + wr * 64 + fr, col0 = u.pn * 128 + wc * 32 + 8 * fq;
        int slot = 0;
#pragma unroll 1
        for (int i = 0; i < 8; ++i) { pg8::Unit uu; if (!S.next(i, uu)) break; if (uu.pm == u.pm && uu.pn == u.pn) { slot = i; break; } }
        const LAS float* rsp = RS + slot * 256 + wr * 64 + fr;
#pragma unroll
        for (int ai = 0; ai < 2; ++ai)
#pragma unroll
            for (int m = 0; m < 4; ++m) { float a[8]; const float rs = rsp[ai * 128 + m * 16];
#pragma unroll
                for (int n = 0; n < 2; ++n)
#pragma unroll
                    for (int e = 0; e < 4; ++e) a[4 * n + e] = silu_f(rs * acc[ai][0][m][n][e]) * (rs * acc[ai][1][m][n][e]);
                v4u w; w.x = pk2(a[0], a[1]); w.y = pk2(a[2], a[3]); w.z = pk2(a[4], a[5]); w.w = pk2(a[6], a[7]);
                *(v4u*)(O + (size_t)(row0 + ai * 128 + m * 16) * DFF + col0) = w; }
    }
};

template <class ARow, class Epi>
__device__ __forceinline__ void small_gemm(const bf16* A, int lda, const bf16* Bt, int K, int nrt, int nct, const ARow& arow, const Epi& E, int gw, int NGW, int lane, int ksplit = 1) {
    const int ntask = nrt * nct * ksplit, kc = K / ksplit;
    for (int task = gw; task < ntask; task += NGW) {
        const int rt = task % nrt, ct = (task / nrt) % nct, kq = task / (nrt * nct);
        const bf16* ap = A + (size_t)arow(rt * 16 + (lane & 15)) * lda + kq * kc + 8 * (lane >> 4);
        const bf16* bp = Bt + (size_t)(ct * 16 + (lane & 15)) * K + kq * kc + 8 * (lane >> 4);
        f32x4 acc = {0.f, 0.f, 0.f, 0.f};
#pragma unroll 1
        for (int k0 = 0; k0 < kc; k0 += 32 * 11) {
            bf16x8 av[11], bv[11];
#pragma unroll
            for (int j = 0; j < 11; ++j) if (k0 + 32 * j < kc) { av[j] = *(const bf16x8*)(ap + k0 + 32 * j); bv[j] = *(const bf16x8*)(bp + k0 + 32 * j); }
#pragma unroll
            for (int j = 0; j < 11; ++j) if (k0 + 32 * j < kc) acc = __builtin_amdgcn_mfma_f32_16x16x32_bf16(av[j], bv[j], acc, 0, 0, 0);
        }
        E(acc, rt, ct, lane);
    }
}

template <class RM>
__device__ __forceinline__ void transpose_item(const float* W, int N, int ldw, bf16* WT, int ldt, int item, LAS float* scr, int lane, const RM& rm, const float* kscale = nullptr) {
    const int nblk = (N + 31) / 32, kb = item / nblk, nb = item % nblk, k0 = 64 * kb, n0 = 32 * nb;
    { const int n = n0 + (lane & 31); float v[32];
#pragma unroll
      for (int i = 0; i < 32; ++i) { const int kk = 2 * i + (lane >> 5); v[i] = (n < N) ? W[(size_t)(k0 + kk) * ldw + n] : 0.f; }
#pragma unroll
      for (int i = 0; i < 32; ++i) { const int kk = 2 * i + (lane >> 5); float x = v[i]; if (kscale) x *= kscale[k0 + kk]; scr[kk * 33 + (lane & 31)] = x; } }
    LDS_WAIT(); asm volatile("" ::: "memory");
    const int c = lane & 7;
#pragma unroll
    for (int j = 0; j < 4; ++j) { const int n = (lane >> 3) + 8 * j; const LAS float* s = scr + (8 * c) * 33 + n;
        if (n0 + n < N) { v4u o; o.x = pk2(s[0 * 33], s[1 * 33]); o.y = pk2(s[2 * 33], s[3 * 33]); o.z = pk2(s[4 * 33], s[5 * 33]); o.w = pk2(s[6 * 33], s[7 * 33]);
            *(v4u*)(WT + (size_t)rm(n0 + n) * ldt + k0 + 8 * c) = o; } }
    LDS_WAIT(); asm volatile("" ::: "memory");
}
__device__ __forceinline__ int map_in(int n) {
    return n < S_DT ? n : n < S_CQ ? C_DT + (n - S_DT) : n < S_CKV ? C_CQ + (n - S_CQ) : n < S_KR ? C_CKV + (n - S_CKV) : n;
}
__device__ __forceinline__ void p0_prologue(Frame& F) {
    LAS float* scr = (LAS float*)(F.lds + RING_OFF + F.wave * 16384);
    const float* w_in = (const float*)F.in[9]; const float* w_uq = (const float*)F.in[17]; const float* w_ukv = (const float*)F.in[19]; const float* w_out = (const float*)F.in[25];
    const float* w_gate = (const float*)F.in[27]; const float* w_up = (const float*)F.in[28]; const float* w_down = (const float*)F.in[29];
    bf16* WIN = (bf16*)(F.ws + WS_WIN); bf16* WUQ = (bf16*)(F.ws + WS_WUQ); bf16* WUKV = (bf16*)(F.ws + WS_WUKV); bf16* WOUT = (bf16*)(F.ws + WS_WOUT); bf16* WGU = (bf16*)(F.ws + WS_WGU); bf16* WDN = (bf16*)(F.ws + WS_WDN);
    const float* ffg = (const float*)F.in[26];
    constexpr int I_IN = 16 * 62, I_UQ = 6 * 24, I_UKV = 4 * 32, I_OUT = 16 * 32, I_G = 16 * 88, I_DN = 44 * 32;
    constexpr int NITEMS = I_IN + I_UQ + I_UKV + I_OUT + 2 * I_G + I_DN;
    for (int it = F.gw; it < NITEMS; it += F.NGW) {
        int r = it;
        if (r < I_IN) { transpose_item(w_in, INC, INC, WIN, DM, r, scr, F.lane, [](int n) { return map_in(n); }); continue; } r -= I_IN;
        if (r < I_UQ) { transpose_item(w_uq, 768, 768, WUQ, QL, r, scr, F.lane, [](int n) { return n; }); continue; } r -= I_UQ;
        if (r < I_UKV) { transpose_item(w_ukv, 1024, 1024, WUKV, KVL, r, scr, F.lane, [](int n) { return n; }); continue; } r -= I_UKV;
        if (r < I_OUT) { transpose_item(w_out, DM, DM, WOUT, 1024, r, scr, F.lane, [](int n) { return n; }); continue; } r -= I_OUT;
        if (r < I_G) { transpose_item(w_gate, DFF, DFF, WGU, DM, r, scr, F.lane, [](int n) { return 256 * (n >> 7) + (n & 127); }, ffg); continue; } r -= I_G;
        if (r < I_G) { transpose_item(w_up, DFF, DFF, WGU, DM, r, scr, F.lane, [](int n) { return 256 * (n >> 7) + 128 + (n & 127); }, ffg); continue; } r -= I_G;
        transpose_item(w_down, DM, DM, WDN, DFF, r, scr, F.lane, [](int n) { return n; });
    }
    for (int i = F.gw * 64 + F.lane; i < 88 * 1024 / 8; i += F.NGW * 64) *(v4u*)(WIN + (size_t)1960 * 1024 + (size_t)i * 8) = (v4u){0u, 0u, 0u, 0u};
    const float* xp = (const float*)F.in[0]; const float* xs = (const float*)F.in[1]; const float* meta = (const float*)F.in[7]; const float* g = (const float*)F.in[8];
    bf16* XN = (bf16*)(F.ws + WS_XN);
    f32x4 gv[4];
#pragma unroll
    for (int j = 0; j < 4; ++j) gv[j] = ((const f32x4*)g)[F.lane + 64 * j];
    for (int r0 = 2 * F.gw; r0 < R; r0 += 2 * F.NGW) {
        f32x4 v[2][4];
#pragma unroll
        for (int i = 0; i < 2; ++i) { const int row = r0 + i; const float* src;
            if (row < RP) { const int b = row / TT, t = row % TT; src = (t < NMETA) ? meta + (size_t)t * DM : xp + ((size_t)b * SEQ + (t - NMETA)) * DM; } else src = xs + (size_t)(row - RP) * DM;
#pragma unroll
            for (int j = 0; j < 4; ++j) v[i][j] = ((const f32x4*)src)[F.lane + 64 * j]; }
#pragma unroll
        for (int i = 0; i < 2; ++i) { float s = 0.f;
#pragma unroll
            for (int j = 0; j < 4; ++j) s += (v[i][j].x * v[i][j].x + v[i][j].y * v[i][j].y) + (v[i][j].z * v[i][j].z + v[i][j].w * v[i][j].w);
            const float rs = 1.0f / sqrtf(wave_sum(s) * (1.f / DM) + EPS);
            v2u* o8 = (v2u*)(XN + (size_t)(r0 + i) * DM) + F.lane;
#pragma unroll
            for (int j = 0; j < 4; ++j) { v2u o; o.x = pk2(v[i][j].x * rs * gv[j].x, v[i][j].y * rs * gv[j].y); o.y = pk2(v[i][j].z * rs * gv[j].z, v[i][j].w * rs * gv[j].w); o8[64 * j] = o; } }
    }
    float* ROPE = (float*)(F.ws + WS_ROPE);
    for (int i = blockIdx.x * NTHR + F.tid; i < (TT + 1) * 16; i += F.G * NTHR) { const int p = i >> 4, j = i & 15; const float ang = (float)(p < TT ? p : PAST) * rope_inv(j); ROPE[2 * i] = cosf(ang); ROPE[2 * i + 1] = sinf(ang); }
}

__device__ __forceinline__ int small_arow(int r) { return r < NMETA ? r : RP + (r - NMETA); }
__device__ __forceinline__ void p1_inproj(Frame& F) {
    const bf16* XN = (const bf16*)(F.ws + WS_XN); const bf16* WIN = (const bf16*)(F.ws + WS_WIN); bf16* PROJ = (bf16*)(F.ws + WS_PROJ); float* DTRAW = (float*)(F.ws + WS_DTRAW);
    { pg8::Gemm g{XN, WIN, MMAIN, PJ, DM, 1}; pg8::StaticOrder S; S.init(MMAIN, PJ, F.G, (int)blockIdx.x);
      EpiProj E{PROJ, DTRAW, 1};
      pg8::gemm_phase<EpiProj, pg8::StaticOrder, true, true>(F.lds + RING_OFF, g, S, E); }
    auto epi = [&](const f32x4& acc, int rt, int ct, int lane) {
        const int col = ct * 16 + (lane & 15);
#pragma unroll
        for (int i = 0; i < 4; ++i) { const int r = rt * 16 + 4 * (lane >> 4) + i; const bf16 v = f2bf(acc[i]);
            if (r < NMETA) { for (int b = 0; b < NB; ++b) { PROJ[(size_t)(b * TT + r) * PJ + col] = v; if (col >= C_DT && col < C_DT + 8) DTRAW[(size_t)(b * TT + r) * 8 + (col - C_DT)] = acc[i]; } }
            else { const int row = RP + (r - NMETA); PROJ[(size_t)row * PJ + col] = v; if (col >= C_DT && col < C_DT + 8) DTRAW[(size_t)row * 8 + (col - C_DT)] = acc[i]; } }
    };
    small_gemm(XN, DM, WIN, DM, NS / 16, PJ / 16, [](int r) { return small_arow(r); }, epi, F.gw, F.NGW, F.lane);
}

constexpr int CV_LDS_STRIDE = 82;
__device__ __forceinline__ void p2_elementwise(Frame& F) {
    const bf16* PROJ = (const bf16*)(F.ws + WS_PROJ); const float* DTRAW = (const float*)(F.ws + WS_DTRAW); float* DT = (float*)(F.ws + WS_DT);
    bf16* LAT = (bf16*)(F.ws + WS_LAT); bf16* CQN = (bf16*)(F.ws + WS_CQN); float* KRF = (float*)(F.ws + WS_KRF);
    const float* kvg = (const float*)F.in[18]; const float* qng = (const float*)F.in[16]; const float* dtb = (const float*)F.in[12]; const float* ROPE = (const float*)(F.ws + WS_ROPE);
    {
        const f32x4 gg = ((const f32x4*)kvg)[F.lane]; const float* gq = qng + 6 * F.lane; const float g0 = gq[0], g1 = gq[1], g2 = gq[2], g3 = gq[3], g4 = gq[4], g5 = gq[5]; const float dbias = dtb[F.lane & 7];
        v2u wk[4], wkn[4]; unsigned wq[4][3], wqn[4][3]; unsigned short kr1[4], kr2[4], kr1n[4], kr2n[4]; float dtr[4], dtrn[4]; f32x2_t cs[4], csn[4];
#define P2A_LOAD(WK, WQ, K1, K2, DTR, CS, r0, n) do { _Pragma("unroll") for (int i = 0; i < 4; ++i) if (i < (n)) { const int row = (r0) + i; const bf16* pr = PROJ + (size_t)row * PJ; \
            WK[i] = *(const v2u*)(pr + C_CKV + 4 * F.lane); const unsigned* p = (const unsigned*)(pr + C_CQ + 6 * F.lane); WQ[i][0] = p[0]; WQ[i][1] = p[1]; WQ[i][2] = p[2]; \
            K1[i] = pr[C_KR + (F.lane & 15)]; K2[i] = pr[C_KR + 16 + (F.lane & 15)]; DTR[i] = DTRAW[(size_t)row * 8 + (F.lane & 7)]; \
            CS[i] = *(const f32x2_t*)(ROPE + 2 * ((row < RP ? row % TT : TT) * 16 + (F.lane & 15))); } } while (0)
#define P2A_PROC(r0, n) do { _Pragma("unroll") for (int i = 0; i < 4; ++i) if (i < (n)) { const int row = (r0) + i; \
            { const float v0 = bflo(wk[i].x), v1 = bfhi(wk[i].x), v2 = bflo(wk[i].y), v3 = bfhi(wk[i].y); \
              const float rs = 1.0f / sqrtf(wave_sum((v0 * v0 + v1 * v1) + (v2 * v2 + v3 * v3)) * (1.f / KVL) + EPS); \
              const f32x4 o = {v0 * rs * gg.x, v1 * rs * gg.y, v2 * rs * gg.z, v3 * rs * gg.w}; \
              float* of = (row < RP) ? F.out + OUT_LATP + (size_t)row * KVL : F.out + OUT_LATS + (size_t)(row - RP) * KVL; \
              ((f32x4*)of)[F.lane] = o; v2u ob; ob.x = pk2(o.x, o.y); ob.y = pk2(o.z, o.w); *(v2u*)(LAT + (size_t)row * KVL + 4 * F.lane) = ob; } \
            { const float v0 = bflo(wq[i][0]), v1 = bfhi(wq[i][0]), v2 = bflo(wq[i][1]), v3 = bfhi(wq[i][1]), v4 = bflo(wq[i][2]), v5 = bfhi(wq[i][2]); \
              const float rs = 1.0f / sqrtf(wave_sum((v0 * v0 + v1 * v1) + (v2 * v2 + v3 * v3) + (v4 * v4 + v5 * v5)) * (1.f / QL) + EPS); \
              unsigned* o = (unsigned*)(CQN + (size_t)row * QL + 6 * F.lane); \
              o[0] = pk2(v0 * rs * g0, v1 * rs * g1); o[1] = pk2(v2 * rs * g2, v3 * rs * g3); o[2] = pk2(v4 * rs * g4, v5 * rs * g5); } \
            if (F.lane < 16) { const int j = F.lane; const float c = cs[i].x, s = cs[i].y; \
              const float x1 = bf2f(kr1[i]), x2 = bf2f(kr2[i]); const float y1 = x1 * c - x2 * s, y2 = x1 * s + x2 * c; \
              KRF[(size_t)row * 32 + j] = y1; KRF[(size_t)row * 32 + 16 + j] = y2; \
              float* of = (row < RP) ? F.out + OUT_KRP + (size_t)row * 32 : F.out + OUT_KRS + (size_t)(row - RP) * 32; of[j] = y1; of[16 + j] = y2; } \
            if (F.lane < 8) DT[(size_t)row * 8 + F.lane] = softplus_f(dtr[i] + dbias); } } while (0)
#define P2A_ROT() do { _Pragma("unroll") for (int i = 0; i < 4; ++i) { wk[i] = wkn[i]; wq[i][0] = wqn[i][0]; wq[i][1] = wqn[i][1]; wq[i][2] = wqn[i][2]; kr1[i] = kr1n[i]; kr2[i] = kr2n[i]; dtr[i] = dtrn[i]; cs[i] = csn[i]; } } while (0)
        if (F.NGW == 2048) {
            const int ra = 4 * F.gw, rb2 = 8192 + 4 * F.gw, rc = 16384 + F.gw;
            P2A_LOAD(wk, wq, kr1, kr2, dtr, cs, ra, 4);
            P2A_LOAD(wkn, wqn, kr1n, kr2n, dtrn, csn, rb2, 4);
            P2A_PROC(ra, 4); P2A_ROT();
            if (F.gw < 256) P2A_LOAD(wkn, wqn, kr1n, kr2n, dtrn, csn, rc, 1);
            P2A_PROC(rb2, 4);
            if (F.gw < 256) { P2A_ROT(); P2A_PROC(rc, 1); }
        } else {
            for (int r0 = 4 * F.gw; r0 < R; r0 += 4 * F.NGW) { P2A_LOAD(wk, wq, kr1, kr2, dtr, cs, r0, 4); P2A_PROC(r0, 4); }
        }
#undef P2A_LOAD
#undef P2A_PROC
#undef P2A_ROT
    }
    const float* cw = (const float*)F.in[10]; const float* cb = (const float*)F.in[11];
    bf16* XST = (bf16*)(F.ws + WS_XST); bf16* BT = (bf16*)(F.ws + WS_BT); bf16* BC = (bf16*)(F.ws + WS_BC);
    LAS bf16* tile = (LAS bf16*)(F.lds + RING_OFF);
    for (int i = blockIdx.x * NTHR + F.tid; i < NB * 640 * 6; i += F.G * NTHR) { const int rowi = i / 6, pc = i % 6; const int bb = rowi / 640, cc = rowi % 640;
        bf16* dst = (cc < SSDW) ? XST + ((size_t)(bb * SSDW + cc)) * TPAD : BT + ((size_t)(bb * 128 + (cc - SSDW))) * TPAD; *(v4u*)(dst + pc * 8) = (v4u){0u, 0u, 0u, 0u}; }
    for (int u = blockIdx.x; u < NB * 32 * 3; u += F.G) {
        const int third = u % 3, tb = 1 + (u / 3) % 32, b = u / 96; const int t0 = tb * CHL - TOFF;
        {
            const int cl = 2 * (F.tid & 127), c = third * 256 + cl, tq = F.tid >> 7;
            const float w0a = cw[0 * CONVD + c], w1a = cw[1 * CONVD + c], w2a = cw[2 * CONVD + c], w3a = cw[3 * CONVD + c], ba = cb[c];
            const float w0b = cw[0 * CONVD + c + 1], w1b = cw[1 * CONVD + c + 1], w2b = cw[2 * CONVD + c + 1], w3b = cw[3 * CONVD + c + 1], bb = cb[c + 1];
            const bf16* base = PROJ + (size_t)b * TT * PJ + C_XBC + c;
#define CV_QUARTER(tfirst, lcol) do { float xa[19], xb[19]; \
                _Pragma("unroll") for (int k = 0; k < 19; ++k) { const int t = (tfirst) - 3 + k; xa[k] = 0.f; xb[k] = 0.f; if (t >= 0) { const unsigned w = *(const unsigned*)(base + (size_t)t * PJ); xa[k] = bflo(w); xb[k] = bfhi(w); } } \
                _Pragma("unroll") for (int k = 0; k < 16; ++k) { const int t = (tfirst) + k; \
                    const float ya = silu_f(ba + xa[k] * w0a + xa[k + 1] * w1a + xa[k + 2] * w2a + xa[k + 3] * w3a), yb = silu_f(bb + xb[k] * w0b + xb[k + 1] * w1b + xb[k + 2] * w2b + xb[k + 3] * w3b); \
                    const unsigned pk = pk2(ya, yb); \
                    tile[cl * CV_LDS_STRIDE + (lcol) + k] = (bf16)(pk & 0xffffu); tile[(cl + 1) * CV_LDS_STRIDE + (lcol) + k] = (bf16)(pk >> 16); \
                    if (third == 2) *(unsigned*)(BC + (size_t)(b * TT + t) * 256 + cl) = pk; } } while (0)
            CV_QUARTER(t0 + 16 * tq, 16 * tq);
            if (tb == 1 && tq == 0) CV_QUARTER(0, 64);
#undef CV_QUARTER
        }
        __syncthreads();
        { const int nrows = (third == 2) ? 128 : 256; const int npc = (tb == 1) ? 10 : 8;
          for (int i = F.tid; i < nrows * npc; i += NTHR) { const int cl = i / npc, pc = i % npc;
            const LAS unsigned* s = (const LAS unsigned*)(tile + cl * CV_LDS_STRIDE + pc * 8); v4u o; o.x = s[0]; o.y = s[1]; o.z = s[2]; o.w = s[3];
            bf16* dst = (third < 2) ? XST + ((size_t)(b * SSDW + third * 256 + cl)) * TPAD : BT + ((size_t)(b * 128 + cl)) * TPAD;
            *(v4u*)(dst + ((pc < 8) ? tb * CHL + pc * 8 : TOFF + (pc - 8) * 8)) = o; } }
        __syncthreads();
    }
    const float* sconv = (const float*)F.in[4]; float* XAS = (float*)(F.ws + WS_XAS);
    for (int i = blockIdx.x * NTHR + F.tid; i < DB * CONVD; i += F.G * NTHR) { const int b = i / CONVD, c = i % CONVD;
        const float xc = bf2f(PROJ[(size_t)(RP + b) * PJ + C_XBC + c]);
        const float s0 = sconv[(size_t)(b * 3 + 0) * CONVD + c], s1 = sconv[(size_t)(b * 3 + 1) * CONVD + c], s2 = sconv[(size_t)(b * 3 + 2) * CONVD + c];
        XAS[i] = silu_f(cb[c] + s0 * cw[c] + s1 * cw[CONVD + c] + s2 * cw[2 * CONVD + c] + xc * cw[3 * CONVD + c]);
        float* oc = F.out + OUT_CONVS + (size_t)b * 3 * CONVD + c; oc[0] = s1; oc[CONVD] = s2; oc[2 * CONVD] = xc; }
    for (int i = blockIdx.x * NTHR + F.tid; i < NB * 3 * CONVD; i += F.G * NTHR) { const int b = i / (3 * CONVD), k = (i / CONVD) % 3, c = i % CONVD;
        F.out[OUT_CONVP + i] = bf2f(PROJ[(size_t)(b * TT + TT - 3 + k) * PJ + C_XBC + c]); }
}
#define MFMA32(a, b, c) __builtin_amdgcn_mfma_f32_32x32x16_bf16((a), (b), (c), 0, 0, 0)
#define MFMA16(a, b, c) __builtin_amdgcn_mfma_f32_16x16x32_bf16((a), (b), (c), 0, 0, 0)
__device__ __forceinline__ int crow(int reg, int hi) { return (reg & 3) + 8 * (reg >> 2) + 4 * hi; }
__device__ __forceinline__ bf16x8 pack8(const f32x16& x, int s) {
    v4u p; p.x = pk2(x[8 * s + 0], x[8 * s + 1]); p.y = pk2(x[8 * s + 2], x[8 * s + 3]); p.z = pk2(x[8 * s + 4], x[8 * s + 5]); p.w = pk2(x[8 * s + 6], x[8 * s + 7]);
    return __builtin_bit_cast(bf16x8, p);
}
__device__ __forceinline__ bf16x8 ld2x8(const bf16* p0, const bf16* p1) {
    const v2u a = *(const v2u*)p0, b = *(const v2u*)p1; v4u r; r.x = a.x; r.y = a.y; r.z = b.x; r.w = b.y; return __builtin_bit_cast(bf16x8, r);
}
__device__ __forceinline__ float softmax_ref(Frame& F) {
    const float* gqn = (const float*)F.in[20]; const float* gqr = (const float*)F.in[21]; const float* gkn = (const float*)F.in[22]; const float* gkr = (const float*)F.in[23];
    float a = fabsf(gqn[F.lane]), b = fabsf(gkn[F.lane]);
    if (F.lane < 16) { a = fmaxf(a, fabsf(gqr[F.lane])); b = fmaxf(b, fabsf(gkr[F.lane])); }
    return LOG2E * 9.797958971132712f * wave_max(a) * wave_max(b) * 1.0001f;
}
constexpr size_t WS_YS = 495 * MiB;
constexpr size_t WS_KS = 498 * MiB;
constexpr int NKT = 65;

__device__ __forceinline__ void p3_upproj_states(Frame& F) {
    const bf16* CQN = (const bf16*)(F.ws + WS_CQN); const bf16* LAT = (const bf16*)(F.ws + WS_LAT); const bf16* WUQ = (const bf16*)(F.ws + WS_WUQ); const bf16* WUKV = (const bf16*)(F.ws + WS_WUKV);
    bf16* QRAW = (bf16*)(F.ws + WS_QRAW); bf16* KVRAW = (bf16*)(F.ws + WS_KVRAW);
    { pg8::Gemm g{CQN, WUQ, MMAIN, 768, QL, 1}; pg8::StaticOrder S; S.init(MMAIN, 768, F.G, (int)blockIdx.x); EpiBf16 E{QRAW, 768, 1};
      pg8::gemm_phase<EpiBf16, pg8::StaticOrder, true, true>(F.lds + RING_OFF, g, S, E); }
    { pg8::Gemm g{LAT, WUKV, MMAIN, 1024, KVL, 1}; pg8::StaticOrder S; S.init(MMAIN, 1024, F.G, (int)blockIdx.x); EpiBf16 E{KVRAW, 1024, 1};
      pg8::gemm_phase<EpiBf16, pg8::StaticOrder, true, true>(F.lds + RING_OFF, g, S, E); }
    const bool sub = (F.G == 256);
    const int sgw = sub ? (blockIdx.x - 192) * NWAVES + F.wave : F.gw, sngw = sub ? 64 * NWAVES : F.NGW;
    if (!sub || blockIdx.x >= 192) {
    small_gemm(CQN, QL, WUQ, QL, DB / 16, 768 / 16, [](int r) { return RP + r; },
        [&](const f32x4& acc, int rt, int ct, int lane) { const int col = ct * 16 + (lane & 15);
#pragma unroll
            for (int i = 0; i < 4; ++i) QRAW[(size_t)(RP + rt * 16 + 4 * (lane >> 4) + i) * 768 + col] = f2bf(acc[i]); }, sgw, sngw, F.lane);
    small_gemm(LAT, KVL, WUKV, KVL, NS / 16, 1024 / 16, [](int r) { return small_arow(r); },
        [&](const f32x4& acc, int rt, int ct, int lane) { const int col = ct * 16 + (lane & 15);
#pragma unroll
            for (int i = 0; i < 4; ++i) { const int r = rt * 16 + 4 * (lane >> 4) + i; const bf16 v = f2bf(acc[i]);
                if (r < NMETA) { for (int b = 0; b < NB; ++b) KVRAW[(size_t)(b * TT + r) * 1024 + col] = v; } else KVRAW[(size_t)(RP + r - NMETA) * 1024 + col] = v; } }, sgw, sngw, F.lane);
    }
    const float* DT = (const float*)(F.ws + WS_DT); const float* a_log = (const float*)F.in[13];
    const bf16* XST = (const bf16*)(F.ws + WS_XST); const bf16* BT = (const bf16*)(F.ws + WS_BT);
    float* STATES = (float*)(F.ws + WS_STATES); float* DECAY = (float*)(F.ws + WS_DECAY);
    LAS float* wl = (LAS float*)(F.lds + RING_OFF + F.wave * 1024);
    const int r32 = F.lane & 31, hi = F.lane >> 5;
    for (int u = F.gw; u < NB * NCH * NH; u += F.NGW) {
        const int h = u % NH, c = (u / NH) % NCH, b = u / (NH * NCH); const int g = h >> 2;
        const int t = c * CHL - TOFF + F.lane;
        const float dt = (t >= 0) ? DT[(size_t)(b * TT + t) * 8 + h] : 0.f;
        const float A = -__expf(a_log[h]);
        float acs = dt * A;
#pragma unroll
        for (int o = 1; o < 64; o <<= 1) { const float v = __shfl_up(acs, o); if (F.lane >= o) acs += v; }
        const float last = __shfl(acs, 63);
        wl[F.lane] = __expf(last - acs) * dt;
        LDS_WAIT(); asm volatile("" ::: "memory");
        f32x16 acc[2][2];
#pragma unroll
        for (int i = 0; i < 2; ++i)
#pragma unroll
            for (int j = 0; j < 2; ++j) acc[i][j] = (f32x16){};
        const bf16* xb = XST + ((size_t)(b * SSDW + h * HP)) * TPAD + c * CHL; const bf16* bb = BT + ((size_t)(b * 128 + g * DS)) * TPAD + c * CHL;
#pragma unroll
        for (int s = 0; s < 4; ++s) {
            const f32x4 w0 = *(const LAS f32x4*)(wl + 16 * s + 8 * hi), w1 = *(const LAS f32x4*)(wl + 16 * s + 8 * hi + 4);
            bf16x8 af[2], bfr[2];
#pragma unroll
            for (int pt = 0; pt < 2; ++pt) { const v4u x = *(const v4u*)(xb + (size_t)(32 * pt + r32) * TPAD + 16 * s + 8 * hi);
                v4u y; y.x = pk2(bflo(x.x) * w0.x, bfhi(x.x) * w0.y); y.y = pk2(bflo(x.y) * w0.z, bfhi(x.y) * w0.w); y.z = pk2(bflo(x.z) * w1.x, bfhi(x.z) * w1.y); y.w = pk2(bflo(x.w) * w1.z, bfhi(x.w) * w1.w);
                af[pt] = __builtin_bit_cast(bf16x8, y); }
#pragma unroll
            for (int nt = 0; nt < 2; ++nt) bfr[nt] = *(const bf16x8*)(bb + (size_t)(32 * nt + r32) * TPAD + 16 * s + 8 * hi);
#pragma unroll
            for (int pt = 0; pt < 2; ++pt)
#pragma unroll
                for (int nt = 0; nt < 2; ++nt) acc[pt][nt] = MFMA32(af[pt], bfr[nt], acc[pt][nt]);
        }
        float* so = STATES + ((size_t)((b * NCH + c) * NH + h)) * 4096;
#pragma unroll
        for (int pt = 0; pt < 2; ++pt)
#pragma unroll
            for (int nt = 0; nt < 2; ++nt)
#pragma unroll
                for (int rg = 0; rg < 16; ++rg) so[(32 * pt + crow(rg, hi)) * 64 + 32 * nt + r32] = acc[pt][nt][rg];
        if (F.lane == 0) DECAY[(b * NCH + c) * NH + h] = __expf(last);
        LDS_WAIT(); asm volatile("" ::: "memory");
    }
}

#ifdef MK_TS
#define P4_STAMP(k) do { if (blockIdx.x == 0 && F.tid == 0) ((unsigned long long*)(F.ws + 600 * MiB))[20 + (k)] = __builtin_amdgcn_s_memrealtime(); } while (0)
#else
#define P4_STAMP(k) do { } while (0)
#endif
__device__ __forceinline__ void p4_post(Frame& F) {
    const bf16* QRAW = (const bf16*)(F.ws + WS_QRAW); const bf16* KVRAW = (const bf16*)(F.ws + WS_KVRAW); const float* KRF = (const float*)(F.ws + WS_KRF);
    bf16* Q = (bf16*)(F.ws + WS_Q); bf16* K = (bf16*)(F.ws + WS_K); bf16* VT = (bf16*)(F.ws + WS_VT); float* VS = (float*)(F.ws + WS_VS);
    const float* gqn = (const float*)F.in[20]; const float* gqr = (const float*)F.in[21]; const float* gkn = (const float*)F.in[22]; const float* gkr = (const float*)F.in[23];
    const float* ROPE = (const float*)(F.ws + WS_ROPE);
    const int h = F.lane >> 3, sub = F.lane & 7;
    bf16* KS = (bf16*)(F.ws + WS_KS);
    for (int row = RP + F.gw; row < R; row += F.NGW) {
        const int t = PAST;
        if (row >= RP) { const bf16* kp = KVRAW + (size_t)row * 1024 + 128 * h + 8 * sub; const v4u kw = *(const v4u*)kp; const v4u vw = *(const v4u*)(kp + 64);
          const f32x4 kr = *(const f32x4*)(KRF + (size_t)row * 32 + 4 * sub);
          float kn[8] = {bflo(kw.x), bfhi(kw.x), bflo(kw.y), bfhi(kw.y), bflo(kw.z), bfhi(kw.z), bflo(kw.w), bfhi(kw.w)};
          float ss = (kr.x * kr.x + kr.y * kr.y) + (kr.z * kr.z + kr.w * kr.w);
#pragma unroll
          for (int e = 0; e < 8; ++e) ss += kn[e] * kn[e];
          ss += __shfl_xor(ss, 1); ss += __shfl_xor(ss, 2); ss += __shfl_xor(ss, 4);
          const float rs = 1.0f / sqrtf(ss * (1.f / 96.f) + EPS);
          const float* gn = gkn + 8 * sub; v4u o; o.x = pk2(kn[0] * rs * gn[0], kn[1] * rs * gn[1]); o.y = pk2(kn[2] * rs * gn[2], kn[3] * rs * gn[3]); o.z = pk2(kn[4] * rs * gn[4], kn[5] * rs * gn[5]); o.w = pk2(kn[6] * rs * gn[6], kn[7] * rs * gn[7]);
          bf16* ko = KS + (size_t)(row - RP) * 768 + 96 * h; *(v4u*)(ko + 8 * sub) = o;
          const float* gr = gkr + ((4 * sub) & 15); v2u o2; o2.x = pk2(kr.x * rs * gr[0], kr.y * rs * gr[1]); o2.y = pk2(kr.z * rs * gr[2], kr.w * rs * gr[3]);
          *(v2u*)(ko + 64 + 4 * sub) = o2;
          const unsigned vv[4] = {vw.x, vw.y, vw.z, vw.w}; float* vs = VS + (size_t)(row - RP) * 512 + 64 * h + 8 * sub;
#pragma unroll
          for (int e = 0; e < 4; ++e) { vs[2 * e] = bflo(vv[e]); vs[2 * e + 1] = bfhi(vv[e]); } }
        if (row >= RP || t >= NMETA) {
            const bf16* qp = QRAW + (size_t)row * 768 + 96 * h; const v4u qw = *(const v4u*)(qp + 8 * sub);
            const unsigned r1 = *(const unsigned*)(qp + 64 + 2 * sub), r2 = *(const unsigned*)(qp + 80 + 2 * sub);
            float qn[8] = {bflo(qw.x), bfhi(qw.x), bflo(qw.y), bfhi(qw.y), bflo(qw.z), bfhi(qw.z), bflo(qw.w), bfhi(qw.w)};
            const f32x4 cs = *(const f32x4*)(ROPE + 2 * ((row < RP ? t : TT) * 16 + 2 * sub)); const float c0 = cs.x, s0 = cs.y, c1 = cs.z, s1 = cs.w;
            const float x10 = bflo(r1), x11 = bfhi(r1), x20 = bflo(r2), x21 = bfhi(r2);
            const float y10 = x10 * c0 - x20 * s0, y20 = x10 * s0 + x20 * c0, y11 = x11 * c1 - x21 * s1, y21 = x11 * s1 + x21 * c1;
            float ss = (y10 * y10 + y20 * y20) + (y11 * y11 + y21 * y21);
#pragma unroll
            for (int e = 0; e < 8; ++e) ss += qn[e] * qn[e];
            ss += __shfl_xor(ss, 1); ss += __shfl_xor(ss, 2); ss += __shfl_xor(ss, 4);
            const float rs = (ATTN_SCALE * LOG2E) / sqrtf(ss * (1.f / 96.f) + EPS);
            const float* gn = gqn + 8 * sub; v4u o; o.x = pk2(qn[0] * rs * gn[0], qn[1] * rs * gn[1]); o.y = pk2(qn[2] * rs * gn[2], qn[3] * rs * gn[3]); o.z = pk2(qn[4] * rs * gn[4], qn[5] * rs * gn[5]); o.w = pk2(qn[6] * rs * gn[6], qn[7] * rs * gn[7]);
            bf16* qo = Q + (size_t)row * 768 + 96 * h; *(v4u*)(qo + 8 * sub) = o;
            const float g0 = gqr[2 * sub], g1 = gqr[2 * sub + 1];
            *(unsigned*)(qo + 64 + 2 * sub) = pk2(y10 * rs * g0, y11 * rs * g1); *(unsigned*)(qo + 80 + 2 * sub) = pk2(y20 * rs * g0, y21 * rs * g1);
        }
    }
    { bf16* KF = (bf16*)(F.ws + WS_K); bf16* VF = (bf16*)(F.ws + WS_VT);
      LAS unsigned char* vtile = F.lds + RING_OFF + F.wave * 4608;
      const int r8 = F.lane >> 3;
      for (int u = F.gw; u < NB * NKT * NH; u += F.NGW) {
          const int hh = u % NH, kt = (u / NH) % NKT, bb = u / (NH * NKT);
          bf16* kfb = KF + ((size_t)((bb * NH + hh) * NKT + kt)) * (6 * 512); bf16* vfb = VF + ((size_t)((bb * NH + hh) * NKT + kt)) * (4 * 512);
          v4u kwa[4], vwa[4]; f32x4 kra[4];
#pragma unroll
          for (int i = 0; i < 4; ++i) { const int tk = kt * 32 + 8 * i + r8; const int tkc = tk < TT ? tk : TT - 1;
              const bf16* kp = KVRAW + (size_t)(bb * TT + tkc) * 1024 + 128 * hh + 8 * sub; kwa[i] = *(const v4u*)kp; vwa[i] = *(const v4u*)(kp + 64); kra[i] = *(const f32x4*)(KRF + (size_t)(bb * TT + tkc) * 32 + 4 * sub); }
#pragma unroll
          for (int i = 0; i < 4; ++i) {
              const int key = 8 * i + r8, tk = kt * 32 + key; v4u kw = kwa[i], vw = vwa[i]; f32x4 kr = kra[i];
              if (tk >= TT) { kw = (v4u){0u, 0u, 0u, 0u}; vw = kw; kr = (f32x4){0.f, 0.f, 0.f, 0.f}; }
              float kn[8] = {bflo(kw.x), bfhi(kw.x), bflo(kw.y), bfhi(kw.y), bflo(kw.z), bfhi(kw.z), bflo(kw.w), bfhi(kw.w)};
              float ss = (kr.x * kr.x + kr.y * kr.y) + (kr.z * kr.z + kr.w * kr.w);
#pragma unroll
              for (int e = 0; e < 8; ++e) ss += kn[e] * kn[e];
              ss += __shfl_xor(ss, 1); ss += __shfl_xor(ss, 2); ss += __shfl_xor(ss, 4);
              const float rs = 1.0f / sqrtf(ss * (1.f / 96.f) + EPS);
              const float* gn = gkn + 8 * sub; v4u o; o.x = pk2(kn[0] * rs * gn[0], kn[1] * rs * gn[1]); o.y = pk2(kn[2] * rs * gn[2], kn[3] * rs * gn[3]); o.z = pk2(kn[4] * rs * gn[4], kn[5] * rs * gn[5]); o.w = pk2(kn[6] * rs * gn[6], kn[7] * rs * gn[7]);
              *(v4u*)(kfb + (sub >> 1) * 512 + ((sub & 1) * 32 + key) * 8) = o;
              const float* gr = gkr + ((4 * sub) & 15); v2u o2; o2.x = pk2(kr.x * rs * gr[0], kr.y * rs * gr[1]); o2.y = pk2(kr.z * rs * gr[2], kr.w * rs * gr[3]);
              *(v2u*)(kfb + (4 + (sub >> 2)) * 512 + (((sub >> 1) & 1) * 32 + key) * 8 + 4 * (sub & 1)) = o2;
              *(LAS v4u*)(vtile + key * 144 + sub * 16) = vw; }
          LDS_WAIT(); asm volatile("" ::: "memory");
          const int g = F.lane >> 4, q4 = (F.lane & 15) >> 2, pp = F.lane & 3;
          const unsigned a_lo = (unsigned)(uintptr_t)vtile + (unsigned)((4 * (g >> 1) + q4) * 144 + (16 * (g & 1) + 4 * pp) * 2);
#define VF_TR(dt, s2) do { s16x4 lo, hi4; \
              asm volatile("ds_read_b64_tr_b16 %0, %2 offset:%c3\n\tds_read_b64_tr_b16 %1, %2 offset:%c4\n\ts_waitcnt lgkmcnt(0)" : "=&v"(lo), "=&v"(hi4) : "v"(a_lo), "i"(16 * (s2) * 144 + 64 * (dt)), "i"(16 * (s2) * 144 + 64 * (dt) + 8 * 144) : "memory"); \
              v4u o; o.x = (unsigned)(unsigned short)lo[0] | ((unsigned)(unsigned short)lo[1] << 16); o.y = (unsigned)(unsigned short)lo[2] | ((unsigned)(unsigned short)lo[3] << 16); \
              o.z = (unsigned)(unsigned short)hi4[0] | ((unsigned)(unsigned short)hi4[1] << 16); o.w = (unsigned)(unsigned short)hi4[2] | ((unsigned)(unsigned short)hi4[3] << 16); \
              *(v4u*)(vfb + ((dt) * 2 + (s2)) * 512 + F.lane * 8) = o; } while (0)
          VF_TR(0, 0); VF_TR(0, 1); VF_TR(1, 0); VF_TR(1, 1);
#undef VF_TR
          LDS_WAIT(); asm volatile("" ::: "memory");
      } }
    P4_STAMP(0);
    const float* STATES = (const float*)(F.ws + WS_STATES); const float* DECAY = (const float*)(F.ws + WS_DECAY); bf16* HIN = (bf16*)(F.ws + WS_HIN);
    for (int e2 = blockIdx.x * NTHR + F.tid; e2 < NB * NH * 2048; e2 += F.G * NTHR) {
        const int e = 2 * e2; const int b = e / (NH * 4096), hh = (e / 4096) % NH, pn = e % 4096;
        float h0 = 0.f, h1 = 0.f;
#pragma unroll 1
        for (int c0 = 0; c0 < NCH; c0 += 11) {
            f32x2_t st[11]; float dc[11];
#pragma unroll
            for (int j = 0; j < 11; ++j) { const int c = c0 + j; st[j] = *(const f32x2_t*)(STATES + ((size_t)((b * NCH + c) * NH + hh)) * 4096 + pn); dc[j] = DECAY[(b * NCH + c) * NH + hh]; }
#pragma unroll
            for (int j = 0; j < 11; ++j) { const int c = c0 + j; *(unsigned*)(HIN + ((size_t)((b * NCH + c) * NH + hh)) * 4096 + pn) = pk2(h0, h1); h0 = h0 * dc[j] + st[j].x; h1 = h1 * dc[j] + st[j].y; }
        }
        *(f32x2_t*)(F.out + OUT_SSMP + e) = (f32x2_t){h0, h1};
    }
    P4_STAMP(1);
    const float* XAS = (const float*)(F.ws + WS_XAS); const float* DT = (const float*)(F.ws + WS_DT); const float* sst = (const float*)F.in[5];
    const float* a_log = (const float*)F.in[13]; const float* d_skip = (const float*)F.in[14]; float* YS = (float*)(F.ws + WS_YS);
    for (int u = F.gw; u < DB * NH * 16; u += F.NGW) {
        const int pq = u & 15, hh = (u >> 4) & 7, b = u >> 7; const int g = hh >> 2; const int p = 4 * pq + (F.lane >> 4), n4 = F.lane & 15;
        const float dt = DT[(size_t)(RP + b) * 8 + hh]; const float a = __expf(dt * -__expf(a_log[hh]));
        const float x = XAS[(size_t)b * CONVD + hh * HP + p]; const float uu = dt * x;
        const f32x4 Bv = *(const f32x4*)(XAS + (size_t)b * CONVD + SSDW + g * DS + 4 * n4), Cv = *(const f32x4*)(XAS + (size_t)b * CONVD + SSDW + 128 + g * DS + 4 * n4);
        const size_t si = (((size_t)b * NH + hh) * HP + p) * DS + 4 * n4;
        const f32x4 s0 = *(const f32x4*)(sst + si); const f32x4 s1 = s0 * a + uu * Bv;
        *(f32x4*)(F.out + OUT_SSMS + si) = s1;
        float y = (Cv.x * s1.x + Cv.y * s1.y) + (Cv.z * s1.z + Cv.w * s1.w);
        y += __shfl_xor(y, 1); y += __shfl_xor(y, 2); y += __shfl_xor(y, 4); y += __shfl_xor(y, 8);
        if (n4 == 0) YS[(size_t)b * 512 + hh * HP + p] = y + d_skip[hh] * x;
    }
}
constexpr int DA_ROWB = 528;
constexpr int DA_LAT = 0, DA_KR = 128 * DA_ROWB, DA_PB = DA_KR + 128 * 33 * 4, DA_QG = DA_PB + 2 * 16 * 32 * 2, DA_END = DA_QG + 8 * 96 * 4;
constexpr int P5_EXCH = 100 * 1024;
static_assert(DA_END <= P5_EXCH, "LDS map of P5");

constexpr int AT_SLOT = 20480, AT_D = 4;
constexpr size_t WS_ATT = 499 * MiB;
__device__ __forceinline__ void at_issue(Frame& F, const bf16* kt_k, const bf16* kt_v, LAS unsigned char* slot) {
    const int w = F.wave;
    __builtin_amdgcn_global_load_lds((const unsigned*)((const char*)kt_k + w * 1024 + F.lane * 16), (LAS unsigned*)(slot + w * 1024), 16, 0, 0);
    const char* srcB = (w < 4) ? (const char*)kt_k + 8192 + w * 1024 : (const char*)kt_v + (w - 4) * 1024;
    __builtin_amdgcn_global_load_lds((const unsigned*)(srcB + F.lane * 16), (LAS unsigned*)(slot + 8192 + w * 1024), 16, 0, 0);
    __builtin_amdgcn_global_load_lds((const unsigned*)((const char*)kt_v + 4096 + w * 256 + F.lane * 4), (LAS unsigned*)(slot + 16384 + w * 256), 4, 0, 0);
    __builtin_amdgcn_global_load_lds((const unsigned*)((const char*)kt_v + 6144 + w * 256 + F.lane * 4), (LAS unsigned*)(slot + 18432 + w * 256), 4, 0, 0);
}
__device__ __forceinline__ void p5_attn_prompt(Frame& F, float M0) {
    const bf16* QRAW = (const bf16*)(F.ws + WS_QRAW); const bf16* KF = (const bf16*)(F.ws + WS_K); const bf16* VF = (const bf16*)(F.ws + WS_VT); bf16* ATT = (bf16*)(F.ws + WS_ATT);
    const float* ROPE = (const float*)(F.ws + WS_ROPE); const float* gqn = (const float*)F.in[20]; const float* gqr = (const float*)F.in[21];
    LAS unsigned char* ring = F.lds + RING_OFF;
    const int w = F.wave, r32 = F.lane & 31, hi = F.lane >> 5;
    f32x16 negm;
#pragma unroll
    for (int i = 0; i < 16; ++i) negm[i] = -M0;
    for (int u = blockIdx.x; u < 256; u += F.G) {
        const int b = u >> 5, h = (u >> 2) & 7, pr = u & 3;
        const bf16* kfb = KF + ((size_t)((b * NH + h) * NKT)) * (6 * 512); const bf16* vfb = VF + ((size_t)((b * NH + h) * NKT)) * (4 * 512);
#pragma unroll 1
        for (int half = 0; half < 2; ++half) {
            const int qb = half ? 7 - pr : pr; const int a = 8 * qb + w; const int qi = NMETA + 32 * a + r32;
            const int nkt = 8 * qb + 9, nkw = a + 2;
            bf16x8 qf[6];
            { const bf16* qp = QRAW + (size_t)(b * TT + qi) * 768 + 96 * h + 8 * hi;
              v4u qw[6];
#pragma unroll
              for (int s = 0; s < 6; ++s) qw[s] = *(const v4u*)(qp + 16 * s);
              f32x4 cs[4];
#pragma unroll
              for (int i = 0; i < 4; ++i) cs[i] = *(const f32x4*)(ROPE + 2 * (qi * 16 + 8 * hi) + 4 * i);
              float qv[6][8]; float ss = 0.f;
#pragma unroll
              for (int s = 0; s < 6; ++s) { const unsigned ww[4] = {qw[s].x, qw[s].y, qw[s].z, qw[s].w};
#pragma unroll
                  for (int e = 0; e < 4; ++e) { qv[s][2 * e] = bflo(ww[e]); qv[s][2 * e + 1] = bfhi(ww[e]); ss += qv[s][2 * e] * qv[s][2 * e] + qv[s][2 * e + 1] * qv[s][2 * e + 1]; } }
              ss += __shfl_xor(ss, 32);
              const float rs = (ATTN_SCALE * LOG2E) / sqrtf(ss * (1.f / 96.f) + EPS);
#pragma unroll
              for (int jj = 0; jj < 8; ++jj) { const float c = cs[jj >> 1][2 * (jj & 1)], sn = cs[jj >> 1][2 * (jj & 1) + 1]; const float x1 = qv[4][jj], x2 = qv[5][jj];
                  const float gr = gqr[8 * hi + jj] * rs; qv[4][jj] = (x1 * c - x2 * sn) * gr; qv[5][jj] = (x1 * sn + x2 * c) * gr; }
#pragma unroll
              for (int s = 0; s < 4; ++s) { const f32x4 g0 = *(const f32x4*)(gqn + 16 * s + 8 * hi), g1 = *(const f32x4*)(gqn + 16 * s + 8 * hi + 4);
                  qv[s][0] *= g0.x * rs; qv[s][1] *= g0.y * rs; qv[s][2] *= g0.z * rs; qv[s][3] *= g0.w * rs; qv[s][4] *= g1.x * rs; qv[s][5] *= g1.y * rs; qv[s][6] *= g1.z * rs; qv[s][7] *= g1.w * rs; }
#pragma unroll
              for (int s = 0; s < 6; ++s) { v4u o; o.x = pk2(qv[s][0], qv[s][1]); o.y = pk2(qv[s][2], qv[s][3]); o.z = pk2(qv[s][4], qv[s][5]); o.w = pk2(qv[s][6], qv[s][7]); qf[s] = __builtin_bit_cast(bf16x8, o); } }
            f32x16 o0 = (f32x16){}, o1 = (f32x16){}; float l = 0.f;
            const int ns = (nkt + 1) >> 1;
#pragma unroll
            for (int j = 0; j < AT_D - 1; ++j) at_issue(F, kfb + (size_t)j * 6144, vfb + (size_t)j * 4096, ring + j * AT_SLOT);
#pragma unroll 1
            for (int st = 0; st < ns; ++st) {
                const int rem = ns - 1 - st;
                if (rem >= 2) asm volatile("s_waitcnt vmcnt(8)" ::: "memory"); else if (rem == 1) asm volatile("s_waitcnt vmcnt(4)" ::: "memory"); else asm volatile("s_waitcnt vmcnt(0)" ::: "memory");
                __builtin_amdgcn_s_barrier(); asm volatile("" ::: "memory");
                if (st + AT_D - 1 < ns) at_issue(F, kfb + (size_t)(st + AT_D - 1) * 6144, vfb + (size_t)(st + AT_D - 1) * 4096, ring + ((st + AT_D - 1) & (AT_D - 1)) * AT_SLOT);
#pragma unroll
                for (int tt = 0; tt < 2; ++tt) { const int kt = 2 * st + tt;
                  if (kt < nkw) {
                    const LAS unsigned char* sl = ring + (st & (AT_D - 1)) * AT_SLOT + F.lane * 16; const int j0 = 32 * kt;
                    f32x16 S = negm;
#pragma unroll
                    for (int s = 0; s < 6; ++s) S = MFMA32(*(const LAS bf16x8*)(sl + tt * 6144 + 1024 * s), qf[s], S);
                    bf16x8 vf[4];
#pragma unroll
                    for (int i = 0; i < 4; ++i) vf[i] = *(const LAS bf16x8*)(sl + 12288 + tt * 4096 + 1024 * i);
#pragma unroll
                    for (int i = 0; i < 16; ++i) S[i] = __builtin_amdgcn_exp2f(S[i]);
                    if (kt >= a) {
#pragma unroll
                        for (int i = 0; i < 16; ++i) if (j0 + crow(i, hi) > qi) S[i] = 0.f; }
#pragma unroll
                    for (int i = 0; i < 16; ++i) l += S[i];
                    const bf16x8 p0 = pack8(S, 0), p1 = pack8(S, 1);
                    o0 = MFMA32(vf[0], p0, o0); o0 = MFMA32(vf[1], p1, o0);
                    o1 = MFMA32(vf[2], p0, o1); o1 = MFMA32(vf[3], p1, o1);
                  } }
            }
            l += __shfl_xor(l, 32);
            const float il = 1.0f / l;
            bf16* ao = ATT + (size_t)(b * TT + qi) * 512 + 64 * h + 4 * hi;
#pragma unroll
            for (int gq = 0; gq < 4; ++gq) {
                v2u w0, w1; w0.x = pk2(o0[4 * gq] * il, o0[4 * gq + 1] * il); w0.y = pk2(o0[4 * gq + 2] * il, o0[4 * gq + 3] * il);
                w1.x = pk2(o1[4 * gq] * il, o1[4 * gq + 1] * il); w1.y = pk2(o1[4 * gq + 2] * il, o1[4 * gq + 3] * il);
                *(v2u*)(ao + 8 * gq) = w0; *(v2u*)(ao + 32 + 8 * gq) = w1; }
            asm volatile("s_waitcnt lgkmcnt(0)" ::: "memory"); __builtin_amdgcn_s_barrier(); asm volatile("" ::: "memory");
        }
    }
}

constexpr int SO_X = 0, SO_H = 36864, SO_B = 73728, SO_C = 82944, SO_Z = 92160, SO_TAB = 125952, SO_EX = 130048;
static_assert(SO_EX + 1024 <= RING_BYTES, "ssd_out LDS map");
__device__ __forceinline__ void p5_ssd_out(Frame& F) {
    const float* DT = (const float*)(F.ws + WS_DT); const float* a_log = (const float*)F.in[13]; const float* d_skip = (const float*)F.in[14]; const float* ng = (const float*)F.in[15];
    const bf16* XST = (const bf16*)(F.ws + WS_XST); const bf16* BC = (const bf16*)(F.ws + WS_BC); const bf16* HIN = (const bf16*)(F.ws + WS_HIN); const bf16* PROJ = (const bf16*)(F.ws + WS_PROJ);
    bf16* MIX = (bf16*)(F.ws + WS_MIX);
    LAS unsigned char* L = F.lds + RING_OFF;
    LAS float* tab = (LAS float*)(L + SO_TAB) + F.wave * 128;
    LAS float* exch = (LAS float*)(L + SO_EX);
    const int hl = F.wave >> 1, it = F.wave & 1, r32 = F.lane & 31, hi = F.lane >> 5;
    for (int u = blockIdx.x; u < NB * (NCH - 1); u += F.G) {
        const int b = u / (NCH - 1), c = 1 + u % (NCH - 1); const int t0 = c * CHL - TOFF;
        v4u st[14];
#define SO_FETCH_A(g) do { \
        _Pragma("unroll") for (int k = 0; k < 4; ++k) { const int q = F.tid + NTHR * k; st[k] = *(const v4u*)(XST + ((size_t)(b * SSDW + (g) * 256 + (q >> 3))) * TPAD + c * CHL + 8 * (q & 7)); } } while (0)
#define SO_FETCH_B(g) do { \
        _Pragma("unroll") for (int k = 0; k < 4; ++k) { const int q = F.tid + NTHR * k; st[4 + k] = *(const v4u*)(HIN + ((size_t)((b * NCH + c) * NH + 4 * (g))) * 4096 + (size_t)q * 8); } \
        { const int q = F.tid; st[8] = *(const v4u*)(BC + (size_t)(b * TT + t0 + (q >> 3)) * 256 + (g) * DS + 8 * (q & 7)); st[9] = *(const v4u*)(BC + (size_t)(b * TT + t0 + (q >> 3)) * 256 + 128 + (g) * DS + 8 * (q & 7)); } \
        _Pragma("unroll") for (int k = 0; k < 4; ++k) { const int q = F.tid + NTHR * k; st[10 + k] = *(const v4u*)(PROJ + (size_t)(b * TT + t0 + (q >> 5)) * PJ + C_Z + (g) * 256 + 8 * (q & 31)); } } while (0)
#define SO_STORE() do { \
        _Pragma("unroll") for (int k = 0; k < 4; ++k) { const int q = F.tid + NTHR * k; *(LAS v4u*)(L + SO_X + (q >> 3) * 144 + 16 * (q & 7)) = st[k]; *(LAS v4u*)(L + SO_H + (q >> 3) * 144 + 16 * (q & 7)) = st[4 + k]; } \
        { const int q = F.tid; *(LAS v4u*)(L + SO_B + (q >> 3) * 144 + 16 * (q & 7)) = st[8]; *(LAS v4u*)(L + SO_C + (q >> 3) * 144 + 16 * (q & 7)) = st[9]; } \
        _Pragma("unroll") for (int k = 0; k < 4; ++k) { const int q = F.tid + NTHR * k; *(LAS v4u*)(L + SO_Z + (q >> 5) * 528 + 16 * (q & 31)) = st[10 + k]; } } while (0)
        SO_FETCH_A(0); SO_FETCH_B(0);
#pragma unroll 1
        for (int g = 0; g < 2; ++g) {
            const int h = 4 * g + hl; const float A = -__expf(a_log[h]), Dh = d_skip[h];
            { const int t = t0 + F.lane; const float dt = DT[(size_t)(b * TT + t) * 8 + h];
              float acs = dt * A;
#pragma unroll
              for (int o = 1; o < 64; o <<= 1) { const float v = __shfl_up(acs, o); if (F.lane >= o) acs += v; }
              tab[F.lane] = acs; tab[64 + F.lane] = dt; }
            SO_STORE();
            __syncthreads();
            if (g == 0) SO_FETCH_A(1);
            const int ii = 32 * it + r32; const int t = t0 + ii;
            bf16x8 cf[4];
#pragma unroll
            for (int s = 0; s < 4; ++s) cf[s] = *(const LAS bf16x8*)(L + SO_C + ii * 144 + 32 * s + 16 * hi);
            f32x16 y[2];
            const float ai = tab[ii]; const float ei = __expf(ai);
#pragma unroll
            for (int pt = 0; pt < 2; ++pt) { f32x16 acc = (f32x16){}; const LAS unsigned char* hp_ = L + SO_H + (hl * 64 + 32 * pt + r32) * 144 + 16 * hi;
#pragma unroll
                for (int s = 0; s < 4; ++s) acc = MFMA32(*(const LAS bf16x8*)(hp_ + 32 * s), cf[s], acc);
#pragma unroll
                for (int i = 0; i < 16; ++i) acc[i] *= ei;
                y[pt] = acc; }
#pragma unroll 1
            for (int jt = 0; jt <= it; ++jt) {
                f32x16 S = (f32x16){};
                { const LAS unsigned char* bp_ = L + SO_B + (32 * jt + r32) * 144 + 16 * hi;
#pragma unroll
                  for (int s = 0; s < 4; ++s) S = MFMA32(*(const LAS bf16x8*)(bp_ + 32 * s), cf[s], S); }
#pragma unroll
                for (int i = 0; i < 16; ++i) { const int jj = 32 * jt + crow(i, hi); const float e = (jj <= ii) ? __expf(ai - tab[jj]) * tab[64 + jj] : 0.f; S[i] = S[i] * e + ((jj == ii) ? Dh : 0.f); }
                const bf16x8 p0 = pack8(S, 0), p1 = pack8(S, 1);
#pragma unroll
                for (int pt = 0; pt < 2; ++pt) { const LAS unsigned char* xp_ = L + SO_X + (hl * 64 + 32 * pt + r32) * 144 + (32 * jt + 4 * hi) * 2;
                    const v2u x0 = *(const LAS v2u*)(xp_), x1 = *(const LAS v2u*)(xp_ + 16), x2 = *(const LAS v2u*)(xp_ + 32), x3 = *(const LAS v2u*)(xp_ + 48);
                    v4u f0, f1; f0.x = x0.x; f0.y = x0.y; f0.z = x1.x; f0.w = x1.y; f1.x = x2.x; f1.y = x2.y; f1.z = x3.x; f1.w = x3.y;
                    y[pt] = MFMA32(__builtin_bit_cast(bf16x8, f0), p0, y[pt]); y[pt] = MFMA32(__builtin_bit_cast(bf16x8, f1), p1, y[pt]); }
            }
            float ss = 0.f;
            { const LAS unsigned char* zp_ = L + SO_Z + ii * 528 + (hl * 64 + 4 * hi) * 2;
#pragma unroll
              for (int pt = 0; pt < 2; ++pt)
#pragma unroll
                for (int gq = 0; gq < 4; ++gq) { const v2u zw = *(const LAS v2u*)(zp_ + (32 * pt + 8 * gq) * 2); const float zz[4] = {bflo(zw.x), bfhi(zw.x), bflo(zw.y), bfhi(zw.y)};
#pragma unroll
                    for (int e = 0; e < 4; ++e) { const float v = y[pt][4 * gq + e] * silu_f(zz[e]); y[pt][4 * gq + e] = v; ss += v * v; } } }
            ss += __shfl_xor(ss, 32);
            if (g == 0) SO_FETCH_B(1);
            LAS float* ex = exch + it * 128;
            if (hi == 0) ex[hl * 32 + r32] = ss;
            __syncthreads();
            const float tot = (ex[r32] + ex[32 + r32]) + (ex[64 + r32] + ex[96 + r32]);
            const float rs = 1.0f / sqrtf(tot * (1.f / 256.f) + EPS);
            { bf16* mo = MIX + (size_t)(b * TT + t) * 1024 + 64 * h + 4 * hi;
#pragma unroll
              for (int pt = 0; pt < 2; ++pt)
#pragma unroll
                for (int gq = 0; gq < 4; ++gq) { const f32x4 gg = *(const f32x4*)(ng + 64 * h + 32 * pt + 8 * gq + 4 * hi);
                    v2u w; w.x = pk2(y[pt][4 * gq] * rs * gg.x, y[pt][4 * gq + 1] * rs * gg.y); w.y = pk2(y[pt][4 * gq + 2] * rs * gg.z, y[pt][4 * gq + 3] * rs * gg.w);
                    *(v2u*)(mo + 32 * pt + 8 * gq) = w; } }
        }
#undef SO_FETCH_A
#undef SO_FETCH_B
#undef SO_STORE
        __syncthreads();
    }
    const float* YS = (const float*)(F.ws + WS_YS);
    for (int u = F.gw; u < DB * NG; u += F.NGW) { const int b = u >> 1, gg = u & 1; const int cc = gg * 256 + 4 * F.lane;
        const f32x4 yv = *(const f32x4*)(YS + (size_t)b * 512 + cc); const v2u zw = *(const v2u*)(PROJ + (size_t)(RP + b) * PJ + C_Z + cc);
        const f32x4 v = {yv.x * silu_f(bflo(zw.x)), yv.y * silu_f(bfhi(zw.x)), yv.z * silu_f(bflo(zw.y)), yv.w * silu_f(bfhi(zw.y))};
        const float rs = 1.0f / sqrtf(wave_sum((v.x * v.x + v.y * v.y) + (v.z * v.z + v.w * v.w)) * (1.f / 256.f) + EPS);
        const f32x4 gv = *(const f32x4*)(ng + cc); v2u w; w.x = pk2(v.x * rs * gv.x, v.y * rs * gv.y); w.y = pk2(v.z * rs * gv.z, v.w * rs * gv.w);
        *(v2u*)(MIX + (size_t)(RP + b) * 1024 + cc) = w; }
}

constexpr int DB_STAGE = 0, DB_KRST = 65536, DB_LAT = DB_KRST + 8192, DB_KR = DB_LAT + 64 * DA_ROWB, DB_PB = DB_KR + 64 * 36 * 4, DB_QG = DB_PB + 16 * 64 * 2, DB_END = DB_QG + 8 * 96 * 4;
static_assert(DB_END <= RING_BYTES, "decode attention LDS map");
#define RAW_BAR_L() do { asm volatile("s_waitcnt lgkmcnt(0)" ::: "memory"); __builtin_amdgcn_s_barrier(); asm volatile("" ::: "memory"); } while (0)
#define RAW_BAR_VL() do { asm volatile("s_waitcnt vmcnt(0) lgkmcnt(0)" ::: "memory"); __builtin_amdgcn_s_barrier(); asm volatile("" ::: "memory"); } while (0)
__device__ __forceinline__ void da_issue(Frame& F, LAS unsigned char* L, const float* clat, const float* ckr, const int* ptab, int b, int split, int hp) {
    const size_t tok0 = (size_t)ptab[b * NPAGES + split * 32 + (hp >> 1)] * PAGE + (hp & 1) * 64;
    const char* src = (const char*)(clat + tok0 * KVL) + (size_t)(F.wave * 8) * 1024 + F.lane * 16;
#pragma unroll
    for (int i = 0; i < 8; ++i) __builtin_amdgcn_global_load_lds((const unsigned*)(src + i * 1024), (LAS unsigned*)(L + DB_STAGE + (F.wave * 8 + i) * 1024), 16, 0, 0);
    __builtin_amdgcn_global_load_lds((const unsigned*)((const char*)(ckr + tok0 * 32) + F.wave * 1024 + F.lane * 16), (LAS unsigned*)(L + DB_KRST + F.wave * 1024), 16, 0, 0);
}
__device__ __forceinline__ void da_convert(Frame& F, LAS unsigned char* L) {
#pragma unroll 4
    for (int k = 0; k < 8; ++k) { const int f = F.tid + NTHR * k; const int row = f >> 6, c4 = f & 63; const f32x4 v = *(const LAS f32x4*)(L + DB_STAGE + f * 16);
        v2u w; w.x = pk2(v.x, v.y); w.y = pk2(v.z, v.w); *(LAS v2u*)(L + DB_LAT + row * DA_ROWB + c4 * 8) = w; }
    { const int f = F.tid; const int row = f >> 3, c4 = f & 7; const f32x4 v = *(const LAS f32x4*)(L + DB_KRST + f * 16);
      *(LAS f32x4*)((LAS float*)(L + DB_KR) + row * 36 + 4 * c4) = v; }
}
template <int MODE>
__device__ __forceinline__ void p5_attn_decode_t(Frame& F, float M0) {
    const float* clat = (const float*)F.in[2]; const float* ckr = (const float*)F.in[3]; const int* ptab = (const int*)F.in[6];
    const bf16* WUKV = (const bf16*)(F.ws + WS_WUKV); const bf16* Q = (const bf16*)(F.ws + WS_Q); const float* gkn = (const float*)F.in[22]; const float* gkr = (const float*)F.in[23];
    float* DPART = (float*)(F.ws + WS_DPART);
    LAS unsigned char* L = F.lds + RING_OFF;
    LAS float* krl = (LAS float*)(L + DB_KR); LAS bf16* pb = (LAS bf16*)(L + DB_PB); LAS float* qg = (LAS float*)(L + DB_QG) + F.wave * 96;
    const int h = F.wave, r32 = F.lane & 31, hi = F.lane >> 5;
    for (int u = blockIdx.x; u < DB * 2; u += F.G) {
        const int b = u >> 1, split = u & 1;
        da_issue(F, L, clat, ckr, ptab, b, split, 0);
        bf16x8 wf[4][8];
#pragma unroll
        for (int dt = 0; dt < 4; ++dt)
#pragma unroll
            for (int s = 0; s < 8; ++s) wf[dt][s] = *(const bf16x8*)(WUKV + (size_t)(128 * h + 16 * dt + (F.lane & 15)) * KVL + 32 * s + 8 * (F.lane >> 4));
        { const bf16* qp = Q + (size_t)(RP + b) * 768 + 96 * h; qg[F.lane] = bf2f(qp[F.lane]) * gkn[F.lane]; if (F.lane < 32) qg[64 + F.lane] = bf2f(qp[64 + F.lane]) * gkr[F.lane & 15]; }
        for (int i = F.tid; i < 16 * 64; i += NTHR) pb[i] = 0;
        f32x4 ao[2] = {(f32x4){0.f, 0.f, 0.f, 0.f}, (f32x4){0.f, 0.f, 0.f, 0.f}}; float l = 0.f;
        RAW_BAR_VL();
        da_convert(F, L);
        RAW_BAR_L();
        da_issue(F, L, clat, ckr, ptab, b, split, 1);
#pragma unroll 1
        for (int hp = 0; hp < 64; ++hp) {
          if (MODE == 0 || MODE == 3) {
            const int n16 = F.lane & 15, kg4 = F.lane >> 4;
#pragma unroll 1
            for (int sb = 0; sb < 2; ++sb) {
                const LAS unsigned char* bp = L + DB_LAT + (32 * sb + n16) * DA_ROWB + 16 * kg4;
                f32x4 acc[4][2];
#pragma unroll
                for (int dt = 0; dt < 4; ++dt) { acc[dt][0] = (f32x4){0.f, 0.f, 0.f, 0.f}; acc[dt][1] = acc[dt][0]; }
                bf16x8 fa[2], fb[2];
                fa[0] = *(const LAS bf16x8*)(bp); fa[1] = *(const LAS bf16x8*)(bp + 16 * DA_ROWB);
#pragma unroll
                for (int s = 0; s < 8; ++s) {
                    if (s < 7) { fb[0] = *(const LAS bf16x8*)(bp + 64 * (s + 1)); fb[1] = *(const LAS bf16x8*)(bp + 16 * DA_ROWB + 64 * (s + 1)); }
#pragma unroll
                    for (int dt = 0; dt < 4; ++dt) { acc[dt][0] = MFMA16(wf[dt][s], fa[0], acc[dt][0]); acc[dt][1] = MFMA16(wf[dt][s], fa[1], acc[dt][1]); }
                    fa[0] = fb[0]; fa[1] = fb[1];
                }
                __builtin_amdgcn_sched_barrier(0);
                f32x4 s4[2] = {(f32x4){0.f, 0.f, 0.f, 0.f}, (f32x4){0.f, 0.f, 0.f, 0.f}}, d4[2] = {s4[0], s4[0]};
#pragma unroll
                for (int dt = 0; dt < 4; ++dt) { const f32x4 qq = *(const LAS f32x4*)(qg + 16 * dt + 4 * kg4);
#pragma unroll
                    for (int tt = 0; tt < 2; ++tt) { s4[tt] += acc[dt][tt] * acc[dt][tt]; d4[tt] += acc[dt][tt] * qq; } }
                { const LAS float* qr = qg + 64 + 8 * kg4; const f32x4 q0 = *(const LAS f32x4*)(qr), q1 = *(const LAS f32x4*)(qr + 4);
#pragma unroll
                  for (int tt = 0; tt < 2; ++tt) { const LAS float* kr = krl + (32 * sb + 16 * tt + n16) * 36 + 8 * kg4; const f32x4 k0 = *(const LAS f32x4*)(kr), k1 = *(const LAS f32x4*)(kr + 4);
                      s4[tt] += k0 * k0; s4[tt] += k1 * k1; d4[tt] += k0 * q0; d4[tt] += k1 * q1; } }
                __builtin_amdgcn_sched_barrier(0);
#pragma unroll
                for (int tt = 0; tt < 2; ++tt) { float ss = (s4[tt].x + s4[tt].y) + (s4[tt].z + s4[tt].w), dot = (d4[tt].x + d4[tt].y) + (d4[tt].z + d4[tt].w);
                    ss += __shfl_xor(ss, 16); dot += __shfl_xor(dot, 16); ss += __shfl_xor(ss, 32); dot += __shfl_xor(dot, 32);
                    const float p = __builtin_amdgcn_exp2f(dot * __builtin_amdgcn_rsqf(ss * (1.f / 96.f) + EPS) - M0);
                    if (kg4 == 0) { l += p; pb[h * 64 + 32 * sb + 16 * tt + n16] = f2bf(p); } }
            }
            RAW_BAR_L();
            if (MODE < 4) { const int q4 = (F.lane & 15) >> 2, pp = F.lane & 3, kg = F.lane >> 4;
              const unsigned a_lo = (unsigned)(uintptr_t)(L + DB_LAT) + (unsigned)((8 * kg + q4) * DA_ROWB + (32 * h + 4 * pp) * 2);
              const LAS bf16* pap = pb + (F.lane & 15) * 64 + 8 * kg;
              s16x4 t0, t1, t2, t3, t4, t5, t6, t7;
              asm volatile("ds_read_b64_tr_b16 %0, %8 offset:%c9\n\tds_read_b64_tr_b16 %1, %8 offset:%c10\n\tds_read_b64_tr_b16 %2, %8 offset:%c11\n\tds_read_b64_tr_b16 %3, %8 offset:%c12\n\t"
                           "ds_read_b64_tr_b16 %4, %8 offset:%c13\n\tds_read_b64_tr_b16 %5, %8 offset:%c14\n\tds_read_b64_tr_b16 %6, %8 offset:%c15\n\tds_read_b64_tr_b16 %7, %8 offset:%c16\n\ts_waitcnt lgkmcnt(0)"
                           : "=&v"(t0), "=&v"(t1), "=&v"(t2), "=&v"(t3), "=&v"(t4), "=&v"(t5), "=&v"(t6), "=&v"(t7)
                           : "v"(a_lo), "i"(0), "i"(4 * DA_ROWB), "i"(32), "i"(32 + 4 * DA_ROWB), "i"(32 * DA_ROWB), "i"(32 * DA_ROWB + 4 * DA_ROWB), "i"(32 * DA_ROWB + 32), "i"(32 * DA_ROWB + 32 + 4 * DA_ROWB) : "memory");
              const bf16x8 pa0 = *(const LAS bf16x8*)(pap), pa1 = *(const LAS bf16x8*)(pap + 32);
#define DA_FR(x, y) ((bf16x8){x[0], x[1], x[2], x[3], y[0], y[1], y[2], y[3]})
              ao[0] = MFMA16(pa0, DA_FR(t0, t1), ao[0]); ao[1] = MFMA16(pa0, DA_FR(t2, t3), ao[1]);
              ao[0] = MFMA16(pa1, DA_FR(t4, t5), ao[0]); ao[1] = MFMA16(pa1, DA_FR(t6, t7), ao[1]);
#undef DA_FR
#define DA_PV(ks, nt) do { } while (0)
#undef DA_PV
            }
          }
            RAW_BAR_VL();
            if (hp + 1 < 64) { if (MODE <= 1 || MODE >= 3) da_convert(F, L); RAW_BAR_L(); if (hp + 2 < 64 && MODE < 3) da_issue(F, L, clat, ckr, ptab, b, split, hp + 2); }
        }
        if (MODE >= 3 && l == 123.456f) DPART[0] = l;
        if (MODE == 0) { const int kg = F.lane >> 4;
          if (kg < 2) {
#pragma unroll
              for (int nt = 0; nt < 2; ++nt)
#pragma unroll
                  for (int i = 0; i < 4; ++i) DPART[((size_t)((b * 2 + split) * NH + 4 * kg + i)) * 264 + 32 * h + 16 * nt + (F.lane & 15)] = ao[nt][i]; }
          float lt = wave_sum(l);
          if (F.lane == 0) DPART[((size_t)((b * 2 + split) * NH + h)) * 264 + 256] = lt; }
        RAW_BAR_L();
    }
}

__device__ __forceinline__ void p5_attn_decode(Frame& F, float M0) { p5_attn_decode_t<0>(F, M0); }

__device__ __forceinline__ void p6_decode_combine(Frame& F, float M0) {
    {
      const bf16* ATT = (const bf16*)(F.ws + WS_ATT); bf16* MIXo = (bf16*)(F.ws + WS_MIX); const float* mgg = (const float*)F.in[24];
      const f32x4 g0 = ((const f32x4*)mgg)[2 * F.lane], g1 = ((const f32x4*)mgg)[2 * F.lane + 1];
      for (int r0 = 4 * F.gw; r0 < MMAIN; r0 += 4 * F.NGW) { v4u xx[4];
#pragma unroll
          for (int i = 0; i < 4; ++i) { const int r = r0 + i; const size_t row = (size_t)(r >> 11) * TT + NMETA + (r & 2047); xx[i] = *(const v4u*)(ATT + row * 512 + 8 * F.lane); }
#pragma unroll
          for (int i = 0; i < 4; ++i) { const int r = r0 + i; const size_t row = (size_t)(r >> 11) * TT + NMETA + (r & 2047); const v4u x = xx[i];
          const float v[8] = {bflo(x.x), bfhi(x.x), bflo(x.y), bfhi(x.y), bflo(x.z), bfhi(x.z), bflo(x.w), bfhi(x.w)};
          float ss = 0.f;
#pragma unroll
          for (int e = 0; e < 8; ++e) ss += v[e] * v[e];
          const float rs = 1.0f / sqrtf(wave_sum(ss) * (1.f / MLAW) + EPS);
          v4u o; o.x = pk2(v[0] * rs * g0.x, v[1] * rs * g0.y); o.y = pk2(v[2] * rs * g0.z, v[3] * rs * g0.w); o.z = pk2(v[4] * rs * g1.x, v[5] * rs * g1.y); o.w = pk2(v[6] * rs * g1.z, v[7] * rs * g1.w);
          *(v4u*)(MIXo + row * 1024 + 512 + 8 * F.lane) = o; } } }
    const float* DPART = (const float*)(F.ws + WS_DPART); const bf16* WUKV = (const bf16*)(F.ws + WS_WUKV); const bf16* Q = (const bf16*)(F.ws + WS_Q); const bf16* KS = (const bf16*)(F.ws + WS_KS);
    const float* VS = (const float*)(F.ws + WS_VS); const float* mg = (const float*)F.in[24]; bf16* MIX = (bf16*)(F.ws + WS_MIX);
    LAS float* accl = (LAS float*)(F.lds + RING_OFF) + F.wave * 256; LAS float* exch = (LAS float*)(F.lds + P5_EXCH);
    const int h = F.wave;
    for (int b = blockIdx.x; b < DB; b += F.G) {
        const float* p0 = DPART + ((size_t)((b * 2 + 0) * NH + h)) * 264; const float* p1 = DPART + ((size_t)((b * 2 + 1) * NH + h)) * 264;
#pragma unroll
        for (int k = 0; k < 4; ++k) accl[F.lane + 64 * k] = p0[F.lane + 64 * k] + p1[F.lane + 64 * k];
        float l = p0[256] + p1[256];
        const bf16* qp = Q + (size_t)(RP + b) * 768 + 96 * h; const bf16* kp = KS + (size_t)b * 768 + 96 * h;
        float sd = bf2f(qp[F.lane]) * bf2f(kp[F.lane]); if (F.lane < 32) sd += bf2f(qp[64 + F.lane]) * bf2f(kp[64 + F.lane]);
        sd = wave_sum(sd);
        const float pn = __builtin_amdgcn_exp2f(sd - M0); l += pn;
        LDS_WAIT(); asm volatile("" ::: "memory");
        const bf16* wv = WUKV + (size_t)(128 * h + 64 + F.lane) * KVL;
        float o = 0.f;
        { v4u wv4[32];
#pragma unroll
          for (int c8 = 0; c8 < 32; ++c8) wv4[c8] = *(const v4u*)(wv + 8 * c8);
#pragma unroll
          for (int c8 = 0; c8 < 32; ++c8) { const v4u w = wv4[c8]; const f32x4 x0 = *(const LAS f32x4*)(accl + 8 * c8), x1 = *(const LAS f32x4*)(accl + 8 * c8 + 4);
            o += (bflo(w.x) * x0.x + bfhi(w.x) * x0.y) + (bflo(w.y) * x0.z + bfhi(w.y) * x0.w) + (bflo(w.z) * x1.x + bfhi(w.z) * x1.y) + (bflo(w.w) * x1.z + bfhi(w.w) * x1.w); } }
        o = (o + pn * VS[(size_t)b * 512 + 64 * h + F.lane]) / l;
        const float ss = wave_sum(o * o);
        if (F.lane == 0) exch[h] = ss;
        __syncthreads();
        float tot = 0.f;
#pragma unroll
        for (int hh = 0; hh < NH; ++hh) tot += exch[hh];
        const float rs = 1.0f / sqrtf(tot * (1.f / MLAW) + EPS);
        MIX[(size_t)(RP + b) * 1024 + 512 + 64 * h + F.lane] = f2bf(o * rs * mg[64 * h + F.lane]);
        __syncthreads();
    }
}

__device__ __forceinline__ void p7_outproj(Frame& F) {
    const bf16* MIX = (const bf16*)(F.ws + WS_MIX); const bf16* WOUT = (const bf16*)(F.ws + WS_WOUT); const float* xp = (const float*)F.in[0]; const float* xs = (const float*)F.in[1]; float* HS = (float*)(F.ws + WS_HS);
    bf16* HB = (bf16*)(F.ws + WS_XN); float* SS = (float*)(F.ws + WS_SSP); float* ysamp = F.out + OUT_YS;
    { pg8::Gemm g{MIX, WOUT, MMAIN, DM, 1024, 1}; pg8::StaticOrder S; S.init(MMAIN, DM, F.G, (int)blockIdx.x); EpiOutProj E{xp, F.out + OUT_YP, HB, SS};
      pg8::gemm_phase<EpiOutProj, pg8::StaticOrder, true, true>(F.lds + RING_OFF, g, S, E); }
    { LAS f32x4* part = (LAS f32x4*)(F.lds + RING_OFF);
      for (int tp = blockIdx.x; tp < 256; tp += F.G) {
          const int t = 2 * tp + (F.wave >> 2), kq = F.wave & 3, rt = t & 7, ct = t >> 3;
          const bf16* ap = MIX + (size_t)(RP + rt * 16 + (F.lane & 15)) * 1024 + 256 * kq + 8 * (F.lane >> 4);
          const bf16* bp = WOUT + (size_t)(ct * 16 + (F.lane & 15)) * 1024 + 256 * kq + 8 * (F.lane >> 4);
          bf16x8 av[8], bv[8];
#pragma unroll
          for (int j = 0; j < 8; ++j) { av[j] = *(const bf16x8*)(ap + 32 * j); bv[j] = *(const bf16x8*)(bp + 32 * j); }
          f32x4 acc = {0.f, 0.f, 0.f, 0.f};
#pragma unroll
          for (int j = 0; j < 8; ++j) acc = MFMA16(av[j], bv[j], acc);
          part[F.wave * 64 + F.lane] = acc;
          __syncthreads();
          if (kq == 0) { acc = (acc + part[(F.wave + 1) * 64 + F.lane]) + (part[(F.wave + 2) * 64 + F.lane] + part[(F.wave + 3) * 64 + F.lane]);
              const int col = ct * 16 + (F.lane & 15);
#pragma unroll
              for (int i = 0; i < 4; ++i) { const int r = rt * 16 + 4 * (F.lane >> 4) + i; const size_t o = (size_t)r * DM + col; const float v = xs[o] + acc[i]; HS[o] = v; ysamp[o] = v; HB[(size_t)(RP + r) * DM + col] = f2bf(v);
                  float ss = v * v; ss += __shfl_xor(ss, 1); ss += __shfl_xor(ss, 2); ss += __shfl_xor(ss, 4); ss += __shfl_xor(ss, 8);
                  if ((F.lane & 15) == 0) SS[(size_t)MMAIN * 16 + (size_t)r * 64 + ct] = ss; } }
          __syncthreads();
      } }
}
__device__ __forceinline__ void p9_gateup(Frame& F) {
    const bf16* HB = (const bf16*)(F.ws + WS_XN); const bf16* WGU = (const bf16*)(F.ws + WS_WGU); bf16* ACT = (bf16*)(F.ws + WS_ACT); const float* SS = (const float*)(F.ws + WS_SSP);
    { pg8::Gemm g{HB, WGU, MMAIN, 2 * DFF, DM, 1}; pg8::StaticOrder S; S.init(MMAIN, 2 * DFF, F.G, (int)blockIdx.x);
      LAS float* RS = (LAS float*)(F.lds + LDSCTL_OFF + 1024);
#pragma unroll 1
      for (int i = 0; i < 8; ++i) { pg8::Unit uu; if (!S.next(i, uu)) break;
          int tl = (int)threadIdx.x; asm volatile("" : "+v"(tl));
          if (tl < 256) { const pg8::f32x4* sp = (const pg8::f32x4*)(SS + (size_t)(uu.pm * 256 + tl) * 16); const pg8::f32x4 s4 = (sp[0] + sp[1]) + (sp[2] + sp[3]);
              RS[i * 256 + tl] = 1.0f / sqrtf(((s4[0] + s4[1]) + (s4[2] + s4[3])) * (1.f / DM) + EPS); } }
      __syncthreads();
      EpiSwiGLU E{ACT, RS, S};
      pg8::gemm_phase<EpiSwiGLU, pg8::StaticOrder, true, true>(F.lds + RING_OFF, g, S, E); }
    const int gw = F.gw, ngw = F.NGW;
    const int nrt = DB / 16, nlt = DFF / 16;
    for (int task = gw; task < nrt * nlt; task += ngw) {
        const int rt = task % nrt, lt = task / nrt; const int lc = lt * 16 + (F.lane & 15);
        const bf16* ap = HB + (size_t)(RP + rt * 16 + (F.lane & 15)) * DM + 8 * (F.lane >> 4);
        const bf16* gp = WGU + (size_t)(256 * (lc >> 7) + (lc & 127)) * DM + 8 * (F.lane >> 4); const bf16* up = gp + (size_t)128 * DM;
        f32x4 ag = {0.f, 0.f, 0.f, 0.f}, au = {0.f, 0.f, 0.f, 0.f};
#pragma unroll 8
        for (int k0 = 0; k0 < DM; k0 += 32) { const bf16x8 a = *(const bf16x8*)(ap + k0); ag = MFMA16(a, *(const bf16x8*)(gp + k0), ag); au = MFMA16(a, *(const bf16x8*)(up + k0), au); }
#pragma unroll
        for (int i = 0; i < 4; ++i) { const int r = rt * 16 + 4 * (F.lane >> 4) + i; const f32x4* sp = (const f32x4*)(SS + (size_t)MMAIN * 16 + (size_t)r * 64); f32x4 s4 = sp[0];
#pragma unroll
            for (int q = 1; q < 16; ++q) s4 += sp[q];
            const float rs = 1.0f / sqrtf(((s4[0] + s4[1]) + (s4[2] + s4[3])) * (1.f / DM) + EPS);
            ACT[(size_t)(RP + r) * DFF + lc] = f2bf(silu_f(rs * ag[i]) * (rs * au[i])); }
    }
}
__device__ __forceinline__ void p10_down(Frame& F) {
    const bf16* ACT = (const bf16*)(F.ws + WS_ACT); const bf16* WDN = (const bf16*)(F.ws + WS_WDN); const float* HS = (const float*)(F.ws + WS_HS);
    { pg8::Gemm g{ACT, WDN, MMAIN, DM, DFF, 1}; pg8::StaticOrder S; S.init(MMAIN, DM, F.G, (int)blockIdx.x); EpiDown E{(const bf16*)(F.ws + WS_XN), F.out + OUT_YP};
      pg8::gemm_phase<EpiDown, pg8::StaticOrder, true, true>(F.lds + RING_OFF, g, S, E); }
    float* ys = F.out + OUT_YS;
    small_gemm(ACT, DFF, WDN, DFF, DB / 16, DM / 16, [](int r) { return RP + r; },
        [&](const f32x4& acc, int rt, int ct, int lane) { const int col = ct * 16 + (lane & 15);
#pragma unroll
            for (int i = 0; i < 4; ++i) atomicAdd(ys + (size_t)(rt * 16 + 4 * (lane >> 4) + i) * DM + col, acc[i]); }, F.gw, F.NGW, F.lane, 4);
}
#ifndef MK_ONE_LAUNCH
#define MK_ONE_LAUNCH 0
#endif
constexpr int N_PHASES = 10;
__global__ void __launch_bounds__(NTHR, 2) mk_fwd(Args args) {
    extern __shared__ __attribute__((aligned(16))) unsigned char lds_raw[];
    Frame F;
    F.lds = (LAS unsigned char*)lds_raw;
    F.tid = threadIdx.x; F.lane = F.tid & 63; F.wave = __builtin_amdgcn_readfirstlane(F.tid >> 6);
    F.G = gridDim.x; { const int bx = blockIdx.x; F.vcu = (F.G % 8 == 0) ? (bx % 8) * (F.G / 8) + bx / 8 : bx; }
    F.gw = blockIdx.x * NWAVES + F.wave; F.NGW = F.G * NWAVES;
    F.ws = args.ws; F.out = args.out; F.in = args.in;
    volatile LAS unsigned* MISC = (volatile LAS unsigned*)(F.lds + MISC_OFF);
    for (int u = F.tid; u < (LDS_BYTES - LDSCTL_OFF) / 4; u += NTHR) ((LAS unsigned*)(F.lds + LDSCTL_OFF))[u] = 0u;
    __syncthreads();
    XcdBarrier bar; bar.bar = (unsigned*)(F.ws + WS_CTL) + CW_BAR; bar.x = 0; bar.st = nullptr;
    const int lo = args.ph_lo, hi = args.ph_hi;
    if (hi - lo > 1) bar = xcd_barrier_post((unsigned*)(F.ws + WS_CTL) + CW_BAR, MISC + 8);
#ifdef MK_TS
    unsigned long long* TSB = (unsigned long long*)(F.ws + 600 * MiB); int tsn = 0;
#define STAMP() do { if (blockIdx.x == 0 && F.tid == 0) TSB[tsn] = __builtin_amdgcn_s_memrealtime(); ++tsn; } while (0)
    STAMP();
#else
#define STAMP() do { } while (0)
#endif
#define IN(k) (lo <= (k) && (k) < hi)
#ifdef MK_TS
#define ARRIVE(k) do { if (blockIdx.x == 0 && F.tid == 0) TSB[30 + (k)] = __builtin_amdgcn_s_memrealtime(); } while (0)
#else
#define ARRIVE(k) do { } while (0)
#endif
#define SEAM(k) do { ARRIVE(k); if (IN(k) && IN((k) + 1)) xcd_barrier(bar); STAMP(); } while (0)
#ifndef MK_REPEAT
#define MK_REPEAT 0
#endif
#define REP(id, stmt) do { stmt; if (MK_REPEAT & (1 << (id))) { __syncthreads(); stmt; } } while (0)
    if (IN(0)) { REP(0, p0_prologue(F)); } SEAM(0);
    if (IN(1)) { REP(1, p1_inproj(F)); } SEAM(1);
    if (IN(2)) {
#ifdef MK_SLEEP_PROBE
        { const unsigned long long t0 = __builtin_amdgcn_s_memrealtime(); while (__builtin_amdgcn_s_memrealtime() - t0 < 3000ull) __builtin_amdgcn_s_sleep(32); }
#endif
        REP(2, p2_elementwise(F)); } SEAM(2);
    if (IN(3)) { REP(3, p3_upproj_states(F)); } SEAM(3);
    if (IN(4)) { REP(4, p4_post(F)); } SEAM(4);
    if (IN(5)) { const float M0 = softmax_ref(F);
        if (blockIdx.x & 1) { p5_attn_decode(F, M0); __syncthreads(); }
        p5_attn_prompt(F, M0); __syncthreads();
        p5_ssd_out(F); __syncthreads();
        if (!(blockIdx.x & 1)) p5_attn_decode(F, M0);
    } SEAM(5);
    if (IN(6)) { const float M0 = softmax_ref(F); REP(8, p6_decode_combine(F, M0)); } SEAM(6);
    if (IN(7)) { REP(9, p7_outproj(F)); } SEAM(7);
    if (IN(8)) { REP(11, p9_gateup(F)); } SEAM(8);
    if (IN(9)) { p10_down(F); }
#ifdef MK_TS
    __syncthreads(); STAMP();
#endif
#undef IN
#undef SEAM
}
#ifndef MK_DIAG
#define MK_DIAG 0
#endif
__device__ __forceinline__ size_t nmrow(size_t r) { return r < (size_t)MMAIN ? (r >> 11) * TT + NMETA + (r & 2047) : (size_t)RP + (r - MMAIN); }
constexpr size_t WS_OUT2 = 1024 * MiB;
#ifdef MK_TS
__global__ void k_ts_encode(const unsigned long long* ts, float* out, int ia0, int ia1, int ib0, int ib1) {
    const float ta = (float)(ts[ia1] - ts[ia0]) * 0.01f, tb = (float)(ts[ib1] - ts[ib0]) * 0.01f;
    const float f = 1.f + sqrtf(ta * 1e-3f);
    for (int i = blockIdx.x * blockDim.x + threadIdx.x; i < 131072; i += gridDim.x * blockDim.x) out[OUT_YS + i] *= f;
    if (blockIdx.x == 0 && threadIdx.x == 0) out[0] += tb * 0.1f;
}
#endif
extern "C" void kernel_launch(void* const* d_in, const int* in_sizes, int n_in, void* d_out, int out_size, void* d_ws, size_t ws_size, hipStream_t stream) {
    (void)hipFuncSetAttribute((const void*)mk_fwd, hipFuncAttributeMaxDynamicSharedMemorySize, LDS_BYTES);
    unsigned char* ws = (unsigned char*)d_ws;
    (void)hipMemsetAsync(ws + WS_CTL, 0, CTL_ZERO_BYTES, stream);
    Args a{};
    for (int i = 0; i < 30; ++i) a.in[i] = d_in[i];
    a.ws = ws; a.out = (float*)d_out;
#if MK_DIAG
    float* diag = (float*)(ws + WS_DIAG);
    (void)hipMemsetAsync(diag, 0, 512, stream);
    nv::forward(d_in, (float*)d_out, (float*)(ws + WS_NAIVE), stream);
    a.out = (float*)(ws + WS_OUT2);
#endif
    static int one_launch = -1;
    if (one_launch < 0) { int dev = 0, cus = 0, per_cu = 0; one_launch = 0;
        if (hipGetDevice(&dev) == hipSuccess && hipDeviceGetAttribute(&cus, hipDeviceAttributeMultiprocessorCount, dev) == hipSuccess && cus >= 256) one_launch = 1;
        (void)per_cu;
        (void)hipGetLastError(); }
    const int grid = 256;
    if (one_launch && MK_ONE_LAUNCH) { a.ph_lo = 0; a.ph_hi = N_PHASES; a.li = 0; hipLaunchKernelGGL(mk_fwd, dim3(grid), dim3(NTHR), LDS_BYTES, stream, a); }
    else for (int ph = 0; ph < N_PHASES; ++ph) { a.ph_lo = ph; a.ph_hi = ph + 1; a.li = ph; hipLaunchKernelGGL(mk_fwd, dim3(grid), dim3(NTHR), LDS_BYTES, stream, a); }
#ifdef MK_TS
    k_ts_encode<<<64, 256, 0, stream>>>((const unsigned long long*)(ws + 600 * MiB), (float*)d_out, MK_TS_A0, MK_TS_A1, MK_TS_B0, MK_TS_B1);
#endif
#if MK_DIAG
    {
        nv::Ws w = nv::carve((float*)(ws + WS_NAIVE));
        const bf16* QRAW = (const bf16*)(ws + WS_QRAW); const bf16* KVRAW = (const bf16*)(ws + WS_KVRAW); const bf16* Q = (const bf16*)(ws + WS_Q); const bf16* K = (const bf16*)(ws + WS_K);
        const bf16* VT = (const bf16*)(ws + WS_VT); const float* VS = (const float*)(ws + WS_VS); const bf16* MIX = (const bf16*)(ws + WS_MIX);
        const float* o2 = (const float*)(ws + WS_OUT2); const float* o1 = (const float*)d_out;
        const float* nQRAW = w.QRAW; const float* nKV = w.KV; const float* nQ = w.Q; const float* nK = w.K; const float* nV = w.V; const float* nMIX = w.MIX;
        const size_t NMR = (size_t)MMAIN + DB;
        cmp(stream, 0, diag, NMR * 768, [=] __device__(size_t i) { return bf2f(QRAW[nmrow(i / 768) * 768 + i % 768]); }, [=] __device__(size_t i) { return nQRAW[nmrow(i / 768) * 768 + i % 768]; });
        cmp(stream, 1, diag, (size_t)R * 1024, [=] __device__(size_t i) { return bf2f(KVRAW[i]); }, [=] __device__(size_t i) { return nKV[i]; });
        cmp(stream, 2, diag, NMR * 768, [=] __device__(size_t i) { return bf2f(Q[nmrow(i / 768) * 768 + i % 768]); }, [=] __device__(size_t i) { return nQ[nmrow(i / 768) * 768 + i % 768] * (ATTN_SCALE * LOG2E); });
        cmp(stream, 3, diag, (size_t)R * 768, [=] __device__(size_t i) { return bf2f(K[i]); }, [=] __device__(size_t i) { return nK[i]; });
        cmp(stream, 4, diag, (size_t)NB * 512 * TT, [=] __device__(size_t i) { const size_t bhd = i / TT; const int t = (int)(i % TT); return bf2f(VT[bhd * TPAD + t]); },
            [=] __device__(size_t i) { const size_t bhd = i / TT; const int t = (int)(i % TT); const size_t b = bhd / 512, hd = bhd % 512; return nV[(b * TT + t) * 512 + hd]; });
        cmp(stream, 4, diag, (size_t)DB * 512, [=] __device__(size_t i) { return VS[i]; }, [=] __device__(size_t i) { return nV[(size_t)RP * 512 + i]; });
        cmp(stream, 5, diag, (size_t)(OUT_LATS - OUT_SSMP), [=] __device__(size_t i) { return o2[OUT_SSMP + i]; }, [=] __device__(size_t i) { return o1[OUT_SSMP + i]; });
        cmp(stream, 5, diag, (size_t)4194304, [=] __device__(size_t i) { return o2[OUT_SSMS + i]; }, [=] __device__(size_t i) { return o1[OUT_SSMS + i]; });
        cmp(stream, 6, diag, (size_t)R * 512, [=] __device__(size_t i) { return bf2f(MIX[(i >> 9) * 1024 + (i & 511)]); }, [=] __device__(size_t i) { return nMIX[(i >> 9) * 1024 + (i & 511)]; });
        cmp(stream, 7, diag, NMR * 512, [=] __device__(size_t i) { return bf2f(MIX[nmrow(i >> 9) * 1024 + 512 + (i & 511)]); }, [=] __device__(size_t i) { return nMIX[nmrow(i >> 9) * 1024 + 512 + (i & 511)]; });
        cmp(stream, 8, diag, (size_t)OUT_LATP, [=] __device__(size_t i) { return o2[i]; }, [=] __device__(size_t i) { return o1[i]; });
        k_diag_encode<<<64, 256, 0, stream>>>(diag, 9, 1e-3f, (float*)d_out);
    }
#endif
}
```

```cpp
#define MK_DIAG 0
#define MK_ONE_LAUNCH 1
#include <hip/hip_runtime.h>
#include <cstdio>
#include <cstdint>
namespace pg8 {
#define PG8_LAS __attribute__((address_space(3)))
typedef unsigned short bf16_t;
typedef short bf16x8 __attribute__((ext_vector_type(8)));
typedef float f32x4 __attribute__((ext_vector_type(4)));
typedef unsigned u32x4 __attribute__((ext_vector_type(4)));
constexpr int BM = 256, BK = 64, HALF = 128, HTB = HALF * BK * 2  , STAGE_BYTES = 8 * HTB, NXCD = 8, WGM = 8;

__host__ __device__ __forceinline__ int lds_byte(int r, int c) { const int st = (r >> 4) * 2 + (c >> 5), rr = r & 15, cc = c & 31, ob = rr * 64 + cc * 2; return st * 1024 + (ob ^ (((ob >> 9) & 1) << 5)); }
__host__ __device__ __forceinline__ void stage_rc(int b, int& R, int& C) { const int st = b / 1024, sb = b % 1024, swz = sb ^ (((sb >> 9) & 1) << 5); R = (st >> 1) * 16 + swz / 64; C = (st & 1) * 32 + (swz % 64) / 2; }
__host__ __device__ __forceinline__ int perm32(int rho) { const int n = rho >> 4, i = rho & 15; return 8 * (i >> 2) + 4 * n + (i & 3); }

struct Unit { int pm, pn; };
struct Gemm { const bf16_t* A; const bf16_t* Bt; int M, N, K; int rmode; int lda;
    __host__ __device__ __forceinline__ int rowbase(int pm) const { return rmode ? (pm >> 3) * 2064 + 16 + (pm & 7) * 256 : pm * 256; } };

struct StaticOrder {
    int nM, nN, nwg, G, c;
    __host__ __device__ void init(int M, int N, int G_, int c_) { nM = M / BM; nN = N / BM; nwg = nM * nN; G = G_; c = c_; }
    __host__ __device__ bool next(int i, Unit& u) const {
        const long L = (long)i * G + c; if (L >= nwg) return false;
        int wgid = (int)L; { const int q = nwg / NXCD, r = nwg % NXCD, xcd = wgid % NXCD, off = wgid / NXCD; wgid = (xcd < r ? xcd * (q + 1) : r * (q + 1) + (xcd - r) * q) + off; }
        const int nig = WGM * nN, gid = wgid / nig, fm = gid * WGM, gsz = (nM - fm) < WGM ? (nM - fm) : WGM;
        u.pm = fm + ((wgid % nig) % gsz); u.pn = (wgid % nig) / gsz; return true;
    }
    __device__ __forceinline__ void a_ready(const Unit&) const {}
    __device__ __forceinline__ void done(const Unit&) const {}
};


template <class Epi, class Sched, bool ALIGN_EPI = false, bool SP2 = false>
__device__ __forceinline__ void gemm_phase(PG8_LAS unsigned char* lds, const Gemm g, const Sched& S, const Epi& E) {
    const int tid = threadIdx.x, wid = __builtin_amdgcn_readfirstlane(tid >> 6), lane = tid & 63, wr = wid >> 2, wc = wid & 3, fr = lane & 15, fq = lane >> 4;
    const int K = g.K, nt = K / BK;
    unsigned voffA[2], voffB[2];
#pragma unroll
    for (int i = 0; i < 2; ++i) { int R, C; stage_rc(tid * 16 + i * 8192, R, C); const int Rb = Epi::PERM ? ((R & ~31) + perm32(R & 31)) : R;
        voffA[i] = (unsigned)(R * g.lda + C) * 2u; voffB[i] = (unsigned)(Rb * K + C) * 2u; }
    const size_t kstep = (size_t)(BK * 2);
    const size_t hstepA = (size_t)HALF * g.lda * 2;
    const size_t hstep = (size_t)HALF * K * 2;
    const size_t tstep = 2 * hstep;
    const unsigned ldsw = (unsigned)wid * 1024u;
    const int aoff = lds_byte(wr * 64 + fr, fq * 8), boff = lds_byte(wc * 32 + fr, fq * 8);
#define PG8_SA(b, h) (((b) * 2 + (h)) * HTB)
#define PG8_SB(b, h) ((4 + (b) * 2 + (h)) * HTB)
#define PG8_STAGE(bufoff, gbase, voff) do { _Pragma("unroll") for (int _i = 0; _i < 2; ++_i) \
        __builtin_amdgcn_global_load_lds((const unsigned*)((const char*)(gbase) + (voff)[_i]), (PG8_LAS unsigned*)(lds + (bufoff) + ldsw + _i * 8192), 16, 0, 0); } while (0)
#define PG8_LDA(dst, b, h) do { _Pragma("unroll") for (int m = 0; m < 4; ++m) _Pragma("unroll") for (int k = 0; k < 2; ++k) dst[m][k] = *(const PG8_LAS bf16x8*)(lds + PG8_SA(b, h) + aoff + m * 2048 + k * 1024); } while (0)
#define PG8_LDB(dst, b, h) do { _Pragma("unroll") for (int n = 0; n < 2; ++n) _Pragma("unroll") for (int k = 0; k < 2; ++k) dst[n][k] = *(const PG8_LAS bf16x8*)(lds + PG8_SB(b, h) + boff + n * 2048 + k * 1024); } while (0)
#define PG8_MMA(ai, bj, At, Bt) do { __builtin_amdgcn_s_setprio(1); _Pragma("unroll") for (int m = 0; m < 4; ++m) _Pragma("unroll") for (int n = 0; n < 2; ++n) _Pragma("unroll") for (int k = 0; k < 2; ++k) \
        acc[ai][bj][m][n] = __builtin_amdgcn_mfma_f32_16x16x32_bf16(Bt[n][k], At[m][k], acc[ai][bj][m][n], 0, 0, 0); __builtin_amdgcn_s_setprio(0); } while (0)
#define PG8_WAIT_V(n) asm volatile("s_waitcnt vmcnt(" #n ")" ::: "memory")
#define PG8_WAIT_L(n) asm volatile("s_waitcnt lgkmcnt(" #n ")" ::: "memory")
#define PG8_BAR __builtin_amdgcn_s_barrier()
#define PG8_SCHED __builtin_amdgcn_sched_barrier(0)
    Unit cur, nxt; int ui = 0;
    if (!S.next(0, cur)) return;
    f32x4 acc[2][2][4][2];
#pragma unroll
    for (int a = 0; a < 2; ++a)
#pragma unroll
        for (int b = 0; b < 2; ++b)
#pragma unroll
            for (int m = 0; m < 4; ++m)
#pragma unroll
                for (int n = 0; n < 2; ++n) acc[a][b][m][n] = (f32x4){0.f, 0.f, 0.f, 0.f};
    bf16x8 At[4][2], B0[2][2], B1[2][2];
    const char* cA = (const char*)g.A + (size_t)g.rowbase(cur.pm) * g.lda * 2; const char* cB = (const char*)g.Bt + (size_t)cur.pn * tstep;
    S.a_ready(cur);
    if constexpr (SP2) {
        PG8_STAGE(PG8_SB(0, 0), cB, voffB); PG8_STAGE(PG8_SB(0, 1), cB + hstep, voffB); PG8_STAGE(PG8_SA(0, 0), cA, voffA); PG8_STAGE(PG8_SA(0, 1), cA + hstepA, voffA);
        if (wr == 1) PG8_BAR;
        PG8_WAIT_V(2); PG8_BAR;
        PG8_STAGE(PG8_SB(1, 0), cB + kstep, voffB); PG8_STAGE(PG8_SA(1, 0), cA + kstep, voffA); PG8_STAGE(PG8_SB(1, 1), cB + hstep + kstep, voffB);
        PG8_WAIT_V(6); PG8_BAR;
    } else {
        PG8_STAGE(PG8_SB(0, 0), cB, voffB); PG8_STAGE(PG8_SA(0, 0), cA, voffA); PG8_STAGE(PG8_SB(0, 1), cB + hstep, voffB); PG8_STAGE(PG8_SA(0, 1), cA + hstepA, voffA);
        if (wr == 1) PG8_BAR;
        PG8_WAIT_V(4); PG8_BAR;
        PG8_STAGE(PG8_SB(1, 0), cB + kstep, voffB); PG8_STAGE(PG8_SA(1, 0), cA + kstep, voffA); PG8_STAGE(PG8_SB(1, 1), cB + hstep + kstep, voffB);
        PG8_WAIT_V(6); PG8_BAR;
    }
    for (;;) {
        const bool has_next = S.next(ui + 1, nxt);
        const char* nA = has_next ? (const char*)g.A + (size_t)g.rowbase(nxt.pm) * g.lda * 2 : cA; const char* nB = has_next ? (const char*)g.Bt + (size_t)nxt.pn * tstep : cB;
        for (int t = 0; t < nt; t += 2) {
            const bool last = (t == nt - 2);
            const char* a1 = cA + (size_t)(t + 1) * kstep;
            const char* a2 = last ? nA : cA + (size_t)(t + 2) * kstep; const char* b2 = last ? nB : cB + (size_t)(t + 2) * kstep;
            const char* a3 = a2 + kstep; const char* b3 = b2 + kstep;
            if (last && has_next) S.a_ready(nxt);
            if constexpr (SP2) {
            PG8_LDB(B0, 0, 0); PG8_LDB(B1, 0, 1); PG8_SCHED; PG8_LDA(At, 0, 0); PG8_STAGE(PG8_SA(1, 1), a1 + hstepA, voffA);
            PG8_WAIT_V(8); PG8_WAIT_L(0); PG8_BAR; PG8_MMA(0, 0, At, B0); PG8_MMA(0, 1, At, B1); PG8_BAR; PG8_SCHED;
            PG8_LDA(At, 0, 1); PG8_STAGE(PG8_SB(0, 0), b2, voffB); PG8_STAGE(PG8_SB(0, 1), b2 + hstep, voffB); PG8_STAGE(PG8_SA(0, 0), a2, voffA);
            PG8_WAIT_V(8); PG8_WAIT_L(0); PG8_BAR; PG8_MMA(1, 0, At, B0); PG8_MMA(1, 1, At, B1); PG8_BAR; PG8_SCHED;
            PG8_LDB(B0, 1, 0); PG8_LDB(B1, 1, 1); PG8_SCHED; PG8_LDA(At, 1, 0); PG8_STAGE(PG8_SA(0, 1), a2 + hstepA, voffA);
            PG8_WAIT_V(8); PG8_WAIT_L(0); PG8_BAR; PG8_MMA(0, 0, At, B0); PG8_MMA(0, 1, At, B1); PG8_BAR; PG8_SCHED;
            PG8_LDA(At, 1, 1); PG8_STAGE(PG8_SB(1, 0), b3, voffB); PG8_STAGE(PG8_SB(1, 1), b3 + hstep, voffB); PG8_STAGE(PG8_SA(1, 0), a3, voffA);
            PG8_WAIT_V(8); PG8_WAIT_L(0); PG8_BAR; PG8_MMA(1, 0, At, B0); PG8_MMA(1, 1, At, B1); PG8_BAR; PG8_SCHED;
            } else {
            PG8_LDB(B0, 0, 0); PG8_SCHED; PG8_LDA(At, 0, 0); PG8_STAGE(PG8_SA(1, 1), a1 + hstepA, voffA);
            PG8_WAIT_L(8); PG8_BAR; PG8_WAIT_L(0); PG8_MMA(0, 0, At, B0); PG8_BAR; PG8_SCHED;
            PG8_LDB(B1, 0, 1); PG8_STAGE(PG8_SB(0, 0), b2, voffB);
            PG8_BAR; PG8_WAIT_L(0); PG8_MMA(0, 1, At, B1); PG8_BAR;
            PG8_LDA(At, 0, 1); PG8_STAGE(PG8_SA(0, 0), a2, voffA);
            PG8_BAR; PG8_WAIT_L(0); PG8_MMA(1, 0, At, B0); PG8_BAR; PG8_SCHED;
            PG8_STAGE(PG8_SB(0, 1), b2 + hstep, voffB);
            PG8_WAIT_V(6); PG8_BAR; PG8_MMA(1, 1, At, B1); PG8_BAR;
            PG8_LDB(B0, 1, 0); PG8_SCHED; PG8_LDA(At, 1, 0); PG8_STAGE(PG8_SA(0, 1), a2 + hstepA, voffA);
            PG8_WAIT_L(8); PG8_BAR; PG8_WAIT_L(0); PG8_MMA(0, 0, At, B0); PG8_BAR; PG8_SCHED;
            PG8_LDB(B1, 1, 1); PG8_STAGE(PG8_SB(1, 0), b3, voffB);
            PG8_BAR; PG8_WAIT_L(0); PG8_MMA(0, 1, At, B1); PG8_BAR;
            PG8_LDA(At, 1, 1); PG8_STAGE(PG8_SA(1, 0), a3, voffA);
            PG8_BAR; PG8_WAIT_L(0); PG8_MMA(1, 0, At, B0); PG8_BAR; PG8_SCHED;
            PG8_STAGE(PG8_SB(1, 1), b3 + hstep, voffB);
            PG8_WAIT_V(6); PG8_BAR; PG8_MMA(1, 1, At, B1); PG8_BAR;
            }
        }
        if constexpr (ALIGN_EPI) { if (wr == 0) PG8_BAR; }
        if constexpr (!Epi::AFTER_DRAIN) { E(acc, cur, wr, wc, fr, fq); S.done(cur); }
        if (!has_next) break;
#pragma unroll
        for (int a = 0; a < 2; ++a)
#pragma unroll
            for (int b = 0; b < 2; ++b)
#pragma unroll
                for (int m = 0; m < 4; ++m)
#pragma unroll
                    for (int n = 0; n < 2; ++n) acc[a][b][m][n] = (f32x4){0.f, 0.f, 0.f, 0.f};
        cur = nxt; cA = nA; cB = nB; ++ui;
        if constexpr (ALIGN_EPI) { if (wr == 1) PG8_BAR; }
    }
    PG8_WAIT_V(0);
    if constexpr (!ALIGN_EPI) { if (wr == 0) PG8_BAR; }
    PG8_BAR;
    if constexpr (Epi::AFTER_DRAIN) { E.fused(acc, cur, wr, wc, fr, fq, lds, wid, lane); S.done(cur); }
#undef PG8_SA
#undef PG8_SB
#undef PG8_STAGE
#undef PG8_LDA
#undef PG8_LDB
#undef PG8_MMA
#undef PG8_WAIT_V
#undef PG8_WAIT_L
#undef PG8_BAR
#undef PG8_SCHED
}
}

#define GAS __attribute__((address_space(1)))
#define LAS __attribute__((address_space(3)))
typedef unsigned short bf16;
typedef unsigned v4u __attribute__((ext_vector_type(4)));
typedef unsigned v2u __attribute__((ext_vector_type(2)));
typedef float f32x4 __attribute__((ext_vector_type(4)));
typedef float f32x16 __attribute__((ext_vector_type(16)));
typedef short bf16x8 __attribute__((ext_vector_type(8)));
typedef short s16x4 __attribute__((ext_vector_type(4)));
typedef GAS unsigned gu32;
#define RLX_AGENT __ATOMIC_RELAXED, __HIP_MEMORY_SCOPE_AGENT
#define LDS_WAIT() asm volatile("s_waitcnt lgkmcnt(0)" ::: "memory")
#define VM_WAIT() asm volatile("s_waitcnt vmcnt(0)" ::: "memory")
typedef float f32x2_t __attribute__((ext_vector_type(2))); typedef __bf16 bf16x2_t __attribute__((ext_vector_type(2)));
__device__ __forceinline__ unsigned pk2(float lo, float hi) { f32x2_t v = {lo, hi}; bf16x2_t b = __builtin_convertvector(v, bf16x2_t); return __builtin_bit_cast(unsigned, b); }
__device__ __forceinline__ bf16 f2bf(float f) { return (bf16)(pk2(f, 0.f) & 0xffffu); }
__device__ __forceinline__ float bf2f(bf16 v) { return __uint_as_float((unsigned)v << 16); }
__device__ __forceinline__ float bflo(unsigned w) { return __uint_as_float(w << 16); }
__device__ __forceinline__ float bfhi(unsigned w) { return __uint_as_float(w & 0xffff0000u); }

#define XB_TMO      128
#define XB_XCNT(j)  (256  + 64 * (j))
#define XB_XSUB(j)  (1280 + 64 * (j))
#define XB_XGEN(j)  (2304 + 64 * (j))
#define XB_TOP      3328
#define XB_TOPGEN   3392
#define XCD_BAR_WORDS 3456
#define XB_SPIN_CAP (1u << 18)
__device__ __forceinline__ unsigned xb_ld(unsigned* p)              { return __hip_atomic_load(p, __ATOMIC_RELAXED, __HIP_MEMORY_SCOPE_AGENT); }
__device__ __forceinline__ unsigned xb_add(unsigned* p, unsigned v) { return __hip_atomic_fetch_add(p, v, __ATOMIC_RELAXED, __HIP_MEMORY_SCOPE_AGENT); }
__device__ __forceinline__ unsigned xb_xcc_id() { return (unsigned)__builtin_amdgcn_s_getreg((3 << 11) | 20) & 0xFu; }
#define XB_SPIN(cond, bar) do { unsigned _sp = 0; while (cond) { __builtin_amdgcn_s_sleep(1); \
    if ((++_sp & 255u) == 0u) { if (xb_ld(&(bar)[XB_TMO])) break; if (_sp > XB_SPIN_CAP) { atomicAdd(&(bar)[XB_TMO], 1u); break; } } } } while (0)
struct XcdBarrier { unsigned* bar; unsigned x; volatile LAS unsigned* st; };
__device__ __forceinline__ XcdBarrier xcd_barrier_post(unsigned* bar, volatile LAS unsigned* st) {
    XcdBarrier b; b.bar = bar; b.x = xb_xcc_id(); b.st = st;
    if (threadIdx.x == 0) (void)xb_add(&bar[XB_XCNT(b.x)], 1u);
    return b;
}
__device__ __forceinline__ void xcd_barrier_complete(unsigned* bar, unsigned x, unsigned& nloc, unsigned& nx) {
    const unsigned G = gridDim.x * gridDim.y * gridDim.z;
    unsigned sum, cnt, mine, sp = 0u;
    for (;;) {
        sum = 0u; cnt = 0u; mine = 0u;
#pragma unroll
        for (unsigned j = 0; j < 16; ++j) { const unsigned c = xb_ld(&bar[XB_XCNT(j)]); sum += c; cnt += (c > 0u) ? 1u : 0u; mine = (j == x) ? c : mine; }
        if (sum == G) break;
        __builtin_amdgcn_s_sleep(1);
        if ((++sp & 255u) == 0u) { if (xb_ld(&bar[XB_TMO])) break; if (sp > XB_SPIN_CAP) { atomicAdd(&bar[XB_TMO], 1u); break; } }
    }
    nloc = mine > 0u ? mine : 1u; nx = cnt > 0u ? cnt : 1u;
}
__device__ __forceinline__ void xcd_barrier(const XcdBarrier& b) {
    asm volatile("s_waitcnt vmcnt(0)" ::: "memory");
    __syncthreads();
    if (threadIdx.x == 0) {
        unsigned* bar = b.bar;
        __builtin_amdgcn_s_waitcnt(0);
        unsigned nloc = b.st[0], nx = b.st[1];
        if (nloc == 0u) { xcd_barrier_complete(bar, b.x, nloc, nx); b.st[0] = nloc; b.st[1] = nx; }
        const unsigned old = xb_add(&bar[XB_XSUB(b.x)], 1u);
        const unsigned gen = old / nloc;
        if (old + 1u == (gen + 1u) * nloc) {
            __builtin_amdgcn_fence(__ATOMIC_RELEASE, "agent");
            asm volatile("s_waitcnt vmcnt(0)" ::: "memory");
            const unsigned og = xb_add(&bar[XB_TOP], 1u);
            const unsigned tg = og / nx;
            if (og + 1u == (tg + 1u) * nx) xb_add(&bar[XB_TOPGEN], 1u);
            else XB_SPIN(xb_ld(&bar[XB_TOPGEN]) == tg, bar);
            __builtin_amdgcn_fence(__ATOMIC_ACQUIRE, "agent");
            xb_add(&bar[XB_XGEN(b.x)], 1u);
            asm volatile("s_waitcnt vmcnt(0)" ::: "memory");
        } else {
            XB_SPIN(xb_ld(&bar[XB_XGEN(b.x)]) == gen, bar);
            __builtin_amdgcn_fence(__ATOMIC_ACQUIRE, "agent");
            asm volatile("s_waitcnt vmcnt(0)" ::: "memory");
        }
    }
    __syncthreads();
}

constexpr int DM = 1024, NB = 8, SEQ = 2048, NMETA = 16, TT = SEQ + NMETA;
constexpr int DB = 128, PAST = 8192, PAGE = 128, NPAGES = 64;
constexpr int NH = 8, HP = 64, SSDW = 512, NG = 2, DS = 64, CONVD = 768;
constexpr int QKD = 96, VD = 64, MLAW = 512, QL = 384, KVL = 256, DFF = 2816, INC = 1960;
constexpr int RP = NB * TT, R = RP + DB;
constexpr int MMAIN = NB * SEQ;
constexpr int NS = NMETA + DB;
constexpr float EPS = 1e-6f, ATTN_SCALE = 0.10206207261596577f, LOG2E = 1.4426950408889634f;
constexpr int PJ = 2048, C_Z = 0, C_XBC = 512, C_CKV = 1280, C_CQ = 1536, C_DT = 1920, C_KR = 1928;
constexpr int S_Z = 0, S_XBC = 512, S_DT = 1280, S_CQ = 1288, S_CKV = 1672, S_KR = 1928;
constexpr int TPAD = 2112;
constexpr int NCH = 33, CHL = 64, TOFF = 48;
constexpr size_t OUT_YP = 0, OUT_YS = 16777216, OUT_LATP = 16908288, OUT_KRP = 21135360, OUT_CONVP = 21663744,
                 OUT_SSMP = 21682176, OUT_LATS = 21944320, OUT_KRS = 21977088, OUT_CONVS = 21981184, OUT_SSMS = 22276096;

constexpr size_t MiB = 1u << 20;
constexpr size_t WS_CTL = 0, CTL_ZERO_BYTES = 32 * 1024;
constexpr int CW_BAR = 4096;
constexpr size_t WS_SS = 512 * 1024;
constexpr size_t WS_WIN = 2 * MiB;
constexpr size_t WS_WUQ = 6 * MiB;
constexpr size_t WS_WUKV = 7 * MiB;
constexpr size_t WS_WOUT = 8 * MiB;
constexpr size_t WS_WGU = 10 * MiB;
constexpr size_t WS_WDN = 22 * MiB;
constexpr size_t WS_XN = 32 * MiB;
constexpr size_t WS_PROJ = 66 * MiB;
constexpr size_t WS_DTRAW = 132 * MiB;
constexpr size_t WS_DT = 133 * MiB;
constexpr size_t WS_LAT = 134 * MiB;
constexpr size_t WS_CQN = 143 * MiB;
constexpr size_t WS_KRF = 156 * MiB;
constexpr size_t WS_XST = 159 * MiB;
constexpr size_t WS_BT = 176 * MiB;
constexpr size_t WS_BC = 181 * MiB;
constexpr size_t WS_XAS = 190 * MiB;
constexpr size_t WS_QRAW = 191 * MiB;
constexpr size_t WS_KVRAW = 216 * MiB;
constexpr size_t WS_Q = 249 * MiB;
constexpr size_t WS_K = 274 * MiB;
constexpr size_t WS_VT = 299 * MiB;
constexpr size_t WS_STATES = 316 * MiB;
constexpr size_t WS_DECAY = 350 * MiB;
constexpr size_t WS_HIN = 351 * MiB;
constexpr size_t WS_MIX = 368 * MiB;
constexpr size_t WS_ACT = 401 * MiB;
constexpr size_t WS_VS = 491 * MiB;
constexpr size_t WS_DPART = 492 * MiB;
constexpr size_t WS_HS = 494 * MiB;
constexpr size_t WS_ROPE = 496 * MiB;
constexpr size_t WS_SSP = 520 * MiB;
constexpr size_t WS_WUKV2 = 524 * MiB;
constexpr size_t WS_RQ = 522 * MiB;
constexpr size_t WS_OPT_END = 525 * MiB;
constexpr size_t WS_NAIVE = 2048 * MiB;
constexpr size_t WS_DIAG = 1 * MiB;

constexpr int RING_OFF = 0, RING_BYTES = 131072;
constexpr int LDSCTL_OFF = RING_BYTES, MISC_OFF = LDSCTL_OFF + 320;
constexpr int LDS_BYTES = 163840;
constexpr int NWAVES = 8, NTHR = 512;

struct Args { const void* in[30]; float* out; unsigned char* ws; int ph_lo, ph_hi, li, pad; };

struct Frame {
    LAS unsigned char* lds;
    int tid, lane, wave, G, vcu, gw, NGW;
    unsigned char* ws; float* out;
    const void* const* in;
};
__device__ __forceinline__ float wave_sum(float v) {
#pragma unroll
    for (int o = 1; o < 64; o <<= 1) v += __shfl_xor(v, o);
    return v;
}
__device__ __forceinline__ float wave_max(float v) {
#pragma unroll
    for (int o = 1; o < 64; o <<= 1) v = fmaxf(v, __shfl_xor(v, o));
    return v;
}
__device__ __forceinline__ float silu_f(float x) { return x / (1.f + __expf(-x)); }
__device__ __forceinline__ float softplus_f(float x) { return fmaxf(x, 0.f) + log1pf(expf(-fabsf(x))); }
__device__ __forceinline__ float rope_inv(int j) { return exp2f(-(float)j * (13.287712379549449f / 16.0f)); }
struct EpiProj {
    static constexpr bool PERM = true, AFTER_DRAIN = false;
    bf16* O; float* dtraw; int rmode;
    __device__ __forceinline__ void operator()(const pg8::f32x4 (&acc)[2][2][4][2], const pg8::Unit& u, int wr, int wc, int fr, int fq) const {
        const int rb = rmode ? (u.pm >> 3) * 2064 + 16 + (u.pm & 7) * 256 : u.pm * 256;
        const int row0 = rb + wr * 64 + fr, col0 = u.pn * 256 + wc * 32 + 8 * fq;
#pragma unroll
        for (int ai = 0; ai < 2; ++ai)
#pragma unroll
            for (int m = 0; m < 4; ++m) { const int row = row0 + ai * 128 + m * 16; bf16* rowp = O + (size_t)row * PJ + col0;
#pragma unroll
                for (int bj = 0; bj < 2; ++bj) { const pg8::f32x4 v0 = acc[ai][bj][m][0], v1 = acc[ai][bj][m][1];
                    v4u w; w.x = pk2(v0[0], v0[1]); w.y = pk2(v0[2], v0[3]); w.z = pk2(v1[0], v1[1]); w.w = pk2(v1[2], v1[3]);
                    *(v4u*)(rowp + bj * 128) = w; }
                if (u.pn == 7 && wc == 0 && fq == 0) { *(pg8::f32x4*)(dtraw + (size_t)row * 8) = acc[ai][1][m][0]; *(pg8::f32x4*)(dtraw + (size_t)row * 8 + 4) = acc[ai][1][m][1]; } }
    }
};
struct EpiBf16 {
    static constexpr bool PERM = true, AFTER_DRAIN = false;
    bf16* O; int ldc; int rmode;
    __device__ __forceinline__ void operator()(const pg8::f32x4 (&acc)[2][2][4][2], const pg8::Unit& u, int wr, int wc, int fr, int fq) const {
        const int rb = rmode ? (u.pm >> 3) * 2064 + 16 + (u.pm & 7) * 256 : u.pm * 256;
        const int row0 = rb + wr * 64 + fr, col0 = u.pn * 256 + wc * 32 + 8 * fq;
#pragma unroll
        for (int ai = 0; ai < 2; ++ai)
#pragma unroll
            for (int m = 0; m < 4; ++m) { bf16* rowp = O + (size_t)(row0 + ai * 128 + m * 16) * ldc + col0;
#pragma unroll
                for (int bj = 0; bj < 2; ++bj) { const pg8::f32x4 v0 = acc[ai][bj][m][0], v1 = acc[ai][bj][m][1];
                    v4u w; w.x = pk2(v0[0], v0[1]); w.y = pk2(v0[2], v0[3]); w.z = pk2(v1[0], v1[1]); w.w = pk2(v1[2], v1[3]);
                    *(v4u*)(rowp + bj * 128) = w; } }
    }
};
struct EpiResF32 {
    static constexpr bool PERM = false, AFTER_DRAIN = false;
    const float* res; float* out;
    __device__ __forceinline__ void operator()(const pg8::f32x4 (&acc)[2][2][4][2], const pg8::Unit& u, int wr, int wc, int fr, int fq) const {
        const int row0 = u.pm * 256 + wr * 64 + fr, col0 = u.pn * 256 + wc * 32 + 4 * fq;
#pragma unroll
        for (int ai = 0; ai < 2; ++ai)
#pragma unroll
            for (int m = 0; m < 4; ++m) { const size_t off = (size_t)(row0 + ai * 128 + m * 16) * DM + col0;
#pragma unroll
                for (int bj = 0; bj < 2; ++bj)
#pragma unroll
                    for (int n = 0; n < 2; ++n) { const pg8::f32x4 r = *(const pg8::f32x4*)(res + off + bj * 128 + n * 16); *(pg8::f32x4*)(out + off + bj * 128 + n * 16) = r + acc[ai][bj][m][n]; } }
    }
};
struct EpiOutProj {
    static constexpr bool PERM = false, AFTER_DRAIN = false;
    const float* res; float* out; bf16* HB; float* SS;
    __device__ __forceinline__ void operator()(const pg8::f32x4 (&acc)[2][2][4][2], const pg8::Unit& u, int wr, int wc, int fr, int fq) const {
        const int rb = (u.pm >> 3) * 2064 + 16 + (u.pm & 7) * 256;
        const int row0 = u.pm * 256 + wr * 64 + fr, col0 = u.pn * 256 + wc * 32 + 4 * fq;
        pg8::f32x4 rc[4], rn[4];
#define EOP_LOAD(dst, g) do { const size_t off_ = (size_t)(row0 + ((g) >> 2) * 128 + ((g) & 3) * 16) * DM + col0; \
            dst[0] = *(const pg8::f32x4*)(res + off_); dst[1] = *(const pg8::f32x4*)(res + off_ + 16); dst[2] = *(const pg8::f32x4*)(res + off_ + 128); dst[3] = *(const pg8::f32x4*)(res + off_ + 144); } while (0)
        EOP_LOAD(rc, 0);
#pragma unroll
        for (int g = 0; g < 8; ++g) { const int ai = g >> 2, m = g & 3;
            if (g < 7) EOP_LOAD(rn, g + 1);
            const int orow = row0 + ai * 128 + m * 16; bf16* hb = HB + (size_t)(rb + wr * 64 + fr + ai * 128 + m * 16) * DM + col0; float ss = 0.f;
#pragma unroll
            for (int bj = 0; bj < 2; ++bj)
#pragma unroll
                for (int n = 0; n < 2; ++n) { const pg8::f32x4 v = rc[2 * bj + n] + acc[ai][bj][m][n];
                    ss += (v[0] * v[0] + v[1] * v[1]) + (v[2] * v[2] + v[3] * v[3]); v2u w; w.x = pk2(v[0], v[1]); w.y = pk2(v[2], v[3]); *(v2u*)(hb + bj * 128 + n * 16) = w; }
            ss += __shfl_xor(ss, 16); ss += __shfl_xor(ss, 32);
            if (fq == 0) SS[(size_t)orow * 16 + u.pn * 4 + wc] = ss;
#pragma unroll
            for (int i = 0; i < 4; ++i) rc[i] = rn[i]; }
#undef EOP_LOAD
    }
};
struct EpiDown {
    static constexpr bool PERM = false, AFTER_DRAIN = false;
    const bf16* HB; float* out;
    __device__ __forceinline__ void operator()(const pg8::f32x4 (&acc)[2][2][4][2], const pg8::Unit& u, int wr, int wc, int fr, int fq) const {
        const int rb = (u.pm >> 3) * 2064 + 16 + (u.pm & 7) * 256;
        const int row0 = u.pm * 256 + wr * 64 + fr, col0 = u.pn * 256 + wc * 32 + 4 * fq;
        v2u rc[4], rn[4];
#define EDN_LOAD(dst, g) do { const bf16* hb_ = HB + (size_t)(rb + wr * 64 + fr + ((g) >> 2) * 128 + ((g) & 3) * 16) * DM + col0; \
            dst[0] = *(const v2u*)(hb_); dst[1] = *(const v2u*)(hb_ + 16); dst[2] = *(const v2u*)(hb_ + 128); dst[3] = *(const v2u*)(hb_ + 144); } while (0)
        EDN_LOAD(rc, 0);
#pragma unroll
        for (int g = 0; g < 8; ++g) { const int ai = g >> 2, m = g & 3;
            if (g < 7) EDN_LOAD(rn, g + 1);
            const size_t off = (size_t)(row0 + ai * 128 + m * 16) * DM + col0;
#pragma unroll
            for (int bj = 0; bj < 2; ++bj)
#pragma unroll
                for (int n = 0; n < 2; ++n) { const v2u w = rc[2 * bj + n]; const pg8::f32x4 r = {bflo(w.x), bfhi(w.x), bflo(w.y), bfhi(w.y)}; *(pg8::f32x4*)(out + off + bj * 128 + n * 16) = r + acc[ai][bj][m][n]; }
#pragma unroll
            for (int i = 0; i < 4; ++i) rc[i] = rn[i]; }
#undef EDN_LOAD
    }
};
struct EpiSwiGLU {
    static constexpr bool PERM = true, AFTER_DRAIN = false;
    bf16* O; const LAS float* RS; pg8::StaticOrder S;
    __device__ __forceinline__ void operator()(const pg8::f32x4 (&acc)[2][2][4][2], const pg8::Unit& u, int wr, int wc, int fr, int fq) const {
        const int rb = (u.pm >> 3) * 2064 + 16 + (u.pm & 7) * 256;
        const int row0 = rb + wr * 64 + fr, col0 = u.pn * 128 + wc * 32 + 8 * fq;
        int slot = 0;
#pragma unroll 1
        for (int i = 0; i < 8; ++i) { pg8::Unit uu; if (!S.next(i, uu)) break; if (uu.pm == u.pm && uu.pn == u.pn) { slot = i; break; } }
        const LAS float* rsp = RS + slot * 256 + wr * 64 + fr;
#pragma unroll
        for (int ai = 0; ai < 2; ++ai)
#pragma unroll
            for (int m = 0; m < 4; ++m) { float a[8]; const float rs = rsp[ai * 128 + m * 16];
#pragma unroll
                for (int n = 0; n < 2; ++n)
#pragma unroll
                    for (int e = 0; e < 4; ++e) a[4 * n + e] = silu_f(rs * acc[ai][0][m][n][e]) * (rs * acc[ai][1][m][n][e]);
                v4u w; w.x = pk2(a[0], a[1]); w.y = pk2(a[2], a[3]); w.z = pk2(a[4], a[5]); w.w = pk2(a[6], a[7]);
                *(v4u*)(O + (size_t)(row0 + ai * 128 + m * 16) * DFF + col0) = w; }
    }
};

template <class ARow, class Epi>
__device__ __forceinline__ void small_gemm(const bf16* A, int lda, const bf16* Bt, int K, int nrt, int nct, const ARow& arow, const Epi& E, int gw, int NGW, int lane, int ksplit = 1) {
    const int ntask = nrt * nct * ksplit, kc = K / ksplit;
    for (int task = gw; task < ntask; task += NGW) {
        const int rt = task % nrt, ct = (task / nrt) % nct, kq = task / (nrt * nct);
        const bf16* ap = A + (size_t)arow(rt * 16 + (lane & 15)) * lda + kq * kc + 8 * (lane >> 4);
        const bf16* bp = Bt + (size_t)(ct * 16 + (lane & 15)) * K + kq * kc + 8 * (lane >> 4);
        f32x4 acc = {0.f, 0.f, 0.f, 0.f};
#pragma unroll 1
        for (int k0 = 0; k0 < kc; k0 += 32 * 11) {
            bf16x8 av[11], bv[11];
#pragma unroll
            for (int j = 0; j < 11; ++j) if (k0 + 32 * j < kc) { av[j] = *(const bf16x8*)(ap + k0 + 32 * j); bv[j] = *(const bf16x8*)(bp + k0 + 32 * j); }
#pragma unroll
            for (int j = 0; j < 11; ++j) if (k0 + 32 * j < kc) acc = __builtin_amdgcn_mfma_f32_16x16x32_bf16(av[j], bv[j], acc, 0, 0, 0);
        }
        E(acc, rt, ct, lane);
    }
}

template <class RM>
__device__ __forceinline__ void transpose_item(const float* W, int N, int ldw, bf16* WT, int ldt, int item, LAS float* scr, int lane, const RM& rm, const float* kscale = nullptr) {
    const int nblk = (N + 31) / 32, kb = item / nblk, nb = item % nblk, k0 = 64 * kb, n0 = 32 * nb;
    { const int n = n0 + (lane & 31); float v[32];
#pragma unroll
      for (int i = 0; i < 32; ++i) { const int kk = 2 * i + (lane >> 5); v[i] = (n < N) ? W[(size_t)(k0 + kk) * ldw + n] : 0.f; }
#pragma unroll
      for (int i = 0; i < 32; ++i) { const int kk = 2 * i + (lane >> 5); float x = v[i]; if (kscale) x *= kscale[k0 + kk]; scr[kk * 33 + (lane & 31)] = x; } }
    LDS_WAIT(); asm volatile("" ::: "memory");
    const int c = lane & 7;
#pragma unroll
    for (int j = 0; j < 4; ++j) { const int n = (lane >> 3) + 8 * j; const LAS float* s = scr + (8 * c) * 33 + n;
        if (n0 + n < N) { v4u o; o.x = pk2(s[0 * 33], s[1 * 33]); o.y = pk2(s[2 * 33], s[3 * 33]); o.z = pk2(s[4 * 33], s[5 * 33]); o.w = pk2(s[6 * 33], s[7 * 33]);
            *(v4u*)(WT + (size_t)rm(n0 + n) * ldt + k0 + 8 * c) = o; } }
    LDS_WAIT(); asm volatile("" ::: "memory");
}
__device__ __forceinline__ int map_in(int n) {
    return n < S_DT ? n : n < S_CQ ? C_DT + (n - S_DT) : n < S_CKV ? C_CQ + (n - S_CQ) : n < S_KR ? C_CKV + (n - S_CKV) : n;
}
__device__ __forceinline__ void p0_prologue(Frame& F) {
    LAS float* scr = (LAS float*)(F.lds + RING_OFF + F.wave * 16384);
    const float* w_in = (const float*)F.in[9]; const float* w_uq = (const float*)F.in[17]; const float* w_ukv = (const float*)F.in[19]; const float* w_out = (const float*)F.in[25];
    const float* w_gate = (const float*)F.in[27]; const float* w_up = (const float*)F.in[28]; const float* w_down = (const float*)F.in[29];
    bf16* WIN = (bf16*)(F.ws + WS_WIN); bf16* WUQ = (bf16*)(F.ws + WS_WUQ); bf16* WUKV = (bf16*)(F.ws + WS_WUKV); bf16* WOUT = (bf16*)(F.ws + WS_WOUT); bf16* WGU = (bf16*)(F.ws + WS_WGU); bf16* WDN = (bf16*)(F.ws + WS_WDN);
    const float* ffg = (const float*)F.in[26];
    constexpr int I_IN = 16 * 62, I_UQ = 6 * 24, I_UKV = 4 * 32, I_OUT = 16 * 32, I_G = 16 * 88, I_DN = 44 * 32;
    constexpr int NITEMS = I_IN + I_UQ + 2 * I_UKV + I_OUT + 2 * I_G + I_DN;
    bf16* WUKV2 = (bf16*)(F.ws + WS_WUKV2);
    for (int it = F.gw; it < NITEMS; it += F.NGW) {
        int r = it;
        if (r < I_IN) { transpose_item(w_in, INC, INC, WIN, DM, r, scr, F.lane, [](int n) { return map_in(n); }); continue; } r -= I_IN;
        if (r < I_UQ) { transpose_item(w_uq, 768, 768, WUQ, QL, r, scr, F.lane, [](int n) { return n; }, (const float*)F.in[16]); continue; } r -= I_UQ;
        if (r < I_UKV) { transpose_item(w_ukv, 1024, 1024, WUKV, KVL, r, scr, F.lane, [](int n) { return n; }, (const float*)F.in[18]); continue; } r -= I_UKV;
        if (r < I_UKV) { transpose_item(w_ukv, 1024, 1024, WUKV2, KVL, r, scr, F.lane, [](int n) { return n; }); continue; } r -= I_UKV;
        if (r < I_OUT) { transpose_item(w_out, DM, DM, WOUT, 1024, r, scr, F.lane, [](int n) { return n; }); continue; } r -= I_OUT;
        if (r < I_G) { transpose_item(w_gate, DFF, DFF, WGU, DM, r, scr, F.lane, [](int n) { return 256 * (n >> 7) + (n & 127); }, ffg); continue; } r -= I_G;
        if (r < I_G) { transpose_item(w_up, DFF, DFF, WGU, DM, r, scr, F.lane, [](int n) { return 256 * (n >> 7) + 128 + (n & 127); }, ffg); continue; } r -= I_G;
        transpose_item(w_down, DM, DM, WDN, DFF, r, scr, F.lane, [](int n) { return n; });
    }
    for (int i = F.gw * 64 + F.lane; i < 88 * 1024 / 8; i += F.NGW * 64) *(v4u*)(WIN + (size_t)1960 * 1024 + (size_t)i * 8) = (v4u){0u, 0u, 0u, 0u};
    const float* xp = (const float*)F.in[0]; const float* xs = (const float*)F.in[1]; const float* meta = (const float*)F.in[7]; const float* g = (const float*)F.in[8];
    bf16* XN = (bf16*)(F.ws + WS_XN);
    f32x4 gv[4];
#pragma unroll
    for (int j = 0; j < 4; ++j) gv[j] = ((const f32x4*)g)[F.lane + 64 * j];
    for (int r0 = 2 * F.gw; r0 < R; r0 += 2 * F.NGW) {
        f32x4 v[2][4];
#pragma unroll
        for (int i = 0; i < 2; ++i) { const int row = r0 + i; const float* src;
            if (row < RP) { const int b = row / TT, t = row % TT; src = (t < NMETA) ? meta + (size_t)t * DM : xp + ((size_t)b * SEQ + (t - NMETA)) * DM; } else src = xs + (size_t)(row - RP) * DM;
#pragma unroll
            for (int j = 0; j < 4; ++j) v[i][j] = ((const f32x4*)src)[F.lane + 64 * j]; }
#pragma unroll
        for (int i = 0; i < 2; ++i) { float s = 0.f;
#pragma unroll
            for (int j = 0; j < 4; ++j) s += (v[i][j].x * v[i][j].x + v[i][j].y * v[i][j].y) + (v[i][j].z * v[i][j].z + v[i][j].w * v[i][j].w);
            const float rs = 1.0f / sqrtf(wave_sum(s) * (1.f / DM) + EPS);
            v2u* o8 = (v2u*)(XN + (size_t)(r0 + i) * DM) + F.lane;
#pragma unroll
            for (int j = 0; j < 4; ++j) { v2u o; o.x = pk2(v[i][j].x * rs * gv[j].x, v[i][j].y * rs * gv[j].y); o.y = pk2(v[i][j].z * rs * gv[j].z, v[i][j].w * rs * gv[j].w); o8[64 * j] = o; } }
    }
    float* ROPE = (float*)(F.ws + WS_ROPE);
    for (int i = blockIdx.x * NTHR + F.tid; i < (TT + 1) * 16; i += F.G * NTHR) { const int p = i >> 4, j = i & 15; const float ang = (float)(p < TT ? p : PAST) * rope_inv(j); ROPE[2 * i] = cosf(ang); ROPE[2 * i + 1] = sinf(ang); }
}

__device__ __forceinline__ int small_arow(int r) { return r < NMETA ? r : RP + (r - NMETA); }
__device__ __forceinline__ void p1_inproj(Frame& F) {
    const bf16* XN = (const bf16*)(F.ws + WS_XN); const bf16* WIN = (const bf16*)(F.ws + WS_WIN); bf16* PROJ = (bf16*)(F.ws + WS_PROJ); float* DTRAW = (float*)(F.ws + WS_DTRAW);
    { pg8::Gemm g{XN, WIN, MMAIN, PJ, DM, 1, DM}; pg8::StaticOrder S; S.init(MMAIN, PJ, F.G, (int)blockIdx.x);
      EpiProj E{PROJ, DTRAW, 1};
      pg8::gemm_phase<EpiProj, pg8::StaticOrder, true, true>(F.lds + RING_OFF, g, S, E); }
    auto epi = [&](const f32x4& acc, int rt, int ct, int lane) {
        const int col = ct * 16 + (lane & 15);
#pragma unroll
        for (int i = 0; i < 4; ++i) { const int r = rt * 16 + 4 * (lane >> 4) + i; const bf16 v = f2bf(acc[i]);
            if (r < NMETA) { for (int b = 0; b < NB; ++b) { PROJ[(size_t)(b * TT + r) * PJ + col] = v; if (col >= C_DT && col < C_DT + 8) DTRAW[(size_t)(b * TT + r) * 8 + (col - C_DT)] = acc[i]; } }
            else { const int row = RP + (r - NMETA); PROJ[(size_t)row * PJ + col] = v; if (col >= C_DT && col < C_DT + 8) DTRAW[(size_t)row * 8 + (col - C_DT)] = acc[i]; } }
    };
    small_gemm(XN, DM, WIN, DM, NS / 16, PJ / 16, [](int r) { return small_arow(r); }, epi, F.gw, F.NGW, F.lane);
}

constexpr int CV_LDS_STRIDE = 82;
__device__ __forceinline__ void p2_elementwise(Frame& F) {
    const bf16* PROJ = (const bf16*)(F.ws + WS_PROJ); const float* DTRAW = (const float*)(F.ws + WS_DTRAW); float* DT = (float*)(F.ws + WS_DT);
    float* RQS = (float*)(F.ws + WS_RQ); float* KRF = (float*)(F.ws + WS_KRF);
    const float* kvg = (const float*)F.in[18]; const float* qng = (const float*)F.in[16]; const float* dtb = (const float*)F.in[12]; const float* ROPE = (const float*)(F.ws + WS_ROPE);
    {
        const f32x4 gg = ((const f32x4*)kvg)[F.lane]; const float* gq = qng + 6 * F.lane; const float g0 = gq[0], g1 = gq[1], g2 = gq[2], g3 = gq[3], g4 = gq[4], g5 = gq[5]; const float dbias = dtb[F.lane & 7];
        v2u wk[4], wkn[4]; unsigned wq[4][3], wqn[4][3]; unsigned short kr1[4], kr2[4], kr1n[4], kr2n[4]; float dtr[4], dtrn[4]; f32x2_t cs[4], csn[4];
#define P2A_LOAD(WK, WQ, K1, K2, DTR, CS, r0, n) do { _Pragma("unroll") for (int i = 0; i < 4; ++i) if (i < (n)) { const int row = (r0) + i; const bf16* pr = PROJ + (size_t)row * PJ; \
            WK[i] = *(const v2u*)(pr + C_CKV + 4 * F.lane); const unsigned* p = (const unsigned*)(pr + C_CQ + 6 * F.lane); WQ[i][0] = p[0]; WQ[i][1] = p[1]; WQ[i][2] = p[2]; \
            K1[i] = pr[C_KR + (F.lane & 15)]; K2[i] = pr[C_KR + 16 + (F.lane & 15)]; DTR[i] = DTRAW[(size_t)row * 8 + (F.lane & 7)]; \
            CS[i] = *(const f32x2_t*)(ROPE + 2 * ((row < RP ? row % TT : TT) * 16 + (F.lane & 15))); } } while (0)
#define P2A_PROC(r0, n) do { _Pragma("unroll") for (int i = 0; i < 4; ++i) if (i < (n)) { const int row = (r0) + i; \
            { const float v0 = bflo(wk[i].x), v1 = bfhi(wk[i].x), v2 = bflo(wk[i].y), v3 = bfhi(wk[i].y); \
              const float rs = 1.0f / sqrtf(wave_sum((v0 * v0 + v1 * v1) + (v2 * v2 + v3 * v3)) * (1.f / KVL) + EPS); \
              const f32x4 o = {v0 * rs * gg.x, v1 * rs * gg.y, v2 * rs * gg.z, v3 * rs * gg.w}; \
              float* of = (row < RP) ? F.out + OUT_LATP + (size_t)row * KVL : F.out + OUT_LATS + (size_t)(row - RP) * KVL; \
              ((f32x4*)of)[F.lane] = o; if (F.lane == 0) RQS[R + row] = rs; } \
            { const float v0 = bflo(wq[i][0]), v1 = bfhi(wq[i][0]), v2 = bflo(wq[i][1]), v3 = bfhi(wq[i][1]), v4 = bflo(wq[i][2]), v5 = bfhi(wq[i][2]); \
              const float rs = 1.0f / sqrtf(wave_sum((v0 * v0 + v1 * v1) + (v2 * v2 + v3 * v3) + (v4 * v4 + v5 * v5)) * (1.f / QL) + EPS); \
              if (F.lane == 0) RQS[row] = rs; } \
            if (F.lane < 16) { const int j = F.lane; const float c = cs[i].x, s = cs[i].y; \
              const float x1 = bf2f(kr1[i]), x2 = bf2f(kr2[i]); const float y1 = x1 * c - x2 * s, y2 = x1 * s + x2 * c; \
              KRF[(size_t)row * 32 + j] = y1; KRF[(size_t)row * 32 + 16 + j] = y2; \
              float* of = (row < RP) ? F.out + OUT_KRP + (size_t)row * 32 : F.out + OUT_KRS + (size_t)(row - RP) * 32; of[j] = y1; of[16 + j] = y2; } \
            if (F.lane < 8) DT[(size_t)row * 8 + F.lane] = softplus_f(dtr[i] + dbias); } } while (0)
#define P2A_ROT() do { _Pragma("unroll") for (int i = 0; i < 4; ++i) { wk[i] = wkn[i]; wq[i][0] = wqn[i][0]; wq[i][1] = wqn[i][1]; wq[i][2] = wqn[i][2]; kr1[i] = kr1n[i]; kr2[i] = kr2n[i]; dtr[i] = dtrn[i]; cs[i] = csn[i]; } } while (0)
        if (F.NGW == 2048) {
            const int ra = 4 * F.gw, rb2 = 8192 + 4 * F.gw, rc = 16384 + F.gw;
            P2A_LOAD(wk, wq, kr1, kr2, dtr, cs, ra, 4);
            P2A_LOAD(wkn, wqn, kr1n, kr2n, dtrn, csn, rb2, 4);
            P2A_PROC(ra, 4); P2A_ROT();
            if (F.gw < 256) P2A_LOAD(wkn, wqn, kr1n, kr2n, dtrn, csn, rc, 1);
            P2A_PROC(rb2, 4);
            if (F.gw < 256) { P2A_ROT(); P2A_PROC(rc, 1); }
        } else {
            for (int r0 = 4 * F.gw; r0 < R; r0 += 4 * F.NGW) { P2A_LOAD(wk, wq, kr1, kr2, dtr, cs, r0, 4); P2A_PROC(r0, 4); }
        }
#undef P2A_LOAD
#undef P2A_PROC
#undef P2A_ROT
    }
    const float* cw = (const float*)F.in[10]; const float* cb = (const float*)F.in[11];
    bf16* XST = (bf16*)(F.ws + WS_XST); bf16* BT = (bf16*)(F.ws + WS_BT); bf16* BC = (bf16*)(F.ws + WS_BC);
    LAS bf16* tile = (LAS bf16*)(F.lds + RING_OFF);
    for (int i = blockIdx.x * NTHR + F.tid; i < NB * 640 * 6; i += F.G * NTHR) { const int rowi = i / 6, pc = i % 6; const int bb = rowi / 640, cc = rowi % 640;
        bf16* dst = (cc < SSDW) ? XST + ((size_t)(bb * SSDW + cc)) * TPAD : BT + ((size_t)(bb * 128 + (cc - SSDW))) * TPAD; *(v4u*)(dst + pc * 8) = (v4u){0u, 0u, 0u, 0u}; }
    for (int u = blockIdx.x; u < NB * 32 * 3; u += F.G) {
        const int third = u % 3, tb = 1 + (u / 3) % 32, b = u / 96; const int t0 = tb * CHL - TOFF;
        {
            const int cl = 2 * (F.tid & 127), c = third * 256 + cl, tq = F.tid >> 7;
            const float w0a = cw[0 * CONVD + c], w1a = cw[1 * CONVD + c], w2a = cw[2 * CONVD + c], w3a = cw[3 * CONVD + c], ba = cb[c];
            const float w0b = cw[0 * CONVD + c + 1], w1b = cw[1 * CONVD + c + 1], w2b = cw[2 * CONVD + c + 1], w3b = cw[3 * CONVD + c + 1], bb = cb[c + 1];
            const bf16* base = PROJ + (size_t)b * TT * PJ + C_XBC + c;
#define CV_QUARTER(tfirst, lcol) do { float xa[19], xb[19]; \
                _Pragma("unroll") for (int k = 0; k < 19; ++k) { const int t = (tfirst) - 3 + k; xa[k] = 0.f; xb[k] = 0.f; if (t >= 0) { const unsigned w = *(const unsigned*)(base + (size_t)t * PJ); xa[k] = bflo(w); xb[k] = bfhi(w); } } \
                _Pragma("unroll") for (int k = 0; k < 16; ++k) { const int t = (tfirst) + k; \
                    const float ya = silu_f(ba + xa[k] * w0a + xa[k + 1] * w1a + xa[k + 2] * w2a + xa[k + 3] * w3a), yb = silu_f(bb + xb[k] * w0b + xb[k + 1] * w1b + xb[k + 2] * w2b + xb[k + 3] * w3b); \
                    const unsigned pk = pk2(ya, yb); \
                    tile[cl * CV_LDS_STRIDE + (lcol) + k] = (bf16)(pk & 0xffffu); tile[(cl + 1) * CV_LDS_STRIDE + (lcol) + k] = (bf16)(pk >> 16); \
                    if (third == 2) *(unsigned*)(BC + (size_t)(b * TT + t) * 256 + cl) = pk; } } while (0)
            CV_QUARTER(t0 + 16 * tq, 16 * tq);
            if (tb == 1 && tq == 0) CV_QUARTER(0, 64);
#undef CV_QUARTER
        }
        __syncthreads();
        { const int nrows = (third == 2) ? 128 : 256; const int npc = (tb == 1) ? 10 : 8;
          for (int i = F.tid; i < nrows * npc; i += NTHR) { const int cl = i / npc, pc = i % npc;
            const LAS unsigned* s = (const LAS unsigned*)(tile + cl * CV_LDS_STRIDE + pc * 8); v4u o; o.x = s[0]; o.y = s[1]; o.z = s[2]; o.w = s[3];
            bf16* dst = (third < 2) ? XST + ((size_t)(b * SSDW + third * 256 + cl)) * TPAD : BT + ((size_t)(b * 128 + cl)) * TPAD;
            *(v4u*)(dst + ((pc < 8) ? tb * CHL + pc * 8 : TOFF + (pc - 8) * 8)) = o; } }
        __syncthreads();
    }
    const float* sconv = (const float*)F.in[4]; float* XAS = (float*)(F.ws + WS_XAS);
    for (int i = blockIdx.x * NTHR + F.tid; i < DB * CONVD; i += F.G * NTHR) { const int b = i / CONVD, c = i % CONVD;
        const float xc = bf2f(PROJ[(size_t)(RP + b) * PJ + C_XBC + c]);
        const float s0 = sconv[(size_t)(b * 3 + 0) * CONVD + c], s1 = sconv[(size_t)(b * 3 + 1) * CONVD + c], s2 = sconv[(size_t)(b * 3 + 2) * CONVD + c];
        XAS[i] = silu_f(cb[c] + s0 * cw[c] + s1 * cw[CONVD + c] + s2 * cw[2 * CONVD + c] + xc * cw[3 * CONVD + c]);
        float* oc = F.out + OUT_CONVS + (size_t)b * 3 * CONVD + c; oc[0] = s1; oc[CONVD] = s2; oc[2 * CONVD] = xc; }
    for (int i = blockIdx.x * NTHR + F.tid; i < NB * 3 * CONVD; i += F.G * NTHR) { const int b = i / (3 * CONVD), k = (i / CONVD) % 3, c = i % CONVD;
        F.out[OUT_CONVP + i] = bf2f(PROJ[(size_t)(b * TT + TT - 3 + k) * PJ + C_XBC + c]); }
}
#define MFMA32(a, b, c) __builtin_amdgcn_mfma_f32_32x32x16_bf16((a), (b), (c), 0, 0, 0)
#define MFMA16(a, b, c) __builtin_amdgcn_mfma_f32_16x16x32_bf16((a), (b), (c), 0, 0, 0)
__device__ __forceinline__ int crow(int reg, int hi) { return (reg & 3) + 8 * (reg >> 2) + 4 * hi; }
__device__ __forceinline__ bf16x8 pack8(const f32x16& x, int s) {
    v4u p; p.x = pk2(x[8 * s + 0], x[8 * s + 1]); p.y = pk2(x[8 * s + 2], x[8 * s + 3]); p.z = pk2(x[8 * s + 4], x[8 * s + 5]); p.w = pk2(x[8 * s + 6], x[8 * s + 7]);
    return __builtin_bit_cast(bf16x8, p);
}
__device__ __forceinline__ bf16x8 ld2x8(const bf16* p0, const bf16* p1) {
    const v2u a = *(const v2u*)p0, b = *(const v2u*)p1; v4u r; r.x = a.x; r.y = a.y; r.z = b.x; r.w = b.y; return __builtin_bit_cast(bf16x8, r);
}
__device__ __forceinline__ float softmax_ref(Frame& F) {
    const float* gqn = (const float*)F.in[20]; const float* gqr = (const float*)F.in[21]; const float* gkn = (const float*)F.in[22]; const float* gkr = (const float*)F.in[23];
    float a = fabsf(gqn[F.lane]), b = fabsf(gkn[F.lane]);
    if (F.lane < 16) { a = fmaxf(a, fabsf(gqr[F.lane])); b = fmaxf(b, fabsf(gkr[F.lane])); }
    return LOG2E * 9.797958971132712f * wave_max(a) * wave_max(b) * 1.0001f;
}
constexpr size_t WS_YS = 495 * MiB;
constexpr size_t WS_KS = 498 * MiB;
constexpr int NKT = 65;

__device__ __forceinline__ void p3_upproj_states(Frame& F) {
    const bf16* PROJ = (const bf16*)(F.ws + WS_PROJ); const bf16* WUQ = (const bf16*)(F.ws + WS_WUQ); const bf16* WUKV = (const bf16*)(F.ws + WS_WUKV);
    bf16* QRAW = (bf16*)(F.ws + WS_QRAW); bf16* KVRAW = (bf16*)(F.ws + WS_KVRAW);
    { pg8::Gemm g{PROJ + C_CQ, WUQ, MMAIN, 768, QL, 1, PJ}; pg8::StaticOrder S; S.init(MMAIN, 768, F.G, (int)blockIdx.x); EpiBf16 E{QRAW, 768, 1};
      pg8::gemm_phase<EpiBf16, pg8::StaticOrder, true, true>(F.lds + RING_OFF, g, S, E); }
    { pg8::Gemm g{PROJ + C_CKV, WUKV, MMAIN, 1024, KVL, 1, PJ}; pg8::StaticOrder S; S.init(MMAIN, 1024, F.G, (int)blockIdx.x); EpiBf16 E{KVRAW, 1024, 1};
      pg8::gemm_phase<EpiBf16, pg8::StaticOrder, true, true>(F.lds + RING_OFF, g, S, E); }
    const bool sub = (F.G == 256);
    const int sgw = sub ? (blockIdx.x - 192) * NWAVES + F.wave : F.gw, sngw = sub ? 64 * NWAVES : F.NGW;
    if (!sub || blockIdx.x >= 192) {
    small_gemm(PROJ + C_CQ, PJ, WUQ, QL, DB / 16, 768 / 16, [](int r) { return RP + r; },
        [&](const f32x4& acc, int rt, int ct, int lane) { const int col = ct * 16 + (lane & 15);
#pragma unroll
            for (int i = 0; i < 4; ++i) QRAW[(size_t)(RP + rt * 16 + 4 * (lane >> 4) + i) * 768 + col] = f2bf(acc[i]); }, sgw, sngw, F.lane);
    small_gemm(PROJ + C_CKV, PJ, WUKV, KVL, NS / 16, 1024 / 16, [](int r) { return small_arow(r); },
        [&](const f32x4& acc, int rt, int ct, int lane) { const int col = ct * 16 + (lane & 15);
#pragma unroll
            for (int i = 0; i < 4; ++i) { const int r = rt * 16 + 4 * (lane >> 4) + i; const bf16 v = f2bf(acc[i]);
                if (r < NMETA) { for (int b = 0; b < NB; ++b) KVRAW[(size_t)(b * TT + r) * 1024 + col] = v; } else KVRAW[(size_t)(RP + r - NMETA) * 1024 + col] = v; } }, sgw, sngw, F.lane);
    }
    const float* DT = (const float*)(F.ws + WS_DT); const float* a_log = (const float*)F.in[13];
    const bf16* XST = (const bf16*)(F.ws + WS_XST); const bf16* BT = (const bf16*)(F.ws + WS_BT);
    float* STATES = (float*)(F.ws + WS_STATES); float* DECAY = (float*)(F.ws + WS_DECAY);
    LAS float* wl = (LAS float*)(F.lds + RING_OFF + F.wave * 1024);
    const int r32 = F.lane & 31, hi = F.lane >> 5;
    for (int u = F.gw; u < NB * NCH * NH; u += F.NGW) {
        const int h = u % NH, c = (u / NH) % NCH, b = u / (NH * NCH); const int g = h >> 2;
        const int t = c * CHL - TOFF + F.lane;
        const float dt = (t >= 0) ? DT[(size_t)(b * TT + t) * 8 + h] : 0.f;
        const float A = -__expf(a_log[h]);
        float acs = dt * A;
#pragma unroll
        for (int o = 1; o < 64; o <<= 1) { const float v = __shfl_up(acs, o); if (F.lane >= o) acs += v; }
        const float last = __shfl(acs, 63);
        wl[F.lane] = __expf(last - acs) * dt;
        LDS_WAIT(); asm volatile("" ::: "memory");
        f32x16 acc[2][2];
#pragma unroll
        for (int i = 0; i < 2; ++i)
#pragma unroll
            for (int j = 0; j < 2; ++j) acc[i][j] = (f32x16){};
        const bf16* xb = XST + ((size_t)(b * SSDW + h * HP)) * TPAD + c * CHL; const bf16* bb = BT + ((size_t)(b * 128 + g * DS)) * TPAD + c * CHL;
#pragma unroll
        for (int s = 0; s < 4; ++s) {
            const f32x4 w0 = *(const LAS f32x4*)(wl + 16 * s + 8 * hi), w1 = *(const LAS f32x4*)(wl + 16 * s + 8 * hi + 4);
            bf16x8 af[2], bfr[2];
#pragma unroll
            for (int pt = 0; pt < 2; ++pt) { const v4u x = *(const v4u*)(xb + (size_t)(32 * pt + r32) * TPAD + 16 * s + 8 * hi);
                v4u y; y.x = pk2(bflo(x.x) * w0.x, bfhi(x.x) * w0.y); y.y = pk2(bflo(x.y) * w0.z, bfhi(x.y) * w0.w); y.z = pk2(bflo(x.z) * w1.x, bfhi(x.z) * w1.y); y.w = pk2(bflo(x.w) * w1.z, bfhi(x.w) * w1.w);
                af[pt] = __builtin_bit_cast(bf16x8, y); }
#pragma unroll
            for (int nt = 0; nt < 2; ++nt) bfr[nt] = *(const bf16x8*)(bb + (size_t)(32 * nt + r32) * TPAD + 16 * s + 8 * hi);
#pragma unroll
            for (int pt = 0; pt < 2; ++pt)
#pragma unroll
                for (int nt = 0; nt < 2; ++nt) acc[pt][nt] = MFMA32(af[pt], bfr[nt], acc[pt][nt]);
        }
        float* so = STATES + ((size_t)((b * NCH + c) * NH + h)) * 4096;
#pragma unroll
        for (int pt = 0; pt < 2; ++pt)
#pragma unroll
            for (int nt = 0; nt < 2; ++nt)
#pragma unroll
                for (int rg = 0; rg < 16; ++rg) so[(32 * pt + crow(rg, hi)) * 64 + 32 * nt + r32] = acc[pt][nt][rg];
        if (F.lane == 0) DECAY[(b * NCH + c) * NH + h] = __expf(last);
        LDS_WAIT(); asm volatile("" ::: "memory");
    }
}

#ifdef MK_TS
#define P4_STAMP(k) do { if (blockIdx.x == 0 && F.tid == 0) ((unsigned long long*)(F.ws + 600 * MiB))[20 + (k)] = __builtin_amdgcn_s_memrealtime(); } while (0)
#else
#define P4_STAMP(k) do { } while (0)
#endif
__device__ __forceinline__ void p4_post(Frame& F) {
    const bf16* QRAW = (const bf16*)(F.ws + WS_QRAW); const bf16* KVRAW = (const bf16*)(F.ws + WS_KVRAW); const float* KRF = (const float*)(F.ws + WS_KRF);
    bf16* Q = (bf16*)(F.ws + WS_Q); bf16* K = (bf16*)(F.ws + WS_K); bf16* VT = (bf16*)(F.ws + WS_VT); float* VS = (float*)(F.ws + WS_VS);
    const float* gqn = (const float*)F.in[20]; const float* gqr = (const float*)F.in[21]; const float* gkn = (const float*)F.in[22]; const float* gkr = (const float*)F.in[23];
    const float* ROPE = (const float*)(F.ws + WS_ROPE); const float* RQS = (const float*)(F.ws + WS_RQ);
    const int h = F.lane >> 3, sub = F.lane & 7;
    bf16* KS = (bf16*)(F.ws + WS_KS);
    for (int row = RP + F.gw; row < R; row += F.NGW) {
        const int t = PAST;
        if (row >= RP) { const bf16* kp = KVRAW + (size_t)row * 1024 + 128 * h + 8 * sub; const v4u kw = *(const v4u*)kp; const v4u vw = *(const v4u*)(kp + 64);
          const f32x4 kr = *(const f32x4*)(KRF + (size_t)row * 32 + 4 * sub);
          const float rkv = RQS[R + row];
          float kn[8] = {bflo(kw.x) * rkv, bfhi(kw.x) * rkv, bflo(kw.y) * rkv, bfhi(kw.y) * rkv, bflo(kw.z) * rkv, bfhi(kw.z) * rkv, bflo(kw.w) * rkv, bfhi(kw.w) * rkv};
          float ss = (kr.x * kr.x + kr.y * kr.y) + (kr.z * kr.z + kr.w * kr.w);
#pragma unroll
          for (int e = 0; e < 8; ++e) ss += kn[e] * kn[e];
          ss += __shfl_xor(ss, 1); ss += __shfl_xor(ss, 2); ss += __shfl_xor(ss, 4);
          const float rs = 1.0f / sqrtf(ss * (1.f / 96.f) + EPS);
          const float* gn = gkn + 8 * sub; v4u o; o.x = pk2(kn[0] * rs * gn[0], kn[1] * rs * gn[1]); o.y = pk2(kn[2] * rs * gn[2], kn[3] * rs * gn[3]); o.z = pk2(kn[4] * rs * gn[4], kn[5] * rs * gn[5]); o.w = pk2(kn[6] * rs * gn[6], kn[7] * rs * gn[7]);
          bf16* ko = KS + (size_t)(row - RP) * 768 + 96 * h; *(v4u*)(ko + 8 * sub) = o;
          const float* gr = gkr + ((4 * sub) & 15); v2u o2; o2.x = pk2(kr.x * rs * gr[0], kr.y * rs * gr[1]); o2.y = pk2(kr.z * rs * gr[2], kr.w * rs * gr[3]);
          *(v2u*)(ko + 64 + 4 * sub) = o2;
          const unsigned vv[4] = {vw.x, vw.y, vw.z, vw.w}; float* vs = VS + (size_t)(row - RP) * 512 + 64 * h + 8 * sub;
#pragma unroll
          for (int e = 0; e < 4; ++e) { vs[2 * e] = bflo(vv[e]) * rkv; vs[2 * e + 1] = bfhi(vv[e]) * rkv; } }
        if (row >= RP || t >= NMETA) {
            const bf16* qp = QRAW + (size_t)row * 768 + 96 * h; const v4u qw = *(const v4u*)(qp + 8 * sub);
            const unsigned r1 = *(const unsigned*)(qp + 64 + 2 * sub), r2 = *(const unsigned*)(qp + 80 + 2 * sub);
            float qn[8] = {bflo(qw.x), bfhi(qw.x), bflo(qw.y), bfhi(qw.y), bflo(qw.z), bfhi(qw.z), bflo(qw.w), bfhi(qw.w)};
            const f32x4 cs = *(const f32x4*)(ROPE + 2 * ((row < RP ? t : TT) * 16 + 2 * sub)); const float c0 = cs.x, s0 = cs.y, c1 = cs.z, s1 = cs.w;
            const float x10 = bflo(r1), x11 = bfhi(r1), x20 = bflo(r2), x21 = bfhi(r2);
            const float y10 = x10 * c0 - x20 * s0, y20 = x10 * s0 + x20 * c0, y11 = x11 * c1 - x21 * s1, y21 = x11 * s1 + x21 * c1;
            float ss = (y10 * y10 + y20 * y20) + (y11 * y11 + y21 * y21);
#pragma unroll
            for (int e = 0; e < 8; ++e) ss += qn[e] * qn[e];
            ss += __shfl_xor(ss, 1); ss += __shfl_xor(ss, 2); ss += __shfl_xor(ss, 4);
            const float sq = RQS[row];
            const float rs = (ATTN_SCALE * LOG2E) * sq / sqrtf(ss * sq * sq * (1.f / 96.f) + EPS);
            const float* gn = gqn + 8 * sub; v4u o; o.x = pk2(qn[0] * rs * gn[0], qn[1] * rs * gn[1]); o.y = pk2(qn[2] * rs * gn[2], qn[3] * rs * gn[3]); o.z = pk2(qn[4] * rs * gn[4], qn[5] * rs * gn[5]); o.w = pk2(qn[6] * rs * gn[6], qn[7] * rs * gn[7]);
            bf16* qo = Q + (size_t)row * 768 + 96 * h; *(v4u*)(qo + 8 * sub) = o;
            const float g0 = gqr[2 * sub], g1 = gqr[2 * sub + 1];
            *(unsigned*)(qo + 64 + 2 * sub) = pk2(y10 * rs * g0, y11 * rs * g1); *(unsigned*)(qo + 80 + 2 * sub) = pk2(y20 * rs * g0, y21 * rs * g1);
        }
    }
    { bf16* KF = (bf16*)(F.ws + WS_K); bf16* VF = (bf16*)(F.ws + WS_VT);
      LAS unsigned char* vtile = F.lds + RING_OFF + F.wave * 4608;
      const int r8 = F.lane >> 3;
      for (int u = F.gw; u < NB * NKT * NH; u += F.NGW) {
          const int hh = u % NH, kt = (u / NH) % NKT, bb = u / (NH * NKT);
          bf16* kfb = KF + ((size_t)((bb * NH + hh) * NKT + kt)) * (6 * 512); bf16* vfb = VF + ((size_t)((bb * NH + hh) * NKT + kt)) * (4 * 512);
          v4u kwa[4], vwa[4]; f32x4 kra[4]; float rka[4];
#pragma unroll
          for (int i = 0; i < 4; ++i) { const int tk = kt * 32 + 8 * i + r8; const int tkc = tk < TT ? tk : TT - 1; rka[i] = RQS[R + bb * TT + tkc];
              const bf16* kp = KVRAW + (size_t)(bb * TT + tkc) * 1024 + 128 * hh + 8 * sub; kwa[i] = *(const v4u*)kp; vwa[i] = *(const v4u*)(kp + 64); kra[i] = *(const f32x4*)(KRF + (size_t)(bb * TT + tkc) * 32 + 4 * sub); }
#pragma unroll
          for (int i = 0; i < 4; ++i) {
              const int key = 8 * i + r8, tk = kt * 32 + key; v4u kw = kwa[i], vw = vwa[i]; f32x4 kr = kra[i];
              if (tk >= TT) { kw = (v4u){0u, 0u, 0u, 0u}; vw = kw; kr = (f32x4){0.f, 0.f, 0.f, 0.f}; }
              const float rkv = rka[i];
              float kn[8] = {bflo(kw.x) * rkv, bfhi(kw.x) * rkv, bflo(kw.y) * rkv, bfhi(kw.y) * rkv, bflo(kw.z) * rkv, bfhi(kw.z) * rkv, bflo(kw.w) * rkv, bfhi(kw.w) * rkv};
              vw.x = pk2(bflo(vw.x) * rkv, bfhi(vw.x) * rkv); vw.y = pk2(bflo(vw.y) * rkv, bfhi(vw.y) * rkv); vw.z = pk2(bflo(vw.z) * rkv, bfhi(vw.z) * rkv); vw.w = pk2(bflo(vw.w) * rkv, bfhi(vw.w) * rkv);
              float ss = (kr.x * kr.x + kr.y * kr.y) + (kr.z * kr.z + kr.w * kr.w);
#pragma unroll
              for (int e = 0; e < 8; ++e) ss += kn[e] * kn[e];
              ss += __shfl_xor(ss, 1); ss += __shfl_xor(ss, 2); ss += __shfl_xor(ss, 4);
              const float rs = 1.0f / sqrtf(ss * (1.f / 96.f) + EPS);
              const float* gn = gkn + 8 * sub; v4u o; o.x = pk2(kn[0] * rs * gn[0], kn[1] * rs * gn[1]); o.y = pk2(kn[2] * rs * gn[2], kn[3] * rs * gn[3]); o.z = pk2(kn[4] * rs * gn[4], kn[5] * rs * gn[5]); o.w = pk2(kn[6] * rs * gn[6], kn[7] * rs * gn[7]);
              *(v4u*)(kfb + (sub >> 1) * 512 + ((sub & 1) * 32 + key) * 8) = o;
              const float* gr = gkr + ((4 * sub) & 15); v2u o2; o2.x = pk2(kr.x * rs * gr[0], kr.y * rs * gr[1]); o2.y = pk2(kr.z * rs * gr[2], kr.w * rs * gr[3]);
              *(v2u*)(kfb + (4 + (sub >> 2)) * 512 + (((sub >> 1) & 1) * 32 + key) * 8 + 4 * (sub & 1)) = o2;
              *(LAS v4u*)(vtile + key * 144 + sub * 16) = vw; }
          LDS_WAIT(); asm volatile("" ::: "memory");
          const int g = F.lane >> 4, q4 = (F.lane & 15) >> 2, pp = F.lane & 3;
          const unsigned a_lo = (unsigned)(uintptr_t)vtile + (unsigned)((4 * (g >> 1) + q4) * 144 + (16 * (g & 1) + 4 * pp) * 2);
#define VF_TR(dt, s2) do { s16x4 lo, hi4; \
              asm volatile("ds_read_b64_tr_b16 %0, %2 offset:%c3\n\tds_read_b64_tr_b16 %1, %2 offset:%c4\n\ts_waitcnt lgkmcnt(0)" : "=&v"(lo), "=&v"(hi4) : "v"(a_lo), "i"(16 * (s2) * 144 + 64 * (dt)), "i"(16 * (s2) * 144 + 64 * (dt) + 8 * 144) : "memory"); \
              v4u o; o.x = (unsigned)(unsigned short)lo[0] | ((unsigned)(unsigned short)lo[1] << 16); o.y = (unsigned)(unsigned short)lo[2] | ((unsigned)(unsigned short)lo[3] << 16); \
              o.z = (unsigned)(unsigned short)hi4[0] | ((unsigned)(unsigned short)hi4[1] << 16); o.w = (unsigned)(unsigned short)hi4[2] | ((unsigned)(unsigned short)hi4[3] << 16); \
              *(v4u*)(vfb + ((dt) * 2 + (s2)) * 512 + F.lane * 8) = o; } while (0)
          VF_TR(0, 0); VF_TR(0, 1); VF_TR(1, 0); VF_TR(1, 1);
#undef VF_TR
          LDS_WAIT(); asm volatile("" ::: "memory");
      } }
    P4_STAMP(0);
    const float* STATES = (const float*)(F.ws + WS_STATES); const float* DECAY = (const float*)(F.ws + WS_DECAY); bf16* HIN = (bf16*)(F.ws + WS_HIN);
    for (int e2 = blockIdx.x * NTHR + F.tid; e2 < NB * NH * 2048; e2 += F.G * NTHR) {
        const int e = 2 * e2; const int b = e / (NH * 4096), hh = (e / 4096) % NH, pn = e % 4096;
        float h0 = 0.f, h1 = 0.f;
#pragma unroll 1
        for (int c0 = 0; c0 < NCH; c0 += 11) {
            f32x2_t st[11]; float dc[11];
#pragma unroll
            for (int j = 0; j < 11; ++j) { const int c = c0 + j; st[j] = *(const f32x2_t*)(STATES + ((size_t)((b * NCH + c) * NH + hh)) * 4096 + pn); dc[j] = DECAY[(b * NCH + c) * NH + hh]; }
#pragma unroll
            for (int j = 0; j < 11; ++j) { const int c = c0 + j; *(unsigned*)(HIN + ((size_t)((b * NCH + c) * NH + hh)) * 4096 + pn) = pk2(h0, h1); h0 = h0 * dc[j] + st[j].x; h1 = h1 * dc[j] + st[j].y; }
        }
        *(f32x2_t*)(F.out + OUT_SSMP + e) = (f32x2_t){h0, h1};
    }
    P4_STAMP(1);
    const float* XAS = (const float*)(F.ws + WS_XAS); const float* DT = (const float*)(F.ws + WS_DT); const float* sst = (const float*)F.in[5];
    const float* a_log = (const float*)F.in[13]; const float* d_skip = (const float*)F.in[14]; float* YS = (float*)(F.ws + WS_YS);
    for (int u = F.gw; u < DB * NH * 16; u += F.NGW) {
        const int pq = u & 15, hh = (u >> 4) & 7, b = u >> 7; const int g = hh >> 2; const int p = 4 * pq + (F.lane >> 4), n4 = F.lane & 15;
        const float dt = DT[(size_t)(RP + b) * 8 + hh]; const float a = __expf(dt * -__expf(a_log[hh]));
        const float x = XAS[(size_t)b * CONVD + hh * HP + p]; const float uu = dt * x;
        const f32x4 Bv = *(const f32x4*)(XAS + (size_t)b * CONVD + SSDW + g * DS + 4 * n4), Cv = *(const f32x4*)(XAS + (size_t)b * CONVD + SSDW + 128 + g * DS + 4 * n4);
        const size_t si = (((size_t)b * NH + hh) * HP + p) * DS + 4 * n4;
        const f32x4 s0 = *(const f32x4*)(sst + si); const f32x4 s1 = s0 * a + uu * Bv;
        *(f32x4*)(F.out + OUT_SSMS + si) = s1;
        float y = (Cv.x * s1.x + Cv.y * s1.y) + (Cv.z * s1.z + Cv.w * s1.w);
        y += __shfl_xor(y, 1); y += __shfl_xor(y, 2); y += __shfl_xor(y, 4); y += __shfl_xor(y, 8);
        if (n4 == 0) YS[(size_t)b * 512 + hh * HP + p] = y + d_skip[hh] * x;
    }
}
constexpr int DA_ROWB = 528;
constexpr int DA_LAT = 0, DA_KR = 128 * DA_ROWB, DA_PB = DA_KR + 128 * 33 * 4, DA_QG = DA_PB + 2 * 16 * 32 * 2, DA_END = DA_QG + 8 * 96 * 4;
constexpr int P5_EXCH = 100 * 1024;
static_assert(DA_END <= P5_EXCH, "LDS map of P5");

constexpr int AT_SLOT = 20480, AT_D = 4;
constexpr size_t WS_ATT = 499 * MiB;
__device__ __forceinline__ void at_issue(Frame& F, const bf16* kt_k, const bf16* kt_v, LAS unsigned char* slot) {
    const int w = F.wave;
    __builtin_amdgcn_global_load_lds((const unsigned*)((const char*)kt_k + w * 1024 + F.lane * 16), (LAS unsigned*)(slot + w * 1024), 16, 0, 0);
    const char* srcB = (w < 4) ? (const char*)kt_k + 8192 + w * 1024 : (const char*)kt_v + (w - 4) * 1024;
    __builtin_amdgcn_global_load_lds((const unsigned*)(srcB + F.lane * 16), (LAS unsigned*)(slot + 8192 + w * 1024), 16, 0, 0);
    __builtin_amdgcn_global_load_lds((const unsigned*)((const char*)kt_v + 4096 + w * 256 + F.lane * 4), (LAS unsigned*)(slot + 16384 + w * 256), 4, 0, 0);
    __builtin_amdgcn_global_load_lds((const unsigned*)((const char*)kt_v + 6144 + w * 256 + F.lane * 4), (LAS unsigned*)(slot + 18432 + w * 256), 4, 0, 0);
}
__device__ __forceinline__ void p5_attn_prompt(Frame& F, float M0) {
    const bf16* QRAW = (const bf16*)(F.ws + WS_QRAW); const bf16* KF = (const bf16*)(F.ws + WS_K); const bf16* VF = (const bf16*)(F.ws + WS_VT); bf16* ATT = (bf16*)(F.ws + WS_ATT);
    const float* ROPE = (const float*)(F.ws + WS_ROPE); const float* gqn = (const float*)F.in[20]; const float* gqr = (const float*)F.in[21]; const float* RQS = (const float*)(F.ws + WS_RQ);
    LAS unsigned char* ring = F.lds + RING_OFF;
    const int w = F.wave, r32 = F.lane & 31, hi = F.lane >> 5;
    f32x16 negm;
#pragma unroll
    for (int i = 0; i < 16; ++i) negm[i] = -M0;
    for (int u = blockIdx.x; u < 256; u += F.G) {
        const int b = u >> 5, h = (u >> 2) & 7, pr = u & 3;
        const bf16* kfb = KF + ((size_t)((b * NH + h) * NKT)) * (6 * 512); const bf16* vfb = VF + ((size_t)((b * NH + h) * NKT)) * (4 * 512);
#pragma unroll 1
        for (int half = 0; half < 2; ++half) {
            const int qb = half ? 7 - pr : pr; const int a = 8 * qb + w; const int qi = NMETA + 32 * a + r32;
            const int nkt = 8 * qb + 9, nkw = a + 2;
            bf16x8 qf[6];
            { const bf16* qp = QRAW + (size_t)(b * TT + qi) * 768 + 96 * h + 8 * hi;
              v4u qw[6];
#pragma unroll
              for (int s = 0; s < 6; ++s) qw[s] = *(const v4u*)(qp + 16 * s);
              f32x4 cs[4];
#pragma unroll
              for (int i = 0; i < 4; ++i) cs[i] = *(const f32x4*)(ROPE + 2 * (qi * 16 + 8 * hi) + 4 * i);
              float qv[6][8]; float ss = 0.f;
#pragma unroll
              for (int s = 0; s < 6; ++s) { const unsigned ww[4] = {qw[s].x, qw[s].y, qw[s].z, qw[s].w};
#pragma unroll
                  for (int e = 0; e < 4; ++e) { qv[s][2 * e] = bflo(ww[e]); qv[s][2 * e + 1] = bfhi(ww[e]); ss += qv[s][2 * e] * qv[s][2 * e] + qv[s][2 * e + 1] * qv[s][2 * e + 1]; } }
              ss += __shfl_xor(ss, 32);
              const float sq = RQS[b * TT + qi];
              const float rs = (ATTN_SCALE * LOG2E) * sq / sqrtf(ss * sq * sq * (1.f / 96.f) + EPS);
#pragma unroll
              for (int jj = 0; jj < 8; ++jj) { const float c = cs[jj >> 1][2 * (jj & 1)], sn = cs[jj >> 1][2 * (jj & 1) + 1]; const float x1 = qv[4][jj], x2 = qv[5][jj];
                  const float gr = gqr[8 * hi + jj] * rs; qv[4][jj] = (x1 * c - x2 * sn) * gr; qv[5][jj] = (x1 * sn + x2 * c) * gr; }
#pragma unroll
              for (int s = 0; s < 4; ++s) { const f32x4 g0 = *(const f32x4*)(gqn + 16 * s + 8 * hi), g1 = *(const f32x4*)(gqn + 16 * s + 8 * hi + 4);
                  qv[s][0] *= g0.x * rs; qv[s][1] *= g0.y * rs; qv[s][2] *= g0.z * rs; qv[s][3] *= g0.w * rs; qv[s][4] *= g1.x * rs; qv[s][5] *= g1.y * rs; qv[s][6] *= g1.z * rs; qv[s][7] *= g1.w * rs; }
#pragma unroll
              for (int s = 0; s < 6; ++s) { v4u o; o.x = pk2(qv[s][0], qv[s][1]); o.y = pk2(qv[s][2], qv[s][3]); o.z = pk2(qv[s][4], qv[s][5]); o.w = pk2(qv[s][6], qv[s][7]); qf[s] = __builtin_bit_cast(bf16x8, o); } }
            f32x16 o0 = (f32x16){}, o1 = (f32x16){}; float l = 0.f;
            const int ns = (nkt + 1) >> 1;
#pragma unroll
            for (int j = 0; j < AT_D - 1; ++j) at_issue(F, kfb + (size_t)j * 6144, vfb + (size_t)j * 4096, ring + j * AT_SLOT);
#pragma unroll 1
            for (int st = 0; st < ns; ++st) {
                const int rem = ns - 1 - st;
                if (rem >= 2) asm volatile("s_waitcnt vmcnt(8)" ::: "memory"); else if (rem == 1) asm volatile("s_waitcnt vmcnt(4)" ::: "memory"); else asm volatile("s_waitcnt vmcnt(0)" ::: "memory");
                __builtin_amdgcn_s_barrier(); asm volatile("" ::: "memory");
                if (st + AT_D - 1 < ns) at_issue(F, kfb + (size_t)(st + AT_D - 1) * 6144, vfb + (size_t)(st + AT_D - 1) * 4096, ring + ((st + AT_D - 1) & (AT_D - 1)) * AT_SLOT);
#pragma unroll
                for (int tt = 0; tt < 2; ++tt) { const int kt = 2 * st + tt;
                  if (kt < nkw) {
                    const LAS unsigned char* sl = ring + (st & (AT_D - 1)) * AT_SLOT + F.lane * 16; const int j0 = 32 * kt;
                    f32x16 S = negm;
#pragma unroll
                    for (int s = 0; s < 6; ++s) S = MFMA32(*(const LAS bf16x8*)(sl + tt * 6144 + 1024 * s), qf[s], S);
                    bf16x8 vf[4];
#pragma unroll
                    for (int i = 0; i < 4; ++i) vf[i] = *(const LAS bf16x8*)(sl + 12288 + tt * 4096 + 1024 * i);
#pragma unroll
                    for (int i = 0; i < 16; ++i) S[i] = __builtin_amdgcn_exp2f(S[i]);
                    if (kt >= a) {
#pragma unroll
                        for (int i = 0; i < 16; ++i) if (j0 + crow(i, hi) > qi) S[i] = 0.f; }
#pragma unroll
                    for (int i = 0; i < 16; ++i) l += S[i];
                    const bf16x8 p0 = pack8(S, 0), p1 = pack8(S, 1);
                    o0 = MFMA32(vf[0], p0, o0); o0 = MFMA32(vf[1], p1, o0);
                    o1 = MFMA32(vf[2], p0, o1); o1 = MFMA32(vf[3], p1, o1);
                  } }
            }
            l += __shfl_xor(l, 32);
            const float il = 1.0f / l;
            bf16* ao = ATT + (size_t)(b * TT + qi) * 512 + 64 * h + 4 * hi;
#pragma unroll
            for (int gq = 0; gq < 4; ++gq) {
                v2u w0, w1; w0.x = pk2(o0[4 * gq] * il, o0[4 * gq + 1] * il); w0.y = pk2(o0[4 * gq + 2] * il, o0[4 * gq + 3] * il);
                w1.x = pk2(o1[4 * gq] * il, o1[4 * gq + 1] * il); w1.y = pk2(o1[4 * gq + 2] * il, o1[4 * gq + 3] * il);
                *(v2u*)(ao + 8 * gq) = w0; *(v2u*)(ao + 32 + 8 * gq) = w1; }
            asm volatile("s_waitcnt lgkmcnt(0)" ::: "memory"); __builtin_amdgcn_s_barrier(); asm volatile("" ::: "memory");
        }
    }
}

constexpr int SO_X = 0, SO_H = 36864, SO_B = 73728, SO_C = 82944, SO_Z = 92160, SO_TAB = 125952, SO_EX = 130048;
static_assert(SO_EX + 1024 <= RING_BYTES, "ssd_out LDS map");
__device__ __forceinline__ void p5_ssd_out(Frame& F) {
    const float* DT = (const float*)(F.ws + WS_DT); const float* a_log = (const float*)F.in[13]; const float* d_skip = (const float*)F.in[14]; const float* ng = (const float*)F.in[15];
    const bf16* XST = (const bf16*)(F.ws + WS_XST); const bf16* BC = (const bf16*)(F.ws + WS_BC); const bf16* HIN = (const bf16*)(F.ws + WS_HIN); const bf16* PROJ = (const bf16*)(F.ws + WS_PROJ);
    bf16* MIX = (bf16*)(F.ws + WS_MIX);
    LAS unsigned char* L = F.lds + RING_OFF;
    LAS float* tab = (LAS float*)(L + SO_TAB) + F.wave * 128;
    LAS float* exch = (LAS float*)(L + SO_EX);
    const int hl = F.wave >> 1, it = F.wave & 1, r32 = F.lane & 31, hi = F.lane >> 5;
    for (int u = blockIdx.x; u < NB * (NCH - 1); u += F.G) {
        const int b = u / (NCH - 1), c = 1 + u % (NCH - 1); const int t0 = c * CHL - TOFF;
        v4u st[14];
#define SO_FETCH_A(g) do { \
        _Pragma("unroll") for (int k = 0; k < 4; ++k) { const int q = F.tid + NTHR * k; st[k] = *(const v4u*)(XST + ((size_t)(b * SSDW + (g) * 256 + (q >> 3))) * TPAD + c * CHL + 8 * (q & 7)); } } while (0)
#define SO_FETCH_B(g) do { \
        _Pragma("unroll") for (int k = 0; k < 4; ++k) { const int q = F.tid + NTHR * k; st[4 + k] = *(const v4u*)(HIN + ((size_t)((b * NCH + c) * NH + 4 * (g))) * 4096 + (size_t)q * 8); } \
        { const int q = F.tid; st[8] = *(const v4u*)(BC + (size_t)(b * TT + t0 + (q >> 3)) * 256 + (g) * DS + 8 * (q & 7)); st[9] = *(const v4u*)(BC + (size_t)(b * TT + t0 + (q >> 3)) * 256 + 128 + (g) * DS + 8 * (q & 7)); } \
        _Pragma("unroll") for (int k = 0; k < 4; ++k) { const int q = F.tid + NTHR * k; st[10 + k] = *(const v4u*)(PROJ + (size_t)(b * TT + t0 + (q >> 5)) * PJ + C_Z + (g) * 256 + 8 * (q & 31)); } } while (0)
#define SO_STORE() do { \
        _Pragma("unroll") for (int k = 0; k < 4; ++k) { const int q = F.tid + NTHR * k; *(LAS v4u*)(L + SO_X + (q >> 3) * 144 + 16 * (q & 7)) = st[k]; *(LAS v4u*)(L + SO_H + (q >> 3) * 144 + 16 * (q & 7)) = st[4 + k]; } \
        { const int q = F.tid; *(LAS v4u*)(L + SO_B + (q >> 3) * 144 + 16 * (q & 7)) = st[8]; *(LAS v4u*)(L + SO_C + (q >> 3) * 144 + 16 * (q & 7)) = st[9]; } \
        _Pragma("unroll") for (int k = 0; k < 4; ++k) { const int q = F.tid + NTHR * k; *(LAS v4u*)(L + SO_Z + (q >> 5) * 528 + 16 * (q & 31)) = st[10 + k]; } } while (0)
        SO_FETCH_A(0); SO_FETCH_B(0);
#pragma unroll 1
        for (int g = 0; g < 2; ++g) {
            const int h = 4 * g + hl; const float A = -__expf(a_log[h]), Dh = d_skip[h];
            { const int t = t0 + F.lane; const float dt = DT[(size_t)(b * TT + t) * 8 + h];
              float acs = dt * A;
#pragma unroll
              for (int o = 1; o < 64; o <<= 1) { const float v = __shfl_up(acs, o); if (F.lane >= o) acs += v; }
              tab[F.lane] = acs; tab[64 + F.lane] = dt; }
            SO_STORE();
            __syncthreads();
            if (g == 0) SO_FETCH_A(1);
            const int ii = 32 * it + r32; const int t = t0 + ii;
            bf16x8 cf[4];
#pragma unroll
            for (int s = 0; s < 4; ++s) cf[s] = *(const LAS bf16x8*)(L + SO_C + ii * 144 + 32 * s + 16 * hi);
            f32x16 y[2];
            const float ai = tab[ii]; const float ei = __expf(ai);
#pragma unroll
            for (int pt = 0; pt < 2; ++pt) { f32x16 acc = (f32x16){}; const LAS unsigned char* hp_ = L + SO_H + (hl * 64 + 32 * pt + r32) * 144 + 16 * hi;
#pragma unroll
                for (int s = 0; s < 4; ++s) acc = MFMA32(*(const LAS bf16x8*)(hp_ + 32 * s), cf[s], acc);
#pragma unroll
                for (int i = 0; i < 16; ++i) acc[i] *= ei;
                y[pt] = acc; }
#pragma unroll 1
            for (int jt = 0; jt <= it; ++jt) {
                f32x16 S = (f32x16){};
                { const LAS unsigned char* bp_ = L + SO_B + (32 * jt + r32) * 144 + 16 * hi;
#pragma unroll
                  for (int s = 0; s < 4; ++s) S = MFMA32(*(const LAS bf16x8*)(bp_ + 32 * s), cf[s], S); }
#pragma unroll
                for (int i = 0; i < 16; ++i) { const int jj = 32 * jt + crow(i, hi); const float e = (jj <= ii) ? __expf(ai - tab[jj]) * tab[64 + jj] : 0.f; S[i] = S[i] * e + ((jj == ii) ? Dh : 0.f); }
                const bf16x8 p0 = pack8(S, 0), p1 = pack8(S, 1);
#pragma unroll
                for (int pt = 0; pt < 2; ++pt) { const LAS unsigned char* xp_ = L + SO_X + (hl * 64 + 32 * pt + r32) * 144 + (32 * jt + 4 * hi) * 2;
                    const v2u x0 = *(const LAS v2u*)(xp_), x1 = *(const LAS v2u*)(xp_ + 16), x2 = *(const LAS v2u*)(xp_ + 32), x3 = *(const LAS v2u*)(xp_ + 48);
                    v4u f0, f1; f0.x = x0.x; f0.y = x0.y; f0.z = x1.x; f0.w = x1.y; f1.x = x2.x; f1.y = x2.y; f1.z = x3.x; f1.w = x3.y;
                    y[pt] = MFMA32(__builtin_bit_cast(bf16x8, f0), p0, y[pt]); y[pt] = MFMA32(__builtin_bit_cast(bf16x8, f1), p1, y[pt]); }
            }
            float ss = 0.f;
            { const LAS unsigned char* zp_ = L + SO_Z + ii * 528 + (hl * 64 + 4 * hi) * 2;
#pragma unroll
              for (int pt = 0; pt < 2; ++pt)
#pragma unroll
                for (int gq = 0; gq < 4; ++gq) { const v2u zw = *(const LAS v2u*)(zp_ + (32 * pt + 8 * gq) * 2); const float zz[4] = {bflo(zw.x), bfhi(zw.x), bflo(zw.y), bfhi(zw.y)};
#pragma unroll
                    for (int e = 0; e < 4; ++e) { const float v = y[pt][4 * gq + e] * silu_f(zz[e]); y[pt][4 * gq + e] = v; ss += v * v; } } }
            ss += __shfl_xor(ss, 32);
            if (g == 0) SO_FETCH_B(1);
            LAS float* ex = exch + it * 128;
            if (hi == 0) ex[hl * 32 + r32] = ss;
            __syncthreads();
            const float tot = (ex[r32] + ex[32 + r32]) + (ex[64 + r32] + ex[96 + r32]);
            const float rs = 1.0f / sqrtf(tot * (1.f / 256.f) + EPS);
            { bf16* mo = MIX + (size_t)(b * TT + t) * 1024 + 64 * h + 4 * hi;
#pragma unroll
              for (int pt = 0; pt < 2; ++pt)
#pragma unroll
                for (int gq = 0; gq < 4; ++gq) { const f32x4 gg = *(const f32x4*)(ng + 64 * h + 32 * pt + 8 * gq + 4 * hi);
                    v2u w; w.x = pk2(y[pt][4 * gq] * rs * gg.x, y[pt][4 * gq + 1] * rs * gg.y); w.y = pk2(y[pt][4 * gq + 2] * rs * gg.z, y[pt][4 * gq + 3] * rs * gg.w);
                    *(v2u*)(mo + 32 * pt + 8 * gq) = w; } }
        }
#undef SO_FETCH_A
#undef SO_FETCH_B
#undef SO_STORE
        __syncthreads();
    }
    const float* YS = (const float*)(F.ws + WS_YS);
    for (int u = F.gw; u < DB * NG; u += F.NGW) { const int b = u >> 1, gg = u & 1; const int cc = gg * 256 + 4 * F.lane;
        const f32x4 yv = *(const f32x4*)(YS + (size_t)b * 512 + cc); const v2u zw = *(const v2u*)(PROJ + (size_t)(RP + b) * PJ + C_Z + cc);
        const f32x4 v = {yv.x * silu_f(bflo(zw.x)), yv.y * silu_f(bfhi(zw.x)), yv.z * silu_f(bflo(zw.y)), yv.w * silu_f(bfhi(zw.y))};
        const float rs = 1.0f / sqrtf(wave_sum((v.x * v.x + v.y * v.y) + (v.z * v.z + v.w * v.w)) * (1.f / 256.f) + EPS);
        const f32x4 gv = *(const f32x4*)(ng + cc); v2u w; w.x = pk2(v.x * rs * gv.x, v.y * rs * gv.y); w.y = pk2(v.z * rs * gv.z, v.w * rs * gv.w);
        *(v2u*)(MIX + (size_t)(RP + b) * 1024 + cc) = w; }
}

constexpr int DB_STAGE = 0, DB_KRST = 65536, DB_LAT = DB_KRST + 8192, DB_KR = DB_LAT + 64 * DA_ROWB, DB_PB = DB_KR + 64 * 36 * 4, DB_QG = DB_PB + 16 * 64 * 2, DB_END = DB_QG + 8 * 96 * 4;
static_assert(DB_END <= RING_BYTES, "decode attention LDS map");
#define RAW_BAR_L() do { asm volatile("s_waitcnt lgkmcnt(0)" ::: "memory"); __builtin_amdgcn_s_barrier(); asm volatile("" ::: "memory"); } while (0)
#define RAW_BAR_VL() do { asm volatile("s_waitcnt vmcnt(0) lgkmcnt(0)" ::: "memory"); __builtin_amdgcn_s_barrier(); asm volatile("" ::: "memory"); } while (0)
__device__ __forceinline__ void da_issue(Frame& F, LAS unsigned char* L, const float* clat, const float* ckr, const int* ptab, int b, int split, int hp) {
    const size_t tok0 = (size_t)ptab[b * NPAGES + split * 32 + (hp >> 1)] * PAGE + (hp & 1) * 64;
    const char* src = (const char*)(clat + tok0 * KVL) + (size_t)(F.wave * 8) * 1024 + F.lane * 16;
#pragma unroll
    for (int i = 0; i < 8; ++i) __builtin_amdgcn_global_load_lds((const unsigned*)(src + i * 1024), (LAS unsigned*)(L + DB_STAGE + (F.wave * 8 + i) * 1024), 16, 0, 0);
    __builtin_amdgcn_global_load_lds((const unsigned*)((const char*)(ckr + tok0 * 32) + F.wave * 1024 + F.lane * 16), (LAS unsigned*)(L + DB_KRST + F.wave * 1024), 16, 0, 0);
}
__device__ __forceinline__ void da_convert(Frame& F, LAS unsigned char* L) {
#pragma unroll 4
    for (int k = 0; k < 8; ++k) { const int f = F.tid + NTHR * k; const int row = f >> 6, c4 = f & 63; const f32x4 v = *(const LAS f32x4*)(L + DB_STAGE + f * 16);
        v2u w; w.x = pk2(v.x, v.y); w.y = pk2(v.z, v.w); *(LAS v2u*)(L + DB_LAT + row * DA_ROWB + c4 * 8) = w; }
    { const int f = F.tid; const int row = f >> 3, c4 = f & 7; const f32x4 v = *(const LAS f32x4*)(L + DB_KRST + f * 16);
      *(LAS f32x4*)((LAS float*)(L + DB_KR) + row * 36 + 4 * c4) = v; }
}
template <int MODE>
__device__ __forceinline__ void p5_attn_decode_t(Frame& F, float M0) {
    const float* clat = (const float*)F.in[2]; const float* ckr = (const float*)F.in[3]; const int* ptab = (const int*)F.in[6];
    const bf16* WUKV = (const bf16*)(F.ws + WS_WUKV2); const bf16* Q = (const bf16*)(F.ws + WS_Q); const float* gkn = (const float*)F.in[22]; const float* gkr = (const float*)F.in[23];
    float* DPART = (float*)(F.ws + WS_DPART);
    LAS unsigned char* L = F.lds + RING_OFF;
    LAS float* krl = (LAS float*)(L + DB_KR); LAS bf16* pb = (LAS bf16*)(L + DB_PB); LAS float* qg = (LAS float*)(L + DB_QG) + F.wave * 96;
    const int h = F.wave, r32 = F.lane & 31, hi = F.lane >> 5;
    for (int u = blockIdx.x; u < DB * 2; u += F.G) {
        const int b = u >> 1, split = u & 1;
        da_issue(F, L, clat, ckr, ptab, b, split, 0);
        bf16x8 wf[4][8];
#pragma unroll
        for (int dt = 0; dt < 4; ++dt)
#pragma unroll
            for (int s = 0; s < 8; ++s) wf[dt][s] = *(const bf16x8*)(WUKV + (size_t)(128 * h + 16 * dt + (F.lane & 15)) * KVL + 32 * s + 8 * (F.lane >> 4));
        { const bf16* qp = Q + (size_t)(RP + b) * 768 + 96 * h; qg[F.lane] = bf2f(qp[F.lane]) * gkn[F.lane]; if (F.lane < 32) qg[64 + F.lane] = bf2f(qp[64 + F.lane]) * gkr[F.lane & 15]; }
        for (int i = F.tid; i < 16 * 64; i += NTHR) pb[i] = 0;
        f32x4 ao[2] = {(f32x4){0.f, 0.f, 0.f, 0.f}, (f32x4){0.f, 0.f, 0.f, 0.f}}; float l = 0.f;
        RAW_BAR_VL();
        da_convert(F, L);
        RAW_BAR_L();
        da_issue(F, L, clat, ckr, ptab, b, split, 1);
#pragma unroll 1
        for (int hp = 0; hp < 64; ++hp) {
          if (MODE == 0 || MODE == 3) {
            const int n16 = F.lane & 15, kg4 = F.lane >> 4;
#pragma unroll 1
            for (int sb = 0; sb < 2; ++sb) {
                const LAS unsigned char* bp = L + DB_LAT + (32 * sb + n16) * DA_ROWB + 16 * kg4;
                f32x4 acc[4][2];
#pragma unroll
                for (int dt = 0; dt < 4; ++dt) { acc[dt][0] = (f32x4){0.f, 0.f, 0.f, 0.f}; acc[dt][1] = acc[dt][0]; }
                bf16x8 fa[2], fb[2];
                fa[0] = *(const LAS bf16x8*)(bp); fa[1] = *(const LAS bf16x8*)(bp + 16 * DA_ROWB);
#pragma unroll
                for (int s = 0; s < 8; ++s) {
                    if (s < 7) { fb[0] = *(const LAS bf16x8*)(bp + 64 * (s + 1)); fb[1] = *(const LAS bf16x8*)(bp + 16 * DA_ROWB + 64 * (s + 1)); }
#pragma unroll
                    for (int dt = 0; dt < 4; ++dt) { acc[dt][0] = MFMA16(wf[dt][s], fa[0], acc[dt][0]); acc[dt][1] = MFMA16(wf[dt][s], fa[1], acc[dt][1]); }
                    fa[0] = fb[0]; fa[1] = fb[1];
                }
                __builtin_amdgcn_sched_barrier(0);
                f32x4 s4[2] = {(f32x4){0.f, 0.f, 0.f, 0.f}, (f32x4){0.f, 0.f, 0.f, 0.f}}, d4[2] = {s4[0], s4[0]};
#pragma unroll
                for (int dt = 0; dt < 4; ++dt) { const f32x4 qq = *(const LAS f32x4*)(qg + 16 * dt + 4 * kg4);
#pragma unroll
                    for (int tt = 0; tt < 2; ++tt) { s4[tt] += acc[dt][tt] * acc[dt][tt]; d4[tt] += acc[dt][tt] * qq; } }
                { const LAS float* qr = qg + 64 + 8 * kg4; const f32x4 q0 = *(const LAS f32x4*)(qr), q1 = *(const LAS f32x4*)(qr + 4);
#pragma unroll
                  for (int tt = 0; tt < 2; ++tt) { const LAS float* kr = krl + (32 * sb + 16 * tt + n16) * 36 + 8 * kg4; const f32x4 k0 = *(const LAS f32x4*)(kr), k1 = *(const LAS f32x4*)(kr + 4);
                      s4[tt] += k0 * k0; s4[tt] += k1 * k1; d4[tt] += k0 * q0; d4[tt] += k1 * q1; } }
                __builtin_amdgcn_sched_barrier(0);
#pragma unroll
                for (int tt = 0; tt < 2; ++tt) { float ss = (s4[tt].x + s4[tt].y) + (s4[tt].z + s4[tt].w), dot = (d4[tt].x + d4[tt].y) + (d4[tt].z + d4[tt].w);
                    ss += __shfl_xor(ss, 16); dot += __shfl_xor(dot, 16); ss += __shfl_xor(ss, 32); dot += __shfl_xor(dot, 32);
                    const float p = __builtin_amdgcn_exp2f(dot * __builtin_amdgcn_rsqf(ss * (1.f / 96.f) + EPS) - M0);
                    if (kg4 == 0) { l += p; pb[h * 64 + 32 * sb + 16 * tt + n16] = f2bf(p); } }
            }
            RAW_BAR_L();
            if (MODE < 4) { const int q4 = (F.lane & 15) >> 2, pp = F.lane & 3, kg = F.lane >> 4;
              const unsigned a_lo = (unsigned)(uintptr_t)(L + DB_LAT) + (unsigned)((8 * kg + q4) * DA_ROWB + (32 * h + 4 * pp) * 2);
              const LAS bf16* pap = pb + (F.lane & 15) * 64 + 8 * kg;
              s16x4 t0, t1, t2, t3, t4, t5, t6, t7;
              asm volatile("ds_read_b64_tr_b16 %0, %8 offset:%c9\n\tds_read_b64_tr_b16 %1, %8 offset:%c10\n\tds_read_b64_tr_b16 %2, %8 offset:%c11\n\tds_read_b64_tr_b16 %3, %8 offset:%c12\n\t"
                           "ds_read_b64_tr_b16 %4, %8 offset:%c13\n\tds_read_b64_tr_b16 %5, %8 offset:%c14\n\tds_read_b64_tr_b16 %6, %8 offset:%c15\n\tds_read_b64_tr_b16 %7, %8 offset:%c16\n\ts_waitcnt lgkmcnt(0)"
                           : "=&v"(t0), "=&v"(t1), "=&v"(t2), "=&v"(t3), "=&v"(t4), "=&v"(t5), "=&v"(t6), "=&v"(t7)
                           : "v"(a_lo), "i"(0), "i"(4 * DA_ROWB), "i"(32), "i"(32 + 4 * DA_ROWB), "i"(32 * DA_ROWB), "i"(32 * DA_ROWB + 4 * DA_ROWB), "i"(32 * DA_ROWB + 32), "i"(32 * DA_ROWB + 32 + 4 * DA_ROWB) : "memory");
              const bf16x8 pa0 = *(const LAS bf16x8*)(pap), pa1 = *(const LAS bf16x8*)(pap + 32);
#define DA_FR(x, y) ((bf16x8){x[0], x[1], x[2], x[3], y[0], y[1], y[2], y[3]})
              ao[0] = MFMA16(pa0, DA_FR(t0, t1), ao[0]); ao[1] = MFMA16(pa0, DA_FR(t2, t3), ao[1]);
              ao[0] = MFMA16(pa1, DA_FR(t4, t5), ao[0]); ao[1] = MFMA16(pa1, DA_FR(t6, t7), ao[1]);
#undef DA_FR
#define DA_PV(ks, nt) do { } while (0)
#undef DA_PV
            }
          }
            RAW_BAR_VL();
            if (hp + 1 < 64) { if (MODE <= 1 || MODE >= 3) da_convert(F, L); RAW_BAR_L(); if (hp + 2 < 64 && MODE < 3) da_issue(F, L, clat, ckr, ptab, b, split, hp + 2); }
        }
        if (MODE >= 3 && l == 123.456f) DPART[0] = l;
        if (MODE == 0) { const int kg = F.lane >> 4;
          if (kg < 2) {
#pragma unroll
              for (int nt = 0; nt < 2; ++nt)
#pragma unroll
                  for (int i = 0; i < 4; ++i) DPART[((size_t)((b * 2 + split) * NH + 4 * kg + i)) * 264 + 32 * h + 16 * nt + (F.lane & 15)] = ao[nt][i]; }
          float lt = wave_sum(l);
          if (F.lane == 0) DPART[((size_t)((b * 2 + split) * NH + h)) * 264 + 256] = lt; }
        RAW_BAR_L();
    }
}

__device__ __forceinline__ void p5_attn_decode(Frame& F, float M0) { p5_attn_decode_t<0>(F, M0); }

__device__ __forceinline__ void p6_decode_combine(Frame& F, float M0) {
    {
      const bf16* ATT = (const bf16*)(F.ws + WS_ATT); bf16* MIXo = (bf16*)(F.ws + WS_MIX); const float* mgg = (const float*)F.in[24];
      const f32x4 g0 = ((const f32x4*)mgg)[2 * F.lane], g1 = ((const f32x4*)mgg)[2 * F.lane + 1];
      for (int r0 = 4 * F.gw; r0 < MMAIN; r0 += 4 * F.NGW) { v4u xx[4];
#pragma unroll
          for (int i = 0; i < 4; ++i) { const int r = r0 + i; const size_t row = (size_t)(r >> 11) * TT + NMETA + (r & 2047); xx[i] = *(const v4u*)(ATT + row * 512 + 8 * F.lane); }
#pragma unroll
          for (int i = 0; i < 4; ++i) { const int r = r0 + i; const size_t row = (size_t)(r >> 11) * TT + NMETA + (r & 2047); const v4u x = xx[i];
          const float v[8] = {bflo(x.x), bfhi(x.x), bflo(x.y), bfhi(x.y), bflo(x.z), bfhi(x.z), bflo(x.w), bfhi(x.w)};
          float ss = 0.f;
#pragma unroll
          for (int e = 0; e < 8; ++e) ss += v[e] * v[e];
          const float rs = 1.0f / sqrtf(wave_sum(ss) * (1.f / MLAW) + EPS);
          v4u o; o.x = pk2(v[0] * rs * g0.x, v[1] * rs * g0.y); o.y = pk2(v[2] * rs * g0.z, v[3] * rs * g0.w); o.z = pk2(v[4] * rs * g1.x, v[5] * rs * g1.y); o.w = pk2(v[6] * rs * g1.z, v[7] * rs * g1.w);
          *(v4u*)(MIXo + row * 1024 + 512 + 8 * F.lane) = o; } } }
    const float* DPART = (const float*)(F.ws + WS_DPART); const bf16* WUKV = (const bf16*)(F.ws + WS_WUKV2); const bf16* Q = (const bf16*)(F.ws + WS_Q); const bf16* KS = (const bf16*)(F.ws + WS_KS);
    const float* VS = (const float*)(F.ws + WS_VS); const float* mg = (const float*)F.in[24]; bf16* MIX = (bf16*)(F.ws + WS_MIX);
    LAS float* accl = (LAS float*)(F.lds + RING_OFF) + F.wave * 256; LAS float* exch = (LAS float*)(F.lds + P5_EXCH);
    const int h = F.wave;
    for (int b = blockIdx.x; b < DB; b += F.G) {
        const float* p0 = DPART + ((size_t)((b * 2 + 0) * NH + h)) * 264; const float* p1 = DPART + ((size_t)((b * 2 + 1) * NH + h)) * 264;
#pragma unroll
        for (int k = 0; k < 4; ++k) accl[F.lane + 64 * k] = p0[F.lane + 64 * k] + p1[F.lane + 64 * k];
        float l = p0[256] + p1[256];
        const bf16* qp = Q + (size_t)(RP + b) * 768 + 96 * h; const bf16* kp = KS + (size_t)b * 768 + 96 * h;
        float sd = bf2f(qp[F.lane]) * bf2f(kp[F.lane]); if (F.lane < 32) sd += bf2f(qp[64 + F.lane]) * bf2f(kp[64 + F.lane]);
        sd = wave_sum(sd);
        const float pn = __builtin_amdgcn_exp2f(sd - M0); l += pn;
        LDS_WAIT(); asm volatile("" ::: "memory");
        const bf16* wv = WUKV + (size_t)(128 * h + 64 + F.lane) * KVL;
        float o = 0.f;
        { v4u wv4[32];
#pragma unroll
          for (int c8 = 0; c8 < 32; ++c8) wv4[c8] = *(const v4u*)(wv + 8 * c8);
#pragma unroll
          for (int c8 = 0; c8 < 32; ++c8) { const v4u w = wv4[c8]; const f32x4 x0 = *(const LAS f32x4*)(accl + 8 * c8), x1 = *(const LAS f32x4*)(accl + 8 * c8 + 4);
            o += (bflo(w.x) * x0.x + bfhi(w.x) * x0.y) + (bflo(w.y) * x0.z + bfhi(w.y) * x0.w) + (bflo(w.z) * x1.x + bfhi(w.z) * x1.y) + (bflo(w.w) * x1.z + bfhi(w.w) * x1.w); } }
        o = (o + pn * VS[(size_t)b * 512 + 64 * h + F.lane]) / l;
        const float ss = wave_sum(o * o);
        if (F.lane == 0) exch[h] = ss;
        __syncthreads();
        float tot = 0.f;
#pragma unroll
        for (int hh = 0; hh < NH; ++hh) tot += exch[hh];
        const float rs = 1.0f / sqrtf(tot * (1.f / MLAW) + EPS);
        MIX[(size_t)(RP + b) * 1024 + 512 + 64 * h + F.lane] = f2bf(o * rs * mg[64 * h + F.lane]);
        __syncthreads();
    }
}

__device__ __forceinline__ void p7_outproj(Frame& F) {
    const bf16* MIX = (const bf16*)(F.ws + WS_MIX); const bf16* WOUT = (const bf16*)(F.ws + WS_WOUT); const float* xp = (const float*)F.in[0]; const float* xs = (const float*)F.in[1]; float* HS = (float*)(F.ws + WS_HS);
    bf16* HB = (bf16*)(F.ws + WS_XN); float* SS = (float*)(F.ws + WS_SSP); float* ysamp = F.out + OUT_YS;
    { pg8::Gemm g{MIX, WOUT, MMAIN, DM, 1024, 1, 1024}; pg8::StaticOrder S; S.init(MMAIN, DM, F.G, (int)blockIdx.x); EpiOutProj E{xp, F.out + OUT_YP, HB, SS};
      pg8::gemm_phase<EpiOutProj, pg8::StaticOrder, true, true>(F.lds + RING_OFF, g, S, E); }
    { LAS f32x4* part = (LAS f32x4*)(F.lds + RING_OFF);
      for (int tp = blockIdx.x; tp < 256; tp += F.G) {
          const int t = 2 * tp + (F.wave >> 2), kq = F.wave & 3, rt = t & 7, ct = t >> 3;
          const bf16* ap = MIX + (size_t)(RP + rt * 16 + (F.lane & 15)) * 1024 + 256 * kq + 8 * (F.lane >> 4);
          const bf16* bp = WOUT + (size_t)(ct * 16 + (F.lane & 15)) * 1024 + 256 * kq + 8 * (F.lane >> 4);
          bf16x8 av[8], bv[8];
#pragma unroll
          for (int j = 0; j < 8; ++j) { av[j] = *(const bf16x8*)(ap + 32 * j); bv[j] = *(const bf16x8*)(bp + 32 * j); }
          f32x4 acc = {0.f, 0.f, 0.f, 0.f};
#pragma unroll
          for (int j = 0; j < 8; ++j) acc = MFMA16(av[j], bv[j], acc);
          part[F.wave * 64 + F.lane] = acc;
          __syncthreads();
          if (kq == 0) { acc = (acc + part[(F.wave + 1) * 64 + F.lane]) + (part[(F.wave + 2) * 64 + F.lane] + part[(F.wave + 3) * 64 + F.lane]);
              const int col = ct * 16 + (F.lane & 15);
#pragma unroll
              for (int i = 0; i < 4; ++i) { const int r = rt * 16 + 4 * (F.lane >> 4) + i; const size_t o = (size_t)r * DM + col; const float v = xs[o] + acc[i]; HS[o] = v; ysamp[o] = v; HB[(size_t)(RP + r) * DM + col] = f2bf(v);
                  float ss = v * v; ss += __shfl_xor(ss, 1); ss += __shfl_xor(ss, 2); ss += __shfl_xor(ss, 4); ss += __shfl_xor(ss, 8);
                  if ((F.lane & 15) == 0) SS[(size_t)MMAIN * 16 + (size_t)r * 64 + ct] = ss; } }
          __syncthreads();
      } }
}
__device__ __forceinline__ void p9_gateup(Frame& F) {
    const bf16* HB = (const bf16*)(F.ws + WS_XN); const bf16* WGU = (const bf16*)(F.ws + WS_WGU); bf16* ACT = (bf16*)(F.ws + WS_ACT); const float* SS = (const float*)(F.ws + WS_SSP);
    { pg8::Gemm g{HB, WGU, MMAIN, 2 * DFF, DM, 1, DM}; pg8::StaticOrder S; S.init(MMAIN, 2 * DFF, F.G, (int)blockIdx.x);
      LAS float* RS = (LAS float*)(F.lds + LDSCTL_OFF + 1024);
#pragma unroll 1
      for (int i = 0; i < 8; ++i) { pg8::Unit uu; if (!S.next(i, uu)) break;
          int tl = (int)threadIdx.x; asm volatile("" : "+v"(tl));
          if (tl < 256) { const pg8::f32x4* sp = (const pg8::f32x4*)(SS + (size_t)(uu.pm * 256 + tl) * 16); const pg8::f32x4 s4 = (sp[0] + sp[1]) + (sp[2] + sp[3]);
              RS[i * 256 + tl] = 1.0f / sqrtf(((s4[0] + s4[1]) + (s4[2] + s4[3])) * (1.f / DM) + EPS); } }
      __syncthreads();
      EpiSwiGLU E{ACT, RS, S};
      pg8::gemm_phase<EpiSwiGLU, pg8::StaticOrder, true, true>(F.lds + RING_OFF, g, S, E); }
    const int gw = F.gw, ngw = F.NGW;
    const int nrt = DB / 16, nlt = DFF / 16;
    for (int task = gw; task < nrt * nlt; task += ngw) {
        const int rt = task % nrt, lt = task / nrt; const int lc = lt * 16 + (F.lane & 15);
        const bf16* ap = HB + (size_t)(RP + rt * 16 + (F.lane & 15)) * DM + 8 * (F.lane >> 4);
        const bf16* gp = WGU + (size_t)(256 * (lc >> 7) + (lc & 127)) * DM + 8 * (F.lane >> 4); const bf16* up = gp + (size_t)128 * DM;
        f32x4 ag = {0.f, 0.f, 0.f, 0.f}, au = {0.f, 0.f, 0.f, 0.f};
#pragma unroll 8
        for (int k0 = 0; k0 < DM; k0 += 32) { const bf16x8 a = *(const bf16x8*)(ap + k0); ag = MFMA16(a, *(const bf16x8*)(gp + k0), ag); au = MFMA16(a, *(const bf16x8*)(up + k0), au); }
#pragma unroll
        for (int i = 0; i < 4; ++i) { const int r = rt * 16 + 4 * (F.lane >> 4) + i; const f32x4* sp = (const f32x4*)(SS + (size_t)MMAIN * 16 + (size_t)r * 64); f32x4 s4 = sp[0];
#pragma unroll
            for (int q = 1; q < 16; ++q) s4 += sp[q];
            const float rs = 1.0f / sqrtf(((s4[0] + s4[1]) + (s4[2] + s4[3])) * (1.f / DM) + EPS);
            ACT[(size_t)(RP + r) * DFF + lc] = f2bf(silu_f(rs * ag[i]) * (rs * au[i])); }
    }
}
__device__ __forceinline__ void p10_down(Frame& F) {
    const bf16* ACT = (const bf16*)(F.ws + WS_ACT); const bf16* WDN = (const bf16*)(F.ws + WS_WDN); const float* HS = (const float*)(F.ws + WS_HS);
    { pg8::Gemm g{ACT, WDN, MMAIN, DM, DFF, 1, DFF}; pg8::StaticOrder S; S.init(MMAIN, DM, F.G, (int)blockIdx.x); EpiDown E{(const bf16*)(F.ws + WS_XN), F.out + OUT_YP};
      pg8::gemm_phase<EpiDown, pg8::StaticOrder, true, true>(F.lds + RING_OFF, g, S, E); }
    float* ys = F.out + OUT_YS;
    small_gemm(ACT, DFF, WDN, DFF, DB / 16, DM / 16, [](int r) { return RP + r; },
        [&](const f32x4& acc, int rt, int ct, int lane) { const int col = ct * 16 + (lane & 15);
#pragma unroll
            for (int i = 0; i < 4; ++i) atomicAdd(ys + (size_t)(rt * 16 + 4 * (lane >> 4) + i) * DM + col, acc[i]); }, F.gw, F.NGW, F.lane, 4);
}
#ifndef MK_ONE_LAUNCH
#define MK_ONE_LAUNCH 0
#endif
constexpr int N_PHASES = 10;
__global__ void __launch_bounds__(NTHR, 2) mk_fwd(Args args) {
    extern __shared__ __attribute__((aligned(16))) unsigned char lds_raw[];
    Frame F;
    F.lds = (LAS unsigned char*)lds_raw;
    F.tid = threadIdx.x; F.lane = F.tid & 63; F.wave = __builtin_amdgcn_readfirstlane(F.tid >> 6);
    F.G = gridDim.x; { const int bx = blockIdx.x; F.vcu = (F.G % 8 == 0) ? (bx % 8) * (F.G / 8) + bx / 8 : bx; }
    F.gw = blockIdx.x * NWAVES + F.wave; F.NGW = F.G * NWAVES;
    F.ws = args.ws; F.out = args.out; F.in = args.in;
    volatile LAS unsigned* MISC = (volatile LAS unsigned*)(F.lds + MISC_OFF);
    for (int u = F.tid; u < (LDS_BYTES - LDSCTL_OFF) / 4; u += NTHR) ((LAS unsigned*)(F.lds + LDSCTL_OFF))[u] = 0u;
    __syncthreads();
    XcdBarrier bar; bar.bar = (unsigned*)(F.ws + WS_CTL) + CW_BAR; bar.x = 0; bar.st = nullptr;
    const int lo = args.ph_lo, hi = args.ph_hi;
    if (hi - lo > 1) bar = xcd_barrier_post((unsigned*)(F.ws + WS_CTL) + CW_BAR, MISC + 8);
#ifdef MK_TS
    unsigned long long* TSB = (unsigned long long*)(F.ws + 600 * MiB); int tsn = 0;
#define STAMP() do { if (blockIdx.x == 0 && F.tid == 0) TSB[tsn] = __builtin_amdgcn_s_memrealtime(); ++tsn; } while (0)
    STAMP();
#else
#define STAMP() do { } while (0)
#endif
#define IN(k) (lo <= (k) && (k) < hi)
#ifdef MK_TS
#define ARRIVE(k) do { if (blockIdx.x == 0 && F.tid == 0) TSB[30 + (k)] = __builtin_amdgcn_s_memrealtime(); } while (0)
#else
#define ARRIVE(k) do { } while (0)
#endif
#define SEAM(k) do { ARRIVE(k); if (IN(k) && IN((k) + 1)) xcd_barrier(bar); STAMP(); } while (0)
#ifndef MK_REPEAT
#define MK_REPEAT 0
#endif
#define REP(id, stmt) do { stmt; if (MK_REPEAT & (1 << (id))) { __syncthreads(); stmt; } } while (0)
    if (IN(0)) { REP(0, p0_prologue(F)); } SEAM(0);
    if (IN(1)) { REP(1, p1_inproj(F)); } SEAM(1);
    if (IN(2)) {
#ifdef MK_SLEEP_PROBE
        { const unsigned long long t0 = __builtin_amdgcn_s_memrealtime(); while (__builtin_amdgcn_s_memrealtime() - t0 < 3000ull) __builtin_amdgcn_s_sleep(32); }
#endif
        REP(2, p2_elementwise(F)); } SEAM(2);
    if (IN(3)) { REP(3, p3_upproj_states(F)); } SEAM(3);
    if (IN(4)) { REP(4, p4_post(F)); } SEAM(4);
    if (IN(5)) { const float M0 = softmax_ref(F);
        if (blockIdx.x & 1) { p5_attn_decode(F, M0); __syncthreads(); }
        p5_attn_prompt(F, M0); __syncthreads();
        p5_ssd_out(F); __syncthreads();
        if (!(blockIdx.x & 1)) p5_attn_decode(F, M0);
    } SEAM(5);
    if (IN(6)) { const float M0 = softmax_ref(F); REP(8, p6_decode_combine(F, M0)); } SEAM(6);
    if (IN(7)) { REP(9, p7_outproj(F)); } SEAM(7);
    if (IN(8)) { REP(11, p9_gateup(F)); } SEAM(8);
    if (IN(9)) { p10_down(F); }
#ifdef MK_TS
    __syncthreads(); STAMP();
#endif
#undef IN
#undef SEAM
}
#ifndef MK_DIAG
#define MK_DIAG 0
#endif
__device__ __forceinline__ size_t nmrow(size_t r) { return r < (size_t)MMAIN ? (r >> 11) * TT + NMETA + (r & 2047) : (size_t)RP + (r - MMAIN); }
constexpr size_t WS_OUT2 = 1024 * MiB;
#ifdef MK_TS
__global__ void k_ts_encode(const unsigned long long* ts, float* out, int ia0, int ia1, int ib0, int ib1) {
    const float ta = (float)(ts[ia1] - ts[ia0]) * 0.01f, tb = (float)(ts[ib1] - ts[ib0]) * 0.01f;
    const float f = 1.f + sqrtf(ta * 1e-3f);
    for (int i = blockIdx.x * blockDim.x + threadIdx.x; i < 131072; i += gridDim.x * blockDim.x) out[OUT_YS + i] *= f;
    if (blockIdx.x == 0 && threadIdx.x == 0) out[0] += tb * 0.1f;
}
#endif
extern "C" void kernel_launch(void* const* d_in, const int* in_sizes, int n_in, void* d_out, int out_size, void* d_ws, size_t ws_size, hipStream_t stream) {
    (void)hipFuncSetAttribute((const void*)mk_fwd, hipFuncAttributeMaxDynamicSharedMemorySize, LDS_BYTES);
    unsigned char* ws = (unsigned char*)d_ws;
    (void)hipMemsetAsync(ws + WS_CTL, 0, CTL_ZERO_BYTES, stream);
    Args a{};
    for (int i = 0; i < 30; ++i) a.in[i] = d_in[i];
    a.ws = ws; a.out = (float*)d_out;
#if MK_DIAG
    float* diag = (float*)(ws + WS_DIAG);
    (void)hipMemsetAsync(diag, 0, 512, stream);
    nv::forward(d_in, (float*)d_out, (float*)(ws + WS_NAIVE), stream);
    a.out = (float*)(ws + WS_OUT2);
#endif
    static int one_launch = -1;
    if (one_launch < 0) { int dev = 0, cus = 0, per_cu = 0; one_launch = 0;
        if (hipGetDevice(&dev) == hipSuccess && hipDeviceGetAttribute(&cus, hipDeviceAttributeMultiprocessorCount, dev) == hipSuccess && cus >= 256) one_launch = 1;
        (void)per_cu;
        (void)hipGetLastError(); }
    const int grid = 256;
    if (one_launch && MK_ONE_LAUNCH) { a.ph_lo = 0; a.ph_hi = N_PHASES; a.li = 0; hipLaunchKernelGGL(mk_fwd, dim3(grid), dim3(NTHR), LDS_BYTES, stream, a); }
    else for (int ph = 0; ph < N_PHASES; ++ph) { a.ph_lo = ph; a.ph_hi = ph + 1; a.li = ph; hipLaunchKernelGGL(mk_fwd, dim3(grid), dim3(NTHR), LDS_BYTES, stream, a); }
#ifdef MK_TS
    k_ts_encode<<<64, 256, 0, stream>>>((const unsigned long long*)(ws + 600 * MiB), (float*)d_out, MK_TS_A0, MK_TS_A1, MK_TS_B0, MK_TS_B1);
#endif
#if MK_DIAG
    {
        nv::Ws w = nv::carve((float*)(ws + WS_NAIVE));
        const bf16* QRAW = (const bf16*)(ws + WS_QRAW); const bf16* KVRAW = (const bf16*)(ws + WS_KVRAW); const bf16* Q = (const bf16*)(ws + WS_Q); const bf16* K = (const bf16*)(ws + WS_K);
        const bf16* VT = (const bf16*)(ws + WS_VT); const float* VS = (const float*)(ws + WS_VS); const bf16* MIX = (const bf16*)(ws + WS_MIX);
        const float* o2 = (const float*)(ws + WS_OUT2); const float* o1 = (const float*)d_out;
        const float* nQRAW = w.QRAW; const float* nKV = w.KV; const float* nQ = w.Q; const float* nK = w.K; const float* nV = w.V; const float* nMIX = w.MIX;
        const size_t NMR = (size_t)MMAIN + DB;
        cmp(stream, 0, diag, NMR * 768, [=] __device__(size_t i) { return bf2f(QRAW[nmrow(i / 768) * 768 + i % 768]); }, [=] __device__(size_t i) { return nQRAW[nmrow(i / 768) * 768 + i % 768]; });
        cmp(stream, 1, diag, (size_t)R * 1024, [=] __device__(size_t i) { return bf2f(KVRAW[i]); }, [=] __device__(size_t i) { return nKV[i]; });
        cmp(stream, 2, diag, NMR * 768, [=] __device__(size_t i) { return bf2f(Q[nmrow(i / 768) * 768 + i % 768]); }, [=] __device__(size_t i) { return nQ[nmrow(i / 768) * 768 + i % 768] * (ATTN_SCALE * LOG2E); });
        cmp(stream, 3, diag, (size_t)R * 768, [=] __device__(size_t i) { return bf2f(K[i]); }, [=] __device__(size_t i) { return nK[i]; });
        cmp(stream, 4, diag, (size_t)NB * 512 * TT, [=] __device__(size_t i) { const size_t bhd = i / TT; const int t = (int)(i % TT); return bf2f(VT[bhd * TPAD + t]); },
            [=] __device__(size_t i) { const size_t bhd = i / TT; const int t = (int)(i % TT); const size_t b = bhd / 512, hd = bhd % 512; return nV[(b * TT + t) * 512 + hd]; });
        cmp(stream, 4, diag, (size_t)DB * 512, [=] __device__(size_t i) { return VS[i]; }, [=] __device__(size_t i) { return nV[(size_t)RP * 512 + i]; });
        cmp(stream, 5, diag, (size_t)(OUT_LATS - OUT_SSMP), [=] __device__(size_t i) { return o2[OUT_SSMP + i]; }, [=] __device__(size_t i) { return o1[OUT_SSMP + i]; });
        cmp(stream, 5, diag, (size_t)4194304, [=] __device__(size_t i) { return o2[OUT_SSMS + i]; }, [=] __device__(size_t i) { return o1[OUT_SSMS + i]; });
        cmp(stream, 6, diag, (size_t)R * 512, [=] __device__(size_t i) { return bf2f(MIX[(i >> 9) * 1024 + (i & 511)]); }, [=] __device__(size_t i) { return nMIX[(i >> 9) * 1024 + (i & 511)]; });
        cmp(stream, 7, diag, NMR * 512, [=] __device__(size_t i) { return bf2f(MIX[nmrow(i >> 9) * 1024 + 512 + (i & 511)]); }, [=] __device__(size_t i) { return nMIX[nmrow(i >> 9) * 1024 + 512 + (i & 511)]; });
        cmp(stream, 8, diag, (size_t)OUT_LATP, [=] __device__(size_t i) { return o2[i]; }, [=] __device__(size_t i) { return o1[i]; });
        k_diag_encode<<<64, 256, 0, stream>>>(diag, 9, 1e-3f, (float*)d_out);
    }
#endif
}
```

```cpp
#define MK_DIAG 0
#define MK_ONE_LAUNCH 1
#include <hip/hip_runtime.h>
#include <cstdio>
#include <cstdint>
namespace pg8 {
#define PG8_LAS __attribute__((address_space(3)))
typedef unsigned short bf16_t;
typedef short bf16x8 __attribute__((ext_vector_type(8)));
typedef float f32x4 __attribute__((ext_vector_type(4)));
typedef unsigned u32x4 __attribute__((ext_vector_type(4)));
constexpr int BM = 256, BK = 64, HALF = 128, HTB = HALF * BK * 2  , STAGE_BYTES = 8 * HTB, NXCD = 8, WGM = 8;

__host__ __device__ __forceinline__ int lds_byte(int r, int c) { const int st = (r >> 4) * 2 + (c >> 5), rr = r & 15, cc = c & 31, ob = rr * 64 + cc * 2; return st * 1024 + (ob ^ (((ob >> 9) & 1) << 5)); }
__host__ __device__ __forceinline__ void stage_rc(int b, int& R, int& C) { const int st = b / 1024, sb = b % 1024, swz = sb ^ (((sb >> 9) & 1) << 5); R = (st >> 1) * 16 + swz / 64; C = (st & 1) * 32 + (swz % 64) / 2; }
__host__ __device__ __forceinline__ int perm32(int rho) { const int n = rho >> 4, i = rho & 15; return 8 * (i >> 2) + 4 * n + (i & 3); }

struct Unit { int pm, pn; };
struct Gemm { const bf16_t* A; const bf16_t* Bt; int M, N, K; int rmode; int lda;
    __host__ __device__ __forceinline__ int rowbase(int pm) const { return rmode ? (pm >> 3) * 2064 + 16 + (pm & 7) * 256 : pm * 256; } };

struct StaticOrder {
    int nM, nN, nwg, G, c;
    __host__ __device__ void init(int M, int N, int G_, int c_) { nM = M / BM; nN = N / BM; nwg = nM * nN; G = G_; c = c_; }
    __host__ __device__ bool next(int i, Unit& u) const {
        const long L = (long)i * G + c; if (L >= nwg) return false;
        int wgid = (int)L; { const int q = nwg / NXCD, r = nwg % NXCD, xcd = wgid % NXCD, off = wgid / NXCD; wgid = (xcd < r ? xcd * (q + 1) : r * (q + 1) + (xcd - r) * q) + off; }
        const int nig = WGM * nN, gid = wgid / nig, fm = gid * WGM, gsz = (nM - fm) < WGM ? (nM - fm) : WGM;
        u.pm = fm + ((wgid % nig) % gsz); u.pn = (wgid % nig) / gsz; return true;
    }
    __device__ __forceinline__ void a_ready(const Unit&) const {}
    __device__ __forceinline__ void done(const Unit&) const {}
};


template <class Epi, class Sched, bool ALIGN_EPI = false, bool SP2 = false>
__device__ __forceinline__ void gemm_phase(PG8_LAS unsigned char* lds, const Gemm g, const Sched& S, const Epi& E) {
    const int tid = threadIdx.x, wid = __builtin_amdgcn_readfirstlane(tid >> 6), lane = tid & 63, wr = wid >> 2, wc = wid & 3, fr = lane & 15, fq = lane >> 4;
    const int K = g.K, nt = K / BK;
    unsigned voffA[2], voffB[2];
#pragma unroll
    for (int i = 0; i < 2; ++i) { int R, C; stage_rc(tid * 16 + i * 8192, R, C); const int Rb = Epi::PERM ? ((R & ~31) + perm32(R & 31)) : R;
        voffA[i] = (unsigned)(R * g.lda + C) * 2u; voffB[i] = (unsigned)(Rb * K + C) * 2u; }
    const size_t kstep = (size_t)(BK * 2);
    const size_t hstepA = (size_t)HALF * g.lda * 2;
    const size_t hstep = (size_t)HALF * K * 2;
    const size_t tstep = 2 * hstep;
    const unsigned ldsw = (unsigned)wid * 1024u;
    const int aoff = lds_byte(wr * 64 + fr, fq * 8), boff = lds_byte(wc * 32 + fr, fq * 8);
#define PG8_SA(b, h) (((b) * 2 + (h)) * HTB)
#define PG8_SB(b, h) ((4 + (b) * 2 + (h)) * HTB)
#define PG8_STAGE(bufoff, gbase, voff) do { _Pragma("unroll") for (int _i = 0; _i < 2; ++_i) \
        __builtin_amdgcn_global_load_lds((const unsigned*)((const char*)(gbase) + (voff)[_i]), (PG8_LAS unsigned*)(lds + (bufoff) + ldsw + _i * 8192), 16, 0, 0); } while (0)
#define PG8_LDA(dst, b, h) do { _Pragma("unroll") for (int m = 0; m < 4; ++m) _Pragma("unroll") for (int k = 0; k < 2; ++k) dst[m][k] = *(const PG8_LAS bf16x8*)(lds + PG8_SA(b, h) + aoff + m * 2048 + k * 1024); } while (0)
#define PG8_LDB(dst, b, h) do { _Pragma("unroll") for (int n = 0; n < 2; ++n) _Pragma("unroll") for (int k = 0; k < 2; ++k) dst[n][k] = *(const PG8_LAS bf16x8*)(lds + PG8_SB(b, h) + boff + n * 2048 + k * 1024); } while (0)
#define PG8_MMA(ai, bj, At, Bt) do { __builtin_amdgcn_s_setprio(1); _Pragma("unroll") for (int m = 0; m < 4; ++m) _Pragma("unroll") for (int n = 0; n < 2; ++n) _Pragma("unroll") for (int k = 0; k < 2; ++k) \
        acc[ai][bj][m][n] = __builtin_amdgcn_mfma_f32_16x16x32_bf16(Bt[n][k], At[m][k], acc[ai][bj][m][n], 0, 0, 0); __builtin_amdgcn_s_setprio(0); } while (0)
#define PG8_WAIT_V(n) asm volatile("s_waitcnt vmcnt(" #n ")" ::: "memory")
#define PG8_WAIT_L(n) asm volatile("s_waitcnt lgkmcnt(" #n ")" ::: "memory")
#define PG8_BAR __builtin_amdgcn_s_barrier()
#define PG8_SCHED __builtin_amdgcn_sched_barrier(0)
    Unit cur, nxt; int ui = 0;
    if (!S.next(0, cur)) return;
    f32x4 acc[2][2][4][2];
#pragma unroll
    for (int a = 0; a < 2; ++a)
#pragma unroll
        for (int b = 0; b < 2; ++b)
#pragma unroll
            for (int m = 0; m < 4; ++m)
#pragma unroll
                for (int n = 0; n < 2; ++n) acc[a][b][m][n] = (f32x4){0.f, 0.f, 0.f, 0.f};
    bf16x8 At[4][2], B0[2][2], B1[2][2];
    const char* cA = (const char*)g.A + (size_t)g.rowbase(cur.pm) * g.lda * 2; const char* cB = (const char*)g.Bt + (size_t)cur.pn * tstep;
    S.a_ready(cur);
    if constexpr (SP2) {
        PG8_STAGE(PG8_SB(0, 0), cB, voffB); PG8_STAGE(PG8_SB(0, 1), cB + hstep, voffB); PG8_STAGE(PG8_SA(0, 0), cA, voffA); PG8_STAGE(PG8_SA(0, 1), cA + hstepA, voffA);
        if (wr == 1) PG8_BAR;
        PG8_WAIT_V(2); PG8_BAR;
        PG8_STAGE(PG8_SB(1, 0), cB + kstep, voffB); PG8_STAGE(PG8_SA(1, 0), cA + kstep, voffA); PG8_STAGE(PG8_SB(1, 1), cB + hstep + kstep, voffB);
        PG8_WAIT_V(6); PG8_BAR;
    } else {
        PG8_STAGE(PG8_SB(0, 0), cB, voffB); PG8_STAGE(PG8_SA(0, 0), cA, voffA); PG8_STAGE(PG8_SB(0, 1), cB + hstep, voffB); PG8_STAGE(PG8_SA(0, 1), cA + hstepA, voffA);
        if (wr == 1) PG8_BAR;
        PG8_WAIT_V(4); PG8_BAR;
        PG8_STAGE(PG8_SB(1, 0), cB + kstep, voffB); PG8_STAGE(PG8_SA(1, 0), cA + kstep, voffA); PG8_STAGE(PG8_SB(1, 1), cB + hstep + kstep, voffB);
        PG8_WAIT_V(6); PG8_BAR;
    }
    for (;;) {
        const bool has_next = S.next(ui + 1, nxt);
        const char* nA = has_next ? (const char*)g.A + (size_t)g.rowbase(nxt.pm) * g.lda * 2 : cA; const char* nB = has_next ? (const char*)g.Bt + (size_t)nxt.pn * tstep : cB;
        for (int t = 0; t < nt; t += 2) {
            const bool last = (t == nt - 2);
            const char* a1 = cA + (size_t)(t + 1) * kstep;
            const char* a2 = last ? nA : cA + (size_t)(t + 2) * kstep; const char* b2 = last ? nB : cB + (size_t)(t + 2) * kstep;
            const char* a3 = a2 + kstep; const char* b3 = b2 + kstep;
            if (last && has_next) S.a_ready(nxt);
            if constexpr (SP2) {
            PG8_LDB(B0, 0, 0); PG8_LDB(B1, 0, 1); PG8_SCHED; PG8_LDA(At, 0, 0); PG8_STAGE(PG8_SA(1, 1), a1 + hstepA, voffA);
            PG8_WAIT_V(8); PG8_WAIT_L(0); PG8_BAR; PG8_MMA(0, 0, At, B0); PG8_MMA(0, 1, At, B1); PG8_BAR; PG8_SCHED;
            PG8_LDA(At, 0, 1); PG8_STAGE(PG8_SB(0, 0), b2, voffB); PG8_STAGE(PG8_SB(0, 1), b2 + hstep, voffB); PG8_STAGE(PG8_SA(0, 0), a2, voffA);
            PG8_WAIT_V(8); PG8_WAIT_L(0); PG8_BAR; PG8_MMA(1, 0, At, B0); PG8_MMA(1, 1, At, B1); PG8_BAR; PG8_SCHED;
            PG8_LDB(B0, 1, 0); PG8_LDB(B1, 1, 1); PG8_SCHED; PG8_LDA(At, 1, 0); PG8_STAGE(PG8_SA(0, 1), a2 + hstepA, voffA);
            PG8_WAIT_V(8); PG8_WAIT_L(0); PG8_BAR; PG8_MMA(0, 0, At, B0); PG8_MMA(0, 1, At, B1); PG8_BAR; PG8_SCHED;
            PG8_LDA(At, 1, 1); PG8_STAGE(PG8_SB(1, 0), b3, voffB); PG8_STAGE(PG8_SB(1, 1), b3 + hstep, voffB); PG8_STAGE(PG8_SA(1, 0), a3, voffA);
            PG8_WAIT_V(8); PG8_WAIT_L(0); PG8_BAR; PG8_MMA(1, 0, At, B0); PG8_MMA(1, 1, At, B1); PG8_BAR; PG8_SCHED;
            } else {
            PG8_LDB(B0, 0, 0); PG8_SCHED; PG8_LDA(At, 0, 0); PG8_STAGE(PG8_SA(1, 1), a1 + hstepA, voffA);
            PG8_WAIT_L(8); PG8_BAR; PG8_WAIT_L(0); PG8_MMA(0, 0, At, B0); PG8_BAR; PG8_SCHED;
            PG8_LDB(B1, 0, 1); PG8_STAGE(PG8_SB(0, 0), b2, voffB);
            PG8_BAR; PG8_WAIT_L(0); PG8_MMA(0, 1, At, B1); PG8_BAR;
            PG8_LDA(At, 0, 1); PG8_STAGE(PG8_SA(0, 0), a2, voffA);
            PG8_BAR; PG8_WAIT_L(0); PG8_MMA(1, 0, At, B0); PG8_BAR; PG8_SCHED;
            PG8_STAGE(PG8_SB(0, 1), b2 + hstep, voffB);
            PG8_WAIT_V(6); PG8_BAR; PG8_MMA(1, 1, At, B1); PG8_BAR;
            PG8_LDB(B0, 1, 0); PG8_SCHED; PG8_LDA(At, 1, 0); PG8_STAGE(PG8_SA(0, 1), a2 + hstepA, voffA);
            PG8_WAIT_L(8); PG8_BAR; PG8_WAIT_L(0); PG8_MMA(0, 0, At, B0); PG8_BAR; PG8_SCHED;
            PG8_LDB(B1, 1, 1); PG8_STAGE(PG8_SB(1, 0), b3, voffB);
            PG8_BAR; PG8_WAIT_L(0); PG8_MMA(0, 1, At, B1); PG8_BAR;
            PG8_LDA(At, 1, 1); PG8_STAGE(PG8_SA(1, 0), a3, voffA);
            PG8_BAR; PG8_WAIT_L(0); PG8_MMA(1, 0, At, B0); PG8_BAR; PG8_SCHED;
            PG8_STAGE(PG8_SB(1, 1), b3 + hstep, voffB);
            PG8_WAIT_V(6); PG8_BAR; PG8_MMA(1, 1, At, B1); PG8_BAR;
            }
        }
        if constexpr (ALIGN_EPI) { if (wr == 0) PG8_BAR; }
        if constexpr (!Epi::AFTER_DRAIN) { E(acc, cur, wr, wc, fr, fq); S.done(cur); }
        if (!has_next) break;
#pragma unroll
        for (int a = 0; a < 2; ++a)
#pragma unroll
            for (int b = 0; b < 2; ++b)
#pragma unroll
                for (int m = 0; m < 4; ++m)
#pragma unroll
                    for (int n = 0; n < 2; ++n) acc[a][b][m][n] = (f32x4){0.f, 0.f, 0.f, 0.f};
        cur = nxt; cA = nA; cB = nB; ++ui;
        if constexpr (ALIGN_EPI) { if (wr == 1) PG8_BAR; }
    }
    PG8_WAIT_V(0);
    if constexpr (!ALIGN_EPI) { if (wr == 0) PG8_BAR; }
    PG8_BAR;
    if constexpr (Epi::AFTER_DRAIN) { E.fused(acc, cur, wr, wc, fr, fq, lds, wid, lane); S.done(cur); }
#undef PG8_SA
#undef PG8_SB
#undef PG8_STAGE
#undef PG8_LDA
#undef PG8_LDB
#undef PG8_MMA
#undef PG8_WAIT_V
#undef PG8_WAIT_L
#undef PG8_BAR
#undef PG8_SCHED
}
}

#define GAS __attribute__((address_space(1)))
#define LAS __attribute__((address_space(3)))
typedef unsigned short bf16;
typedef unsigned v4u __attribute__((ext_vector_type(4)));
typedef unsigned v2u __attribute__((ext_vector_type(2)));
typedef float f32x4 __attribute__((ext_vector_type(4)));
typedef float f32x16 __attribute__((ext_vector_type(16)));
typedef short bf16x8 __attribute__((ext_vector_type(8)));
typedef short s16x4 __attribute__((ext_vector_type(4)));
typedef GAS unsigned gu32;
#define RLX_AGENT __ATOMIC_RELAXED, __HIP_MEMORY_SCOPE_AGENT
#define LDS_WAIT() asm volatile("s_waitcnt lgkmcnt(0)" ::: "memory")
#define VM_WAIT() asm volatile("s_waitcnt vmcnt(0)" ::: "memory")
typedef float f32x2_t __attribute__((ext_vector_type(2))); typedef __bf16 bf16x2_t __attribute__((ext_vector_type(2)));
__device__ __forceinline__ unsigned pk2(float lo, float hi) { f32x2_t v = {lo, hi}; bf16x2_t b = __builtin_convertvector(v, bf16x2_t); return __builtin_bit_cast(unsigned, b); }
__device__ __forceinline__ bf16 f2bf(float f) { return (bf16)(pk2(f, 0.f) & 0xffffu); }
__device__ __forceinline__ float bf2f(bf16 v) { return __uint_as_float((unsigned)v << 16); }
__device__ __forceinline__ float bflo(unsigned w) { return __uint_as_float(w << 16); }
__device__ __forceinline__ float bfhi(unsigned w) { return __uint_as_float(w & 0xffff0000u); }

#define XB_TMO      128
#define XB_XCNT(j)  (256  + 64 * (j))
#define XB_XSUB(j)  (1280 + 64 * (j))
#define XB_XGEN(j)  (2304 + 64 * (j))
#define XB_TOP      3328
#define XB_TOPGEN   3392
#define XCD_BAR_WORDS 3456
#define XB_SPIN_CAP (1u << 18)
__device__ __forceinline__ unsigned xb_ld(unsigned* p)              { return __hip_atomic_load(p, __ATOMIC_RELAXED, __HIP_MEMORY_SCOPE_AGENT); }
__device__ __forceinline__ unsigned xb_add(unsigned* p, unsigned v) { return __hip_atomic_fetch_add(p, v, __ATOMIC_RELAXED, __HIP_MEMORY_SCOPE_AGENT); }
__device__ __forceinline__ unsigned xb_xcc_id() { return (unsigned)__builtin_amdgcn_s_getreg((3 << 11) | 20) & 0xFu; }
#define XB_SPIN(cond, bar) do { unsigned _sp = 0; while (cond) { __builtin_amdgcn_s_sleep(1); \
    if ((++_sp & 255u) == 0u) { if (xb_ld(&(bar)[XB_TMO])) break; if (_sp > XB_SPIN_CAP) { atomicAdd(&(bar)[XB_TMO], 1u); break; } } } } while (0)
struct XcdBarrier { unsigned* bar; unsigned x; volatile LAS unsigned* st; };
__device__ __forceinline__ XcdBarrier xcd_barrier_post(unsigned* bar, volatile LAS unsigned* st) {
    XcdBarrier b; b.bar = bar; b.x = xb_xcc_id(); b.st = st;
    if (threadIdx.x == 0) (void)xb_add(&bar[XB_XCNT(b.x)], 1u);
    return b;
}
__device__ __forceinline__ void xcd_barrier_complete(unsigned* bar, unsigned x, unsigned& nloc, unsigned& nx) {
    const unsigned G = gridDim.x * gridDim.y * gridDim.z;
    unsigned sum, cnt, mine, sp = 0u;
    for (;;) {
        sum = 0u; cnt = 0u; mine = 0u;
#pragma unroll
        for (unsigned j = 0; j < 16; ++j) { const unsigned c = xb_ld(&bar[XB_XCNT(j)]); sum += c; cnt += (c > 0u) ? 1u : 0u; mine = (j == x) ? c : mine; }
        if (sum == G) break;
        __builtin_amdgcn_s_sleep(1);
        if ((++sp & 255u) == 0u) { if (xb_ld(&bar[XB_TMO])) break; if (sp > XB_SPIN_CAP) { atomicAdd(&bar[XB_TMO], 1u); break; } }
    }
    nloc = mine > 0u ? mine : 1u; nx = cnt > 0u ? cnt : 1u;
}
__device__ __forceinline__ void xcd_barrier(const XcdBarrier& b) {
    asm volatile("s_waitcnt vmcnt(0)" ::: "memory");
    __syncthreads();
    if (threadIdx.x == 0) {
        unsigned* bar = b.bar;
        __builtin_amdgcn_s_waitcnt(0);
        unsigned nloc = b.st[0], nx = b.st[1];
        if (nloc == 0u) { xcd_barrier_complete(bar, b.x, nloc, nx); b.st[0] = nloc; b.st[1] = nx; }
        const unsigned old = xb_add(&bar[XB_XSUB(b.x)], 1u);
        const unsigned gen = old / nloc;
        if (old + 1u == (gen + 1u) * nloc) {
            __builtin_amdgcn_fence(__ATOMIC_RELEASE, "agent");
            asm volatile("s_waitcnt vmcnt(0)" ::: "memory");
            const unsigned og = xb_add(&bar[XB_TOP], 1u);
            const unsigned tg = og / nx;
            if (og + 1u == (tg + 1u) * nx) xb_add(&bar[XB_TOPGEN], 1u);
            else XB_SPIN(xb_ld(&bar[XB_TOPGEN]) == tg, bar);
            __builtin_amdgcn_fence(__ATOMIC_ACQUIRE, "agent");
            xb_add(&bar[XB_XGEN(b.x)], 1u);
            asm volatile("s_waitcnt vmcnt(0)" ::: "memory");
        } else {
            XB_SPIN(xb_ld(&bar[XB_XGEN(b.x)]) == gen, bar);
            __builtin_amdgcn_fence(__ATOMIC_ACQUIRE, "agent");
            asm volatile("s_waitcnt vmcnt(0)" ::: "memory");
        }
    }
    __syncthreads();
}

constexpr int DM = 1024, NB = 8, SEQ = 2048, NMETA = 16, TT = SEQ + NMETA;
constexpr int DB = 128, PAST = 8192, PAGE = 128, NPAGES = 64;
constexpr int NH = 8, HP = 64, SSDW = 512, NG = 2, DS = 64, CONVD = 768;
constexpr int QKD = 96, VD = 64, MLAW = 512, QL = 384, KVL = 256, DFF = 2816, INC = 1960;
constexpr int RP = NB * TT, R = RP + DB;
constexpr int MMAIN = NB * SEQ;
constexpr int NS = NMETA + DB;
constexpr float EPS = 1e-6f, ATTN_SCALE = 0.10206207261596577f, LOG2E = 1.4426950408889634f;
constexpr int PJ = 2048, C_Z = 0, C_XBC = 512, C_CKV = 1280, C_CQ = 1536, C_DT = 1920, C_KR = 1928;
constexpr int S_Z = 0, S_XBC = 512, S_DT = 1280, S_CQ = 1288, S_CKV = 1672, S_KR = 1928;
constexpr int TPAD = 2112;
constexpr int NCH = 33, CHL = 64, TOFF = 48;
constexpr size_t OUT_YP = 0, OUT_YS = 16777216, OUT_LATP = 16908288, OUT_KRP = 21135360, OUT_CONVP = 21663744,
                 OUT_SSMP = 21682176, OUT_LATS = 21944320, OUT_KRS = 21977088, OUT_CONVS = 21981184, OUT_SSMS = 22276096;

constexpr size_t MiB = 1u << 20;
constexpr size_t WS_CTL = 0, CTL_ZERO_BYTES = 32 * 1024;
constexpr int CW_BAR = 4096;
constexpr size_t WS_SS = 512 * 1024;
constexpr size_t WS_WIN = 2 * MiB;
constexpr size_t WS_WUQ = 6 * MiB;
constexpr size_t WS_WUKV = 7 * MiB;
constexpr size_t WS_WOUT = 8 * MiB;
constexpr size_t WS_WGU = 10 * MiB;
constexpr size_t WS_WDN = 22 * MiB;
constexpr size_t WS_XN = 32 * MiB;
constexpr size_t WS_PROJ = 66 * MiB;
constexpr size_t WS_DTRAW = 132 * MiB;
constexpr size_t WS_DT = 133 * MiB;
constexpr size_t WS_LAT = 134 * MiB;
constexpr size_t WS_CQN = 143 * MiB;
constexpr size_t WS_KRF = 156 * MiB;
constexpr size_t WS_XST = 159 * MiB;
constexpr size_t WS_BT = 176 * MiB;
constexpr size_t WS_BC = 181 * MiB;
constexpr size_t WS_XAS = 190 * MiB;
constexpr size_t WS_QRAW = 191 * MiB;
constexpr size_t WS_KVRAW = 216 * MiB;
constexpr size_t WS_Q = 249 * MiB;
constexpr size_t WS_K = 274 * MiB;
constexpr size_t WS_VT = 299 * MiB;
constexpr size_t WS_STATES = 316 * MiB;
constexpr size_t WS_DECAY = 350 * MiB;
constexpr size_t WS_HIN = 351 * MiB;
constexpr size_t WS_MIX = 368 * MiB;
constexpr size_t WS_ACT = 401 * MiB;
constexpr size_t WS_VS = 491 * MiB;
constexpr size_t WS_DPART = 492 * MiB;
constexpr size_t WS_HS = 494 * MiB;
constexpr size_t WS_ROPE = 496 * MiB;
constexpr size_t WS_SSP = 520 * MiB;
constexpr size_t WS_WUKV2 = 524 * MiB;
constexpr size_t WS_RQ = 522 * MiB;
constexpr size_t WS_OPT_END = 525 * MiB;
constexpr size_t WS_NAIVE = 2048 * MiB;
constexpr size_t WS_DIAG = 1 * MiB;

constexpr int RING_OFF = 0, RING_BYTES = 131072;
constexpr int LDSCTL_OFF = RING_BYTES, MISC_OFF = LDSCTL_OFF + 320;
constexpr int LDS_BYTES = 163840;
constexpr int NWAVES = 8, NTHR = 512;

struct Args { const void* in[30]; float* out; unsigned char* ws; int ph_lo, ph_hi, li, pad; };

struct Frame {
    LAS unsigned char* lds;
    int tid, lane, wave, G, vcu, gw, NGW;
    unsigned char* ws; float* out;
    const void* const* in;
};
#define DPP_F(x, ctrl) __builtin_bit_cast(float, __builtin_amdgcn_update_dpp(0, __builtin_bit_cast(int, (x)), (ctrl), 0xF, 0xF, true))
__device__ __forceinline__ float sum_x1(float x) { return x + DPP_F(x, 0xB1); }
__device__ __forceinline__ float sum_x2(float x) { return x + DPP_F(x, 0x4E); }
__device__ __forceinline__ float sum_x4(float x) { return x + DPP_F(x, 0x141); }
__device__ __forceinline__ float sum_x8(float x) { return x + DPP_F(x, 0x140); }
__device__ __forceinline__ float sum_x16(float x) { const unsigned u = __builtin_bit_cast(unsigned, x); const auto r = __builtin_amdgcn_permlane16_swap(u, u, false, false); return __uint_as_float(r[0]) + __uint_as_float(r[1]); }
__device__ __forceinline__ float sum_x32(float x) { const unsigned u = __builtin_bit_cast(unsigned, x); const auto r = __builtin_amdgcn_permlane32_swap(u, u, false, false); return __uint_as_float(r[0]) + __uint_as_float(r[1]); }
__device__ __forceinline__ float wave_sum(float v) { return sum_x32(sum_x16(sum_x8(sum_x4(sum_x2(sum_x1(v)))))); }
__device__ __forceinline__ float wave_max(float v) {
#pragma unroll
    for (int o = 1; o < 64; o <<= 1) v = fmaxf(v, __shfl_xor(v, o));
    return v;
}
__device__ __forceinline__ float silu_f(float x) { return x * __builtin_amdgcn_rcpf(1.f + __expf(-x)); }
__device__ __forceinline__ float softplus_f(float x) { return fmaxf(x, 0.f) + log1pf(expf(-fabsf(x))); }
__device__ __forceinline__ float rope_inv(int j) { return exp2f(-(float)j * (13.287712379549449f / 16.0f)); }
struct EpiProj {
    static constexpr bool PERM = true, AFTER_DRAIN = false;
    bf16* O; float* dtraw; int rmode;
    __device__ __forceinline__ void operator()(const pg8::f32x4 (&acc)[2][2][4][2], const pg8::Unit& u, int wr, int wc, int fr, int fq) const {
        const int rb = rmode ? (u.pm >> 3) * 2064 + 16 + (u.pm & 7) * 256 : u.pm * 256;
        const int row0 = rb + wr * 64 + fr, col0 = u.pn * 256 + wc * 32 + 8 * fq;
#pragma unroll
        for (int ai = 0; ai < 2; ++ai)
#pragma unroll
            for (int m = 0; m < 4; ++m) { const int row = row0 + ai * 128 + m * 16; bf16* rowp = O + (size_t)row * PJ + col0;
#pragma unroll
                for (int bj = 0; bj < 2; ++bj) { const pg8::f32x4 v0 = acc[ai][bj][m][0], v1 = acc[ai][bj][m][1];
                    v4u w; w.x = pk2(v0[0], v0[1]); w.y = pk2(v0[2], v0[3]); w.z = pk2(v1[0], v1[1]); w.w = pk2(v1[2], v1[3]);
                    *(v4u*)(rowp + bj * 128) = w; }
                if (u.pn == 7 && wc == 0 && fq == 0) { *(pg8::f32x4*)(dtraw + (size_t)row * 8) = acc[ai][1][m][0]; *(pg8::f32x4*)(dtraw + (size_t)row * 8 + 4) = acc[ai][1][m][1]; } }
    }
};
struct EpiBf16 {
    static constexpr bool PERM = true, AFTER_DRAIN = false;
    bf16* O; int ldc; int rmode;
    __device__ __forceinline__ void operator()(const pg8::f32x4 (&acc)[2][2][4][2], const pg8::Unit& u, int wr, int wc, int fr, int fq) const {
        const int rb = rmode ? (u.pm >> 3) * 2064 + 16 + (u.pm & 7) * 256 : u.pm * 256;
        const int row0 = rb + wr * 64 + fr, col0 = u.pn * 256 + wc * 32 + 8 * fq;
#pragma unroll
        for (int ai = 0; ai < 2; ++ai)
#pragma unroll
            for (int m = 0; m < 4; ++m) { bf16* rowp = O + (size_t)(row0 + ai * 128 + m * 16) * ldc + col0;
#pragma unroll
                for (int bj = 0; bj < 2; ++bj) { const pg8::f32x4 v0 = acc[ai][bj][m][0], v1 = acc[ai][bj][m][1];
                    v4u w; w.x = pk2(v0[0], v0[1]); w.y = pk2(v0[2], v0[3]); w.z = pk2(v1[0], v1[1]); w.w = pk2(v1[2], v1[3]);
                    *(v4u*)(rowp + bj * 128) = w; } }
    }
};
struct EpiResF32 {
    static constexpr bool PERM = false, AFTER_DRAIN = false;
    const float* res; float* out;
    __device__ __forceinline__ void operator()(const pg8::f32x4 (&acc)[2][2][4][2], const pg8::Unit& u, int wr, int wc, int fr, int fq) const {
        const int row0 = u.pm * 256 + wr * 64 + fr, col0 = u.pn * 256 + wc * 32 + 4 * fq;
#pragma unroll
        for (int ai = 0; ai < 2; ++ai)
#pragma unroll
            for (int m = 0; m < 4; ++m) { const size_t off = (size_t)(row0 + ai * 128 + m * 16) * DM + col0;
#pragma unroll
                for (int bj = 0; bj < 2; ++bj)
#pragma unroll
                    for (int n = 0; n < 2; ++n) { const pg8::f32x4 r = *(const pg8::f32x4*)(res + off + bj * 128 + n * 16); *(pg8::f32x4*)(out + off + bj * 128 + n * 16) = r + acc[ai][bj][m][n]; } }
    }
};
struct EpiOutProj {
    static constexpr bool PERM = false, AFTER_DRAIN = false;
    const float* res; float* out; bf16* HB; float* SS;
    __device__ __forceinline__ void operator()(const pg8::f32x4 (&acc)[2][2][4][2], const pg8::Unit& u, int wr, int wc, int fr, int fq) const {
        const int rb = (u.pm >> 3) * 2064 + 16 + (u.pm & 7) * 256;
        const int row0 = u.pm * 256 + wr * 64 + fr, col0 = u.pn * 256 + wc * 32 + 4 * fq;
        pg8::f32x4 rc[4], rn[4];
#define EOP_LOAD(dst, g) do { const size_t off_ = (size_t)(row0 + ((g) >> 2) * 128 + ((g) & 3) * 16) * DM + col0; \
            dst[0] = *(const pg8::f32x4*)(res + off_); dst[1] = *(const pg8::f32x4*)(res + off_ + 16); dst[2] = *(const pg8::f32x4*)(res + off_ + 128); dst[3] = *(const pg8::f32x4*)(res + off_ + 144); } while (0)
        EOP_LOAD(rc, 0);
#pragma unroll
        for (int g = 0; g < 8; ++g) { const int ai = g >> 2, m = g & 3;
            if (g < 7) EOP_LOAD(rn, g + 1);
            const int orow = row0 + ai * 128 + m * 16; bf16* hb = HB + (size_t)(rb + wr * 64 + fr + ai * 128 + m * 16) * DM + col0; float ss = 0.f;
#pragma unroll
            for (int bj = 0; bj < 2; ++bj)
#pragma unroll
                for (int n = 0; n < 2; ++n) { const pg8::f32x4 v = rc[2 * bj + n] + acc[ai][bj][m][n];
                    ss += (v[0] * v[0] + v[1] * v[1]) + (v[2] * v[2] + v[3] * v[3]); v2u w; w.x = pk2(v[0], v[1]); w.y = pk2(v[2], v[3]); *(v2u*)(hb + bj * 128 + n * 16) = w; }
            ss = sum_x16(ss); ss = sum_x32(ss);
            if (fq == 0) SS[(size_t)orow * 16 + u.pn * 4 + wc] = ss;
#pragma unroll
            for (int i = 0; i < 4; ++i) rc[i] = rn[i]; }
#undef EOP_LOAD
    }
};
struct EpiDown {
    static constexpr bool PERM = false, AFTER_DRAIN = false;
    const bf16* HB; float* out;
    __device__ __forceinline__ void operator()(const pg8::f32x4 (&acc)[2][2][4][2], const pg8::Unit& u, int wr, int wc, int fr, int fq) const {
        const int rb = (u.pm >> 3) * 2064 + 16 + (u.pm & 7) * 256;
        const int row0 = u.pm * 256 + wr * 64 + fr, col0 = u.pn * 256 + wc * 32 + 4 * fq;
        v2u rc[4], rn[4];
#define EDN_LOAD(dst, g) do { const bf16* hb_ = HB + (size_t)(rb + wr * 64 + fr + ((g) >> 2) * 128 + ((g) & 3) * 16) * DM + col0; \
            dst[0] = *(const v2u*)(hb_); dst[1] = *(const v2u*)(hb_ + 16); dst[2] = *(const v2u*)(hb_ + 128); dst[3] = *(const v2u*)(hb_ + 144); } while (0)
        EDN_LOAD(rc, 0);
#pragma unroll
        for (int g = 0; g < 8; ++g) { const int ai = g >> 2, m = g & 3;
            if (g < 7) EDN_LOAD(rn, g + 1);
            const size_t off = (size_t)(row0 + ai * 128 + m * 16) * DM + col0;
#pragma unroll
            for (int bj = 0; bj < 2; ++bj)
#pragma unroll
                for (int n = 0; n < 2; ++n) { const v2u w = rc[2 * bj + n]; const pg8::f32x4 r = {bflo(w.x), bfhi(w.x), bflo(w.y), bfhi(w.y)}; *(pg8::f32x4*)(out + off + bj * 128 + n * 16) = r + acc[ai][bj][m][n]; }
#pragma unroll
            for (int i = 0; i < 4; ++i) rc[i] = rn[i]; }
#undef EDN_LOAD
    }
};
struct EpiSwiGLU {
    static constexpr bool PERM = true, AFTER_DRAIN = false;
    bf16* O; const LAS float* RS; pg8::StaticOrder S;
    __device__ __forceinline__ void operator()(const pg8::f32x4 (&acc)[2][2][4][2], const pg8::Unit& u, int wr, int wc, int fr, int fq) const {
        const int rb = (u.pm >> 3) * 2064 + 16 + (u.pm & 7) * 256;
        const int row0 = rb + wr * 64 + fr, col0 = u.pn * 128 + wc * 32 + 8 * fq;
        int slot = 0;
#pragma unroll 1
        for (int i = 0; i < 8; ++i) { pg8::Unit uu; if (!S.next(i, uu)) break; if (uu.pm == u.pm && uu.pn == u.pn) { slot = i; break; } }
        const LAS float* rsp = RS + slot * 256 + wr * 64 + fr;
#pragma unroll
        for (int ai = 0; ai < 2; ++ai)
#pragma unroll
            for (int m = 0; m < 4; ++m) { float a[8]; const float rs = rsp[ai * 128 + m * 16];
#pragma unroll
                for (int n = 0; n < 2; ++n)
#pragma unroll
                    for (int e = 0; e < 4; ++e) a[4 * n + e] = silu_f(rs * acc[ai][0][m][n][e]) * (rs * acc[ai][1][m][n][e]);
                v4u w; w.x = pk2(a[0], a[1]); w.y = pk2(a[2], a[3]); w.z = pk2(a[4], a[5]); w.w = pk2(a[6], a[7]);
                *(v4u*)(O + (size_t)(row0 + ai * 128 + m * 16) * DFF + col0) = w; }
    }
};

template <class ARow, class Epi>
__device__ __forceinline__ void small_gemm(const bf16* A, int lda, const bf16* Bt, int K, int nrt, int nct, const ARow& arow, const Epi& E, int gw, int NGW, int lane, int ksplit = 1) {
    const int ntask = nrt * nct * ksplit, kc = K / ksplit;
    for (int task = gw; task < ntask; task += NGW) {
        const int rt = task % nrt, ct = (task / nrt) % nct, kq = task / (nrt * nct);
        const bf16* ap = A + (size_t)arow(rt * 16 + (lane & 15)) * lda + kq * kc + 8 * (lane >> 4);
        const bf16* bp = Bt + (size_t)(ct * 16 + (lane & 15)) * K + kq * kc + 8 * (lane >> 4);
        f32x4 acc = {0.f, 0.f, 0.f, 0.f};
#pragma unroll 1
        for (int k0 = 0; k0 < kc; k0 += 32 * 11) {
            bf16x8 av[11], bv[11];
#pragma unroll
            for (int j = 0; j < 11; ++j) if (k0 + 32 * j < kc) { av[j] = *(const bf16x8*)(ap + k0 + 32 * j); bv[j] = *(const bf16x8*)(bp + k0 + 32 * j); }
#pragma unroll
            for (int j = 0; j < 11; ++j) if (k0 + 32 * j < kc) acc = __builtin_amdgcn_mfma_f32_16x16x32_bf16(av[j], bv[j], acc, 0, 0, 0);
        }
        E(acc, rt, ct, lane);
    }
}

template <class RM>
__device__ __forceinline__ void transpose_item(const float* W, int N, int ldw, bf16* WT, int ldt, int item, LAS float* scr, int lane, const RM& rm, const float* kscale = nullptr) {
    const int nblk = (N + 31) / 32, kb = item / nblk, nb = item % nblk, k0 = 64 * kb, n0 = 32 * nb;
    { const int n = n0 + (lane & 31); float v[32];
#pragma unroll
      for (int i = 0; i < 32; ++i) { const int kk = 2 * i + (lane >> 5); v[i] = (n < N) ? W[(size_t)(k0 + kk) * ldw + n] : 0.f; }
#pragma unroll
      for (int i = 0; i < 32; ++i) { const int kk = 2 * i + (lane >> 5); float x = v[i]; if (kscale) x *= kscale[k0 + kk]; scr[kk * 33 + (lane & 31)] = x; } }
    LDS_WAIT(); asm volatile("" ::: "memory");
    const int c = lane & 7;
#pragma unroll
    for (int j = 0; j < 4; ++j) { const int n = (lane >> 3) + 8 * j; const LAS float* s = scr + (8 * c) * 33 + n;
        if (n0 + n < N) { v4u o; o.x = pk2(s[0 * 33], s[1 * 33]); o.y = pk2(s[2 * 33], s[3 * 33]); o.z = pk2(s[4 * 33], s[5 * 33]); o.w = pk2(s[6 * 33], s[7 * 33]);
            *(v4u*)(WT + (size_t)rm(n0 + n) * ldt + k0 + 8 * c) = o; } }
    LDS_WAIT(); asm volatile("" ::: "memory");
}
__device__ __forceinline__ int map_in(int n) {
    return n < S_DT ? n : n < S_CQ ? C_DT + (n - S_DT) : n < S_CKV ? C_CQ + (n - S_CQ) : n < S_KR ? C_CKV + (n - S_CKV) : n;
}
__device__ __forceinline__ void p0_prologue(Frame& F) {
    LAS float* scr = (LAS float*)(F.lds + RING_OFF + F.wave * 16384);
    const float* w_in = (const float*)F.in[9]; const float* w_uq = (const float*)F.in[17]; const float* w_ukv = (const float*)F.in[19]; const float* w_out = (const float*)F.in[25];
    const float* w_gate = (const float*)F.in[27]; const float* w_up = (const float*)F.in[28]; const float* w_down = (const float*)F.in[29];
    bf16* WIN = (bf16*)(F.ws + WS_WIN); bf16* WUQ = (bf16*)(F.ws + WS_WUQ); bf16* WUKV = (bf16*)(F.ws + WS_WUKV); bf16* WOUT = (bf16*)(F.ws + WS_WOUT); bf16* WGU = (bf16*)(F.ws + WS_WGU); bf16* WDN = (bf16*)(F.ws + WS_WDN);
    const float* ffg = (const float*)F.in[26];
    constexpr int I_IN = 16 * 62, I_UQ = 6 * 24, I_UKV = 4 * 32, I_OUT = 16 * 32, I_G = 16 * 88, I_DN = 44 * 32;
    constexpr int NITEMS = I_IN + I_UQ + 2 * I_UKV + I_OUT + 2 * I_G + I_DN;
    bf16* WUKV2 = (bf16*)(F.ws + WS_WUKV2);
    for (int it = F.gw; it < NITEMS; it += F.NGW) {
        int r = it;
        if (r < I_IN) { transpose_item(w_in, INC, INC, WIN, DM, r, scr, F.lane, [](int n) { return map_in(n); }); continue; } r -= I_IN;
        if (r < I_UQ) { transpose_item(w_uq, 768, 768, WUQ, QL, r, scr, F.lane, [](int n) { return n; }, (const float*)F.in[16]); continue; } r -= I_UQ;
        if (r < I_UKV) { transpose_item(w_ukv, 1024, 1024, WUKV, KVL, r, scr, F.lane, [](int n) { return n; }, (const float*)F.in[18]); continue; } r -= I_UKV;
        if (r < I_UKV) { transpose_item(w_ukv, 1024, 1024, WUKV2, KVL, r, scr, F.lane, [](int n) { return n; }); continue; } r -= I_UKV;
        if (r < I_OUT) { transpose_item(w_out, DM, DM, WOUT, 1024, r, scr, F.lane, [](int n) { return n; }); continue; } r -= I_OUT;
        if (r < I_G) { transpose_item(w_gate, DFF, DFF, WGU, DM, r, scr, F.lane, [](int n) { return 256 * (n >> 7) + (n & 127); }, ffg); continue; } r -= I_G;
        if (r < I_G) { transpose_item(w_up, DFF, DFF, WGU, DM, r, scr, F.lane, [](int n) { return 256 * (n >> 7) + 128 + (n & 127); }, ffg); continue; } r -= I_G;
        transpose_item(w_down, DM, DM, WDN, DFF, r, scr, F.lane, [](int n) { return n; });
    }
    for (int i = F.gw * 64 + F.lane; i < 88 * 1024 / 8; i += F.NGW * 64) *(v4u*)(WIN + (size_t)1960 * 1024 + (size_t)i * 8) = (v4u){0u, 0u, 0u, 0u};
    const float* xp = (const float*)F.in[0]; const float* xs = (const float*)F.in[1]; const float* meta = (const float*)F.in[7]; const float* g = (const float*)F.in[8];
    bf16* XN = (bf16*)(F.ws + WS_XN);
    f32x4 gv[4];
#pragma unroll
    for (int j = 0; j < 4; ++j) gv[j] = ((const f32x4*)g)[F.lane + 64 * j];
    for (int r0 = 2 * F.gw; r0 < R; r0 += 2 * F.NGW) {
        f32x4 v[2][4];
#pragma unroll
        for (int i = 0; i < 2; ++i) { const int row = r0 + i; const float* src;
            if (row < RP) { const int b = row / TT, t = row % TT; src = (t < NMETA) ? meta + (size_t)t * DM : xp + ((size_t)b * SEQ + (t - NMETA)) * DM; } else src = xs + (size_t)(row - RP) * DM;
#pragma unroll
            for (int j = 0; j < 4; ++j) v[i][j] = ((const f32x4*)src)[F.lane + 64 * j]; }
#pragma unroll
        for (int i = 0; i < 2; ++i) { float s = 0.f;
#pragma unroll
            for (int j = 0; j < 4; ++j) s += (v[i][j].x * v[i][j].x + v[i][j].y * v[i][j].y) + (v[i][j].z * v[i][j].z + v[i][j].w * v[i][j].w);
            const float rs = __builtin_amdgcn_rsqf(wave_sum(s) * (1.f / DM) + EPS);
            v2u* o8 = (v2u*)(XN + (size_t)(r0 + i) * DM) + F.lane;
#pragma unroll
            for (int j = 0; j < 4; ++j) { v2u o; o.x = pk2(v[i][j].x * rs * gv[j].x, v[i][j].y * rs * gv[j].y); o.y = pk2(v[i][j].z * rs * gv[j].z, v[i][j].w * rs * gv[j].w); o8[64 * j] = o; } }
    }
    float* ROPE = (float*)(F.ws + WS_ROPE);
    for (int i = blockIdx.x * NTHR + F.tid; i < (TT + 1) * 16; i += F.G * NTHR) { const int p = i >> 4, j = i & 15; const float ang = (float)(p < TT ? p : PAST) * rope_inv(j); ROPE[2 * i] = cosf(ang); ROPE[2 * i + 1] = sinf(ang); }
}

__device__ __forceinline__ int small_arow(int r) { return r < NMETA ? r : RP + (r - NMETA); }
__device__ __forceinline__ void p1_inproj(Frame& F) {
    const bf16* XN = (const bf16*)(F.ws + WS_XN); const bf16* WIN = (const bf16*)(F.ws + WS_WIN); bf16* PROJ = (bf16*)(F.ws + WS_PROJ); float* DTRAW = (float*)(F.ws + WS_DTRAW);
    { pg8::Gemm g{XN, WIN, MMAIN, PJ, DM, 1, DM}; pg8::StaticOrder S; S.init(MMAIN, PJ, F.G, (int)blockIdx.x);
      EpiProj E{PROJ, DTRAW, 1};
      pg8::gemm_phase<EpiProj, pg8::StaticOrder, true, true>(F.lds + RING_OFF, g, S, E); }
    auto epi = [&](const f32x4& acc, int rt, int ct, int lane) {
        const int col = ct * 16 + (lane & 15);
#pragma unroll
        for (int i = 0; i < 4; ++i) { const int r = rt * 16 + 4 * (lane >> 4) + i; const bf16 v = f2bf(acc[i]);
            if (r < NMETA) { for (int b = 0; b < NB; ++b) { PROJ[(size_t)(b * TT + r) * PJ + col] = v; if (col >= C_DT && col < C_DT + 8) DTRAW[(size_t)(b * TT + r) * 8 + (col - C_DT)] = acc[i]; } }
            else { const int row = RP + (r - NMETA); PROJ[(size_t)row * PJ + col] = v; if (col >= C_DT && col < C_DT + 8) DTRAW[(size_t)row * 8 + (col - C_DT)] = acc[i]; } }
    };
    small_gemm(XN, DM, WIN, DM, NS / 16, PJ / 16, [](int r) { return small_arow(r); }, epi, F.gw, F.NGW, F.lane);
}

constexpr int CV_LDS_STRIDE = 82;
__device__ __forceinline__ void p2_elementwise(Frame& F) {
    const bf16* PROJ = (const bf16*)(F.ws + WS_PROJ); const float* DTRAW = (const float*)(F.ws + WS_DTRAW); float* DT = (float*)(F.ws + WS_DT);
    float* RQS = (float*)(F.ws + WS_RQ); float* KRF = (float*)(F.ws + WS_KRF);
    const float* kvg = (const float*)F.in[18]; const float* qng = (const float*)F.in[16]; const float* dtb = (const float*)F.in[12]; const float* ROPE = (const float*)(F.ws + WS_ROPE);
    {
        const f32x4 gg = ((const f32x4*)kvg)[F.lane]; const float* gq = qng + 6 * F.lane; const float g0 = gq[0], g1 = gq[1], g2 = gq[2], g3 = gq[3], g4 = gq[4], g5 = gq[5]; const float dbias = dtb[F.lane & 7];
        v2u wk[4], wkn[4]; unsigned wq[4][3], wqn[4][3]; unsigned short kr1[4], kr2[4], kr1n[4], kr2n[4]; float dtr[4], dtrn[4]; f32x2_t cs[4], csn[4];
#define P2A_LOAD(WK, WQ, K1, K2, DTR, CS, r0, n) do { _Pragma("unroll") for (int i = 0; i < 4; ++i) if (i < (n)) { const int row = (r0) + i; const bf16* pr = PROJ + (size_t)row * PJ; \
            WK[i] = *(const v2u*)(pr + C_CKV + 4 * F.lane); const unsigned* p = (const unsigned*)(pr + C_CQ + 6 * F.lane); WQ[i][0] = p[0]; WQ[i][1] = p[1]; WQ[i][2] = p[2]; \
            K1[i] = pr[C_KR + (F.lane & 15)]; K2[i] = pr[C_KR + 16 + (F.lane & 15)]; DTR[i] = DTRAW[(size_t)row * 8 + (F.lane & 7)]; \
            CS[i] = *(const f32x2_t*)(ROPE + 2 * ((row < RP ? row % TT : TT) * 16 + (F.lane & 15))); } } while (0)
#define P2A_PROC(r0, n) do { _Pragma("unroll") for (int i = 0; i < 4; ++i) if (i < (n)) { const int row = (r0) + i; \
            { const float v0 = bflo(wk[i].x), v1 = bfhi(wk[i].x), v2 = bflo(wk[i].y), v3 = bfhi(wk[i].y); \
              const float rs = __builtin_amdgcn_rsqf(wave_sum((v0 * v0 + v1 * v1) + (v2 * v2 + v3 * v3)) * (1.f / KVL) + EPS); \
              const f32x4 o = {v0 * rs * gg.x, v1 * rs * gg.y, v2 * rs * gg.z, v3 * rs * gg.w}; \
              float* of = (row < RP) ? F.out + OUT_LATP + (size_t)row * KVL : F.out + OUT_LATS + (size_t)(row - RP) * KVL; \
              ((f32x4*)of)[F.lane] = o; if (F.lane == 0) RQS[R + row] = rs; } \
            { const float v0 = bflo(wq[i][0]), v1 = bfhi(wq[i][0]), v2 = bflo(wq[i][1]), v3 = bfhi(wq[i][1]), v4 = bflo(wq[i][2]), v5 = bfhi(wq[i][2]); \
              const float rs = __builtin_amdgcn_rsqf(wave_sum((v0 * v0 + v1 * v1) + (v2 * v2 + v3 * v3) + (v4 * v4 + v5 * v5)) * (1.f / QL) + EPS); \
              if (F.lane == 0) RQS[row] = rs; } \
            if (F.lane < 16) { const int j = F.lane; const float c = cs[i].x, s = cs[i].y; \
              const float x1 = bf2f(kr1[i]), x2 = bf2f(kr2[i]); const float y1 = x1 * c - x2 * s, y2 = x1 * s + x2 * c; \
              KRF[(size_t)row * 32 + j] = y1; KRF[(size_t)row * 32 + 16 + j] = y2; \
              float* of = (row < RP) ? F.out + OUT_KRP + (size_t)row * 32 : F.out + OUT_KRS + (size_t)(row - RP) * 32; of[j] = y1; of[16 + j] = y2; } \
            if (F.lane < 8) DT[(size_t)row * 8 + F.lane] = softplus_f(dtr[i] + dbias); } } while (0)
#define P2A_ROT() do { _Pragma("unroll") for (int i = 0; i < 4; ++i) { wk[i] = wkn[i]; wq[i][0] = wqn[i][0]; wq[i][1] = wqn[i][1]; wq[i][2] = wqn[i][2]; kr1[i] = kr1n[i]; kr2[i] = kr2n[i]; dtr[i] = dtrn[i]; cs[i] = csn[i]; } } while (0)
        if (F.NGW == 2048) {
            const int ra = 4 * F.gw, rb2 = 8192 + 4 * F.gw, rc = 16384 + F.gw;
            P2A_LOAD(wk, wq, kr1, kr2, dtr, cs, ra, 4);
            P2A_LOAD(wkn, wqn, kr1n, kr2n, dtrn, csn, rb2, 4);
            P2A_PROC(ra, 4); P2A_ROT();
            if (F.gw < 256) P2A_LOAD(wkn, wqn, kr1n, kr2n, dtrn, csn, rc, 1);
            P2A_PROC(rb2, 4);
            if (F.gw < 256) { P2A_ROT(); P2A_PROC(rc, 1); }
        } else {
            for (int r0 = 4 * F.gw; r0 < R; r0 += 4 * F.NGW) { P2A_LOAD(wk, wq, kr1, kr2, dtr, cs, r0, 4); P2A_PROC(r0, 4); }
        }
#undef P2A_LOAD
#undef P2A_PROC
#undef P2A_ROT
    }
    const float* cw = (const float*)F.in[10]; const float* cb = (const float*)F.in[11];
    bf16* XST = (bf16*)(F.ws + WS_XST); bf16* BT = (bf16*)(F.ws + WS_BT); bf16* BC = (bf16*)(F.ws + WS_BC);
    LAS bf16* tile = (LAS bf16*)(F.lds + RING_OFF);
    for (int i = blockIdx.x * NTHR + F.tid; i < NB * 640 * 6; i += F.G * NTHR) { const int rowi = i / 6, pc = i % 6; const int bb = rowi / 640, cc = rowi % 640;
        bf16* dst = (cc < SSDW) ? XST + ((size_t)(bb * SSDW + cc)) * TPAD : BT + ((size_t)(bb * 128 + (cc - SSDW))) * TPAD; *(v4u*)(dst + pc * 8) = (v4u){0u, 0u, 0u, 0u}; }
    for (int u = blockIdx.x; u < NB * 32 * 3; u += F.G) {
        const int third = u % 3, tb = 1 + (u / 3) % 32, b = u / 96; const int t0 = tb * CHL - TOFF;
        {
            const int cl = 2 * (F.tid & 127), c = third * 256 + cl, tq = F.tid >> 7;
            const float w0a = cw[0 * CONVD + c], w1a = cw[1 * CONVD + c], w2a = cw[2 * CONVD + c], w3a = cw[3 * CONVD + c], ba = cb[c];
            const float w0b = cw[0 * CONVD + c + 1], w1b = cw[1 * CONVD + c + 1], w2b = cw[2 * CONVD + c + 1], w3b = cw[3 * CONVD + c + 1], bb = cb[c + 1];
            const bf16* base = PROJ + (size_t)b * TT * PJ + C_XBC + c;
#define CV_QUARTER(tfirst, lcol) do { float xa[19], xb[19]; \
                _Pragma("unroll") for (int k = 0; k < 19; ++k) { const int t = (tfirst) - 3 + k; xa[k] = 0.f; xb[k] = 0.f; if (t >= 0) { const unsigned w = *(const unsigned*)(base + (size_t)t * PJ); xa[k] = bflo(w); xb[k] = bfhi(w); } } \
                _Pragma("unroll") for (int k = 0; k < 16; ++k) { const int t = (tfirst) + k; \
                    const float ya = silu_f(ba + xa[k] * w0a + xa[k + 1] * w1a + xa[k + 2] * w2a + xa[k + 3] * w3a), yb = silu_f(bb + xb[k] * w0b + xb[k + 1] * w1b + xb[k + 2] * w2b + xb[k + 3] * w3b); \
                    const unsigned pk = pk2(ya, yb); \
                    tile[cl * CV_LDS_STRIDE + (lcol) + k] = (bf16)(pk & 0xffffu); tile[(cl + 1) * CV_LDS_STRIDE + (lcol) + k] = (bf16)(pk >> 16); \
                    if (third == 2) *(unsigned*)(BC + (size_t)(b * TT + t) * 256 + cl) = pk; } } while (0)
            CV_QUARTER(t0 + 16 * tq, 16 * tq);
            if (tb == 1 && tq == 0) CV_QUARTER(0, 64);
#undef CV_QUARTER
        }
        __syncthreads();
        { const int nrows = (third == 2) ? 128 : 256; const int npc = (tb == 1) ? 10 : 8;
          for (int i = F.tid; i < nrows * npc; i += NTHR) { const int cl = i / npc, pc = i % npc;
            const LAS unsigned* s = (const LAS unsigned*)(tile + cl * CV_LDS_STRIDE + pc * 8); v4u o; o.x = s[0]; o.y = s[1]; o.z = s[2]; o.w = s[3];
            bf16* dst = (third < 2) ? XST + ((size_t)(b * SSDW + third * 256 + cl)) * TPAD : BT + ((size_t)(b * 128 + cl)) * TPAD;
            *(v4u*)(dst + ((pc < 8) ? tb * CHL + pc * 8 : TOFF + (pc - 8) * 8)) = o; } }
        __syncthreads();
    }
    const float* sconv = (const float*)F.in[4]; float* XAS = (float*)(F.ws + WS_XAS);
    for (int i = blockIdx.x * NTHR + F.tid; i < DB * CONVD; i += F.G * NTHR) { const int b = i / CONVD, c = i % CONVD;
        const float xc = bf2f(PROJ[(size_t)(RP + b) * PJ + C_XBC + c]);
        const float s0 = sconv[(size_t)(b * 3 + 0) * CONVD + c], s1 = sconv[(size_t)(b * 3 + 1) * CONVD + c], s2 = sconv[(size_t)(b * 3 + 2) * CONVD + c];
        XAS[i] = silu_f(cb[c] + s0 * cw[c] + s1 * cw[CONVD + c] + s2 * cw[2 * CONVD + c] + xc * cw[3 * CONVD + c]);
        float* oc = F.out + OUT_CONVS + (size_t)b * 3 * CONVD + c; oc[0] = s1; oc[CONVD] = s2; oc[2 * CONVD] = xc; }
    for (int i = blockIdx.x * NTHR + F.tid; i < NB * 3 * CONVD; i += F.G * NTHR) { const int b = i / (3 * CONVD), k = (i / CONVD) % 3, c = i % CONVD;
        F.out[OUT_CONVP + i] = bf2f(PROJ[(size_t)(b * TT + TT - 3 + k) * PJ + C_XBC + c]); }
}
#define MFMA32(a, b, c) __builtin_amdgcn_mfma_f32_32x32x16_bf16((a), (b), (c), 0, 0, 0)
#define MFMA16(a, b, c) __builtin_amdgcn_mfma_f32_16x16x32_bf16((a), (b), (c), 0, 0, 0)
__device__ __forceinline__ int crow(int reg, int hi) { return (reg & 3) + 8 * (reg >> 2) + 4 * hi; }
__device__ __forceinline__ bf16x8 pack8(const f32x16& x, int s) {
    v4u p; p.x = pk2(x[8 * s + 0], x[8 * s + 1]); p.y = pk2(x[8 * s + 2], x[8 * s + 3]); p.z = pk2(x[8 * s + 4], x[8 * s + 5]); p.w = pk2(x[8 * s + 6], x[8 * s + 7]);
    return __builtin_bit_cast(bf16x8, p);
}
__device__ __forceinline__ bf16x8 ld2x8(const bf16* p0, const bf16* p1) {
    const v2u a = *(const v2u*)p0, b = *(const v2u*)p1; v4u r; r.x = a.x; r.y = a.y; r.z = b.x; r.w = b.y; return __builtin_bit_cast(bf16x8, r);
}
__device__ __forceinline__ float softmax_ref(Frame& F) {
    const float* gqn = (const float*)F.in[20]; const float* gqr = (const float*)F.in[21]; const float* gkn = (const float*)F.in[22]; const float* gkr = (const float*)F.in[23];
    float a = fabsf(gqn[F.lane]), b = fabsf(gkn[F.lane]);
    if (F.lane < 16) { a = fmaxf(a, fabsf(gqr[F.lane])); b = fmaxf(b, fabsf(gkr[F.lane])); }
    return LOG2E * 9.797958971132712f * wave_max(a) * wave_max(b) * 1.0001f;
}
constexpr size_t WS_YS = 495 * MiB;
constexpr size_t WS_KS = 498 * MiB;
constexpr int NKT = 65;

__device__ __forceinline__ void p3_upproj_states(Frame& F) {
    const bf16* PROJ = (const bf16*)(F.ws + WS_PROJ); const bf16* WUQ = (const bf16*)(F.ws + WS_WUQ); const bf16* WUKV = (const bf16*)(F.ws + WS_WUKV);
    bf16* QRAW = (bf16*)(F.ws + WS_QRAW); bf16* KVRAW = (bf16*)(F.ws + WS_KVRAW);
    { pg8::Gemm g{PROJ + C_CQ, WUQ, MMAIN, 768, QL, 1, PJ}; pg8::StaticOrder S; S.init(MMAIN, 768, F.G, (int)blockIdx.x); EpiBf16 E{QRAW, 768, 1};
      pg8::gemm_phase<EpiBf16, pg8::StaticOrder, true, true>(F.lds + RING_OFF, g, S, E); }
    { pg8::Gemm g{PROJ + C_CKV, WUKV, MMAIN, 1024, KVL, 1, PJ}; pg8::StaticOrder S; S.init(MMAIN, 1024, F.G, (int)blockIdx.x); EpiBf16 E{KVRAW, 1024, 1};
      pg8::gemm_phase<EpiBf16, pg8::StaticOrder, true, true>(F.lds + RING_OFF, g, S, E); }
    const bool sub = (F.G == 256);
    const int sgw = sub ? (blockIdx.x - 192) * NWAVES + F.wave : F.gw, sngw = sub ? 64 * NWAVES : F.NGW;
    if (!sub || blockIdx.x >= 192) {
    small_gemm(PROJ + C_CQ, PJ, WUQ, QL, DB / 16, 768 / 16, [](int r) { return RP + r; },
        [&](const f32x4& acc, int rt, int ct, int lane) { const int col = ct * 16 + (lane & 15);
#pragma unroll
            for (int i = 0; i < 4; ++i) QRAW[(size_t)(RP + rt * 16 + 4 * (lane >> 4) + i) * 768 + col] = f2bf(acc[i]); }, sgw, sngw, F.lane);
    small_gemm(PROJ + C_CKV, PJ, WUKV, KVL, NS / 16, 1024 / 16, [](int r) { return small_arow(r); },
        [&](const f32x4& acc, int rt, int ct, int lane) { const int col = ct * 16 + (lane & 15);
#pragma unroll
            for (int i = 0; i < 4; ++i) { const int r = rt * 16 + 4 * (lane >> 4) + i; const bf16 v = f2bf(acc[i]);
                if (r < NMETA) { for (int b = 0; b < NB; ++b) KVRAW[(size_t)(b * TT + r) * 1024 + col] = v; } else KVRAW[(size_t)(RP + r - NMETA) * 1024 + col] = v; } }, sgw, sngw, F.lane);
    }
    const float* DT = (const float*)(F.ws + WS_DT); const float* a_log = (const float*)F.in[13];
    const bf16* XST = (const bf16*)(F.ws + WS_XST); const bf16* BT = (const bf16*)(F.ws + WS_BT);
    float* STATES = (float*)(F.ws + WS_STATES); float* DECAY = (float*)(F.ws + WS_DECAY);
    LAS float* wl = (LAS float*)(F.lds + RING_OFF + F.wave * 1024);
    const int r32 = F.lane & 31, hi = F.lane >> 5;
    for (int u = F.gw; u < NB * NCH * NH; u += F.NGW) {
        const int h = u % NH, c = (u / NH) % NCH, b = u / (NH * NCH); const int g = h >> 2;
        const int t = c * CHL - TOFF + F.lane;
        const float dt = (t >= 0) ? DT[(size_t)(b * TT + t) * 8 + h] : 0.f;
        const float A = -__expf(a_log[h]);
        float acs = dt * A;
#pragma unroll
        for (int o = 1; o < 64; o <<= 1) { const float v = __shfl_up(acs, o); if (F.lane >= o) acs += v; }
        const float last = __shfl(acs, 63);
        wl[F.lane] = __expf(last - acs) * dt;
        LDS_WAIT(); asm volatile("" ::: "memory");
        f32x16 acc[2][2];
#pragma unroll
        for (int i = 0; i < 2; ++i)
#pragma unroll
            for (int j = 0; j < 2; ++j) acc[i][j] = (f32x16){};
        const bf16* xb = XST + ((size_t)(b * SSDW + h * HP)) * TPAD + c * CHL; const bf16* bb = BT + ((size_t)(b * 128 + g * DS)) * TPAD + c * CHL;
#pragma unroll
        for (int s = 0; s < 4; ++s) {
            const f32x4 w0 = *(const LAS f32x4*)(wl + 16 * s + 8 * hi), w1 = *(const LAS f32x4*)(wl + 16 * s + 8 * hi + 4);
            bf16x8 af[2], bfr[2];
#pragma unroll
            for (int pt = 0; pt < 2; ++pt) { const v4u x = *(const v4u*)(xb + (size_t)(32 * pt + r32) * TPAD + 16 * s + 8 * hi);
                v4u y; y.x = pk2(bflo(x.x) * w0.x, bfhi(x.x) * w0.y); y.y = pk2(bflo(x.y) * w0.z, bfhi(x.y) * w0.w); y.z = pk2(bflo(x.z) * w1.x, bfhi(x.z) * w1.y); y.w = pk2(bflo(x.w) * w1.z, bfhi(x.w) * w1.w);
                af[pt] = __builtin_bit_cast(bf16x8, y); }
#pragma unroll
            for (int nt = 0; nt < 2; ++nt) bfr[nt] = *(const bf16x8*)(bb + (size_t)(32 * nt + r32) * TPAD + 16 * s + 8 * hi);
#pragma unroll
            for (int pt = 0; pt < 2; ++pt)
#pragma unroll
                for (int nt = 0; nt < 2; ++nt) acc[pt][nt] = MFMA32(af[pt], bfr[nt], acc[pt][nt]);
        }
        float* so = STATES + ((size_t)((b * NCH + c) * NH + h)) * 4096;
#pragma unroll
        for (int pt = 0; pt < 2; ++pt)
#pragma unroll
            for (int nt = 0; nt < 2; ++nt)
#pragma unroll
                for (int rg = 0; rg < 16; ++rg) so[(32 * pt + crow(rg, hi)) * 64 + 32 * nt + r32] = acc[pt][nt][rg];
        if (F.lane == 0) DECAY[(b * NCH + c) * NH + h] = __expf(last);
        LDS_WAIT(); asm volatile("" ::: "memory");
    }
}

#ifdef MK_TS
#define P4_STAMP(k) do { if (blockIdx.x == 0 && F.tid == 0) ((unsigned long long*)(F.ws + 600 * MiB))[20 + (k)] = __builtin_amdgcn_s_memrealtime(); } while (0)
#else
#define P4_STAMP(k) do { } while (0)
#endif
__device__ __forceinline__ void p4_post(Frame& F) {
    const bf16* QRAW = (const bf16*)(F.ws + WS_QRAW); const bf16* KVRAW = (const bf16*)(F.ws + WS_KVRAW); const float* KRF = (const float*)(F.ws + WS_KRF);
    bf16* Q = (bf16*)(F.ws + WS_Q); bf16* K = (bf16*)(F.ws + WS_K); bf16* VT = (bf16*)(F.ws + WS_VT); float* VS = (float*)(F.ws + WS_VS);
    const float* gqn = (const float*)F.in[20]; const float* gqr = (const float*)F.in[21]; const float* gkn = (const float*)F.in[22]; const float* gkr = (const float*)F.in[23];
    const float* ROPE = (const float*)(F.ws + WS_ROPE); const float* RQS = (const float*)(F.ws + WS_RQ);
    const int h = F.lane >> 3, sub = F.lane & 7;
    bf16* KS = (bf16*)(F.ws + WS_KS);
    for (int row = RP + F.gw; row < R; row += F.NGW) {
        const int t = PAST;
        if (row >= RP) { const bf16* kp = KVRAW + (size_t)row * 1024 + 128 * h + 8 * sub; const v4u kw = *(const v4u*)kp; const v4u vw = *(const v4u*)(kp + 64);
          const f32x4 kr = *(const f32x4*)(KRF + (size_t)row * 32 + 4 * sub);
          const float rkv = RQS[R + row];
          float kn[8] = {bflo(kw.x) * rkv, bfhi(kw.x) * rkv, bflo(kw.y) * rkv, bfhi(kw.y) * rkv, bflo(kw.z) * rkv, bfhi(kw.z) * rkv, bflo(kw.w) * rkv, bfhi(kw.w) * rkv};
          float ss = (kr.x * kr.x + kr.y * kr.y) + (kr.z * kr.z + kr.w * kr.w);
#pragma unroll
          for (int e = 0; e < 8; ++e) ss += kn[e] * kn[e];
          ss = sum_x1(ss); ss = sum_x2(ss); ss = sum_x4(ss);
          const float rs = __builtin_amdgcn_rsqf(ss * (1.f / 96.f) + EPS);
          const float* gn = gkn + 8 * sub; v4u o; o.x = pk2(kn[0] * rs * gn[0], kn[1] * rs * gn[1]); o.y = pk2(kn[2] * rs * gn[2], kn[3] * rs * gn[3]); o.z = pk2(kn[4] * rs * gn[4], kn[5] * rs * gn[5]); o.w = pk2(kn[6] * rs * gn[6], kn[7] * rs * gn[7]);
          bf16* ko = KS + (size_t)(row - RP) * 768 + 96 * h; *(v4u*)(ko + 8 * sub) = o;
          const float* gr = gkr + ((4 * sub) & 15); v2u o2; o2.x = pk2(kr.x * rs * gr[0], kr.y * rs * gr[1]); o2.y = pk2(kr.z * rs * gr[2], kr.w * rs * gr[3]);
          *(v2u*)(ko + 64 + 4 * sub) = o2;
          const unsigned vv[4] = {vw.x, vw.y, vw.z, vw.w}; float* vs = VS + (size_t)(row - RP) * 512 + 64 * h + 8 * sub;
#pragma unroll
          for (int e = 0; e < 4; ++e) { vs[2 * e] = bflo(vv[e]) * rkv; vs[2 * e + 1] = bfhi(vv[e]) * rkv; } }
        if (row >= RP || t >= NMETA) {
            const bf16* qp = QRAW + (size_t)row * 768 + 96 * h; const v4u qw = *(const v4u*)(qp + 8 * sub);
            const unsigned r1 = *(const unsigned*)(qp + 64 + 2 * sub), r2 = *(const unsigned*)(qp + 80 + 2 * sub);
            float qn[8] = {bflo(qw.x), bfhi(qw.x), bflo(qw.y), bfhi(qw.y), bflo(qw.z), bfhi(qw.z), bflo(qw.w), bfhi(qw.w)};
            const f32x4 cs = *(const f32x4*)(ROPE + 2 * ((row < RP ? t : TT) * 16 + 2 * sub)); const float c0 = cs.x, s0 = cs.y, c1 = cs.z, s1 = cs.w;
            const float x10 = bflo(r1), x11 = bfhi(r1), x20 = bflo(r2), x21 = bfhi(r2);
            const float y10 = x10 * c0 - x20 * s0, y20 = x10 * s0 + x20 * c0, y11 = x11 * c1 - x21 * s1, y21 = x11 * s1 + x21 * c1;
            float ss = (y10 * y10 + y20 * y20) + (y11 * y11 + y21 * y21);
#pragma unroll
            for (int e = 0; e < 8; ++e) ss += qn[e] * qn[e];
            ss = sum_x1(ss); ss = sum_x2(ss); ss = sum_x4(ss);
            const float sq = RQS[row];
            const float rs = (ATTN_SCALE * LOG2E) * sq * __builtin_amdgcn_rsqf(ss * sq * sq * (1.f / 96.f) + EPS);
            const float* gn = gqn + 8 * sub; v4u o; o.x = pk2(qn[0] * rs * gn[0], qn[1] * rs * gn[1]); o.y = pk2(qn[2] * rs * gn[2], qn[3] * rs * gn[3]); o.z = pk2(qn[4] * rs * gn[4], qn[5] * rs * gn[5]); o.w = pk2(qn[6] * rs * gn[6], qn[7] * rs * gn[7]);
            bf16* qo = Q + (size_t)row * 768 + 96 * h; *(v4u*)(qo + 8 * sub) = o;
            const float g0 = gqr[2 * sub], g1 = gqr[2 * sub + 1];
            *(unsigned*)(qo + 64 + 2 * sub) = pk2(y10 * rs * g0, y11 * rs * g1); *(unsigned*)(qo + 80 + 2 * sub) = pk2(y20 * rs * g0, y21 * rs * g1);
        }
    }
    { bf16* KF = (bf16*)(F.ws + WS_K); bf16* VF = (bf16*)(F.ws + WS_VT);
      LAS unsigned char* vtile = F.lds + RING_OFF + F.wave * 4608;
      const int r8 = F.lane >> 3;
      for (int u = F.gw; u < NB * NKT * NH; u += F.NGW) {
          const int hh = u % NH, kt = (u / NH) % NKT, bb = u / (NH * NKT);
          bf16* kfb = KF + ((size_t)((bb * NH + hh) * NKT + kt)) * (6 * 512); bf16* vfb = VF + ((size_t)((bb * NH + hh) * NKT + kt)) * (4 * 512);
          v4u kwa[4], vwa[4]; f32x4 kra[4]; float rka[4];
#pragma unroll
          for (int i = 0; i < 4; ++i) { const int tk = kt * 32 + 8 * i + r8; const int tkc = tk < TT ? tk : TT - 1; rka[i] = RQS[R + bb * TT + tkc];
              const bf16* kp = KVRAW + (size_t)(bb * TT + tkc) * 1024 + 128 * hh + 8 * sub; kwa[i] = *(const v4u*)kp; vwa[i] = *(const v4u*)(kp + 64); kra[i] = *(const f32x4*)(KRF + (size_t)(bb * TT + tkc) * 32 + 4 * sub); }
#pragma unroll
          for (int i = 0; i < 4; ++i) {
              const int key = 8 * i + r8, tk = kt * 32 + key; v4u kw = kwa[i], vw = vwa[i]; f32x4 kr = kra[i];
              if (tk >= TT) { kw = (v4u){0u, 0u, 0u, 0u}; vw = kw; kr = (f32x4){0.f, 0.f, 0.f, 0.f}; }
              const float rkv = rka[i];
              float kn[8] = {bflo(kw.x) * rkv, bfhi(kw.x) * rkv, bflo(kw.y) * rkv, bfhi(kw.y) * rkv, bflo(kw.z) * rkv, bfhi(kw.z) * rkv, bflo(kw.w) * rkv, bfhi(kw.w) * rkv};
              vw.x = pk2(bflo(vw.x) * rkv, bfhi(vw.x) * rkv); vw.y = pk2(bflo(vw.y) * rkv, bfhi(vw.y) * rkv); vw.z = pk2(bflo(vw.z) * rkv, bfhi(vw.z) * rkv); vw.w = pk2(bflo(vw.w) * rkv, bfhi(vw.w) * rkv);
              float ss = (kr.x * kr.x + kr.y * kr.y) + (kr.z * kr.z + kr.w * kr.w);
#pragma unroll
              for (int e = 0; e < 8; ++e) ss += kn[e] * kn[e];
              ss = sum_x1(ss); ss = sum_x2(ss); ss = sum_x4(ss);
              const float rs = __builtin_amdgcn_rsqf(ss * (1.f / 96.f) + EPS);
              const float* gn = gkn + 8 * sub; v4u o; o.x = pk2(kn[0] * rs * gn[0], kn[1] * rs * gn[1]); o.y = pk2(kn[2] * rs * gn[2], kn[3] * rs * gn[3]); o.z = pk2(kn[4] * rs * gn[4], kn[5] * rs * gn[5]); o.w = pk2(kn[6] * rs * gn[6], kn[7] * rs * gn[7]);
              *(v4u*)(kfb + (sub >> 1) * 512 + ((sub & 1) * 32 + key) * 8) = o;
              const float* gr = gkr + ((4 * sub) & 15); v2u o2; o2.x = pk2(kr.x * rs * gr[0], kr.y * rs * gr[1]); o2.y = pk2(kr.z * rs * gr[2], kr.w * rs * gr[3]);
              *(v2u*)(kfb + (4 + (sub >> 2)) * 512 + (((sub >> 1) & 1) * 32 + key) * 8 + 4 * (sub & 1)) = o2;
              *(LAS v4u*)(vtile + key * 144 + sub * 16) = vw; }
          LDS_WAIT(); asm volatile("" ::: "memory");
          const int g = F.lane >> 4, q4 = (F.lane & 15) >> 2, pp = F.lane & 3;
          const unsigned a_lo = (unsigned)(uintptr_t)vtile + (unsigned)((4 * (g >> 1) + q4) * 144 + (16 * (g & 1) + 4 * pp) * 2);
#define VF_TR(dt, s2) do { s16x4 lo, hi4; \
              asm volatile("ds_read_b64_tr_b16 %0, %2 offset:%c3\n\tds_read_b64_tr_b16 %1, %2 offset:%c4\n\ts_waitcnt lgkmcnt(0)" : "=&v"(lo), "=&v"(hi4) : "v"(a_lo), "i"(16 * (s2) * 144 + 64 * (dt)), "i"(16 * (s2) * 144 + 64 * (dt) + 8 * 144) : "memory"); \
              v4u o; o.x = (unsigned)(unsigned short)lo[0] | ((unsigned)(unsigned short)lo[1] << 16); o.y = (unsigned)(unsigned short)lo[2] | ((unsigned)(unsigned short)lo[3] << 16); \
              o.z = (unsigned)(unsigned short)hi4[0] | ((unsigned)(unsigned short)hi4[1] << 16); o.w = (unsigned)(unsigned short)hi4[2] | ((unsigned)(unsigned short)hi4[3] << 16); \
              *(v4u*)(vfb + ((dt) * 2 + (s2)) * 512 + F.lane * 8) = o; } while (0)
          VF_TR(0, 0); VF_TR(0, 1); VF_TR(1, 0); VF_TR(1, 1);
#undef VF_TR
          LDS_WAIT(); asm volatile("" ::: "memory");
      } }
    P4_STAMP(0);
    const float* STATES = (const float*)(F.ws + WS_STATES); const float* DECAY = (const float*)(F.ws + WS_DECAY); bf16* HIN = (bf16*)(F.ws + WS_HIN);
    for (int e2 = blockIdx.x * NTHR + F.tid; e2 < NB * NH * 2048; e2 += F.G * NTHR) {
        const int e = 2 * e2; const int b = e / (NH * 4096), hh = (e / 4096) % NH, pn = e % 4096;
        float h0 = 0.f, h1 = 0.f;
#pragma unroll 1
        for (int c0 = 0; c0 < NCH; c0 += 11) {
            f32x2_t st[11]; float dc[11];
#pragma unroll
            for (int j = 0; j < 11; ++j) { const int c = c0 + j; st[j] = *(const f32x2_t*)(STATES + ((size_t)((b * NCH + c) * NH + hh)) * 4096 + pn); dc[j] = DECAY[(b * NCH + c) * NH + hh]; }
#pragma unroll
            for (int j = 0; j < 11; ++j) { const int c = c0 + j; *(unsigned*)(HIN + ((size_t)((b * NCH + c) * NH + hh)) * 4096 + pn) = pk2(h0, h1); h0 = h0 * dc[j] + st[j].x; h1 = h1 * dc[j] + st[j].y; }
        }
        *(f32x2_t*)(F.out + OUT_SSMP + e) = (f32x2_t){h0, h1};
    }
    P4_STAMP(1);
    const float* XAS = (const float*)(F.ws + WS_XAS); const float* DT = (const float*)(F.ws + WS_DT); const float* sst = (const float*)F.in[5];
    const float* a_log = (const float*)F.in[13]; const float* d_skip = (const float*)F.in[14]; float* YS = (float*)(F.ws + WS_YS);
    for (int u = F.gw; u < DB * NH * 16; u += F.NGW) {
        const int pq = u & 15, hh = (u >> 4) & 7, b = u >> 7; const int g = hh >> 2; const int p = 4 * pq + (F.lane >> 4), n4 = F.lane & 15;
        const float dt = DT[(size_t)(RP + b) * 8 + hh]; const float a = __expf(dt * -__expf(a_log[hh]));
        const float x = XAS[(size_t)b * CONVD + hh * HP + p]; const float uu = dt * x;
        const f32x4 Bv = *(const f32x4*)(XAS + (size_t)b * CONVD + SSDW + g * DS + 4 * n4), Cv = *(const f32x4*)(XAS + (size_t)b * CONVD + SSDW + 128 + g * DS + 4 * n4);
        const size_t si = (((size_t)b * NH + hh) * HP + p) * DS + 4 * n4;
        const f32x4 s0 = *(const f32x4*)(sst + si); const f32x4 s1 = s0 * a + uu * Bv;
        *(f32x4*)(F.out + OUT_SSMS + si) = s1;
        float y = (Cv.x * s1.x + Cv.y * s1.y) + (Cv.z * s1.z + Cv.w * s1.w);
        y = sum_x1(y); y = sum_x2(y); y = sum_x4(y); y = sum_x8(y);
        if (n4 == 0) YS[(size_t)b * 512 + hh * HP + p] = y + d_skip[hh] * x;
    }
}
constexpr int DA_ROWB = 528;
constexpr int DA_LAT = 0, DA_KR = 128 * DA_ROWB, DA_PB = DA_KR + 128 * 33 * 4, DA_QG = DA_PB + 2 * 16 * 32 * 2, DA_END = DA_QG + 8 * 96 * 4;
constexpr int P5_EXCH = 100 * 1024;
static_assert(DA_END <= P5_EXCH, "LDS map of P5");

constexpr int AT_SLOT = 20480, AT_D = 4;
constexpr size_t WS_ATT = 499 * MiB;
__device__ __forceinline__ void at_issue(Frame& F, const bf16* kt_k, const bf16* kt_v, LAS unsigned char* slot) {
    const int w = F.wave;
    __builtin_amdgcn_global_load_lds((const unsigned*)((const char*)kt_k + w * 1024 + F.lane * 16), (LAS unsigned*)(slot + w * 1024), 16, 0, 0);
    const char* srcB = (w < 4) ? (const char*)kt_k + 8192 + w * 1024 : (const char*)kt_v + (w - 4) * 1024;
    __builtin_amdgcn_global_load_lds((const unsigned*)(srcB + F.lane * 16), (LAS unsigned*)(slot + 8192 + w * 1024), 16, 0, 0);
    __builtin_amdgcn_global_load_lds((const unsigned*)((const char*)kt_v + 4096 + w * 256 + F.lane * 4), (LAS unsigned*)(slot + 16384 + w * 256), 4, 0, 0);
    __builtin_amdgcn_global_load_lds((const unsigned*)((const char*)kt_v + 6144 + w * 256 + F.lane * 4), (LAS unsigned*)(slot + 18432 + w * 256), 4, 0, 0);
}
__device__ __forceinline__ void p5_attn_prompt(Frame& F, float M0) {
    const bf16* QRAW = (const bf16*)(F.ws + WS_QRAW); const bf16* KF = (const bf16*)(F.ws + WS_K); const bf16* VF = (const bf16*)(F.ws + WS_VT); bf16* ATT = (bf16*)(F.ws + WS_ATT);
    const float* ROPE = (const float*)(F.ws + WS_ROPE); const float* gqn = (const float*)F.in[20]; const float* gqr = (const float*)F.in[21]; const float* RQS = (const float*)(F.ws + WS_RQ);
    LAS unsigned char* ring = F.lds + RING_OFF;
    const int w = F.wave, r32 = F.lane & 31, hi = F.lane >> 5;
    f32x16 negm;
#pragma unroll
    for (int i = 0; i < 16; ++i) negm[i] = -M0;
    for (int u = F.vcu; u < 256; u += F.G) {
        const int b = u >> 5, h = (u >> 2) & 7, pr = u & 3;
        const bf16* kfb = KF + ((size_t)((b * NH + h) * NKT)) * (6 * 512); const bf16* vfb = VF + ((size_t)((b * NH + h) * NKT)) * (4 * 512);
#pragma unroll 1
        for (int half = 0; half < 2; ++half) {
            const int qb = half ? 7 - pr : pr; const int a = 8 * qb + w; const int qi = NMETA + 32 * a + r32;
            const int nkt = 8 * qb + 9, nkw = a + 2;
            bf16x8 qf[6];
            { const bf16* qp = QRAW + (size_t)(b * TT + qi) * 768 + 96 * h + 8 * hi;
              v4u qw[6];
#pragma unroll
              for (int s = 0; s < 6; ++s) qw[s] = *(const v4u*)(qp + 16 * s);
              f32x4 cs[4];
#pragma unroll
              for (int i = 0; i < 4; ++i) cs[i] = *(const f32x4*)(ROPE + 2 * (qi * 16 + 8 * hi) + 4 * i);
              float qv[6][8]; float ss = 0.f;
#pragma unroll
              for (int s = 0; s < 6; ++s) { const unsigned ww[4] = {qw[s].x, qw[s].y, qw[s].z, qw[s].w};
#pragma unroll
                  for (int e = 0; e < 4; ++e) { qv[s][2 * e] = bflo(ww[e]); qv[s][2 * e + 1] = bfhi(ww[e]); ss += qv[s][2 * e] * qv[s][2 * e] + qv[s][2 * e + 1] * qv[s][2 * e + 1]; } }
              ss = sum_x32(ss);
              const float sq = RQS[b * TT + qi];
              const float rs = (ATTN_SCALE * LOG2E) * sq * __builtin_amdgcn_rsqf(ss * sq * sq * (1.f / 96.f) + EPS);
#pragma unroll
              for (int jj = 0; jj < 8; ++jj) { const float c = cs[jj >> 1][2 * (jj & 1)], sn = cs[jj >> 1][2 * (jj & 1) + 1]; const float x1 = qv[4][jj], x2 = qv[5][jj];
                  const float gr = gqr[8 * hi + jj] * rs; qv[4][jj] = (x1 * c - x2 * sn) * gr; qv[5][jj] = (x1 * sn + x2 * c) * gr; }
#pragma unroll
              for (int s = 0; s < 4; ++s) { const f32x4 g0 = *(const f32x4*)(gqn + 16 * s + 8 * hi), g1 = *(const f32x4*)(gqn + 16 * s + 8 * hi + 4);
                  qv[s][0] *= g0.x * rs; qv[s][1] *= g0.y * rs; qv[s][2] *= g0.z * rs; qv[s][3] *= g0.w * rs; qv[s][4] *= g1.x * rs; qv[s][5] *= g1.y * rs; qv[s][6] *= g1.z * rs; qv[s][7] *= g1.w * rs; }
#pragma unroll
              for (int s = 0; s < 6; ++s) { v4u o; o.x = pk2(qv[s][0], qv[s][1]); o.y = pk2(qv[s][2], qv[s][3]); o.z = pk2(qv[s][4], qv[s][5]); o.w = pk2(qv[s][6], qv[s][7]); qf[s] = __builtin_bit_cast(bf16x8, o); } }
            f32x16 o0 = (f32x16){}, o1 = (f32x16){}; float l = 0.f;
            const int ns = (nkt + 1) >> 1;
#pragma unroll
            for (int j = 0; j < AT_D - 1; ++j) at_issue(F, kfb + (size_t)j * 6144, vfb + (size_t)j * 4096, ring + j * AT_SLOT);
#pragma unroll 1
            for (int st = 0; st < ns; ++st) {
                const int rem = ns - 1 - st;
                if (rem >= 2) asm volatile("s_waitcnt vmcnt(8)" ::: "memory"); else if (rem == 1) asm volatile("s_waitcnt vmcnt(4)" ::: "memory"); else asm volatile("s_waitcnt vmcnt(0)" ::: "memory");
                __builtin_amdgcn_s_barrier(); asm volatile("" ::: "memory");
                if (st + AT_D - 1 < ns) at_issue(F, kfb + (size_t)(st + AT_D - 1) * 6144, vfb + (size_t)(st + AT_D - 1) * 4096, ring + ((st + AT_D - 1) & (AT_D - 1)) * AT_SLOT);
#pragma unroll
                for (int tt = 0; tt < 2; ++tt) { const int kt = 2 * st + tt;
                  if (kt < nkw) {
                    const LAS unsigned char* sl = ring + (st & (AT_D - 1)) * AT_SLOT + F.lane * 16; const int j0 = 32 * kt;
                    f32x16 S = negm;
#pragma unroll
                    for (int s = 0; s < 6; ++s) S = MFMA32(*(const LAS bf16x8*)(sl + tt * 6144 + 1024 * s), qf[s], S);
                    bf16x8 vf[4];
#pragma unroll
                    for (int i = 0; i < 4; ++i) vf[i] = *(const LAS bf16x8*)(sl + 12288 + tt * 4096 + 1024 * i);
#pragma unroll
                    for (int i = 0; i < 16; ++i) S[i] = __builtin_amdgcn_exp2f(S[i]);
                    if (kt >= a) {
#pragma unroll
                        for (int i = 0; i < 16; ++i) if (j0 + crow(i, hi) > qi) S[i] = 0.f; }
#pragma unroll
                    for (int i = 0; i < 16; ++i) l += S[i];
                    const bf16x8 p0 = pack8(S, 0), p1 = pack8(S, 1);
                    o0 = MFMA32(vf[0], p0, o0); o0 = MFMA32(vf[1], p1, o0);
                    o1 = MFMA32(vf[2], p0, o1); o1 = MFMA32(vf[3], p1, o1);
                  } }
            }
            l = sum_x32(l);
            const float il = __builtin_amdgcn_rcpf(l);
            bf16* ao = ATT + (size_t)(b * TT + qi) * 512 + 64 * h + 4 * hi;
#pragma unroll
            for (int gq = 0; gq < 4; ++gq) {
                v2u w0, w1; w0.x = pk2(o0[4 * gq] * il, o0[4 * gq + 1] * il); w0.y = pk2(o0[4 * gq + 2] * il, o0[4 * gq + 3] * il);
                w1.x = pk2(o1[4 * gq] * il, o1[4 * gq + 1] * il); w1.y = pk2(o1[4 * gq + 2] * il, o1[4 * gq + 3] * il);
                *(v2u*)(ao + 8 * gq) = w0; *(v2u*)(ao + 32 + 8 * gq) = w1; }
            asm volatile("s_waitcnt lgkmcnt(0)" ::: "memory"); __builtin_amdgcn_s_barrier(); asm volatile("" ::: "memory");
        }
    }
}

constexpr int SO_X = 0, SO_H = 36864, SO_B = 73728, SO_C = 82944, SO_Z = 92160, SO_TAB = 125952, SO_EX = 130048;
static_assert(SO_EX + 1024 <= RING_BYTES, "ssd_out LDS map");
__device__ __forceinline__ void p5_ssd_out(Frame& F) {
    const float* DT = (const float*)(F.ws + WS_DT); const float* a_log = (const float*)F.in[13]; const float* d_skip = (const float*)F.in[14]; const float* ng = (const float*)F.in[15];
    const bf16* XST = (const bf16*)(F.ws + WS_XST); const bf16* BC = (const bf16*)(F.ws + WS_BC); const bf16* HIN = (const bf16*)(F.ws + WS_HIN); const bf16* PROJ = (const bf16*)(F.ws + WS_PROJ);
    bf16* MIX = (bf16*)(F.ws + WS_MIX);
    LAS unsigned char* L = F.lds + RING_OFF;
    LAS float* tab = (LAS float*)(L + SO_TAB) + F.wave * 128;
    LAS float* exch = (LAS float*)(L + SO_EX);
    const int hl = F.wave >> 1, it = F.wave & 1, r32 = F.lane & 31, hi = F.lane >> 5;
    for (int u = blockIdx.x; u < NB * (NCH - 1); u += F.G) {
        const int b = u / (NCH - 1), c = 1 + u % (NCH - 1); const int t0 = c * CHL - TOFF;
        v4u st[14];
#define SO_FETCH_A(g) do { \
        _Pragma("unroll") for (int k = 0; k < 4; ++k) { const int q = F.tid + NTHR * k; st[k] = *(const v4u*)(XST + ((size_t)(b * SSDW + (g) * 256 + (q >> 3))) * TPAD + c * CHL + 8 * (q & 7)); } } while (0)
#define SO_FETCH_B(g) do { \
        _Pragma("unroll") for (int k = 0; k < 4; ++k) { const int q = F.tid + NTHR * k; st[4 + k] = *(const v4u*)(HIN + ((size_t)((b * NCH + c) * NH + 4 * (g))) * 4096 + (size_t)q * 8); } \
        { const int q = F.tid; st[8] = *(const v4u*)(BC + (size_t)(b * TT + t0 + (q >> 3)) * 256 + (g) * DS + 8 * (q & 7)); st[9] = *(const v4u*)(BC + (size_t)(b * TT + t0 + (q >> 3)) * 256 + 128 + (g) * DS + 8 * (q & 7)); } \
        _Pragma("unroll") for (int k = 0; k < 4; ++k) { const int q = F.tid + NTHR * k; st[10 + k] = *(const v4u*)(PROJ + (size_t)(b * TT + t0 + (q >> 5)) * PJ + C_Z + (g) * 256 + 8 * (q & 31)); } } while (0)
#define SO_STORE() do { \
        _Pragma("unroll") for (int k = 0; k < 4; ++k) { const int q = F.tid + NTHR * k; *(LAS v4u*)(L + SO_X + (q >> 3) * 144 + 16 * (q & 7)) = st[k]; *(LAS v4u*)(L + SO_H + (q >> 3) * 144 + 16 * (q & 7)) = st[4 + k]; } \
        { const int q = F.tid; *(LAS v4u*)(L + SO_B + (q >> 3) * 144 + 16 * (q & 7)) = st[8]; *(LAS v4u*)(L + SO_C + (q >> 3) * 144 + 16 * (q & 7)) = st[9]; } \
        _Pragma("unroll") for (int k = 0; k < 4; ++k) { const int q = F.tid + NTHR * k; *(LAS v4u*)(L + SO_Z + (q >> 5) * 528 + 16 * (q & 31)) = st[10 + k]; } } while (0)
        SO_FETCH_A(0); SO_FETCH_B(0);
#pragma unroll 1
        for (int g = 0; g < 2; ++g) {
            const int h = 4 * g + hl; const float A = -__expf(a_log[h]), Dh = d_skip[h];
            { const int t = t0 + F.lane; const float dt = DT[(size_t)(b * TT + t) * 8 + h];
              float acs = dt * A;
#pragma unroll
              for (int o = 1; o < 64; o <<= 1) { const float v = __shfl_up(acs, o); if (F.lane >= o) acs += v; }
              tab[F.lane] = acs; tab[64 + F.lane] = dt; }
            SO_STORE();
            __syncthreads();
            if (g == 0) SO_FETCH_A(1);
            const int ii = 32 * it + r32; const int t = t0 + ii;
            bf16x8 cf[4];
#pragma unroll
            for (int s = 0; s < 4; ++s) cf[s] = *(const LAS bf16x8*)(L + SO_C + ii * 144 + 32 * s + 16 * hi);
            f32x16 y[2];
            const float ai = tab[ii]; const float ei = __expf(ai);
#pragma unroll
            for (int pt = 0; pt < 2; ++pt) { f32x16 acc = (f32x16){}; const LAS unsigned char* hp_ = L + SO_H + (hl * 64 + 32 * pt + r32) * 144 + 16 * hi;
#pragma unroll
                for (int s = 0; s < 4; ++s) acc = MFMA32(*(const LAS bf16x8*)(hp_ + 32 * s), cf[s], acc);
#pragma unroll
                for (int i = 0; i < 16; ++i) acc[i] *= ei;
                y[pt] = acc; }
#pragma unroll 1
            for (int jt = 0; jt <= it; ++jt) {
                f32x16 S = (f32x16){};
                { const LAS unsigned char* bp_ = L + SO_B + (32 * jt + r32) * 144 + 16 * hi;
#pragma unroll
                  for (int s = 0; s < 4; ++s) S = MFMA32(*(const LAS bf16x8*)(bp_ + 32 * s), cf[s], S); }
#pragma unroll
                for (int i = 0; i < 16; ++i) { const int jj = 32 * jt + crow(i, hi); const float e = (jj <= ii) ? __expf(ai - tab[jj]) * tab[64 + jj] : 0.f; S[i] = S[i] * e + ((jj == ii) ? Dh : 0.f); }
                const bf16x8 p0 = pack8(S, 0), p1 = pack8(S, 1);
#pragma unroll
                for (int pt = 0; pt < 2; ++pt) { const LAS unsigned char* xp_ = L + SO_X + (hl * 64 + 32 * pt + r32) * 144 + (32 * jt + 4 * hi) * 2;
                    const v2u x0 = *(const LAS v2u*)(xp_), x1 = *(const LAS v2u*)(xp_ + 16), x2 = *(const LAS v2u*)(xp_ + 32), x3 = *(const LAS v2u*)(xp_ + 48);
                    v4u f0, f1; f0.x = x0.x; f0.y = x0.y; f0.z = x1.x; f0.w = x1.y; f1.x = x2.x; f1.y = x2.y; f1.z = x3.x; f1.w = x3.y;
                    y[pt] = MFMA32(__builtin_bit_cast(bf16x8, f0), p0, y[pt]); y[pt] = MFMA32(__builtin_bit_cast(bf16x8, f1), p1, y[pt]); }
            }
            float ss = 0.f;
            { const LAS unsigned char* zp_ = L + SO_Z + ii * 528 + (hl * 64 + 4 * hi) * 2;
#pragma unroll
              for (int pt = 0; pt < 2; ++pt)
#pragma unroll
                for (int gq = 0; gq < 4; ++gq) { const v2u zw = *(const LAS v2u*)(zp_ + (32 * pt + 8 * gq) * 2); const float zz[4] = {bflo(zw.x), bfhi(zw.x), bflo(zw.y), bfhi(zw.y)};
#pragma unroll
                    for (int e = 0; e < 4; ++e) { const float v = y[pt][4 * gq + e] * silu_f(zz[e]); y[pt][4 * gq + e] = v; ss += v * v; } } }
            ss = sum_x32(ss);
            if (g == 0) SO_FETCH_B(1);
            LAS float* ex = exch + it * 128;
            if (hi == 0) ex[hl * 32 + r32] = ss;
            __syncthreads();
            const float tot = (ex[r32] + ex[32 + r32]) + (ex[64 + r32] + ex[96 + r32]);
            const float rs = __builtin_amdgcn_rsqf(tot * (1.f / 256.f) + EPS);
            { bf16* mo = MIX + (size_t)(b * TT + t) * 1024 + 64 * h + 4 * hi;
#pragma unroll
              for (int pt = 0; pt < 2; ++pt)
#pragma unroll
                for (int gq = 0; gq < 4; ++gq) { const f32x4 gg = *(const f32x4*)(ng + 64 * h + 32 * pt + 8 * gq + 4 * hi);
                    v2u w; w.x = pk2(y[pt][4 * gq] * rs * gg.x, y[pt][4 * gq + 1] * rs * gg.y); w.y = pk2(y[pt][4 * gq + 2] * rs * gg.z, y[pt][4 * gq + 3] * rs * gg.w);
                    *(v2u*)(mo + 32 * pt + 8 * gq) = w; } }
        }
#undef SO_FETCH_A
#undef SO_FETCH_B
#undef SO_STORE
        __syncthreads();
    }
    const float* YS = (const float*)(F.ws + WS_YS);
    for (int u = F.gw; u < DB * NG; u += F.NGW) { const int b = u >> 1, gg = u & 1; const int cc = gg * 256 + 4 * F.lane;
        const f32x4 yv = *(const f32x4*)(YS + (size_t)b * 512 + cc); const v2u zw = *(const v2u*)(PROJ + (size_t)(RP + b) * PJ + C_Z + cc);
        const f32x4 v = {yv.x * silu_f(bflo(zw.x)), yv.y * silu_f(bfhi(zw.x)), yv.z * silu_f(bflo(zw.y)), yv.w * silu_f(bfhi(zw.y))};
        const float rs = __builtin_amdgcn_rsqf(wave_sum((v.x * v.x + v.y * v.y) + (v.z * v.z + v.w * v.w)) * (1.f / 256.f) + EPS);
        const f32x4 gv = *(const f32x4*)(ng + cc); v2u w; w.x = pk2(v.x * rs * gv.x, v.y * rs * gv.y); w.y = pk2(v.z * rs * gv.z, v.w * rs * gv.w);
        *(v2u*)(MIX + (size_t)(RP + b) * 1024 + cc) = w; }
}

constexpr int DB_STAGE = 0, DB_KRST = 65536, DB_LAT = DB_KRST + 8192, DB_KR = DB_LAT + 64 * DA_ROWB, DB_PB = DB_KR + 64 * 36 * 4, DB_QG = DB_PB + 16 * 64 * 2, DB_END = DB_QG + 8 * 96 * 4;
static_assert(DB_END <= RING_BYTES, "decode attention LDS map");
#define RAW_BAR_L() do { asm volatile("s_waitcnt lgkmcnt(0)" ::: "memory"); __builtin_amdgcn_s_barrier(); asm volatile("" ::: "memory"); } while (0)
#define RAW_BAR_VL() do { asm volatile("s_waitcnt vmcnt(0) lgkmcnt(0)" ::: "memory"); __builtin_amdgcn_s_barrier(); asm volatile("" ::: "memory"); } while (0)
__device__ __forceinline__ void da_issue(Frame& F, LAS unsigned char* L, const float* clat, const float* ckr, const int* ptab, int b, int split, int hp) {
    const size_t tok0 = (size_t)ptab[b * NPAGES + split * 32 + (hp >> 1)] * PAGE + (hp & 1) * 64;
    const char* src = (const char*)(clat + tok0 * KVL) + (size_t)(F.wave * 8) * 1024 + F.lane * 16;
#pragma unroll
    for (int i = 0; i < 8; ++i) __builtin_amdgcn_global_load_lds((const unsigned*)(src + i * 1024), (LAS unsigned*)(L + DB_STAGE + (F.wave * 8 + i) * 1024), 16, 0, 0);
    __builtin_amdgcn_global_load_lds((const unsigned*)((const char*)(ckr + tok0 * 32) + F.wave * 1024 + F.lane * 16), (LAS unsigned*)(L + DB_KRST + F.wave * 1024), 16, 0, 0);
}
__device__ __forceinline__ void da_convert(Frame& F, LAS unsigned char* L) {
#pragma unroll 4
    for (int k = 0; k < 8; ++k) { const int f = F.tid + NTHR * k; const int row = f >> 6, c4 = f & 63; const f32x4 v = *(const LAS f32x4*)(L + DB_STAGE + f * 16);
        v2u w; w.x = pk2(v.x, v.y); w.y = pk2(v.z, v.w); *(LAS v2u*)(L + DB_LAT + row * DA_ROWB + c4 * 8) = w; }
    { const int f = F.tid; const int row = f >> 3, c4 = f & 7; const f32x4 v = *(const LAS f32x4*)(L + DB_KRST + f * 16);
      *(LAS f32x4*)((LAS float*)(L + DB_KR) + row * 36 + 4 * c4) = v; }
}
template <int MODE>
__device__ __forceinline__ void p5_attn_decode_t(Frame& F, float M0) {
    const float* clat = (const float*)F.in[2]; const float* ckr = (const float*)F.in[3]; const int* ptab = (const int*)F.in[6];
    const bf16* WUKV = (const bf16*)(F.ws + WS_WUKV2); const bf16* Q = (const bf16*)(F.ws + WS_Q); const float* gkn = (const float*)F.in[22]; const float* gkr = (const float*)F.in[23];
    float* DPART = (float*)(F.ws + WS_DPART);
    LAS unsigned char* L = F.lds + RING_OFF;
    LAS float* krl = (LAS float*)(L + DB_KR); LAS bf16* pb = (LAS bf16*)(L + DB_PB); LAS float* qg = (LAS float*)(L + DB_QG) + F.wave * 96;
    const int h = F.wave, r32 = F.lane & 31, hi = F.lane >> 5;
    for (int u = blockIdx.x; u < DB * 2; u += F.G) {
        const int b = u >> 1, split = u & 1;
        da_issue(F, L, clat, ckr, ptab, b, split, 0);
        bf16x8 wf[4][8];
#pragma unroll
        for (int dt = 0; dt < 4; ++dt)
#pragma unroll
            for (int s = 0; s < 8; ++s) wf[dt][s] = *(const bf16x8*)(WUKV + (size_t)(128 * h + 16 * dt + (F.lane & 15)) * KVL + 32 * s + 8 * (F.lane >> 4));
        { const bf16* qp = Q + (size_t)(RP + b) * 768 + 96 * h; qg[F.lane] = bf2f(qp[F.lane]) * gkn[F.lane]; if (F.lane < 32) qg[64 + F.lane] = bf2f(qp[64 + F.lane]) * gkr[F.lane & 15]; }
        for (int i = F.tid; i < 16 * 64; i += NTHR) pb[i] = 0;
        f32x4 ao[2] = {(f32x4){0.f, 0.f, 0.f, 0.f}, (f32x4){0.f, 0.f, 0.f, 0.f}}; float l = 0.f;
        RAW_BAR_VL();
        da_convert(F, L);
        RAW_BAR_L();
        da_issue(F, L, clat, ckr, ptab, b, split, 1);
#pragma unroll 1
        for (int hp = 0; hp < 64; ++hp) {
          if (MODE == 0 || MODE == 3) {
            const int n16 = F.lane & 15, kg4 = F.lane >> 4;
#pragma unroll 1
            for (int sb = 0; sb < 2; ++sb) {
                const LAS unsigned char* bp = L + DB_LAT + (32 * sb + n16) * DA_ROWB + 16 * kg4;
                f32x4 acc[4][2];
#pragma unroll
                for (int dt = 0; dt < 4; ++dt) { acc[dt][0] = (f32x4){0.f, 0.f, 0.f, 0.f}; acc[dt][1] = acc[dt][0]; }
                bf16x8 fa[2], fb[2];
                fa[0] = *(const LAS bf16x8*)(bp); fa[1] = *(const LAS bf16x8*)(bp + 16 * DA_ROWB);
#pragma unroll
                for (int s = 0; s < 8; ++s) {
                    if (s < 7) { fb[0] = *(const LAS bf16x8*)(bp + 64 * (s + 1)); fb[1] = *(const LAS bf16x8*)(bp + 16 * DA_ROWB + 64 * (s + 1)); }
#pragma unroll
                    for (int dt = 0; dt < 4; ++dt) { acc[dt][0] = MFMA16(wf[dt][s], fa[0], acc[dt][0]); acc[dt][1] = MFMA16(wf[dt][s], fa[1], acc[dt][1]); }
                    fa[0] = fb[0]; fa[1] = fb[1];
                }
                __builtin_amdgcn_sched_barrier(0);
                f32x4 s4[2] = {(f32x4){0.f, 0.f, 0.f, 0.f}, (f32x4){0.f, 0.f, 0.f, 0.f}}, d4[2] = {s4[0], s4[0]};
#pragma unroll
                for (int dt = 0; dt < 4; ++dt) { const f32x4 qq = *(const LAS f32x4*)(qg + 16 * dt + 4 * kg4);
#pragma unroll
                    for (int tt = 0; tt < 2; ++tt) { s4[tt] += acc[dt][tt] * acc[dt][tt]; d4[tt] += acc[dt][tt] * qq; } }
                { const LAS float* qr = qg + 64 + 8 * kg4; const f32x4 q0 = *(const LAS f32x4*)(qr), q1 = *(const LAS f32x4*)(qr + 4);
#pragma unroll
                  for (int tt = 0; tt < 2; ++tt) { const LAS float* kr = krl + (32 * sb + 16 * tt + n16) * 36 + 8 * kg4; const f32x4 k0 = *(const LAS f32x4*)(kr), k1 = *(const LAS f32x4*)(kr + 4);
                      s4[tt] += k0 * k0; s4[tt] += k1 * k1; d4[tt] += k0 * q0; d4[tt] += k1 * q1; } }
                __builtin_amdgcn_sched_barrier(0);
#pragma unroll
                for (int tt = 0; tt < 2; ++tt) { float ss = (s4[tt].x + s4[tt].y) + (s4[tt].z + s4[tt].w), dot = (d4[tt].x + d4[tt].y) + (d4[tt].z + d4[tt].w);
                    ss = sum_x16(ss); dot = sum_x16(dot); ss = sum_x32(ss); dot = sum_x32(dot);
                    const float p = __builtin_amdgcn_exp2f(dot * __builtin_amdgcn_rsqf(ss * (1.f / 96.f) + EPS) - M0);
                    if (kg4 == 0) { l += p; pb[h * 64 + 32 * sb + 16 * tt + n16] = f2bf(p); } }
            }
            RAW_BAR_L();
            if (MODE < 4) { const int q4 = (F.lane & 15) >> 2, pp = F.lane & 3, kg = F.lane >> 4;
              const unsigned a_lo = (unsigned)(uintptr_t)(L + DB_LAT) + (unsigned)((8 * kg + q4) * DA_ROWB + (32 * h + 4 * pp) * 2);
              const LAS bf16* pap = pb + (F.lane & 15) * 64 + 8 * kg;
              s16x4 t0, t1, t2, t3, t4, t5, t6, t7;
              asm volatile("ds_read_b64_tr_b16 %0, %8 offset:%c9\n\tds_read_b64_tr_b16 %1, %8 offset:%c10\n\tds_read_b64_tr_b16 %2, %8 offset:%c11\n\tds_read_b64_tr_b16 %3, %8 offset:%c12\n\t"
                           "ds_read_b64_tr_b16 %4, %8 offset:%c13\n\tds_read_b64_tr_b16 %5, %8 offset:%c14\n\tds_read_b64_tr_b16 %6, %8 offset:%c15\n\tds_read_b64_tr_b16 %7, %8 offset:%c16\n\ts_waitcnt lgkmcnt(0)"
                           : "=&v"(t0), "=&v"(t1), "=&v"(t2), "=&v"(t3), "=&v"(t4), "=&v"(t5), "=&v"(t6), "=&v"(t7)
                           : "v"(a_lo), "i"(0), "i"(4 * DA_ROWB), "i"(32), "i"(32 + 4 * DA_ROWB), "i"(32 * DA_ROWB), "i"(32 * DA_ROWB + 4 * DA_ROWB), "i"(32 * DA_ROWB + 32), "i"(32 * DA_ROWB + 32 + 4 * DA_ROWB) : "memory");
              const bf16x8 pa0 = *(const LAS bf16x8*)(pap), pa1 = *(const LAS bf16x8*)(pap + 32);
#define DA_FR(x, y) ((bf16x8){x[0], x[1], x[2], x[3], y[0], y[1], y[2], y[3]})
              ao[0] = MFMA16(pa0, DA_FR(t0, t1), ao[0]); ao[1] = MFMA16(pa0, DA_FR(t2, t3), ao[1]);
              ao[0] = MFMA16(pa1, DA_FR(t4, t5), ao[0]); ao[1] = MFMA16(pa1, DA_FR(t6, t7), ao[1]);
#undef DA_FR
#define DA_PV(ks, nt) do { } while (0)
#undef DA_PV
            }
          }
            RAW_BAR_VL();
            if (hp + 1 < 64) { if (MODE <= 1 || MODE >= 3) da_convert(F, L); RAW_BAR_L(); if (hp + 2 < 64 && MODE < 3) da_issue(F, L, clat, ckr, ptab, b, split, hp + 2); }
        }
        if (MODE >= 3 && l == 123.456f) DPART[0] = l;
        if (MODE == 0) { const int kg = F.lane >> 4;
          if (kg < 2) {
#pragma unroll
              for (int nt = 0; nt < 2; ++nt)
#pragma unroll
                  for (int i = 0; i < 4; ++i) DPART[((size_t)((b * 2 + split) * NH + 4 * kg + i)) * 264 + 32 * h + 16 * nt + (F.lane & 15)] = ao[nt][i]; }
          float lt = wave_sum(l);
          if (F.lane == 0) DPART[((size_t)((b * 2 + split) * NH + h)) * 264 + 256] = lt; }
        RAW_BAR_L();
    }
}

__device__ __forceinline__ void p5_attn_decode(Frame& F, float M0) { p5_attn_decode_t<0>(F, M0); }

__device__ __forceinline__ void p6_decode_combine(Frame& F, float M0) {
    {
      const bf16* ATT = (const bf16*)(F.ws + WS_ATT); bf16* MIXo = (bf16*)(F.ws + WS_MIX); const float* mgg = (const float*)F.in[24];
      const f32x4 g0 = ((const f32x4*)mgg)[2 * F.lane], g1 = ((const f32x4*)mgg)[2 * F.lane + 1];
      for (int r0 = 4 * F.gw; r0 < MMAIN; r0 += 4 * F.NGW) { v4u xx[4];
#pragma unroll
          for (int i = 0; i < 4; ++i) { const int r = r0 + i; const size_t row = (size_t)(r >> 11) * TT + NMETA + (r & 2047); xx[i] = *(const v4u*)(ATT + row * 512 + 8 * F.lane); }
#pragma unroll
          for (int i = 0; i < 4; ++i) { const int r = r0 + i; const size_t row = (size_t)(r >> 11) * TT + NMETA + (r & 2047); const v4u x = xx[i];
          const float v[8] = {bflo(x.x), bfhi(x.x), bflo(x.y), bfhi(x.y), bflo(x.z), bfhi(x.z), bflo(x.w), bfhi(x.w)};
          float ss = 0.f;
#pragma unroll
          for (int e = 0; e < 8; ++e) ss += v[e] * v[e];
          const float rs = __builtin_amdgcn_rsqf(wave_sum(ss) * (1.f / MLAW) + EPS);
          v4u o; o.x = pk2(v[0] * rs * g0.x, v[1] * rs * g0.y); o.y = pk2(v[2] * rs * g0.z, v[3] * rs * g0.w); o.z = pk2(v[4] * rs * g1.x, v[5] * rs * g1.y); o.w = pk2(v[6] * rs * g1.z, v[7] * rs * g1.w);
          *(v4u*)(MIXo + row * 1024 + 512 + 8 * F.lane) = o; } } }
    const float* DPART = (const float*)(F.ws + WS_DPART); const bf16* WUKV = (const bf16*)(F.ws + WS_WUKV2); const bf16* Q = (const bf16*)(F.ws + WS_Q); const bf16* KS = (const bf16*)(F.ws + WS_KS);
    const float* VS = (const float*)(F.ws + WS_VS); const float* mg = (const float*)F.in[24]; bf16* MIX = (bf16*)(F.ws + WS_MIX);
    LAS float* accl = (LAS float*)(F.lds + RING_OFF) + F.wave * 256; LAS float* exch = (LAS float*)(F.lds + P5_EXCH);
    const int h = F.wave;
    for (int b = blockIdx.x; b < DB; b += F.G) {
        const float* p0 = DPART + ((size_t)((b * 2 + 0) * NH + h)) * 264; const float* p1 = DPART + ((size_t)((b * 2 + 1) * NH + h)) * 264;
#pragma unroll
        for (int k = 0; k < 4; ++k) accl[F.lane + 64 * k] = p0[F.lane + 64 * k] + p1[F.lane + 64 * k];
        float l = p0[256] + p1[256];
        const bf16* qp = Q + (size_t)(RP + b) * 768 + 96 * h; const bf16* kp = KS + (size_t)b * 768 + 96 * h;
        float sd = bf2f(qp[F.lane]) * bf2f(kp[F.lane]); if (F.lane < 32) sd += bf2f(qp[64 + F.lane]) * bf2f(kp[64 + F.lane]);
        sd = wave_sum(sd);
        const float pn = __builtin_amdgcn_exp2f(sd - M0); l += pn;
        LDS_WAIT(); asm volatile("" ::: "memory");
        const bf16* wv = WUKV + (size_t)(128 * h + 64 + F.lane) * KVL;
        float o = 0.f;
        { v4u wv4[32];
#pragma unroll
          for (int c8 = 0; c8 < 32; ++c8) wv4[c8] = *(const v4u*)(wv + 8 * c8);
#pragma unroll
          for (int c8 = 0; c8 < 32; ++c8) { const v4u w = wv4[c8]; const f32x4 x0 = *(const LAS f32x4*)(accl + 8 * c8), x1 = *(const LAS f32x4*)(accl + 8 * c8 + 4);
            o += (bflo(w.x) * x0.x + bfhi(w.x) * x0.y) + (bflo(w.y) * x0.z + bfhi(w.y) * x0.w) + (bflo(w.z) * x1.x + bfhi(w.z) * x1.y) + (bflo(w.w) * x1.z + bfhi(w.w) * x1.w); } }
        o = (o + pn * VS[(size_t)b * 512 + 64 * h + F.lane]) * __builtin_amdgcn_rcpf(l);
        const float ss = wave_sum(o * o);
        if (F.lane == 0) exch[h] = ss;
        __syncthreads();
        float tot = 0.f;
#pragma unroll
        for (int hh = 0; hh < NH; ++hh) tot += exch[hh];
        const float rs = __builtin_amdgcn_rsqf(tot * (1.f / MLAW) + EPS);
        MIX[(size_t)(RP + b) * 1024 + 512 + 64 * h + F.lane] = f2bf(o * rs * mg[64 * h + F.lane]);
        __syncthreads();
    }
}

__device__ __forceinline__ void p7_outproj(Frame& F) {
    const bf16* MIX = (const bf16*)(F.ws + WS_MIX); const bf16* WOUT = (const bf16*)(F.ws + WS_WOUT); const float* xp = (const float*)F.in[0]; const float* xs = (const float*)F.in[1]; float* HS = (float*)(F.ws + WS_HS);
    bf16* HB = (bf16*)(F.ws + WS_XN); float* SS = (float*)(F.ws + WS_SSP); float* ysamp = F.out + OUT_YS;
    { pg8::Gemm g{MIX, WOUT, MMAIN, DM, 1024, 1, 1024}; pg8::StaticOrder S; S.init(MMAIN, DM, F.G, (int)blockIdx.x); EpiOutProj E{xp, F.out + OUT_YP, HB, SS};
      pg8::gemm_phase<EpiOutProj, pg8::StaticOrder, true, true>(F.lds + RING_OFF, g, S, E); }
    { LAS f32x4* part = (LAS f32x4*)(F.lds + RING_OFF);
      for (int tp = blockIdx.x; tp < 256; tp += F.G) {
          const int t = 2 * tp + (F.wave >> 2), kq = F.wave & 3, rt = t & 7, ct = t >> 3;
          const bf16* ap = MIX + (size_t)(RP + rt * 16 + (F.lane & 15)) * 1024 + 256 * kq + 8 * (F.lane >> 4);
          const bf16* bp = WOUT + (size_t)(ct * 16 + (F.lane & 15)) * 1024 + 256 * kq + 8 * (F.lane >> 4);
          bf16x8 av[8], bv[8];
#pragma unroll
          for (int j = 0; j < 8; ++j) { av[j] = *(const bf16x8*)(ap + 32 * j); bv[j] = *(const bf16x8*)(bp + 32 * j); }
          f32x4 acc = {0.f, 0.f, 0.f, 0.f};
#pragma unroll
          for (int j = 0; j < 8; ++j) acc = MFMA16(av[j], bv[j], acc);
          part[F.wave * 64 + F.lane] = acc;
          __syncthreads();
          if (kq == 0) { acc = (acc + part[(F.wave + 1) * 64 + F.lane]) + (part[(F.wave + 2) * 64 + F.lane] + part[(F.wave + 3) * 64 + F.lane]);
              const int col = ct * 16 + (F.lane & 15);
#pragma unroll
              for (int i = 0; i < 4; ++i) { const int r = rt * 16 + 4 * (F.lane >> 4) + i; const size_t o = (size_t)r * DM + col; const float v = xs[o] + acc[i]; HS[o] = v; ysamp[o] = v; HB[(size_t)(RP + r) * DM + col] = f2bf(v);
                  float ss = v * v; ss = sum_x1(ss); ss = sum_x2(ss); ss = sum_x4(ss); ss = sum_x8(ss);
                  if ((F.lane & 15) == 0) SS[(size_t)MMAIN * 16 + (size_t)r * 64 + ct] = ss; } }
          __syncthreads();
      } }
}
__device__ __forceinline__ void p9_gateup(Frame& F) {
    const bf16* HB = (const bf16*)(F.ws + WS_XN); const bf16* WGU = (const bf16*)(F.ws + WS_WGU); bf16* ACT = (bf16*)(F.ws + WS_ACT); const float* SS = (const float*)(F.ws + WS_SSP);
    { pg8::Gemm g{HB, WGU, MMAIN, 2 * DFF, DM, 1, DM}; pg8::StaticOrder S; S.init(MMAIN, 2 * DFF, F.G, (int)blockIdx.x);
      LAS float* RS = (LAS float*)(F.lds + LDSCTL_OFF + 1024);
#pragma unroll 1
      for (int i = 0; i < 8; ++i) { pg8::Unit uu; if (!S.next(i, uu)) break;
          int tl = (int)threadIdx.x; asm volatile("" : "+v"(tl));
          if (tl < 256) { const pg8::f32x4* sp = (const pg8::f32x4*)(SS + (size_t)(uu.pm * 256 + tl) * 16); const pg8::f32x4 s4 = (sp[0] + sp[1]) + (sp[2] + sp[3]);
              RS[i * 256 + tl] = __builtin_amdgcn_rsqf(((s4[0] + s4[1]) + (s4[2] + s4[3])) * (1.f / DM) + EPS); } }
      __syncthreads();
      EpiSwiGLU E{ACT, RS, S};
      pg8::gemm_phase<EpiSwiGLU, pg8::StaticOrder, true, true>(F.lds + RING_OFF, g, S, E); }
    const int gw = F.gw, ngw = F.NGW;
    const int nrt = DB / 16, nlt = DFF / 16;
    for (int task = gw; task < nrt * nlt; task += ngw) {
        const int rt = task % nrt, lt = task / nrt; const int lc = lt * 16 + (F.lane & 15);
        const bf16* ap = HB + (size_t)(RP + rt * 16 + (F.lane & 15)) * DM + 8 * (F.lane >> 4);
        const bf16* gp = WGU + (size_t)(256 * (lc >> 7) + (lc & 127)) * DM + 8 * (F.lane >> 4); const bf16* up = gp + (size_t)128 * DM;
        f32x4 ag = {0.f, 0.f, 0.f, 0.f}, au = {0.f, 0.f, 0.f, 0.f};
#pragma unroll 8
        for (int k0 = 0; k0 < DM; k0 += 32) { const bf16x8 a = *(const bf16x8*)(ap + k0); ag = MFMA16(a, *(const bf16x8*)(gp + k0), ag); au = MFMA16(a, *(const bf16x8*)(up + k0), au); }
#pragma unroll
        for (int i = 0; i < 4; ++i) { const int r = rt * 16 + 4 * (F.lane >> 4) + i; const f32x4* sp = (const f32x4*)(SS + (size_t)MMAIN * 16 + (size_t)r * 64); f32x4 s4 = sp[0];
#pragma unroll
            for (int q = 1; q < 16; ++q) s4 += sp[q];
            const float rs = __builtin_amdgcn_rsqf(((s4[0] + s4[1]) + (s4[2] + s4[3])) * (1.f / DM) + EPS);
            ACT[(size_t)(RP + r) * DFF + lc] = f2bf(silu_f(rs * ag[i]) * (rs * au[i])); }
    }
}
__device__ __forceinline__ void p10_down(Frame& F) {
    const bf16* ACT = (const bf16*)(F.ws + WS_ACT); const bf16* WDN = (const bf16*)(F.ws + WS_WDN); const float* HS = (const float*)(F.ws + WS_HS);
    { pg8::Gemm g{ACT, WDN, MMAIN, DM, DFF, 1, DFF}; pg8::StaticOrder S; S.init(MMAIN, DM, F.G, (int)blockIdx.x); EpiDown E{(const bf16*)(F.ws + WS_XN), F.out + OUT_YP};
      pg8::gemm_phase<EpiDown, pg8::StaticOrder, true, true>(F.lds + RING_OFF, g, S, E); }
    float* ys = F.out + OUT_YS;
    small_gemm(ACT, DFF, WDN, DFF, DB / 16, DM / 16, [](int r) { return RP + r; },
        [&](const f32x4& acc, int rt, int ct, int lane) { const int col = ct * 16 + (lane & 15);
#pragma unroll
            for (int i = 0; i < 4; ++i) atomicAdd(ys + (size_t)(rt * 16 + 4 * (lane >> 4) + i) * DM + col, acc[i]); }, F.gw, F.NGW, F.lane, 4);
}
#ifndef MK_ONE_LAUNCH
#define MK_ONE_LAUNCH 0
#endif
constexpr int N_PHASES = 10;
__global__ void __launch_bounds__(NTHR, 2) mk_fwd(Args args) {
    extern __shared__ __attribute__((aligned(16))) unsigned char lds_raw[];
    Frame F;
    F.lds = (LAS unsigned char*)lds_raw;
    F.tid = threadIdx.x; F.lane = F.tid & 63; F.wave = __builtin_amdgcn_readfirstlane(F.tid >> 6);
    F.G = gridDim.x; { const int bx = blockIdx.x; F.vcu = (F.G % 8 == 0) ? (bx % 8) * (F.G / 8) + bx / 8 : bx; }
    F.gw = blockIdx.x * NWAVES + F.wave; F.NGW = F.G * NWAVES;
    F.ws = args.ws; F.out = args.out; F.in = args.in;
    volatile LAS unsigned* MISC = (volatile LAS unsigned*)(F.lds + MISC_OFF);
    for (int u = F.tid; u < (LDS_BYTES - LDSCTL_OFF) / 4; u += NTHR) ((LAS unsigned*)(F.lds + LDSCTL_OFF))[u] = 0u;
    __syncthreads();
    XcdBarrier bar; bar.bar = (unsigned*)(F.ws + WS_CTL) + CW_BAR; bar.x = 0; bar.st = nullptr;
    const int lo = args.ph_lo, hi = args.ph_hi;
    if (hi - lo > 1) bar = xcd_barrier_post((unsigned*)(F.ws + WS_CTL) + CW_BAR, MISC + 8);
#ifdef MK_TS
    unsigned long long* TSB = (unsigned long long*)(F.ws + 600 * MiB); int tsn = 0;
#define STAMP() do { if (blockIdx.x == 0 && F.tid == 0) TSB[tsn] = __builtin_amdgcn_s_memrealtime(); ++tsn; } while (0)
    STAMP();
#else
#define STAMP() do { } while (0)
#endif
#define IN(k) (lo <= (k) && (k) < hi)
#ifdef MK_TS
#define ARRIVE(k) do { if (blockIdx.x == 0 && F.tid == 0) TSB[30 + (k)] = __builtin_amdgcn_s_memrealtime(); } while (0)
#else
#define ARRIVE(k) do { } while (0)
#endif
#define SEAM(k) do { ARRIVE(k); if (IN(k) && IN((k) + 1)) xcd_barrier(bar); STAMP(); } while (0)
#ifndef MK_REPEAT
#define MK_REPEAT 0
#endif
#define REP(id, stmt) do { stmt; if (MK_REPEAT & (1 << (id))) { __syncthreads(); stmt; } } while (0)
    if (IN(0)) { REP(0, p0_prologue(F)); } SEAM(0);
    if (IN(1)) { REP(1, p1_inproj(F)); } SEAM(1);
    if (IN(2)) {
#ifdef MK_SLEEP_PROBE
        { const unsigned long long t0 = __builtin_amdgcn_s_memrealtime(); while (__builtin_amdgcn_s_memrealtime() - t0 < 3000ull) __builtin_amdgcn_s_sleep(32); }
#endif
        REP(2, p2_elementwise(F)); } SEAM(2);
    if (IN(3)) { REP(3, p3_upproj_states(F)); } SEAM(3);
    if (IN(4)) { REP(4, p4_post(F)); } SEAM(4);
    if (IN(5)) { const float M0 = softmax_ref(F);
        if (blockIdx.x & 1) { p5_attn_decode(F, M0); __syncthreads(); }
        p5_attn_prompt(F, M0); __syncthreads();
        p5_ssd_out(F); __syncthreads();
        if (!(blockIdx.x & 1)) p5_attn_decode(F, M0);
    } SEAM(5);
    if (IN(6)) { const float M0 = softmax_ref(F); REP(8, p6_decode_combine(F, M0)); } SEAM(6);
    if (IN(7)) { REP(9, p7_outproj(F)); } SEAM(7);
    if (IN(8)) { REP(11, p9_gateup(F)); } SEAM(8);
    if (IN(9)) { p10_down(F); }
#ifdef MK_TS
    __syncthreads(); STAMP();
#endif
#undef IN
#undef SEAM
}
#ifndef MK_DIAG
#define MK_DIAG 0
#endif
__device__ __forceinline__ size_t nmrow(size_t r) { return r < (size_t)MMAIN ? (r >> 11) * TT + NMETA + (r & 2047) : (size_t)RP + (r - MMAIN); }
constexpr size_t WS_OUT2 = 1024 * MiB;
#ifdef MK_TS
__global__ void k_ts_encode(const unsigned long long* ts, float* out, int ia0, int ia1, int ib0, int ib1) {
    const float ta = (float)(ts[ia1] - ts[ia0]) * 0.01f, tb = (float)(ts[ib1] - ts[ib0]) * 0.01f;
    const float f = 1.f + sqrtf(ta * 1e-3f);
    for (int i = blockIdx.x * blockDim.x + threadIdx.x; i < 131072; i += gridDim.x * blockDim.x) out[OUT_YS + i] *= f;
    if (blockIdx.x == 0 && threadIdx.x == 0) out[0] += tb * 0.1f;
}
#endif
extern "C" void kernel_launch(void* const* d_in, const int* in_sizes, int n_in, void* d_out, int out_size, void* d_ws, size_t ws_size, hipStream_t stream) {
    (void)hipFuncSetAttribute((const void*)mk_fwd, hipFuncAttributeMaxDynamicSharedMemorySize, LDS_BYTES);
    unsigned char* ws = (unsigned char*)d_ws;
    (void)hipMemsetAsync(ws + WS_CTL, 0, CTL_ZERO_BYTES, stream);
    Args a{};
    for (int i = 0; i < 30; ++i) a.in[i] = d_in[i];
    a.ws = ws; a.out = (float*)d_out;
#if MK_DIAG
    float* diag = (float*)(ws + WS_DIAG);
    (void)hipMemsetAsync(diag, 0, 512, stream);
    nv::forward(d_in, (float*)d_out, (float*)(ws + WS_NAIVE), stream);
    a.out = (float*)(ws + WS_OUT2);
#endif
    static int one_launch = -1;
    if (one_launch < 0) { int dev = 0, cus = 0, per_cu = 0; one_launch = 0;
        if (hipGetDevice(&dev) == hipSuccess && hipDeviceGetAttribute(&cus, hipDeviceAttributeMultiprocessorCount, dev) == hipSuccess && cus >= 256) one_launch = 1;
        (void)per_cu;
        (void)hipGetLastError(); }
    const int grid = 256;
    if (one_launch && MK_ONE_LAUNCH) { a.ph_lo = 0; a.ph_hi = N_PHASES; a.li = 0; hipLaunchKernelGGL(mk_fwd, dim3(grid), dim3(NTHR), LDS_BYTES, stream, a); }
    else for (int ph = 0; ph < N_PHASES; ++ph) { a.ph_lo = ph; a.ph_hi = ph + 1; a.li = ph; hipLaunchKernelGGL(mk_fwd, dim3(grid), dim3(NTHR), LDS_BYTES, stream, a); }
#ifdef MK_TS
    k_ts_encode<<<64, 256, 0, stream>>>((const unsigned long long*)(ws + 600 * MiB), (float*)d_out, MK_TS_A0, MK_TS_A1, MK_TS_B0, MK_TS_B1);
#endif
#if MK_DIAG
    {
        nv::Ws w = nv::carve((float*)(ws + WS_NAIVE));
        const bf16* QRAW = (const bf16*)(ws + WS_QRAW); const bf16* KVRAW = (const bf16*)(ws + WS_KVRAW); const bf16* Q = (const bf16*)(ws + WS_Q); const bf16* K = (const bf16*)(ws + WS_K);
        const bf16* VT = (const bf16*)(ws + WS_VT); const float* VS = (const float*)(ws + WS_VS); const bf16* MIX = (const bf16*)(ws + WS_MIX);
        const float* o2 = (const float*)(ws + WS_OUT2); const float* o1 = (const float*)d_out;
        const float* nQRAW = w.QRAW; const float* nKV = w.KV; const float* nQ = w.Q; const float* nK = w.K; const float* nV = w.V; const float* nMIX = w.MIX;
        const size_t NMR = (size_t)MMAIN + DB;
        cmp(stream, 0, diag, NMR * 768, [=] __device__(size_t i) { return bf2f(QRAW[nmrow(i / 768) * 768 + i % 768]); }, [=] __device__(size_t i) { return nQRAW[nmrow(i / 768) * 768 + i % 768]; });
        cmp(stream, 1, diag, (size_t)R * 1024, [=] __device__(size_t i) { return bf2f(KVRAW[i]); }, [=] __device__(size_t i) { return nKV[i]; });
        cmp(stream, 2, diag, NMR * 768, [=] __device__(size_t i) { return bf2f(Q[nmrow(i / 768) * 768 + i % 768]); }, [=] __device__(size_t i) { return nQ[nmrow(i / 768) * 768 + i % 768] * (ATTN_SCALE * LOG2E); });
        cmp(stream, 3, diag, (size_t)R * 768, [=] __device__(size_t i) { return bf2f(K[i]); }, [=] __device__(size_t i) { return nK[i]; });
        cmp(stream, 4, diag, (size_t)NB * 512 * TT, [=] __device__(size_t i) { const size_t bhd = i / TT; const int t = (int)(i % TT); return bf2f(VT[bhd * TPAD + t]); },
            [=] __device__(size_t i) { const size_t bhd = i / TT; const int t = (int)(i % TT); const size_t b = bhd / 512, hd = bhd % 512; return nV[(b * TT + t) * 512 + hd]; });
        cmp(stream, 4, diag, (size_t)DB * 512, [=] __device__(size_t i) { return VS[i]; }, [=] __device__(size_t i) { return nV[(size_t)RP * 512 + i]; });
        cmp(stream, 5, diag, (size_t)(OUT_LATS - OUT_SSMP), [=] __device__(size_t i) { return o2[OUT_SSMP + i]; }, [=] __device__(size_t i) { return o1[OUT_SSMP + i]; });
        cmp(stream, 5, diag, (size_t)4194304, [=] __device__(size_t i) { return o2[OUT_SSMS + i]; }, [=] __device__(size_t i) { return o1[OUT_SSMS + i]; });
        cmp(stream, 6, diag, (size_t)R * 512, [=] __device__(size_t i) { return bf2f(MIX[(i >> 9) * 1024 + (i & 511)]); }, [=] __device__(size_t i) { return nMIX[(i >> 9) * 1024 + (i & 511)]; });
        cmp(stream, 7, diag, NMR * 512, [=] __device__(size_t i) { return bf2f(MIX[nmrow(i >> 9) * 1024 + 512 + (i & 511)]); }, [=] __device__(size_t i) { return nMIX[nmrow(i >> 9) * 1024 + 512 + (i & 511)]; });
        cmp(stream, 8, diag, (size_t)OUT_LATP, [=] __device__(size_t i) { return o2[i]; }, [=] __device__(size_t i) { return o1[i]; });
        k_diag_encode<<<64, 256, 0, stream>>>(diag, 9, 1e-3f, (float*)d_out);
    }
#endif
}
```

```cpp
#define MK_DIAG 0
#define MK_ONE_LAUNCH 1
#include <hip/hip_runtime.h>
#include <cstdio>
#include <cstdint>
namespace pg8 {
#define PG8_LAS __attribute__((address_space(3)))
typedef unsigned short bf16_t;
typedef short bf16x8 __attribute__((ext_vector_type(8)));
typedef float f32x4 __attribute__((ext_vector_type(4)));
typedef unsigned u32x4 __attribute__((ext_vector_type(4)));
constexpr int BM = 256, BK = 64, HALF = 128, HTB = HALF * BK * 2  , STAGE_BYTES = 8 * HTB, NXCD = 8, WGM = 8;

__host__ __device__ __forceinline__ int lds_byte(int r, int c) { const int st = (r >> 4) * 2 + (c >> 5), rr = r & 15, cc = c & 31, ob = rr * 64 + cc * 2; return st * 1024 + (ob ^ (((ob >> 9) & 1) << 5)); }
__host__ __device__ __forceinline__ void stage_rc(int b, int& R, int& C) { const int st = b / 1024, sb = b % 1024, swz = sb ^ (((sb >> 9) & 1) << 5); R = (st >> 1) * 16 + swz / 64; C = (st & 1) * 32 + (swz % 64) / 2; }
__host__ __device__ __forceinline__ int perm32(int rho) { const int n = rho >> 4, i = rho & 15; return 8 * (i >> 2) + 4 * n + (i & 3); }

struct Unit { int pm, pn; };
template <class E> constexpr bool has_midscale = false;
struct Gemm { const bf16_t* A; const bf16_t* Bt; int M, N, K; int rmode; int lda;
    __host__ __device__ __forceinline__ int rowbase(int pm) const { return rmode ? (pm >> 3) * 2064 + 16 + (pm & 7) * 256 : pm * 256; } };

struct StaticOrder {
    int nM, nN, nwg, G, c;
    __host__ __device__ void init(int M, int N, int G_, int c_) { nM = M / BM; nN = N / BM; nwg = nM * nN; G = G_; c = c_; }
    __host__ __device__ bool next(int i, Unit& u) const {
        const long L = (long)i * G + c; if (L >= nwg) return false;
        int wgid = (int)L; { const int q = nwg / NXCD, r = nwg % NXCD, xcd = wgid % NXCD, off = wgid / NXCD; wgid = (xcd < r ? xcd * (q + 1) : r * (q + 1) + (xcd - r) * q) + off; }
        const int nig = WGM * nN, gid = wgid / nig, fm = gid * WGM, gsz = (nM - fm) < WGM ? (nM - fm) : WGM;
        u.pm = fm + ((wgid % nig) % gsz); u.pn = (wgid % nig) / gsz; return true;
    }
    __device__ __forceinline__ void a_ready(const Unit&) const {}
    __device__ __forceinline__ void done(const Unit&) const {}
};


template <class Epi, class Sched, bool ALIGN_EPI = false, bool SP2 = false, int ROT = 0>
__device__ __forceinline__ void gemm_phase(PG8_LAS unsigned char* lds, const Gemm g, const Sched& S, const Epi& E) {
    const int tid = threadIdx.x, wid = __builtin_amdgcn_readfirstlane(tid >> 6), lane = tid & 63, wr = wid >> 2, wc = wid & 3, fr = lane & 15, fq = lane >> 4;
    const int K = g.K, nt = K / BK;
    unsigned voffA[2], voffB[2];
#pragma unroll
    for (int i = 0; i < 2; ++i) { int R, C; stage_rc(tid * 16 + i * 8192, R, C); const int Rb = Epi::PERM ? ((R & ~31) + perm32(R & 31)) : R;
        voffA[i] = (unsigned)(R * g.lda + C) * 2u; voffB[i] = (unsigned)(Rb * K + C) * 2u; }
    const size_t kstep = (size_t)(BK * 2);
    const size_t hstepA = (size_t)HALF * g.lda * 2;
    const size_t hstep = (size_t)HALF * K * 2;
    const size_t tstep = 2 * hstep;
    const unsigned ldsw = (unsigned)wid * 1024u;
    const int aoff = lds_byte(wr * 64 + fr, fq * 8), boff = lds_byte(wc * 32 + fr, fq * 8);
#define PG8_SA(b, h) (((b) * 2 + (h)) * HTB)
#define PG8_SB(b, h) ((4 + (b) * 2 + (h)) * HTB)
#define PG8_STAGE(bufoff, gbase, voff) do { _Pragma("unroll") for (int _i = 0; _i < 2; ++_i) \
        __builtin_amdgcn_global_load_lds((const unsigned*)((const char*)(gbase) + (voff)[_i]), (PG8_LAS unsigned*)(lds + (bufoff) + ldsw + _i * 8192), 16, 0, 0); } while (0)
#define PG8_LDA(dst, b, h) do { _Pragma("unroll") for (int m = 0; m < 4; ++m) _Pragma("unroll") for (int k = 0; k < 2; ++k) dst[m][k] = *(const PG8_LAS bf16x8*)(lds + PG8_SA(b, h) + aoff + m * 2048 + k * 1024); } while (0)
#define PG8_LDB(dst, b, h) do { _Pragma("unroll") for (int n = 0; n < 2; ++n) _Pragma("unroll") for (int k = 0; k < 2; ++k) dst[n][k] = *(const PG8_LAS bf16x8*)(lds + PG8_SB(b, h) + boff + n * 2048 + k * 1024); } while (0)
#define PG8_MMA(ai, bj, At, Bt) do { __builtin_amdgcn_s_setprio(1); _Pragma("unroll") for (int m = 0; m < 4; ++m) _Pragma("unroll") for (int n = 0; n < 2; ++n) _Pragma("unroll") for (int k = 0; k < 2; ++k) \
        acc[ai][bj][m][n] = __builtin_amdgcn_mfma_f32_16x16x32_bf16(Bt[n][k], At[m][k], acc[ai][bj][m][n], 0, 0, 0); __builtin_amdgcn_s_setprio(0); } while (0)
#define PG8_WAIT_V(n) asm volatile("s_waitcnt vmcnt(" #n ")" ::: "memory")
#define PG8_WAIT_L(n) asm volatile("s_waitcnt lgkmcnt(" #n ")" ::: "memory")
#define PG8_BAR __builtin_amdgcn_s_barrier()
#define PG8_SCHED __builtin_amdgcn_sched_barrier(0)
    Unit cur, nxt; int ui = 0;
    if (!S.next(0, cur)) return;
    f32x4 acc[2][2][4][2];
#pragma unroll
    for (int a = 0; a < 2; ++a)
#pragma unroll
        for (int b = 0; b < 2; ++b)
#pragma unroll
            for (int m = 0; m < 4; ++m)
#pragma unroll
                for (int n = 0; n < 2; ++n) acc[a][b][m][n] = (f32x4){0.f, 0.f, 0.f, 0.f};
    bf16x8 At[4][2], B0[2][2], B1[2][2];
    const char* cA = (const char*)g.A + (size_t)g.rowbase(cur.pm) * g.lda * 2 + ROT * kstep; const char* cB = (const char*)g.Bt + (size_t)cur.pn * tstep + ROT * kstep;
#define PG8_KOFF(j) ((long)((ROT != 0 && (j) >= nt - ROT) ? (j) - nt : (j)) * (long)kstep)
    S.a_ready(cur);
    if constexpr (SP2) {
        PG8_STAGE(PG8_SB(0, 0), cB, voffB); PG8_STAGE(PG8_SB(0, 1), cB + hstep, voffB); PG8_STAGE(PG8_SA(0, 0), cA, voffA); PG8_STAGE(PG8_SA(0, 1), cA + hstepA, voffA);
        if (wr == 1) PG8_BAR;
        PG8_WAIT_V(2); PG8_BAR;
        PG8_STAGE(PG8_SB(1, 0), cB + kstep, voffB); PG8_STAGE(PG8_SA(1, 0), cA + kstep, voffA); PG8_STAGE(PG8_SB(1, 1), cB + hstep + kstep, voffB);
        PG8_WAIT_V(6); PG8_BAR;
    } else {
        PG8_STAGE(PG8_SB(0, 0), cB, voffB); PG8_STAGE(PG8_SA(0, 0), cA, voffA); PG8_STAGE(PG8_SB(0, 1), cB + hstep, voffB); PG8_STAGE(PG8_SA(0, 1), cA + hstepA, voffA);
        if (wr == 1) PG8_BAR;
        PG8_WAIT_V(4); PG8_BAR;
        PG8_STAGE(PG8_SB(1, 0), cB + kstep, voffB); PG8_STAGE(PG8_SA(1, 0), cA + kstep, voffA); PG8_STAGE(PG8_SB(1, 1), cB + hstep + kstep, voffB);
        PG8_WAIT_V(6); PG8_BAR;
    }
    for (;;) {
        const bool has_next = S.next(ui + 1, nxt);
        const char* nA = has_next ? (const char*)g.A + (size_t)g.rowbase(nxt.pm) * g.lda * 2 + ROT * kstep : cA; const char* nB = has_next ? (const char*)g.Bt + (size_t)nxt.pn * tstep + ROT * kstep : cB;
        for (int t = 0; t < nt; t += 2) {
            const bool last = (t == nt - 2);
            const char* a1 = cA + PG8_KOFF(t + 1);
            const char* a2 = last ? nA : cA + PG8_KOFF(t + 2); const char* b2 = last ? nB : cB + PG8_KOFF(t + 2);
            if constexpr (has_midscale<Epi>) { if (t == nt - ROT) E.midscale(acc, cur, wr, fr); }
            const char* a3 = a2 + kstep; const char* b3 = b2 + kstep;
            if (last && has_next) S.a_ready(nxt);
            if constexpr (SP2) {
            PG8_LDB(B0, 0, 0); PG8_LDB(B1, 0, 1); PG8_SCHED; PG8_LDA(At, 0, 0); PG8_STAGE(PG8_SA(1, 1), a1 + hstepA, voffA);
            PG8_WAIT_V(8); PG8_WAIT_L(0); PG8_BAR; PG8_MMA(0, 0, At, B0); PG8_MMA(0, 1, At, B1); PG8_BAR; PG8_SCHED;
            PG8_LDA(At, 0, 1); PG8_STAGE(PG8_SB(0, 0), b2, voffB); PG8_STAGE(PG8_SB(0, 1), b2 + hstep, voffB); PG8_STAGE(PG8_SA(0, 0), a2, voffA);
            PG8_WAIT_V(8); PG8_WAIT_L(0); PG8_BAR; PG8_MMA(1, 0, At, B0); PG8_MMA(1, 1, At, B1); PG8_BAR; PG8_SCHED;
            PG8_LDB(B0, 1, 0); PG8_LDB(B1, 1, 1); PG8_SCHED; PG8_LDA(At, 1, 0); PG8_STAGE(PG8_SA(0, 1), a2 + hstepA, voffA);
            PG8_WAIT_V(8); PG8_WAIT_L(0); PG8_BAR; PG8_MMA(0, 0, At, B0); PG8_MMA(0, 1, At, B1); PG8_BAR; PG8_SCHED;
            PG8_LDA(At, 1, 1); PG8_STAGE(PG8_SB(1, 0), b3, voffB); PG8_STAGE(PG8_SB(1, 1), b3 + hstep, voffB); PG8_STAGE(PG8_SA(1, 0), a3, voffA);
            PG8_WAIT_V(8); PG8_WAIT_L(0); PG8_BAR; PG8_MMA(1, 0, At, B0); PG8_MMA(1, 1, At, B1); PG8_BAR; PG8_SCHED;
            } else {
            PG8_LDB(B0, 0, 0); PG8_SCHED; PG8_LDA(At, 0, 0); PG8_STAGE(PG8_SA(1, 1), a1 + hstepA, voffA);
            PG8_WAIT_L(8); PG8_BAR; PG8_WAIT_L(0); PG8_MMA(0, 0, At, B0); PG8_BAR; PG8_SCHED;
            PG8_LDB(B1, 0, 1); PG8_STAGE(PG8_SB(0, 0), b2, voffB);
            PG8_BAR; PG8_WAIT_L(0); PG8_MMA(0, 1, At, B1); PG8_BAR;
            PG8_LDA(At, 0, 1); PG8_STAGE(PG8_SA(0, 0), a2, voffA);
            PG8_BAR; PG8_WAIT_L(0); PG8_MMA(1, 0, At, B0); PG8_BAR; PG8_SCHED;
            PG8_STAGE(PG8_SB(0, 1), b2 + hstep, voffB);
            PG8_WAIT_V(6); PG8_BAR; PG8_MMA(1, 1, At, B1); PG8_BAR;
            PG8_LDB(B0, 1, 0); PG8_SCHED; PG8_LDA(At, 1, 0); PG8_STAGE(PG8_SA(0, 1), a2 + hstepA, voffA);
            PG8_WAIT_L(8); PG8_BAR; PG8_WAIT_L(0); PG8_MMA(0, 0, At, B0); PG8_BAR; PG8_SCHED;
            PG8_LDB(B1, 1, 1); PG8_STAGE(PG8_SB(1, 0), b3, voffB);
            PG8_BAR; PG8_WAIT_L(0); PG8_MMA(0, 1, At, B1); PG8_BAR;
            PG8_LDA(At, 1, 1); PG8_STAGE(PG8_SA(1, 0), a3, voffA);
            PG8_BAR; PG8_WAIT_L(0); PG8_MMA(1, 0, At, B0); PG8_BAR; PG8_SCHED;
            PG8_STAGE(PG8_SB(1, 1), b3 + hstep, voffB);
            PG8_WAIT_V(6); PG8_BAR; PG8_MMA(1, 1, At, B1); PG8_BAR;
            }
        }
        if constexpr (ALIGN_EPI) { if (wr == 0) PG8_BAR; }
        if constexpr (!Epi::AFTER_DRAIN) { E(acc, cur, wr, wc, fr, fq); S.done(cur); }
        if (!has_next) break;
#pragma unroll
        for (int a = 0; a < 2; ++a)
#pragma unroll
            for (int b = 0; b < 2; ++b)
#pragma unroll
                for (int m = 0; m < 4; ++m)
#pragma unroll
                    for (int n = 0; n < 2; ++n) acc[a][b][m][n] = (f32x4){0.f, 0.f, 0.f, 0.f};
        cur = nxt; cA = nA; cB = nB; ++ui;
        if constexpr (ALIGN_EPI) { if (wr == 1) PG8_BAR; }
    }
    PG8_WAIT_V(0);
    if constexpr (!ALIGN_EPI) { if (wr == 0) PG8_BAR; }
    PG8_BAR;
    if constexpr (Epi::AFTER_DRAIN) { E.fused(acc, cur, wr, wc, fr, fq, lds, wid, lane); S.done(cur); }
#undef PG8_KOFF
#undef PG8_SA
#undef PG8_SB
#undef PG8_STAGE
#undef PG8_LDA
#undef PG8_LDB
#undef PG8_MMA
#undef PG8_WAIT_V
#undef PG8_WAIT_L
#undef PG8_BAR
#undef PG8_SCHED
}
}

#define GAS __attribute__((address_space(1)))
#define LAS __attribute__((address_space(3)))
typedef unsigned short bf16;
typedef unsigned v4u __attribute__((ext_vector_type(4)));
typedef unsigned v2u __attribute__((ext_vector_type(2)));
typedef float f32x4 __attribute__((ext_vector_type(4)));
typedef float f32x16 __attribute__((ext_vector_type(16)));
typedef short bf16x8 __attribute__((ext_vector_type(8)));
typedef short s16x4 __attribute__((ext_vector_type(4)));
typedef GAS unsigned gu32;
#define RLX_AGENT __ATOMIC_RELAXED, __HIP_MEMORY_SCOPE_AGENT
#define LDS_WAIT() asm volatile("s_waitcnt lgkmcnt(0)" ::: "memory")
#define VM_WAIT() asm volatile("s_waitcnt vmcnt(0)" ::: "memory")
typedef float f32x2_t __attribute__((ext_vector_type(2))); typedef __bf16 bf16x2_t __attribute__((ext_vector_type(2)));
__device__ __forceinline__ unsigned pk2(float lo, float hi) { f32x2_t v = {lo, hi}; bf16x2_t b = __builtin_convertvector(v, bf16x2_t); return __builtin_bit_cast(unsigned, b); }
__device__ __forceinline__ bf16 f2bf(float f) { return (bf16)(pk2(f, 0.f) & 0xffffu); }
__device__ __forceinline__ float bf2f(bf16 v) { return __uint_as_float((unsigned)v << 16); }
__device__ __forceinline__ float bflo(unsigned w) { return __uint_as_float(w << 16); }
__device__ __forceinline__ float bfhi(unsigned w) { return __uint_as_float(w & 0xffff0000u); }

#define XB_TMO      128
#define XB_XCNT(j)  (256  + 64 * (j))
#define XB_XSUB(j)  (1280 + 64 * (j))
#define XB_XGEN(j)  (2304 + 64 * (j))
#define XB_TOP      3328
#define XB_TOPGEN   3392
#define XCD_BAR_WORDS 3456
#define XB_SPIN_CAP (1u << 18)
__device__ __forceinline__ unsigned xb_ld(unsigned* p)              { return __hip_atomic_load(p, __ATOMIC_RELAXED, __HIP_MEMORY_SCOPE_AGENT); }
__device__ __forceinline__ unsigned xb_add(unsigned* p, unsigned v) { return __hip_atomic_fetch_add(p, v, __ATOMIC_RELAXED, __HIP_MEMORY_SCOPE_AGENT); }
__device__ __forceinline__ unsigned xb_xcc_id() { return (unsigned)__builtin_amdgcn_s_getreg((3 << 11) | 20) & 0xFu; }
#define XB_SPIN(cond, bar) do { unsigned _sp = 0; while (cond) { __builtin_amdgcn_s_sleep(1); \
    if ((++_sp & 255u) == 0u) { if (xb_ld(&(bar)[XB_TMO])) break; if (_sp > XB_SPIN_CAP) { atomicAdd(&(bar)[XB_TMO], 1u); break; } } } } while (0)
struct XcdBarrier { unsigned* bar; unsigned x; volatile LAS unsigned* st; };
__device__ __forceinline__ XcdBarrier xcd_barrier_post(unsigned* bar, volatile LAS unsigned* st) {
    XcdBarrier b; b.bar = bar; b.x = xb_xcc_id(); b.st = st;
    if (threadIdx.x == 0) (void)xb_add(&bar[XB_XCNT(b.x)], 1u);
    return b;
}
__device__ __forceinline__ void xcd_barrier_complete(unsigned* bar, unsigned x, unsigned& nloc, unsigned& nx) {
    const unsigned G = gridDim.x * gridDim.y * gridDim.z;
    unsigned sum, cnt, mine, sp = 0u;
    for (;;) {
        sum = 0u; cnt = 0u; mine = 0u;
#pragma unroll
        for (unsigned j = 0; j < 16; ++j) { const unsigned c = xb_ld(&bar[XB_XCNT(j)]); sum += c; cnt += (c > 0u) ? 1u : 0u; mine = (j == x) ? c : mine; }
        if (sum == G) break;
        __builtin_amdgcn_s_sleep(1);
        if ((++sp & 255u) == 0u) { if (xb_ld(&bar[XB_TMO])) break; if (sp > XB_SPIN_CAP) { atomicAdd(&bar[XB_TMO], 1u); break; } }
    }
    nloc = mine > 0u ? mine : 1u; nx = cnt > 0u ? cnt : 1u;
}
__device__ __forceinline__ void xcd_barrier(const XcdBarrier& b) {
    asm volatile("s_waitcnt vmcnt(0)" ::: "memory");
    __syncthreads();
    if (threadIdx.x == 0) {
        unsigned* bar = b.bar;
        __builtin_amdgcn_s_waitcnt(0);
        unsigned nloc = b.st[0], nx = b.st[1];
        if (nloc == 0u) { xcd_barrier_complete(bar, b.x, nloc, nx); b.st[0] = nloc; b.st[1] = nx; }
        const unsigned old = xb_add(&bar[XB_XSUB(b.x)], 1u);
        const unsigned gen = old / nloc;
        if (old + 1u == (gen + 1u) * nloc) {
            __builtin_amdgcn_fence(__ATOMIC_RELEASE, "agent");
            asm volatile("s_waitcnt vmcnt(0)" ::: "memory");
            const unsigned og = xb_add(&bar[XB_TOP], 1u);
            const unsigned tg = og / nx;
            if (og + 1u == (tg + 1u) * nx) xb_add(&bar[XB_TOPGEN], 1u);
            else XB_SPIN(xb_ld(&bar[XB_TOPGEN]) == tg, bar);
            __builtin_amdgcn_fence(__ATOMIC_ACQUIRE, "agent");
            xb_add(&bar[XB_XGEN(b.x)], 1u);
            asm volatile("s_waitcnt vmcnt(0)" ::: "memory");
        } else {
            XB_SPIN(xb_ld(&bar[XB_XGEN(b.x)]) == gen, bar);
            __builtin_amdgcn_fence(__ATOMIC_ACQUIRE, "agent");
            asm volatile("s_waitcnt vmcnt(0)" ::: "memory");
        }
    }
    __syncthreads();
}

constexpr int DM = 1024, NB = 8, SEQ = 2048, NMETA = 16, TT = SEQ + NMETA;
constexpr int DB = 128, PAST = 8192, PAGE = 128, NPAGES = 64;
constexpr int NH = 8, HP = 64, SSDW = 512, NG = 2, DS = 64, CONVD = 768;
constexpr int QKD = 96, VD = 64, MLAW = 512, QL = 384, KVL = 256, DFF = 2816, INC = 1960;
constexpr int RP = NB * TT, R = RP + DB;
constexpr int MMAIN = NB * SEQ;
constexpr int NS = NMETA + DB;
constexpr float EPS = 1e-6f, ATTN_SCALE = 0.10206207261596577f, LOG2E = 1.4426950408889634f;
constexpr int PJ = 2048, C_Z = 0, C_XBC = 512, C_CKV = 1280, C_CQ = 1536, C_DT = 1920, C_KR = 1928;
constexpr int S_Z = 0, S_XBC = 512, S_DT = 1280, S_CQ = 1288, S_CKV = 1672, S_KR = 1928;
constexpr int TPAD = 2112;
constexpr int NCH = 33, CHL = 64, TOFF = 48;
constexpr size_t OUT_YP = 0, OUT_YS = 16777216, OUT_LATP = 16908288, OUT_KRP = 21135360, OUT_CONVP = 21663744,
                 OUT_SSMP = 21682176, OUT_LATS = 21944320, OUT_KRS = 21977088, OUT_CONVS = 21981184, OUT_SSMS = 22276096;

constexpr size_t MiB = 1u << 20;
constexpr size_t WS_CTL = 0, CTL_ZERO_BYTES = 32 * 1024;
constexpr int CW_BAR = 4096;
constexpr size_t WS_SS = 512 * 1024;
constexpr size_t WS_WIN = 2 * MiB;
constexpr size_t WS_WUQ = 6 * MiB;
constexpr size_t WS_WUKV = 7 * MiB;
constexpr size_t WS_WOUT = 8 * MiB;
constexpr size_t WS_WGU = 10 * MiB;
constexpr size_t WS_WDN = 22 * MiB;
constexpr size_t WS_XN = 32 * MiB;
constexpr size_t WS_PROJ = 66 * MiB;
constexpr size_t WS_DTRAW = 132 * MiB;
constexpr size_t WS_DT = 133 * MiB;
constexpr size_t WS_LAT = 134 * MiB;
constexpr size_t WS_CQN = 143 * MiB;
constexpr size_t WS_KRF = 156 * MiB;
constexpr size_t WS_XST = 159 * MiB;
constexpr size_t WS_BT = 176 * MiB;
constexpr size_t WS_BC = 181 * MiB;
constexpr size_t WS_XAS = 190 * MiB;
constexpr size_t WS_QRAW = 191 * MiB;
constexpr size_t WS_KVRAW = 216 * MiB;
constexpr size_t WS_Q = 249 * MiB;
constexpr size_t WS_K = 274 * MiB;
constexpr size_t WS_VT = 299 * MiB;
constexpr size_t WS_STATES = 316 * MiB;
constexpr size_t WS_DECAY = 350 * MiB;
constexpr size_t WS_HIN = 351 * MiB;
constexpr size_t WS_MIX = 368 * MiB;
constexpr size_t WS_ACT = 401 * MiB;
constexpr size_t WS_VS = 491 * MiB;
constexpr size_t WS_DPART = 492 * MiB;
constexpr size_t WS_HS = 494 * MiB;
constexpr size_t WS_ROPE = 496 * MiB;
constexpr size_t WS_SSP = 520 * MiB;
constexpr size_t WS_WUKV2 = 524 * MiB;
constexpr size_t WS_RQ = 522 * MiB;
constexpr size_t WS_SSQ = 526 * MiB;
constexpr size_t WS_OPT_END = 527 * MiB;
constexpr int CW_DCNT = 1024;
constexpr size_t WS_NAIVE = 2048 * MiB;
constexpr size_t WS_DIAG = 1 * MiB;

constexpr int RING_OFF = 0, RING_BYTES = 131072;
constexpr int LDSCTL_OFF = RING_BYTES, MISC_OFF = LDSCTL_OFF + 320;
constexpr int LDS_BYTES = 163840;
constexpr int NWAVES = 8, NTHR = 512;

struct Args { const void* in[30]; float* out; unsigned char* ws; int ph_lo, ph_hi, li, pad; };

struct Frame {
    LAS unsigned char* lds;
    int tid, lane, wave, G, vcu, gw, NGW;
    unsigned char* ws; float* out;
    const void* const* in;
};
#define DPP_F(x, ctrl) __builtin_bit_cast(float, __builtin_amdgcn_update_dpp(0, __builtin_bit_cast(int, (x)), (ctrl), 0xF, 0xF, true))
__device__ __forceinline__ float sum_x1(float x) { return x + DPP_F(x, 0xB1); }
__device__ __forceinline__ float sum_x2(float x) { return x + DPP_F(x, 0x4E); }
__device__ __forceinline__ float sum_x4(float x) { return x + DPP_F(x, 0x141); }
__device__ __forceinline__ float sum_x8(float x) { return x + DPP_F(x, 0x140); }
__device__ __forceinline__ float sum_x16(float x) { const unsigned u = __builtin_bit_cast(unsigned, x); const auto r = __builtin_amdgcn_permlane16_swap(u, u, false, false); return __uint_as_float(r[0]) + __uint_as_float(r[1]); }
__device__ __forceinline__ float sum_x32(float x) { const unsigned u = __builtin_bit_cast(unsigned, x); const auto r = __builtin_amdgcn_permlane32_swap(u, u, false, false); return __uint_as_float(r[0]) + __uint_as_float(r[1]); }
__device__ __forceinline__ float wave_sum(float v) { return sum_x32(sum_x16(sum_x8(sum_x4(sum_x2(sum_x1(v)))))); }
__device__ __forceinline__ float wave_max(float v) {
#pragma unroll
    for (int o = 1; o < 64; o <<= 1) v = fmaxf(v, __shfl_xor(v, o));
    return v;
}
__device__ __forceinline__ float silu_f(float x) { return x * __builtin_amdgcn_rcpf(1.f + __expf(-x)); }
__device__ __forceinline__ float softplus_f(float x) { return fmaxf(x, 0.f) + log1pf(expf(-fabsf(x))); }
__device__ __forceinline__ float rope_inv(int j) { return exp2f(-(float)j * (13.287712379549449f / 16.0f)); }
struct EpiProj {
    static constexpr bool PERM = true, AFTER_DRAIN = false;
    bf16* O; float* dtraw; int rmode;
    __device__ __forceinline__ void operator()(const pg8::f32x4 (&acc)[2][2][4][2], const pg8::Unit& u, int wr, int wc, int fr, int fq) const {
        const int rb = rmode ? (u.pm >> 3) * 2064 + 16 + (u.pm & 7) * 256 : u.pm * 256;
        const int row0 = rb + wr * 64 + fr, col0 = u.pn * 256 + wc * 32 + 8 * fq;
#pragma unroll
        for (int ai = 0; ai < 2; ++ai)
#pragma unroll
            for (int m = 0; m < 4; ++m) { const int row = row0 + ai * 128 + m * 16; bf16* rowp = O + (size_t)row * PJ + col0;
#pragma unroll
                for (int bj = 0; bj < 2; ++bj) { const pg8::f32x4 v0 = acc[ai][bj][m][0], v1 = acc[ai][bj][m][1];
                    v4u w; w.x = pk2(v0[0], v0[1]); w.y = pk2(v0[2], v0[3]); w.z = pk2(v1[0], v1[1]); w.w = pk2(v1[2], v1[3]);
                    *(v4u*)(rowp + bj * 128) = w; }
                if (u.pn == 7 && wc == 0 && fq == 0) { *(pg8::f32x4*)(dtraw + (size_t)row * 8) = acc[ai][1][m][0]; *(pg8::f32x4*)(dtraw + (size_t)row * 8 + 4) = acc[ai][1][m][1]; } }
    }
};
struct EpiBf16 {
    static constexpr bool PERM = true, AFTER_DRAIN = false;
    bf16* O; int ldc; int rmode;
    __device__ __forceinline__ void operator()(const pg8::f32x4 (&acc)[2][2][4][2], const pg8::Unit& u, int wr, int wc, int fr, int fq) const {
        const int rb = rmode ? (u.pm >> 3) * 2064 + 16 + (u.pm & 7) * 256 : u.pm * 256;
        const int row0 = rb + wr * 64 + fr, col0 = u.pn * 256 + wc * 32 + 8 * fq;
#pragma unroll
        for (int ai = 0; ai < 2; ++ai)
#pragma unroll
            for (int m = 0; m < 4; ++m) { bf16* rowp = O + (size_t)(row0 + ai * 128 + m * 16) * ldc + col0;
#pragma unroll
                for (int bj = 0; bj < 2; ++bj) { const pg8::f32x4 v0 = acc[ai][bj][m][0], v1 = acc[ai][bj][m][1];
                    v4u w; w.x = pk2(v0[0], v0[1]); w.y = pk2(v0[2], v0[3]); w.z = pk2(v1[0], v1[1]); w.w = pk2(v1[2], v1[3]);
                    *(v4u*)(rowp + bj * 128) = w; } }
    }
};
struct EpiResF32 {
    static constexpr bool PERM = false, AFTER_DRAIN = false;
    const float* res; float* out;
    __device__ __forceinline__ void operator()(const pg8::f32x4 (&acc)[2][2][4][2], const pg8::Unit& u, int wr, int wc, int fr, int fq) const {
        const int row0 = u.pm * 256 + wr * 64 + fr, col0 = u.pn * 256 + wc * 32 + 4 * fq;
#pragma unroll
        for (int ai = 0; ai < 2; ++ai)
#pragma unroll
            for (int m = 0; m < 4; ++m) { const size_t off = (size_t)(row0 + ai * 128 + m * 16) * DM + col0;
#pragma unroll
                for (int bj = 0; bj < 2; ++bj)
#pragma unroll
                    for (int n = 0; n < 2; ++n) { const pg8::f32x4 r = *(const pg8::f32x4*)(res + off + bj * 128 + n * 16); *(pg8::f32x4*)(out + off + bj * 128 + n * 16) = r + acc[ai][bj][m][n]; } }
    }
};
struct EpiOutProj {
    static constexpr bool PERM = false, AFTER_DRAIN = false;
    const float* res; float* out; bf16* HB; float* SS; const LAS float* RS; pg8::StaticOrder S;
    __device__ __forceinline__ void midscale(pg8::f32x4 (&acc)[2][2][4][2], const pg8::Unit& u, int wr, int fr) const {
        int slot = 0;
#pragma unroll 1
        for (int i = 0; i < 8; ++i) { pg8::Unit uu; if (!S.next(i, uu)) break; if (uu.pm == u.pm && uu.pn == u.pn) { slot = i; break; } }
        const LAS float* rsp = RS + slot * 256 + wr * 64 + fr;
#pragma unroll
        for (int ai = 0; ai < 2; ++ai)
#pragma unroll
            for (int m = 0; m < 4; ++m) { const float rs = rsp[ai * 128 + m * 16];
#pragma unroll
                for (int bj = 0; bj < 2; ++bj)
#pragma unroll
                    for (int n = 0; n < 2; ++n) acc[ai][bj][m][n] *= rs; }
    }
    __device__ __forceinline__ void operator()(const pg8::f32x4 (&acc)[2][2][4][2], const pg8::Unit& u, int wr, int wc, int fr, int fq) const {
        const int rb = (u.pm >> 3) * 2064 + 16 + (u.pm & 7) * 256;
        const int row0 = u.pm * 256 + wr * 64 + fr, col0 = u.pn * 256 + wc * 32 + 4 * fq;
        pg8::f32x4 rc[4], rn[4];
#define EOP_LOAD(dst, g) do { const size_t off_ = (size_t)(row0 + ((g) >> 2) * 128 + ((g) & 3) * 16) * DM + col0; \
            dst[0] = *(const pg8::f32x4*)(res + off_); dst[1] = *(const pg8::f32x4*)(res + off_ + 16); dst[2] = *(const pg8::f32x4*)(res + off_ + 128); dst[3] = *(const pg8::f32x4*)(res + off_ + 144); } while (0)
        EOP_LOAD(rc, 0);
#pragma unroll
        for (int g = 0; g < 8; ++g) { const int ai = g >> 2, m = g & 3;
            if (g < 7) EOP_LOAD(rn, g + 1);
            const int orow = row0 + ai * 128 + m * 16; bf16* hb = HB + (size_t)(rb + wr * 64 + fr + ai * 128 + m * 16) * DM + col0; float ss = 0.f;
#pragma unroll
            for (int bj = 0; bj < 2; ++bj)
#pragma unroll
                for (int n = 0; n < 2; ++n) { const pg8::f32x4 v = rc[2 * bj + n] + acc[ai][bj][m][n];
                    ss += (v[0] * v[0] + v[1] * v[1]) + (v[2] * v[2] + v[3] * v[3]); v2u w; w.x = pk2(v[0], v[1]); w.y = pk2(v[2], v[3]); *(v2u*)(hb + bj * 128 + n * 16) = w; }
            ss = sum_x16(ss); ss = sum_x32(ss);
            if (fq == 0) SS[(size_t)orow * 16 + u.pn * 4 + wc] = ss;
#pragma unroll
            for (int i = 0; i < 4; ++i) rc[i] = rn[i]; }
#undef EOP_LOAD
    }
};
namespace pg8 { template <> constexpr bool has_midscale<EpiOutProj> = true; }
struct EpiDown {
    static constexpr bool PERM = false, AFTER_DRAIN = false;
    const bf16* HB; float* out;
    __device__ __forceinline__ void operator()(const pg8::f32x4 (&acc)[2][2][4][2], const pg8::Unit& u, int wr, int wc, int fr, int fq) const {
        const int rb = (u.pm >> 3) * 2064 + 16 + (u.pm & 7) * 256;
        const int row0 = u.pm * 256 + wr * 64 + fr, col0 = u.pn * 256 + wc * 32 + 4 * fq;
        v2u rc[4], rn[4];
#define EDN_LOAD(dst, g) do { const bf16* hb_ = HB + (size_t)(rb + wr * 64 + fr + ((g) >> 2) * 128 + ((g) & 3) * 16) * DM + col0; \
            dst[0] = *(const v2u*)(hb_); dst[1] = *(const v2u*)(hb_ + 16); dst[2] = *(const v2u*)(hb_ + 128); dst[3] = *(const v2u*)(hb_ + 144); } while (0)
        EDN_LOAD(rc, 0);
#pragma unroll
        for (int g = 0; g < 8; ++g) { const int ai = g >> 2, m = g & 3;
            if (g < 7) EDN_LOAD(rn, g + 1);
            const size_t off = (size_t)(row0 + ai * 128 + m * 16) * DM + col0;
#pragma unroll
            for (int bj = 0; bj < 2; ++bj)
#pragma unroll
                for (int n = 0; n < 2; ++n) { const v2u w = rc[2 * bj + n]; const pg8::f32x4 r = {bflo(w.x), bfhi(w.x), bflo(w.y), bfhi(w.y)}; *(pg8::f32x4*)(out + off + bj * 128 + n * 16) = r + acc[ai][bj][m][n]; }
#pragma unroll
            for (int i = 0; i < 4; ++i) rc[i] = rn[i]; }
#undef EDN_LOAD
    }
};
struct EpiSwiGLU {
    static constexpr bool PERM = true, AFTER_DRAIN = false;
    bf16* O; const LAS float* RS; pg8::StaticOrder S;
    __device__ __forceinline__ void operator()(const pg8::f32x4 (&acc)[2][2][4][2], const pg8::Unit& u, int wr, int wc, int fr, int fq) const {
        const int rb = (u.pm >> 3) * 2064 + 16 + (u.pm & 7) * 256;
        const int row0 = rb + wr * 64 + fr, col0 = u.pn * 128 + wc * 32 + 8 * fq;
        int slot = 0;
#pragma unroll 1
        for (int i = 0; i < 8; ++i) { pg8::Unit uu; if (!S.next(i, uu)) break; if (uu.pm == u.pm && uu.pn == u.pn) { slot = i; break; } }
        const LAS float* rsp = RS + slot * 256 + wr * 64 + fr;
#pragma unroll
        for (int ai = 0; ai < 2; ++ai)
#pragma unroll
            for (int m = 0; m < 4; ++m) { float a[8]; const float rs = rsp[ai * 128 + m * 16];
#pragma unroll
                for (int n = 0; n < 2; ++n)
#pragma unroll
                    for (int e = 0; e < 4; ++e) a[4 * n + e] = silu_f(rs * acc[ai][0][m][n][e]) * (rs * acc[ai][1][m][n][e]);
                v4u w; w.x = pk2(a[0], a[1]); w.y = pk2(a[2], a[3]); w.z = pk2(a[4], a[5]); w.w = pk2(a[6], a[7]);
                *(v4u*)(O + (size_t)(row0 + ai * 128 + m * 16) * DFF + col0) = w; }
    }
};

template <class ARow, class Epi>
__device__ __forceinline__ void small_gemm(const bf16* A, int lda, const bf16* Bt, int K, int nrt, int nct, const ARow& arow, const Epi& E, int gw, int NGW, int lane, int ksplit = 1) {
    const int ntask = nrt * nct * ksplit, kc = K / ksplit;
    for (int task = gw; task < ntask; task += NGW) {
        const int rt = task % nrt, ct = (task / nrt) % nct, kq = task / (nrt * nct);
        const bf16* ap = A + (size_t)arow(rt * 16 + (lane & 15)) * lda + kq * kc + 8 * (lane >> 4);
        const bf16* bp = Bt + (size_t)(ct * 16 + (lane & 15)) * K + kq * kc + 8 * (lane >> 4);
        f32x4 acc = {0.f, 0.f, 0.f, 0.f};
#pragma unroll 1
        for (int k0 = 0; k0 < kc; k0 += 32 * 11) {
            bf16x8 av[11], bv[11];
#pragma unroll
            for (int j = 0; j < 11; ++j) if (k0 + 32 * j < kc) { av[j] = *(const bf16x8*)(ap + k0 + 32 * j); bv[j] = *(const bf16x8*)(bp + k0 + 32 * j); }
#pragma unroll
            for (int j = 0; j < 11; ++j) if (k0 + 32 * j < kc) acc = __builtin_amdgcn_mfma_f32_16x16x32_bf16(av[j], bv[j], acc, 0, 0, 0);
        }
        E(acc, rt, ct, lane);
    }
}

template <class RM>
__device__ __forceinline__ void transpose_item(const float* W, int N, int ldw, bf16* WT, int ldt, int item, LAS float* scr, int lane, const RM& rm, const float* kscale = nullptr) {
    const int nblk = (N + 31) / 32, kb = item / nblk, nb = item % nblk, k0 = 64 * kb, n0 = 32 * nb;
    { const int n = n0 + (lane & 31); float v[32];
#pragma unroll
      for (int i = 0; i < 32; ++i) { const int kk = 2 * i + (lane >> 5); v[i] = (n < N) ? W[(size_t)(k0 + kk) * ldw + n] : 0.f; }
#pragma unroll
      for (int i = 0; i < 32; ++i) { const int kk = 2 * i + (lane >> 5); float x = v[i]; if (kscale) x *= kscale[k0 + kk]; scr[kk * 33 + (lane & 31)] = x; } }
    LDS_WAIT(); asm volatile("" ::: "memory");
    const int c = lane & 7;
#pragma unroll
    for (int j = 0; j < 4; ++j) { const int n = (lane >> 3) + 8 * j; const LAS float* s = scr + (8 * c) * 33 + n;
        if (n0 + n < N) { v4u o; o.x = pk2(s[0 * 33], s[1 * 33]); o.y = pk2(s[2 * 33], s[3 * 33]); o.z = pk2(s[4 * 33], s[5 * 33]); o.w = pk2(s[6 * 33], s[7 * 33]);
            *(v4u*)(WT + (size_t)rm(n0 + n) * ldt + k0 + 8 * c) = o; } }
    LDS_WAIT(); asm volatile("" ::: "memory");
}
__device__ __forceinline__ int map_in(int n) {
    return n < S_DT ? n : n < S_CQ ? C_DT + (n - S_DT) : n < S_CKV ? C_CQ + (n - S_CQ) : n < S_KR ? C_CKV + (n - S_CKV) : n;
}
__device__ __forceinline__ void p0_prologue(Frame& F) {
    LAS float* scr = (LAS float*)(F.lds + RING_OFF + F.wave * 16384);
    const float* w_in = (const float*)F.in[9]; const float* w_uq = (const float*)F.in[17]; const float* w_ukv = (const float*)F.in[19]; const float* w_out = (const float*)F.in[25];
    const float* w_gate = (const float*)F.in[27]; const float* w_up = (const float*)F.in[28]; const float* w_down = (const float*)F.in[29];
    bf16* WIN = (bf16*)(F.ws + WS_WIN); bf16* WUQ = (bf16*)(F.ws + WS_WUQ); bf16* WUKV = (bf16*)(F.ws + WS_WUKV); bf16* WOUT = (bf16*)(F.ws + WS_WOUT); bf16* WGU = (bf16*)(F.ws + WS_WGU); bf16* WDN = (bf16*)(F.ws + WS_WDN);
    const float* ffg = (const float*)F.in[26];
    constexpr int I_IN = 16 * 62, I_UQ = 6 * 24, I_UKV = 4 * 32, I_OUT = 16 * 32, I_G = 16 * 88, I_DN = 44 * 32;
    constexpr int NITEMS = I_IN + I_UQ + 2 * I_UKV + I_OUT + 2 * I_G + I_DN;
    bf16* WUKV2 = (bf16*)(F.ws + WS_WUKV2);
    for (int it = F.gw; it < NITEMS; it += F.NGW) {
        int r = it;
        if (r < I_IN) { transpose_item(w_in, INC, INC, WIN, DM, r, scr, F.lane, [](int n) { return map_in(n); }); continue; } r -= I_IN;
        if (r < I_UQ) { transpose_item(w_uq, 768, 768, WUQ, QL, r, scr, F.lane, [](int n) { return n; }, (const float*)F.in[16]); continue; } r -= I_UQ;
        if (r < I_UKV) { transpose_item(w_ukv, 1024, 1024, WUKV, KVL, r, scr, F.lane, [](int n) { return n; }, (const float*)F.in[18]); continue; } r -= I_UKV;
        if (r < I_UKV) { transpose_item(w_ukv, 1024, 1024, WUKV2, KVL, r, scr, F.lane, [](int n) { return n; }); continue; } r -= I_UKV;
        if (r < I_OUT) { transpose_item(w_out, DM, DM, WOUT, 1024, r, scr, F.lane, [](int n) { return n; }, (r >= 8 * 32) ? (const float*)F.in[24] - 512 : nullptr); continue; } r -= I_OUT;
        if (r < I_G) { transpose_item(w_gate, DFF, DFF, WGU, DM, r, scr, F.lane, [](int n) { return 256 * (n >> 7) + (n & 127); }, ffg); continue; } r -= I_G;
        if (r < I_G) { transpose_item(w_up, DFF, DFF, WGU, DM, r, scr, F.lane, [](int n) { return 256 * (n >> 7) + 128 + (n & 127); }, ffg); continue; } r -= I_G;
        transpose_item(w_down, DM, DM, WDN, DFF, r, scr, F.lane, [](int n) { return n; });
    }
    for (int i = F.gw * 64 + F.lane; i < 88 * 1024 / 8; i += F.NGW * 64) *(v4u*)(WIN + (size_t)1960 * 1024 + (size_t)i * 8) = (v4u){0u, 0u, 0u, 0u};
    const float* xp = (const float*)F.in[0]; const float* xs = (const float*)F.in[1]; const float* meta = (const float*)F.in[7]; const float* g = (const float*)F.in[8];
    bf16* XN = (bf16*)(F.ws + WS_XN);
    f32x4 gv[4];
#pragma unroll
    for (int j = 0; j < 4; ++j) gv[j] = ((const f32x4*)g)[F.lane + 64 * j];
#define XN_ROWS(r0, n) do { f32x4 v[4][4]; \
        _Pragma("unroll") for (int i = 0; i < 4; ++i) if (i < (n)) { const int row = (r0) + i; const float* src; \
            if (row < RP) { const int b = row / TT, t = row % TT; src = (t < NMETA) ? meta + (size_t)t * DM : xp + ((size_t)b * SEQ + (t - NMETA)) * DM; } else src = xs + (size_t)(row - RP) * DM; \
            _Pragma("unroll") for (int j = 0; j < 4; ++j) v[i][j] = ((const f32x4*)src)[F.lane + 64 * j]; } \
        _Pragma("unroll") for (int i = 0; i < 4; ++i) if (i < (n)) { float s = 0.f; \
            _Pragma("unroll") for (int j = 0; j < 4; ++j) s += (v[i][j].x * v[i][j].x + v[i][j].y * v[i][j].y) + (v[i][j].z * v[i][j].z + v[i][j].w * v[i][j].w); \
            const float rs = __builtin_amdgcn_rsqf(wave_sum(s) * (1.f / DM) + EPS); \
            v2u* o8 = (v2u*)(XN + (size_t)((r0) + i) * DM) + F.lane; \
            _Pragma("unroll") for (int j = 0; j < 4; ++j) { v2u o; o.x = pk2(v[i][j].x * rs * gv[j].x, v[i][j].y * rs * gv[j].y); o.y = pk2(v[i][j].z * rs * gv[j].z, v[i][j].w * rs * gv[j].w); o8[64 * j] = o; } } } while (0)
    if (F.NGW == 2048) { XN_ROWS(4 * F.gw, 4); XN_ROWS(8192 + 4 * F.gw, 4); if (F.gw < 256) XN_ROWS(16384 + F.gw, 1); }
    else for (int r0 = 4 * F.gw; r0 < R; r0 += 4 * F.NGW) XN_ROWS(r0, 4);
#undef XN_ROWS
    float* ROPE = (float*)(F.ws + WS_ROPE);
    for (int i = blockIdx.x * NTHR + F.tid; i < (TT + 1) * 16; i += F.G * NTHR) { const int p = i >> 4, j = i & 15; const float ang = (float)(p < TT ? p : PAST) * rope_inv(j); ROPE[2 * i] = cosf(ang); ROPE[2 * i + 1] = sinf(ang); }
}

__device__ __forceinline__ int small_arow(int r) { return r < NMETA ? r : RP + (r - NMETA); }
__device__ __forceinline__ void p1_inproj(Frame& F) {
    const bf16* XN = (const bf16*)(F.ws + WS_XN); const bf16* WIN = (const bf16*)(F.ws + WS_WIN); bf16* PROJ = (bf16*)(F.ws + WS_PROJ); float* DTRAW = (float*)(F.ws + WS_DTRAW);
    { pg8::Gemm g{XN, WIN, MMAIN, PJ, DM, 1, DM}; pg8::StaticOrder S; S.init(MMAIN, PJ, F.G, (int)blockIdx.x);
      EpiProj E{PROJ, DTRAW, 1};
      pg8::gemm_phase<EpiProj, pg8::StaticOrder, true, true>(F.lds + RING_OFF, g, S, E); }
    auto epi = [&](const f32x4& acc, int rt, int ct, int lane) {
        const int col = ct * 16 + (lane & 15);
#pragma unroll
        for (int i = 0; i < 4; ++i) { const int r = rt * 16 + 4 * (lane >> 4) + i; const bf16 v = f2bf(acc[i]);
            if (r < NMETA) { for (int b = 0; b < NB; ++b) { PROJ[(size_t)(b * TT + r) * PJ + col] = v; if (col >= C_DT && col < C_DT + 8) DTRAW[(size_t)(b * TT + r) * 8 + (col - C_DT)] = acc[i]; } }
            else { const int row = RP + (r - NMETA); PROJ[(size_t)row * PJ + col] = v; if (col >= C_DT && col < C_DT + 8) DTRAW[(size_t)row * 8 + (col - C_DT)] = acc[i]; } }
    };
    small_gemm(XN, DM, WIN, DM, NS / 16, PJ / 16, [](int r) { return small_arow(r); }, epi, F.gw, F.NGW, F.lane);
}

constexpr int CV_LDS_STRIDE = 82;
__device__ __forceinline__ void p2_elementwise(Frame& F) {
    const bf16* PROJ = (const bf16*)(F.ws + WS_PROJ); const float* DTRAW = (const float*)(F.ws + WS_DTRAW); float* DT = (float*)(F.ws + WS_DT);
    float* RQS = (float*)(F.ws + WS_RQ); float* KRF = (float*)(F.ws + WS_KRF);
    const float* kvg = (const float*)F.in[18]; const float* qng = (const float*)F.in[16]; const float* dtb = (const float*)F.in[12]; const float* ROPE = (const float*)(F.ws + WS_ROPE);
    {
        const f32x4 gg = ((const f32x4*)kvg)[F.lane]; const float* gq = qng + 6 * F.lane; const float g0 = gq[0], g1 = gq[1], g2 = gq[2], g3 = gq[3], g4 = gq[4], g5 = gq[5]; const float dbias = dtb[F.lane & 7];
        v2u wk[4], wkn[4]; unsigned wq[4][3], wqn[4][3]; unsigned short kr1[4], kr2[4], kr1n[4], kr2n[4]; float dtr[4], dtrn[4]; f32x2_t cs[4], csn[4];
#define P2A_LOAD(WK, WQ, K1, K2, DTR, CS, r0, n) do { _Pragma("unroll") for (int i = 0; i < 4; ++i) if (i < (n)) { const int row = (r0) + i; const bf16* pr = PROJ + (size_t)row * PJ; \
            WK[i] = *(const v2u*)(pr + C_CKV + 4 * F.lane); const unsigned* p = (const unsigned*)(pr + C_CQ + 6 * F.lane); WQ[i][0] = p[0]; WQ[i][1] = p[1]; WQ[i][2] = p[2]; \
            K1[i] = pr[C_KR + (F.lane & 15)]; K2[i] = pr[C_KR + 16 + (F.lane & 15)]; DTR[i] = DTRAW[(size_t)row * 8 + (F.lane & 7)]; \
            CS[i] = *(const f32x2_t*)(ROPE + 2 * ((row < RP ? row % TT : TT) * 16 + (F.lane & 15))); } } while (0)
#define P2A_PROC(r0, n) do { _Pragma("unroll") for (int i = 0; i < 4; ++i) if (i < (n)) { const int row = (r0) + i; \
            { const float v0 = bflo(wk[i].x), v1 = bfhi(wk[i].x), v2 = bflo(wk[i].y), v3 = bfhi(wk[i].y); \
              const float rs = __builtin_amdgcn_rsqf(wave_sum((v0 * v0 + v1 * v1) + (v2 * v2 + v3 * v3)) * (1.f / KVL) + EPS); \
              const f32x4 o = {v0 * rs * gg.x, v1 * rs * gg.y, v2 * rs * gg.z, v3 * rs * gg.w}; \
              float* of = (row < RP) ? F.out + OUT_LATP + (size_t)row * KVL : F.out + OUT_LATS + (size_t)(row - RP) * KVL; \
              ((f32x4*)of)[F.lane] = o; if (F.lane == 0) RQS[R + row] = rs; } \
            { const float v0 = bflo(wq[i][0]), v1 = bfhi(wq[i][0]), v2 = bflo(wq[i][1]), v3 = bfhi(wq[i][1]), v4 = bflo(wq[i][2]), v5 = bfhi(wq[i][2]); \
              const float rs = __builtin_amdgcn_rsqf(wave_sum((v0 * v0 + v1 * v1) + (v2 * v2 + v3 * v3) + (v4 * v4 + v5 * v5)) * (1.f / QL) + EPS); \
              if (F.lane == 0) RQS[row] = rs; } \
            if (F.lane < 16) { const int j = F.lane; const float c = cs[i].x, s = cs[i].y; \
              const float x1 = bf2f(kr1[i]), x2 = bf2f(kr2[i]); const float y1 = x1 * c - x2 * s, y2 = x1 * s + x2 * c; \
              KRF[(size_t)row * 32 + j] = y1; KRF[(size_t)row * 32 + 16 + j] = y2; \
              float* of = (row < RP) ? F.out + OUT_KRP + (size_t)row * 32 : F.out + OUT_KRS + (size_t)(row - RP) * 32; of[j] = y1; of[16 + j] = y2; } \
            if (F.lane < 8) DT[(size_t)row * 8 + F.lane] = softplus_f(dtr[i] + dbias); } } while (0)
#define P2A_ROT() do { _Pragma("unroll") for (int i = 0; i < 4; ++i) { wk[i] = wkn[i]; wq[i][0] = wqn[i][0]; wq[i][1] = wqn[i][1]; wq[i][2] = wqn[i][2]; kr1[i] = kr1n[i]; kr2[i] = kr2n[i]; dtr[i] = dtrn[i]; cs[i] = csn[i]; } } while (0)
        if (F.NGW == 2048) {
            const int ra = 4 * F.gw, rb2 = 8192 + 4 * F.gw, rc = 16384 + F.gw;
            P2A_LOAD(wk, wq, kr1, kr2, dtr, cs, ra, 4);
            P2A_LOAD(wkn, wqn, kr1n, kr2n, dtrn, csn, rb2, 4);
            P2A_PROC(ra, 4); P2A_ROT();
            if (F.gw < 256) P2A_LOAD(wkn, wqn, kr1n, kr2n, dtrn, csn, rc, 1);
            P2A_PROC(rb2, 4);
            if (F.gw < 256) { P2A_ROT(); P2A_PROC(rc, 1); }
        } else {
            for (int r0 = 4 * F.gw; r0 < R; r0 += 4 * F.NGW) { P2A_LOAD(wk, wq, kr1, kr2, dtr, cs, r0, 4); P2A_PROC(r0, 4); }
        }
#undef P2A_LOAD
#undef P2A_PROC
#undef P2A_ROT
    }
    const float* cw = (const float*)F.in[10]; const float* cb = (const float*)F.in[11];
    bf16* XST = (bf16*)(F.ws + WS_XST); bf16* BT = (bf16*)(F.ws + WS_BT); bf16* BC = (bf16*)(F.ws + WS_BC);
    LAS bf16* tile = (LAS bf16*)(F.lds + RING_OFF);
    for (int i = blockIdx.x * NTHR + F.tid; i < NB * 640 * 6; i += F.G * NTHR) { const int rowi = i / 6, pc = i % 6; const int bb = rowi / 640, cc = rowi % 640;
        bf16* dst = (cc < SSDW) ? XST + ((size_t)(bb * SSDW + cc)) * TPAD : BT + ((size_t)(bb * 128 + (cc - SSDW))) * TPAD; *(v4u*)(dst + pc * 8) = (v4u){0u, 0u, 0u, 0u}; }
    for (int u = blockIdx.x; u < NB * 32 * 3; u += F.G) {
        const int third = u % 3, tb = 1 + (u / 3) % 32, b = u / 96; const int t0 = tb * CHL - TOFF;
        {
            const int cl = 2 * (F.tid & 127), c = third * 256 + cl, tq = F.tid >> 7;
            const float w0a = cw[0 * CONVD + c], w1a = cw[1 * CONVD + c], w2a = cw[2 * CONVD + c], w3a = cw[3 * CONVD + c], ba = cb[c];
            const float w0b = cw[0 * CONVD + c + 1], w1b = cw[1 * CONVD + c + 1], w2b = cw[2 * CONVD + c + 1], w3b = cw[3 * CONVD + c + 1], bb = cb[c + 1];
            const bf16* base = PROJ + (size_t)b * TT * PJ + C_XBC + c;
#define CV_QUARTER(tfirst, lcol) do { float xa[19], xb[19]; \
                _Pragma("unroll") for (int k = 0; k < 19; ++k) { const int t = (tfirst) - 3 + k; xa[k] = 0.f; xb[k] = 0.f; if (t >= 0) { const unsigned w = *(const unsigned*)(base + (size_t)t * PJ); xa[k] = bflo(w); xb[k] = bfhi(w); } } \
                _Pragma("unroll") for (int k = 0; k < 16; ++k) { const int t = (tfirst) + k; \
                    const float ya = silu_f(ba + xa[k] * w0a + xa[k + 1] * w1a + xa[k + 2] * w2a + xa[k + 3] * w3a), yb = silu_f(bb + xb[k] * w0b + xb[k + 1] * w1b + xb[k + 2] * w2b + xb[k + 3] * w3b); \
                    const unsigned pk = pk2(ya, yb); \
                    tile[cl * CV_LDS_STRIDE + (lcol) + k] = (bf16)(pk & 0xffffu); tile[(cl + 1) * CV_LDS_STRIDE + (lcol) + k] = (bf16)(pk >> 16); \
                    if (third == 2) *(unsigned*)(BC + (size_t)(b * TT + t) * 256 + cl) = pk; } } while (0)
            CV_QUARTER(t0 + 16 * tq, 16 * tq);
            if (tb == 1 && tq == 0) CV_QUARTER(0, 64);
#undef CV_QUARTER
        }
        __syncthreads();
        { const int nrows = (third == 2) ? 128 : 256; const int npc = (tb == 1) ? 10 : 8;
          for (int i = F.tid; i < nrows * npc; i += NTHR) { const int cl = i / npc, pc = i % npc;
            const LAS unsigned* s = (const LAS unsigned*)(tile + cl * CV_LDS_STRIDE + pc * 8); v4u o; o.x = s[0]; o.y = s[1]; o.z = s[2]; o.w = s[3];
            bf16* dst = (third < 2) ? XST + ((size_t)(b * SSDW + third * 256 + cl)) * TPAD : BT + ((size_t)(b * 128 + cl)) * TPAD;
            *(v4u*)(dst + ((pc < 8) ? tb * CHL + pc * 8 : TOFF + (pc - 8) * 8)) = o; } }
        __syncthreads();
    }
    const float* sconv = (const float*)F.in[4]; float* XAS = (float*)(F.ws + WS_XAS);
    for (int i = blockIdx.x * NTHR + F.tid; i < DB * CONVD; i += F.G * NTHR) { const int b = i / CONVD, c = i % CONVD;
        const float xc = bf2f(PROJ[(size_t)(RP + b) * PJ + C_XBC + c]);
        const float s0 = sconv[(size_t)(b * 3 + 0) * CONVD + c], s1 = sconv[(size_t)(b * 3 + 1) * CONVD + c], s2 = sconv[(size_t)(b * 3 + 2) * CONVD + c];
        XAS[i] = silu_f(cb[c] + s0 * cw[c] + s1 * cw[CONVD + c] + s2 * cw[2 * CONVD + c] + xc * cw[3 * CONVD + c]);
        float* oc = F.out + OUT_CONVS + (size_t)b * 3 * CONVD + c; oc[0] = s1; oc[CONVD] = s2; oc[2 * CONVD] = xc; }
    for (int i = blockIdx.x * NTHR + F.tid; i < NB * 3 * CONVD; i += F.G * NTHR) { const int b = i / (3 * CONVD), k = (i / CONVD) % 3, c = i % CONVD;
        F.out[OUT_CONVP + i] = bf2f(PROJ[(size_t)(b * TT + TT - 3 + k) * PJ + C_XBC + c]); }
}
#define MFMA32(a, b, c) __builtin_amdgcn_mfma_f32_32x32x16_bf16((a), (b), (c), 0, 0, 0)
#define MFMA16(a, b, c) __builtin_amdgcn_mfma_f32_16x16x32_bf16((a), (b), (c), 0, 0, 0)
__device__ __forceinline__ int crow(int reg, int hi) { return (reg & 3) + 8 * (reg >> 2) + 4 * hi; }
__device__ __forceinline__ bf16x8 pack8(const f32x16& x, int s) {
    v4u p; p.x = pk2(x[8 * s + 0], x[8 * s + 1]); p.y = pk2(x[8 * s + 2], x[8 * s + 3]); p.z = pk2(x[8 * s + 4], x[8 * s + 5]); p.w = pk2(x[8 * s + 6], x[8 * s + 7]);
    return __builtin_bit_cast(bf16x8, p);
}
__device__ __forceinline__ bf16x8 ld2x8(const bf16* p0, const bf16* p1) {
    const v2u a = *(const v2u*)p0, b = *(const v2u*)p1; v4u r; r.x = a.x; r.y = a.y; r.z = b.x; r.w = b.y; return __builtin_bit_cast(bf16x8, r);
}
__device__ __forceinline__ float softmax_ref(Frame& F) {
    const float* gqn = (const float*)F.in[20]; const float* gqr = (const float*)F.in[21]; const float* gkn = (const float*)F.in[22]; const float* gkr = (const float*)F.in[23];
    float a = fabsf(gqn[F.lane]), b = fabsf(gkn[F.lane]);
    if (F.lane < 16) { a = fmaxf(a, fabsf(gqr[F.lane])); b = fmaxf(b, fabsf(gkr[F.lane])); }
    return LOG2E * 9.797958971132712f * wave_max(a) * wave_max(b) * 1.0001f;
}
constexpr size_t WS_YS = 495 * MiB;
constexpr size_t WS_KS = 498 * MiB;
constexpr int NKT = 65;

__device__ __forceinline__ void p3_upproj_states(Frame& F) {
    const bf16* PROJ = (const bf16*)(F.ws + WS_PROJ); const bf16* WUQ = (const bf16*)(F.ws + WS_WUQ); const bf16* WUKV = (const bf16*)(F.ws + WS_WUKV);
    bf16* QRAW = (bf16*)(F.ws + WS_QRAW); bf16* KVRAW = (bf16*)(F.ws + WS_KVRAW);
    { pg8::Gemm g{PROJ + C_CQ, WUQ, MMAIN, 768, QL, 1, PJ}; pg8::StaticOrder S; S.init(MMAIN, 768, F.G, (int)blockIdx.x); EpiBf16 E{QRAW, 768, 1};
      pg8::gemm_phase<EpiBf16, pg8::StaticOrder, true, true>(F.lds + RING_OFF, g, S, E); }
    { pg8::Gemm g{PROJ + C_CKV, WUKV, MMAIN, 1024, KVL, 1, PJ}; pg8::StaticOrder S; S.init(MMAIN, 1024, F.G, (int)blockIdx.x); EpiBf16 E{KVRAW, 1024, 1};
      pg8::gemm_phase<EpiBf16, pg8::StaticOrder, true, true>(F.lds + RING_OFF, g, S, E); }
    const bool sub = (F.G == 256);
    const int sgw = sub ? (blockIdx.x - 192) * NWAVES + F.wave : F.gw, sngw = sub ? 64 * NWAVES : F.NGW;
    if (!sub || blockIdx.x >= 192) {
    small_gemm(PROJ + C_CQ, PJ, WUQ, QL, DB / 16, 768 / 16, [](int r) { return RP + r; },
        [&](const f32x4& acc, int rt, int ct, int lane) { const int col = ct * 16 + (lane & 15);
#pragma unroll
            for (int i = 0; i < 4; ++i) QRAW[(size_t)(RP + rt * 16 + 4 * (lane >> 4) + i) * 768 + col] = f2bf(acc[i]); }, sgw, sngw, F.lane);
    small_gemm(PROJ + C_CKV, PJ, WUKV, KVL, NS / 16, 1024 / 16, [](int r) { return small_arow(r); },
        [&](const f32x4& acc, int rt, int ct, int lane) { const int col = ct * 16 + (lane & 15);
#pragma unroll
            for (int i = 0; i < 4; ++i) { const int r = rt * 16 + 4 * (lane >> 4) + i; const bf16 v = f2bf(acc[i]);
                if (r < NMETA) { for (int b = 0; b < NB; ++b) KVRAW[(size_t)(b * TT + r) * 1024 + col] = v; } else KVRAW[(size_t)(RP + r - NMETA) * 1024 + col] = v; } }, sgw, sngw, F.lane);
    }
    const float* DT = (const float*)(F.ws + WS_DT); const float* a_log = (const float*)F.in[13];
    const bf16* XST = (const bf16*)(F.ws + WS_XST); const bf16* BT = (const bf16*)(F.ws + WS_BT);
    float* STATES = (float*)(F.ws + WS_STATES); float* DECAY = (float*)(F.ws + WS_DECAY);
    LAS float* wl = (LAS float*)(F.lds + RING_OFF + F.wave * 1024);
    const int r32 = F.lane & 31, hi = F.lane >> 5;
    for (int u = F.gw; u < NB * NCH * NH; u += F.NGW) {
        const int h = u % NH, c = (u / NH) % NCH, b = u / (NH * NCH); const int g = h >> 2;
        const int t = c * CHL - TOFF + F.lane;
        const float dt = (t >= 0) ? DT[(size_t)(b * TT + t) * 8 + h] : 0.f;
        const float A = -__expf(a_log[h]);
        float acs = dt * A;
#pragma unroll
        for (int o = 1; o < 64; o <<= 1) { const float v = __shfl_up(acs, o); if (F.lane >= o) acs += v; }
        const float last = __shfl(acs, 63);
        wl[F.lane] = __expf(last - acs) * dt;
        LDS_WAIT(); asm volatile("" ::: "memory");
        f32x16 acc[2][2];
#pragma unroll
        for (int i = 0; i < 2; ++i)
#pragma unroll
            for (int j = 0; j < 2; ++j) acc[i][j] = (f32x16){};
        const bf16* xb = XST + ((size_t)(b * SSDW + h * HP)) * TPAD + c * CHL; const bf16* bb = BT + ((size_t)(b * 128 + g * DS)) * TPAD + c * CHL;
#pragma unroll
        for (int s = 0; s < 4; ++s) {
            const f32x4 w0 = *(const LAS f32x4*)(wl + 16 * s + 8 * hi), w1 = *(const LAS f32x4*)(wl + 16 * s + 8 * hi + 4);
            bf16x8 af[2], bfr[2];
#pragma unroll
            for (int pt = 0; pt < 2; ++pt) { const v4u x = *(const v4u*)(xb + (size_t)(32 * pt + r32) * TPAD + 16 * s + 8 * hi);
                v4u y; y.x = pk2(bflo(x.x) * w0.x, bfhi(x.x) * w0.y); y.y = pk2(bflo(x.y) * w0.z, bfhi(x.y) * w0.w); y.z = pk2(bflo(x.z) * w1.x, bfhi(x.z) * w1.y); y.w = pk2(bflo(x.w) * w1.z, bfhi(x.w) * w1.w);
                af[pt] = __builtin_bit_cast(bf16x8, y); }
#pragma unroll
            for (int nt = 0; nt < 2; ++nt) bfr[nt] = *(const bf16x8*)(bb + (size_t)(32 * nt + r32) * TPAD + 16 * s + 8 * hi);
#pragma unroll
            for (int pt = 0; pt < 2; ++pt)
#pragma unroll
                for (int nt = 0; nt < 2; ++nt) acc[pt][nt] = MFMA32(af[pt], bfr[nt], acc[pt][nt]);
        }
        float* so = STATES + ((size_t)((b * NCH + c) * NH + h)) * 4096;
#pragma unroll
        for (int pt = 0; pt < 2; ++pt)
#pragma unroll
            for (int nt = 0; nt < 2; ++nt)
#pragma unroll
                for (int rg = 0; rg < 16; ++rg) so[(32 * pt + crow(rg, hi)) * 64 + 32 * nt + r32] = acc[pt][nt][rg];
        if (F.lane == 0) DECAY[(b * NCH + c) * NH + h] = __expf(last);
        LDS_WAIT(); asm volatile("" ::: "memory");
    }
}

#ifdef MK_TS
#define P4_STAMP(k) do { if (blockIdx.x == 0 && F.tid == 0) ((unsigned long long*)(F.ws + 600 * MiB))[20 + (k)] = __builtin_amdgcn_s_memrealtime(); } while (0)
#else
#define P4_STAMP(k) do { } while (0)
#endif
__device__ __forceinline__ void p4_post(Frame& F) {
    const bf16* QRAW = (const bf16*)(F.ws + WS_QRAW); const bf16* KVRAW = (const bf16*)(F.ws + WS_KVRAW); const float* KRF = (const float*)(F.ws + WS_KRF);
    bf16* Q = (bf16*)(F.ws + WS_Q); bf16* K = (bf16*)(F.ws + WS_K); bf16* VT = (bf16*)(F.ws + WS_VT); float* VS = (float*)(F.ws + WS_VS);
    const float* gqn = (const float*)F.in[20]; const float* gqr = (const float*)F.in[21]; const float* gkn = (const float*)F.in[22]; const float* gkr = (const float*)F.in[23];
    const float* ROPE = (const float*)(F.ws + WS_ROPE); const float* RQS = (const float*)(F.ws + WS_RQ);
    const int h = F.lane >> 3, sub = F.lane & 7;
    bf16* KS = (bf16*)(F.ws + WS_KS);
    for (int row = RP + F.gw; row < R; row += F.NGW) {
        const int t = PAST;
        if (row >= RP) { const bf16* kp = KVRAW + (size_t)row * 1024 + 128 * h + 8 * sub; const v4u kw = *(const v4u*)kp; const v4u vw = *(const v4u*)(kp + 64);
          const f32x4 kr = *(const f32x4*)(KRF + (size_t)row * 32 + 4 * sub);
          const float rkv = RQS[R + row];
          float kn[8] = {bflo(kw.x) * rkv, bfhi(kw.x) * rkv, bflo(kw.y) * rkv, bfhi(kw.y) * rkv, bflo(kw.z) * rkv, bfhi(kw.z) * rkv, bflo(kw.w) * rkv, bfhi(kw.w) * rkv};
          float ss = (kr.x * kr.x + kr.y * kr.y) + (kr.z * kr.z + kr.w * kr.w);
#pragma unroll
          for (int e = 0; e < 8; ++e) ss += kn[e] * kn[e];
          ss = sum_x1(ss); ss = sum_x2(ss); ss = sum_x4(ss);
          const float rs = __builtin_amdgcn_rsqf(ss * (1.f / 96.f) + EPS);
          const float* gn = gkn + 8 * sub; v4u o; o.x = pk2(kn[0] * rs * gn[0], kn[1] * rs * gn[1]); o.y = pk2(kn[2] * rs * gn[2], kn[3] * rs * gn[3]); o.z = pk2(kn[4] * rs * gn[4], kn[5] * rs * gn[5]); o.w = pk2(kn[6] * rs * gn[6], kn[7] * rs * gn[7]);
          bf16* ko = KS + (size_t)(row - RP) * 768 + 96 * h; *(v4u*)(ko + 8 * sub) = o;
          const float* gr = gkr + ((4 * sub) & 15); v2u o2; o2.x = pk2(kr.x * rs * gr[0], kr.y * rs * gr[1]); o2.y = pk2(kr.z * rs * gr[2], kr.w * rs * gr[3]);
          *(v2u*)(ko + 64 + 4 * sub) = o2;
          const unsigned vv[4] = {vw.x, vw.y, vw.z, vw.w}; float* vs = VS + (size_t)(row - RP) * 512 + 64 * h + 8 * sub;
#pragma unroll
          for (int e = 0; e < 4; ++e) { vs[2 * e] = bflo(vv[e]) * rkv; vs[2 * e + 1] = bfhi(vv[e]) * rkv; } }
        if (row >= RP || t >= NMETA) {
            const bf16* qp = QRAW + (size_t)row * 768 + 96 * h; const v4u qw = *(const v4u*)(qp + 8 * sub);
            const unsigned r1 = *(const unsigned*)(qp + 64 + 2 * sub), r2 = *(const unsigned*)(qp + 80 + 2 * sub);
            float qn[8] = {bflo(qw.x), bfhi(qw.x), bflo(qw.y), bfhi(qw.y), bflo(qw.z), bfhi(qw.z), bflo(qw.w), bfhi(qw.w)};
            const f32x4 cs = *(const f32x4*)(ROPE + 2 * ((row < RP ? t : TT) * 16 + 2 * sub)); const float c0 = cs.x, s0 = cs.y, c1 = cs.z, s1 = cs.w;
            const float x10 = bflo(r1), x11 = bfhi(r1), x20 = bflo(r2), x21 = bfhi(r2);
            const float y10 = x10 * c0 - x20 * s0, y20 = x10 * s0 + x20 * c0, y11 = x11 * c1 - x21 * s1, y21 = x11 * s1 + x21 * c1;
            float ss = (y10 * y10 + y20 * y20) + (y11 * y11 + y21 * y21);
#pragma unroll
            for (int e = 0; e < 8; ++e) ss += qn[e] * qn[e];
            ss = sum_x1(ss); ss = sum_x2(ss); ss = sum_x4(ss);
            const float sq = RQS[row];
            const float rs = (ATTN_SCALE * LOG2E) * sq * __builtin_amdgcn_rsqf(ss * sq * sq * (1.f / 96.f) + EPS);
            const float* gn = gqn + 8 * sub; v4u o; o.x = pk2(qn[0] * rs * gn[0], qn[1] * rs * gn[1]); o.y = pk2(qn[2] * rs * gn[2], qn[3] * rs * gn[3]); o.z = pk2(qn[4] * rs * gn[4], qn[5] * rs * gn[5]); o.w = pk2(qn[6] * rs * gn[6], qn[7] * rs * gn[7]);
            bf16* qo = Q + (size_t)row * 768 + 96 * h; *(v4u*)(qo + 8 * sub) = o;
            const float g0 = gqr[2 * sub], g1 = gqr[2 * sub + 1];
            *(unsigned*)(qo + 64 + 2 * sub) = pk2(y10 * rs * g0, y11 * rs * g1); *(unsigned*)(qo + 80 + 2 * sub) = pk2(y20 * rs * g0, y21 * rs * g1);
        }
    }
    { bf16* KF = (bf16*)(F.ws + WS_K); bf16* VF = (bf16*)(F.ws + WS_VT);
      LAS unsigned char* vtile = F.lds + RING_OFF + F.wave * 4608;
      const int r8 = F.lane >> 3;
      for (int u = F.gw; u < NB * NKT * NH; u += F.NGW) {
          const int hh = u % NH, kt = (u / NH) % NKT, bb = u / (NH * NKT);
          bf16* kfb = KF + ((size_t)((bb * NH + hh) * NKT + kt)) * (6 * 512); bf16* vfb = VF + ((size_t)((bb * NH + hh) * NKT + kt)) * (4 * 512);
          v4u kwa[4], vwa[4]; f32x4 kra[4]; float rka[4];
#pragma unroll
          for (int i = 0; i < 4; ++i) { const int tk = kt * 32 + 8 * i + r8; const int tkc = tk < TT ? tk : TT - 1; rka[i] = RQS[R + bb * TT + tkc];
              const bf16* kp = KVRAW + (size_t)(bb * TT + tkc) * 1024 + 128 * hh + 8 * sub; kwa[i] = *(const v4u*)kp; vwa[i] = *(const v4u*)(kp + 64); kra[i] = *(const f32x4*)(KRF + (size_t)(bb * TT + tkc) * 32 + 4 * sub); }
#pragma unroll
          for (int i = 0; i < 4; ++i) {
              const int key = 8 * i + r8, tk = kt * 32 + key; v4u kw = kwa[i], vw = vwa[i]; f32x4 kr = kra[i];
              if (tk >= TT) { kw = (v4u){0u, 0u, 0u, 0u}; vw = kw; kr = (f32x4){0.f, 0.f, 0.f, 0.f}; }
              const float rkv = rka[i];
              float kn[8] = {bflo(kw.x) * rkv, bfhi(kw.x) * rkv, bflo(kw.y) * rkv, bfhi(kw.y) * rkv, bflo(kw.z) * rkv, bfhi(kw.z) * rkv, bflo(kw.w) * rkv, bfhi(kw.w) * rkv};
              vw.x = pk2(bflo(vw.x) * rkv, bfhi(vw.x) * rkv); vw.y = pk2(bflo(vw.y) * rkv, bfhi(vw.y) * rkv); vw.z = pk2(bflo(vw.z) * rkv, bfhi(vw.z) * rkv); vw.w = pk2(bflo(vw.w) * rkv, bfhi(vw.w) * rkv);
              float ss = (kr.x * kr.x + kr.y * kr.y) + (kr.z * kr.z + kr.w * kr.w);
#pragma unroll
              for (int e = 0; e < 8; ++e) ss += kn[e] * kn[e];
              ss = sum_x1(ss); ss = sum_x2(ss); ss = sum_x4(ss);
              const float rs = __builtin_amdgcn_rsqf(ss * (1.f / 96.f) + EPS);
              const float* gn = gkn + 8 * sub; v4u o; o.x = pk2(kn[0] * rs * gn[0], kn[1] * rs * gn[1]); o.y = pk2(kn[2] * rs * gn[2], kn[3] * rs * gn[3]); o.z = pk2(kn[4] * rs * gn[4], kn[5] * rs * gn[5]); o.w = pk2(kn[6] * rs * gn[6], kn[7] * rs * gn[7]);
              *(v4u*)(kfb + (sub >> 1) * 512 + ((sub & 1) * 32 + key) * 8) = o;
              const float* gr = gkr + ((4 * sub) & 15); v2u o2; o2.x = pk2(kr.x * rs * gr[0], kr.y * rs * gr[1]); o2.y = pk2(kr.z * rs * gr[2], kr.w * rs * gr[3]);
              *(v2u*)(kfb + (4 + (sub >> 2)) * 512 + (((sub >> 1) & 1) * 32 + key) * 8 + 4 * (sub & 1)) = o2;
              *(LAS v4u*)(vtile + key * 144 + sub * 16) = vw; }
          LDS_WAIT(); asm volatile("" ::: "memory");
          const int g = F.lane >> 4, q4 = (F.lane & 15) >> 2, pp = F.lane & 3;
          const unsigned a_lo = (unsigned)(uintptr_t)vtile + (unsigned)((4 * (g >> 1) + q4) * 144 + (16 * (g & 1) + 4 * pp) * 2);
#define VF_TR(dt, s2) do { s16x4 lo, hi4; \
              asm volatile("ds_read_b64_tr_b16 %0, %2 offset:%c3\n\tds_read_b64_tr_b16 %1, %2 offset:%c4\n\ts_waitcnt lgkmcnt(0)" : "=&v"(lo), "=&v"(hi4) : "v"(a_lo), "i"(16 * (s2) * 144 + 64 * (dt)), "i"(16 * (s2) * 144 + 64 * (dt) + 8 * 144) : "memory"); \
              v4u o; o.x = (unsigned)(unsigned short)lo[0] | ((unsigned)(unsigned short)lo[1] << 16); o.y = (unsigned)(unsigned short)lo[2] | ((unsigned)(unsigned short)lo[3] << 16); \
              o.z = (unsigned)(unsigned short)hi4[0] | ((unsigned)(unsigned short)hi4[1] << 16); o.w = (unsigned)(unsigned short)hi4[2] | ((unsigned)(unsigned short)hi4[3] << 16); \
              *(v4u*)(vfb + ((dt) * 2 + (s2)) * 512 + F.lane * 8) = o; } while (0)
          VF_TR(0, 0); VF_TR(0, 1); VF_TR(1, 0); VF_TR(1, 1);
#undef VF_TR
          LDS_WAIT(); asm volatile("" ::: "memory");
      } }
    P4_STAMP(0);
    const float* STATES = (const float*)(F.ws + WS_STATES); const float* DECAY = (const float*)(F.ws + WS_DECAY); bf16* HIN = (bf16*)(F.ws + WS_HIN);
    for (int e2 = blockIdx.x * NTHR + F.tid; e2 < NB * NH * 2048; e2 += F.G * NTHR) {
        const int e = 2 * e2; const int b = e / (NH * 4096), hh = (e / 4096) % NH, pn = e % 4096;
        float h0 = 0.f, h1 = 0.f;
#pragma unroll 1
        for (int c0 = 0; c0 < NCH; c0 += 11) {
            f32x2_t st[11]; float dc[11];
#pragma unroll
            for (int j = 0; j < 11; ++j) { const int c = c0 + j; st[j] = *(const f32x2_t*)(STATES + ((size_t)((b * NCH + c) * NH + hh)) * 4096 + pn); dc[j] = DECAY[(b * NCH + c) * NH + hh]; }
#pragma unroll
            for (int j = 0; j < 11; ++j) { const int c = c0 + j; *(unsigned*)(HIN + ((size_t)((b * NCH + c) * NH + hh)) * 4096 + pn) = pk2(h0, h1); h0 = h0 * dc[j] + st[j].x; h1 = h1 * dc[j] + st[j].y; }
        }
        *(f32x2_t*)(F.out + OUT_SSMP + e) = (f32x2_t){h0, h1};
    }
    P4_STAMP(1);
    const float* XAS = (const float*)(F.ws + WS_XAS); const float* DT = (const float*)(F.ws + WS_DT); const float* sst = (const float*)F.in[5];
    const float* a_log = (const float*)F.in[13]; const float* d_skip = (const float*)F.in[14]; float* YS = (float*)(F.ws + WS_YS);
    for (int u = F.gw; u < DB * NH * 16; u += F.NGW) {
        const int pq = u & 15, hh = (u >> 4) & 7, b = u >> 7; const int g = hh >> 2; const int p = 4 * pq + (F.lane >> 4), n4 = F.lane & 15;
        const float dt = DT[(size_t)(RP + b) * 8 + hh]; const float a = __expf(dt * -__expf(a_log[hh]));
        const float x = XAS[(size_t)b * CONVD + hh * HP + p]; const float uu = dt * x;
        const f32x4 Bv = *(const f32x4*)(XAS + (size_t)b * CONVD + SSDW + g * DS + 4 * n4), Cv = *(const f32x4*)(XAS + (size_t)b * CONVD + SSDW + 128 + g * DS + 4 * n4);
        const size_t si = (((size_t)b * NH + hh) * HP + p) * DS + 4 * n4;
        const f32x4 s0 = *(const f32x4*)(sst + si); const f32x4 s1 = s0 * a + uu * Bv;
        *(f32x4*)(F.out + OUT_SSMS + si) = s1;
        float y = (Cv.x * s1.x + Cv.y * s1.y) + (Cv.z * s1.z + Cv.w * s1.w);
        y = sum_x1(y); y = sum_x2(y); y = sum_x4(y); y = sum_x8(y);
        if (n4 == 0) YS[(size_t)b * 512 + hh * HP + p] = y + d_skip[hh] * x;
    }
}
constexpr int DA_ROWB = 528;
constexpr int DA_LAT = 0, DA_KR = 128 * DA_ROWB, DA_PB = DA_KR + 128 * 33 * 4, DA_QG = DA_PB + 2 * 16 * 32 * 2, DA_END = DA_QG + 8 * 96 * 4;
constexpr int P5_EXCH = 100 * 1024;
static_assert(DA_END <= P5_EXCH, "LDS map of P5");

constexpr int AT_SLOT = 20480, AT_D = 4;
constexpr size_t WS_ATT = 499 * MiB;
__device__ __forceinline__ void at_issue(Frame& F, const bf16* kt_k, const bf16* kt_v, LAS unsigned char* slot) {
    const int w = F.wave;
    __builtin_amdgcn_global_load_lds((const unsigned*)((const char*)kt_k + w * 1024 + F.lane * 16), (LAS unsigned*)(slot + w * 1024), 16, 0, 0);
    const char* srcB = (w < 4) ? (const char*)kt_k + 8192 + w * 1024 : (const char*)kt_v + (w - 4) * 1024;
    __builtin_amdgcn_global_load_lds((const unsigned*)(srcB + F.lane * 16), (LAS unsigned*)(slot + 8192 + w * 1024), 16, 0, 0);
    __builtin_amdgcn_global_load_lds((const unsigned*)((const char*)kt_v + 4096 + w * 256 + F.lane * 4), (LAS unsigned*)(slot + 16384 + w * 256), 4, 0, 0);
    __builtin_amdgcn_global_load_lds((const unsigned*)((const char*)kt_v + 6144 + w * 256 + F.lane * 4), (LAS unsigned*)(slot + 18432 + w * 256), 4, 0, 0);
}
__device__ __forceinline__ void p5_attn_prompt(Frame& F, float M0) {
    const bf16* QRAW = (const bf16*)(F.ws + WS_QRAW); const bf16* KF = (const bf16*)(F.ws + WS_K); const bf16* VF = (const bf16*)(F.ws + WS_VT); bf16* MIXA = (bf16*)(F.ws + WS_MIX); float* SSQ = (float*)(F.ws + WS_SSQ);
    const float* ROPE = (const float*)(F.ws + WS_ROPE); const float* gqn = (const float*)F.in[20]; const float* gqr = (const float*)F.in[21]; const float* RQS = (const float*)(F.ws + WS_RQ);
    LAS unsigned char* ring = F.lds + RING_OFF;
    const int w = F.wave, r32 = F.lane & 31, hi = F.lane >> 5;
    f32x16 negm;
#pragma unroll
    for (int i = 0; i < 16; ++i) negm[i] = -M0;
    for (int u = F.vcu; u < 256; u += F.G) {
        const int b = u >> 5, h = (u >> 2) & 7, pr = u & 3;
        const bf16* kfb = KF + ((size_t)((b * NH + h) * NKT)) * (6 * 512); const bf16* vfb = VF + ((size_t)((b * NH + h) * NKT)) * (4 * 512);
#pragma unroll 1
        for (int half = 0; half < 2; ++half) {
            const int qb = half ? 7 - pr : pr; const int a = 8 * qb + w; const int qi = NMETA + 32 * a + r32;
            const int nkt = 8 * qb + 9, nkw = a + 2;
            bf16x8 qf[6];
            { const bf16* qp = QRAW + (size_t)(b * TT + qi) * 768 + 96 * h + 8 * hi;
              v4u qw[6];
#pragma unroll
              for (int s = 0; s < 6; ++s) qw[s] = *(const v4u*)(qp + 16 * s);
              f32x4 cs[4];
#pragma unroll
              for (int i = 0; i < 4; ++i) cs[i] = *(const f32x4*)(ROPE + 2 * (qi * 16 + 8 * hi) + 4 * i);
              float qv[6][8]; float ss = 0.f;
#pragma unroll
              for (int s = 0; s < 6; ++s) { const unsigned ww[4] = {qw[s].x, qw[s].y, qw[s].z, qw[s].w};
#pragma unroll
                  for (int e = 0; e < 4; ++e) { qv[s][2 * e] = bflo(ww[e]); qv[s][2 * e + 1] = bfhi(ww[e]); ss += qv[s][2 * e] * qv[s][2 * e] + qv[s][2 * e + 1] * qv[s][2 * e + 1]; } }
              ss = sum_x32(ss);
              const float sq = RQS[b * TT + qi];
              const float rs = (ATTN_SCALE * LOG2E) * sq * __builtin_amdgcn_rsqf(ss * sq * sq * (1.f / 96.f) + EPS);
#pragma unroll
              for (int jj = 0; jj < 8; ++jj) { const float c = cs[jj >> 1][2 * (jj & 1)], sn = cs[jj >> 1][2 * (jj & 1) + 1]; const float x1 = qv[4][jj], x2 = qv[5][jj];
                  const float gr = gqr[8 * hi + jj] * rs; qv[4][jj] = (x1 * c - x2 * sn) * gr; qv[5][jj] = (x1 * sn + x2 * c) * gr; }
#pragma unroll
              for (int s = 0; s < 4; ++s) { const f32x4 g0 = *(const f32x4*)(gqn + 16 * s + 8 * hi), g1 = *(const f32x4*)(gqn + 16 * s + 8 * hi + 4);
                  qv[s][0] *= g0.x * rs; qv[s][1] *= g0.y * rs; qv[s][2] *= g0.z * rs; qv[s][3] *= g0.w * rs; qv[s][4] *= g1.x * rs; qv[s][5] *= g1.y * rs; qv[s][6] *= g1.z * rs; qv[s][7] *= g1.w * rs; }
#pragma unroll
              for (int s = 0; s < 6; ++s) { v4u o; o.x = pk2(qv[s][0], qv[s][1]); o.y = pk2(qv[s][2], qv[s][3]); o.z = pk2(qv[s][4], qv[s][5]); o.w = pk2(qv[s][6], qv[s][7]); qf[s] = __builtin_bit_cast(bf16x8, o); } }
            f32x16 o0 = (f32x16){}, o1 = (f32x16){}; float l = 0.f;
            const int ns = (nkt + 1) >> 1;
#pragma unroll
            for (int j = 0; j < AT_D - 1; ++j) at_issue(F, kfb + (size_t)j * 6144, vfb + (size_t)j * 4096, ring + j * AT_SLOT);
#pragma unroll 1
            for (int st = 0; st < ns; ++st) {
                const int rem = ns - 1 - st;
                if (rem >= 2) asm volatile("s_waitcnt vmcnt(8)" ::: "memory"); else if (rem == 1) asm volatile("s_waitcnt vmcnt(4)" ::: "memory"); else asm volatile("s_waitcnt vmcnt(0)" ::: "memory");
                __builtin_amdgcn_s_barrier(); asm volatile("" ::: "memory");
                if (st + AT_D - 1 < ns) at_issue(F, kfb + (size_t)(st + AT_D - 1) * 6144, vfb + (size_t)(st + AT_D - 1) * 4096, ring + ((st + AT_D - 1) & (AT_D - 1)) * AT_SLOT);
#pragma unroll
                for (int tt = 0; tt < 2; ++tt) { const int kt = 2 * st + tt;
                  if (kt < nkw) {
                    const LAS unsigned char* sl = ring + (st & (AT_D - 1)) * AT_SLOT + F.lane * 16; const int j0 = 32 * kt;
                    f32x16 S = negm;
#pragma unroll
                    for (int s = 0; s < 6; ++s) S = MFMA32(*(const LAS bf16x8*)(sl + tt * 6144 + 1024 * s), qf[s], S);
                    bf16x8 vf[4];
#pragma unroll
                    for (int i = 0; i < 4; ++i) vf[i] = *(const LAS bf16x8*)(sl + 12288 + tt * 4096 + 1024 * i);
#pragma unroll
                    for (int i = 0; i < 16; ++i) S[i] = __builtin_amdgcn_exp2f(S[i]);
                    if (kt >= a) {
#pragma unroll
                        for (int i = 0; i < 16; ++i) if (j0 + crow(i, hi) > qi) S[i] = 0.f; }
#pragma unroll
                    for (int i = 0; i < 16; ++i) l += S[i];
                    const bf16x8 p0 = pack8(S, 0), p1 = pack8(S, 1);
                    o0 = MFMA32(vf[0], p0, o0); o0 = MFMA32(vf[1], p1, o0);
                    o1 = MFMA32(vf[2], p0, o1); o1 = MFMA32(vf[3], p1, o1);
                  } }
            }
            l = sum_x32(l);
            const float il = __builtin_amdgcn_rcpf(l);
            bf16* ao = MIXA + (size_t)(b * TT + qi) * 1024 + 512 + 64 * h + 4 * hi; float ssq = 0.f;
#pragma unroll
            for (int gq = 0; gq < 4; ++gq) {
                v2u w0, w1; w0.x = pk2(o0[4 * gq] * il, o0[4 * gq + 1] * il); w0.y = pk2(o0[4 * gq + 2] * il, o0[4 * gq + 3] * il);
                w1.x = pk2(o1[4 * gq] * il, o1[4 * gq + 1] * il); w1.y = pk2(o1[4 * gq + 2] * il, o1[4 * gq + 3] * il);
                ssq += (bflo(w0.x) * bflo(w0.x) + bfhi(w0.x) * bfhi(w0.x)) + (bflo(w0.y) * bflo(w0.y) + bfhi(w0.y) * bfhi(w0.y));
                ssq += (bflo(w1.x) * bflo(w1.x) + bfhi(w1.x) * bfhi(w1.x)) + (bflo(w1.y) * bflo(w1.y) + bfhi(w1.y) * bfhi(w1.y));
                *(v2u*)(ao + 8 * gq) = w0; *(v2u*)(ao + 32 + 8 * gq) = w1; }
            ssq = sum_x32(ssq);
            if (hi == 0) SSQ[(size_t)(b * TT + qi) * 8 + h] = ssq;
            asm volatile("s_waitcnt lgkmcnt(0)" ::: "memory"); __builtin_amdgcn_s_barrier(); asm volatile("" ::: "memory");
        }
    }
}

constexpr int SO_X = 0, SO_H = 36864, SO_B = 73728, SO_C = 82944, SO_Z = 92160, SO_TAB = 125952, SO_EX = 130048;
static_assert(SO_EX + 1024 <= RING_BYTES, "ssd_out LDS map");
__device__ __forceinline__ void p5_ssd_out(Frame& F) {
    const float* DT = (const float*)(F.ws + WS_DT); const float* a_log = (const float*)F.in[13]; const float* d_skip = (const float*)F.in[14]; const float* ng = (const float*)F.in[15];
    const bf16* XST = (const bf16*)(F.ws + WS_XST); const bf16* BC = (const bf16*)(F.ws + WS_BC); const bf16* HIN = (const bf16*)(F.ws + WS_HIN); const bf16* PROJ = (const bf16*)(F.ws + WS_PROJ);
    bf16* MIX = (bf16*)(F.ws + WS_MIX);
    LAS unsigned char* L = F.lds + RING_OFF;
    LAS float* tab = (LAS float*)(L + SO_TAB) + F.wave * 128;
    LAS float* exch = (LAS float*)(L + SO_EX);
    const int hl = F.wave >> 1, it = F.wave & 1, r32 = F.lane & 31, hi = F.lane >> 5;
    for (int u = blockIdx.x; u < NB * (NCH - 1); u += F.G) {
        const int b = u / (NCH - 1), c = 1 + u % (NCH - 1); const int t0 = c * CHL - TOFF;
        v4u st[14];
#define SO_FETCH_A(g) do { \
        _Pragma("unroll") for (int k = 0; k < 4; ++k) { const int q = F.tid + NTHR * k; st[k] = *(const v4u*)(XST + ((size_t)(b * SSDW + (g) * 256 + (q >> 3))) * TPAD + c * CHL + 8 * (q & 7)); } } while (0)
#define SO_FETCH_B(g) do { \
        _Pragma("unroll") for (int k = 0; k < 4; ++k) { const int q = F.tid + NTHR * k; st[4 + k] = *(const v4u*)(HIN + ((size_t)((b * NCH + c) * NH + 4 * (g))) * 4096 + (size_t)q * 8); } \
        { const int q = F.tid; st[8] = *(const v4u*)(BC + (size_t)(b * TT + t0 + (q >> 3)) * 256 + (g) * DS + 8 * (q & 7)); st[9] = *(const v4u*)(BC + (size_t)(b * TT + t0 + (q >> 3)) * 256 + 128 + (g) * DS + 8 * (q & 7)); } \
        _Pragma("unroll") for (int k = 0; k < 4; ++k) { const int q = F.tid + NTHR * k; st[10 + k] = *(const v4u*)(PROJ + (size_t)(b * TT + t0 + (q >> 5)) * PJ + C_Z + (g) * 256 + 8 * (q & 31)); } } while (0)
#define SO_STORE() do { \
        _Pragma("unroll") for (int k = 0; k < 4; ++k) { const int q = F.tid + NTHR * k; *(LAS v4u*)(L + SO_X + (q >> 3) * 144 + 16 * (q & 7)) = st[k]; *(LAS v4u*)(L + SO_H + (q >> 3) * 144 + 16 * (q & 7)) = st[4 + k]; } \
        { const int q = F.tid; *(LAS v4u*)(L + SO_B + (q >> 3) * 144 + 16 * (q & 7)) = st[8]; *(LAS v4u*)(L + SO_C + (q >> 3) * 144 + 16 * (q & 7)) = st[9]; } \
        _Pragma("unroll") for (int k = 0; k < 4; ++k) { const int q = F.tid + NTHR * k; *(LAS v4u*)(L + SO_Z + (q >> 5) * 528 + 16 * (q & 31)) = st[10 + k]; } } while (0)
        SO_FETCH_A(0); SO_FETCH_B(0);
#pragma unroll 1
        for (int g = 0; g < 2; ++g) {
            const int h = 4 * g + hl; const float A = -__expf(a_log[h]), Dh = d_skip[h];
            { const int t = t0 + F.lane; const float dt = DT[(size_t)(b * TT + t) * 8 + h];
              float acs = dt * A;
#pragma unroll
              for (int o = 1; o < 64; o <<= 1) { const float v = __shfl_up(acs, o); if (F.lane >= o) acs += v; }
              tab[F.lane] = acs; tab[64 + F.lane] = dt; }
            SO_STORE();
            __syncthreads();
            if (g == 0) SO_FETCH_A(1);
            const int ii = 32 * it + r32; const int t = t0 + ii;
            bf16x8 cf[4];
#pragma unroll
            for (int s = 0; s < 4; ++s) cf[s] = *(const LAS bf16x8*)(L + SO_C + ii * 144 + 32 * s + 16 * hi);
            f32x16 y[2];
            const float ai = tab[ii]; const float ei = __expf(ai);
#pragma unroll
            for (int pt = 0; pt < 2; ++pt) { f32x16 acc = (f32x16){}; const LAS unsigned char* hp_ = L + SO_H + (hl * 64 + 32 * pt + r32) * 144 + 16 * hi;
#pragma unroll
                for (int s = 0; s < 4; ++s) acc = MFMA32(*(const LAS bf16x8*)(hp_ + 32 * s), cf[s], acc);
#pragma unroll
                for (int i = 0; i < 16; ++i) acc[i] *= ei;
                y[pt] = acc; }
#pragma unroll 1
            for (int jt = 0; jt <= it; ++jt) {
                f32x16 S = (f32x16){};
                { const LAS unsigned char* bp_ = L + SO_B + (32 * jt + r32) * 144 + 16 * hi;
#pragma unroll
                  for (int s = 0; s < 4; ++s) S = MFMA32(*(const LAS bf16x8*)(bp_ + 32 * s), cf[s], S); }
#pragma unroll
                for (int i = 0; i < 16; ++i) { const int jj = 32 * jt + crow(i, hi); const float e = (jj <= ii) ? __expf(ai - tab[jj]) * tab[64 + jj] : 0.f; S[i] = S[i] * e + ((jj == ii) ? Dh : 0.f); }
                const bf16x8 p0 = pack8(S, 0), p1 = pack8(S, 1);
#pragma unroll
                for (int pt = 0; pt < 2; ++pt) { const LAS unsigned char* xp_ = L + SO_X + (hl * 64 + 32 * pt + r32) * 144 + (32 * jt + 4 * hi) * 2;
                    const v2u x0 = *(const LAS v2u*)(xp_), x1 = *(const LAS v2u*)(xp_ + 16), x2 = *(const LAS v2u*)(xp_ + 32), x3 = *(const LAS v2u*)(xp_ + 48);
                    v4u f0, f1; f0.x = x0.x; f0.y = x0.y; f0.z = x1.x; f0.w = x1.y; f1.x = x2.x; f1.y = x2.y; f1.z = x3.x; f1.w = x3.y;
                    y[pt] = MFMA32(__builtin_bit_cast(bf16x8, f0), p0, y[pt]); y[pt] = MFMA32(__builtin_bit_cast(bf16x8, f1), p1, y[pt]); }
            }
            float ss = 0.f;
            { const LAS unsigned char* zp_ = L + SO_Z + ii * 528 + (hl * 64 + 4 * hi) * 2;
#pragma unroll
              for (int pt = 0; pt < 2; ++pt)
#pragma unroll
                for (int gq = 0; gq < 4; ++gq) { const v2u zw = *(const LAS v2u*)(zp_ + (32 * pt + 8 * gq) * 2); const float zz[4] = {bflo(zw.x), bfhi(zw.x), bflo(zw.y), bfhi(zw.y)};
#pragma unroll
                    for (int e = 0; e < 4; ++e) { const float v = y[pt][4 * gq + e] * silu_f(zz[e]); y[pt][4 * gq + e] = v; ss += v * v; } } }
            ss = sum_x32(ss);
            if (g == 0) SO_FETCH_B(1);
            LAS float* ex = exch + it * 128;
            if (hi == 0) ex[hl * 32 + r32] = ss;
            __syncthreads();
            const float tot = (ex[r32] + ex[32 + r32]) + (ex[64 + r32] + ex[96 + r32]);
            const float rs = __builtin_amdgcn_rsqf(tot * (1.f / 256.f) + EPS);
            { bf16* mo = MIX + (size_t)(b * TT + t) * 1024 + 64 * h + 4 * hi;
#pragma unroll
              for (int pt = 0; pt < 2; ++pt)
#pragma unroll
                for (int gq = 0; gq < 4; ++gq) { const f32x4 gg = *(const f32x4*)(ng + 64 * h + 32 * pt + 8 * gq + 4 * hi);
                    v2u w; w.x = pk2(y[pt][4 * gq] * rs * gg.x, y[pt][4 * gq + 1] * rs * gg.y); w.y = pk2(y[pt][4 * gq + 2] * rs * gg.z, y[pt][4 * gq + 3] * rs * gg.w);
                    *(v2u*)(mo + 32 * pt + 8 * gq) = w; } }
        }
#undef SO_FETCH_A
#undef SO_FETCH_B
#undef SO_STORE
        __syncthreads();
    }
    const float* YS = (const float*)(F.ws + WS_YS);
    for (int u = F.gw; u < DB * NG; u += F.NGW) { const int b = u >> 1, gg = u & 1; const int cc = gg * 256 + 4 * F.lane;
        const f32x4 yv = *(const f32x4*)(YS + (size_t)b * 512 + cc); const v2u zw = *(const v2u*)(PROJ + (size_t)(RP + b) * PJ + C_Z + cc);
        const f32x4 v = {yv.x * silu_f(bflo(zw.x)), yv.y * silu_f(bfhi(zw.x)), yv.z * silu_f(bflo(zw.y)), yv.w * silu_f(bfhi(zw.y))};
        const float rs = __builtin_amdgcn_rsqf(wave_sum((v.x * v.x + v.y * v.y) + (v.z * v.z + v.w * v.w)) * (1.f / 256.f) + EPS);
        const f32x4 gv = *(const f32x4*)(ng + cc); v2u w; w.x = pk2(v.x * rs * gv.x, v.y * rs * gv.y); w.y = pk2(v.z * rs * gv.z, v.w * rs * gv.w);
        *(v2u*)(MIX + (size_t)(RP + b) * 1024 + cc) = w; }
}

constexpr int DB_STAGE = 0, DB_KRST = 65536, DB_LAT = DB_KRST + 8192, DB_KR = DB_LAT + 64 * DA_ROWB, DB_PB = DB_KR + 64 * 36 * 4, DB_QG = DB_PB + 16 * 64 * 2, DB_END = DB_QG + 8 * 96 * 4;
static_assert(DB_END <= RING_BYTES, "decode attention LDS map");
#define RAW_BAR_L() do { asm volatile("s_waitcnt lgkmcnt(0)" ::: "memory"); __builtin_amdgcn_s_barrier(); asm volatile("" ::: "memory"); } while (0)
#define RAW_BAR_VL() do { asm volatile("s_waitcnt vmcnt(0) lgkmcnt(0)" ::: "memory"); __builtin_amdgcn_s_barrier(); asm volatile("" ::: "memory"); } while (0)
__device__ __forceinline__ void da_issue(Frame& F, LAS unsigned char* L, const float* clat, const float* ckr, const int* ptab, int b, int split, int hp) {
    const size_t tok0 = (size_t)ptab[b * NPAGES + split * 32 + (hp >> 1)] * PAGE + (hp & 1) * 64;
    const char* src = (const char*)(clat + tok0 * KVL) + (size_t)(F.wave * 8) * 1024 + F.lane * 16;
#pragma unroll
    for (int i = 0; i < 8; ++i) __builtin_amdgcn_global_load_lds((const unsigned*)(src + i * 1024), (LAS unsigned*)(L + DB_STAGE + (F.wave * 8 + i) * 1024), 16, 0, 0);
    __builtin_amdgcn_global_load_lds((const unsigned*)((const char*)(ckr + tok0 * 32) + F.wave * 1024 + F.lane * 16), (LAS unsigned*)(L + DB_KRST + F.wave * 1024), 16, 0, 0);
}
__device__ __forceinline__ void da_convert(Frame& F, LAS unsigned char* L) {
#pragma unroll 4
    for (int k = 0; k < 8; ++k) { const int f = F.tid + NTHR * k; const int row = f >> 6, c4 = f & 63; const f32x4 v = *(const LAS f32x4*)(L + DB_STAGE + f * 16);
        v2u w; w.x = pk2(v.x, v.y); w.y = pk2(v.z, v.w); *(LAS v2u*)(L + DB_LAT + row * DA_ROWB + c4 * 8) = w; }
    { const int f = F.tid; const int row = f >> 3, c4 = f & 7; const f32x4 v = *(const LAS f32x4*)(L + DB_KRST + f * 16);
      *(LAS f32x4*)((LAS float*)(L + DB_KR) + row * 36 + 4 * c4) = v; }
}
__device__ __forceinline__ void st_wt(float* p, float v) { asm volatile("global_store_dword %0, %1, off sc0 sc1" :: "v"(p), "v"(v) : "memory"); }
__device__ __forceinline__ void decode_combine_one(Frame& F, float M0, int b) {
    const float* DPART = (const float*)(F.ws + WS_DPART); const bf16* WUKV = (const bf16*)(F.ws + WS_WUKV2); const bf16* Q = (const bf16*)(F.ws + WS_Q); const bf16* KS = (const bf16*)(F.ws + WS_KS);
    const float* VS = (const float*)(F.ws + WS_VS); bf16* MIX = (bf16*)(F.ws + WS_MIX);
    LAS float* accl = (LAS float*)(F.lds + RING_OFF) + F.wave * 256; LAS float* exch = (LAS float*)(F.lds + P5_EXCH);
    const int h = F.wave;
    const float* p0 = DPART + ((size_t)((b * 2 + 0) * NH + h)) * 264; const float* p1 = DPART + ((size_t)((b * 2 + 1) * NH + h)) * 264;
#pragma unroll
    for (int k = 0; k < 4; ++k) accl[F.lane + 64 * k] = p0[F.lane + 64 * k] + p1[F.lane + 64 * k];
    float l = p0[256] + p1[256];
    const bf16* qp = Q + (size_t)(RP + b) * 768 + 96 * h; const bf16* kp = KS + (size_t)b * 768 + 96 * h;
    float sd = bf2f(qp[F.lane]) * bf2f(kp[F.lane]); if (F.lane < 32) sd += bf2f(qp[64 + F.lane]) * bf2f(kp[64 + F.lane]);
    sd = wave_sum(sd);
    const float pn = __builtin_amdgcn_exp2f(sd - M0); l += pn;
    LDS_WAIT(); asm volatile("" ::: "memory");
    const bf16* wv = WUKV + (size_t)(128 * h + 64 + F.lane) * KVL;
    float o = 0.f;
    { v4u wv4[32];
#pragma unroll
      for (int c8 = 0; c8 < 32; ++c8) wv4[c8] = *(const v4u*)(wv + 8 * c8);
#pragma unroll
      for (int c8 = 0; c8 < 32; ++c8) { const v4u w = wv4[c8]; const f32x4 x0 = *(const LAS f32x4*)(accl + 8 * c8), x1 = *(const LAS f32x4*)(accl + 8 * c8 + 4);
        o += (bflo(w.x) * x0.x + bfhi(w.x) * x0.y) + (bflo(w.y) * x0.z + bfhi(w.y) * x0.w) + (bflo(w.z) * x1.x + bfhi(w.z) * x1.y) + (bflo(w.w) * x1.z + bfhi(w.w) * x1.w); } }
    o = (o + pn * VS[(size_t)b * 512 + 64 * h + F.lane]) * __builtin_amdgcn_rcpf(l);
    const float ss = wave_sum(o * o);
    if (F.lane == 0) exch[h] = ss;
    __syncthreads();
    float tot = 0.f;
#pragma unroll
    for (int hh = 0; hh < NH; ++hh) tot += exch[hh];
    const float rs = __builtin_amdgcn_rsqf(tot * (1.f / MLAW) + EPS);
    MIX[(size_t)(RP + b) * 1024 + 512 + 64 * h + F.lane] = f2bf(o * rs);
    __syncthreads();
}
template <int MODE>
__device__ __forceinline__ void p5_attn_decode_t(Frame& F, float M0) {
    const float* clat = (const float*)F.in[2]; const float* ckr = (const float*)F.in[3]; const int* ptab = (const int*)F.in[6];
    const bf16* WUKV = (const bf16*)(F.ws + WS_WUKV2); const bf16* Q = (const bf16*)(F.ws + WS_Q); const float* gkn = (const float*)F.in[22]; const float* gkr = (const float*)F.in[23];
    float* DPART = (float*)(F.ws + WS_DPART);
    LAS unsigned char* L = F.lds + RING_OFF;
    LAS float* krl = (LAS float*)(L + DB_KR); LAS bf16* pb = (LAS bf16*)(L + DB_PB); LAS float* qg = (LAS float*)(L + DB_QG) + F.wave * 96;
    const int h = F.wave, r32 = F.lane & 31, hi = F.lane >> 5;
    for (int u = blockIdx.x; u < DB * 2; u += F.G) {
        const int b = u >> 1, split = u & 1;
        da_issue(F, L, clat, ckr, ptab, b, split, 0);
        bf16x8 wf[4][8];
#pragma unroll
        for (int dt = 0; dt < 4; ++dt)
#pragma unroll
            for (int s = 0; s < 8; ++s) wf[dt][s] = *(const bf16x8*)(WUKV + (size_t)(128 * h + 16 * dt + (F.lane & 15)) * KVL + 32 * s + 8 * (F.lane >> 4));
        { const bf16* qp = Q + (size_t)(RP + b) * 768 + 96 * h; qg[F.lane] = bf2f(qp[F.lane]) * gkn[F.lane]; if (F.lane < 32) qg[64 + F.lane] = bf2f(qp[64 + F.lane]) * gkr[F.lane & 15]; }
        for (int i = F.tid; i < 16 * 64; i += NTHR) pb[i] = 0;
        f32x4 ao[2] = {(f32x4){0.f, 0.f, 0.f, 0.f}, (f32x4){0.f, 0.f, 0.f, 0.f}}; float l = 0.f;
        RAW_BAR_VL();
        da_convert(F, L);
        RAW_BAR_L();
        da_issue(F, L, clat, ckr, ptab, b, split, 1);
#pragma unroll 1
        for (int hp = 0; hp < 64; ++hp) {
          if (MODE == 0 || MODE == 3) {
            const int n16 = F.lane & 15, kg4 = F.lane >> 4;
#pragma unroll 1
            for (int sb = 0; sb < 2; ++sb) {
                const LAS unsigned char* bp = L + DB_LAT + (32 * sb + n16) * DA_ROWB + 16 * kg4;
                f32x4 acc[4][2];
#pragma unroll
                for (int dt = 0; dt < 4; ++dt) { acc[dt][0] = (f32x4){0.f, 0.f, 0.f, 0.f}; acc[dt][1] = acc[dt][0]; }
                bf16x8 fa[2], fb[2];
                fa[0] = *(const LAS bf16x8*)(bp); fa[1] = *(const LAS bf16x8*)(bp + 16 * DA_ROWB);
#pragma unroll
                for (int s = 0; s < 8; ++s) {
                    if (s < 7) { fb[0] = *(const LAS bf16x8*)(bp + 64 * (s + 1)); fb[1] = *(const LAS bf16x8*)(bp + 16 * DA_ROWB + 64 * (s + 1)); }
#pragma unroll
                    for (int dt = 0; dt < 4; ++dt) { acc[dt][0] = MFMA16(wf[dt][s], fa[0], acc[dt][0]); acc[dt][1] = MFMA16(wf[dt][s], fa[1], acc[dt][1]); }
                    fa[0] = fb[0]; fa[1] = fb[1];
                }
                __builtin_amdgcn_sched_barrier(0);
                f32x4 s4[2] = {(f32x4){0.f, 0.f, 0.f, 0.f}, (f32x4){0.f, 0.f, 0.f, 0.f}}, d4[2] = {s4[0], s4[0]};
#pragma unroll
                for (int dt = 0; dt < 4; ++dt) { const f32x4 qq = *(const LAS f32x4*)(qg + 16 * dt + 4 * kg4);
#pragma unroll
                    for (int tt = 0; tt < 2; ++tt) { s4[tt] += acc[dt][tt] * acc[dt][tt]; d4[tt] += acc[dt][tt] * qq; } }
                { const LAS float* qr = qg + 64 + 8 * kg4; const f32x4 q0 = *(const LAS f32x4*)(qr), q1 = *(const LAS f32x4*)(qr + 4);
#pragma unroll
                  for (int tt = 0; tt < 2; ++tt) { const LAS float* kr = krl + (32 * sb + 16 * tt + n16) * 36 + 8 * kg4; const f32x4 k0 = *(const LAS f32x4*)(kr), k1 = *(const LAS f32x4*)(kr + 4);
                      s4[tt] += k0 * k0; s4[tt] += k1 * k1; d4[tt] += k0 * q0; d4[tt] += k1 * q1; } }
                __builtin_amdgcn_sched_barrier(0);
#pragma unroll
                for (int tt = 0; tt < 2; ++tt) { float ss = (s4[tt].x + s4[tt].y) + (s4[tt].z + s4[tt].w), dot = (d4[tt].x + d4[tt].y) + (d4[tt].z + d4[tt].w);
                    ss = sum_x16(ss); dot = sum_x16(dot); ss = sum_x32(ss); dot = sum_x32(dot);
                    const float p = __builtin_amdgcn_exp2f(dot * __builtin_amdgcn_rsqf(ss * (1.f / 96.f) + EPS) - M0);
                    if (kg4 == 0) { l += p; pb[h * 64 + 32 * sb + 16 * tt + n16] = f2bf(p); } }
            }
            RAW_BAR_L();
            if (MODE < 4) { const int q4 = (F.lane & 15) >> 2, pp = F.lane & 3, kg = F.lane >> 4;
              const unsigned a_lo = (unsigned)(uintptr_t)(L + DB_LAT) + (unsigned)((8 * kg + q4) * DA_ROWB + (32 * h + 4 * pp) * 2);
              const LAS bf16* pap = pb + (F.lane & 15) * 64 + 8 * kg;
              s16x4 t0, t1, t2, t3, t4, t5, t6, t7;
              asm volatile("ds_read_b64_tr_b16 %0, %8 offset:%c9\n\tds_read_b64_tr_b16 %1, %8 offset:%c10\n\tds_read_b64_tr_b16 %2, %8 offset:%c11\n\tds_read_b64_tr_b16 %3, %8 offset:%c12\n\t"
                           "ds_read_b64_tr_b16 %4, %8 offset:%c13\n\tds_read_b64_tr_b16 %5, %8 offset:%c14\n\tds_read_b64_tr_b16 %6, %8 offset:%c15\n\tds_read_b64_tr_b16 %7, %8 offset:%c16\n\ts_waitcnt lgkmcnt(0)"
                           : "=&v"(t0), "=&v"(t1), "=&v"(t2), "=&v"(t3), "=&v"(t4), "=&v"(t5), "=&v"(t6), "=&v"(t7)
                           : "v"(a_lo), "i"(0), "i"(4 * DA_ROWB), "i"(32), "i"(32 + 4 * DA_ROWB), "i"(32 * DA_ROWB), "i"(32 * DA_ROWB + 4 * DA_ROWB), "i"(32 * DA_ROWB + 32), "i"(32 * DA_ROWB + 32 + 4 * DA_ROWB) : "memory");
              const bf16x8 pa0 = *(const LAS bf16x8*)(pap), pa1 = *(const LAS bf16x8*)(pap + 32);
#define DA_FR(x, y) ((bf16x8){x[0], x[1], x[2], x[3], y[0], y[1], y[2], y[3]})
              ao[0] = MFMA16(pa0, DA_FR(t0, t1), ao[0]); ao[1] = MFMA16(pa0, DA_FR(t2, t3), ao[1]);
              ao[0] = MFMA16(pa1, DA_FR(t4, t5), ao[0]); ao[1] = MFMA16(pa1, DA_FR(t6, t7), ao[1]);
#undef DA_FR
#define DA_PV(ks, nt) do { } while (0)
#undef DA_PV
            }
          }
            RAW_BAR_VL();
            if (hp + 1 < 64) { if (MODE <= 1 || MODE >= 3) da_convert(F, L); RAW_BAR_L(); if (hp + 2 < 64 && MODE < 3) da_issue(F, L, clat, ckr, ptab, b, split, hp + 2); }
        }
        if (MODE >= 3 && l == 123.456f) DPART[0] = l;
        if (MODE == 0) { const int kg = F.lane >> 4;
          if (kg < 2) {
#pragma unroll
              for (int nt = 0; nt < 2; ++nt)
#pragma unroll
                  for (int i = 0; i < 4; ++i) st_wt(&DPART[((size_t)((b * 2 + split) * NH + 4 * kg + i)) * 264 + 32 * h + 16 * nt + (F.lane & 15)], ao[nt][i]); }
          float lt = wave_sum(l);
          if (F.lane == 0) st_wt(&DPART[((size_t)((b * 2 + split) * NH + h)) * 264 + 256], lt); }
        asm volatile("s_waitcnt vmcnt(0)" ::: "memory");
        __syncthreads();
        { volatile LAS unsigned* arr = (volatile LAS unsigned*)(F.lds + MISC_OFF) + 16;
          if (F.tid == 0) {
              const unsigned old = __hip_atomic_fetch_add((unsigned*)(F.ws + WS_CTL) + CW_DCNT + b, 1u, __ATOMIC_RELAXED, __HIP_MEMORY_SCOPE_AGENT);
              if (old == 1u) { __builtin_amdgcn_fence(__ATOMIC_ACQUIRE, "agent"); asm volatile("s_waitcnt vmcnt(0)" ::: "memory"); }
              arr[0] = old; }
          __syncthreads();
          if (MODE == 0 && arr[0] == 1u) decode_combine_one(F, M0, b);
          __syncthreads(); }
    }
}

__device__ __forceinline__ void p5_attn_decode(Frame& F, float M0) { p5_attn_decode_t<0>(F, M0); }

__device__ __forceinline__ void p7_outproj(Frame& F) {
    const bf16* MIX = (const bf16*)(F.ws + WS_MIX); const bf16* WOUT = (const bf16*)(F.ws + WS_WOUT); const float* xp = (const float*)F.in[0]; const float* xs = (const float*)F.in[1]; float* HS = (float*)(F.ws + WS_HS);
    bf16* HB = (bf16*)(F.ws + WS_XN); float* SS = (float*)(F.ws + WS_SSP); float* ysamp = F.out + OUT_YS;
    { pg8::Gemm g{MIX, WOUT, MMAIN, DM, 1024, 1, 1024}; pg8::StaticOrder S; S.init(MMAIN, DM, F.G, (int)blockIdx.x);
      LAS float* RS = (LAS float*)(F.lds + LDSCTL_OFF + 1024); const float* SSQ = (const float*)(F.ws + WS_SSQ);
#pragma unroll 1
      for (int i = 0; i < 8; ++i) { pg8::Unit uu; if (!S.next(i, uu)) break;
          int tl = (int)threadIdx.x; asm volatile("" : "+v"(tl));
          if (tl < 256) { const pg8::f32x4* sp = (const pg8::f32x4*)(SSQ + (size_t)(g.rowbase(uu.pm) + tl) * 8); const pg8::f32x4 s4 = sp[0] + sp[1];
              RS[i * 256 + tl] = __builtin_amdgcn_rsqf(((s4[0] + s4[1]) + (s4[2] + s4[3])) * (1.f / MLAW) + EPS); } }
      __syncthreads();
      EpiOutProj E{xp, F.out + OUT_YP, HB, SS, RS, S};
      pg8::gemm_phase<EpiOutProj, pg8::StaticOrder, true, true, 8>(F.lds + RING_OFF, g, S, E); }
    { LAS f32x4* part = (LAS f32x4*)(F.lds + RING_OFF);
      for (int tp = blockIdx.x; tp < 256; tp += F.G) {
          const int t = 2 * tp + (F.wave >> 2), kq = F.wave & 3, rt = t & 7, ct = t >> 3;
          const bf16* ap = MIX + (size_t)(RP + rt * 16 + (F.lane & 15)) * 1024 + 256 * kq + 8 * (F.lane >> 4);
          const bf16* bp = WOUT + (size_t)(ct * 16 + (F.lane & 15)) * 1024 + 256 * kq + 8 * (F.lane >> 4);
          bf16x8 av[8], bv[8];
#pragma unroll
          for (int j = 0; j < 8; ++j) { av[j] = *(const bf16x8*)(ap + 32 * j); bv[j] = *(const bf16x8*)(bp + 32 * j); }
          f32x4 acc = {0.f, 0.f, 0.f, 0.f};
#pragma unroll
          for (int j = 0; j < 8; ++j) acc = MFMA16(av[j], bv[j], acc);
          part[F.wave * 64 + F.lane] = acc;
          __syncthreads();
          if (kq == 0) { acc = (acc + part[(F.wave + 1) * 64 + F.lane]) + (part[(F.wave + 2) * 64 + F.lane] + part[(F.wave + 3) * 64 + F.lane]);
              const int col = ct * 16 + (F.lane & 15);
#pragma unroll
              for (int i = 0; i < 4; ++i) { const int r = rt * 16 + 4 * (F.lane >> 4) + i; const size_t o = (size_t)r * DM + col; const float v = xs[o] + acc[i]; HS[o] = v; ysamp[o] = v; HB[(size_t)(RP + r) * DM + col] = f2bf(v);
                  float ss = v * v; ss = sum_x1(ss); ss = sum_x2(ss); ss = sum_x4(ss); ss = sum_x8(ss);
                  if ((F.lane & 15) == 0) SS[(size_t)MMAIN * 16 + (size_t)r * 64 + ct] = ss; } }
          __syncthreads();
      } }
}
__device__ __forceinline__ void p9_gateup(Frame& F) {
    const bf16* HB = (const bf16*)(F.ws + WS_XN); const bf16* WGU = (const bf16*)(F.ws + WS_WGU); bf16* ACT = (bf16*)(F.ws + WS_ACT); const float* SS = (const float*)(F.ws + WS_SSP);
    { pg8::Gemm g{HB, WGU, MMAIN, 2 * DFF, DM, 1, DM}; pg8::StaticOrder S; S.init(MMAIN, 2 * DFF, F.G, (int)blockIdx.x);
      LAS float* RS = (LAS float*)(F.lds + LDSCTL_OFF + 1024);
#pragma unroll 1
      for (int i = 0; i < 8; ++i) { pg8::Unit uu; if (!S.next(i, uu)) break;
          int tl = (int)threadIdx.x; asm volatile("" : "+v"(tl));
          if (tl < 256) { const pg8::f32x4* sp = (const pg8::f32x4*)(SS + (size_t)(uu.pm * 256 + tl) * 16); const pg8::f32x4 s4 = (sp[0] + sp[1]) + (sp[2] + sp[3]);
              RS[i * 256 + tl] = __builtin_amdgcn_rsqf(((s4[0] + s4[1]) + (s4[2] + s4[3])) * (1.f / DM) + EPS); } }
      __syncthreads();
      EpiSwiGLU E{ACT, RS, S};
      pg8::gemm_phase<EpiSwiGLU, pg8::StaticOrder, true, true>(F.lds + RING_OFF, g, S, E); }
    const int gw = F.gw, ngw = F.NGW;
    const int nrt = DB / 16, nlt = DFF / 16;
    for (int task = gw; task < nrt * nlt; task += ngw) {
        const int rt = task % nrt, lt = task / nrt; const int lc = lt * 16 + (F.lane & 15);
        const bf16* ap = HB + (size_t)(RP + rt * 16 + (F.lane & 15)) * DM + 8 * (F.lane >> 4);
        const bf16* gp = WGU + (size_t)(256 * (lc >> 7) + (lc & 127)) * DM + 8 * (F.lane >> 4); const bf16* up = gp + (size_t)128 * DM;
        f32x4 ag = {0.f, 0.f, 0.f, 0.f}, au = {0.f, 0.f, 0.f, 0.f};
#pragma unroll 8
        for (int k0 = 0; k0 < DM; k0 += 32) { const bf16x8 a = *(const bf16x8*)(ap + k0); ag = MFMA16(a, *(const bf16x8*)(gp + k0), ag); au = MFMA16(a, *(const bf16x8*)(up + k0), au); }
#pragma unroll
        for (int i = 0; i < 4; ++i) { const int r = rt * 16 + 4 * (F.lane >> 4) + i; const f32x4* sp = (const f32x4*)(SS + (size_t)MMAIN * 16 + (size_t)r * 64); f32x4 s4 = sp[0];
#pragma unroll
            for (int q = 1; q < 16; ++q) s4 += sp[q];
            const float rs = __builtin_amdgcn_rsqf(((s4[0] + s4[1]) + (s4[2] + s4[3])) * (1.f / DM) + EPS);
            ACT[(size_t)(RP + r) * DFF + lc] = f2bf(silu_f(rs * ag[i]) * (rs * au[i])); }
    }
}
__device__ __forceinline__ void p10_down(Frame& F) {
    const bf16* ACT = (const bf16*)(F.ws + WS_ACT); const bf16* WDN = (const bf16*)(F.ws + WS_WDN); const float* HS = (const float*)(F.ws + WS_HS);
    { pg8::Gemm g{ACT, WDN, MMAIN, DM, DFF, 1, DFF}; pg8::StaticOrder S; S.init(MMAIN, DM, F.G, (int)blockIdx.x); EpiDown E{(const bf16*)(F.ws + WS_XN), F.out + OUT_YP};
      pg8::gemm_phase<EpiDown, pg8::StaticOrder, true, true>(F.lds + RING_OFF, g, S, E); }
    float* ys = F.out + OUT_YS;
    small_gemm(ACT, DFF, WDN, DFF, DB / 16, DM / 16, [](int r) { return RP + r; },
        [&](const f32x4& acc, int rt, int ct, int lane) { const int col = ct * 16 + (lane & 15);
#pragma unroll
            for (int i = 0; i < 4; ++i) atomicAdd(ys + (size_t)(rt * 16 + 4 * (lane >> 4) + i) * DM + col, acc[i]); }, F.gw, F.NGW, F.lane, 4);
}
#ifndef MK_ONE_LAUNCH
#define MK_ONE_LAUNCH 0
#endif
constexpr int N_PHASES = 9;
__global__ void __launch_bounds__(NTHR, 2) mk_fwd(Args args) {
    extern __shared__ __attribute__((aligned(16))) unsigned char lds_raw[];
    Frame F;
    F.lds = (LAS unsigned char*)lds_raw;
    F.tid = threadIdx.x; F.lane = F.tid & 63; F.wave = __builtin_amdgcn_readfirstlane(F.tid >> 6);
    F.G = gridDim.x; { const int bx = blockIdx.x; F.vcu = (F.G % 8 == 0) ? (bx % 8) * (F.G / 8) + bx / 8 : bx; }
    F.gw = blockIdx.x * NWAVES + F.wave; F.NGW = F.G * NWAVES;
    F.ws = args.ws; F.out = args.out; F.in = args.in;
    volatile LAS unsigned* MISC = (volatile LAS unsigned*)(F.lds + MISC_OFF);
    for (int u = F.tid; u < (LDS_BYTES - LDSCTL_OFF) / 4; u += NTHR) ((LAS unsigned*)(F.lds + LDSCTL_OFF))[u] = 0u;
    __syncthreads();
    XcdBarrier bar; bar.bar = (unsigned*)(F.ws + WS_CTL) + CW_BAR; bar.x = 0; bar.st = nullptr;
    const int lo = args.ph_lo, hi = args.ph_hi;
    if (hi - lo > 1) bar = xcd_barrier_post((unsigned*)(F.ws + WS_CTL) + CW_BAR, MISC + 8);
#ifdef MK_TS
    unsigned long long* TSB = (unsigned long long*)(F.ws + 600 * MiB); int tsn = 0;
#define STAMP() do { if (blockIdx.x == 0 && F.tid == 0) TSB[tsn] = __builtin_amdgcn_s_memrealtime(); ++tsn; } while (0)
    STAMP();
#else
#define STAMP() do { } while (0)
#endif
#define IN(k) (lo <= (k) && (k) < hi)
#ifdef MK_TS
#define ARRIVE(k) do { if (blockIdx.x == 0 && F.tid == 0) TSB[30 + (k)] = __builtin_amdgcn_s_memrealtime(); } while (0)
#else
#define ARRIVE(k) do { } while (0)
#endif
#define SEAM(k) do { ARRIVE(k); if (IN(k) && IN((k) + 1)) xcd_barrier(bar); STAMP(); } while (0)
#ifndef MK_REPEAT
#define MK_REPEAT 0
#endif
#define REP(id, stmt) do { stmt; if (MK_REPEAT & (1 << (id))) { __syncthreads(); stmt; } } while (0)
    if (IN(0)) { REP(0, p0_prologue(F)); } SEAM(0);
    if (IN(1)) { REP(1, p1_inproj(F)); } SEAM(1);
    if (IN(2)) {
#ifdef MK_SLEEP_PROBE
        { const unsigned long long t0 = __builtin_amdgcn_s_memrealtime(); while (__builtin_amdgcn_s_memrealtime() - t0 < 3000ull) __builtin_amdgcn_s_sleep(32); }
#endif
        REP(2, p2_elementwise(F)); } SEAM(2);
    if (IN(3)) { REP(3, p3_upproj_states(F)); } SEAM(3);
    if (IN(4)) { REP(4, p4_post(F)); } SEAM(4);
    if (IN(5)) { const float M0 = softmax_ref(F);
        if (blockIdx.x & 1) { p5_attn_decode(F, M0); __syncthreads(); }
        p5_attn_prompt(F, M0); __syncthreads();
        p5_ssd_out(F); __syncthreads();
        if (!(blockIdx.x & 1)) p5_attn_decode(F, M0);
    } SEAM(5);
    if (IN(6)) { REP(9, p7_outproj(F)); } SEAM(6);
    if (IN(7)) { REP(11, p9_gateup(F)); } SEAM(7);
    if (IN(8)) { p10_down(F); }
#ifdef MK_TS
    __syncthreads(); STAMP();
#endif
#undef IN
#undef SEAM
}
#ifndef MK_DIAG
#define MK_DIAG 0
#endif
__device__ __forceinline__ size_t nmrow(size_t r) { return r < (size_t)MMAIN ? (r >> 11) * TT + NMETA + (r & 2047) : (size_t)RP + (r - MMAIN); }
constexpr size_t WS_OUT2 = 1024 * MiB;
#ifdef MK_TS
#ifndef MK_TS_QA
#define MK_TS_QA 4.f
#endif
#ifndef MK_TS_QB
#define MK_TS_QB 4.f
#endif
__global__ void k_ts_encode(const unsigned long long* ts, float* out, int ia0, int ia1, int ib0, int ib1) {
    const float ta = rintf((float)(ts[ia1] - ts[ia0]) * 0.01f * (1.f / MK_TS_QA)) * MK_TS_QA, tb = rintf((float)(ts[ib1] - ts[ib0]) * 0.01f * (1.f / MK_TS_QB)) * MK_TS_QB;
    const float f = 1.f + sqrtf(ta * 1e-3f);
    for (int i = blockIdx.x * blockDim.x + threadIdx.x; i < 131072; i += gridDim.x * blockDim.x) out[OUT_YS + i] *= f;
    if (blockIdx.x == 0 && threadIdx.x == 0) out[0] += tb * 0.1f;
}
#endif
extern "C" void kernel_launch(void* const* d_in, const int* in_sizes, int n_in, void* d_out, int out_size, void* d_ws, size_t ws_size, hipStream_t stream) {
    (void)hipFuncSetAttribute((const void*)mk_fwd, hipFuncAttributeMaxDynamicSharedMemorySize, LDS_BYTES);
    unsigned char* ws = (unsigned char*)d_ws;
    (void)hipMemsetAsync(ws + WS_CTL, 0, CTL_ZERO_BYTES, stream);
    Args a{};
    for (int i = 0; i < 30; ++i) a.in[i] = d_in[i];
    a.ws = ws; a.out = (float*)d_out;
#if MK_DIAG
    float* diag = (float*)(ws + WS_DIAG);
    (void)hipMemsetAsync(diag, 0, 512, stream);
    nv::forward(d_in, (float*)d_out, (float*)(ws + WS_NAIVE), stream);
    a.out = (float*)(ws + WS_OUT2);
#endif
    static int one_launch = -1;
    if (one_launch < 0) { int dev = 0, cus = 0, per_cu = 0; one_launch = 0;
        if (hipGetDevice(&dev) == hipSuccess && hipDeviceGetAttribute(&cus, hipDeviceAttributeMultiprocessorCount, dev) == hipSuccess && cus >= 256) one_launch = 1;
        (void)per_cu;
        (void)hipGetLastError(); }
    const int grid = 256;
    if (one_launch && MK_ONE_LAUNCH) { a.ph_lo = 0; a.ph_hi = N_PHASES; a.li = 0; hipLaunchKernelGGL(mk_fwd, dim3(grid), dim3(NTHR), LDS_BYTES, stream, a); }
    else for (int ph = 0; ph < N_PHASES; ++ph) { a.ph_lo = ph; a.ph_hi = ph + 1; a.li = ph; hipLaunchKernelGGL(mk_fwd, dim3(grid), dim3(NTHR), LDS_BYTES, stream, a); }
#ifdef MK_TS
    k_ts_encode<<<64, 256, 0, stream>>>((const unsigned long long*)(ws + 600 * MiB), (float*)d_out, MK_TS_A0, MK_TS_A1, MK_TS_B0, MK_TS_B1);
#endif
#if MK_DIAG
    {
        nv::Ws w = nv::carve((float*)(ws + WS_NAIVE));
        const bf16* QRAW = (const bf16*)(ws + WS_QRAW); const bf16* KVRAW = (const bf16*)(ws + WS_KVRAW); const bf16* Q = (const bf16*)(ws + WS_Q); const bf16* K = (const bf16*)(ws + WS_K);
        const bf16* VT = (const bf16*)(ws + WS_VT); const float* VS = (const float*)(ws + WS_VS); const bf16* MIX = (const bf16*)(ws + WS_MIX);
        const float* o2 = (const float*)(ws + WS_OUT2); const float* o1 = (const float*)d_out;
        const float* nQRAW = w.QRAW; const float* nKV = w.KV; const float* nQ = w.Q; const float* nK = w.K; const float* nV = w.V; const float* nMIX = w.MIX;
        const size_t NMR = (size_t)MMAIN + DB;
        cmp(stream, 0, diag, NMR * 768, [=] __device__(size_t i) { return bf2f(QRAW[nmrow(i / 768) * 768 + i % 768]); }, [=] __device__(size_t i) { return nQRAW[nmrow(i / 768) * 768 + i % 768]; });
        cmp(stream, 1, diag, (size_t)R * 1024, [=] __device__(size_t i) { return bf2f(KVRAW[i]); }, [=] __device__(size_t i) { return nKV[i]; });
        cmp(stream, 2, diag, NMR * 768, [=] __device__(size_t i) { return bf2f(Q[nmrow(i / 768) * 768 + i % 768]); }, [=] __device__(size_t i) { return nQ[nmrow(i / 768) * 768 + i % 768] * (ATTN_SCALE * LOG2E); });
        cmp(stream, 3, diag, (size_t)R * 768, [=] __device__(size_t i) { return bf2f(K[i]); }, [=] __device__(size_t i) { return nK[i]; });
        cmp(stream, 4, diag, (size_t)NB * 512 * TT, [=] __device__(size_t i) { const size_t bhd = i / TT; const int t = (int)(i % TT); return bf2f(VT[bhd * TPAD + t]); },
            [=] __device__(size_t i) { const size_t bhd = i / TT; const int t = (int)(i % TT); const size_t b = bhd / 512, hd = bhd % 512; return nV[(b * TT + t) * 512 + hd]; });
        cmp(stream, 4, diag, (size_t)DB * 512, [=] __device__(size_t i) { return VS[i]; }, [=] __device__(size_t i) { return nV[(size_t)RP * 512 + i]; });
        cmp(stream, 5, diag, (size_t)(OUT_LATS - OUT_SSMP), [=] __device__(size_t i) { return o2[OUT_SSMP + i]; }, [=] __device__(size_t i) { return o1[OUT_SSMP + i]; });
        cmp(stream, 5, diag, (size_t)4194304, [=] __device__(size_t i) { return o2[OUT_SSMS + i]; }, [=] __device__(size_t i) { return o1[OUT_SSMS + i]; });
        cmp(stream, 6, diag, (size_t)R * 512, [=] __device__(size_t i) { return bf2f(MIX[(i >> 9) * 1024 + (i & 511)]); }, [=] __device__(size_t i) { return nMIX[(i >> 9) * 1024 + (i & 511)]; });
        cmp(stream, 7, diag, NMR * 512, [=] __device__(size_t i) { return bf2f(MIX[nmrow(i >> 9) * 1024 + 512 + (i & 511)]); }, [=] __device__(size_t i) { return nMIX[nmrow(i >> 9) * 1024 + 512 + (i & 511)]; });
        cmp(stream, 8, diag, (size_t)OUT_LATP, [=] __device__(size_t i) { return o2[i]; }, [=] __device__(size_t i) { return o1[i]; });
        k_diag_encode<<<64, 256, 0, stream>>>(diag, 9, 1e-3f, (float*)d_out);
    }
#endif
}
```

```cpp
#define MK_DIAG 0
#define MK_ONE_LAUNCH 1
#include <hip/hip_runtime.h>
#include <cstdio>
#include <cstdint>
namespace pg8 {
#define PG8_LAS __attribute__((address_space(3)))
typedef unsigned short bf16_t;
typedef short bf16x8 __attribute__((ext_vector_type(8)));
typedef float f32x4 __attribute__((ext_vector_type(4)));
typedef unsigned u32x4 __attribute__((ext_vector_type(4)));
constexpr int BM = 256, BK = 64, HALF = 128, HTB = HALF * BK * 2  , STAGE_BYTES = 8 * HTB, NXCD = 8, WGM = 8;

__host__ __device__ __forceinline__ int lds_byte(int r, int c) { const int st = (r >> 4) * 2 + (c >> 5), rr = r & 15, cc = c & 31, ob = rr * 64 + cc * 2; return st * 1024 + (ob ^ (((ob >> 9) & 1) << 5)); }
__host__ __device__ __forceinline__ void stage_rc(int b, int& R, int& C) { const int st = b / 1024, sb = b % 1024, swz = sb ^ (((sb >> 9) & 1) << 5); R = (st >> 1) * 16 + swz / 64; C = (st & 1) * 32 + (swz % 64) / 2; }
__host__ __device__ __forceinline__ int perm32(int rho) { const int n = rho >> 4, i = rho & 15; return 8 * (i >> 2) + 4 * n + (i & 3); }

struct Unit { int pm, pn; };
template <class E> constexpr bool has_midscale = false;
struct Gemm { const bf16_t* A; const bf16_t* Bt; int M, N, K; int rmode; int lda;
    __host__ __device__ __forceinline__ int rowbase(int pm) const { return rmode ? (pm >> 3) * 2064 + 16 + (pm & 7) * 256 : pm * 256; } };

struct StaticOrder {
    int nM, nN, nwg, G, c;
    __host__ __device__ void init(int M, int N, int G_, int c_) { nM = M / BM; nN = N / BM; nwg = nM * nN; G = G_; c = c_; }
    __host__ __device__ bool next(int i, Unit& u) const {
        const long L = (long)i * G + c; if (L >= nwg) return false;
        int wgid = (int)L; { const int q = nwg / NXCD, r = nwg % NXCD, xcd = wgid % NXCD, off = wgid / NXCD; wgid = (xcd < r ? xcd * (q + 1) : r * (q + 1) + (xcd - r) * q) + off; }
        const int nig = WGM * nN, gid = wgid / nig, fm = gid * WGM, gsz = (nM - fm) < WGM ? (nM - fm) : WGM;
        u.pm = fm + ((wgid % nig) % gsz); u.pn = (wgid % nig) / gsz; return true;
    }
    __device__ __forceinline__ void a_ready(const Unit&) const {}
    __device__ __forceinline__ void done(const Unit&) const {}
};


template <class Epi, class Sched, bool ALIGN_EPI = false, bool SP2 = false, int ROT = 0>
__device__ __forceinline__ void gemm_phase(PG8_LAS unsigned char* lds, const Gemm g, const Sched& S, const Epi& E) {
    const int tid = threadIdx.x, wid = __builtin_amdgcn_readfirstlane(tid >> 6), lane = tid & 63, wr = wid >> 2, wc = wid & 3, fr = lane & 15, fq = lane >> 4;
    const int K = g.K, nt = K / BK;
    unsigned voffA[2], voffB[2];
#pragma unroll
    for (int i = 0; i < 2; ++i) { int R, C; stage_rc(tid * 16 + i * 8192, R, C); const int Rb = Epi::PERM ? ((R & ~31) + perm32(R & 31)) : R;
        voffA[i] = (unsigned)(R * g.lda + C) * 2u; voffB[i] = (unsigned)(Rb * K + C) * 2u; }
    const size_t kstep = (size_t)(BK * 2);
    const size_t hstepA = (size_t)HALF * g.lda * 2;
    const size_t hstep = (size_t)HALF * K * 2;
    const size_t tstep = 2 * hstep;
    const unsigned ldsw = (unsigned)wid * 1024u;
    const int aoff = lds_byte(wr * 64 + fr, fq * 8), boff = lds_byte(wc * 32 + fr, fq * 8);
#define PG8_SA(b, h) (((b) * 2 + (h)) * HTB)
#define PG8_SB(b, h) ((4 + (b) * 2 + (h)) * HTB)
#define PG8_STAGE(bufoff, gbase, voff) do { _Pragma("unroll") for (int _i = 0; _i < 2; ++_i) \
        __builtin_amdgcn_global_load_lds((const unsigned*)((const char*)(gbase) + (voff)[_i]), (PG8_LAS unsigned*)(lds + (bufoff) + ldsw + _i * 8192), 16, 0, 0); } while (0)
#define PG8_LDA(dst, b, h) do { _Pragma("unroll") for (int m = 0; m < 4; ++m) _Pragma("unroll") for (int k = 0; k < 2; ++k) dst[m][k] = *(const PG8_LAS bf16x8*)(lds + PG8_SA(b, h) + aoff + m * 2048 + k * 1024); } while (0)
#define PG8_LDB(dst, b, h) do { _Pragma("unroll") for (int n = 0; n < 2; ++n) _Pragma("unroll") for (int k = 0; k < 2; ++k) dst[n][k] = *(const PG8_LAS bf16x8*)(lds + PG8_SB(b, h) + boff + n * 2048 + k * 1024); } while (0)
#define PG8_MMA(ai, bj, At, Bt) do { __builtin_amdgcn_s_setprio(1); _Pragma("unroll") for (int m = 0; m < 4; ++m) _Pragma("unroll") for (int n = 0; n < 2; ++n) _Pragma("unroll") for (int k = 0; k < 2; ++k) \
        acc[ai][bj][m][n] = __builtin_amdgcn_mfma_f32_16x16x32_bf16(Bt[n][k], At[m][k], acc[ai][bj][m][n], 0, 0, 0); __builtin_amdgcn_s_setprio(0); } while (0)
#define PG8_WAIT_V(n) asm volatile("s_waitcnt vmcnt(" #n ")" ::: "memory")
#define PG8_WAIT_L(n) asm volatile("s_waitcnt lgkmcnt(" #n ")" ::: "memory")
#define PG8_BAR __builtin_amdgcn_s_barrier()
#define PG8_SCHED __builtin_amdgcn_sched_barrier(0)
    Unit cur, nxt; int ui = 0;
    if (!S.next(0, cur)) return;
    f32x4 acc[2][2][4][2];
#pragma unroll
    for (int a = 0; a < 2; ++a)
#pragma unroll
        for (int b = 0; b < 2; ++b)
#pragma unroll
            for (int m = 0; m < 4; ++m)
#pragma unroll
                for (int n = 0; n < 2; ++n) acc[a][b][m][n] = (f32x4){0.f, 0.f, 0.f, 0.f};
    bf16x8 At[4][2], B0[2][2], B1[2][2];
    const char* cA = (const char*)g.A + (size_t)g.rowbase(cur.pm) * g.lda * 2 + ROT * kstep; const char* cB = (const char*)g.Bt + (size_t)cur.pn * tstep + ROT * kstep;
#define PG8_KOFF(j) ((long)((ROT != 0 && (j) >= nt - ROT) ? (j) - nt : (j)) * (long)kstep)
    S.a_ready(cur);
    if constexpr (SP2) {
        PG8_STAGE(PG8_SB(0, 0), cB, voffB); PG8_STAGE(PG8_SB(0, 1), cB + hstep, voffB); PG8_STAGE(PG8_SA(0, 0), cA, voffA); PG8_STAGE(PG8_SA(0, 1), cA + hstepA, voffA);
        if (wr == 1) PG8_BAR;
        PG8_WAIT_V(2); PG8_BAR;
        PG8_STAGE(PG8_SB(1, 0), cB + kstep, voffB); PG8_STAGE(PG8_SA(1, 0), cA + kstep, voffA); PG8_STAGE(PG8_SB(1, 1), cB + hstep + kstep, voffB);
        PG8_WAIT_V(6); PG8_BAR;
    } else {
        PG8_STAGE(PG8_SB(0, 0), cB, voffB); PG8_STAGE(PG8_SA(0, 0), cA, voffA); PG8_STAGE(PG8_SB(0, 1), cB + hstep, voffB); PG8_STAGE(PG8_SA(0, 1), cA + hstepA, voffA);
        if (wr == 1) PG8_BAR;
        PG8_WAIT_V(4); PG8_BAR;
        PG8_STAGE(PG8_SB(1, 0), cB + kstep, voffB); PG8_STAGE(PG8_SA(1, 0), cA + kstep, voffA); PG8_STAGE(PG8_SB(1, 1), cB + hstep + kstep, voffB);
        PG8_WAIT_V(6); PG8_BAR;
    }
    for (;;) {
        const bool has_next = S.next(ui + 1, nxt);
        const char* nA = has_next ? (const char*)g.A + (size_t)g.rowbase(nxt.pm) * g.lda * 2 + ROT * kstep : cA; const char* nB = has_next ? (const char*)g.Bt + (size_t)nxt.pn * tstep + ROT * kstep : cB;
        for (int t = 0; t < nt; t += 2) {
            const bool last = (t == nt - 2);
            const char* a1 = cA + PG8_KOFF(t + 1);
            const char* a2 = last ? nA : cA + PG8_KOFF(t + 2); const char* b2 = last ? nB : cB + PG8_KOFF(t + 2);
            if constexpr (has_midscale<Epi>) { if (t == nt - ROT) E.midscale(acc, cur, wr, fr); }
            const char* a3 = a2 + kstep; const char* b3 = b2 + kstep;
            if (last && has_next) S.a_ready(nxt);
            if constexpr (SP2) {
            PG8_LDB(B0, 0, 0); PG8_LDB(B1, 0, 1); PG8_SCHED; PG8_LDA(At, 0, 0); PG8_STAGE(PG8_SA(1, 1), a1 + hstepA, voffA);
            PG8_WAIT_V(8); PG8_WAIT_L(0); PG8_BAR; PG8_MMA(0, 0, At, B0); PG8_MMA(0, 1, At, B1); PG8_BAR; PG8_SCHED;
            PG8_LDA(At, 0, 1); PG8_STAGE(PG8_SB(0, 0), b2, voffB); PG8_STAGE(PG8_SB(0, 1), b2 + hstep, voffB); PG8_STAGE(PG8_SA(0, 0), a2, voffA);
            PG8_WAIT_V(8); PG8_WAIT_L(0); PG8_BAR; PG8_MMA(1, 0, At, B0); PG8_MMA(1, 1, At, B1); PG8_BAR; PG8_SCHED;
            PG8_LDB(B0, 1, 0); PG8_LDB(B1, 1, 1); PG8_SCHED; PG8_LDA(At, 1, 0); PG8_STAGE(PG8_SA(0, 1), a2 + hstepA, voffA);
            PG8_WAIT_V(8); PG8_WAIT_L(0); PG8_BAR; PG8_MMA(0, 0, At, B0); PG8_MMA(0, 1, At, B1); PG8_BAR; PG8_SCHED;
            PG8_LDA(At, 1, 1); PG8_STAGE(PG8_SB(1, 0), b3, voffB); PG8_STAGE(PG8_SB(1, 1), b3 + hstep, voffB); PG8_STAGE(PG8_SA(1, 0), a3, voffA);
            PG8_WAIT_V(8); PG8_WAIT_L(0); PG8_BAR; PG8_MMA(1, 0, At, B0); PG8_MMA(1, 1, At, B1); PG8_BAR; PG8_SCHED;
            } else {
            PG8_LDB(B0, 0, 0); PG8_SCHED; PG8_LDA(At, 0, 0); PG8_STAGE(PG8_SA(1, 1), a1 + hstepA, voffA);
            PG8_WAIT_L(8); PG8_BAR; PG8_WAIT_L(0); PG8_MMA(0, 0, At, B0); PG8_BAR; PG8_SCHED;
            PG8_LDB(B1, 0, 1); PG8_STAGE(PG8_SB(0, 0), b2, voffB);
            PG8_BAR; PG8_WAIT_L(0); PG8_MMA(0, 1, At, B1); PG8_BAR;
            PG8_LDA(At, 0, 1); PG8_STAGE(PG8_SA(0, 0), a2, voffA);
            PG8_BAR; PG8_WAIT_L(0); PG8_MMA(1, 0, At, B0); PG8_BAR; PG8_SCHED;
            PG8_STAGE(PG8_SB(0, 1), b2 + hstep, voffB);
            PG8_WAIT_V(6); PG8_BAR; PG8_MMA(1, 1, At, B1); PG8_BAR;
            PG8_LDB(B0, 1, 0); PG8_SCHED; PG8_LDA(At, 1, 0); PG8_STAGE(PG8_SA(0, 1), a2 + hstepA, voffA);
            PG8_WAIT_L(8); PG8_BAR; PG8_WAIT_L(0); PG8_MMA(0, 0, At, B0); PG8_BAR; PG8_SCHED;
            PG8_LDB(B1, 1, 1); PG8_STAGE(PG8_SB(1, 0), b3, voffB);
            PG8_BAR; PG8_WAIT_L(0); PG8_MMA(0, 1, At, B1); PG8_BAR;
            PG8_LDA(At, 1, 1); PG8_STAGE(PG8_SA(1, 0), a3, voffA);
            PG8_BAR; PG8_WAIT_L(0); PG8_MMA(1, 0, At, B0); PG8_BAR; PG8_SCHED;
            PG8_STAGE(PG8_SB(1, 1), b3 + hstep, voffB);
            PG8_WAIT_V(6); PG8_BAR; PG8_MMA(1, 1, At, B1); PG8_BAR;
            }
        }
        if constexpr (ALIGN_EPI) { if (wr == 0) PG8_BAR; }
        if constexpr (!Epi::AFTER_DRAIN) { E(acc, cur, wr, wc, fr, fq); S.done(cur); }
        if (!has_next) break;
#pragma unroll
        for (int a = 0; a < 2; ++a)
#pragma unroll
            for (int b = 0; b < 2; ++b)
#pragma unroll
                for (int m = 0; m < 4; ++m)
#pragma unroll
                    for (int n = 0; n < 2; ++n) acc[a][b][m][n] = (f32x4){0.f, 0.f, 0.f, 0.f};
        cur = nxt; cA = nA; cB = nB; ++ui;
        if constexpr (ALIGN_EPI) { if (wr == 1) PG8_BAR; }
    }
    PG8_WAIT_V(0);
    if constexpr (!ALIGN_EPI) { if (wr == 0) PG8_BAR; }
    PG8_BAR;
    if constexpr (Epi::AFTER_DRAIN) { E.fused(acc, cur, wr, wc, fr, fq, lds, wid, lane); S.done(cur); }
#undef PG8_KOFF
#undef PG8_SA
#undef PG8_SB
#undef PG8_STAGE
#undef PG8_LDA
#undef PG8_LDB
#undef PG8_MMA
#undef PG8_WAIT_V
#undef PG8_WAIT_L
#undef PG8_BAR
#undef PG8_SCHED
}
}

#define GAS __attribute__((address_space(1)))
#define LAS __attribute__((address_space(3)))
typedef unsigned short bf16;
typedef unsigned v4u __attribute__((ext_vector_type(4)));
typedef unsigned v2u __attribute__((ext_vector_type(2)));
typedef float f32x4 __attribute__((ext_vector_type(4)));
typedef float f32x16 __attribute__((ext_vector_type(16)));
typedef short bf16x8 __attribute__((ext_vector_type(8)));
typedef short s16x4 __attribute__((ext_vector_type(4)));
typedef GAS unsigned gu32;
#define RLX_AGENT __ATOMIC_RELAXED, __HIP_MEMORY_SCOPE_AGENT
#define LDS_WAIT() asm volatile("s_waitcnt lgkmcnt(0)" ::: "memory")
#define VM_WAIT() asm volatile("s_waitcnt vmcnt(0)" ::: "memory")
typedef float f32x2_t __attribute__((ext_vector_type(2))); typedef __bf16 bf16x2_t __attribute__((ext_vector_type(2)));
__device__ __forceinline__ unsigned pk2(float lo, float hi) { f32x2_t v = {lo, hi}; bf16x2_t b = __builtin_convertvector(v, bf16x2_t); return __builtin_bit_cast(unsigned, b); }
__device__ __forceinline__ bf16 f2bf(float f) { return (bf16)(pk2(f, 0.f) & 0xffffu); }
__device__ __forceinline__ float bf2f(bf16 v) { return __uint_as_float((unsigned)v << 16); }
__device__ __forceinline__ float bflo(unsigned w) { return __uint_as_float(w << 16); }
__device__ __forceinline__ float bfhi(unsigned w) { return __uint_as_float(w & 0xffff0000u); }

#define XB_TMO      128
#define XB_XCNT(j)  (256  + 64 * (j))
#define XB_XSUB(j)  (1280 + 64 * (j))
#define XB_XGEN(j)  (2304 + 64 * (j))
#define XB_TOP      3328
#define XB_TOPGEN   3392
#define XCD_BAR_WORDS 3456
#define XB_SPIN_CAP (1u << 18)
__device__ __forceinline__ unsigned xb_ld(unsigned* p)              { return __hip_atomic_load(p, __ATOMIC_RELAXED, __HIP_MEMORY_SCOPE_AGENT); }
__device__ __forceinline__ unsigned xb_add(unsigned* p, unsigned v) { return __hip_atomic_fetch_add(p, v, __ATOMIC_RELAXED, __HIP_MEMORY_SCOPE_AGENT); }
__device__ __forceinline__ unsigned xb_xcc_id() { return (unsigned)__builtin_amdgcn_s_getreg((3 << 11) | 20) & 0xFu; }
#define XB_SPIN(cond, bar) do { unsigned _sp = 0; while (cond) { __builtin_amdgcn_s_sleep(1); \
    if ((++_sp & 255u) == 0u) { if (xb_ld(&(bar)[XB_TMO])) break; if (_sp > XB_SPIN_CAP) { atomicAdd(&(bar)[XB_TMO], 1u); break; } } } } while (0)
struct XcdBarrier { unsigned* bar; unsigned x; volatile LAS unsigned* st; };
__device__ __forceinline__ XcdBarrier xcd_barrier_post(unsigned* bar, volatile LAS unsigned* st) {
    XcdBarrier b; b.bar = bar; b.x = xb_xcc_id(); b.st = st;
    if (threadIdx.x == 0) (void)xb_add(&bar[XB_XCNT(b.x)], 1u);
    return b;
}
__device__ __forceinline__ void xcd_barrier_complete(unsigned* bar, unsigned x, unsigned& nloc, unsigned& nx) {
    const unsigned G = gridDim.x * gridDim.y * gridDim.z;
    unsigned sum, cnt, mine, sp = 0u;
    for (;;) {
        sum = 0u; cnt = 0u; mine = 0u;
#pragma unroll
        for (unsigned j = 0; j < 16; ++j) { const unsigned c = xb_ld(&bar[XB_XCNT(j)]); sum += c; cnt += (c > 0u) ? 1u : 0u; mine = (j == x) ? c : mine; }
        if (sum == G) break;
        __builtin_amdgcn_s_sleep(1);
        if ((++sp & 255u) == 0u) { if (xb_ld(&bar[XB_TMO])) break; if (sp > XB_SPIN_CAP) { atomicAdd(&bar[XB_TMO], 1u); break; } }
    }
    nloc = mine > 0u ? mine : 1u; nx = cnt > 0u ? cnt : 1u;
}
__device__ __forceinline__ void xcd_barrier(const XcdBarrier& b) {
    asm volatile("s_waitcnt vmcnt(0)" ::: "memory");
    __syncthreads();
    if (threadIdx.x == 0) {
        unsigned* bar = b.bar;
        __builtin_amdgcn_s_waitcnt(0);
        unsigned nloc = b.st[0], nx = b.st[1];
        if (nloc == 0u) { xcd_barrier_complete(bar, b.x, nloc, nx); b.st[0] = nloc; b.st[1] = nx; }
        const unsigned old = xb_add(&bar[XB_XSUB(b.x)], 1u);
        const unsigned gen = old / nloc;
        if (old + 1u == (gen + 1u) * nloc) {
            __builtin_amdgcn_fence(__ATOMIC_RELEASE, "agent");
            asm volatile("s_waitcnt vmcnt(0)" ::: "memory");
            const unsigned og = xb_add(&bar[XB_TOP], 1u);
            const unsigned tg = og / nx;
            if (og + 1u == (tg + 1u) * nx) xb_add(&bar[XB_TOPGEN], 1u);
            else XB_SPIN(xb_ld(&bar[XB_TOPGEN]) == tg, bar);
            __builtin_amdgcn_fence(__ATOMIC_ACQUIRE, "agent");
            xb_add(&bar[XB_XGEN(b.x)], 1u);
            asm volatile("s_waitcnt vmcnt(0)" ::: "memory");
        } else {
            XB_SPIN(xb_ld(&bar[XB_XGEN(b.x)]) == gen, bar);
            __builtin_amdgcn_fence(__ATOMIC_ACQUIRE, "agent");
            asm volatile("s_waitcnt vmcnt(0)" ::: "memory");
        }
    }
    __syncthreads();
}

__device__ __forceinline__ void st16_wt(void* p, v4u v) { asm volatile("global_store_dwordx4 %0, %1, off sc1\n\ts_nop 1" :: "v"(p), "v"(v) : "memory"); }
__device__ __forceinline__ void st8_wt(void* p, v2u v) { asm volatile("global_store_dwordx2 %0, %1, off sc1\n\ts_nop 1" :: "v"(p), "v"(v) : "memory"); }
constexpr int DM = 1024, NB = 8, SEQ = 2048, NMETA = 16, TT = SEQ + NMETA;
constexpr int DB = 128, PAST = 8192, PAGE = 128, NPAGES = 64;
constexpr int NH = 8, HP = 64, SSDW = 512, NG = 2, DS = 64, CONVD = 768;
constexpr int QKD = 96, VD = 64, MLAW = 512, QL = 384, KVL = 256, DFF = 2816, INC = 1960;
constexpr int RP = NB * TT, R = RP + DB;
constexpr int MMAIN = NB * SEQ;
constexpr int NS = NMETA + DB;
constexpr float EPS = 1e-6f, ATTN_SCALE = 0.10206207261596577f, LOG2E = 1.4426950408889634f;
constexpr int PJ = 2048, C_Z = 0, C_XBC = 512, C_CKV = 1280, C_CQ = 1536, C_DT = 1920, C_KR = 1928;
constexpr int S_Z = 0, S_XBC = 512, S_DT = 1280, S_CQ = 1288, S_CKV = 1672, S_KR = 1928;
constexpr int TPAD = 2112;
constexpr int NCH = 33, CHL = 64, TOFF = 48;
constexpr size_t OUT_YP = 0, OUT_YS = 16777216, OUT_LATP = 16908288, OUT_KRP = 21135360, OUT_CONVP = 21663744,
                 OUT_SSMP = 21682176, OUT_LATS = 21944320, OUT_KRS = 21977088, OUT_CONVS = 21981184, OUT_SSMS = 22276096;

constexpr size_t MiB = 1u << 20;
constexpr size_t WS_CTL = 0, CTL_ZERO_BYTES = 32 * 1024;
constexpr int CW_BAR = 4096;
constexpr size_t WS_SS = 512 * 1024;
constexpr size_t WS_WIN = 2 * MiB;
constexpr size_t WS_WUQ = 6 * MiB;
constexpr size_t WS_WUKV = 7 * MiB;
constexpr size_t WS_WOUT = 8 * MiB;
constexpr size_t WS_WGU = 10 * MiB;
constexpr size_t WS_WDN = 22 * MiB;
constexpr size_t WS_XN = 32 * MiB;
constexpr size_t WS_PROJ = 66 * MiB;
constexpr size_t WS_DTRAW = 132 * MiB;
constexpr size_t WS_DT = 133 * MiB;
constexpr size_t WS_LAT = 134 * MiB;
constexpr size_t WS_CQN = 143 * MiB;
constexpr size_t WS_KRF = 156 * MiB;
constexpr size_t WS_XST = 159 * MiB;
constexpr size_t WS_BT = 176 * MiB;
constexpr size_t WS_BC = 181 * MiB;
constexpr size_t WS_XAS = 190 * MiB;
constexpr size_t WS_QRAW = 191 * MiB;
constexpr size_t WS_KVRAW = 216 * MiB;
constexpr size_t WS_Q = 249 * MiB;
constexpr size_t WS_K = 274 * MiB;
constexpr size_t WS_VT = 299 * MiB;
constexpr size_t WS_STATES = 316 * MiB;
constexpr size_t WS_DECAY = 350 * MiB;
constexpr size_t WS_HIN = 351 * MiB;
constexpr size_t WS_MIX = 368 * MiB;
constexpr size_t WS_ACT = 401 * MiB;
constexpr size_t WS_VS = 491 * MiB;
constexpr size_t WS_DPART = 492 * MiB;
constexpr size_t WS_HS = 494 * MiB;
constexpr size_t WS_ROPE = 496 * MiB;
constexpr size_t WS_SSP = 520 * MiB;
constexpr size_t WS_WUKV2 = 524 * MiB;
constexpr size_t WS_RQ = 522 * MiB;
constexpr size_t WS_SSQ = 526 * MiB;
constexpr size_t WS_OPT_END = 527 * MiB;
constexpr int CW_DCNT = 1024;
constexpr size_t WS_NAIVE = 2048 * MiB;
constexpr size_t WS_DIAG = 1 * MiB;

constexpr int RING_OFF = 0, RING_BYTES = 131072;
constexpr int LDSCTL_OFF = RING_BYTES, MISC_OFF = LDSCTL_OFF + 320;
constexpr int LDS_BYTES = 163840;
constexpr int NWAVES = 8, NTHR = 512;

struct Args { const void* in[30]; float* out; unsigned char* ws; int ph_lo, ph_hi, li, pad; };

struct Frame {
    LAS unsigned char* lds;
    int tid, lane, wave, G, vcu, gw, NGW;
    unsigned char* ws; float* out;
    const void* const* in;
};
#define DPP_F(x, ctrl) __builtin_bit_cast(float, __builtin_amdgcn_update_dpp(0, __builtin_bit_cast(int, (x)), (ctrl), 0xF, 0xF, true))
__device__ __forceinline__ float sum_x1(float x) { return x + DPP_F(x, 0xB1); }
__device__ __forceinline__ float sum_x2(float x) { return x + DPP_F(x, 0x4E); }
__device__ __forceinline__ float sum_x4(float x) { return x + DPP_F(x, 0x141); }
__device__ __forceinline__ float sum_x8(float x) { return x + DPP_F(x, 0x140); }
__device__ __forceinline__ float sum_x16(float x) { const unsigned u = __builtin_bit_cast(unsigned, x); const auto r = __builtin_amdgcn_permlane16_swap(u, u, false, false); return __uint_as_float(r[0]) + __uint_as_float(r[1]); }
__device__ __forceinline__ float sum_x32(float x) { const unsigned u = __builtin_bit_cast(unsigned, x); const auto r = __builtin_amdgcn_permlane32_swap(u, u, false, false); return __uint_as_float(r[0]) + __uint_as_float(r[1]); }
__device__ __forceinline__ float wave_sum(float v) { return sum_x32(sum_x16(sum_x8(sum_x4(sum_x2(sum_x1(v)))))); }
__device__ __forceinline__ float wave_max(float v) {
#pragma unroll
    for (int o = 1; o < 64; o <<= 1) v = fmaxf(v, __shfl_xor(v, o));
    return v;
}
__device__ __forceinline__ float silu_f(float x) { return x * __builtin_amdgcn_rcpf(1.f + __expf(-x)); }
__device__ __forceinline__ float softplus_f(float x) { return fmaxf(x, 0.f) + log1pf(expf(-fabsf(x))); }
__device__ __forceinline__ float rope_inv(int j) { return exp2f(-(float)j * (13.287712379549449f / 16.0f)); }
struct EpiProj {
    static constexpr bool PERM = true, AFTER_DRAIN = false;
    bf16* O; float* dtraw; int rmode;
    __device__ __forceinline__ void operator()(const pg8::f32x4 (&acc)[2][2][4][2], const pg8::Unit& u, int wr, int wc, int fr, int fq) const {
        const int rb = rmode ? (u.pm >> 3) * 2064 + 16 + (u.pm & 7) * 256 : u.pm * 256;
        const int row0 = rb + wr * 64 + fr, col0 = u.pn * 256 + wc * 32 + 8 * fq;
#pragma unroll
        for (int ai = 0; ai < 2; ++ai)
#pragma unroll
            for (int m = 0; m < 4; ++m) { const int row = row0 + ai * 128 + m * 16; bf16* rowp = O + (size_t)row * PJ + col0;
#pragma unroll
                for (int bj = 0; bj < 2; ++bj) { const pg8::f32x4 v0 = acc[ai][bj][m][0], v1 = acc[ai][bj][m][1];
                    v4u w; w.x = pk2(v0[0], v0[1]); w.y = pk2(v0[2], v0[3]); w.z = pk2(v1[0], v1[1]); w.w = pk2(v1[2], v1[3]);
                    *(v4u*)(rowp + bj * 128) = w; }
                if (u.pn == 7 && wc == 0 && fq == 0) { *(pg8::f32x4*)(dtraw + (size_t)row * 8) = acc[ai][1][m][0]; *(pg8::f32x4*)(dtraw + (size_t)row * 8 + 4) = acc[ai][1][m][1]; } }
    }
};
struct EpiBf16 {
    static constexpr bool PERM = true, AFTER_DRAIN = false;
    bf16* O; int ldc; int rmode;
    __device__ __forceinline__ void operator()(const pg8::f32x4 (&acc)[2][2][4][2], const pg8::Unit& u, int wr, int wc, int fr, int fq) const {
        const int rb = rmode ? (u.pm >> 3) * 2064 + 16 + (u.pm & 7) * 256 : u.pm * 256;
        const int row0 = rb + wr * 64 + fr, col0 = u.pn * 256 + wc * 32 + 8 * fq;
#pragma unroll
        for (int ai = 0; ai < 2; ++ai)
#pragma unroll
            for (int m = 0; m < 4; ++m) { bf16* rowp = O + (size_t)(row0 + ai * 128 + m * 16) * ldc + col0;
#pragma unroll
                for (int bj = 0; bj < 2; ++bj) { const pg8::f32x4 v0 = acc[ai][bj][m][0], v1 = acc[ai][bj][m][1];
                    v4u w; w.x = pk2(v0[0], v0[1]); w.y = pk2(v0[2], v0[3]); w.z = pk2(v1[0], v1[1]); w.w = pk2(v1[2], v1[3]);
                    *(v4u*)(rowp + bj * 128) = w; } }
    }
};
struct EpiResF32 {
    static constexpr bool PERM = false, AFTER_DRAIN = false;
    const float* res; float* out;
    __device__ __forceinline__ void operator()(const pg8::f32x4 (&acc)[2][2][4][2], const pg8::Unit& u, int wr, int wc, int fr, int fq) const {
        const int row0 = u.pm * 256 + wr * 64 + fr, col0 = u.pn * 256 + wc * 32 + 4 * fq;
#pragma unroll
        for (int ai = 0; ai < 2; ++ai)
#pragma unroll
            for (int m = 0; m < 4; ++m) { const size_t off = (size_t)(row0 + ai * 128 + m * 16) * DM + col0;
#pragma unroll
                for (int bj = 0; bj < 2; ++bj)
#pragma unroll
                    for (int n = 0; n < 2; ++n) { const pg8::f32x4 r = *(const pg8::f32x4*)(res + off + bj * 128 + n * 16); *(pg8::f32x4*)(out + off + bj * 128 + n * 16) = r + acc[ai][bj][m][n]; } }
    }
};
struct EpiOutProj {
    static constexpr bool PERM = false, AFTER_DRAIN = false;
    const float* res; float* out; bf16* HB; float* SS; const LAS float* RS; mutable int nth;
    __device__ __forceinline__ void midscale(pg8::f32x4 (&acc)[2][2][4][2], const pg8::Unit& u, int wr, int fr) const {
        const int slot = nth++;
        const LAS float* rsp = RS + slot * 256 + wr * 64 + fr;
#pragma unroll
        for (int ai = 0; ai < 2; ++ai)
#pragma unroll
            for (int m = 0; m < 4; ++m) { const float rs = rsp[ai * 128 + m * 16];
#pragma unroll
                for (int bj = 0; bj < 2; ++bj)
#pragma unroll
                    for (int n = 0; n < 2; ++n) acc[ai][bj][m][n] *= rs; }
    }
    __device__ __forceinline__ void operator()(const pg8::f32x4 (&acc)[2][2][4][2], const pg8::Unit& u, int wr, int wc, int fr, int fq) const {
        const int rb = (u.pm >> 3) * 2064 + 16 + (u.pm & 7) * 256;
        const int row0 = u.pm * 256 + wr * 64 + fr, col0 = u.pn * 256 + wc * 32 + 4 * fq;
        pg8::f32x4 rc[4], rn[4];
#define EOP_LOAD(dst, g) do { const size_t off_ = (size_t)(row0 + ((g) >> 2) * 128 + ((g) & 3) * 16) * DM + col0; \
            dst[0] = *(const pg8::f32x4*)(res + off_); dst[1] = *(const pg8::f32x4*)(res + off_ + 16); dst[2] = *(const pg8::f32x4*)(res + off_ + 128); dst[3] = *(const pg8::f32x4*)(res + off_ + 144); } while (0)
        EOP_LOAD(rc, 0);
#pragma unroll
        for (int g = 0; g < 8; ++g) { const int ai = g >> 2, m = g & 3;
            if (g < 7) EOP_LOAD(rn, g + 1);
            const int orow = row0 + ai * 128 + m * 16; bf16* hb = HB + (size_t)(rb + wr * 64 + fr + ai * 128 + m * 16) * DM + col0; float ss = 0.f;
#pragma unroll
            for (int bj = 0; bj < 2; ++bj)
#pragma unroll
                for (int n = 0; n < 2; ++n) { const pg8::f32x4 v = rc[2 * bj + n] + acc[ai][bj][m][n];
                    ss += (v[0] * v[0] + v[1] * v[1]) + (v[2] * v[2] + v[3] * v[3]); v2u w; w.x = pk2(v[0], v[1]); w.y = pk2(v[2], v[3]); *(v2u*)(hb + bj * 128 + n * 16) = w; }
            ss = sum_x16(ss); ss = sum_x32(ss);
            if (fq == 0) SS[(size_t)orow * 16 + u.pn * 4 + wc] = ss;
#pragma unroll
            for (int i = 0; i < 4; ++i) rc[i] = rn[i]; }
#undef EOP_LOAD
    }
};
namespace pg8 { template <> constexpr bool has_midscale<EpiOutProj> = true; }
struct EpiDown {
    static constexpr bool PERM = false, AFTER_DRAIN = false;
    const bf16* HB; float* out;
    __device__ __forceinline__ void operator()(const pg8::f32x4 (&acc)[2][2][4][2], const pg8::Unit& u, int wr, int wc, int fr, int fq) const {
        const int rb = (u.pm >> 3) * 2064 + 16 + (u.pm & 7) * 256;
        const int row0 = u.pm * 256 + wr * 64 + fr, col0 = u.pn * 256 + wc * 32 + 4 * fq;
        v2u rc[4], rn[4];
#define EDN_LOAD(dst, g) do { const bf16* hb_ = HB + (size_t)(rb + wr * 64 + fr + ((g) >> 2) * 128 + ((g) & 3) * 16) * DM + col0; \
            dst[0] = *(const v2u*)(hb_); dst[1] = *(const v2u*)(hb_ + 16); dst[2] = *(const v2u*)(hb_ + 128); dst[3] = *(const v2u*)(hb_ + 144); } while (0)
        EDN_LOAD(rc, 0);
#pragma unroll
        for (int g = 0; g < 8; ++g) { const int ai = g >> 2, m = g & 3;
            if (g < 7) EDN_LOAD(rn, g + 1);
            const size_t off = (size_t)(row0 + ai * 128 + m * 16) * DM + col0;
#pragma unroll
            for (int bj = 0; bj < 2; ++bj)
#pragma unroll
                for (int n = 0; n < 2; ++n) { const v2u w = rc[2 * bj + n]; const pg8::f32x4 r = {bflo(w.x), bfhi(w.x), bflo(w.y), bfhi(w.y)}; *(pg8::f32x4*)(out + off + bj * 128 + n * 16) = r + acc[ai][bj][m][n]; }
#pragma unroll
            for (int i = 0; i < 4; ++i) rc[i] = rn[i]; }
#undef EDN_LOAD
    }
};
struct EpiSwiGLU {
    static constexpr bool PERM = true, AFTER_DRAIN = false;
    bf16* O; const LAS float* RS; mutable int nth;
    __device__ __forceinline__ void operator()(const pg8::f32x4 (&acc)[2][2][4][2], const pg8::Unit& u, int wr, int wc, int fr, int fq) const {
        const int rb = (u.pm >> 3) * 2064 + 16 + (u.pm & 7) * 256;
        const int row0 = rb + wr * 64 + fr, col0 = u.pn * 128 + wc * 32 + 8 * fq;
        const int slot = nth++;
        const LAS float* rsp = RS + slot * 256 + wr * 64 + fr;
#pragma unroll
        for (int ai = 0; ai < 2; ++ai)
#pragma unroll
            for (int m = 0; m < 4; ++m) { float a[8]; const float rs = rsp[ai * 128 + m * 16];
#pragma unroll
                for (int n = 0; n < 2; ++n)
#pragma unroll
                    for (int e = 0; e < 4; ++e) a[4 * n + e] = silu_f(rs * acc[ai][0][m][n][e]) * (rs * acc[ai][1][m][n][e]);
                v4u w; w.x = pk2(a[0], a[1]); w.y = pk2(a[2], a[3]); w.z = pk2(a[4], a[5]); w.w = pk2(a[6], a[7]);
                *(v4u*)(O + (size_t)(row0 + ai * 128 + m * 16) * DFF + col0) = w; }
    }
};

template <class ARow, class Epi>
__device__ __forceinline__ void small_gemm(const bf16* A, int lda, const bf16* Bt, int K, int nrt, int nct, const ARow& arow, const Epi& E, int gw, int NGW, int lane, int ksplit = 1) {
    const int ntask = nrt * nct * ksplit, kc = K / ksplit;
    for (int task = gw; task < ntask; task += NGW) {
        const int rt = task % nrt, ct = (task / nrt) % nct, kq = task / (nrt * nct);
        const bf16* ap = A + (size_t)arow(rt * 16 + (lane & 15)) * lda + kq * kc + 8 * (lane >> 4);
        const bf16* bp = Bt + (size_t)(ct * 16 + (lane & 15)) * K + kq * kc + 8 * (lane >> 4);
        f32x4 acc = {0.f, 0.f, 0.f, 0.f};
#pragma unroll 1
        for (int k0 = 0; k0 < kc; k0 += 32 * 11) {
            bf16x8 av[11], bv[11];
#pragma unroll
            for (int j = 0; j < 11; ++j) if (k0 + 32 * j < kc) { av[j] = *(const bf16x8*)(ap + k0 + 32 * j); bv[j] = *(const bf16x8*)(bp + k0 + 32 * j); }
#pragma unroll
            for (int j = 0; j < 11; ++j) if (k0 + 32 * j < kc) acc = __builtin_amdgcn_mfma_f32_16x16x32_bf16(av[j], bv[j], acc, 0, 0, 0);
        }
        E(acc, rt, ct, lane);
    }
}

template <class RM>
__device__ __forceinline__ void transpose_item(const float* W, int N, int ldw, bf16* WT, int ldt, int item, LAS float* scr, int lane, const RM& rm, const float* kscale = nullptr) {
    const int nblk = (N + 31) / 32, kb = item / nblk, nb = item % nblk, k0 = 64 * kb, n0 = 32 * nb;
    { const int n = n0 + (lane & 31); float v[32];
#pragma unroll
      for (int i = 0; i < 32; ++i) { const int kk = 2 * i + (lane >> 5); v[i] = (n < N) ? W[(size_t)(k0 + kk) * ldw + n] : 0.f; }
#pragma unroll
      for (int i = 0; i < 32; ++i) { const int kk = 2 * i + (lane >> 5); float x = v[i]; if (kscale) x *= kscale[k0 + kk]; scr[kk * 33 + (lane & 31)] = x; } }
    LDS_WAIT(); asm volatile("" ::: "memory");
    const int c = lane & 7;
#pragma unroll
    for (int j = 0; j < 4; ++j) { const int n = (lane >> 3) + 8 * j; const LAS float* s = scr + (8 * c) * 33 + n;
        if (n0 + n < N) { v4u o; o.x = pk2(s[0 * 33], s[1 * 33]); o.y = pk2(s[2 * 33], s[3 * 33]); o.z = pk2(s[4 * 33], s[5 * 33]); o.w = pk2(s[6 * 33], s[7 * 33]);
            *(v4u*)(WT + (size_t)rm(n0 + n) * ldt + k0 + 8 * c) = o; } }
    LDS_WAIT(); asm volatile("" ::: "memory");
}
__device__ __forceinline__ int map_in(int n) {
    return n < S_DT ? n : n < S_CQ ? C_DT + (n - S_DT) : n < S_CKV ? C_CQ + (n - S_CQ) : n < S_KR ? C_CKV + (n - S_CKV) : n;
}
__device__ __forceinline__ void p0_prologue(Frame& F) {
    LAS float* scr = (LAS float*)(F.lds + RING_OFF + F.wave * 16384);
    const float* w_in = (const float*)F.in[9]; const float* w_uq = (const float*)F.in[17]; const float* w_ukv = (const float*)F.in[19]; const float* w_out = (const float*)F.in[25];
    const float* w_gate = (const float*)F.in[27]; const float* w_up = (const float*)F.in[28]; const float* w_down = (const float*)F.in[29];
    bf16* WIN = (bf16*)(F.ws + WS_WIN); bf16* WUQ = (bf16*)(F.ws + WS_WUQ); bf16* WUKV = (bf16*)(F.ws + WS_WUKV); bf16* WOUT = (bf16*)(F.ws + WS_WOUT); bf16* WGU = (bf16*)(F.ws + WS_WGU); bf16* WDN = (bf16*)(F.ws + WS_WDN);
    const float* ffg = (const float*)F.in[26];
    constexpr int I_IN = 16 * 62, I_UQ = 6 * 24, I_UKV = 4 * 32, I_OUT = 16 * 32;
    constexpr int NITEMS = I_IN + I_UQ + 2 * I_UKV + I_OUT;
    bf16* WUKV2 = (bf16*)(F.ws + WS_WUKV2);
    for (int it = F.gw; it < NITEMS; it += F.NGW) {
        int r = it;
        if (r < I_IN) { transpose_item(w_in, INC, INC, WIN, DM, r, scr, F.lane, [](int n) { return map_in(n); }); continue; } r -= I_IN;
        if (r < I_UQ) { transpose_item(w_uq, 768, 768, WUQ, QL, r, scr, F.lane, [](int n) { return n; }, (const float*)F.in[16]); continue; } r -= I_UQ;
        if (r < I_UKV) { transpose_item(w_ukv, 1024, 1024, WUKV, KVL, r, scr, F.lane, [](int n) { return n; }, (const float*)F.in[18]); continue; } r -= I_UKV;
        if (r < I_UKV) { transpose_item(w_ukv, 1024, 1024, WUKV2, KVL, r, scr, F.lane, [](int n) { return n; }); continue; } r -= I_UKV;
        transpose_item(w_out, DM, DM, WOUT, 1024, r, scr, F.lane, [](int n) { return n; }, (r >= 8 * 32) ? (const float*)F.in[24] - 512 : nullptr);
    }
    for (int i = F.gw * 64 + F.lane; i < 88 * 1024 / 8; i += F.NGW * 64) *(v4u*)(WIN + (size_t)1960 * 1024 + (size_t)i * 8) = (v4u){0u, 0u, 0u, 0u};
    const float* xp = (const float*)F.in[0]; const float* xs = (const float*)F.in[1]; const float* meta = (const float*)F.in[7]; const float* g = (const float*)F.in[8];
    bf16* XN = (bf16*)(F.ws + WS_XN);
    f32x4 gv[4];
#pragma unroll
    for (int j = 0; j < 4; ++j) gv[j] = ((const f32x4*)g)[F.lane + 64 * j];
#define XN_ROWS(r0, n) do { f32x4 v[4][4]; \
        _Pragma("unroll") for (int i = 0; i < 4; ++i) if (i < (n)) { const int row = (r0) + i; const float* src; \
            if (row < RP) { const int b = row / TT, t = row % TT; src = (t < NMETA) ? meta + (size_t)t * DM : xp + ((size_t)b * SEQ + (t - NMETA)) * DM; } else src = xs + (size_t)(row - RP) * DM; \
            _Pragma("unroll") for (int j = 0; j < 4; ++j) v[i][j] = ((const f32x4*)src)[F.lane + 64 * j]; } \
        _Pragma("unroll") for (int i = 0; i < 4; ++i) if (i < (n)) { float s = 0.f; \
            _Pragma("unroll") for (int j = 0; j < 4; ++j) s += (v[i][j].x * v[i][j].x + v[i][j].y * v[i][j].y) + (v[i][j].z * v[i][j].z + v[i][j].w * v[i][j].w); \
            const float rs = __builtin_amdgcn_rsqf(wave_sum(s) * (1.f / DM) + EPS); \
            v2u* o8 = (v2u*)(XN + (size_t)((r0) + i) * DM) + F.lane; \
            _Pragma("unroll") for (int j = 0; j < 4; ++j) { v2u o; o.x = pk2(v[i][j].x * rs * gv[j].x, v[i][j].y * rs * gv[j].y); o.y = pk2(v[i][j].z * rs * gv[j].z, v[i][j].w * rs * gv[j].w); o8[64 * j] = o; } } } while (0)
    if (F.NGW == 2048) { XN_ROWS(4 * F.gw, 4); XN_ROWS(8192 + 4 * F.gw, 4); if (F.gw < 256) XN_ROWS(16384 + F.gw, 1); }
    else for (int r0 = 4 * F.gw; r0 < R; r0 += 4 * F.NGW) XN_ROWS(r0, 4);
#undef XN_ROWS
    float* ROPE = (float*)(F.ws + WS_ROPE);
    for (int i = blockIdx.x * NTHR + F.tid; i < (TT + 1) * 16; i += F.G * NTHR) { const int p = i >> 4, j = i & 15; const float ang = (float)(p < TT ? p : PAST) * rope_inv(j); ROPE[2 * i] = cosf(ang); ROPE[2 * i + 1] = sinf(ang); }
}

__device__ __forceinline__ void p1_ffn_weights(Frame& F, int w0, int nw) {
    LAS float* scr = (LAS float*)(F.lds + RING_OFF + F.wave * 16384);
    const float* w_gate = (const float*)F.in[27]; const float* w_up = (const float*)F.in[28]; const float* w_down = (const float*)F.in[29]; const float* ffg = (const float*)F.in[26];
    bf16* WGU = (bf16*)(F.ws + WS_WGU); bf16* WDN = (bf16*)(F.ws + WS_WDN);
    constexpr int I_G = 16 * 88, I_DN = 44 * 32;
    for (int it = F.gw - w0; it < 2 * I_G + I_DN; it += nw) {
        int r = it;
        if (r < I_G) { transpose_item(w_gate, DFF, DFF, WGU, DM, r, scr, F.lane, [](int n) { return 256 * (n >> 7) + (n & 127); }, ffg); continue; } r -= I_G;
        if (r < I_G) { transpose_item(w_up, DFF, DFF, WGU, DM, r, scr, F.lane, [](int n) { return 256 * (n >> 7) + 128 + (n & 127); }, ffg); continue; } r -= I_G;
        transpose_item(w_down, DM, DM, WDN, DFF, r, scr, F.lane, [](int n) { return n; });
    }
}
__device__ __forceinline__ int small_arow(int r) { return r < NMETA ? r : RP + (r - NMETA); }
__device__ __forceinline__ void p1_inproj(Frame& F) {
    const bf16* XN = (const bf16*)(F.ws + WS_XN); const bf16* WIN = (const bf16*)(F.ws + WS_WIN); bf16* PROJ = (bf16*)(F.ws + WS_PROJ); float* DTRAW = (float*)(F.ws + WS_DTRAW);
    { pg8::Gemm g{XN, WIN, MMAIN, PJ, DM, 1, DM}; pg8::StaticOrder S; S.init(MMAIN, PJ, F.G, (int)blockIdx.x);
      EpiProj E{PROJ, DTRAW, 1};
      pg8::gemm_phase<EpiProj, pg8::StaticOrder, true, true>(F.lds + RING_OFF, g, S, E); }
    auto epi = [&](const f32x4& acc, int rt, int ct, int lane) {
        const int col = ct * 16 + (lane & 15);
#pragma unroll
        for (int i = 0; i < 4; ++i) { const int r = rt * 16 + 4 * (lane >> 4) + i; const bf16 v = f2bf(acc[i]);
            if (r < NMETA) { for (int b = 0; b < NB; ++b) { PROJ[(size_t)(b * TT + r) * PJ + col] = v; if (col >= C_DT && col < C_DT + 8) DTRAW[(size_t)(b * TT + r) * 8 + (col - C_DT)] = acc[i]; } }
            else { const int row = RP + (r - NMETA); PROJ[(size_t)row * PJ + col] = v; if (col >= C_DT && col < C_DT + 8) DTRAW[(size_t)row * 8 + (col - C_DT)] = acc[i]; } }
    };
    small_gemm(XN, DM, WIN, DM, NS / 16, PJ / 16, [](int r) { return small_arow(r); }, epi, F.gw, F.NGW, F.lane);
    { constexpr int NSM = (NS / 16) * (PJ / 16);
      if (F.NGW > NSM + 256) { if (F.gw >= NSM) p1_ffn_weights(F, NSM, F.NGW - NSM); } else p1_ffn_weights(F, 0, F.NGW); }
}

constexpr int CV_LDS_STRIDE = 82;
__device__ __forceinline__ void p2_elementwise(Frame& F) {
    const bf16* PROJ = (const bf16*)(F.ws + WS_PROJ); const float* DTRAW = (const float*)(F.ws + WS_DTRAW); float* DT = (float*)(F.ws + WS_DT);
    float* RQS = (float*)(F.ws + WS_RQ); float* KRF = (float*)(F.ws + WS_KRF);
    const float* kvg = (const float*)F.in[18]; const float* qng = (const float*)F.in[16]; const float* dtb = (const float*)F.in[12]; const float* ROPE = (const float*)(F.ws + WS_ROPE);
    {
        const f32x4 gg = ((const f32x4*)kvg)[F.lane]; const float* gq = qng + 6 * F.lane; const float g0 = gq[0], g1 = gq[1], g2 = gq[2], g3 = gq[3], g4 = gq[4], g5 = gq[5]; const float dbias = dtb[F.lane & 7];
        v2u wk[4], wkn[4]; unsigned wq[4][3], wqn[4][3]; unsigned short kr1[4], kr2[4], kr1n[4], kr2n[4]; float dtr[4], dtrn[4]; f32x2_t cs[4], csn[4];
#define P2A_LOAD(WK, WQ, K1, K2, DTR, CS, r0, n) do { _Pragma("unroll") for (int i = 0; i < 4; ++i) if (i < (n)) { const int row = (r0) + i; const bf16* pr = PROJ + (size_t)row * PJ; \
            WK[i] = *(const v2u*)(pr + C_CKV + 4 * F.lane); const unsigned* p = (const unsigned*)(pr + C_CQ + 6 * F.lane); WQ[i][0] = p[0]; WQ[i][1] = p[1]; WQ[i][2] = p[2]; \
            K1[i] = pr[C_KR + (F.lane & 15)]; K2[i] = pr[C_KR + 16 + (F.lane & 15)]; DTR[i] = DTRAW[(size_t)row * 8 + (F.lane & 7)]; \
            CS[i] = *(const f32x2_t*)(ROPE + 2 * ((row < RP ? row % TT : TT) * 16 + (F.lane & 15))); } } while (0)
#define P2A_PROC(r0, n) do { _Pragma("unroll") for (int i = 0; i < 4; ++i) if (i < (n)) { const int row = (r0) + i; \
            { const float v0 = bflo(wk[i].x), v1 = bfhi(wk[i].x), v2 = bflo(wk[i].y), v3 = bfhi(wk[i].y); \
              const float rs = __builtin_amdgcn_rsqf(wave_sum((v0 * v0 + v1 * v1) + (v2 * v2 + v3 * v3)) * (1.f / KVL) + EPS); \
              const f32x4 o = {v0 * rs * gg.x, v1 * rs * gg.y, v2 * rs * gg.z, v3 * rs * gg.w}; \
              float* of = (row < RP) ? F.out + OUT_LATP + (size_t)row * KVL : F.out + OUT_LATS + (size_t)(row - RP) * KVL; \
              ((f32x4*)of)[F.lane] = o; if (F.lane == 0) RQS[R + row] = rs; } \
            { const float v0 = bflo(wq[i][0]), v1 = bfhi(wq[i][0]), v2 = bflo(wq[i][1]), v3 = bfhi(wq[i][1]), v4 = bflo(wq[i][2]), v5 = bfhi(wq[i][2]); \
              const float rs = __builtin_amdgcn_rsqf(wave_sum((v0 * v0 + v1 * v1) + (v2 * v2 + v3 * v3) + (v4 * v4 + v5 * v5)) * (1.f / QL) + EPS); \
              if (F.lane == 0) RQS[row] = rs; } \
            if (F.lane < 16) { const int j = F.lane; const float c = cs[i].x, s = cs[i].y; \
              const float x1 = bf2f(kr1[i]), x2 = bf2f(kr2[i]); const float y1 = x1 * c - x2 * s, y2 = x1 * s + x2 * c; \
              KRF[(size_t)row * 32 + j] = y1; KRF[(size_t)row * 32 + 16 + j] = y2; \
              float* of = (row < RP) ? F.out + OUT_KRP + (size_t)row * 32 : F.out + OUT_KRS + (size_t)(row - RP) * 32; of[j] = y1; of[16 + j] = y2; } \
            if (F.lane < 8) DT[(size_t)row * 8 + F.lane] = softplus_f(dtr[i] + dbias); } } while (0)
#define P2A_ROT() do { _Pragma("unroll") for (int i = 0; i < 4; ++i) { wk[i] = wkn[i]; wq[i][0] = wqn[i][0]; wq[i][1] = wqn[i][1]; wq[i][2] = wqn[i][2]; kr1[i] = kr1n[i]; kr2[i] = kr2n[i]; dtr[i] = dtrn[i]; cs[i] = csn[i]; } } while (0)
        if (F.NGW == 2048) {
            const int ra = 4 * F.gw, rb2 = 8192 + 4 * F.gw, rc = 16384 + F.gw;
            P2A_LOAD(wk, wq, kr1, kr2, dtr, cs, ra, 4);
            P2A_LOAD(wkn, wqn, kr1n, kr2n, dtrn, csn, rb2, 4);
            P2A_PROC(ra, 4); P2A_ROT();
            if (F.gw < 256) P2A_LOAD(wkn, wqn, kr1n, kr2n, dtrn, csn, rc, 1);
            P2A_PROC(rb2, 4);
            if (F.gw < 256) { P2A_ROT(); P2A_PROC(rc, 1); }
        } else {
            for (int r0 = 4 * F.gw; r0 < R; r0 += 4 * F.NGW) { P2A_LOAD(wk, wq, kr1, kr2, dtr, cs, r0, 4); P2A_PROC(r0, 4); }
        }
#undef P2A_LOAD
#undef P2A_PROC
#undef P2A_ROT
    }
    const float* cw = (const float*)F.in[10]; const float* cb = (const float*)F.in[11];
    bf16* XST = (bf16*)(F.ws + WS_XST); bf16* BT = (bf16*)(F.ws + WS_BT); bf16* BC = (bf16*)(F.ws + WS_BC);
    LAS bf16* tile = (LAS bf16*)(F.lds + RING_OFF);
    for (int i = blockIdx.x * NTHR + F.tid; i < NB * 640 * 6; i += F.G * NTHR) { const int rowi = i / 6, pc = i % 6; const int bb = rowi / 640, cc = rowi % 640;
        bf16* dst = (cc < SSDW) ? XST + ((size_t)(bb * SSDW + cc)) * TPAD : BT + ((size_t)(bb * 128 + (cc - SSDW))) * TPAD; *(v4u*)(dst + pc * 8) = (v4u){0u, 0u, 0u, 0u}; }
    for (int u = blockIdx.x; u < NB * 32 * 3; u += F.G) {
        const int third = u % 3, tb = 1 + (u / 3) % 32, b = u / 96; const int t0 = tb * CHL - TOFF;
        {
            const int cl = 2 * (F.tid & 127), c = third * 256 + cl, tq = F.tid >> 7;
            const float w0a = cw[0 * CONVD + c], w1a = cw[1 * CONVD + c], w2a = cw[2 * CONVD + c], w3a = cw[3 * CONVD + c], ba = cb[c];
            const float w0b = cw[0 * CONVD + c + 1], w1b = cw[1 * CONVD + c + 1], w2b = cw[2 * CONVD + c + 1], w3b = cw[3 * CONVD + c + 1], bb = cb[c + 1];
            const bf16* base = PROJ + (size_t)b * TT * PJ + C_XBC + c;
#define CV_QUARTER(tfirst, lcol) do { float xa[19], xb[19]; \
                _Pragma("unroll") for (int k = 0; k < 19; ++k) { const int t = (tfirst) - 3 + k; xa[k] = 0.f; xb[k] = 0.f; if (t >= 0) { const unsigned w = *(const unsigned*)(base + (size_t)t * PJ); xa[k] = bflo(w); xb[k] = bfhi(w); } } \
                _Pragma("unroll") for (int k = 0; k < 16; ++k) { const int t = (tfirst) + k; \
                    const float ya = silu_f(ba + xa[k] * w0a + xa[k + 1] * w1a + xa[k + 2] * w2a + xa[k + 3] * w3a), yb = silu_f(bb + xb[k] * w0b + xb[k + 1] * w1b + xb[k + 2] * w2b + xb[k + 3] * w3b); \
                    const unsigned pk = pk2(ya, yb); \
                    tile[cl * CV_LDS_STRIDE + (lcol) + k] = (bf16)(pk & 0xffffu); tile[(cl + 1) * CV_LDS_STRIDE + (lcol) + k] = (bf16)(pk >> 16); \
                    if (third == 2) *(unsigned*)(BC + (size_t)(b * TT + t) * 256 + cl) = pk; } } while (0)
            CV_QUARTER(t0 + 16 * tq, 16 * tq);
            if (tb == 1 && tq == 0) CV_QUARTER(0, 64);
#undef CV_QUARTER
        }
        __syncthreads();
        { const int nrows = (third == 2) ? 128 : 256; const int npc = (tb == 1) ? 10 : 8;
          for (int i = F.tid; i < nrows * npc; i += NTHR) { const int cl = i / npc, pc = i % npc;
            const LAS unsigned* s = (const LAS unsigned*)(tile + cl * CV_LDS_STRIDE + pc * 8); v4u o; o.x = s[0]; o.y = s[1]; o.z = s[2]; o.w = s[3];
            bf16* dst = (third < 2) ? XST + ((size_t)(b * SSDW + third * 256 + cl)) * TPAD : BT + ((size_t)(b * 128 + cl)) * TPAD;
            *(v4u*)(dst + ((pc < 8) ? tb * CHL + pc * 8 : TOFF + (pc - 8) * 8)) = o; } }
        __syncthreads();
    }
    const float* sconv = (const float*)F.in[4]; float* XAS = (float*)(F.ws + WS_XAS);
    for (int i = blockIdx.x * NTHR + F.tid; i < DB * CONVD; i += F.G * NTHR) { const int b = i / CONVD, c = i % CONVD;
        const float xc = bf2f(PROJ[(size_t)(RP + b) * PJ + C_XBC + c]);
        const float s0 = sconv[(size_t)(b * 3 + 0) * CONVD + c], s1 = sconv[(size_t)(b * 3 + 1) * CONVD + c], s2 = sconv[(size_t)(b * 3 + 2) * CONVD + c];
        XAS[i] = silu_f(cb[c] + s0 * cw[c] + s1 * cw[CONVD + c] + s2 * cw[2 * CONVD + c] + xc * cw[3 * CONVD + c]);
        float* oc = F.out + OUT_CONVS + (size_t)b * 3 * CONVD + c; oc[0] = s1; oc[CONVD] = s2; oc[2 * CONVD] = xc; }
    for (int i = blockIdx.x * NTHR + F.tid; i < NB * 3 * CONVD; i += F.G * NTHR) { const int b = i / (3 * CONVD), k = (i / CONVD) % 3, c = i % CONVD;
        F.out[OUT_CONVP + i] = bf2f(PROJ[(size_t)(b * TT + TT - 3 + k) * PJ + C_XBC + c]); }
}
#define MFMA32(a, b, c) __builtin_amdgcn_mfma_f32_32x32x16_bf16((a), (b), (c), 0, 0, 0)
#define MFMA16(a, b, c) __builtin_amdgcn_mfma_f32_16x16x32_bf16((a), (b), (c), 0, 0, 0)
__device__ __forceinline__ int crow(int reg, int hi) { return (reg & 3) + 8 * (reg >> 2) + 4 * hi; }
__device__ __forceinline__ bf16x8 pack8(const f32x16& x, int s) {
    v4u p; p.x = pk2(x[8 * s + 0], x[8 * s + 1]); p.y = pk2(x[8 * s + 2], x[8 * s + 3]); p.z = pk2(x[8 * s + 4], x[8 * s + 5]); p.w = pk2(x[8 * s + 6], x[8 * s + 7]);
    return __builtin_bit_cast(bf16x8, p);
}
__device__ __forceinline__ bf16x8 ld2x8(const bf16* p0, const bf16* p1) {
    const v2u a = *(const v2u*)p0, b = *(const v2u*)p1; v4u r; r.x = a.x; r.y = a.y; r.z = b.x; r.w = b.y; return __builtin_bit_cast(bf16x8, r);
}
__device__ __forceinline__ float softmax_ref(Frame& F) {
    const float* gqn = (const float*)F.in[20]; const float* gqr = (const float*)F.in[21]; const float* gkn = (const float*)F.in[22]; const float* gkr = (const float*)F.in[23];
    float a = fabsf(gqn[F.lane]), b = fabsf(gkn[F.lane]);
    if (F.lane < 16) { a = fmaxf(a, fabsf(gqr[F.lane])); b = fmaxf(b, fabsf(gkr[F.lane])); }
    return LOG2E * 9.797958971132712f * wave_max(a) * wave_max(b) * 1.0001f;
}
constexpr size_t WS_YS = 495 * MiB;
constexpr size_t WS_KS = 498 * MiB;
constexpr int NKT = 65;

__device__ __forceinline__ void p3_upproj_states(Frame& F) {
    const bf16* PROJ = (const bf16*)(F.ws + WS_PROJ); const bf16* WUQ = (const bf16*)(F.ws + WS_WUQ); const bf16* WUKV = (const bf16*)(F.ws + WS_WUKV);
    bf16* QRAW = (bf16*)(F.ws + WS_QRAW); bf16* KVRAW = (bf16*)(F.ws + WS_KVRAW);
    { pg8::Gemm g{PROJ + C_CQ, WUQ, MMAIN, 768, QL, 1, PJ}; pg8::StaticOrder S; S.init(MMAIN, 768, F.G, (int)blockIdx.x); EpiBf16 E{QRAW, 768, 1};
      pg8::gemm_phase<EpiBf16, pg8::StaticOrder, true, true>(F.lds + RING_OFF, g, S, E); }
    { pg8::Gemm g{PROJ + C_CKV, WUKV, MMAIN, 1024, KVL, 1, PJ}; pg8::StaticOrder S; S.init(MMAIN, 1024, F.G, (int)blockIdx.x); EpiBf16 E{KVRAW, 1024, 1};
      pg8::gemm_phase<EpiBf16, pg8::StaticOrder, true, true>(F.lds + RING_OFF, g, S, E); }
    const bool sub = (F.G == 256);
    const int sgw = sub ? (blockIdx.x - 192) * NWAVES + F.wave : F.gw, sngw = sub ? 64 * NWAVES : F.NGW;
    if (!sub || blockIdx.x >= 192) {
    small_gemm(PROJ + C_CQ, PJ, WUQ, QL, DB / 16, 768 / 16, [](int r) { return RP + r; },
        [&](const f32x4& acc, int rt, int ct, int lane) { const int col = ct * 16 + (lane & 15);
#pragma unroll
            for (int i = 0; i < 4; ++i) QRAW[(size_t)(RP + rt * 16 + 4 * (lane >> 4) + i) * 768 + col] = f2bf(acc[i]); }, sgw, sngw, F.lane);
    small_gemm(PROJ + C_CKV, PJ, WUKV, KVL, NS / 16, 1024 / 16, [](int r) { return small_arow(r); },
        [&](const f32x4& acc, int rt, int ct, int lane) { const int col = ct * 16 + (lane & 15);
#pragma unroll
            for (int i = 0; i < 4; ++i) { const int r = rt * 16 + 4 * (lane >> 4) + i; const bf16 v = f2bf(acc[i]);
                if (r < NMETA) { for (int b = 0; b < NB; ++b) KVRAW[(size_t)(b * TT + r) * 1024 + col] = v; } else KVRAW[(size_t)(RP + r - NMETA) * 1024 + col] = v; } }, sgw, sngw, F.lane);
    }
    const float* DT = (const float*)(F.ws + WS_DT); const float* a_log = (const float*)F.in[13];
    const bf16* XST = (const bf16*)(F.ws + WS_XST); const bf16* BT = (const bf16*)(F.ws + WS_BT);
    float* STATES = (float*)(F.ws + WS_STATES); float* DECAY = (float*)(F.ws + WS_DECAY);
    LAS float* wl = (LAS float*)(F.lds + RING_OFF + F.wave * 1024);
    const int r32 = F.lane & 31, hi = F.lane >> 5;
    for (int u = F.gw; u < NB * NCH * NH; u += F.NGW) {
        const int h = u % NH, c = (u / NH) % NCH, b = u / (NH * NCH); const int g = h >> 2;
        const int t = c * CHL - TOFF + F.lane;
        const float dt = (t >= 0) ? DT[(size_t)(b * TT + t) * 8 + h] : 0.f;
        const float A = -__expf(a_log[h]);
        float acs = dt * A;
#pragma unroll
        for (int o = 1; o < 64; o <<= 1) { const float v = __shfl_up(acs, o); if (F.lane >= o) acs += v; }
        const float last = __shfl(acs, 63);
        wl[F.lane] = __expf(last - acs) * dt;
        LDS_WAIT(); asm volatile("" ::: "memory");
        f32x16 acc[2][2];
#pragma unroll
        for (int i = 0; i < 2; ++i)
#pragma unroll
            for (int j = 0; j < 2; ++j) acc[i][j] = (f32x16){};
        const bf16* xb = XST + ((size_t)(b * SSDW + h * HP)) * TPAD + c * CHL; const bf16* bb = BT + ((size_t)(b * 128 + g * DS)) * TPAD + c * CHL;
#pragma unroll
        for (int s = 0; s < 4; ++s) {
            const f32x4 w0 = *(const LAS f32x4*)(wl + 16 * s + 8 * hi), w1 = *(const LAS f32x4*)(wl + 16 * s + 8 * hi + 4);
            bf16x8 af[2], bfr[2];
#pragma unroll
            for (int pt = 0; pt < 2; ++pt) { const v4u x = *(const v4u*)(xb + (size_t)(32 * pt + r32) * TPAD + 16 * s + 8 * hi);
                v4u y; y.x = pk2(bflo(x.x) * w0.x, bfhi(x.x) * w0.y); y.y = pk2(bflo(x.y) * w0.z, bfhi(x.y) * w0.w); y.z = pk2(bflo(x.z) * w1.x, bfhi(x.z) * w1.y); y.w = pk2(bflo(x.w) * w1.z, bfhi(x.w) * w1.w);
                af[pt] = __builtin_bit_cast(bf16x8, y); }
#pragma unroll
            for (int nt = 0; nt < 2; ++nt) bfr[nt] = *(const bf16x8*)(bb + (size_t)(32 * nt + r32) * TPAD + 16 * s + 8 * hi);
#pragma unroll
            for (int pt = 0; pt < 2; ++pt)
#pragma unroll
                for (int nt = 0; nt < 2; ++nt) acc[pt][nt] = MFMA32(af[pt], bfr[nt], acc[pt][nt]);
        }
        float* so = STATES + ((size_t)((b * NCH + c) * NH + h)) * 4096;
#pragma unroll
        for (int pt = 0; pt < 2; ++pt)
#pragma unroll
            for (int nt = 0; nt < 2; ++nt)
#pragma unroll
                for (int rg = 0; rg < 16; ++rg) so[(32 * pt + crow(rg, hi)) * 64 + 32 * nt + r32] = acc[pt][nt][rg];
        if (F.lane == 0) DECAY[(b * NCH + c) * NH + h] = __expf(last);
        LDS_WAIT(); asm volatile("" ::: "memory");
    }
}

#ifdef MK_TS
#define P4_STAMP(k) do { if (blockIdx.x == 0 && F.tid == 0) ((unsigned long long*)(F.ws + 600 * MiB))[20 + (k)] = __builtin_amdgcn_s_memrealtime(); } while (0)
#else
#define P4_STAMP(k) do { } while (0)
#endif
__device__ __forceinline__ void p4_post(Frame& F) {
    const bf16* QRAW = (const bf16*)(F.ws + WS_QRAW); const bf16* KVRAW = (const bf16*)(F.ws + WS_KVRAW); const float* KRF = (const float*)(F.ws + WS_KRF);
    bf16* Q = (bf16*)(F.ws + WS_Q); bf16* K = (bf16*)(F.ws + WS_K); bf16* VT = (bf16*)(F.ws + WS_VT); float* VS = (float*)(F.ws + WS_VS);
    const float* gqn = (const float*)F.in[20]; const float* gqr = (const float*)F.in[21]; const float* gkn = (const float*)F.in[22]; const float* gkr = (const float*)F.in[23];
    const float* ROPE = (const float*)(F.ws + WS_ROPE); const float* RQS = (const float*)(F.ws + WS_RQ);
    const int h = F.lane >> 3, sub = F.lane & 7;
    bf16* KS = (bf16*)(F.ws + WS_KS);
    for (int row = RP + F.gw; row < R; row += F.NGW) {
        const int t = PAST;
        if (row >= RP) { const bf16* kp = KVRAW + (size_t)row * 1024 + 128 * h + 8 * sub; const v4u kw = *(const v4u*)kp; const v4u vw = *(const v4u*)(kp + 64);
          const f32x4 kr = *(const f32x4*)(KRF + (size_t)row * 32 + 4 * sub);
          const float rkv = RQS[R + row];
          float kn[8] = {bflo(kw.x) * rkv, bfhi(kw.x) * rkv, bflo(kw.y) * rkv, bfhi(kw.y) * rkv, bflo(kw.z) * rkv, bfhi(kw.z) * rkv, bflo(kw.w) * rkv, bfhi(kw.w) * rkv};
          float ss = (kr.x * kr.x + kr.y * kr.y) + (kr.z * kr.z + kr.w * kr.w);
#pragma unroll
          for (int e = 0; e < 8; ++e) ss += kn[e] * kn[e];
          ss = sum_x1(ss); ss = sum_x2(ss); ss = sum_x4(ss);
          const float rs = __builtin_amdgcn_rsqf(ss * (1.f / 96.f) + EPS);
          const float* gn = gkn + 8 * sub; v4u o; o.x = pk2(kn[0] * rs * gn[0], kn[1] * rs * gn[1]); o.y = pk2(kn[2] * rs * gn[2], kn[3] * rs * gn[3]); o.z = pk2(kn[4] * rs * gn[4], kn[5] * rs * gn[5]); o.w = pk2(kn[6] * rs * gn[6], kn[7] * rs * gn[7]);
          bf16* ko = KS + (size_t)(row - RP) * 768 + 96 * h; *(v4u*)(ko + 8 * sub) = o;
          const float* gr = gkr + ((4 * sub) & 15); v2u o2; o2.x = pk2(kr.x * rs * gr[0], kr.y * rs * gr[1]); o2.y = pk2(kr.z * rs * gr[2], kr.w * rs * gr[3]);
          *(v2u*)(ko + 64 + 4 * sub) = o2;
          const unsigned vv[4] = {vw.x, vw.y, vw.z, vw.w}; float* vs = VS + (size_t)(row - RP) * 512 + 64 * h + 8 * sub;
#pragma unroll
          for (int e = 0; e < 4; ++e) { vs[2 * e] = bflo(vv[e]) * rkv; vs[2 * e + 1] = bfhi(vv[e]) * rkv; } }
        if (row >= RP || t >= NMETA) {
            const bf16* qp = QRAW + (size_t)row * 768 + 96 * h; const v4u qw = *(const v4u*)(qp + 8 * sub);
            const unsigned r1 = *(const unsigned*)(qp + 64 + 2 * sub), r2 = *(const unsigned*)(qp + 80 + 2 * sub);
            float qn[8] = {bflo(qw.x), bfhi(qw.x), bflo(qw.y), bfhi(qw.y), bflo(qw.z), bfhi(qw.z), bflo(qw.w), bfhi(qw.w)};
            const f32x4 cs = *(const f32x4*)(ROPE + 2 * ((row < RP ? t : TT) * 16 + 2 * sub)); const float c0 = cs.x, s0 = cs.y, c1 = cs.z, s1 = cs.w;
            const float x10 = bflo(r1), x11 = bfhi(r1), x20 = bflo(r2), x21 = bfhi(r2);
            const float y10 = x10 * c0 - x20 * s0, y20 = x10 * s0 + x20 * c0, y11 = x11 * c1 - x21 * s1, y21 = x11 * s1 + x21 * c1;
            float ss = (y10 * y10 + y20 * y20) + (y11 * y11 + y21 * y21);
#pragma unroll
            for (int e = 0; e < 8; ++e) ss += qn[e] * qn[e];
            ss = sum_x1(ss); ss = sum_x2(ss); ss = sum_x4(ss);
            const float sq = RQS[row];
            const float rs = (ATTN_SCALE * LOG2E) * sq * __builtin_amdgcn_rsqf(ss * sq * sq * (1.f / 96.f) + EPS);
            const float* gn = gqn + 8 * sub; v4u o; o.x = pk2(qn[0] * rs * gn[0], qn[1] * rs * gn[1]); o.y = pk2(qn[2] * rs * gn[2], qn[3] * rs * gn[3]); o.z = pk2(qn[4] * rs * gn[4], qn[5] * rs * gn[5]); o.w = pk2(qn[6] * rs * gn[6], qn[7] * rs * gn[7]);
            bf16* qo = Q + (size_t)row * 768 + 96 * h; *(v4u*)(qo + 8 * sub) = o;
            const float g0 = gqr[2 * sub], g1 = gqr[2 * sub + 1];
            *(unsigned*)(qo + 64 + 2 * sub) = pk2(y10 * rs * g0, y11 * rs * g1); *(unsigned*)(qo + 80 + 2 * sub) = pk2(y20 * rs * g0, y21 * rs * g1);
        }
    }
    { bf16* KF = (bf16*)(F.ws + WS_K); bf16* VF = (bf16*)(F.ws + WS_VT);
      LAS unsigned char* vtile = F.lds + RING_OFF + F.wave * 4608;
      const int r8 = F.lane >> 3;
      for (int u = F.gw; u < NB * NKT * NH; u += F.NGW) {
          const int hh = u % NH, kt = (u / NH) % NKT, bb = u / (NH * NKT);
          bf16* kfb = KF + ((size_t)((bb * NH + hh) * NKT + kt)) * (6 * 512); bf16* vfb = VF + ((size_t)((bb * NH + hh) * NKT + kt)) * (4 * 512);
          v4u kwa[4], vwa[4]; f32x4 kra[4]; float rka[4];
#pragma unroll
          for (int i = 0; i < 4; ++i) { const int tk = kt * 32 + 8 * i + r8; const int tkc = tk < TT ? tk : TT - 1; rka[i] = RQS[R + bb * TT + tkc];
              const bf16* kp = KVRAW + (size_t)(bb * TT + tkc) * 1024 + 128 * hh + 8 * sub; kwa[i] = *(const v4u*)kp; vwa[i] = *(const v4u*)(kp + 64); kra[i] = *(const f32x4*)(KRF + (size_t)(bb * TT + tkc) * 32 + 4 * sub); }
#pragma unroll
          for (int i = 0; i < 4; ++i) {
              const int key = 8 * i + r8, tk = kt * 32 + key; v4u kw = kwa[i], vw = vwa[i]; f32x4 kr = kra[i];
              if (tk >= TT) { kw = (v4u){0u, 0u, 0u, 0u}; vw = kw; kr = (f32x4){0.f, 0.f, 0.f, 0.f}; }
              const float rkv = rka[i];
              float kn[8] = {bflo(kw.x) * rkv, bfhi(kw.x) * rkv, bflo(kw.y) * rkv, bfhi(kw.y) * rkv, bflo(kw.z) * rkv, bfhi(kw.z) * rkv, bflo(kw.w) * rkv, bfhi(kw.w) * rkv};
              vw.x = pk2(bflo(vw.x) * rkv, bfhi(vw.x) * rkv); vw.y = pk2(bflo(vw.y) * rkv, bfhi(vw.y) * rkv); vw.z = pk2(bflo(vw.z) * rkv, bfhi(vw.z) * rkv); vw.w = pk2(bflo(vw.w) * rkv, bfhi(vw.w) * rkv);
              float ss = (kr.x * kr.x + kr.y * kr.y) + (kr.z * kr.z + kr.w * kr.w);
#pragma unroll
              for (int e = 0; e < 8; ++e) ss += kn[e] * kn[e];
              ss = sum_x1(ss); ss = sum_x2(ss); ss = sum_x4(ss);
              const float rs = __builtin_amdgcn_rsqf(ss * (1.f / 96.f) + EPS);
              const float* gn = gkn + 8 * sub; v4u o; o.x = pk2(kn[0] * rs * gn[0], kn[1] * rs * gn[1]); o.y = pk2(kn[2] * rs * gn[2], kn[3] * rs * gn[3]); o.z = pk2(kn[4] * rs * gn[4], kn[5] * rs * gn[5]); o.w = pk2(kn[6] * rs * gn[6], kn[7] * rs * gn[7]);
              *(v4u*)(kfb + (sub >> 1) * 512 + ((sub & 1) * 32 + key) * 8) = o;
              const float* gr = gkr + ((4 * sub) & 15); v2u o2; o2.x = pk2(kr.x * rs * gr[0], kr.y * rs * gr[1]); o2.y = pk2(kr.z * rs * gr[2], kr.w * rs * gr[3]);
              *(v2u*)(kfb + (4 + (sub >> 2)) * 512 + (((sub >> 1) & 1) * 32 + key) * 8 + 4 * (sub & 1)) = o2;
              *(LAS v4u*)(vtile + key * 144 + sub * 16) = vw; }
          LDS_WAIT(); asm volatile("" ::: "memory");
          const int g = F.lane >> 4, q4 = (F.lane & 15) >> 2, pp = F.lane & 3;
          const unsigned a_lo = (unsigned)(uintptr_t)vtile + (unsigned)((4 * (g >> 1) + q4) * 144 + (16 * (g & 1) + 4 * pp) * 2);
#define VF_TR(dt, s2) do { s16x4 lo, hi4; \
              asm volatile("ds_read_b64_tr_b16 %0, %2 offset:%c3\n\tds_read_b64_tr_b16 %1, %2 offset:%c4\n\ts_waitcnt lgkmcnt(0)" : "=&v"(lo), "=&v"(hi4) : "v"(a_lo), "i"(16 * (s2) * 144 + 64 * (dt)), "i"(16 * (s2) * 144 + 64 * (dt) + 8 * 144) : "memory"); \
              v4u o; o.x = (unsigned)(unsigned short)lo[0] | ((unsigned)(unsigned short)lo[1] << 16); o.y = (unsigned)(unsigned short)lo[2] | ((unsigned)(unsigned short)lo[3] << 16); \
              o.z = (unsigned)(unsigned short)hi4[0] | ((unsigned)(unsigned short)hi4[1] << 16); o.w = (unsigned)(unsigned short)hi4[2] | ((unsigned)(unsigned short)hi4[3] << 16); \
              *(v4u*)(vfb + ((dt) * 2 + (s2)) * 512 + F.lane * 8) = o; } while (0)
          VF_TR(0, 0); VF_TR(0, 1); VF_TR(1, 0); VF_TR(1, 1);
#undef VF_TR
          LDS_WAIT(); asm volatile("" ::: "memory");
      } }
    P4_STAMP(0);
    const float* STATES = (const float*)(F.ws + WS_STATES); const float* DECAY = (const float*)(F.ws + WS_DECAY); bf16* HIN = (bf16*)(F.ws + WS_HIN);
    for (int e2 = blockIdx.x * NTHR + F.tid; e2 < NB * NH * 2048; e2 += F.G * NTHR) {
        const int e = 2 * e2; const int b = e / (NH * 4096), hh = (e / 4096) % NH, pn = e % 4096;
        float h0 = 0.f, h1 = 0.f;
#pragma unroll 1
        for (int c0 = 0; c0 < NCH; c0 += 11) {
            f32x2_t st[11]; float dc[11];
#pragma unroll
            for (int j = 0; j < 11; ++j) { const int c = c0 + j; st[j] = *(const f32x2_t*)(STATES + ((size_t)((b * NCH + c) * NH + hh)) * 4096 + pn); dc[j] = DECAY[(b * NCH + c) * NH + hh]; }
#pragma unroll
            for (int j = 0; j < 11; ++j) { const int c = c0 + j; *(unsigned*)(HIN + ((size_t)((b * NCH + c) * NH + hh)) * 4096 + pn) = pk2(h0, h1); h0 = h0 * dc[j] + st[j].x; h1 = h1 * dc[j] + st[j].y; }
        }
        *(f32x2_t*)(F.out + OUT_SSMP + e) = (f32x2_t){h0, h1};
    }
    P4_STAMP(1);
    const float* XAS = (const float*)(F.ws + WS_XAS); const float* DT = (const float*)(F.ws + WS_DT); const float* sst = (const float*)F.in[5];
    const float* a_log = (const float*)F.in[13]; const float* d_skip = (const float*)F.in[14]; float* YS = (float*)(F.ws + WS_YS);
    for (int u = F.gw; u < DB * NH * 16; u += F.NGW) {
        const int pq = u & 15, hh = (u >> 4) & 7, b = u >> 7; const int g = hh >> 2; const int p = 4 * pq + (F.lane >> 4), n4 = F.lane & 15;
        const float dt = DT[(size_t)(RP + b) * 8 + hh]; const float a = __expf(dt * -__expf(a_log[hh]));
        const float x = XAS[(size_t)b * CONVD + hh * HP + p]; const float uu = dt * x;
        const f32x4 Bv = *(const f32x4*)(XAS + (size_t)b * CONVD + SSDW + g * DS + 4 * n4), Cv = *(const f32x4*)(XAS + (size_t)b * CONVD + SSDW + 128 + g * DS + 4 * n4);
        const size_t si = (((size_t)b * NH + hh) * HP + p) * DS + 4 * n4;
        const f32x4 s0 = *(const f32x4*)(sst + si); const f32x4 s1 = s0 * a + uu * Bv;
        *(f32x4*)(F.out + OUT_SSMS + si) = s1;
        float y = (Cv.x * s1.x + Cv.y * s1.y) + (Cv.z * s1.z + Cv.w * s1.w);
        y = sum_x1(y); y = sum_x2(y); y = sum_x4(y); y = sum_x8(y);
        if (n4 == 0) YS[(size_t)b * 512 + hh * HP + p] = y + d_skip[hh] * x;
    }
}
constexpr int DA_ROWB = 528;
constexpr int DA_LAT = 0, DA_KR = 128 * DA_ROWB, DA_PB = DA_KR + 128 * 33 * 4, DA_QG = DA_PB + 2 * 16 * 32 * 2, DA_END = DA_QG + 8 * 96 * 4;
constexpr int P5_EXCH = 100 * 1024;
static_assert(DA_END <= P5_EXCH, "LDS map of P5");

constexpr int AT_SLOT = 20480, AT_D = 4;
constexpr size_t WS_ATT = 499 * MiB;
__device__ __forceinline__ void at_issue(Frame& F, const bf16* kt_k, const bf16* kt_v, LAS unsigned char* slot) {
    const int w = F.wave;
    __builtin_amdgcn_global_load_lds((const unsigned*)((const char*)kt_k + w * 1024 + F.lane * 16), (LAS unsigned*)(slot + w * 1024), 16, 0, 0);
    const char* srcB = (w < 4) ? (const char*)kt_k + 8192 + w * 1024 : (const char*)kt_v + (w - 4) * 1024;
    __builtin_amdgcn_global_load_lds((const unsigned*)(srcB + F.lane * 16), (LAS unsigned*)(slot + 8192 + w * 1024), 16, 0, 0);
    __builtin_amdgcn_global_load_lds((const unsigned*)((const char*)kt_v + 4096 + w * 256 + F.lane * 4), (LAS unsigned*)(slot + 16384 + w * 256), 4, 0, 0);
    __builtin_amdgcn_global_load_lds((const unsigned*)((const char*)kt_v + 6144 + w * 256 + F.lane * 4), (LAS unsigned*)(slot + 18432 + w * 256), 4, 0, 0);
}
__device__ __forceinline__ void p5_attn_prompt(Frame& F, float M0) {
    const bf16* QRAW = (const bf16*)(F.ws + WS_QRAW); const bf16* KF = (const bf16*)(F.ws + WS_K); const bf16* VF = (const bf16*)(F.ws + WS_VT); bf16* MIXA = (bf16*)(F.ws + WS_MIX); float* SSQ = (float*)(F.ws + WS_SSQ);
    const float* ROPE = (const float*)(F.ws + WS_ROPE); const float* gqn = (const float*)F.in[20]; const float* gqr = (const float*)F.in[21]; const float* RQS = (const float*)(F.ws + WS_RQ);
    LAS unsigned char* ring = F.lds + RING_OFF;
    const int w = F.wave, r32 = F.lane & 31, hi = F.lane >> 5;
    f32x16 negm;
#pragma unroll
    for (int i = 0; i < 16; ++i) negm[i] = -M0;
    for (int u = F.vcu; u < 256; u += F.G) {
        const int b = u >> 5, h = (u >> 2) & 7, pr = u & 3;
        const bf16* kfb = KF + ((size_t)((b * NH + h) * NKT)) * (6 * 512); const bf16* vfb = VF + ((size_t)((b * NH + h) * NKT)) * (4 * 512);
#pragma unroll 1
        for (int half = 0; half < 2; ++half) {
            const int qb = half ? 7 - pr : pr; const int a = 8 * qb + w; const int qi = NMETA + 32 * a + r32;
            const int nkt = 8 * qb + 9, nkw = a + 2;
            bf16x8 qf[6];
            { const bf16* qp = QRAW + (size_t)(b * TT + qi) * 768 + 96 * h + 8 * hi;
              v4u qw[6];
#pragma unroll
              for (int s = 0; s < 6; ++s) qw[s] = *(const v4u*)(qp + 16 * s);
              f32x4 cs[4];
#pragma unroll
              for (int i = 0; i < 4; ++i) cs[i] = *(const f32x4*)(ROPE + 2 * (qi * 16 + 8 * hi) + 4 * i);
              float qv[6][8]; float ss = 0.f;
#pragma unroll
              for (int s = 0; s < 6; ++s) { const unsigned ww[4] = {qw[s].x, qw[s].y, qw[s].z, qw[s].w};
#pragma unroll
                  for (int e = 0; e < 4; ++e) { qv[s][2 * e] = bflo(ww[e]); qv[s][2 * e + 1] = bfhi(ww[e]); ss += qv[s][2 * e] * qv[s][2 * e] + qv[s][2 * e + 1] * qv[s][2 * e + 1]; } }
              ss = sum_x32(ss);
              const float sq = RQS[b * TT + qi];
              const float rs = (ATTN_SCALE * LOG2E) * sq * __builtin_amdgcn_rsqf(ss * sq * sq * (1.f / 96.f) + EPS);
#pragma unroll
              for (int jj = 0; jj < 8; ++jj) { const float c = cs[jj >> 1][2 * (jj & 1)], sn = cs[jj >> 1][2 * (jj & 1) + 1]; const float x1 = qv[4][jj], x2 = qv[5][jj];
                  const float gr = gqr[8 * hi + jj] * rs; qv[4][jj] = (x1 * c - x2 * sn) * gr; qv[5][jj] = (x1 * sn + x2 * c) * gr; }
#pragma unroll
              for (int s = 0; s < 4; ++s) { const f32x4 g0 = *(const f32x4*)(gqn + 16 * s + 8 * hi), g1 = *(const f32x4*)(gqn + 16 * s + 8 * hi + 4);
                  qv[s][0] *= g0.x * rs; qv[s][1] *= g0.y * rs; qv[s][2] *= g0.z * rs; qv[s][3] *= g0.w * rs; qv[s][4] *= g1.x * rs; qv[s][5] *= g1.y * rs; qv[s][6] *= g1.z * rs; qv[s][7] *= g1.w * rs; }
#pragma unroll
              for (int s = 0; s < 6; ++s) { v4u o; o.x = pk2(qv[s][0], qv[s][1]); o.y = pk2(qv[s][2], qv[s][3]); o.z = pk2(qv[s][4], qv[s][5]); o.w = pk2(qv[s][6], qv[s][7]); qf[s] = __builtin_bit_cast(bf16x8, o); } }
            f32x16 o0 = (f32x16){}, o1 = (f32x16){}; float l = 0.f;
            const int ns = (nkt + 1) >> 1;
#pragma unroll
            for (int j = 0; j < AT_D - 1; ++j) at_issue(F, kfb + (size_t)j * 6144, vfb + (size_t)j * 4096, ring + j * AT_SLOT);
#pragma unroll 1
            for (int st = 0; st < ns; ++st) {
                const int rem = ns - 1 - st;
                if (rem >= 2) asm volatile("s_waitcnt vmcnt(8)" ::: "memory"); else if (rem == 1) asm volatile("s_waitcnt vmcnt(4)" ::: "memory"); else asm volatile("s_waitcnt vmcnt(0)" ::: "memory");
                __builtin_amdgcn_s_barrier(); asm volatile("" ::: "memory");
                if (st + AT_D - 1 < ns) at_issue(F, kfb + (size_t)(st + AT_D - 1) * 6144, vfb + (size_t)(st + AT_D - 1) * 4096, ring + ((st + AT_D - 1) & (AT_D - 1)) * AT_SLOT);
#pragma unroll
                for (int tt = 0; tt < 2; ++tt) { const int kt = 2 * st + tt;
                  if (kt < nkw) {
                    const LAS unsigned char* sl = ring + (st & (AT_D - 1)) * AT_SLOT + F.lane * 16; const int j0 = 32 * kt;
                    f32x16 S = negm;
#pragma unroll
                    for (int s = 0; s < 6; ++s) S = MFMA32(*(const LAS bf16x8*)(sl + tt * 6144 + 1024 * s), qf[s], S);
                    bf16x8 vf[4];
#pragma unroll
                    for (int i = 0; i < 4; ++i) vf[i] = *(const LAS bf16x8*)(sl + 12288 + tt * 4096 + 1024 * i);
#pragma unroll
                    for (int i = 0; i < 16; ++i) S[i] = __builtin_amdgcn_exp2f(S[i]);
                    if (kt >= a) {
#pragma unroll
                        for (int i = 0; i < 16; ++i) if (j0 + crow(i, hi) > qi) S[i] = 0.f; }
#pragma unroll
                    for (int i = 0; i < 16; ++i) l += S[i];
                    const bf16x8 p0 = pack8(S, 0), p1 = pack8(S, 1);
                    o0 = MFMA32(vf[0], p0, o0); o0 = MFMA32(vf[1], p1, o0);
                    o1 = MFMA32(vf[2], p0, o1); o1 = MFMA32(vf[3], p1, o1);
                  } }
            }
            l = sum_x32(l);
            const float il = __builtin_amdgcn_rcpf(l);
            bf16* ao = MIXA + (size_t)(b * TT + qi) * 1024 + 512 + 64 * h + 4 * hi; float ssq = 0.f;
#pragma unroll
            for (int gq = 0; gq < 4; ++gq) {
                v2u w0, w1; w0.x = pk2(o0[4 * gq] * il, o0[4 * gq + 1] * il); w0.y = pk2(o0[4 * gq + 2] * il, o0[4 * gq + 3] * il);
                w1.x = pk2(o1[4 * gq] * il, o1[4 * gq + 1] * il); w1.y = pk2(o1[4 * gq + 2] * il, o1[4 * gq + 3] * il);
                ssq += (bflo(w0.x) * bflo(w0.x) + bfhi(w0.x) * bfhi(w0.x)) + (bflo(w0.y) * bflo(w0.y) + bfhi(w0.y) * bfhi(w0.y));
                ssq += (bflo(w1.x) * bflo(w1.x) + bfhi(w1.x) * bfhi(w1.x)) + (bflo(w1.y) * bflo(w1.y) + bfhi(w1.y) * bfhi(w1.y));
                *(v2u*)(ao + 8 * gq) = w0; *(v2u*)(ao + 32 + 8 * gq) = w1; }
            ssq = sum_x32(ssq);
            if (hi == 0) SSQ[(size_t)(b * TT + qi) * 8 + h] = ssq;
            asm volatile("s_waitcnt lgkmcnt(0)" ::: "memory"); __builtin_amdgcn_s_barrier(); asm volatile("" ::: "memory");
        }
    }
}

constexpr int SO_X = 0, SO_H = 36864, SO_B = 73728, SO_C = 82944, SO_Z = 92160, SO_TAB = 125952, SO_EX = 130048;
static_assert(SO_EX + 1024 <= RING_BYTES, "ssd_out LDS map");
__device__ __forceinline__ void p5_ssd_out(Frame& F) {
    const float* DT = (const float*)(F.ws + WS_DT); const float* a_log = (const float*)F.in[13]; const float* d_skip = (const float*)F.in[14]; const float* ng = (const float*)F.in[15];
    const bf16* XST = (const bf16*)(F.ws + WS_XST); const bf16* BC = (const bf16*)(F.ws + WS_BC); const bf16* HIN = (const bf16*)(F.ws + WS_HIN); const bf16* PROJ = (const bf16*)(F.ws + WS_PROJ);
    bf16* MIX = (bf16*)(F.ws + WS_MIX);
    LAS unsigned char* L = F.lds + RING_OFF;
    LAS float* tab = (LAS float*)(L + SO_TAB) + F.wave * 128;
    LAS float* exch = (LAS float*)(L + SO_EX);
    const int hl = F.wave >> 1, it = F.wave & 1, r32 = F.lane & 31, hi = F.lane >> 5;
    for (int u = blockIdx.x; u < NB * (NCH - 1); u += F.G) {
        const int b = u / (NCH - 1), c = 1 + u % (NCH - 1); const int t0 = c * CHL - TOFF;
        v4u st[14];
#define SO_FETCH_A(g) do { \
        _Pragma("unroll") for (int k = 0; k < 4; ++k) { const int q = F.tid + NTHR * k; st[k] = *(const v4u*)(XST + ((size_t)(b * SSDW + (g) * 256 + (q >> 3))) * TPAD + c * CHL + 8 * (q & 7)); } } while (0)
#define SO_FETCH_B(g) do { \
        _Pragma("unroll") for (int k = 0; k < 4; ++k) { const int q = F.tid + NTHR * k; st[4 + k] = *(const v4u*)(HIN + ((size_t)((b * NCH + c) * NH + 4 * (g))) * 4096 + (size_t)q * 8); } \
        { const int q = F.tid; st[8] = *(const v4u*)(BC + (size_t)(b * TT + t0 + (q >> 3)) * 256 + (g) * DS + 8 * (q & 7)); st[9] = *(const v4u*)(BC + (size_t)(b * TT + t0 + (q >> 3)) * 256 + 128 + (g) * DS + 8 * (q & 7)); } \
        _Pragma("unroll") for (int k = 0; k < 4; ++k) { const int q = F.tid + NTHR * k; st[10 + k] = *(const v4u*)(PROJ + (size_t)(b * TT + t0 + (q >> 5)) * PJ + C_Z + (g) * 256 + 8 * (q & 31)); } } while (0)
#define SO_STORE() do { \
        _Pragma("unroll") for (int k = 0; k < 4; ++k) { const int q = F.tid + NTHR * k; *(LAS v4u*)(L + SO_X + (q >> 3) * 144 + 16 * (q & 7)) = st[k]; *(LAS v4u*)(L + SO_H + (q >> 3) * 144 + 16 * (q & 7)) = st[4 + k]; } \
        { const int q = F.tid; *(LAS v4u*)(L + SO_B + (q >> 3) * 144 + 16 * (q & 7)) = st[8]; *(LAS v4u*)(L + SO_C + (q >> 3) * 144 + 16 * (q & 7)) = st[9]; } \
        _Pragma("unroll") for (int k = 0; k < 4; ++k) { const int q = F.tid + NTHR * k; *(LAS v4u*)(L + SO_Z + (q >> 5) * 528 + 16 * (q & 31)) = st[10 + k]; } } while (0)
        SO_FETCH_A(0); SO_FETCH_B(0);
#pragma unroll 1
        for (int g = 0; g < 2; ++g) {
            const int h = 4 * g + hl; const float A = -__expf(a_log[h]), Dh = d_skip[h];
            { const int t = t0 + F.lane; const float dt = DT[(size_t)(b * TT + t) * 8 + h];
              float acs = dt * A;
#pragma unroll
              for (int o = 1; o < 64; o <<= 1) { const float v = __shfl_up(acs, o); if (F.lane >= o) acs += v; }
              tab[F.lane] = acs; tab[64 + F.lane] = dt; }
            SO_STORE();
            __syncthreads();
            if (g == 0) SO_FETCH_A(1);
            const int ii = 32 * it + r32; const int t = t0 + ii;
            bf16x8 cf[4];
#pragma unroll
            for (int s = 0; s < 4; ++s) cf[s] = *(const LAS bf16x8*)(L + SO_C + ii * 144 + 32 * s + 16 * hi);
            f32x16 y[2];
            const float ai = tab[ii]; const float ei = __expf(ai);
#pragma unroll
            for (int pt = 0; pt < 2; ++pt) { f32x16 acc = (f32x16){}; const LAS unsigned char* hp_ = L + SO_H + (hl * 64 + 32 * pt + r32) * 144 + 16 * hi;
#pragma unroll
                for (int s = 0; s < 4; ++s) acc = MFMA32(*(const LAS bf16x8*)(hp_ + 32 * s), cf[s], acc);
#pragma unroll
                for (int i = 0; i < 16; ++i) acc[i] *= ei;
                y[pt] = acc; }
#pragma unroll 1
            for (int jt = 0; jt <= it; ++jt) {
                f32x16 S = (f32x16){};
                { const LAS unsigned char* bp_ = L + SO_B + (32 * jt + r32) * 144 + 16 * hi;
#pragma unroll
                  for (int s = 0; s < 4; ++s) S = MFMA32(*(const LAS bf16x8*)(bp_ + 32 * s), cf[s], S); }
#pragma unroll
                for (int i = 0; i < 16; ++i) { const int jj = 32 * jt + crow(i, hi); const float e = (jj <= ii) ? __expf(ai - tab[jj]) * tab[64 + jj] : 0.f; S[i] = S[i] * e + ((jj == ii) ? Dh : 0.f); }
                const bf16x8 p0 = pack8(S, 0), p1 = pack8(S, 1);
#pragma unroll
                for (int pt = 0; pt < 2; ++pt) { const LAS unsigned char* xp_ = L + SO_X + (hl * 64 + 32 * pt + r32) * 144 + (32 * jt + 4 * hi) * 2;
                    const v2u x0 = *(const LAS v2u*)(xp_), x1 = *(const LAS v2u*)(xp_ + 16), x2 = *(const LAS v2u*)(xp_ + 32), x3 = *(const LAS v2u*)(xp_ + 48);
                    v4u f0, f1; f0.x = x0.x; f0.y = x0.y; f0.z = x1.x; f0.w = x1.y; f1.x = x2.x; f1.y = x2.y; f1.z = x3.x; f1.w = x3.y;
                    y[pt] = MFMA32(__builtin_bit_cast(bf16x8, f0), p0, y[pt]); y[pt] = MFMA32(__builtin_bit_cast(bf16x8, f1), p1, y[pt]); }
            }
            float ss = 0.f;
            { const LAS unsigned char* zp_ = L + SO_Z + ii * 528 + (hl * 64 + 4 * hi) * 2;
#pragma unroll
              for (int pt = 0; pt < 2; ++pt)
#pragma unroll
                for (int gq = 0; gq < 4; ++gq) { const v2u zw = *(const LAS v2u*)(zp_ + (32 * pt + 8 * gq) * 2); const float zz[4] = {bflo(zw.x), bfhi(zw.x), bflo(zw.y), bfhi(zw.y)};
#pragma unroll
                    for (int e = 0; e < 4; ++e) { const float v = y[pt][4 * gq + e] * silu_f(zz[e]); y[pt][4 * gq + e] = v; ss += v * v; } } }
            ss = sum_x32(ss);
            if (g == 0) SO_FETCH_B(1);
            LAS float* ex = exch + it * 128;
            if (hi == 0) ex[hl * 32 + r32] = ss;
            __syncthreads();
            const float tot = (ex[r32] + ex[32 + r32]) + (ex[64 + r32] + ex[96 + r32]);
            const float rs = __builtin_amdgcn_rsqf(tot * (1.f / 256.f) + EPS);
            { bf16* mo = MIX + (size_t)(b * TT + t) * 1024 + 64 * h + 4 * hi;
#pragma unroll
              for (int pt = 0; pt < 2; ++pt)
#pragma unroll
                for (int gq = 0; gq < 4; ++gq) { const f32x4 gg = *(const f32x4*)(ng + 64 * h + 32 * pt + 8 * gq + 4 * hi);
                    v2u w; w.x = pk2(y[pt][4 * gq] * rs * gg.x, y[pt][4 * gq + 1] * rs * gg.y); w.y = pk2(y[pt][4 * gq + 2] * rs * gg.z, y[pt][4 * gq + 3] * rs * gg.w);
                    *(v2u*)(mo + 32 * pt + 8 * gq) = w; } }
        }
#undef SO_FETCH_A
#undef SO_FETCH_B
#undef SO_STORE
        __syncthreads();
    }
    const float* YS = (const float*)(F.ws + WS_YS);
    for (int u = F.gw; u < DB * NG; u += F.NGW) { const int b = u >> 1, gg = u & 1; const int cc = gg * 256 + 4 * F.lane;
        const f32x4 yv = *(const f32x4*)(YS + (size_t)b * 512 + cc); const v2u zw = *(const v2u*)(PROJ + (size_t)(RP + b) * PJ + C_Z + cc);
        const f32x4 v = {yv.x * silu_f(bflo(zw.x)), yv.y * silu_f(bfhi(zw.x)), yv.z * silu_f(bflo(zw.y)), yv.w * silu_f(bfhi(zw.y))};
        const float rs = __builtin_amdgcn_rsqf(wave_sum((v.x * v.x + v.y * v.y) + (v.z * v.z + v.w * v.w)) * (1.f / 256.f) + EPS);
        const f32x4 gv = *(const f32x4*)(ng + cc); v2u w; w.x = pk2(v.x * rs * gv.x, v.y * rs * gv.y); w.y = pk2(v.z * rs * gv.z, v.w * rs * gv.w);
        *(v2u*)(MIX + (size_t)(RP + b) * 1024 + cc) = w; }
}

constexpr int DB_STAGE = 0, DB_KRST = 65536, DB_LAT = DB_KRST + 8192, DB_KR = DB_LAT + 64 * DA_ROWB, DB_PB = DB_KR + 64 * 36 * 4, DB_QG = DB_PB + 16 * 64 * 2, DB_END = DB_QG + 8 * 96 * 4;
static_assert(DB_END <= RING_BYTES, "decode attention LDS map");
#define RAW_BAR_L() do { asm volatile("s_waitcnt lgkmcnt(0)" ::: "memory"); __builtin_amdgcn_s_barrier(); asm volatile("" ::: "memory"); } while (0)
#define RAW_BAR_VL() do { asm volatile("s_waitcnt vmcnt(0) lgkmcnt(0)" ::: "memory"); __builtin_amdgcn_s_barrier(); asm volatile("" ::: "memory"); } while (0)
__device__ __forceinline__ void da_issue(Frame& F, LAS unsigned char* L, const float* clat, const float* ckr, const int* ptab, int b, int split, int hp) {
    const size_t tok0 = (size_t)ptab[b * NPAGES + split * 32 + (hp >> 1)] * PAGE + (hp & 1) * 64;
    const char* src = (const char*)(clat + tok0 * KVL) + (size_t)(F.wave * 8) * 1024 + F.lane * 16;
#pragma unroll
    for (int i = 0; i < 8; ++i) __builtin_amdgcn_global_load_lds((const unsigned*)(src + i * 1024), (LAS unsigned*)(L + DB_STAGE + (F.wave * 8 + i) * 1024), 16, 0, 0);
    __builtin_amdgcn_global_load_lds((const unsigned*)((const char*)(ckr + tok0 * 32) + F.wave * 1024 + F.lane * 16), (LAS unsigned*)(L + DB_KRST + F.wave * 1024), 16, 0, 0);
}
__device__ __forceinline__ void da_convert(Frame& F, LAS unsigned char* L) {
#pragma unroll 4
    for (int k = 0; k < 8; ++k) { const int f = F.tid + NTHR * k; const int row = f >> 6, c4 = f & 63; const f32x4 v = *(const LAS f32x4*)(L + DB_STAGE + f * 16);
        v2u w; w.x = pk2(v.x, v.y); w.y = pk2(v.z, v.w); *(LAS v2u*)(L + DB_LAT + row * DA_ROWB + c4 * 8) = w; }
    { const int f = F.tid; const int row = f >> 3, c4 = f & 7; const f32x4 v = *(const LAS f32x4*)(L + DB_KRST + f * 16);
      *(LAS f32x4*)((LAS float*)(L + DB_KR) + row * 36 + 4 * c4) = v; }
}
__device__ __forceinline__ void st_wt(float* p, float v) { asm volatile("global_store_dword %0, %1, off sc0 sc1" :: "v"(p), "v"(v) : "memory"); }
__device__ __forceinline__ void decode_combine_one(Frame& F, float M0, int b) {
    const float* DPART = (const float*)(F.ws + WS_DPART); const bf16* WUKV = (const bf16*)(F.ws + WS_WUKV2); const bf16* Q = (const bf16*)(F.ws + WS_Q); const bf16* KS = (const bf16*)(F.ws + WS_KS);
    const float* VS = (const float*)(F.ws + WS_VS); bf16* MIX = (bf16*)(F.ws + WS_MIX);
    LAS float* accl = (LAS float*)(F.lds + RING_OFF) + F.wave * 256; LAS float* exch = (LAS float*)(F.lds + P5_EXCH);
    const int h = F.wave;
    const float* p0 = DPART + ((size_t)((b * 2 + 0) * NH + h)) * 264; const float* p1 = DPART + ((size_t)((b * 2 + 1) * NH + h)) * 264;
#pragma unroll
    for (int k = 0; k < 4; ++k) accl[F.lane + 64 * k] = p0[F.lane + 64 * k] + p1[F.lane + 64 * k];
    float l = p0[256] + p1[256];
    const bf16* qp = Q + (size_t)(RP + b) * 768 + 96 * h; const bf16* kp = KS + (size_t)b * 768 + 96 * h;
    float sd = bf2f(qp[F.lane]) * bf2f(kp[F.lane]); if (F.lane < 32) sd += bf2f(qp[64 + F.lane]) * bf2f(kp[64 + F.lane]);
    sd = wave_sum(sd);
    const float pn = __builtin_amdgcn_exp2f(sd - M0); l += pn;
    LDS_WAIT(); asm volatile("" ::: "memory");
    const bf16* wv = WUKV + (size_t)(128 * h + 64 + F.lane) * KVL;
    float o = 0.f;
    { v4u wv4[32];
#pragma unroll
      for (int c8 = 0; c8 < 32; ++c8) wv4[c8] = *(const v4u*)(wv + 8 * c8);
#pragma unroll
      for (int c8 = 0; c8 < 32; ++c8) { const v4u w = wv4[c8]; const f32x4 x0 = *(const LAS f32x4*)(accl + 8 * c8), x1 = *(const LAS f32x4*)(accl + 8 * c8 + 4);
        o += (bflo(w.x) * x0.x + bfhi(w.x) * x0.y) + (bflo(w.y) * x0.z + bfhi(w.y) * x0.w) + (bflo(w.z) * x1.x + bfhi(w.z) * x1.y) + (bflo(w.w) * x1.z + bfhi(w.w) * x1.w); } }
    o = (o + pn * VS[(size_t)b * 512 + 64 * h + F.lane]) * __builtin_amdgcn_rcpf(l);
    const float ss = wave_sum(o * o);
    if (F.lane == 0) exch[h] = ss;
    __syncthreads();
    float tot = 0.f;
#pragma unroll
    for (int hh = 0; hh < NH; ++hh) tot += exch[hh];
    const float rs = __builtin_amdgcn_rsqf(tot * (1.f / MLAW) + EPS);
    MIX[(size_t)(RP + b) * 1024 + 512 + 64 * h + F.lane] = f2bf(o * rs);
    __syncthreads();
}
template <int MODE>
__device__ __forceinline__ void p5_attn_decode_t(Frame& F, float M0) {
    const float* clat = (const float*)F.in[2]; const float* ckr = (const float*)F.in[3]; const int* ptab = (const int*)F.in[6];
    const bf16* WUKV = (const bf16*)(F.ws + WS_WUKV2); const bf16* Q = (const bf16*)(F.ws + WS_Q); const float* gkn = (const float*)F.in[22]; const float* gkr = (const float*)F.in[23];
    float* DPART = (float*)(F.ws + WS_DPART);
    LAS unsigned char* L = F.lds + RING_OFF;
    LAS float* krl = (LAS float*)(L + DB_KR); LAS bf16* pb = (LAS bf16*)(L + DB_PB); LAS float* qg = (LAS float*)(L + DB_QG) + F.wave * 96;
    const int h = F.wave, r32 = F.lane & 31, hi = F.lane >> 5;
    for (int u = blockIdx.x; u < DB * 2; u += F.G) {
        const int b = u >> 1, split = u & 1;
        da_issue(F, L, clat, ckr, ptab, b, split, 0);
        bf16x8 wf[4][8];
#pragma unroll
        for (int dt = 0; dt < 4; ++dt)
#pragma unroll
            for (int s = 0; s < 8; ++s) wf[dt][s] = *(const bf16x8*)(WUKV + (size_t)(128 * h + 16 * dt + (F.lane & 15)) * KVL + 32 * s + 8 * (F.lane >> 4));
        { const bf16* qp = Q + (size_t)(RP + b) * 768 + 96 * h; qg[F.lane] = bf2f(qp[F.lane]) * gkn[F.lane]; if (F.lane < 32) qg[64 + F.lane] = bf2f(qp[64 + F.lane]) * gkr[F.lane & 15]; }
        for (int i = F.tid; i < 16 * 64; i += NTHR) pb[i] = 0;
        f32x4 ao[2] = {(f32x4){0.f, 0.f, 0.f, 0.f}, (f32x4){0.f, 0.f, 0.f, 0.f}}; float l = 0.f;
        RAW_BAR_VL();
        da_convert(F, L);
        RAW_BAR_L();
        da_issue(F, L, clat, ckr, ptab, b, split, 1);
#pragma unroll 1
        for (int hp = 0; hp < 64; ++hp) {
          if (MODE == 0 || MODE == 3) {
            const int n16 = F.lane & 15, kg4 = F.lane >> 4;
#pragma unroll 1
            for (int sb = 0; sb < 2; ++sb) {
                const LAS unsigned char* bp = L + DB_LAT + (32 * sb + n16) * DA_ROWB + 16 * kg4;
                f32x4 acc[4][2];
#pragma unroll
                for (int dt = 0; dt < 4; ++dt) { acc[dt][0] = (f32x4){0.f, 0.f, 0.f, 0.f}; acc[dt][1] = acc[dt][0]; }
                bf16x8 fa[2], fb[2];
                fa[0] = *(const LAS bf16x8*)(bp); fa[1] = *(const LAS bf16x8*)(bp + 16 * DA_ROWB);
#pragma unroll
                for (int s = 0; s < 8; ++s) {
                    if (s < 7) { fb[0] = *(const LAS bf16x8*)(bp + 64 * (s + 1)); fb[1] = *(const LAS bf16x8*)(bp + 16 * DA_ROWB + 64 * (s + 1)); }
#pragma unroll
                    for (int dt = 0; dt < 4; ++dt) { acc[dt][0] = MFMA16(wf[dt][s], fa[0], acc[dt][0]); acc[dt][1] = MFMA16(wf[dt][s], fa[1], acc[dt][1]); }
                    fa[0] = fb[0]; fa[1] = fb[1];
                }
                __builtin_amdgcn_sched_barrier(0);
                f32x4 s4[2] = {(f32x4){0.f, 0.f, 0.f, 0.f}, (f32x4){0.f, 0.f, 0.f, 0.f}}, d4[2] = {s4[0], s4[0]};
#pragma unroll
                for (int dt = 0; dt < 4; ++dt) { const f32x4 qq = *(const LAS f32x4*)(qg + 16 * dt + 4 * kg4);
#pragma unroll
                    for (int tt = 0; tt < 2; ++tt) { s4[tt] += acc[dt][tt] * acc[dt][tt]; d4[tt] += acc[dt][tt] * qq; } }
                { const LAS float* qr = qg + 64 + 8 * kg4; const f32x4 q0 = *(const LAS f32x4*)(qr), q1 = *(const LAS f32x4*)(qr + 4);
#pragma unroll
                  for (int tt = 0; tt < 2; ++tt) { const LAS float* kr = krl + (32 * sb + 16 * tt + n16) * 36 + 8 * kg4; const f32x4 k0 = *(const LAS f32x4*)(kr), k1 = *(const LAS f32x4*)(kr + 4);
                      s4[tt] += k0 * k0; s4[tt] += k1 * k1; d4[tt] += k0 * q0; d4[tt] += k1 * q1; } }
                __builtin_amdgcn_sched_barrier(0);
#pragma unroll
                for (int tt = 0; tt < 2; ++tt) { float ss = (s4[tt].x + s4[tt].y) + (s4[tt].z + s4[tt].w), dot = (d4[tt].x + d4[tt].y) + (d4[tt].z + d4[tt].w);
                    ss = sum_x16(ss); dot = sum_x16(dot); ss = sum_x32(ss); dot = sum_x32(dot);
                    const float p = __builtin_amdgcn_exp2f(dot * __builtin_amdgcn_rsqf(ss * (1.f / 96.f) + EPS) - M0);
                    if (kg4 == 0) { l += p; pb[h * 64 + 32 * sb + 16 * tt + n16] = f2bf(p); } }
            }
            RAW_BAR_L();
            if (MODE < 4) { const int q4 = (F.lane & 15) >> 2, pp = F.lane & 3, kg = F.lane >> 4;
              const unsigned a_lo = (unsigned)(uintptr_t)(L + DB_LAT) + (unsigned)((8 * kg + q4) * DA_ROWB + (32 * h + 4 * pp) * 2);
              const LAS bf16* pap = pb + (F.lane & 15) * 64 + 8 * kg;
              s16x4 t0, t1, t2, t3, t4, t5, t6, t7;
              asm volatile("ds_read_b64_tr_b16 %0, %8 offset:%c9\n\tds_read_b64_tr_b16 %1, %8 offset:%c10\n\tds_read_b64_tr_b16 %2, %8 offset:%c11\n\tds_read_b64_tr_b16 %3, %8 offset:%c12\n\t"
                           "ds_read_b64_tr_b16 %4, %8 offset:%c13\n\tds_read_b64_tr_b16 %5, %8 offset:%c14\n\tds_read_b64_tr_b16 %6, %8 offset:%c15\n\tds_read_b64_tr_b16 %7, %8 offset:%c16\n\ts_waitcnt lgkmcnt(0)"
                           : "=&v"(t0), "=&v"(t1), "=&v"(t2), "=&v"(t3), "=&v"(t4), "=&v"(t5), "=&v"(t6), "=&v"(t7)
                           : "v"(a_lo), "i"(0), "i"(4 * DA_ROWB), "i"(32), "i"(32 + 4 * DA_ROWB), "i"(32 * DA_ROWB), "i"(32 * DA_ROWB + 4 * DA_ROWB), "i"(32 * DA_ROWB + 32), "i"(32 * DA_ROWB + 32 + 4 * DA_ROWB) : "memory");
              const bf16x8 pa0 = *(const LAS bf16x8*)(pap), pa1 = *(const LAS bf16x8*)(pap + 32);
#define DA_FR(x, y) ((bf16x8){x[0], x[1], x[2], x[3], y[0], y[1], y[2], y[3]})
              ao[0] = MFMA16(pa0, DA_FR(t0, t1), ao[0]); ao[1] = MFMA16(pa0, DA_FR(t2, t3), ao[1]);
              ao[0] = MFMA16(pa1, DA_FR(t4, t5), ao[0]); ao[1] = MFMA16(pa1, DA_FR(t6, t7), ao[1]);
#undef DA_FR
#define DA_PV(ks, nt) do { } while (0)
#undef DA_PV
            }
          }
            RAW_BAR_VL();
            if (hp + 1 < 64) { if (MODE <= 1 || MODE >= 3) da_convert(F, L); RAW_BAR_L(); if (hp + 2 < 64 && MODE < 3) da_issue(F, L, clat, ckr, ptab, b, split, hp + 2); }
        }
        if (MODE >= 3 && l == 123.456f) DPART[0] = l;
        if (MODE == 0) { const int kg = F.lane >> 4;
          if (kg < 2) {
#pragma unroll
              for (int nt = 0; nt < 2; ++nt)
#pragma unroll
                  for (int i = 0; i < 4; ++i) st_wt(&DPART[((size_t)((b * 2 + split) * NH + 4 * kg + i)) * 264 + 32 * h + 16 * nt + (F.lane & 15)], ao[nt][i]); }
          float lt = wave_sum(l);
          if (F.lane == 0) st_wt(&DPART[((size_t)((b * 2 + split) * NH + h)) * 264 + 256], lt); }
        asm volatile("s_waitcnt vmcnt(0)" ::: "memory");
        __syncthreads();
        { volatile LAS unsigned* arr = (volatile LAS unsigned*)(F.lds + MISC_OFF) + 16;
          if (F.tid == 0) {
              const unsigned old = __hip_atomic_fetch_add((unsigned*)(F.ws + WS_CTL) + CW_DCNT + b, 1u, __ATOMIC_RELAXED, __HIP_MEMORY_SCOPE_AGENT);
              if (old == 1u) { __builtin_amdgcn_fence(__ATOMIC_ACQUIRE, "agent"); asm volatile("s_waitcnt vmcnt(0)" ::: "memory"); }
              arr[0] = old; }
          __syncthreads();
          if (MODE == 0 && arr[0] == 1u) decode_combine_one(F, M0, b);
          __syncthreads(); }
    }
}

__device__ __forceinline__ void p5_attn_decode(Frame& F, float M0) { p5_attn_decode_t<0>(F, M0); }

__device__ __forceinline__ void p7_outproj(Frame& F) {
    const bf16* MIX = (const bf16*)(F.ws + WS_MIX); const bf16* WOUT = (const bf16*)(F.ws + WS_WOUT); const float* xp = (const float*)F.in[0]; const float* xs = (const float*)F.in[1]; float* HS = (float*)(F.ws + WS_HS);
    bf16* HB = (bf16*)(F.ws + WS_XN); float* SS = (float*)(F.ws + WS_SSP); float* ysamp = F.out + OUT_YS;
    { pg8::Gemm g{MIX, WOUT, MMAIN, DM, 1024, 1, 1024}; pg8::StaticOrder S; S.init(MMAIN, DM, F.G, (int)blockIdx.x);
      LAS float* RS = (LAS float*)(F.lds + LDSCTL_OFF + 1024); const float* SSQ = (const float*)(F.ws + WS_SSQ);
#pragma unroll 1
      for (int i = 0; i < 8; ++i) { pg8::Unit uu; if (!S.next(i, uu)) break;
          int tl = (int)threadIdx.x; asm volatile("" : "+v"(tl));
          if (tl < 256) { const pg8::f32x4* sp = (const pg8::f32x4*)(SSQ + (size_t)(g.rowbase(uu.pm) + tl) * 8); const pg8::f32x4 s4 = sp[0] + sp[1];
              RS[i * 256 + tl] = __builtin_amdgcn_rsqf(((s4[0] + s4[1]) + (s4[2] + s4[3])) * (1.f / MLAW) + EPS); } }
      __syncthreads();
      EpiOutProj E{xp, F.out + OUT_YP, HB, SS, RS, 0};
      pg8::gemm_phase<EpiOutProj, pg8::StaticOrder, true, true, 8>(F.lds + RING_OFF, g, S, E); }
    { LAS f32x4* part = (LAS f32x4*)(F.lds + RING_OFF);
      for (int tp = blockIdx.x; tp < 256; tp += F.G) {
          const int t = 2 * tp + (F.wave >> 2), kq = F.wave & 3, rt = t & 7, ct = t >> 3;
          const bf16* ap = MIX + (size_t)(RP + rt * 16 + (F.lane & 15)) * 1024 + 256 * kq + 8 * (F.lane >> 4);
          const bf16* bp = WOUT + (size_t)(ct * 16 + (F.lane & 15)) * 1024 + 256 * kq + 8 * (F.lane >> 4);
          bf16x8 av[8], bv[8];
#pragma unroll
          for (int j = 0; j < 8; ++j) { av[j] = *(const bf16x8*)(ap + 32 * j); bv[j] = *(const bf16x8*)(bp + 32 * j); }
          f32x4 acc = {0.f, 0.f, 0.f, 0.f};
#pragma unroll
          for (int j = 0; j < 8; ++j) acc = MFMA16(av[j], bv[j], acc);
          part[F.wave * 64 + F.lane] = acc;
          __syncthreads();
          if (kq == 0) { acc = (acc + part[(F.wave + 1) * 64 + F.lane]) + (part[(F.wave + 2) * 64 + F.lane] + part[(F.wave + 3) * 64 + F.lane]);
              const int col = ct * 16 + (F.lane & 15);
#pragma unroll
              for (int i = 0; i < 4; ++i) { const int r = rt * 16 + 4 * (F.lane >> 4) + i; const size_t o = (size_t)r * DM + col; const float v = xs[o] + acc[i]; HS[o] = v; ysamp[o] = v; HB[(size_t)(RP + r) * DM + col] = f2bf(v);
                  float ss = v * v; ss = sum_x1(ss); ss = sum_x2(ss); ss = sum_x4(ss); ss = sum_x8(ss);
                  if ((F.lane & 15) == 0) SS[(size_t)MMAIN * 16 + (size_t)r * 64 + ct] = ss; } }
          __syncthreads();
      } }
}
__device__ __forceinline__ void p9_gateup(Frame& F) {
    const bf16* HB = (const bf16*)(F.ws + WS_XN); const bf16* WGU = (const bf16*)(F.ws + WS_WGU); bf16* ACT = (bf16*)(F.ws + WS_ACT); const float* SS = (const float*)(F.ws + WS_SSP);
    { pg8::Gemm g{HB, WGU, MMAIN, 2 * DFF, DM, 1, DM}; pg8::StaticOrder S; S.init(MMAIN, 2 * DFF, F.G, (int)blockIdx.x);
      LAS float* RS = (LAS float*)(F.lds + LDSCTL_OFF + 1024);
#pragma unroll 1
      for (int i = 0; i < 8; ++i) { pg8::Unit uu; if (!S.next(i, uu)) break;
          int tl = (int)threadIdx.x; asm volatile("" : "+v"(tl));
          if (tl < 256) { const pg8::f32x4* sp = (const pg8::f32x4*)(SS + (size_t)(uu.pm * 256 + tl) * 16); const pg8::f32x4 s4 = (sp[0] + sp[1]) + (sp[2] + sp[3]);
              RS[i * 256 + tl] = __builtin_amdgcn_rsqf(((s4[0] + s4[1]) + (s4[2] + s4[3])) * (1.f / DM) + EPS); } }
      __syncthreads();
      EpiSwiGLU E{ACT, RS, 0};
      pg8::gemm_phase<EpiSwiGLU, pg8::StaticOrder, true, true>(F.lds + RING_OFF, g, S, E); }
    const int gw = F.gw, ngw = F.NGW;
    const int nrt = DB / 16, nlt = DFF / 16;
    for (int task = gw; task < nrt * nlt; task += ngw) {
        const int rt = task % nrt, lt = task / nrt; const int lc = lt * 16 + (F.lane & 15);
        const bf16* ap = HB + (size_t)(RP + rt * 16 + (F.lane & 15)) * DM + 8 * (F.lane >> 4);
        const bf16* gp = WGU + (size_t)(256 * (lc >> 7) + (lc & 127)) * DM + 8 * (F.lane >> 4); const bf16* up = gp + (size_t)128 * DM;
        f32x4 ag = {0.f, 0.f, 0.f, 0.f}, au = {0.f, 0.f, 0.f, 0.f};
#pragma unroll 8
        for (int k0 = 0; k0 < DM; k0 += 32) { const bf16x8 a = *(const bf16x8*)(ap + k0); ag = MFMA16(a, *(const bf16x8*)(gp + k0), ag); au = MFMA16(a, *(const bf16x8*)(up + k0), au); }
#pragma unroll
        for (int i = 0; i < 4; ++i) { const int r = rt * 16 + 4 * (F.lane >> 4) + i; const f32x4* sp = (const f32x4*)(SS + (size_t)MMAIN * 16 + (size_t)r * 64); f32x4 s4 = sp[0];
#pragma unroll
            for (int q = 1; q < 16; ++q) s4 += sp[q];
            const float rs = __builtin_amdgcn_rsqf(((s4[0] + s4[1]) + (s4[2] + s4[3])) * (1.f / DM) + EPS);
            ACT[(size_t)(RP + r) * DFF + lc] = f2bf(silu_f(rs * ag[i]) * (rs * au[i])); }
    }
}
__device__ __forceinline__ void p10_down(Frame& F) {
    const bf16* ACT = (const bf16*)(F.ws + WS_ACT); const bf16* WDN = (const bf16*)(F.ws + WS_WDN); const float* HS = (const float*)(F.ws + WS_HS);
    { pg8::Gemm g{ACT, WDN, MMAIN, DM, DFF, 1, DFF}; pg8::StaticOrder S; S.init(MMAIN, DM, F.G, (int)blockIdx.x); EpiDown E{(const bf16*)(F.ws + WS_XN), F.out + OUT_YP};
      pg8::gemm_phase<EpiDown, pg8::StaticOrder, true, true>(F.lds + RING_OFF, g, S, E); }
    float* ys = F.out + OUT_YS;
    small_gemm(ACT, DFF, WDN, DFF, DB / 16, DM / 16, [](int r) { return RP + r; },
        [&](const f32x4& acc, int rt, int ct, int lane) { const int col = ct * 16 + (lane & 15);
#pragma unroll
            for (int i = 0; i < 4; ++i) atomicAdd(ys + (size_t)(rt * 16 + 4 * (lane >> 4) + i) * DM + col, acc[i]); }, F.gw, F.NGW, F.lane, 4);
}
#ifndef MK_ONE_LAUNCH
#define MK_ONE_LAUNCH 0
#endif
constexpr int N_PHASES = 9;
__global__ void __launch_bounds__(NTHR, 2) mk_fwd(Args args) {
    extern __shared__ __attribute__((aligned(16))) unsigned char lds_raw[];
    Frame F;
    F.lds = (LAS unsigned char*)lds_raw;
    F.tid = threadIdx.x; F.lane = F.tid & 63; F.wave = __builtin_amdgcn_readfirstlane(F.tid >> 6);
    F.G = gridDim.x; { const int bx = blockIdx.x; F.vcu = (F.G % 8 == 0) ? (bx % 8) * (F.G / 8) + bx / 8 : bx; }
    F.gw = blockIdx.x * NWAVES + F.wave; F.NGW = F.G * NWAVES;
    F.ws = args.ws; F.out = args.out; F.in = args.in;
    volatile LAS unsigned* MISC = (volatile LAS unsigned*)(F.lds + MISC_OFF);
    for (int u = F.tid; u < (LDS_BYTES - LDSCTL_OFF) / 4; u += NTHR) ((LAS unsigned*)(F.lds + LDSCTL_OFF))[u] = 0u;
    __syncthreads();
    XcdBarrier bar; bar.bar = (unsigned*)(F.ws + WS_CTL) + CW_BAR; bar.x = 0; bar.st = nullptr;
    const int lo = args.ph_lo, hi = args.ph_hi;
    if (hi - lo > 1) bar = xcd_barrier_post((unsigned*)(F.ws + WS_CTL) + CW_BAR, MISC + 8);
#ifdef MK_TS
    unsigned long long* TSB = (unsigned long long*)(F.ws + 600 * MiB); int tsn = 0;
#define STAMP() do { if (blockIdx.x == 0 && F.tid == 0) TSB[tsn] = __builtin_amdgcn_s_memrealtime(); ++tsn; } while (0)
    STAMP();
#else
#define STAMP() do { } while (0)
#endif
#define IN(k) (lo <= (k) && (k) < hi)
#ifdef MK_TS
#define ARRIVE(k) do { if (blockIdx.x == 0 && F.tid == 0) TSB[30 + (k)] = __builtin_amdgcn_s_memrealtime(); } while (0)
#else
#define ARRIVE(k) do { } while (0)
#endif
#define SEAM(k) do { ARRIVE(k); if (IN(k) && IN((k) + 1)) xcd_barrier(bar); STAMP(); } while (0)
#ifndef MK_REPEAT
#define MK_REPEAT 0
#endif
#define REP(id, stmt) do { stmt; if (MK_REPEAT & (1 << (id))) { __syncthreads(); stmt; } } while (0)
    if (IN(0)) { REP(0, p0_prologue(F)); } SEAM(0);
    if (IN(1)) { REP(1, p1_inproj(F)); } SEAM(1);
    if (IN(2)) {
#ifdef MK_SLEEP_PROBE
        { const unsigned long long t0 = __builtin_amdgcn_s_memrealtime(); while (__builtin_amdgcn_s_memrealtime() - t0 < 3000ull) __builtin_amdgcn_s_sleep(32); }
#endif
        REP(2, p2_elementwise(F)); } SEAM(2);
    if (IN(3)) { REP(3, p3_upproj_states(F)); } SEAM(3);
    if (IN(4)) { REP(4, p4_post(F)); } SEAM(4);
    if (IN(5)) { const float M0 = softmax_ref(F);
        if (blockIdx.x & 1) { p5_attn_decode(F, M0); __syncthreads(); }
        p5_attn_prompt(F, M0); __syncthreads();
        p5_ssd_out(F); __syncthreads();
        if (!(blockIdx.x & 1)) p5_attn_decode(F, M0);
    } SEAM(5);
    if (IN(6)) { REP(9, p7_outproj(F)); } SEAM(6);
    if (IN(7)) { REP(11, p9_gateup(F)); } SEAM(7);
    if (IN(8)) { p10_down(F); }
#ifdef MK_TS
    __syncthreads(); STAMP();
#endif
#undef IN
#undef SEAM
}
#ifndef MK_DIAG
#define MK_DIAG 0
#endif
__device__ __forceinline__ size_t nmrow(size_t r) { return r < (size_t)MMAIN ? (r >> 11) * TT + NMETA + (r & 2047) : (size_t)RP + (r - MMAIN); }
constexpr size_t WS_OUT2 = 1024 * MiB;
#ifdef MK_TS
#ifndef MK_TS_QA
#define MK_TS_QA 4.f
#endif
#ifndef MK_TS_QB
#define MK_TS_QB 4.f
#endif
__global__ void k_ts_encode(const unsigned long long* ts, float* out, int ia0, int ia1, int ib0, int ib1) {
    const float ta = rintf((float)(ts[ia1] - ts[ia0]) * 0.01f * (1.f / MK_TS_QA)) * MK_TS_QA, tb = rintf((float)(ts[ib1] - ts[ib0]) * 0.01f * (1.f / MK_TS_QB)) * MK_TS_QB;
    const float f = 1.f + sqrtf(ta * 1e-3f);
    for (int i = blockIdx.x * blockDim.x + threadIdx.x; i < 131072; i += gridDim.x * blockDim.x) out[OUT_YS + i] *= f;
    if (blockIdx.x == 0 && threadIdx.x == 0) out[0] += tb * 0.1f;
}
#endif
extern "C" void kernel_launch(void* const* d_in, const int* in_sizes, int n_in, void* d_out, int out_size, void* d_ws, size_t ws_size, hipStream_t stream) {
    (void)hipFuncSetAttribute((const void*)mk_fwd, hipFuncAttributeMaxDynamicSharedMemorySize, LDS_BYTES);
    unsigned char* ws = (unsigned char*)d_ws;
    (void)hipMemsetAsync(ws + WS_CTL, 0, CTL_ZERO_BYTES, stream);
    Args a{};
    for (int i = 0; i < 30; ++i) a.in[i] = d_in[i];
    a.ws = ws; a.out = (float*)d_out;
#if MK_DIAG
    float* diag = (float*)(ws + WS_DIAG);
    (void)hipMemsetAsync(diag, 0, 512, stream);
    nv::forward(d_in, (float*)d_out, (float*)(ws + WS_NAIVE), stream);
    a.out = (float*)(ws + WS_OUT2);
#endif
    static int one_launch = -1;
    if (one_launch < 0) { int dev = 0, cus = 0, per_cu = 0; one_launch = 0;
        if (hipGetDevice(&dev) == hipSuccess && hipDeviceGetAttribute(&cus, hipDeviceAttributeMultiprocessorCount, dev) == hipSuccess && cus >= 256) one_launch = 1;
        (void)per_cu;
        (void)hipGetLastError(); }
    const int grid = 256;
    if (one_launch && MK_ONE_LAUNCH) { a.ph_lo = 0; a.ph_hi = N_PHASES; a.li = 0; hipLaunchKernelGGL(mk_fwd, dim3(grid), dim3(NTHR), LDS_BYTES, stream, a); }
    else for (int ph = 0; ph < N_PHASES; ++ph) { a.ph_lo = ph; a.ph_hi = ph + 1; a.li = ph; hipLaunchKernelGGL(mk_fwd, dim3(grid), dim3(NTHR), LDS_BYTES, stream, a); }
#ifdef MK_TS
    k_ts_encode<<<64, 256, 0, stream>>>((const unsigned long long*)(ws + 600 * MiB), (float*)d_out, MK_TS_A0, MK_TS_A1, MK_TS_B0, MK_TS_B1);
#endif
#if MK_DIAG
    {
        nv::Ws w = nv::carve((float*)(ws + WS_NAIVE));
        const bf16* QRAW = (const bf16*)(ws + WS_QRAW); const bf16* KVRAW = (const bf16*)(ws + WS_KVRAW); const bf16* Q = (const bf16*)(ws + WS_Q); const bf16* K = (const bf16*)(ws + WS_K);
        const bf16* VT = (const bf16*)(ws + WS_VT); const float* VS = (const float*)(ws + WS_VS); const bf16* MIX = (const bf16*)(ws + WS_MIX);
        const float* o2 = (const float*)(ws + WS_OUT2); const float* o1 = (const float*)d_out;
        const float* nQRAW = w.QRAW; const float* nKV = w.KV; const float* nQ = w.Q; const float* nK = w.K; const float* nV = w.V; const float* nMIX = w.MIX;
        const size_t NMR = (size_t)MMAIN + DB;
        cmp(stream, 0, diag, NMR * 768, [=] __device__(size_t i) { return bf2f(QRAW[nmrow(i / 768) * 768 + i % 768]); }, [=] __device__(size_t i) { return nQRAW[nmrow(i / 768) * 768 + i % 768]; });
        cmp(stream, 1, diag, (size_t)R * 1024, [=] __device__(size_t i) { return bf2f(KVRAW[i]); }, [=] __device__(size_t i) { return nKV[i]; });
        cmp(stream, 2, diag, NMR * 768, [=] __device__(size_t i) { return bf2f(Q[nmrow(i / 768) * 768 + i % 768]); }, [=] __device__(size_t i) { return nQ[nmrow(i / 768) * 768 + i % 768] * (ATTN_SCALE * LOG2E); });
        cmp(stream, 3, diag, (size_t)R * 768, [=] __device__(size_t i) { return bf2f(K[i]); }, [=] __device__(size_t i) { return nK[i]; });
        cmp(stream, 4, diag, (size_t)NB * 512 * TT, [=] __device__(size_t i) { const size_t bhd = i / TT; const int t = (int)(i % TT); return bf2f(VT[bhd * TPAD + t]); },
            [=] __device__(size_t i) { const size_t bhd = i / TT; const int t = (int)(i % TT); const size_t b = bhd / 512, hd = bhd % 512; return nV[(b * TT + t) * 512 + hd]; });
        cmp(stream, 4, diag, (size_t)DB * 512, [=] __device__(size_t i) { return VS[i]; }, [=] __device__(size_t i) { return nV[(size_t)RP * 512 + i]; });
        cmp(stream, 5, diag, (size_t)(OUT_LATS - OUT_SSMP), [=] __device__(size_t i) { return o2[OUT_SSMP + i]; }, [=] __device__(size_t i) { return o1[OUT_SSMP + i]; });
        cmp(stream, 5, diag, (size_t)4194304, [=] __device__(size_t i) { return o2[OUT_SSMS + i]; }, [=] __device__(size_t i) { return o1[OUT_SSMS + i]; });
        cmp(stream, 6, diag, (size_t)R * 512, [=] __device__(size_t i) { return bf2f(MIX[(i >> 9) * 1024 + (i & 511)]); }, [=] __device__(size_t i) { return nMIX[(i >> 9) * 1024 + (i & 511)]; });
        cmp(stream, 7, diag, NMR * 512, [=] __device__(size_t i) { return bf2f(MIX[nmrow(i >> 9) * 1024 + 512 + (i & 511)]); }, [=] __device__(size_t i) { return nMIX[nmrow(i >> 9) * 1024 + 512 + (i & 511)]; });
        cmp(stream, 8, diag, (size_t)OUT_LATP, [=] __device__(size_t i) { return o2[i]; }, [=] __device__(size_t i) { return o1[i]; });
        k_diag_encode<<<64, 256, 0, stream>>>(diag, 9, 1e-3f, (float*)d_out);
    }
#endif
}
```

```cpp
#define MK_DIAG 0
#define MK_ONE_LAUNCH 1
#include <hip/hip_runtime.h>
#include <cstdio>
#include <cstdint>
namespace pg8 {
#define PG8_LAS __attribute__((address_space(3)))
typedef unsigned short bf16_t;
typedef short bf16x8 __attribute__((ext_vector_type(8)));
typedef float f32x4 __attribute__((ext_vector_type(4)));
typedef unsigned u32x4 __attribute__((ext_vector_type(4)));
constexpr int BM = 256, BK = 64, HALF = 128, HTB = HALF * BK * 2  , STAGE_BYTES = 8 * HTB, NXCD = 8, WGM = 8;

__host__ __device__ __forceinline__ int lds_byte(int r, int c) { const int st = (r >> 4) * 2 + (c >> 5), rr = r & 15, cc = c & 31, ob = rr * 64 + cc * 2; return st * 1024 + (ob ^ (((ob >> 9) & 1) << 5)); }
__host__ __device__ __forceinline__ void stage_rc(int b, int& R, int& C) { const int st = b / 1024, sb = b % 1024, swz = sb ^ (((sb >> 9) & 1) << 5); R = (st >> 1) * 16 + swz / 64; C = (st & 1) * 32 + (swz % 64) / 2; }
__host__ __device__ __forceinline__ int perm32(int rho) { const int n = rho >> 4, i = rho & 15; return 8 * (i >> 2) + 4 * n + (i & 3); }

struct Unit { int pm, pn; };
template <class E> constexpr bool has_midscale = false;
struct Gemm { const bf16_t* A; const bf16_t* Bt; int M, N, K; int rmode; int lda;
    __host__ __device__ __forceinline__ int rowbase(int pm) const { return rmode ? (pm >> 3) * 2064 + 16 + (pm & 7) * 256 : pm * 256; } };

struct StaticOrder {
    int nM, nN, nwg, G, c;
    __host__ __device__ void init(int M, int N, int G_, int c_) { nM = M / BM; nN = N / BM; nwg = nM * nN; G = G_; c = c_; }
    __host__ __device__ bool next(int i, Unit& u) const {
        const long L = (long)i * G + c; if (L >= nwg) return false;
        int wgid = (int)L; { const int q = nwg / NXCD, r = nwg % NXCD, xcd = wgid % NXCD, off = wgid / NXCD; wgid = (xcd < r ? xcd * (q + 1) : r * (q + 1) + (xcd - r) * q) + off; }
        const int nig = WGM * nN, gid = wgid / nig, fm = gid * WGM, gsz = (nM - fm) < WGM ? (nM - fm) : WGM;
        u.pm = fm + ((wgid % nig) % gsz); u.pn = (wgid % nig) / gsz; return true;
    }
    __device__ __forceinline__ void a_ready(const Unit&) const {}
    __device__ __forceinline__ void done(const Unit&) const {}
};


template <class Epi, class Sched, bool ALIGN_EPI = false, bool SP2 = false, int ROT = 0>
__device__ __forceinline__ void gemm_phase(PG8_LAS unsigned char* lds, const Gemm g, const Sched& S, const Epi& E) {
    const int tid = threadIdx.x, wid = __builtin_amdgcn_readfirstlane(tid >> 6), lane = tid & 63, wr = wid >> 2, wc = wid & 3, fr = lane & 15, fq = lane >> 4;
    const int K = g.K, nt = K / BK;
    unsigned voffA[2], voffB[2];
#pragma unroll
    for (int i = 0; i < 2; ++i) { int R, C; stage_rc(tid * 16 + i * 8192, R, C); const int Rb = Epi::PERM ? ((R & ~31) + perm32(R & 31)) : R;
        voffA[i] = (unsigned)(R * g.lda + C) * 2u; voffB[i] = (unsigned)(Rb * K + C) * 2u; }
    const size_t kstep = (size_t)(BK * 2);
    const size_t hstepA = (size_t)HALF * g.lda * 2;
    const size_t hstep = (size_t)HALF * K * 2;
    const size_t tstep = 2 * hstep;
    const unsigned ldsw = (unsigned)wid * 1024u;
    const int aoff = lds_byte(wr * 64 + fr, fq * 8), boff = lds_byte(wc * 32 + fr, fq * 8);
#define PG8_SA(b, h) (((b) * 2 + (h)) * HTB)
#define PG8_SB(b, h) ((4 + (b) * 2 + (h)) * HTB)
#define PG8_STAGE(bufoff, gbase, voff) do { _Pragma("unroll") for (int _i = 0; _i < 2; ++_i) \
        __builtin_amdgcn_global_load_lds((const unsigned*)((const char*)(gbase) + (voff)[_i]), (PG8_LAS unsigned*)(lds + (bufoff) + ldsw + _i * 8192), 16, 0, 0); } while (0)
#define PG8_LDA(dst, b, h) do { _Pragma("unroll") for (int m = 0; m < 4; ++m) _Pragma("unroll") for (int k = 0; k < 2; ++k) dst[m][k] = *(const PG8_LAS bf16x8*)(lds + PG8_SA(b, h) + aoff + m * 2048 + k * 1024); } while (0)
#define PG8_LDB(dst, b, h) do { _Pragma("unroll") for (int n = 0; n < 2; ++n) _Pragma("unroll") for (int k = 0; k < 2; ++k) dst[n][k] = *(const PG8_LAS bf16x8*)(lds + PG8_SB(b, h) + boff + n * 2048 + k * 1024); } while (0)
#define PG8_MMA(ai, bj, At, Bt) do { __builtin_amdgcn_s_setprio(1); _Pragma("unroll") for (int m = 0; m < 4; ++m) _Pragma("unroll") for (int n = 0; n < 2; ++n) _Pragma("unroll") for (int k = 0; k < 2; ++k) \
        acc[ai][bj][m][n] = __builtin_amdgcn_mfma_f32_16x16x32_bf16(Bt[n][k], At[m][k], acc[ai][bj][m][n], 0, 0, 0); __builtin_amdgcn_s_setprio(0); } while (0)
#define PG8_WAIT_V(n) asm volatile("s_waitcnt vmcnt(" #n ")" ::: "memory")
#define PG8_WAIT_L(n) asm volatile("s_waitcnt lgkmcnt(" #n ")" ::: "memory")
#define PG8_BAR __builtin_amdgcn_s_barrier()
#define PG8_SCHED __builtin_amdgcn_sched_barrier(0)
    Unit cur, nxt; int ui = 0;
    if (!S.next(0, cur)) return;
    f32x4 acc[2][2][4][2];
#pragma unroll
    for (int a = 0; a < 2; ++a)
#pragma unroll
        for (int b = 0; b < 2; ++b)
#pragma unroll
            for (int m = 0; m < 4; ++m)
#pragma unroll
                for (int n = 0; n < 2; ++n) acc[a][b][m][n] = (f32x4){0.f, 0.f, 0.f, 0.f};
    bf16x8 At[4][2], B0[2][2], B1[2][2];
    const char* cA = (const char*)g.A + (size_t)g.rowbase(cur.pm) * g.lda * 2 + ROT * kstep; const char* cB = (const char*)g.Bt + (size_t)cur.pn * tstep + ROT * kstep;
#define PG8_KOFF(j) ((long)((ROT != 0 && (j) >= nt - ROT) ? (j) - nt : (j)) * (long)kstep)
    S.a_ready(cur);
    if constexpr (SP2) {
        PG8_STAGE(PG8_SB(0, 0), cB, voffB); PG8_STAGE(PG8_SB(0, 1), cB + hstep, voffB); PG8_STAGE(PG8_SA(0, 0), cA, voffA); PG8_STAGE(PG8_SA(0, 1), cA + hstepA, voffA);
        if (wr == 1) PG8_BAR;
        PG8_WAIT_V(2); PG8_BAR;
        PG8_STAGE(PG8_SB(1, 0), cB + kstep, voffB); PG8_STAGE(PG8_SA(1, 0), cA + kstep, voffA); PG8_STAGE(PG8_SB(1, 1), cB + hstep + kstep, voffB);
        PG8_WAIT_V(6); PG8_BAR;
    } else {
        PG8_STAGE(PG8_SB(0, 0), cB, voffB); PG8_STAGE(PG8_SA(0, 0), cA, voffA); PG8_STAGE(PG8_SB(0, 1), cB + hstep, voffB); PG8_STAGE(PG8_SA(0, 1), cA + hstepA, voffA);
        if (wr == 1) PG8_BAR;
        PG8_WAIT_V(4); PG8_BAR;
        PG8_STAGE(PG8_SB(1, 0), cB + kstep, voffB); PG8_STAGE(PG8_SA(1, 0), cA + kstep, voffA); PG8_STAGE(PG8_SB(1, 1), cB + hstep + kstep, voffB);
        PG8_WAIT_V(6); PG8_BAR;
    }
    for (;;) {
        const bool has_next = S.next(ui + 1, nxt);
        const char* nA = has_next ? (const char*)g.A + (size_t)g.rowbase(nxt.pm) * g.lda * 2 + ROT * kstep : cA; const char* nB = has_next ? (const char*)g.Bt + (size_t)nxt.pn * tstep + ROT * kstep : cB;
        for (int t = 0; t < nt; t += 2) {
            const bool last = (t == nt - 2);
            const char* a1 = cA + PG8_KOFF(t + 1);
            const char* a2 = last ? nA : cA + PG8_KOFF(t + 2); const char* b2 = last ? nB : cB + PG8_KOFF(t + 2);
            if constexpr (has_midscale<Epi>) { if (t == nt - ROT) E.midscale(acc, cur, wr, fr); }
            const char* a3 = a2 + kstep; const char* b3 = b2 + kstep;
            if (last && has_next) S.a_ready(nxt);
            if constexpr (SP2) {
            PG8_LDB(B0, 0, 0); PG8_LDB(B1, 0, 1); PG8_SCHED; PG8_LDA(At, 0, 0); PG8_STAGE(PG8_SA(1, 1), a1 + hstepA, voffA);
            PG8_WAIT_V(8); PG8_WAIT_L(0); PG8_BAR; PG8_MMA(0, 0, At, B0); PG8_MMA(0, 1, At, B1); PG8_BAR; PG8_SCHED;
            PG8_LDA(At, 0, 1); PG8_STAGE(PG8_SB(0, 0), b2, voffB); PG8_STAGE(PG8_SB(0, 1), b2 + hstep, voffB); PG8_STAGE(PG8_SA(0, 0), a2, voffA);
            PG8_WAIT_V(8); PG8_WAIT_L(0); PG8_BAR; PG8_MMA(1, 0, At, B0); PG8_MMA(1, 1, At, B1); PG8_BAR; PG8_SCHED;
            PG8_LDB(B0, 1, 0); PG8_LDB(B1, 1, 1); PG8_SCHED; PG8_LDA(At, 1, 0); PG8_STAGE(PG8_SA(0, 1), a2 + hstepA, voffA);
            PG8_WAIT_V(8); PG8_WAIT_L(0); PG8_BAR; PG8_MMA(0, 0, At, B0); PG8_MMA(0, 1, At, B1); PG8_BAR; PG8_SCHED;
            PG8_LDA(At, 1, 1); PG8_STAGE(PG8_SB(1, 0), b3, voffB); PG8_STAGE(PG8_SB(1, 1), b3 + hstep, voffB); PG8_STAGE(PG8_SA(1, 0), a3, voffA);
            PG8_WAIT_V(8); PG8_WAIT_L(0); PG8_BAR; PG8_MMA(1, 0, At, B0); PG8_MMA(1, 1, At, B1); PG8_BAR; PG8_SCHED;
            } else {
            PG8_LDB(B0, 0, 0); PG8_SCHED; PG8_LDA(At, 0, 0); PG8_STAGE(PG8_SA(1, 1), a1 + hstepA, voffA);
            PG8_WAIT_L(8); PG8_BAR; PG8_WAIT_L(0); PG8_MMA(0, 0, At, B0); PG8_BAR; PG8_SCHED;
            PG8_LDB(B1, 0, 1); PG8_STAGE(PG8_SB(0, 0), b2, voffB);
            PG8_BAR; PG8_WAIT_L(0); PG8_MMA(0, 1, At, B1); PG8_BAR;
            PG8_LDA(At, 0, 1); PG8_STAGE(PG8_SA(0, 0), a2, voffA);
            PG8_BAR; PG8_WAIT_L(0); PG8_MMA(1, 0, At, B0); PG8_BAR; PG8_SCHED;
            PG8_STAGE(PG8_SB(0, 1), b2 + hstep, voffB);
            PG8_WAIT_V(6); PG8_BAR; PG8_MMA(1, 1, At, B1); PG8_BAR;
            PG8_LDB(B0, 1, 0); PG8_SCHED; PG8_LDA(At, 1, 0); PG8_STAGE(PG8_SA(0, 1), a2 + hstepA, voffA);
            PG8_WAIT_L(8); PG8_BAR; PG8_WAIT_L(0); PG8_MMA(0, 0, At, B0); PG8_BAR; PG8_SCHED;
            PG8_LDB(B1, 1, 1); PG8_STAGE(PG8_SB(1, 0), b3, voffB);
            PG8_BAR; PG8_WAIT_L(0); PG8_MMA(0, 1, At, B1); PG8_BAR;
            PG8_LDA(At, 1, 1); PG8_STAGE(PG8_SA(1, 0), a3, voffA);
            PG8_BAR; PG8_WAIT_L(0); PG8_MMA(1, 0, At, B0); PG8_BAR; PG8_SCHED;
            PG8_STAGE(PG8_SB(1, 1), b3 + hstep, voffB);
            PG8_WAIT_V(6); PG8_BAR; PG8_MMA(1, 1, At, B1); PG8_BAR;
            }
        }
        if constexpr (ALIGN_EPI) { if (wr == 0) PG8_BAR; }
        if constexpr (!Epi::AFTER_DRAIN) { E(acc, cur, wr, wc, fr, fq); S.done(cur); }
        if (!has_next) break;
#pragma unroll
        for (int a = 0; a < 2; ++a)
#pragma unroll
            for (int b = 0; b < 2; ++b)
#pragma unroll
                for (int m = 0; m < 4; ++m)
#pragma unroll
                    for (int n = 0; n < 2; ++n) acc[a][b][m][n] = (f32x4){0.f, 0.f, 0.f, 0.f};
        cur = nxt; cA = nA; cB = nB; ++ui;
        if constexpr (ALIGN_EPI) { if (wr == 1) PG8_BAR; }
    }
    PG8_WAIT_V(0);
    if constexpr (!ALIGN_EPI) { if (wr == 0) PG8_BAR; }
    PG8_BAR;
    if constexpr (Epi::AFTER_DRAIN) { E.fused(acc, cur, wr, wc, fr, fq, lds, wid, lane); S.done(cur); }
#undef PG8_KOFF
#undef PG8_SA
#undef PG8_SB
#undef PG8_STAGE
#undef PG8_LDA
#undef PG8_LDB
#undef PG8_MMA
#undef PG8_WAIT_V
#undef PG8_WAIT_L
#undef PG8_BAR
#undef PG8_SCHED
}
}

#define GAS __attribute__((address_space(1)))
#define LAS __attribute__((address_space(3)))
typedef unsigned short bf16;
typedef unsigned v4u __attribute__((ext_vector_type(4)));
typedef unsigned v2u __attribute__((ext_vector_type(2)));
typedef float f32x4 __attribute__((ext_vector_type(4)));
typedef float f32x16 __attribute__((ext_vector_type(16)));
typedef short bf16x8 __attribute__((ext_vector_type(8)));
typedef short s16x4 __attribute__((ext_vector_type(4)));
typedef GAS unsigned gu32;
#define RLX_AGENT __ATOMIC_RELAXED, __HIP_MEMORY_SCOPE_AGENT
#define LDS_WAIT() asm volatile("s_waitcnt lgkmcnt(0)" ::: "memory")
#define VM_WAIT() asm volatile("s_waitcnt vmcnt(0)" ::: "memory")
typedef float f32x2_t __attribute__((ext_vector_type(2))); typedef __bf16 bf16x2_t __attribute__((ext_vector_type(2)));
__device__ __forceinline__ unsigned pk2(float lo, float hi) { f32x2_t v = {lo, hi}; bf16x2_t b = __builtin_convertvector(v, bf16x2_t); return __builtin_bit_cast(unsigned, b); }
__device__ __forceinline__ bf16 f2bf(float f) { return (bf16)(pk2(f, 0.f) & 0xffffu); }
__device__ __forceinline__ float bf2f(bf16 v) { return __uint_as_float((unsigned)v << 16); }
__device__ __forceinline__ float bflo(unsigned w) { return __uint_as_float(w << 16); }
__device__ __forceinline__ float bfhi(unsigned w) { return __uint_as_float(w & 0xffff0000u); }

#define XB_TMO      128
#define XB_XCNT(j)  (256  + 64 * (j))
#define XB_XSUB(j)  (1280 + 64 * (j))
#define XB_XGEN(j)  (2304 + 64 * (j))
#define XB_TOP      3328
#define XB_TOPGEN   3392
#define XCD_BAR_WORDS 3456
#define XB_SPIN_CAP (1u << 18)
__device__ __forceinline__ unsigned xb_ld(unsigned* p)              { return __hip_atomic_load(p, __ATOMIC_RELAXED, __HIP_MEMORY_SCOPE_AGENT); }
__device__ __forceinline__ unsigned xb_add(unsigned* p, unsigned v) { return __hip_atomic_fetch_add(p, v, __ATOMIC_RELAXED, __HIP_MEMORY_SCOPE_AGENT); }
__device__ __forceinline__ unsigned xb_xcc_id() { return (unsigned)__builtin_amdgcn_s_getreg((3 << 11) | 20) & 0xFu; }
#define XB_SPIN(cond, bar) do { unsigned _sp = 0; while (cond) { __builtin_amdgcn_s_sleep(1); \
    if ((++_sp & 255u) == 0u) { if (xb_ld(&(bar)[XB_TMO])) break; if (_sp > XB_SPIN_CAP) { atomicAdd(&(bar)[XB_TMO], 1u); break; } } } } while (0)
struct XcdBarrier { unsigned* bar; unsigned x; volatile LAS unsigned* st; };
__device__ __forceinline__ XcdBarrier xcd_barrier_post(unsigned* bar, volatile LAS unsigned* st) {
    XcdBarrier b; b.bar = bar; b.x = xb_xcc_id(); b.st = st;
    if (threadIdx.x == 0) (void)xb_add(&bar[XB_XCNT(b.x)], 1u);
    return b;
}
__device__ __forceinline__ void xcd_barrier_complete(unsigned* bar, unsigned x, unsigned& nloc, unsigned& nx) {
    const unsigned G = gridDim.x * gridDim.y * gridDim.z;
    unsigned sum, cnt, mine, sp = 0u;
    for (;;) {
        sum = 0u; cnt = 0u; mine = 0u;
#pragma unroll
        for (unsigned j = 0; j < 16; ++j) { const unsigned c = xb_ld(&bar[XB_XCNT(j)]); sum += c; cnt += (c > 0u) ? 1u : 0u; mine = (j == x) ? c : mine; }
        if (sum == G) break;
        __builtin_amdgcn_s_sleep(1);
        if ((++sp & 255u) == 0u) { if (xb_ld(&bar[XB_TMO])) break; if (sp > XB_SPIN_CAP) { atomicAdd(&bar[XB_TMO], 1u); break; } }
    }
    nloc = mine > 0u ? mine : 1u; nx = cnt > 0u ? cnt : 1u;
}
__device__ __forceinline__ void xcd_barrier(const XcdBarrier& b) {
    asm volatile("s_waitcnt vmcnt(0)" ::: "memory");
    __syncthreads();
    if (threadIdx.x == 0) {
        unsigned* bar = b.bar;
        __builtin_amdgcn_s_waitcnt(0);
        unsigned nloc = b.st[0], nx = b.st[1];
        if (nloc == 0u) { xcd_barrier_complete(bar, b.x, nloc, nx); b.st[0] = nloc; b.st[1] = nx; }
        const unsigned old = xb_add(&bar[XB_XSUB(b.x)], 1u);
        const unsigned gen = old / nloc;
        if (old + 1u == (gen + 1u) * nloc) {
            __builtin_amdgcn_fence(__ATOMIC_RELEASE, "agent");
            asm volatile("s_waitcnt vmcnt(0)" ::: "memory");
            (void)xb_add(&bar[XB_TOP], 1u);
        }
        XB_SPIN(xb_ld(&bar[XB_TOP]) < (gen + 1u) * nx, bar);
        __builtin_amdgcn_fence(__ATOMIC_ACQUIRE, "agent");
        asm volatile("s_waitcnt vmcnt(0)" ::: "memory");
    }
    __syncthreads();
}

constexpr int DM = 1024, NB = 8, SEQ = 2048, NMETA = 16, TT = SEQ + NMETA;
constexpr int DB = 128, PAST = 8192, PAGE = 128, NPAGES = 64;
constexpr int NH = 8, HP = 64, SSDW = 512, NG = 2, DS = 64, CONVD = 768;
constexpr int QKD = 96, VD = 64, MLAW = 512, QL = 384, KVL = 256, DFF = 2816, INC = 1960;
constexpr int RP = NB * TT, R = RP + DB;
constexpr int MMAIN = NB * SEQ;
constexpr int NS = NMETA + DB;
constexpr float EPS = 1e-6f, ATTN_SCALE = 0.10206207261596577f, LOG2E = 1.4426950408889634f;
constexpr int PJ = 2048, C_Z = 0, C_XBC = 512, C_CKV = 1280, C_CQ = 1536, C_DT = 1920, C_KR = 1928;
constexpr int S_Z = 0, S_XBC = 512, S_DT = 1280, S_CQ = 1288, S_CKV = 1672, S_KR = 1928;
constexpr int TPAD = 2112;
constexpr int NCH = 33, CHL = 64, TOFF = 48;
constexpr size_t OUT_YP = 0, OUT_YS = 16777216, OUT_LATP = 16908288, OUT_KRP = 21135360, OUT_CONVP = 21663744,
                 OUT_SSMP = 21682176, OUT_LATS = 21944320, OUT_KRS = 21977088, OUT_CONVS = 21981184, OUT_SSMS = 22276096;

constexpr size_t MiB = 1u << 20;
constexpr size_t WS_CTL = 0, CTL_ZERO_BYTES = 32 * 1024;
constexpr int CW_BAR = 4096;
constexpr size_t WS_SS = 512 * 1024;
constexpr size_t WS_WIN = 2 * MiB;
constexpr size_t WS_WUQ = 6 * MiB;
constexpr size_t WS_WUKV = 7 * MiB;
constexpr size_t WS_WOUT = 8 * MiB;
constexpr size_t WS_WGU = 10 * MiB;
constexpr size_t WS_WDN = 22 * MiB;
constexpr size_t WS_XN = 32 * MiB;
constexpr size_t WS_PROJ = 66 * MiB;
constexpr size_t WS_DTRAW = 132 * MiB;
constexpr size_t WS_DT = 133 * MiB;
constexpr size_t WS_LAT = 134 * MiB;
constexpr size_t WS_CQN = 143 * MiB;
constexpr size_t WS_KRF = 156 * MiB;
constexpr size_t WS_XST = 159 * MiB;
constexpr size_t WS_BT = 176 * MiB;
constexpr size_t WS_BC = 181 * MiB;
constexpr size_t WS_XAS = 190 * MiB;
constexpr size_t WS_QRAW = 191 * MiB;
constexpr size_t WS_KVRAW = 216 * MiB;
constexpr size_t WS_Q = 249 * MiB;
constexpr size_t WS_K = 274 * MiB;
constexpr size_t WS_VT = 299 * MiB;
constexpr size_t WS_STATES = 316 * MiB;
constexpr size_t WS_DECAY = 350 * MiB;
constexpr size_t WS_HIN = 351 * MiB;
constexpr size_t WS_MIX = 368 * MiB;
constexpr size_t WS_ACT = 401 * MiB;
constexpr size_t WS_VS = 491 * MiB;
constexpr size_t WS_DPART = 492 * MiB;
constexpr size_t WS_HS = 494 * MiB;
constexpr size_t WS_ROPE = 496 * MiB;
constexpr size_t WS_SSP = 520 * MiB;
constexpr size_t WS_WUKV2 = 524 * MiB;
constexpr size_t WS_RQ = 522 * MiB;
constexpr size_t WS_SSQ = 526 * MiB;
constexpr size_t WS_OPT_END = 527 * MiB;
constexpr int CW_DCNT = 1024;
constexpr size_t WS_NAIVE = 2048 * MiB;
constexpr size_t WS_DIAG = 1 * MiB;

constexpr int RING_OFF = 0, RING_BYTES = 131072;
constexpr int LDSCTL_OFF = RING_BYTES, MISC_OFF = LDSCTL_OFF + 320;
constexpr int LDS_BYTES = 163840;
constexpr int NWAVES = 8, NTHR = 512;

struct Args { const void* in[30]; float* out; unsigned char* ws; int ph_lo, ph_hi, li, pad; };

struct Frame {
    LAS unsigned char* lds;
    int tid, lane, wave, G, vcu, gw, NGW;
    unsigned char* ws; float* out;
    const void* const* in;
};
#define DPP_F(x, ctrl) __builtin_bit_cast(float, __builtin_amdgcn_update_dpp(0, __builtin_bit_cast(int, (x)), (ctrl), 0xF, 0xF, true))
__device__ __forceinline__ float sum_x1(float x) { return x + DPP_F(x, 0xB1); }
__device__ __forceinline__ float sum_x2(float x) { return x + DPP_F(x, 0x4E); }
__device__ __forceinline__ float sum_x4(float x) { return x + DPP_F(x, 0x141); }
__device__ __forceinline__ float sum_x8(float x) { return x + DPP_F(x, 0x140); }
__device__ __forceinline__ float sum_x16(float x) { const unsigned u = __builtin_bit_cast(unsigned, x); const auto r = __builtin_amdgcn_permlane16_swap(u, u, false, false); return __uint_as_float(r[0]) + __uint_as_float(r[1]); }
__device__ __forceinline__ float sum_x32(float x) { const unsigned u = __builtin_bit_cast(unsigned, x); const auto r = __builtin_amdgcn_permlane32_swap(u, u, false, false); return __uint_as_float(r[0]) + __uint_as_float(r[1]); }
__device__ __forceinline__ float wave_sum(float v) { return sum_x32(sum_x16(sum_x8(sum_x4(sum_x2(sum_x1(v)))))); }
__device__ __forceinline__ float wave_max(float v) {
#pragma unroll
    for (int o = 1; o < 64; o <<= 1) v = fmaxf(v, __shfl_xor(v, o));
    return v;
}
__device__ __forceinline__ float silu_f(float x) { return x * __builtin_amdgcn_rcpf(1.f + __expf(-x)); }
__device__ __forceinline__ float softplus_f(float x) { return fmaxf(x, 0.f) + log1pf(expf(-fabsf(x))); }
__device__ __forceinline__ float rope_inv(int j) { return exp2f(-(float)j * (13.287712379549449f / 16.0f)); }
struct EpiProj {
    static constexpr bool PERM = true, AFTER_DRAIN = false;
    bf16* O; float* dtraw; int rmode;
    __device__ __forceinline__ void operator()(const pg8::f32x4 (&acc)[2][2][4][2], const pg8::Unit& u, int wr, int wc, int fr, int fq) const {
        const int rb = rmode ? (u.pm >> 3) * 2064 + 16 + (u.pm & 7) * 256 : u.pm * 256;
        const int row0 = rb + wr * 64 + fr, col0 = u.pn * 256 + wc * 32 + 8 * fq;
#pragma unroll
        for (int ai = 0; ai < 2; ++ai)
#pragma unroll
            for (int m = 0; m < 4; ++m) { const int row = row0 + ai * 128 + m * 16; bf16* rowp = O + (size_t)row * PJ + col0;
#pragma unroll
                for (int bj = 0; bj < 2; ++bj) { const pg8::f32x4 v0 = acc[ai][bj][m][0], v1 = acc[ai][bj][m][1];
                    v4u w; w.x = pk2(v0[0], v0[1]); w.y = pk2(v0[2], v0[3]); w.z = pk2(v1[0], v1[1]); w.w = pk2(v1[2], v1[3]);
                    *(v4u*)(rowp + bj * 128) = w; }
                if (u.pn == 7 && wc == 0 && fq == 0) { *(pg8::f32x4*)(dtraw + (size_t)row * 8) = acc[ai][1][m][0]; *(pg8::f32x4*)(dtraw + (size_t)row * 8 + 4) = acc[ai][1][m][1]; } }
    }
};
struct EpiBf16 {
    static constexpr bool PERM = true, AFTER_DRAIN = false;
    bf16* O; int ldc; int rmode;
    __device__ __forceinline__ void operator()(const pg8::f32x4 (&acc)[2][2][4][2], const pg8::Unit& u, int wr, int wc, int fr, int fq) const {
        const int rb = rmode ? (u.pm >> 3) * 2064 + 16 + (u.pm & 7) * 256 : u.pm * 256;
        const int row0 = rb + wr * 64 + fr, col0 = u.pn * 256 + wc * 32 + 8 * fq;
#pragma unroll
        for (int ai = 0; ai < 2; ++ai)
#pragma unroll
            for (int m = 0; m < 4; ++m) { bf16* rowp = O + (size_t)(row0 + ai * 128 + m * 16) * ldc + col0;
#pragma unroll
                for (int bj = 0; bj < 2; ++bj) { const pg8::f32x4 v0 = acc[ai][bj][m][0], v1 = acc[ai][bj][m][1];
                    v4u w; w.x = pk2(v0[0], v0[1]); w.y = pk2(v0[2], v0[3]); w.z = pk2(v1[0], v1[1]); w.w = pk2(v1[2], v1[3]);
                    *(v4u*)(rowp + bj * 128) = w; } }
    }
};
struct EpiResF32 {
    static constexpr bool PERM = false, AFTER_DRAIN = false;
    const float* res; float* out;
    __device__ __forceinline__ void operator()(const pg8::f32x4 (&acc)[2][2][4][2], const pg8::Unit& u, int wr, int wc, int fr, int fq) const {
        const int row0 = u.pm * 256 + wr * 64 + fr, col0 = u.pn * 256 + wc * 32 + 4 * fq;
#pragma unroll
        for (int ai = 0; ai < 2; ++ai)
#pragma unroll
            for (int m = 0; m < 4; ++m) { const size_t off = (size_t)(row0 + ai * 128 + m * 16) * DM + col0;
#pragma unroll
                for (int bj = 0; bj < 2; ++bj)
#pragma unroll
                    for (int n = 0; n < 2; ++n) { const pg8::f32x4 r = *(const pg8::f32x4*)(res + off + bj * 128 + n * 16); *(pg8::f32x4*)(out + off + bj * 128 + n * 16) = r + acc[ai][bj][m][n]; } }
    }
};
struct EpiOutProj {
    static constexpr bool PERM = false, AFTER_DRAIN = false;
    const float* res; float* out; bf16* HB; float* SS; const LAS float* RS; mutable int nth;
    __device__ __forceinline__ void midscale(pg8::f32x4 (&acc)[2][2][4][2], const pg8::Unit& u, int wr, int fr) const {
        const int slot = nth++;
        const LAS float* rsp = RS + slot * 256 + wr * 64 + fr;
#pragma unroll
        for (int ai = 0; ai < 2; ++ai)
#pragma unroll
            for (int m = 0; m < 4; ++m) { const float rs = rsp[ai * 128 + m * 16];
#pragma unroll
                for (int bj = 0; bj < 2; ++bj)
#pragma unroll
                    for (int n = 0; n < 2; ++n) acc[ai][bj][m][n] *= rs; }
    }
    __device__ __forceinline__ void operator()(const pg8::f32x4 (&acc)[2][2][4][2], const pg8::Unit& u, int wr, int wc, int fr, int fq) const {
        const int rb = (u.pm >> 3) * 2064 + 16 + (u.pm & 7) * 256;
        const int row0 = u.pm * 256 + wr * 64 + fr, col0 = u.pn * 256 + wc * 32 + 4 * fq;
        pg8::f32x4 rc[4], rn[4];
#define EOP_LOAD(dst, g) do { const size_t off_ = (size_t)(row0 + ((g) >> 2) * 128 + ((g) & 3) * 16) * DM + col0; \
            dst[0] = *(const pg8::f32x4*)(res + off_); dst[1] = *(const pg8::f32x4*)(res + off_ + 16); dst[2] = *(const pg8::f32x4*)(res + off_ + 128); dst[3] = *(const pg8::f32x4*)(res + off_ + 144); } while (0)
        EOP_LOAD(rc, 0);
#pragma unroll
        for (int g = 0; g < 8; ++g) { const int ai = g >> 2, m = g & 3;
            if (g < 7) EOP_LOAD(rn, g + 1);
            const int orow = row0 + ai * 128 + m * 16; bf16* hb = HB + (size_t)(rb + wr * 64 + fr + ai * 128 + m * 16) * DM + col0; float ss = 0.f;
#pragma unroll
            for (int bj = 0; bj < 2; ++bj)
#pragma unroll
                for (int n = 0; n < 2; ++n) { const pg8::f32x4 v = rc[2 * bj + n] + acc[ai][bj][m][n];
                    ss += (v[0] * v[0] + v[1] * v[1]) + (v[2] * v[2] + v[3] * v[3]); v2u w; w.x = pk2(v[0], v[1]); w.y = pk2(v[2], v[3]); *(v2u*)(hb + bj * 128 + n * 16) = w; }
            ss = sum_x16(ss); ss = sum_x32(ss);
            if (fq == 0) SS[(size_t)orow * 16 + u.pn * 4 + wc] = ss;
#pragma unroll
            for (int i = 0; i < 4; ++i) rc[i] = rn[i]; }
#undef EOP_LOAD
    }
};
namespace pg8 { template <> constexpr bool has_midscale<EpiOutProj> = true; }
struct EpiDown {
    static constexpr bool PERM = false, AFTER_DRAIN = false;
    const bf16* HB; float* out;
    __device__ __forceinline__ void operator()(const pg8::f32x4 (&acc)[2][2][4][2], const pg8::Unit& u, int wr, int wc, int fr, int fq) const {
        const int rb = (u.pm >> 3) * 2064 + 16 + (u.pm & 7) * 256;
        const int row0 = u.pm * 256 + wr * 64 + fr, col0 = u.pn * 256 + wc * 32 + 4 * fq;
        v2u rc[4], rn[4];
#define EDN_LOAD(dst, g) do { const bf16* hb_ = HB + (size_t)(rb + wr * 64 + fr + ((g) >> 2) * 128 + ((g) & 3) * 16) * DM + col0; \
            dst[0] = *(const v2u*)(hb_); dst[1] = *(const v2u*)(hb_ + 16); dst[2] = *(const v2u*)(hb_ + 128); dst[3] = *(const v2u*)(hb_ + 144); } while (0)
        EDN_LOAD(rc, 0);
#pragma unroll
        for (int g = 0; g < 8; ++g) { const int ai = g >> 2, m = g & 3;
            if (g < 7) EDN_LOAD(rn, g + 1);
            const size_t off = (size_t)(row0 + ai * 128 + m * 16) * DM + col0;
#pragma unroll
            for (int bj = 0; bj < 2; ++bj)
#pragma unroll
                for (int n = 0; n < 2; ++n) { const v2u w = rc[2 * bj + n]; const pg8::f32x4 r = {bflo(w.x), bfhi(w.x), bflo(w.y), bfhi(w.y)}; *(pg8::f32x4*)(out + off + bj * 128 + n * 16) = r + acc[ai][bj][m][n]; }
#pragma unroll
            for (int i = 0; i < 4; ++i) rc[i] = rn[i]; }
#undef EDN_LOAD
    }
};
struct EpiSwiGLU {
    static constexpr bool PERM = true, AFTER_DRAIN = false;
    bf16* O; const LAS float* RS; mutable int nth;
    __device__ __forceinline__ void operator()(const pg8::f32x4 (&acc)[2][2][4][2], const pg8::Unit& u, int wr, int wc, int fr, int fq) const {
        const int rb = (u.pm >> 3) * 2064 + 16 + (u.pm & 7) * 256;
        const int row0 = rb + wr * 64 + fr, col0 = u.pn * 128 + wc * 32 + 8 * fq;
        const int slot = nth++;
        const LAS float* rsp = RS + slot * 256 + wr * 64 + fr;
#pragma unroll
        for (int ai = 0; ai < 2; ++ai)
#pragma unroll
            for (int m = 0; m < 4; ++m) { float a[8]; const float rs = rsp[ai * 128 + m * 16];
#pragma unroll
                for (int n = 0; n < 2; ++n)
#pragma unroll
                    for (int e = 0; e < 4; ++e) a[4 * n + e] = silu_f(rs * acc[ai][0][m][n][e]) * (rs * acc[ai][1][m][n][e]);
                v4u w; w.x = pk2(a[0], a[1]); w.y = pk2(a[2], a[3]); w.z = pk2(a[4], a[5]); w.w = pk2(a[6], a[7]);
                *(v4u*)(O + (size_t)(row0 + ai * 128 + m * 16) * DFF + col0) = w; }
    }
};

template <class ARow, class Epi>
__device__ __forceinline__ void small_gemm(const bf16* A, int lda, const bf16* Bt, int K, int nrt, int nct, const ARow& arow, const Epi& E, int gw, int NGW, int lane, int ksplit = 1) {
    const int ntask = nrt * nct * ksplit, kc = K / ksplit;
    for (int task = gw; task < ntask; task += NGW) {
        const int rt = task % nrt, ct = (task / nrt) % nct, kq = task / (nrt * nct);
        const bf16* ap = A + (size_t)arow(rt * 16 + (lane & 15)) * lda + kq * kc + 8 * (lane >> 4);
        const bf16* bp = Bt + (size_t)(ct * 16 + (lane & 15)) * K + kq * kc + 8 * (lane >> 4);
        f32x4 acc = {0.f, 0.f, 0.f, 0.f};
#pragma unroll 1
        for (int k0 = 0; k0 < kc; k0 += 32 * 11) {
            bf16x8 av[11], bv[11];
#pragma unroll
            for (int j = 0; j < 11; ++j) if (k0 + 32 * j < kc) { av[j] = *(const bf16x8*)(ap + k0 + 32 * j); bv[j] = *(const bf16x8*)(bp + k0 + 32 * j); }
#pragma unroll
            for (int j = 0; j < 11; ++j) if (k0 + 32 * j < kc) acc = __builtin_amdgcn_mfma_f32_16x16x32_bf16(av[j], bv[j], acc, 0, 0, 0);
        }
        E(acc, rt, ct, lane);
    }
}

template <class RM>
__device__ __forceinline__ void transpose_item(const float* W, int N, int ldw, bf16* WT, int ldt, int item, LAS float* scr, int lane, const RM& rm, const float* kscale = nullptr) {
    const int nblk = (N + 31) / 32, kb = item / nblk, nb = item % nblk, k0 = 64 * kb, n0 = 32 * nb;
    { const int n = n0 + (lane & 31); float v[32];
#pragma unroll
      for (int i = 0; i < 32; ++i) { const int kk = 2 * i + (lane >> 5); v[i] = (n < N) ? W[(size_t)(k0 + kk) * ldw + n] : 0.f; }
#pragma unroll
      for (int i = 0; i < 32; ++i) { const int kk = 2 * i + (lane >> 5); float x = v[i]; if (kscale) x *= kscale[k0 + kk]; scr[kk * 33 + (lane & 31)] = x; } }
    LDS_WAIT(); asm volatile("" ::: "memory");
    const int c = lane & 7;
#pragma unroll
    for (int j = 0; j < 4; ++j) { const int n = (lane >> 3) + 8 * j; const LAS float* s = scr + (8 * c) * 33 + n;
        if (n0 + n < N) { v4u o; o.x = pk2(s[0 * 33], s[1 * 33]); o.y = pk2(s[2 * 33], s[3 * 33]); o.z = pk2(s[4 * 33], s[5 * 33]); o.w = pk2(s[6 * 33], s[7 * 33]);
            *(v4u*)(WT + (size_t)rm(n0 + n) * ldt + k0 + 8 * c) = o; } }
    LDS_WAIT(); asm volatile("" ::: "memory");
}
__device__ __forceinline__ int map_in(int n) {
    return n < S_DT ? n : n < S_CQ ? C_DT + (n - S_DT) : n < S_CKV ? C_CQ + (n - S_CQ) : n < S_KR ? C_CKV + (n - S_CKV) : n;
}
__device__ __forceinline__ void p0_prologue(Frame& F) {
    LAS float* scr = (LAS float*)(F.lds + RING_OFF + F.wave * 16384);
    const float* w_in = (const float*)F.in[9]; const float* w_uq = (const float*)F.in[17]; const float* w_ukv = (const float*)F.in[19]; const float* w_out = (const float*)F.in[25];
    const float* w_gate = (const float*)F.in[27]; const float* w_up = (const float*)F.in[28]; const float* w_down = (const float*)F.in[29];
    bf16* WIN = (bf16*)(F.ws + WS_WIN); bf16* WUQ = (bf16*)(F.ws + WS_WUQ); bf16* WUKV = (bf16*)(F.ws + WS_WUKV); bf16* WOUT = (bf16*)(F.ws + WS_WOUT); bf16* WGU = (bf16*)(F.ws + WS_WGU); bf16* WDN = (bf16*)(F.ws + WS_WDN);
    const float* ffg = (const float*)F.in[26];
    constexpr int I_IN = 16 * 62, I_UQ = 6 * 24, I_UKV = 4 * 32, I_OUT = 16 * 32;
    constexpr int NITEMS = I_IN + I_UQ + 2 * I_UKV + I_OUT;
    bf16* WUKV2 = (bf16*)(F.ws + WS_WUKV2);
    for (int it = F.gw; it < NITEMS; it += F.NGW) {
        int r = it;
        if (r < I_IN) { transpose_item(w_in, INC, INC, WIN, DM, r, scr, F.lane, [](int n) { return map_in(n); }); continue; } r -= I_IN;
        if (r < I_UQ) { transpose_item(w_uq, 768, 768, WUQ, QL, r, scr, F.lane, [](int n) { return n; }, (const float*)F.in[16]); continue; } r -= I_UQ;
        if (r < I_UKV) { transpose_item(w_ukv, 1024, 1024, WUKV, KVL, r, scr, F.lane, [](int n) { return n; }, (const float*)F.in[18]); continue; } r -= I_UKV;
        if (r < I_UKV) { transpose_item(w_ukv, 1024, 1024, WUKV2, KVL, r, scr, F.lane, [](int n) { return n; }); continue; } r -= I_UKV;
        transpose_item(w_out, DM, DM, WOUT, 1024, r, scr, F.lane, [](int n) { return n; }, (r >= 8 * 32) ? (const float*)F.in[24] - 512 : nullptr);
    }
    for (int i = F.gw * 64 + F.lane; i < 88 * 1024 / 8; i += F.NGW * 64) *(v4u*)(WIN + (size_t)1960 * 1024 + (size_t)i * 8) = (v4u){0u, 0u, 0u, 0u};
    const float* xp = (const float*)F.in[0]; const float* xs = (const float*)F.in[1]; const float* meta = (const float*)F.in[7]; const float* g = (const float*)F.in[8];
    bf16* XN = (bf16*)(F.ws + WS_XN);
    f32x4 gv[4];
#pragma unroll
    for (int j = 0; j < 4; ++j) gv[j] = ((const f32x4*)g)[F.lane + 64 * j];
#define XN_ROWS(r0, n) do { f32x4 v[4][4]; \
        _Pragma("unroll") for (int i = 0; i < 4; ++i) if (i < (n)) { const int row = (r0) + i; const float* src; \
            if (row < RP) { const int b = row / TT, t = row % TT; src = (t < NMETA) ? meta + (size_t)t * DM : xp + ((size_t)b * SEQ + (t - NMETA)) * DM; } else src = xs + (size_t)(row - RP) * DM; \
            _Pragma("unroll") for (int j = 0; j < 4; ++j) v[i][j] = ((const f32x4*)src)[F.lane + 64 * j]; } \
        _Pragma("unroll") for (int i = 0; i < 4; ++i) if (i < (n)) { float s = 0.f; \
            _Pragma("unroll") for (int j = 0; j < 4; ++j) s += (v[i][j].x * v[i][j].x + v[i][j].y * v[i][j].y) + (v[i][j].z * v[i][j].z + v[i][j].w * v[i][j].w); \
            const float rs = __builtin_amdgcn_rsqf(wave_sum(s) * (1.f / DM) + EPS); \
            v2u* o8 = (v2u*)(XN + (size_t)((r0) + i) * DM) + F.lane; \
            _Pragma("unroll") for (int j = 0; j < 4; ++j) { v2u o; o.x = pk2(v[i][j].x * rs * gv[j].x, v[i][j].y * rs * gv[j].y); o.y = pk2(v[i][j].z * rs * gv[j].z, v[i][j].w * rs * gv[j].w); o8[64 * j] = o; } } } while (0)
    if (F.NGW == 2048) { XN_ROWS(4 * F.gw, 4); XN_ROWS(8192 + 4 * F.gw, 4); if (F.gw < 256) XN_ROWS(16384 + F.gw, 1); }
    else for (int r0 = 4 * F.gw; r0 < R; r0 += 4 * F.NGW) XN_ROWS(r0, 4);
#undef XN_ROWS
    float* ROPE = (float*)(F.ws + WS_ROPE);
    for (int i = blockIdx.x * NTHR + F.tid; i < (TT + 1) * 16; i += F.G * NTHR) { const int p = i >> 4, j = i & 15; const float ang = (float)(p < TT ? p : PAST) * rope_inv(j); ROPE[2 * i] = cosf(ang); ROPE[2 * i + 1] = sinf(ang); }
}

__device__ __forceinline__ void p1_ffn_weights(Frame& F, int w0, int nw) {
    LAS float* scr = (LAS float*)(F.lds + RING_OFF + F.wave * 16384);
    const float* w_gate = (const float*)F.in[27]; const float* w_up = (const float*)F.in[28]; const float* w_down = (const float*)F.in[29]; const float* ffg = (const float*)F.in[26];
    bf16* WGU = (bf16*)(F.ws + WS_WGU); bf16* WDN = (bf16*)(F.ws + WS_WDN);
    constexpr int I_G = 16 * 88, I_DN = 44 * 32;
    for (int it = F.gw - w0; it < 2 * I_G + I_DN; it += nw) {
        int r = it;
        if (r < I_G) { transpose_item(w_gate, DFF, DFF, WGU, DM, r, scr, F.lane, [](int n) { return 256 * (n >> 7) + (n & 127); }, ffg); continue; } r -= I_G;
        if (r < I_G) { transpose_item(w_up, DFF, DFF, WGU, DM, r, scr, F.lane, [](int n) { return 256 * (n >> 7) + 128 + (n & 127); }, ffg); continue; } r -= I_G;
        transpose_item(w_down, DM, DM, WDN, DFF, r, scr, F.lane, [](int n) { return n; });
    }
}
__device__ __forceinline__ int small_arow(int r) { return r < NMETA ? r : RP + (r - NMETA); }
__device__ __forceinline__ void p1_inproj(Frame& F) {
    const bf16* XN = (const bf16*)(F.ws + WS_XN); const bf16* WIN = (const bf16*)(F.ws + WS_WIN); bf16* PROJ = (bf16*)(F.ws + WS_PROJ); float* DTRAW = (float*)(F.ws + WS_DTRAW);
    { pg8::Gemm g{XN, WIN, MMAIN, PJ, DM, 1, DM}; pg8::StaticOrder S; S.init(MMAIN, PJ, F.G, (int)blockIdx.x);
      EpiProj E{PROJ, DTRAW, 1};
      pg8::gemm_phase<EpiProj, pg8::StaticOrder, true, true>(F.lds + RING_OFF, g, S, E); }
    auto epi = [&](const f32x4& acc, int rt, int ct, int lane) {
        const int col = ct * 16 + (lane & 15);
#pragma unroll
        for (int i = 0; i < 4; ++i) { const int r = rt * 16 + 4 * (lane >> 4) + i; const bf16 v = f2bf(acc[i]);
            if (r < NMETA) { for (int b = 0; b < NB; ++b) { PROJ[(size_t)(b * TT + r) * PJ + col] = v; if (col >= C_DT && col < C_DT + 8) DTRAW[(size_t)(b * TT + r) * 8 + (col - C_DT)] = acc[i]; } }
            else { const int row = RP + (r - NMETA); PROJ[(size_t)row * PJ + col] = v; if (col >= C_DT && col < C_DT + 8) DTRAW[(size_t)row * 8 + (col - C_DT)] = acc[i]; } }
    };
    small_gemm(XN, DM, WIN, DM, NS / 16, PJ / 16, [](int r) { return small_arow(r); }, epi, F.gw, F.NGW, F.lane);
    { constexpr int NSM = (NS / 16) * (PJ / 16);
      if (F.NGW > NSM + 256) { if (F.gw >= NSM) p1_ffn_weights(F, NSM, F.NGW - NSM); } else p1_ffn_weights(F, 0, F.NGW); }
}

constexpr int CV_LDS_STRIDE = 88;
__device__ __forceinline__ void p2_elementwise(Frame& F) {
    const bf16* PROJ = (const bf16*)(F.ws + WS_PROJ); const float* DTRAW = (const float*)(F.ws + WS_DTRAW); float* DT = (float*)(F.ws + WS_DT);
    float* RQS = (float*)(F.ws + WS_RQ); float* KRF = (float*)(F.ws + WS_KRF);
    const float* kvg = (const float*)F.in[18]; const float* qng = (const float*)F.in[16]; const float* dtb = (const float*)F.in[12]; const float* ROPE = (const float*)(F.ws + WS_ROPE);
    {
        const f32x4 gg = ((const f32x4*)kvg)[F.lane]; const float* gq = qng + 6 * F.lane; const float g0 = gq[0], g1 = gq[1], g2 = gq[2], g3 = gq[3], g4 = gq[4], g5 = gq[5]; const float dbias = dtb[F.lane & 7];
        v2u wk[4], wkn[4]; unsigned wq[4][3], wqn[4][3]; unsigned short kr1[4], kr2[4], kr1n[4], kr2n[4]; float dtr[4], dtrn[4]; f32x2_t cs[4], csn[4];
#define P2A_LOAD(WK, WQ, K1, K2, DTR, CS, r0, n) do { _Pragma("unroll") for (int i = 0; i < 4; ++i) if (i < (n)) { const int row = (r0) + i; const bf16* pr = PROJ + (size_t)row * PJ; \
            WK[i] = *(const v2u*)(pr + C_CKV + 4 * F.lane); const unsigned* p = (const unsigned*)(pr + C_CQ + 6 * F.lane); WQ[i][0] = p[0]; WQ[i][1] = p[1]; WQ[i][2] = p[2]; \
            K1[i] = pr[C_KR + (F.lane & 15)]; K2[i] = pr[C_KR + 16 + (F.lane & 15)]; DTR[i] = DTRAW[(size_t)row * 8 + (F.lane & 7)]; \
            CS[i] = *(const f32x2_t*)(ROPE + 2 * ((row < RP ? row % TT : TT) * 16 + (F.lane & 15))); } } while (0)
#define P2A_PROC(r0, n) do { _Pragma("unroll") for (int i = 0; i < 4; ++i) if (i < (n)) { const int row = (r0) + i; \
            { const float v0 = bflo(wk[i].x), v1 = bfhi(wk[i].x), v2 = bflo(wk[i].y), v3 = bfhi(wk[i].y); \
              const float rs = __builtin_amdgcn_rsqf(wave_sum((v0 * v0 + v1 * v1) + (v2 * v2 + v3 * v3)) * (1.f / KVL) + EPS); \
              const f32x4 o = {v0 * rs * gg.x, v1 * rs * gg.y, v2 * rs * gg.z, v3 * rs * gg.w}; \
              float* of = (row < RP) ? F.out + OUT_LATP + (size_t)row * KVL : F.out + OUT_LATS + (size_t)(row - RP) * KVL; \
              ((f32x4*)of)[F.lane] = o; if (F.lane == 0) RQS[R + row] = rs; } \
            { const float v0 = bflo(wq[i][0]), v1 = bfhi(wq[i][0]), v2 = bflo(wq[i][1]), v3 = bfhi(wq[i][1]), v4 = bflo(wq[i][2]), v5 = bfhi(wq[i][2]); \
              const float rs = __builtin_amdgcn_rsqf(wave_sum((v0 * v0 + v1 * v1) + (v2 * v2 + v3 * v3) + (v4 * v4 + v5 * v5)) * (1.f / QL) + EPS); \
              if (F.lane == 0) RQS[row] = rs; } \
            if (F.lane < 16) { const int j = F.lane; const float c = cs[i].x, s = cs[i].y; \
              const float x1 = bf2f(kr1[i]), x2 = bf2f(kr2[i]); const float y1 = x1 * c - x2 * s, y2 = x1 * s + x2 * c; \
              KRF[(size_t)row * 32 + j] = y1; KRF[(size_t)row * 32 + 16 + j] = y2; \
              float* of = (row < RP) ? F.out + OUT_KRP + (size_t)row * 32 : F.out + OUT_KRS + (size_t)(row - RP) * 32; of[j] = y1; of[16 + j] = y2; } \
            if (F.lane < 8) DT[(size_t)row * 8 + F.lane] = softplus_f(dtr[i] + dbias); } } while (0)
#define P2A_ROT() do { _Pragma("unroll") for (int i = 0; i < 4; ++i) { wk[i] = wkn[i]; wq[i][0] = wqn[i][0]; wq[i][1] = wqn[i][1]; wq[i][2] = wqn[i][2]; kr1[i] = kr1n[i]; kr2[i] = kr2n[i]; dtr[i] = dtrn[i]; cs[i] = csn[i]; } } while (0)
        if (F.NGW == 2048) {
            const int ra = 4 * F.gw, rb2 = 8192 + 4 * F.gw, rc = 16384 + F.gw;
            P2A_LOAD(wk, wq, kr1, kr2, dtr, cs, ra, 4);
            P2A_LOAD(wkn, wqn, kr1n, kr2n, dtrn, csn, rb2, 4);
            P2A_PROC(ra, 4); P2A_ROT();
            if (F.gw < 256) P2A_LOAD(wkn, wqn, kr1n, kr2n, dtrn, csn, rc, 1);
            P2A_PROC(rb2, 4);
            if (F.gw < 256) { P2A_ROT(); P2A_PROC(rc, 1); }
        } else {
            for (int r0 = 4 * F.gw; r0 < R; r0 += 4 * F.NGW) { P2A_LOAD(wk, wq, kr1, kr2, dtr, cs, r0, 4); P2A_PROC(r0, 4); }
        }
#undef P2A_LOAD
#undef P2A_PROC
#undef P2A_ROT
    }
    const float* cw = (const float*)F.in[10]; const float* cb = (const float*)F.in[11];
    bf16* XST = (bf16*)(F.ws + WS_XST); bf16* BT = (bf16*)(F.ws + WS_BT); bf16* BC = (bf16*)(F.ws + WS_BC);
    LAS bf16* tile = (LAS bf16*)(F.lds + RING_OFF);
    for (int i = blockIdx.x * NTHR + F.tid; i < NB * 640 * 6; i += F.G * NTHR) { const int rowi = i / 6, pc = i % 6; const int bb = rowi / 640, cc = rowi % 640;
        bf16* dst = (cc < SSDW) ? XST + ((size_t)(bb * SSDW + cc)) * TPAD : BT + ((size_t)(bb * 128 + (cc - SSDW))) * TPAD; *(v4u*)(dst + pc * 8) = (v4u){0u, 0u, 0u, 0u}; }
    {
        const int cl = 2 * (F.tid & 127), tq = F.tid >> 7;
        unsigned raw[19], rawn[19]; float wv[10], wn[10];
#define CV_FETCH(RAW, WV, uu) do { const int third_ = (uu) % 3, tb_ = 1 + ((uu) / 3) % 32, b_ = (uu) / 96; const int c_ = third_ * 256 + cl, tf_ = tb_ * CHL - TOFF + 16 * tq; \
            const bf16* base_ = PROJ + (size_t)b_ * TT * PJ + C_XBC + c_; \
            _Pragma("unroll") for (int k = 0; k < 19; ++k) { const int t = tf_ - 3 + k; RAW[k] = (t >= 0) ? *(const unsigned*)(base_ + (size_t)t * PJ) : 0u; } \
            _Pragma("unroll") for (int k = 0; k < 4; ++k) { WV[2 * k] = cw[k * CONVD + c_]; WV[2 * k + 1] = cw[k * CONVD + c_ + 1]; } WV[8] = cb[c_]; WV[9] = cb[c_ + 1]; } while (0)
#define CV_COMPUTE(RAW, WV, tfirst, lcol, third, b) do { unsigned wa_[8], wb_[8]; float pa_ = 0.f, pb_ = 0.f; \
            _Pragma("unroll") for (int k = 0; k < 16; ++k) { const int t = (tfirst) + k; \
                const float ya = silu_f(WV[8] + bflo(RAW[k]) * WV[0] + bflo(RAW[k + 1]) * WV[2] + bflo(RAW[k + 2]) * WV[4] + bflo(RAW[k + 3]) * WV[6]); \
                const float yb = silu_f(WV[9] + bfhi(RAW[k]) * WV[1] + bfhi(RAW[k + 1]) * WV[3] + bfhi(RAW[k + 2]) * WV[5] + bfhi(RAW[k + 3]) * WV[7]); \
                if ((third) == 2) *(unsigned*)(BC + (size_t)((b) * TT + t) * 256 + cl) = pk2(ya, yb); \
                if (k & 1) { wa_[k >> 1] = pk2(pa_, ya); wb_[k >> 1] = pk2(pb_, yb); } else { pa_ = ya; pb_ = yb; } } \
            LAS v4u* ra_ = (LAS v4u*)(tile + cl * CV_LDS_STRIDE + (lcol)); LAS v4u* rb_ = (LAS v4u*)(tile + (cl + 1) * CV_LDS_STRIDE + (lcol)); \
            ra_[0] = (v4u){wa_[0], wa_[1], wa_[2], wa_[3]}; ra_[1] = (v4u){wa_[4], wa_[5], wa_[6], wa_[7]}; rb_[0] = (v4u){wb_[0], wb_[1], wb_[2], wb_[3]}; rb_[1] = (v4u){wb_[4], wb_[5], wb_[6], wb_[7]}; } while (0)
        if ((int)blockIdx.x < NB * 32 * 3) CV_FETCH(rawn, wn, (int)blockIdx.x);
        for (int u = blockIdx.x; u < NB * 32 * 3; u += F.G) {
            const int third = u % 3, tb = 1 + (u / 3) % 32, b = u / 96; const int t0 = tb * CHL - TOFF;
#pragma unroll
            for (int k = 0; k < 19; ++k) raw[k] = rawn[k];
#pragma unroll
            for (int k = 0; k < 10; ++k) wv[k] = wn[k];
            CV_COMPUTE(raw, wv, t0 + 16 * tq, 16 * tq, third, b);
            if (tb == 1 && tq == 0) {
                const bf16* base = PROJ + (size_t)b * TT * PJ + C_XBC + third * 256 + cl;
#pragma unroll
                for (int k = 0; k < 19; ++k) { const int t = k - 3; raw[k] = (t >= 0) ? *(const unsigned*)(base + (size_t)t * PJ) : 0u; }
                CV_COMPUTE(raw, wv, 0, 64, third, b); }
            __syncthreads();
            if (u + F.G < NB * 32 * 3) CV_FETCH(rawn, wn, u + F.G);
            { const int nrows = (third == 2) ? 128 : 256; const int npc = (tb == 1) ? 10 : 8;
              for (int i = F.tid; i < nrows * npc; i += NTHR) { const int cr = i / npc, pc = i % npc;
                const v4u o = *(const LAS v4u*)(tile + cr * CV_LDS_STRIDE + pc * 8);
                bf16* dst = (third < 2) ? XST + ((size_t)(b * SSDW + third * 256 + cr)) * TPAD : BT + ((size_t)(b * 128 + cr)) * TPAD;
                *(v4u*)(dst + ((pc < 8) ? tb * CHL + pc * 8 : TOFF + (pc - 8) * 8)) = o; } }
            __syncthreads();
        }
#undef CV_FETCH
#undef CV_COMPUTE
    }
    const float* sconv = (const float*)F.in[4]; float* XAS = (float*)(F.ws + WS_XAS);
    for (int i = blockIdx.x * NTHR + F.tid; i < DB * CONVD; i += F.G * NTHR) { const int b = i / CONVD, c = i % CONVD;
        const float xc = bf2f(PROJ[(size_t)(RP + b) * PJ + C_XBC + c]);
        const float s0 = sconv[(size_t)(b * 3 + 0) * CONVD + c], s1 = sconv[(size_t)(b * 3 + 1) * CONVD + c], s2 = sconv[(size_t)(b * 3 + 2) * CONVD + c];
        XAS[i] = silu_f(cb[c] + s0 * cw[c] + s1 * cw[CONVD + c] + s2 * cw[2 * CONVD + c] + xc * cw[3 * CONVD + c]);
        float* oc = F.out + OUT_CONVS + (size_t)b * 3 * CONVD + c; oc[0] = s1; oc[CONVD] = s2; oc[2 * CONVD] = xc; }
    for (int i = blockIdx.x * NTHR + F.tid; i < NB * 3 * CONVD; i += F.G * NTHR) { const int b = i / (3 * CONVD), k = (i / CONVD) % 3, c = i % CONVD;
        F.out[OUT_CONVP + i] = bf2f(PROJ[(size_t)(b * TT + TT - 3 + k) * PJ + C_XBC + c]); }
}
#define MFMA32(a, b, c) __builtin_amdgcn_mfma_f32_32x32x16_bf16((a), (b), (c), 0, 0, 0)
#define MFMA16(a, b, c) __builtin_amdgcn_mfma_f32_16x16x32_bf16((a), (b), (c), 0, 0, 0)
__device__ __forceinline__ int crow(int reg, int hi) { return (reg & 3) + 8 * (reg >> 2) + 4 * hi; }
__device__ __forceinline__ bf16x8 pack8(const f32x16& x, int s) {
    v4u p; p.x = pk2(x[8 * s + 0], x[8 * s + 1]); p.y = pk2(x[8 * s + 2], x[8 * s + 3]); p.z = pk2(x[8 * s + 4], x[8 * s + 5]); p.w = pk2(x[8 * s + 6], x[8 * s + 7]);
    return __builtin_bit_cast(bf16x8, p);
}
__device__ __forceinline__ bf16x8 ld2x8(const bf16* p0, const bf16* p1) {
    const v2u a = *(const v2u*)p0, b = *(const v2u*)p1; v4u r; r.x = a.x; r.y = a.y; r.z = b.x; r.w = b.y; return __builtin_bit_cast(bf16x8, r);
}
__device__ __forceinline__ float softmax_ref(Frame& F) {
    const float* gqn = (const float*)F.in[20]; const float* gqr = (const float*)F.in[21]; const float* gkn = (const float*)F.in[22]; const float* gkr = (const float*)F.in[23];
    float a = fabsf(gqn[F.lane]), b = fabsf(gkn[F.lane]);
    if (F.lane < 16) { a = fmaxf(a, fabsf(gqr[F.lane])); b = fmaxf(b, fabsf(gkr[F.lane])); }
    return LOG2E * 9.797958971132712f * wave_max(a) * wave_max(b) * 1.0001f;
}
constexpr size_t WS_YS = 495 * MiB;
constexpr size_t WS_KS = 498 * MiB;
constexpr int NKT = 65;

__device__ __forceinline__ void p3_upproj_states(Frame& F) {
    const bf16* PROJ = (const bf16*)(F.ws + WS_PROJ); const bf16* WUQ = (const bf16*)(F.ws + WS_WUQ); const bf16* WUKV = (const bf16*)(F.ws + WS_WUKV);
    bf16* QRAW = (bf16*)(F.ws + WS_QRAW); bf16* KVRAW = (bf16*)(F.ws + WS_KVRAW);
    { pg8::Gemm g{PROJ + C_CQ, WUQ, MMAIN, 768, QL, 1, PJ}; pg8::StaticOrder S; S.init(MMAIN, 768, F.G, (int)blockIdx.x); EpiBf16 E{QRAW, 768, 1};
      pg8::gemm_phase<EpiBf16, pg8::StaticOrder, true, true>(F.lds + RING_OFF, g, S, E); }
    { pg8::Gemm g{PROJ + C_CKV, WUKV, MMAIN, 1024, KVL, 1, PJ}; pg8::StaticOrder S; S.init(MMAIN, 1024, F.G, (int)blockIdx.x); EpiBf16 E{KVRAW, 1024, 1};
      pg8::gemm_phase<EpiBf16, pg8::StaticOrder, true, true>(F.lds + RING_OFF, g, S, E); }
    const bool sub = (F.G == 256);
    const int sgw = sub ? (blockIdx.x - 192) * NWAVES + F.wave : F.gw, sngw = sub ? 64 * NWAVES : F.NGW;
    if (!sub || blockIdx.x >= 192) {
    small_gemm(PROJ + C_CQ, PJ, WUQ, QL, DB / 16, 768 / 16, [](int r) { return RP + r; },
        [&](const f32x4& acc, int rt, int ct, int lane) { const int col = ct * 16 + (lane & 15);
#pragma unroll
            for (int i = 0; i < 4; ++i) QRAW[(size_t)(RP + rt * 16 + 4 * (lane >> 4) + i) * 768 + col] = f2bf(acc[i]); }, sgw, sngw, F.lane);
    small_gemm(PROJ + C_CKV, PJ, WUKV, KVL, NS / 16, 1024 / 16, [](int r) { return small_arow(r); },
        [&](const f32x4& acc, int rt, int ct, int lane) { const int col = ct * 16 + (lane & 15);
#pragma unroll
            for (int i = 0; i < 4; ++i) { const int r = rt * 16 + 4 * (lane >> 4) + i; const bf16 v = f2bf(acc[i]);
                if (r < NMETA) { for (int b = 0; b < NB; ++b) KVRAW[(size_t)(b * TT + r) * 1024 + col] = v; } else KVRAW[(size_t)(RP + r - NMETA) * 1024 + col] = v; } }, sgw, sngw, F.lane);
    }
    const float* DT = (const float*)(F.ws + WS_DT); const float* a_log = (const float*)F.in[13];
    const bf16* XST = (const bf16*)(F.ws + WS_XST); const bf16* BT = (const bf16*)(F.ws + WS_BT);
    bf16* STATES = (bf16*)(F.ws + WS_STATES); float* DECAY = (float*)(F.ws + WS_DECAY);
    LAS float* wl = (LAS float*)(F.lds + RING_OFF + F.wave * 1024);
    const int r32 = F.lane & 31, hi = F.lane >> 5;
    for (int u = F.gw; u < NB * NCH * NH; u = sub ? ((u < F.NGW && F.gw >= 192 * NWAVES) ? F.NGW + (F.gw - 192 * NWAVES) : NB * NCH * NH) : u + F.NGW) {
        const int h = u % NH, c = (u / NH) % NCH, b = u / (NH * NCH); const int g = h >> 2;
        const int t = c * CHL - TOFF + F.lane;
        const float dt = (t >= 0) ? DT[(size_t)(b * TT + t) * 8 + h] : 0.f;
        const float A = -__expf(a_log[h]);
        float acs = dt * A;
#pragma unroll
        for (int o = 1; o < 64; o <<= 1) { const float v = __shfl_up(acs, o); if (F.lane >= o) acs += v; }
        const float last = __shfl(acs, 63);
        wl[F.lane] = __expf(last - acs) * dt;
        LDS_WAIT(); asm volatile("" ::: "memory");
        f32x16 acc[2][2];
#pragma unroll
        for (int i = 0; i < 2; ++i)
#pragma unroll
            for (int j = 0; j < 2; ++j) acc[i][j] = (f32x16){};
        const bf16* xb = XST + ((size_t)(b * SSDW + h * HP)) * TPAD + c * CHL; const bf16* bb = BT + ((size_t)(b * 128 + g * DS)) * TPAD + c * CHL;
#pragma unroll
        for (int s = 0; s < 4; ++s) {
            const f32x4 w0 = *(const LAS f32x4*)(wl + 16 * s + 8 * hi), w1 = *(const LAS f32x4*)(wl + 16 * s + 8 * hi + 4);
            bf16x8 af[2], bfr[2];
#pragma unroll
            for (int pt = 0; pt < 2; ++pt) { const v4u x = *(const v4u*)(xb + (size_t)(32 * pt + r32) * TPAD + 16 * s + 8 * hi);
                v4u y; y.x = pk2(bflo(x.x) * w0.x, bfhi(x.x) * w0.y); y.y = pk2(bflo(x.y) * w0.z, bfhi(x.y) * w0.w); y.z = pk2(bflo(x.z) * w1.x, bfhi(x.z) * w1.y); y.w = pk2(bflo(x.w) * w1.z, bfhi(x.w) * w1.w);
                af[pt] = __builtin_bit_cast(bf16x8, y); }
#pragma unroll
            for (int nt = 0; nt < 2; ++nt) bfr[nt] = *(const bf16x8*)(bb + (size_t)(32 * nt + r32) * TPAD + 16 * s + 8 * hi);
#pragma unroll
            for (int pt = 0; pt < 2; ++pt)
#pragma unroll
                for (int nt = 0; nt < 2; ++nt) acc[pt][nt] = MFMA32(af[pt], bfr[nt], acc[pt][nt]);
        }
        bf16* so = STATES + ((size_t)((b * NCH + c) * NH + h)) * 4096;
        const bool odd = (F.lane & 1) != 0;
#pragma unroll
        for (int pt = 0; pt < 2; ++pt)
#pragma unroll
            for (int nt = 0; nt < 2; ++nt)
#pragma unroll
                for (int r2 = 0; r2 < 8; ++r2) { const float oe = acc[pt][nt][2 * r2], oo = acc[pt][nt][2 * r2 + 1];
                    const float got = DPP_F(odd ? oe : oo, 0xB1);
                    const unsigned w = odd ? pk2(got, oo) : pk2(oe, got);
                    *(unsigned*)(so + (32 * pt + crow(2 * r2 + (odd ? 1 : 0), hi)) * 64 + 32 * nt + (r32 & ~1)) = w; }
        if (F.lane == 0) DECAY[(b * NCH + c) * NH + h] = __expf(last);
        LDS_WAIT(); asm volatile("" ::: "memory");
    }
}

#ifdef MK_TS
#define P4_STAMP(k) do { if (blockIdx.x == 0 && F.tid == 0) ((unsigned long long*)(F.ws + 600 * MiB))[20 + (k)] = __builtin_amdgcn_s_memrealtime(); } while (0)
#else
#define P4_STAMP(k) do { } while (0)
#endif
__device__ __forceinline__ void p4_post(Frame& F) {
    const bf16* QRAW = (const bf16*)(F.ws + WS_QRAW); const bf16* KVRAW = (const bf16*)(F.ws + WS_KVRAW); const float* KRF = (const float*)(F.ws + WS_KRF);
    bf16* Q = (bf16*)(F.ws + WS_Q); bf16* K = (bf16*)(F.ws + WS_K); bf16* VT = (bf16*)(F.ws + WS_VT); float* VS = (float*)(F.ws + WS_VS);
    const float* gqn = (const float*)F.in[20]; const float* gqr = (const float*)F.in[21]; const float* gkn = (const float*)F.in[22]; const float* gkr = (const float*)F.in[23];
    const float* ROPE = (const float*)(F.ws + WS_ROPE); const float* RQS = (const float*)(F.ws + WS_RQ);
    const int h = F.lane >> 3, sub = F.lane & 7;
    bf16* KS = (bf16*)(F.ws + WS_KS);
    for (int row = RP + (F.gw + F.NGW / 2) % F.NGW; row < R; row += F.NGW) {
        const int t = PAST;
        if (row >= RP) { const bf16* kp = KVRAW + (size_t)row * 1024 + 128 * h + 8 * sub; const v4u kw = *(const v4u*)kp; const v4u vw = *(const v4u*)(kp + 64);
          const f32x4 kr = *(const f32x4*)(KRF + (size_t)row * 32 + 4 * sub);
          const float rkv = RQS[R + row];
          float kn[8] = {bflo(kw.x) * rkv, bfhi(kw.x) * rkv, bflo(kw.y) * rkv, bfhi(kw.y) * rkv, bflo(kw.z) * rkv, bfhi(kw.z) * rkv, bflo(kw.w) * rkv, bfhi(kw.w) * rkv};
          float ss = (kr.x * kr.x + kr.y * kr.y) + (kr.z * kr.z + kr.w * kr.w);
#pragma unroll
          for (int e = 0; e < 8; ++e) ss += kn[e] * kn[e];
          ss = sum_x1(ss); ss = sum_x2(ss); ss = sum_x4(ss);
          const float rs = __builtin_amdgcn_rsqf(ss * (1.f / 96.f) + EPS);
          const float* gn = gkn + 8 * sub; v4u o; o.x = pk2(kn[0] * rs * gn[0], kn[1] * rs * gn[1]); o.y = pk2(kn[2] * rs * gn[2], kn[3] * rs * gn[3]); o.z = pk2(kn[4] * rs * gn[4], kn[5] * rs * gn[5]); o.w = pk2(kn[6] * rs * gn[6], kn[7] * rs * gn[7]);
          bf16* ko = KS + (size_t)(row - RP) * 768 + 96 * h; *(v4u*)(ko + 8 * sub) = o;
          const float* gr = gkr + ((4 * sub) & 15); v2u o2; o2.x = pk2(kr.x * rs * gr[0], kr.y * rs * gr[1]); o2.y = pk2(kr.z * rs * gr[2], kr.w * rs * gr[3]);
          *(v2u*)(ko + 64 + 4 * sub) = o2;
          const unsigned vv[4] = {vw.x, vw.y, vw.z, vw.w}; float* vs = VS + (size_t)(row - RP) * 512 + 64 * h + 8 * sub;
#pragma unroll
          for (int e = 0; e < 4; ++e) { vs[2 * e] = bflo(vv[e]) * rkv; vs[2 * e + 1] = bfhi(vv[e]) * rkv; } }
        if (row >= RP || t >= NMETA) {
            const bf16* qp = QRAW + (size_t)row * 768 + 96 * h; const v4u qw = *(const v4u*)(qp + 8 * sub);
            const unsigned r1 = *(const unsigned*)(qp + 64 + 2 * sub), r2 = *(const unsigned*)(qp + 80 + 2 * sub);
            float qn[8] = {bflo(qw.x), bfhi(qw.x), bflo(qw.y), bfhi(qw.y), bflo(qw.z), bfhi(qw.z), bflo(qw.w), bfhi(qw.w)};
            const f32x4 cs = *(const f32x4*)(ROPE + 2 * ((row < RP ? t : TT) * 16 + 2 * sub)); const float c0 = cs.x, s0 = cs.y, c1 = cs.z, s1 = cs.w;
            const float x10 = bflo(r1), x11 = bfhi(r1), x20 = bflo(r2), x21 = bfhi(r2);
            const float y10 = x10 * c0 - x20 * s0, y20 = x10 * s0 + x20 * c0, y11 = x11 * c1 - x21 * s1, y21 = x11 * s1 + x21 * c1;
            float ss = (y10 * y10 + y20 * y20) + (y11 * y11 + y21 * y21);
#pragma unroll
            for (int e = 0; e < 8; ++e) ss += qn[e] * qn[e];
            ss = sum_x1(ss); ss = sum_x2(ss); ss = sum_x4(ss);
            const float sq = RQS[row];
            const float rs = (ATTN_SCALE * LOG2E) * sq * __builtin_amdgcn_rsqf(ss * sq * sq * (1.f / 96.f) + EPS);
            const float* gn = gqn + 8 * sub; v4u o; o.x = pk2(qn[0] * rs * gn[0], qn[1] * rs * gn[1]); o.y = pk2(qn[2] * rs * gn[2], qn[3] * rs * gn[3]); o.z = pk2(qn[4] * rs * gn[4], qn[5] * rs * gn[5]); o.w = pk2(qn[6] * rs * gn[6], qn[7] * rs * gn[7]);
            bf16* qo = Q + (size_t)row * 768 + 96 * h; *(v4u*)(qo + 8 * sub) = o;
            const float g0 = gqr[2 * sub], g1 = gqr[2 * sub + 1];
            *(unsigned*)(qo + 64 + 2 * sub) = pk2(y10 * rs * g0, y11 * rs * g1); *(unsigned*)(qo + 80 + 2 * sub) = pk2(y20 * rs * g0, y21 * rs * g1);
        }
    }
    { bf16* KF = (bf16*)(F.ws + WS_K); bf16* VF = (bf16*)(F.ws + WS_VT);
      LAS unsigned char* vtile = F.lds + RING_OFF + F.wave * 4608;
      const int r8 = F.lane >> 3;
      const int nfull = (NB * NKT * NH) / F.NGW, rot = (F.gw + F.NGW - F.NGW / 4) % F.NGW;
      for (int i = 0; i <= nfull; ++i) { const int u = (i < nfull) ? i * F.NGW + F.gw : nfull * F.NGW + rot; if (u >= NB * NKT * NH) break;
          const int hh = u % NH, kt = (u / NH) % NKT, bb = u / (NH * NKT);
          bf16* kfb = KF + ((size_t)((bb * NH + hh) * NKT + kt)) * (6 * 512); bf16* vfb = VF + ((size_t)((bb * NH + hh) * NKT + kt)) * (4 * 512);
          v4u kwa[4], vwa[4]; f32x4 kra[4]; float rka[4];
#pragma unroll
          for (int i = 0; i < 4; ++i) { const int tk = kt * 32 + 8 * i + r8; const int tkc = tk < TT ? tk : TT - 1; rka[i] = RQS[R + bb * TT + tkc];
              const bf16* kp = KVRAW + (size_t)(bb * TT + tkc) * 1024 + 128 * hh + 8 * sub; kwa[i] = *(const v4u*)kp; vwa[i] = *(const v4u*)(kp + 64); kra[i] = *(const f32x4*)(KRF + (size_t)(bb * TT + tkc) * 32 + 4 * sub); }
#pragma unroll
          for (int i = 0; i < 4; ++i) {
              const int key = 8 * i + r8, tk = kt * 32 + key; v4u kw = kwa[i], vw = vwa[i]; f32x4 kr = kra[i];
              if (tk >= TT) { kw = (v4u){0u, 0u, 0u, 0u}; vw = kw; kr = (f32x4){0.f, 0.f, 0.f, 0.f}; }
              const float rkv = rka[i];
              float kn[8] = {bflo(kw.x) * rkv, bfhi(kw.x) * rkv, bflo(kw.y) * rkv, bfhi(kw.y) * rkv, bflo(kw.z) * rkv, bfhi(kw.z) * rkv, bflo(kw.w) * rkv, bfhi(kw.w) * rkv};
              vw.x = pk2(bflo(vw.x) * rkv, bfhi(vw.x) * rkv); vw.y = pk2(bflo(vw.y) * rkv, bfhi(vw.y) * rkv); vw.z = pk2(bflo(vw.z) * rkv, bfhi(vw.z) * rkv); vw.w = pk2(bflo(vw.w) * rkv, bfhi(vw.w) * rkv);
              float ss = (kr.x * kr.x + kr.y * kr.y) + (kr.z * kr.z + kr.w * kr.w);
#pragma unroll
              for (int e = 0; e < 8; ++e) ss += kn[e] * kn[e];
              ss = sum_x1(ss); ss = sum_x2(ss); ss = sum_x4(ss);
              const float rs = __builtin_amdgcn_rsqf(ss * (1.f / 96.f) + EPS);
              const float* gn = gkn + 8 * sub; v4u o; o.x = pk2(kn[0] * rs * gn[0], kn[1] * rs * gn[1]); o.y = pk2(kn[2] * rs * gn[2], kn[3] * rs * gn[3]); o.z = pk2(kn[4] * rs * gn[4], kn[5] * rs * gn[5]); o.w = pk2(kn[6] * rs * gn[6], kn[7] * rs * gn[7]);
              *(v4u*)(kfb + (sub >> 1) * 512 + ((sub & 1) * 32 + key) * 8) = o;
              const float* gr = gkr + ((4 * sub) & 15); v2u o2; o2.x = pk2(kr.x * rs * gr[0], kr.y * rs * gr[1]); o2.y = pk2(kr.z * rs * gr[2], kr.w * rs * gr[3]);
              *(v2u*)(kfb + (4 + (sub >> 2)) * 512 + (((sub >> 1) & 1) * 32 + key) * 8 + 4 * (sub & 1)) = o2;
              *(LAS v4u*)(vtile + key * 144 + sub * 16) = vw; }
          LDS_WAIT(); asm volatile("" ::: "memory");
          const int g = F.lane >> 4, q4 = (F.lane & 15) >> 2, pp = F.lane & 3;
          const unsigned a_lo = (unsigned)(uintptr_t)vtile + (unsigned)((4 * (g >> 1) + q4) * 144 + (16 * (g & 1) + 4 * pp) * 2);
#define VF_TR(dt, s2) do { s16x4 lo, hi4; \
              asm volatile("ds_read_b64_tr_b16 %0, %2 offset:%c3\n\tds_read_b64_tr_b16 %1, %2 offset:%c4\n\ts_waitcnt lgkmcnt(0)" : "=&v"(lo), "=&v"(hi4) : "v"(a_lo), "i"(16 * (s2) * 144 + 64 * (dt)), "i"(16 * (s2) * 144 + 64 * (dt) + 8 * 144) : "memory"); \
              v4u o; o.x = (unsigned)(unsigned short)lo[0] | ((unsigned)(unsigned short)lo[1] << 16); o.y = (unsigned)(unsigned short)lo[2] | ((unsigned)(unsigned short)lo[3] << 16); \
              o.z = (unsigned)(unsigned short)hi4[0] | ((unsigned)(unsigned short)hi4[1] << 16); o.w = (unsigned)(unsigned short)hi4[2] | ((unsigned)(unsigned short)hi4[3] << 16); \
              *(v4u*)(vfb + ((dt) * 2 + (s2)) * 512 + F.lane * 8) = o; } while (0)
          VF_TR(0, 0); VF_TR(0, 1); VF_TR(1, 0); VF_TR(1, 1);
#undef VF_TR
          LDS_WAIT(); asm volatile("" ::: "memory");
      } }
    P4_STAMP(0);
    const bf16* STATES = (const bf16*)(F.ws + WS_STATES); const float* DECAY = (const float*)(F.ws + WS_DECAY); bf16* HIN = (bf16*)(F.ws + WS_HIN);
    for (int e2 = blockIdx.x * NTHR + F.tid; e2 < NB * NH * 2048; e2 += F.G * NTHR) {
        const int e = 2 * e2; const int b = e / (NH * 4096), hh = (e / 4096) % NH, pn = e % 4096;
        float h0 = 0.f, h1 = 0.f;
#pragma unroll 1
        for (int c0 = 0; c0 < NCH; c0 += 11) {
            unsigned st[11]; float dc[11];
#pragma unroll
            for (int j = 0; j < 11; ++j) { const int c = c0 + j; st[j] = *(const unsigned*)(STATES + ((size_t)((b * NCH + c) * NH + hh)) * 4096 + pn); dc[j] = DECAY[(b * NCH + c) * NH + hh]; }
#pragma unroll
            for (int j = 0; j < 11; ++j) { const int c = c0 + j; *(unsigned*)(HIN + ((size_t)((b * NCH + c) * NH + hh)) * 4096 + pn) = pk2(h0, h1); h0 = h0 * dc[j] + bflo(st[j]); h1 = h1 * dc[j] + bfhi(st[j]); }
        }
        *(f32x2_t*)(F.out + OUT_SSMP + e) = (f32x2_t){h0, h1};
    }
    P4_STAMP(1);
    const float* XAS = (const float*)(F.ws + WS_XAS); const float* DT = (const float*)(F.ws + WS_DT); const float* sst = (const float*)F.in[5];
    const float* a_log = (const float*)F.in[13]; const float* d_skip = (const float*)F.in[14]; float* YS = (float*)(F.ws + WS_YS);
    for (int u = F.gw; u < DB * NH * 16; u += F.NGW) {
        const int pq = u & 15, hh = (u >> 4) & 7, b = u >> 7; const int g = hh >> 2; const int p = 4 * pq + (F.lane >> 4), n4 = F.lane & 15;
        const float dt = DT[(size_t)(RP + b) * 8 + hh]; const float a = __expf(dt * -__expf(a_log[hh]));
        const float x = XAS[(size_t)b * CONVD + hh * HP + p]; const float uu = dt * x;
        const f32x4 Bv = *(const f32x4*)(XAS + (size_t)b * CONVD + SSDW + g * DS + 4 * n4), Cv = *(const f32x4*)(XAS + (size_t)b * CONVD + SSDW + 128 + g * DS + 4 * n4);
        const size_t si = (((size_t)b * NH + hh) * HP + p) * DS + 4 * n4;
        const f32x4 s0 = *(const f32x4*)(sst + si); const f32x4 s1 = s0 * a + uu * Bv;
        *(f32x4*)(F.out + OUT_SSMS + si) = s1;
        float y = (Cv.x * s1.x + Cv.y * s1.y) + (Cv.z * s1.z + Cv.w * s1.w);
        y = sum_x1(y); y = sum_x2(y); y = sum_x4(y); y = sum_x8(y);
        if (n4 == 0) YS[(size_t)b * 512 + hh * HP + p] = y + d_skip[hh] * x;
    }
}
constexpr int DA_ROWB = 528;
constexpr int DA_LAT = 0, DA_KR = 128 * DA_ROWB, DA_PB = DA_KR + 128 * 33 * 4, DA_QG = DA_PB + 2 * 16 * 32 * 2, DA_END = DA_QG + 8 * 96 * 4;
constexpr int P5_EXCH = 100 * 1024;
static_assert(DA_END <= P5_EXCH, "LDS map of P5");

constexpr int AT_SLOT = 20480, AT_D = 4;
__device__ __forceinline__ void at_issue(Frame& F, const bf16* kt_k, const bf16* kt_v, LAS unsigned char* slot) {
    const int w = F.wave;
    __builtin_amdgcn_global_load_lds((const unsigned*)((const char*)kt_k + w * 1024 + F.lane * 16), (LAS unsigned*)(slot + w * 1024), 16, 0, 0);
    const char* srcB = (w < 4) ? (const char*)kt_k + 8192 + w * 1024 : (const char*)kt_v + (w - 4) * 1024;
    __builtin_amdgcn_global_load_lds((const unsigned*)(srcB + F.lane * 16), (LAS unsigned*)(slot + 8192 + w * 1024), 16, 0, 0);
    __builtin_amdgcn_global_load_lds((const unsigned*)((const char*)kt_v + 4096 + w * 256 + F.lane * 4), (LAS unsigned*)(slot + 16384 + w * 256), 4, 0, 0);
    __builtin_amdgcn_global_load_lds((const unsigned*)((const char*)kt_v + 6144 + w * 256 + F.lane * 4), (LAS unsigned*)(slot + 18432 + w * 256), 4, 0, 0);
}
__device__ __forceinline__ void p5_attn_prompt(Frame& F, float M0) {
    const bf16* QRAW = (const bf16*)(F.ws + WS_QRAW); const bf16* KF = (const bf16*)(F.ws + WS_K); const bf16* VF = (const bf16*)(F.ws + WS_VT); bf16* MIXA = (bf16*)(F.ws + WS_MIX); float* SSQ = (float*)(F.ws + WS_SSQ);
    const float* ROPE = (const float*)(F.ws + WS_ROPE); const float* gqn = (const float*)F.in[20]; const float* gqr = (const float*)F.in[21]; const float* RQS = (const float*)(F.ws + WS_RQ);
    LAS unsigned char* ring = F.lds + RING_OFF;
    const int w = F.wave, r32 = F.lane & 31, hi = F.lane >> 5;
    f32x16 negm;
#pragma unroll
    for (int i = 0; i < 16; ++i) negm[i] = -M0;
    for (int u = F.vcu; u < 256; u += F.G) {
        const int b = u >> 5, h = (u >> 2) & 7, pr = u & 3;
        const bf16* kfb = KF + ((size_t)((b * NH + h) * NKT)) * (6 * 512); const bf16* vfb = VF + ((size_t)((b * NH + h) * NKT)) * (4 * 512);
#pragma unroll 1
        for (int half = 0; half < 2; ++half) {
            const int qb = half ? 7 - pr : pr; const int a = 8 * qb + w; const int qi = NMETA + 32 * a + r32;
            const int nkt = 8 * qb + 9, nkw = a + 2;
            bf16x8 qf[6];
            { const bf16* qp = QRAW + (size_t)(b * TT + qi) * 768 + 96 * h + 8 * hi;
              v4u qw[6];
#pragma unroll
              for (int s = 0; s < 6; ++s) qw[s] = *(const v4u*)(qp + 16 * s);
              f32x4 cs[4];
#pragma unroll
              for (int i = 0; i < 4; ++i) cs[i] = *(const f32x4*)(ROPE + 2 * (qi * 16 + 8 * hi) + 4 * i);
              float qv[6][8]; float ss = 0.f;
#pragma unroll
              for (int s = 0; s < 6; ++s) { const unsigned ww[4] = {qw[s].x, qw[s].y, qw[s].z, qw[s].w};
#pragma unroll
                  for (int e = 0; e < 4; ++e) { qv[s][2 * e] = bflo(ww[e]); qv[s][2 * e + 1] = bfhi(ww[e]); ss += qv[s][2 * e] * qv[s][2 * e] + qv[s][2 * e + 1] * qv[s][2 * e + 1]; } }
              ss = sum_x32(ss);
              const float sq = RQS[b * TT + qi];
              const float rs = (ATTN_SCALE * LOG2E) * sq * __builtin_amdgcn_rsqf(ss * sq * sq * (1.f / 96.f) + EPS);
#pragma unroll
              for (int jj = 0; jj < 8; ++jj) { const float c = cs[jj >> 1][2 * (jj & 1)], sn = cs[jj >> 1][2 * (jj & 1) + 1]; const float x1 = qv[4][jj], x2 = qv[5][jj];
                  const float gr = gqr[8 * hi + jj] * rs; qv[4][jj] = (x1 * c - x2 * sn) * gr; qv[5][jj] = (x1 * sn + x2 * c) * gr; }
#pragma unroll
              for (int s = 0; s < 4; ++s) { const f32x4 g0 = *(const f32x4*)(gqn + 16 * s + 8 * hi), g1 = *(const f32x4*)(gqn + 16 * s + 8 * hi + 4);
                  qv[s][0] *= g0.x * rs; qv[s][1] *= g0.y * rs; qv[s][2] *= g0.z * rs; qv[s][3] *= g0.w * rs; qv[s][4] *= g1.x * rs; qv[s][5] *= g1.y * rs; qv[s][6] *= g1.z * rs; qv[s][7] *= g1.w * rs; }
#pragma unroll
              for (int s = 0; s < 6; ++s) { v4u o; o.x = pk2(qv[s][0], qv[s][1]); o.y = pk2(qv[s][2], qv[s][3]); o.z = pk2(qv[s][4], qv[s][5]); o.w = pk2(qv[s][6], qv[s][7]); qf[s] = __builtin_bit_cast(bf16x8, o); } }
            f32x16 o0 = (f32x16){}, o1 = (f32x16){}; float l = 0.f;
            const int ns = (nkt + 1) >> 1;
#pragma unroll
            for (int j = 0; j < AT_D - 1; ++j) at_issue(F, kfb + (size_t)j * 6144, vfb + (size_t)j * 4096, ring + j * AT_SLOT);
#pragma unroll 1
            for (int st = 0; st < ns; ++st) {
                const int rem = ns - 1 - st;
                if (rem >= 2) asm volatile("s_waitcnt vmcnt(8)" ::: "memory"); else if (rem == 1) asm volatile("s_waitcnt vmcnt(4)" ::: "memory"); else asm volatile("s_waitcnt vmcnt(0)" ::: "memory");
                __builtin_amdgcn_s_barrier(); asm volatile("" ::: "memory");
                if (st + AT_D - 1 < ns) at_issue(F, kfb + (size_t)(st + AT_D - 1) * 6144, vfb + (size_t)(st + AT_D - 1) * 4096, ring + ((st + AT_D - 1) & (AT_D - 1)) * AT_SLOT);
#pragma unroll
                for (int tt = 0; tt < 2; ++tt) { const int kt = 2 * st + tt;
                  if (kt < nkw) {
                    const LAS unsigned char* sl = ring + (st & (AT_D - 1)) * AT_SLOT + F.lane * 16; const int j0 = 32 * kt;
                    f32x16 S = negm;
#pragma unroll
                    for (int s = 0; s < 6; ++s) S = MFMA32(*(const LAS bf16x8*)(sl + tt * 6144 + 1024 * s), qf[s], S);
                    bf16x8 vf[4];
#pragma unroll
                    for (int i = 0; i < 4; ++i) vf[i] = *(const LAS bf16x8*)(sl + 12288 + tt * 4096 + 1024 * i);
#pragma unroll
                    for (int i = 0; i < 16; ++i) S[i] = __builtin_amdgcn_exp2f(S[i]);
                    if (kt >= a) {
#pragma unroll
                        for (int i = 0; i < 16; ++i) if (j0 + crow(i, hi) > qi) S[i] = 0.f; }
#pragma unroll
                    for (int i = 0; i < 16; ++i) l += S[i];
                    const bf16x8 p0 = pack8(S, 0), p1 = pack8(S, 1);
                    o0 = MFMA32(vf[0], p0, o0); o0 = MFMA32(vf[1], p1, o0);
                    o1 = MFMA32(vf[2], p0, o1); o1 = MFMA32(vf[3], p1, o1);
                  } }
            }
            l = sum_x32(l);
            const float il = __builtin_amdgcn_rcpf(l);
            bf16* ao = MIXA + (size_t)(b * TT + qi) * 1024 + 512 + 64 * h + 4 * hi; float ssq = 0.f;
#pragma unroll
            for (int gq = 0; gq < 4; ++gq) {
                v2u w0, w1; w0.x = pk2(o0[4 * gq] * il, o0[4 * gq + 1] * il); w0.y = pk2(o0[4 * gq + 2] * il, o0[4 * gq + 3] * il);
                w1.x = pk2(o1[4 * gq] * il, o1[4 * gq + 1] * il); w1.y = pk2(o1[4 * gq + 2] * il, o1[4 * gq + 3] * il);
                ssq += (bflo(w0.x) * bflo(w0.x) + bfhi(w0.x) * bfhi(w0.x)) + (bflo(w0.y) * bflo(w0.y) + bfhi(w0.y) * bfhi(w0.y));
                ssq += (bflo(w1.x) * bflo(w1.x) + bfhi(w1.x) * bfhi(w1.x)) + (bflo(w1.y) * bflo(w1.y) + bfhi(w1.y) * bfhi(w1.y));
                *(v2u*)(ao + 8 * gq) = w0; *(v2u*)(ao + 32 + 8 * gq) = w1; }
            ssq = sum_x32(ssq);
            if (hi == 0) SSQ[(size_t)(b * TT + qi) * 8 + h] = ssq;
            asm volatile("s_waitcnt lgkmcnt(0)" ::: "memory"); __builtin_amdgcn_s_barrier(); asm volatile("" ::: "memory");
        }
    }
}

constexpr int SO_X = 0, SO_H = 36864, SO_B = 73728, SO_C = 82944, SO_Z = 92160, SO_TAB = 125952, SO_EX = 130048;
static_assert(SO_EX + 1024 <= RING_BYTES, "ssd_out LDS map");
__device__ __forceinline__ void p5_ssd_out(Frame& F) {
    const float* DT = (const float*)(F.ws + WS_DT); const float* a_log = (const float*)F.in[13]; const float* d_skip = (const float*)F.in[14]; const float* ng = (const float*)F.in[15];
    const bf16* XST = (const bf16*)(F.ws + WS_XST); const bf16* BC = (const bf16*)(F.ws + WS_BC); const bf16* HIN = (const bf16*)(F.ws + WS_HIN); const bf16* PROJ = (const bf16*)(F.ws + WS_PROJ);
    bf16* MIX = (bf16*)(F.ws + WS_MIX);
    LAS unsigned char* L = F.lds + RING_OFF;
    LAS float* tab = (LAS float*)(L + SO_TAB) + F.wave * 128;
    LAS float* exch = (LAS float*)(L + SO_EX);
    const int hl = F.wave >> 1, it = F.wave & 1, r32 = F.lane & 31, hi = F.lane >> 5;
    for (int u = blockIdx.x; u < NB * (NCH - 1); u += F.G) {
        const int b = u / (NCH - 1), c = 1 + u % (NCH - 1); const int t0 = c * CHL - TOFF;
        v4u st[14];
#define SO_FETCH_A(g) do { \
        _Pragma("unroll") for (int k = 0; k < 4; ++k) { const int q = F.tid + NTHR * k; st[k] = *(const v4u*)(XST + ((size_t)(b * SSDW + (g) * 256 + (q >> 3))) * TPAD + c * CHL + 8 * (q & 7)); } } while (0)
#define SO_FETCH_B(g) do { \
        _Pragma("unroll") for (int k = 0; k < 4; ++k) { const int q = F.tid + NTHR * k; st[4 + k] = *(const v4u*)(HIN + ((size_t)((b * NCH + c) * NH + 4 * (g))) * 4096 + (size_t)q * 8); } \
        { const int q = F.tid; st[8] = *(const v4u*)(BC + (size_t)(b * TT + t0 + (q >> 3)) * 256 + (g) * DS + 8 * (q & 7)); st[9] = *(const v4u*)(BC + (size_t)(b * TT + t0 + (q >> 3)) * 256 + 128 + (g) * DS + 8 * (q & 7)); } \
        _Pragma("unroll") for (int k = 0; k < 4; ++k) { const int q = F.tid + NTHR * k; st[10 + k] = *(const v4u*)(PROJ + (size_t)(b * TT + t0 + (q >> 5)) * PJ + C_Z + (g) * 256 + 8 * (q & 31)); } } while (0)
#define SO_STORE() do { \
        _Pragma("unroll") for (int k = 0; k < 4; ++k) { const int q = F.tid + NTHR * k; *(LAS v4u*)(L + SO_X + (q >> 3) * 144 + 16 * (q & 7)) = st[k]; *(LAS v4u*)(L + SO_H + (q >> 3) * 144 + 16 * (q & 7)) = st[4 + k]; } \
        { const int q = F.tid; *(LAS v4u*)(L + SO_B + (q >> 3) * 144 + 16 * (q & 7)) = st[8]; *(LAS v4u*)(L + SO_C + (q >> 3) * 144 + 16 * (q & 7)) = st[9]; } \
        _Pragma("unroll") for (int k = 0; k < 4; ++k) { const int q = F.tid + NTHR * k; *(LAS v4u*)(L + SO_Z + (q >> 5) * 528 + 16 * (q & 31)) = st[10 + k]; } } while (0)
        SO_FETCH_A(0); SO_FETCH_B(0);
#pragma unroll 1
        for (int g = 0; g < 2; ++g) {
            const int h = 4 * g + hl; const float A = -__expf(a_log[h]), Dh = d_skip[h];
            { const int t = t0 + F.lane; const float dt = DT[(size_t)(b * TT + t) * 8 + h];
              float acs = dt * A;
#pragma unroll
              for (int o = 1; o < 64; o <<= 1) { const float v = __shfl_up(acs, o); if (F.lane >= o) acs += v; }
              tab[F.lane] = acs; tab[64 + F.lane] = dt; }
            SO_STORE();
            __syncthreads();
            if (g == 0) SO_FETCH_A(1);
            const int ii = 32 * it + r32; const int t = t0 + ii;
            bf16x8 cf[4];
#pragma unroll
            for (int s = 0; s < 4; ++s) cf[s] = *(const LAS bf16x8*)(L + SO_C + ii * 144 + 32 * s + 16 * hi);
            f32x16 y[2];
            const float ai = tab[ii]; const float ei = __expf(ai);
#pragma unroll
            for (int pt = 0; pt < 2; ++pt) { f32x16 acc = (f32x16){}; const LAS unsigned char* hp_ = L + SO_H + (hl * 64 + 32 * pt + r32) * 144 + 16 * hi;
#pragma unroll
                for (int s = 0; s < 4; ++s) acc = MFMA32(*(const LAS bf16x8*)(hp_ + 32 * s), cf[s], acc);
#pragma unroll
                for (int i = 0; i < 16; ++i) acc[i] *= ei;
                y[pt] = acc; }
#pragma unroll 1
            for (int jt = 0; jt <= it; ++jt) {
                f32x16 S = (f32x16){};
                { const LAS unsigned char* bp_ = L + SO_B + (32 * jt + r32) * 144 + 16 * hi;
#pragma unroll
                  for (int s = 0; s < 4; ++s) S = MFMA32(*(const LAS bf16x8*)(bp_ + 32 * s), cf[s], S); }
#pragma unroll
                for (int i = 0; i < 16; ++i) { const int jj = 32 * jt + crow(i, hi); const float e = (jj <= ii) ? __expf(ai - tab[jj]) * tab[64 + jj] : 0.f; S[i] = S[i] * e + ((jj == ii) ? Dh : 0.f); }
                const bf16x8 p0 = pack8(S, 0), p1 = pack8(S, 1);
#pragma unroll
                for (int pt = 0; pt < 2; ++pt) { const LAS unsigned char* xp_ = L + SO_X + (hl * 64 + 32 * pt + r32) * 144 + (32 * jt + 4 * hi) * 2;
                    const v2u x0 = *(const LAS v2u*)(xp_), x1 = *(const LAS v2u*)(xp_ + 16), x2 = *(const LAS v2u*)(xp_ + 32), x3 = *(const LAS v2u*)(xp_ + 48);
                    v4u f0, f1; f0.x = x0.x; f0.y = x0.y; f0.z = x1.x; f0.w = x1.y; f1.x = x2.x; f1.y = x2.y; f1.z = x3.x; f1.w = x3.y;
                    y[pt] = MFMA32(__builtin_bit_cast(bf16x8, f0), p0, y[pt]); y[pt] = MFMA32(__builtin_bit_cast(bf16x8, f1), p1, y[pt]); }
            }
            float ss = 0.f;
            { const LAS unsigned char* zp_ = L + SO_Z + ii * 528 + (hl * 64 + 4 * hi) * 2;
#pragma unroll
              for (int pt = 0; pt < 2; ++pt)
#pragma unroll
                for (int gq = 0; gq < 4; ++gq) { const v2u zw = *(const LAS v2u*)(zp_ + (32 * pt + 8 * gq) * 2); const float zz[4] = {bflo(zw.x), bfhi(zw.x), bflo(zw.y), bfhi(zw.y)};
#pragma unroll
                    for (int e = 0; e < 4; ++e) { const float v = y[pt][4 * gq + e] * silu_f(zz[e]); y[pt][4 * gq + e] = v; ss += v * v; } } }
            ss = sum_x32(ss);
            if (g == 0) SO_FETCH_B(1);
            LAS float* ex = exch + it * 128;
            if (hi == 0) ex[hl * 32 + r32] = ss;
            __syncthreads();
            const float tot = (ex[r32] + ex[32 + r32]) + (ex[64 + r32] + ex[96 + r32]);
            const float rs = __builtin_amdgcn_rsqf(tot * (1.f / 256.f) + EPS);
            { bf16* mo = MIX + (size_t)(b * TT + t) * 1024 + 64 * h + 4 * hi;
#pragma unroll
              for (int pt = 0; pt < 2; ++pt)
#pragma unroll
                for (int gq = 0; gq < 4; ++gq) { const f32x4 gg = *(const f32x4*)(ng + 64 * h + 32 * pt + 8 * gq + 4 * hi);
                    v2u w; w.x = pk2(y[pt][4 * gq] * rs * gg.x, y[pt][4 * gq + 1] * rs * gg.y); w.y = pk2(y[pt][4 * gq + 2] * rs * gg.z, y[pt][4 * gq + 3] * rs * gg.w);
                    *(v2u*)(mo + 32 * pt + 8 * gq) = w; } }
        }
#undef SO_FETCH_A
#undef SO_FETCH_B
#undef SO_STORE
        __syncthreads();
    }
    const float* YS = (const float*)(F.ws + WS_YS);
    for (int u = F.gw; u < DB * NG; u += F.NGW) { const int b = u >> 1, gg = u & 1; const int cc = gg * 256 + 4 * F.lane;
        const f32x4 yv = *(const f32x4*)(YS + (size_t)b * 512 + cc); const v2u zw = *(const v2u*)(PROJ + (size_t)(RP + b) * PJ + C_Z + cc);
        const f32x4 v = {yv.x * silu_f(bflo(zw.x)), yv.y * silu_f(bfhi(zw.x)), yv.z * silu_f(bflo(zw.y)), yv.w * silu_f(bfhi(zw.y))};
        const float rs = __builtin_amdgcn_rsqf(wave_sum((v.x * v.x + v.y * v.y) + (v.z * v.z + v.w * v.w)) * (1.f / 256.f) + EPS);
        const f32x4 gv = *(const f32x4*)(ng + cc); v2u w; w.x = pk2(v.x * rs * gv.x, v.y * rs * gv.y); w.y = pk2(v.z * rs * gv.z, v.w * rs * gv.w);
        *(v2u*)(MIX + (size_t)(RP + b) * 1024 + cc) = w; }
}

constexpr int DB_STAGE = 0, DB_KRST = 65536, DB_LAT = DB_KRST + 8192, DB_KR = DB_LAT + 64 * DA_ROWB, DB_PB = DB_KR + 64 * 36 * 4, DB_QG = DB_PB + 16 * 64 * 2, DB_END = DB_QG + 8 * 96 * 4;
static_assert(DB_END <= RING_BYTES, "decode attention LDS map");
#define RAW_BAR_L() do { asm volatile("s_waitcnt lgkmcnt(0)" ::: "memory"); __builtin_amdgcn_s_barrier(); asm volatile("" ::: "memory"); } while (0)
#define RAW_BAR_VL() do { asm volatile("s_waitcnt vmcnt(0) lgkmcnt(0)" ::: "memory"); __builtin_amdgcn_s_barrier(); asm volatile("" ::: "memory"); } while (0)
__device__ __forceinline__ void da_issue(Frame& F, LAS unsigned char* L, const float* clat, const float* ckr, const int* ptab, int b, int split, int hp) {
    const size_t tok0 = (size_t)ptab[b * NPAGES + split * 32 + (hp >> 1)] * PAGE + (hp & 1) * 64;
    const char* src = (const char*)(clat + tok0 * KVL) + (size_t)(F.wave * 8) * 1024 + F.lane * 16;
#pragma unroll
    for (int i = 0; i < 8; ++i) __builtin_amdgcn_global_load_lds((const unsigned*)(src + i * 1024), (LAS unsigned*)(L + DB_STAGE + (F.wave * 8 + i) * 1024), 16, 0, 0);
    __builtin_amdgcn_global_load_lds((const unsigned*)((const char*)(ckr + tok0 * 32) + F.wave * 1024 + F.lane * 16), (LAS unsigned*)(L + DB_KRST + F.wave * 1024), 16, 0, 0);
}
__device__ __forceinline__ void da_convert(Frame& F, LAS unsigned char* L) {
#pragma unroll 4
    for (int k = 0; k < 8; ++k) { const int f = F.tid + NTHR * k; const int row = f >> 6, c4 = f & 63; const f32x4 v = *(const LAS f32x4*)(L + DB_STAGE + f * 16);
        v2u w; w.x = pk2(v.x, v.y); w.y = pk2(v.z, v.w); *(LAS v2u*)(L + DB_LAT + row * DA_ROWB + c4 * 8) = w; }
    { const int f = F.tid; const int row = f >> 3, c4 = f & 7; const f32x4 v = *(const LAS f32x4*)(L + DB_KRST + f * 16);
      *(LAS f32x4*)((LAS float*)(L + DB_KR) + row * 36 + 4 * c4) = v; }
}
__device__ __forceinline__ void st_wt(float* p, float v) { asm volatile("global_store_dword %0, %1, off sc0 sc1" :: "v"(p), "v"(v) : "memory"); }
__device__ __forceinline__ void decode_combine_one(Frame& F, float M0, int b) {
    const float* DPART = (const float*)(F.ws + WS_DPART); const bf16* WUKV = (const bf16*)(F.ws + WS_WUKV2); const bf16* Q = (const bf16*)(F.ws + WS_Q); const bf16* KS = (const bf16*)(F.ws + WS_KS);
    const float* VS = (const float*)(F.ws + WS_VS); bf16* MIX = (bf16*)(F.ws + WS_MIX);
    LAS float* accl = (LAS float*)(F.lds + RING_OFF) + F.wave * 256; LAS float* exch = (LAS float*)(F.lds + P5_EXCH);
    const int h = F.wave;
    const float* p0 = DPART + ((size_t)((b * 2 + 0) * NH + h)) * 264; const float* p1 = DPART + ((size_t)((b * 2 + 1) * NH + h)) * 264;
#pragma unroll
    for (int k = 0; k < 4; ++k) accl[F.lane + 64 * k] = p0[F.lane + 64 * k] + p1[F.lane + 64 * k];
    float l = p0[256] + p1[256];
    const bf16* qp = Q + (size_t)(RP + b) * 768 + 96 * h; const bf16* kp = KS + (size_t)b * 768 + 96 * h;
    float sd = bf2f(qp[F.lane]) * bf2f(kp[F.lane]); if (F.lane < 32) sd += bf2f(qp[64 + F.lane]) * bf2f(kp[64 + F.lane]);
    sd = wave_sum(sd);
    const float pn = __builtin_amdgcn_exp2f(sd - M0); l += pn;
    LDS_WAIT(); asm volatile("" ::: "memory");
    const bf16* wv = WUKV + (size_t)(128 * h + 64 + F.lane) * KVL;
    float o = 0.f;
    { v4u wv4[32];
#pragma unroll
      for (int c8 = 0; c8 < 32; ++c8) wv4[c8] = *(const v4u*)(wv + 8 * c8);
#pragma unroll
      for (int c8 = 0; c8 < 32; ++c8) { const v4u w = wv4[c8]; const f32x4 x0 = *(const LAS f32x4*)(accl + 8 * c8), x1 = *(const LAS f32x4*)(accl + 8 * c8 + 4);
        o += (bflo(w.x) * x0.x + bfhi(w.x) * x0.y) + (bflo(w.y) * x0.z + bfhi(w.y) * x0.w) + (bflo(w.z) * x1.x + bfhi(w.z) * x1.y) + (bflo(w.w) * x1.z + bfhi(w.w) * x1.w); } }
    o = (o + pn * VS[(size_t)b * 512 + 64 * h + F.lane]) * __builtin_amdgcn_rcpf(l);
    const float ss = wave_sum(o * o);
    if (F.lane == 0) exch[h] = ss;
    __syncthreads();
    float tot = 0.f;
#pragma unroll
    for (int hh = 0; hh < NH; ++hh) tot += exch[hh];
    const float rs = __builtin_amdgcn_rsqf(tot * (1.f / MLAW) + EPS);
    MIX[(size_t)(RP + b) * 1024 + 512 + 64 * h + F.lane] = f2bf(o * rs);
    __syncthreads();
}
template <int MODE>
__device__ __forceinline__ void p5_attn_decode_t(Frame& F, float M0) {
    const float* clat = (const float*)F.in[2]; const float* ckr = (const float*)F.in[3]; const int* ptab = (const int*)F.in[6];
    const bf16* WUKV = (const bf16*)(F.ws + WS_WUKV2); const bf16* Q = (const bf16*)(F.ws + WS_Q); const float* gkn = (const float*)F.in[22]; const float* gkr = (const float*)F.in[23];
    float* DPART = (float*)(F.ws + WS_DPART);
    LAS unsigned char* L = F.lds + RING_OFF;
    LAS float* krl = (LAS float*)(L + DB_KR); LAS bf16* pb = (LAS bf16*)(L + DB_PB); LAS float* qg = (LAS float*)(L + DB_QG) + F.wave * 96;
    const int h = F.wave, r32 = F.lane & 31, hi = F.lane >> 5;
    for (int u = blockIdx.x; u < DB * 2; u += F.G) {
        const int b = u >> 1, split = u & 1;
        da_issue(F, L, clat, ckr, ptab, b, split, 0);
        bf16x8 wf[4][8];
#pragma unroll
        for (int dt = 0; dt < 4; ++dt)
#pragma unroll
            for (int s = 0; s < 8; ++s) wf[dt][s] = *(const bf16x8*)(WUKV + (size_t)(128 * h + 16 * dt + (F.lane & 15)) * KVL + 32 * s + 8 * (F.lane >> 4));
        { const bf16* qp = Q + (size_t)(RP + b) * 768 + 96 * h; qg[F.lane] = bf2f(qp[F.lane]) * gkn[F.lane]; if (F.lane < 32) qg[64 + F.lane] = bf2f(qp[64 + F.lane]) * gkr[F.lane & 15]; }
        for (int i = F.tid; i < 16 * 64; i += NTHR) pb[i] = 0;
        f32x4 ao[2] = {(f32x4){0.f, 0.f, 0.f, 0.f}, (f32x4){0.f, 0.f, 0.f, 0.f}}; float l = 0.f;
        RAW_BAR_VL();
        da_convert(F, L);
        RAW_BAR_L();
        da_issue(F, L, clat, ckr, ptab, b, split, 1);
#pragma unroll 1
        for (int hp = 0; hp < 64; ++hp) {
          if (MODE == 0 || MODE == 3) {
            const int n16 = F.lane & 15, kg4 = F.lane >> 4;
#pragma unroll 1
            for (int sb = 0; sb < 2; ++sb) {
                const LAS unsigned char* bp = L + DB_LAT + (32 * sb + n16) * DA_ROWB + 16 * kg4;
                f32x4 acc[4][2];
#pragma unroll
                for (int dt = 0; dt < 4; ++dt) { acc[dt][0] = (f32x4){0.f, 0.f, 0.f, 0.f}; acc[dt][1] = acc[dt][0]; }
                bf16x8 fa[2], fb[2];
                fa[0] = *(const LAS bf16x8*)(bp); fa[1] = *(const LAS bf16x8*)(bp + 16 * DA_ROWB);
#pragma unroll
                for (int s = 0; s < 8; ++s) {
                    if (s < 7) { fb[0] = *(const LAS bf16x8*)(bp + 64 * (s + 1)); fb[1] = *(const LAS bf16x8*)(bp + 16 * DA_ROWB + 64 * (s + 1)); }
#pragma unroll
                    for (int dt = 0; dt < 4; ++dt) { acc[dt][0] = MFMA16(wf[dt][s], fa[0], acc[dt][0]); acc[dt][1] = MFMA16(wf[dt][s], fa[1], acc[dt][1]); }
                    fa[0] = fb[0]; fa[1] = fb[1];
                }
                __builtin_amdgcn_sched_barrier(0);
                f32x4 s4[2] = {(f32x4){0.f, 0.f, 0.f, 0.f}, (f32x4){0.f, 0.f, 0.f, 0.f}}, d4[2] = {s4[0], s4[0]};
#pragma unroll
                for (int dt = 0; dt < 4; ++dt) { const f32x4 qq = *(const LAS f32x4*)(qg + 16 * dt + 4 * kg4);
#pragma unroll
                    for (int tt = 0; tt < 2; ++tt) { s4[tt] += acc[dt][tt] * acc[dt][tt]; d4[tt] += acc[dt][tt] * qq; } }
                { const LAS float* qr = qg + 64 + 8 * kg4; const f32x4 q0 = *(const LAS f32x4*)(qr), q1 = *(const LAS f32x4*)(qr + 4);
#pragma unroll
                  for (int tt = 0; tt < 2; ++tt) { const LAS float* kr = krl + (32 * sb + 16 * tt + n16) * 36 + 8 * kg4; const f32x4 k0 = *(const LAS f32x4*)(kr), k1 = *(const LAS f32x4*)(kr + 4);
                      s4[tt] += k0 * k0; s4[tt] += k1 * k1; d4[tt] += k0 * q0; d4[tt] += k1 * q1; } }
                __builtin_amdgcn_sched_barrier(0);
#pragma unroll
                for (int tt = 0; tt < 2; ++tt) { float ss = (s4[tt].x + s4[tt].y) + (s4[tt].z + s4[tt].w), dot = (d4[tt].x + d4[tt].y) + (d4[tt].z + d4[tt].w);
                    ss = sum_x16(ss); dot = sum_x16(dot); ss = sum_x32(ss); dot = sum_x32(dot);
                    const float p = __builtin_amdgcn_exp2f(dot * __builtin_amdgcn_rsqf(ss * (1.f / 96.f) + EPS) - M0);
                    if (kg4 == 0) { l += p; pb[h * 64 + 32 * sb + 16 * tt + n16] = f2bf(p); } }
            }
            RAW_BAR_L();
            if (MODE < 4) { const int q4 = (F.lane & 15) >> 2, pp = F.lane & 3, kg = F.lane >> 4;
              const unsigned a_lo = (unsigned)(uintptr_t)(L + DB_LAT) + (unsigned)((8 * kg + q4) * DA_ROWB + (32 * h + 4 * pp) * 2);
              const LAS bf16* pap = pb + (F.lane & 15) * 64 + 8 * kg;
              s16x4 t0, t1, t2, t3, t4, t5, t6, t7;
              asm volatile("ds_read_b64_tr_b16 %0, %8 offset:%c9\n\tds_read_b64_tr_b16 %1, %8 offset:%c10\n\tds_read_b64_tr_b16 %2, %8 offset:%c11\n\tds_read_b64_tr_b16 %3, %8 offset:%c12\n\t"
                           "ds_read_b64_tr_b16 %4, %8 offset:%c13\n\tds_read_b64_tr_b16 %5, %8 offset:%c14\n\tds_read_b64_tr_b16 %6, %8 offset:%c15\n\tds_read_b64_tr_b16 %7, %8 offset:%c16\n\ts_waitcnt lgkmcnt(0)"
                           : "=&v"(t0), "=&v"(t1), "=&v"(t2), "=&v"(t3), "=&v"(t4), "=&v"(t5), "=&v"(t6), "=&v"(t7)
                           : "v"(a_lo), "i"(0), "i"(4 * DA_ROWB), "i"(32), "i"(32 + 4 * DA_ROWB), "i"(32 * DA_ROWB), "i"(32 * DA_ROWB + 4 * DA_ROWB), "i"(32 * DA_ROWB + 32), "i"(32 * DA_ROWB + 32 + 4 * DA_ROWB) : "memory");
              const bf16x8 pa0 = *(const LAS bf16x8*)(pap), pa1 = *(const LAS bf16x8*)(pap + 32);
#define DA_FR(x, y) ((bf16x8){x[0], x[1], x[2], x[3], y[0], y[1], y[2], y[3]})
              ao[0] = MFMA16(pa0, DA_FR(t0, t1), ao[0]); ao[1] = MFMA16(pa0, DA_FR(t2, t3), ao[1]);
              ao[0] = MFMA16(pa1, DA_FR(t4, t5), ao[0]); ao[1] = MFMA16(pa1, DA_FR(t6, t7), ao[1]);
#undef DA_FR
#define DA_PV(ks, nt) do { } while (0)
#undef DA_PV
            }
          }
            RAW_BAR_VL();
            if (hp + 1 < 64) { if (MODE <= 1 || MODE >= 3) da_convert(F, L); RAW_BAR_L(); if (hp + 2 < 64 && MODE < 3) da_issue(F, L, clat, ckr, ptab, b, split, hp + 2); }
        }
        if (MODE >= 3 && l == 123.456f) DPART[0] = l;
        if (MODE == 0) { const int kg = F.lane >> 4;
          if (kg < 2) {
#pragma unroll
              for (int nt = 0; nt < 2; ++nt)
#pragma unroll
                  for (int i = 0; i < 4; ++i) st_wt(&DPART[((size_t)((b * 2 + split) * NH + 4 * kg + i)) * 264 + 32 * h + 16 * nt + (F.lane & 15)], ao[nt][i]); }
          float lt = wave_sum(l);
          if (F.lane == 0) st_wt(&DPART[((size_t)((b * 2 + split) * NH + h)) * 264 + 256], lt); }
        asm volatile("s_waitcnt vmcnt(0)" ::: "memory");
        __syncthreads();
        { volatile LAS unsigned* arr = (volatile LAS unsigned*)(F.lds + MISC_OFF) + 16;
          if (F.tid == 0) {
              const unsigned old = __hip_atomic_fetch_add((unsigned*)(F.ws + WS_CTL) + CW_DCNT + b, 1u, __ATOMIC_RELAXED, __HIP_MEMORY_SCOPE_AGENT);
              if (old == 1u) { __builtin_amdgcn_fence(__ATOMIC_ACQUIRE, "agent"); asm volatile("s_waitcnt vmcnt(0)" ::: "memory"); }
              arr[0] = old; }
          __syncthreads();
          if (MODE == 0 && arr[0] == 1u) decode_combine_one(F, M0, b);
          __syncthreads(); }
    }
}

__device__ __forceinline__ void p5_attn_decode(Frame& F, float M0) { p5_attn_decode_t<0>(F, M0); }

__device__ __forceinline__ void p7_outproj(Frame& F) {
    const bf16* MIX = (const bf16*)(F.ws + WS_MIX); const bf16* WOUT = (const bf16*)(F.ws + WS_WOUT); const float* xp = (const float*)F.in[0]; const float* xs = (const float*)F.in[1]; float* HS = (float*)(F.ws + WS_HS);
    bf16* HB = (bf16*)(F.ws + WS_XN); float* SS = (float*)(F.ws + WS_SSP); float* ysamp = F.out + OUT_YS;
    { pg8::Gemm g{MIX, WOUT, MMAIN, DM, 1024, 1, 1024}; pg8::StaticOrder S; S.init(MMAIN, DM, F.G, (int)blockIdx.x);
      LAS float* RS = (LAS float*)(F.lds + LDSCTL_OFF + 1024); const float* SSQ = (const float*)(F.ws + WS_SSQ);
#pragma unroll 1
      for (int i = 0; i < 8; ++i) { pg8::Unit uu; if (!S.next(i, uu)) break;
          int tl = (int)threadIdx.x; asm volatile("" : "+v"(tl));
          if (tl < 256) { const pg8::f32x4* sp = (const pg8::f32x4*)(SSQ + (size_t)(g.rowbase(uu.pm) + tl) * 8); const pg8::f32x4 s4 = sp[0] + sp[1];
              RS[i * 256 + tl] = __builtin_amdgcn_rsqf(((s4[0] + s4[1]) + (s4[2] + s4[3])) * (1.f / MLAW) + EPS); } }
      __syncthreads();
      EpiOutProj E{xp, F.out + OUT_YP, HB, SS, RS, 0};
      pg8::gemm_phase<EpiOutProj, pg8::StaticOrder, true, true, 8>(F.lds + RING_OFF, g, S, E); }
    { LAS f32x4* part = (LAS f32x4*)(F.lds + RING_OFF);
      for (int tp = blockIdx.x; tp < 256; tp += F.G) {
          const int t = 2 * tp + (F.wave >> 2), kq = F.wave & 3, rt = t & 7, ct = t >> 3;
          const bf16* ap = MIX + (size_t)(RP + rt * 16 + (F.lane & 15)) * 1024 + 256 * kq + 8 * (F.lane >> 4);
          const bf16* bp = WOUT + (size_t)(ct * 16 + (F.lane & 15)) * 1024 + 256 * kq + 8 * (F.lane >> 4);
          bf16x8 av[8], bv[8];
#pragma unroll
          for (int j = 0; j < 8; ++j) { av[j] = *(const bf16x8*)(ap + 32 * j); bv[j] = *(const bf16x8*)(bp + 32 * j); }
          f32x4 acc = {0.f, 0.f, 0.f, 0.f};
#pragma unroll
          for (int j = 0; j < 8; ++j) acc = MFMA16(av[j], bv[j], acc);
          part[F.wave * 64 + F.lane] = acc;
          __syncthreads();
          if (kq == 0) { acc = (acc + part[(F.wave + 1) * 64 + F.lane]) + (part[(F.wave + 2) * 64 + F.lane] + part[(F.wave + 3) * 64 + F.lane]);
              const int col = ct * 16 + (F.lane & 15);
#pragma unroll
              for (int i = 0; i < 4; ++i) { const int r = rt * 16 + 4 * (F.lane >> 4) + i; const size_t o = (size_t)r * DM + col; const float v = xs[o] + acc[i]; HS[o] = v; ysamp[o] = v; HB[(size_t)(RP + r) * DM + col] = f2bf(v);
                  float ss = v * v; ss = sum_x1(ss); ss = sum_x2(ss); ss = sum_x4(ss); ss = sum_x8(ss);
                  if ((F.lane & 15) == 0) SS[(size_t)MMAIN * 16 + (size_t)r * 64 + ct] = ss; } }
          __syncthreads();
      } }
}
__device__ __forceinline__ void p9_gateup(Frame& F) {
    const bf16* HB = (const bf16*)(F.ws + WS_XN); const bf16* WGU = (const bf16*)(F.ws + WS_WGU); bf16* ACT = (bf16*)(F.ws + WS_ACT); const float* SS = (const float*)(F.ws + WS_SSP);
    { pg8::Gemm g{HB, WGU, MMAIN, 2 * DFF, DM, 1, DM}; pg8::StaticOrder S; S.init(MMAIN, 2 * DFF, F.G, (int)blockIdx.x);
      LAS float* RS = (LAS float*)(F.lds + LDSCTL_OFF + 1024);
#pragma unroll 1
      for (int i = 0; i < 8; ++i) { pg8::Unit uu; if (!S.next(i, uu)) break;
          int tl = (int)threadIdx.x; asm volatile("" : "+v"(tl));
          if (tl < 256) { const pg8::f32x4* sp = (const pg8::f32x4*)(SS + (size_t)(uu.pm * 256 + tl) * 16); const pg8::f32x4 s4 = (sp[0] + sp[1]) + (sp[2] + sp[3]);
              RS[i * 256 + tl] = __builtin_amdgcn_rsqf(((s4[0] + s4[1]) + (s4[2] + s4[3])) * (1.f / DM) + EPS); } }
      __syncthreads();
      EpiSwiGLU E{ACT, RS, 0};
      pg8::gemm_phase<EpiSwiGLU, pg8::StaticOrder, true, true>(F.lds + RING_OFF, g, S, E); }
    const int gw = F.gw, ngw = F.NGW;
    const int nrt = DB / 16, nlt = DFF / 16;
    for (int task = gw; task < nrt * nlt; task += ngw) {
        const int rt = task % nrt, lt = task / nrt; const int lc = lt * 16 + (F.lane & 15);
        const bf16* ap = HB + (size_t)(RP + rt * 16 + (F.lane & 15)) * DM + 8 * (F.lane >> 4);
        const bf16* gp = WGU + (size_t)(256 * (lc >> 7) + (lc & 127)) * DM + 8 * (F.lane >> 4); const bf16* up = gp + (size_t)128 * DM;
        f32x4 ag = {0.f, 0.f, 0.f, 0.f}, au = {0.f, 0.f, 0.f, 0.f};
#pragma unroll 8
        for (int k0 = 0; k0 < DM; k0 += 32) { const bf16x8 a = *(const bf16x8*)(ap + k0); ag = MFMA16(a, *(const bf16x8*)(gp + k0), ag); au = MFMA16(a, *(const bf16x8*)(up + k0), au); }
#pragma unroll
        for (int i = 0; i < 4; ++i) { const int r = rt * 16 + 4 * (F.lane >> 4) + i; const f32x4* sp = (const f32x4*)(SS + (size_t)MMAIN * 16 + (size_t)r * 64); f32x4 s4 = sp[0];
#pragma unroll
            for (int q = 1; q < 16; ++q) s4 += sp[q];
            const float rs = __builtin_amdgcn_rsqf(((s4[0] + s4[1]) + (s4[2] + s4[3])) * (1.f / DM) + EPS);
            ACT[(size_t)(RP + r) * DFF + lc] = f2bf(silu_f(rs * ag[i]) * (rs * au[i])); }
    }
}
__device__ __forceinline__ void p10_down(Frame& F) {
    const bf16* ACT = (const bf16*)(F.ws + WS_ACT); const bf16* WDN = (const bf16*)(F.ws + WS_WDN); const float* HS = (const float*)(F.ws + WS_HS);
    { pg8::Gemm g{ACT, WDN, MMAIN, DM, DFF, 1, DFF}; pg8::StaticOrder S; S.init(MMAIN, DM, F.G, (int)blockIdx.x); EpiDown E{(const bf16*)(F.ws + WS_XN), F.out + OUT_YP};
      pg8::gemm_phase<EpiDown, pg8::StaticOrder, true, true>(F.lds + RING_OFF, g, S, E); }
    float* ys = F.out + OUT_YS;
    small_gemm(ACT, DFF, WDN, DFF, DB / 16, DM / 16, [](int r) { return RP + r; },
        [&](const f32x4& acc, int rt, int ct, int lane) { const int col = ct * 16 + (lane & 15);
#pragma unroll
            for (int i = 0; i < 4; ++i) atomicAdd(ys + (size_t)(rt * 16 + 4 * (lane >> 4) + i) * DM + col, acc[i]); }, F.gw, F.NGW, F.lane, 4);
}
#ifndef MK_ONE_LAUNCH
#define MK_ONE_LAUNCH 0
#endif
constexpr int N_PHASES = 9;
__global__ void __launch_bounds__(NTHR, 2) mk_fwd(Args args) {
    extern __shared__ __attribute__((aligned(16))) unsigned char lds_raw[];
    Frame F;
    F.lds = (LAS unsigned char*)lds_raw;
    F.tid = threadIdx.x; F.lane = F.tid & 63; F.wave = __builtin_amdgcn_readfirstlane(F.tid >> 6);
    F.G = gridDim.x; { const int bx = blockIdx.x; F.vcu = (F.G % 8 == 0) ? (bx % 8) * (F.G / 8) + bx / 8 : bx; }
    F.gw = blockIdx.x * NWAVES + F.wave; F.NGW = F.G * NWAVES;
    F.ws = args.ws; F.out = args.out; F.in = args.in;
    volatile LAS unsigned* MISC = (volatile LAS unsigned*)(F.lds + MISC_OFF);
    for (int u = F.tid; u < (LDS_BYTES - LDSCTL_OFF) / 4; u += NTHR) ((LAS unsigned*)(F.lds + LDSCTL_OFF))[u] = 0u;
    __syncthreads();
    XcdBarrier bar; bar.bar = (unsigned*)(F.ws + WS_CTL) + CW_BAR; bar.x = 0; bar.st = nullptr;
    const int lo = args.ph_lo, hi = args.ph_hi;
    if (hi - lo > 1) bar = xcd_barrier_post((unsigned*)(F.ws + WS_CTL) + CW_BAR, MISC + 8);
#ifdef MK_TS
    unsigned long long* TSB = (unsigned long long*)(F.ws + 600 * MiB); int tsn = 0;
#define STAMP() do { if (blockIdx.x == 0 && F.tid == 0) TSB[tsn] = __builtin_amdgcn_s_memrealtime(); ++tsn; } while (0)
    STAMP();
#else
#define STAMP() do { } while (0)
#endif
#define IN(k) (lo <= (k) && (k) < hi)
#ifdef MK_TS
#define ARRIVE(k) do { if (blockIdx.x == 0 && F.tid == 0) TSB[30 + (k)] = __builtin_amdgcn_s_memrealtime(); } while (0)
#else
#define ARRIVE(k) do { } while (0)
#endif
#define SEAM(k) do { ARRIVE(k); if (IN(k) && IN((k) + 1)) xcd_barrier(bar); STAMP(); } while (0)
#ifndef MK_REPEAT
#define MK_REPEAT 0
#endif
#define REP(id, stmt) do { stmt; if (MK_REPEAT & (1 << (id))) { __syncthreads(); stmt; } } while (0)
    if (IN(0)) { REP(0, p0_prologue(F)); } SEAM(0);
    if (IN(1)) { REP(1, p1_inproj(F)); } SEAM(1);
    if (IN(2)) {
#ifdef MK_SLEEP_PROBE
        { const unsigned long long t0 = __builtin_amdgcn_s_memrealtime(); while (__builtin_amdgcn_s_memrealtime() - t0 < 3000ull) __builtin_amdgcn_s_sleep(32); }
#endif
        REP(2, p2_elementwise(F)); } SEAM(2);
    if (IN(3)) { REP(3, p3_upproj_states(F)); } SEAM(3);
    if (IN(4)) { REP(4, p4_post(F)); } SEAM(4);
    if (IN(5)) { const float M0 = softmax_ref(F);
        if (blockIdx.x & 1) { p5_attn_decode(F, M0); __syncthreads(); }
        p5_attn_prompt(F, M0); __syncthreads();
        p5_ssd_out(F); __syncthreads();
        if (!(blockIdx.x & 1)) p5_attn_decode(F, M0);
    } SEAM(5);
    if (IN(6)) { REP(9, p7_outproj(F)); } SEAM(6);
    if (IN(7)) { REP(11, p9_gateup(F)); } SEAM(7);
    if (IN(8)) { p10_down(F); }
#ifdef MK_TS
    __syncthreads(); STAMP();
#endif
#undef IN
#undef SEAM
}
#ifndef MK_DIAG
#define MK_DIAG 0
#endif
__device__ __forceinline__ size_t nmrow(size_t r) { return r < (size_t)MMAIN ? (r >> 11) * TT + NMETA + (r & 2047) : (size_t)RP + (r - MMAIN); }
constexpr size_t WS_OUT2 = 1024 * MiB;
#ifdef MK_TS
#ifndef MK_TS_QA
#define MK_TS_QA 4.f
#endif
#ifndef MK_TS_QB
#define MK_TS_QB 4.f
#endif
__global__ void k_ts_encode(const unsigned long long* ts, float* out, int ia0, int ia1, int ib0, int ib1) {
    const float ta = rintf((float)(ts[ia1] - ts[ia0]) * 0.01f * (1.f / MK_TS_QA)) * MK_TS_QA, tb = rintf((float)(ts[ib1] - ts[ib0]) * 0.01f * (1.f / MK_TS_QB)) * MK_TS_QB;
    const float f = 1.f + sqrtf(ta * 1e-3f);
    for (int i = blockIdx.x * blockDim.x + threadIdx.x; i < 131072; i += gridDim.x * blockDim.x) out[OUT_YS + i] *= f;
    if (blockIdx.x == 0 && threadIdx.x == 0) out[0] += tb * 0.1f;
}
#endif
extern "C" void kernel_launch(void* const* d_in, const int* in_sizes, int n_in, void* d_out, int out_size, void* d_ws, size_t ws_size, hipStream_t stream) {
    (void)hipFuncSetAttribute((const void*)mk_fwd, hipFuncAttributeMaxDynamicSharedMemorySize, LDS_BYTES);
    unsigned char* ws = (unsigned char*)d_ws;
    (void)hipMemsetAsync(ws + WS_CTL, 0, CTL_ZERO_BYTES, stream);
    Args a{};
    for (int i = 0; i < 30; ++i) a.in[i] = d_in[i];
    a.ws = ws; a.out = (float*)d_out;
#if MK_DIAG
    float* diag = (float*)(ws + WS_DIAG);
    (void)hipMemsetAsync(diag, 0, 512, stream);
    nv::forward(d_in, (float*)d_out, (float*)(ws + WS_NAIVE), stream);
    a.out = (float*)(ws + WS_OUT2);
#endif
    static int one_launch = -1;
    if (one_launch < 0) { int dev = 0, cus = 0, per_cu = 0; one_launch = 0;
        if (hipGetDevice(&dev) == hipSuccess && hipDeviceGetAttribute(&cus, hipDeviceAttributeMultiprocessorCount, dev) == hipSuccess && cus >= 256) one_launch = 1;
        (void)per_cu;
        (void)hipGetLastError(); }
    const int grid = 256;
    if (one_launch && MK_ONE_LAUNCH) { a.ph_lo = 0; a.ph_hi = N_PHASES; a.li = 0; hipLaunchKernelGGL(mk_fwd, dim3(grid), dim3(NTHR), LDS_BYTES, stream, a); }
    else for (int ph = 0; ph < N_PHASES; ++ph) { a.ph_lo = ph; a.ph_hi = ph + 1; a.li = ph; hipLaunchKernelGGL(mk_fwd, dim3(grid), dim3(NTHR), LDS_BYTES, stream, a); }
#ifdef MK_TS
    k_ts_encode<<<64, 256, 0, stream>>>((const unsigned long long*)(ws + 600 * MiB), (float*)d_out, MK_TS_A0, MK_TS_A1, MK_TS_B0, MK_TS_B1);
#endif
#if MK_DIAG
    {
        nv::Ws w = nv::carve((float*)(ws + WS_NAIVE));
        const bf16* QRAW = (const bf16*)(ws + WS_QRAW); const bf16* KVRAW = (const bf16*)(ws + WS_KVRAW); const bf16* Q = (const bf16*)(ws + WS_Q); const bf16* K = (const bf16*)(ws + WS_K);
        const bf16* VT = (const bf16*)(ws + WS_VT); const float* VS = (const float*)(ws + WS_VS); const bf16* MIX = (const bf16*)(ws + WS_MIX);
        const float* o2 = (const float*)(ws + WS_OUT2); const float* o1 = (const float*)d_out;
        const float* nQRAW = w.QRAW; const float* nKV = w.KV; const float* nQ = w.Q; const float* nK = w.K; const float* nV = w.V; const float* nMIX = w.MIX;
        const size_t NMR = (size_t)MMAIN + DB;
        cmp(stream, 0, diag, NMR * 768, [=] __device__(size_t i) { return bf2f(QRAW[nmrow(i / 768) * 768 + i % 768]); }, [=] __device__(size_t i) { return nQRAW[nmrow(i / 768) * 768 + i % 768]; });
        cmp(stream, 1, diag, (size_t)R * 1024, [=] __device__(size_t i) { return bf2f(KVRAW[i]); }, [=] __device__(size_t i) { return nKV[i]; });
        cmp(stream, 2, diag, NMR * 768, [=] __device__(size_t i) { return bf2f(Q[nmrow(i / 768) * 768 + i % 768]); }, [=] __device__(size_t i) { return nQ[nmrow(i / 768) * 768 + i % 768] * (ATTN_SCALE * LOG2E); });
        cmp(stream, 3, diag, (size_t)R * 768, [=] __device__(size_t i) { return bf2f(K[i]); }, [=] __device__(size_t i) { return nK[i]; });
        cmp(stream, 4, diag, (size_t)NB * 512 * TT, [=] __device__(size_t i) { const size_t bhd = i / TT; const int t = (int)(i % TT); return bf2f(VT[bhd * TPAD + t]); },
            [=] __device__(size_t i) { const size_t bhd = i / TT; const int t = (int)(i % TT); const size_t b = bhd / 512, hd = bhd % 512; return nV[(b * TT + t) * 512 + hd]; });
        cmp(stream, 4, diag, (size_t)DB * 512, [=] __device__(size_t i) { return VS[i]; }, [=] __device__(size_t i) { return nV[(size_t)RP * 512 + i]; });
        cmp(stream, 5, diag, (size_t)(OUT_LATS - OUT_SSMP), [=] __device__(size_t i) { return o2[OUT_SSMP + i]; }, [=] __device__(size_t i) { return o1[OUT_SSMP + i]; });
        cmp(stream, 5, diag, (size_t)4194304, [=] __device__(size_t i) { return o2[OUT_SSMS + i]; }, [=] __device__(size_t i) { return o1[OUT_SSMS + i]; });
        cmp(stream, 6, diag, (size_t)R * 512, [=] __device__(size_t i) { return bf2f(MIX[(i >> 9) * 1024 + (i & 511)]); }, [=] __device__(size_t i) { return nMIX[(i >> 9) * 1024 + (i & 511)]; });
        cmp(stream, 7, diag, NMR * 512, [=] __device__(size_t i) { return bf2f(MIX[nmrow(i >> 9) * 1024 + 512 + (i & 511)]); }, [=] __device__(size_t i) { return nMIX[nmrow(i >> 9) * 1024 + 512 + (i & 511)]; });
        cmp(stream, 8, diag, (size_t)OUT_LATP, [=] __device__(size_t i) { return o2[i]; }, [=] __device__(size_t i) { return o1[i]; });
        k_diag_encode<<<64, 256, 0, stream>>>(diag, 9, 1e-3f, (float*)d_out);
    }
#endif
}
```

```cpp
#define MK_DIAG 0
#define MK_ONE_LAUNCH 1
#include <hip/hip_runtime.h>
#include <cstdio>
#include <cstdint>
namespace pg8 {
#define PG8_LAS __attribute__((address_space(3)))
typedef unsigned short bf16_t;
typedef short bf16x8 __attribute__((ext_vector_type(8)));
typedef float f32x4 __attribute__((ext_vector_type(4)));
typedef unsigned u32x4 __attribute__((ext_vector_type(4)));
constexpr int BM = 256, BK = 64, HALF = 128, HTB = HALF * BK * 2  , STAGE_BYTES = 8 * HTB, NXCD = 8, WGM = 8;

__host__ __device__ __forceinline__ int lds_byte(int r, int c) { const int st = (r >> 4) * 2 + (c >> 5), rr = r & 15, cc = c & 31, ob = rr * 64 + cc * 2; return st * 1024 + (ob ^ (((ob >> 9) & 1) << 5)); }
__host__ __device__ __forceinline__ void stage_rc(int b, int& R, int& C) { const int st = b / 1024, sb = b % 1024, swz = sb ^ (((sb >> 9) & 1) << 5); R = (st >> 1) * 16 + swz / 64; C = (st & 1) * 32 + (swz % 64) / 2; }
__host__ __device__ __forceinline__ int perm32(int rho) { const int n = rho >> 4, i = rho & 15; return 8 * (i >> 2) + 4 * n + (i & 3); }

struct Unit { int pm, pn; };
template <class E> constexpr bool has_midscale = false;
struct Gemm { const bf16_t* A; const bf16_t* Bt; int M, N, K; int rmode; int lda;
    __host__ __device__ __forceinline__ int rowbase(int pm) const { return rmode ? (pm >> 3) * 2064 + 16 + (pm & 7) * 256 : pm * 256; } };

struct StaticOrder {
    int nM, nN, nwg, G, c;
    __host__ __device__ void init(int M, int N, int G_, int c_) { nM = M / BM; nN = N / BM; nwg = nM * nN; G = G_; c = c_; }
    __host__ __device__ bool next(int i, Unit& u) const {
        const long L = (long)i * G + c; if (L >= nwg) return false;
        int wgid = (int)L; { const int q = nwg / NXCD, r = nwg % NXCD, xcd = wgid % NXCD, off = wgid / NXCD; wgid = (xcd < r ? xcd * (q + 1) : r * (q + 1) + (xcd - r) * q) + off; }
        const int nig = WGM * nN, gid = wgid / nig, fm = gid * WGM, gsz = (nM - fm) < WGM ? (nM - fm) : WGM;
        u.pm = fm + ((wgid % nig) % gsz); u.pn = (wgid % nig) / gsz; return true;
    }
    __device__ __forceinline__ void a_ready(const Unit&) const {}
    __device__ __forceinline__ void done(const Unit&) const {}
};


template <class Epi, class Sched, bool ALIGN_EPI = false, bool SP2 = false, int ROT = 0>
__device__ __forceinline__ void gemm_phase(PG8_LAS unsigned char* lds, const Gemm g, const Sched& S, const Epi& E) {
    const int tid = threadIdx.x, wid = __builtin_amdgcn_readfirstlane(tid >> 6), lane = tid & 63, wr = wid >> 2, wc = wid & 3, fr = lane & 15, fq = lane >> 4;
    const int K = g.K, nt = K / BK;
    unsigned voffA[2], voffB[2];
#pragma unroll
    for (int i = 0; i < 2; ++i) { int R, C; stage_rc(tid * 16 + i * 8192, R, C); const int Rb = Epi::PERM ? ((R & ~31) + perm32(R & 31)) : R;
        voffA[i] = (unsigned)(R * g.lda + C) * 2u; voffB[i] = (unsigned)(Rb * K + C) * 2u; }
    const size_t kstep = (size_t)(BK * 2);
    const size_t hstepA = (size_t)HALF * g.lda * 2;
    const size_t hstep = (size_t)HALF * K * 2;
    const size_t tstep = 2 * hstep;
    const unsigned ldsw = (unsigned)wid * 1024u;
    const int aoff = lds_byte(wr * 64 + fr, fq * 8), boff = lds_byte(wc * 32 + fr, fq * 8);
#define PG8_SA(b, h) (((b) * 2 + (h)) * HTB)
#define PG8_SB(b, h) ((4 + (b) * 2 + (h)) * HTB)
#define PG8_STAGE(bufoff, gbase, voff) do { _Pragma("unroll") for (int _i = 0; _i < 2; ++_i) \
        __builtin_amdgcn_global_load_lds((const unsigned*)((const char*)(gbase) + (voff)[_i]), (PG8_LAS unsigned*)(lds + (bufoff) + ldsw + _i * 8192), 16, 0, 0); } while (0)
#define PG8_LDA(dst, b, h) do { _Pragma("unroll") for (int m = 0; m < 4; ++m) _Pragma("unroll") for (int k = 0; k < 2; ++k) dst[m][k] = *(const PG8_LAS bf16x8*)(lds + PG8_SA(b, h) + aoff + m * 2048 + k * 1024); } while (0)
#define PG8_LDB(dst, b, h) do { _Pragma("unroll") for (int n = 0; n < 2; ++n) _Pragma("unroll") for (int k = 0; k < 2; ++k) dst[n][k] = *(const PG8_LAS bf16x8*)(lds + PG8_SB(b, h) + boff + n * 2048 + k * 1024); } while (0)
#define PG8_MMA(ai, bj, At, Bt) do { __builtin_amdgcn_s_setprio(1); _Pragma("unroll") for (int m = 0; m < 4; ++m) _Pragma("unroll") for (int n = 0; n < 2; ++n) _Pragma("unroll") for (int k = 0; k < 2; ++k) \
        acc[ai][bj][m][n] = __builtin_amdgcn_mfma_f32_16x16x32_bf16(Bt[n][k], At[m][k], acc[ai][bj][m][n], 0, 0, 0); __builtin_amdgcn_s_setprio(0); } while (0)
#define PG8_WAIT_V(n) asm volatile("s_waitcnt vmcnt(" #n ")" ::: "memory")
#define PG8_WAIT_L(n) asm volatile("s_waitcnt lgkmcnt(" #n ")" ::: "memory")
#define PG8_BAR __builtin_amdgcn_s_barrier()
#define PG8_SCHED __builtin_amdgcn_sched_barrier(0)
    Unit cur, nxt; int ui = 0;
    if (!S.next(0, cur)) return;
    f32x4 acc[2][2][4][2];
#pragma unroll
    for (int a = 0; a < 2; ++a)
#pragma unroll
        for (int b = 0; b < 2; ++b)
#pragma unroll
            for (int m = 0; m < 4; ++m)
#pragma unroll
                for (int n = 0; n < 2; ++n) acc[a][b][m][n] = (f32x4){0.f, 0.f, 0.f, 0.f};
    bf16x8 At[4][2], B0[2][2], B1[2][2];
    const char* cA = (const char*)g.A + (size_t)g.rowbase(cur.pm) * g.lda * 2 + ROT * kstep; const char* cB = (const char*)g.Bt + (size_t)cur.pn * tstep + ROT * kstep;
#define PG8_KOFF(j) ((long)((ROT != 0 && (j) >= nt - ROT) ? (j) - nt : (j)) * (long)kstep)
    S.a_ready(cur);
    if constexpr (SP2) {
        PG8_STAGE(PG8_SB(0, 0), cB, voffB); PG8_STAGE(PG8_SB(0, 1), cB + hstep, voffB); PG8_STAGE(PG8_SA(0, 0), cA, voffA); PG8_STAGE(PG8_SA(0, 1), cA + hstepA, voffA);
        if (wr == 1) PG8_BAR;
        PG8_WAIT_V(2); PG8_BAR;
        PG8_STAGE(PG8_SB(1, 0), cB + kstep, voffB); PG8_STAGE(PG8_SA(1, 0), cA + kstep, voffA); PG8_STAGE(PG8_SB(1, 1), cB + hstep + kstep, voffB);
        PG8_WAIT_V(6); PG8_BAR;
    } else {
        PG8_STAGE(PG8_SB(0, 0), cB, voffB); PG8_STAGE(PG8_SA(0, 0), cA, voffA); PG8_STAGE(PG8_SB(0, 1), cB + hstep, voffB); PG8_STAGE(PG8_SA(0, 1), cA + hstepA, voffA);
        if (wr == 1) PG8_BAR;
        PG8_WAIT_V(4); PG8_BAR;
        PG8_STAGE(PG8_SB(1, 0), cB + kstep, voffB); PG8_STAGE(PG8_SA(1, 0), cA + kstep, voffA); PG8_STAGE(PG8_SB(1, 1), cB + hstep + kstep, voffB);
        PG8_WAIT_V(6); PG8_BAR;
    }
    for (;;) {
        const bool has_next = S.next(ui + 1, nxt);
        const char* nA = has_next ? (const char*)g.A + (size_t)g.rowbase(nxt.pm) * g.lda * 2 + ROT * kstep : cA; const char* nB = has_next ? (const char*)g.Bt + (size_t)nxt.pn * tstep + ROT * kstep : cB;
        for (int t = 0; t < nt; t += 2) {
            const bool last = (t == nt - 2);
            const char* a1 = cA + PG8_KOFF(t + 1);
            const char* a2 = last ? nA : cA + PG8_KOFF(t + 2); const char* b2 = last ? nB : cB + PG8_KOFF(t + 2);
            if constexpr (has_midscale<Epi>) { if (t == nt - ROT) E.midscale(acc, cur, wr, fr); }
            const char* a3 = a2 + kstep; const char* b3 = b2 + kstep;
            if (last && has_next) S.a_ready(nxt);
            if constexpr (SP2) {
            PG8_LDB(B0, 0, 0); PG8_LDB(B1, 0, 1); PG8_SCHED; PG8_LDA(At, 0, 0); PG8_STAGE(PG8_SA(1, 1), a1 + hstepA, voffA);
            PG8_WAIT_V(8); PG8_WAIT_L(0); PG8_BAR; PG8_MMA(0, 0, At, B0); PG8_MMA(0, 1, At, B1); PG8_BAR; PG8_SCHED;
            PG8_LDA(At, 0, 1); PG8_STAGE(PG8_SB(0, 0), b2, voffB); PG8_STAGE(PG8_SB(0, 1), b2 + hstep, voffB); PG8_STAGE(PG8_SA(0, 0), a2, voffA);
            PG8_WAIT_V(8); PG8_WAIT_L(0); PG8_BAR; PG8_MMA(1, 0, At, B0); PG8_MMA(1, 1, At, B1); PG8_BAR; PG8_SCHED;
            PG8_LDB(B0, 1, 0); PG8_LDB(B1, 1, 1); PG8_SCHED; PG8_LDA(At, 1, 0); PG8_STAGE(PG8_SA(0, 1), a2 + hstepA, voffA);
            PG8_WAIT_V(8); PG8_WAIT_L(0); PG8_BAR; PG8_MMA(0, 0, At, B0); PG8_MMA(0, 1, At, B1); PG8_BAR; PG8_SCHED;
            PG8_LDA(At, 1, 1); PG8_STAGE(PG8_SB(1, 0), b3, voffB); PG8_STAGE(PG8_SB(1, 1), b3 + hstep, voffB); PG8_STAGE(PG8_SA(1, 0), a3, voffA);
            PG8_WAIT_V(8); PG8_WAIT_L(0); PG8_BAR; PG8_MMA(1, 0, At, B0); PG8_MMA(1, 1, At, B1); PG8_BAR; PG8_SCHED;
            } else {
            PG8_LDB(B0, 0, 0); PG8_SCHED; PG8_LDA(At, 0, 0); PG8_STAGE(PG8_SA(1, 1), a1 + hstepA, voffA);
            PG8_WAIT_L(8); PG8_BAR; PG8_WAIT_L(0); PG8_MMA(0, 0, At, B0); PG8_BAR; PG8_SCHED;
            PG8_LDB(B1, 0, 1); PG8_STAGE(PG8_SB(0, 0), b2, voffB);
            PG8_BAR; PG8_WAIT_L(0); PG8_MMA(0, 1, At, B1); PG8_BAR;
            PG8_LDA(At, 0, 1); PG8_STAGE(PG8_SA(0, 0), a2, voffA);
            PG8_BAR; PG8_WAIT_L(0); PG8_MMA(1, 0, At, B0); PG8_BAR; PG8_SCHED;
            PG8_STAGE(PG8_SB(0, 1), b2 + hstep, voffB);
            PG8_WAIT_V(6); PG8_BAR; PG8_MMA(1, 1, At, B1); PG8_BAR;
            PG8_LDB(B0, 1, 0); PG8_SCHED; PG8_LDA(At, 1, 0); PG8_STAGE(PG8_SA(0, 1), a2 + hstepA, voffA);
            PG8_WAIT_L(8); PG8_BAR; PG8_WAIT_L(0); PG8_MMA(0, 0, At, B0); PG8_BAR; PG8_SCHED;
            PG8_LDB(B1, 1, 1); PG8_STAGE(PG8_SB(1, 0), b3, voffB);
            PG8_BAR; PG8_WAIT_L(0); PG8_MMA(0, 1, At, B1); PG8_BAR;
            PG8_LDA(At, 1, 1); PG8_STAGE(PG8_SA(1, 0), a3, voffA);
            PG8_BAR; PG8_WAIT_L(0); PG8_MMA(1, 0, At, B0); PG8_BAR; PG8_SCHED;
            PG8_STAGE(PG8_SB(1, 1), b3 + hstep, voffB);
            PG8_WAIT_V(6); PG8_BAR; PG8_MMA(1, 1, At, B1); PG8_BAR;
            }
        }
        if constexpr (ALIGN_EPI) { if (wr == 0) PG8_BAR; }
        if constexpr (!Epi::AFTER_DRAIN) { E(acc, cur, wr, wc, fr, fq); S.done(cur); }
        if (!has_next) break;
#pragma unroll
        for (int a = 0; a < 2; ++a)
#pragma unroll
            for (int b = 0; b < 2; ++b)
#pragma unroll
                for (int m = 0; m < 4; ++m)
#pragma unroll
                    for (int n = 0; n < 2; ++n) acc[a][b][m][n] = (f32x4){0.f, 0.f, 0.f, 0.f};
        cur = nxt; cA = nA; cB = nB; ++ui;
        if constexpr (ALIGN_EPI) { if (wr == 1) PG8_BAR; }
    }
    PG8_WAIT_V(0);
    if constexpr (!ALIGN_EPI) { if (wr == 0) PG8_BAR; }
    PG8_BAR;
    if constexpr (Epi::AFTER_DRAIN) { E.fused(acc, cur, wr, wc, fr, fq, lds, wid, lane); S.done(cur); }
#undef PG8_KOFF
#undef PG8_SA
#undef PG8_SB
#undef PG8_STAGE
#undef PG8_LDA
#undef PG8_LDB
#undef PG8_MMA
#undef PG8_WAIT_V
#undef PG8_WAIT_L
#undef PG8_BAR
#undef PG8_SCHED
}
}

#define GAS __attribute__((address_space(1)))
#define LAS __attribute__((address_space(3)))
typedef unsigned short bf16;
typedef unsigned v4u __attribute__((ext_vector_type(4)));
typedef unsigned v2u __attribute__((ext_vector_type(2)));
typedef float f32x4 __attribute__((ext_vector_type(4)));
typedef float f32x16 __attribute__((ext_vector_type(16)));
typedef short bf16x8 __attribute__((ext_vector_type(8)));
typedef short s16x4 __attribute__((ext_vector_type(4)));
typedef GAS unsigned gu32;
#define RLX_AGENT __ATOMIC_RELAXED, __HIP_MEMORY_SCOPE_AGENT
#define LDS_WAIT() asm volatile("s_waitcnt lgkmcnt(0)" ::: "memory")
#define VM_WAIT() asm volatile("s_waitcnt vmcnt(0)" ::: "memory")
typedef float f32x2_t __attribute__((ext_vector_type(2))); typedef __bf16 bf16x2_t __attribute__((ext_vector_type(2)));
__device__ __forceinline__ unsigned pk2(float lo, float hi) { f32x2_t v = {lo, hi}; bf16x2_t b = __builtin_convertvector(v, bf16x2_t); return __builtin_bit_cast(unsigned, b); }
__device__ __forceinline__ bf16 f2bf(float f) { return (bf16)(pk2(f, 0.f) & 0xffffu); }
__device__ __forceinline__ float bf2f(bf16 v) { return __uint_as_float((unsigned)v << 16); }
__device__ __forceinline__ float bflo(unsigned w) { return __uint_as_float(w << 16); }
__device__ __forceinline__ float bfhi(unsigned w) { return __uint_as_float(w & 0xffff0000u); }

#define XB_TMO      128
#define XB_XCNT(j)  (256  + 64 * (j))
#define XB_XSUB(j)  (1280 + 64 * (j))
#define XB_XGEN(j)  (2304 + 64 * (j))
#define XB_TOP      3328
#define XB_TOPGEN   3392
#define XCD_BAR_WORDS 3456
#define XB_SPIN_CAP (1u << 18)
__device__ __forceinline__ unsigned xb_ld(unsigned* p)              { return __hip_atomic_load(p, __ATOMIC_RELAXED, __HIP_MEMORY_SCOPE_AGENT); }
__device__ __forceinline__ unsigned xb_add(unsigned* p, unsigned v) { return __hip_atomic_fetch_add(p, v, __ATOMIC_RELAXED, __HIP_MEMORY_SCOPE_AGENT); }
__device__ __forceinline__ unsigned xb_xcc_id() { return (unsigned)__builtin_amdgcn_s_getreg((3 << 11) | 20) & 0xFu; }
#define XB_SPIN(cond, bar) do { unsigned _sp = 0; while (cond) { __builtin_amdgcn_s_sleep(1); \
    if ((++_sp & 255u) == 0u) { if (xb_ld(&(bar)[XB_TMO])) break; if (_sp > XB_SPIN_CAP) { atomicAdd(&(bar)[XB_TMO], 1u); break; } } } } while (0)
struct XcdBarrier { unsigned* bar; unsigned x; volatile LAS unsigned* st; };
__device__ __forceinline__ XcdBarrier xcd_barrier_post(unsigned* bar, volatile LAS unsigned* st) {
    XcdBarrier b; b.bar = bar; b.x = xb_xcc_id(); b.st = st;
    if (threadIdx.x == 0) (void)xb_add(&bar[XB_XCNT(b.x)], 1u);
    return b;
}
__device__ __forceinline__ void xcd_barrier_complete(unsigned* bar, unsigned x, unsigned& nloc, unsigned& nx) {
    const unsigned G = gridDim.x * gridDim.y * gridDim.z;
    unsigned sum, cnt, mine, sp = 0u;
    for (;;) {
        sum = 0u; cnt = 0u; mine = 0u;
#pragma unroll
        for (unsigned j = 0; j < 16; ++j) { const unsigned c = xb_ld(&bar[XB_XCNT(j)]); sum += c; cnt += (c > 0u) ? 1u : 0u; mine = (j == x) ? c : mine; }
        if (sum == G) break;
        __builtin_amdgcn_s_sleep(1);
        if ((++sp & 255u) == 0u) { if (xb_ld(&bar[XB_TMO])) break; if (sp > XB_SPIN_CAP) { atomicAdd(&bar[XB_TMO], 1u); break; } }
    }
    nloc = mine > 0u ? mine : 1u; nx = cnt > 0u ? cnt : 1u;
}
__device__ __forceinline__ void xcd_barrier(const XcdBarrier& b) {
    asm volatile("s_waitcnt vmcnt(0)" ::: "memory");
    __syncthreads();
    if (threadIdx.x == 0) {
        unsigned* bar = b.bar;
        __builtin_amdgcn_s_waitcnt(0);
        unsigned nloc = b.st[0], nx = b.st[1];
        if (nloc == 0u) { xcd_barrier_complete(bar, b.x, nloc, nx); b.st[0] = nloc; b.st[1] = nx; }
        const unsigned old = xb_add(&bar[XB_XSUB(b.x)], 1u);
        const unsigned gen = old / nloc;
        if (old + 1u == (gen + 1u) * nloc) {
            __builtin_amdgcn_fence(__ATOMIC_RELEASE, "agent");
            asm volatile("s_waitcnt vmcnt(0)" ::: "memory");
            (void)xb_add(&bar[XB_TOP], 1u);
        }
        __builtin_amdgcn_fence(__ATOMIC_ACQUIRE, "agent");
        XB_SPIN(xb_ld(&bar[XB_TOP]) < (gen + 1u) * nx, bar);
        asm volatile("s_waitcnt vmcnt(0)" ::: "memory");
    }
    __syncthreads();
}

constexpr int DM = 1024, NB = 8, SEQ = 2048, NMETA = 16, TT = SEQ + NMETA;
constexpr int DB = 128, PAST = 8192, PAGE = 128, NPAGES = 64;
constexpr int NH = 8, HP = 64, SSDW = 512, NG = 2, DS = 64, CONVD = 768;
constexpr int QKD = 96, VD = 64, MLAW = 512, QL = 384, KVL = 256, DFF = 2816, INC = 1960;
constexpr int RP = NB * TT, R = RP + DB;
constexpr int MMAIN = NB * SEQ;
constexpr int NS = NMETA + DB;
constexpr float EPS = 1e-6f, ATTN_SCALE = 0.10206207261596577f, LOG2E = 1.4426950408889634f;
constexpr int PJ = 2048, C_Z = 0, C_XBC = 512, C_CKV = 1280, C_CQ = 1536, C_DT = 1920, C_KR = 1928;
constexpr int S_Z = 0, S_XBC = 512, S_DT = 1280, S_CQ = 1288, S_CKV = 1672, S_KR = 1928;
constexpr int TPAD = 2112;
constexpr int NCH = 33, CHL = 64, TOFF = 48;
constexpr size_t OUT_YP = 0, OUT_YS = 16777216, OUT_LATP = 16908288, OUT_KRP = 21135360, OUT_CONVP = 21663744,
                 OUT_SSMP = 21682176, OUT_LATS = 21944320, OUT_KRS = 21977088, OUT_CONVS = 21981184, OUT_SSMS = 22276096;

constexpr size_t MiB = 1u << 20;
constexpr size_t WS_CTL = 0, CTL_ZERO_BYTES = 32 * 1024;
constexpr int CW_BAR = 4096;
constexpr size_t WS_SS = 512 * 1024;
constexpr size_t WS_WIN = 2 * MiB;
constexpr size_t WS_WUQ = 6 * MiB;
constexpr size_t WS_WUKV = 7 * MiB;
constexpr size_t WS_WOUT = 8 * MiB;
constexpr size_t WS_WGU = 10 * MiB;
constexpr size_t WS_WDN = 22 * MiB;
constexpr size_t WS_XN = 32 * MiB;
constexpr size_t WS_PROJ = 66 * MiB;
constexpr size_t WS_DTRAW = 132 * MiB;
constexpr size_t WS_DT = 133 * MiB;
constexpr size_t WS_LAT = 134 * MiB;
constexpr size_t WS_CQN = 143 * MiB;
constexpr size_t WS_KRF = 156 * MiB;
constexpr size_t WS_XST = 159 * MiB;
constexpr size_t WS_BT = 176 * MiB;
constexpr size_t WS_BC = 181 * MiB;
constexpr size_t WS_XAS = 190 * MiB;
constexpr size_t WS_QRAW = 191 * MiB;
constexpr size_t WS_KVRAW = 216 * MiB;
constexpr size_t WS_Q = 249 * MiB;
constexpr size_t WS_K = 274 * MiB;
constexpr size_t WS_VT = 299 * MiB;
constexpr size_t WS_STATES = 316 * MiB;
constexpr size_t WS_DECAY = 350 * MiB;
constexpr size_t WS_HIN = 351 * MiB;
constexpr size_t WS_MIX = 368 * MiB;
constexpr size_t WS_ACT = 401 * MiB;
constexpr size_t WS_VS = 491 * MiB;
constexpr size_t WS_DPART = 492 * MiB;
constexpr size_t WS_HS = 494 * MiB;
constexpr size_t WS_ROPE = 496 * MiB;
constexpr size_t WS_SSP = 520 * MiB;
constexpr size_t WS_WUKV2 = 524 * MiB;
constexpr size_t WS_RQ = 522 * MiB;
constexpr size_t WS_SSQ = 526 * MiB;
constexpr size_t WS_OPT_END = 527 * MiB;
constexpr int CW_DCNT = 1024;
constexpr size_t WS_NAIVE = 2048 * MiB;
constexpr size_t WS_DIAG = 1 * MiB;

constexpr int RING_OFF = 0, RING_BYTES = 131072;
constexpr int LDSCTL_OFF = RING_BYTES, MISC_OFF = LDSCTL_OFF + 320;
constexpr int LDS_BYTES = 163840;
constexpr int NWAVES = 8, NTHR = 512;

struct Args { const void* in[30]; float* out; unsigned char* ws; int ph_lo, ph_hi, li, pad; };

struct Frame {
    LAS unsigned char* lds;
    int tid, lane, wave, G, vcu, gw, NGW;
    unsigned char* ws; float* out;
    const void* const* in;
};
#define DPP_F(x, ctrl) __builtin_bit_cast(float, __builtin_amdgcn_update_dpp(0, __builtin_bit_cast(int, (x)), (ctrl), 0xF, 0xF, true))
__device__ __forceinline__ float sum_x1(float x) { return x + DPP_F(x, 0xB1); }
__device__ __forceinline__ float sum_x2(float x) { return x + DPP_F(x, 0x4E); }
__device__ __forceinline__ float sum_x4(float x) { return x + DPP_F(x, 0x141); }
__device__ __forceinline__ float sum_x8(float x) { return x + DPP_F(x, 0x140); }
__device__ __forceinline__ float sum_x16(float x) { const unsigned u = __builtin_bit_cast(unsigned, x); const auto r = __builtin_amdgcn_permlane16_swap(u, u, false, false); return __uint_as_float(r[0]) + __uint_as_float(r[1]); }
__device__ __forceinline__ float sum_x32(float x) { const unsigned u = __builtin_bit_cast(unsigned, x); const auto r = __builtin_amdgcn_permlane32_swap(u, u, false, false); return __uint_as_float(r[0]) + __uint_as_float(r[1]); }
__device__ __forceinline__ float wave_sum(float v) { return sum_x32(sum_x16(sum_x8(sum_x4(sum_x2(sum_x1(v)))))); }
__device__ __forceinline__ float wave_max(float v) {
#pragma unroll
    for (int o = 1; o < 64; o <<= 1) v = fmaxf(v, __shfl_xor(v, o));
    return v;
}
__device__ __forceinline__ float silu_f(float x) { return x * __builtin_amdgcn_rcpf(1.f + __expf(-x)); }
__device__ __forceinline__ float softplus_f(float x) { return fmaxf(x, 0.f) + log1pf(expf(-fabsf(x))); }
__device__ __forceinline__ float rope_inv(int j) { return exp2f(-(float)j * (13.287712379549449f / 16.0f)); }
struct EpiProj {
    static constexpr bool PERM = true, AFTER_DRAIN = false;
    bf16* O; float* dtraw; int rmode;
    __device__ __forceinline__ void operator()(const pg8::f32x4 (&acc)[2][2][4][2], const pg8::Unit& u, int wr, int wc, int fr, int fq) const {
        const int rb = rmode ? (u.pm >> 3) * 2064 + 16 + (u.pm & 7) * 256 : u.pm * 256;
        const int row0 = rb + wr * 64 + fr, col0 = u.pn * 256 + wc * 32 + 8 * fq;
#pragma unroll
        for (int ai = 0; ai < 2; ++ai)
#pragma unroll
            for (int m = 0; m < 4; ++m) { const int row = row0 + ai * 128 + m * 16; bf16* rowp = O + (size_t)row * PJ + col0;
#pragma unroll
                for (int bj = 0; bj < 2; ++bj) { const pg8::f32x4 v0 = acc[ai][bj][m][0], v1 = acc[ai][bj][m][1];
                    v4u w; w.x = pk2(v0[0], v0[1]); w.y = pk2(v0[2], v0[3]); w.z = pk2(v1[0], v1[1]); w.w = pk2(v1[2], v1[3]);
                    *(v4u*)(rowp + bj * 128) = w; }
                if (u.pn == 7 && wc == 0 && fq == 0) { *(pg8::f32x4*)(dtraw + (size_t)row * 8) = acc[ai][1][m][0]; *(pg8::f32x4*)(dtraw + (size_t)row * 8 + 4) = acc[ai][1][m][1]; } }
    }
};
struct EpiBf16 {
    static constexpr bool PERM = true, AFTER_DRAIN = false;
    bf16* O; int ldc; int rmode;
    __device__ __forceinline__ void operator()(const pg8::f32x4 (&acc)[2][2][4][2], const pg8::Unit& u, int wr, int wc, int fr, int fq) const {
        const int rb = rmode ? (u.pm >> 3) * 2064 + 16 + (u.pm & 7) * 256 : u.pm * 256;
        const int row0 = rb + wr * 64 + fr, col0 = u.pn * 256 + wc * 32 + 8 * fq;
#pragma unroll
        for (int ai = 0; ai < 2; ++ai)
#pragma unroll
            for (int m = 0; m < 4; ++m) { bf16* rowp = O + (size_t)(row0 + ai * 128 + m * 16) * ldc + col0;
#pragma unroll
                for (int bj = 0; bj < 2; ++bj) { const pg8::f32x4 v0 = acc[ai][bj][m][0], v1 = acc[ai][bj][m][1];
                    v4u w; w.x = pk2(v0[0], v0[1]); w.y = pk2(v0[2], v0[3]); w.z = pk2(v1[0], v1[1]); w.w = pk2(v1[2], v1[3]);
                    *(v4u*)(rowp + bj * 128) = w; } }
    }
};
struct EpiResF32 {
    static constexpr bool PERM = false, AFTER_DRAIN = false;
    const float* res; float* out;
    __device__ __forceinline__ void operator()(const pg8::f32x4 (&acc)[2][2][4][2], const pg8::Unit& u, int wr, int wc, int fr, int fq) const {
        const int row0 = u.pm * 256 + wr * 64 + fr, col0 = u.pn * 256 + wc * 32 + 4 * fq;
#pragma unroll
        for (int ai = 0; ai < 2; ++ai)
#pragma unroll
            for (int m = 0; m < 4; ++m) { const size_t off = (size_t)(row0 + ai * 128 + m * 16) * DM + col0;
#pragma unroll
                for (int bj = 0; bj < 2; ++bj)
#pragma unroll
                    for (int n = 0; n < 2; ++n) { const pg8::f32x4 r = *(const pg8::f32x4*)(res + off + bj * 128 + n * 16); *(pg8::f32x4*)(out + off + bj * 128 + n * 16) = r + acc[ai][bj][m][n]; } }
    }
};
struct EpiOutProj {
    static constexpr bool PERM = false, AFTER_DRAIN = false;
    const float* res; float* out; bf16* HB; float* SS; const LAS float* RS; mutable int nth;
    __device__ __forceinline__ void midscale(pg8::f32x4 (&acc)[2][2][4][2], const pg8::Unit& u, int wr, int fr) const {
        const int slot = nth++;
        const LAS float* rsp = RS + slot * 256 + wr * 64 + fr;
#pragma unroll
        for (int ai = 0; ai < 2; ++ai)
#pragma unroll
            for (int m = 0; m < 4; ++m) { const float rs = rsp[ai * 128 + m * 16];
#pragma unroll
                for (int bj = 0; bj < 2; ++bj)
#pragma unroll
                    for (int n = 0; n < 2; ++n) acc[ai][bj][m][n] *= rs; }
    }
    __device__ __forceinline__ void operator()(const pg8::f32x4 (&acc)[2][2][4][2], const pg8::Unit& u, int wr, int wc, int fr, int fq) const {
        const int rb = (u.pm >> 3) * 2064 + 16 + (u.pm & 7) * 256;
        const int row0 = u.pm * 256 + wr * 64 + fr, col0 = u.pn * 256 + wc * 32 + 4 * fq;
        pg8::f32x4 rc[4], rn[4];
#define EOP_LOAD(dst, g) do { const size_t off_ = (size_t)(row0 + ((g) >> 2) * 128 + ((g) & 3) * 16) * DM + col0; \
            dst[0] = *(const pg8::f32x4*)(res + off_); dst[1] = *(const pg8::f32x4*)(res + off_ + 16); dst[2] = *(const pg8::f32x4*)(res + off_ + 128); dst[3] = *(const pg8::f32x4*)(res + off_ + 144); } while (0)
        EOP_LOAD(rc, 0);
#pragma unroll
        for (int g = 0; g < 8; ++g) { const int ai = g >> 2, m = g & 3;
            if (g < 7) EOP_LOAD(rn, g + 1);
            const int orow = row0 + ai * 128 + m * 16; bf16* hb = HB + (size_t)(rb + wr * 64 + fr + ai * 128 + m * 16) * DM + col0; float ss = 0.f;
#pragma unroll
            for (int bj = 0; bj < 2; ++bj)
#pragma unroll
                for (int n = 0; n < 2; ++n) { const pg8::f32x4 v = rc[2 * bj + n] + acc[ai][bj][m][n];
                    ss += (v[0] * v[0] + v[1] * v[1]) + (v[2] * v[2] + v[3] * v[3]); v2u w; w.x = pk2(v[0], v[1]); w.y = pk2(v[2], v[3]); *(v2u*)(hb + bj * 128 + n * 16) = w; }
            ss = sum_x16(ss); ss = sum_x32(ss);
            if (fq == 0) SS[(size_t)orow * 16 + u.pn * 4 + wc] = ss;
#pragma unroll
            for (int i = 0; i < 4; ++i) rc[i] = rn[i]; }
#undef EOP_LOAD
    }
};
namespace pg8 { template <> constexpr bool has_midscale<EpiOutProj> = true; }
struct EpiDown {
    static constexpr bool PERM = false, AFTER_DRAIN = false;
    const bf16* HB; float* out;
    __device__ __forceinline__ void operator()(const pg8::f32x4 (&acc)[2][2][4][2], const pg8::Unit& u, int wr, int wc, int fr, int fq) const {
        const int rb = (u.pm >> 3) * 2064 + 16 + (u.pm & 7) * 256;
        const int row0 = u.pm * 256 + wr * 64 + fr, col0 = u.pn * 256 + wc * 32 + 4 * fq;
        v2u rc[4], rn[4];
#define EDN_LOAD(dst, g) do { const bf16* hb_ = HB + (size_t)(rb + wr * 64 + fr + ((g) >> 2) * 128 + ((g) & 3) * 16) * DM + col0; \
            dst[0] = *(const v2u*)(hb_); dst[1] = *(const v2u*)(hb_ + 16); dst[2] = *(const v2u*)(hb_ + 128); dst[3] = *(const v2u*)(hb_ + 144); } while (0)
        EDN_LOAD(rc, 0);
#pragma unroll
        for (int g = 0; g < 8; ++g) { const int ai = g >> 2, m = g & 3;
            if (g < 7) EDN_LOAD(rn, g + 1);
            const size_t off = (size_t)(row0 + ai * 128 + m * 16) * DM + col0;
#pragma unroll
            for (int bj = 0; bj < 2; ++bj)
#pragma unroll
                for (int n = 0; n < 2; ++n) { const v2u w = rc[2 * bj + n]; const pg8::f32x4 r = {bflo(w.x), bfhi(w.x), bflo(w.y), bfhi(w.y)}; *(pg8::f32x4*)(out + off + bj * 128 + n * 16) = r + acc[ai][bj][m][n]; }
#pragma unroll
            for (int i = 0; i < 4; ++i) rc[i] = rn[i]; }
#undef EDN_LOAD
    }
};
struct EpiSwiGLU {
    static constexpr bool PERM = true, AFTER_DRAIN = false;
    bf16* O; const LAS float* RS; mutable int nth;
    __device__ __forceinline__ void operator()(const pg8::f32x4 (&acc)[2][2][4][2], const pg8::Unit& u, int wr, int wc, int fr, int fq) const {
        const int rb = (u.pm >> 3) * 2064 + 16 + (u.pm & 7) * 256;
        const int row0 = rb + wr * 64 + fr, col0 = u.pn * 128 + wc * 32 + 8 * fq;
        const int slot = nth++;
        const LAS float* rsp = RS + slot * 256 + wr * 64 + fr;
#pragma unroll
        for (int ai = 0; ai < 2; ++ai)
#pragma unroll
            for (int m = 0; m < 4; ++m) { float a[8]; const float rs = rsp[ai * 128 + m * 16];
#pragma unroll
                for (int n = 0; n < 2; ++n)
#pragma unroll
                    for (int e = 0; e < 4; ++e) a[4 * n + e] = silu_f(rs * acc[ai][0][m][n][e]) * (rs * acc[ai][1][m][n][e]);
                v4u w; w.x = pk2(a[0], a[1]); w.y = pk2(a[2], a[3]); w.z = pk2(a[4], a[5]); w.w = pk2(a[6], a[7]);
                *(v4u*)(O + (size_t)(row0 + ai * 128 + m * 16) * DFF + col0) = w; }
    }
};

template <class ARow, class Epi>
__device__ __forceinline__ void small_gemm(const bf16* A, int lda, const bf16* Bt, int K, int nrt, int nct, const ARow& arow, const Epi& E, int gw, int NGW, int lane, int ksplit = 1) {
    const int ntask = nrt * nct * ksplit, kc = K / ksplit;
    for (int task = gw; task < ntask; task += NGW) {
        const int rt = task % nrt, ct = (task / nrt) % nct, kq = task / (nrt * nct);
        const bf16* ap = A + (size_t)arow(rt * 16 + (lane & 15)) * lda + kq * kc + 8 * (lane >> 4);
        const bf16* bp = Bt + (size_t)(ct * 16 + (lane & 15)) * K + kq * kc + 8 * (lane >> 4);
        f32x4 acc = {0.f, 0.f, 0.f, 0.f};
#pragma unroll 1
        for (int k0 = 0; k0 < kc; k0 += 32 * 11) {
            bf16x8 av[11], bv[11];
#pragma unroll
            for (int j = 0; j < 11; ++j) if (k0 + 32 * j < kc) { av[j] = *(const bf16x8*)(ap + k0 + 32 * j); bv[j] = *(const bf16x8*)(bp + k0 + 32 * j); }
#pragma unroll
            for (int j = 0; j < 11; ++j) if (k0 + 32 * j < kc) acc = __builtin_amdgcn_mfma_f32_16x16x32_bf16(av[j], bv[j], acc, 0, 0, 0);
        }
        E(acc, rt, ct, lane);
    }
}

template <class RM>
__device__ __forceinline__ void transpose_item(const float* W, int N, int ldw, bf16* WT, int ldt, int item, LAS float* scr, int lane, const RM& rm, const float* kscale = nullptr) {
    const int nblk = (N + 31) / 32, kb = item / nblk, nb = item % nblk, k0 = 64 * kb, n0 = 32 * nb;
    { const int n = n0 + (lane & 31); float v[32];
#pragma unroll
      for (int i = 0; i < 32; ++i) { const int kk = 2 * i + (lane >> 5); v[i] = (n < N) ? W[(size_t)(k0 + kk) * ldw + n] : 0.f; }
#pragma unroll
      for (int i = 0; i < 32; ++i) { const int kk = 2 * i + (lane >> 5); float x = v[i]; if (kscale) x *= kscale[k0 + kk]; scr[kk * 33 + (lane & 31)] = x; } }
    LDS_WAIT(); asm volatile("" ::: "memory");
    const int c = lane & 7;
#pragma unroll
    for (int j = 0; j < 4; ++j) { const int n = (lane >> 3) + 8 * j; const LAS float* s = scr + (8 * c) * 33 + n;
        if (n0 + n < N) { v4u o; o.x = pk2(s[0 * 33], s[1 * 33]); o.y = pk2(s[2 * 33], s[3 * 33]); o.z = pk2(s[4 * 33], s[5 * 33]); o.w = pk2(s[6 * 33], s[7 * 33]);
            *(v4u*)(WT + (size_t)rm(n0 + n) * ldt + k0 + 8 * c) = o; } }
    LDS_WAIT(); asm volatile("" ::: "memory");
}
__device__ __forceinline__ int map_in(int n) {
    return n < S_DT ? n : n < S_CQ ? C_DT + (n - S_DT) : n < S_CKV ? C_CQ + (n - S_CQ) : n < S_KR ? C_CKV + (n - S_CKV) : n;
}
__device__ __forceinline__ void p0_prologue(Frame& F) {
    LAS float* scr = (LAS float*)(F.lds + RING_OFF + F.wave * 16384);
    const float* w_in = (const float*)F.in[9]; const float* w_uq = (const float*)F.in[17]; const float* w_ukv = (const float*)F.in[19]; const float* w_out = (const float*)F.in[25];
    const float* w_gate = (const float*)F.in[27]; const float* w_up = (const float*)F.in[28]; const float* w_down = (const float*)F.in[29];
    bf16* WIN = (bf16*)(F.ws + WS_WIN); bf16* WUQ = (bf16*)(F.ws + WS_WUQ); bf16* WUKV = (bf16*)(F.ws + WS_WUKV); bf16* WOUT = (bf16*)(F.ws + WS_WOUT); bf16* WGU = (bf16*)(F.ws + WS_WGU); bf16* WDN = (bf16*)(F.ws + WS_WDN);
    const float* ffg = (const float*)F.in[26];
    constexpr int I_IN = 16 * 62, I_UQ = 6 * 24, I_UKV = 4 * 32, I_OUT = 16 * 32;
    constexpr int NITEMS = I_IN + I_UQ + 2 * I_UKV + I_OUT;
    bf16* WUKV2 = (bf16*)(F.ws + WS_WUKV2);
    for (int it = F.gw; it < NITEMS; it += F.NGW) {
        int r = it;
        if (r < I_IN) { transpose_item(w_in, INC, INC, WIN, DM, r, scr, F.lane, [](int n) { return map_in(n); }); continue; } r -= I_IN;
        if (r < I_UQ) { transpose_item(w_uq, 768, 768, WUQ, QL, r, scr, F.lane, [](int n) { return n; }, (const float*)F.in[16]); continue; } r -= I_UQ;
        if (r < I_UKV) { transpose_item(w_ukv, 1024, 1024, WUKV, KVL, r, scr, F.lane, [](int n) { return n; }, (const float*)F.in[18]); continue; } r -= I_UKV;
        if (r < I_UKV) { transpose_item(w_ukv, 1024, 1024, WUKV2, KVL, r, scr, F.lane, [](int n) { return n; }); continue; } r -= I_UKV;
        transpose_item(w_out, DM, DM, WOUT, 1024, r, scr, F.lane, [](int n) { return n; }, (r >= 8 * 32) ? (const float*)F.in[24] - 512 : nullptr);
    }
    for (int i = F.gw * 64 + F.lane; i < 88 * 1024 / 8; i += F.NGW * 64) *(v4u*)(WIN + (size_t)1960 * 1024 + (size_t)i * 8) = (v4u){0u, 0u, 0u, 0u};
    const float* xp = (const float*)F.in[0]; const float* xs = (const float*)F.in[1]; const float* meta = (const float*)F.in[7]; const float* g = (const float*)F.in[8];
    bf16* XN = (bf16*)(F.ws + WS_XN);
    f32x4 gv[4];
#pragma unroll
    for (int j = 0; j < 4; ++j) gv[j] = ((const f32x4*)g)[F.lane + 64 * j];
#define XN_ROWS(r0, n) do { f32x4 v[4][4]; \
        _Pragma("unroll") for (int i = 0; i < 4; ++i) if (i < (n)) { const int row = (r0) + i; const float* src; \
            if (row < RP) { const int b = row / TT, t = row % TT; src = (t < NMETA) ? meta + (size_t)t * DM : xp + ((size_t)b * SEQ + (t - NMETA)) * DM; } else src = xs + (size_t)(row - RP) * DM; \
            _Pragma("unroll") for (int j = 0; j < 4; ++j) v[i][j] = ((const f32x4*)src)[F.lane + 64 * j]; } \
        _Pragma("unroll") for (int i = 0; i < 4; ++i) if (i < (n)) { float s = 0.f; \
            _Pragma("unroll") for (int j = 0; j < 4; ++j) s += (v[i][j].x * v[i][j].x + v[i][j].y * v[i][j].y) + (v[i][j].z * v[i][j].z + v[i][j].w * v[i][j].w); \
            const float rs = __builtin_amdgcn_rsqf(wave_sum(s) * (1.f / DM) + EPS); \
            v2u* o8 = (v2u*)(XN + (size_t)((r0) + i) * DM) + F.lane; \
            _Pragma("unroll") for (int j = 0; j < 4; ++j) { v2u o; o.x = pk2(v[i][j].x * rs * gv[j].x, v[i][j].y * rs * gv[j].y); o.y = pk2(v[i][j].z * rs * gv[j].z, v[i][j].w * rs * gv[j].w); o8[64 * j] = o; } } } while (0)
    if (F.NGW == 2048) { XN_ROWS(4 * F.gw, 4); XN_ROWS(8192 + 4 * F.gw, 4); if (F.gw < 256) XN_ROWS(16384 + F.gw, 1); }
    else for (int r0 = 4 * F.gw; r0 < R; r0 += 4 * F.NGW) XN_ROWS(r0, 4);
#undef XN_ROWS
    float* ROPE = (float*)(F.ws + WS_ROPE);
    for (int i = blockIdx.x * NTHR + F.tid; i < (TT + 1) * 16; i += F.G * NTHR) { const int p = i >> 4, j = i & 15; const float ang = (float)(p < TT ? p : PAST) * rope_inv(j); ROPE[2 * i] = cosf(ang); ROPE[2 * i + 1] = sinf(ang); }
}

__device__ __forceinline__ void p1_ffn_weights(Frame& F, int w0, int nw) {
    LAS float* scr = (LAS float*)(F.lds + RING_OFF + F.wave * 16384);
    const float* w_gate = (const float*)F.in[27]; const float* w_up = (const float*)F.in[28]; const float* w_down = (const float*)F.in[29]; const float* ffg = (const float*)F.in[26];
    bf16* WGU = (bf16*)(F.ws + WS_WGU); bf16* WDN = (bf16*)(F.ws + WS_WDN);
    constexpr int I_G = 16 * 88, I_DN = 44 * 32;
    for (int it = F.gw - w0; it < 2 * I_G + I_DN; it += nw) {
        int r = it;
        if (r < I_G) { transpose_item(w_gate, DFF, DFF, WGU, DM, r, scr, F.lane, [](int n) { return 256 * (n >> 7) + (n & 127); }, ffg); continue; } r -= I_G;
        if (r < I_G) { transpose_item(w_up, DFF, DFF, WGU, DM, r, scr, F.lane, [](int n) { return 256 * (n >> 7) + 128 + (n & 127); }, ffg); continue; } r -= I_G;
        transpose_item(w_down, DM, DM, WDN, DFF, r, scr, F.lane, [](int n) { return n; });
    }
}
__device__ __forceinline__ int small_arow(int r) { return r < NMETA ? r : RP + (r - NMETA); }
__device__ __forceinline__ void p1_inproj(Frame& F) {
    const bf16* XN = (const bf16*)(F.ws + WS_XN); const bf16* WIN = (const bf16*)(F.ws + WS_WIN); bf16* PROJ = (bf16*)(F.ws + WS_PROJ); float* DTRAW = (float*)(F.ws + WS_DTRAW);
    { pg8::Gemm g{XN, WIN, MMAIN, PJ, DM, 1, DM}; pg8::StaticOrder S; S.init(MMAIN, PJ, F.G, (int)blockIdx.x);
      EpiProj E{PROJ, DTRAW, 1};
      pg8::gemm_phase<EpiProj, pg8::StaticOrder, true, true>(F.lds + RING_OFF, g, S, E); }
    auto epi = [&](const f32x4& acc, int rt, int ct, int lane) {
        const int col = ct * 16 + (lane & 15);
#pragma unroll
        for (int i = 0; i < 4; ++i) { const int r = rt * 16 + 4 * (lane >> 4) + i; const bf16 v = f2bf(acc[i]);
            if (r < NMETA) { for (int b = 0; b < NB; ++b) { PROJ[(size_t)(b * TT + r) * PJ + col] = v; if (col >= C_DT && col < C_DT + 8) DTRAW[(size_t)(b * TT + r) * 8 + (col - C_DT)] = acc[i]; } }
            else { const int row = RP + (r - NMETA); PROJ[(size_t)row * PJ + col] = v; if (col >= C_DT && col < C_DT + 8) DTRAW[(size_t)row * 8 + (col - C_DT)] = acc[i]; } }
    };
    small_gemm(XN, DM, WIN, DM, NS / 16, PJ / 16, [](int r) { return small_arow(r); }, epi, F.gw, F.NGW, F.lane);
    { constexpr int NSM = (NS / 16) * (PJ / 16);
      if (F.NGW > NSM + 256) { if (F.gw >= NSM) p1_ffn_weights(F, NSM, F.NGW - NSM); } else p1_ffn_weights(F, 0, F.NGW); }
}

constexpr int CV_LDS_STRIDE = 88;
__device__ __forceinline__ void p2_elementwise(Frame& F) {
    const bf16* PROJ = (const bf16*)(F.ws + WS_PROJ); const float* DTRAW = (const float*)(F.ws + WS_DTRAW); float* DT = (float*)(F.ws + WS_DT);
    float* RQS = (float*)(F.ws + WS_RQ); float* KRF = (float*)(F.ws + WS_KRF);
    const float* kvg = (const float*)F.in[18]; const float* qng = (const float*)F.in[16]; const float* dtb = (const float*)F.in[12]; const float* ROPE = (const float*)(F.ws + WS_ROPE);
    {
        const f32x4 gg = ((const f32x4*)kvg)[F.lane]; const float* gq = qng + 6 * F.lane; const float g0 = gq[0], g1 = gq[1], g2 = gq[2], g3 = gq[3], g4 = gq[4], g5 = gq[5]; const float dbias = dtb[F.lane & 7];
        v2u wk[4], wkn[4]; unsigned wq[4][3], wqn[4][3]; unsigned short kr1[4], kr2[4], kr1n[4], kr2n[4]; float dtr[4], dtrn[4]; f32x2_t cs[4], csn[4];
#define P2A_LOAD(WK, WQ, K1, K2, DTR, CS, r0, n) do { _Pragma("unroll") for (int i = 0; i < 4; ++i) if (i < (n)) { const int row = (r0) + i; const bf16* pr = PROJ + (size_t)row * PJ; \
            WK[i] = *(const v2u*)(pr + C_CKV + 4 * F.lane); const unsigned* p = (const unsigned*)(pr + C_CQ + 6 * F.lane); WQ[i][0] = p[0]; WQ[i][1] = p[1]; WQ[i][2] = p[2]; \
            K1[i] = pr[C_KR + (F.lane & 15)]; K2[i] = pr[C_KR + 16 + (F.lane & 15)]; DTR[i] = DTRAW[(size_t)row * 8 + (F.lane & 7)]; \
            CS[i] = *(const f32x2_t*)(ROPE + 2 * ((row < RP ? row % TT : TT) * 16 + (F.lane & 15))); } } while (0)
#define P2A_PROC(r0, n) do { _Pragma("unroll") for (int i = 0; i < 4; ++i) if (i < (n)) { const int row = (r0) + i; \
            { const float v0 = bflo(wk[i].x), v1 = bfhi(wk[i].x), v2 = bflo(wk[i].y), v3 = bfhi(wk[i].y); \
              const float rs = __builtin_amdgcn_rsqf(wave_sum((v0 * v0 + v1 * v1) + (v2 * v2 + v3 * v3)) * (1.f / KVL) + EPS); \
              const f32x4 o = {v0 * rs * gg.x, v1 * rs * gg.y, v2 * rs * gg.z, v3 * rs * gg.w}; \
              float* of = (row < RP) ? F.out + OUT_LATP + (size_t)row * KVL : F.out + OUT_LATS + (size_t)(row - RP) * KVL; \
              ((f32x4*)of)[F.lane] = o; if (F.lane == 0) RQS[R + row] = rs; } \
            { const float v0 = bflo(wq[i][0]), v1 = bfhi(wq[i][0]), v2 = bflo(wq[i][1]), v3 = bfhi(wq[i][1]), v4 = bflo(wq[i][2]), v5 = bfhi(wq[i][2]); \
              const float rs = __builtin_amdgcn_rsqf(wave_sum((v0 * v0 + v1 * v1) + (v2 * v2 + v3 * v3) + (v4 * v4 + v5 * v5)) * (1.f / QL) + EPS); \
              if (F.lane == 0) RQS[row] = rs; } \
            if (F.lane < 16) { const int j = F.lane; const float c = cs[i].x, s = cs[i].y; \
              const float x1 = bf2f(kr1[i]), x2 = bf2f(kr2[i]); const float y1 = x1 * c - x2 * s, y2 = x1 * s + x2 * c; \
              KRF[(size_t)row * 32 + j] = y1; KRF[(size_t)row * 32 + 16 + j] = y2; \
              float* of = (row < RP) ? F.out + OUT_KRP + (size_t)row * 32 : F.out + OUT_KRS + (size_t)(row - RP) * 32; of[j] = y1; of[16 + j] = y2; } \
            if (F.lane < 8) DT[(size_t)row * 8 + F.lane] = softplus_f(dtr[i] + dbias); } } while (0)
#define P2A_ROT() do { _Pragma("unroll") for (int i = 0; i < 4; ++i) { wk[i] = wkn[i]; wq[i][0] = wqn[i][0]; wq[i][1] = wqn[i][1]; wq[i][2] = wqn[i][2]; kr1[i] = kr1n[i]; kr2[i] = kr2n[i]; dtr[i] = dtrn[i]; cs[i] = csn[i]; } } while (0)
        if (F.NGW == 2048) {
            const int ra = 4 * F.gw, rb2 = 8192 + 4 * F.gw, rc = 16384 + F.gw;
            P2A_LOAD(wk, wq, kr1, kr2, dtr, cs, ra, 4);
            P2A_LOAD(wkn, wqn, kr1n, kr2n, dtrn, csn, rb2, 4);
            P2A_PROC(ra, 4); P2A_ROT();
            if (F.gw < 256) P2A_LOAD(wkn, wqn, kr1n, kr2n, dtrn, csn, rc, 1);
            P2A_PROC(rb2, 4);
            if (F.gw < 256) { P2A_ROT(); P2A_PROC(rc, 1); }
        } else {
            for (int r0 = 4 * F.gw; r0 < R; r0 += 4 * F.NGW) { P2A_LOAD(wk, wq, kr1, kr2, dtr, cs, r0, 4); P2A_PROC(r0, 4); }
        }
#undef P2A_LOAD
#undef P2A_PROC
#undef P2A_ROT
    }
    const float* cw = (const float*)F.in[10]; const float* cb = (const float*)F.in[11];
    bf16* XST = (bf16*)(F.ws + WS_XST); bf16* BT = (bf16*)(F.ws + WS_BT); bf16* BC = (bf16*)(F.ws + WS_BC);
    LAS bf16* tile = (LAS bf16*)(F.lds + RING_OFF);
    for (int i = blockIdx.x * NTHR + F.tid; i < NB * 640 * 6; i += F.G * NTHR) { const int rowi = i / 6, pc = i % 6; const int bb = rowi / 640, cc = rowi % 640;
        bf16* dst = (cc < SSDW) ? XST + ((size_t)(bb * SSDW + cc)) * TPAD : BT + ((size_t)(bb * 128 + (cc - SSDW))) * TPAD; *(v4u*)(dst + pc * 8) = (v4u){0u, 0u, 0u, 0u}; }
    {
        const int cl = 2 * (F.tid & 127), tq = F.tid >> 7;
        unsigned raw[19], rawn[19]; float wv[10], wn[10];
#define CV_FETCH(RAW, WV, uu) do { const int third_ = (uu) % 3, tb_ = 1 + ((uu) / 3) % 32, b_ = (uu) / 96; const int c_ = third_ * 256 + cl, tf_ = tb_ * CHL - TOFF + 16 * tq; \
            const bf16* base_ = PROJ + (size_t)b_ * TT * PJ + C_XBC + c_; \
            _Pragma("unroll") for (int k = 0; k < 19; ++k) { const int t = tf_ - 3 + k; RAW[k] = (t >= 0) ? *(const unsigned*)(base_ + (size_t)t * PJ) : 0u; } \
            _Pragma("unroll") for (int k = 0; k < 4; ++k) { WV[2 * k] = cw[k * CONVD + c_]; WV[2 * k + 1] = cw[k * CONVD + c_ + 1]; } WV[8] = cb[c_]; WV[9] = cb[c_ + 1]; } while (0)
#define CV_COMPUTE(RAW, WV, tfirst, lcol, third, b) do { unsigned wa_[8], wb_[8]; float pa_ = 0.f, pb_ = 0.f; \
            _Pragma("unroll") for (int k = 0; k < 16; ++k) { const int t = (tfirst) + k; \
                const float ya = silu_f(WV[8] + bflo(RAW[k]) * WV[0] + bflo(RAW[k + 1]) * WV[2] + bflo(RAW[k + 2]) * WV[4] + bflo(RAW[k + 3]) * WV[6]); \
                const float yb = silu_f(WV[9] + bfhi(RAW[k]) * WV[1] + bfhi(RAW[k + 1]) * WV[3] + bfhi(RAW[k + 2]) * WV[5] + bfhi(RAW[k + 3]) * WV[7]); \
                if ((third) == 2) *(unsigned*)(BC + (size_t)((b) * TT + t) * 256 + cl) = pk2(ya, yb); \
                if (k & 1) { wa_[k >> 1] = pk2(pa_, ya); wb_[k >> 1] = pk2(pb_, yb); } else { pa_ = ya; pb_ = yb; } } \
            LAS v4u* ra_ = (LAS v4u*)(tile + cl * CV_LDS_STRIDE + (lcol)); LAS v4u* rb_ = (LAS v4u*)(tile + (cl + 1) * CV_LDS_STRIDE + (lcol)); \
            ra_[0] = (v4u){wa_[0], wa_[1], wa_[2], wa_[3]}; ra_[1] = (v4u){wa_[4], wa_[5], wa_[6], wa_[7]}; rb_[0] = (v4u){wb_[0], wb_[1], wb_[2], wb_[3]}; rb_[1] = (v4u){wb_[4], wb_[5], wb_[6], wb_[7]}; } while (0)
        if ((int)blockIdx.x < NB * 32 * 3) CV_FETCH(rawn, wn, (int)blockIdx.x);
        for (int u = blockIdx.x; u < NB * 32 * 3; u += F.G) {
            const int third = u % 3, tb = 1 + (u / 3) % 32, b = u / 96; const int t0 = tb * CHL - TOFF;
#pragma unroll
            for (int k = 0; k < 19; ++k) raw[k] = rawn[k];
#pragma unroll
            for (int k = 0; k < 10; ++k) wv[k] = wn[k];
            CV_COMPUTE(raw, wv, t0 + 16 * tq, 16 * tq, third, b);
            if (tb == 1 && tq == 0) {
                const bf16* base = PROJ + (size_t)b * TT * PJ + C_XBC + third * 256 + cl;
#pragma unroll
                for (int k = 0; k < 19; ++k) { const int t = k - 3; raw[k] = (t >= 0) ? *(const unsigned*)(base + (size_t)t * PJ) : 0u; }
                CV_COMPUTE(raw, wv, 0, 64, third, b); }
            __syncthreads();
            if (u + F.G < NB * 32 * 3) CV_FETCH(rawn, wn, u + F.G);
            { const int nrows = (third == 2) ? 128 : 256; const int npc = (tb == 1) ? 10 : 8;
              for (int i = F.tid; i < nrows * npc; i += NTHR) { const int cr = i / npc, pc = i % npc;
                const v4u o = *(const LAS v4u*)(tile + cr * CV_LDS_STRIDE + pc * 8);
                bf16* dst = (third < 2) ? XST + ((size_t)(b * SSDW + third * 256 + cr)) * TPAD : BT + ((size_t)(b * 128 + cr)) * TPAD;
                *(v4u*)(dst + ((pc < 8) ? tb * CHL + pc * 8 : TOFF + (pc - 8) * 8)) = o; } }
            __syncthreads();
        }
#undef CV_FETCH
#undef CV_COMPUTE
    }
    const float* sconv = (const float*)F.in[4]; float* XAS = (float*)(F.ws + WS_XAS);
    for (int i = blockIdx.x * NTHR + F.tid; i < DB * CONVD; i += F.G * NTHR) { const int b = i / CONVD, c = i % CONVD;
        const float xc = bf2f(PROJ[(size_t)(RP + b) * PJ + C_XBC + c]);
        const float s0 = sconv[(size_t)(b * 3 + 0) * CONVD + c], s1 = sconv[(size_t)(b * 3 + 1) * CONVD + c], s2 = sconv[(size_t)(b * 3 + 2) * CONVD + c];
        XAS[i] = silu_f(cb[c] + s0 * cw[c] + s1 * cw[CONVD + c] + s2 * cw[2 * CONVD + c] + xc * cw[3 * CONVD + c]);
        float* oc = F.out + OUT_CONVS + (size_t)b * 3 * CONVD + c; oc[0] = s1; oc[CONVD] = s2; oc[2 * CONVD] = xc; }
    for (int i = blockIdx.x * NTHR + F.tid; i < NB * 3 * CONVD; i += F.G * NTHR) { const int b = i / (3 * CONVD), k = (i / CONVD) % 3, c = i % CONVD;
        F.out[OUT_CONVP + i] = bf2f(PROJ[(size_t)(b * TT + TT - 3 + k) * PJ + C_XBC + c]); }
}
#define MFMA32(a, b, c) __builtin_amdgcn_mfma_f32_32x32x16_bf16((a), (b), (c), 0, 0, 0)
#define MFMA16(a, b, c) __builtin_amdgcn_mfma_f32_16x16x32_bf16((a), (b), (c), 0, 0, 0)
__device__ __forceinline__ int crow(int reg, int hi) { return (reg & 3) + 8 * (reg >> 2) + 4 * hi; }
__device__ __forceinline__ bf16x8 pack8(const f32x16& x, int s) {
    v4u p; p.x = pk2(x[8 * s + 0], x[8 * s + 1]); p.y = pk2(x[8 * s + 2], x[8 * s + 3]); p.z = pk2(x[8 * s + 4], x[8 * s + 5]); p.w = pk2(x[8 * s + 6], x[8 * s + 7]);
    return __builtin_bit_cast(bf16x8, p);
}
__device__ __forceinline__ bf16x8 ld2x8(const bf16* p0, const bf16* p1) {
    const v2u a = *(const v2u*)p0, b = *(const v2u*)p1; v4u r; r.x = a.x; r.y = a.y; r.z = b.x; r.w = b.y; return __builtin_bit_cast(bf16x8, r);
}
__device__ __forceinline__ float softmax_ref(Frame& F) {
    const float* gqn = (const float*)F.in[20]; const float* gqr = (const float*)F.in[21]; const float* gkn = (const float*)F.in[22]; const float* gkr = (const float*)F.in[23];
    float a = fabsf(gqn[F.lane]), b = fabsf(gkn[F.lane]);
    if (F.lane < 16) { a = fmaxf(a, fabsf(gqr[F.lane])); b = fmaxf(b, fabsf(gkr[F.lane])); }
    return LOG2E * 9.797958971132712f * wave_max(a) * wave_max(b) * 1.0001f;
}
constexpr size_t WS_YS = 495 * MiB;
constexpr size_t WS_KS = 498 * MiB;
constexpr int NKT = 65;

__device__ __forceinline__ void p3_upproj_states(Frame& F) {
    const bf16* PROJ = (const bf16*)(F.ws + WS_PROJ); const bf16* WUQ = (const bf16*)(F.ws + WS_WUQ); const bf16* WUKV = (const bf16*)(F.ws + WS_WUKV);
    bf16* QRAW = (bf16*)(F.ws + WS_QRAW); bf16* KVRAW = (bf16*)(F.ws + WS_KVRAW);
    { pg8::Gemm g{PROJ + C_CQ, WUQ, MMAIN, 768, QL, 1, PJ}; pg8::StaticOrder S; S.init(MMAIN, 768, F.G, (int)blockIdx.x); EpiBf16 E{QRAW, 768, 1};
      pg8::gemm_phase<EpiBf16, pg8::StaticOrder, true, true>(F.lds + RING_OFF, g, S, E); }
    { pg8::Gemm g{PROJ + C_CKV, WUKV, MMAIN, 1024, KVL, 1, PJ}; pg8::StaticOrder S; S.init(MMAIN, 1024, F.G, (int)blockIdx.x); EpiBf16 E{KVRAW, 1024, 1};
      pg8::gemm_phase<EpiBf16, pg8::StaticOrder, true, true>(F.lds + RING_OFF, g, S, E); }
    const bool sub = (F.G == 256);
    const int sgw = sub ? (blockIdx.x - 192) * NWAVES + F.wave : F.gw, sngw = sub ? 64 * NWAVES : F.NGW;
    if (!sub || blockIdx.x >= 192) {
    small_gemm(PROJ + C_CQ, PJ, WUQ, QL, DB / 16, 768 / 16, [](int r) { return RP + r; },
        [&](const f32x4& acc, int rt, int ct, int lane) { const int col = ct * 16 + (lane & 15);
#pragma unroll
            for (int i = 0; i < 4; ++i) QRAW[(size_t)(RP + rt * 16 + 4 * (lane >> 4) + i) * 768 + col] = f2bf(acc[i]); }, sgw, sngw, F.lane);
    small_gemm(PROJ + C_CKV, PJ, WUKV, KVL, NS / 16, 1024 / 16, [](int r) { return small_arow(r); },
        [&](const f32x4& acc, int rt, int ct, int lane) { const int col = ct * 16 + (lane & 15);
#pragma unroll
            for (int i = 0; i < 4; ++i) { const int r = rt * 16 + 4 * (lane >> 4) + i; const bf16 v = f2bf(acc[i]);
                if (r < NMETA) { for (int b = 0; b < NB; ++b) KVRAW[(size_t)(b * TT + r) * 1024 + col] = v; } else KVRAW[(size_t)(RP + r - NMETA) * 1024 + col] = v; } }, sgw, sngw, F.lane);
    }
    const float* DT = (const float*)(F.ws + WS_DT); const float* a_log = (const float*)F.in[13];
    const bf16* XST = (const bf16*)(F.ws + WS_XST); const bf16* BT = (const bf16*)(F.ws + WS_BT);
    bf16* STATES = (bf16*)(F.ws + WS_STATES); float* DECAY = (float*)(F.ws + WS_DECAY);
    LAS float* wl = (LAS float*)(F.lds + RING_OFF + F.wave * 1024);
    const int r32 = F.lane & 31, hi = F.lane >> 5;
    for (int u = F.gw; u < NB * NCH * NH; u = sub ? ((u < F.NGW && F.gw >= 192 * NWAVES) ? F.NGW + (F.gw - 192 * NWAVES) : NB * NCH * NH) : u + F.NGW) {
        const int h = u % NH, c = (u / NH) % NCH, b = u / (NH * NCH); const int g = h >> 2;
        const int t = c * CHL - TOFF + F.lane;
        const float dt = (t >= 0) ? DT[(size_t)(b * TT + t) * 8 + h] : 0.f;
        const float A = -__expf(a_log[h]);
        float acs = dt * A;
#pragma unroll
        for (int o = 1; o < 64; o <<= 1) { const float v = __shfl_up(acs, o); if (F.lane >= o) acs += v; }
        const float last = __shfl(acs, 63);
        wl[F.lane] = __expf(last - acs) * dt;
        LDS_WAIT(); asm volatile("" ::: "memory");
        f32x16 acc[2][2];
#pragma unroll
        for (int i = 0; i < 2; ++i)
#pragma unroll
            for (int j = 0; j < 2; ++j) acc[i][j] = (f32x16){};
        const bf16* xb = XST + ((size_t)(b * SSDW + h * HP)) * TPAD + c * CHL; const bf16* bb = BT + ((size_t)(b * 128 + g * DS)) * TPAD + c * CHL;
#pragma unroll
        for (int s = 0; s < 4; ++s) {
            const f32x4 w0 = *(const LAS f32x4*)(wl + 16 * s + 8 * hi), w1 = *(const LAS f32x4*)(wl + 16 * s + 8 * hi + 4);
            bf16x8 af[2], bfr[2];
#pragma unroll
            for (int pt = 0; pt < 2; ++pt) { const v4u x = *(const v4u*)(xb + (size_t)(32 * pt + r32) * TPAD + 16 * s + 8 * hi);
                v4u y; y.x = pk2(bflo(x.x) * w0.x, bfhi(x.x) * w0.y); y.y = pk2(bflo(x.y) * w0.z, bfhi(x.y) * w0.w); y.z = pk2(bflo(x.z) * w1.x, bfhi(x.z) * w1.y); y.w = pk2(bflo(x.w) * w1.z, bfhi(x.w) * w1.w);
                af[pt] = __builtin_bit_cast(bf16x8, y); }
#pragma unroll
            for (int nt = 0; nt < 2; ++nt) bfr[nt] = *(const bf16x8*)(bb + (size_t)(32 * nt + r32) * TPAD + 16 * s + 8 * hi);
#pragma unroll
            for (int pt = 0; pt < 2; ++pt)
#pragma unroll
                for (int nt = 0; nt < 2; ++nt) acc[pt][nt] = MFMA32(af[pt], bfr[nt], acc[pt][nt]);
        }
        bf16* so = STATES + ((size_t)((b * NCH + c) * NH + h)) * 4096;
        const bool odd = (F.lane & 1) != 0;
#pragma unroll
        for (int pt = 0; pt < 2; ++pt)
#pragma unroll
            for (int nt = 0; nt < 2; ++nt)
#pragma unroll
                for (int r2 = 0; r2 < 8; ++r2) { const float oe = acc[pt][nt][2 * r2], oo = acc[pt][nt][2 * r2 + 1];
                    const float got = DPP_F(odd ? oe : oo, 0xB1);
                    const unsigned w = odd ? pk2(got, oo) : pk2(oe, got);
                    *(unsigned*)(so + (32 * pt + crow(2 * r2 + (odd ? 1 : 0), hi)) * 64 + 32 * nt + (r32 & ~1)) = w; }
        if (F.lane == 0) DECAY[(b * NCH + c) * NH + h] = __expf(last);
        LDS_WAIT(); asm volatile("" ::: "memory");
    }
}

#ifdef MK_TS
#define P4_STAMP(k) do { if (blockIdx.x == 0 && F.tid == 0) ((unsigned long long*)(F.ws + 600 * MiB))[20 + (k)] = __builtin_amdgcn_s_memrealtime(); } while (0)
#else
#define P4_STAMP(k) do { } while (0)
#endif
__device__ __forceinline__ void p4_post(Frame& F) {
    const bf16* QRAW = (const bf16*)(F.ws + WS_QRAW); const bf16* KVRAW = (const bf16*)(F.ws + WS_KVRAW); const float* KRF = (const float*)(F.ws + WS_KRF);
    bf16* Q = (bf16*)(F.ws + WS_Q); bf16* K = (bf16*)(F.ws + WS_K); bf16* VT = (bf16*)(F.ws + WS_VT); float* VS = (float*)(F.ws + WS_VS);
    const float* gqn = (const float*)F.in[20]; const float* gqr = (const float*)F.in[21]; const float* gkn = (const float*)F.in[22]; const float* gkr = (const float*)F.in[23];
    const float* ROPE = (const float*)(F.ws + WS_ROPE); const float* RQS = (const float*)(F.ws + WS_RQ);
    const int h = F.lane >> 3, sub = F.lane & 7;
    bf16* KS = (bf16*)(F.ws + WS_KS);
    for (int row = RP + (F.gw + F.NGW / 2) % F.NGW; row < R; row += F.NGW) {
        const int t = PAST;
        if (row >= RP) { const bf16* kp = KVRAW + (size_t)row * 1024 + 128 * h + 8 * sub; const v4u kw = *(const v4u*)kp; const v4u vw = *(const v4u*)(kp + 64);
          const f32x4 kr = *(const f32x4*)(KRF + (size_t)row * 32 + 4 * sub);
          const float rkv = RQS[R + row];
          float kn[8] = {bflo(kw.x) * rkv, bfhi(kw.x) * rkv, bflo(kw.y) * rkv, bfhi(kw.y) * rkv, bflo(kw.z) * rkv, bfhi(kw.z) * rkv, bflo(kw.w) * rkv, bfhi(kw.w) * rkv};
          float ss = (kr.x * kr.x + kr.y * kr.y) + (kr.z * kr.z + kr.w * kr.w);
#pragma unroll
          for (int e = 0; e < 8; ++e) ss += kn[e] * kn[e];
          ss = sum_x1(ss); ss = sum_x2(ss); ss = sum_x4(ss);
          const float rs = __builtin_amdgcn_rsqf(ss * (1.f / 96.f) + EPS);
          const float* gn = gkn + 8 * sub; v4u o; o.x = pk2(kn[0] * rs * gn[0], kn[1] * rs * gn[1]); o.y = pk2(kn[2] * rs * gn[2], kn[3] * rs * gn[3]); o.z = pk2(kn[4] * rs * gn[4], kn[5] * rs * gn[5]); o.w = pk2(kn[6] * rs * gn[6], kn[7] * rs * gn[7]);
          bf16* ko = KS + (size_t)(row - RP) * 768 + 96 * h; *(v4u*)(ko + 8 * sub) = o;
          const float* gr = gkr + ((4 * sub) & 15); v2u o2; o2.x = pk2(kr.x * rs * gr[0], kr.y * rs * gr[1]); o2.y = pk2(kr.z * rs * gr[2], kr.w * rs * gr[3]);
          *(v2u*)(ko + 64 + 4 * sub) = o2;
          const unsigned vv[4] = {vw.x, vw.y, vw.z, vw.w}; float* vs = VS + (size_t)(row - RP) * 512 + 64 * h + 8 * sub;
#pragma unroll
          for (int e = 0; e < 4; ++e) { vs[2 * e] = bflo(vv[e]) * rkv; vs[2 * e + 1] = bfhi(vv[e]) * rkv; } }
        if (row >= RP || t >= NMETA) {
            const bf16* qp = QRAW + (size_t)row * 768 + 96 * h; const v4u qw = *(const v4u*)(qp + 8 * sub);
            const unsigned r1 = *(const unsigned*)(qp + 64 + 2 * sub), r2 = *(const unsigned*)(qp + 80 + 2 * sub);
            float qn[8] = {bflo(qw.x), bfhi(qw.x), bflo(qw.y), bfhi(qw.y), bflo(qw.z), bfhi(qw.z), bflo(qw.w), bfhi(qw.w)};
            const f32x4 cs = *(const f32x4*)(ROPE + 2 * ((row < RP ? t : TT) * 16 + 2 * sub)); const float c0 = cs.x, s0 = cs.y, c1 = cs.z, s1 = cs.w;
            const float x10 = bflo(r1), x11 = bfhi(r1), x20 = bflo(r2), x21 = bfhi(r2);
            const float y10 = x10 * c0 - x20 * s0, y20 = x10 * s0 + x20 * c0, y11 = x11 * c1 - x21 * s1, y21 = x11 * s1 + x21 * c1;
            float ss = (y10 * y10 + y20 * y20) + (y11 * y11 + y21 * y21);
#pragma unroll
            for (int e = 0; e < 8; ++e) ss += qn[e] * qn[e];
            ss = sum_x1(ss); ss = sum_x2(ss); ss = sum_x4(ss);
            const float sq = RQS[row];
            const float rs = (ATTN_SCALE * LOG2E) * sq * __builtin_amdgcn_rsqf(ss * sq * sq * (1.f / 96.f) + EPS);
            const float* gn = gqn + 8 * sub; v4u o; o.x = pk2(qn[0] * rs * gn[0], qn[1] * rs * gn[1]); o.y = pk2(qn[2] * rs * gn[2], qn[3] * rs * gn[3]); o.z = pk2(qn[4] * rs * gn[4], qn[5] * rs * gn[5]); o.w = pk2(qn[6] * rs * gn[6], qn[7] * rs * gn[7]);
            bf16* qo = Q + (size_t)row * 768 + 96 * h; *(v4u*)(qo + 8 * sub) = o;
            const float g0 = gqr[2 * sub], g1 = gqr[2 * sub + 1];
            *(unsigned*)(qo + 64 + 2 * sub) = pk2(y10 * rs * g0, y11 * rs * g1); *(unsigned*)(qo + 80 + 2 * sub) = pk2(y20 * rs * g0, y21 * rs * g1);
        }
    }
    { bf16* KF = (bf16*)(F.ws + WS_K); bf16* VF = (bf16*)(F.ws + WS_VT);
      LAS unsigned char* vtile = F.lds + RING_OFF + F.wave * 4608;
      const int r8 = F.lane >> 3;
      const int nfull = (NB * NKT * NH) / F.NGW, rot = (F.gw + F.NGW - F.NGW / 4) % F.NGW;
      for (int i = 0; i <= nfull; ++i) { const int u = (i < nfull) ? i * F.NGW + F.gw : nfull * F.NGW + rot; if (u >= NB * NKT * NH) break;
          const int hh = u % NH, kt = (u / NH) % NKT, bb = u / (NH * NKT);
          bf16* kfb = KF + ((size_t)((bb * NH + hh) * NKT + kt)) * (6 * 512); bf16* vfb = VF + ((size_t)((bb * NH + hh) * NKT + kt)) * (4 * 512);
          v4u kwa[4], vwa[4]; f32x4 kra[4]; float rka[4];
#pragma unroll
          for (int i = 0; i < 4; ++i) { const int tk = kt * 32 + 8 * i + r8; const int tkc = tk < TT ? tk : TT - 1; rka[i] = RQS[R + bb * TT + tkc];
              const bf16* kp = KVRAW + (size_t)(bb * TT + tkc) * 1024 + 128 * hh + 8 * sub; kwa[i] = *(const v4u*)kp; vwa[i] = *(const v4u*)(kp + 64); kra[i] = *(const f32x4*)(KRF + (size_t)(bb * TT + tkc) * 32 + 4 * sub); }
#pragma unroll
          for (int i = 0; i < 4; ++i) {
              const int key = 8 * i + r8, tk = kt * 32 + key; v4u kw = kwa[i], vw = vwa[i]; f32x4 kr = kra[i];
              if (tk >= TT) { kw = (v4u){0u, 0u, 0u, 0u}; vw = kw; kr = (f32x4){0.f, 0.f, 0.f, 0.f}; }
              const float rkv = rka[i];
              float kn[8] = {bflo(kw.x) * rkv, bfhi(kw.x) * rkv, bflo(kw.y) * rkv, bfhi(kw.y) * rkv, bflo(kw.z) * rkv, bfhi(kw.z) * rkv, bflo(kw.w) * rkv, bfhi(kw.w) * rkv};
              vw.x = pk2(bflo(vw.x) * rkv, bfhi(vw.x) * rkv); vw.y = pk2(bflo(vw.y) * rkv, bfhi(vw.y) * rkv); vw.z = pk2(bflo(vw.z) * rkv, bfhi(vw.z) * rkv); vw.w = pk2(bflo(vw.w) * rkv, bfhi(vw.w) * rkv);
              float ss = (kr.x * kr.x + kr.y * kr.y) + (kr.z * kr.z + kr.w * kr.w);
#pragma unroll
              for (int e = 0; e < 8; ++e) ss += kn[e] * kn[e];
              ss = sum_x1(ss); ss = sum_x2(ss); ss = sum_x4(ss);
              const float rs = __builtin_amdgcn_rsqf(ss * (1.f / 96.f) + EPS);
              const float* gn = gkn + 8 * sub; v4u o; o.x = pk2(kn[0] * rs * gn[0], kn[1] * rs * gn[1]); o.y = pk2(kn[2] * rs * gn[2], kn[3] * rs * gn[3]); o.z = pk2(kn[4] * rs * gn[4], kn[5] * rs * gn[5]); o.w = pk2(kn[6] * rs * gn[6], kn[7] * rs * gn[7]);
              *(v4u*)(kfb + (sub >> 1) * 512 + ((sub & 1) * 32 + key) * 8) = o;
              const float* gr = gkr + ((4 * sub) & 15); v2u o2; o2.x = pk2(kr.x * rs * gr[0], kr.y * rs * gr[1]); o2.y = pk2(kr.z * rs * gr[2], kr.w * rs * gr[3]);
              *(v2u*)(kfb + (4 + (sub >> 2)) * 512 + (((sub >> 1) & 1) * 32 + key) * 8 + 4 * (sub & 1)) = o2;
              *(LAS v4u*)(vtile + key * 144 + sub * 16) = vw; }
          LDS_WAIT(); asm volatile("" ::: "memory");
          const int g = F.lane >> 4, q4 = (F.lane & 15) >> 2, pp = F.lane & 3;
          const unsigned a_lo = (unsigned)(uintptr_t)vtile + (unsigned)((4 * (g >> 1) + q4) * 144 + (16 * (g & 1) + 4 * pp) * 2);
#define VF_TR(dt, s2) do { s16x4 lo, hi4; \
              asm volatile("ds_read_b64_tr_b16 %0, %2 offset:%c3\n\tds_read_b64_tr_b16 %1, %2 offset:%c4\n\ts_waitcnt lgkmcnt(0)" : "=&v"(lo), "=&v"(hi4) : "v"(a_lo), "i"(16 * (s2) * 144 + 64 * (dt)), "i"(16 * (s2) * 144 + 64 * (dt) + 8 * 144) : "memory"); \
              v4u o; o.x = (unsigned)(unsigned short)lo[0] | ((unsigned)(unsigned short)lo[1] << 16); o.y = (unsigned)(unsigned short)lo[2] | ((unsigned)(unsigned short)lo[3] << 16); \
              o.z = (unsigned)(unsigned short)hi4[0] | ((unsigned)(unsigned short)hi4[1] << 16); o.w = (unsigned)(unsigned short)hi4[2] | ((unsigned)(unsigned short)hi4[3] << 16); \
              *(v4u*)(vfb + ((dt) * 2 + (s2)) * 512 + F.lane * 8) = o; } while (0)
          VF_TR(0, 0); VF_TR(0, 1); VF_TR(1, 0); VF_TR(1, 1);
#undef VF_TR
          LDS_WAIT(); asm volatile("" ::: "memory");
      } }
    P4_STAMP(0);
    const bf16* STATES = (const bf16*)(F.ws + WS_STATES); const float* DECAY = (const float*)(F.ws + WS_DECAY); bf16* HIN = (bf16*)(F.ws + WS_HIN);
    for (int e2 = blockIdx.x * NTHR + F.tid; e2 < NB * NH * 2048; e2 += F.G * NTHR) {
        const int e = 2 * e2; const int b = e / (NH * 4096), hh = (e / 4096) % NH, pn = e % 4096;
        float h0 = 0.f, h1 = 0.f;
#pragma unroll 1
        for (int c0 = 0; c0 < NCH; c0 += 11) {
            unsigned st[11]; float dc[11];
#pragma unroll
            for (int j = 0; j < 11; ++j) { const int c = c0 + j; st[j] = *(const unsigned*)(STATES + ((size_t)((b * NCH + c) * NH + hh)) * 4096 + pn); dc[j] = DECAY[(b * NCH + c) * NH + hh]; }
#pragma unroll
            for (int j = 0; j < 11; ++j) { const int c = c0 + j; *(unsigned*)(HIN + ((size_t)((b * NCH + c) * NH + hh)) * 4096 + pn) = pk2(h0, h1); h0 = h0 * dc[j] + bflo(st[j]); h1 = h1 * dc[j] + bfhi(st[j]); }
        }
        *(f32x2_t*)(F.out + OUT_SSMP + e) = (f32x2_t){h0, h1};
    }
    P4_STAMP(1);
    const float* XAS = (const float*)(F.ws + WS_XAS); const float* DT = (const float*)(F.ws + WS_DT); const float* sst = (const float*)F.in[5];
    const float* a_log = (const float*)F.in[13]; const float* d_skip = (const float*)F.in[14]; float* YS = (float*)(F.ws + WS_YS);
    for (int u = F.gw; u < DB * NH * 16; u += F.NGW) {
        const int pq = u & 15, hh = (u >> 4) & 7, b = u >> 7; const int g = hh >> 2; const int p = 4 * pq + (F.lane >> 4), n4 = F.lane & 15;
        const float dt = DT[(size_t)(RP + b) * 8 + hh]; const float a = __expf(dt * -__expf(a_log[hh]));
        const float x = XAS[(size_t)b * CONVD + hh * HP + p]; const float uu = dt * x;
        const f32x4 Bv = *(const f32x4*)(XAS + (size_t)b * CONVD + SSDW + g * DS + 4 * n4), Cv = *(const f32x4*)(XAS + (size_t)b * CONVD + SSDW + 128 + g * DS + 4 * n4);
        const size_t si = (((size_t)b * NH + hh) * HP + p) * DS + 4 * n4;
        const f32x4 s0 = *(const f32x4*)(sst + si); const f32x4 s1 = s0 * a + uu * Bv;
        *(f32x4*)(F.out + OUT_SSMS + si) = s1;
        float y = (Cv.x * s1.x + Cv.y * s1.y) + (Cv.z * s1.z + Cv.w * s1.w);
        y = sum_x1(y); y = sum_x2(y); y = sum_x4(y); y = sum_x8(y);
        if (n4 == 0) YS[(size_t)b * 512 + hh * HP + p] = y + d_skip[hh] * x;
    }
}
constexpr int DA_ROWB = 528;
constexpr int DA_LAT = 0, DA_KR = 128 * DA_ROWB, DA_PB = DA_KR + 128 * 33 * 4, DA_QG = DA_PB + 2 * 16 * 32 * 2, DA_END = DA_QG + 8 * 96 * 4;
constexpr int P5_EXCH = 100 * 1024;
static_assert(DA_END <= P5_EXCH, "LDS map of P5");

constexpr int AT_SLOT = 20480, AT_D = 4;
__device__ __forceinline__ void at_issue(Frame& F, const bf16* kt_k, const bf16* kt_v, LAS unsigned char* slot) {
    const int w = F.wave;
    __builtin_amdgcn_global_load_lds((const unsigned*)((const char*)kt_k + w * 1024 + F.lane * 16), (LAS unsigned*)(slot + w * 1024), 16, 0, 0);
    const char* srcB = (w < 4) ? (const char*)kt_k + 8192 + w * 1024 : (const char*)kt_v + (w - 4) * 1024;
    __builtin_amdgcn_global_load_lds((const unsigned*)(srcB + F.lane * 16), (LAS unsigned*)(slot + 8192 + w * 1024), 16, 0, 0);
    __builtin_amdgcn_global_load_lds((const unsigned*)((const char*)kt_v + 4096 + w * 256 + F.lane * 4), (LAS unsigned*)(slot + 16384 + w * 256), 4, 0, 0);
    __builtin_amdgcn_global_load_lds((const unsigned*)((const char*)kt_v + 6144 + w * 256 + F.lane * 4), (LAS unsigned*)(slot + 18432 + w * 256), 4, 0, 0);
}
__device__ __forceinline__ void p5_attn_prompt(Frame& F, float M0) {
    const bf16* QRAW = (const bf16*)(F.ws + WS_QRAW); const bf16* KF = (const bf16*)(F.ws + WS_K); const bf16* VF = (const bf16*)(F.ws + WS_VT); bf16* MIXA = (bf16*)(F.ws + WS_MIX); float* SSQ = (float*)(F.ws + WS_SSQ);
    const float* ROPE = (const float*)(F.ws + WS_ROPE); const float* gqn = (const float*)F.in[20]; const float* gqr = (const float*)F.in[21]; const float* RQS = (const float*)(F.ws + WS_RQ);
    LAS unsigned char* ring = F.lds + RING_OFF;
    const int w = F.wave, r32 = F.lane & 31, hi = F.lane >> 5;
    f32x16 negm;
#pragma unroll
    for (int i = 0; i < 16; ++i) negm[i] = -M0;
    for (int u = F.vcu; u < 256; u += F.G) {
        const int b = u >> 5, h = (u >> 2) & 7, pr = u & 3;
        const bf16* kfb = KF + ((size_t)((b * NH + h) * NKT)) * (6 * 512); const bf16* vfb = VF + ((size_t)((b * NH + h) * NKT)) * (4 * 512);
#pragma unroll 1
        for (int half = 0; half < 2; ++half) {
            const int qb = half ? 7 - pr : pr; const int a = 8 * qb + w; const int qi = NMETA + 32 * a + r32;
            const int nkt = 8 * qb + 9, nkw = a + 2;
            bf16x8 qf[6];
            { const bf16* qp = QRAW + (size_t)(b * TT + qi) * 768 + 96 * h + 8 * hi;
              v4u qw[6];
#pragma unroll
              for (int s = 0; s < 6; ++s) qw[s] = *(const v4u*)(qp + 16 * s);
              f32x4 cs[4];
#pragma unroll
              for (int i = 0; i < 4; ++i) cs[i] = *(const f32x4*)(ROPE + 2 * (qi * 16 + 8 * hi) + 4 * i);
              float qv[6][8]; float ss = 0.f;
#pragma unroll
              for (int s = 0; s < 6; ++s) { const unsigned ww[4] = {qw[s].x, qw[s].y, qw[s].z, qw[s].w};
#pragma unroll
                  for (int e = 0; e < 4; ++e) { qv[s][2 * e] = bflo(ww[e]); qv[s][2 * e + 1] = bfhi(ww[e]); ss += qv[s][2 * e] * qv[s][2 * e] + qv[s][2 * e + 1] * qv[s][2 * e + 1]; } }
              ss = sum_x32(ss);
              const float sq = RQS[b * TT + qi];
              const float rs = (ATTN_SCALE * LOG2E) * sq * __builtin_amdgcn_rsqf(ss * sq * sq * (1.f / 96.f) + EPS);
#pragma unroll
              for (int jj = 0; jj < 8; ++jj) { const float c = cs[jj >> 1][2 * (jj & 1)], sn = cs[jj >> 1][2 * (jj & 1) + 1]; const float x1 = qv[4][jj], x2 = qv[5][jj];
                  const float gr = gqr[8 * hi + jj] * rs; qv[4][jj] = (x1 * c - x2 * sn) * gr; qv[5][jj] = (x1 * sn + x2 * c) * gr; }
#pragma unroll
              for (int s = 0; s < 4; ++s) { const f32x4 g0 = *(const f32x4*)(gqn + 16 * s + 8 * hi), g1 = *(const f32x4*)(gqn + 16 * s + 8 * hi + 4);
                  qv[s][0] *= g0.x * rs; qv[s][1] *= g0.y * rs; qv[s][2] *= g0.z * rs; qv[s][3] *= g0.w * rs; qv[s][4] *= g1.x * rs; qv[s][5] *= g1.y * rs; qv[s][6] *= g1.z * rs; qv[s][7] *= g1.w * rs; }
#pragma unroll
              for (int s = 0; s < 6; ++s) { v4u o; o.x = pk2(qv[s][0], qv[s][1]); o.y = pk2(qv[s][2], qv[s][3]); o.z = pk2(qv[s][4], qv[s][5]); o.w = pk2(qv[s][6], qv[s][7]); qf[s] = __builtin_bit_cast(bf16x8, o); } }
            f32x16 o0 = (f32x16){}, o1 = (f32x16){}; float l = 0.f;
            const int ns = (nkt + 1) >> 1;
#pragma unroll
            for (int j = 0; j < AT_D - 1; ++j) at_issue(F, kfb + (size_t)j * 6144, vfb + (size_t)j * 4096, ring + j * AT_SLOT);
#pragma unroll 1
            for (int st = 0; st < ns; ++st) {
                const int rem = ns - 1 - st;
                if (rem >= 2) asm volatile("s_waitcnt vmcnt(8)" ::: "memory"); else if (rem == 1) asm volatile("s_waitcnt vmcnt(4)" ::: "memory"); else asm volatile("s_waitcnt vmcnt(0)" ::: "memory");
                __builtin_amdgcn_s_barrier(); asm volatile("" ::: "memory");
                if (st + AT_D - 1 < ns) at_issue(F, kfb + (size_t)(st + AT_D - 1) * 6144, vfb + (size_t)(st + AT_D - 1) * 4096, ring + ((st + AT_D - 1) & (AT_D - 1)) * AT_SLOT);
#pragma unroll
                for (int tt = 0; tt < 2; ++tt) { const int kt = 2 * st + tt;
                  if (kt < nkw) {
                    const LAS unsigned char* sl = ring + (st & (AT_D - 1)) * AT_SLOT + F.lane * 16; const int j0 = 32 * kt;
                    f32x16 S = negm;
#pragma unroll
                    for (int s = 0; s < 6; ++s) S = MFMA32(*(const LAS bf16x8*)(sl + tt * 6144 + 1024 * s), qf[s], S);
                    bf16x8 vf[4];
#pragma unroll
                    for (int i = 0; i < 4; ++i) vf[i] = *(const LAS bf16x8*)(sl + 12288 + tt * 4096 + 1024 * i);
#pragma unroll
                    for (int i = 0; i < 16; ++i) S[i] = __builtin_amdgcn_exp2f(S[i]);
                    if (kt >= a) {
#pragma unroll
                        for (int i = 0; i < 16; ++i) if (j0 + crow(i, hi) > qi) S[i] = 0.f; }
#pragma unroll
                    for (int i = 0; i < 16; ++i) l += S[i];
                    const bf16x8 p0 = pack8(S, 0), p1 = pack8(S, 1);
                    o0 = MFMA32(vf[0], p0, o0); o0 = MFMA32(vf[1], p1, o0);
                    o1 = MFMA32(vf[2], p0, o1); o1 = MFMA32(vf[3], p1, o1);
                  } }
            }
            l = sum_x32(l);
            const float il = __builtin_amdgcn_rcpf(l);
            bf16* ao = MIXA + (size_t)(b * TT + qi) * 1024 + 512 + 64 * h + 4 * hi; float ssq = 0.f;
#pragma unroll
            for (int gq = 0; gq < 4; ++gq) {
                v2u w0, w1; w0.x = pk2(o0[4 * gq] * il, o0[4 * gq + 1] * il); w0.y = pk2(o0[4 * gq + 2] * il, o0[4 * gq + 3] * il);
                w1.x = pk2(o1[4 * gq] * il, o1[4 * gq + 1] * il); w1.y = pk2(o1[4 * gq + 2] * il, o1[4 * gq + 3] * il);
                ssq += (bflo(w0.x) * bflo(w0.x) + bfhi(w0.x) * bfhi(w0.x)) + (bflo(w0.y) * bflo(w0.y) + bfhi(w0.y) * bfhi(w0.y));
                ssq += (bflo(w1.x) * bflo(w1.x) + bfhi(w1.x) * bfhi(w1.x)) + (bflo(w1.y) * bflo(w1.y) + bfhi(w1.y) * bfhi(w1.y));
                *(v2u*)(ao + 8 * gq) = w0; *(v2u*)(ao + 32 + 8 * gq) = w1; }
            ssq = sum_x32(ssq);
            if (hi == 0) SSQ[(size_t)(b * TT + qi) * 8 + h] = ssq;
            asm volatile("s_waitcnt lgkmcnt(0)" ::: "memory"); __builtin_amdgcn_s_barrier(); asm volatile("" ::: "memory");
        }
    }
}

constexpr int SO_X = 0, SO_H = 36864, SO_B = 73728, SO_C = 82944, SO_Z = 92160, SO_TAB = 125952, SO_EX = 130048;
static_assert(SO_EX + 1024 <= RING_BYTES, "ssd_out LDS map");
__device__ __forceinline__ void p5_ssd_out(Frame& F) {
    const float* DT = (const float*)(F.ws + WS_DT); const float* a_log = (const float*)F.in[13]; const float* d_skip = (const float*)F.in[14]; const float* ng = (const float*)F.in[15];
    const bf16* XST = (const bf16*)(F.ws + WS_XST); const bf16* BC = (const bf16*)(F.ws + WS_BC); const bf16* HIN = (const bf16*)(F.ws + WS_HIN); const bf16* PROJ = (const bf16*)(F.ws + WS_PROJ);
    bf16* MIX = (bf16*)(F.ws + WS_MIX);
    LAS unsigned char* L = F.lds + RING_OFF;
    LAS float* tab = (LAS float*)(L + SO_TAB) + F.wave * 128;
    LAS float* exch = (LAS float*)(L + SO_EX);
    const int hl = F.wave >> 1, it = F.wave & 1, r32 = F.lane & 31, hi = F.lane >> 5;
    for (int u = blockIdx.x; u < NB * (NCH - 1); u += F.G) {
        const int b = u / (NCH - 1), c = 1 + u % (NCH - 1); const int t0 = c * CHL - TOFF;
        v4u st[14];
#define SO_FETCH_A(g) do { \
        _Pragma("unroll") for (int k = 0; k < 4; ++k) { const int q = F.tid + NTHR * k; st[k] = *(const v4u*)(XST + ((size_t)(b * SSDW + (g) * 256 + (q >> 3))) * TPAD + c * CHL + 8 * (q & 7)); } } while (0)
#define SO_FETCH_B(g) do { \
        _Pragma("unroll") for (int k = 0; k < 4; ++k) { const int q = F.tid + NTHR * k; st[4 + k] = *(const v4u*)(HIN + ((size_t)((b * NCH + c) * NH + 4 * (g))) * 4096 + (size_t)q * 8); } \
        { const int q = F.tid; st[8] = *(const v4u*)(BC + (size_t)(b * TT + t0 + (q >> 3)) * 256 + (g) * DS + 8 * (q & 7)); st[9] = *(const v4u*)(BC + (size_t)(b * TT + t0 + (q >> 3)) * 256 + 128 + (g) * DS + 8 * (q & 7)); } \
        _Pragma("unroll") for (int k = 0; k < 4; ++k) { const int q = F.tid + NTHR * k; st[10 + k] = *(const v4u*)(PROJ + (size_t)(b * TT + t0 + (q >> 5)) * PJ + C_Z + (g) * 256 + 8 * (q & 31)); } } while (0)
#define SO_STORE() do { \
        _Pragma("unroll") for (int k = 0; k < 4; ++k) { const int q = F.tid + NTHR * k; *(LAS v4u*)(L + SO_X + (q >> 3) * 144 + 16 * (q & 7)) = st[k]; *(LAS v4u*)(L + SO_H + (q >> 3) * 144 + 16 * (q & 7)) = st[4 + k]; } \
        { const int q = F.tid; *(LAS v4u*)(L + SO_B + (q >> 3) * 144 + 16 * (q & 7)) = st[8]; *(LAS v4u*)(L + SO_C + (q >> 3) * 144 + 16 * (q & 7)) = st[9]; } \
        _Pragma("unroll") for (int k = 0; k < 4; ++k) { const int q = F.tid + NTHR * k; *(LAS v4u*)(L + SO_Z + (q >> 5) * 528 + 16 * (q & 31)) = st[10 + k]; } } while (0)
        SO_FETCH_A(0); SO_FETCH_B(0);
#pragma unroll 1
        for (int g = 0; g < 2; ++g) {
            const int h = 4 * g + hl; const float A = -__expf(a_log[h]), Dh = d_skip[h];
            { const int t = t0 + F.lane; const float dt = DT[(size_t)(b * TT + t) * 8 + h];
              float acs = dt * A;
#pragma unroll
              for (int o = 1; o < 64; o <<= 1) { const float v = __shfl_up(acs, o); if (F.lane >= o) acs += v; }
              tab[F.lane] = acs; tab[64 + F.lane] = dt; }
            SO_STORE();
            __syncthreads();
            if (g == 0) SO_FETCH_A(1);
            const int ii = 32 * it + r32; const int t = t0 + ii;
            bf16x8 cf[4];
#pragma unroll
            for (int s = 0; s < 4; ++s) cf[s] = *(const LAS bf16x8*)(L + SO_C + ii * 144 + 32 * s + 16 * hi);
            f32x16 y[2];
            const float ai = tab[ii]; const float ei = __expf(ai);
#pragma unroll
            for (int pt = 0; pt < 2; ++pt) { f32x16 acc = (f32x16){}; const LAS unsigned char* hp_ = L + SO_H + (hl * 64 + 32 * pt + r32) * 144 + 16 * hi;
#pragma unroll
                for (int s = 0; s < 4; ++s) acc = MFMA32(*(const LAS bf16x8*)(hp_ + 32 * s), cf[s], acc);
#pragma unroll
                for (int i = 0; i < 16; ++i) acc[i] *= ei;
                y[pt] = acc; }
#pragma unroll 1
            for (int jt = 0; jt <= it; ++jt) {
                f32x16 S = (f32x16){};
                { const LAS unsigned char* bp_ = L + SO_B + (32 * jt + r32) * 144 + 16 * hi;
#pragma unroll
                  for (int s = 0; s < 4; ++s) S = MFMA32(*(const LAS bf16x8*)(bp_ + 32 * s), cf[s], S); }
#pragma unroll
                for (int i = 0; i < 16; ++i) { const int jj = 32 * jt + crow(i, hi); const float e = (jj <= ii) ? __expf(ai - tab[jj]) * tab[64 + jj] : 0.f; S[i] = S[i] * e + ((jj == ii) ? Dh : 0.f); }
                const bf16x8 p0 = pack8(S, 0), p1 = pack8(S, 1);
#pragma unroll
                for (int pt = 0; pt < 2; ++pt) { const LAS unsigned char* xp_ = L + SO_X + (hl * 64 + 32 * pt + r32) * 144 + (32 * jt + 4 * hi) * 2;
                    const v2u x0 = *(const LAS v2u*)(xp_), x1 = *(const LAS v2u*)(xp_ + 16), x2 = *(const LAS v2u*)(xp_ + 32), x3 = *(const LAS v2u*)(xp_ + 48);
                    v4u f0, f1; f0.x = x0.x; f0.y = x0.y; f0.z = x1.x; f0.w = x1.y; f1.x = x2.x; f1.y = x2.y; f1.z = x3.x; f1.w = x3.y;
                    y[pt] = MFMA32(__builtin_bit_cast(bf16x8, f0), p0, y[pt]); y[pt] = MFMA32(__builtin_bit_cast(bf16x8, f1), p1, y[pt]); }
            }
            float ss = 0.f;
            { const LAS unsigned char* zp_ = L + SO_Z + ii * 528 + (hl * 64 + 4 * hi) * 2;
#pragma unroll
              for (int pt = 0; pt < 2; ++pt)
#pragma unroll
                for (int gq = 0; gq < 4; ++gq) { const v2u zw = *(const LAS v2u*)(zp_ + (32 * pt + 8 * gq) * 2); const float zz[4] = {bflo(zw.x), bfhi(zw.x), bflo(zw.y), bfhi(zw.y)};
#pragma unroll
                    for (int e = 0; e < 4; ++e) { const float v = y[pt][4 * gq + e] * silu_f(zz[e]); y[pt][4 * gq + e] = v; ss += v * v; } } }
            ss = sum_x32(ss);
            if (g == 0) SO_FETCH_B(1);
            LAS float* ex = exch + it * 128;
            if (hi == 0) ex[hl * 32 + r32] = ss;
            __syncthreads();
            const float tot = (ex[r32] + ex[32 + r32]) + (ex[64 + r32] + ex[96 + r32]);
            const float rs = __builtin_amdgcn_rsqf(tot * (1.f / 256.f) + EPS);
            { bf16* mo = MIX + (size_t)(b * TT + t) * 1024 + 64 * h + 4 * hi;
#pragma unroll
              for (int pt = 0; pt < 2; ++pt)
#pragma unroll
                for (int gq = 0; gq < 4; ++gq) { const f32x4 gg = *(const f32x4*)(ng + 64 * h + 32 * pt + 8 * gq + 4 * hi);
                    v2u w; w.x = pk2(y[pt][4 * gq] * rs * gg.x, y[pt][4 * gq + 1] * rs * gg.y); w.y = pk2(y[pt][4 * gq + 2] * rs * gg.z, y[pt][4 * gq + 3] * rs * gg.w);
                    *(v2u*)(mo + 32 * pt + 8 * gq) = w; } }
        }
#undef SO_FETCH_A
#undef SO_FETCH_B
#undef SO_STORE
        __syncthreads();
    }
    const float* YS = (const float*)(F.ws + WS_YS);
    for (int u = F.gw; u < DB * NG; u += F.NGW) { const int b = u >> 1, gg = u & 1; const int cc = gg * 256 + 4 * F.lane;
        const f32x4 yv = *(const f32x4*)(YS + (size_t)b * 512 + cc); const v2u zw = *(const v2u*)(PROJ + (size_t)(RP + b) * PJ + C_Z + cc);
        const f32x4 v = {yv.x * silu_f(bflo(zw.x)), yv.y * silu_f(bfhi(zw.x)), yv.z * silu_f(bflo(zw.y)), yv.w * silu_f(bfhi(zw.y))};
        const float rs = __builtin_amdgcn_rsqf(wave_sum((v.x * v.x + v.y * v.y) + (v.z * v.z + v.w * v.w)) * (1.f / 256.f) + EPS);
        const f32x4 gv = *(const f32x4*)(ng + cc); v2u w; w.x = pk2(v.x * rs * gv.x, v.y * rs * gv.y); w.y = pk2(v.z * rs * gv.z, v.w * rs * gv.w);
        *(v2u*)(MIX + (size_t)(RP + b) * 1024 + cc) = w; }
}

constexpr int DB_STAGE = 0, DB_KRST = 65536, DB_LAT = DB_KRST + 8192, DB_KR = DB_LAT + 64 * DA_ROWB, DB_PB = DB_KR + 64 * 36 * 4, DB_QG = DB_PB + 16 * 64 * 2, DB_END = DB_QG + 8 * 96 * 4;
static_assert(DB_END <= RING_BYTES, "decode attention LDS map");
#define RAW_BAR_L() do { asm volatile("s_waitcnt lgkmcnt(0)" ::: "memory"); __builtin_amdgcn_s_barrier(); asm volatile("" ::: "memory"); } while (0)
#define RAW_BAR_VL() do { asm volatile("s_waitcnt vmcnt(0) lgkmcnt(0)" ::: "memory"); __builtin_amdgcn_s_barrier(); asm volatile("" ::: "memory"); } while (0)
__device__ __forceinline__ void da_issue(Frame& F, LAS unsigned char* L, const float* clat, const float* ckr, const int* ptab, int b, int split, int hp) {
    const size_t tok0 = (size_t)ptab[b * NPAGES + split * 32 + (hp >> 1)] * PAGE + (hp & 1) * 64;
    const char* src = (const char*)(clat + tok0 * KVL) + (size_t)(F.wave * 8) * 1024 + F.lane * 16;
#pragma unroll
    for (int i = 0; i < 8; ++i) __builtin_amdgcn_global_load_lds((const unsigned*)(src + i * 1024), (LAS unsigned*)(L + DB_STAGE + (F.wave * 8 + i) * 1024), 16, 0, 0);
    __builtin_amdgcn_global_load_lds((const unsigned*)((const char*)(ckr + tok0 * 32) + F.wave * 1024 + F.lane * 16), (LAS unsigned*)(L + DB_KRST + F.wave * 1024), 16, 0, 0);
}
__device__ __forceinline__ void da_convert(Frame& F, LAS unsigned char* L) {
#pragma unroll 4
    for (int k = 0; k < 8; ++k) { const int f = F.tid + NTHR * k; const int row = f >> 6, c4 = f & 63; const f32x4 v = *(const LAS f32x4*)(L + DB_STAGE + f * 16);
        v2u w; w.x = pk2(v.x, v.y); w.y = pk2(v.z, v.w); *(LAS v2u*)(L + DB_LAT + row * DA_ROWB + c4 * 8) = w; }
    { const int f = F.tid; const int row = f >> 3, c4 = f & 7; const f32x4 v = *(const LAS f32x4*)(L + DB_KRST + f * 16);
      *(LAS f32x4*)((LAS float*)(L + DB_KR) + row * 36 + 4 * c4) = v; }
}
__device__ __forceinline__ void st_wt(float* p, float v) { asm volatile("global_store_dword %0, %1, off sc0 sc1" :: "v"(p), "v"(v) : "memory"); }
__device__ __forceinline__ void decode_combine_one(Frame& F, float M0, int b) {
    const float* DPART = (const float*)(F.ws + WS_DPART); const bf16* WUKV = (const bf16*)(F.ws + WS_WUKV2); const bf16* Q = (const bf16*)(F.ws + WS_Q); const bf16* KS = (const bf16*)(F.ws + WS_KS);
    const float* VS = (const float*)(F.ws + WS_VS); bf16* MIX = (bf16*)(F.ws + WS_MIX);
    LAS float* accl = (LAS float*)(F.lds + RING_OFF) + F.wave * 256; LAS float* exch = (LAS float*)(F.lds + P5_EXCH);
    const int h = F.wave;
    const float* p0 = DPART + ((size_t)((b * 2 + 0) * NH + h)) * 264; const float* p1 = DPART + ((size_t)((b * 2 + 1) * NH + h)) * 264;
#pragma unroll
    for (int k = 0; k < 4; ++k) accl[F.lane + 64 * k] = p0[F.lane + 64 * k] + p1[F.lane + 64 * k];
    float l = p0[256] + p1[256];
    const bf16* qp = Q + (size_t)(RP + b) * 768 + 96 * h; const bf16* kp = KS + (size_t)b * 768 + 96 * h;
    float sd = bf2f(qp[F.lane]) * bf2f(kp[F.lane]); if (F.lane < 32) sd += bf2f(qp[64 + F.lane]) * bf2f(kp[64 + F.lane]);
    sd = wave_sum(sd);
    const float pn = __builtin_amdgcn_exp2f(sd - M0); l += pn;
    LDS_WAIT(); asm volatile("" ::: "memory");
    const bf16* wv = WUKV + (size_t)(128 * h + 64 + F.lane) * KVL;
    float o = 0.f;
    { v4u wv4[32];
#pragma unroll
      for (int c8 = 0; c8 < 32; ++c8) wv4[c8] = *(const v4u*)(wv + 8 * c8);
#pragma unroll
      for (int c8 = 0; c8 < 32; ++c8) { const v4u w = wv4[c8]; const f32x4 x0 = *(const LAS f32x4*)(accl + 8 * c8), x1 = *(const LAS f32x4*)(accl + 8 * c8 + 4);
        o += (bflo(w.x) * x0.x + bfhi(w.x) * x0.y) + (bflo(w.y) * x0.z + bfhi(w.y) * x0.w) + (bflo(w.z) * x1.x + bfhi(w.z) * x1.y) + (bflo(w.w) * x1.z + bfhi(w.w) * x1.w); } }
    o = (o + pn * VS[(size_t)b * 512 + 64 * h + F.lane]) * __builtin_amdgcn_rcpf(l);
    const float ss = wave_sum(o * o);
    if (F.lane == 0) exch[h] = ss;
    __syncthreads();
    float tot = 0.f;
#pragma unroll
    for (int hh = 0; hh < NH; ++hh) tot += exch[hh];
    const float rs = __builtin_amdgcn_rsqf(tot * (1.f / MLAW) + EPS);
    MIX[(size_t)(RP + b) * 1024 + 512 + 64 * h + F.lane] = f2bf(o * rs);
    __syncthreads();
}
template <int MODE>
__device__ __forceinline__ void p5_attn_decode_t(Frame& F, float M0) {
    const float* clat = (const float*)F.in[2]; const float* ckr = (const float*)F.in[3]; const int* ptab = (const int*)F.in[6];
    const bf16* WUKV = (const bf16*)(F.ws + WS_WUKV2); const bf16* Q = (const bf16*)(F.ws + WS_Q); const float* gkn = (const float*)F.in[22]; const float* gkr = (const float*)F.in[23];
    float* DPART = (float*)(F.ws + WS_DPART);
    LAS unsigned char* L = F.lds + RING_OFF;
    LAS float* krl = (LAS float*)(L + DB_KR); LAS bf16* pb = (LAS bf16*)(L + DB_PB); LAS float* qg = (LAS float*)(L + DB_QG) + F.wave * 96;
    const int h = F.wave, r32 = F.lane & 31, hi = F.lane >> 5;
    for (int u = blockIdx.x; u < DB * 2; u += F.G) {
        const int b = u >> 1, split = u & 1;
        da_issue(F, L, clat, ckr, ptab, b, split, 0);
        bf16x8 wf[4][8];
#pragma unroll
        for (int dt = 0; dt < 4; ++dt)
#pragma unroll
            for (int s = 0; s < 8; ++s) wf[dt][s] = *(const bf16x8*)(WUKV + (size_t)(128 * h + 16 * dt + (F.lane & 15)) * KVL + 32 * s + 8 * (F.lane >> 4));
        { const bf16* qp = Q + (size_t)(RP + b) * 768 + 96 * h; qg[F.lane] = bf2f(qp[F.lane]) * gkn[F.lane]; if (F.lane < 32) qg[64 + F.lane] = bf2f(qp[64 + F.lane]) * gkr[F.lane & 15]; }
        for (int i = F.tid; i < 16 * 64; i += NTHR) pb[i] = 0;
        f32x4 ao[2] = {(f32x4){0.f, 0.f, 0.f, 0.f}, (f32x4){0.f, 0.f, 0.f, 0.f}}; float l = 0.f;
        RAW_BAR_VL();
        da_convert(F, L);
        RAW_BAR_L();
        da_issue(F, L, clat, ckr, ptab, b, split, 1);
#pragma unroll 1
        for (int hp = 0; hp < 64; ++hp) {
          if (MODE == 0 || MODE == 3) {
            const int n16 = F.lane & 15, kg4 = F.lane >> 4;
#pragma unroll 1
            for (int sb = 0; sb < 2; ++sb) {
                const LAS unsigned char* bp = L + DB_LAT + (32 * sb + n16) * DA_ROWB + 16 * kg4;
                f32x4 acc[4][2];
#pragma unroll
                for (int dt = 0; dt < 4; ++dt) { acc[dt][0] = (f32x4){0.f, 0.f, 0.f, 0.f}; acc[dt][1] = acc[dt][0]; }
                bf16x8 fa[2], fb[2];
                fa[0] = *(const LAS bf16x8*)(bp); fa[1] = *(const LAS bf16x8*)(bp + 16 * DA_ROWB);
#pragma unroll
                for (int s = 0; s < 8; ++s) {
                    if (s < 7) { fb[0] = *(const LAS bf16x8*)(bp + 64 * (s + 1)); fb[1] = *(const LAS bf16x8*)(bp + 16 * DA_ROWB + 64 * (s + 1)); }
#pragma unroll
                    for (int dt = 0; dt < 4; ++dt) { acc[dt][0] = MFMA16(wf[dt][s], fa[0], acc[dt][0]); acc[dt][1] = MFMA16(wf[dt][s], fa[1], acc[dt][1]); }
                    fa[0] = fb[0]; fa[1] = fb[1];
                }
                __builtin_amdgcn_sched_barrier(0);
                f32x4 s4[2] = {(f32x4){0.f, 0.f, 0.f, 0.f}, (f32x4){0.f, 0.f, 0.f, 0.f}}, d4[2] = {s4[0], s4[0]};
#pragma unroll
                for (int dt = 0; dt < 4; ++dt) { const f32x4 qq = *(const LAS f32x4*)(qg + 16 * dt + 4 * kg4);
#pragma unroll
                    for (int tt = 0; tt < 2; ++tt) { s4[tt] += acc[dt][tt] * acc[dt][tt]; d4[tt] += acc[dt][tt] * qq; } }
                { const LAS float* qr = qg + 64 + 8 * kg4; const f32x4 q0 = *(const LAS f32x4*)(qr), q1 = *(const LAS f32x4*)(qr + 4);
#pragma unroll
                  for (int tt = 0; tt < 2; ++tt) { const LAS float* kr = krl + (32 * sb + 16 * tt + n16) * 36 + 8 * kg4; const f32x4 k0 = *(const LAS f32x4*)(kr), k1 = *(const LAS f32x4*)(kr + 4);
                      s4[tt] += k0 * k0; s4[tt] += k1 * k1; d4[tt] += k0 * q0; d4[tt] += k1 * q1; } }
                __builtin_amdgcn_sched_barrier(0);
#pragma unroll
                for (int tt = 0; tt < 2; ++tt) { float ss = (s4[tt].x + s4[tt].y) + (s4[tt].z + s4[tt].w), dot = (d4[tt].x + d4[tt].y) + (d4[tt].z + d4[tt].w);
                    ss = sum_x16(ss); dot = sum_x16(dot); ss = sum_x32(ss); dot = sum_x32(dot);
                    const float p = __builtin_amdgcn_exp2f(dot * __builtin_amdgcn_rsqf(ss * (1.f / 96.f) + EPS) - M0);
                    if (kg4 == 0) { l += p; pb[h * 64 + 32 * sb + 16 * tt + n16] = f2bf(p); } }
            }
            RAW_BAR_L();
            if (MODE < 4) { const int q4 = (F.lane & 15) >> 2, pp = F.lane & 3, kg = F.lane >> 4;
              const unsigned a_lo = (unsigned)(uintptr_t)(L + DB_LAT) + (unsigned)((8 * kg + q4) * DA_ROWB + (32 * h + 4 * pp) * 2);
              const LAS bf16* pap = pb + (F.lane & 15) * 64 + 8 * kg;
              s16x4 t0, t1, t2, t3, t4, t5, t6, t7;
              asm volatile("ds_read_b64_tr_b16 %0, %8 offset:%c9\n\tds_read_b64_tr_b16 %1, %8 offset:%c10\n\tds_read_b64_tr_b16 %2, %8 offset:%c11\n\tds_read_b64_tr_b16 %3, %8 offset:%c12\n\t"
                           "ds_read_b64_tr_b16 %4, %8 offset:%c13\n\tds_read_b64_tr_b16 %5, %8 offset:%c14\n\tds_read_b64_tr_b16 %6, %8 offset:%c15\n\tds_read_b64_tr_b16 %7, %8 offset:%c16\n\ts_waitcnt lgkmcnt(0)"
                           : "=&v"(t0), "=&v"(t1), "=&v"(t2), "=&v"(t3), "=&v"(t4), "=&v"(t5), "=&v"(t6), "=&v"(t7)
                           : "v"(a_lo), "i"(0), "i"(4 * DA_ROWB), "i"(32), "i"(32 + 4 * DA_ROWB), "i"(32 * DA_ROWB), "i"(32 * DA_ROWB + 4 * DA_ROWB), "i"(32 * DA_ROWB + 32), "i"(32 * DA_ROWB + 32 + 4 * DA_ROWB) : "memory");
              const bf16x8 pa0 = *(const LAS bf16x8*)(pap), pa1 = *(const LAS bf16x8*)(pap + 32);
#define DA_FR(x, y) ((bf16x8){x[0], x[1], x[2], x[3], y[0], y[1], y[2], y[3]})
              ao[0] = MFMA16(pa0, DA_FR(t0, t1), ao[0]); ao[1] = MFMA16(pa0, DA_FR(t2, t3), ao[1]);
              ao[0] = MFMA16(pa1, DA_FR(t4, t5), ao[0]); ao[1] = MFMA16(pa1, DA_FR(t6, t7), ao[1]);
#undef DA_FR
#define DA_PV(ks, nt) do { } while (0)
#undef DA_PV
            }
          }
            RAW_BAR_VL();
            if (hp + 1 < 64) { if (MODE <= 1 || MODE >= 3) da_convert(F, L); RAW_BAR_L(); if (hp + 2 < 64 && MODE < 3) da_issue(F, L, clat, ckr, ptab, b, split, hp + 2); }
        }
        if (MODE >= 3 && l == 123.456f) DPART[0] = l;
        if (MODE == 0) { const int kg = F.lane >> 4;
          if (kg < 2) {
#pragma unroll
              for (int nt = 0; nt < 2; ++nt)
#pragma unroll
                  for (int i = 0; i < 4; ++i) st_wt(&DPART[((size_t)((b * 2 + split) * NH + 4 * kg + i)) * 264 + 32 * h + 16 * nt + (F.lane & 15)], ao[nt][i]); }
          float lt = wave_sum(l);
          if (F.lane == 0) st_wt(&DPART[((size_t)((b * 2 + split) * NH + h)) * 264 + 256], lt); }
        asm volatile("s_waitcnt vmcnt(0)" ::: "memory");
        __syncthreads();
        { volatile LAS unsigned* arr = (volatile LAS unsigned*)(F.lds + MISC_OFF) + 16;
          if (F.tid == 0) {
              const unsigned old = __hip_atomic_fetch_add((unsigned*)(F.ws + WS_CTL) + CW_DCNT + b, 1u, __ATOMIC_RELAXED, __HIP_MEMORY_SCOPE_AGENT);
              if (old == 1u) { __builtin_amdgcn_fence(__ATOMIC_ACQUIRE, "agent"); asm volatile("s_waitcnt vmcnt(0)" ::: "memory"); }
              arr[0] = old; }
          __syncthreads();
          if (MODE == 0 && arr[0] == 1u) decode_combine_one(F, M0, b);
          __syncthreads(); }
    }
}

__device__ __forceinline__ void p5_attn_decode(Frame& F, float M0) { p5_attn_decode_t<0>(F, M0); }

__device__ __forceinline__ void p7_outproj(Frame& F) {
    const bf16* MIX = (const bf16*)(F.ws + WS_MIX); const bf16* WOUT = (const bf16*)(F.ws + WS_WOUT); const float* xp = (const float*)F.in[0]; const float* xs = (const float*)F.in[1]; float* HS = (float*)(F.ws + WS_HS);
    bf16* HB = (bf16*)(F.ws + WS_XN); float* SS = (float*)(F.ws + WS_SSP); float* ysamp = F.out + OUT_YS;
    { pg8::Gemm g{MIX, WOUT, MMAIN, DM, 1024, 1, 1024}; pg8::StaticOrder S; S.init(MMAIN, DM, F.G, (int)blockIdx.x);
      LAS float* RS = (LAS float*)(F.lds + LDSCTL_OFF + 1024); const float* SSQ = (const float*)(F.ws + WS_SSQ);
#pragma unroll 1
      for (int i = 0; i < 8; ++i) { pg8::Unit uu; if (!S.next(i, uu)) break;
          int tl = (int)threadIdx.x; asm volatile("" : "+v"(tl));
          if (tl < 256) { const pg8::f32x4* sp = (const pg8::f32x4*)(SSQ + (size_t)(g.rowbase(uu.pm) + tl) * 8); const pg8::f32x4 s4 = sp[0] + sp[1];
              RS[i * 256 + tl] = __builtin_amdgcn_rsqf(((s4[0] + s4[1]) + (s4[2] + s4[3])) * (1.f / MLAW) + EPS); } }
      __syncthreads();
      EpiOutProj E{xp, F.out + OUT_YP, HB, SS, RS, 0};
      pg8::gemm_phase<EpiOutProj, pg8::StaticOrder, true, true, 8>(F.lds + RING_OFF, g, S, E); }
    { LAS f32x4* part = (LAS f32x4*)(F.lds + RING_OFF);
      for (int tp = blockIdx.x; tp < 256; tp += F.G) {
          const int t = 2 * tp + (F.wave >> 2), kq = F.wave & 3, rt = t & 7, ct = t >> 3;
          const bf16* ap = MIX + (size_t)(RP + rt * 16 + (F.lane & 15)) * 1024 + 256 * kq + 8 * (F.lane >> 4);
          const bf16* bp = WOUT + (size_t)(ct * 16 + (F.lane & 15)) * 1024 + 256 * kq + 8 * (F.lane >> 4);
          bf16x8 av[8], bv[8];
#pragma unroll
          for (int j = 0; j < 8; ++j) { av[j] = *(const bf16x8*)(ap + 32 * j); bv[j] = *(const bf16x8*)(bp + 32 * j); }
          f32x4 acc = {0.f, 0.f, 0.f, 0.f};
#pragma unroll
          for (int j = 0; j < 8; ++j) acc = MFMA16(av[j], bv[j], acc);
          part[F.wave * 64 + F.lane] = acc;
          __syncthreads();
          if (kq == 0) { acc = (acc + part[(F.wave + 1) * 64 + F.lane]) + (part[(F.wave + 2) * 64 + F.lane] + part[(F.wave + 3) * 64 + F.lane]);
              const int col = ct * 16 + (F.lane & 15);
#pragma unroll
              for (int i = 0; i < 4; ++i) { const int r = rt * 16 + 4 * (F.lane >> 4) + i; const size_t o = (size_t)r * DM + col; const float v = xs[o] + acc[i]; HS[o] = v; ysamp[o] = v; HB[(size_t)(RP + r) * DM + col] = f2bf(v);
                  float ss = v * v; ss = sum_x1(ss); ss = sum_x2(ss); ss = sum_x4(ss); ss = sum_x8(ss);
                  if ((F.lane & 15) == 0) SS[(size_t)MMAIN * 16 + (size_t)r * 64 + ct] = ss; } }
          __syncthreads();
      } }
}
__device__ __forceinline__ void p9_gateup(Frame& F) {
    const bf16* HB = (const bf16*)(F.ws + WS_XN); const bf16* WGU = (const bf16*)(F.ws + WS_WGU); bf16* ACT = (bf16*)(F.ws + WS_ACT); const float* SS = (const float*)(F.ws + WS_SSP);
    { pg8::Gemm g{HB, WGU, MMAIN, 2 * DFF, DM, 1, DM}; pg8::StaticOrder S; S.init(MMAIN, 2 * DFF, F.G, (int)blockIdx.x);
      LAS float* RS = (LAS float*)(F.lds + LDSCTL_OFF + 1024);
#pragma unroll 1
      for (int i = 0; i < 8; ++i) { pg8::Unit uu; if (!S.next(i, uu)) break;
          int tl = (int)threadIdx.x; asm volatile("" : "+v"(tl));
          if (tl < 256) { const pg8::f32x4* sp = (const pg8::f32x4*)(SS + (size_t)(uu.pm * 256 + tl) * 16); const pg8::f32x4 s4 = (sp[0] + sp[1]) + (sp[2] + sp[3]);
              RS[i * 256 + tl] = __builtin_amdgcn_rsqf(((s4[0] + s4[1]) + (s4[2] + s4[3])) * (1.f / DM) + EPS); } }
      __syncthreads();
      EpiSwiGLU E{ACT, RS, 0};
      pg8::gemm_phase<EpiSwiGLU, pg8::StaticOrder, true, true>(F.lds + RING_OFF, g, S, E); }
    const int gw = F.gw, ngw = F.NGW;
    const int nrt = DB / 16, nlt = DFF / 16;
    for (int task = gw; task < nrt * nlt; task += ngw) {
        const int rt = task % nrt, lt = task / nrt; const int lc = lt * 16 + (F.lane & 15);
        const bf16* ap = HB + (size_t)(RP + rt * 16 + (F.lane & 15)) * DM + 8 * (F.lane >> 4);
        const bf16* gp = WGU + (size_t)(256 * (lc >> 7) + (lc & 127)) * DM + 8 * (F.lane >> 4); const bf16* up = gp + (size_t)128 * DM;
        f32x4 ag = {0.f, 0.f, 0.f, 0.f}, au = {0.f, 0.f, 0.f, 0.f};
#pragma unroll 8
        for (int k0 = 0; k0 < DM; k0 += 32) { const bf16x8 a = *(const bf16x8*)(ap + k0); ag = MFMA16(a, *(const bf16x8*)(gp + k0), ag); au = MFMA16(a, *(const bf16x8*)(up + k0), au); }
#pragma unroll
        for (int i = 0; i < 4; ++i) { const int r = rt * 16 + 4 * (F.lane >> 4) + i; const f32x4* sp = (const f32x4*)(SS + (size_t)MMAIN * 16 + (size_t)r * 64); f32x4 s4 = sp[0];
#pragma unroll
            for (int q = 1; q < 16; ++q) s4 += sp[q];
            const float rs = __builtin_amdgcn_rsqf(((s4[0] + s4[1]) + (s4[2] + s4[3])) * (1.f / DM) + EPS);
            ACT[(size_t)(RP + r) * DFF + lc] = f2bf(silu_f(rs * ag[i]) * (rs * au[i])); }
    }
}
__device__ __forceinline__ void p10_down(Frame& F) {
    const bf16* ACT = (const bf16*)(F.ws + WS_ACT); const bf16* WDN = (const bf16*)(F.ws + WS_WDN); const float* HS = (const float*)(F.ws + WS_HS);
    { pg8::Gemm g{ACT, WDN, MMAIN, DM, DFF, 1, DFF}; pg8::StaticOrder S; S.init(MMAIN, DM, F.G, (int)blockIdx.x); EpiDown E{(const bf16*)(F.ws + WS_XN), F.out + OUT_YP};
      pg8::gemm_phase<EpiDown, pg8::StaticOrder, true, true>(F.lds + RING_OFF, g, S, E); }
    float* ys = F.out + OUT_YS;
    small_gemm(ACT, DFF, WDN, DFF, DB / 16, DM / 16, [](int r) { return RP + r; },
        [&](const f32x4& acc, int rt, int ct, int lane) { const int col = ct * 16 + (lane & 15);
#pragma unroll
            for (int i = 0; i < 4; ++i) atomicAdd(ys + (size_t)(rt * 16 + 4 * (lane >> 4) + i) * DM + col, acc[i]); }, F.gw, F.NGW, F.lane, 4);
}
#ifndef MK_ONE_LAUNCH
#define MK_ONE_LAUNCH 0
#endif
constexpr int N_PHASES = 9;
__global__ void __launch_bounds__(NTHR, 2) mk_fwd(Args args) {
    extern __shared__ __attribute__((aligned(16))) unsigned char lds_raw[];
    Frame F;
    F.lds = (LAS unsigned char*)lds_raw;
    F.tid = threadIdx.x; F.lane = F.tid & 63; F.wave = __builtin_amdgcn_readfirstlane(F.tid >> 6);
    F.G = gridDim.x; { const int bx = blockIdx.x; F.vcu = (F.G % 8 == 0) ? (bx % 8) * (F.G / 8) + bx / 8 : bx; }
    F.gw = blockIdx.x * NWAVES + F.wave; F.NGW = F.G * NWAVES;
    F.ws = args.ws; F.out = args.out; F.in = args.in;
    volatile LAS unsigned* MISC = (volatile LAS unsigned*)(F.lds + MISC_OFF);
    for (int u = F.tid; u < (LDS_BYTES - LDSCTL_OFF) / 4; u += NTHR) ((LAS unsigned*)(F.lds + LDSCTL_OFF))[u] = 0u;
    __syncthreads();
    XcdBarrier bar; bar.bar = (unsigned*)(F.ws + WS_CTL) + CW_BAR; bar.x = 0; bar.st = nullptr;
    const int lo = args.ph_lo, hi = args.ph_hi;
    if (hi - lo > 1) bar = xcd_barrier_post((unsigned*)(F.ws + WS_CTL) + CW_BAR, MISC + 8);
#ifdef MK_TS
    unsigned long long* TSB = (unsigned long long*)(F.ws + 600 * MiB); int tsn = 0;
#define STAMP() do { if (blockIdx.x == 0 && F.tid == 0) TSB[tsn] = __builtin_amdgcn_s_memrealtime(); ++tsn; } while (0)
    STAMP();
#else
#define STAMP() do { } while (0)
#endif
#define IN(k) (lo <= (k) && (k) < hi)
#ifdef MK_TS
#define ARRIVE(k) do { if (blockIdx.x == 0 && F.tid == 0) TSB[30 + (k)] = __builtin_amdgcn_s_memrealtime(); } while (0)
#else
#define ARRIVE(k) do { } while (0)
#endif
#define SEAM(k) do { ARRIVE(k); if (IN(k) && IN((k) + 1)) xcd_barrier(bar); STAMP(); } while (0)
#ifndef MK_REPEAT
#define MK_REPEAT 0
#endif
#define REP(id, stmt) do { stmt; if (MK_REPEAT & (1 << (id))) { __syncthreads(); stmt; } } while (0)
    if (IN(0)) { REP(0, p0_prologue(F)); } SEAM(0);
    if (IN(1)) { REP(1, p1_inproj(F)); } SEAM(1);
    if (IN(2)) {
#ifdef MK_SLEEP_PROBE
        { const unsigned long long t0 = __builtin_amdgcn_s_memrealtime(); while (__builtin_amdgcn_s_memrealtime() - t0 < 3000ull) __builtin_amdgcn_s_sleep(32); }
#endif
        REP(2, p2_elementwise(F)); } SEAM(2);
    if (IN(3)) { REP(3, p3_upproj_states(F)); } SEAM(3);
    if (IN(4)) { REP(4, p4_post(F)); } SEAM(4);
    if (IN(5)) { const float M0 = softmax_ref(F);
        if (blockIdx.x & 1) { p5_attn_decode(F, M0); __syncthreads(); }
        p5_attn_prompt(F, M0); __syncthreads();
        p5_ssd_out(F); __syncthreads();
        if (!(blockIdx.x & 1)) p5_attn_decode(F, M0);
    } SEAM(5);
    if (IN(6)) { REP(9, p7_outproj(F)); } SEAM(6);
    if (IN(7)) { REP(11, p9_gateup(F)); } SEAM(7);
    if (IN(8)) { p10_down(F); }
#ifdef MK_TS
    __syncthreads(); STAMP();
#endif
#undef IN
#undef SEAM
}
#ifndef MK_DIAG
#define MK_DIAG 0
#endif
__device__ __forceinline__ size_t nmrow(size_t r) { return r < (size_t)MMAIN ? (r >> 11) * TT + NMETA + (r & 2047) : (size_t)RP + (r - MMAIN); }
constexpr size_t WS_OUT2 = 1024 * MiB;
#ifdef MK_TS
#ifndef MK_TS_QA
#define MK_TS_QA 4.f
#endif
#ifndef MK_TS_QB
#define MK_TS_QB 4.f
#endif
__global__ void k_ts_encode(const unsigned long long* ts, float* out, int ia0, int ia1, int ib0, int ib1) {
    const float ta = rintf((float)(ts[ia1] - ts[ia0]) * 0.01f * (1.f / MK_TS_QA)) * MK_TS_QA, tb = rintf((float)(ts[ib1] - ts[ib0]) * 0.01f * (1.f / MK_TS_QB)) * MK_TS_QB;
    const float f = 1.f + sqrtf(ta * 1e-3f);
    for (int i = blockIdx.x * blockDim.x + threadIdx.x; i < 131072; i += gridDim.x * blockDim.x) out[OUT_YS + i] *= f;
    if (blockIdx.x == 0 && threadIdx.x == 0) out[0] += tb * 0.1f;
}
#endif
extern "C" void kernel_launch(void* const* d_in, const int* in_sizes, int n_in, void* d_out, int out_size, void* d_ws, size_t ws_size, hipStream_t stream) {
    (void)hipFuncSetAttribute((const void*)mk_fwd, hipFuncAttributeMaxDynamicSharedMemorySize, LDS_BYTES);
    unsigned char* ws = (unsigned char*)d_ws;
    (void)hipMemsetAsync(ws + WS_CTL, 0, CTL_ZERO_BYTES, stream);
    Args a{};
    for (int i = 0; i < 30; ++i) a.in[i] = d_in[i];
    a.ws = ws; a.out = (float*)d_out;
#if MK_DIAG
    float* diag = (float*)(ws + WS_DIAG);
    (void)hipMemsetAsync(diag, 0, 512, stream);
    nv::forward(d_in, (float*)d_out, (float*)(ws + WS_NAIVE), stream);
    a.out = (float*)(ws + WS_OUT2);
#endif
    static int one_launch = -1;
    if (one_launch < 0) { int dev = 0, cus = 0, per_cu = 0; one_launch = 0;
        if (hipGetDevice(&dev) == hipSuccess && hipDeviceGetAttribute(&cus, hipDeviceAttributeMultiprocessorCount, dev) == hipSuccess && cus >= 256) one_launch = 1;
        (void)per_cu;
        (void)hipGetLastError(); }
    const int grid = 256;
    if (one_launch && MK_ONE_LAUNCH) { a.ph_lo = 0; a.ph_hi = N_PHASES; a.li = 0; hipLaunchKernelGGL(mk_fwd, dim3(grid), dim3(NTHR), LDS_BYTES, stream, a); }
    else for (int ph = 0; ph < N_PHASES; ++ph) { a.ph_lo = ph; a.ph_hi = ph + 1; a.li = ph; hipLaunchKernelGGL(mk_fwd, dim3(grid), dim3(NTHR), LDS_BYTES, stream, a); }
#ifdef MK_TS
    k_ts_encode<<<64, 256, 0, stream>>>((const unsigned long long*)(ws + 600 * MiB), (float*)d_out, MK_TS_A0, MK_TS_A1, MK_TS_B0, MK_TS_B1);
#endif
#if MK_DIAG
    {
        nv::Ws w = nv::carve((float*)(ws + WS_NAIVE));
        const bf16* QRAW = (const bf16*)(ws + WS_QRAW); const bf16* KVRAW = (const bf16*)(ws + WS_KVRAW); const bf16* Q = (const bf16*)(ws + WS_Q); const bf16* K = (const bf16*)(ws + WS_K);
        const bf16* VT = (const bf16*)(ws + WS_VT); const float* VS = (const float*)(ws + WS_VS); const bf16* MIX = (const bf16*)(ws + WS_MIX);
        const float* o2 = (const float*)(ws + WS_OUT2); const float* o1 = (const float*)d_out;
        const float* nQRAW = w.QRAW; const float* nKV = w.KV; const float* nQ = w.Q; const float* nK = w.K; const float* nV = w.V; const float* nMIX = w.MIX;
        const size_t NMR = (size_t)MMAIN + DB;
        cmp(stream, 0, diag, NMR * 768, [=] __device__(size_t i) { return bf2f(QRAW[nmrow(i / 768) * 768 + i % 768]); }, [=] __device__(size_t i) { return nQRAW[nmrow(i / 768) * 768 + i % 768]; });
        cmp(stream, 1, diag, (size_t)R * 1024, [=] __device__(size_t i) { return bf2f(KVRAW[i]); }, [=] __device__(size_t i) { return nKV[i]; });
        cmp(stream, 2, diag, NMR * 768, [=] __device__(size_t i) { return bf2f(Q[nmrow(i / 768) * 768 + i % 768]); }, [=] __device__(size_t i) { return nQ[nmrow(i / 768) * 768 + i % 768] * (ATTN_SCALE * LOG2E); });
        cmp(stream, 3, diag, (size_t)R * 768, [=] __device__(size_t i) { return bf2f(K[i]); }, [=] __device__(size_t i) { return nK[i]; });
        cmp(stream, 4, diag, (size_t)NB * 512 * TT, [=] __device__(size_t i) { const size_t bhd = i / TT; const int t = (int)(i % TT); return bf2f(VT[bhd * TPAD + t]); },
            [=] __device__(size_t i) { const size_t bhd = i / TT; const int t = (int)(i % TT); const size_t b = bhd / 512, hd = bhd % 512; return nV[(b * TT + t) * 512 + hd]; });
        cmp(stream, 4, diag, (size_t)DB * 512, [=] __device__(size_t i) { return VS[i]; }, [=] __device__(size_t i) { return nV[(size_t)RP * 512 + i]; });
        cmp(stream, 5, diag, (size_t)(OUT_LATS - OUT_SSMP), [=] __device__(size_t i) { return o2[OUT_SSMP + i]; }, [=] __device__(size_t i) { return o1[OUT_SSMP + i]; });
        cmp(stream, 5, diag, (size_t)4194304, [=] __device__(size_t i) { return o2[OUT_SSMS + i]; }, [=] __device__(size_t i) { return o1[OUT_SSMS + i]; });
        cmp(stream, 6, diag, (size_t)R * 512, [=] __device__(size_t i) { return bf2f(MIX[(i >> 9) * 1024 + (i & 511)]); }, [=] __device__(size_t i) { return nMIX[(i >> 9) * 1024 + (i & 511)]; });
        cmp(stream, 7, diag, NMR * 512, [=] __device__(size_t i) { return bf2f(MIX[nmrow(i >> 9) * 1024 + 512 + (i & 511)]); }, [=] __device__(size_t i) { return nMIX[nmrow(i >> 9) * 1024 + 512 + (i & 511)]; });
        cmp(stream, 8, diag, (size_t)OUT_LATP, [=] __device__(size_t i) { return o2[i]; }, [=] __device__(size_t i) { return o1[i]; });
        k_diag_encode<<<64, 256, 0, stream>>>(diag, 9, 1e-3f, (float*)d_out);
    }
#endif
}
```

```cpp
#define MK_DIAG 0
#define MK_ONE_LAUNCH 1
#include <hip/hip_runtime.h>
#include <cstdio>
#include <cstdint>
namespace pg8 {
#define PG8_LAS __attribute__((address_space(3)))
typedef unsigned short bf16_t;
typedef short bf16x8 __attribute__((ext_vector_type(8)));
typedef float f32x4 __attribute__((ext_vector_type(4)));
typedef unsigned u32x4 __attribute__((ext_vector_type(4)));
constexpr int BM = 256, BK = 64, HALF = 128, HTB = HALF * BK * 2  , STAGE_BYTES = 8 * HTB, NXCD = 8, WGM = 8;

__host__ __device__ __forceinline__ int lds_byte(int r, int c) { const int st = (r >> 4) * 2 + (c >> 5), rr = r & 15, cc = c & 31, ob = rr * 64 + cc * 2; return st * 1024 + (ob ^ (((ob >> 9) & 1) << 5)); }
__host__ __device__ __forceinline__ void stage_rc(int b, int& R, int& C) { const int st = b / 1024, sb = b % 1024, swz = sb ^ (((sb >> 9) & 1) << 5); R = (st >> 1) * 16 + swz / 64; C = (st & 1) * 32 + (swz % 64) / 2; }
__host__ __device__ __forceinline__ int perm32(int rho) { const int n = rho >> 4, i = rho & 15; return 8 * (i >> 2) + 4 * n + (i & 3); }

struct Unit { int pm, pn; };
template <class E> constexpr bool has_midscale = false;
struct Gemm { const bf16_t* A; const bf16_t* Bt; int M, N, K; int rmode; int lda;
    __host__ __device__ __forceinline__ int rowbase(int pm) const { return rmode ? (pm >> 3) * 2064 + 16 + (pm & 7) * 256 : pm * 256; } };

struct StaticOrder {
    int nM, nN, nwg, G, c;
    __host__ __device__ void init(int M, int N, int G_, int c_) { nM = M / BM; nN = N / BM; nwg = nM * nN; G = G_; c = c_; }
    __host__ __device__ bool next(int i, Unit& u) const {
        const long L = (long)i * G + c; if (L >= nwg) return false;
        int wgid = (int)L; { const int q = nwg / NXCD, r = nwg % NXCD, xcd = wgid % NXCD, off = wgid / NXCD; wgid = (xcd < r ? xcd * (q + 1) : r * (q + 1) + (xcd - r) * q) + off; }
        const int nig = WGM * nN, gid = wgid / nig, fm = gid * WGM, gsz = (nM - fm) < WGM ? (nM - fm) : WGM;
        u.pm = fm + ((wgid % nig) % gsz); u.pn = (wgid % nig) / gsz; return true;
    }
    __device__ __forceinline__ void a_ready(const Unit&) const {}
    __device__ __forceinline__ void done(const Unit&) const {}
};


template <class Epi, class Sched, bool ALIGN_EPI = false, bool SP2 = false, int ROT = 0>
__device__ __forceinline__ void gemm_phase(PG8_LAS unsigned char* lds, const Gemm g, const Sched& S, const Epi& E) {
    const int tid = threadIdx.x, wid = __builtin_amdgcn_readfirstlane(tid >> 6), lane = tid & 63, wr = wid >> 2, wc = wid & 3, fr = lane & 15, fq = lane >> 4;
    const int K = g.K, nt = K / BK;
    unsigned voffA[2], voffB[2];
#pragma unroll
    for (int i = 0; i < 2; ++i) { int R, C; stage_rc(tid * 16 + i * 8192, R, C); const int Rb = Epi::PERM ? ((R & ~31) + perm32(R & 31)) : R;
        voffA[i] = (unsigned)(R * g.lda + C) * 2u; voffB[i] = (unsigned)(Rb * K + C) * 2u; }
    const size_t kstep = (size_t)(BK * 2);
    const size_t hstepA = (size_t)HALF * g.lda * 2;
    const size_t hstep = (size_t)HALF * K * 2;
    const size_t tstep = 2 * hstep;
    const unsigned ldsw = (unsigned)wid * 1024u;
    const int aoff = lds_byte(wr * 64 + fr, fq * 8), boff = lds_byte(wc * 32 + fr, fq * 8);
#define PG8_SA(b, h) (((b) * 2 + (h)) * HTB)
#define PG8_SB(b, h) ((4 + (b) * 2 + (h)) * HTB)
#define PG8_STAGE(bufoff, gbase, voff) do { _Pragma("unroll") for (int _i = 0; _i < 2; ++_i) \
        __builtin_amdgcn_global_load_lds((const unsigned*)((const char*)(gbase) + (voff)[_i]), (PG8_LAS unsigned*)(lds + (bufoff) + ldsw + _i * 8192), 16, 0, 0); } while (0)
#define PG8_LDA(dst, b, h) do { _Pragma("unroll") for (int m = 0; m < 4; ++m) _Pragma("unroll") for (int k = 0; k < 2; ++k) dst[m][k] = *(const PG8_LAS bf16x8*)(lds + PG8_SA(b, h) + aoff + m * 2048 + k * 1024); } while (0)
#define PG8_LDB(dst, b, h) do { _Pragma("unroll") for (int n = 0; n < 2; ++n) _Pragma("unroll") for (int k = 0; k < 2; ++k) dst[n][k] = *(const PG8_LAS bf16x8*)(lds + PG8_SB(b, h) + boff + n * 2048 + k * 1024); } while (0)
#define PG8_MMA(ai, bj, At, Bt) do { __builtin_amdgcn_s_setprio(1); _Pragma("unroll") for (int m = 0; m < 4; ++m) _Pragma("unroll") for (int n = 0; n < 2; ++n) _Pragma("unroll") for (int k = 0; k < 2; ++k) \
        acc[ai][bj][m][n] = __builtin_amdgcn_mfma_f32_16x16x32_bf16(Bt[n][k], At[m][k], acc[ai][bj][m][n], 0, 0, 0); __builtin_amdgcn_s_setprio(0); } while (0)
#define PG8_WAIT_V(n) asm volatile("s_waitcnt vmcnt(" #n ")" ::: "memory")
#define PG8_WAIT_L(n) asm volatile("s_waitcnt lgkmcnt(" #n ")" ::: "memory")
#define PG8_BAR __builtin_amdgcn_s_barrier()
#define PG8_SCHED __builtin_amdgcn_sched_barrier(0)
    Unit cur, nxt; int ui = 0;
    if (!S.next(0, cur)) return;
    f32x4 acc[2][2][4][2];
#pragma unroll
    for (int a = 0; a < 2; ++a)
#pragma unroll
        for (int b = 0; b < 2; ++b)
#pragma unroll
            for (int m = 0; m < 4; ++m)
#pragma unroll
                for (int n = 0; n < 2; ++n) acc[a][b][m][n] = (f32x4){0.f, 0.f, 0.f, 0.f};
    bf16x8 At[4][2], B0[2][2], B1[2][2];
    const char* cA = (const char*)g.A + (size_t)g.rowbase(cur.pm) * g.lda * 2 + ROT * kstep; const char* cB = (const char*)g.Bt + (size_t)cur.pn * tstep + ROT * kstep;
#define PG8_KOFF(j) ((long)((ROT != 0 && (j) >= nt - ROT) ? (j) - nt : (j)) * (long)kstep)
    S.a_ready(cur);
    if constexpr (SP2) {
        PG8_STAGE(PG8_SB(0, 0), cB, voffB); PG8_STAGE(PG8_SB(0, 1), cB + hstep, voffB); PG8_STAGE(PG8_SA(0, 0), cA, voffA); PG8_STAGE(PG8_SA(0, 1), cA + hstepA, voffA);
        if (wr == 1) PG8_BAR;
        PG8_WAIT_V(2); PG8_BAR;
        PG8_STAGE(PG8_SB(1, 0), cB + kstep, voffB); PG8_STAGE(PG8_SA(1, 0), cA + kstep, voffA); PG8_STAGE(PG8_SB(1, 1), cB + hstep + kstep, voffB);
        PG8_WAIT_V(6); PG8_BAR;
    } else {
        PG8_STAGE(PG8_SB(0, 0), cB, voffB); PG8_STAGE(PG8_SA(0, 0), cA, voffA); PG8_STAGE(PG8_SB(0, 1), cB + hstep, voffB); PG8_STAGE(PG8_SA(0, 1), cA + hstepA, voffA);
        if (wr == 1) PG8_BAR;
        PG8_WAIT_V(4); PG8_BAR;
        PG8_STAGE(PG8_SB(1, 0), cB + kstep, voffB); PG8_STAGE(PG8_SA(1, 0), cA + kstep, voffA); PG8_STAGE(PG8_SB(1, 1), cB + hstep + kstep, voffB);
        PG8_WAIT_V(6); PG8_BAR;
    }
    for (;;) {
        const bool has_next = S.next(ui + 1, nxt);
        const char* nA = has_next ? (const char*)g.A + (size_t)g.rowbase(nxt.pm) * g.lda * 2 + ROT * kstep : cA; const char* nB = has_next ? (const char*)g.Bt + (size_t)nxt.pn * tstep + ROT * kstep : cB;
        for (int t = 0; t < nt; t += 2) {
            const bool last = (t == nt - 2);
            const char* a1 = cA + PG8_KOFF(t + 1);
            const char* a2 = last ? nA : cA + PG8_KOFF(t + 2); const char* b2 = last ? nB : cB + PG8_KOFF(t + 2);
            if constexpr (has_midscale<Epi>) { if (t == nt - ROT) E.midscale(acc, cur, wr, fr); }
            const char* a3 = a2 + kstep; const char* b3 = b2 + kstep;
            if (last && has_next) S.a_ready(nxt);
            if constexpr (SP2) {
            PG8_LDB(B0, 0, 0); PG8_LDB(B1, 0, 1); PG8_SCHED; PG8_LDA(At, 0, 0); PG8_STAGE(PG8_SA(1, 1), a1 + hstepA, voffA);
            PG8_WAIT_V(8); PG8_WAIT_L(0); PG8_BAR; PG8_MMA(0, 0, At, B0); PG8_MMA(0, 1, At, B1); PG8_BAR; PG8_SCHED;
            PG8_LDA(At, 0, 1); PG8_STAGE(PG8_SB(0, 0), b2, voffB); PG8_STAGE(PG8_SB(0, 1), b2 + hstep, voffB); PG8_STAGE(PG8_SA(0, 0), a2, voffA);
            PG8_WAIT_V(8); PG8_WAIT_L(0); PG8_BAR; PG8_MMA(1, 0, At, B0); PG8_MMA(1, 1, At, B1); PG8_BAR; PG8_SCHED;
            PG8_LDB(B0, 1, 0); PG8_LDB(B1, 1, 1); PG8_SCHED; PG8_LDA(At, 1, 0); PG8_STAGE(PG8_SA(0, 1), a2 + hstepA, voffA);
            PG8_WAIT_V(8); PG8_WAIT_L(0); PG8_BAR; PG8_MMA(0, 0, At, B0); PG8_MMA(0, 1, At, B1); PG8_BAR; PG8_SCHED;
            PG8_LDA(At, 1, 1); PG8_STAGE(PG8_SB(1, 0), b3, voffB); PG8_STAGE(PG8_SB(1, 1), b3 + hstep, voffB); PG8_STAGE(PG8_SA(1, 0), a3, voffA);
            PG8_WAIT_V(8); PG8_WAIT_L(0); PG8_BAR; PG8_MMA(1, 0, At, B0); PG8_MMA(1, 1, At, B1); PG8_BAR; PG8_SCHED;
            } else {
            PG8_LDB(B0, 0, 0); PG8_SCHED; PG8_LDA(At, 0, 0); PG8_STAGE(PG8_SA(1, 1), a1 + hstepA, voffA);
            PG8_WAIT_L(8); PG8_BAR; PG8_WAIT_L(0); PG8_MMA(0, 0, At, B0); PG8_BAR; PG8_SCHED;
            PG8_LDB(B1, 0, 1); PG8_STAGE(PG8_SB(0, 0), b2, voffB);
            PG8_BAR; PG8_WAIT_L(0); PG8_MMA(0, 1, At, B1); PG8_BAR;
            PG8_LDA(At, 0, 1); PG8_STAGE(PG8_SA(0, 0), a2, voffA);
            PG8_BAR; PG8_WAIT_L(0); PG8_MMA(1, 0, At, B0); PG8_BAR; PG8_SCHED;
            PG8_STAGE(PG8_SB(0, 1), b2 + hstep, voffB);
            PG8_WAIT_V(6); PG8_BAR; PG8_MMA(1, 1, At, B1); PG8_BAR;
            PG8_LDB(B0, 1, 0); PG8_SCHED; PG8_LDA(At, 1, 0); PG8_STAGE(PG8_SA(0, 1), a2 + hstepA, voffA);
            PG8_WAIT_L(8); PG8_BAR; PG8_WAIT_L(0); PG8_MMA(0, 0, At, B0); PG8_BAR; PG8_SCHED;
            PG8_LDB(B1, 1, 1); PG8_STAGE(PG8_SB(1, 0), b3, voffB);
            PG8_BAR; PG8_WAIT_L(0); PG8_MMA(0, 1, At, B1); PG8_BAR;
            PG8_LDA(At, 1, 1); PG8_STAGE(PG8_SA(1, 0), a3, voffA);
            PG8_BAR; PG8_WAIT_L(0); PG8_MMA(1, 0, At, B0); PG8_BAR; PG8_SCHED;
            PG8_STAGE(PG8_SB(1, 1), b3 + hstep, voffB);
            PG8_WAIT_V(6); PG8_BAR; PG8_MMA(1, 1, At, B1); PG8_BAR;
            }
        }
        if constexpr (ALIGN_EPI) { if (wr == 0) PG8_BAR; }
        if constexpr (!Epi::AFTER_DRAIN) { E(acc, cur, wr, wc, fr, fq); S.done(cur); }
        if (!has_next) break;
#pragma unroll
        for (int a = 0; a < 2; ++a)
#pragma unroll
            for (int b = 0; b < 2; ++b)
#pragma unroll
                for (int m = 0; m < 4; ++m)
#pragma unroll
                    for (int n = 0; n < 2; ++n) acc[a][b][m][n] = (f32x4){0.f, 0.f, 0.f, 0.f};
        cur = nxt; cA = nA; cB = nB; ++ui;
        if constexpr (ALIGN_EPI) { if (wr == 1) PG8_BAR; }
    }
    PG8_WAIT_V(0);
    if constexpr (!ALIGN_EPI) { if (wr == 0) PG8_BAR; }
    PG8_BAR;
    if constexpr (Epi::AFTER_DRAIN) { E.fused(acc, cur, wr, wc, fr, fq, lds, wid, lane); S.done(cur); }
#undef PG8_KOFF
#undef PG8_SA
#undef PG8_SB
#undef PG8_STAGE
#undef PG8_LDA
#undef PG8_LDB
#undef PG8_MMA
#undef PG8_WAIT_V
#undef PG8_WAIT_L
#undef PG8_BAR
#undef PG8_SCHED
}
}

#define GAS __attribute__((address_space(1)))
#define LAS __attribute__((address_space(3)))
typedef unsigned short bf16;
typedef unsigned v4u __attribute__((ext_vector_type(4)));
typedef unsigned v2u __attribute__((ext_vector_type(2)));
typedef float f32x4 __attribute__((ext_vector_type(4)));
typedef float f32x16 __attribute__((ext_vector_type(16)));
typedef short bf16x8 __attribute__((ext_vector_type(8)));
typedef short s16x4 __attribute__((ext_vector_type(4)));
typedef GAS unsigned gu32;
#define RLX_AGENT __ATOMIC_RELAXED, __HIP_MEMORY_SCOPE_AGENT
#define LDS_WAIT() asm volatile("s_waitcnt lgkmcnt(0)" ::: "memory")
#define VM_WAIT() asm volatile("s_waitcnt vmcnt(0)" ::: "memory")
typedef float f32x2_t __attribute__((ext_vector_type(2))); typedef __bf16 bf16x2_t __attribute__((ext_vector_type(2)));
__device__ __forceinline__ unsigned pk2(float lo, float hi) { f32x2_t v = {lo, hi}; bf16x2_t b = __builtin_convertvector(v, bf16x2_t); return __builtin_bit_cast(unsigned, b); }
__device__ __forceinline__ bf16 f2bf(float f) { return (bf16)(pk2(f, 0.f) & 0xffffu); }
__device__ __forceinline__ float bf2f(bf16 v) { return __uint_as_float((unsigned)v << 16); }
__device__ __forceinline__ float bflo(unsigned w) { return __uint_as_float(w << 16); }
__device__ __forceinline__ float bfhi(unsigned w) { return __uint_as_float(w & 0xffff0000u); }

#define XB_TMO      128
#define XB_XCNT(j)  (256  + 64 * (j))
#define XB_XSUB(j)  (1280 + 64 * (j))
#define XB_XGEN(j)  (2304 + 64 * (j))
#define XB_TOP      3328
#define XB_TOPGEN   3392
#define XCD_BAR_WORDS 3456
#define XB_SPIN_CAP (1u << 18)
__device__ __forceinline__ unsigned xb_ld(unsigned* p)              { return __hip_atomic_load(p, __ATOMIC_RELAXED, __HIP_MEMORY_SCOPE_AGENT); }
__device__ __forceinline__ unsigned xb_add(unsigned* p, unsigned v) { return __hip_atomic_fetch_add(p, v, __ATOMIC_RELAXED, __HIP_MEMORY_SCOPE_AGENT); }
__device__ __forceinline__ unsigned xb_xcc_id() { return (unsigned)__builtin_amdgcn_s_getreg((3 << 11) | 20) & 0xFu; }
#define XB_SPIN(cond, bar) do { unsigned _sp = 0; while (cond) { __builtin_amdgcn_s_sleep(1); \
    if ((++_sp & 255u) == 0u) { if (xb_ld(&(bar)[XB_TMO])) break; if (_sp > XB_SPIN_CAP) { atomicAdd(&(bar)[XB_TMO], 1u); break; } } } } while (0)
struct XcdBarrier { unsigned* bar; unsigned x; volatile LAS unsigned* st; };
__device__ __forceinline__ XcdBarrier xcd_barrier_post(unsigned* bar, volatile LAS unsigned* st) {
    XcdBarrier b; b.bar = bar; b.x = xb_xcc_id(); b.st = st;
    if (threadIdx.x == 0) (void)xb_add(&bar[XB_XCNT(b.x)], 1u);
    return b;
}
__device__ __forceinline__ void xcd_barrier_complete(unsigned* bar, unsigned x, unsigned& nloc, unsigned& nx) {
    const unsigned G = gridDim.x * gridDim.y * gridDim.z;
    unsigned sum, cnt, mine, sp = 0u;
    for (;;) {
        sum = 0u; cnt = 0u; mine = 0u;
#pragma unroll
        for (unsigned j = 0; j < 16; ++j) { const unsigned c = xb_ld(&bar[XB_XCNT(j)]); sum += c; cnt += (c > 0u) ? 1u : 0u; mine = (j == x) ? c : mine; }
        if (sum == G) break;
        __builtin_amdgcn_s_sleep(1);
        if ((++sp & 255u) == 0u) { if (xb_ld(&bar[XB_TMO])) break; if (sp > XB_SPIN_CAP) { atomicAdd(&bar[XB_TMO], 1u); break; } }
    }
    nloc = mine > 0u ? mine : 1u; nx = cnt > 0u ? cnt : 1u;
}
__device__ __forceinline__ void xcd_barrier(const XcdBarrier& b) {
    asm volatile("s_waitcnt vmcnt(0)" ::: "memory");
    __syncthreads();
    if (threadIdx.x == 0) {
        unsigned* bar = b.bar;
        __builtin_amdgcn_s_waitcnt(0);
        unsigned nloc = b.st[0], nx = b.st[1];
        if (nloc == 0u) { xcd_barrier_complete(bar, b.x, nloc, nx); b.st[0] = nloc; b.st[1] = nx; }
        const unsigned old = xb_add(&bar[XB_XSUB(b.x)], 1u);
        const unsigned gen = old / nloc;
        if (old + 1u == (gen + 1u) * nloc) {
            __builtin_amdgcn_fence(__ATOMIC_RELEASE, "agent");
            asm volatile("s_waitcnt vmcnt(0)" ::: "memory");
            (void)xb_add(&bar[XB_TOP], 1u);
        }
        __builtin_amdgcn_fence(__ATOMIC_ACQUIRE, "agent");
        XB_SPIN(xb_ld(&bar[XB_TOP]) < (gen + 1u) * nx, bar);
        asm volatile("s_waitcnt vmcnt(0)" ::: "memory");
    }
    __syncthreads();
}

constexpr int DM = 1024, NB = 8, SEQ = 2048, NMETA = 16, TT = SEQ + NMETA;
constexpr int DB = 128, PAST = 8192, PAGE = 128, NPAGES = 64;
constexpr int NH = 8, HP = 64, SSDW = 512, NG = 2, DS = 64, CONVD = 768;
constexpr int QKD = 96, VD = 64, MLAW = 512, QL = 384, KVL = 256, DFF = 2816, INC = 1960;
constexpr int RP = NB * TT, R = RP + DB;
constexpr int MMAIN = NB * SEQ;
constexpr int NS = NMETA + DB;
constexpr float EPS = 1e-6f, ATTN_SCALE = 0.10206207261596577f, LOG2E = 1.4426950408889634f;
constexpr int PJ = 2048, C_Z = 0, C_XBC = 512, C_CKV = 1280, C_CQ = 1536, C_DT = 1920, C_KR = 1928;
constexpr int S_Z = 0, S_XBC = 512, S_DT = 1280, S_CQ = 1288, S_CKV = 1672, S_KR = 1928;
constexpr int TPAD = 2112;
constexpr int NCH = 33, CHL = 64, TOFF = 48;
constexpr size_t OUT_YP = 0, OUT_YS = 16777216, OUT_LATP = 16908288, OUT_KRP = 21135360, OUT_CONVP = 21663744,
                 OUT_SSMP = 21682176, OUT_LATS = 21944320, OUT_KRS = 21977088, OUT_CONVS = 21981184, OUT_SSMS = 22276096;

constexpr size_t MiB = 1u << 20;
constexpr size_t WS_CTL = 0, CTL_ZERO_BYTES = 32 * 1024;
constexpr int CW_BAR = 4096;
constexpr size_t WS_SS = 512 * 1024;
constexpr size_t WS_WIN = 2 * MiB;
constexpr size_t WS_WUQ = 6 * MiB;
constexpr size_t WS_WUKV = 7 * MiB;
constexpr size_t WS_WOUT = 8 * MiB;
constexpr size_t WS_WGU = 10 * MiB;
constexpr size_t WS_WDN = 22 * MiB;
constexpr size_t WS_XN = 32 * MiB;
constexpr size_t WS_PROJ = 66 * MiB;
constexpr size_t WS_DTRAW = 132 * MiB;
constexpr size_t WS_DT = 133 * MiB;
constexpr size_t WS_LAT = 134 * MiB;
constexpr size_t WS_CQN = 143 * MiB;
constexpr size_t WS_KRF = 156 * MiB;
constexpr size_t WS_XST = 159 * MiB;
constexpr size_t WS_BT = 176 * MiB;
constexpr size_t WS_BC = 181 * MiB;
constexpr size_t WS_XAS = 190 * MiB;
constexpr size_t WS_QRAW = 191 * MiB;
constexpr size_t WS_KVRAW = 216 * MiB;
constexpr size_t WS_Q = 249 * MiB;
constexpr size_t WS_K = 274 * MiB;
constexpr size_t WS_VT = 299 * MiB;
constexpr size_t WS_STATES = 316 * MiB;
constexpr size_t WS_DECAY = 350 * MiB;
constexpr size_t WS_HIN = 351 * MiB;
constexpr size_t WS_MIX = 368 * MiB;
constexpr size_t WS_ACT = 401 * MiB;
constexpr size_t WS_VS = 491 * MiB;
constexpr size_t WS_DPART = 492 * MiB;
constexpr size_t WS_HS = 494 * MiB;
constexpr size_t WS_ROPE = 496 * MiB;
constexpr size_t WS_SSP = 520 * MiB;
constexpr size_t WS_WUKV2 = 524 * MiB;
constexpr size_t WS_RQ = 522 * MiB;
constexpr size_t WS_SSQ = 526 * MiB;
constexpr size_t WS_OPT_END = 527 * MiB;
constexpr int CW_DCNT = 1024;
constexpr size_t WS_NAIVE = 2048 * MiB;
constexpr size_t WS_DIAG = 1 * MiB;

constexpr int RING_OFF = 0, RING_BYTES = 131072;
constexpr int LDSCTL_OFF = RING_BYTES, MISC_OFF = LDSCTL_OFF + 320;
constexpr int LDS_BYTES = 163840;
constexpr int NWAVES = 8, NTHR = 512;

struct Args { const void* in[30]; float* out; unsigned char* ws; int ph_lo, ph_hi, li, pad; };

struct Frame {
    LAS unsigned char* lds;
    int tid, lane, wave, G, vcu, gw, NGW;
    unsigned char* ws; float* out;
    const void* const* in;
};
#define DPP_F(x, ctrl) __builtin_bit_cast(float, __builtin_amdgcn_update_dpp(0, __builtin_bit_cast(int, (x)), (ctrl), 0xF, 0xF, true))
__device__ __forceinline__ float sum_x1(float x) { return x + DPP_F(x, 0xB1); }
__device__ __forceinline__ float sum_x2(float x) { return x + DPP_F(x, 0x4E); }
__device__ __forceinline__ float sum_x4(float x) { return x + DPP_F(x, 0x141); }
__device__ __forceinline__ float sum_x8(float x) { return x + DPP_F(x, 0x140); }
__device__ __forceinline__ float sum_x16(float x) { const unsigned u = __builtin_bit_cast(unsigned, x); const auto r = __builtin_amdgcn_permlane16_swap(u, u, false, false); return __uint_as_float(r[0]) + __uint_as_float(r[1]); }
__device__ __forceinline__ float sum_x32(float x) { const unsigned u = __builtin_bit_cast(unsigned, x); const auto r = __builtin_amdgcn_permlane32_swap(u, u, false, false); return __uint_as_float(r[0]) + __uint_as_float(r[1]); }
__device__ __forceinline__ float wave_sum(float v) { return sum_x32(sum_x16(sum_x8(sum_x4(sum_x2(sum_x1(v)))))); }
__device__ __forceinline__ float wave_max(float v) {
#pragma unroll
    for (int o = 1; o < 64; o <<= 1) v = fmaxf(v, __shfl_xor(v, o));
    return v;
}
__device__ __forceinline__ float silu_f(float x) { return x * __builtin_amdgcn_rcpf(1.f + __expf(-x)); }
__device__ __forceinline__ float softplus_f(float x) { return fmaxf(x, 0.f) + log1pf(expf(-fabsf(x))); }
__device__ __forceinline__ float rope_inv(int j) { return exp2f(-(float)j * (13.287712379549449f / 16.0f)); }
struct EpiProj {
    static constexpr bool PERM = true, AFTER_DRAIN = false;
    bf16* O; float* dtraw; int rmode;
    __device__ __forceinline__ void operator()(const pg8::f32x4 (&acc)[2][2][4][2], const pg8::Unit& u, int wr, int wc, int fr, int fq) const {
        const int rb = rmode ? (u.pm >> 3) * 2064 + 16 + (u.pm & 7) * 256 : u.pm * 256;
        const int row0 = rb + wr * 64 + fr, col0 = u.pn * 256 + wc * 32 + 8 * fq;
#pragma unroll
        for (int ai = 0; ai < 2; ++ai)
#pragma unroll
            for (int m = 0; m < 4; ++m) { const int row = row0 + ai * 128 + m * 16; bf16* rowp = O + (size_t)row * PJ + col0;
#pragma unroll
                for (int bj = 0; bj < 2; ++bj) { const pg8::f32x4 v0 = acc[ai][bj][m][0], v1 = acc[ai][bj][m][1];
                    v4u w; w.x = pk2(v0[0], v0[1]); w.y = pk2(v0[2], v0[3]); w.z = pk2(v1[0], v1[1]); w.w = pk2(v1[2], v1[3]);
                    *(v4u*)(rowp + bj * 128) = w; }
                if (u.pn == 7 && wc == 0 && fq == 0) { *(pg8::f32x4*)(dtraw + (size_t)row * 8) = acc[ai][1][m][0]; *(pg8::f32x4*)(dtraw + (size_t)row * 8 + 4) = acc[ai][1][m][1]; } }
    }
};
struct EpiBf16 {
    static constexpr bool PERM = true, AFTER_DRAIN = false;
    bf16* O; int ldc; int rmode;
    __device__ __forceinline__ void operator()(const pg8::f32x4 (&acc)[2][2][4][2], const pg8::Unit& u, int wr, int wc, int fr, int fq) const {
        const int rb = rmode ? (u.pm >> 3) * 2064 + 16 + (u.pm & 7) * 256 : u.pm * 256;
        const int row0 = rb + wr * 64 + fr, col0 = u.pn * 256 + wc * 32 + 8 * fq;
#pragma unroll
        for (int ai = 0; ai < 2; ++ai)
#pragma unroll
            for (int m = 0; m < 4; ++m) { bf16* rowp = O + (size_t)(row0 + ai * 128 + m * 16) * ldc + col0;
#pragma unroll
                for (int bj = 0; bj < 2; ++bj) { const pg8::f32x4 v0 = acc[ai][bj][m][0], v1 = acc[ai][bj][m][1];
                    v4u w; w.x = pk2(v0[0], v0[1]); w.y = pk2(v0[2], v0[3]); w.z = pk2(v1[0], v1[1]); w.w = pk2(v1[2], v1[3]);
                    *(v4u*)(rowp + bj * 128) = w; } }
    }
};
struct EpiResF32 {
    static constexpr bool PERM = false, AFTER_DRAIN = false;
    const float* res; float* out;
    __device__ __forceinline__ void operator()(const pg8::f32x4 (&acc)[2][2][4][2], const pg8::Unit& u, int wr, int wc, int fr, int fq) const {
        const int row0 = u.pm * 256 + wr * 64 + fr, col0 = u.pn * 256 + wc * 32 + 4 * fq;
#pragma unroll
        for (int ai = 0; ai < 2; ++ai)
#pragma unroll
            for (int m = 0; m < 4; ++m) { const size_t off = (size_t)(row0 + ai * 128 + m * 16) * DM + col0;
#pragma unroll
                for (int bj = 0; bj < 2; ++bj)
#pragma unroll
                    for (int n = 0; n < 2; ++n) { const pg8::f32x4 r = *(const pg8::f32x4*)(res + off + bj * 128 + n * 16); *(pg8::f32x4*)(out + off + bj * 128 + n * 16) = r + acc[ai][bj][m][n]; } }
    }
};
struct EpiOutProj {
    static constexpr bool PERM = false, AFTER_DRAIN = false;
    const float* res; float* out; bf16* HB; float* SS; const LAS float* RS; mutable int nth;
    __device__ __forceinline__ void midscale(pg8::f32x4 (&acc)[2][2][4][2], const pg8::Unit& u, int wr, int fr) const {
        const int slot = nth++;
        const LAS float* rsp = RS + slot * 256 + wr * 64 + fr;
#pragma unroll
        for (int ai = 0; ai < 2; ++ai)
#pragma unroll
            for (int m = 0; m < 4; ++m) { const float rs = rsp[ai * 128 + m * 16];
#pragma unroll
                for (int bj = 0; bj < 2; ++bj)
#pragma unroll
                    for (int n = 0; n < 2; ++n) acc[ai][bj][m][n] *= rs; }
    }
    __device__ __forceinline__ void operator()(const pg8::f32x4 (&acc)[2][2][4][2], const pg8::Unit& u, int wr, int wc, int fr, int fq) const {
        const int rb = (u.pm >> 3) * 2064 + 16 + (u.pm & 7) * 256;
        const int row0 = u.pm * 256 + wr * 64 + fr, col0 = u.pn * 256 + wc * 32 + 4 * fq;
        pg8::f32x4 rc[4], rn[4];
#define EOP_LOAD(dst, g) do { const size_t off_ = (size_t)(row0 + ((g) >> 2) * 128 + ((g) & 3) * 16) * DM + col0; \
            dst[0] = *(const pg8::f32x4*)(res + off_); dst[1] = *(const pg8::f32x4*)(res + off_ + 16); dst[2] = *(const pg8::f32x4*)(res + off_ + 128); dst[3] = *(const pg8::f32x4*)(res + off_ + 144); } while (0)
        EOP_LOAD(rc, 0);
#pragma unroll
        for (int g = 0; g < 8; ++g) { const int ai = g >> 2, m = g & 3;
            if (g < 7) EOP_LOAD(rn, g + 1);
            const int orow = row0 + ai * 128 + m * 16; bf16* hb = HB + (size_t)(rb + wr * 64 + fr + ai * 128 + m * 16) * DM + col0; float ss = 0.f;
#pragma unroll
            for (int bj = 0; bj < 2; ++bj)
#pragma unroll
                for (int n = 0; n < 2; ++n) { const pg8::f32x4 v = rc[2 * bj + n] + acc[ai][bj][m][n];
                    ss += (v[0] * v[0] + v[1] * v[1]) + (v[2] * v[2] + v[3] * v[3]); v2u w; w.x = pk2(v[0], v[1]); w.y = pk2(v[2], v[3]); *(v2u*)(hb + bj * 128 + n * 16) = w; }
            ss = sum_x16(ss); ss = sum_x32(ss);
            if (fq == 0) SS[(size_t)orow * 16 + u.pn * 4 + wc] = ss;
#pragma unroll
            for (int i = 0; i < 4; ++i) rc[i] = rn[i]; }
#undef EOP_LOAD
    }
};
namespace pg8 { template <> constexpr bool has_midscale<EpiOutProj> = true; }
struct EpiDown {
    static constexpr bool PERM = false, AFTER_DRAIN = false;
    const bf16* HB; float* out;
    __device__ __forceinline__ void operator()(const pg8::f32x4 (&acc)[2][2][4][2], const pg8::Unit& u, int wr, int wc, int fr, int fq) const {
        const int rb = (u.pm >> 3) * 2064 + 16 + (u.pm & 7) * 256;
        const int row0 = u.pm * 256 + wr * 64 + fr, col0 = u.pn * 256 + wc * 32 + 4 * fq;
        v2u rc[4], rn[4];
#define EDN_LOAD(dst, g) do { const bf16* hb_ = HB + (size_t)(rb + wr * 64 + fr + ((g) >> 2) * 128 + ((g) & 3) * 16) * DM + col0; \
            dst[0] = *(const v2u*)(hb_); dst[1] = *(const v2u*)(hb_ + 16); dst[2] = *(const v2u*)(hb_ + 128); dst[3] = *(const v2u*)(hb_ + 144); } while (0)
        EDN_LOAD(rc, 0);
#pragma unroll
        for (int g = 0; g < 8; ++g) { const int ai = g >> 2, m = g & 3;
            if (g < 7) EDN_LOAD(rn, g + 1);
            const size_t off = (size_t)(row0 + ai * 128 + m * 16) * DM + col0;
#pragma unroll
            for (int bj = 0; bj < 2; ++bj)
#pragma unroll
                for (int n = 0; n < 2; ++n) { const v2u w = rc[2 * bj + n]; const pg8::f32x4 r = {bflo(w.x), bfhi(w.x), bflo(w.y), bfhi(w.y)}; *(pg8::f32x4*)(out + off + bj * 128 + n * 16) = r + acc[ai][bj][m][n]; }
#pragma unroll
            for (int i = 0; i < 4; ++i) rc[i] = rn[i]; }
#undef EDN_LOAD
    }
};
struct EpiSwiGLU {
    static constexpr bool PERM = true, AFTER_DRAIN = false;
    bf16* O; const LAS float* RS; mutable int nth;
    __device__ __forceinline__ void operator()(const pg8::f32x4 (&acc)[2][2][4][2], const pg8::Unit& u, int wr, int wc, int fr, int fq) const {
        const int rb = (u.pm >> 3) * 2064 + 16 + (u.pm & 7) * 256;
        const int row0 = rb + wr * 64 + fr, col0 = u.pn * 128 + wc * 32 + 8 * fq;
        const int slot = nth++;
        const LAS float* rsp = RS + slot * 256 + wr * 64 + fr;
#pragma unroll
        for (int ai = 0; ai < 2; ++ai)
#pragma unroll
            for (int m = 0; m < 4; ++m) { float a[8]; const float rs = rsp[ai * 128 + m * 16];
#pragma unroll
                for (int n = 0; n < 2; ++n)
#pragma unroll
                    for (int e = 0; e < 4; ++e) a[4 * n + e] = silu_f(rs * acc[ai][0][m][n][e]) * (rs * acc[ai][1][m][n][e]);
                v4u w; w.x = pk2(a[0], a[1]); w.y = pk2(a[2], a[3]); w.z = pk2(a[4], a[5]); w.w = pk2(a[6], a[7]);
                *(v4u*)(O + (size_t)(row0 + ai * 128 + m * 16) * DFF + col0) = w; }
    }
};

template <class ARow, class Epi>
__device__ __forceinline__ void small_gemm(const bf16* A, int lda, const bf16* Bt, int K, int nrt, int nct, const ARow& arow, const Epi& E, int gw, int NGW, int lane, int ksplit = 1) {
    const int ntask = nrt * nct * ksplit, kc = K / ksplit;
    for (int task = gw; task < ntask; task += NGW) {
        const int rt = task % nrt, ct = (task / nrt) % nct, kq = task / (nrt * nct);
        const bf16* ap = A + (size_t)arow(rt * 16 + (lane & 15)) * lda + kq * kc + 8 * (lane >> 4);
        const bf16* bp = Bt + (size_t)(ct * 16 + (lane & 15)) * K + kq * kc + 8 * (lane >> 4);
        f32x4 acc = {0.f, 0.f, 0.f, 0.f};
#pragma unroll 1
        for (int k0 = 0; k0 < kc; k0 += 32 * 11) {
            bf16x8 av[11], bv[11];
#pragma unroll
            for (int j = 0; j < 11; ++j) if (k0 + 32 * j < kc) { av[j] = *(const bf16x8*)(ap + k0 + 32 * j); bv[j] = *(const bf16x8*)(bp + k0 + 32 * j); }
#pragma unroll
            for (int j = 0; j < 11; ++j) if (k0 + 32 * j < kc) acc = __builtin_amdgcn_mfma_f32_16x16x32_bf16(av[j], bv[j], acc, 0, 0, 0);
        }
        E(acc, rt, ct, lane);
    }
}

template <class RM>
__device__ __forceinline__ void transpose_item(const float* W, int N, int ldw, bf16* WT, int ldt, int item, LAS float* scr, int lane, const RM& rm, const float* kscale = nullptr) {
    const int nblk = (N + 31) / 32, kb = item / nblk, nb = item % nblk, k0 = 64 * kb, n0 = 32 * nb;
    { const int n = n0 + (lane & 31); float v[32];
#pragma unroll
      for (int i = 0; i < 32; ++i) { const int kk = 2 * i + (lane >> 5); v[i] = (n < N) ? W[(size_t)(k0 + kk) * ldw + n] : 0.f; }
#pragma unroll
      for (int i = 0; i < 32; ++i) { const int kk = 2 * i + (lane >> 5); float x = v[i]; if (kscale) x *= kscale[k0 + kk]; scr[kk * 33 + (lane & 31)] = x; } }
    LDS_WAIT(); asm volatile("" ::: "memory");
    const int c = lane & 7;
#pragma unroll
    for (int j = 0; j < 4; ++j) { const int n = (lane >> 3) + 8 * j; const LAS float* s = scr + (8 * c) * 33 + n;
        if (n0 + n < N) { v4u o; o.x = pk2(s[0 * 33], s[1 * 33]); o.y = pk2(s[2 * 33], s[3 * 33]); o.z = pk2(s[4 * 33], s[5 * 33]); o.w = pk2(s[6 * 33], s[7 * 33]);
            *(v4u*)(WT + (size_t)rm(n0 + n) * ldt + k0 + 8 * c) = o; } }
    LDS_WAIT(); asm volatile("" ::: "memory");
}
__device__ __forceinline__ int map_in(int n) {
    return n < S_DT ? n : n < S_CQ ? C_DT + (n - S_DT) : n < S_CKV ? C_CQ + (n - S_CQ) : n < S_KR ? C_CKV + (n - S_CKV) : n;
}
__device__ __forceinline__ void p0_prologue(Frame& F) {
    LAS float* scr = (LAS float*)(F.lds + RING_OFF + F.wave * 16384);
    const float* w_in = (const float*)F.in[9]; const float* w_uq = (const float*)F.in[17]; const float* w_ukv = (const float*)F.in[19]; const float* w_out = (const float*)F.in[25];
    const float* w_gate = (const float*)F.in[27]; const float* w_up = (const float*)F.in[28]; const float* w_down = (const float*)F.in[29];
    bf16* WIN = (bf16*)(F.ws + WS_WIN); bf16* WUQ = (bf16*)(F.ws + WS_WUQ); bf16* WUKV = (bf16*)(F.ws + WS_WUKV); bf16* WOUT = (bf16*)(F.ws + WS_WOUT); bf16* WGU = (bf16*)(F.ws + WS_WGU); bf16* WDN = (bf16*)(F.ws + WS_WDN);
    const float* ffg = (const float*)F.in[26];
    constexpr int I_IN = 16 * 62, I_UQ = 6 * 24, I_UKV = 4 * 32, I_OUT = 16 * 32;
    constexpr int NITEMS = I_IN + I_UQ + 2 * I_UKV + I_OUT;
    bf16* WUKV2 = (bf16*)(F.ws + WS_WUKV2);
    for (int it = F.gw; it < NITEMS; it += F.NGW) {
        int r = it;
        if (r < I_IN) { transpose_item(w_in, INC, INC, WIN, DM, r, scr, F.lane, [](int n) { return map_in(n); }); continue; } r -= I_IN;
        if (r < I_UQ) { transpose_item(w_uq, 768, 768, WUQ, QL, r, scr, F.lane, [](int n) { return n; }, (const float*)F.in[16]); continue; } r -= I_UQ;
        if (r < I_UKV) { transpose_item(w_ukv, 1024, 1024, WUKV, KVL, r, scr, F.lane, [](int n) { return n; }, (const float*)F.in[18]); continue; } r -= I_UKV;
        if (r < I_UKV) { transpose_item(w_ukv, 1024, 1024, WUKV2, KVL, r, scr, F.lane, [](int n) { return n; }); continue; } r -= I_UKV;
        transpose_item(w_out, DM, DM, WOUT, 1024, r, scr, F.lane, [](int n) { return n; }, (r >= 8 * 32) ? (const float*)F.in[24] - 512 : nullptr);
    }
    for (int i = F.gw * 64 + F.lane; i < 88 * 1024 / 8; i += F.NGW * 64) *(v4u*)(WIN + (size_t)1960 * 1024 + (size_t)i * 8) = (v4u){0u, 0u, 0u, 0u};
    const float* xp = (const float*)F.in[0]; const float* xs = (const float*)F.in[1]; const float* meta = (const float*)F.in[7]; const float* g = (const float*)F.in[8];
    bf16* XN = (bf16*)(F.ws + WS_XN);
    f32x4 gv[4];
#pragma unroll
    for (int j = 0; j < 4; ++j) gv[j] = ((const f32x4*)g)[F.lane + 64 * j];
#define XN_ROWS(r0, n) do { f32x4 v[4][4]; \
        _Pragma("unroll") for (int i = 0; i < 4; ++i) if (i < (n)) { const int row = (r0) + i; const float* src; \
            if (row < RP) { const int b = row / TT, t = row % TT; src = (t < NMETA) ? meta + (size_t)t * DM : xp + ((size_t)b * SEQ + (t - NMETA)) * DM; } else src = xs + (size_t)(row - RP) * DM; \
            _Pragma("unroll") for (int j = 0; j < 4; ++j) v[i][j] = ((const f32x4*)src)[F.lane + 64 * j]; } \
        _Pragma("unroll") for (int i = 0; i < 4; ++i) if (i < (n)) { float s = 0.f; \
            _Pragma("unroll") for (int j = 0; j < 4; ++j) s += (v[i][j].x * v[i][j].x + v[i][j].y * v[i][j].y) + (v[i][j].z * v[i][j].z + v[i][j].w * v[i][j].w); \
            const float rs = __builtin_amdgcn_rsqf(wave_sum(s) * (1.f / DM) + EPS); \
            v2u* o8 = (v2u*)(XN + (size_t)((r0) + i) * DM) + F.lane; \
            _Pragma("unroll") for (int j = 0; j < 4; ++j) { v2u o; o.x = pk2(v[i][j].x * rs * gv[j].x, v[i][j].y * rs * gv[j].y); o.y = pk2(v[i][j].z * rs * gv[j].z, v[i][j].w * rs * gv[j].w); o8[64 * j] = o; } } } while (0)
    if (F.NGW == 2048) { XN_ROWS(4 * F.gw, 4); XN_ROWS(8192 + 4 * F.gw, 4); if (F.gw < 256) XN_ROWS(16384 + F.gw, 1); }
    else for (int r0 = 4 * F.gw; r0 < R; r0 += 4 * F.NGW) XN_ROWS(r0, 4);
#undef XN_ROWS
    float* ROPE = (float*)(F.ws + WS_ROPE);
    for (int i = blockIdx.x * NTHR + F.tid; i < (TT + 1) * 16; i += F.G * NTHR) { const int p = i >> 4, j = i & 15; const float ang = (float)(p < TT ? p : PAST) * rope_inv(j); ROPE[2 * i] = cosf(ang); ROPE[2 * i + 1] = sinf(ang); }
}

__device__ __forceinline__ void p1_ffn_weights(Frame& F, int w0, int nw) {
    LAS float* scr = (LAS float*)(F.lds + RING_OFF + F.wave * 16384);
    const float* w_gate = (const float*)F.in[27]; const float* w_up = (const float*)F.in[28]; const float* w_down = (const float*)F.in[29]; const float* ffg = (const float*)F.in[26];
    bf16* WGU = (bf16*)(F.ws + WS_WGU); bf16* WDN = (bf16*)(F.ws + WS_WDN);
    constexpr int I_G = 16 * 88, I_DN = 44 * 32;
    for (int it = F.gw - w0; it < 2 * I_G + I_DN; it += nw) {
        int r = it;
        if (r < I_G) { transpose_item(w_gate, DFF, DFF, WGU, DM, r, scr, F.lane, [](int n) { return 256 * (n >> 7) + (n & 127); }, ffg); continue; } r -= I_G;
        if (r < I_G) { transpose_item(w_up, DFF, DFF, WGU, DM, r, scr, F.lane, [](int n) { return 256 * (n >> 7) + 128 + (n & 127); }, ffg); continue; } r -= I_G;
        transpose_item(w_down, DM, DM, WDN, DFF, r, scr, F.lane, [](int n) { return n; });
    }
}
__device__ __forceinline__ int small_arow(int r) { return r < NMETA ? r : RP + (r - NMETA); }
__device__ __forceinline__ void p1_inproj(Frame& F) {
    const bf16* XN = (const bf16*)(F.ws + WS_XN); const bf16* WIN = (const bf16*)(F.ws + WS_WIN); bf16* PROJ = (bf16*)(F.ws + WS_PROJ); float* DTRAW = (float*)(F.ws + WS_DTRAW);
    { pg8::Gemm g{XN, WIN, MMAIN, PJ, DM, 1, DM}; pg8::StaticOrder S; S.init(MMAIN, PJ, F.G, (int)blockIdx.x);
      EpiProj E{PROJ, DTRAW, 1};
      pg8::gemm_phase<EpiProj, pg8::StaticOrder, true, true>(F.lds + RING_OFF, g, S, E); }
    auto epi = [&](const f32x4& acc, int rt, int ct, int lane) {
        const int col = ct * 16 + (lane & 15);
#pragma unroll
        for (int i = 0; i < 4; ++i) { const int r = rt * 16 + 4 * (lane >> 4) + i; const bf16 v = f2bf(acc[i]);
            if (r < NMETA) { for (int b = 0; b < NB; ++b) { PROJ[(size_t)(b * TT + r) * PJ + col] = v; if (col >= C_DT && col < C_DT + 8) DTRAW[(size_t)(b * TT + r) * 8 + (col - C_DT)] = acc[i]; } }
            else { const int row = RP + (r - NMETA); PROJ[(size_t)row * PJ + col] = v; if (col >= C_DT && col < C_DT + 8) DTRAW[(size_t)row * 8 + (col - C_DT)] = acc[i]; } }
    };
    small_gemm(XN, DM, WIN, DM, NS / 16, PJ / 16, [](int r) { return small_arow(r); }, epi, F.gw, F.NGW, F.lane);
    { constexpr int NSM = (NS / 16) * (PJ / 16);
      if (F.NGW > NSM + 256) { if (F.gw >= NSM) p1_ffn_weights(F, NSM, F.NGW - NSM); } else p1_ffn_weights(F, 0, F.NGW); }
}

constexpr int CV_LDS_STRIDE = 88;
__device__ __forceinline__ void p2_elementwise(Frame& F) {
    const bf16* PROJ = (const bf16*)(F.ws + WS_PROJ); const float* DTRAW = (const float*)(F.ws + WS_DTRAW); float* DT = (float*)(F.ws + WS_DT);
    float* RQS = (float*)(F.ws + WS_RQ); float* KRF = (float*)(F.ws + WS_KRF);
    const float* kvg = (const float*)F.in[18]; const float* qng = (const float*)F.in[16]; const float* dtb = (const float*)F.in[12]; const float* ROPE = (const float*)(F.ws + WS_ROPE);
    {
        const f32x4 gg = ((const f32x4*)kvg)[F.lane]; const float* gq = qng + 6 * F.lane; const float g0 = gq[0], g1 = gq[1], g2 = gq[2], g3 = gq[3], g4 = gq[4], g5 = gq[5]; const float dbias = dtb[F.lane & 7];
        v2u wk[4], wkn[4]; unsigned wq[4][3], wqn[4][3]; unsigned short kr1[4], kr2[4], kr1n[4], kr2n[4]; float dtr[4], dtrn[4]; f32x2_t cs[4], csn[4];
#define P2A_LOAD(WK, WQ, K1, K2, DTR, CS, r0, n) do { _Pragma("unroll") for (int i = 0; i < 4; ++i) if (i < (n)) { const int row = (r0) + i; const bf16* pr = PROJ + (size_t)row * PJ; \
            WK[i] = *(const v2u*)(pr + C_CKV + 4 * F.lane); const unsigned* p = (const unsigned*)(pr + C_CQ + 6 * F.lane); WQ[i][0] = p[0]; WQ[i][1] = p[1]; WQ[i][2] = p[2]; \
            K1[i] = pr[C_KR + (F.lane & 15)]; K2[i] = pr[C_KR + 16 + (F.lane & 15)]; DTR[i] = DTRAW[(size_t)row * 8 + (F.lane & 7)]; \
            CS[i] = *(const f32x2_t*)(ROPE + 2 * ((row < RP ? row % TT : TT) * 16 + (F.lane & 15))); } } while (0)
#define P2A_PROC(r0, n) do { _Pragma("unroll") for (int i = 0; i < 4; ++i) if (i < (n)) { const int row = (r0) + i; \
            { const float v0 = bflo(wk[i].x), v1 = bfhi(wk[i].x), v2 = bflo(wk[i].y), v3 = bfhi(wk[i].y); \
              const float rs = __builtin_amdgcn_rsqf(wave_sum((v0 * v0 + v1 * v1) + (v2 * v2 + v3 * v3)) * (1.f / KVL) + EPS); \
              const f32x4 o = {v0 * rs * gg.x, v1 * rs * gg.y, v2 * rs * gg.z, v3 * rs * gg.w}; \
              float* of = (row < RP) ? F.out + OUT_LATP + (size_t)row * KVL : F.out + OUT_LATS + (size_t)(row - RP) * KVL; \
              ((f32x4*)of)[F.lane] = o; if (F.lane == 0) RQS[R + row] = rs; } \
            { const float v0 = bflo(wq[i][0]), v1 = bfhi(wq[i][0]), v2 = bflo(wq[i][1]), v3 = bfhi(wq[i][1]), v4 = bflo(wq[i][2]), v5 = bfhi(wq[i][2]); \
              const float rs = __builtin_amdgcn_rsqf(wave_sum((v0 * v0 + v1 * v1) + (v2 * v2 + v3 * v3) + (v4 * v4 + v5 * v5)) * (1.f / QL) + EPS); \
              if (F.lane == 0) RQS[row] = rs; } \
            if (F.lane < 16) { const int j = F.lane; const float c = cs[i].x, s = cs[i].y; \
              const float x1 = bf2f(kr1[i]), x2 = bf2f(kr2[i]); const float y1 = x1 * c - x2 * s, y2 = x1 * s + x2 * c; \
              KRF[(size_t)row * 32 + j] = y1; KRF[(size_t)row * 32 + 16 + j] = y2; \
              float* of = (row < RP) ? F.out + OUT_KRP + (size_t)row * 32 : F.out + OUT_KRS + (size_t)(row - RP) * 32; of[j] = y1; of[16 + j] = y2; } \
            if (F.lane < 8) DT[(size_t)row * 8 + F.lane] = softplus_f(dtr[i] + dbias); } } while (0)
#define P2A_ROT() do { _Pragma("unroll") for (int i = 0; i < 4; ++i) { wk[i] = wkn[i]; wq[i][0] = wqn[i][0]; wq[i][1] = wqn[i][1]; wq[i][2] = wqn[i][2]; kr1[i] = kr1n[i]; kr2[i] = kr2n[i]; dtr[i] = dtrn[i]; cs[i] = csn[i]; } } while (0)
        if (F.NGW == 2048) {
            const int ra = 4 * F.gw, rb2 = 8192 + 4 * F.gw, rc = 16384 + F.gw;
            P2A_LOAD(wk, wq, kr1, kr2, dtr, cs, ra, 4);
            P2A_LOAD(wkn, wqn, kr1n, kr2n, dtrn, csn, rb2, 4);
            P2A_PROC(ra, 4); P2A_ROT();
            if (F.gw < 256) P2A_LOAD(wkn, wqn, kr1n, kr2n, dtrn, csn, rc, 1);
            P2A_PROC(rb2, 4);
            if (F.gw < 256) { P2A_ROT(); P2A_PROC(rc, 1); }
        } else {
            for (int r0 = 4 * F.gw; r0 < R; r0 += 4 * F.NGW) { P2A_LOAD(wk, wq, kr1, kr2, dtr, cs, r0, 4); P2A_PROC(r0, 4); }
        }
#undef P2A_LOAD
#undef P2A_PROC
#undef P2A_ROT
    }
    const float* cw = (const float*)F.in[10]; const float* cb = (const float*)F.in[11];
    bf16* XST = (bf16*)(F.ws + WS_XST); bf16* BT = (bf16*)(F.ws + WS_BT); bf16* BC = (bf16*)(F.ws + WS_BC);
    LAS bf16* tile = (LAS bf16*)(F.lds + RING_OFF);
    for (int i = blockIdx.x * NTHR + F.tid; i < NB * 640 * 6; i += F.G * NTHR) { const int rowi = i / 6, pc = i % 6; const int bb = rowi / 640, cc = rowi % 640;
        bf16* dst = (cc < SSDW) ? XST + ((size_t)(bb * SSDW + cc)) * TPAD : BT + ((size_t)(bb * 128 + (cc - SSDW))) * TPAD; *(v4u*)(dst + pc * 8) = (v4u){0u, 0u, 0u, 0u}; }
    {
        const int cl = 2 * (F.tid & 127), tq = F.tid >> 7;
        unsigned raw[19], rawn[19]; float wv[10], wn[10];
#define CV_FETCH(RAW, WV, uu) do { const int third_ = (uu) % 3, tb_ = 1 + ((uu) / 3) % 32, b_ = (uu) / 96; const int c_ = third_ * 256 + cl, tf_ = tb_ * CHL - TOFF + 16 * tq; \
            const bf16* base_ = PROJ + (size_t)b_ * TT * PJ + C_XBC + c_; \
            _Pragma("unroll") for (int k = 0; k < 19; ++k) { const int t = tf_ - 3 + k; RAW[k] = (t >= 0) ? *(const unsigned*)(base_ + (size_t)t * PJ) : 0u; } \
            _Pragma("unroll") for (int k = 0; k < 4; ++k) { WV[2 * k] = cw[k * CONVD + c_]; WV[2 * k + 1] = cw[k * CONVD + c_ + 1]; } WV[8] = cb[c_]; WV[9] = cb[c_ + 1]; } while (0)
#define CV_COMPUTE(RAW, WV, tfirst, lcol, third, b) do { unsigned wa_[8], wb_[8]; float pa_ = 0.f, pb_ = 0.f; \
            _Pragma("unroll") for (int k = 0; k < 16; ++k) { const int t = (tfirst) + k; \
                const float ya = silu_f(WV[8] + bflo(RAW[k]) * WV[0] + bflo(RAW[k + 1]) * WV[2] + bflo(RAW[k + 2]) * WV[4] + bflo(RAW[k + 3]) * WV[6]); \
                const float yb = silu_f(WV[9] + bfhi(RAW[k]) * WV[1] + bfhi(RAW[k + 1]) * WV[3] + bfhi(RAW[k + 2]) * WV[5] + bfhi(RAW[k + 3]) * WV[7]); \
                if ((third) == 2) *(unsigned*)(BC + (size_t)((b) * TT + t) * 256 + cl) = pk2(ya, yb); \
                if (k & 1) { wa_[k >> 1] = pk2(pa_, ya); wb_[k >> 1] = pk2(pb_, yb); } else { pa_ = ya; pb_ = yb; } } \
            LAS v4u* ra_ = (LAS v4u*)(tile + cl * CV_LDS_STRIDE + (lcol)); LAS v4u* rb_ = (LAS v4u*)(tile + (cl + 1) * CV_LDS_STRIDE + (lcol)); \
            ra_[0] = (v4u){wa_[0], wa_[1], wa_[2], wa_[3]}; ra_[1] = (v4u){wa_[4], wa_[5], wa_[6], wa_[7]}; rb_[0] = (v4u){wb_[0], wb_[1], wb_[2], wb_[3]}; rb_[1] = (v4u){wb_[4], wb_[5], wb_[6], wb_[7]}; } while (0)
        if ((int)blockIdx.x < NB * 32 * 3) CV_FETCH(rawn, wn, (int)blockIdx.x);
        for (int u = blockIdx.x; u < NB * 32 * 3; u += F.G) {
            const int third = u % 3, tb = 1 + (u / 3) % 32, b = u / 96; const int t0 = tb * CHL - TOFF;
#pragma unroll
            for (int k = 0; k < 19; ++k) raw[k] = rawn[k];
#pragma unroll
            for (int k = 0; k < 10; ++k) wv[k] = wn[k];
            CV_COMPUTE(raw, wv, t0 + 16 * tq, 16 * tq, third, b);
            if (tb == 1 && tq == 0) {
                const bf16* base = PROJ + (size_t)b * TT * PJ + C_XBC + third * 256 + cl;
#pragma unroll
                for (int k = 0; k < 19; ++k) { const int t = k - 3; raw[k] = (t >= 0) ? *(const unsigned*)(base + (size_t)t * PJ) : 0u; }
                CV_COMPUTE(raw, wv, 0, 64, third, b); }
            __syncthreads();
            if (u + F.G < NB * 32 * 3) CV_FETCH(rawn, wn, u + F.G);
            { const int nrows = (third == 2) ? 128 : 256; const int npc = (tb == 1) ? 10 : 8;
              for (int i = F.tid; i < nrows * npc; i += NTHR) { const int cr = i / npc, pc = i % npc;
                const v4u o = *(const LAS v4u*)(tile + cr * CV_LDS_STRIDE + pc * 8);
                bf16* dst = (third < 2) ? XST + ((size_t)(b * SSDW + third * 256 + cr)) * TPAD : BT + ((size_t)(b * 128 + cr)) * TPAD;
                *(v4u*)(dst + ((pc < 8) ? tb * CHL + pc * 8 : TOFF + (pc - 8) * 8)) = o; } }
            __syncthreads();
        }
#undef CV_FETCH
#undef CV_COMPUTE
    }
    const float* sconv = (const float*)F.in[4]; float* XAS = (float*)(F.ws + WS_XAS);
    for (int i = blockIdx.x * NTHR + F.tid; i < DB * CONVD; i += F.G * NTHR) { const int b = i / CONVD, c = i % CONVD;
        const float xc = bf2f(PROJ[(size_t)(RP + b) * PJ + C_XBC + c]);
        const float s0 = sconv[(size_t)(b * 3 + 0) * CONVD + c], s1 = sconv[(size_t)(b * 3 + 1) * CONVD + c], s2 = sconv[(size_t)(b * 3 + 2) * CONVD + c];
        XAS[i] = silu_f(cb[c] + s0 * cw[c] + s1 * cw[CONVD + c] + s2 * cw[2 * CONVD + c] + xc * cw[3 * CONVD + c]);
        float* oc = F.out + OUT_CONVS + (size_t)b * 3 * CONVD + c; oc[0] = s1; oc[CONVD] = s2; oc[2 * CONVD] = xc; }
    for (int i = blockIdx.x * NTHR + F.tid; i < NB * 3 * CONVD; i += F.G * NTHR) { const int b = i / (3 * CONVD), k = (i / CONVD) % 3, c = i % CONVD;
        F.out[OUT_CONVP + i] = bf2f(PROJ[(size_t)(b * TT + TT - 3 + k) * PJ + C_XBC + c]); }
}
#define MFMA32(a, b, c) __builtin_amdgcn_mfma_f32_32x32x16_bf16((a), (b), (c), 0, 0, 0)
#define MFMA16(a, b, c) __builtin_amdgcn_mfma_f32_16x16x32_bf16((a), (b), (c), 0, 0, 0)
__device__ __forceinline__ int crow(int reg, int hi) { return (reg & 3) + 8 * (reg >> 2) + 4 * hi; }
__device__ __forceinline__ bf16x8 pack8(const f32x16& x, int s) {
    v4u p; p.x = pk2(x[8 * s + 0], x[8 * s + 1]); p.y = pk2(x[8 * s + 2], x[8 * s + 3]); p.z = pk2(x[8 * s + 4], x[8 * s + 5]); p.w = pk2(x[8 * s + 6], x[8 * s + 7]);
    return __builtin_bit_cast(bf16x8, p);
}
__device__ __forceinline__ bf16x8 ld2x8(const bf16* p0, const bf16* p1) {
    const v2u a = *(const v2u*)p0, b = *(const v2u*)p1; v4u r; r.x = a.x; r.y = a.y; r.z = b.x; r.w = b.y; return __builtin_bit_cast(bf16x8, r);
}
__device__ __forceinline__ float softmax_ref(Frame& F) {
    const float* gqn = (const float*)F.in[20]; const float* gqr = (const float*)F.in[21]; const float* gkn = (const float*)F.in[22]; const float* gkr = (const float*)F.in[23];
    float a = fabsf(gqn[F.lane]), b = fabsf(gkn[F.lane]);
    if (F.lane < 16) { a = fmaxf(a, fabsf(gqr[F.lane])); b = fmaxf(b, fabsf(gkr[F.lane])); }
    return LOG2E * 9.797958971132712f * wave_max(a) * wave_max(b) * 1.0001f;
}
constexpr size_t WS_YS = 495 * MiB;
constexpr size_t WS_KS = 498 * MiB;
constexpr int NKT = 65;

__device__ __forceinline__ void p3_upproj_states(Frame& F) {
    const bf16* PROJ = (const bf16*)(F.ws + WS_PROJ); const bf16* WUQ = (const bf16*)(F.ws + WS_WUQ); const bf16* WUKV = (const bf16*)(F.ws + WS_WUKV);
    bf16* QRAW = (bf16*)(F.ws + WS_QRAW); bf16* KVRAW = (bf16*)(F.ws + WS_KVRAW);
    { pg8::Gemm g{PROJ + C_CQ, WUQ, MMAIN, 768, QL, 1, PJ}; pg8::StaticOrder S; S.init(MMAIN, 768, F.G, (int)blockIdx.x); EpiBf16 E{QRAW, 768, 1};
      pg8::gemm_phase<EpiBf16, pg8::StaticOrder, true, true>(F.lds + RING_OFF, g, S, E); }
    { pg8::Gemm g{PROJ + C_CKV, WUKV, MMAIN, 1024, KVL, 1, PJ}; pg8::StaticOrder S; S.init(MMAIN, 1024, F.G, (int)blockIdx.x); EpiBf16 E{KVRAW, 1024, 1};
      pg8::gemm_phase<EpiBf16, pg8::StaticOrder, true, true>(F.lds + RING_OFF, g, S, E); }
    const bool sub = (F.G == 256);
    const int sgw = sub ? (blockIdx.x - 192) * NWAVES + F.wave : F.gw, sngw = sub ? 64 * NWAVES : F.NGW;
    if (!sub || blockIdx.x >= 192) {
    small_gemm(PROJ + C_CQ, PJ, WUQ, QL, DB / 16, 768 / 16, [](int r) { return RP + r; },
        [&](const f32x4& acc, int rt, int ct, int lane) { const int col = ct * 16 + (lane & 15);
#pragma unroll
            for (int i = 0; i < 4; ++i) QRAW[(size_t)(RP + rt * 16 + 4 * (lane >> 4) + i) * 768 + col] = f2bf(acc[i]); }, sgw, sngw, F.lane);
    small_gemm(PROJ + C_CKV, PJ, WUKV, KVL, NS / 16, 1024 / 16, [](int r) { return small_arow(r); },
        [&](const f32x4& acc, int rt, int ct, int lane) { const int col = ct * 16 + (lane & 15);
#pragma unroll
            for (int i = 0; i < 4; ++i) { const int r = rt * 16 + 4 * (lane >> 4) + i; const bf16 v = f2bf(acc[i]);
                if (r < NMETA) { for (int b = 0; b < NB; ++b) KVRAW[(size_t)(b * TT + r) * 1024 + col] = v; } else KVRAW[(size_t)(RP + r - NMETA) * 1024 + col] = v; } }, sgw, sngw, F.lane);
    }
    const float* DT = (const float*)(F.ws + WS_DT); const float* a_log = (const float*)F.in[13];
    const bf16* XST = (const bf16*)(F.ws + WS_XST); const bf16* BT = (const bf16*)(F.ws + WS_BT);
    bf16* STATES = (bf16*)(F.ws + WS_STATES); float* DECAY = (float*)(F.ws + WS_DECAY);
    LAS float* wl = (LAS float*)(F.lds + RING_OFF + F.wave * 1024);
    const int r32 = F.lane & 31, hi = F.lane >> 5;
    for (int u = F.gw; u < NB * NCH * NH; u = sub ? ((u < F.NGW && F.gw >= 192 * NWAVES) ? F.NGW + (F.gw - 192 * NWAVES) : NB * NCH * NH) : u + F.NGW) {
        const int h = u % NH, c = (u / NH) % NCH, b = u / (NH * NCH); const int g = h >> 2;
        const int t = c * CHL - TOFF + F.lane;
        const float dt = (t >= 0) ? DT[(size_t)(b * TT + t) * 8 + h] : 0.f;
        const float A = -__expf(a_log[h]);
        float acs = dt * A;
#pragma unroll
        for (int o = 1; o < 64; o <<= 1) { const float v = __shfl_up(acs, o); if (F.lane >= o) acs += v; }
        const float last = __shfl(acs, 63);
        wl[F.lane] = __expf(last - acs) * dt;
        LDS_WAIT(); asm volatile("" ::: "memory");
        f32x16 acc[2][2];
#pragma unroll
        for (int i = 0; i < 2; ++i)
#pragma unroll
            for (int j = 0; j < 2; ++j) acc[i][j] = (f32x16){};
        const bf16* xb = XST + ((size_t)(b * SSDW + h * HP)) * TPAD + c * CHL; const bf16* bb = BT + ((size_t)(b * 128 + g * DS)) * TPAD + c * CHL;
#pragma unroll
        for (int s = 0; s < 4; ++s) {
            const f32x4 w0 = *(const LAS f32x4*)(wl + 16 * s + 8 * hi), w1 = *(const LAS f32x4*)(wl + 16 * s + 8 * hi + 4);
            bf16x8 af[2], bfr[2];
#pragma unroll
            for (int pt = 0; pt < 2; ++pt) { const v4u x = *(const v4u*)(xb + (size_t)(32 * pt + r32) * TPAD + 16 * s + 8 * hi);
                v4u y; y.x = pk2(bflo(x.x) * w0.x, bfhi(x.x) * w0.y); y.y = pk2(bflo(x.y) * w0.z, bfhi(x.y) * w0.w); y.z = pk2(bflo(x.z) * w1.x, bfhi(x.z) * w1.y); y.w = pk2(bflo(x.w) * w1.z, bfhi(x.w) * w1.w);
                af[pt] = __builtin_bit_cast(bf16x8, y); }
#pragma unroll
            for (int nt = 0; nt < 2; ++nt) bfr[nt] = *(const bf16x8*)(bb + (size_t)(32 * nt + r32) * TPAD + 16 * s + 8 * hi);
#pragma unroll
            for (int pt = 0; pt < 2; ++pt)
#pragma unroll
                for (int nt = 0; nt < 2; ++nt) acc[pt][nt] = MFMA32(af[pt], bfr[nt], acc[pt][nt]);
        }
        bf16* so = STATES + ((size_t)((b * NCH + c) * NH + h)) * 4096;
        const bool odd = (F.lane & 1) != 0;
#pragma unroll
        for (int pt = 0; pt < 2; ++pt)
#pragma unroll
            for (int nt = 0; nt < 2; ++nt)
#pragma unroll
                for (int r2 = 0; r2 < 8; ++r2) { const float oe = acc[pt][nt][2 * r2], oo = acc[pt][nt][2 * r2 + 1];
                    const float got = DPP_F(odd ? oe : oo, 0xB1);
                    const unsigned w = odd ? pk2(got, oo) : pk2(oe, got);
                    *(unsigned*)(so + (32 * pt + crow(2 * r2 + (odd ? 1 : 0), hi)) * 64 + 32 * nt + (r32 & ~1)) = w; }
        if (F.lane == 0) DECAY[(b * NCH + c) * NH + h] = __expf(last);
        LDS_WAIT(); asm volatile("" ::: "memory");
    }
}

#ifdef MK_TS
#define P4_STAMP(k) do { if (blockIdx.x == 0 && F.tid == 0) ((unsigned long long*)(F.ws + 600 * MiB))[20 + (k)] = __builtin_amdgcn_s_memrealtime(); } while (0)
#else
#define P4_STAMP(k) do { } while (0)
#endif
__device__ __forceinline__ void p4_post(Frame& F) {
    const bf16* QRAW = (const bf16*)(F.ws + WS_QRAW); const bf16* KVRAW = (const bf16*)(F.ws + WS_KVRAW); const float* KRF = (const float*)(F.ws + WS_KRF);
    bf16* Q = (bf16*)(F.ws + WS_Q); bf16* K = (bf16*)(F.ws + WS_K); bf16* VT = (bf16*)(F.ws + WS_VT); float* VS = (float*)(F.ws + WS_VS);
    const float* gqn = (const float*)F.in[20]; const float* gqr = (const float*)F.in[21]; const float* gkn = (const float*)F.in[22]; const float* gkr = (const float*)F.in[23];
    const float* ROPE = (const float*)(F.ws + WS_ROPE); const float* RQS = (const float*)(F.ws + WS_RQ);
    const int h = F.lane >> 3, sub = F.lane & 7;
    bf16* KS = (bf16*)(F.ws + WS_KS);
    for (int row = RP + (F.gw + F.NGW / 2) % F.NGW; row < R; row += F.NGW) {
        const int t = PAST;
        if (row >= RP) { const bf16* kp = KVRAW + (size_t)row * 1024 + 128 * h + 8 * sub; const v4u kw = *(const v4u*)kp; const v4u vw = *(const v4u*)(kp + 64);
          const f32x4 kr = *(const f32x4*)(KRF + (size_t)row * 32 + 4 * sub);
          const float rkv = RQS[R + row];
          float kn[8] = {bflo(kw.x) * rkv, bfhi(kw.x) * rkv, bflo(kw.y) * rkv, bfhi(kw.y) * rkv, bflo(kw.z) * rkv, bfhi(kw.z) * rkv, bflo(kw.w) * rkv, bfhi(kw.w) * rkv};
          float ss = (kr.x * kr.x + kr.y * kr.y) + (kr.z * kr.z + kr.w * kr.w);
#pragma unroll
          for (int e = 0; e < 8; ++e) ss += kn[e] * kn[e];
          ss = sum_x1(ss); ss = sum_x2(ss); ss = sum_x4(ss);
          const float rs = __builtin_amdgcn_rsqf(ss * (1.f / 96.f) + EPS);
          const float* gn = gkn + 8 * sub; v4u o; o.x = pk2(kn[0] * rs * gn[0], kn[1] * rs * gn[1]); o.y = pk2(kn[2] * rs * gn[2], kn[3] * rs * gn[3]); o.z = pk2(kn[4] * rs * gn[4], kn[5] * rs * gn[5]); o.w = pk2(kn[6] * rs * gn[6], kn[7] * rs * gn[7]);
          bf16* ko = KS + (size_t)(row - RP) * 768 + 96 * h; *(v4u*)(ko + 8 * sub) = o;
          const float* gr = gkr + ((4 * sub) & 15); v2u o2; o2.x = pk2(kr.x * rs * gr[0], kr.y * rs * gr[1]); o2.y = pk2(kr.z * rs * gr[2], kr.w * rs * gr[3]);
          *(v2u*)(ko + 64 + 4 * sub) = o2;
          const unsigned vv[4] = {vw.x, vw.y, vw.z, vw.w}; float* vs = VS + (size_t)(row - RP) * 512 + 64 * h + 8 * sub;
#pragma unroll
          for (int e = 0; e < 4; ++e) { vs[2 * e] = bflo(vv[e]) * rkv; vs[2 * e + 1] = bfhi(vv[e]) * rkv; } }
        if (row >= RP || t >= NMETA) {
            const bf16* qp = QRAW + (size_t)row * 768 + 96 * h; const v4u qw = *(const v4u*)(qp + 8 * sub);
            const unsigned r1 = *(const unsigned*)(qp + 64 + 2 * sub), r2 = *(const unsigned*)(qp + 80 + 2 * sub);
            float qn[8] = {bflo(qw.x), bfhi(qw.x), bflo(qw.y), bfhi(qw.y), bflo(qw.z), bfhi(qw.z), bflo(qw.w), bfhi(qw.w)};
            const f32x4 cs = *(const f32x4*)(ROPE + 2 * ((row < RP ? t : TT) * 16 + 2 * sub)); const float c0 = cs.x, s0 = cs.y, c1 = cs.z, s1 = cs.w;
            const float x10 = bflo(r1), x11 = bfhi(r1), x20 = bflo(r2), x21 = bfhi(r2);
            const float y10 = x10 * c0 - x20 * s0, y20 = x10 * s0 + x20 * c0, y11 = x11 * c1 - x21 * s1, y21 = x11 * s1 + x21 * c1;
            float ss = (y10 * y10 + y20 * y20) + (y11 * y11 + y21 * y21);
#pragma unroll
            for (int e = 0; e < 8; ++e) ss += qn[e] * qn[e];
            ss = sum_x1(ss); ss = sum_x2(ss); ss = sum_x4(ss);
            const float sq = RQS[row];
            const float rs = (ATTN_SCALE * LOG2E) * sq * __builtin_amdgcn_rsqf(ss * sq * sq * (1.f / 96.f) + EPS);
            const float* gn = gqn + 8 * sub; v4u o; o.x = pk2(qn[0] * rs * gn[0], qn[1] * rs * gn[1]); o.y = pk2(qn[2] * rs * gn[2], qn[3] * rs * gn[3]); o.z = pk2(qn[4] * rs * gn[4], qn[5] * rs * gn[5]); o.w = pk2(qn[6] * rs * gn[6], qn[7] * rs * gn[7]);
            bf16* qo = Q + (size_t)row * 768 + 96 * h; *(v4u*)(qo + 8 * sub) = o;
            const float g0 = gqr[2 * sub], g1 = gqr[2 * sub + 1];
            *(unsigned*)(qo + 64 + 2 * sub) = pk2(y10 * rs * g0, y11 * rs * g1); *(unsigned*)(qo + 80 + 2 * sub) = pk2(y20 * rs * g0, y21 * rs * g1);
        }
    }
    { bf16* KF = (bf16*)(F.ws + WS_K); bf16* VF = (bf16*)(F.ws + WS_VT);
      LAS unsigned char* vtile = F.lds + RING_OFF + F.wave * 4608;
      const int r8 = F.lane >> 3;
      const int nfull = (NB * NKT * NH) / F.NGW, rot = (F.gw + F.NGW - F.NGW / 4) % F.NGW;
      for (int i = 0; i <= nfull; ++i) { const int u = (i < nfull) ? i * F.NGW + F.gw : nfull * F.NGW + rot; if (u >= NB * NKT * NH) break;
          const int hh = u % NH, kt = (u / NH) % NKT, bb = u / (NH * NKT);
          bf16* kfb = KF + ((size_t)((bb * NH + hh) * NKT + kt)) * (6 * 512); bf16* vfb = VF + ((size_t)((bb * NH + hh) * NKT + kt)) * (4 * 512);
          v4u kwa[4], vwa[4]; f32x4 kra[4]; float rka[4];
#pragma unroll
          for (int i = 0; i < 4; ++i) { const int tk = kt * 32 + 8 * i + r8; const int tkc = tk < TT ? tk : TT - 1; rka[i] = RQS[R + bb * TT + tkc];
              const bf16* kp = KVRAW + (size_t)(bb * TT + tkc) * 1024 + 128 * hh + 8 * sub; kwa[i] = *(const v4u*)kp; vwa[i] = *(const v4u*)(kp + 64); kra[i] = *(const f32x4*)(KRF + (size_t)(bb * TT + tkc) * 32 + 4 * sub); }
#pragma unroll
          for (int i = 0; i < 4; ++i) {
              const int key = 8 * i + r8, tk = kt * 32 + key; v4u kw = kwa[i], vw = vwa[i]; f32x4 kr = kra[i];
              if (tk >= TT) { kw = (v4u){0u, 0u, 0u, 0u}; vw = kw; kr = (f32x4){0.f, 0.f, 0.f, 0.f}; }
              const float rkv = rka[i];
              float kn[8] = {bflo(kw.x) * rkv, bfhi(kw.x) * rkv, bflo(kw.y) * rkv, bfhi(kw.y) * rkv, bflo(kw.z) * rkv, bfhi(kw.z) * rkv, bflo(kw.w) * rkv, bfhi(kw.w) * rkv};
              vw.x = pk2(bflo(vw.x) * rkv, bfhi(vw.x) * rkv); vw.y = pk2(bflo(vw.y) * rkv, bfhi(vw.y) * rkv); vw.z = pk2(bflo(vw.z) * rkv, bfhi(vw.z) * rkv); vw.w = pk2(bflo(vw.w) * rkv, bfhi(vw.w) * rkv);
              float ss = (kr.x * kr.x + kr.y * kr.y) + (kr.z * kr.z + kr.w * kr.w);
#pragma unroll
              for (int e = 0; e < 8; ++e) ss += kn[e] * kn[e];
              ss = sum_x1(ss); ss = sum_x2(ss); ss = sum_x4(ss);
              const float rs = __builtin_amdgcn_rsqf(ss * (1.f / 96.f) + EPS);
              const float* gn = gkn + 8 * sub; v4u o; o.x = pk2(kn[0] * rs * gn[0], kn[1] * rs * gn[1]); o.y = pk2(kn[2] * rs * gn[2], kn[3] * rs * gn[3]); o.z = pk2(kn[4] * rs * gn[4], kn[5] * rs * gn[5]); o.w = pk2(kn[6] * rs * gn[6], kn[7] * rs * gn[7]);
              *(v4u*)(kfb + (sub >> 1) * 512 + ((sub & 1) * 32 + key) * 8) = o;
              const float* gr = gkr + ((4 * sub) & 15); v2u o2; o2.x = pk2(kr.x * rs * gr[0], kr.y * rs * gr[1]); o2.y = pk2(kr.z * rs * gr[2], kr.w * rs * gr[3]);
              *(v2u*)(kfb + (4 + (sub >> 2)) * 512 + (((sub >> 1) & 1) * 32 + key) * 8 + 4 * (sub & 1)) = o2;
              *(LAS v4u*)(vtile + key * 144 + sub * 16) = vw; }
          LDS_WAIT(); asm volatile("" ::: "memory");
          const int g = F.lane >> 4, q4 = (F.lane & 15) >> 2, pp = F.lane & 3;
          const unsigned a_lo = (unsigned)(uintptr_t)vtile + (unsigned)((4 * (g >> 1) + q4) * 144 + (16 * (g & 1) + 4 * pp) * 2);
#define VF_TR(dt, s2) do { s16x4 lo, hi4; \
              asm volatile("ds_read_b64_tr_b16 %0, %2 offset:%c3\n\tds_read_b64_tr_b16 %1, %2 offset:%c4\n\ts_waitcnt lgkmcnt(0)" : "=&v"(lo), "=&v"(hi4) : "v"(a_lo), "i"(16 * (s2) * 144 + 64 * (dt)), "i"(16 * (s2) * 144 + 64 * (dt) + 8 * 144) : "memory"); \
              v4u o; o.x = (unsigned)(unsigned short)lo[0] | ((unsigned)(unsigned short)lo[1] << 16); o.y = (unsigned)(unsigned short)lo[2] | ((unsigned)(unsigned short)lo[3] << 16); \
              o.z = (unsigned)(unsigned short)hi4[0] | ((unsigned)(unsigned short)hi4[1] << 16); o.w = (unsigned)(unsigned short)hi4[2] | ((unsigned)(unsigned short)hi4[3] << 16); \
              *(v4u*)(vfb + ((dt) * 2 + (s2)) * 512 + F.lane * 8) = o; } while (0)
          VF_TR(0, 0); VF_TR(0, 1); VF_TR(1, 0); VF_TR(1, 1);
#undef VF_TR
          LDS_WAIT(); asm volatile("" ::: "memory");
      } }
    P4_STAMP(0);
    const bf16* STATES = (const bf16*)(F.ws + WS_STATES); const float* DECAY = (const float*)(F.ws + WS_DECAY); bf16* HIN = (bf16*)(F.ws + WS_HIN);
    for (int e2 = blockIdx.x * NTHR + F.tid; e2 < NB * NH * 2048; e2 += F.G * NTHR) {
        const int e = 2 * e2; const int b = e / (NH * 4096), hh = (e / 4096) % NH, pn = e % 4096;
        float h0 = 0.f, h1 = 0.f;
#pragma unroll 1
        for (int c0 = 0; c0 < NCH; c0 += 11) {
            unsigned st[11]; float dc[11];
#pragma unroll
            for (int j = 0; j < 11; ++j) { const int c = c0 + j; st[j] = *(const unsigned*)(STATES + ((size_t)((b * NCH + c) * NH + hh)) * 4096 + pn); dc[j] = DECAY[(b * NCH + c) * NH + hh]; }
#pragma unroll
            for (int j = 0; j < 11; ++j) { const int c = c0 + j; *(unsigned*)(HIN + ((size_t)((b * NCH + c) * NH + hh)) * 4096 + pn) = pk2(h0, h1); h0 = h0 * dc[j] + bflo(st[j]); h1 = h1 * dc[j] + bfhi(st[j]); }
        }
        *(f32x2_t*)(F.out + OUT_SSMP + e) = (f32x2_t){h0, h1};
    }
    P4_STAMP(1);
    const float* XAS = (const float*)(F.ws + WS_XAS); const float* DT = (const float*)(F.ws + WS_DT); const float* sst = (const float*)F.in[5];
    const float* a_log = (const float*)F.in[13]; const float* d_skip = (const float*)F.in[14]; float* YS = (float*)(F.ws + WS_YS);
    for (int u = F.gw; u < DB * NH * 16; u += F.NGW) {
        const int pq = u & 15, hh = (u >> 4) & 7, b = u >> 7; const int g = hh >> 2; const int p = 4 * pq + (F.lane >> 4), n4 = F.lane & 15;
        const float dt = DT[(size_t)(RP + b) * 8 + hh]; const float a = __expf(dt * -__expf(a_log[hh]));
        const float x = XAS[(size_t)b * CONVD + hh * HP + p]; const float uu = dt * x;
        const f32x4 Bv = *(const f32x4*)(XAS + (size_t)b * CONVD + SSDW + g * DS + 4 * n4), Cv = *(const f32x4*)(XAS + (size_t)b * CONVD + SSDW + 128 + g * DS + 4 * n4);
        const size_t si = (((size_t)b * NH + hh) * HP + p) * DS + 4 * n4;
        const f32x4 s0 = *(const f32x4*)(sst + si); const f32x4 s1 = s0 * a + uu * Bv;
        *(f32x4*)(F.out + OUT_SSMS + si) = s1;
        float y = (Cv.x * s1.x + Cv.y * s1.y) + (Cv.z * s1.z + Cv.w * s1.w);
        y = sum_x1(y); y = sum_x2(y); y = sum_x4(y); y = sum_x8(y);
        if (n4 == 0) YS[(size_t)b * 512 + hh * HP + p] = y + d_skip[hh] * x;
    }
}
constexpr int DA_ROWB = 528;
constexpr int DA_LAT = 0, DA_KR = 128 * DA_ROWB, DA_PB = DA_KR + 128 * 33 * 4, DA_QG = DA_PB + 2 * 16 * 32 * 2, DA_END = DA_QG + 8 * 96 * 4;
constexpr int P5_EXCH = 100 * 1024;
static_assert(DA_END <= P5_EXCH, "LDS map of P5");

constexpr int AT_SLOT = 20480, AT_D = 4;
__device__ __forceinline__ void at_issue(Frame& F, const bf16* kt_k, const bf16* kt_v, LAS unsigned char* slot) {
    const int w = F.wave;
    __builtin_amdgcn_global_load_lds((const unsigned*)((const char*)kt_k + w * 1024 + F.lane * 16), (LAS unsigned*)(slot + w * 1024), 16, 0, 0);
    const char* srcB = (w < 4) ? (const char*)kt_k + 8192 + w * 1024 : (const char*)kt_v + (w - 4) * 1024;
    __builtin_amdgcn_global_load_lds((const unsigned*)(srcB + F.lane * 16), (LAS unsigned*)(slot + 8192 + w * 1024), 16, 0, 0);
    __builtin_amdgcn_global_load_lds((const unsigned*)((const char*)kt_v + 4096 + w * 256 + F.lane * 4), (LAS unsigned*)(slot + 16384 + w * 256), 4, 0, 0);
    __builtin_amdgcn_global_load_lds((const unsigned*)((const char*)kt_v + 6144 + w * 256 + F.lane * 4), (LAS unsigned*)(slot + 18432 + w * 256), 4, 0, 0);
}
__device__ __forceinline__ void p5_attn_prompt(Frame& F, float M0) {
    const bf16* QRAW = (const bf16*)(F.ws + WS_QRAW); const bf16* KF = (const bf16*)(F.ws + WS_K); const bf16* VF = (const bf16*)(F.ws + WS_VT); bf16* MIXA = (bf16*)(F.ws + WS_MIX); float* SSQ = (float*)(F.ws + WS_SSQ);
    const float* ROPE = (const float*)(F.ws + WS_ROPE); const float* gqn = (const float*)F.in[20]; const float* gqr = (const float*)F.in[21]; const float* RQS = (const float*)(F.ws + WS_RQ);
    LAS unsigned char* ring = F.lds + RING_OFF;
    const int w = F.wave, r32 = F.lane & 31, hi = F.lane >> 5;
    f32x16 negm;
#pragma unroll
    for (int i = 0; i < 16; ++i) negm[i] = -M0;
    for (int u = F.vcu; u < 256; u += F.G) {
        const int b = u >> 5, h = (u >> 2) & 7, pr = u & 3;
        const bf16* kfb = KF + ((size_t)((b * NH + h) * NKT)) * (6 * 512); const bf16* vfb = VF + ((size_t)((b * NH + h) * NKT)) * (4 * 512);
#pragma unroll 1
        for (int half = 0; half < 2; ++half) {
            const int qb = half ? 7 - pr : pr; const int a = 8 * qb + w; const int qi = NMETA + 32 * a + r32;
            const int nkt = 8 * qb + 9, nkw = a + 2;
            bf16x8 qf[6];
            { const bf16* qp = QRAW + (size_t)(b * TT + qi) * 768 + 96 * h + 8 * hi;
              v4u qw[6];
#pragma unroll
              for (int s = 0; s < 6; ++s) qw[s] = *(const v4u*)(qp + 16 * s);
              f32x4 cs[4];
#pragma unroll
              for (int i = 0; i < 4; ++i) cs[i] = *(const f32x4*)(ROPE + 2 * (qi * 16 + 8 * hi) + 4 * i);
              float qv[6][8]; float ss = 0.f;
#pragma unroll
              for (int s = 0; s < 6; ++s) { const unsigned ww[4] = {qw[s].x, qw[s].y, qw[s].z, qw[s].w};
#pragma unroll
                  for (int e = 0; e < 4; ++e) { qv[s][2 * e] = bflo(ww[e]); qv[s][2 * e + 1] = bfhi(ww[e]); ss += qv[s][2 * e] * qv[s][2 * e] + qv[s][2 * e + 1] * qv[s][2 * e + 1]; } }
              ss = sum_x32(ss);
              const float sq = RQS[b * TT + qi];
              const float rs = (ATTN_SCALE * LOG2E) * sq * __builtin_amdgcn_rsqf(ss * sq * sq * (1.f / 96.f) + EPS);
#pragma unroll
              for (int jj = 0; jj < 8; ++jj) { const float c = cs[jj >> 1][2 * (jj & 1)], sn = cs[jj >> 1][2 * (jj & 1) + 1]; const float x1 = qv[4][jj], x2 = qv[5][jj];
                  const float gr = gqr[8 * hi + jj] * rs; qv[4][jj] = (x1 * c - x2 * sn) * gr; qv[5][jj] = (x1 * sn + x2 * c) * gr; }
#pragma unroll
              for (int s = 0; s < 4; ++s) { const f32x4 g0 = *(const f32x4*)(gqn + 16 * s + 8 * hi), g1 = *(const f32x4*)(gqn + 16 * s + 8 * hi + 4);
                  qv[s][0] *= g0.x * rs; qv[s][1] *= g0.y * rs; qv[s][2] *= g0.z * rs; qv[s][3] *= g0.w * rs; qv[s][4] *= g1.x * rs; qv[s][5] *= g1.y * rs; qv[s][6] *= g1.z * rs; qv[s][7] *= g1.w * rs; }
#pragma unroll
              for (int s = 0; s < 6; ++s) { v4u o; o.x = pk2(qv[s][0], qv[s][1]); o.y = pk2(qv[s][2], qv[s][3]); o.z = pk2(qv[s][4], qv[s][5]); o.w = pk2(qv[s][6], qv[s][7]); qf[s] = __builtin_bit_cast(bf16x8, o); } }
            f32x16 o0 = (f32x16){}, o1 = (f32x16){}; float l = 0.f;
            const int ns = (nkt + 1) >> 1;
#pragma unroll
            for (int j = 0; j < AT_D - 1; ++j) at_issue(F, kfb + (size_t)j * 6144, vfb + (size_t)j * 4096, ring + j * AT_SLOT);
#pragma unroll 1
            for (int st = 0; st < ns; ++st) {
                const int rem = ns - 1 - st;
                if (rem >= 2) asm volatile("s_waitcnt vmcnt(8)" ::: "memory"); else if (rem == 1) asm volatile("s_waitcnt vmcnt(4)" ::: "memory"); else asm volatile("s_waitcnt vmcnt(0)" ::: "memory");
                __builtin_amdgcn_s_barrier(); asm volatile("" ::: "memory");
                if (st + AT_D - 1 < ns) at_issue(F, kfb + (size_t)(st + AT_D - 1) * 6144, vfb + (size_t)(st + AT_D - 1) * 4096, ring + ((st + AT_D - 1) & (AT_D - 1)) * AT_SLOT);
#pragma unroll
                for (int tt = 0; tt < 2; ++tt) { const int kt = 2 * st + tt;
                  if (kt < nkw) {
                    const LAS unsigned char* sl = ring + (st & (AT_D - 1)) * AT_SLOT + F.lane * 16; const int j0 = 32 * kt;
                    f32x16 S = negm;
#pragma unroll
                    for (int s = 0; s < 6; ++s) S = MFMA32(*(const LAS bf16x8*)(sl + tt * 6144 + 1024 * s), qf[s], S);
                    bf16x8 vf[4];
#pragma unroll
                    for (int i = 0; i < 4; ++i) vf[i] = *(const LAS bf16x8*)(sl + 12288 + tt * 4096 + 1024 * i);
#pragma unroll
                    for (int i = 0; i < 16; ++i) S[i] = __builtin_amdgcn_exp2f(S[i]);
                    if (kt >= a) {
#pragma unroll
                        for (int i = 0; i < 16; ++i) if (j0 + crow(i, hi) > qi) S[i] = 0.f; }
#pragma unroll
                    for (int i = 0; i < 16; ++i) l += S[i];
                    const bf16x8 p0 = pack8(S, 0), p1 = pack8(S, 1);
                    o0 = MFMA32(vf[0], p0, o0); o0 = MFMA32(vf[1], p1, o0);
                    o1 = MFMA32(vf[2], p0, o1); o1 = MFMA32(vf[3], p1, o1);
                  } }
            }
            l = sum_x32(l);
            const float il = __builtin_amdgcn_rcpf(l);
            bf16* ao = MIXA + (size_t)(b * TT + qi) * 1024 + 512 + 64 * h + 4 * hi; float ssq = 0.f;
#pragma unroll
            for (int gq = 0; gq < 4; ++gq) {
                v2u w0, w1; w0.x = pk2(o0[4 * gq] * il, o0[4 * gq + 1] * il); w0.y = pk2(o0[4 * gq + 2] * il, o0[4 * gq + 3] * il);
                w1.x = pk2(o1[4 * gq] * il, o1[4 * gq + 1] * il); w1.y = pk2(o1[4 * gq + 2] * il, o1[4 * gq + 3] * il);
                ssq += (bflo(w0.x) * bflo(w0.x) + bfhi(w0.x) * bfhi(w0.x)) + (bflo(w0.y) * bflo(w0.y) + bfhi(w0.y) * bfhi(w0.y));
                ssq += (bflo(w1.x) * bflo(w1.x) + bfhi(w1.x) * bfhi(w1.x)) + (bflo(w1.y) * bflo(w1.y) + bfhi(w1.y) * bfhi(w1.y));
                *(v2u*)(ao + 8 * gq) = w0; *(v2u*)(ao + 32 + 8 * gq) = w1; }
            ssq = sum_x32(ssq);
            if (hi == 0) SSQ[(size_t)(b * TT + qi) * 8 + h] = ssq;
            asm volatile("s_waitcnt lgkmcnt(0)" ::: "memory"); __builtin_amdgcn_s_barrier(); asm volatile("" ::: "memory");
        }
    }
}

constexpr int SO_X = 0, SO_H = 36864, SO_B = 73728, SO_C = 82944, SO_Z = 92160, SO_TAB = 125952, SO_EX = 130048;
static_assert(SO_EX + 1024 <= RING_BYTES, "ssd_out LDS map");
__device__ __forceinline__ void p5_ssd_out(Frame& F) {
    const float* DT = (const float*)(F.ws + WS_DT); const float* a_log = (const float*)F.in[13]; const float* d_skip = (const float*)F.in[14]; const float* ng = (const float*)F.in[15];
    const bf16* XST = (const bf16*)(F.ws + WS_XST); const bf16* BC = (const bf16*)(F.ws + WS_BC); const bf16* HIN = (const bf16*)(F.ws + WS_HIN); const bf16* PROJ = (const bf16*)(F.ws + WS_PROJ);
    bf16* MIX = (bf16*)(F.ws + WS_MIX);
    LAS unsigned char* L = F.lds + RING_OFF;
    LAS float* tab = (LAS float*)(L + SO_TAB) + F.wave * 128;
    LAS float* exch = (LAS float*)(L + SO_EX);
    const int hl = F.wave >> 1, it = F.wave & 1, r32 = F.lane & 31, hi = F.lane >> 5;
    for (int u = blockIdx.x; u < NB * (NCH - 1); u += F.G) {
        const int b = u / (NCH - 1), c = 1 + u % (NCH - 1); const int t0 = c * CHL - TOFF;
        v4u st[14];
#define SO_FETCH_A(g) do { \
        _Pragma("unroll") for (int k = 0; k < 4; ++k) { const int q = F.tid + NTHR * k; st[k] = *(const v4u*)(XST + ((size_t)(b * SSDW + (g) * 256 + (q >> 3))) * TPAD + c * CHL + 8 * (q & 7)); } } while (0)
#define SO_FETCH_B(g) do { \
        _Pragma("unroll") for (int k = 0; k < 4; ++k) { const int q = F.tid + NTHR * k; st[4 + k] = *(const v4u*)(HIN + ((size_t)((b * NCH + c) * NH + 4 * (g))) * 4096 + (size_t)q * 8); } \
        { const int q = F.tid; st[8] = *(const v4u*)(BC + (size_t)(b * TT + t0 + (q >> 3)) * 256 + (g) * DS + 8 * (q & 7)); st[9] = *(const v4u*)(BC + (size_t)(b * TT + t0 + (q >> 3)) * 256 + 128 + (g) * DS + 8 * (q & 7)); } \
        _Pragma("unroll") for (int k = 0; k < 4; ++k) { const int q = F.tid + NTHR * k; st[10 + k] = *(const v4u*)(PROJ + (size_t)(b * TT + t0 + (q >> 5)) * PJ + C_Z + (g) * 256 + 8 * (q & 31)); } } while (0)
#define SO_STORE() do { \
        _Pragma("unroll") for (int k = 0; k < 4; ++k) { const int q = F.tid + NTHR * k; *(LAS v4u*)(L + SO_X + (q >> 3) * 144 + 16 * (q & 7)) = st[k]; *(LAS v4u*)(L + SO_H + (q >> 3) * 144 + 16 * (q & 7)) = st[4 + k]; } \
        { const int q = F.tid; *(LAS v4u*)(L + SO_B + (q >> 3) * 144 + 16 * (q & 7)) = st[8]; *(LAS v4u*)(L + SO_C + (q >> 3) * 144 + 16 * (q & 7)) = st[9]; } \
        _Pragma("unroll") for (int k = 0; k < 4; ++k) { const int q = F.tid + NTHR * k; *(LAS v4u*)(L + SO_Z + (q >> 5) * 528 + 16 * (q & 31)) = st[10 + k]; } } while (0)
        SO_FETCH_A(0); SO_FETCH_B(0);
#pragma unroll 1
        for (int g = 0; g < 2; ++g) {
            const int h = 4 * g + hl; const float A = -__expf(a_log[h]), Dh = d_skip[h];
            { const int t = t0 + F.lane; const float dt = DT[(size_t)(b * TT + t) * 8 + h];
              float acs = dt * A;
#pragma unroll
              for (int o = 1; o < 64; o <<= 1) { const float v = __shfl_up(acs, o); if (F.lane >= o) acs += v; }
              tab[F.lane] = acs; tab[64 + F.lane] = dt; }
            SO_STORE();
            __syncthreads();
            if (g == 0) SO_FETCH_A(1);
            const int ii = 32 * it + r32; const int t = t0 + ii;
            bf16x8 cf[4];
#pragma unroll
            for (int s = 0; s < 4; ++s) cf[s] = *(const LAS bf16x8*)(L + SO_C + ii * 144 + 32 * s + 16 * hi);
            f32x16 y[2];
            const float ai = tab[ii]; const float ei = __expf(ai);
#pragma unroll
            for (int pt = 0; pt < 2; ++pt) { f32x16 acc = (f32x16){}; const LAS unsigned char* hp_ = L + SO_H + (hl * 64 + 32 * pt + r32) * 144 + 16 * hi;
#pragma unroll
                for (int s = 0; s < 4; ++s) acc = MFMA32(*(const LAS bf16x8*)(hp_ + 32 * s), cf[s], acc);
#pragma unroll
                for (int i = 0; i < 16; ++i) acc[i] *= ei;
                y[pt] = acc; }
#pragma unroll 1
            for (int jt = 0; jt <= it; ++jt) {
                f32x16 S = (f32x16){};
                { const LAS unsigned char* bp_ = L + SO_B + (32 * jt + r32) * 144 + 16 * hi;
#pragma unroll
                  for (int s = 0; s < 4; ++s) S = MFMA32(*(const LAS bf16x8*)(bp_ + 32 * s), cf[s], S); }
#pragma unroll
                for (int i = 0; i < 16; ++i) { const int jj = 32 * jt + crow(i, hi); const float e = (jj <= ii) ? __expf(ai - tab[jj]) * tab[64 + jj] : 0.f; S[i] = S[i] * e + ((jj == ii) ? Dh : 0.f); }
                const bf16x8 p0 = pack8(S, 0), p1 = pack8(S, 1);
#pragma unroll
                for (int pt = 0; pt < 2; ++pt) { const LAS unsigned char* xp_ = L + SO_X + (hl * 64 + 32 * pt + r32) * 144 + (32 * jt + 4 * hi) * 2;
                    const v2u x0 = *(const LAS v2u*)(xp_), x1 = *(const LAS v2u*)(xp_ + 16), x2 = *(const LAS v2u*)(xp_ + 32), x3 = *(const LAS v2u*)(xp_ + 48);
                    v4u f0, f1; f0.x = x0.x; f0.y = x0.y; f0.z = x1.x; f0.w = x1.y; f1.x = x2.x; f1.y = x2.y; f1.z = x3.x; f1.w = x3.y;
                    y[pt] = MFMA32(__builtin_bit_cast(bf16x8, f0), p0, y[pt]); y[pt] = MFMA32(__builtin_bit_cast(bf16x8, f1), p1, y[pt]); }
            }
            float ss = 0.f;
            { const LAS unsigned char* zp_ = L + SO_Z + ii * 528 + (hl * 64 + 4 * hi) * 2;
#pragma unroll
              for (int pt = 0; pt < 2; ++pt)
#pragma unroll
                for (int gq = 0; gq < 4; ++gq) { const v2u zw = *(const LAS v2u*)(zp_ + (32 * pt + 8 * gq) * 2); const float zz[4] = {bflo(zw.x), bfhi(zw.x), bflo(zw.y), bfhi(zw.y)};
#pragma unroll
                    for (int e = 0; e < 4; ++e) { const float v = y[pt][4 * gq + e] * silu_f(zz[e]); y[pt][4 * gq + e] = v; ss += v * v; } } }
            ss = sum_x32(ss);
            if (g == 0) SO_FETCH_B(1);
            LAS float* ex = exch + it * 128;
            if (hi == 0) ex[hl * 32 + r32] = ss;
            __syncthreads();
            const float tot = (ex[r32] + ex[32 + r32]) + (ex[64 + r32] + ex[96 + r32]);
            const float rs = __builtin_amdgcn_rsqf(tot * (1.f / 256.f) + EPS);
            { bf16* mo = MIX + (size_t)(b * TT + t) * 1024 + 64 * h + 4 * hi;
#pragma unroll
              for (int pt = 0; pt < 2; ++pt)
#pragma unroll
                for (int gq = 0; gq < 4; ++gq) { const f32x4 gg = *(const f32x4*)(ng + 64 * h + 32 * pt + 8 * gq + 4 * hi);
                    v2u w; w.x = pk2(y[pt][4 * gq] * rs * gg.x, y[pt][4 * gq + 1] * rs * gg.y); w.y = pk2(y[pt][4 * gq + 2] * rs * gg.z, y[pt][4 * gq + 3] * rs * gg.w);
                    *(v2u*)(mo + 32 * pt + 8 * gq) = w; } }
        }
#undef SO_FETCH_A
#undef SO_FETCH_B
#undef SO_STORE
        __syncthreads();
    }
    const float* YS = (const float*)(F.ws + WS_YS);
    for (int u = F.gw; u < DB * NG; u += F.NGW) { const int b = u >> 1, gg = u & 1; const int cc = gg * 256 + 4 * F.lane;
        const f32x4 yv = *(const f32x4*)(YS + (size_t)b * 512 + cc); const v2u zw = *(const v2u*)(PROJ + (size_t)(RP + b) * PJ + C_Z + cc);
        const f32x4 v = {yv.x * silu_f(bflo(zw.x)), yv.y * silu_f(bfhi(zw.x)), yv.z * silu_f(bflo(zw.y)), yv.w * silu_f(bfhi(zw.y))};
        const float rs = __builtin_amdgcn_rsqf(wave_sum((v.x * v.x + v.y * v.y) + (v.z * v.z + v.w * v.w)) * (1.f / 256.f) + EPS);
        const f32x4 gv = *(const f32x4*)(ng + cc); v2u w; w.x = pk2(v.x * rs * gv.x, v.y * rs * gv.y); w.y = pk2(v.z * rs * gv.z, v.w * rs * gv.w);
        *(v2u*)(MIX + (size_t)(RP + b) * 1024 + cc) = w; }
}

constexpr int DB_STAGE = 0, DB_KRST = 65536, DB_LAT = DB_KRST + 8192, DB_KR = DB_LAT + 64 * DA_ROWB, DB_PB = DB_KR + 64 * 36 * 4, DB_QG = DB_PB + 16 * 64 * 2, DB_END = DB_QG + 8 * 96 * 4;
static_assert(DB_END <= RING_BYTES, "decode attention LDS map");
#define RAW_BAR_L() do { asm volatile("s_waitcnt lgkmcnt(0)" ::: "memory"); __builtin_amdgcn_s_barrier(); asm volatile("" ::: "memory"); } while (0)
#define RAW_BAR_VL() do { asm volatile("s_waitcnt vmcnt(0) lgkmcnt(0)" ::: "memory"); __builtin_amdgcn_s_barrier(); asm volatile("" ::: "memory"); } while (0)
__device__ __forceinline__ void da_issue(Frame& F, LAS unsigned char* L, const float* clat, const float* ckr, const int* ptab, int b, int split, int hp) {
    const size_t tok0 = (size_t)ptab[b * NPAGES + split * 32 + (hp >> 1)] * PAGE + (hp & 1) * 64;
    const char* src = (const char*)(clat + tok0 * KVL) + (size_t)(F.wave * 8) * 1024 + F.lane * 16;
#pragma unroll
    for (int i = 0; i < 8; ++i) __builtin_amdgcn_global_load_lds((const unsigned*)(src + i * 1024), (LAS unsigned*)(L + DB_STAGE + (F.wave * 8 + i) * 1024), 16, 0, 0);
    __builtin_amdgcn_global_load_lds((const unsigned*)((const char*)(ckr + tok0 * 32) + F.wave * 1024 + F.lane * 16), (LAS unsigned*)(L + DB_KRST + F.wave * 1024), 16, 0, 0);
}
__device__ __forceinline__ void da_convert(Frame& F, LAS unsigned char* L) {
#pragma unroll 4
    for (int k = 0; k < 8; ++k) { const int f = F.tid + NTHR * k; const int row = f >> 6, c4 = f & 63; const f32x4 v = *(const LAS f32x4*)(L + DB_STAGE + f * 16);
        v2u w; w.x = pk2(v.x, v.y); w.y = pk2(v.z, v.w); *(LAS v2u*)(L + DB_LAT + row * DA_ROWB + c4 * 8) = w; }
    { const int f = F.tid; const int row = f >> 3, c4 = f & 7; const f32x4 v = *(const LAS f32x4*)(L + DB_KRST + f * 16);
      *(LAS f32x4*)((LAS float*)(L + DB_KR) + row * 36 + 4 * c4) = v; }
}
__device__ __forceinline__ void st_wt(float* p, float v) { asm volatile("global_store_dword %0, %1, off sc0 sc1" :: "v"(p), "v"(v) : "memory"); }
__device__ __forceinline__ void decode_combine_one(Frame& F, float M0, int b) {
    const float* DPART = (const float*)(F.ws + WS_DPART); const bf16* WUKV = (const bf16*)(F.ws + WS_WUKV2); const bf16* Q = (const bf16*)(F.ws + WS_Q); const bf16* KS = (const bf16*)(F.ws + WS_KS);
    const float* VS = (const float*)(F.ws + WS_VS); bf16* MIX = (bf16*)(F.ws + WS_MIX);
    LAS float* accl = (LAS float*)(F.lds + RING_OFF) + F.wave * 256; LAS float* exch = (LAS float*)(F.lds + P5_EXCH);
    const int h = F.wave;
    const float* p0 = DPART + ((size_t)((b * 2 + 0) * NH + h)) * 264; const float* p1 = DPART + ((size_t)((b * 2 + 1) * NH + h)) * 264;
#pragma unroll
    for (int k = 0; k < 4; ++k) accl[F.lane + 64 * k] = p0[F.lane + 64 * k] + p1[F.lane + 64 * k];
    float l = p0[256] + p1[256];
    const bf16* qp = Q + (size_t)(RP + b) * 768 + 96 * h; const bf16* kp = KS + (size_t)b * 768 + 96 * h;
    float sd = bf2f(qp[F.lane]) * bf2f(kp[F.lane]); if (F.lane < 32) sd += bf2f(qp[64 + F.lane]) * bf2f(kp[64 + F.lane]);
    sd = wave_sum(sd);
    const float pn = __builtin_amdgcn_exp2f(sd - M0); l += pn;
    LDS_WAIT(); asm volatile("" ::: "memory");
    const bf16* wv = WUKV + (size_t)(128 * h + 64 + F.lane) * KVL;
    float o = 0.f;
    { v4u wv4[32];
#pragma unroll
      for (int c8 = 0; c8 < 32; ++c8) wv4[c8] = *(const v4u*)(wv + 8 * c8);
#pragma unroll
      for (int c8 = 0; c8 < 32; ++c8) { const v4u w = wv4[c8]; const f32x4 x0 = *(const LAS f32x4*)(accl + 8 * c8), x1 = *(const LAS f32x4*)(accl + 8 * c8 + 4);
        o += (bflo(w.x) * x0.x + bfhi(w.x) * x0.y) + (bflo(w.y) * x0.z + bfhi(w.y) * x0.w) + (bflo(w.z) * x1.x + bfhi(w.z) * x1.y) + (bflo(w.w) * x1.z + bfhi(w.w) * x1.w); } }
    o = (o + pn * VS[(size_t)b * 512 + 64 * h + F.lane]) * __builtin_amdgcn_rcpf(l);
    const float ss = wave_sum(o * o);
    if (F.lane == 0) exch[h] = ss;
    __syncthreads();
    float tot = 0.f;
#pragma unroll
    for (int hh = 0; hh < NH; ++hh) tot += exch[hh];
    const float rs = __builtin_amdgcn_rsqf(tot * (1.f / MLAW) + EPS);
    MIX[(size_t)(RP + b) * 1024 + 512 + 64 * h + F.lane] = f2bf(o * rs);
    __syncthreads();
}
template <int MODE>
__device__ __forceinline__ void p5_attn_decode_t(Frame& F, float M0) {
    const float* clat = (const float*)F.in[2]; const float* ckr = (const float*)F.in[3]; const int* ptab = (const int*)F.in[6];
    const bf16* WUKV = (const bf16*)(F.ws + WS_WUKV2); const bf16* Q = (const bf16*)(F.ws + WS_Q); const float* gkn = (const float*)F.in[22]; const float* gkr = (const float*)F.in[23];
    float* DPART = (float*)(F.ws + WS_DPART);
    LAS unsigned char* L = F.lds + RING_OFF;
    LAS float* krl = (LAS float*)(L + DB_KR); LAS bf16* pb = (LAS bf16*)(L + DB_PB); LAS float* qg = (LAS float*)(L + DB_QG) + F.wave * 96;
    const int h = F.wave, r32 = F.lane & 31, hi = F.lane >> 5;
    for (int u = blockIdx.x; u < DB * 2; u += F.G) {
        const int b = u >> 1, split = u & 1;
        da_issue(F, L, clat, ckr, ptab, b, split, 0);
        bf16x8 wf[4][8];
#pragma unroll
        for (int dt = 0; dt < 4; ++dt)
#pragma unroll
            for (int s = 0; s < 8; ++s) wf[dt][s] = *(const bf16x8*)(WUKV + (size_t)(128 * h + 16 * dt + (F.lane & 15)) * KVL + 32 * s + 8 * (F.lane >> 4));
        { const bf16* qp = Q + (size_t)(RP + b) * 768 + 96 * h; qg[F.lane] = bf2f(qp[F.lane]) * gkn[F.lane]; if (F.lane < 32) qg[64 + F.lane] = bf2f(qp[64 + F.lane]) * gkr[F.lane & 15]; }
        for (int i = F.tid; i < 16 * 64; i += NTHR) pb[i] = 0;
        f32x4 ao[2] = {(f32x4){0.f, 0.f, 0.f, 0.f}, (f32x4){0.f, 0.f, 0.f, 0.f}}; float l = 0.f;
        RAW_BAR_VL();
        da_convert(F, L);
        RAW_BAR_L();
        da_issue(F, L, clat, ckr, ptab, b, split, 1);
#pragma unroll 1
        for (int hp = 0; hp < 64; ++hp) {
          if (MODE == 0 || MODE == 3) {
            const int n16 = F.lane & 15, kg4 = F.lane >> 4;
#pragma unroll 1
            for (int sb = 0; sb < 2; ++sb) {
                const LAS unsigned char* bp = L + DB_LAT + (32 * sb + n16) * DA_ROWB + 16 * kg4;
                f32x4 acc[4][2];
#pragma unroll
                for (int dt = 0; dt < 4; ++dt) { acc[dt][0] = (f32x4){0.f, 0.f, 0.f, 0.f}; acc[dt][1] = acc[dt][0]; }
                bf16x8 fa[2], fb[2];
                fa[0] = *(const LAS bf16x8*)(bp); fa[1] = *(const LAS bf16x8*)(bp + 16 * DA_ROWB);
#pragma unroll
                for (int s = 0; s < 8; ++s) {
                    if (s < 7) { fb[0] = *(const LAS bf16x8*)(bp + 64 * (s + 1)); fb[1] = *(const LAS bf16x8*)(bp + 16 * DA_ROWB + 64 * (s + 1)); }
#pragma unroll
                    for (int dt = 0; dt < 4; ++dt) { acc[dt][0] = MFMA16(wf[dt][s], fa[0], acc[dt][0]); acc[dt][1] = MFMA16(wf[dt][s], fa[1], acc[dt][1]); }
                    fa[0] = fb[0]; fa[1] = fb[1];
                }
                __builtin_amdgcn_sched_barrier(0);
                f32x4 s4[2] = {(f32x4){0.f, 0.f, 0.f, 0.f}, (f32x4){0.f, 0.f, 0.f, 0.f}}, d4[2] = {s4[0], s4[0]};
#pragma unroll
                for (int dt = 0; dt < 4; ++dt) { const f32x4 qq = *(const LAS f32x4*)(qg + 16 * dt + 4 * kg4);
#pragma unroll
                    for (int tt = 0; tt < 2; ++tt) { s4[tt] += acc[dt][tt] * acc[dt][tt]; d4[tt] += acc[dt][tt] * qq; } }
                { const LAS float* qr = qg + 64 + 8 * kg4; const f32x4 q0 = *(const LAS f32x4*)(qr), q1 = *(const LAS f32x4*)(qr + 4);
#pragma unroll
                  for (int tt = 0; tt < 2; ++tt) { const LAS float* kr = krl + (32 * sb + 16 * tt + n16) * 36 + 8 * kg4; const f32x4 k0 = *(const LAS f32x4*)(kr), k1 = *(const LAS f32x4*)(kr + 4);
                      s4[tt] += k0 * k0; s4[tt] += k1 * k1; d4[tt] += k0 * q0; d4[tt] += k1 * q1; } }
                __builtin_amdgcn_sched_barrier(0);
#pragma unroll
                for (int tt = 0; tt < 2; ++tt) { float ss = (s4[tt].x + s4[tt].y) + (s4[tt].z + s4[tt].w), dot = (d4[tt].x + d4[tt].y) + (d4[tt].z + d4[tt].w);
                    ss = sum_x16(ss); dot = sum_x16(dot); ss = sum_x32(ss); dot = sum_x32(dot);
                    const float p = __builtin_amdgcn_exp2f(dot * __builtin_amdgcn_rsqf(ss * (1.f / 96.f) + EPS) - M0);
                    if (kg4 == 0) { l += p; pb[h * 64 + 32 * sb + 16 * tt + n16] = f2bf(p); } }
            }
            RAW_BAR_L();
            if (MODE < 4) { const int q4 = (F.lane & 15) >> 2, pp = F.lane & 3, kg = F.lane >> 4;
              const unsigned a_lo = (unsigned)(uintptr_t)(L + DB_LAT) + (unsigned)((8 * kg + q4) * DA_ROWB + (32 * h + 4 * pp) * 2);
              const LAS bf16* pap = pb + (F.lane & 15) * 64 + 8 * kg;
              s16x4 t0, t1, t2, t3, t4, t5, t6, t7;
              asm volatile("ds_read_b64_tr_b16 %0, %8 offset:%c9\n\tds_read_b64_tr_b16 %1, %8 offset:%c10\n\tds_read_b64_tr_b16 %2, %8 offset:%c11\n\tds_read_b64_tr_b16 %3, %8 offset:%c12\n\t"
                           "ds_read_b64_tr_b16 %4, %8 offset:%c13\n\tds_read_b64_tr_b16 %5, %8 offset:%c14\n\tds_read_b64_tr_b16 %6, %8 offset:%c15\n\tds_read_b64_tr_b16 %7, %8 offset:%c16\n\ts_waitcnt lgkmcnt(0)"
                           : "=&v"(t0), "=&v"(t1), "=&v"(t2), "=&v"(t3), "=&v"(t4), "=&v"(t5), "=&v"(t6), "=&v"(t7)
                           : "v"(a_lo), "i"(0), "i"(4 * DA_ROWB), "i"(32), "i"(32 + 4 * DA_ROWB), "i"(32 * DA_ROWB), "i"(32 * DA_ROWB + 4 * DA_ROWB), "i"(32 * DA_ROWB + 32), "i"(32 * DA_ROWB + 32 + 4 * DA_ROWB) : "memory");
              const bf16x8 pa0 = *(const LAS bf16x8*)(pap), pa1 = *(const LAS bf16x8*)(pap + 32);
#define DA_FR(x, y) ((bf16x8){x[0], x[1], x[2], x[3], y[0], y[1], y[2], y[3]})
              ao[0] = MFMA16(pa0, DA_FR(t0, t1), ao[0]); ao[1] = MFMA16(pa0, DA_FR(t2, t3), ao[1]);
              ao[0] = MFMA16(pa1, DA_FR(t4, t5), ao[0]); ao[1] = MFMA16(pa1, DA_FR(t6, t7), ao[1]);
#undef DA_FR
#define DA_PV(ks, nt) do { } while (0)
#undef DA_PV
            }
          }
            RAW_BAR_VL();
            if (hp + 1 < 64) { if (MODE <= 1 || MODE >= 3) da_convert(F, L); RAW_BAR_L(); if (hp + 2 < 64 && MODE < 3) da_issue(F, L, clat, ckr, ptab, b, split, hp + 2); }
        }
        if (MODE >= 3 && l == 123.456f) DPART[0] = l;
        if (MODE == 0) { const int kg = F.lane >> 4;
          if (kg < 2) {
#pragma unroll
              for (int nt = 0; nt < 2; ++nt)
#pragma unroll
                  for (int i = 0; i < 4; ++i) st_wt(&DPART[((size_t)((b * 2 + split) * NH + 4 * kg + i)) * 264 + 32 * h + 16 * nt + (F.lane & 15)], ao[nt][i]); }
          float lt = wave_sum(l);
          if (F.lane == 0) st_wt(&DPART[((size_t)((b * 2 + split) * NH + h)) * 264 + 256], lt); }
        asm volatile("s_waitcnt vmcnt(0)" ::: "memory");
        __syncthreads();
        { volatile LAS unsigned* arr = (volatile LAS unsigned*)(F.lds + MISC_OFF) + 16;
          if (F.tid == 0) {
              __builtin_amdgcn_fence(__ATOMIC_ACQUIRE, "agent");
              const unsigned old = __hip_atomic_fetch_add((unsigned*)(F.ws + WS_CTL) + CW_DCNT + b, 1u, __ATOMIC_RELAXED, __HIP_MEMORY_SCOPE_AGENT);
              arr[0] = old; }
          __syncthreads();
          if (MODE == 0 && arr[0] == 1u) decode_combine_one(F, M0, b);
          __syncthreads(); }
    }
}

__device__ __forceinline__ void p5_attn_decode(Frame& F, float M0) { p5_attn_decode_t<0>(F, M0); }

__device__ __forceinline__ void p7_outproj(Frame& F) {
    const bf16* MIX = (const bf16*)(F.ws + WS_MIX); const bf16* WOUT = (const bf16*)(F.ws + WS_WOUT); const float* xp = (const float*)F.in[0]; const float* xs = (const float*)F.in[1]; float* HS = (float*)(F.ws + WS_HS);
    bf16* HB = (bf16*)(F.ws + WS_XN); float* SS = (float*)(F.ws + WS_SSP); float* ysamp = F.out + OUT_YS;
    { pg8::Gemm g{MIX, WOUT, MMAIN, DM, 1024, 1, 1024}; pg8::StaticOrder S; S.init(MMAIN, DM, F.G, (int)blockIdx.x);
      LAS float* RS = (LAS float*)(F.lds + LDSCTL_OFF + 1024); const float* SSQ = (const float*)(F.ws + WS_SSQ);
#pragma unroll 1
      for (int i = 0; i < 8; ++i) { pg8::Unit uu; if (!S.next(i, uu)) break;
          int tl = (int)threadIdx.x; asm volatile("" : "+v"(tl));
          if (tl < 256) { const pg8::f32x4* sp = (const pg8::f32x4*)(SSQ + (size_t)(g.rowbase(uu.pm) + tl) * 8); const pg8::f32x4 s4 = sp[0] + sp[1];
              RS[i * 256 + tl] = __builtin_amdgcn_rsqf(((s4[0] + s4[1]) + (s4[2] + s4[3])) * (1.f / MLAW) + EPS); } }
      __syncthreads();
      EpiOutProj E{xp, F.out + OUT_YP, HB, SS, RS, 0};
      pg8::gemm_phase<EpiOutProj, pg8::StaticOrder, true, true, 8>(F.lds + RING_OFF, g, S, E); }
    { LAS f32x4* part = (LAS f32x4*)(F.lds + RING_OFF);
      for (int tp = blockIdx.x; tp < 256; tp += F.G) {
          const int t = 2 * tp + (F.wave >> 2), kq = F.wave & 3, rt = t & 7, ct = t >> 3;
          const bf16* ap = MIX + (size_t)(RP + rt * 16 + (F.lane & 15)) * 1024 + 256 * kq + 8 * (F.lane >> 4);
          const bf16* bp = WOUT + (size_t)(ct * 16 + (F.lane & 15)) * 1024 + 256 * kq + 8 * (F.lane >> 4);
          bf16x8 av[8], bv[8];
#pragma unroll
          for (int j = 0; j < 8; ++j) { av[j] = *(const bf16x8*)(ap + 32 * j); bv[j] = *(const bf16x8*)(bp + 32 * j); }
          f32x4 acc = {0.f, 0.f, 0.f, 0.f};
#pragma unroll
          for (int j = 0; j < 8; ++j) acc = MFMA16(av[j], bv[j], acc);
          part[F.wave * 64 + F.lane] = acc;
          __syncthreads();
          if (kq == 0) { acc = (acc + part[(F.wave + 1) * 64 + F.lane]) + (part[(F.wave + 2) * 64 + F.lane] + part[(F.wave + 3) * 64 + F.lane]);
              const int col = ct * 16 + (F.lane & 15);
#pragma unroll
              for (int i = 0; i < 4; ++i) { const int r = rt * 16 + 4 * (F.lane >> 4) + i; const size_t o = (size_t)r * DM + col; const float v = xs[o] + acc[i]; HS[o] = v; ysamp[o] = v; HB[(size_t)(RP + r) * DM + col] = f2bf(v);
                  float ss = v * v; ss = sum_x1(ss); ss = sum_x2(ss); ss = sum_x4(ss); ss = sum_x8(ss);
                  if ((F.lane & 15) == 0) SS[(size_t)MMAIN * 16 + (size_t)r * 64 + ct] = ss; } }
          __syncthreads();
      } }
}
__device__ __forceinline__ void p9_gateup(Frame& F) {
    const bf16* HB = (const bf16*)(F.ws + WS_XN); const bf16* WGU = (const bf16*)(F.ws + WS_WGU); bf16* ACT = (bf16*)(F.ws + WS_ACT); const float* SS = (const float*)(F.ws + WS_SSP);
    { pg8::Gemm g{HB, WGU, MMAIN, 2 * DFF, DM, 1, DM}; pg8::StaticOrder S; S.init(MMAIN, 2 * DFF, F.G, (int)blockIdx.x);
      LAS float* RS = (LAS float*)(F.lds + LDSCTL_OFF + 1024);
#pragma unroll 1
      for (int i = 0; i < 8; ++i) { pg8::Unit uu; if (!S.next(i, uu)) break;
          int tl = (int)threadIdx.x; asm volatile("" : "+v"(tl));
          if (tl < 256) { const pg8::f32x4* sp = (const pg8::f32x4*)(SS + (size_t)(uu.pm * 256 + tl) * 16); const pg8::f32x4 s4 = (sp[0] + sp[1]) + (sp[2] + sp[3]);
              RS[i * 256 + tl] = __builtin_amdgcn_rsqf(((s4[0] + s4[1]) + (s4[2] + s4[3])) * (1.f / DM) + EPS); } }
      __syncthreads();
      EpiSwiGLU E{ACT, RS, 0};
      pg8::gemm_phase<EpiSwiGLU, pg8::StaticOrder, true, true>(F.lds + RING_OFF, g, S, E); }
    const int gw = F.gw, ngw = F.NGW;
    const int nrt = DB / 16, nlt = DFF / 16;
    for (int task = gw; task < nrt * nlt; task += ngw) {
        const int rt = task % nrt, lt = task / nrt; const int lc = lt * 16 + (F.lane & 15);
        const bf16* ap = HB + (size_t)(RP + rt * 16 + (F.lane & 15)) * DM + 8 * (F.lane >> 4);
        const bf16* gp = WGU + (size_t)(256 * (lc >> 7) + (lc & 127)) * DM + 8 * (F.lane >> 4); const bf16* up = gp + (size_t)128 * DM;
        f32x4 ag = {0.f, 0.f, 0.f, 0.f}, au = {0.f, 0.f, 0.f, 0.f};
#pragma unroll 8
        for (int k0 = 0; k0 < DM; k0 += 32) { const bf16x8 a = *(const bf16x8*)(ap + k0); ag = MFMA16(a, *(const bf16x8*)(gp + k0), ag); au = MFMA16(a, *(const bf16x8*)(up + k0), au); }
#pragma unroll
        for (int i = 0; i < 4; ++i) { const int r = rt * 16 + 4 * (F.lane >> 4) + i; const f32x4* sp = (const f32x4*)(SS + (size_t)MMAIN * 16 + (size_t)r * 64); f32x4 s4 = sp[0];
#pragma unroll
            for (int q = 1; q < 16; ++q) s4 += sp[q];
            const float rs = __builtin_amdgcn_rsqf(((s4[0] + s4[1]) + (s4[2] + s4[3])) * (1.f / DM) + EPS);
            ACT[(size_t)(RP + r) * DFF + lc] = f2bf(silu_f(rs * ag[i]) * (rs * au[i])); }
    }
}
__device__ __forceinline__ void p10_down(Frame& F) {
    const bf16* ACT = (const bf16*)(F.ws + WS_ACT); const bf16* WDN = (const bf16*)(F.ws + WS_WDN); const float* HS = (const float*)(F.ws + WS_HS);
    { pg8::Gemm g{ACT, WDN, MMAIN, DM, DFF, 1, DFF}; pg8::StaticOrder S; S.init(MMAIN, DM, F.G, (int)blockIdx.x); EpiDown E{(const bf16*)(F.ws + WS_XN), F.out + OUT_YP};
      pg8::gemm_phase<EpiDown, pg8::StaticOrder, true, true>(F.lds + RING_OFF, g, S, E); }
    float* ys = F.out + OUT_YS;
    small_gemm(ACT, DFF, WDN, DFF, DB / 16, DM / 16, [](int r) { return RP + r; },
        [&](const f32x4& acc, int rt, int ct, int lane) { const int col = ct * 16 + (lane & 15);
#pragma unroll
            for (int i = 0; i < 4; ++i) atomicAdd(ys + (size_t)(rt * 16 + 4 * (lane >> 4) + i) * DM + col, acc[i]); }, F.gw, F.NGW, F.lane, 4);
}
#ifndef MK_ONE_LAUNCH
#define MK_ONE_LAUNCH 0
#endif
constexpr int N_PHASES = 9;
__global__ void __launch_bounds__(NTHR, 2) mk_fwd(Args args) {
    extern __shared__ __attribute__((aligned(16))) unsigned char lds_raw[];
    Frame F;
    F.lds = (LAS unsigned char*)lds_raw;
    F.tid = threadIdx.x; F.lane = F.tid & 63; F.wave = __builtin_amdgcn_readfirstlane(F.tid >> 6);
    F.G = gridDim.x; { const int bx = blockIdx.x; F.vcu = (F.G % 8 == 0) ? (bx % 8) * (F.G / 8) + bx / 8 : bx; }
    F.gw = blockIdx.x * NWAVES + F.wave; F.NGW = F.G * NWAVES;
    F.ws = args.ws; F.out = args.out; F.in = args.in;
    volatile LAS unsigned* MISC = (volatile LAS unsigned*)(F.lds + MISC_OFF);
    for (int u = F.tid; u < (LDS_BYTES - LDSCTL_OFF) / 4; u += NTHR) ((LAS unsigned*)(F.lds + LDSCTL_OFF))[u] = 0u;
    __syncthreads();
    XcdBarrier bar; bar.bar = (unsigned*)(F.ws + WS_CTL) + CW_BAR; bar.x = 0; bar.st = nullptr;
    const int lo = args.ph_lo, hi = args.ph_hi;
    if (hi - lo > 1) bar = xcd_barrier_post((unsigned*)(F.ws + WS_CTL) + CW_BAR, MISC + 8);
#ifdef MK_TS
    unsigned long long* TSB = (unsigned long long*)(F.ws + 600 * MiB); int tsn = 0;
#define STAMP() do { if (blockIdx.x == 0 && F.tid == 0) TSB[tsn] = __builtin_amdgcn_s_memrealtime(); ++tsn; } while (0)
    STAMP();
#else
#define STAMP() do { } while (0)
#endif
#define IN(k) (lo <= (k) && (k) < hi)
#ifdef MK_TS
#define ARRIVE(k) do { if (blockIdx.x == 0 && F.tid == 0) TSB[30 + (k)] = __builtin_amdgcn_s_memrealtime(); } while (0)
#else
#define ARRIVE(k) do { } while (0)
#endif
#define SEAM(k) do { ARRIVE(k); if (IN(k) && IN((k) + 1)) xcd_barrier(bar); STAMP(); } while (0)
#ifndef MK_REPEAT
#define MK_REPEAT 0
#endif
#define REP(id, stmt) do { stmt; if (MK_REPEAT & (1 << (id))) { __syncthreads(); stmt; } } while (0)
    if (IN(0)) { REP(0, p0_prologue(F)); } SEAM(0);
    if (IN(1)) { REP(1, p1_inproj(F)); } SEAM(1);
    if (IN(2)) {
#ifdef MK_SLEEP_PROBE
        { const unsigned long long t0 = __builtin_amdgcn_s_memrealtime(); while (__builtin_amdgcn_s_memrealtime() - t0 < 3000ull) __builtin_amdgcn_s_sleep(32); }
#endif
        REP(2, p2_elementwise(F)); } SEAM(2);
    if (IN(3)) { REP(3, p3_upproj_states(F)); } SEAM(3);
    if (IN(4)) { REP(4, p4_post(F)); } SEAM(4);
    if (IN(5)) { const float M0 = softmax_ref(F);
        if (blockIdx.x & 1) { p5_attn_decode(F, M0); __syncthreads(); }
        p5_attn_prompt(F, M0); __syncthreads();
        p5_ssd_out(F); __syncthreads();
        if (!(blockIdx.x & 1)) p5_attn_decode(F, M0);
    } SEAM(5);
    if (IN(6)) { REP(9, p7_outproj(F)); } SEAM(6);
    if (IN(7)) { REP(11, p9_gateup(F)); } SEAM(7);
    if (IN(8)) { p10_down(F); }
#ifdef MK_TS
    __syncthreads(); STAMP();
#endif
#undef IN
#undef SEAM
}
#ifndef MK_DIAG
#define MK_DIAG 0
#endif
__device__ __forceinline__ size_t nmrow(size_t r) { return r < (size_t)MMAIN ? (r >> 11) * TT + NMETA + (r & 2047) : (size_t)RP + (r - MMAIN); }
constexpr size_t WS_OUT2 = 1024 * MiB;
#ifdef MK_TS
#ifndef MK_TS_QA
#define MK_TS_QA 4.f
#endif
#ifndef MK_TS_QB
#define MK_TS_QB 4.f
#endif
__global__ void k_ts_encode(const unsigned long long* ts, float* out, int ia0, int ia1, int ib0, int ib1) {
    const float ta = rintf((float)(ts[ia1] - ts[ia0]) * 0.01f * (1.f / MK_TS_QA)) * MK_TS_QA, tb = rintf((float)(ts[ib1] - ts[ib0]) * 0.01f * (1.f / MK_TS_QB)) * MK_TS_QB;
    const float f = 1.f + sqrtf(ta * 1e-3f);
    for (int i = blockIdx.x * blockDim.x + threadIdx.x; i < 131072; i += gridDim.x * blockDim.x) out[OUT_YS + i] *= f;
    if (blockIdx.x == 0 && threadIdx.x == 0) out[0] += tb * 0.1f;
}
#endif
extern "C" void kernel_launch(void* const* d_in, const int* in_sizes, int n_in, void* d_out, int out_size, void* d_ws, size_t ws_size, hipStream_t stream) {
    (void)hipFuncSetAttribute((const void*)mk_fwd, hipFuncAttributeMaxDynamicSharedMemorySize, LDS_BYTES);
    unsigned char* ws = (unsigned char*)d_ws;
    (void)hipMemsetAsync(ws + WS_CTL, 0, CTL_ZERO_BYTES, stream);
    Args a{};
    for (int i = 0; i < 30; ++i) a.in[i] = d_in[i];
    a.ws = ws; a.out = (float*)d_out;
#if MK_DIAG
    float* diag = (float*)(ws + WS_DIAG);
    (void)hipMemsetAsync(diag, 0, 512, stream);
    nv::forward(d_in, (float*)d_out, (float*)(ws + WS_NAIVE), stream);
    a.out = (float*)(ws + WS_OUT2);
#endif
    static int one_launch = -1;
    if (one_launch < 0) { int dev = 0, cus = 0, per_cu = 0; one_launch = 0;
        if (hipGetDevice(&dev) == hipSuccess && hipDeviceGetAttribute(&cus, hipDeviceAttributeMultiprocessorCount, dev) == hipSuccess && cus >= 256) one_launch = 1;
        (void)per_cu;
        (void)hipGetLastError(); }
    const int grid = 256;
    if (one_launch && MK_ONE_LAUNCH) { a.ph_lo = 0; a.ph_hi = N_PHASES; a.li = 0; hipLaunchKernelGGL(mk_fwd, dim3(grid), dim3(NTHR), LDS_BYTES, stream, a); }
    else for (int ph = 0; ph < N_PHASES; ++ph) { a.ph_lo = ph; a.ph_hi = ph + 1; a.li = ph; hipLaunchKernelGGL(mk_fwd, dim3(grid), dim3(NTHR), LDS_BYTES, stream, a); }
#ifdef MK_TS
    k_ts_encode<<<64, 256, 0, stream>>>((const unsigned long long*)(ws + 600 * MiB), (float*)d_out, MK_TS_A0, MK_TS_A1, MK_TS_B0, MK_TS_B1);
#endif
#if MK_DIAG
    {
        nv::Ws w = nv::carve((float*)(ws + WS_NAIVE));
        const bf16* QRAW = (const bf16*)(ws + WS_QRAW); const bf16* KVRAW = (const bf16*)(ws + WS_KVRAW); const bf16* Q = (const bf16*)(ws + WS_Q); const bf16* K = (const bf16*)(ws + WS_K);
        const bf16* VT = (const bf16*)(ws + WS_VT); const float* VS = (const float*)(ws + WS_VS); const bf16* MIX = (const bf16*)(ws + WS_MIX);
        const float* o2 = (const float*)(ws + WS_OUT2); const float* o1 = (const float*)d_out;
        const float* nQRAW = w.QRAW; const float* nKV = w.KV; const float* nQ = w.Q; const float* nK = w.K; const float* nV = w.V; const float* nMIX = w.MIX;
        const size_t NMR = (size_t)MMAIN + DB;
        cmp(stream, 0, diag, NMR * 768, [=] __device__(size_t i) { return bf2f(QRAW[nmrow(i / 768) * 768 + i % 768]); }, [=] __device__(size_t i) { return nQRAW[nmrow(i / 768) * 768 + i % 768]; });
        cmp(stream, 1, diag, (size_t)R * 1024, [=] __device__(size_t i) { return bf2f(KVRAW[i]); }, [=] __device__(size_t i) { return nKV[i]; });
        cmp(stream, 2, diag, NMR * 768, [=] __device__(size_t i) { return bf2f(Q[nmrow(i / 768) * 768 + i % 768]); }, [=] __device__(size_t i) { return nQ[nmrow(i / 768) * 768 + i % 768] * (ATTN_SCALE * LOG2E); });
        cmp(stream, 3, diag, (size_t)R * 768, [=] __device__(size_t i) { return bf2f(K[i]); }, [=] __device__(size_t i) { return nK[i]; });
        cmp(stream, 4, diag, (size_t)NB * 512 * TT, [=] __device__(size_t i) { const size_t bhd = i / TT; const int t = (int)(i % TT); return bf2f(VT[bhd * TPAD + t]); },
            [=] __device__(size_t i) { const size_t bhd = i / TT; const int t = (int)(i % TT); const size_t b = bhd / 512, hd = bhd % 512; return nV[(b * TT + t) * 512 + hd]; });
        cmp(stream, 4, diag, (size_t)DB * 512, [=] __device__(size_t i) { return VS[i]; }, [=] __device__(size_t i) { return nV[(size_t)RP * 512 + i]; });
        cmp(stream, 5, diag, (size_t)(OUT_LATS - OUT_SSMP), [=] __device__(size_t i) { return o2[OUT_SSMP + i]; }, [=] __device__(size_t i) { return o1[OUT_SSMP + i]; });
        cmp(stream, 5, diag, (size_t)4194304, [=] __device__(size_t i) { return o2[OUT_SSMS + i]; }, [=] __device__(size_t i) { return o1[OUT_SSMS + i]; });
        cmp(stream, 6, diag, (size_t)R * 512, [=] __device__(size_t i) { return bf2f(MIX[(i >> 9) * 1024 + (i & 511)]); }, [=] __device__(size_t i) { return nMIX[(i >> 9) * 1024 + (i & 511)]; });
        cmp(stream, 7, diag, NMR * 512, [=] __device__(size_t i) { return bf2f(MIX[nmrow(i >> 9) * 1024 + 512 + (i & 511)]); }, [=] __device__(size_t i) { return nMIX[nmrow(i >> 9) * 1024 + 512 + (i & 511)]; });
        cmp(stream, 8, diag, (size_t)OUT_LATP, [=] __device__(size_t i) { return o2[i]; }, [=] __device__(size_t i) { return o1[i]; });
        k_diag_encode<<<64, 256, 0, stream>>>(diag, 9, 1e-3f, (float*)d_out);
    }
#endif
}
```

```cpp
#define MK_DIAG 0
#define MK_ONE_LAUNCH 1
#include <hip/hip_runtime.h>
#include <cstdio>
#include <cstdint>
namespace pg8 {
#define PG8_LAS __attribute__((address_space(3)))
typedef unsigned short bf16_t;
typedef short bf16x8 __attribute__((ext_vector_type(8)));
typedef float f32x4 __attribute__((ext_vector_type(4)));
typedef unsigned u32x4 __attribute__((ext_vector_type(4)));
constexpr int BM = 256, BK = 64, HALF = 128, HTB = HALF * BK * 2  , STAGE_BYTES = 8 * HTB, NXCD = 8, WGM = 8;

__host__ __device__ __forceinline__ int lds_byte(int r, int c) { const int st = (r >> 4) * 2 + (c >> 5), rr = r & 15, cc = c & 31, ob = rr * 64 + cc * 2; return st * 1024 + (ob ^ (((ob >> 9) & 1) << 5)); }
__host__ __device__ __forceinline__ void stage_rc(int b, int& R, int& C) { const int st = b / 1024, sb = b % 1024, swz = sb ^ (((sb >> 9) & 1) << 5); R = (st >> 1) * 16 + swz / 64; C = (st & 1) * 32 + (swz % 64) / 2; }
__host__ __device__ __forceinline__ int perm32(int rho) { const int n = rho >> 4, i = rho & 15; return 8 * (i >> 2) + 4 * n + (i & 3); }

struct Unit { int pm, pn; };
template <class E> constexpr bool has_midscale = false;
struct Gemm { const bf16_t* A; const bf16_t* Bt; int M, N, K; int rmode; int lda;
    __host__ __device__ __forceinline__ int rowbase(int pm) const { return rmode ? (pm >> 3) * 2064 + 16 + (pm & 7) * 256 : pm * 256; } };

struct StaticOrder {
    int nM, nN, nwg, G, c;
    __host__ __device__ void init(int M, int N, int G_, int c_) { nM = M / BM; nN = N / BM; nwg = nM * nN; G = G_; c = c_; }
    __host__ __device__ bool next(int i, Unit& u) const {
        const long L = (long)i * G + c; if (L >= nwg) return false;
        int wgid = (int)L; { const int q = nwg / NXCD, r = nwg % NXCD, xcd = wgid % NXCD, off = wgid / NXCD; wgid = (xcd < r ? xcd * (q + 1) : r * (q + 1) + (xcd - r) * q) + off; }
        const int nig = WGM * nN, gid = wgid / nig, fm = gid * WGM, gsz = (nM - fm) < WGM ? (nM - fm) : WGM;
        u.pm = fm + ((wgid % nig) % gsz); u.pn = (wgid % nig) / gsz; return true;
    }
    __device__ __forceinline__ void a_ready(const Unit&) const {}
    __device__ __forceinline__ void done(const Unit&) const {}
};


template <class Epi, class Sched, bool ALIGN_EPI = false, bool SP2 = false, int ROT = 0>
__device__ __forceinline__ void gemm_phase(PG8_LAS unsigned char* lds, const Gemm g, const Sched& S, const Epi& E) {
    const int tid = threadIdx.x, wid = __builtin_amdgcn_readfirstlane(tid >> 6), lane = tid & 63, wr = wid >> 2, wc = wid & 3, fr = lane & 15, fq = lane >> 4;
    const int K = g.K, nt = K / BK;
    unsigned voffA[2], voffB[2];
#pragma unroll
    for (int i = 0; i < 2; ++i) { int R, C; stage_rc(tid * 16 + i * 8192, R, C); const int Rb = Epi::PERM ? ((R & ~31) + perm32(R & 31)) : R;
        voffA[i] = (unsigned)(R * g.lda + C) * 2u; voffB[i] = (unsigned)(Rb * K + C) * 2u; }
    const size_t kstep = (size_t)(BK * 2);
    const size_t hstepA = (size_t)HALF * g.lda * 2;
    const size_t hstep = (size_t)HALF * K * 2;
    const size_t tstep = 2 * hstep;
    const unsigned ldsw = (unsigned)wid * 1024u;
    const int aoff = lds_byte(wr * 64 + fr, fq * 8), boff = lds_byte(wc * 32 + fr, fq * 8);
#define PG8_SA(b, h) (((b) * 2 + (h)) * HTB)
#define PG8_SB(b, h) ((4 + (b) * 2 + (h)) * HTB)
#define PG8_STAGE(bufoff, gbase, voff) do { _Pragma("unroll") for (int _i = 0; _i < 2; ++_i) \
        __builtin_amdgcn_global_load_lds((const unsigned*)((const char*)(gbase) + (voff)[_i]), (PG8_LAS unsigned*)(lds + (bufoff) + ldsw + _i * 8192), 16, 0, 0); } while (0)
#define PG8_LDA(dst, b, h) do { _Pragma("unroll") for (int m = 0; m < 4; ++m) _Pragma("unroll") for (int k = 0; k < 2; ++k) dst[m][k] = *(const PG8_LAS bf16x8*)(lds + PG8_SA(b, h) + aoff + m * 2048 + k * 1024); } while (0)
#define PG8_LDB(dst, b, h) do { _Pragma("unroll") for (int n = 0; n < 2; ++n) _Pragma("unroll") for (int k = 0; k < 2; ++k) dst[n][k] = *(const PG8_LAS bf16x8*)(lds + PG8_SB(b, h) + boff + n * 2048 + k * 1024); } while (0)
#define PG8_MMA(ai, bj, At, Bt) do { __builtin_amdgcn_s_setprio(1); _Pragma("unroll") for (int m = 0; m < 4; ++m) _Pragma("unroll") for (int n = 0; n < 2; ++n) _Pragma("unroll") for (int k = 0; k < 2; ++k) \
        acc[ai][bj][m][n] = __builtin_amdgcn_mfma_f32_16x16x32_bf16(Bt[n][k], At[m][k], acc[ai][bj][m][n], 0, 0, 0); __builtin_amdgcn_s_setprio(0); } while (0)
#define PG8_WAIT_V(n) asm volatile("s_waitcnt vmcnt(" #n ")" ::: "memory")
#define PG8_WAIT_L(n) asm volatile("s_waitcnt lgkmcnt(" #n ")" ::: "memory")
#define PG8_BAR __builtin_amdgcn_s_barrier()
#define PG8_SCHED __builtin_amdgcn_sched_barrier(0)
    Unit cur, nxt; int ui = 0;
    if (!S.next(0, cur)) return;
    f32x4 acc[2][2][4][2];
#pragma unroll
    for (int a = 0; a < 2; ++a)
#pragma unroll
        for (int b = 0; b < 2; ++b)
#pragma unroll
            for (int m = 0; m < 4; ++m)
#pragma unroll
                for (int n = 0; n < 2; ++n) acc[a][b][m][n] = (f32x4){0.f, 0.f, 0.f, 0.f};
    bf16x8 At[4][2], B0[2][2], B1[2][2];
    const char* cA = (const char*)g.A + (size_t)g.rowbase(cur.pm) * g.lda * 2 + ROT * kstep; const char* cB = (const char*)g.Bt + (size_t)cur.pn * tstep + ROT * kstep;
#define PG8_KOFF(j) ((long)((ROT != 0 && (j) >= nt - ROT) ? (j) - nt : (j)) * (long)kstep)
    S.a_ready(cur);
    if constexpr (SP2) {
        PG8_STAGE(PG8_SB(0, 0), cB, voffB); PG8_STAGE(PG8_SB(0, 1), cB + hstep, voffB); PG8_STAGE(PG8_SA(0, 0), cA, voffA); PG8_STAGE(PG8_SA(0, 1), cA + hstepA, voffA);
        if (wr == 1) PG8_BAR;
        PG8_WAIT_V(2); PG8_BAR;
        PG8_STAGE(PG8_SB(1, 0), cB + kstep, voffB); PG8_STAGE(PG8_SA(1, 0), cA + kstep, voffA); PG8_STAGE(PG8_SB(1, 1), cB + hstep + kstep, voffB);
        PG8_WAIT_V(6); PG8_BAR;
    } else {
        PG8_STAGE(PG8_SB(0, 0), cB, voffB); PG8_STAGE(PG8_SA(0, 0), cA, voffA); PG8_STAGE(PG8_SB(0, 1), cB + hstep, voffB); PG8_STAGE(PG8_SA(0, 1), cA + hstepA, voffA);
        if (wr == 1) PG8_BAR;
        PG8_WAIT_V(4); PG8_BAR;
        PG8_STAGE(PG8_SB(1, 0), cB + kstep, voffB); PG8_STAGE(PG8_SA(1, 0), cA + kstep, voffA); PG8_STAGE(PG8_SB(1, 1), cB + hstep + kstep, voffB);
        PG8_WAIT_V(6); PG8_BAR;
    }
    for (;;) {
        const bool has_next = S.next(ui + 1, nxt);
        const char* nA = has_next ? (const char*)g.A + (size_t)g.rowbase(nxt.pm) * g.lda * 2 + ROT * kstep : cA; const char* nB = has_next ? (const char*)g.Bt + (size_t)nxt.pn * tstep + ROT * kstep : cB;
        for (int t = 0; t < nt; t += 2) {
            const bool last = (t == nt - 2);
            const char* a1 = cA + PG8_KOFF(t + 1);
            const char* a2 = last ? nA : cA + PG8_KOFF(t + 2); const char* b2 = last ? nB : cB + PG8_KOFF(t + 2);
            if constexpr (has_midscale<Epi>) { if (t == nt - ROT) E.midscale(acc, cur, wr, fr); }
            const char* a3 = a2 + kstep; const char* b3 = b2 + kstep;
            if (last && has_next) S.a_ready(nxt);
            if constexpr (SP2) {
            PG8_LDB(B0, 0, 0); PG8_LDB(B1, 0, 1); PG8_SCHED; PG8_LDA(At, 0, 0); PG8_STAGE(PG8_SA(1, 1), a1 + hstepA, voffA);
            PG8_WAIT_V(8); PG8_WAIT_L(0); PG8_BAR; PG8_MMA(0, 0, At, B0); PG8_MMA(0, 1, At, B1); PG8_BAR; PG8_SCHED;
            PG8_LDA(At, 0, 1); PG8_STAGE(PG8_SB(0, 0), b2, voffB); PG8_STAGE(PG8_SB(0, 1), b2 + hstep, voffB); PG8_STAGE(PG8_SA(0, 0), a2, voffA);
            PG8_WAIT_V(8); PG8_WAIT_L(0); PG8_BAR; PG8_MMA(1, 0, At, B0); PG8_MMA(1, 1, At, B1); PG8_BAR; PG8_SCHED;
            PG8_LDB(B0, 1, 0); PG8_LDB(B1, 1, 1); PG8_SCHED; PG8_LDA(At, 1, 0); PG8_STAGE(PG8_SA(0, 1), a2 + hstepA, voffA);
            PG8_WAIT_V(8); PG8_WAIT_L(0); PG8_BAR; PG8_MMA(0, 0, At, B0); PG8_MMA(0, 1, At, B1); PG8_BAR; PG8_SCHED;
            PG8_LDA(At, 1, 1); PG8_STAGE(PG8_SB(1, 0), b3, voffB); PG8_STAGE(PG8_SB(1, 1), b3 + hstep, voffB); PG8_STAGE(PG8_SA(1, 0), a3, voffA);
            PG8_WAIT_V(8); PG8_WAIT_L(0); PG8_BAR; PG8_MMA(1, 0, At, B0); PG8_MMA(1, 1, At, B1); PG8_BAR; PG8_SCHED;
            } else {
            PG8_LDB(B0, 0, 0); PG8_SCHED; PG8_LDA(At, 0, 0); PG8_STAGE(PG8_SA(1, 1), a1 + hstepA, voffA);
            PG8_WAIT_L(8); PG8_BAR; PG8_WAIT_L(0); PG8_MMA(0, 0, At, B0); PG8_BAR; PG8_SCHED;
            PG8_LDB(B1, 0, 1); PG8_STAGE(PG8_SB(0, 0), b2, voffB);
            PG8_BAR; PG8_WAIT_L(0); PG8_MMA(0, 1, At, B1); PG8_BAR;
            PG8_LDA(At, 0, 1); PG8_STAGE(PG8_SA(0, 0), a2, voffA);
            PG8_BAR; PG8_WAIT_L(0); PG8_MMA(1, 0, At, B0); PG8_BAR; PG8_SCHED;
            PG8_STAGE(PG8_SB(0, 1), b2 + hstep, voffB);
            PG8_WAIT_V(6); PG8_BAR; PG8_MMA(1, 1, At, B1); PG8_BAR;
            PG8_LDB(B0, 1, 0); PG8_SCHED; PG8_LDA(At, 1, 0); PG8_STAGE(PG8_SA(0, 1), a2 + hstepA, voffA);
            PG8_WAIT_L(8); PG8_BAR; PG8_WAIT_L(0); PG8_MMA(0, 0, At, B0); PG8_BAR; PG8_SCHED;
            PG8_LDB(B1, 1, 1); PG8_STAGE(PG8_SB(1, 0), b3, voffB);
            PG8_BAR; PG8_WAIT_L(0); PG8_MMA(0, 1, At, B1); PG8_BAR;
            PG8_LDA(At, 1, 1); PG8_STAGE(PG8_SA(1, 0), a3, voffA);
            PG8_BAR; PG8_WAIT_L(0); PG8_MMA(1, 0, At, B0); PG8_BAR; PG8_SCHED;
            PG8_STAGE(PG8_SB(1, 1), b3 + hstep, voffB);
            PG8_WAIT_V(6); PG8_BAR; PG8_MMA(1, 1, At, B1); PG8_BAR;
            }
        }
        if constexpr (ALIGN_EPI) { if (wr == 0) PG8_BAR; }
        if constexpr (!Epi::AFTER_DRAIN) { E(acc, cur, wr, wc, fr, fq); S.done(cur); }
        if (!has_next) break;
#pragma unroll
        for (int a = 0; a < 2; ++a)
#pragma unroll
            for (int b = 0; b < 2; ++b)
#pragma unroll
                for (int m = 0; m < 4; ++m)
#pragma unroll
                    for (int n = 0; n < 2; ++n) acc[a][b][m][n] = (f32x4){0.f, 0.f, 0.f, 0.f};
        cur = nxt; cA = nA; cB = nB; ++ui;
        if constexpr (ALIGN_EPI) { if (wr == 1) PG8_BAR; }
    }
    PG8_WAIT_V(0);
    if constexpr (!ALIGN_EPI) { if (wr == 0) PG8_BAR; }
    PG8_BAR;
    if constexpr (Epi::AFTER_DRAIN) { E.fused(acc, cur, wr, wc, fr, fq, lds, wid, lane); S.done(cur); }
#undef PG8_KOFF
#undef PG8_SA
#undef PG8_SB
#undef PG8_STAGE
#undef PG8_LDA
#undef PG8_LDB
#undef PG8_MMA
#undef PG8_WAIT_V
#undef PG8_WAIT_L
#undef PG8_BAR
#undef PG8_SCHED
}
}

#define GAS __attribute__((address_space(1)))
#define LAS __attribute__((address_space(3)))
typedef unsigned short bf16;
typedef unsigned v4u __attribute__((ext_vector_type(4)));
typedef unsigned v2u __attribute__((ext_vector_type(2)));
typedef float f32x4 __attribute__((ext_vector_type(4)));
typedef float f32x16 __attribute__((ext_vector_type(16)));
typedef short bf16x8 __attribute__((ext_vector_type(8)));
typedef short s16x4 __attribute__((ext_vector_type(4)));
typedef GAS unsigned gu32;
#define RLX_AGENT __ATOMIC_RELAXED, __HIP_MEMORY_SCOPE_AGENT
#define LDS_WAIT() asm volatile("s_waitcnt lgkmcnt(0)" ::: "memory")
#define VM_WAIT() asm volatile("s_waitcnt vmcnt(0)" ::: "memory")
typedef float f32x2_t __attribute__((ext_vector_type(2))); typedef __bf16 bf16x2_t __attribute__((ext_vector_type(2)));
__device__ __forceinline__ unsigned pk2(float lo, float hi) { f32x2_t v = {lo, hi}; bf16x2_t b = __builtin_convertvector(v, bf16x2_t); return __builtin_bit_cast(unsigned, b); }
__device__ __forceinline__ bf16 f2bf(float f) { return (bf16)(pk2(f, 0.f) & 0xffffu); }
__device__ __forceinline__ float bf2f(bf16 v) { return __uint_as_float((unsigned)v << 16); }
__device__ __forceinline__ float bflo(unsigned w) { return __uint_as_float(w << 16); }
__device__ __forceinline__ float bfhi(unsigned w) { return __uint_as_float(w & 0xffff0000u); }

#define XB_TMO      128
#define XB_XCNT(j)  (256  + 64 * (j))
#define XB_XSUB(j)  (1280 + 64 * (j))
#define XB_XGEN(j)  (2304 + 64 * (j))
#define XB_TOP      3328
#define XB_TOPGEN   3392
#define XCD_BAR_WORDS 3456
#define XB_SPIN_CAP (1u << 18)
__device__ __forceinline__ unsigned xb_ld(unsigned* p)              { return __hip_atomic_load(p, __ATOMIC_RELAXED, __HIP_MEMORY_SCOPE_AGENT); }
__device__ __forceinline__ unsigned xb_add(unsigned* p, unsigned v) { return __hip_atomic_fetch_add(p, v, __ATOMIC_RELAXED, __HIP_MEMORY_SCOPE_AGENT); }
__device__ __forceinline__ unsigned xb_xcc_id() { return (unsigned)__builtin_amdgcn_s_getreg((3 << 11) | 20) & 0xFu; }
#define XB_SPIN(cond, bar) do { unsigned _sp = 0; while (cond) { __builtin_amdgcn_s_sleep(1); \
    if ((++_sp & 255u) == 0u) { if (xb_ld(&(bar)[XB_TMO])) break; if (_sp > XB_SPIN_CAP) { atomicAdd(&(bar)[XB_TMO], 1u); break; } } } } while (0)
struct XcdBarrier { unsigned* bar; unsigned x; volatile LAS unsigned* st; };
__device__ __forceinline__ XcdBarrier xcd_barrier_post(unsigned* bar, volatile LAS unsigned* st) {
    XcdBarrier b; b.bar = bar; b.x = xb_xcc_id(); b.st = st;
    if (threadIdx.x == 0) (void)xb_add(&bar[XB_XCNT(b.x)], 1u);
    return b;
}
__device__ __forceinline__ void xcd_barrier_complete(unsigned* bar, unsigned x, unsigned& nloc, unsigned& nx) {
    const unsigned G = gridDim.x * gridDim.y * gridDim.z;
    unsigned sum, cnt, mine, sp = 0u;
    for (;;) {
        sum = 0u; cnt = 0u; mine = 0u;
#pragma unroll
        for (unsigned j = 0; j < 16; ++j) { const unsigned c = xb_ld(&bar[XB_XCNT(j)]); sum += c; cnt += (c > 0u) ? 1u : 0u; mine = (j == x) ? c : mine; }
        if (sum == G) break;
        __builtin_amdgcn_s_sleep(1);
        if ((++sp & 255u) == 0u) { if (xb_ld(&bar[XB_TMO])) break; if (sp > XB_SPIN_CAP) { atomicAdd(&bar[XB_TMO], 1u); break; } }
    }
    nloc = mine > 0u ? mine : 1u; nx = cnt > 0u ? cnt : 1u;
}
__device__ __forceinline__ void xcd_barrier(const XcdBarrier& b) {
    asm volatile("s_waitcnt vmcnt(0)" ::: "memory");
    __syncthreads();
    if (threadIdx.x == 0) {
        unsigned* bar = b.bar;
        __builtin_amdgcn_s_waitcnt(0);
        unsigned nloc = b.st[0], nx = b.st[1];
        if (nloc == 0u) { xcd_barrier_complete(bar, b.x, nloc, nx); b.st[0] = nloc; b.st[1] = nx; }
        const unsigned old = xb_add(&bar[XB_XSUB(b.x)], 1u);
        const unsigned gen = old / nloc;
        if (old + 1u == (gen + 1u) * nloc) {
            __builtin_amdgcn_fence(__ATOMIC_RELEASE, "agent");
            asm volatile("s_waitcnt vmcnt(0)" ::: "memory");
            (void)xb_add(&bar[XB_TOP], 1u);
        }
        __builtin_amdgcn_fence(__ATOMIC_ACQUIRE, "agent");
        XB_SPIN(xb_ld(&bar[XB_TOP]) < (gen + 1u) * nx, bar);
        asm volatile("s_waitcnt vmcnt(0)" ::: "memory");
    }
    __syncthreads();
}

constexpr int DM = 1024, NB = 8, SEQ = 2048, NMETA = 16, TT = SEQ + NMETA;
constexpr int DB = 128, PAST = 8192, PAGE = 128, NPAGES = 64;
constexpr int NH = 8, HP = 64, SSDW = 512, NG = 2, DS = 64, CONVD = 768;
constexpr int QKD = 96, VD = 64, MLAW = 512, QL = 384, KVL = 256, DFF = 2816, INC = 1960;
constexpr int RP = NB * TT, R = RP + DB;
constexpr int MMAIN = NB * SEQ;
constexpr int NS = NMETA + DB;
constexpr float EPS = 1e-6f, ATTN_SCALE = 0.10206207261596577f, LOG2E = 1.4426950408889634f;
constexpr int PJ = 2048, C_Z = 0, C_XBC = 512, C_CKV = 1280, C_CQ = 1536, C_DT = 1920, C_KR = 1928;
constexpr int S_Z = 0, S_XBC = 512, S_DT = 1280, S_CQ = 1288, S_CKV = 1672, S_KR = 1928;
constexpr int TPAD = 2112;
constexpr int NCH = 33, CHL = 64, TOFF = 48;
constexpr size_t OUT_YP = 0, OUT_YS = 16777216, OUT_LATP = 16908288, OUT_KRP = 21135360, OUT_CONVP = 21663744,
                 OUT_SSMP = 21682176, OUT_LATS = 21944320, OUT_KRS = 21977088, OUT_CONVS = 21981184, OUT_SSMS = 22276096;

constexpr size_t MiB = 1u << 20;
constexpr size_t WS_CTL = 0, CTL_ZERO_BYTES = 32 * 1024;
constexpr int CW_BAR = 4096;
constexpr size_t WS_SS = 512 * 1024;
constexpr size_t WS_WIN = 2 * MiB;
constexpr size_t WS_WUQ = 6 * MiB;
constexpr size_t WS_WUKV = 7 * MiB;
constexpr size_t WS_WOUT = 8 * MiB;
constexpr size_t WS_WGU = 10 * MiB;
constexpr size_t WS_WDN = 22 * MiB;
constexpr size_t WS_XN = 32 * MiB;
constexpr size_t WS_PROJ = 66 * MiB;
constexpr size_t WS_DTRAW = 132 * MiB;
constexpr size_t WS_DT = 133 * MiB;
constexpr size_t WS_LAT = 134 * MiB;
constexpr size_t WS_CQN = 143 * MiB;
constexpr size_t WS_KRF = 156 * MiB;
constexpr size_t WS_XST = 159 * MiB;
constexpr size_t WS_BT = 176 * MiB;
constexpr size_t WS_BC = 181 * MiB;
constexpr size_t WS_XAS = 190 * MiB;
constexpr size_t WS_QRAW = 191 * MiB;
constexpr size_t WS_KVRAW = 216 * MiB;
constexpr size_t WS_Q = 249 * MiB;
constexpr size_t WS_K = 274 * MiB;
constexpr size_t WS_VT = 299 * MiB;
constexpr size_t WS_STATES = 316 * MiB;
constexpr size_t WS_DECAY = 350 * MiB;
constexpr size_t WS_HIN = 351 * MiB;
constexpr size_t WS_MIX = 368 * MiB;
constexpr size_t WS_ACT = 401 * MiB;
constexpr size_t WS_VS = 491 * MiB;
constexpr size_t WS_DPART = 492 * MiB;
constexpr size_t WS_HS = 494 * MiB;
constexpr size_t WS_ROPE = 496 * MiB;
constexpr size_t WS_SSP = 520 * MiB;
constexpr size_t WS_WUKV2 = 524 * MiB;
constexpr size_t WS_RQ = 522 * MiB;
constexpr size_t WS_SSQ = 526 * MiB;
constexpr size_t WS_OPT_END = 527 * MiB;
constexpr int CW_DCNT = 1024;
constexpr size_t WS_NAIVE = 2048 * MiB;
constexpr size_t WS_DIAG = 1 * MiB;

constexpr int RING_OFF = 0, RING_BYTES = 131072;
constexpr int LDSCTL_OFF = RING_BYTES, MISC_OFF = LDSCTL_OFF + 320;
constexpr int LDS_BYTES = 163840;
constexpr int NWAVES = 8, NTHR = 512;

struct Args { const void* in[30]; float* out; unsigned char* ws; int ph_lo, ph_hi, li, pad; };

struct Frame {
    LAS unsigned char* lds;
    int tid, lane, wave, G, vcu, gw, NGW;
    unsigned char* ws; float* out;
    const void* const* in;
};
#define DPP_F(x, ctrl) __builtin_bit_cast(float, __builtin_amdgcn_update_dpp(0, __builtin_bit_cast(int, (x)), (ctrl), 0xF, 0xF, true))
__device__ __forceinline__ float sum_x1(float x) { return x + DPP_F(x, 0xB1); }
__device__ __forceinline__ float sum_x2(float x) { return x + DPP_F(x, 0x4E); }
__device__ __forceinline__ float sum_x4(float x) { return x + DPP_F(x, 0x141); }
__device__ __forceinline__ float sum_x8(float x) { return x + DPP_F(x, 0x140); }
__device__ __forceinline__ float sum_x16(float x) { const unsigned u = __builtin_bit_cast(unsigned, x); const auto r = __builtin_amdgcn_permlane16_swap(u, u, false, false); return __uint_as_float(r[0]) + __uint_as_float(r[1]); }
__device__ __forceinline__ float sum_x32(float x) { const unsigned u = __builtin_bit_cast(unsigned, x); const auto r = __builtin_amdgcn_permlane32_swap(u, u, false, false); return __uint_as_float(r[0]) + __uint_as_float(r[1]); }
__device__ __forceinline__ float wave_sum(float v) { return sum_x32(sum_x16(sum_x8(sum_x4(sum_x2(sum_x1(v)))))); }
__device__ __forceinline__ float wave_max(float v) {
#pragma unroll
    for (int o = 1; o < 64; o <<= 1) v = fmaxf(v, __shfl_xor(v, o));
    return v;
}
__device__ __forceinline__ float silu_f(float x) { return x * __builtin_amdgcn_rcpf(1.f + __expf(-x)); }
__device__ __forceinline__ float softplus_f(float x) { return fmaxf(x, 0.f) + log1pf(expf(-fabsf(x))); }
__device__ __forceinline__ float rope_inv(int j) { return exp2f(-(float)j * (13.287712379549449f / 16.0f)); }
struct EpiProj {
    static constexpr bool PERM = true, AFTER_DRAIN = false;
    bf16* O; float* dtraw; int rmode;
    __device__ __forceinline__ void operator()(const pg8::f32x4 (&acc)[2][2][4][2], const pg8::Unit& u, int wr, int wc, int fr, int fq) const {
        const int rb = rmode ? (u.pm >> 3) * 2064 + 16 + (u.pm & 7) * 256 : u.pm * 256;
        const int row0 = rb + wr * 64 + fr, col0 = u.pn * 256 + wc * 32 + 8 * fq;
#pragma unroll
        for (int ai = 0; ai < 2; ++ai)
#pragma unroll
            for (int m = 0; m < 4; ++m) { const int row = row0 + ai * 128 + m * 16; bf16* rowp = O + (size_t)row * PJ + col0;
#pragma unroll
                for (int bj = 0; bj < 2; ++bj) { const pg8::f32x4 v0 = acc[ai][bj][m][0], v1 = acc[ai][bj][m][1];
                    v4u w; w.x = pk2(v0[0], v0[1]); w.y = pk2(v0[2], v0[3]); w.z = pk2(v1[0], v1[1]); w.w = pk2(v1[2], v1[3]);
                    *(v4u*)(rowp + bj * 128) = w; }
                if (u.pn == 7 && wc == 0 && fq == 0) { *(pg8::f32x4*)(dtraw + (size_t)row * 8) = acc[ai][1][m][0]; *(pg8::f32x4*)(dtraw + (size_t)row * 8 + 4) = acc[ai][1][m][1]; } }
    }
};
struct EpiBf16 {
    static constexpr bool PERM = true, AFTER_DRAIN = false;
    bf16* O; int ldc; int rmode;
    __device__ __forceinline__ void operator()(const pg8::f32x4 (&acc)[2][2][4][2], const pg8::Unit& u, int wr, int wc, int fr, int fq) const {
        const int rb = rmode ? (u.pm >> 3) * 2064 + 16 + (u.pm & 7) * 256 : u.pm * 256;
        const int row0 = rb + wr * 64 + fr, col0 = u.pn * 256 + wc * 32 + 8 * fq;
#pragma unroll
        for (int ai = 0; ai < 2; ++ai)
#pragma unroll
            for (int m = 0; m < 4; ++m) { bf16* rowp = O + (size_t)(row0 + ai * 128 + m * 16) * ldc + col0;
#pragma unroll
                for (int bj = 0; bj < 2; ++bj) { const pg8::f32x4 v0 = acc[ai][bj][m][0], v1 = acc[ai][bj][m][1];
                    v4u w; w.x = pk2(v0[0], v0[1]); w.y = pk2(v0[2], v0[3]); w.z = pk2(v1[0], v1[1]); w.w = pk2(v1[2], v1[3]);
                    *(v4u*)(rowp + bj * 128) = w; } }
    }
};
struct EpiResF32 {
    static constexpr bool PERM = false, AFTER_DRAIN = false;
    const float* res; float* out;
    __device__ __forceinline__ void operator()(const pg8::f32x4 (&acc)[2][2][4][2], const pg8::Unit& u, int wr, int wc, int fr, int fq) const {
        const int row0 = u.pm * 256 + wr * 64 + fr, col0 = u.pn * 256 + wc * 32 + 4 * fq;
#pragma unroll
        for (int ai = 0; ai < 2; ++ai)
#pragma unroll
            for (int m = 0; m < 4; ++m) { const size_t off = (size_t)(row0 + ai * 128 + m * 16) * DM + col0;
#pragma unroll
                for (int bj = 0; bj < 2; ++bj)
#pragma unroll
                    for (int n = 0; n < 2; ++n) { const pg8::f32x4 r = *(const pg8::f32x4*)(res + off + bj * 128 + n * 16); *(pg8::f32x4*)(out + off + bj * 128 + n * 16) = r + acc[ai][bj][m][n]; } }
    }
};
struct EpiOutProj {
    static constexpr bool PERM = false, AFTER_DRAIN = false;
    const float* res; float* out; bf16* HB; float* SS; const LAS float* RS; mutable int nth;
    __device__ __forceinline__ void midscale(pg8::f32x4 (&acc)[2][2][4][2], const pg8::Unit& u, int wr, int fr) const {
        const int slot = nth++;
        const LAS float* rsp = RS + slot * 256 + wr * 64 + fr;
#pragma unroll
        for (int ai = 0; ai < 2; ++ai)
#pragma unroll
            for (int m = 0; m < 4; ++m) { const float rs = rsp[ai * 128 + m * 16];
#pragma unroll
                for (int bj = 0; bj < 2; ++bj)
#pragma unroll
                    for (int n = 0; n < 2; ++n) acc[ai][bj][m][n] *= rs; }
    }
    __device__ __forceinline__ void operator()(const pg8::f32x4 (&acc)[2][2][4][2], const pg8::Unit& u, int wr, int wc, int fr, int fq) const {
        const int rb = (u.pm >> 3) * 2064 + 16 + (u.pm & 7) * 256;
        const int row0 = u.pm * 256 + wr * 64 + fr, col0 = u.pn * 256 + wc * 32 + 4 * fq;
        pg8::f32x4 rc[4], rn[4];
#define EOP_LOAD(dst, g) do { const size_t off_ = (size_t)(row0 + ((g) >> 2) * 128 + ((g) & 3) * 16) * DM + col0; \
            dst[0] = *(const pg8::f32x4*)(res + off_); dst[1] = *(const pg8::f32x4*)(res + off_ + 16); dst[2] = *(const pg8::f32x4*)(res + off_ + 128); dst[3] = *(const pg8::f32x4*)(res + off_ + 144); } while (0)
        EOP_LOAD(rc, 0);
#pragma unroll
        for (int g = 0; g < 8; ++g) { const int ai = g >> 2, m = g & 3;
            if (g < 7) EOP_LOAD(rn, g + 1);
            const int orow = row0 + ai * 128 + m * 16; bf16* hb = HB + (size_t)(rb + wr * 64 + fr + ai * 128 + m * 16) * DM + col0; float ss = 0.f;
#pragma unroll
            for (int bj = 0; bj < 2; ++bj)
#pragma unroll
                for (int n = 0; n < 2; ++n) { const pg8::f32x4 v = rc[2 * bj + n] + acc[ai][bj][m][n];
                    ss += (v[0] * v[0] + v[1] * v[1]) + (v[2] * v[2] + v[3] * v[3]); v2u w; w.x = pk2(v[0], v[1]); w.y = pk2(v[2], v[3]); *(v2u*)(hb + bj * 128 + n * 16) = w; }
            ss = sum_x16(ss); ss = sum_x32(ss);
            if (fq == 0) SS[(size_t)orow * 16 + u.pn * 4 + wc] = ss;
#pragma unroll
            for (int i = 0; i < 4; ++i) rc[i] = rn[i]; }
#undef EOP_LOAD
    }
};
namespace pg8 { template <> constexpr bool has_midscale<EpiOutProj> = true; }
struct EpiDown {
    static constexpr bool PERM = false, AFTER_DRAIN = false;
    const bf16* HB; float* out;
    __device__ __forceinline__ void operator()(const pg8::f32x4 (&acc)[2][2][4][2], const pg8::Unit& u, int wr, int wc, int fr, int fq) const {
        const int rb = (u.pm >> 3) * 2064 + 16 + (u.pm & 7) * 256;
        const int row0 = u.pm * 256 + wr * 64 + fr, col0 = u.pn * 256 + wc * 32 + 4 * fq;
        v2u rc[4], rn[4];
#define EDN_LOAD(dst, g) do { const bf16* hb_ = HB + (size_t)(rb + wr * 64 + fr + ((g) >> 2) * 128 + ((g) & 3) * 16) * DM + col0; \
            dst[0] = *(const v2u*)(hb_); dst[1] = *(const v2u*)(hb_ + 16); dst[2] = *(const v2u*)(hb_ + 128); dst[3] = *(const v2u*)(hb_ + 144); } while (0)
        EDN_LOAD(rc, 0);
#pragma unroll
        for (int g = 0; g < 8; ++g) { const int ai = g >> 2, m = g & 3;
            if (g < 7) EDN_LOAD(rn, g + 1);
            const size_t off = (size_t)(row0 + ai * 128 + m * 16) * DM + col0;
#pragma unroll
            for (int bj = 0; bj < 2; ++bj)
#pragma unroll
                for (int n = 0; n < 2; ++n) { const v2u w = rc[2 * bj + n]; const pg8::f32x4 r = {bflo(w.x), bfhi(w.x), bflo(w.y), bfhi(w.y)}; *(pg8::f32x4*)(out + off + bj * 128 + n * 16) = r + acc[ai][bj][m][n]; }
#pragma unroll
            for (int i = 0; i < 4; ++i) rc[i] = rn[i]; }
#undef EDN_LOAD
    }
};
struct EpiSwiGLU {
    static constexpr bool PERM = true, AFTER_DRAIN = false;
    bf16* O; const LAS float* RS; mutable int nth;
    __device__ __forceinline__ void operator()(const pg8::f32x4 (&acc)[2][2][4][2], const pg8::Unit& u, int wr, int wc, int fr, int fq) const {
        const int rb = (u.pm >> 3) * 2064 + 16 + (u.pm & 7) * 256;
        const int row0 = rb + wr * 64 + fr, col0 = u.pn * 128 + wc * 32 + 8 * fq;
        const int slot = nth++;
        const LAS float* rsp = RS + slot * 256 + wr * 64 + fr;
#pragma unroll
        for (int ai = 0; ai < 2; ++ai)
#pragma unroll
            for (int m = 0; m < 4; ++m) { float a[8]; const float rs = rsp[ai * 128 + m * 16];
#pragma unroll
                for (int n = 0; n < 2; ++n)
#pragma unroll
                    for (int e = 0; e < 4; ++e) a[4 * n + e] = silu_f(rs * acc[ai][0][m][n][e]) * (rs * acc[ai][1][m][n][e]);
                v4u w; w.x = pk2(a[0], a[1]); w.y = pk2(a[2], a[3]); w.z = pk2(a[4], a[5]); w.w = pk2(a[6], a[7]);
                *(v4u*)(O + (size_t)(row0 + ai * 128 + m * 16) * DFF + col0) = w; }
    }
};

template <class ARow, class Epi>
__device__ __forceinline__ void small_gemm(const bf16* A, int lda, const bf16* Bt, int K, int nrt, int nct, const ARow& arow, const Epi& E, int gw, int NGW, int lane, int ksplit = 1) {
    const int ntask = nrt * nct * ksplit, kc = K / ksplit;
    for (int task = gw; task < ntask; task += NGW) {
        const int rt = task % nrt, ct = (task / nrt) % nct, kq = task / (nrt * nct);
        const bf16* ap = A + (size_t)arow(rt * 16 + (lane & 15)) * lda + kq * kc + 8 * (lane >> 4);
        const bf16* bp = Bt + (size_t)(ct * 16 + (lane & 15)) * K + kq * kc + 8 * (lane >> 4);
        f32x4 acc = {0.f, 0.f, 0.f, 0.f};
#pragma unroll 1
        for (int k0 = 0; k0 < kc; k0 += 32 * 11) {
            bf16x8 av[11], bv[11];
#pragma unroll
            for (int j = 0; j < 11; ++j) if (k0 + 32 * j < kc) { av[j] = *(const bf16x8*)(ap + k0 + 32 * j); bv[j] = *(const bf16x8*)(bp + k0 + 32 * j); }
#pragma unroll
            for (int j = 0; j < 11; ++j) if (k0 + 32 * j < kc) acc = __builtin_amdgcn_mfma_f32_16x16x32_bf16(av[j], bv[j], acc, 0, 0, 0);
        }
        E(acc, rt, ct, lane);
    }
}

template <class RM>
__device__ __forceinline__ void transpose_item(const float* W, int N, int ldw, bf16* WT, int ldt, int item, LAS float* scr, int lane, const RM& rm, const float* kscale = nullptr) {
    const int nblk = (N + 31) / 32, kb = item / nblk, nb = item % nblk, k0 = 64 * kb, n0 = 32 * nb;
    { const int n = n0 + (lane & 31); float v[32];
#pragma unroll
      for (int i = 0; i < 32; ++i) { const int kk = 2 * i + (lane >> 5); v[i] = (n < N) ? W[(size_t)(k0 + kk) * ldw + n] : 0.f; }
#pragma unroll
      for (int i = 0; i < 32; ++i) { const int kk = 2 * i + (lane >> 5); float x = v[i]; if (kscale) x *= kscale[k0 + kk]; scr[kk * 33 + (lane & 31)] = x; } }
    LDS_WAIT(); asm volatile("" ::: "memory");
    const int c = lane & 7;
#pragma unroll
    for (int j = 0; j < 4; ++j) { const int n = (lane >> 3) + 8 * j; const LAS float* s = scr + (8 * c) * 33 + n;
        if (n0 + n < N) { v4u o; o.x = pk2(s[0 * 33], s[1 * 33]); o.y = pk2(s[2 * 33], s[3 * 33]); o.z = pk2(s[4 * 33], s[5 * 33]); o.w = pk2(s[6 * 33], s[7 * 33]);
            *(v4u*)(WT + (size_t)rm(n0 + n) * ldt + k0 + 8 * c) = o; } }
    LDS_WAIT(); asm volatile("" ::: "memory");
}
__device__ __forceinline__ int map_in(int n) {
    return n < S_DT ? n : n < S_CQ ? C_DT + (n - S_DT) : n < S_CKV ? C_CQ + (n - S_CQ) : n < S_KR ? C_CKV + (n - S_CKV) : n;
}
__device__ __forceinline__ void p0_prologue(Frame& F) {
    LAS float* scr = (LAS float*)(F.lds + RING_OFF + F.wave * 16384);
    const float* w_in = (const float*)F.in[9]; const float* w_uq = (const float*)F.in[17]; const float* w_ukv = (const float*)F.in[19]; const float* w_out = (const float*)F.in[25];
    const float* w_gate = (const float*)F.in[27]; const float* w_up = (const float*)F.in[28]; const float* w_down = (const float*)F.in[29];
    bf16* WIN = (bf16*)(F.ws + WS_WIN); bf16* WUQ = (bf16*)(F.ws + WS_WUQ); bf16* WUKV = (bf16*)(F.ws + WS_WUKV); bf16* WOUT = (bf16*)(F.ws + WS_WOUT); bf16* WGU = (bf16*)(F.ws + WS_WGU); bf16* WDN = (bf16*)(F.ws + WS_WDN);
    const float* ffg = (const float*)F.in[26];
    constexpr int I_IN = 16 * 62, I_UQ = 6 * 24, I_UKV = 4 * 32, I_OUT = 16 * 32;
    constexpr int NITEMS = I_IN + I_UQ + 2 * I_UKV + I_OUT;
    bf16* WUKV2 = (bf16*)(F.ws + WS_WUKV2);
    for (int it = F.gw; it < NITEMS; it += F.NGW) {
        int r = it;
        if (r < I_IN) { transpose_item(w_in, INC, INC, WIN, DM, r, scr, F.lane, [](int n) { return map_in(n); }); continue; } r -= I_IN;
        if (r < I_UQ) { transpose_item(w_uq, 768, 768, WUQ, QL, r, scr, F.lane, [](int n) { return n; }, (const float*)F.in[16]); continue; } r -= I_UQ;
        if (r < I_UKV) { transpose_item(w_ukv, 1024, 1024, WUKV, KVL, r, scr, F.lane, [](int n) { return n; }, (const float*)F.in[18]); continue; } r -= I_UKV;
        if (r < I_UKV) { transpose_item(w_ukv, 1024, 1024, WUKV2, KVL, r, scr, F.lane, [](int n) { return n; }); continue; } r -= I_UKV;
        transpose_item(w_out, DM, DM, WOUT, 1024, r, scr, F.lane, [](int n) { return n; }, (r >= 8 * 32) ? (const float*)F.in[24] - 512 : nullptr);
    }
    for (int i = F.gw * 64 + F.lane; i < 88 * 1024 / 8; i += F.NGW * 64) *(v4u*)(WIN + (size_t)1960 * 1024 + (size_t)i * 8) = (v4u){0u, 0u, 0u, 0u};
    const float* xp = (const float*)F.in[0]; const float* xs = (const float*)F.in[1]; const float* meta = (const float*)F.in[7]; const float* g = (const float*)F.in[8];
    bf16* XN = (bf16*)(F.ws + WS_XN);
    f32x4 gv[4];
#pragma unroll
    for (int j = 0; j < 4; ++j) gv[j] = ((const f32x4*)g)[F.lane + 64 * j];
#define XN_ROWS(r0, n) do { f32x4 v[4][4]; \
        _Pragma("unroll") for (int i = 0; i < 4; ++i) if (i < (n)) { const int row = (r0) + i; const float* src; \
            if (row < RP) { const int b = row / TT, t = row % TT; src = (t < NMETA) ? meta + (size_t)t * DM : xp + ((size_t)b * SEQ + (t - NMETA)) * DM; } else src = xs + (size_t)(row - RP) * DM; \
            _Pragma("unroll") for (int j = 0; j < 4; ++j) v[i][j] = ((const f32x4*)src)[F.lane + 64 * j]; } \
        _Pragma("unroll") for (int i = 0; i < 4; ++i) if (i < (n)) { float s = 0.f; \
            _Pragma("unroll") for (int j = 0; j < 4; ++j) s += (v[i][j].x * v[i][j].x + v[i][j].y * v[i][j].y) + (v[i][j].z * v[i][j].z + v[i][j].w * v[i][j].w); \
            const float rs = __builtin_amdgcn_rsqf(wave_sum(s) * (1.f / DM) + EPS); \
            v2u* o8 = (v2u*)(XN + (size_t)((r0) + i) * DM) + F.lane; \
            _Pragma("unroll") for (int j = 0; j < 4; ++j) { v2u o; o.x = pk2(v[i][j].x * rs * gv[j].x, v[i][j].y * rs * gv[j].y); o.y = pk2(v[i][j].z * rs * gv[j].z, v[i][j].w * rs * gv[j].w); o8[64 * j] = o; } } } while (0)
    if (F.NGW == 2048) { XN_ROWS(4 * F.gw, 4); XN_ROWS(8192 + 4 * F.gw, 4); if (F.gw < 256) XN_ROWS(16384 + F.gw, 1); }
    else for (int r0 = 4 * F.gw; r0 < R; r0 += 4 * F.NGW) XN_ROWS(r0, 4);
#undef XN_ROWS
    float* ROPE = (float*)(F.ws + WS_ROPE);
    for (int i = blockIdx.x * NTHR + F.tid; i < (TT + 1) * 16; i += F.G * NTHR) { const int p = i >> 4, j = i & 15; const float ang = (float)(p < TT ? p : PAST) * rope_inv(j); ROPE[2 * i] = cosf(ang); ROPE[2 * i + 1] = sinf(ang); }
}

__device__ __forceinline__ void p1_ffn_weights(Frame& F, int w0, int nw) {
    LAS float* scr = (LAS float*)(F.lds + RING_OFF + F.wave * 16384);
    const float* w_gate = (const float*)F.in[27]; const float* w_up = (const float*)F.in[28]; const float* w_down = (const float*)F.in[29]; const float* ffg = (const float*)F.in[26];
    bf16* WGU = (bf16*)(F.ws + WS_WGU); bf16* WDN = (bf16*)(F.ws + WS_WDN);
    constexpr int I_G = 16 * 88, I_DN = 44 * 32;
    for (int it = F.gw - w0; it < 2 * I_G + I_DN; it += nw) {
        int r = it;
        if (r < I_G) { transpose_item(w_gate, DFF, DFF, WGU, DM, r, scr, F.lane, [](int n) { return 256 * (n >> 7) + (n & 127); }, ffg); continue; } r -= I_G;
        if (r < I_G) { transpose_item(w_up, DFF, DFF, WGU, DM, r, scr, F.lane, [](int n) { return 256 * (n >> 7) + 128 + (n & 127); }, ffg); continue; } r -= I_G;
        transpose_item(w_down, DM, DM, WDN, DFF, r, scr, F.lane, [](int n) { return n; });
    }
}
__device__ __forceinline__ int small_arow(int r) { return r < NMETA ? r : RP + (r - NMETA); }
__device__ __forceinline__ void p1_inproj(Frame& F) {
    const bf16* XN = (const bf16*)(F.ws + WS_XN); const bf16* WIN = (const bf16*)(F.ws + WS_WIN); bf16* PROJ = (bf16*)(F.ws + WS_PROJ); float* DTRAW = (float*)(F.ws + WS_DTRAW);
    { pg8::Gemm g{XN, WIN, MMAIN, PJ, DM, 1, DM}; pg8::StaticOrder S; S.init(MMAIN, PJ, F.G, (int)blockIdx.x);
      EpiProj E{PROJ, DTRAW, 1};
      pg8::gemm_phase<EpiProj, pg8::StaticOrder, true, true>(F.lds + RING_OFF, g, S, E); }
    auto epi = [&](const f32x4& acc, int rt, int ct, int lane) {
        const int col = ct * 16 + (lane & 15);
#pragma unroll
        for (int i = 0; i < 4; ++i) { const int r = rt * 16 + 4 * (lane >> 4) + i; const bf16 v = f2bf(acc[i]);
            if (r < NMETA) { for (int b = 0; b < NB; ++b) { PROJ[(size_t)(b * TT + r) * PJ + col] = v; if (col >= C_DT && col < C_DT + 8) DTRAW[(size_t)(b * TT + r) * 8 + (col - C_DT)] = acc[i]; } }
            else { const int row = RP + (r - NMETA); PROJ[(size_t)row * PJ + col] = v; if (col >= C_DT && col < C_DT + 8) DTRAW[(size_t)row * 8 + (col - C_DT)] = acc[i]; } }
    };
    small_gemm(XN, DM, WIN, DM, NS / 16, PJ / 16, [](int r) { return small_arow(r); }, epi, F.gw, F.NGW, F.lane);
    { constexpr int NSM = (NS / 16) * (PJ / 16);
      if (F.NGW > NSM + 256) { if (F.gw >= NSM) p1_ffn_weights(F, NSM, F.NGW - NSM); } else p1_ffn_weights(F, 0, F.NGW); }
}

constexpr int CV_LDS_STRIDE = 88;
__device__ __forceinline__ void p2_elementwise(Frame& F) {
    const bf16* PROJ = (const bf16*)(F.ws + WS_PROJ); const float* DTRAW = (const float*)(F.ws + WS_DTRAW); float* DT = (float*)(F.ws + WS_DT);
    float* RQS = (float*)(F.ws + WS_RQ); float* KRF = (float*)(F.ws + WS_KRF);
    const float* kvg = (const float*)F.in[18]; const float* qng = (const float*)F.in[16]; const float* dtb = (const float*)F.in[12]; const float* ROPE = (const float*)(F.ws + WS_ROPE);
    {
        const f32x4 gg = ((const f32x4*)kvg)[F.lane]; const float* gq = qng + 6 * F.lane; const float g0 = gq[0], g1 = gq[1], g2 = gq[2], g3 = gq[3], g4 = gq[4], g5 = gq[5]; const float dbias = dtb[F.lane & 7];
        v2u wk[4], wkn[4]; unsigned wq[4][3], wqn[4][3]; unsigned short kr1[4], kr2[4], kr1n[4], kr2n[4]; float dtr[4], dtrn[4]; f32x2_t cs[4], csn[4];
#define P2A_LOAD(WK, WQ, K1, K2, DTR, CS, r0, n) do { _Pragma("unroll") for (int i = 0; i < 4; ++i) if (i < (n)) { const int row = (r0) + i; const bf16* pr = PROJ + (size_t)row * PJ; \
            WK[i] = *(const v2u*)(pr + C_CKV + 4 * F.lane); const unsigned* p = (const unsigned*)(pr + C_CQ + 6 * F.lane); WQ[i][0] = p[0]; WQ[i][1] = p[1]; WQ[i][2] = p[2]; \
            K1[i] = pr[C_KR + (F.lane & 15)]; K2[i] = pr[C_KR + 16 + (F.lane & 15)]; DTR[i] = DTRAW[(size_t)row * 8 + (F.lane & 7)]; \
            CS[i] = *(const f32x2_t*)(ROPE + 2 * ((row < RP ? row % TT : TT) * 16 + (F.lane & 15))); } } while (0)
#define P2A_PROC(r0, n) do { _Pragma("unroll") for (int i = 0; i < 4; ++i) if (i < (n)) { const int row = (r0) + i; \
            { const float v0 = bflo(wk[i].x), v1 = bfhi(wk[i].x), v2 = bflo(wk[i].y), v3 = bfhi(wk[i].y); \
              const float rs = __builtin_amdgcn_rsqf(wave_sum((v0 * v0 + v1 * v1) + (v2 * v2 + v3 * v3)) * (1.f / KVL) + EPS); \
              const f32x4 o = {v0 * rs * gg.x, v1 * rs * gg.y, v2 * rs * gg.z, v3 * rs * gg.w}; \
              float* of = (row < RP) ? F.out + OUT_LATP + (size_t)row * KVL : F.out + OUT_LATS + (size_t)(row - RP) * KVL; \
              ((f32x4*)of)[F.lane] = o; if (F.lane == 0) RQS[R + row] = rs; } \
            { const float v0 = bflo(wq[i][0]), v1 = bfhi(wq[i][0]), v2 = bflo(wq[i][1]), v3 = bfhi(wq[i][1]), v4 = bflo(wq[i][2]), v5 = bfhi(wq[i][2]); \
              const float rs = __builtin_amdgcn_rsqf(wave_sum((v0 * v0 + v1 * v1) + (v2 * v2 + v3 * v3) + (v4 * v4 + v5 * v5)) * (1.f / QL) + EPS); \
              if (F.lane == 0) RQS[row] = rs; } \
            if (F.lane < 16) { const int j = F.lane; const float c = cs[i].x, s = cs[i].y; \
              const float x1 = bf2f(kr1[i]), x2 = bf2f(kr2[i]); const float y1 = x1 * c - x2 * s, y2 = x1 * s + x2 * c; \
              KRF[(size_t)row * 32 + j] = y1; KRF[(size_t)row * 32 + 16 + j] = y2; \
              float* of = (row < RP) ? F.out + OUT_KRP + (size_t)row * 32 : F.out + OUT_KRS + (size_t)(row - RP) * 32; of[j] = y1; of[16 + j] = y2; } \
            if (F.lane < 8) DT[(size_t)row * 8 + F.lane] = softplus_f(dtr[i] + dbias); } } while (0)
#define P2A_ROT() do { _Pragma("unroll") for (int i = 0; i < 4; ++i) { wk[i] = wkn[i]; wq[i][0] = wqn[i][0]; wq[i][1] = wqn[i][1]; wq[i][2] = wqn[i][2]; kr1[i] = kr1n[i]; kr2[i] = kr2n[i]; dtr[i] = dtrn[i]; cs[i] = csn[i]; } } while (0)
        if (F.NGW == 2048) {
            const int ra = 4 * F.gw, rb2 = 8192 + 4 * F.gw, rc = 16384 + F.gw;
            P2A_LOAD(wk, wq, kr1, kr2, dtr, cs, ra, 4);
            P2A_LOAD(wkn, wqn, kr1n, kr2n, dtrn, csn, rb2, 4);
            P2A_PROC(ra, 4); P2A_ROT();
            if (F.gw < 256) P2A_LOAD(wkn, wqn, kr1n, kr2n, dtrn, csn, rc, 1);
            P2A_PROC(rb2, 4);
            if (F.gw < 256) { P2A_ROT(); P2A_PROC(rc, 1); }
        } else {
            for (int r0 = 4 * F.gw; r0 < R; r0 += 4 * F.NGW) { P2A_LOAD(wk, wq, kr1, kr2, dtr, cs, r0, 4); P2A_PROC(r0, 4); }
        }
#undef P2A_LOAD
#undef P2A_PROC
#undef P2A_ROT
    }
    const float* cw = (const float*)F.in[10]; const float* cb = (const float*)F.in[11];
    bf16* XST = (bf16*)(F.ws + WS_XST); bf16* BT = (bf16*)(F.ws + WS_BT); bf16* BC = (bf16*)(F.ws + WS_BC);
    LAS bf16* tile = (LAS bf16*)(F.lds + RING_OFF);
    for (int i = blockIdx.x * NTHR + F.tid; i < NB * 640 * 6; i += F.G * NTHR) { const int rowi = i / 6, pc = i % 6; const int bb = rowi / 640, cc = rowi % 640;
        bf16* dst = (cc < SSDW) ? XST + ((size_t)(bb * SSDW + cc)) * TPAD : BT + ((size_t)(bb * 128 + (cc - SSDW))) * TPAD; *(v4u*)(dst + pc * 8) = (v4u){0u, 0u, 0u, 0u}; }
    {
        const int cl = 2 * (F.tid & 127), tq = F.tid >> 7;
        unsigned raw[19], rawn[19]; float wv[10], wn[10];
#define CV_FETCH(RAW, WV, uu) do { const int third_ = (uu) % 3, tb_ = 1 + ((uu) / 3) % 32, b_ = (uu) / 96; const int c_ = third_ * 256 + cl, tf_ = tb_ * CHL - TOFF + 16 * tq; \
            const bf16* base_ = PROJ + (size_t)b_ * TT * PJ + C_XBC + c_; \
            _Pragma("unroll") for (int k = 0; k < 19; ++k) { const int t = tf_ - 3 + k; RAW[k] = (t >= 0) ? *(const unsigned*)(base_ + (size_t)t * PJ) : 0u; } \
            _Pragma("unroll") for (int k = 0; k < 4; ++k) { WV[2 * k] = cw[k * CONVD + c_]; WV[2 * k + 1] = cw[k * CONVD + c_ + 1]; } WV[8] = cb[c_]; WV[9] = cb[c_ + 1]; } while (0)
#define CV_COMPUTE(RAW, WV, tfirst, lcol, third, b) do { unsigned wa_[8], wb_[8]; float pa_ = 0.f, pb_ = 0.f; \
            _Pragma("unroll") for (int k = 0; k < 16; ++k) { const int t = (tfirst) + k; \
                const float ya = silu_f(WV[8] + bflo(RAW[k]) * WV[0] + bflo(RAW[k + 1]) * WV[2] + bflo(RAW[k + 2]) * WV[4] + bflo(RAW[k + 3]) * WV[6]); \
                const float yb = silu_f(WV[9] + bfhi(RAW[k]) * WV[1] + bfhi(RAW[k + 1]) * WV[3] + bfhi(RAW[k + 2]) * WV[5] + bfhi(RAW[k + 3]) * WV[7]); \
                if ((third) == 2) *(unsigned*)(BC + (size_t)((b) * TT + t) * 256 + cl) = pk2(ya, yb); \
                if (k & 1) { wa_[k >> 1] = pk2(pa_, ya); wb_[k >> 1] = pk2(pb_, yb); } else { pa_ = ya; pb_ = yb; } } \
            LAS v4u* ra_ = (LAS v4u*)(tile + cl * CV_LDS_STRIDE + (lcol)); LAS v4u* rb_ = (LAS v4u*)(tile + (cl + 1) * CV_LDS_STRIDE + (lcol)); \
            ra_[0] = (v4u){wa_[0], wa_[1], wa_[2], wa_[3]}; ra_[1] = (v4u){wa_[4], wa_[5], wa_[6], wa_[7]}; rb_[0] = (v4u){wb_[0], wb_[1], wb_[2], wb_[3]}; rb_[1] = (v4u){wb_[4], wb_[5], wb_[6], wb_[7]}; } while (0)
        if ((int)blockIdx.x < NB * 32 * 3) CV_FETCH(rawn, wn, (int)blockIdx.x);
        for (int u = blockIdx.x; u < NB * 32 * 3; u += F.G) {
            const int third = u % 3, tb = 1 + (u / 3) % 32, b = u / 96; const int t0 = tb * CHL - TOFF;
#pragma unroll
            for (int k = 0; k < 19; ++k) raw[k] = rawn[k];
#pragma unroll
            for (int k = 0; k < 10; ++k) wv[k] = wn[k];
            CV_COMPUTE(raw, wv, t0 + 16 * tq, 16 * tq, third, b);
            if (tb == 1 && tq == 0) {
                const bf16* base = PROJ + (size_t)b * TT * PJ + C_XBC + third * 256 + cl;
#pragma unroll
                for (int k = 0; k < 19; ++k) { const int t = k - 3; raw[k] = (t >= 0) ? *(const unsigned*)(base + (size_t)t * PJ) : 0u; }
                CV_COMPUTE(raw, wv, 0, 64, third, b); }
            __syncthreads();
            if (u + F.G < NB * 32 * 3) CV_FETCH(rawn, wn, u + F.G);
            { const int nrows = (third == 2) ? 128 : 256; const int npc = (tb == 1) ? 10 : 8;
              for (int i = F.tid; i < nrows * npc; i += NTHR) { const int cr = i / npc, pc = i % npc;
                const v4u o = *(const LAS v4u*)(tile + cr * CV_LDS_STRIDE + pc * 8);
                bf16* dst = (third < 2) ? XST + ((size_t)(b * SSDW + third * 256 + cr)) * TPAD : BT + ((size_t)(b * 128 + cr)) * TPAD;
                *(v4u*)(dst + ((pc < 8) ? tb * CHL + pc * 8 : TOFF + (pc - 8) * 8)) = o; } }
            __syncthreads();
        }
#undef CV_FETCH
#undef CV_COMPUTE
    }
    const float* sconv = (const float*)F.in[4]; float* XAS = (float*)(F.ws + WS_XAS);
    for (int i = blockIdx.x * NTHR + F.tid; i < DB * CONVD; i += F.G * NTHR) { const int b = i / CONVD, c = i % CONVD;
        const float xc = bf2f(PROJ[(size_t)(RP + b) * PJ + C_XBC + c]);
        const float s0 = sconv[(size_t)(b * 3 + 0) * CONVD + c], s1 = sconv[(size_t)(b * 3 + 1) * CONVD + c], s2 = sconv[(size_t)(b * 3 + 2) * CONVD + c];
        XAS[i] = silu_f(cb[c] + s0 * cw[c] + s1 * cw[CONVD + c] + s2 * cw[2 * CONVD + c] + xc * cw[3 * CONVD + c]);
        float* oc = F.out + OUT_CONVS + (size_t)b * 3 * CONVD + c; oc[0] = s1; oc[CONVD] = s2; oc[2 * CONVD] = xc; }
    for (int i = blockIdx.x * NTHR + F.tid; i < NB * 3 * CONVD; i += F.G * NTHR) { const int b = i / (3 * CONVD), k = (i / CONVD) % 3, c = i % CONVD;
        F.out[OUT_CONVP + i] = bf2f(PROJ[(size_t)(b * TT + TT - 3 + k) * PJ + C_XBC + c]); }
}
#define MFMA32(a, b, c) __builtin_amdgcn_mfma_f32_32x32x16_bf16((a), (b), (c), 0, 0, 0)
#define MFMA16(a, b, c) __builtin_amdgcn_mfma_f32_16x16x32_bf16((a), (b), (c), 0, 0, 0)
__device__ __forceinline__ int crow(int reg, int hi) { return (reg & 3) + 8 * (reg >> 2) + 4 * hi; }
__device__ __forceinline__ bf16x8 pack8(const f32x16& x, int s) {
    v4u p; p.x = pk2(x[8 * s + 0], x[8 * s + 1]); p.y = pk2(x[8 * s + 2], x[8 * s + 3]); p.z = pk2(x[8 * s + 4], x[8 * s + 5]); p.w = pk2(x[8 * s + 6], x[8 * s + 7]);
    return __builtin_bit_cast(bf16x8, p);
}
__device__ __forceinline__ bf16x8 ld2x8(const bf16* p0, const bf16* p1) {
    const v2u a = *(const v2u*)p0, b = *(const v2u*)p1; v4u r; r.x = a.x; r.y = a.y; r.z = b.x; r.w = b.y; return __builtin_bit_cast(bf16x8, r);
}
__device__ __forceinline__ float softmax_ref(Frame& F) {
    const float* gqn = (const float*)F.in[20]; const float* gqr = (const float*)F.in[21]; const float* gkn = (const float*)F.in[22]; const float* gkr = (const float*)F.in[23];
    float a = fabsf(gqn[F.lane]), b = fabsf(gkn[F.lane]);
    if (F.lane < 16) { a = fmaxf(a, fabsf(gqr[F.lane])); b = fmaxf(b, fabsf(gkr[F.lane])); }
    return LOG2E * 9.797958971132712f * wave_max(a) * wave_max(b) * 1.0001f;
}
constexpr size_t WS_YS = 495 * MiB;
constexpr size_t WS_KS = 498 * MiB;
constexpr int NKT = 65;

__device__ __forceinline__ void p3_upproj_states(Frame& F) {
    const bf16* PROJ = (const bf16*)(F.ws + WS_PROJ); const bf16* WUQ = (const bf16*)(F.ws + WS_WUQ); const bf16* WUKV = (const bf16*)(F.ws + WS_WUKV);
    bf16* QRAW = (bf16*)(F.ws + WS_QRAW); bf16* KVRAW = (bf16*)(F.ws + WS_KVRAW);
    { pg8::Gemm g{PROJ + C_CQ, WUQ, MMAIN, 768, QL, 1, PJ}; pg8::StaticOrder S; S.init(MMAIN, 768, F.G, (int)blockIdx.x); EpiBf16 E{QRAW, 768, 1};
      pg8::gemm_phase<EpiBf16, pg8::StaticOrder, true, true>(F.lds + RING_OFF, g, S, E); }
    { pg8::Gemm g{PROJ + C_CKV, WUKV, MMAIN, 1024, KVL, 1, PJ}; pg8::StaticOrder S; S.init(MMAIN, 1024, F.G, (int)blockIdx.x); EpiBf16 E{KVRAW, 1024, 1};
      pg8::gemm_phase<EpiBf16, pg8::StaticOrder, true, true>(F.lds + RING_OFF, g, S, E); }
    const bool sub = (F.G == 256);
    const int sgw = sub ? (blockIdx.x - 192) * NWAVES + F.wave : F.gw, sngw = sub ? 64 * NWAVES : F.NGW;
    if (!sub || blockIdx.x >= 192) {
    small_gemm(PROJ + C_CQ, PJ, WUQ, QL, DB / 16, 768 / 16, [](int r) { return RP + r; },
        [&](const f32x4& acc, int rt, int ct, int lane) { const int col = ct * 16 + (lane & 15);
#pragma unroll
            for (int i = 0; i < 4; ++i) QRAW[(size_t)(RP + rt * 16 + 4 * (lane >> 4) + i) * 768 + col] = f2bf(acc[i]); }, sgw, sngw, F.lane);
    small_gemm(PROJ + C_CKV, PJ, WUKV, KVL, NS / 16, 1024 / 16, [](int r) { return small_arow(r); },
        [&](const f32x4& acc, int rt, int ct, int lane) { const int col = ct * 16 + (lane & 15);
#pragma unroll
            for (int i = 0; i < 4; ++i) { const int r = rt * 16 + 4 * (lane >> 4) + i; const bf16 v = f2bf(acc[i]);
                if (r < NMETA) { for (int b = 0; b < NB; ++b) KVRAW[(size_t)(b * TT + r) * 1024 + col] = v; } else KVRAW[(size_t)(RP + r - NMETA) * 1024 + col] = v; } }, sgw, sngw, F.lane);
    }
    const float* DT = (const float*)(F.ws + WS_DT); const float* a_log = (const float*)F.in[13];
    const bf16* XST = (const bf16*)(F.ws + WS_XST); const bf16* BT = (const bf16*)(F.ws + WS_BT);
    bf16* STATES = (bf16*)(F.ws + WS_STATES); float* DECAY = (float*)(F.ws + WS_DECAY);
    LAS float* wl = (LAS float*)(F.lds + RING_OFF + F.wave * 1024);
    const int r32 = F.lane & 31, hi = F.lane >> 5;
    for (int u = F.gw; u < NB * NCH * NH; u = sub ? ((u < F.NGW && F.gw >= 192 * NWAVES) ? F.NGW + (F.gw - 192 * NWAVES) : NB * NCH * NH) : u + F.NGW) {
        const int h = u % NH, c = (u / NH) % NCH, b = u / (NH * NCH); const int g = h >> 2;
        const int t = c * CHL - TOFF + F.lane;
        const float dt = (t >= 0) ? DT[(size_t)(b * TT + t) * 8 + h] : 0.f;
        const float A = -__expf(a_log[h]);
        float acs = dt * A;
#pragma unroll
        for (int o = 1; o < 64; o <<= 1) { const float v = __shfl_up(acs, o); if (F.lane >= o) acs += v; }
        const float last = __shfl(acs, 63);
        wl[F.lane] = __expf(last - acs) * dt;
        LDS_WAIT(); asm volatile("" ::: "memory");
        f32x16 acc[2][2];
#pragma unroll
        for (int i = 0; i < 2; ++i)
#pragma unroll
            for (int j = 0; j < 2; ++j) acc[i][j] = (f32x16){};
        const bf16* xb = XST + ((size_t)(b * SSDW + h * HP)) * TPAD + c * CHL; const bf16* bb = BT + ((size_t)(b * 128 + g * DS)) * TPAD + c * CHL;
#pragma unroll
        for (int s = 0; s < 4; ++s) {
            const f32x4 w0 = *(const LAS f32x4*)(wl + 16 * s + 8 * hi), w1 = *(const LAS f32x4*)(wl + 16 * s + 8 * hi + 4);
            bf16x8 af[2], bfr[2];
#pragma unroll
            for (int pt = 0; pt < 2; ++pt) { const v4u x = *(const v4u*)(xb + (size_t)(32 * pt + r32) * TPAD + 16 * s + 8 * hi);
                v4u y; y.x = pk2(bflo(x.x) * w0.x, bfhi(x.x) * w0.y); y.y = pk2(bflo(x.y) * w0.z, bfhi(x.y) * w0.w); y.z = pk2(bflo(x.z) * w1.x, bfhi(x.z) * w1.y); y.w = pk2(bflo(x.w) * w1.z, bfhi(x.w) * w1.w);
                af[pt] = __builtin_bit_cast(bf16x8, y); }
#pragma unroll
            for (int nt = 0; nt < 2; ++nt) bfr[nt] = *(const bf16x8*)(bb + (size_t)(32 * nt + r32) * TPAD + 16 * s + 8 * hi);
#pragma unroll
            for (int pt = 0; pt < 2; ++pt)
#pragma unroll
                for (int nt = 0; nt < 2; ++nt) acc[pt][nt] = MFMA32(af[pt], bfr[nt], acc[pt][nt]);
        }
        bf16* so = STATES + ((size_t)((b * NCH + c) * NH + h)) * 4096;
        const bool odd = (F.lane & 1) != 0;
#pragma unroll
        for (int pt = 0; pt < 2; ++pt)
#pragma unroll
            for (int nt = 0; nt < 2; ++nt)
#pragma unroll
                for (int r2 = 0; r2 < 8; ++r2) { const float oe = acc[pt][nt][2 * r2], oo = acc[pt][nt][2 * r2 + 1];
                    const float got = DPP_F(odd ? oe : oo, 0xB1);
                    const unsigned w = odd ? pk2(got, oo) : pk2(oe, got);
                    *(unsigned*)(so + (32 * pt + crow(2 * r2 + (odd ? 1 : 0), hi)) * 64 + 32 * nt + (r32 & ~1)) = w; }
        if (F.lane == 0) DECAY[(b * NCH + c) * NH + h] = __expf(last);
        LDS_WAIT(); asm volatile("" ::: "memory");
    }
}

#ifdef MK_TS
#define P4_STAMP(k) do { if (blockIdx.x == 0 && F.tid == 0) ((unsigned long long*)(F.ws + 600 * MiB))[20 + (k)] = __builtin_amdgcn_s_memrealtime(); } while (0)
#else
#define P4_STAMP(k) do { } while (0)
#endif
__device__ __forceinline__ void p4_post(Frame& F) {
    const bf16* QRAW = (const bf16*)(F.ws + WS_QRAW); const bf16* KVRAW = (const bf16*)(F.ws + WS_KVRAW); const float* KRF = (const float*)(F.ws + WS_KRF);
    bf16* Q = (bf16*)(F.ws + WS_Q); bf16* K = (bf16*)(F.ws + WS_K); bf16* VT = (bf16*)(F.ws + WS_VT); float* VS = (float*)(F.ws + WS_VS);
    const float* gqn = (const float*)F.in[20]; const float* gqr = (const float*)F.in[21]; const float* gkn = (const float*)F.in[22]; const float* gkr = (const float*)F.in[23];
    const float* ROPE = (const float*)(F.ws + WS_ROPE); const float* RQS = (const float*)(F.ws + WS_RQ);
    const int h = F.lane >> 3, sub = F.lane & 7;
    bf16* KS = (bf16*)(F.ws + WS_KS);
    for (int row = RP + (F.gw + F.NGW / 2) % F.NGW; row < R; row += F.NGW) {
        const int t = PAST;
        if (row >= RP) { const bf16* kp = KVRAW + (size_t)row * 1024 + 128 * h + 8 * sub; const v4u kw = *(const v4u*)kp; const v4u vw = *(const v4u*)(kp + 64);
          const f32x4 kr = *(const f32x4*)(KRF + (size_t)row * 32 + 4 * sub);
          const float rkv = RQS[R + row];
          float kn[8] = {bflo(kw.x) * rkv, bfhi(kw.x) * rkv, bflo(kw.y) * rkv, bfhi(kw.y) * rkv, bflo(kw.z) * rkv, bfhi(kw.z) * rkv, bflo(kw.w) * rkv, bfhi(kw.w) * rkv};
          float ss = (kr.x * kr.x + kr.y * kr.y) + (kr.z * kr.z + kr.w * kr.w);
#pragma unroll
          for (int e = 0; e < 8; ++e) ss += kn[e] * kn[e];
          ss = sum_x1(ss); ss = sum_x2(ss); ss = sum_x4(ss);
          const float rs = __builtin_amdgcn_rsqf(ss * (1.f / 96.f) + EPS);
          const float* gn = gkn + 8 * sub; v4u o; o.x = pk2(kn[0] * rs * gn[0], kn[1] * rs * gn[1]); o.y = pk2(kn[2] * rs * gn[2], kn[3] * rs * gn[3]); o.z = pk2(kn[4] * rs * gn[4], kn[5] * rs * gn[5]); o.w = pk2(kn[6] * rs * gn[6], kn[7] * rs * gn[7]);
          bf16* ko = KS + (size_t)(row - RP) * 768 + 96 * h; *(v4u*)(ko + 8 * sub) = o;
          const float* gr = gkr + ((4 * sub) & 15); v2u o2; o2.x = pk2(kr.x * rs * gr[0], kr.y * rs * gr[1]); o2.y = pk2(kr.z * rs * gr[2], kr.w * rs * gr[3]);
          *(v2u*)(ko + 64 + 4 * sub) = o2;
          const unsigned vv[4] = {vw.x, vw.y, vw.z, vw.w}; float* vs = VS + (size_t)(row - RP) * 512 + 64 * h + 8 * sub;
#pragma unroll
          for (int e = 0; e < 4; ++e) { vs[2 * e] = bflo(vv[e]) * rkv; vs[2 * e + 1] = bfhi(vv[e]) * rkv; } }
        if (row >= RP || t >= NMETA) {
            const bf16* qp = QRAW + (size_t)row * 768 + 96 * h; const v4u qw = *(const v4u*)(qp + 8 * sub);
            const unsigned r1 = *(const unsigned*)(qp + 64 + 2 * sub), r2 = *(const unsigned*)(qp + 80 + 2 * sub);
            float qn[8] = {bflo(qw.x), bfhi(qw.x), bflo(qw.y), bfhi(qw.y), bflo(qw.z), bfhi(qw.z), bflo(qw.w), bfhi(qw.w)};
            const f32x4 cs = *(const f32x4*)(ROPE + 2 * ((row < RP ? t : TT) * 16 + 2 * sub)); const float c0 = cs.x, s0 = cs.y, c1 = cs.z, s1 = cs.w;
            const float x10 = bflo(r1), x11 = bfhi(r1), x20 = bflo(r2), x21 = bfhi(r2);
            const float y10 = x10 * c0 - x20 * s0, y20 = x10 * s0 + x20 * c0, y11 = x11 * c1 - x21 * s1, y21 = x11 * s1 + x21 * c1;
            float ss = (y10 * y10 + y20 * y20) + (y11 * y11 + y21 * y21);
#pragma unroll
            for (int e = 0; e < 8; ++e) ss += qn[e] * qn[e];
            ss = sum_x1(ss); ss = sum_x2(ss); ss = sum_x4(ss);
            const float sq = RQS[row];
            const float rs = (ATTN_SCALE * LOG2E) * sq * __builtin_amdgcn_rsqf(ss * sq * sq * (1.f / 96.f) + EPS);
            const float* gn = gqn + 8 * sub; v4u o; o.x = pk2(qn[0] * rs * gn[0], qn[1] * rs * gn[1]); o.y = pk2(qn[2] * rs * gn[2], qn[3] * rs * gn[3]); o.z = pk2(qn[4] * rs * gn[4], qn[5] * rs * gn[5]); o.w = pk2(qn[6] * rs * gn[6], qn[7] * rs * gn[7]);
            bf16* qo = Q + (size_t)row * 768 + 96 * h; *(v4u*)(qo + 8 * sub) = o;
            const float g0 = gqr[2 * sub], g1 = gqr[2 * sub + 1];
            *(unsigned*)(qo + 64 + 2 * sub) = pk2(y10 * rs * g0, y11 * rs * g1); *(unsigned*)(qo + 80 + 2 * sub) = pk2(y20 * rs * g0, y21 * rs * g1);
        }
    }
    { bf16* KF = (bf16*)(F.ws + WS_K); bf16* VF = (bf16*)(F.ws + WS_VT);
      LAS unsigned char* vtile = F.lds + RING_OFF + F.wave * 4608;
      const int r8 = F.lane >> 3;
      const int nfull = (NB * NKT * NH) / F.NGW, rot = (F.gw + F.NGW - F.NGW / 4) % F.NGW;
      for (int i = 0; i <= nfull; ++i) { const int u = (i < nfull) ? i * F.NGW + F.gw : nfull * F.NGW + rot; if (u >= NB * NKT * NH) break;
          const int hh = u % NH, kt = (u / NH) % NKT, bb = u / (NH * NKT);
          bf16* kfb = KF + ((size_t)((bb * NH + hh) * NKT + kt)) * (6 * 512); bf16* vfb = VF + ((size_t)((bb * NH + hh) * NKT + kt)) * (4 * 512);
          v4u kwa[4], vwa[4]; f32x4 kra[4]; float rka[4];
#pragma unroll
          for (int i = 0; i < 4; ++i) { const int tk = kt * 32 + 8 * i + r8; const int tkc = tk < TT ? tk : TT - 1; rka[i] = RQS[R + bb * TT + tkc];
              const bf16* kp = KVRAW + (size_t)(bb * TT + tkc) * 1024 + 128 * hh + 8 * sub; kwa[i] = *(const v4u*)kp; vwa[i] = *(const v4u*)(kp + 64); kra[i] = *(const f32x4*)(KRF + (size_t)(bb * TT + tkc) * 32 + 4 * sub); }
#pragma unroll
          for (int i = 0; i < 4; ++i) {
              const int key = 8 * i + r8, tk = kt * 32 + key; v4u kw = kwa[i], vw = vwa[i]; f32x4 kr = kra[i];
              if (tk >= TT) { kw = (v4u){0u, 0u, 0u, 0u}; vw = kw; kr = (f32x4){0.f, 0.f, 0.f, 0.f}; }
              const float rkv = rka[i];
              float kn[8] = {bflo(kw.x) * rkv, bfhi(kw.x) * rkv, bflo(kw.y) * rkv, bfhi(kw.y) * rkv, bflo(kw.z) * rkv, bfhi(kw.z) * rkv, bflo(kw.w) * rkv, bfhi(kw.w) * rkv};
              vw.x = pk2(bflo(vw.x) * rkv, bfhi(vw.x) * rkv); vw.y = pk2(bflo(vw.y) * rkv, bfhi(vw.y) * rkv); vw.z = pk2(bflo(vw.z) * rkv, bfhi(vw.z) * rkv); vw.w = pk2(bflo(vw.w) * rkv, bfhi(vw.w) * rkv);
              float ss = (kr.x * kr.x + kr.y * kr.y) + (kr.z * kr.z + kr.w * kr.w);
#pragma unroll
              for (int e = 0; e < 8; ++e) ss += kn[e] * kn[e];
              ss = sum_x1(ss); ss = sum_x2(ss); ss = sum_x4(ss);
              const float rs = __builtin_amdgcn_rsqf(ss * (1.f / 96.f) + EPS);
              const float* gn = gkn + 8 * sub; v4u o; o.x = pk2(kn[0] * rs * gn[0], kn[1] * rs * gn[1]); o.y = pk2(kn[2] * rs * gn[2], kn[3] * rs * gn[3]); o.z = pk2(kn[4] * rs * gn[4], kn[5] * rs * gn[5]); o.w = pk2(kn[6] * rs * gn[6], kn[7] * rs * gn[7]);
              *(v4u*)(kfb + (sub >> 1) * 512 + ((sub & 1) * 32 + key) * 8) = o;
              const float* gr = gkr + ((4 * sub) & 15); v2u o2; o2.x = pk2(kr.x * rs * gr[0], kr.y * rs * gr[1]); o2.y = pk2(kr.z * rs * gr[2], kr.w * rs * gr[3]);
              *(v2u*)(kfb + (4 + (sub >> 2)) * 512 + (((sub >> 1) & 1) * 32 + key) * 8 + 4 * (sub & 1)) = o2;
              *(LAS v4u*)(vtile + key * 144 + sub * 16) = vw; }
          LDS_WAIT(); asm volatile("" ::: "memory");
          const int g = F.lane >> 4, q4 = (F.lane & 15) >> 2, pp = F.lane & 3;
          const unsigned a_lo = (unsigned)(uintptr_t)vtile + (unsigned)((4 * (g >> 1) + q4) * 144 + (16 * (g & 1) + 4 * pp) * 2);
#define VF_TR(dt, s2) do { s16x4 lo, hi4; \
              asm volatile("ds_read_b64_tr_b16 %0, %2 offset:%c3\n\tds_read_b64_tr_b16 %1, %2 offset:%c4\n\ts_waitcnt lgkmcnt(0)" : "=&v"(lo), "=&v"(hi4) : "v"(a_lo), "i"(16 * (s2) * 144 + 64 * (dt)), "i"(16 * (s2) * 144 + 64 * (dt) + 8 * 144) : "memory"); \
              v4u o; o.x = (unsigned)(unsigned short)lo[0] | ((unsigned)(unsigned short)lo[1] << 16); o.y = (unsigned)(unsigned short)lo[2] | ((unsigned)(unsigned short)lo[3] << 16); \
              o.z = (unsigned)(unsigned short)hi4[0] | ((unsigned)(unsigned short)hi4[1] << 16); o.w = (unsigned)(unsigned short)hi4[2] | ((unsigned)(unsigned short)hi4[3] << 16); \
              *(v4u*)(vfb + ((dt) * 2 + (s2)) * 512 + F.lane * 8) = o; } while (0)
          VF_TR(0, 0); VF_TR(0, 1); VF_TR(1, 0); VF_TR(1, 1);
#undef VF_TR
          LDS_WAIT(); asm volatile("" ::: "memory");
      } }
    P4_STAMP(0);
    const bf16* STATES = (const bf16*)(F.ws + WS_STATES); const float* DECAY = (const float*)(F.ws + WS_DECAY); bf16* HIN = (bf16*)(F.ws + WS_HIN);
    for (int e2 = blockIdx.x * NTHR + F.tid; e2 < NB * NH * 2048; e2 += F.G * NTHR) {
        const int e = 2 * e2; const int b = e / (NH * 4096), hh = (e / 4096) % NH, pn = e % 4096;
        float h0 = 0.f, h1 = 0.f;
        static_assert(NCH == 33, "three batches of 11 chunks");
        unsigned sa[11], sb[11]; float da[11], db[11];
#define CH_LOAD(ST, DC, c0) do { _Pragma("unroll") for (int j = 0; j < 11; ++j) { const int c = (c0) + j; ST[j] = *(const unsigned*)(STATES + ((size_t)((b * NCH + c) * NH + hh)) * 4096 + pn); DC[j] = DECAY[(b * NCH + c) * NH + hh]; } } while (0)
#define CH_STEP(ST, DC, c0) do { _Pragma("unroll") for (int j = 0; j < 11; ++j) { const int c = (c0) + j; *(unsigned*)(HIN + ((size_t)((b * NCH + c) * NH + hh)) * 4096 + pn) = pk2(h0, h1); h0 = h0 * DC[j] + bflo(ST[j]); h1 = h1 * DC[j] + bfhi(ST[j]); } } while (0)
        CH_LOAD(sa, da, 0); CH_LOAD(sb, db, 11);
        CH_STEP(sa, da, 0);
        CH_LOAD(sa, da, 22);
        CH_STEP(sb, db, 11);
        CH_STEP(sa, da, 22);
#undef CH_LOAD
#undef CH_STEP
        *(f32x2_t*)(F.out + OUT_SSMP + e) = (f32x2_t){h0, h1};
    }
    P4_STAMP(1);
    const float* XAS = (const float*)(F.ws + WS_XAS); const float* DT = (const float*)(F.ws + WS_DT); const float* sst = (const float*)F.in[5];
    const float* a_log = (const float*)F.in[13]; const float* d_skip = (const float*)F.in[14]; float* YS = (float*)(F.ws + WS_YS);
    for (int u = F.gw; u < DB * NH * 16; u += F.NGW) {
        const int pq = u & 15, hh = (u >> 4) & 7, b = u >> 7; const int g = hh >> 2; const int p = 4 * pq + (F.lane >> 4), n4 = F.lane & 15;
        const float dt = DT[(size_t)(RP + b) * 8 + hh]; const float a = __expf(dt * -__expf(a_log[hh]));
        const float x = XAS[(size_t)b * CONVD + hh * HP + p]; const float uu = dt * x;
        const f32x4 Bv = *(const f32x4*)(XAS + (size_t)b * CONVD + SSDW + g * DS + 4 * n4), Cv = *(const f32x4*)(XAS + (size_t)b * CONVD + SSDW + 128 + g * DS + 4 * n4);
        const size_t si = (((size_t)b * NH + hh) * HP + p) * DS + 4 * n4;
        const f32x4 s0 = *(const f32x4*)(sst + si); const f32x4 s1 = s0 * a + uu * Bv;
        *(f32x4*)(F.out + OUT_SSMS + si) = s1;
        float y = (Cv.x * s1.x + Cv.y * s1.y) + (Cv.z * s1.z + Cv.w * s1.w);
        y = sum_x1(y); y = sum_x2(y); y = sum_x4(y); y = sum_x8(y);
        if (n4 == 0) YS[(size_t)b * 512 + hh * HP + p] = y + d_skip[hh] * x;
    }
}
constexpr int DA_ROWB = 528;
constexpr int DA_LAT = 0, DA_KR = 128 * DA_ROWB, DA_PB = DA_KR + 128 * 33 * 4, DA_QG = DA_PB + 2 * 16 * 32 * 2, DA_END = DA_QG + 8 * 96 * 4;
constexpr int P5_EXCH = 100 * 1024;
static_assert(DA_END <= P5_EXCH, "LDS map of P5");

constexpr int AT_SLOT = 20480, AT_D = 4;
__device__ __forceinline__ void at_issue(Frame& F, const bf16* kt_k, const bf16* kt_v, LAS unsigned char* slot) {
    const int w = F.wave;
    __builtin_amdgcn_global_load_lds((const unsigned*)((const char*)kt_k + w * 1024 + F.lane * 16), (LAS unsigned*)(slot + w * 1024), 16, 0, 0);
    const char* srcB = (w < 4) ? (const char*)kt_k + 8192 + w * 1024 : (const char*)kt_v + (w - 4) * 1024;
    __builtin_amdgcn_global_load_lds((const unsigned*)(srcB + F.lane * 16), (LAS unsigned*)(slot + 8192 + w * 1024), 16, 0, 0);
    __builtin_amdgcn_global_load_lds((const unsigned*)((const char*)kt_v + 4096 + w * 256 + F.lane * 4), (LAS unsigned*)(slot + 16384 + w * 256), 4, 0, 0);
    __builtin_amdgcn_global_load_lds((const unsigned*)((const char*)kt_v + 6144 + w * 256 + F.lane * 4), (LAS unsigned*)(slot + 18432 + w * 256), 4, 0, 0);
}
__device__ __forceinline__ void p5_attn_prompt(Frame& F, float M0) {
    const bf16* QRAW = (const bf16*)(F.ws + WS_QRAW); const bf16* KF = (const bf16*)(F.ws + WS_K); const bf16* VF = (const bf16*)(F.ws + WS_VT); bf16* MIXA = (bf16*)(F.ws + WS_MIX); float* SSQ = (float*)(F.ws + WS_SSQ);
    const float* ROPE = (const float*)(F.ws + WS_ROPE); const float* gqn = (const float*)F.in[20]; const float* gqr = (const float*)F.in[21]; const float* RQS = (const float*)(F.ws + WS_RQ);
    LAS unsigned char* ring = F.lds + RING_OFF;
    const int w = F.wave, r32 = F.lane & 31, hi = F.lane >> 5;
    f32x16 negm;
#pragma unroll
    for (int i = 0; i < 16; ++i) negm[i] = -M0;
    for (int u = F.vcu; u < 256; u += F.G) {
        const int b = u >> 5, h = (u >> 2) & 7, pr = u & 3;
        const bf16* kfb = KF + ((size_t)((b * NH + h) * NKT)) * (6 * 512); const bf16* vfb = VF + ((size_t)((b * NH + h) * NKT)) * (4 * 512);
#pragma unroll 1
        for (int half = 0; half < 2; ++half) {
            const int qb = half ? 7 - pr : pr; const int a = 8 * qb + w; const int qi = NMETA + 32 * a + r32;
            const int nkt = 8 * qb + 9, nkw = a + 2;
            bf16x8 qf[6];
            { const bf16* qp = QRAW + (size_t)(b * TT + qi) * 768 + 96 * h + 8 * hi;
              v4u qw[6];
#pragma unroll
              for (int s = 0; s < 6; ++s) qw[s] = *(const v4u*)(qp + 16 * s);
              f32x4 cs[4];
#pragma unroll
              for (int i = 0; i < 4; ++i) cs[i] = *(const f32x4*)(ROPE + 2 * (qi * 16 + 8 * hi) + 4 * i);
              float qv[6][8]; float ss = 0.f;
#pragma unroll
              for (int s = 0; s < 6; ++s) { const unsigned ww[4] = {qw[s].x, qw[s].y, qw[s].z, qw[s].w};
#pragma unroll
                  for (int e = 0; e < 4; ++e) { qv[s][2 * e] = bflo(ww[e]); qv[s][2 * e + 1] = bfhi(ww[e]); ss += qv[s][2 * e] * qv[s][2 * e] + qv[s][2 * e + 1] * qv[s][2 * e + 1]; } }
              ss = sum_x32(ss);
              const float sq = RQS[b * TT + qi];
              const float rs = (ATTN_SCALE * LOG2E) * sq * __builtin_amdgcn_rsqf(ss * sq * sq * (1.f / 96.f) + EPS);
#pragma unroll
              for (int jj = 0; jj < 8; ++jj) { const float c = cs[jj >> 1][2 * (jj & 1)], sn = cs[jj >> 1][2 * (jj & 1) + 1]; const float x1 = qv[4][jj], x2 = qv[5][jj];
                  const float gr = gqr[8 * hi + jj] * rs; qv[4][jj] = (x1 * c - x2 * sn) * gr; qv[5][jj] = (x1 * sn + x2 * c) * gr; }
#pragma unroll
              for (int s = 0; s < 4; ++s) { const f32x4 g0 = *(const f32x4*)(gqn + 16 * s + 8 * hi), g1 = *(const f32x4*)(gqn + 16 * s + 8 * hi + 4);
                  qv[s][0] *= g0.x * rs; qv[s][1] *= g0.y * rs; qv[s][2] *= g0.z * rs; qv[s][3] *= g0.w * rs; qv[s][4] *= g1.x * rs; qv[s][5] *= g1.y * rs; qv[s][6] *= g1.z * rs; qv[s][7] *= g1.w * rs; }
#pragma unroll
              for (int s = 0; s < 6; ++s) { v4u o; o.x = pk2(qv[s][0], qv[s][1]); o.y = pk2(qv[s][2], qv[s][3]); o.z = pk2(qv[s][4], qv[s][5]); o.w = pk2(qv[s][6], qv[s][7]); qf[s] = __builtin_bit_cast(bf16x8, o); } }
            f32x16 o0 = (f32x16){}, o1 = (f32x16){}; float l = 0.f;
            const int ns = (nkt + 1) >> 1;
#pragma unroll
            for (int j = 0; j < AT_D - 1; ++j) at_issue(F, kfb + (size_t)j * 6144, vfb + (size_t)j * 4096, ring + j * AT_SLOT);
#pragma unroll 1
            for (int st = 0; st < ns; ++st) {
                const int rem = ns - 1 - st;
                if (rem >= 2) asm volatile("s_waitcnt vmcnt(8)" ::: "memory"); else if (rem == 1) asm volatile("s_waitcnt vmcnt(4)" ::: "memory"); else asm volatile("s_waitcnt vmcnt(0)" ::: "memory");
                __builtin_amdgcn_s_barrier(); asm volatile("" ::: "memory");
                if (st + AT_D - 1 < ns) at_issue(F, kfb + (size_t)(st + AT_D - 1) * 6144, vfb + (size_t)(st + AT_D - 1) * 4096, ring + ((st + AT_D - 1) & (AT_D - 1)) * AT_SLOT);
#pragma unroll
                for (int tt = 0; tt < 2; ++tt) { const int kt = 2 * st + tt;
                  if (kt < nkw) {
                    const LAS unsigned char* sl = ring + (st & (AT_D - 1)) * AT_SLOT + F.lane * 16; const int j0 = 32 * kt;
                    f32x16 S = negm;
#pragma unroll
                    for (int s = 0; s < 6; ++s) S = MFMA32(*(const LAS bf16x8*)(sl + tt * 6144 + 1024 * s), qf[s], S);
                    bf16x8 vf[4];
#pragma unroll
                    for (int i = 0; i < 4; ++i) vf[i] = *(const LAS bf16x8*)(sl + 12288 + tt * 4096 + 1024 * i);
#pragma unroll
                    for (int i = 0; i < 16; ++i) S[i] = __builtin_amdgcn_exp2f(S[i]);
                    if (kt >= a) {
#pragma unroll
                        for (int i = 0; i < 16; ++i) if (j0 + crow(i, hi) > qi) S[i] = 0.f; }
#pragma unroll
                    for (int i = 0; i < 16; ++i) l += S[i];
                    const bf16x8 p0 = pack8(S, 0), p1 = pack8(S, 1);
                    o0 = MFMA32(vf[0], p0, o0); o0 = MFMA32(vf[1], p1, o0);
                    o1 = MFMA32(vf[2], p0, o1); o1 = MFMA32(vf[3], p1, o1);
                  } }
            }
            l = sum_x32(l);
            const float il = __builtin_amdgcn_rcpf(l);
            bf16* ao = MIXA + (size_t)(b * TT + qi) * 1024 + 512 + 64 * h + 4 * hi; float ssq = 0.f;
#pragma unroll
            for (int gq = 0; gq < 4; ++gq) {
                v2u w0, w1; w0.x = pk2(o0[4 * gq] * il, o0[4 * gq + 1] * il); w0.y = pk2(o0[4 * gq + 2] * il, o0[4 * gq + 3] * il);
                w1.x = pk2(o1[4 * gq] * il, o1[4 * gq + 1] * il); w1.y = pk2(o1[4 * gq + 2] * il, o1[4 * gq + 3] * il);
                ssq += (bflo(w0.x) * bflo(w0.x) + bfhi(w0.x) * bfhi(w0.x)) + (bflo(w0.y) * bflo(w0.y) + bfhi(w0.y) * bfhi(w0.y));
                ssq += (bflo(w1.x) * bflo(w1.x) + bfhi(w1.x) * bfhi(w1.x)) + (bflo(w1.y) * bflo(w1.y) + bfhi(w1.y) * bfhi(w1.y));
                *(v2u*)(ao + 8 * gq) = w0; *(v2u*)(ao + 32 + 8 * gq) = w1; }
            ssq = sum_x32(ssq);
            if (hi == 0) SSQ[(size_t)(b * TT + qi) * 8 + h] = ssq;
            asm volatile("s_waitcnt lgkmcnt(0)" ::: "memory"); __builtin_amdgcn_s_barrier(); asm volatile("" ::: "memory");
        }
    }
}

constexpr int SO_X = 0, SO_H = 36864, SO_B = 73728, SO_C = 82944, SO_Z = 92160, SO_TAB = 125952, SO_EX = 130048;
static_assert(SO_EX + 1024 <= RING_BYTES, "ssd_out LDS map");
__device__ __forceinline__ void p5_ssd_out(Frame& F) {
    const float* DT = (const float*)(F.ws + WS_DT); const float* a_log = (const float*)F.in[13]; const float* d_skip = (const float*)F.in[14]; const float* ng = (const float*)F.in[15];
    const bf16* XST = (const bf16*)(F.ws + WS_XST); const bf16* BC = (const bf16*)(F.ws + WS_BC); const bf16* HIN = (const bf16*)(F.ws + WS_HIN); const bf16* PROJ = (const bf16*)(F.ws + WS_PROJ);
    bf16* MIX = (bf16*)(F.ws + WS_MIX);
    LAS unsigned char* L = F.lds + RING_OFF;
    LAS float* tab = (LAS float*)(L + SO_TAB) + F.wave * 128;
    LAS float* exch = (LAS float*)(L + SO_EX);
    const int hl = F.wave >> 1, it = F.wave & 1, r32 = F.lane & 31, hi = F.lane >> 5;
    for (int u = blockIdx.x; u < NB * (NCH - 1); u += F.G) {
        const int b = u / (NCH - 1), c = 1 + u % (NCH - 1); const int t0 = c * CHL - TOFF;
        v4u st[14];
#define SO_FETCH_A(g) do { \
        _Pragma("unroll") for (int k = 0; k < 4; ++k) { const int q = F.tid + NTHR * k; st[k] = *(const v4u*)(XST + ((size_t)(b * SSDW + (g) * 256 + (q >> 3))) * TPAD + c * CHL + 8 * (q & 7)); } } while (0)
#define SO_FETCH_B(g) do { \
        _Pragma("unroll") for (int k = 0; k < 4; ++k) { const int q = F.tid + NTHR * k; st[4 + k] = *(const v4u*)(HIN + ((size_t)((b * NCH + c) * NH + 4 * (g))) * 4096 + (size_t)q * 8); } \
        { const int q = F.tid; st[8] = *(const v4u*)(BC + (size_t)(b * TT + t0 + (q >> 3)) * 256 + (g) * DS + 8 * (q & 7)); st[9] = *(const v4u*)(BC + (size_t)(b * TT + t0 + (q >> 3)) * 256 + 128 + (g) * DS + 8 * (q & 7)); } \
        _Pragma("unroll") for (int k = 0; k < 4; ++k) { const int q = F.tid + NTHR * k; st[10 + k] = *(const v4u*)(PROJ + (size_t)(b * TT + t0 + (q >> 5)) * PJ + C_Z + (g) * 256 + 8 * (q & 31)); } } while (0)
#define SO_STORE() do { \
        _Pragma("unroll") for (int k = 0; k < 4; ++k) { const int q = F.tid + NTHR * k; *(LAS v4u*)(L + SO_X + (q >> 3) * 144 + 16 * (q & 7)) = st[k]; *(LAS v4u*)(L + SO_H + (q >> 3) * 144 + 16 * (q & 7)) = st[4 + k]; } \
        { const int q = F.tid; *(LAS v4u*)(L + SO_B + (q >> 3) * 144 + 16 * (q & 7)) = st[8]; *(LAS v4u*)(L + SO_C + (q >> 3) * 144 + 16 * (q & 7)) = st[9]; } \
        _Pragma("unroll") for (int k = 0; k < 4; ++k) { const int q = F.tid + NTHR * k; *(LAS v4u*)(L + SO_Z + (q >> 5) * 528 + 16 * (q & 31)) = st[10 + k]; } } while (0)
        SO_FETCH_A(0); SO_FETCH_B(0);
#pragma unroll 1
        for (int g = 0; g < 2; ++g) {
            const int h = 4 * g + hl; const float A = -__expf(a_log[h]), Dh = d_skip[h];
            { const int t = t0 + F.lane; const float dt = DT[(size_t)(b * TT + t) * 8 + h];
              float acs = dt * A;
#pragma unroll
              for (int o = 1; o < 64; o <<= 1) { const float v = __shfl_up(acs, o); if (F.lane >= o) acs += v; }
              tab[F.lane] = acs; tab[64 + F.lane] = dt; }
            SO_STORE();
            __syncthreads();
            if (g == 0) SO_FETCH_A(1);
            const int ii = 32 * it + r32; const int t = t0 + ii;
            bf16x8 cf[4];
#pragma unroll
            for (int s = 0; s < 4; ++s) cf[s] = *(const LAS bf16x8*)(L + SO_C + ii * 144 + 32 * s + 16 * hi);
            f32x16 y[2];
            const float ai = tab[ii]; const float ei = __expf(ai);
#pragma unroll
            for (int pt = 0; pt < 2; ++pt) { f32x16 acc = (f32x16){}; const LAS unsigned char* hp_ = L + SO_H + (hl * 64 + 32 * pt + r32) * 144 + 16 * hi;
#pragma unroll
                for (int s = 0; s < 4; ++s) acc = MFMA32(*(const LAS bf16x8*)(hp_ + 32 * s), cf[s], acc);
#pragma unroll
                for (int i = 0; i < 16; ++i) acc[i] *= ei;
                y[pt] = acc; }
#pragma unroll 1
            for (int jt = 0; jt <= it; ++jt) {
                f32x16 S = (f32x16){};
                { const LAS unsigned char* bp_ = L + SO_B + (32 * jt + r32) * 144 + 16 * hi;
#pragma unroll
                  for (int s = 0; s < 4; ++s) S = MFMA32(*(const LAS bf16x8*)(bp_ + 32 * s), cf[s], S); }
#pragma unroll
                for (int i = 0; i < 16; ++i) { const int jj = 32 * jt + crow(i, hi); const float e = (jj <= ii) ? __expf(ai - tab[jj]) * tab[64 + jj] : 0.f; S[i] = S[i] * e + ((jj == ii) ? Dh : 0.f); }
                const bf16x8 p0 = pack8(S, 0), p1 = pack8(S, 1);
#pragma unroll
                for (int pt = 0; pt < 2; ++pt) { const LAS unsigned char* xp_ = L + SO_X + (hl * 64 + 32 * pt + r32) * 144 + (32 * jt + 4 * hi) * 2;
                    const v2u x0 = *(const LAS v2u*)(xp_), x1 = *(const LAS v2u*)(xp_ + 16), x2 = *(const LAS v2u*)(xp_ + 32), x3 = *(const LAS v2u*)(xp_ + 48);
                    v4u f0, f1; f0.x = x0.x; f0.y = x0.y; f0.z = x1.x; f0.w = x1.y; f1.x = x2.x; f1.y = x2.y; f1.z = x3.x; f1.w = x3.y;
                    y[pt] = MFMA32(__builtin_bit_cast(bf16x8, f0), p0, y[pt]); y[pt] = MFMA32(__builtin_bit_cast(bf16x8, f1), p1, y[pt]); }
            }
            float ss = 0.f;
            { const LAS unsigned char* zp_ = L + SO_Z + ii * 528 + (hl * 64 + 4 * hi) * 2;
#pragma unroll
              for (int pt = 0; pt < 2; ++pt)
#pragma unroll
                for (int gq = 0; gq < 4; ++gq) { const v2u zw = *(const LAS v2u*)(zp_ + (32 * pt + 8 * gq) * 2); const float zz[4] = {bflo(zw.x), bfhi(zw.x), bflo(zw.y), bfhi(zw.y)};
#pragma unroll
                    for (int e = 0; e < 4; ++e) { const float v = y[pt][4 * gq + e] * silu_f(zz[e]); y[pt][4 * gq + e] = v; ss += v * v; } } }
            ss = sum_x32(ss);
            if (g == 0) SO_FETCH_B(1);
            LAS float* ex = exch + it * 128;
            if (hi == 0) ex[hl * 32 + r32] = ss;
            __syncthreads();
            const float tot = (ex[r32] + ex[32 + r32]) + (ex[64 + r32] + ex[96 + r32]);
            const float rs = __builtin_amdgcn_rsqf(tot * (1.f / 256.f) + EPS);
            { bf16* mo = MIX + (size_t)(b * TT + t) * 1024 + 64 * h + 4 * hi;
#pragma unroll
              for (int pt = 0; pt < 2; ++pt)
#pragma unroll
                for (int gq = 0; gq < 4; ++gq) { const f32x4 gg = *(const f32x4*)(ng + 64 * h + 32 * pt + 8 * gq + 4 * hi);
                    v2u w; w.x = pk2(y[pt][4 * gq] * rs * gg.x, y[pt][4 * gq + 1] * rs * gg.y); w.y = pk2(y[pt][4 * gq + 2] * rs * gg.z, y[pt][4 * gq + 3] * rs * gg.w);
                    *(v2u*)(mo + 32 * pt + 8 * gq) = w; } }
        }
#undef SO_FETCH_A
#undef SO_FETCH_B
#undef SO_STORE
        __syncthreads();
    }
    const float* YS = (const float*)(F.ws + WS_YS);
    for (int u = F.gw; u < DB * NG; u += F.NGW) { const int b = u >> 1, gg = u & 1; const int cc = gg * 256 + 4 * F.lane;
        const f32x4 yv = *(const f32x4*)(YS + (size_t)b * 512 + cc); const v2u zw = *(const v2u*)(PROJ + (size_t)(RP + b) * PJ + C_Z + cc);
        const f32x4 v = {yv.x * silu_f(bflo(zw.x)), yv.y * silu_f(bfhi(zw.x)), yv.z * silu_f(bflo(zw.y)), yv.w * silu_f(bfhi(zw.y))};
        const float rs = __builtin_amdgcn_rsqf(wave_sum((v.x * v.x + v.y * v.y) + (v.z * v.z + v.w * v.w)) * (1.f / 256.f) + EPS);
        const f32x4 gv = *(const f32x4*)(ng + cc); v2u w; w.x = pk2(v.x * rs * gv.x, v.y * rs * gv.y); w.y = pk2(v.z * rs * gv.z, v.w * rs * gv.w);
        *(v2u*)(MIX + (size_t)(RP + b) * 1024 + cc) = w; }
}

constexpr int DB_STAGE = 0, DB_KRST = 65536, DB_LAT = DB_KRST + 8192, DB_KR = DB_LAT + 64 * DA_ROWB, DB_PB = DB_KR + 64 * 36 * 4, DB_QG = DB_PB + 16 * 64 * 2, DB_END = DB_QG + 8 * 96 * 4;
static_assert(DB_END <= RING_BYTES, "decode attention LDS map");
#define RAW_BAR_L() do { asm volatile("s_waitcnt lgkmcnt(0)" ::: "memory"); __builtin_amdgcn_s_barrier(); asm volatile("" ::: "memory"); } while (0)
#define RAW_BAR_VL() do { asm volatile("s_waitcnt vmcnt(0) lgkmcnt(0)" ::: "memory"); __builtin_amdgcn_s_barrier(); asm volatile("" ::: "memory"); } while (0)
__device__ __forceinline__ void da_issue(Frame& F, LAS unsigned char* L, const float* clat, const float* ckr, const int* ptab, int b, int split, int hp) {
    const size_t tok0 = (size_t)ptab[b * NPAGES + split * 32 + (hp >> 1)] * PAGE + (hp & 1) * 64;
    const char* src = (const char*)(clat + tok0 * KVL) + (size_t)(F.wave * 8) * 1024 + F.lane * 16;
#pragma unroll
    for (int i = 0; i < 8; ++i) __builtin_amdgcn_global_load_lds((const unsigned*)(src + i * 1024), (LAS unsigned*)(L + DB_STAGE + (F.wave * 8 + i) * 1024), 16, 0, 0);
    __builtin_amdgcn_global_load_lds((const unsigned*)((const char*)(ckr + tok0 * 32) + F.wave * 1024 + F.lane * 16), (LAS unsigned*)(L + DB_KRST + F.wave * 1024), 16, 0, 0);
}
__device__ __forceinline__ void da_convert(Frame& F, LAS unsigned char* L) {
#pragma unroll 4
    for (int k = 0; k < 8; ++k) { const int f = F.tid + NTHR * k; const int row = f >> 6, c4 = f & 63; const f32x4 v = *(const LAS f32x4*)(L + DB_STAGE + f * 16);
        v2u w; w.x = pk2(v.x, v.y); w.y = pk2(v.z, v.w); *(LAS v2u*)(L + DB_LAT + row * DA_ROWB + c4 * 8) = w; }
    { const int f = F.tid; const int row = f >> 3, c4 = f & 7; const f32x4 v = *(const LAS f32x4*)(L + DB_KRST + f * 16);
      *(LAS f32x4*)((LAS float*)(L + DB_KR) + row * 36 + 4 * c4) = v; }
}
__device__ __forceinline__ void st_wt(float* p, float v) { asm volatile("global_store_dword %0, %1, off sc0 sc1" :: "v"(p), "v"(v) : "memory"); }
__device__ __forceinline__ void decode_combine_one(Frame& F, float M0, int b) {
    const float* DPART = (const float*)(F.ws + WS_DPART); const bf16* WUKV = (const bf16*)(F.ws + WS_WUKV2); const bf16* Q = (const bf16*)(F.ws + WS_Q); const bf16* KS = (const bf16*)(F.ws + WS_KS);
    const float* VS = (const float*)(F.ws + WS_VS); bf16* MIX = (bf16*)(F.ws + WS_MIX);
    LAS float* accl = (LAS float*)(F.lds + RING_OFF) + F.wave * 256; LAS float* exch = (LAS float*)(F.lds + P5_EXCH);
    const int h = F.wave;
    const float* p0 = DPART + ((size_t)((b * 2 + 0) * NH + h)) * 264; const float* p1 = DPART + ((size_t)((b * 2 + 1) * NH + h)) * 264;
#pragma unroll
    for (int k = 0; k < 4; ++k) accl[F.lane + 64 * k] = p0[F.lane + 64 * k] + p1[F.lane + 64 * k];
    float l = p0[256] + p1[256];
    const bf16* qp = Q + (size_t)(RP + b) * 768 + 96 * h; const bf16* kp = KS + (size_t)b * 768 + 96 * h;
    float sd = bf2f(qp[F.lane]) * bf2f(kp[F.lane]); if (F.lane < 32) sd += bf2f(qp[64 + F.lane]) * bf2f(kp[64 + F.lane]);
    sd = wave_sum(sd);
    const float pn = __builtin_amdgcn_exp2f(sd - M0); l += pn;
    LDS_WAIT(); asm volatile("" ::: "memory");
    const bf16* wv = WUKV + (size_t)(128 * h + 64 + F.lane) * KVL;
    float o = 0.f;
    { v4u wv4[32];
#pragma unroll
      for (int c8 = 0; c8 < 32; ++c8) wv4[c8] = *(const v4u*)(wv + 8 * c8);
#pragma unroll
      for (int c8 = 0; c8 < 32; ++c8) { const v4u w = wv4[c8]; const f32x4 x0 = *(const LAS f32x4*)(accl + 8 * c8), x1 = *(const LAS f32x4*)(accl + 8 * c8 + 4);
        o += (bflo(w.x) * x0.x + bfhi(w.x) * x0.y) + (bflo(w.y) * x0.z + bfhi(w.y) * x0.w) + (bflo(w.z) * x1.x + bfhi(w.z) * x1.y) + (bflo(w.w) * x1.z + bfhi(w.w) * x1.w); } }
    o = (o + pn * VS[(size_t)b * 512 + 64 * h + F.lane]) * __builtin_amdgcn_rcpf(l);
    const float ss = wave_sum(o * o);
    if (F.lane == 0) exch[h] = ss;
    __syncthreads();
    float tot = 0.f;
#pragma unroll
    for (int hh = 0; hh < NH; ++hh) tot += exch[hh];
    const float rs = __builtin_amdgcn_rsqf(tot * (1.f / MLAW) + EPS);
    MIX[(size_t)(RP + b) * 1024 + 512 + 64 * h + F.lane] = f2bf(o * rs);
    __syncthreads();
}
template <int MODE>
__device__ __forceinline__ void p5_attn_decode_t(Frame& F, float M0) {
    const float* clat = (const float*)F.in[2]; const float* ckr = (const float*)F.in[3]; const int* ptab = (const int*)F.in[6];
    const bf16* WUKV = (const bf16*)(F.ws + WS_WUKV2); const bf16* Q = (const bf16*)(F.ws + WS_Q); const float* gkn = (const float*)F.in[22]; const float* gkr = (const float*)F.in[23];
    float* DPART = (float*)(F.ws + WS_DPART);
    LAS unsigned char* L = F.lds + RING_OFF;
    LAS float* krl = (LAS float*)(L + DB_KR); LAS bf16* pb = (LAS bf16*)(L + DB_PB); LAS float* qg = (LAS float*)(L + DB_QG) + F.wave * 96;
    const int h = F.wave, r32 = F.lane & 31, hi = F.lane >> 5;
    for (int u = blockIdx.x; u < DB * 2; u += F.G) {
        const int b = u >> 1, split = u & 1;
        da_issue(F, L, clat, ckr, ptab, b, split, 0);
        bf16x8 wf[4][8];
#pragma unroll
        for (int dt = 0; dt < 4; ++dt)
#pragma unroll
            for (int s = 0; s < 8; ++s) wf[dt][s] = *(const bf16x8*)(WUKV + (size_t)(128 * h + 16 * dt + (F.lane & 15)) * KVL + 32 * s + 8 * (F.lane >> 4));
        { const bf16* qp = Q + (size_t)(RP + b) * 768 + 96 * h; qg[F.lane] = bf2f(qp[F.lane]) * gkn[F.lane]; if (F.lane < 32) qg[64 + F.lane] = bf2f(qp[64 + F.lane]) * gkr[F.lane & 15]; }
        for (int i = F.tid; i < 16 * 64; i += NTHR) pb[i] = 0;
        f32x4 ao[2] = {(f32x4){0.f, 0.f, 0.f, 0.f}, (f32x4){0.f, 0.f, 0.f, 0.f}}; float l = 0.f;
        RAW_BAR_VL();
        da_convert(F, L);
        RAW_BAR_L();
        da_issue(F, L, clat, ckr, ptab, b, split, 1);
#pragma unroll 1
        for (int hp = 0; hp < 64; ++hp) {
          if (MODE == 0 || MODE == 3) {
            const int n16 = F.lane & 15, kg4 = F.lane >> 4;
#pragma unroll 1
            for (int sb = 0; sb < 2; ++sb) {
                const LAS unsigned char* bp = L + DB_LAT + (32 * sb + n16) * DA_ROWB + 16 * kg4;
                f32x4 acc[4][2];
#pragma unroll
                for (int dt = 0; dt < 4; ++dt) { acc[dt][0] = (f32x4){0.f, 0.f, 0.f, 0.f}; acc[dt][1] = acc[dt][0]; }
                bf16x8 fa[2], fb[2];
                fa[0] = *(const LAS bf16x8*)(bp); fa[1] = *(const LAS bf16x8*)(bp + 16 * DA_ROWB);
#pragma unroll
                for (int s = 0; s < 8; ++s) {
                    if (s < 7) { fb[0] = *(const LAS bf16x8*)(bp + 64 * (s + 1)); fb[1] = *(const LAS bf16x8*)(bp + 16 * DA_ROWB + 64 * (s + 1)); }
#pragma unroll
                    for (int dt = 0; dt < 4; ++dt) { acc[dt][0] = MFMA16(wf[dt][s], fa[0], acc[dt][0]); acc[dt][1] = MFMA16(wf[dt][s], fa[1], acc[dt][1]); }
                    fa[0] = fb[0]; fa[1] = fb[1];
                }
                __builtin_amdgcn_sched_barrier(0);
                f32x4 s4[2] = {(f32x4){0.f, 0.f, 0.f, 0.f}, (f32x4){0.f, 0.f, 0.f, 0.f}}, d4[2] = {s4[0], s4[0]};
#pragma unroll
                for (int dt = 0; dt < 4; ++dt) { const f32x4 qq = *(const LAS f32x4*)(qg + 16 * dt + 4 * kg4);
#pragma unroll
                    for (int tt = 0; tt < 2; ++tt) { s4[tt] += acc[dt][tt] * acc[dt][tt]; d4[tt] += acc[dt][tt] * qq; } }
                { const LAS float* qr = qg + 64 + 8 * kg4; const f32x4 q0 = *(const LAS f32x4*)(qr), q1 = *(const LAS f32x4*)(qr + 4);
#pragma unroll
                  for (int tt = 0; tt < 2; ++tt) { const LAS float* kr = krl + (32 * sb + 16 * tt + n16) * 36 + 8 * kg4; const f32x4 k0 = *(const LAS f32x4*)(kr), k1 = *(const LAS f32x4*)(kr + 4);
                      s4[tt] += k0 * k0; s4[tt] += k1 * k1; d4[tt] += k0 * q0; d4[tt] += k1 * q1; } }
                __builtin_amdgcn_sched_barrier(0);
#pragma unroll
                for (int tt = 0; tt < 2; ++tt) { float ss = (s4[tt].x + s4[tt].y) + (s4[tt].z + s4[tt].w), dot = (d4[tt].x + d4[tt].y) + (d4[tt].z + d4[tt].w);
                    ss = sum_x16(ss); dot = sum_x16(dot); ss = sum_x32(ss); dot = sum_x32(dot);
                    const float p = __builtin_amdgcn_exp2f(dot * __builtin_amdgcn_rsqf(ss * (1.f / 96.f) + EPS) - M0);
                    if (kg4 == 0) { l += p; pb[h * 64 + 32 * sb + 16 * tt + n16] = f2bf(p); } }
            }
            RAW_BAR_L();
            if (MODE < 4) { const int q4 = (F.lane & 15) >> 2, pp = F.lane & 3, kg = F.lane >> 4;
              const unsigned a_lo = (unsigned)(uintptr_t)(L + DB_LAT) + (unsigned)((8 * kg + q4) * DA_ROWB + (32 * h + 4 * pp) * 2);
              const LAS bf16* pap = pb + (F.lane & 15) * 64 + 8 * kg;
              s16x4 t0, t1, t2, t3, t4, t5, t6, t7;
              asm volatile("ds_read_b64_tr_b16 %0, %8 offset:%c9\n\tds_read_b64_tr_b16 %1, %8 offset:%c10\n\tds_read_b64_tr_b16 %2, %8 offset:%c11\n\tds_read_b64_tr_b16 %3, %8 offset:%c12\n\t"
                           "ds_read_b64_tr_b16 %4, %8 offset:%c13\n\tds_read_b64_tr_b16 %5, %8 offset:%c14\n\tds_read_b64_tr_b16 %6, %8 offset:%c15\n\tds_read_b64_tr_b16 %7, %8 offset:%c16\n\ts_waitcnt lgkmcnt(0)"
                           : "=&v"(t0), "=&v"(t1), "=&v"(t2), "=&v"(t3), "=&v"(t4), "=&v"(t5), "=&v"(t6), "=&v"(t7)
                           : "v"(a_lo), "i"(0), "i"(4 * DA_ROWB), "i"(32), "i"(32 + 4 * DA_ROWB), "i"(32 * DA_ROWB), "i"(32 * DA_ROWB + 4 * DA_ROWB), "i"(32 * DA_ROWB + 32), "i"(32 * DA_ROWB + 32 + 4 * DA_ROWB) : "memory");
              const bf16x8 pa0 = *(const LAS bf16x8*)(pap), pa1 = *(const LAS bf16x8*)(pap + 32);
#define DA_FR(x, y) ((bf16x8){x[0], x[1], x[2], x[3], y[0], y[1], y[2], y[3]})
              ao[0] = MFMA16(pa0, DA_FR(t0, t1), ao[0]); ao[1] = MFMA16(pa0, DA_FR(t2, t3), ao[1]);
              ao[0] = MFMA16(pa1, DA_FR(t4, t5), ao[0]); ao[1] = MFMA16(pa1, DA_FR(t6, t7), ao[1]);
#undef DA_FR
#define DA_PV(ks, nt) do { } while (0)
#undef DA_PV
            }
          }
            RAW_BAR_VL();
            if (hp + 1 < 64) { if (MODE <= 1 || MODE >= 3) da_convert(F, L); RAW_BAR_L(); if (hp + 2 < 64 && MODE < 3) da_issue(F, L, clat, ckr, ptab, b, split, hp + 2); }
        }
        if (MODE >= 3 && l == 123.456f) DPART[0] = l;
        if (MODE == 0) { const int kg = F.lane >> 4;
          if (kg < 2) {
#pragma unroll
              for (int nt = 0; nt < 2; ++nt)
#pragma unroll
                  for (int i = 0; i < 4; ++i) st_wt(&DPART[((size_t)((b * 2 + split) * NH + 4 * kg + i)) * 264 + 32 * h + 16 * nt + (F.lane & 15)], ao[nt][i]); }
          float lt = wave_sum(l);
          if (F.lane == 0) st_wt(&DPART[((size_t)((b * 2 + split) * NH + h)) * 264 + 256], lt); }
        asm volatile("s_waitcnt vmcnt(0)" ::: "memory");
        __syncthreads();
        { volatile LAS unsigned* arr = (volatile LAS unsigned*)(F.lds + MISC_OFF) + 16;
          if (F.tid == 0) {
              __builtin_amdgcn_fence(__ATOMIC_ACQUIRE, "agent");
              const unsigned old = __hip_atomic_fetch_add((unsigned*)(F.ws + WS_CTL) + CW_DCNT + b, 1u, __ATOMIC_RELAXED, __HIP_MEMORY_SCOPE_AGENT);
              arr[0] = old; }
          __syncthreads();
          if (MODE == 0 && arr[0] == 1u) decode_combine_one(F, M0, b);
          __syncthreads(); }
    }
}

__device__ __forceinline__ void p5_attn_decode(Frame& F, float M0) { p5_attn_decode_t<0>(F, M0); }

__device__ __forceinline__ void p7_outproj(Frame& F) {
    const bf16* MIX = (const bf16*)(F.ws + WS_MIX); const bf16* WOUT = (const bf16*)(F.ws + WS_WOUT); const float* xp = (const float*)F.in[0]; const float* xs = (const float*)F.in[1]; float* HS = (float*)(F.ws + WS_HS);
    bf16* HB = (bf16*)(F.ws + WS_XN); float* SS = (float*)(F.ws + WS_SSP); float* ysamp = F.out + OUT_YS;
    { pg8::Gemm g{MIX, WOUT, MMAIN, DM, 1024, 1, 1024}; pg8::StaticOrder S; S.init(MMAIN, DM, F.G, (int)blockIdx.x);
      LAS float* RS = (LAS float*)(F.lds + LDSCTL_OFF + 1024); const float* SSQ = (const float*)(F.ws + WS_SSQ);
#pragma unroll 1
      for (int i = 0; i < 8; ++i) { pg8::Unit uu; if (!S.next(i, uu)) break;
          int tl = (int)threadIdx.x; asm volatile("" : "+v"(tl));
          if (tl < 256) { const pg8::f32x4* sp = (const pg8::f32x4*)(SSQ + (size_t)(g.rowbase(uu.pm) + tl) * 8); const pg8::f32x4 s4 = sp[0] + sp[1];
              RS[i * 256 + tl] = __builtin_amdgcn_rsqf(((s4[0] + s4[1]) + (s4[2] + s4[3])) * (1.f / MLAW) + EPS); } }
      __syncthreads();
      EpiOutProj E{xp, F.out + OUT_YP, HB, SS, RS, 0};
      pg8::gemm_phase<EpiOutProj, pg8::StaticOrder, true, true, 8>(F.lds + RING_OFF, g, S, E); }
    { LAS f32x4* part = (LAS f32x4*)(F.lds + RING_OFF);
      for (int tp = blockIdx.x; tp < 256; tp += F.G) {
          const int t = 2 * tp + (F.wave >> 2), kq = F.wave & 3, rt = t & 7, ct = t >> 3;
          const bf16* ap = MIX + (size_t)(RP + rt * 16 + (F.lane & 15)) * 1024 + 256 * kq + 8 * (F.lane >> 4);
          const bf16* bp = WOUT + (size_t)(ct * 16 + (F.lane & 15)) * 1024 + 256 * kq + 8 * (F.lane >> 4);
          bf16x8 av[8], bv[8];
#pragma unroll
          for (int j = 0; j < 8; ++j) { av[j] = *(const bf16x8*)(ap + 32 * j); bv[j] = *(const bf16x8*)(bp + 32 * j); }
          f32x4 acc = {0.f, 0.f, 0.f, 0.f};
#pragma unroll
          for (int j = 0; j < 8; ++j) acc = MFMA16(av[j], bv[j], acc);
          part[F.wave * 64 + F.lane] = acc;
          __syncthreads();
          if (kq == 0) { acc = (acc + part[(F.wave + 1) * 64 + F.lane]) + (part[(F.wave + 2) * 64 + F.lane] + part[(F.wave + 3) * 64 + F.lane]);
              const int col = ct * 16 + (F.lane & 15);
#pragma unroll
              for (int i = 0; i < 4; ++i) { const int r = rt * 16 + 4 * (F.lane >> 4) + i; const size_t o = (size_t)r * DM + col; const float v = xs[o] + acc[i]; HS[o] = v; ysamp[o] = v; HB[(size_t)(RP + r) * DM + col] = f2bf(v);
                  float ss = v * v; ss = sum_x1(ss); ss = sum_x2(ss); ss = sum_x4(ss); ss = sum_x8(ss);
                  if ((F.lane & 15) == 0) SS[(size_t)MMAIN * 16 + (size_t)r * 64 + ct] = ss; } }
          __syncthreads();
      } }
}
__device__ __forceinline__ void p9_gateup(Frame& F) {
    const bf16* HB = (const bf16*)(F.ws + WS_XN); const bf16* WGU = (const bf16*)(F.ws + WS_WGU); bf16* ACT = (bf16*)(F.ws + WS_ACT); const float* SS = (const float*)(F.ws + WS_SSP);
    { pg8::Gemm g{HB, WGU, MMAIN, 2 * DFF, DM, 1, DM}; pg8::StaticOrder S; S.init(MMAIN, 2 * DFF, F.G, (int)blockIdx.x);
      LAS float* RS = (LAS float*)(F.lds + LDSCTL_OFF + 1024);
      int pm_prev = -1;
#pragma unroll 1
      for (int i = 0; i < 8; ++i) { pg8::Unit uu; if (!S.next(i, uu)) break;
          int tl = (int)threadIdx.x; asm volatile("" : "+v"(tl));
          if (tl < 256) {
              if (uu.pm == pm_prev) RS[i * 256 + tl] = RS[(i - 1) * 256 + tl];
              else { const pg8::f32x4* sp = (const pg8::f32x4*)(SS + (size_t)(uu.pm * 256 + tl) * 16); const pg8::f32x4 s4 = (sp[0] + sp[1]) + (sp[2] + sp[3]);
                  RS[i * 256 + tl] = __builtin_amdgcn_rsqf(((s4[0] + s4[1]) + (s4[2] + s4[3])) * (1.f / DM) + EPS); } }
          pm_prev = uu.pm; }
      __syncthreads();
      EpiSwiGLU E{ACT, RS, 0};
      pg8::gemm_phase<EpiSwiGLU, pg8::StaticOrder, true, true>(F.lds + RING_OFF, g, S, E); }
    const int gw = F.gw, ngw = F.NGW;
    const int nrt = DB / 16, nlt = DFF / 16;
    for (int task = gw; task < nrt * nlt; task += ngw) {
        const int rt = task % nrt, lt = task / nrt; const int lc = lt * 16 + (F.lane & 15);
        const bf16* ap = HB + (size_t)(RP + rt * 16 + (F.lane & 15)) * DM + 8 * (F.lane >> 4);
        const bf16* gp = WGU + (size_t)(256 * (lc >> 7) + (lc & 127)) * DM + 8 * (F.lane >> 4); const bf16* up = gp + (size_t)128 * DM;
        f32x4 ag = {0.f, 0.f, 0.f, 0.f}, au = {0.f, 0.f, 0.f, 0.f};
#pragma unroll 8
        for (int k0 = 0; k0 < DM; k0 += 32) { const bf16x8 a = *(const bf16x8*)(ap + k0); ag = MFMA16(a, *(const bf16x8*)(gp + k0), ag); au = MFMA16(a, *(const bf16x8*)(up + k0), au); }
#pragma unroll
        for (int i = 0; i < 4; ++i) { const int r = rt * 16 + 4 * (F.lane >> 4) + i; const f32x4* sp = (const f32x4*)(SS + (size_t)MMAIN * 16 + (size_t)r * 64); f32x4 s4 = sp[0];
#pragma unroll
            for (int q = 1; q < 16; ++q) s4 += sp[q];
            const float rs = __builtin_amdgcn_rsqf(((s4[0] + s4[1]) + (s4[2] + s4[3])) * (1.f / DM) + EPS);
            ACT[(size_t)(RP + r) * DFF + lc] = f2bf(silu_f(rs * ag[i]) * (rs * au[i])); }
    }
}
__device__ __forceinline__ void p10_down(Frame& F) {
    const bf16* ACT = (const bf16*)(F.ws + WS_ACT); const bf16* WDN = (const bf16*)(F.ws + WS_WDN); const float* HS = (const float*)(F.ws + WS_HS);
    { pg8::Gemm g{ACT, WDN, MMAIN, DM, DFF, 1, DFF}; pg8::StaticOrder S; S.init(MMAIN, DM, F.G, (int)blockIdx.x); EpiDown E{(const bf16*)(F.ws + WS_XN), F.out + OUT_YP};
      pg8::gemm_phase<EpiDown, pg8::StaticOrder, true, true>(F.lds + RING_OFF, g, S, E); }
    float* ys = F.out + OUT_YS;
    small_gemm(ACT, DFF, WDN, DFF, DB / 16, DM / 16, [](int r) { return RP + r; },
        [&](const f32x4& acc, int rt, int ct, int lane) { const int col = ct * 16 + (lane & 15);
#pragma unroll
            for (int i = 0; i < 4; ++i) atomicAdd(ys + (size_t)(rt * 16 + 4 * (lane >> 4) + i) * DM + col, acc[i]); }, F.gw, F.NGW, F.lane, 4);
}
#ifndef MK_ONE_LAUNCH
#define MK_ONE_LAUNCH 0
#endif
constexpr int N_PHASES = 9;
__global__ void __launch_bounds__(NTHR, 2) mk_fwd(Args args) {
    extern __shared__ __attribute__((aligned(16))) unsigned char lds_raw[];
    Frame F;
    F.lds = (LAS unsigned char*)lds_raw;
    F.tid = threadIdx.x; F.lane = F.tid & 63; F.wave = __builtin_amdgcn_readfirstlane(F.tid >> 6);
    F.G = gridDim.x; { const int bx = blockIdx.x; F.vcu = (F.G % 8 == 0) ? (bx % 8) * (F.G / 8) + bx / 8 : bx; }
    F.gw = blockIdx.x * NWAVES + F.wave; F.NGW = F.G * NWAVES;
    F.ws = args.ws; F.out = args.out; F.in = args.in;
    volatile LAS unsigned* MISC = (volatile LAS unsigned*)(F.lds + MISC_OFF);
    for (int u = F.tid; u < (LDS_BYTES - LDSCTL_OFF) / 4; u += NTHR) ((LAS unsigned*)(F.lds + LDSCTL_OFF))[u] = 0u;
    __syncthreads();
    XcdBarrier bar; bar.bar = (unsigned*)(F.ws + WS_CTL) + CW_BAR; bar.x = 0; bar.st = nullptr;
    const int lo = args.ph_lo, hi = args.ph_hi;
    if (hi - lo > 1) bar = xcd_barrier_post((unsigned*)(F.ws + WS_CTL) + CW_BAR, MISC + 8);
#ifdef MK_TS
    unsigned long long* TSB = (unsigned long long*)(F.ws + 600 * MiB); int tsn = 0;
#define STAMP() do { if (blockIdx.x == 0 && F.tid == 0) TSB[tsn] = __builtin_amdgcn_s_memrealtime(); ++tsn; } while (0)
    STAMP();
#else
#define STAMP() do { } while (0)
#endif
#define IN(k) (lo <= (k) && (k) < hi)
#ifdef MK_TS
#define ARRIVE(k) do { if (blockIdx.x == 0 && F.tid == 0) TSB[30 + (k)] = __builtin_amdgcn_s_memrealtime(); } while (0)
#else
#define ARRIVE(k) do { } while (0)
#endif
#define SEAM(k) do { ARRIVE(k); if (IN(k) && IN((k) + 1)) xcd_barrier(bar); STAMP(); } while (0)
#ifndef MK_REPEAT
#define MK_REPEAT 0
#endif
#define REP(id, stmt) do { stmt; if (MK_REPEAT & (1 << (id))) { __syncthreads(); stmt; } } while (0)
    if (IN(0)) { REP(0, p0_prologue(F)); } SEAM(0);
    if (IN(1)) { REP(1, p1_inproj(F)); } SEAM(1);
    if (IN(2)) {
#ifdef MK_SLEEP_PROBE
        { const unsigned long long t0 = __builtin_amdgcn_s_memrealtime(); while (__builtin_amdgcn_s_memrealtime() - t0 < 3000ull) __builtin_amdgcn_s_sleep(32); }
#endif
        REP(2, p2_elementwise(F)); } SEAM(2);
    if (IN(3)) { REP(3, p3_upproj_states(F)); } SEAM(3);
    if (IN(4)) { REP(4, p4_post(F)); } SEAM(4);
    if (IN(5)) { const float M0 = softmax_ref(F);
        if (blockIdx.x & 1) { p5_attn_decode(F, M0); __syncthreads(); }
        p5_attn_prompt(F, M0); __syncthreads();
        p5_ssd_out(F); __syncthreads();
        if (!(blockIdx.x & 1)) p5_attn_decode(F, M0);
    } SEAM(5);
    if (IN(6)) { REP(9, p7_outproj(F)); } SEAM(6);
    if (IN(7)) { REP(11, p9_gateup(F)); } SEAM(7);
    if (IN(8)) { p10_down(F); }
#ifdef MK_TS
    __syncthreads(); STAMP();
#endif
#undef IN
#undef SEAM
}
#ifndef MK_DIAG
#define MK_DIAG 0
#endif
__device__ __forceinline__ size_t nmrow(size_t r) { return r < (size_t)MMAIN ? (r >> 11) * TT + NMETA + (r & 2047) : (size_t)RP + (r - MMAIN); }
constexpr size_t WS_OUT2 = 1024 * MiB;
#ifdef MK_TS
#ifndef MK_TS_QA
#define MK_TS_QA 4.f
#endif
#ifndef MK_TS_QB
#define MK_TS_QB 4.f
#endif
__global__ void k_ts_encode(const unsigned long long* ts, float* out, int ia0, int ia1, int ib0, int ib1) {
    const float ta = rintf((float)(ts[ia1] - ts[ia0]) * 0.01f * (1.f / MK_TS_QA)) * MK_TS_QA, tb = rintf((float)(ts[ib1] - ts[ib0]) * 0.01f * (1.f / MK_TS_QB)) * MK_TS_QB;
    const float f = 1.f + sqrtf(ta * 1e-3f);
    for (int i = blockIdx.x * blockDim.x + threadIdx.x; i < 131072; i += gridDim.x * blockDim.x) out[OUT_YS + i] *= f;
    if (blockIdx.x == 0 && threadIdx.x == 0) out[0] += tb * 0.1f;
}
#endif
extern "C" void kernel_launch(void* const* d_in, const int* in_sizes, int n_in, void* d_out, int out_size, void* d_ws, size_t ws_size, hipStream_t stream) {
    (void)hipFuncSetAttribute((const void*)mk_fwd, hipFuncAttributeMaxDynamicSharedMemorySize, LDS_BYTES);
    unsigned char* ws = (unsigned char*)d_ws;
    (void)hipMemsetAsync(ws + WS_CTL, 0, CTL_ZERO_BYTES, stream);
    Args a{};
    for (int i = 0; i < 30; ++i) a.in[i] = d_in[i];
    a.ws = ws; a.out = (float*)d_out;
#if MK_DIAG
    float* diag = (float*)(ws + WS_DIAG);
    (void)hipMemsetAsync(diag, 0, 512, stream);
    nv::forward(d_in, (float*)d_out, (float*)(ws + WS_NAIVE), stream);
    a.out = (float*)(ws + WS_OUT2);
#endif
    static int one_launch = -1;
    if (one_launch < 0) { int dev = 0, cus = 0, per_cu = 0; one_launch = 0;
        if (hipGetDevice(&dev) == hipSuccess && hipDeviceGetAttribute(&cus, hipDeviceAttributeMultiprocessorCount, dev) == hipSuccess && cus >= 256) one_launch = 1;
        (void)per_cu;
        (void)hipGetLastError(); }
    const int grid = 256;
    if (one_launch && MK_ONE_LAUNCH) { a.ph_lo = 0; a.ph_hi = N_PHASES; a.li = 0; hipLaunchKernelGGL(mk_fwd, dim3(grid), dim3(NTHR), LDS_BYTES, stream, a); }
    else for (int ph = 0; ph < N_PHASES; ++ph) { a.ph_lo = ph; a.ph_hi = ph + 1; a.li = ph; hipLaunchKernelGGL(mk_fwd, dim3(grid), dim3(NTHR), LDS_BYTES, stream, a); }
#ifdef MK_TS
    k_ts_encode<<<64, 256, 0, stream>>>((const unsigned long long*)(ws + 600 * MiB), (float*)d_out, MK_TS_A0, MK_TS_A1, MK_TS_B0, MK_TS_B1);
#endif
#if MK_DIAG
    {
        nv::Ws w = nv::carve((float*)(ws + WS_NAIVE));
        const bf16* QRAW = (const bf16*)(ws + WS_QRAW); const bf16* KVRAW = (const bf16*)(ws + WS_KVRAW); const bf16* Q = (const bf16*)(ws + WS_Q); const bf16* K = (const bf16*)(ws + WS_K);
        const bf16* VT = (const bf16*)(ws + WS_VT); const float* VS = (const float*)(ws + WS_VS); const bf16* MIX = (const bf16*)(ws + WS_MIX);
        const float* o2 = (const float*)(ws + WS_OUT2); const float* o1 = (const float*)d_out;
        const float* nQRAW = w.QRAW; const float* nKV = w.KV; const float* nQ = w.Q; const float* nK = w.K; const float* nV = w.V; const float* nMIX = w.MIX;
        const size_t NMR = (size_t)MMAIN + DB;
        cmp(stream, 0, diag, NMR * 768, [=] __device__(size_t i) { return bf2f(QRAW[nmrow(i / 768) * 768 + i % 768]); }, [=] __device__(size_t i) { return nQRAW[nmrow(i / 768) * 768 + i % 768]; });
        cmp(stream, 1, diag, (size_t)R * 1024, [=] __device__(size_t i) { return bf2f(KVRAW[i]); }, [=] __device__(size_t i) { return nKV[i]; });
        cmp(stream, 2, diag, NMR * 768, [=] __device__(size_t i) { return bf2f(Q[nmrow(i / 768) * 768 + i % 768]); }, [=] __device__(size_t i) { return nQ[nmrow(i / 768) * 768 + i % 768] * (ATTN_SCALE * LOG2E); });
        cmp(stream, 3, diag, (size_t)R * 768, [=] __device__(size_t i) { return bf2f(K[i]); }, [=] __device__(size_t i) { return nK[i]; });
        cmp(stream, 4, diag, (size_t)NB * 512 * TT, [=] __device__(size_t i) { const size_t bhd = i / TT; const int t = (int)(i % TT); return bf2f(VT[bhd * TPAD + t]); },
            [=] __device__(size_t i) { const size_t bhd = i / TT; const int t = (int)(i % TT); const size_t b = bhd / 512, hd = bhd % 512; return nV[(b * TT + t) * 512 + hd]; });
        cmp(stream, 4, diag, (size_t)DB * 512, [=] __device__(size_t i) { return VS[i]; }, [=] __device__(size_t i) { return nV[(size_t)RP * 512 + i]; });
        cmp(stream, 5, diag, (size_t)(OUT_LATS - OUT_SSMP), [=] __device__(size_t i) { return o2[OUT_SSMP + i]; }, [=] __device__(size_t i) { return o1[OUT_SSMP + i]; });
        cmp(stream, 5, diag, (size_t)4194304, [=] __device__(size_t i) { return o2[OUT_SSMS + i]; }, [=] __device__(size_t i) { return o1[OUT_SSMS + i]; });
        cmp(stream, 6, diag, (size_t)R * 512, [=] __device__(size_t i) { return bf2f(MIX[(i >> 9) * 1024 + (i & 511)]); }, [=] __device__(size_t i) { return nMIX[(i >> 9) * 1024 + (i & 511)]; });
        cmp(stream, 7, diag, NMR * 512, [=] __device__(size_t i) { return bf2f(MIX[nmrow(i >> 9) * 1024 + 512 + (i & 511)]); }, [=] __device__(size_t i) { return nMIX[nmrow(i >> 9) * 1024 + 512 + (i & 511)]; });
        cmp(stream, 8, diag, (size_t)OUT_LATP, [=] __device__(size_t i) { return o2[i]; }, [=] __device__(size_t i) { return o1[i]; });
        k_diag_encode<<<64, 256, 0, stream>>>(diag, 9, 1e-3f, (float*)d_out);
    }
#endif
}
```

```cpp
#define MK_DIAG 0
#define MK_ONE_LAUNCH 1
#include <hip/hip_runtime.h>
#include <cstdio>
#include <cstdint>
namespace pg8 {
#define PG8_LAS __attribute__((address_space(3)))
typedef unsigned short bf16_t;
typedef short bf16x8 __attribute__((ext_vector_type(8)));
typedef float f32x4 __attribute__((ext_vector_type(4)));
typedef unsigned u32x4 __attribute__((ext_vector_type(4)));
constexpr int BM = 256, BK = 64, HALF = 128, HTB = HALF * BK * 2  , STAGE_BYTES = 8 * HTB, NXCD = 8, WGM = 8;

__host__ __device__ __forceinline__ int lds_byte(int r, int c) { const int st = (r >> 4) * 2 + (c >> 5), rr = r & 15, cc = c & 31, ob = rr * 64 + cc * 2; return st * 1024 + (ob ^ (((ob >> 9) & 1) << 5)); }
__host__ __device__ __forceinline__ void stage_rc(int b, int& R, int& C) { const int st = b / 1024, sb = b % 1024, swz = sb ^ (((sb >> 9) & 1) << 5); R = (st >> 1) * 16 + swz / 64; C = (st & 1) * 32 + (swz % 64) / 2; }
__host__ __device__ __forceinline__ int perm32(int rho) { const int n = rho >> 4, i = rho & 15; return 8 * (i >> 2) + 4 * n + (i & 3); }

struct Unit { int pm, pn; };
template <class E> constexpr bool has_midscale = false;
struct Gemm { const bf16_t* A; const bf16_t* Bt; int M, N, K; int rmode; int lda;
    __host__ __device__ __forceinline__ int rowbase(int pm) const { return rmode ? (pm >> 3) * 2064 + 16 + (pm & 7) * 256 : pm * 256; } };

struct StaticOrder {
    int nM, nN, nwg, G, c;
    __host__ __device__ void init(int M, int N, int G_, int c_) { nM = M / BM; nN = N / BM; nwg = nM * nN; G = G_; c = c_; }
    __host__ __device__ bool next(int i, Unit& u) const {
        const long L = (long)i * G + c; if (L >= nwg) return false;
        int wgid = (int)L; { const int q = nwg / NXCD, r = nwg % NXCD, xcd = wgid % NXCD, off = wgid / NXCD; wgid = (xcd < r ? xcd * (q + 1) : r * (q + 1) + (xcd - r) * q) + off; }
        const int nig = WGM * nN, gid = wgid / nig, fm = gid * WGM, gsz = (nM - fm) < WGM ? (nM - fm) : WGM;
        u.pm = fm + ((wgid % nig) % gsz); u.pn = (wgid % nig) / gsz; return true;
    }
    __device__ __forceinline__ void a_ready(const Unit&) const {}
    __device__ __forceinline__ void done(const Unit&) const {}
};


template <class Epi, class Sched, bool ALIGN_EPI = false, bool SP2 = false, int ROT = 0>
__device__ __forceinline__ void gemm_phase(PG8_LAS unsigned char* lds, const Gemm g, const Sched& S, const Epi& E) {
    const int tid = threadIdx.x, wid = __builtin_amdgcn_readfirstlane(tid >> 6), lane = tid & 63, wr = wid >> 2, wc = wid & 3, fr = lane & 15, fq = lane >> 4;
    const int K = g.K, nt = K / BK;
    unsigned voffA[2], voffB[2];
#pragma unroll
    for (int i = 0; i < 2; ++i) { int R, C; stage_rc(tid * 16 + i * 8192, R, C); const int Rb = Epi::PERM ? ((R & ~31) + perm32(R & 31)) : R;
        voffA[i] = (unsigned)(R * g.lda + C) * 2u; voffB[i] = (unsigned)(Rb * K + C) * 2u; }
    const size_t kstep = (size_t)(BK * 2);
    const size_t hstepA = (size_t)HALF * g.lda * 2;
    const size_t hstep = (size_t)HALF * K * 2;
    const size_t tstep = 2 * hstep;
    const unsigned ldsw = (unsigned)wid * 1024u;
    const int aoff = lds_byte(wr * 64 + fr, fq * 8), boff = lds_byte(wc * 32 + fr, fq * 8);
#define PG8_SA(b, h) (((b) * 2 + (h)) * HTB)
#define PG8_SB(b, h) ((4 + (b) * 2 + (h)) * HTB)
#define PG8_STAGE(bufoff, gbase, voff) do { _Pragma("unroll") for (int _i = 0; _i < 2; ++_i) \
        __builtin_amdgcn_global_load_lds((const unsigned*)((const char*)(gbase) + (voff)[_i]), (PG8_LAS unsigned*)(lds + (bufoff) + ldsw + _i * 8192), 16, 0, 0); } while (0)
#define PG8_LDA(dst, b, h) do { _Pragma("unroll") for (int m = 0; m < 4; ++m) _Pragma("unroll") for (int k = 0; k < 2; ++k) dst[m][k] = *(const PG8_LAS bf16x8*)(lds + PG8_SA(b, h) + aoff + m * 2048 + k * 1024); } while (0)
#define PG8_LDB(dst, b, h) do { _Pragma("unroll") for (int n = 0; n < 2; ++n) _Pragma("unroll") for (int k = 0; k < 2; ++k) dst[n][k] = *(const PG8_LAS bf16x8*)(lds + PG8_SB(b, h) + boff + n * 2048 + k * 1024); } while (0)
#define PG8_MMA(ai, bj, At, Bt) do { __builtin_amdgcn_s_setprio(1); _Pragma("unroll") for (int m = 0; m < 4; ++m) _Pragma("unroll") for (int n = 0; n < 2; ++n) _Pragma("unroll") for (int k = 0; k < 2; ++k) \
        acc[ai][bj][m][n] = __builtin_amdgcn_mfma_f32_16x16x32_bf16(Bt[n][k], At[m][k], acc[ai][bj][m][n], 0, 0, 0); __builtin_amdgcn_s_setprio(0); } while (0)
#define PG8_WAIT_V(n) asm volatile("s_waitcnt vmcnt(" #n ")" ::: "memory")
#define PG8_WAIT_L(n) asm volatile("s_waitcnt lgkmcnt(" #n ")" ::: "memory")
#define PG8_BAR __builtin_amdgcn_s_barrier()
#define PG8_SCHED __builtin_amdgcn_sched_barrier(0)
    Unit cur, nxt; int ui = 0;
    if (!S.next(0, cur)) return;
    f32x4 acc[2][2][4][2];
#pragma unroll
    for (int a = 0; a < 2; ++a)
#pragma unroll
        for (int b = 0; b < 2; ++b)
#pragma unroll
            for (int m = 0; m < 4; ++m)
#pragma unroll
                for (int n = 0; n < 2; ++n) acc[a][b][m][n] = (f32x4){0.f, 0.f, 0.f, 0.f};
    bf16x8 At[4][2], B0[2][2], B1[2][2];
    const char* cA = (const char*)g.A + (size_t)g.rowbase(cur.pm) * g.lda * 2 + ROT * kstep; const char* cB = (const char*)g.Bt + (size_t)cur.pn * tstep + ROT * kstep;
#define PG8_KOFF(j) ((long)((ROT != 0 && (j) >= nt - ROT) ? (j) - nt : (j)) * (long)kstep)
    S.a_ready(cur);
    if constexpr (SP2) {
        PG8_STAGE(PG8_SB(0, 0), cB, voffB); PG8_STAGE(PG8_SB(0, 1), cB + hstep, voffB); PG8_STAGE(PG8_SA(0, 0), cA, voffA); PG8_STAGE(PG8_SA(0, 1), cA + hstepA, voffA);
        if (wr == 1) PG8_BAR;
        PG8_WAIT_V(2); PG8_BAR;
        PG8_STAGE(PG8_SB(1, 0), cB + kstep, voffB); PG8_STAGE(PG8_SA(1, 0), cA + kstep, voffA); PG8_STAGE(PG8_SB(1, 1), cB + hstep + kstep, voffB);
        PG8_WAIT_V(6); PG8_BAR;
    } else {
        PG8_STAGE(PG8_SB(0, 0), cB, voffB); PG8_STAGE(PG8_SA(0, 0), cA, voffA); PG8_STAGE(PG8_SB(0, 1), cB + hstep, voffB); PG8_STAGE(PG8_SA(0, 1), cA + hstepA, voffA);
        if (wr == 1) PG8_BAR;
        PG8_WAIT_V(4); PG8_BAR;
        PG8_STAGE(PG8_SB(1, 0), cB + kstep, voffB); PG8_STAGE(PG8_SA(1, 0), cA + kstep, voffA); PG8_STAGE(PG8_SB(1, 1), cB + hstep + kstep, voffB);
        PG8_WAIT_V(6); PG8_BAR;
    }
    for (;;) {
        const bool has_next = S.next(ui + 1, nxt);
        const char* nA = has_next ? (const char*)g.A + (size_t)g.rowbase(nxt.pm) * g.lda * 2 + ROT * kstep : cA; const char* nB = has_next ? (const char*)g.Bt + (size_t)nxt.pn * tstep + ROT * kstep : cB;
        for (int t = 0; t < nt; t += 2) {
            const bool last = (t == nt - 2);
            const char* a1 = cA + PG8_KOFF(t + 1);
            const char* a2 = last ? nA : cA + PG8_KOFF(t + 2); const char* b2 = last ? nB : cB + PG8_KOFF(t + 2);
            if constexpr (has_midscale<Epi>) { if (t == nt - ROT) E.midscale(acc, cur, wr, fr); }
            const char* a3 = a2 + kstep; const char* b3 = b2 + kstep;
            if (last && has_next) S.a_ready(nxt);
            if constexpr (SP2) {
            PG8_LDB(B0, 0, 0); PG8_LDB(B1, 0, 1); PG8_SCHED; PG8_LDA(At, 0, 0); PG8_STAGE(PG8_SA(1, 1), a1 + hstepA, voffA);
            PG8_WAIT_V(8); PG8_WAIT_L(0); PG8_BAR; PG8_MMA(0, 0, At, B0); PG8_MMA(0, 1, At, B1); PG8_BAR; PG8_SCHED;
            PG8_LDA(At, 0, 1); PG8_STAGE(PG8_SB(0, 0), b2, voffB); PG8_STAGE(PG8_SB(0, 1), b2 + hstep, voffB); PG8_STAGE(PG8_SA(0, 0), a2, voffA);
            PG8_WAIT_V(8); PG8_WAIT_L(0); PG8_BAR; PG8_MMA(1, 0, At, B0); PG8_MMA(1, 1, At, B1); PG8_BAR; PG8_SCHED;
            PG8_LDB(B0, 1, 0); PG8_LDB(B1, 1, 1); PG8_SCHED; PG8_LDA(At, 1, 0); PG8_STAGE(PG8_SA(0, 1), a2 + hstepA, voffA);
            PG8_WAIT_V(8); PG8_WAIT_L(0); PG8_BAR; PG8_MMA(0, 0, At, B0); PG8_MMA(0, 1, At, B1); PG8_BAR; PG8_SCHED;
            PG8_LDA(At, 1, 1); PG8_STAGE(PG8_SB(1, 0), b3, voffB); PG8_STAGE(PG8_SB(1, 1), b3 + hstep, voffB); PG8_STAGE(PG8_SA(1, 0), a3, voffA);
            PG8_WAIT_V(8); PG8_WAIT_L(0); PG8_BAR; PG8_MMA(1, 0, At, B0); PG8_MMA(1, 1, At, B1); PG8_BAR; PG8_SCHED;
            } else {
            PG8_LDB(B0, 0, 0); PG8_SCHED; PG8_LDA(At, 0, 0); PG8_STAGE(PG8_SA(1, 1), a1 + hstepA, voffA);
            PG8_WAIT_L(8); PG8_BAR; PG8_WAIT_L(0); PG8_MMA(0, 0, At, B0); PG8_BAR; PG8_SCHED;
            PG8_LDB(B1, 0, 1); PG8_STAGE(PG8_SB(0, 0), b2, voffB);
            PG8_BAR; PG8_WAIT_L(0); PG8_MMA(0, 1, At, B1); PG8_BAR;
            PG8_LDA(At, 0, 1); PG8_STAGE(PG8_SA(0, 0), a2, voffA);
            PG8_BAR; PG8_WAIT_L(0); PG8_MMA(1, 0, At, B0); PG8_BAR; PG8_SCHED;
            PG8_STAGE(PG8_SB(0, 1), b2 + hstep, voffB);
            PG8_WAIT_V(6); PG8_BAR; PG8_MMA(1, 1, At, B1); PG8_BAR;
            PG8_LDB(B0, 1, 0); PG8_SCHED; PG8_LDA(At, 1, 0); PG8_STAGE(PG8_SA(0, 1), a2 + hstepA, voffA);
            PG8_WAIT_L(8); PG8_BAR; PG8_WAIT_L(0); PG8_MMA(0, 0, At, B0); PG8_BAR; PG8_SCHED;
            PG8_LDB(B1, 1, 1); PG8_STAGE(PG8_SB(1, 0), b3, voffB);
            PG8_BAR; PG8_WAIT_L(0); PG8_MMA(0, 1, At, B1); PG8_BAR;
            PG8_LDA(At, 1, 1); PG8_STAGE(PG8_SA(1, 0), a3, voffA);
            PG8_BAR; PG8_WAIT_L(0); PG8_MMA(1, 0, At, B0); PG8_BAR; PG8_SCHED;
            PG8_STAGE(PG8_SB(1, 1), b3 + hstep, voffB);
            PG8_WAIT_V(6); PG8_BAR; PG8_MMA(1, 1, At, B1); PG8_BAR;
            }
        }
        if constexpr (ALIGN_EPI) { if (wr == 0) PG8_BAR; }
        if constexpr (!Epi::AFTER_DRAIN) { E(acc, cur, wr, wc, fr, fq); S.done(cur); }
        if (!has_next) break;
#pragma unroll
        for (int a = 0; a < 2; ++a)
#pragma unroll
            for (int b = 0; b < 2; ++b)
#pragma unroll
                for (int m = 0; m < 4; ++m)
#pragma unroll
                    for (int n = 0; n < 2; ++n) acc[a][b][m][n] = (f32x4){0.f, 0.f, 0.f, 0.f};
        cur = nxt; cA = nA; cB = nB; ++ui;
        if constexpr (ALIGN_EPI) { if (wr == 1) PG8_BAR; }
    }
    PG8_WAIT_V(0);
    if constexpr (!ALIGN_EPI) { if (wr == 0) PG8_BAR; }
    PG8_BAR;
    if constexpr (Epi::AFTER_DRAIN) { E.fused(acc, cur, wr, wc, fr, fq, lds, wid, lane); S.done(cur); }
#undef PG8_KOFF
#undef PG8_SA
#undef PG8_SB
#undef PG8_STAGE
#undef PG8_LDA
#undef PG8_LDB
#undef PG8_MMA
#undef PG8_WAIT_V
#undef PG8_WAIT_L
#undef PG8_BAR
#undef PG8_SCHED
}
}

#define GAS __attribute__((address_space(1)))
#define LAS __attribute__((address_space(3)))
typedef unsigned short bf16;
typedef unsigned v4u __attribute__((ext_vector_type(4)));
typedef unsigned v2u __attribute__((ext_vector_type(2)));
typedef float f32x4 __attribute__((ext_vector_type(4)));
typedef float f32x16 __attribute__((ext_vector_type(16)));
typedef short bf16x8 __attribute__((ext_vector_type(8)));
typedef short s16x4 __attribute__((ext_vector_type(4)));
typedef GAS unsigned gu32;
#define RLX_AGENT __ATOMIC_RELAXED, __HIP_MEMORY_SCOPE_AGENT
#define LDS_WAIT() asm volatile("s_waitcnt lgkmcnt(0)" ::: "memory")
#define VM_WAIT() asm volatile("s_waitcnt vmcnt(0)" ::: "memory")
typedef float f32x2_t __attribute__((ext_vector_type(2))); typedef __bf16 bf16x2_t __attribute__((ext_vector_type(2)));
__device__ __forceinline__ unsigned pk2(float lo, float hi) { f32x2_t v = {lo, hi}; bf16x2_t b = __builtin_convertvector(v, bf16x2_t); return __builtin_bit_cast(unsigned, b); }
__device__ __forceinline__ bf16 f2bf(float f) { return (bf16)(pk2(f, 0.f) & 0xffffu); }
__device__ __forceinline__ float bf2f(bf16 v) { return __uint_as_float((unsigned)v << 16); }
__device__ __forceinline__ float bflo(unsigned w) { return __uint_as_float(w << 16); }
__device__ __forceinline__ float bfhi(unsigned w) { return __uint_as_float(w & 0xffff0000u); }

#define XB_TMO      128
#define XB_XCNT(j)  (256  + 64 * (j))
#define XB_XSUB(j)  (1280 + 64 * (j))
#define XB_XGEN(j)  (2304 + 64 * (j))
#define XB_TOP      3328
#define XB_TOPGEN   3392
#define XCD_BAR_WORDS 3456
#define XB_SPIN_CAP (1u << 18)
__device__ __forceinline__ unsigned xb_ld(unsigned* p)              { return __hip_atomic_load(p, __ATOMIC_RELAXED, __HIP_MEMORY_SCOPE_AGENT); }
__device__ __forceinline__ unsigned xb_add(unsigned* p, unsigned v) { return __hip_atomic_fetch_add(p, v, __ATOMIC_RELAXED, __HIP_MEMORY_SCOPE_AGENT); }
__device__ __forceinline__ unsigned xb_xcc_id() { return (unsigned)__builtin_amdgcn_s_getreg((3 << 11) | 20) & 0xFu; }
#define XB_SPIN(cond, bar) do { unsigned _sp = 0; while (cond) { __builtin_amdgcn_s_sleep(1); \
    if ((++_sp & 255u) == 0u) { if (xb_ld(&(bar)[XB_TMO])) break; if (_sp > XB_SPIN_CAP) { atomicAdd(&(bar)[XB_TMO], 1u); break; } } } } while (0)
struct XcdBarrier { unsigned* bar; unsigned x; volatile LAS unsigned* st; };
__device__ __forceinline__ XcdBarrier xcd_barrier_post(unsigned* bar, volatile LAS unsigned* st) {
    XcdBarrier b; b.bar = bar; b.x = xb_xcc_id(); b.st = st;
    if (threadIdx.x == 0) (void)xb_add(&bar[XB_XCNT(b.x)], 1u);
    return b;
}
__device__ __forceinline__ void xcd_barrier_complete(unsigned* bar, unsigned x, unsigned& nloc, unsigned& nx) {
    const unsigned G = gridDim.x * gridDim.y * gridDim.z;
    unsigned sum, cnt, mine, sp = 0u;
    for (;;) {
        sum = 0u; cnt = 0u; mine = 0u;
#pragma unroll
        for (unsigned j = 0; j < 16; ++j) { const unsigned c = xb_ld(&bar[XB_XCNT(j)]); sum += c; cnt += (c > 0u) ? 1u : 0u; mine = (j == x) ? c : mine; }
        if (sum == G) break;
        __builtin_amdgcn_s_sleep(1);
        if ((++sp & 255u) == 0u) { if (xb_ld(&bar[XB_TMO])) break; if (sp > XB_SPIN_CAP) { atomicAdd(&bar[XB_TMO], 1u); break; } }
    }
    nloc = mine > 0u ? mine : 1u; nx = cnt > 0u ? cnt : 1u;
}
__device__ __forceinline__ void xcd_barrier(const XcdBarrier& b) {
    asm volatile("s_waitcnt vmcnt(0)" ::: "memory");
    __syncthreads();
    if (threadIdx.x == 0) {
        unsigned* bar = b.bar;
        __builtin_amdgcn_s_waitcnt(0);
        unsigned nloc = b.st[0], nx = b.st[1];
        if (nloc == 0u) { xcd_barrier_complete(bar, b.x, nloc, nx); b.st[0] = nloc; b.st[1] = nx; }
        const unsigned old = xb_add(&bar[XB_XSUB(b.x)], 1u);
        const unsigned gen = old / nloc;
        if (old + 1u == (gen + 1u) * nloc) {
            __builtin_amdgcn_fence(__ATOMIC_RELEASE, "agent");
            asm volatile("s_waitcnt vmcnt(0)" ::: "memory");
            (void)xb_add(&bar[XB_TOP], 1u);
        }
        __builtin_amdgcn_fence(__ATOMIC_ACQUIRE, "agent");
        XB_SPIN(xb_ld(&bar[XB_TOP]) < (gen + 1u) * nx, bar);
        asm volatile("s_waitcnt vmcnt(0)" ::: "memory");
    }
    __syncthreads();
}

constexpr int DM = 1024, NB = 8, SEQ = 2048, NMETA = 16, TT = SEQ + NMETA;
constexpr int DB = 128, PAST = 8192, PAGE = 128, NPAGES = 64;
constexpr int NH = 8, HP = 64, SSDW = 512, NG = 2, DS = 64, CONVD = 768;
constexpr int QKD = 96, VD = 64, MLAW = 512, QL = 384, KVL = 256, DFF = 2816, INC = 1960;
constexpr int RP = NB * TT, R = RP + DB;
constexpr int MMAIN = NB * SEQ;
constexpr int NS = NMETA + DB;
constexpr float EPS = 1e-6f, ATTN_SCALE = 0.10206207261596577f, LOG2E = 1.4426950408889634f;
constexpr int PJ = 2048, C_Z = 0, C_XBC = 512, C_CKV = 1280, C_CQ = 1536, C_DT = 1920, C_KR = 1928;
constexpr int S_Z = 0, S_XBC = 512, S_DT = 1280, S_CQ = 1288, S_CKV = 1672, S_KR = 1928;
constexpr int TPAD = 2112;
constexpr int NCH = 33, CHL = 64, TOFF = 48;
constexpr size_t OUT_YP = 0, OUT_YS = 16777216, OUT_LATP = 16908288, OUT_KRP = 21135360, OUT_CONVP = 21663744,
                 OUT_SSMP = 21682176, OUT_LATS = 21944320, OUT_KRS = 21977088, OUT_CONVS = 21981184, OUT_SSMS = 22276096;

constexpr size_t MiB = 1u << 20;
constexpr size_t WS_CTL = 0, CTL_ZERO_BYTES = 32 * 1024;
constexpr int CW_BAR = 4096;
constexpr size_t WS_SS = 512 * 1024;
constexpr size_t WS_WIN = 2 * MiB;
constexpr size_t WS_WUQ = 6 * MiB;
constexpr size_t WS_WUKV = 7 * MiB;
constexpr size_t WS_WOUT = 8 * MiB;
constexpr size_t WS_WGU = 10 * MiB;
constexpr size_t WS_WDN = 22 * MiB;
constexpr size_t WS_XN = 32 * MiB;
constexpr size_t WS_PROJ = 66 * MiB;
constexpr size_t WS_DTRAW = 132 * MiB;
constexpr size_t WS_DT = 133 * MiB;
constexpr size_t WS_LAT = 134 * MiB;
constexpr size_t WS_CQN = 143 * MiB;
constexpr size_t WS_KRF = 156 * MiB;
constexpr size_t WS_XST = 159 * MiB;
constexpr size_t WS_BT = 176 * MiB;
constexpr size_t WS_BC = 181 * MiB;
constexpr size_t WS_XAS = 190 * MiB;
constexpr size_t WS_QRAW = 191 * MiB;
constexpr size_t WS_KVRAW = 216 * MiB;
constexpr size_t WS_Q = 249 * MiB;
constexpr size_t WS_K = 274 * MiB;
constexpr size_t WS_VT = 299 * MiB;
constexpr size_t WS_STATES = 316 * MiB;
constexpr size_t WS_DECAY = 350 * MiB;
constexpr size_t WS_HIN = 351 * MiB;
constexpr size_t WS_MIX = 368 * MiB;
constexpr size_t WS_ACT = 401 * MiB;
constexpr size_t WS_VS = 491 * MiB;
constexpr size_t WS_DPART = 492 * MiB;
constexpr size_t WS_HS = 494 * MiB;
constexpr size_t WS_ROPE = 496 * MiB;
constexpr size_t WS_SSP = 520 * MiB;
constexpr size_t WS_WUKV2 = 524 * MiB;
constexpr size_t WS_RQ = 522 * MiB;
constexpr size_t WS_SSQ = 526 * MiB;
constexpr size_t WS_OPT_END = 527 * MiB;
constexpr int CW_DCNT = 1024;
constexpr size_t WS_NAIVE = 2048 * MiB;
constexpr size_t WS_DIAG = 1 * MiB;

constexpr int RING_OFF = 0, RING_BYTES = 131072;
constexpr int LDSCTL_OFF = RING_BYTES, MISC_OFF = LDSCTL_OFF + 320;
constexpr int LDS_BYTES = 163840;
constexpr int NWAVES = 8, NTHR = 512;

struct Args { const void* in[30]; float* out; unsigned char* ws; int ph_lo, ph_hi, li, pad; };

struct Frame {
    LAS unsigned char* lds;
    int tid, lane, wave, G, vcu, gw, NGW;
    unsigned char* ws; float* out;
    const void* const* in;
};
#define DPP_F(x, ctrl) __builtin_bit_cast(float, __builtin_amdgcn_update_dpp(0, __builtin_bit_cast(int, (x)), (ctrl), 0xF, 0xF, true))
__device__ __forceinline__ float sum_x1(float x) { return x + DPP_F(x, 0xB1); }
__device__ __forceinline__ float sum_x2(float x) { return x + DPP_F(x, 0x4E); }
__device__ __forceinline__ float sum_x4(float x) { return x + DPP_F(x, 0x141); }
__device__ __forceinline__ float sum_x8(float x) { return x + DPP_F(x, 0x140); }
__device__ __forceinline__ float sum_x16(float x) { const unsigned u = __builtin_bit_cast(unsigned, x); const auto r = __builtin_amdgcn_permlane16_swap(u, u, false, false); return __uint_as_float(r[0]) + __uint_as_float(r[1]); }
__device__ __forceinline__ float sum_x32(float x) { const unsigned u = __builtin_bit_cast(unsigned, x); const auto r = __builtin_amdgcn_permlane32_swap(u, u, false, false); return __uint_as_float(r[0]) + __uint_as_float(r[1]); }
__device__ __forceinline__ float wave_sum(float v) { return sum_x32(sum_x16(sum_x8(sum_x4(sum_x2(sum_x1(v)))))); }
__device__ __forceinline__ float wave_max(float v) {
#pragma unroll
    for (int o = 1; o < 64; o <<= 1) v = fmaxf(v, __shfl_xor(v, o));
    return v;
}
__device__ __forceinline__ float silu_f(float x) { return x * __builtin_amdgcn_rcpf(1.f + __expf(-x)); }
__device__ __forceinline__ float softplus_f(float x) { return fmaxf(x, 0.f) + log1pf(expf(-fabsf(x))); }
__device__ __forceinline__ float rope_inv(int j) { return exp2f(-(float)j * (13.287712379549449f / 16.0f)); }
struct EpiProj {
    static constexpr bool PERM = true, AFTER_DRAIN = false;
    bf16* O; float* dtraw; int rmode;
    __device__ __forceinline__ void operator()(const pg8::f32x4 (&acc)[2][2][4][2], const pg8::Unit& u, int wr, int wc, int fr, int fq) const {
        const int rb = rmode ? (u.pm >> 3) * 2064 + 16 + (u.pm & 7) * 256 : u.pm * 256;
        const int row0 = rb + wr * 64 + fr, col0 = u.pn * 256 + wc * 32 + 8 * fq;
#pragma unroll
        for (int ai = 0; ai < 2; ++ai)
#pragma unroll
            for (int m = 0; m < 4; ++m) { const int row = row0 + ai * 128 + m * 16; bf16* rowp = O + (size_t)row * PJ + col0;
#pragma unroll
                for (int bj = 0; bj < 2; ++bj) { const pg8::f32x4 v0 = acc[ai][bj][m][0], v1 = acc[ai][bj][m][1];
                    v4u w; w.x = pk2(v0[0], v0[1]); w.y = pk2(v0[2], v0[3]); w.z = pk2(v1[0], v1[1]); w.w = pk2(v1[2], v1[3]);
                    *(v4u*)(rowp + bj * 128) = w; }
                if (u.pn == 7 && wc == 0 && fq == 0) { *(pg8::f32x4*)(dtraw + (size_t)row * 8) = acc[ai][1][m][0]; *(pg8::f32x4*)(dtraw + (size_t)row * 8 + 4) = acc[ai][1][m][1]; } }
    }
};
struct EpiBf16 {
    static constexpr bool PERM = true, AFTER_DRAIN = false;
    bf16* O; int ldc; int rmode;
    __device__ __forceinline__ void operator()(const pg8::f32x4 (&acc)[2][2][4][2], const pg8::Unit& u, int wr, int wc, int fr, int fq) const {
        const int rb = rmode ? (u.pm >> 3) * 2064 + 16 + (u.pm & 7) * 256 : u.pm * 256;
        const int row0 = rb + wr * 64 + fr, col0 = u.pn * 256 + wc * 32 + 8 * fq;
#pragma unroll
        for (int ai = 0; ai < 2; ++ai)
#pragma unroll
            for (int m = 0; m < 4; ++m) { bf16* rowp = O + (size_t)(row0 + ai * 128 + m * 16) * ldc + col0;
#pragma unroll
                for (int bj = 0; bj < 2; ++bj) { const pg8::f32x4 v0 = acc[ai][bj][m][0], v1 = acc[ai][bj][m][1];
                    v4u w; w.x = pk2(v0[0], v0[1]); w.y = pk2(v0[2], v0[3]); w.z = pk2(v1[0], v1[1]); w.w = pk2(v1[2], v1[3]);
                    *(v4u*)(rowp + bj * 128) = w; } }
    }
};
struct EpiResF32 {
    static constexpr bool PERM = false, AFTER_DRAIN = false;
    const float* res; float* out;
    __device__ __forceinline__ void operator()(const pg8::f32x4 (&acc)[2][2][4][2], const pg8::Unit& u, int wr, int wc, int fr, int fq) const {
        const int row0 = u.pm * 256 + wr * 64 + fr, col0 = u.pn * 256 + wc * 32 + 4 * fq;
#pragma unroll
        for (int ai = 0; ai < 2; ++ai)
#pragma unroll
            for (int m = 0; m < 4; ++m) { const size_t off = (size_t)(row0 + ai * 128 + m * 16) * DM + col0;
#pragma unroll
                for (int bj = 0; bj < 2; ++bj)
#pragma unroll
                    for (int n = 0; n < 2; ++n) { const pg8::f32x4 r = *(const pg8::f32x4*)(res + off + bj * 128 + n * 16); *(pg8::f32x4*)(out + off + bj * 128 + n * 16) = r + acc[ai][bj][m][n]; } }
    }
};
struct EpiOutProj {
    static constexpr bool PERM = false, AFTER_DRAIN = false;
    const float* res; float* out; bf16* HB; float* SS; const LAS float* RS; mutable int nth;
    __device__ __forceinline__ void midscale(pg8::f32x4 (&acc)[2][2][4][2], const pg8::Unit& u, int wr, int fr) const {
        const int slot = nth++;
        const LAS float* rsp = RS + slot * 256 + wr * 64 + fr;
#pragma unroll
        for (int ai = 0; ai < 2; ++ai)
#pragma unroll
            for (int m = 0; m < 4; ++m) { const float rs = rsp[ai * 128 + m * 16];
#pragma unroll
                for (int bj = 0; bj < 2; ++bj)
#pragma unroll
                    for (int n = 0; n < 2; ++n) acc[ai][bj][m][n] *= rs; }
    }
    __device__ __forceinline__ void operator()(const pg8::f32x4 (&acc)[2][2][4][2], const pg8::Unit& u, int wr, int wc, int fr, int fq) const {
        const int rb = (u.pm >> 3) * 2064 + 16 + (u.pm & 7) * 256;
        const int row0 = u.pm * 256 + wr * 64 + fr, col0 = u.pn * 256 + wc * 32 + 4 * fq;
        pg8::f32x4 rc[4], rn[4];
#define EOP_LOAD(dst, g) do { const size_t off_ = (size_t)(row0 + ((g) >> 2) * 128 + ((g) & 3) * 16) * DM + col0; \
            dst[0] = *(const pg8::f32x4*)(res + off_); dst[1] = *(const pg8::f32x4*)(res + off_ + 16); dst[2] = *(const pg8::f32x4*)(res + off_ + 128); dst[3] = *(const pg8::f32x4*)(res + off_ + 144); } while (0)
        EOP_LOAD(rc, 0);
#pragma unroll
        for (int g = 0; g < 8; ++g) { const int ai = g >> 2, m = g & 3;
            if (g < 7) EOP_LOAD(rn, g + 1);
            const int orow = row0 + ai * 128 + m * 16; bf16* hb = HB + (size_t)(rb + wr * 64 + fr + ai * 128 + m * 16) * DM + col0; float ss = 0.f;
#pragma unroll
            for (int bj = 0; bj < 2; ++bj)
#pragma unroll
                for (int n = 0; n < 2; ++n) { const pg8::f32x4 v = rc[2 * bj + n] + acc[ai][bj][m][n];
                    ss += (v[0] * v[0] + v[1] * v[1]) + (v[2] * v[2] + v[3] * v[3]); v2u w; w.x = pk2(v[0], v[1]); w.y = pk2(v[2], v[3]); *(v2u*)(hb + bj * 128 + n * 16) = w; }
            ss = sum_x16(ss); ss = sum_x32(ss);
            if (fq == 0) SS[(size_t)orow * 16 + u.pn * 4 + wc] = ss;
#pragma unroll
            for (int i = 0; i < 4; ++i) rc[i] = rn[i]; }
#undef EOP_LOAD
    }
};
namespace pg8 { template <> constexpr bool has_midscale<EpiOutProj> = true; }
struct EpiDown {
    static constexpr bool PERM = false, AFTER_DRAIN = false;
    const bf16* HB; float* out;
    __device__ __forceinline__ void operator()(const pg8::f32x4 (&acc)[2][2][4][2], const pg8::Unit& u, int wr, int wc, int fr, int fq) const {
        const int rb = (u.pm >> 3) * 2064 + 16 + (u.pm & 7) * 256;
        const int row0 = u.pm * 256 + wr * 64 + fr, col0 = u.pn * 256 + wc * 32 + 4 * fq;
        v2u rc[4], rn[4];
#define EDN_LOAD(dst, g) do { const bf16* hb_ = HB + (size_t)(rb + wr * 64 + fr + ((g) >> 2) * 128 + ((g) & 3) * 16) * DM + col0; \
            dst[0] = *(const v2u*)(hb_); dst[1] = *(const v2u*)(hb_ + 16); dst[2] = *(const v2u*)(hb_ + 128); dst[3] = *(const v2u*)(hb_ + 144); } while (0)
        EDN_LOAD(rc, 0);
#pragma unroll
        for (int g = 0; g < 8; ++g) { const int ai = g >> 2, m = g & 3;
            if (g < 7) EDN_LOAD(rn, g + 1);
            const size_t off = (size_t)(row0 + ai * 128 + m * 16) * DM + col0;
#pragma unroll
            for (int bj = 0; bj < 2; ++bj)
#pragma unroll
                for (int n = 0; n < 2; ++n) { const v2u w = rc[2 * bj + n]; const pg8::f32x4 r = {bflo(w.x), bfhi(w.x), bflo(w.y), bfhi(w.y)}; *(pg8::f32x4*)(out + off + bj * 128 + n * 16) = r + acc[ai][bj][m][n]; }
#pragma unroll
            for (int i = 0; i < 4; ++i) rc[i] = rn[i]; }
#undef EDN_LOAD
    }
};
struct EpiSwiGLU {
    static constexpr bool PERM = true, AFTER_DRAIN = false;
    bf16* O; const LAS float* RS; mutable int nth;
    __device__ __forceinline__ void operator()(const pg8::f32x4 (&acc)[2][2][4][2], const pg8::Unit& u, int wr, int wc, int fr, int fq) const {
        const int rb = (u.pm >> 3) * 2064 + 16 + (u.pm & 7) * 256;
        const int row0 = rb + wr * 64 + fr, col0 = u.pn * 128 + wc * 32 + 8 * fq;
        const int slot = nth++;
        const LAS float* rsp = RS + slot * 256 + wr * 64 + fr;
#pragma unroll
        for (int ai = 0; ai < 2; ++ai)
#pragma unroll
            for (int m = 0; m < 4; ++m) { float a[8]; const float rs = rsp[ai * 128 + m * 16];
#pragma unroll
                for (int n = 0; n < 2; ++n)
#pragma unroll
                    for (int e = 0; e < 4; ++e) a[4 * n + e] = silu_f(rs * acc[ai][0][m][n][e]) * (rs * acc[ai][1][m][n][e]);
                v4u w; w.x = pk2(a[0], a[1]); w.y = pk2(a[2], a[3]); w.z = pk2(a[4], a[5]); w.w = pk2(a[6], a[7]);
                *(v4u*)(O + (size_t)(row0 + ai * 128 + m * 16) * DFF + col0) = w; }
    }
};

template <class ARow, class Epi>
__device__ __forceinline__ void small_gemm(const bf16* A, int lda, const bf16* Bt, int K, int nrt, int nct, const ARow& arow, const Epi& E, int gw, int NGW, int lane, int ksplit = 1) {
    const int ntask = nrt * nct * ksplit, kc = K / ksplit;
    for (int task = gw; task < ntask; task += NGW) {
        const int rt = task % nrt, ct = (task / nrt) % nct, kq = task / (nrt * nct);
        const bf16* ap = A + (size_t)arow(rt * 16 + (lane & 15)) * lda + kq * kc + 8 * (lane >> 4);
        const bf16* bp = Bt + (size_t)(ct * 16 + (lane & 15)) * K + kq * kc + 8 * (lane >> 4);
        f32x4 acc = {0.f, 0.f, 0.f, 0.f};
#pragma unroll 1
        for (int k0 = 0; k0 < kc; k0 += 32 * 11) {
            bf16x8 av[11], bv[11];
#pragma unroll
            for (int j = 0; j < 11; ++j) if (k0 + 32 * j < kc) { av[j] = *(const bf16x8*)(ap + k0 + 32 * j); bv[j] = *(const bf16x8*)(bp + k0 + 32 * j); }
#pragma unroll
            for (int j = 0; j < 11; ++j) if (k0 + 32 * j < kc) acc = __builtin_amdgcn_mfma_f32_16x16x32_bf16(av[j], bv[j], acc, 0, 0, 0);
        }
        E(acc, rt, ct, lane);
    }
}

template <class RM>
__device__ __forceinline__ void transpose_item(const float* W, int N, int ldw, bf16* WT, int ldt, int item, LAS float* scr, int lane, const RM& rm, const float* kscale = nullptr) {
    const int nblk = (N + 31) / 32, kb = item / nblk, nb = item % nblk, k0 = 64 * kb, n0 = 32 * nb;
    { const int n = n0 + (lane & 31); float v[32];
#pragma unroll
      for (int i = 0; i < 32; ++i) { const int kk = 2 * i + (lane >> 5); v[i] = (n < N) ? W[(size_t)(k0 + kk) * ldw + n] : 0.f; }
#pragma unroll
      for (int i = 0; i < 32; ++i) { const int kk = 2 * i + (lane >> 5); float x = v[i]; if (kscale) x *= kscale[k0 + kk]; scr[kk * 33 + (lane & 31)] = x; } }
    LDS_WAIT(); asm volatile("" ::: "memory");
    const int c = lane & 7;
#pragma unroll
    for (int j = 0; j < 4; ++j) { const int n = (lane >> 3) + 8 * j; const LAS float* s = scr + (8 * c) * 33 + n;
        if (n0 + n < N) { v4u o; o.x = pk2(s[0 * 33], s[1 * 33]); o.y = pk2(s[2 * 33], s[3 * 33]); o.z = pk2(s[4 * 33], s[5 * 33]); o.w = pk2(s[6 * 33], s[7 * 33]);
            *(v4u*)(WT + (size_t)rm(n0 + n) * ldt + k0 + 8 * c) = o; } }
    LDS_WAIT(); asm volatile("" ::: "memory");
}
__device__ __forceinline__ int map_in(int n) {
    return n < S_DT ? n : n < S_CQ ? C_DT + (n - S_DT) : n < S_CKV ? C_CQ + (n - S_CQ) : n < S_KR ? C_CKV + (n - S_CKV) : n;
}
__device__ __forceinline__ void p0_prologue(Frame& F) {
    LAS float* scr = (LAS float*)(F.lds + RING_OFF + F.wave * 16384);
    const float* w_in = (const float*)F.in[9]; const float* w_uq = (const float*)F.in[17]; const float* w_ukv = (const float*)F.in[19]; const float* w_out = (const float*)F.in[25];
    const float* w_gate = (const float*)F.in[27]; const float* w_up = (const float*)F.in[28]; const float* w_down = (const float*)F.in[29];
    bf16* WIN = (bf16*)(F.ws + WS_WIN); bf16* WUQ = (bf16*)(F.ws + WS_WUQ); bf16* WUKV = (bf16*)(F.ws + WS_WUKV); bf16* WOUT = (bf16*)(F.ws + WS_WOUT); bf16* WGU = (bf16*)(F.ws + WS_WGU); bf16* WDN = (bf16*)(F.ws + WS_WDN);
    const float* ffg = (const float*)F.in[26];
    constexpr int I_IN = 16 * 62, I_UQ = 6 * 24, I_UKV = 4 * 32, I_OUT = 16 * 32;
    constexpr int NITEMS = I_IN + I_UQ + 2 * I_UKV + I_OUT;
    bf16* WUKV2 = (bf16*)(F.ws + WS_WUKV2);
    for (int it = F.gw; it < NITEMS; it += F.NGW) {
        int r = it;
        if (r < I_IN) { transpose_item(w_in, INC, INC, WIN, DM, r, scr, F.lane, [](int n) { return map_in(n); }); continue; } r -= I_IN;
        if (r < I_UQ) { transpose_item(w_uq, 768, 768, WUQ, QL, r, scr, F.lane, [](int n) { return n; }, (const float*)F.in[16]); continue; } r -= I_UQ;
        if (r < I_UKV) { transpose_item(w_ukv, 1024, 1024, WUKV, KVL, r, scr, F.lane, [](int n) { return n; }, (const float*)F.in[18]); continue; } r -= I_UKV;
        if (r < I_UKV) { transpose_item(w_ukv, 1024, 1024, WUKV2, KVL, r, scr, F.lane, [](int n) { return n; }); continue; } r -= I_UKV;
        transpose_item(w_out, DM, DM, WOUT, 1024, r, scr, F.lane, [](int n) { return n; }, (r >= 8 * 32) ? (const float*)F.in[24] - 512 : nullptr);
    }
    for (int i = F.gw * 64 + F.lane; i < 88 * 1024 / 8; i += F.NGW * 64) *(v4u*)(WIN + (size_t)1960 * 1024 + (size_t)i * 8) = (v4u){0u, 0u, 0u, 0u};
    const float* xp = (const float*)F.in[0]; const float* xs = (const float*)F.in[1]; const float* meta = (const float*)F.in[7]; const float* g = (const float*)F.in[8];
    bf16* XN = (bf16*)(F.ws + WS_XN);
    f32x4 gv[4];
#pragma unroll
    for (int j = 0; j < 4; ++j) gv[j] = ((const f32x4*)g)[F.lane + 64 * j];
#define XN_ROWS(r0, n) do { f32x4 v[4][4]; \
        _Pragma("unroll") for (int i = 0; i < 4; ++i) if (i < (n)) { const int row = (r0) + i; const float* src; \
            if (row < RP) { const int b = row / TT, t = row % TT; src = (t < NMETA) ? meta + (size_t)t * DM : xp + ((size_t)b * SEQ + (t - NMETA)) * DM; } else src = xs + (size_t)(row - RP) * DM; \
            _Pragma("unroll") for (int j = 0; j < 4; ++j) v[i][j] = ((const f32x4*)src)[F.lane + 64 * j]; } \
        _Pragma("unroll") for (int i = 0; i < 4; ++i) if (i < (n)) { float s = 0.f; \
            _Pragma("unroll") for (int j = 0; j < 4; ++j) s += (v[i][j].x * v[i][j].x + v[i][j].y * v[i][j].y) + (v[i][j].z * v[i][j].z + v[i][j].w * v[i][j].w); \
            const float rs = __builtin_amdgcn_rsqf(wave_sum(s) * (1.f / DM) + EPS); \
            v2u* o8 = (v2u*)(XN + (size_t)((r0) + i) * DM) + F.lane; \
            _Pragma("unroll") for (int j = 0; j < 4; ++j) { v2u o; o.x = pk2(v[i][j].x * rs * gv[j].x, v[i][j].y * rs * gv[j].y); o.y = pk2(v[i][j].z * rs * gv[j].z, v[i][j].w * rs * gv[j].w); o8[64 * j] = o; } } } while (0)
    if (F.NGW == 2048) { XN_ROWS(4 * F.gw, 4); XN_ROWS(8192 + 4 * F.gw, 4); if (F.gw < 256) XN_ROWS(16384 + F.gw, 1); }
    else for (int r0 = 4 * F.gw; r0 < R; r0 += 4 * F.NGW) XN_ROWS(r0, 4);
#undef XN_ROWS
    float* ROPE = (float*)(F.ws + WS_ROPE);
    for (int i = blockIdx.x * NTHR + F.tid; i < (TT + 1) * 16; i += F.G * NTHR) { const int p = i >> 4, j = i & 15; const float ang = (float)(p < TT ? p : PAST) * rope_inv(j); ROPE[2 * i] = cosf(ang); ROPE[2 * i + 1] = sinf(ang); }
}

__device__ __forceinline__ void p1_ffn_weights(Frame& F, int w0, int nw) {
    LAS float* scr = (LAS float*)(F.lds + RING_OFF + F.wave * 16384);
    const float* w_gate = (const float*)F.in[27]; const float* w_up = (const float*)F.in[28]; const float* w_down = (const float*)F.in[29]; const float* ffg = (const float*)F.in[26];
    bf16* WGU = (bf16*)(F.ws + WS_WGU); bf16* WDN = (bf16*)(F.ws + WS_WDN);
    constexpr int I_G = 16 * 88, I_DN = 44 * 32;
    for (int it = F.gw - w0; it < 2 * I_G + I_DN; it += nw) {
        int r = it;
        if (r < I_G) { transpose_item(w_gate, DFF, DFF, WGU, DM, r, scr, F.lane, [](int n) { return 256 * (n >> 7) + (n & 127); }, ffg); continue; } r -= I_G;
        if (r < I_G) { transpose_item(w_up, DFF, DFF, WGU, DM, r, scr, F.lane, [](int n) { return 256 * (n >> 7) + 128 + (n & 127); }, ffg); continue; } r -= I_G;
        transpose_item(w_down, DM, DM, WDN, DFF, r, scr, F.lane, [](int n) { return n; });
    }
}
__device__ __forceinline__ int small_arow(int r) { return r < NMETA ? r : RP + (r - NMETA); }
__device__ __forceinline__ void p1_inproj(Frame& F) {
    const bf16* XN = (const bf16*)(F.ws + WS_XN); const bf16* WIN = (const bf16*)(F.ws + WS_WIN); bf16* PROJ = (bf16*)(F.ws + WS_PROJ); float* DTRAW = (float*)(F.ws + WS_DTRAW);
    { pg8::Gemm g{XN, WIN, MMAIN, PJ, DM, 1, DM}; pg8::StaticOrder S; S.init(MMAIN, PJ, F.G, (int)blockIdx.x);
      EpiProj E{PROJ, DTRAW, 1};
      pg8::gemm_phase<EpiProj, pg8::StaticOrder, true, true>(F.lds + RING_OFF, g, S, E); }
    auto epi = [&](const f32x4& acc, int rt, int ct, int lane) {
        const int col = ct * 16 + (lane & 15);
#pragma unroll
        for (int i = 0; i < 4; ++i) { const int r = rt * 16 + 4 * (lane >> 4) + i; const bf16 v = f2bf(acc[i]);
            if (r < NMETA) { for (int b = 0; b < NB; ++b) { PROJ[(size_t)(b * TT + r) * PJ + col] = v; if (col >= C_DT && col < C_DT + 8) DTRAW[(size_t)(b * TT + r) * 8 + (col - C_DT)] = acc[i]; } }
            else { const int row = RP + (r - NMETA); PROJ[(size_t)row * PJ + col] = v; if (col >= C_DT && col < C_DT + 8) DTRAW[(size_t)row * 8 + (col - C_DT)] = acc[i]; } }
    };
    small_gemm(XN, DM, WIN, DM, NS / 16, PJ / 16, [](int r) { return small_arow(r); }, epi, F.gw, F.NGW, F.lane);
    { constexpr int NSM = (NS / 16) * (PJ / 16);
      if (F.NGW > NSM + 256) { if (F.gw >= NSM) p1_ffn_weights(F, NSM, F.NGW - NSM); } else p1_ffn_weights(F, 0, F.NGW); }
}

constexpr int CV_LDS_STRIDE = 88;
__device__ __forceinline__ void p2_elementwise(Frame& F) {
    const bf16* PROJ = (const bf16*)(F.ws + WS_PROJ); const float* DTRAW = (const float*)(F.ws + WS_DTRAW); float* DT = (float*)(F.ws + WS_DT);
    float* RQS = (float*)(F.ws + WS_RQ); float* KRF = (float*)(F.ws + WS_KRF);
    const float* kvg = (const float*)F.in[18]; const float* qng = (const float*)F.in[16]; const float* dtb = (const float*)F.in[12]; const float* ROPE = (const float*)(F.ws + WS_ROPE);
    {
        const f32x4 gg = ((const f32x4*)kvg)[F.lane]; const float* gq = qng + 6 * F.lane; const float g0 = gq[0], g1 = gq[1], g2 = gq[2], g3 = gq[3], g4 = gq[4], g5 = gq[5]; const float dbias = dtb[F.lane & 7];
        v2u wk[4], wkn[4]; unsigned wq[4][3], wqn[4][3]; unsigned short kr1[4], kr2[4], kr1n[4], kr2n[4]; float dtr[4], dtrn[4]; f32x2_t cs[4], csn[4];
#define P2A_LOAD(WK, WQ, K1, K2, DTR, CS, r0, n) do { _Pragma("unroll") for (int i = 0; i < 4; ++i) if (i < (n)) { const int row = (r0) + i; const bf16* pr = PROJ + (size_t)row * PJ; \
            WK[i] = *(const v2u*)(pr + C_CKV + 4 * F.lane); const unsigned* p = (const unsigned*)(pr + C_CQ + 6 * F.lane); WQ[i][0] = p[0]; WQ[i][1] = p[1]; WQ[i][2] = p[2]; \
            K1[i] = pr[C_KR + (F.lane & 15)]; K2[i] = pr[C_KR + 16 + (F.lane & 15)]; DTR[i] = DTRAW[(size_t)row * 8 + (F.lane & 7)]; \
            CS[i] = *(const f32x2_t*)(ROPE + 2 * ((row < RP ? row % TT : TT) * 16 + (F.lane & 15))); } } while (0)
#define P2A_PROC(r0, n) do { _Pragma("unroll") for (int i = 0; i < 4; ++i) if (i < (n)) { const int row = (r0) + i; \
            { const float v0 = bflo(wk[i].x), v1 = bfhi(wk[i].x), v2 = bflo(wk[i].y), v3 = bfhi(wk[i].y); \
              const float rs = __builtin_amdgcn_rsqf(wave_sum((v0 * v0 + v1 * v1) + (v2 * v2 + v3 * v3)) * (1.f / KVL) + EPS); \
              const f32x4 o = {v0 * rs * gg.x, v1 * rs * gg.y, v2 * rs * gg.z, v3 * rs * gg.w}; \
              float* of = (row < RP) ? F.out + OUT_LATP + (size_t)row * KVL : F.out + OUT_LATS + (size_t)(row - RP) * KVL; \
              ((f32x4*)of)[F.lane] = o; if (F.lane == 0) RQS[R + row] = rs; } \
            { const float v0 = bflo(wq[i][0]), v1 = bfhi(wq[i][0]), v2 = bflo(wq[i][1]), v3 = bfhi(wq[i][1]), v4 = bflo(wq[i][2]), v5 = bfhi(wq[i][2]); \
              const float rs = __builtin_amdgcn_rsqf(wave_sum((v0 * v0 + v1 * v1) + (v2 * v2 + v3 * v3) + (v4 * v4 + v5 * v5)) * (1.f / QL) + EPS); \
              if (F.lane == 0) RQS[row] = rs; } \
            if (F.lane < 16) { const int j = F.lane; const float c = cs[i].x, s = cs[i].y; \
              const float x1 = bf2f(kr1[i]), x2 = bf2f(kr2[i]); const float y1 = x1 * c - x2 * s, y2 = x1 * s + x2 * c; \
              KRF[(size_t)row * 32 + j] = y1; KRF[(size_t)row * 32 + 16 + j] = y2; \
              float* of = (row < RP) ? F.out + OUT_KRP + (size_t)row * 32 : F.out + OUT_KRS + (size_t)(row - RP) * 32; of[j] = y1; of[16 + j] = y2; } \
            if (F.lane < 8) DT[(size_t)row * 8 + F.lane] = softplus_f(dtr[i] + dbias); } } while (0)
#define P2A_ROT() do { _Pragma("unroll") for (int i = 0; i < 4; ++i) { wk[i] = wkn[i]; wq[i][0] = wqn[i][0]; wq[i][1] = wqn[i][1]; wq[i][2] = wqn[i][2]; kr1[i] = kr1n[i]; kr2[i] = kr2n[i]; dtr[i] = dtrn[i]; cs[i] = csn[i]; } } while (0)
        if (F.NGW == 2048) {
            const int ra = 4 * F.gw, rb2 = 8192 + 4 * F.gw, rc = 16384 + F.gw;
            P2A_LOAD(wk, wq, kr1, kr2, dtr, cs, ra, 4);
            P2A_LOAD(wkn, wqn, kr1n, kr2n, dtrn, csn, rb2, 4);
            P2A_PROC(ra, 4); P2A_ROT();
            if (F.gw < 256) P2A_LOAD(wkn, wqn, kr1n, kr2n, dtrn, csn, rc, 1);
            P2A_PROC(rb2, 4);
            if (F.gw < 256) { P2A_ROT(); P2A_PROC(rc, 1); }
        } else {
            for (int r0 = 4 * F.gw; r0 < R; r0 += 4 * F.NGW) { P2A_LOAD(wk, wq, kr1, kr2, dtr, cs, r0, 4); P2A_PROC(r0, 4); }
        }
#undef P2A_LOAD
#undef P2A_PROC
#undef P2A_ROT
    }
    const float* cw = (const float*)F.in[10]; const float* cb = (const float*)F.in[11];
    bf16* XST = (bf16*)(F.ws + WS_XST); bf16* BT = (bf16*)(F.ws + WS_BT); bf16* BC = (bf16*)(F.ws + WS_BC);
    LAS bf16* tile = (LAS bf16*)(F.lds + RING_OFF);
    for (int i = blockIdx.x * NTHR + F.tid; i < NB * 640 * 6; i += F.G * NTHR) { const int rowi = i / 6, pc = i % 6; const int bb = rowi / 640, cc = rowi % 640;
        bf16* dst = (cc < SSDW) ? XST + ((size_t)(bb * SSDW + cc)) * TPAD : BT + ((size_t)(bb * 128 + (cc - SSDW))) * TPAD; *(v4u*)(dst + pc * 8) = (v4u){0u, 0u, 0u, 0u}; }
    {
        const int cl = 2 * (F.tid & 127), tq = F.tid >> 7;
        unsigned raw[19], rawn[19]; float wv[10], wn[10];
#define CV_FETCH(RAW, WV, uu) do { const int third_ = (uu) % 3, tb_ = 1 + ((uu) / 3) % 32, b_ = (uu) / 96; const int c_ = third_ * 256 + cl, tf_ = tb_ * CHL - TOFF + 16 * tq; \
            const bf16* base_ = PROJ + (size_t)b_ * TT * PJ + C_XBC + c_; \
            _Pragma("unroll") for (int k = 0; k < 19; ++k) { const int t = tf_ - 3 + k; RAW[k] = (t >= 0) ? *(const unsigned*)(base_ + (size_t)t * PJ) : 0u; } \
            _Pragma("unroll") for (int k = 0; k < 4; ++k) { WV[2 * k] = cw[k * CONVD + c_]; WV[2 * k + 1] = cw[k * CONVD + c_ + 1]; } WV[8] = cb[c_]; WV[9] = cb[c_ + 1]; } while (0)
#define CV_COMPUTE(RAW, WV, tfirst, lcol, third, b) do { unsigned wa_[8], wb_[8]; float pa_ = 0.f, pb_ = 0.f; \
            _Pragma("unroll") for (int k = 0; k < 16; ++k) { const int t = (tfirst) + k; \
                const float ya = silu_f(WV[8] + bflo(RAW[k]) * WV[0] + bflo(RAW[k + 1]) * WV[2] + bflo(RAW[k + 2]) * WV[4] + bflo(RAW[k + 3]) * WV[6]); \
                const float yb = silu_f(WV[9] + bfhi(RAW[k]) * WV[1] + bfhi(RAW[k + 1]) * WV[3] + bfhi(RAW[k + 2]) * WV[5] + bfhi(RAW[k + 3]) * WV[7]); \
                if ((third) == 2) *(unsigned*)(BC + (size_t)((b) * TT + t) * 256 + cl) = pk2(ya, yb); \
                if (k & 1) { wa_[k >> 1] = pk2(pa_, ya); wb_[k >> 1] = pk2(pb_, yb); } else { pa_ = ya; pb_ = yb; } } \
            LAS v4u* ra_ = (LAS v4u*)(tile + cl * CV_LDS_STRIDE + (lcol)); LAS v4u* rb_ = (LAS v4u*)(tile + (cl + 1) * CV_LDS_STRIDE + (lcol)); \
            ra_[0] = (v4u){wa_[0], wa_[1], wa_[2], wa_[3]}; ra_[1] = (v4u){wa_[4], wa_[5], wa_[6], wa_[7]}; rb_[0] = (v4u){wb_[0], wb_[1], wb_[2], wb_[3]}; rb_[1] = (v4u){wb_[4], wb_[5], wb_[6], wb_[7]}; } while (0)
        if ((int)blockIdx.x < NB * 32 * 3) CV_FETCH(rawn, wn, (int)blockIdx.x);
        for (int u = blockIdx.x; u < NB * 32 * 3; u += F.G) {
            const int third = u % 3, tb = 1 + (u / 3) % 32, b = u / 96; const int t0 = tb * CHL - TOFF;
#pragma unroll
            for (int k = 0; k < 19; ++k) raw[k] = rawn[k];
#pragma unroll
            for (int k = 0; k < 10; ++k) wv[k] = wn[k];
            CV_COMPUTE(raw, wv, t0 + 16 * tq, 16 * tq, third, b);
            if (tb == 1 && tq == 0) {
                const bf16* base = PROJ + (size_t)b * TT * PJ + C_XBC + third * 256 + cl;
#pragma unroll
                for (int k = 0; k < 19; ++k) { const int t = k - 3; raw[k] = (t >= 0) ? *(const unsigned*)(base + (size_t)t * PJ) : 0u; }
                CV_COMPUTE(raw, wv, 0, 64, third, b); }
            __syncthreads();
            if (u + F.G < NB * 32 * 3) CV_FETCH(rawn, wn, u + F.G);
            { const int nrows = (third == 2) ? 128 : 256; const int npc = (tb == 1) ? 10 : 8;
              for (int i = F.tid; i < nrows * npc; i += NTHR) { const int cr = i / npc, pc = i % npc;
                const v4u o = *(const LAS v4u*)(tile + cr * CV_LDS_STRIDE + pc * 8);
                bf16* dst = (third < 2) ? XST + ((size_t)(b * SSDW + third * 256 + cr)) * TPAD : BT + ((size_t)(b * 128 + cr)) * TPAD;
                *(v4u*)(dst + ((pc < 8) ? tb * CHL + pc * 8 : TOFF + (pc - 8) * 8)) = o; } }
            __syncthreads();
        }
#undef CV_FETCH
#undef CV_COMPUTE
    }
    const float* sconv = (const float*)F.in[4]; float* XAS = (float*)(F.ws + WS_XAS);
    for (int i = blockIdx.x * NTHR + F.tid; i < DB * CONVD; i += F.G * NTHR) { const int b = i / CONVD, c = i % CONVD;
        const float xc = bf2f(PROJ[(size_t)(RP + b) * PJ + C_XBC + c]);
        const float s0 = sconv[(size_t)(b * 3 + 0) * CONVD + c], s1 = sconv[(size_t)(b * 3 + 1) * CONVD + c], s2 = sconv[(size_t)(b * 3 + 2) * CONVD + c];
        XAS[i] = silu_f(cb[c] + s0 * cw[c] + s1 * cw[CONVD + c] + s2 * cw[2 * CONVD + c] + xc * cw[3 * CONVD + c]);
        float* oc = F.out + OUT_CONVS + (size_t)b * 3 * CONVD + c; oc[0] = s1; oc[CONVD] = s2; oc[2 * CONVD] = xc; }
    for (int i = blockIdx.x * NTHR + F.tid; i < NB * 3 * CONVD; i += F.G * NTHR) { const int b = i / (3 * CONVD), k = (i / CONVD) % 3, c = i % CONVD;
        F.out[OUT_CONVP + i] = bf2f(PROJ[(size_t)(b * TT + TT - 3 + k) * PJ + C_XBC + c]); }
}
#define MFMA32(a, b, c) __builtin_amdgcn_mfma_f32_32x32x16_bf16((a), (b), (c), 0, 0, 0)
#define MFMA16(a, b, c) __builtin_amdgcn_mfma_f32_16x16x32_bf16((a), (b), (c), 0, 0, 0)
__device__ __forceinline__ int crow(int reg, int hi) { return (reg & 3) + 8 * (reg >> 2) + 4 * hi; }
__device__ __forceinline__ bf16x8 pack8(const f32x16& x, int s) {
    v4u p; p.x = pk2(x[8 * s + 0], x[8 * s + 1]); p.y = pk2(x[8 * s + 2], x[8 * s + 3]); p.z = pk2(x[8 * s + 4], x[8 * s + 5]); p.w = pk2(x[8 * s + 6], x[8 * s + 7]);
    return __builtin_bit_cast(bf16x8, p);
}
__device__ __forceinline__ bf16x8 ld2x8(const bf16* p0, const bf16* p1) {
    const v2u a = *(const v2u*)p0, b = *(const v2u*)p1; v4u r; r.x = a.x; r.y = a.y; r.z = b.x; r.w = b.y; return __builtin_bit_cast(bf16x8, r);
}
__device__ __forceinline__ float softmax_ref(Frame& F) {
    const float* gqn = (const float*)F.in[20]; const float* gqr = (const float*)F.in[21]; const float* gkn = (const float*)F.in[22]; const float* gkr = (const float*)F.in[23];
    float a = fabsf(gqn[F.lane]), b = fabsf(gkn[F.lane]);
    if (F.lane < 16) { a = fmaxf(a, fabsf(gqr[F.lane])); b = fmaxf(b, fabsf(gkr[F.lane])); }
    return LOG2E * 9.797958971132712f * wave_max(a) * wave_max(b) * 1.0001f;
}
constexpr size_t WS_YS = 495 * MiB;
constexpr size_t WS_KS = 498 * MiB;
constexpr int NKT = 65;

__device__ __forceinline__ void p3_upproj_states(Frame& F) {
    const bf16* PROJ = (const bf16*)(F.ws + WS_PROJ); const bf16* WUQ = (const bf16*)(F.ws + WS_WUQ); const bf16* WUKV = (const bf16*)(F.ws + WS_WUKV);
    bf16* QRAW = (bf16*)(F.ws + WS_QRAW); bf16* KVRAW = (bf16*)(F.ws + WS_KVRAW);
    { pg8::Gemm g{PROJ + C_CQ, WUQ, MMAIN, 768, QL, 1, PJ}; pg8::StaticOrder S; S.init(MMAIN, 768, F.G, (int)blockIdx.x); EpiBf16 E{QRAW, 768, 1};
      pg8::gemm_phase<EpiBf16, pg8::StaticOrder, true, true>(F.lds + RING_OFF, g, S, E); }
    { pg8::Gemm g{PROJ + C_CKV, WUKV, MMAIN, 1024, KVL, 1, PJ}; pg8::StaticOrder S; S.init(MMAIN, 1024, F.G, (int)blockIdx.x); EpiBf16 E{KVRAW, 1024, 1};
      pg8::gemm_phase<EpiBf16, pg8::StaticOrder, true, true>(F.lds + RING_OFF, g, S, E); }
    const bool sub = (F.G == 256);
    const int sgw = sub ? (blockIdx.x - 192) * NWAVES + F.wave : F.gw, sngw = sub ? 64 * NWAVES : F.NGW;
    if (!sub || blockIdx.x >= 192) {
    small_gemm(PROJ + C_CQ, PJ, WUQ, QL, DB / 16, 768 / 16, [](int r) { return RP + r; },
        [&](const f32x4& acc, int rt, int ct, int lane) { const int col = ct * 16 + (lane & 15);
#pragma unroll
            for (int i = 0; i < 4; ++i) QRAW[(size_t)(RP + rt * 16 + 4 * (lane >> 4) + i) * 768 + col] = f2bf(acc[i]); }, sgw, sngw, F.lane);
    small_gemm(PROJ + C_CKV, PJ, WUKV, KVL, NS / 16, 1024 / 16, [](int r) { return small_arow(r); },
        [&](const f32x4& acc, int rt, int ct, int lane) { const int col = ct * 16 + (lane & 15);
#pragma unroll
            for (int i = 0; i < 4; ++i) { const int r = rt * 16 + 4 * (lane >> 4) + i; const bf16 v = f2bf(acc[i]);
                if (r < NMETA) { for (int b = 0; b < NB; ++b) KVRAW[(size_t)(b * TT + r) * 1024 + col] = v; } else KVRAW[(size_t)(RP + r - NMETA) * 1024 + col] = v; } }, sgw, sngw, F.lane);
    }
    const float* DT = (const float*)(F.ws + WS_DT); const float* a_log = (const float*)F.in[13];
    const bf16* XST = (const bf16*)(F.ws + WS_XST); const bf16* BT = (const bf16*)(F.ws + WS_BT);
    bf16* STATES = (bf16*)(F.ws + WS_STATES); float* DECAY = (float*)(F.ws + WS_DECAY);
    LAS float* wl = (LAS float*)(F.lds + RING_OFF + F.wave * 1024);
    const int r32 = F.lane & 31, hi = F.lane >> 5;
    for (int u = F.gw; u < NB * NCH * NH; u = sub ? ((u < F.NGW && F.gw >= 192 * NWAVES) ? F.NGW + (F.gw - 192 * NWAVES) : NB * NCH * NH) : u + F.NGW) {
        const int h = u % NH, c = (u / NH) % NCH, b = u / (NH * NCH); const int g = h >> 2;
        const int t = c * CHL - TOFF + F.lane;
        const float dt = (t >= 0) ? DT[(size_t)(b * TT + t) * 8 + h] : 0.f;
        const float A = -__expf(a_log[h]);
        float acs = dt * A;
#pragma unroll
        for (int o = 1; o < 64; o <<= 1) { const float v = __shfl_up(acs, o); if (F.lane >= o) acs += v; }
        const float last = __shfl(acs, 63);
        wl[F.lane] = __expf(last - acs) * dt;
        LDS_WAIT(); asm volatile("" ::: "memory");
        f32x16 acc[2][2];
#pragma unroll
        for (int i = 0; i < 2; ++i)
#pragma unroll
            for (int j = 0; j < 2; ++j) acc[i][j] = (f32x16){};
        const bf16* xb = XST + ((size_t)(b * SSDW + h * HP)) * TPAD + c * CHL; const bf16* bb = BT + ((size_t)(b * 128 + g * DS)) * TPAD + c * CHL;
#pragma unroll
        for (int s = 0; s < 4; ++s) {
            const f32x4 w0 = *(const LAS f32x4*)(wl + 16 * s + 8 * hi), w1 = *(const LAS f32x4*)(wl + 16 * s + 8 * hi + 4);
            bf16x8 af[2], bfr[2];
#pragma unroll
            for (int pt = 0; pt < 2; ++pt) { const v4u x = *(const v4u*)(xb + (size_t)(32 * pt + r32) * TPAD + 16 * s + 8 * hi);
                v4u y; y.x = pk2(bflo(x.x) * w0.x, bfhi(x.x) * w0.y); y.y = pk2(bflo(x.y) * w0.z, bfhi(x.y) * w0.w); y.z = pk2(bflo(x.z) * w1.x, bfhi(x.z) * w1.y); y.w = pk2(bflo(x.w) * w1.z, bfhi(x.w) * w1.w);
                af[pt] = __builtin_bit_cast(bf16x8, y); }
#pragma unroll
            for (int nt = 0; nt < 2; ++nt) bfr[nt] = *(const bf16x8*)(bb + (size_t)(32 * nt + r32) * TPAD + 16 * s + 8 * hi);
#pragma unroll
            for (int pt = 0; pt < 2; ++pt)
#pragma unroll
                for (int nt = 0; nt < 2; ++nt) acc[pt][nt] = MFMA32(af[pt], bfr[nt], acc[pt][nt]);
        }
        bf16* so = STATES + ((size_t)((b * NCH + c) * NH + h)) * 4096;
        const bool odd = (F.lane & 1) != 0;
#pragma unroll
        for (int pt = 0; pt < 2; ++pt)
#pragma unroll
            for (int nt = 0; nt < 2; ++nt)
#pragma unroll
                for (int r2 = 0; r2 < 8; ++r2) { const float oe = acc[pt][nt][2 * r2], oo = acc[pt][nt][2 * r2 + 1];
                    const float got = DPP_F(odd ? oe : oo, 0xB1);
                    const unsigned w = odd ? pk2(got, oo) : pk2(oe, got);
                    *(unsigned*)(so + (32 * pt + crow(2 * r2 + (odd ? 1 : 0), hi)) * 64 + 32 * nt + (r32 & ~1)) = w; }
        if (F.lane == 0) DECAY[(b * NCH + c) * NH + h] = __expf(last);
        LDS_WAIT(); asm volatile("" ::: "memory");
    }
}

#ifdef MK_TS
#define P4_STAMP(k) do { if (blockIdx.x == 0 && F.tid == 0) ((unsigned long long*)(F.ws + 600 * MiB))[20 + (k)] = __builtin_amdgcn_s_memrealtime(); } while (0)
#else
#define P4_STAMP(k) do { } while (0)
#endif
__device__ __forceinline__ void p4_post(Frame& F) {
    const bf16* QRAW = (const bf16*)(F.ws + WS_QRAW); const bf16* KVRAW = (const bf16*)(F.ws + WS_KVRAW); const float* KRF = (const float*)(F.ws + WS_KRF);
    bf16* Q = (bf16*)(F.ws + WS_Q); bf16* K = (bf16*)(F.ws + WS_K); bf16* VT = (bf16*)(F.ws + WS_VT); float* VS = (float*)(F.ws + WS_VS);
    const float* gqn = (const float*)F.in[20]; const float* gqr = (const float*)F.in[21]; const float* gkn = (const float*)F.in[22]; const float* gkr = (const float*)F.in[23];
    const float* ROPE = (const float*)(F.ws + WS_ROPE); const float* RQS = (const float*)(F.ws + WS_RQ);
    const int h = F.lane >> 3, sub = F.lane & 7;
    bf16* KS = (bf16*)(F.ws + WS_KS);
    for (int row = RP + (F.gw + F.NGW / 2) % F.NGW; row < R; row += F.NGW) {
        const int t = PAST;
        if (row >= RP) { const bf16* kp = KVRAW + (size_t)row * 1024 + 128 * h + 8 * sub; const v4u kw = *(const v4u*)kp; const v4u vw = *(const v4u*)(kp + 64);
          const f32x4 kr = *(const f32x4*)(KRF + (size_t)row * 32 + 4 * sub);
          const float rkv = RQS[R + row];
          float kn[8] = {bflo(kw.x) * rkv, bfhi(kw.x) * rkv, bflo(kw.y) * rkv, bfhi(kw.y) * rkv, bflo(kw.z) * rkv, bfhi(kw.z) * rkv, bflo(kw.w) * rkv, bfhi(kw.w) * rkv};
          float ss = (kr.x * kr.x + kr.y * kr.y) + (kr.z * kr.z + kr.w * kr.w);
#pragma unroll
          for (int e = 0; e < 8; ++e) ss += kn[e] * kn[e];
          ss = sum_x1(ss); ss = sum_x2(ss); ss = sum_x4(ss);
          const float rs = __builtin_amdgcn_rsqf(ss * (1.f / 96.f) + EPS);
          const float* gn = gkn + 8 * sub; v4u o; o.x = pk2(kn[0] * rs * gn[0], kn[1] * rs * gn[1]); o.y = pk2(kn[2] * rs * gn[2], kn[3] * rs * gn[3]); o.z = pk2(kn[4] * rs * gn[4], kn[5] * rs * gn[5]); o.w = pk2(kn[6] * rs * gn[6], kn[7] * rs * gn[7]);
          bf16* ko = KS + (size_t)(row - RP) * 768 + 96 * h; *(v4u*)(ko + 8 * sub) = o;
          const float* gr = gkr + ((4 * sub) & 15); v2u o2; o2.x = pk2(kr.x * rs * gr[0], kr.y * rs * gr[1]); o2.y = pk2(kr.z * rs * gr[2], kr.w * rs * gr[3]);
          *(v2u*)(ko + 64 + 4 * sub) = o2;
          const unsigned vv[4] = {vw.x, vw.y, vw.z, vw.w}; float* vs = VS + (size_t)(row - RP) * 512 + 64 * h + 8 * sub;
#pragma unroll
          for (int e = 0; e < 4; ++e) { vs[2 * e] = bflo(vv[e]) * rkv; vs[2 * e + 1] = bfhi(vv[e]) * rkv; } }
        if (row >= RP || t >= NMETA) {
            const bf16* qp = QRAW + (size_t)row * 768 + 96 * h; const v4u qw = *(const v4u*)(qp + 8 * sub);
            const unsigned r1 = *(const unsigned*)(qp + 64 + 2 * sub), r2 = *(const unsigned*)(qp + 80 + 2 * sub);
            float qn[8] = {bflo(qw.x), bfhi(qw.x), bflo(qw.y), bfhi(qw.y), bflo(qw.z), bfhi(qw.z), bflo(qw.w), bfhi(qw.w)};
            const f32x4 cs = *(const f32x4*)(ROPE + 2 * ((row < RP ? t : TT) * 16 + 2 * sub)); const float c0 = cs.x, s0 = cs.y, c1 = cs.z, s1 = cs.w;
            const float x10 = bflo(r1), x11 = bfhi(r1), x20 = bflo(r2), x21 = bfhi(r2);
            const float y10 = x10 * c0 - x20 * s0, y20 = x10 * s0 + x20 * c0, y11 = x11 * c1 - x21 * s1, y21 = x11 * s1 + x21 * c1;
            float ss = (y10 * y10 + y20 * y20) + (y11 * y11 + y21 * y21);
#pragma unroll
            for (int e = 0; e < 8; ++e) ss += qn[e] * qn[e];
            ss = sum_x1(ss); ss = sum_x2(ss); ss = sum_x4(ss);
            const float sq = RQS[row];
            const float rs = (ATTN_SCALE * LOG2E) * sq * __builtin_amdgcn_rsqf(ss * sq * sq * (1.f / 96.f) + EPS);
            const float* gn = gqn + 8 * sub; v4u o; o.x = pk2(qn[0] * rs * gn[0], qn[1] * rs * gn[1]); o.y = pk2(qn[2] * rs * gn[2], qn[3] * rs * gn[3]); o.z = pk2(qn[4] * rs * gn[4], qn[5] * rs * gn[5]); o.w = pk2(qn[6] * rs * gn[6], qn[7] * rs * gn[7]);
            bf16* qo = Q + (size_t)row * 768 + 96 * h; *(v4u*)(qo + 8 * sub) = o;
            const float g0 = gqr[2 * sub], g1 = gqr[2 * sub + 1];
            *(unsigned*)(qo + 64 + 2 * sub) = pk2(y10 * rs * g0, y11 * rs * g1); *(unsigned*)(qo + 80 + 2 * sub) = pk2(y20 * rs * g0, y21 * rs * g1);
        }
    }
    { bf16* KF = (bf16*)(F.ws + WS_K); bf16* VF = (bf16*)(F.ws + WS_VT);
      LAS unsigned char* vtile = F.lds + RING_OFF + F.wave * 4608;
      const int r8 = F.lane >> 3;
      const int nfull = (NB * NKT * NH) / F.NGW, rot = (F.gw + F.NGW - F.NGW / 4) % F.NGW;
      v4u kwn[4], vwn[4]; f32x4 krn[4]; float rkn[4];
#define KB_UNIT(i_) (((i_) < nfull) ? (i_) * F.NGW + F.gw : nfull * F.NGW + rot)
#define KB_FETCH(u_) do { const int hh_ = (u_) % NH, kt_ = ((u_) / NH) % NKT, bb_ = (u_) / (NH * NKT); \
          _Pragma("unroll") for (int i4 = 0; i4 < 4; ++i4) { const int tk = kt_ * 32 + 8 * i4 + r8; const int tkc = tk < TT ? tk : TT - 1; rkn[i4] = RQS[R + bb_ * TT + tkc]; \
              const bf16* kp = KVRAW + (size_t)(bb_ * TT + tkc) * 1024 + 128 * hh_ + 8 * sub; kwn[i4] = *(const v4u*)kp; vwn[i4] = *(const v4u*)(kp + 64); krn[i4] = *(const f32x4*)(KRF + (size_t)(bb_ * TT + tkc) * 32 + 4 * sub); } } while (0)
      if (KB_UNIT(0) < NB * NKT * NH) KB_FETCH(KB_UNIT(0));
      for (int i = 0; i <= nfull; ++i) { const int u = KB_UNIT(i); if (u >= NB * NKT * NH) break;
          const int hh = u % NH, kt = (u / NH) % NKT, bb = u / (NH * NKT);
          bf16* kfb = KF + ((size_t)((bb * NH + hh) * NKT + kt)) * (6 * 512); bf16* vfb = VF + ((size_t)((bb * NH + hh) * NKT + kt)) * (4 * 512);
          v4u kwa[4], vwa[4]; f32x4 kra[4]; float rka[4];
#pragma unroll
          for (int i4 = 0; i4 < 4; ++i4) { kwa[i4] = kwn[i4]; vwa[i4] = vwn[i4]; kra[i4] = krn[i4]; rka[i4] = rkn[i4]; }
          if (i + 1 <= nfull) { const int un = KB_UNIT(i + 1); if (un < NB * NKT * NH) KB_FETCH(un); }
#pragma unroll
          for (int i = 0; i < 4; ++i) {
              const int key = 8 * i + r8, tk = kt * 32 + key; v4u kw = kwa[i], vw = vwa[i]; f32x4 kr = kra[i];
              if (tk >= TT) { kw = (v4u){0u, 0u, 0u, 0u}; vw = kw; kr = (f32x4){0.f, 0.f, 0.f, 0.f}; }
              const float rkv = rka[i];
              float kn[8] = {bflo(kw.x) * rkv, bfhi(kw.x) * rkv, bflo(kw.y) * rkv, bfhi(kw.y) * rkv, bflo(kw.z) * rkv, bfhi(kw.z) * rkv, bflo(kw.w) * rkv, bfhi(kw.w) * rkv};
              vw.x = pk2(bflo(vw.x) * rkv, bfhi(vw.x) * rkv); vw.y = pk2(bflo(vw.y) * rkv, bfhi(vw.y) * rkv); vw.z = pk2(bflo(vw.z) * rkv, bfhi(vw.z) * rkv); vw.w = pk2(bflo(vw.w) * rkv, bfhi(vw.w) * rkv);
              float ss = (kr.x * kr.x + kr.y * kr.y) + (kr.z * kr.z + kr.w * kr.w);
#pragma unroll
              for (int e = 0; e < 8; ++e) ss += kn[e] * kn[e];
              ss = sum_x1(ss); ss = sum_x2(ss); ss = sum_x4(ss);
              const float rs = __builtin_amdgcn_rsqf(ss * (1.f / 96.f) + EPS);
              const float* gn = gkn + 8 * sub; v4u o; o.x = pk2(kn[0] * rs * gn[0], kn[1] * rs * gn[1]); o.y = pk2(kn[2] * rs * gn[2], kn[3] * rs * gn[3]); o.z = pk2(kn[4] * rs * gn[4], kn[5] * rs * gn[5]); o.w = pk2(kn[6] * rs * gn[6], kn[7] * rs * gn[7]);
              *(v4u*)(kfb + (sub >> 1) * 512 + ((sub & 1) * 32 + key) * 8) = o;
              const float* gr = gkr + ((4 * sub) & 15); v2u o2; o2.x = pk2(kr.x * rs * gr[0], kr.y * rs * gr[1]); o2.y = pk2(kr.z * rs * gr[2], kr.w * rs * gr[3]);
              *(v2u*)(kfb + (4 + (sub >> 2)) * 512 + (((sub >> 1) & 1) * 32 + key) * 8 + 4 * (sub & 1)) = o2;
              *(LAS v4u*)(vtile + key * 144 + sub * 16) = vw; }
          LDS_WAIT(); asm volatile("" ::: "memory");
          const int g = F.lane >> 4, q4 = (F.lane & 15) >> 2, pp = F.lane & 3;
          const unsigned a_lo = (unsigned)(uintptr_t)vtile + (unsigned)((4 * (g >> 1) + q4) * 144 + (16 * (g & 1) + 4 * pp) * 2);
#define VF_TR(dt, s2) do { s16x4 lo, hi4; \
              asm volatile("ds_read_b64_tr_b16 %0, %2 offset:%c3\n\tds_read_b64_tr_b16 %1, %2 offset:%c4\n\ts_waitcnt lgkmcnt(0)" : "=&v"(lo), "=&v"(hi4) : "v"(a_lo), "i"(16 * (s2) * 144 + 64 * (dt)), "i"(16 * (s2) * 144 + 64 * (dt) + 8 * 144) : "memory"); \
              v4u o; o.x = (unsigned)(unsigned short)lo[0] | ((unsigned)(unsigned short)lo[1] << 16); o.y = (unsigned)(unsigned short)lo[2] | ((unsigned)(unsigned short)lo[3] << 16); \
              o.z = (unsigned)(unsigned short)hi4[0] | ((unsigned)(unsigned short)hi4[1] << 16); o.w = (unsigned)(unsigned short)hi4[2] | ((unsigned)(unsigned short)hi4[3] << 16); \
              *(v4u*)(vfb + ((dt) * 2 + (s2)) * 512 + F.lane * 8) = o; } while (0)
          VF_TR(0, 0); VF_TR(0, 1); VF_TR(1, 0); VF_TR(1, 1);
#undef VF_TR
          LDS_WAIT(); asm volatile("" ::: "memory");
      }
#undef KB_UNIT
#undef KB_FETCH
    }
    P4_STAMP(0);
    const bf16* STATES = (const bf16*)(F.ws + WS_STATES); const float* DECAY = (const float*)(F.ws + WS_DECAY); bf16* HIN = (bf16*)(F.ws + WS_HIN);
    for (int e2 = blockIdx.x * NTHR + F.tid; e2 < NB * NH * 2048; e2 += F.G * NTHR) {
        const int e = 2 * e2; const int b = e / (NH * 4096), hh = (e / 4096) % NH, pn = e % 4096;
        float h0 = 0.f, h1 = 0.f;
        static_assert(NCH == 33, "three batches of 11 chunks");
        unsigned sa[11], sb[11]; float da[11], db[11];
#define CH_LOAD(ST, DC, c0) do { _Pragma("unroll") for (int j = 0; j < 11; ++j) { const int c = (c0) + j; ST[j] = *(const unsigned*)(STATES + ((size_t)((b * NCH + c) * NH + hh)) * 4096 + pn); DC[j] = DECAY[(b * NCH + c) * NH + hh]; } } while (0)
#define CH_STEP(ST, DC, c0) do { _Pragma("unroll") for (int j = 0; j < 11; ++j) { const int c = (c0) + j; *(unsigned*)(HIN + ((size_t)((b * NCH + c) * NH + hh)) * 4096 + pn) = pk2(h0, h1); h0 = h0 * DC[j] + bflo(ST[j]); h1 = h1 * DC[j] + bfhi(ST[j]); } } while (0)
        CH_LOAD(sa, da, 0); CH_LOAD(sb, db, 11);
        CH_STEP(sa, da, 0);
        CH_LOAD(sa, da, 22);
        CH_STEP(sb, db, 11);
        CH_STEP(sa, da, 22);
#undef CH_LOAD
#undef CH_STEP
        *(f32x2_t*)(F.out + OUT_SSMP + e) = (f32x2_t){h0, h1};
    }
    P4_STAMP(1);
    const float* XAS = (const float*)(F.ws + WS_XAS); const float* DT = (const float*)(F.ws + WS_DT); const float* sst = (const float*)F.in[5];
    const float* a_log = (const float*)F.in[13]; const float* d_skip = (const float*)F.in[14]; float* YS = (float*)(F.ws + WS_YS);
    for (int u = F.gw; u < DB * NH * 16; u += F.NGW) {
        const int pq = u & 15, hh = (u >> 4) & 7, b = u >> 7; const int g = hh >> 2; const int p = 4 * pq + (F.lane >> 4), n4 = F.lane & 15;
        const float dt = DT[(size_t)(RP + b) * 8 + hh]; const float a = __expf(dt * -__expf(a_log[hh]));
        const float x = XAS[(size_t)b * CONVD + hh * HP + p]; const float uu = dt * x;
        const f32x4 Bv = *(const f32x4*)(XAS + (size_t)b * CONVD + SSDW + g * DS + 4 * n4), Cv = *(const f32x4*)(XAS + (size_t)b * CONVD + SSDW + 128 + g * DS + 4 * n4);
        const size_t si = (((size_t)b * NH + hh) * HP + p) * DS + 4 * n4;
        const f32x4 s0 = *(const f32x4*)(sst + si); const f32x4 s1 = s0 * a + uu * Bv;
        *(f32x4*)(F.out + OUT_SSMS + si) = s1;
        float y = (Cv.x * s1.x + Cv.y * s1.y) + (Cv.z * s1.z + Cv.w * s1.w);
        y = sum_x1(y); y = sum_x2(y); y = sum_x4(y); y = sum_x8(y);
        if (n4 == 0) YS[(size_t)b * 512 + hh * HP + p] = y + d_skip[hh] * x;
    }
}
constexpr int DA_ROWB = 528;
constexpr int DA_LAT = 0, DA_KR = 128 * DA_ROWB, DA_PB = DA_KR + 128 * 33 * 4, DA_QG = DA_PB + 2 * 16 * 32 * 2, DA_END = DA_QG + 8 * 96 * 4;
constexpr int P5_EXCH = 100 * 1024;
static_assert(DA_END <= P5_EXCH, "LDS map of P5");

constexpr int AT_SLOT = 20480, AT_D = 4;
__device__ __forceinline__ void at_issue(Frame& F, const bf16* kt_k, const bf16* kt_v, LAS unsigned char* slot) {
    const int w = F.wave;
    __builtin_amdgcn_global_load_lds((const unsigned*)((const char*)kt_k + w * 1024 + F.lane * 16), (LAS unsigned*)(slot + w * 1024), 16, 0, 0);
    const char* srcB = (w < 4) ? (const char*)kt_k + 8192 + w * 1024 : (const char*)kt_v + (w - 4) * 1024;
    __builtin_amdgcn_global_load_lds((const unsigned*)(srcB + F.lane * 16), (LAS unsigned*)(slot + 8192 + w * 1024), 16, 0, 0);
    __builtin_amdgcn_global_load_lds((const unsigned*)((const char*)kt_v + 4096 + w * 256 + F.lane * 4), (LAS unsigned*)(slot + 16384 + w * 256), 4, 0, 0);
    __builtin_amdgcn_global_load_lds((const unsigned*)((const char*)kt_v + 6144 + w * 256 + F.lane * 4), (LAS unsigned*)(slot + 18432 + w * 256), 4, 0, 0);
}
__device__ __forceinline__ void p5_attn_prompt(Frame& F, float M0) {
    const bf16* QRAW = (const bf16*)(F.ws + WS_QRAW); const bf16* KF = (const bf16*)(F.ws + WS_K); const bf16* VF = (const bf16*)(F.ws + WS_VT); bf16* MIXA = (bf16*)(F.ws + WS_MIX); float* SSQ = (float*)(F.ws + WS_SSQ);
    const float* ROPE = (const float*)(F.ws + WS_ROPE); const float* gqn = (const float*)F.in[20]; const float* gqr = (const float*)F.in[21]; const float* RQS = (const float*)(F.ws + WS_RQ);
    LAS unsigned char* ring = F.lds + RING_OFF;
    const int w = F.wave, r32 = F.lane & 31, hi = F.lane >> 5;
    f32x16 negm;
#pragma unroll
    for (int i = 0; i < 16; ++i) negm[i] = -M0;
    for (int u = F.vcu; u < 256; u += F.G) {
        const int b = u >> 5, h = (u >> 2) & 7, pr = u & 3;
        const bf16* kfb = KF + ((size_t)((b * NH + h) * NKT)) * (6 * 512); const bf16* vfb = VF + ((size_t)((b * NH + h) * NKT)) * (4 * 512);
#pragma unroll 1
        for (int half = 0; half < 2; ++half) {
            const int qb = half ? 7 - pr : pr; const int a = 8 * qb + w; const int qi = NMETA + 32 * a + r32;
            const int nkt = 8 * qb + 9, nkw = a + 2;
            bf16x8 qf[6];
            { const bf16* qp = QRAW + (size_t)(b * TT + qi) * 768 + 96 * h + 8 * hi;
              v4u qw[6];
#pragma unroll
              for (int s = 0; s < 6; ++s) qw[s] = *(const v4u*)(qp + 16 * s);
              f32x4 cs[4];
#pragma unroll
              for (int i = 0; i < 4; ++i) cs[i] = *(const f32x4*)(ROPE + 2 * (qi * 16 + 8 * hi) + 4 * i);
              float qv[6][8]; float ss = 0.f;
#pragma unroll
              for (int s = 0; s < 6; ++s) { const unsigned ww[4] = {qw[s].x, qw[s].y, qw[s].z, qw[s].w};
#pragma unroll
                  for (int e = 0; e < 4; ++e) { qv[s][2 * e] = bflo(ww[e]); qv[s][2 * e + 1] = bfhi(ww[e]); ss += qv[s][2 * e] * qv[s][2 * e] + qv[s][2 * e + 1] * qv[s][2 * e + 1]; } }
              ss = sum_x32(ss);
              const float sq = RQS[b * TT + qi];
              const float rs = (ATTN_SCALE * LOG2E) * sq * __builtin_amdgcn_rsqf(ss * sq * sq * (1.f / 96.f) + EPS);
#pragma unroll
              for (int jj = 0; jj < 8; ++jj) { const float c = cs[jj >> 1][2 * (jj & 1)], sn = cs[jj >> 1][2 * (jj & 1) + 1]; const float x1 = qv[4][jj], x2 = qv[5][jj];
                  const float gr = gqr[8 * hi + jj] * rs; qv[4][jj] = (x1 * c - x2 * sn) * gr; qv[5][jj] = (x1 * sn + x2 * c) * gr; }
#pragma unroll
              for (int s = 0; s < 4; ++s) { const f32x4 g0 = *(const f32x4*)(gqn + 16 * s + 8 * hi), g1 = *(const f32x4*)(gqn + 16 * s + 8 * hi + 4);
                  qv[s][0] *= g0.x * rs; qv[s][1] *= g0.y * rs; qv[s][2] *= g0.z * rs; qv[s][3] *= g0.w * rs; qv[s][4] *= g1.x * rs; qv[s][5] *= g1.y * rs; qv[s][6] *= g1.z * rs; qv[s][7] *= g1.w * rs; }
#pragma unroll
              for (int s = 0; s < 6; ++s) { v4u o; o.x = pk2(qv[s][0], qv[s][1]); o.y = pk2(qv[s][2], qv[s][3]); o.z = pk2(qv[s][4], qv[s][5]); o.w = pk2(qv[s][6], qv[s][7]); qf[s] = __builtin_bit_cast(bf16x8, o); } }
            f32x16 o0 = (f32x16){}, o1 = (f32x16){}; float l = 0.f;
            const int ns = (nkt + 1) >> 1;
#pragma unroll
            for (int j = 0; j < AT_D - 1; ++j) at_issue(F, kfb + (size_t)j * 6144, vfb + (size_t)j * 4096, ring + j * AT_SLOT);
#pragma unroll 1
            for (int st = 0; st < ns; ++st) {
                const int rem = ns - 1 - st;
                if (rem >= 2) asm volatile("s_waitcnt vmcnt(8)" ::: "memory"); else if (rem == 1) asm volatile("s_waitcnt vmcnt(4)" ::: "memory"); else asm volatile("s_waitcnt vmcnt(0)" ::: "memory");
                __builtin_amdgcn_s_barrier(); asm volatile("" ::: "memory");
                if (st + AT_D - 1 < ns) at_issue(F, kfb + (size_t)(st + AT_D - 1) * 6144, vfb + (size_t)(st + AT_D - 1) * 4096, ring + ((st + AT_D - 1) & (AT_D - 1)) * AT_SLOT);
#pragma unroll
                for (int tt = 0; tt < 2; ++tt) { const int kt = 2 * st + tt;
                  if (kt < nkw) {
                    const LAS unsigned char* sl = ring + (st & (AT_D - 1)) * AT_SLOT + F.lane * 16; const int j0 = 32 * kt;
                    f32x16 S = negm;
#pragma unroll
                    for (int s = 0; s < 6; ++s) S = MFMA32(*(const LAS bf16x8*)(sl + tt * 6144 + 1024 * s), qf[s], S);
                    bf16x8 vf[4];
#pragma unroll
                    for (int i = 0; i < 4; ++i) vf[i] = *(const LAS bf16x8*)(sl + 12288 + tt * 4096 + 1024 * i);
#pragma unroll
                    for (int i = 0; i < 16; ++i) S[i] = __builtin_amdgcn_exp2f(S[i]);
                    if (kt >= a) {
#pragma unroll
                        for (int i = 0; i < 16; ++i) if (j0 + crow(i, hi) > qi) S[i] = 0.f; }
#pragma unroll
                    for (int i = 0; i < 16; ++i) l += S[i];
                    const bf16x8 p0 = pack8(S, 0), p1 = pack8(S, 1);
                    o0 = MFMA32(vf[0], p0, o0); o0 = MFMA32(vf[1], p1, o0);
                    o1 = MFMA32(vf[2], p0, o1); o1 = MFMA32(vf[3], p1, o1);
                  } }
            }
            l = sum_x32(l);
            const float il = __builtin_amdgcn_rcpf(l);
            bf16* ao = MIXA + (size_t)(b * TT + qi) * 1024 + 512 + 64 * h + 4 * hi; float ssq = 0.f;
#pragma unroll
            for (int gq = 0; gq < 4; ++gq) {
                v2u w0, w1; w0.x = pk2(o0[4 * gq] * il, o0[4 * gq + 1] * il); w0.y = pk2(o0[4 * gq + 2] * il, o0[4 * gq + 3] * il);
                w1.x = pk2(o1[4 * gq] * il, o1[4 * gq + 1] * il); w1.y = pk2(o1[4 * gq + 2] * il, o1[4 * gq + 3] * il);
                ssq += (bflo(w0.x) * bflo(w0.x) + bfhi(w0.x) * bfhi(w0.x)) + (bflo(w0.y) * bflo(w0.y) + bfhi(w0.y) * bfhi(w0.y));
                ssq += (bflo(w1.x) * bflo(w1.x) + bfhi(w1.x) * bfhi(w1.x)) + (bflo(w1.y) * bflo(w1.y) + bfhi(w1.y) * bfhi(w1.y));
                *(v2u*)(ao + 8 * gq) = w0; *(v2u*)(ao + 32 + 8 * gq) = w1; }
            ssq = sum_x32(ssq);
            if (hi == 0) SSQ[(size_t)(b * TT + qi) * 8 + h] = ssq;
            asm volatile("s_waitcnt lgkmcnt(0)" ::: "memory"); __builtin_amdgcn_s_barrier(); asm volatile("" ::: "memory");
        }
    }
}

constexpr int SO_X = 0, SO_H = 36864, SO_B = 73728, SO_C = 82944, SO_Z = 92160, SO_TAB = 125952, SO_EX = 130048;
static_assert(SO_EX + 1024 <= RING_BYTES, "ssd_out LDS map");
__device__ __forceinline__ void p5_ssd_out(Frame& F) {
    const float* DT = (const float*)(F.ws + WS_DT); const float* a_log = (const float*)F.in[13]; const float* d_skip = (const float*)F.in[14]; const float* ng = (const float*)F.in[15];
    const bf16* XST = (const bf16*)(F.ws + WS_XST); const bf16* BC = (const bf16*)(F.ws + WS_BC); const bf16* HIN = (const bf16*)(F.ws + WS_HIN); const bf16* PROJ = (const bf16*)(F.ws + WS_PROJ);
    bf16* MIX = (bf16*)(F.ws + WS_MIX);
    LAS unsigned char* L = F.lds + RING_OFF;
    LAS float* tab = (LAS float*)(L + SO_TAB) + F.wave * 128;
    LAS float* exch = (LAS float*)(L + SO_EX);
    const int hl = F.wave >> 1, it = F.wave & 1, r32 = F.lane & 31, hi = F.lane >> 5;
    for (int u = blockIdx.x; u < NB * (NCH - 1); u += F.G) {
        const int b = u / (NCH - 1), c = 1 + u % (NCH - 1); const int t0 = c * CHL - TOFF;
        v4u st[14];
#define SO_FETCH_A(g) do { \
        _Pragma("unroll") for (int k = 0; k < 4; ++k) { const int q = F.tid + NTHR * k; st[k] = *(const v4u*)(XST + ((size_t)(b * SSDW + (g) * 256 + (q >> 3))) * TPAD + c * CHL + 8 * (q & 7)); } } while (0)
#define SO_FETCH_B(g) do { \
        _Pragma("unroll") for (int k = 0; k < 4; ++k) { const int q = F.tid + NTHR * k; st[4 + k] = *(const v4u*)(HIN + ((size_t)((b * NCH + c) * NH + 4 * (g))) * 4096 + (size_t)q * 8); } \
        { const int q = F.tid; st[8] = *(const v4u*)(BC + (size_t)(b * TT + t0 + (q >> 3)) * 256 + (g) * DS + 8 * (q & 7)); st[9] = *(const v4u*)(BC + (size_t)(b * TT + t0 + (q >> 3)) * 256 + 128 + (g) * DS + 8 * (q & 7)); } \
        _Pragma("unroll") for (int k = 0; k < 4; ++k) { const int q = F.tid + NTHR * k; st[10 + k] = *(const v4u*)(PROJ + (size_t)(b * TT + t0 + (q >> 5)) * PJ + C_Z + (g) * 256 + 8 * (q & 31)); } } while (0)
#define SO_STORE() do { \
        _Pragma("unroll") for (int k = 0; k < 4; ++k) { const int q = F.tid + NTHR * k; *(LAS v4u*)(L + SO_X + (q >> 3) * 144 + 16 * (q & 7)) = st[k]; *(LAS v4u*)(L + SO_H + (q >> 3) * 144 + 16 * (q & 7)) = st[4 + k]; } \
        { const int q = F.tid; *(LAS v4u*)(L + SO_B + (q >> 3) * 144 + 16 * (q & 7)) = st[8]; *(LAS v4u*)(L + SO_C + (q >> 3) * 144 + 16 * (q & 7)) = st[9]; } \
        _Pragma("unroll") for (int k = 0; k < 4; ++k) { const int q = F.tid + NTHR * k; *(LAS v4u*)(L + SO_Z + (q >> 5) * 528 + 16 * (q & 31)) = st[10 + k]; } } while (0)
        SO_FETCH_A(0); SO_FETCH_B(0);
#pragma unroll 1
        for (int g = 0; g < 2; ++g) {
            const int h = 4 * g + hl; const float A = -__expf(a_log[h]), Dh = d_skip[h];
            { const int t = t0 + F.lane; const float dt = DT[(size_t)(b * TT + t) * 8 + h];
              float acs = dt * A;
#pragma unroll
              for (int o = 1; o < 64; o <<= 1) { const float v = __shfl_up(acs, o); if (F.lane >= o) acs += v; }
              tab[F.lane] = acs; tab[64 + F.lane] = dt; }
            SO_STORE();
            __syncthreads();
            if (g == 0) SO_FETCH_A(1);
            const int ii = 32 * it + r32; const int t = t0 + ii;
            bf16x8 cf[4];
#pragma unroll
            for (int s = 0; s < 4; ++s) cf[s] = *(const LAS bf16x8*)(L + SO_C + ii * 144 + 32 * s + 16 * hi);
            f32x16 y[2];
            const float ai = tab[ii]; const float ei = __expf(ai);
#pragma unroll
            for (int pt = 0; pt < 2; ++pt) { f32x16 acc = (f32x16){}; const LAS unsigned char* hp_ = L + SO_H + (hl * 64 + 32 * pt + r32) * 144 + 16 * hi;
#pragma unroll
                for (int s = 0; s < 4; ++s) acc = MFMA32(*(const LAS bf16x8*)(hp_ + 32 * s), cf[s], acc);
#pragma unroll
                for (int i = 0; i < 16; ++i) acc[i] *= ei;
                y[pt] = acc; }
#pragma unroll 1
            for (int jt = 0; jt <= it; ++jt) {
                f32x16 S = (f32x16){};
                { const LAS unsigned char* bp_ = L + SO_B + (32 * jt + r32) * 144 + 16 * hi;
#pragma unroll
                  for (int s = 0; s < 4; ++s) S = MFMA32(*(const LAS bf16x8*)(bp_ + 32 * s), cf[s], S); }
#pragma unroll
                for (int i = 0; i < 16; ++i) { const int jj = 32 * jt + crow(i, hi); const float e = (jj <= ii) ? __expf(ai - tab[jj]) * tab[64 + jj] : 0.f; S[i] = S[i] * e + ((jj == ii) ? Dh : 0.f); }
                const bf16x8 p0 = pack8(S, 0), p1 = pack8(S, 1);
#pragma unroll
                for (int pt = 0; pt < 2; ++pt) { const LAS unsigned char* xp_ = L + SO_X + (hl * 64 + 32 * pt + r32) * 144 + (32 * jt + 4 * hi) * 2;
                    const v2u x0 = *(const LAS v2u*)(xp_), x1 = *(const LAS v2u*)(xp_ + 16), x2 = *(const LAS v2u*)(xp_ + 32), x3 = *(const LAS v2u*)(xp_ + 48);
                    v4u f0, f1; f0.x = x0.x; f0.y = x0.y; f0.z = x1.x; f0.w = x1.y; f1.x = x2.x; f1.y = x2.y; f1.z = x3.x; f1.w = x3.y;
                    y[pt] = MFMA32(__builtin_bit_cast(bf16x8, f0), p0, y[pt]); y[pt] = MFMA32(__builtin_bit_cast(bf16x8, f1), p1, y[pt]); }
            }
            float ss = 0.f;
            { const LAS unsigned char* zp_ = L + SO_Z + ii * 528 + (hl * 64 + 4 * hi) * 2;
#pragma unroll
              for (int pt = 0; pt < 2; ++pt)
#pragma unroll
                for (int gq = 0; gq < 4; ++gq) { const v2u zw = *(const LAS v2u*)(zp_ + (32 * pt + 8 * gq) * 2); const float zz[4] = {bflo(zw.x), bfhi(zw.x), bflo(zw.y), bfhi(zw.y)};
#pragma unroll
                    for (int e = 0; e < 4; ++e) { const float v = y[pt][4 * gq + e] * silu_f(zz[e]); y[pt][4 * gq + e] = v; ss += v * v; } } }
            ss = sum_x32(ss);
            if (g == 0) SO_FETCH_B(1);
            LAS float* ex = exch + it * 128;
            if (hi == 0) ex[hl * 32 + r32] = ss;
            __syncthreads();
            const float tot = (ex[r32] + ex[32 + r32]) + (ex[64 + r32] + ex[96 + r32]);
            const float rs = __builtin_amdgcn_rsqf(tot * (1.f / 256.f) + EPS);
            { bf16* mo = MIX + (size_t)(b * TT + t) * 1024 + 64 * h + 4 * hi;
#pragma unroll
              for (int pt = 0; pt < 2; ++pt)
#pragma unroll
                for (int gq = 0; gq < 4; ++gq) { const f32x4 gg = *(const f32x4*)(ng + 64 * h + 32 * pt + 8 * gq + 4 * hi);
                    v2u w; w.x = pk2(y[pt][4 * gq] * rs * gg.x, y[pt][4 * gq + 1] * rs * gg.y); w.y = pk2(y[pt][4 * gq + 2] * rs * gg.z, y[pt][4 * gq + 3] * rs * gg.w);
                    *(v2u*)(mo + 32 * pt + 8 * gq) = w; } }
        }
#undef SO_FETCH_A
#undef SO_FETCH_B
#undef SO_STORE
        __syncthreads();
    }
    const float* YS = (const float*)(F.ws + WS_YS);
    for (int u = F.gw; u < DB * NG; u += F.NGW) { const int b = u >> 1, gg = u & 1; const int cc = gg * 256 + 4 * F.lane;
        const f32x4 yv = *(const f32x4*)(YS + (size_t)b * 512 + cc); const v2u zw = *(const v2u*)(PROJ + (size_t)(RP + b) * PJ + C_Z + cc);
        const f32x4 v = {yv.x * silu_f(bflo(zw.x)), yv.y * silu_f(bfhi(zw.x)), yv.z * silu_f(bflo(zw.y)), yv.w * silu_f(bfhi(zw.y))};
        const float rs = __builtin_amdgcn_rsqf(wave_sum((v.x * v.x + v.y * v.y) + (v.z * v.z + v.w * v.w)) * (1.f / 256.f) + EPS);
        const f32x4 gv = *(const f32x4*)(ng + cc); v2u w; w.x = pk2(v.x * rs * gv.x, v.y * rs * gv.y); w.y = pk2(v.z * rs * gv.z, v.w * rs * gv.w);
        *(v2u*)(MIX + (size_t)(RP + b) * 1024 + cc) = w; }
}

constexpr int DB_STAGE = 0, DB_KRST = 65536, DB_LAT = DB_KRST + 8192, DB_KR = DB_LAT + 64 * DA_ROWB, DB_PB = DB_KR + 64 * 36 * 4, DB_QG = DB_PB + 16 * 64 * 2, DB_END = DB_QG + 8 * 96 * 4;
static_assert(DB_END <= RING_BYTES, "decode attention LDS map");
#define RAW_BAR_L() do { asm volatile("s_waitcnt lgkmcnt(0)" ::: "memory"); __builtin_amdgcn_s_barrier(); asm volatile("" ::: "memory"); } while (0)
#define RAW_BAR_VL() do { asm volatile("s_waitcnt vmcnt(0) lgkmcnt(0)" ::: "memory"); __builtin_amdgcn_s_barrier(); asm volatile("" ::: "memory"); } while (0)
__device__ __forceinline__ void da_issue(Frame& F, LAS unsigned char* L, const float* clat, const float* ckr, const int* ptab, int b, int split, int hp) {
    const size_t tok0 = (size_t)ptab[b * NPAGES + split * 32 + (hp >> 1)] * PAGE + (hp & 1) * 64;
    const char* src = (const char*)(clat + tok0 * KVL) + (size_t)(F.wave * 8) * 1024 + F.lane * 16;
#pragma unroll
    for (int i = 0; i < 8; ++i) __builtin_amdgcn_global_load_lds((const unsigned*)(src + i * 1024), (LAS unsigned*)(L + DB_STAGE + (F.wave * 8 + i) * 1024), 16, 0, 0);
    __builtin_amdgcn_global_load_lds((const unsigned*)((const char*)(ckr + tok0 * 32) + F.wave * 1024 + F.lane * 16), (LAS unsigned*)(L + DB_KRST + F.wave * 1024), 16, 0, 0);
}
__device__ __forceinline__ void da_convert(Frame& F, LAS unsigned char* L) {
#pragma unroll 4
    for (int k = 0; k < 8; ++k) { const int f = F.tid + NTHR * k; const int row = f >> 6, c4 = f & 63; const f32x4 v = *(const LAS f32x4*)(L + DB_STAGE + f * 16);
        v2u w; w.x = pk2(v.x, v.y); w.y = pk2(v.z, v.w); *(LAS v2u*)(L + DB_LAT + row * DA_ROWB + c4 * 8) = w; }
    { const int f = F.tid; const int row = f >> 3, c4 = f & 7; const f32x4 v = *(const LAS f32x4*)(L + DB_KRST + f * 16);
      *(LAS f32x4*)((LAS float*)(L + DB_KR) + row * 36 + 4 * c4) = v; }
}
__device__ __forceinline__ void st_wt(float* p, float v) { asm volatile("global_store_dword %0, %1, off sc0 sc1" :: "v"(p), "v"(v) : "memory"); }
__device__ __forceinline__ void decode_combine_one(Frame& F, float M0, int b) {
    const float* DPART = (const float*)(F.ws + WS_DPART); const bf16* WUKV = (const bf16*)(F.ws + WS_WUKV2); const bf16* Q = (const bf16*)(F.ws + WS_Q); const bf16* KS = (const bf16*)(F.ws + WS_KS);
    const float* VS = (const float*)(F.ws + WS_VS); bf16* MIX = (bf16*)(F.ws + WS_MIX);
    LAS float* accl = (LAS float*)(F.lds + RING_OFF) + F.wave * 256; LAS float* exch = (LAS float*)(F.lds + P5_EXCH);
    const int h = F.wave;
    const float* p0 = DPART + ((size_t)((b * 2 + 0) * NH + h)) * 264; const float* p1 = DPART + ((size_t)((b * 2 + 1) * NH + h)) * 264;
#pragma unroll
    for (int k = 0; k < 4; ++k) accl[F.lane + 64 * k] = p0[F.lane + 64 * k] + p1[F.lane + 64 * k];
    float l = p0[256] + p1[256];
    const bf16* qp = Q + (size_t)(RP + b) * 768 + 96 * h; const bf16* kp = KS + (size_t)b * 768 + 96 * h;
    float sd = bf2f(qp[F.lane]) * bf2f(kp[F.lane]); if (F.lane < 32) sd += bf2f(qp[64 + F.lane]) * bf2f(kp[64 + F.lane]);
    sd = wave_sum(sd);
    const float pn = __builtin_amdgcn_exp2f(sd - M0); l += pn;
    LDS_WAIT(); asm volatile("" ::: "memory");
    const bf16* wv = WUKV + (size_t)(128 * h + 64 + F.lane) * KVL;
    float o = 0.f;
    { v4u wv4[32];
#pragma unroll
      for (int c8 = 0; c8 < 32; ++c8) wv4[c8] = *(const v4u*)(wv + 8 * c8);
#pragma unroll
      for (int c8 = 0; c8 < 32; ++c8) { const v4u w = wv4[c8]; const f32x4 x0 = *(const LAS f32x4*)(accl + 8 * c8), x1 = *(const LAS f32x4*)(accl + 8 * c8 + 4);
        o += (bflo(w.x) * x0.x + bfhi(w.x) * x0.y) + (bflo(w.y) * x0.z + bfhi(w.y) * x0.w) + (bflo(w.z) * x1.x + bfhi(w.z) * x1.y) + (bflo(w.w) * x1.z + bfhi(w.w) * x1.w); } }
    o = (o + pn * VS[(size_t)b * 512 + 64 * h + F.lane]) * __builtin_amdgcn_rcpf(l);
    const float ss = wave_sum(o * o);
    if (F.lane == 0) exch[h] = ss;
    __syncthreads();
    float tot = 0.f;
#pragma unroll
    for (int hh = 0; hh < NH; ++hh) tot += exch[hh];
    const float rs = __builtin_amdgcn_rsqf(tot * (1.f / MLAW) + EPS);
    MIX[(size_t)(RP + b) * 1024 + 512 + 64 * h + F.lane] = f2bf(o * rs);
    __syncthreads();
}
template <int MODE>
__device__ __forceinline__ void p5_attn_decode_t(Frame& F, float M0) {
    const float* clat = (const float*)F.in[2]; const float* ckr = (const float*)F.in[3]; const int* ptab = (const int*)F.in[6];
    const bf16* WUKV = (const bf16*)(F.ws + WS_WUKV2); const bf16* Q = (const bf16*)(F.ws + WS_Q); const float* gkn = (const float*)F.in[22]; const float* gkr = (const float*)F.in[23];
    float* DPART = (float*)(F.ws + WS_DPART);
    LAS unsigned char* L = F.lds + RING_OFF;
    LAS float* krl = (LAS float*)(L + DB_KR); LAS bf16* pb = (LAS bf16*)(L + DB_PB); LAS float* qg = (LAS float*)(L + DB_QG) + F.wave * 96;
    const int h = F.wave, r32 = F.lane & 31, hi = F.lane >> 5;
    for (int u = blockIdx.x; u < DB * 2; u += F.G) {
        const int b = u >> 1, split = u & 1;
        da_issue(F, L, clat, ckr, ptab, b, split, 0);
        bf16x8 wf[4][8];
#pragma unroll
        for (int dt = 0; dt < 4; ++dt)
#pragma unroll
            for (int s = 0; s < 8; ++s) wf[dt][s] = *(const bf16x8*)(WUKV + (size_t)(128 * h + 16 * dt + (F.lane & 15)) * KVL + 32 * s + 8 * (F.lane >> 4));
        { const bf16* qp = Q + (size_t)(RP + b) * 768 + 96 * h; qg[F.lane] = bf2f(qp[F.lane]) * gkn[F.lane]; if (F.lane < 32) qg[64 + F.lane] = bf2f(qp[64 + F.lane]) * gkr[F.lane & 15]; }
        for (int i = F.tid; i < 16 * 64; i += NTHR) pb[i] = 0;
        f32x4 ao[2] = {(f32x4){0.f, 0.f, 0.f, 0.f}, (f32x4){0.f, 0.f, 0.f, 0.f}}; float l = 0.f;
        RAW_BAR_VL();
        da_convert(F, L);
        RAW_BAR_L();
        da_issue(F, L, clat, ckr, ptab, b, split, 1);
#pragma unroll 1
        for (int hp = 0; hp < 64; ++hp) {
          if (MODE == 0 || MODE == 3) {
            const int n16 = F.lane & 15, kg4 = F.lane >> 4;
#pragma unroll 1
            for (int sb = 0; sb < 2; ++sb) {
                const LAS unsigned char* bp = L + DB_LAT + (32 * sb + n16) * DA_ROWB + 16 * kg4;
                f32x4 acc[4][2];
#pragma unroll
                for (int dt = 0; dt < 4; ++dt) { acc[dt][0] = (f32x4){0.f, 0.f, 0.f, 0.f}; acc[dt][1] = acc[dt][0]; }
                bf16x8 fa[2], fb[2];
                fa[0] = *(const LAS bf16x8*)(bp); fa[1] = *(const LAS bf16x8*)(bp + 16 * DA_ROWB);
#pragma unroll
                for (int s = 0; s < 8; ++s) {
                    if (s < 7) { fb[0] = *(const LAS bf16x8*)(bp + 64 * (s + 1)); fb[1] = *(const LAS bf16x8*)(bp + 16 * DA_ROWB + 64 * (s + 1)); }
#pragma unroll
                    for (int dt = 0; dt < 4; ++dt) { acc[dt][0] = MFMA16(wf[dt][s], fa[0], acc[dt][0]); acc[dt][1] = MFMA16(wf[dt][s], fa[1], acc[dt][1]); }
                    fa[0] = fb[0]; fa[1] = fb[1];
                }
                __builtin_amdgcn_sched_barrier(0);
                f32x4 s4[2] = {(f32x4){0.f, 0.f, 0.f, 0.f}, (f32x4){0.f, 0.f, 0.f, 0.f}}, d4[2] = {s4[0], s4[0]};
#pragma unroll
                for (int dt = 0; dt < 4; ++dt) { const f32x4 qq = *(const LAS f32x4*)(qg + 16 * dt + 4 * kg4);
#pragma unroll
                    for (int tt = 0; tt < 2; ++tt) { s4[tt] += acc[dt][tt] * acc[dt][tt]; d4[tt] += acc[dt][tt] * qq; } }
                { const LAS float* qr = qg + 64 + 8 * kg4; const f32x4 q0 = *(const LAS f32x4*)(qr), q1 = *(const LAS f32x4*)(qr + 4);
#pragma unroll
                  for (int tt = 0; tt < 2; ++tt) { const LAS float* kr = krl + (32 * sb + 16 * tt + n16) * 36 + 8 * kg4; const f32x4 k0 = *(const LAS f32x4*)(kr), k1 = *(const LAS f32x4*)(kr + 4);
                      s4[tt] += k0 * k0; s4[tt] += k1 * k1; d4[tt] += k0 * q0; d4[tt] += k1 * q1; } }
                __builtin_amdgcn_sched_barrier(0);
#pragma unroll
                for (int tt = 0; tt < 2; ++tt) { float ss = (s4[tt].x + s4[tt].y) + (s4[tt].z + s4[tt].w), dot = (d4[tt].x + d4[tt].y) + (d4[tt].z + d4[tt].w);
                    ss = sum_x16(ss); dot = sum_x16(dot); ss = sum_x32(ss); dot = sum_x32(dot);
                    const float p = __builtin_amdgcn_exp2f(dot * __builtin_amdgcn_rsqf(ss * (1.f / 96.f) + EPS) - M0);
                    if (kg4 == 0) { l += p; pb[h * 64 + 32 * sb + 16 * tt + n16] = f2bf(p); } }
            }
            RAW_BAR_L();
            if (MODE < 4) { const int q4 = (F.lane & 15) >> 2, pp = F.lane & 3, kg = F.lane >> 4;
              const unsigned a_lo = (unsigned)(uintptr_t)(L + DB_LAT) + (unsigned)((8 * kg + q4) * DA_ROWB + (32 * h + 4 * pp) * 2);
              const LAS bf16* pap = pb + (F.lane & 15) * 64 + 8 * kg;
              s16x4 t0, t1, t2, t3, t4, t5, t6, t7;
              asm volatile("ds_read_b64_tr_b16 %0, %8 offset:%c9\n\tds_read_b64_tr_b16 %1, %8 offset:%c10\n\tds_read_b64_tr_b16 %2, %8 offset:%c11\n\tds_read_b64_tr_b16 %3, %8 offset:%c12\n\t"
                           "ds_read_b64_tr_b16 %4, %8 offset:%c13\n\tds_read_b64_tr_b16 %5, %8 offset:%c14\n\tds_read_b64_tr_b16 %6, %8 offset:%c15\n\tds_read_b64_tr_b16 %7, %8 offset:%c16\n\ts_waitcnt lgkmcnt(0)"
                           : "=&v"(t0), "=&v"(t1), "=&v"(t2), "=&v"(t3), "=&v"(t4), "=&v"(t5), "=&v"(t6), "=&v"(t7)
                           : "v"(a_lo), "i"(0), "i"(4 * DA_ROWB), "i"(32), "i"(32 + 4 * DA_ROWB), "i"(32 * DA_ROWB), "i"(32 * DA_ROWB + 4 * DA_ROWB), "i"(32 * DA_ROWB + 32), "i"(32 * DA_ROWB + 32 + 4 * DA_ROWB) : "memory");
              const bf16x8 pa0 = *(const LAS bf16x8*)(pap), pa1 = *(const LAS bf16x8*)(pap + 32);
#define DA_FR(x, y) ((bf16x8){x[0], x[1], x[2], x[3], y[0], y[1], y[2], y[3]})
              ao[0] = MFMA16(pa0, DA_FR(t0, t1), ao[0]); ao[1] = MFMA16(pa0, DA_FR(t2, t3), ao[1]);
              ao[0] = MFMA16(pa1, DA_FR(t4, t5), ao[0]); ao[1] = MFMA16(pa1, DA_FR(t6, t7), ao[1]);
#undef DA_FR
#define DA_PV(ks, nt) do { } while (0)
#undef DA_PV
            }
          }
            RAW_BAR_VL();
            if (hp + 1 < 64) { if (MODE <= 1 || MODE >= 3) da_convert(F, L); RAW_BAR_L(); if (hp + 2 < 64 && MODE < 3) da_issue(F, L, clat, ckr, ptab, b, split, hp + 2); }
        }
        if (MODE >= 3 && l == 123.456f) DPART[0] = l;
        if (MODE == 0) { const int kg = F.lane >> 4;
          if (kg < 2) {
#pragma unroll
              for (int nt = 0; nt < 2; ++nt)
#pragma unroll
                  for (int i = 0; i < 4; ++i) st_wt(&DPART[((size_t)((b * 2 + split) * NH + 4 * kg + i)) * 264 + 32 * h + 16 * nt + (F.lane & 15)], ao[nt][i]); }
          float lt = wave_sum(l);
          if (F.lane == 0) st_wt(&DPART[((size_t)((b * 2 + split) * NH + h)) * 264 + 256], lt); }
        asm volatile("s_waitcnt vmcnt(0)" ::: "memory");
        __syncthreads();
        { volatile LAS unsigned* arr = (volatile LAS unsigned*)(F.lds + MISC_OFF) + 16;
          if (F.tid == 0) {
              __builtin_amdgcn_fence(__ATOMIC_ACQUIRE, "agent");
              const unsigned old = __hip_atomic_fetch_add((unsigned*)(F.ws + WS_CTL) + CW_DCNT + b, 1u, __ATOMIC_RELAXED, __HIP_MEMORY_SCOPE_AGENT);
              arr[0] = old; }
          __syncthreads();
          if (MODE == 0 && arr[0] == 1u) decode_combine_one(F, M0, b);
          __syncthreads(); }
    }
}

__device__ __forceinline__ void p5_attn_decode(Frame& F, float M0) { p5_attn_decode_t<0>(F, M0); }

__device__ __forceinline__ void p7_outproj(Frame& F) {
    const bf16* MIX = (const bf16*)(F.ws + WS_MIX); const bf16* WOUT = (const bf16*)(F.ws + WS_WOUT); const float* xp = (const float*)F.in[0]; const float* xs = (const float*)F.in[1]; float* HS = (float*)(F.ws + WS_HS);
    bf16* HB = (bf16*)(F.ws + WS_XN); float* SS = (float*)(F.ws + WS_SSP); float* ysamp = F.out + OUT_YS;
    { pg8::Gemm g{MIX, WOUT, MMAIN, DM, 1024, 1, 1024}; pg8::StaticOrder S; S.init(MMAIN, DM, F.G, (int)blockIdx.x);
      LAS float* RS = (LAS float*)(F.lds + LDSCTL_OFF + 1024); const float* SSQ = (const float*)(F.ws + WS_SSQ);
#pragma unroll 1
      for (int i = 0; i < 8; ++i) { pg8::Unit uu; if (!S.next(i, uu)) break;
          int tl = (int)threadIdx.x; asm volatile("" : "+v"(tl));
          if (tl < 256) { const pg8::f32x4* sp = (const pg8::f32x4*)(SSQ + (size_t)(g.rowbase(uu.pm) + tl) * 8); const pg8::f32x4 s4 = sp[0] + sp[1];
              RS[i * 256 + tl] = __builtin_amdgcn_rsqf(((s4[0] + s4[1]) + (s4[2] + s4[3])) * (1.f / MLAW) + EPS); } }
      __syncthreads();
      EpiOutProj E{xp, F.out + OUT_YP, HB, SS, RS, 0};
      pg8::gemm_phase<EpiOutProj, pg8::StaticOrder, true, true, 8>(F.lds + RING_OFF, g, S, E); }
    { LAS f32x4* part = (LAS f32x4*)(F.lds + RING_OFF);
      for (int tp = blockIdx.x; tp < 256; tp += F.G) {
          const int t = 2 * tp + (F.wave >> 2), kq = F.wave & 3, rt = t & 7, ct = t >> 3;
          const bf16* ap = MIX + (size_t)(RP + rt * 16 + (F.lane & 15)) * 1024 + 256 * kq + 8 * (F.lane >> 4);
          const bf16* bp = WOUT + (size_t)(ct * 16 + (F.lane & 15)) * 1024 + 256 * kq + 8 * (F.lane >> 4);
          bf16x8 av[8], bv[8];
#pragma unroll
          for (int j = 0; j < 8; ++j) { av[j] = *(const bf16x8*)(ap + 32 * j); bv[j] = *(const bf16x8*)(bp + 32 * j); }
          f32x4 acc = {0.f, 0.f, 0.f, 0.f};
#pragma unroll
          for (int j = 0; j < 8; ++j) acc = MFMA16(av[j], bv[j], acc);
          part[F.wave * 64 + F.lane] = acc;
          __syncthreads();
          if (kq == 0) { acc = (acc + part[(F.wave + 1) * 64 + F.lane]) + (part[(F.wave + 2) * 64 + F.lane] + part[(F.wave + 3) * 64 + F.lane]);
              const int col = ct * 16 + (F.lane & 15);
#pragma unroll
              for (int i = 0; i < 4; ++i) { const int r = rt * 16 + 4 * (F.lane >> 4) + i; const size_t o = (size_t)r * DM + col; const float v = xs[o] + acc[i]; HS[o] = v; ysamp[o] = v; HB[(size_t)(RP + r) * DM + col] = f2bf(v);
                  float ss = v * v; ss = sum_x1(ss); ss = sum_x2(ss); ss = sum_x4(ss); ss = sum_x8(ss);
                  if ((F.lane & 15) == 0) SS[(size_t)MMAIN * 16 + (size_t)r * 64 + ct] = ss; } }
          __syncthreads();
      } }
}
__device__ __forceinline__ void p9_gateup(Frame& F) {
    const bf16* HB = (const bf16*)(F.ws + WS_XN); const bf16* WGU = (const bf16*)(F.ws + WS_WGU); bf16* ACT = (bf16*)(F.ws + WS_ACT); const float* SS = (const float*)(F.ws + WS_SSP);
    { pg8::Gemm g{HB, WGU, MMAIN, 2 * DFF, DM, 1, DM}; pg8::StaticOrder S; S.init(MMAIN, 2 * DFF, F.G, (int)blockIdx.x);
      LAS float* RS = (LAS float*)(F.lds + LDSCTL_OFF + 1024);
      int pm_prev = -1;
#pragma unroll 1
      for (int i = 0; i < 8; ++i) { pg8::Unit uu; if (!S.next(i, uu)) break;
          int tl = (int)threadIdx.x; asm volatile("" : "+v"(tl));
          if (tl < 256) {
              if (uu.pm == pm_prev) RS[i * 256 + tl] = RS[(i - 1) * 256 + tl];
              else { const pg8::f32x4* sp = (const pg8::f32x4*)(SS + (size_t)(uu.pm * 256 + tl) * 16); const pg8::f32x4 s4 = (sp[0] + sp[1]) + (sp[2] + sp[3]);
                  RS[i * 256 + tl] = __builtin_amdgcn_rsqf(((s4[0] + s4[1]) + (s4[2] + s4[3])) * (1.f / DM) + EPS); } }
          pm_prev = uu.pm; }
      __syncthreads();
      EpiSwiGLU E{ACT, RS, 0};
      pg8::gemm_phase<EpiSwiGLU, pg8::StaticOrder, true, true>(F.lds + RING_OFF, g, S, E); }
    const int gw = F.gw, ngw = F.NGW;
    const int nrt = DB / 16, nlt = DFF / 16;
    for (int task = gw; task < nrt * nlt; task += ngw) {
        const int rt = task % nrt, lt = task / nrt; const int lc = lt * 16 + (F.lane & 15);
        const bf16* ap = HB + (size_t)(RP + rt * 16 + (F.lane & 15)) * DM + 8 * (F.lane >> 4);
        const bf16* gp = WGU + (size_t)(256 * (lc >> 7) + (lc & 127)) * DM + 8 * (F.lane >> 4); const bf16* up = gp + (size_t)128 * DM;
        f32x4 ag = {0.f, 0.f, 0.f, 0.f}, au = {0.f, 0.f, 0.f, 0.f};
#pragma unroll 8
        for (int k0 = 0; k0 < DM; k0 += 32) { const bf16x8 a = *(const bf16x8*)(ap + k0); ag = MFMA16(a, *(const bf16x8*)(gp + k0), ag); au = MFMA16(a, *(const bf16x8*)(up + k0), au); }
#pragma unroll
        for (int i = 0; i < 4; ++i) { const int r = rt * 16 + 4 * (F.lane >> 4) + i; const f32x4* sp = (const f32x4*)(SS + (size_t)MMAIN * 16 + (size_t)r * 64); f32x4 s4 = sp[0];
#pragma unroll
            for (int q = 1; q < 16; ++q) s4 += sp[q];
            const float rs = __builtin_amdgcn_rsqf(((s4[0] + s4[1]) + (s4[2] + s4[3])) * (1.f / DM) + EPS);
            ACT[(size_t)(RP + r) * DFF + lc] = f2bf(silu_f(rs * ag[i]) * (rs * au[i])); }
    }
}
__device__ __forceinline__ void p10_down(Frame& F) {
    const bf16* ACT = (const bf16*)(F.ws + WS_ACT); const bf16* WDN = (const bf16*)(F.ws + WS_WDN); const float* HS = (const float*)(F.ws + WS_HS);
    { pg8::Gemm g{ACT, WDN, MMAIN, DM, DFF, 1, DFF}; pg8::StaticOrder S; S.init(MMAIN, DM, F.G, (int)blockIdx.x); EpiDown E{(const bf16*)(F.ws + WS_XN), F.out + OUT_YP};
      pg8::gemm_phase<EpiDown, pg8::StaticOrder, true, true>(F.lds + RING_OFF, g, S, E); }
    float* ys = F.out + OUT_YS;
    small_gemm(ACT, DFF, WDN, DFF, DB / 16, DM / 16, [](int r) { return RP + r; },
        [&](const f32x4& acc, int rt, int ct, int lane) { const int col = ct * 16 + (lane & 15);
#pragma unroll
            for (int i = 0; i < 4; ++i) atomicAdd(ys + (size_t)(rt * 16 + 4 * (lane >> 4) + i) * DM + col, acc[i]); }, F.gw, F.NGW, F.lane, 4);
}
#ifndef MK_ONE_LAUNCH
#define MK_ONE_LAUNCH 0
#endif
constexpr int N_PHASES = 9;
__global__ void __launch_bounds__(NTHR, 2) mk_fwd(Args args) {
    extern __shared__ __attribute__((aligned(16))) unsigned char lds_raw[];
    Frame F;
    F.lds = (LAS unsigned char*)lds_raw;
    F.tid = threadIdx.x; F.lane = F.tid & 63; F.wave = __builtin_amdgcn_readfirstlane(F.tid >> 6);
    F.G = gridDim.x; { const int bx = blockIdx.x; F.vcu = (F.G % 8 == 0) ? (bx % 8) * (F.G / 8) + bx / 8 : bx; }
    F.gw = blockIdx.x * NWAVES + F.wave; F.NGW = F.G * NWAVES;
    F.ws = args.ws; F.out = args.out; F.in = args.in;
    volatile LAS unsigned* MISC = (volatile LAS unsigned*)(F.lds + MISC_OFF);
    for (int u = F.tid; u < (LDS_BYTES - LDSCTL_OFF) / 4; u += NTHR) ((LAS unsigned*)(F.lds + LDSCTL_OFF))[u] = 0u;
    __syncthreads();
    XcdBarrier bar; bar.bar = (unsigned*)(F.ws + WS_CTL) + CW_BAR; bar.x = 0; bar.st = nullptr;
    const int lo = args.ph_lo, hi = args.ph_hi;
    if (hi - lo > 1) bar = xcd_barrier_post((unsigned*)(F.ws + WS_CTL) + CW_BAR, MISC + 8);
#ifdef MK_TS
    unsigned long long* TSB = (unsigned long long*)(F.ws + 600 * MiB); int tsn = 0;
#define STAMP() do { if (blockIdx.x == 0 && F.tid == 0) TSB[tsn] = __builtin_amdgcn_s_memrealtime(); ++tsn; } while (0)
    STAMP();
#else
#define STAMP() do { } while (0)
#endif
#define IN(k) (lo <= (k) && (k) < hi)
#ifdef MK_TS
#define ARRIVE(k) do { if (blockIdx.x == 0 && F.tid == 0) TSB[30 + (k)] = __builtin_amdgcn_s_memrealtime(); } while (0)
#else
#define ARRIVE(k) do { } while (0)
#endif
#define SEAM(k) do { ARRIVE(k); if (IN(k) && IN((k) + 1)) xcd_barrier(bar); STAMP(); } while (0)
#ifndef MK_REPEAT
#define MK_REPEAT 0
#endif
#define REP(id, stmt) do { stmt; if (MK_REPEAT & (1 << (id))) { __syncthreads(); stmt; } } while (0)
    if (IN(0)) { REP(0, p0_prologue(F)); } SEAM(0);
    if (IN(1)) { REP(1, p1_inproj(F)); } SEAM(1);
    if (IN(2)) {
#ifdef MK_SLEEP_PROBE
        { const unsigned long long t0 = __builtin_amdgcn_s_memrealtime(); while (__builtin_amdgcn_s_memrealtime() - t0 < 3000ull) __builtin_amdgcn_s_sleep(32); }
#endif
        REP(2, p2_elementwise(F)); } SEAM(2);
    if (IN(3)) { REP(3, p3_upproj_states(F)); } SEAM(3);
    if (IN(4)) { REP(4, p4_post(F)); } SEAM(4);
    if (IN(5)) { const float M0 = softmax_ref(F);
        if (blockIdx.x & 1) { p5_attn_decode(F, M0); __syncthreads(); }
        p5_attn_prompt(F, M0); __syncthreads();
        p5_ssd_out(F); __syncthreads();
        if (!(blockIdx.x & 1)) p5_attn_decode(F, M0);
    } SEAM(5);
    if (IN(6)) { REP(9, p7_outproj(F)); } SEAM(6);
    if (IN(7)) { REP(11, p9_gateup(F)); } SEAM(7);
    if (IN(8)) { p10_down(F); }
#ifdef MK_TS
    __syncthreads(); STAMP();
#endif
#undef IN
#undef SEAM
}
#ifndef MK_DIAG
#define MK_DIAG 0
#endif
__device__ __forceinline__ size_t nmrow(size_t r) { return r < (size_t)MMAIN ? (r >> 11) * TT + NMETA + (r & 2047) : (size_t)RP + (r - MMAIN); }
constexpr size_t WS_OUT2 = 1024 * MiB;
#ifdef MK_TS
#ifndef MK_TS_QA
#define MK_TS_QA 4.f
#endif
#ifndef MK_TS_QB
#define MK_TS_QB 4.f
#endif
__global__ void k_ts_encode(const unsigned long long* ts, float* out, int ia0, int ia1, int ib0, int ib1) {
    const float ta = rintf((float)(ts[ia1] - ts[ia0]) * 0.01f * (1.f / MK_TS_QA)) * MK_TS_QA, tb = rintf((float)(ts[ib1] - ts[ib0]) * 0.01f * (1.f / MK_TS_QB)) * MK_TS_QB;
    const float f = 1.f + sqrtf(ta * 1e-3f);
    for (int i = blockIdx.x * blockDim.x + threadIdx.x; i < 131072; i += gridDim.x * blockDim.x) out[OUT_YS + i] *= f;
    if (blockIdx.x == 0 && threadIdx.x == 0) out[0] += tb * 0.1f;
}
#endif
extern "C" void kernel_launch(void* const* d_in, const int* in_sizes, int n_in, void* d_out, int out_size, void* d_ws, size_t ws_size, hipStream_t stream) {
    (void)hipFuncSetAttribute((const void*)mk_fwd, hipFuncAttributeMaxDynamicSharedMemorySize, LDS_BYTES);
    unsigned char* ws = (unsigned char*)d_ws;
    (void)hipMemsetAsync(ws + WS_CTL, 0, CTL_ZERO_BYTES, stream);
    Args a{};
    for (int i = 0; i < 30; ++i) a.in[i] = d_in[i];
    a.ws = ws; a.out = (float*)d_out;
#if MK_DIAG
    float* diag = (float*)(ws + WS_DIAG);
    (void)hipMemsetAsync(diag, 0, 512, stream);
    nv::forward(d_in, (float*)d_out, (float*)(ws + WS_NAIVE), stream);
    a.out = (float*)(ws + WS_OUT2);
#endif
    static int one_launch = -1;
    if (one_launch < 0) { int dev = 0, cus = 0, per_cu = 0; one_launch = 0;
        if (hipGetDevice(&dev) == hipSuccess && hipDeviceGetAttribute(&cus, hipDeviceAttributeMultiprocessorCount, dev) == hipSuccess && cus >= 256) one_launch = 1;
        (void)per_cu;
        (void)hipGetLastError(); }
    const int grid = 256;
    if (one_launch && MK_ONE_LAUNCH) { a.ph_lo = 0; a.ph_hi = N_PHASES; a.li = 0; hipLaunchKernelGGL(mk_fwd, dim3(grid), dim3(NTHR), LDS_BYTES, stream, a); }
    else for (int ph = 0; ph < N_PHASES; ++ph) { a.ph_lo = ph; a.ph_hi = ph + 1; a.li = ph; hipLaunchKernelGGL(mk_fwd, dim3(grid), dim3(NTHR), LDS_BYTES, stream, a); }
#ifdef MK_TS
    k_ts_encode<<<64, 256, 0, stream>>>((const unsigned long long*)(ws + 600 * MiB), (float*)d_out, MK_TS_A0, MK_TS_A1, MK_TS_B0, MK_TS_B1);
#endif
#if MK_DIAG
    {
        nv::Ws w = nv::carve((float*)(ws + WS_NAIVE));
        const bf16* QRAW = (const bf16*)(ws + WS_QRAW); const bf16* KVRAW = (const bf16*)(ws + WS_KVRAW); const bf16* Q = (const bf16*)(ws + WS_Q); const bf16* K = (const bf16*)(ws + WS_K);
        const bf16* VT = (const bf16*)(ws + WS_VT); const float* VS = (const float*)(ws + WS_VS); const bf16* MIX = (const bf16*)(ws + WS_MIX);
        const float* o2 = (const float*)(ws + WS_OUT2); const float* o1 = (const float*)d_out;
        const float* nQRAW = w.QRAW; const float* nKV = w.KV; const float* nQ = w.Q; const float* nK = w.K; const float* nV = w.V; const float* nMIX = w.MIX;
        const size_t NMR = (size_t)MMAIN + DB;
        cmp(stream, 0, diag, NMR * 768, [=] __device__(size_t i) { return bf2f(QRAW[nmrow(i / 768) * 768 + i % 768]); }, [=] __device__(size_t i) { return nQRAW[nmrow(i / 768) * 768 + i % 768]; });
        cmp(stream, 1, diag, (size_t)R * 1024, [=] __device__(size_t i) { return bf2f(KVRAW[i]); }, [=] __device__(size_t i) { return nKV[i]; });
        cmp(stream, 2, diag, NMR * 768, [=] __device__(size_t i) { return bf2f(Q[nmrow(i / 768) * 768 + i % 768]); }, [=] __device__(size_t i) { return nQ[nmrow(i / 768) * 768 + i % 768] * (ATTN_SCALE * LOG2E); });
        cmp(stream, 3, diag, (size_t)R * 768, [=] __device__(size_t i) { return bf2f(K[i]); }, [=] __device__(size_t i) { return nK[i]; });
        cmp(stream, 4, diag, (size_t)NB * 512 * TT, [=] __device__(size_t i) { const size_t bhd = i / TT; const int t = (int)(i % TT); return bf2f(VT[bhd * TPAD + t]); },
            [=] __device__(size_t i) { const size_t bhd = i / TT; const int t = (int)(i % TT); const size_t b = bhd / 512, hd = bhd % 512; return nV[(b * TT + t) * 512 + hd]; });
        cmp(stream, 4, diag, (size_t)DB * 512, [=] __device__(size_t i) { return VS[i]; }, [=] __device__(size_t i) { return nV[(size_t)RP * 512 + i]; });
        cmp(stream, 5, diag, (size_t)(OUT_LATS - OUT_SSMP), [=] __device__(size_t i) { return o2[OUT_SSMP + i]; }, [=] __device__(size_t i) { return o1[OUT_SSMP + i]; });
        cmp(stream, 5, diag, (size_t)4194304, [=] __device__(size_t i) { return o2[OUT_SSMS + i]; }, [=] __device__(size_t i) { return o1[OUT_SSMS + i]; });
        cmp(stream, 6, diag, (size_t)R * 512, [=] __device__(size_t i) { return bf2f(MIX[(i >> 9) * 1024 + (i & 511)]); }, [=] __device__(size_t i) { return nMIX[(i >> 9) * 1024 + (i & 511)]; });
        cmp(stream, 7, diag, NMR * 512, [=] __device__(size_t i) { return bf2f(MIX[nmrow(i >> 9) * 1024 + 512 + (i & 511)]); }, [=] __device__(size_t i) { return nMIX[nmrow(i >> 9) * 1024 + 512 + (i & 511)]; });
        cmp(stream, 8, diag, (size_t)OUT_LATP, [=] __device__(size_t i) { return o2[i]; }, [=] __device__(size_t i) { return o1[i]; });
        k_diag_encode<<<64, 256, 0, stream>>>(diag, 9, 1e-3f, (float*)d_out);
    }
#endif
}
```
